# Optimizing an MI355X kernel written in HIP

```python
import jax, jax.numpy as jnp
from jax import lax
import numpy as np

D_MODEL = 1024
BATCH = 1
SEQ = 16384
DEPTH = 4

N_MEM = 256
BRANCH_WIDTH = 512
N_BRANCH = 3
MLA_HEADS = 8
MLA_NOPE = 64
MLA_ROPE = 32
MLA_QK = MLA_NOPE + MLA_ROPE
MLA_V = BRANCH_WIDTH // MLA_HEADS
Q_RANK = 384
KV_RANK = 256
ROPE_THETA = 10000.0
Q_BLOCK = 128
SG_CHUNK = 128
SG_GROUPS = 4
SG_WIDTH = BRANCH_WIDTH
X_HEADS = 4
X_HEAD_DIM = BRANCH_WIDTH // X_HEADS
D_FF = 2688
N_EXPERTS = 8
TOP_K = 2
D_FF_EXPERT = 3584
N_DENSE = (DEPTH + 1) // 2
N_MOE = DEPTH // 2
EPS = 1e-6

P_DQ = Q_RANK
P_DKV = KV_RANK
P_KR = MLA_ROPE
P_SG = 2 * SG_WIDTH
P_XQ = X_HEADS * X_HEAD_DIM
P_GATE = N_BRANCH * D_MODEL
P_TOTAL = P_DQ + P_DKV + P_KR + P_SG + P_XQ + P_GATE
SPLITS = [P_DQ, P_DQ + P_DKV, P_DQ + P_DKV + P_KR, P_DQ + P_DKV + P_KR + P_SG,
          P_DQ + P_DKV + P_KR + P_SG + P_XQ]

kernel_name = 'hybrid_mla_sgmlp_mem_moe_encoder'


def rmsnorm(x, g):
    xf = x.astype(jnp.float32)
    y = xf * lax.rsqrt(jnp.mean(xf * xf, axis=-1, keepdims=True) + EPS)
    return (y * g.astype(jnp.float32)).astype(x.dtype)


def rope(t, positions):
    r = t.shape[-1]
    inv_freq = 1.0 / (ROPE_THETA ** (jnp.arange(0, r, 2, dtype=jnp.float32) / r))
    ang = positions.astype(jnp.float32)[..., None] * inv_freq
    cos = jnp.cos(ang)[:, :, None, :]
    sin = jnp.sin(ang)[:, :, None, :]
    tf = t.astype(jnp.float32)
    t1, t2 = tf[..., : r // 2], tf[..., r // 2:]
    out = jnp.concatenate([t1 * cos - t2 * sin, t1 * sin + t2 * cos], axis=-1)
    return out.astype(t.dtype)


def mla_branch(c_q_raw, c_kv_raw, k_r_raw, positions, g_q, g_kv, w_uq, w_uk, w_uv):
    b, s, _ = c_q_raw.shape
    c_q = rmsnorm(c_q_raw, g_q)
    q = (c_q @ w_uq).reshape(b, s, MLA_HEADS, MLA_QK)
    q = jnp.concatenate([q[..., :MLA_NOPE], rope(q[..., MLA_NOPE:], positions)], axis=-1)
    q = q * (MLA_QK ** -0.5)
    c_kv = rmsnorm(c_kv_raw, g_kv)
    k_nope = (c_kv @ w_uk).reshape(b, s, MLA_HEADS, MLA_NOPE)
    v = (c_kv @ w_uv).reshape(b, s, MLA_HEADS, MLA_V)
    k_rope = rope(k_r_raw[:, :, None, :], positions)
    k = jnp.concatenate([k_nope, jnp.broadcast_to(k_rope, (b, s, MLA_HEADS, MLA_ROPE))], axis=-1)
    qb = q.reshape(b, s // Q_BLOCK, Q_BLOCK, MLA_HEADS, MLA_QK).transpose(1, 0, 2, 3, 4)

    def attend(q_blk):
        sc = jnp.einsum('bqhd,bkhd->bhqk', q_blk, k).astype(jnp.float32)
        pr = jax.nn.softmax(sc, axis=-1).astype(v.dtype)
        return jnp.einsum('bhqk,bkhd->bqhd', pr, v)

    o = lax.map(attend, qb)
    return o.transpose(1, 0, 2, 3, 4).reshape(b, s, MLA_HEADS * MLA_V)


def spatial_gating_branch(z, g_v, w_s, b_s):
    b, s, _ = z.shape
    z = jax.nn.gelu(z)
    u, v = z[..., :SG_WIDTH], z[..., SG_WIDTH:]
    v = rmsnorm(v, g_v)
    vc = v.reshape(b, s // SG_CHUNK, SG_CHUNK, SG_GROUPS, SG_WIDTH // SG_GROUPS)
    sg = jnp.einsum('gij,bnjgc->bnigc', w_s, vc) + b_s.T[None, None, :, :, None]
    return u * sg.reshape(b, s, SG_WIDTH)


def memory_branch(q_raw, mem_n, w_mkv):
    b, s, _ = q_raw.shape
    q = q_raw.reshape(b, s, X_HEADS, X_HEAD_DIM) * (X_HEAD_DIM ** -0.5)
    kv = mem_n @ w_mkv
    m = kv.shape[1]
    k = kv[..., :BRANCH_WIDTH].reshape(b, m, X_HEADS, X_HEAD_DIM)
    v = kv[..., BRANCH_WIDTH:].reshape(b, m, X_HEADS, X_HEAD_DIM)
    sc = jnp.einsum('bshd,bmhd->bhsm', q, k).astype(jnp.float32)
    pr = jax.nn.softmax(sc, axis=-1).astype(v.dtype)
    return jnp.einsum('bhsm,bmhd->bshd', pr, v).reshape(b, s, BRANCH_WIDTH)


def swiglu(h, w1, w3, w2):
    return (jax.nn.silu(h @ w1) * (h @ w3)) @ w2


def moe_swiglu(h, w_router, w1, w3, w2):
    logits = (h @ w_router).astype(jnp.float32)
    top_v, top_i = lax.top_k(logits, TOP_K)
    wts = jax.nn.softmax(top_v, axis=-1)
    combine = jnp.sum(jax.nn.one_hot(top_i, N_EXPERTS, dtype=jnp.float32) * wts[..., None], axis=-2)
    combine = combine.astype(h.dtype)
    out = jnp.zeros_like(h)
    for e in range(N_EXPERTS):
        out = out + combine[..., e:e + 1] * swiglu(h, w1[e], w3[e], w2[e])
    return out


def setup_inputs(seed: int = 0) -> dict:
    key = jax.random.key(seed)
    ks = iter(jax.random.split(key, 40))
    f32 = jnp.float32

    def nrm(shape, fan_in):
        return jax.random.normal(next(ks), shape, f32) * (fan_in ** -0.5)

    def gain(shape):
        return 1.0 + 0.02 * jax.random.normal(next(ks), shape, f32)

    x = jax.random.normal(next(ks), (BATCH, SEQ, D_MODEL), f32)
    mem = jax.random.normal(next(ks), (BATCH, N_MEM, D_MODEL), f32)
    positions = jnp.broadcast_to(jnp.arange(SEQ, dtype=jnp.int32), (BATCH, SEQ))
    return {
        'x': x,
        'mem': mem,
        'positions': positions,
        'g_mix': gain((DEPTH, D_MODEL)),
        'w_in': nrm((DEPTH, D_MODEL, P_TOTAL), D_MODEL),
        'g_q': gain((DEPTH, Q_RANK)),
        'g_kv': gain((DEPTH, KV_RANK)),
        'w_uq': nrm((DEPTH, Q_RANK, MLA_HEADS * MLA_QK), Q_RANK),
        'w_uk': nrm((DEPTH, KV_RANK, MLA_HEADS * MLA_NOPE), KV_RANK),
        'w_uv': nrm((DEPTH, KV_RANK, MLA_HEADS * MLA_V), KV_RANK),
        'g_sg': gain((DEPTH, SG_WIDTH)),
        'w_s': nrm((DEPTH, SG_GROUPS, SG_CHUNK, SG_CHUNK), SG_CHUNK),
        'b_s': gain((DEPTH, SG_GROUPS, SG_CHUNK)),
        'g_mem': gain((D_MODEL,)),
        'w_mkv': nrm((DEPTH, D_MODEL, 2 * BRANCH_WIDTH), D_MODEL),
        'w_br': nrm((DEPTH, N_BRANCH, BRANCH_WIDTH, D_MODEL), BRANCH_WIDTH),
        'b_gate': 0.02 * jax.random.normal(next(ks), (DEPTH, N_BRANCH, D_MODEL), f32),
        'w_out': nrm((DEPTH, D_MODEL, D_MODEL), D_MODEL),
        'g_ffn': gain((DEPTH, D_MODEL)),
        'dense_w1': nrm((N_DENSE, D_MODEL, D_FF), D_MODEL),
        'dense_w3': nrm((N_DENSE, D_MODEL, D_FF), D_MODEL),
        'dense_w2': nrm((N_DENSE, D_FF, D_MODEL), D_FF),
        'w_router': nrm((N_MOE, D_MODEL, N_EXPERTS), D_MODEL),
        'moe_w1': nrm((N_MOE, N_EXPERTS, D_MODEL, D_FF_EXPERT), D_MODEL),
        'moe_w3': nrm((N_MOE, N_EXPERTS, D_MODEL, D_FF_EXPERT), D_MODEL),
        'moe_w2': nrm((N_MOE, N_EXPERTS, D_FF_EXPERT, D_MODEL), D_FF_EXPERT),
        'g_final': gain((D_MODEL,)),
    }


def reference(x, mem, positions, g_mix, w_in, g_q, g_kv, w_uq, w_uk, w_uv, g_sg, w_s, b_s,
              g_mem, w_mkv, w_br, b_gate, w_out, g_ffn, dense_w1, dense_w3, dense_w2,
              w_router, moe_w1, moe_w3, moe_w2, g_final):
    b, s, d = x.shape
    mem_n = rmsnorm(mem, g_mem)
    for l in range(DEPTH):
        h = rmsnorm(x, g_mix[l])
        p = h @ w_in[l]
        c_q, c_kv, k_r, z_sg, q_x, gate_logits = jnp.split(p, SPLITS, axis=-1)
        y_a = mla_branch(c_q, c_kv, k_r, positions, g_q[l], g_kv[l], w_uq[l], w_uk[l], w_uv[l])
        y_b = spatial_gating_branch(z_sg, g_sg[l], w_s[l], b_s[l])
        y_c = memory_branch(q_x, mem_n, w_mkv[l])
        ys = jnp.stack([y_a, y_b, y_c], axis=2)
        yd = jnp.einsum('bsnw,nwd->bsnd', ys, w_br[l])
        gates = jax.nn.sigmoid(gate_logits.reshape(b, s, N_BRANCH, d) + b_gate[l])
        x = x + jnp.sum(gates * yd, axis=2) @ w_out[l]
        h = rmsnorm(x, g_ffn[l])
        if l % 2 == 0:
            j = l // 2
            x = x + swiglu(h, dense_w1[j], dense_w3[j], dense_w2[j])
        else:
            j = l // 2
            x = x + moe_swiglu(h, w_router[j], moe_w1[j], moe_w3[j], moe_w2[j])
    return rmsnorm(x, g_final)
```

```cpp
#include <hip/hip_runtime.h>
#include <cstdio>
#include <cstdint>

#ifndef PH_MASK
#define PH_MASK 0xffffffffu
#endif
#define PH(k) ((PH_MASK >> (k)) & 1u)
#define LAS __attribute__((address_space(3)))
#define GAS __attribute__((address_space(1)))
typedef unsigned short bf16;
typedef short bf16x8 __attribute__((ext_vector_type(8)));
typedef short s16x4 __attribute__((ext_vector_type(4)));
typedef float f32x4 __attribute__((ext_vector_type(4)));
typedef float f32x2 __attribute__((ext_vector_type(2)));
typedef float f32x16 __attribute__((ext_vector_type(16)));
typedef unsigned u32x4 __attribute__((ext_vector_type(4)));
typedef unsigned u32x2 __attribute__((ext_vector_type(2)));
typedef int i32x4 __attribute__((ext_vector_type(4)));

constexpr int M = 16384, D = 1024, DEPTH = 4, NMEM = 256;
constexpr int QRANK = 384, KVRANK = 256, NH = 8, QKD = 96, VD = 64;
constexpr int XH = 4, XD = 128, BW = 512;
constexpr int PTOT = 5280, PPAD = 5376, DFF = 2688, NE = 8, DFE = 3584;
constexpr float EPS = 1e-6f;
constexpr int MAXSLOT = 34816;
constexpr float LOG2E = 1.4426950408889634f;
constexpr float QSCALE = 0.10206207261596575f * LOG2E;
constexpr float XSCALE = 0.08838834764831845f * LOG2E;

constexpr size_t MiB = 1u << 20, KiB = 1u << 10;
constexpr size_t WS_CTL = 0, CTL_ZERO_BYTES = 1 * MiB;
constexpr size_t WS_ROPE = 2 * MiB;
constexpr size_t WS_XSTAT = 4 * MiB;
constexpr size_t WS_RX = 5 * MiB;
constexpr size_t WS_CQSTAT = 5 * MiB + 256 * KiB;
constexpr size_t WS_CKVSTAT = 5 * MiB + 768 * KiB;
constexpr size_t WS_VSTAT = 6 * MiB;
constexpr size_t WS_MEMB = 6 * MiB + 512 * KiB;
constexpr size_t WS_KVMEM = 7 * MiB;
constexpr size_t WS_TOPI = 9 * MiB;
constexpr size_t WS_TOPW = 9 * MiB + 256 * KiB;
constexpr size_t WS_LRANK = 9 * MiB + 512 * KiB;
constexpr size_t WS_POS = 9 * MiB + 768 * KiB;
constexpr size_t WS_BLKCNT = 10 * MiB;
constexpr size_t WS_SLOTR = 10 * MiB + 512 * KiB;
constexpr size_t WS_WSB = 11 * MiB;
constexpr size_t WS_WMKVT = 12 * MiB;
constexpr size_t WS_WINT = 20 * MiB;
constexpr size_t WS_WUQT = 31 * MiB;
constexpr size_t WS_WUKVT = 32 * MiB;
constexpr size_t WS_WBRT = 33 * MiB;
constexpr size_t WS_WOUTT = 36 * MiB;
constexpr size_t WS_WFFN = 40 * MiB;
constexpr size_t WS_W2D = WS_WFFN + 11 * MiB;
constexpr size_t WS_W2M = WS_WFFN + 112 * MiB;
constexpr size_t WS_XB = 208 * MiB;
constexpr size_t WS_CQ = 240 * MiB;
constexpr size_t WS_CKV = 256 * MiB;
constexpr size_t WS_U = 264 * MiB;
constexpr size_t WS_VR = 280 * MiB;
constexpr size_t WS_QX = 296 * MiB;
constexpr size_t WS_GATE = 312 * MiB;
constexpr size_t WS_Q = 408 * MiB;
constexpr size_t WS_KN = 432 * MiB;
constexpr size_t WS_KR = 448 * MiB;
constexpr size_t WS_V = 450 * MiB;
constexpr size_t WS_Y = 466 * MiB;
constexpr size_t WS_MIX = 514 * MiB;
constexpr size_t WS_MIXB = 578 * MiB;
constexpr size_t WS_MIX1 = 610 * MiB;
constexpr size_t WS_HFF = 240 * MiB;
constexpr size_t WS_XG = 240 * MiB;
constexpr size_t WS_HG = 308 * MiB;
constexpr size_t WS_OUTG = 546 * MiB;
constexpr size_t WS_END = 682 * MiB;
constexpr int CW_TMO = 0, CW_CODE = 1, CW_CHK = 2, CW_BAR = 4096;
constexpr int CW_KMAX = 8192;

constexpr int RING_BYTES = 131072, LDSCTL_OFF = 159744, MISC_OFF = LDSCTL_OFF + 320, LDS_BYTES = 163840;
constexpr int NWAVES = 8;

#define RLX_AGENT __ATOMIC_RELAXED, __HIP_MEMORY_SCOPE_AGENT
#define LDS_WAIT() asm volatile("s_waitcnt lgkmcnt(0)" ::: "memory")
#define VM_WAIT() asm volatile("s_waitcnt vmcnt(0)" ::: "memory")
typedef __bf16 bf16x2_t __attribute__((ext_vector_type(2)));
__device__ __forceinline__ unsigned cvt_pk_bf16(float lo, float hi) { const f32x2 v = {lo, hi}; const bf16x2_t b = __builtin_convertvector(v, bf16x2_t); return __builtin_bit_cast(unsigned, b); }
__device__ __forceinline__ bf16 f2bf(float f) { return (bf16)(cvt_pk_bf16(f, 0.f) & 0xffffu); }
__device__ __forceinline__ float bf2f(bf16 v) { return __uint_as_float((unsigned)v << 16); }
__device__ __forceinline__ float bflo(unsigned w) { return __uint_as_float(w << 16); }
__device__ __forceinline__ float bfhi(unsigned w) { return __uint_as_float(w & 0xffff0000u); }
__device__ __forceinline__ float fast_exp2(float x) { return __builtin_amdgcn_exp2f(x); }
__device__ __forceinline__ float fast_rcp(float x) { return __builtin_amdgcn_rcpf(x); }
__device__ __forceinline__ float sigmoidf_(float z) { return fast_rcp(1.f + fast_exp2(-LOG2E * z)); }
__device__ __forceinline__ float gelu_tanh(float x) { const float t = x + 0.044715f * x * x * x; return x * fast_rcp(1.f + fast_exp2(-2.f * 0.7978845608028654f * LOG2E * t)); }
__device__ __forceinline__ float wave_sum(float v) {
#pragma unroll
    for (int o = 1; o < 64; o <<= 1) v += __shfl_xor(v, o);
    return v;
}
__device__ __forceinline__ float sumsq4(f32x4 v) { return (v[0] * v[0] + v[1] * v[1]) + (v[2] * v[2] + v[3] * v[3]); }
__device__ __forceinline__ u32x4 pack8(f32x4 a, f32x4 b) { u32x4 w; w.x = cvt_pk_bf16(a[0], a[1]); w.y = cvt_pk_bf16(a[2], a[3]); w.z = cvt_pk_bf16(b[0], b[1]); w.w = cvt_pk_bf16(b[2], b[3]); return w; }
__device__ __forceinline__ void unpack8(u32x4 w, f32x4& a, f32x4& b) { a = (f32x4){bflo(w.x), bfhi(w.x), bflo(w.y), bfhi(w.y)}; b = (f32x4){bflo(w.z), bfhi(w.z), bflo(w.w), bfhi(w.w)}; }

namespace pg8 {
constexpr int BM = 256, BK = 64, HALF = 128, HTB = HALF * BK * 2, STAGE_BYTES = 8 * HTB, NXCD = 8, WGM = 8;
__host__ __device__ __forceinline__ int lds_byte(int r, int c) { const int st = (r >> 4) * 2 + (c >> 5), rr = r & 15, cc = c & 31, ob = rr * 64 + cc * 2; return st * 1024 + (ob ^ (((ob >> 9) & 1) << 5)); }
__host__ __device__ __forceinline__ void stage_rc(int b, int& R, int& C) { const int st = b / 1024, sb = b % 1024, swz = sb ^ (((sb >> 9) & 1) << 5); R = (st >> 1) * 16 + swz / 64; C = (st & 1) * 32 + (swz % 64) / 2; }
__host__ __device__ __forceinline__ int perm32(int rho) { const int n = rho >> 4, i = rho & 15; return 8 * (i >> 2) + 4 * n + (i & 3); }

struct Unit { const char* A; const char* B; int pm, pn, aux; };
typedef f32x4 Acc[2][2][4][2];

__device__ __forceinline__ void tile_of(int L, int nM, int nN, int& pm, int& pn) {
    const int nwg = nM * nN; int wgid = L;
    { const int q = nwg / NXCD, r = nwg % NXCD, xcd = wgid % NXCD, off = wgid / NXCD; wgid = (xcd < r ? xcd * (q + 1) : r * (q + 1) + (xcd - r) * q) + off; }
    const int nig = WGM * nN, gid = wgid / nig, fm = gid * WGM, gsz = (nM - fm) < WGM ? (nM - fm) : WGM;
    pm = fm + ((wgid % nig) % gsz); pn = (wgid % nig) / gsz;
}
struct TileOrder {
    int nM, nN, G, c; const char* A; const char* B; size_t astep, bstep;
    int rev = 0;
    __device__ __forceinline__ bool next(int i, Unit& u) const {
        if (rev) { const int cnt = (nM * nN - c + G - 1) / G; if (i >= cnt) return false; i = cnt - 1 - i; }
        const long L = (long)i * G + c; if (L >= (long)nM * nN) return false;
        int pm, pn; tile_of((int)L, nM, nN, pm, pn);
        u.pm = pm; u.pn = pn; u.aux = 0; u.A = A + (size_t)pm * astep; u.B = B + (size_t)pn * bstep; return true;
    }
};

template <class Epi, class Sched>
__device__ __forceinline__ void gemm_phase(LAS unsigned char* lds, const int lda, const int ldb, const int K, const Sched& S, const Epi& E) {
    int tid_ = threadIdx.x; asm volatile("" : "+v"(tid_));
    const int tid = tid_, wid = __builtin_amdgcn_readfirstlane(tid >> 6), lane = tid & 63, wr = wid >> 2, wc = wid & 3, fr = lane & 15, fq = lane >> 4;
    const int nt = K / BK;
    unsigned voffA[2], voffB[2];
#pragma unroll
    for (int i = 0; i < 2; ++i) { int R, C; stage_rc(tid * 16 + i * 8192, R, C); const int Rb = (R & ~31) + perm32(R & 31);
        voffA[i] = (unsigned)(R * (lda ? lda : BK) + C) * 2u; voffB[i] = (unsigned)(Rb * BK + C) * 2u; }
    const size_t kstep = lda ? (size_t)(BK * 2) : (size_t)BM * BK * 2;
    const size_t hstepA = (size_t)HALF * (lda ? lda : BK) * 2, hstepB = (size_t)HALF * BK * 2, kstepB = (size_t)BM * BK * 2; (void)ldb;
    const unsigned ldsw = (unsigned)wid * 1024u;
    const int aoff = lds_byte(wr * 64 + fr, fq * 8), boff = lds_byte(wc * 32 + fr, fq * 8);
#define PG8_SA(b, h) (((b) * 2 + (h)) * HTB)
#define PG8_SB(b, h) ((4 + (b) * 2 + (h)) * HTB)
#define PG8_STAGE(bufoff, gbase, voff) do { _Pragma("unroll") for (int _i = 0; _i < 2; ++_i) \
        __builtin_amdgcn_global_load_lds((const unsigned*)((const char*)(gbase) + (voff)[_i]), (LAS unsigned*)(lds + (bufoff) + ldsw + _i * 8192), 16, 0, 0); } while (0)
#define PG8_LDA(dst, b, h) do { _Pragma("unroll") for (int m = 0; m < 4; ++m) _Pragma("unroll") for (int k = 0; k < 2; ++k) dst[m][k] = *(const LAS bf16x8*)(lds + PG8_SA(b, h) + aoff + m * 2048 + k * 1024); } while (0)
#define PG8_LDB(dst, b, h) do { _Pragma("unroll") for (int n = 0; n < 2; ++n) _Pragma("unroll") for (int k = 0; k < 2; ++k) dst[n][k] = *(const LAS bf16x8*)(lds + PG8_SB(b, h) + boff + n * 2048 + k * 1024); } while (0)
#define PG8_MMA(ai, bj, At, Bt) do { __builtin_amdgcn_s_setprio(1); _Pragma("unroll") for (int m = 0; m < 4; ++m) _Pragma("unroll") for (int n = 0; n < 2; ++n) _Pragma("unroll") for (int k = 0; k < 2; ++k) \
        acc[ai][bj][m][n] = __builtin_amdgcn_mfma_f32_16x16x32_bf16(Bt[n][k], At[m][k], acc[ai][bj][m][n], 0, 0, 0); __builtin_amdgcn_s_setprio(0); } while (0)
#define PG8_WAIT_V(n) asm volatile("s_waitcnt vmcnt(" #n ")" ::: "memory")
#define PG8_WAIT_L(n) asm volatile("s_waitcnt lgkmcnt(" #n ")" ::: "memory")
#define PG8_BAR __builtin_amdgcn_s_barrier()
#define PG8_SCHED __builtin_amdgcn_sched_barrier(0)
    Unit cur, nxt; int ui = 0;
    if (!S.next(0, cur)) return;
    typename Epi::Pre pre = E.prefetch(cur, wr, fr);
    Acc acc;
#pragma unroll
    for (int a = 0; a < 2; ++a)
#pragma unroll
        for (int b = 0; b < 2; ++b)
#pragma unroll
            for (int m = 0; m < 4; ++m)
#pragma unroll
                for (int n = 0; n < 2; ++n) acc[a][b][m][n] = (f32x4){0.f, 0.f, 0.f, 0.f};
    bf16x8 At[4][2], B0[2][2], B1[2][2];
    const char* cA = cur.A; const char* cB = cur.B;
    PG8_STAGE(PG8_SB(0, 0), cB, voffB); PG8_STAGE(PG8_SB(0, 1), cB + hstepB, voffB); PG8_STAGE(PG8_SA(0, 0), cA, voffA); PG8_STAGE(PG8_SA(0, 1), cA + hstepA, voffA);
    if (wr == 1) PG8_BAR;
    PG8_WAIT_V(2); PG8_BAR;
    PG8_STAGE(PG8_SB(1, 0), cB + kstepB, voffB); PG8_STAGE(PG8_SA(1, 0), cA + kstep, voffA); PG8_STAGE(PG8_SB(1, 1), cB + hstepB + kstepB, voffB);
    PG8_WAIT_V(6); PG8_BAR;
    for (;;) {
        const bool has_next = S.next(ui + 1, nxt);
        const char* nA = has_next ? nxt.A : cA; const char* nB = has_next ? nxt.B : cB;
        for (int t = 0; t < nt; t += 2) {
            const bool last = (t == nt - 2);
            const char* a1 = cA + (size_t)(t + 1) * kstep;
            const char* a2 = last ? nA : cA + (size_t)(t + 2) * kstep; const char* b2 = last ? nB : cB + (size_t)(t + 2) * kstepB;
            const char* a3 = a2 + kstep; const char* b3 = b2 + kstepB;
            PG8_LDB(B0, 0, 0); PG8_LDB(B1, 0, 1); PG8_SCHED; PG8_LDA(At, 0, 0); PG8_STAGE(PG8_SA(1, 1), a1 + hstepA, voffA);
            PG8_WAIT_V(8); PG8_WAIT_L(0); PG8_BAR; PG8_MMA(0, 0, At, B0); PG8_MMA(0, 1, At, B1); PG8_BAR; PG8_SCHED;
            PG8_LDA(At, 0, 1); PG8_STAGE(PG8_SB(0, 0), b2, voffB); PG8_STAGE(PG8_SB(0, 1), b2 + hstepB, voffB); PG8_STAGE(PG8_SA(0, 0), a2, voffA);
            PG8_WAIT_V(8); PG8_WAIT_L(0); PG8_BAR; PG8_MMA(1, 0, At, B0); PG8_MMA(1, 1, At, B1); PG8_BAR; PG8_SCHED;
            PG8_LDB(B0, 1, 0); PG8_LDB(B1, 1, 1); PG8_SCHED; PG8_LDA(At, 1, 0); PG8_STAGE(PG8_SA(0, 1), a2 + hstepA, voffA);
            PG8_WAIT_V(8); PG8_WAIT_L(0); PG8_BAR; PG8_MMA(0, 0, At, B0); PG8_MMA(0, 1, At, B1); PG8_BAR; PG8_SCHED;
            PG8_LDA(At, 1, 1); PG8_STAGE(PG8_SB(1, 0), b3, voffB); PG8_STAGE(PG8_SB(1, 1), b3 + hstepB, voffB); PG8_STAGE(PG8_SA(1, 0), a3, voffA);
            PG8_WAIT_V(8); PG8_WAIT_L(0); PG8_BAR; PG8_MMA(1, 0, At, B0); PG8_MMA(1, 1, At, B1); PG8_BAR; PG8_SCHED;
        }
        if (wr == 0) PG8_BAR;
        E(acc, cur, wr, wc, fr, fq, pre);
        if (!has_next) break;
        pre = E.prefetch(nxt, wr, fr);
#pragma unroll
        for (int a = 0; a < 2; ++a)
#pragma unroll
            for (int b = 0; b < 2; ++b)
#pragma unroll
                for (int m = 0; m < 4; ++m)
#pragma unroll
                    for (int n = 0; n < 2; ++n) acc[a][b][m][n] = (f32x4){0.f, 0.f, 0.f, 0.f};
        cur = nxt; cA = nA; cB = nB; ++ui;
        if (wr == 1) PG8_BAR;
    }
    PG8_WAIT_V(0);
    PG8_BAR;
#undef PG8_SA
#undef PG8_SB
#undef PG8_STAGE
#undef PG8_LDA
#undef PG8_LDB
#undef PG8_MMA
#undef PG8_WAIT_V
#undef PG8_WAIT_L
#undef PG8_BAR
#undef PG8_SCHED
}

#define EPI_FOR _Pragma("unroll") for (int ai = 0; ai < 2; ++ai) _Pragma("unroll") for (int m = 0; m < 4; ++m)
#define EPI_ROW (u.pm * BM + ai * HALF + wr * 64 + m * 16 + fr)
#define EPI_C8(bj) (u.pn * BM + (bj) * HALF + wc * 32 + 8 * fq)
#define EPI_LOAD_R(rr, ptr) float rr[2][4]; _Pragma("unroll") for (int ai = 0; ai < 2; ++ai) _Pragma("unroll") for (int m = 0; m < 4; ++m) rr[ai][m] = (ptr)[EPI_ROW]; asm volatile("" ::: "memory")

#define EPI_LOAD_RS(rr, xstat) float rr[2][4]; { f32x4 st_[2][4]; _Pragma("unroll") for (int ai = 0; ai < 2; ++ai) _Pragma("unroll") for (int m = 0; m < 4; ++m) st_[ai][m] = *(const f32x4*)((xstat) + (size_t)EPI_ROW * 16 + 4 * fq); \
    asm volatile("" ::: "memory"); _Pragma("unroll") for (int ai = 0; ai < 2; ++ai) _Pragma("unroll") for (int m = 0; m < 4; ++m) { float t_ = (st_[ai][m][0] + st_[ai][m][1]) + (st_[ai][m][2] + st_[ai][m][3]); \
        t_ += __shfl_xor(t_, 16); t_ += __shfl_xor(t_, 32); rr[ai][m] = __builtin_amdgcn_rsqf(t_ * (1.f / D) + EPS); } }
struct NoPre {};
#define EPI_NOPRE typedef NoPre Pre; __device__ __forceinline__ Pre prefetch(const Unit&, int, int) const { return Pre{}; }
struct RowPre { float r[2][4]; };
struct EpiInProj {
    unsigned char* ws; const float* bgate; int layer; int from_stats;
    typedef RowPre Pre;
    __device__ __forceinline__ Pre prefetch(const Unit& u, int wr, int fr) const { Pre p; const float* rx = (const float*)(ws + WS_RX);
#pragma unroll
        for (int ai = 0; ai < 2; ++ai)
#pragma unroll
            for (int m = 0; m < 4; ++m) p.r[ai][m] = from_stats ? 0.f : rx[EPI_ROW];
        return p; }
    __device__ __forceinline__ void operator()(const Acc& acc, const Unit& u, int wr, int wc, int fr, int fq, const Pre& pre) const {
        const float* rx = (const float*)(ws + WS_RX); const float* rope = (const float*)(ws + WS_ROPE);
        bf16* CQ = (bf16*)(ws + WS_CQ); bf16* KR = (bf16*)(ws + WS_KR); bf16* CKV = (bf16*)(ws + WS_CKV); bf16* U = (bf16*)(ws + WS_U); bf16* VR = (bf16*)(ws + WS_VR); bf16* QX = (bf16*)(ws + WS_QX); bf16* GATE = (bf16*)(ws + WS_GATE);
        float* cqstat = (float*)(ws + WS_CQSTAT); float* ckvstat = (float*)(ws + WS_CKVSTAT); float* vstat = (float*)(ws + WS_VSTAT); unsigned* kmax = (unsigned*)(ws + WS_CTL) + CW_KMAX + layer * 32;
        const int pn = u.pn;
        float rr[2][4];
        if (from_stats) { EPI_LOAD_RS(rs_, (const float*)(ws + WS_XSTAT));
#pragma unroll
            for (int ai = 0; ai < 2; ++ai)
#pragma unroll
                for (int m = 0; m < 4; ++m) rr[ai][m] = rs_[ai][m]; }
        else {
#pragma unroll
            for (int ai = 0; ai < 2; ++ai)
#pragma unroll
                for (int m = 0; m < 4; ++m) rr[ai][m] = pre.r[ai][m]; }
        if (pn < 2) {
            float krmax = 0.f;
            EPI_FOR { const int row = EPI_ROW;
                const float r = rr[ai][m]; float ss = 0.f;
#pragma unroll
                for (int bj = 0; bj < 2; ++bj) { const f32x4 v0 = acc[ai][bj][m][0] * r, v1 = acc[ai][bj][m][1] * r;
                    if (!(pn == 1 && bj == 1)) ss += sumsq4(v0) + sumsq4(v1);
                    *(u32x4*)(CQ + (size_t)row * 512 + pn * 256 + bj * HALF + wc * 32 + 8 * fq) = pack8(v0, v1);
                    if (pn == 1 && bj == 1 && wc == 0) {
                        const f32x4 c = *(const f32x4*)(rope + (size_t)row * 32 + 4 * fq), s = *(const f32x4*)(rope + (size_t)row * 32 + 16 + 4 * fq);
                        const f32x4 o0 = v0 * c - v1 * s, o1 = v0 * s + v1 * c;
                        *(u32x4*)(KR + (size_t)row * 32 + 8 * fq) = pack8(o0, o1);
                        float q2 = sumsq4(o0) + sumsq4(o1); q2 += __shfl_xor(q2, 16); q2 += __shfl_xor(q2, 32); krmax = fmaxf(krmax, q2); } }
                ss += __shfl_xor(ss, 16); ss += __shfl_xor(ss, 32);
                if (fq == 0) cqstat[(size_t)row * 8 + pn * 4 + wc] = ss;
            }
            if (pn == 1 && wc == 0) {
#pragma unroll
                for (int o = 1; o < 16; o <<= 1) krmax = fmaxf(krmax, __shfl_xor(krmax, o));
                if ((fr | fq) == 0) atomicMax(kmax + 16, __float_as_uint(krmax)); }
        } else if (pn == 2) {
            EPI_FOR { const int row = EPI_ROW;
                const float r = rr[ai][m]; float ss = 0.f;
#pragma unroll
                for (int bj = 0; bj < 2; ++bj) { const f32x4 v0 = acc[ai][bj][m][0] * r, v1 = acc[ai][bj][m][1] * r; ss += sumsq4(v0) + sumsq4(v1);
                    *(u32x4*)(CKV + (size_t)row * 256 + bj * HALF + wc * 32 + 8 * fq) = pack8(v0, v1); }
                ss += __shfl_xor(ss, 16); ss += __shfl_xor(ss, 32);
                if (fq == 0) ckvstat[(size_t)row * 4 + wc] = ss;
            }
        } else if (pn < 7) {
            const bool isv = pn >= 5; bf16* dst = isv ? VR : U; const int t = isv ? pn - 5 : pn - 3;
            EPI_FOR { const int row = EPI_ROW;
                const float r = rr[ai][m]; float ss = 0.f;
#pragma unroll
                for (int bj = 0; bj < 2; ++bj) { f32x4 v0 = acc[ai][bj][m][0] * r, v1 = acc[ai][bj][m][1] * r;
#pragma unroll
                    for (int e = 0; e < 4; ++e) { v0[e] = gelu_tanh(v0[e]); v1[e] = gelu_tanh(v1[e]); }
                    ss += sumsq4(v0) + sumsq4(v1);
                    *(u32x4*)(dst + (size_t)row * 512 + t * 256 + bj * HALF + wc * 32 + 8 * fq) = pack8(v0, v1); }
                if (isv) { ss += __shfl_xor(ss, 16); ss += __shfl_xor(ss, 32); if (fq == 0) vstat[(size_t)row * 8 + t * 4 + wc] = ss; }
            }
        } else if (pn < 9) {
            EPI_FOR { const int row = EPI_ROW;
                const float r = rr[ai][m];
#pragma unroll
                for (int bj = 0; bj < 2; ++bj) *(u32x4*)(QX + (size_t)row * 512 + (pn - 7) * 256 + bj * HALF + wc * 32 + 8 * fq) = pack8(acc[ai][bj][m][0] * r, acc[ai][bj][m][1] * r);
            }
        } else {
            const int gc0 = (pn - 9) * 256 + wc * 32 + 8 * fq;
            f32x4 bg[2][2];
#pragma unroll
            for (int bj = 0; bj < 2; ++bj) { bg[bj][0] = *(const f32x4*)(bgate + gc0 + bj * HALF); bg[bj][1] = *(const f32x4*)(bgate + gc0 + bj * HALF + 4); }
            EPI_FOR { const int row = EPI_ROW;
                const float r = rr[ai][m];
#pragma unroll
                for (int bj = 0; bj < 2; ++bj) { f32x4 v0 = acc[ai][bj][m][0] * r + bg[bj][0], v1 = acc[ai][bj][m][1] * r + bg[bj][1];
#pragma unroll
                    for (int e = 0; e < 4; ++e) { v0[e] = sigmoidf_(v0[e]); v1[e] = sigmoidf_(v1[e]); }
#ifdef DBG_CONSTGATE
                    v0 = acc[ai][bj][m][0] * r; v1 = acc[ai][bj][m][1] * r;
#endif
                    *(u32x4*)(GATE + (size_t)row * 3072 + gc0 + bj * HALF) = pack8(v0, v1); }
            }
        }
    }
};
struct EpiMemKV {
    bf16* KV;
    EPI_NOPRE
    __device__ __forceinline__ void operator()(const Acc& acc, const Unit& u, int wr, int wc, int fr, int fq, const Pre&) const {
        EPI_FOR { const int row = EPI_ROW;
#pragma unroll
            for (int bj = 0; bj < 2; ++bj) *(u32x4*)(KV + (size_t)u.aux * 256 * 1024 + (size_t)row * 1024 + EPI_C8(bj)) = pack8(acc[ai][bj][m][0], acc[ai][bj][m][1]);
        }
    }
};
struct EpiQ {
    const float* cqstat; const float* rope; bf16* Q;
    EPI_NOPRE
    __device__ __forceinline__ void operator()(const Acc& acc, const Unit& u, int wr, int wc, int fr, int fq, const Pre&) const {
        EPI_FOR { const int row = EPI_ROW;
            const f32x4 s0 = *(const f32x4*)(cqstat + (size_t)row * 8), s1 = *(const f32x4*)(cqstat + (size_t)row * 8 + 4);
            const float r = __builtin_amdgcn_rsqf(((s0[0] + s0[1]) + (s0[2] + s0[3]) + (s1[0] + s1[1]) + (s1[2] + s1[3])) * (1.f / QRANK) + EPS);
#pragma unroll
            for (int bj = 0; bj < 2; ++bj) { f32x4 v0 = acc[ai][bj][m][0] * r, v1 = acc[ai][bj][m][1] * r;
                if (((8 * u.pn + 4 * bj + wc) % 3) == 2) {
                    const f32x4 c = *(const f32x4*)(rope + (size_t)row * 32 + 4 * fq), s = *(const f32x4*)(rope + (size_t)row * 32 + 16 + 4 * fq);
                    const f32x4 o0 = v0 * c - v1 * s, o1 = v0 * s + v1 * c; v0 = o0; v1 = o1; }
                *(u32x4*)(Q + (size_t)row * 768 + EPI_C8(bj)) = pack8(v0, v1); }
        }
    }
};
struct EpiKV {
    const float* ckvstat; bf16* KN; bf16* V; unsigned* kmax;
    EPI_NOPRE
    __device__ __forceinline__ void operator()(const Acc& acc, const Unit& u, int wr, int wc, int fr, int fq, const Pre&) const {
        bf16* dst = u.pn < 2 ? KN : V; const int t = u.pn & 1; float hm[2] = {0.f, 0.f};
        EPI_FOR { const int row = EPI_ROW;
            const f32x4 s0 = *(const f32x4*)(ckvstat + (size_t)row * 4);
            const float r = __builtin_amdgcn_rsqf(((s0[0] + s0[1]) + (s0[2] + s0[3])) * (1.f / KVRANK) + EPS);
#pragma unroll
            for (int bj = 0; bj < 2; ++bj) { const f32x4 v0 = acc[ai][bj][m][0] * r, v1 = acc[ai][bj][m][1] * r;
                *(u32x4*)(dst + (size_t)row * 512 + t * 256 + bj * HALF + wc * 32 + 8 * fq) = pack8(v0, v1);
                float q2 = sumsq4(v0) + sumsq4(v1); q2 += __shfl_xor(q2, 16); q2 += __shfl_xor(q2, 32); hm[bj] = fmaxf(hm[bj], q2); }
        }
        if (u.pn < 2) {
#pragma unroll
            for (int bj = 0; bj < 2; ++bj) { float v = hm[bj];
#pragma unroll
                for (int o = 1; o < 16; o <<= 1) v = fmaxf(v, __shfl_xor(v, o));
                if ((fr | fq) == 0) atomicMax(kmax + 2 * (4 * u.pn + 2 * bj + (wc >> 1)) + (wc & 1), __float_as_uint(v)); }
        }
    }
};
struct EpiBranch {
    const bf16* GATE; bf16* MIX0; bf16* MIX1; bf16* MIXB;
    EPI_NOPRE
    __device__ __forceinline__ void operator()(const Acc& acc, const Unit& u, int wr, int wc, int fr, int fq, const Pre&) const {
        const int n = u.aux;
#pragma unroll
        for (int ai = 0; ai < 2; ++ai)
#pragma unroll
            for (int mp = 0; mp < 4; mp += 2) {
                u32x4 gw[2][2], p0[2][2], p1[2][2];
#pragma unroll
                for (int mm = 0; mm < 2; ++mm)
#pragma unroll
                    for (int bj = 0; bj < 2; ++bj) { const int m = mp + mm; const size_t off = (size_t)EPI_ROW * 1024 + EPI_C8(bj);
                        gw[mm][bj] = *(const u32x4*)(GATE + (size_t)EPI_ROW * 3072 + n * 1024 + EPI_C8(bj));
                        if (n == 2) { p0[mm][bj] = *(const u32x4*)(MIX0 + off); p1[mm][bj] = *(const u32x4*)(MIX1 + off); } }
                asm volatile("" ::: "memory");
#pragma unroll
                for (int mm = 0; mm < 2; ++mm)
#pragma unroll
                    for (int bj = 0; bj < 2; ++bj) { const int m = mp + mm; const size_t off = (size_t)EPI_ROW * 1024 + EPI_C8(bj);
                        f32x4 g0, g1; unpack8(gw[mm][bj], g0, g1);
                        f32x4 v0 = acc[ai][bj][m][0] * g0, v1 = acc[ai][bj][m][1] * g1;
                        if (n == 2) { f32x4 a0, a1, b0, b1; unpack8(p0[mm][bj], a0, a1); unpack8(p1[mm][bj], b0, b1); v0 += a0 + b0; v1 += a1 + b1; }
                        if (n < 2) *(u32x4*)((n == 0 ? MIX0 : MIX1) + off) = pack8(v0, v1);
                        else *(u32x4*)(MIXB + (size_t)u.pm * 256 * 1024 + (size_t)(4 * u.pn + 2 * bj + (wc >> 1)) * 16384 + (ai * HALF + wr * 64 + m * 16 + fr) * 64 + (wc & 1) * 32 + 8 * fq) = pack8(v0, v1); }
            }
    }
};
struct EpiResid {
    const float* X; float* Xo; bf16* XB; float* xstat;
    EPI_NOPRE
    __device__ __forceinline__ void operator()(const Acc& acc, const Unit& u, int wr, int wc, int fr, int fq, const Pre&) const {
#pragma unroll
        for (int ai = 0; ai < 2; ++ai) {
            f32x4 xv[4][2][2];
#pragma unroll
            for (int m = 0; m < 4; ++m)
#pragma unroll
                for (int bj = 0; bj < 2; ++bj) { const float* xp = X + (size_t)EPI_ROW * 1024 + EPI_C8(bj); xv[m][bj][0] = *(const f32x4*)xp; xv[m][bj][1] = *(const f32x4*)(xp + 4); }
            asm volatile("" ::: "memory");
#pragma unroll
            for (int m = 0; m < 4; ++m) { const int row = EPI_ROW; float ss = 0.f;
#pragma unroll
                for (int bj = 0; bj < 2; ++bj) { const int col = EPI_C8(bj); float* xp = Xo + (size_t)row * 1024 + col;
                    const f32x4 v0 = xv[m][bj][0] + acc[ai][bj][m][0], v1 = xv[m][bj][1] + acc[ai][bj][m][1];
                    *(f32x4*)xp = v0; *(f32x4*)(xp + 4) = v1; ss += sumsq4(v0) + sumsq4(v1);
                    *(u32x4*)(XB + (size_t)row * 1024 + col) = pack8(v0, v1); }
                ss += __shfl_xor(ss, 16); ss += __shfl_xor(ss, 32);
                if (fq == 0) xstat[(size_t)row * 16 + u.pn * 4 + wc] = ss; }
        }
    }
};
struct EpiSwiGLU {
    const float* rs; bf16* Hh; int ldh; int from_stats;
    typedef RowPre Pre;
    __device__ __forceinline__ Pre prefetch(const Unit& u, int wr, int fr) const { Pre p;
#pragma unroll
        for (int ai = 0; ai < 2; ++ai)
#pragma unroll
            for (int m = 0; m < 4; ++m) p.r[ai][m] = from_stats ? 0.f : rs[EPI_ROW];
        return p; }
    __device__ __forceinline__ void operator()(const Acc& acc, const Unit& u, int wr, int wc, int fr, int fq, const Pre& pre) const {
        float rr[2][4];
        if (from_stats) { EPI_LOAD_RS(rs_, rs);
#pragma unroll
            for (int ai = 0; ai < 2; ++ai)
#pragma unroll
                for (int m = 0; m < 4; ++m) rr[ai][m] = rs_[ai][m]; }
        else {
#pragma unroll
            for (int ai = 0; ai < 2; ++ai)
#pragma unroll
                for (int m = 0; m < 4; ++m) rr[ai][m] = pre.r[ai][m]; }
        bf16* hbase = Hh + (size_t)u.pm * 256 * ldh + (size_t)(2 * u.pn + (wc >> 1)) * 16384 + (wr * 64 + fr) * 64 + (wc & 1) * 32 + 8 * fq;
        EPI_FOR { const int row = EPI_ROW;
            const float r = rr[ai][m];
            f32x4 a0 = acc[ai][0][m][0] * r, a1 = acc[ai][0][m][1] * r; const f32x4 b0 = acc[ai][1][m][0] * r, b1 = acc[ai][1][m][1] * r;
#pragma unroll
            for (int e = 0; e < 4; ++e) { a0[e] = a0[e] * sigmoidf_(a0[e]) * b0[e]; a1[e] = a1[e] * sigmoidf_(a1[e]) * b1[e]; }
            (void)row; *(u32x4*)(hbase + (ai * HALF + m * 16) * 64) = pack8(a0, a1);
        }
    }
};
struct EpiBf16 {
    bf16* C; int ldc;
    EPI_NOPRE
    __device__ __forceinline__ void operator()(const Acc& acc, const Unit& u, int wr, int wc, int fr, int fq, const Pre&) const {
        EPI_FOR { const int row = EPI_ROW;
#pragma unroll
            for (int bj = 0; bj < 2; ++bj) *(u32x4*)(C + (size_t)row * ldc + EPI_C8(bj)) = pack8(acc[ai][bj][m][0], acc[ai][bj][m][1]);
        }
    }
};
struct EpiF32 {
    float* C; int ldc;
    EPI_NOPRE
    __device__ __forceinline__ void operator()(const Acc& acc, const Unit& u, int wr, int wc, int fr, int fq, const Pre&) const {
        EPI_FOR { const int row = EPI_ROW;
#pragma unroll
            for (int bj = 0; bj < 2; ++bj) { float* cp = C + (size_t)row * ldc + EPI_C8(bj); *(f32x4*)cp = acc[ai][bj][m][0]; *(f32x4*)(cp + 4) = acc[ai][bj][m][1]; }
        }
    }
};
}

namespace att {
#define KSWZ(row, colB) ((row) * 256 + ((colB) ^ (((row) & 7) << 4)))
#define SBAR() __builtin_amdgcn_sched_barrier(0)
constexpr float THR = 8.f;
__device__ __forceinline__ int crow(int r, int hi) { return (r & 3) + 8 * (r >> 2) + 4 * hi; }
template <int NB> __device__ __forceinline__ int v_st(int k, int c) { const int kk = (k & ~0xC) | ((k & 4) << 1) | ((k & 8) >> 1); return ((kk >> 3) * NB + (c >> 5)) * 512 + ((kk & 7) * 32 + (c & 31)) * 2; }
__device__ __forceinline__ int v_rd_base(int lane) { return ((lane & 3) << 3) | (((lane >> 2) & 3) << 6) | (((lane >> 4) & 1) << 5) | (((lane >> 5) & 1) << 8); }
template <int OFF> __device__ __forceinline__ s16x4 tr_read(int vb) { s16x4 r; asm volatile("ds_read_b64_tr_b16 %0, %1 offset:%2" : "=&v"(r) : "v"(vb), "i"(OFF) : "memory"); return r; }

__device__ __forceinline__ void partialSM(f32x16& p0, f32x16& p1, float& m_reg, float& alpha) {
    float pmax = p0[0];
#pragma unroll
    for (int r = 1; r < 16; ++r) pmax = fmaxf(pmax, p0[r]);
#pragma unroll
    for (int r = 0; r < 16; ++r) pmax = fmaxf(pmax, p1[r]);
    { auto rr = __builtin_amdgcn_permlane32_swap(__float_as_uint(pmax), __float_as_uint(pmax), false, false); pmax = fmaxf(__uint_as_float(rr[0]), __uint_as_float(rr[1])); }
    float mn;
    if (__builtin_expect(__all(pmax - m_reg <= THR), 1)) { mn = m_reg; alpha = 1.f; }
    else { mn = fmaxf(m_reg, pmax); alpha = __builtin_amdgcn_exp2f(m_reg - mn); m_reg = mn; }
#pragma unroll
    for (int r = 0; r < 16; ++r) { p0[r] -= mn; p1[r] -= mn; }
#pragma unroll
    for (int r = 0; r < 16; ++r) p0[r] = __builtin_amdgcn_exp2f(p0[r]);
}
__device__ __forceinline__ void finishSM(f32x16& p0, f32x16& p1, float alpha, float& l_reg, bf16x8& pa0, bf16x8& pa1, bf16x8& pa2, bf16x8& pa3) {
#pragma unroll
    for (int r = 0; r < 16; ++r) p1[r] = __builtin_amdgcn_exp2f(p1[r]);
    float ps = 0;
#pragma unroll
    for (int r = 0; r < 16; ++r) ps += p0[r];
#pragma unroll
    for (int r = 0; r < 16; ++r) ps += p1[r];
    { auto rr = __builtin_amdgcn_permlane32_swap(__float_as_uint(ps), __float_as_uint(ps), false, false); ps = __uint_as_float(rr[0]) + __uint_as_float(rr[1]); }
    l_reg = l_reg * alpha + ps;
#define PK4(P, BASE, OUT) do { unsigned a0 = cvt_pk_bf16(P[BASE + 0], P[BASE + 1]), a1 = cvt_pk_bf16(P[BASE + 2], P[BASE + 3]);   \
    unsigned b0 = cvt_pk_bf16(P[BASE + 4], P[BASE + 5]), b1 = cvt_pk_bf16(P[BASE + 6], P[BASE + 7]);                              \
    auto r0 = __builtin_amdgcn_permlane32_swap(a0, b0, false, false); auto r1 = __builtin_amdgcn_permlane32_swap(a1, b1, false, false); \
    u32x4 w = {r0[0], r1[0], r0[1], r1[1]}; OUT = __builtin_bit_cast(bf16x8, w); } while (0)
    PK4(p0, 0, pa0); PK4(p0, 8, pa1); PK4(p1, 0, pa2); PK4(p1, 8, pa3);
#undef PK4
}
template <int ND0> __device__ __forceinline__ void qkt(f32x16& p0, f32x16& p1, const LAS char* Ks, const bf16x8* qr, int r32, int hi, const f32x16& init) {
#pragma unroll
    for (int d0 = 0; d0 < ND0; ++d0) { const int cb = (d0 * 16 + hi * 8) * 2;
        const bf16x8 b0 = *(const LAS bf16x8*)(Ks + KSWZ(r32, cb));
        const bf16x8 b1 = *(const LAS bf16x8*)(Ks + KSWZ(32 + r32, cb));
        p0 = __builtin_amdgcn_mfma_f32_32x32x16_bf16(b0, qr[d0], d0 == 0 ? init : p0, 0, 0, 0);
        p1 = __builtin_amdgcn_mfma_f32_32x32x16_bf16(b1, qr[d0], d0 == 0 ? init : p1, 0, 0, 0); }
}
__device__ __forceinline__ void expA(f32x16& p0) {
#pragma unroll
    for (int r = 0; r < 16; ++r) p0[r] = __builtin_amdgcn_exp2f(p0[r]);
}
template <int NB, int D0> __device__ __forceinline__ void pv_one(f32x16& od, int vb, bf16x8 pa0, bf16x8 pa1, bf16x8 pa2, bf16x8 pa3) {
    const s16x4 l0 = tr_read<(0 * NB + D0) * 512>(vb), h0 = tr_read<(1 * NB + D0) * 512>(vb), l1 = tr_read<(2 * NB + D0) * 512>(vb), h1 = tr_read<(3 * NB + D0) * 512>(vb);
    const s16x4 l2 = tr_read<(4 * NB + D0) * 512>(vb), h2 = tr_read<(5 * NB + D0) * 512>(vb), l3 = tr_read<(6 * NB + D0) * 512>(vb), h3 = tr_read<(7 * NB + D0) * 512>(vb);
    asm volatile("s_waitcnt lgkmcnt(0)" ::: "memory"); SBAR();
#define PK(L, H) (bf16x8){L[0], L[1], L[2], L[3], H[0], H[1], H[2], H[3]}
    od = __builtin_amdgcn_mfma_f32_32x32x16_bf16(pa0, PK(l0, h0), od, 0, 0, 0);
    od = __builtin_amdgcn_mfma_f32_32x32x16_bf16(pa1, PK(l1, h1), od, 0, 0, 0);
    od = __builtin_amdgcn_mfma_f32_32x32x16_bf16(pa2, PK(l2, h2), od, 0, 0, 0);
    od = __builtin_amdgcn_mfma_f32_32x32x16_bf16(pa3, PK(l3, h3), od, 0, 0, 0);
#undef PK
}
template <int NB> __device__ __forceinline__ void pv_all(f32x16* o, int vb, bf16x8 pa0, bf16x8 pa1, bf16x8 pa2, bf16x8 pa3) {
    pv_one<NB, 0>(o[0], vb, pa0, pa1, pa2, pa3); pv_one<NB, 1>(o[1], vb, pa0, pa1, pa2, pa3);
    if constexpr (NB == 4) { pv_one<NB, 2>(o[2], vb, pa0, pa1, pa2, pa3); pv_one<NB, 3>(o[3], vb, pa0, pa1, pa2, pa3); }
}

template <int DQK, int D1, int DVV, bool FIXM>
__device__ __forceinline__ void attn_unit(const bf16* __restrict__ Qb, int ldq, const bf16* __restrict__ K1, int ldk1, const bf16* __restrict__ K2, int ldk2,
                                          const bf16* __restrict__ Vh, int ldv, bf16* __restrict__ Ob, int ldo, int seq, LAS char* lds, float kbound) {
    constexpr int ND0 = DQK / 16, NB = DVV / 32, CK = DQK / 8, CV = DVV / 8;
    constexpr int NKL = (64 * CK + 511) / 512, NVL = (64 * CV) / 512;
    constexpr int SHM_V = 64 * DVV * 2, SHM_K = 64 * 256;
    int tid_ = threadIdx.x; asm volatile("" : "+v"(tid_));
    const int tid = tid_, wid = tid >> 6, lane = tid & 63, r32 = lane & 31, hi = lane >> 5;
    LAS char* V_lds = lds; LAS char* K_lds = lds + 2 * SHM_V;
    LAS float* ws = (LAS float*)(lds + 2 * SHM_V + 2 * SHM_K) + wid * 64; LAS float* li_l = ws; LAS float* al_l = ws + 32;
    float m_reg = -1e30f, l_reg = 0; f32x16 o[NB]; bf16x8 qr[ND0];
#pragma unroll
    for (int d = 0; d < NB; ++d) o[d] = f32x16{};
    const bf16* Qw = Qb + (long)(wid * 32 + r32) * ldq + hi * 8;
#pragma unroll
    for (int d0 = 0; d0 < ND0; ++d0) qr[d0] = *(const bf16x8*)(Qw + d0 * 16);
    f32x16 init = f32x16{};
    if constexpr (FIXM) {
        float q2 = 0.f;
#pragma unroll
        for (int d0 = 0; d0 < ND0; ++d0) { const u32x4 w = __builtin_bit_cast(u32x4, qr[d0]); f32x4 a, b; unpack8(w, a, b); q2 += sumsq4(a) + sumsq4(b); }
        { auto rr = __builtin_amdgcn_permlane32_swap(__float_as_uint(q2), __float_as_uint(q2), false, false); q2 = __uint_as_float(rr[0]) + __uint_as_float(rr[1]); }
        const float nm = -sqrtf(q2) * kbound;
#pragma unroll
        for (int r = 0; r < 16; ++r) init[r] = nm;
        asm volatile("" : "+v"(init));
    }
    const bf16* kp[NKL]; int kstr[NKL], kdst[NKL]; bool kval[NKL];
#pragma unroll
    for (int i = 0; i < NKL; ++i) { const int c = tid + 512 * i; kval[i] = c < 64 * CK; const int cc_ = kval[i] ? c : 0; const int row = cc_ / CK, cc = cc_ % CK;
        if (cc * 8 < D1) { kp[i] = K1 + (long)row * ldk1 + cc * 8; kstr[i] = 64 * ldk1; } else { kp[i] = K2 + (long)row * ldk2 + (cc * 8 - D1); kstr[i] = 64 * ldk2; }
        kdst[i] = KSWZ(row, cc * 16); }
    const bf16* vp[NVL]; int vdst[NVL]; const int vstr = 64 * ldv;
#pragma unroll
    for (int i = 0; i < NVL; ++i) { const int c = tid + 512 * i; const int row = c / CV, cc = c % CV; vp[i] = Vh + (long)row * ldv + cc * 8; vdst[i] = v_st<NB>(row, cc * 8); }
    const int vb0 = (int)(uintptr_t)V_lds + v_rd_base(lane);
    struct { bf16x8 ks[NKL]; bf16x8 vs[NVL]; } sr_[2];
#define SLOAD(i, t) do { _Pragma("unroll") for (int q_ = 0; q_ < NVL; ++q_) sr_[i].vs[q_] = *(const bf16x8*)(vp[q_] + (long)(t) * vstr); \
    _Pragma("unroll") for (int q_ = 0; q_ < NKL; ++q_) { if (kval[q_]) sr_[i].ks[q_] = *(const bf16x8*)(kp[q_] + (long)(t) * kstr[q_]); } } while (0)
#define SWRITE(b, i) do { _Pragma("unroll") for (int q_ = 0; q_ < NVL; ++q_) *(LAS bf16x8*)(V_lds + (b) * SHM_V + vdst[q_]) = sr_[i].vs[q_]; \
    _Pragma("unroll") for (int q_ = 0; q_ < NKL; ++q_) { if (kval[q_]) *(LAS bf16x8*)(K_lds + (b) * SHM_K + kdst[q_]) = sr_[i].ks[q_]; } } while (0)
#define SWAIT() asm volatile("s_waitcnt vmcnt(%0)" :: "n"(NKL + NVL) : "memory")
#define RESC(a) do { if (__any((a) < 1.f)) { if (hi == 0) al_l[r32] = (a); asm volatile("s_waitcnt lgkmcnt(0)" ::: "memory"); \
    _Pragma("unroll") for (int d = 0; d < NB; ++d) _Pragma("unroll") for (int r = 0; r < 16; ++r) o[d][r] *= al_l[crow(r, hi)]; } } while (0)
    f32x16 pA0, pA1, pB0, pB1; float alA = 1.f, alB = 1.f; bf16x8 pa0, pa1, pa2, pa3; const int NT = seq / 64;
#define PSM(P0, P1, AL) do { if constexpr (FIXM) expA(P0); else partialSM(P0, P1, m_reg, AL); } while (0)
#define RSC(AL) do { if constexpr (!FIXM) RESC(AL); } while (0)
    SLOAD(0, 0); asm volatile("s_waitcnt vmcnt(0)" ::: "memory"); SWRITE(0, 0); __syncthreads();
    qkt<ND0>(pA0, pA1, K_lds, qr, r32, hi, init); PSM(pA0, pA1, alA);
    SLOAD(1, 1); if (2 < NT) SLOAD(0, 2);
    SWAIT(); SWRITE(1, 1); __syncthreads();
    for (int j = 1; j + 1 < NT; j += 2) {
        SBAR(); qkt<ND0>(pB0, pB1, K_lds + SHM_K, qr, r32, hi, init);
        finishSM(pA0, pA1, alA, l_reg, pa0, pa1, pa2, pa3); SBAR();
        SLOAD(1, j + 2); SBAR();
        pv_all<NB>(o, vb0, pa0, pa1, pa2, pa3); PSM(pB0, pB1, alB);
        __syncthreads(); SWAIT(); SWRITE(0, 0);
        RSC(alB); __syncthreads();
        SBAR(); qkt<ND0>(pA0, pA1, K_lds, qr, r32, hi, init);
        finishSM(pB0, pB1, alB, l_reg, pa0, pa1, pa2, pa3); SBAR();
        if (j + 3 < NT) SLOAD(0, j + 3); SBAR();
        pv_all<NB>(o, vb0 + SHM_V, pa0, pa1, pa2, pa3); PSM(pA0, pA1, alA);
        __syncthreads(); SWAIT(); SWRITE(1, 1);
        RSC(alA); __syncthreads();
    }
    SBAR(); qkt<ND0>(pB0, pB1, K_lds + SHM_K, qr, r32, hi, init);
    finishSM(pA0, pA1, alA, l_reg, pa0, pa1, pa2, pa3); SBAR();
    pv_all<NB>(o, vb0, pa0, pa1, pa2, pa3); PSM(pB0, pB1, alB);
    __syncthreads(); RSC(alB);
    finishSM(pB0, pB1, alB, l_reg, pa0, pa1, pa2, pa3); SBAR();
    pv_all<NB>(o, vb0 + SHM_V, pa0, pa1, pa2, pa3);
#undef PSM
#undef RSC
    if (hi == 0) li_l[r32] = l_reg; asm volatile("s_waitcnt lgkmcnt(0)" ::: "memory");
    float rli[16];
#pragma unroll
    for (int r = 0; r < 16; ++r) rli[r] = __builtin_amdgcn_rcpf(li_l[crow(r, hi)]);
    bf16* Ow = Ob + (long)(wid * 32) * ldo;
#pragma unroll
    for (int r = 0; r < 16; ++r) { const int orow = crow(r, hi);
#pragma unroll
        for (int d0 = 0; d0 < NB; ++d0) Ow[(long)orow * ldo + d0 * 32 + r32] = f2bf(o[d0][r] * rli[r]); }
    __syncthreads();
#undef SLOAD
#undef SWRITE
#undef SWAIT
#undef RESC
}

#define EXP4(P, B) do { P[B] = __builtin_amdgcn_exp2f(P[B]); P[B + 1] = __builtin_amdgcn_exp2f(P[B + 1]); P[B + 2] = __builtin_amdgcn_exp2f(P[B + 2]); P[B + 3] = __builtin_amdgcn_exp2f(P[B + 3]); } while (0)
#define SUM4(S, P, B) do { S += (P[B] + P[B + 1]) + (P[B + 2] + P[B + 3]); } while (0)
#define PK4X(P, BASE, OUT) do { const u32x4 w_ = {cvt_pk_bf16(P[BASE + 0], P[BASE + 1]), cvt_pk_bf16(P[BASE + 2], P[BASE + 3]), cvt_pk_bf16(P[BASE + 4], P[BASE + 5]), cvt_pk_bf16(P[BASE + 6], P[BASE + 7])}; OUT = __builtin_bit_cast(bf16x8, w_); } while (0)
typedef short v4i16_t __attribute__((ext_vector_type(4)));
__device__ __forceinline__ s16x4 vtr(const LAS char* p) { return __builtin_bit_cast(s16x4, __builtin_amdgcn_ds_read_tr16_b64_v4i16((LAS v4i16_t*)p)); }
#define KSWZ2(row, colB) ((row) * 256 + ((colB) ^ (((row) & 15) << 4)))
template <int DQK, int D1, int DVV>
__device__ __forceinline__ void attn_unit2(const bf16* __restrict__ Qb, int ldq, const bf16* __restrict__ K1, int ldk1, const bf16* __restrict__ K2, int ldk2,
                                           const bf16* __restrict__ Vh, int ldv, bf16* __restrict__ Ob, int ldo, int seq, LAS char* lds, float kbound) {
    constexpr int ND0 = DQK / 16, NB = DVV / 32, CK = DQK / 8;
    constexpr int SHM_V = 64 * DVV * 2, SHM_K = 64 * 256;
    static_assert(NB == 2 && ND0 == 6, "written for QK dim 96 / V dim 64");
    int tid_ = threadIdx.x; asm volatile("" : "+v"(tid_));
    const int tid = tid_, wid = __builtin_amdgcn_readfirstlane(tid >> 6), lane = tid & 63, r32 = lane & 31, hi = lane >> 5;
    LAS char* V_lds = lds; LAS char* K_lds = lds + 3 * SHM_V;
    LAS float* ws = (LAS float*)(lds + 3 * SHM_V + 2 * SHM_K) + wid * 64;
    LAS char* QAL = lds + 3 * SHM_V + 2 * SHM_K + 2048 + wid * (2 * ND0 * 1024) + lane * 16; LAS char* QBL = QAL + ND0 * 1024;
    float nm;
    { bf16x8 qa[ND0], qb[ND0];
      const bf16* QwA = Qb + (long)(wid * 64 + r32) * ldq + hi * 8; const bf16* QwB = QwA + (long)32 * ldq;
#pragma unroll
      for (int d0 = 0; d0 < ND0; ++d0) { qa[d0] = *(const bf16x8*)(QwA + d0 * 16); qb[d0] = *(const bf16x8*)(QwB + d0 * 16); }
      float q2a = 0.f, q2b = 0.f;
#pragma unroll
      for (int d0 = 0; d0 < ND0; ++d0) { f32x4 a, b; unpack8(__builtin_bit_cast(u32x4, qa[d0]), a, b); q2a += sumsq4(a) + sumsq4(b); unpack8(__builtin_bit_cast(u32x4, qb[d0]), a, b); q2b += sumsq4(a) + sumsq4(b);
          *(LAS bf16x8*)(QAL + d0 * 1024) = qa[d0]; *(LAS bf16x8*)(QBL + d0 * 1024) = qb[d0]; }
      { auto rr = __builtin_amdgcn_permlane32_swap(__float_as_uint(q2a), __float_as_uint(q2a), false, false); q2a = __uint_as_float(rr[0]) + __uint_as_float(rr[1]); }
      { auto rr = __builtin_amdgcn_permlane32_swap(__float_as_uint(q2b), __float_as_uint(q2b), false, false); q2b = __uint_as_float(rr[0]) + __uint_as_float(rr[1]); }
      nm = -sqrtf(fmaxf(q2a, q2b)) * kbound; }
    const bf16* kp[2]; int kstr[2];
#pragma unroll
    for (int i = 0; i < 2; ++i) { const int row = 8 * wid + 4 * i + (lane >> 4), cc = (lane & 15) ^ (row & 15);
        if (cc >= 8 && cc < CK) { kp[i] = K2 + (long)row * ldk2 + (cc * 8 - D1); kstr[i] = 64 * ldk2; } else { kp[i] = K1 + (long)row * ldk1 + (cc < 8 ? cc * 8 : 0); kstr[i] = 64 * ldk1; } }
    const bf16* vp; { const int k = 8 * wid + ((lane & 31) >> 2); vp = Vh + (long)k * ldv + (lane >> 5) * 32 + (lane & 3) * 8; }
    const int vstr = 64 * ldv;
    const LAS char* vrd0 = V_lds + v_rd_base(lane);
#define DMA2(t, kb, vbuf) do { \
    __builtin_amdgcn_global_load_lds((const unsigned*)(kp[0] + (long)(t) * kstr[0]), (LAS unsigned*)(K_lds + (kb) * SHM_K + wid * 2048), 16, 0, 0); \
    __builtin_amdgcn_global_load_lds((const unsigned*)(kp[1] + (long)(t) * kstr[1]), (LAS unsigned*)(K_lds + (kb) * SHM_K + wid * 2048 + 1024), 16, 0, 0); \
    __builtin_amdgcn_global_load_lds((const unsigned*)(vp + (long)(t) * vstr), (LAS unsigned*)(V_lds + (vbuf) * SHM_V + wid * 1024), 16, 0, 0); } while (0)
#define VRD8(arr, base, D0) do { _Pragma("unroll") for (int j_ = 0; j_ < 8; ++j_) arr[j_] = vtr((base) + (j_ * NB + (D0)) * 512); } while (0)
#define PKV(arr, ks) (bf16x8){arr[2 * (ks)][0], arr[2 * (ks)][1], arr[2 * (ks)][2], arr[2 * (ks)][3], arr[2 * (ks) + 1][0], arr[2 * (ks) + 1][1], arr[2 * (ks) + 1][2], arr[2 * (ks) + 1][3]}
    f32x16 oA[2], oB[2]; oA[0] = f32x16{}; oA[1] = f32x16{}; oB[0] = f32x16{}; oB[1] = f32x16{};
    float lA = 0.f, lB = 0.f; const int NT = seq / 64;
    f32x16 a0, a1, c0, c1; bf16x8 pa0, pa1, pa2, pa3;
#define HALF1(Kb) do { \
        f32x16 init; { float nmv = nm; asm volatile("" : "+v"(nmv)); _Pragma("unroll") for (int r = 0; r < 16; ++r) init[r] = nmv; } \
        SBAR(); \
        _Pragma("unroll") for (int d0 = 0; d0 < ND0; ++d0) { const int cb = (d0 * 16 + hi * 8) * 2; \
            const bf16x8 k0 = *(const LAS bf16x8*)((Kb) + KSWZ2(r32, cb)), k1 = *(const LAS bf16x8*)((Kb) + KSWZ2(32 + r32, cb)), qv = *(const LAS bf16x8*)(QAL + d0 * 1024); \
            a0 = __builtin_amdgcn_mfma_f32_32x32x16_bf16(k0, qv, d0 == 0 ? init : a0, 0, 0, 0); \
            a1 = __builtin_amdgcn_mfma_f32_32x32x16_bf16(k1, qv, d0 == 0 ? init : a1, 0, 0, 0); } \
        SBAR(); \
        float sA = 0.f; \
        _Pragma("unroll") for (int d0 = 0; d0 < ND0; ++d0) { const int cb = (d0 * 16 + hi * 8) * 2; \
            const bf16x8 k0 = *(const LAS bf16x8*)((Kb) + KSWZ2(r32, cb)), k1 = *(const LAS bf16x8*)((Kb) + KSWZ2(32 + r32, cb)), qv = *(const LAS bf16x8*)(QBL + d0 * 1024); \
            c0 = __builtin_amdgcn_mfma_f32_32x32x16_bf16(k0, qv, d0 == 0 ? init : c0, 0, 0, 0); \
            if (d0 == 3) { EXP4(a0, 0); EXP4(a0, 4); } \
            if (d0 == 4) { EXP4(a0, 12); SUM4(sA, a0, 0); SUM4(sA, a0, 4); EXP4(a1, 0); } \
            if (d0 == 5) { EXP4(a1, 8); SUM4(sA, a1, 0); SUM4(sA, a1, 4); } \
            c1 = __builtin_amdgcn_mfma_f32_32x32x16_bf16(k1, qv, d0 == 0 ? init : c1, 0, 0, 0); \
            if (d0 == 3) { EXP4(a0, 8); } \
            if (d0 == 4) { EXP4(a1, 4); SUM4(sA, a0, 8); SUM4(sA, a0, 12); } \
            if (d0 == 5) { EXP4(a1, 12); SUM4(sA, a1, 8); SUM4(sA, a1, 12); } \
            if (d0 >= 2) SBAR(); } \
        lA += sA; \
        PK4X(a0, 0, pa0); PK4X(a0, 8, pa1); PK4X(a1, 0, pa2); PK4X(a1, 8, pa3); \
        SBAR(); } while (0)
#define HALF2(vbase) do { \
        float sB = 0.f; s16x4 va[8], vb_[8]; \
        VRD8(va, vbase, 0); VRD8(vb_, vbase, 1); \
        oA[0] = __builtin_amdgcn_mfma_f32_32x32x16_bf16(pa0, PKV(va, 0), oA[0], 0, 0, 0); SBAR(); \
        oA[1] = __builtin_amdgcn_mfma_f32_32x32x16_bf16(pa0, PKV(vb_, 0), oA[1], 0, 0, 0); EXP4(c0, 0); EXP4(c0, 4); SBAR(); \
        oA[0] = __builtin_amdgcn_mfma_f32_32x32x16_bf16(pa1, PKV(va, 1), oA[0], 0, 0, 0); EXP4(c0, 8); EXP4(c0, 12); SUM4(sB, c0, 0); SBAR(); \
        oA[1] = __builtin_amdgcn_mfma_f32_32x32x16_bf16(pa1, PKV(vb_, 1), oA[1], 0, 0, 0); EXP4(c1, 0); SUM4(sB, c0, 4); SUM4(sB, c0, 8); SBAR(); \
        oA[0] = __builtin_amdgcn_mfma_f32_32x32x16_bf16(pa2, PKV(va, 2), oA[0], 0, 0, 0); EXP4(c1, 4); SUM4(sB, c0, 12); SBAR(); \
        oA[1] = __builtin_amdgcn_mfma_f32_32x32x16_bf16(pa2, PKV(vb_, 2), oA[1], 0, 0, 0); EXP4(c1, 8); SUM4(sB, c1, 0); SBAR(); \
        oA[0] = __builtin_amdgcn_mfma_f32_32x32x16_bf16(pa3, PKV(va, 3), oA[0], 0, 0, 0); EXP4(c1, 12); SUM4(sB, c1, 4); SBAR(); \
        oA[1] = __builtin_amdgcn_mfma_f32_32x32x16_bf16(pa3, PKV(vb_, 3), oA[1], 0, 0, 0); SUM4(sB, c1, 8); SUM4(sB, c1, 12); SBAR(); \
        lB += sB; \
        PK4X(c0, 0, pa0); PK4X(c0, 8, pa1); PK4X(c1, 0, pa2); PK4X(c1, 8, pa3); \
        SBAR(); \
        VRD8(va, vbase, 0); VRD8(vb_, vbase, 1);                       \
        oB[0] = __builtin_amdgcn_mfma_f32_32x32x16_bf16(pa0, PKV(va, 0), oB[0], 0, 0, 0); \
        oB[1] = __builtin_amdgcn_mfma_f32_32x32x16_bf16(pa0, PKV(vb_, 0), oB[1], 0, 0, 0); \
        oB[0] = __builtin_amdgcn_mfma_f32_32x32x16_bf16(pa1, PKV(va, 1), oB[0], 0, 0, 0); \
        oB[1] = __builtin_amdgcn_mfma_f32_32x32x16_bf16(pa1, PKV(vb_, 1), oB[1], 0, 0, 0); \
        oB[0] = __builtin_amdgcn_mfma_f32_32x32x16_bf16(pa2, PKV(va, 2), oB[0], 0, 0, 0); \
        oB[1] = __builtin_amdgcn_mfma_f32_32x32x16_bf16(pa2, PKV(vb_, 2), oB[1], 0, 0, 0); \
        oB[0] = __builtin_amdgcn_mfma_f32_32x32x16_bf16(pa3, PKV(va, 3), oB[0], 0, 0, 0); \
        oB[1] = __builtin_amdgcn_mfma_f32_32x32x16_bf16(pa3, PKV(vb_, 3), oB[1], 0, 0, 0); \
        SBAR(); } while (0)
#define TILE_BAR() do { asm volatile("s_waitcnt vmcnt(0)" ::: "memory"); __syncthreads(); } while (0)
    DMA2(0, 0, 0);
    if (wid < 4) {
        int vs = 0;
#pragma unroll 1
        for (int t = 0; t < NT; ++t) { TILE_BAR();
            const int vn = vs == 2 ? 0 : vs + 1; if (t + 1 < NT) DMA2(t + 1, (t + 1) & 1, vn);
            HALF1(K_lds + (t & 1) * SHM_K); HALF2(vrd0 + vs * SHM_V); vs = vn; }
        TILE_BAR();
    } else {
        __builtin_amdgcn_s_setprio(1);
        TILE_BAR(); if (1 < NT) DMA2(1, 1, 1);
        HALF1(K_lds);
        int vs = 0;
#pragma unroll 1
        for (int t = 1; t < NT; ++t) { TILE_BAR();
            const int vn = vs == 2 ? 0 : vs + 1; const int vnn = vn == 2 ? 0 : vn + 1; if (t + 1 < NT) DMA2(t + 1, (t + 1) & 1, vnn);
            HALF2(vrd0 + vs * SHM_V); HALF1(K_lds + (t & 1) * SHM_K); vs = vn; }
        TILE_BAR();
        HALF2(vrd0 + vs * SHM_V);
        __builtin_amdgcn_s_setprio(0);
    }
#undef HALF1
#undef HALF2
#undef TILE_BAR
    { auto rr = __builtin_amdgcn_permlane32_swap(__float_as_uint(lA), __float_as_uint(lA), false, false); lA = __uint_as_float(rr[0]) + __uint_as_float(rr[1]); }
    { auto rr = __builtin_amdgcn_permlane32_swap(__float_as_uint(lB), __float_as_uint(lB), false, false); lB = __uint_as_float(rr[0]) + __uint_as_float(rr[1]); }
    if (hi == 0) { ws[r32] = lA; ws[32 + r32] = lB; } asm volatile("s_waitcnt lgkmcnt(0)" ::: "memory");
    bf16* Ow = Ob + (long)(wid * 64) * ldo;
#pragma unroll
    for (int r = 0; r < 16; ++r) { const int orow = crow(r, hi); const float ra = __builtin_amdgcn_rcpf(ws[orow]), rb = __builtin_amdgcn_rcpf(ws[32 + orow]);
#pragma unroll
        for (int d0 = 0; d0 < NB; ++d0) { Ow[(long)orow * ldo + d0 * 32 + r32] = f2bf(oA[d0][r] * ra); Ow[(long)(32 + orow) * ldo + d0 * 32 + r32] = f2bf(oB[d0][r] * rb); } }
    __syncthreads();
#undef DMA2
#undef VRD8
#undef PKV
}
#undef EXP4
#undef SUM4
#undef PK4X

__device__ __forceinline__ void spatial_unit(int chunk, int g, const bf16* __restrict__ U, const bf16* __restrict__ VR, const float* __restrict__ vstat, const float* __restrict__ g_sg,
                                             const bf16* __restrict__ Wsb, const float* __restrict__ b_s, bf16* __restrict__ Y, LAS char* lds) {
    int tid_ = threadIdx.x; asm volatile("" : "+v"(tid_));
    const int tid = tid_, wid = tid >> 6, lane = tid & 63, r32 = lane & 31, hi = lane >> 5, rb = wid & 3, ch = wid >> 2;
    LAS char* V_lds = lds; LAS float* rv = (LAS float*)(lds + 32768);
    const int row0 = chunk * 128;
    if (tid < 128) { const f32x4 s0 = *(const f32x4*)(vstat + (size_t)(row0 + tid) * 8), s1 = *(const f32x4*)(vstat + (size_t)(row0 + tid) * 8 + 4);
        rv[tid] = __builtin_amdgcn_rsqf(((s0[0] + s0[1]) + (s0[2] + s0[3]) + (s1[0] + s1[1]) + (s1[2] + s1[3])) * (1.f / 512.f) + EPS); }
    __syncthreads();
#pragma unroll
    for (int i = 0; i < 4; ++i) { const int c = tid + 512 * i, row = c >> 4, cc = c & 15;
        const u32x4 w = *(const u32x4*)(VR + (size_t)(row0 + row) * 512 + g * 128 + cc * 8); f32x4 a, b; unpack8(w, a, b);
        const f32x4 g0 = *(const f32x4*)(g_sg + g * 128 + cc * 8), g1 = *(const f32x4*)(g_sg + g * 128 + cc * 8 + 4); const float r = rv[row];
        *(LAS u32x4*)(V_lds + (row >> 6) * 16384 + v_st<4>(row & 63, cc * 8)) = pack8(a * r * g0, b * r * g1); }
    bf16x8 pa[8];
#pragma unroll
    for (int ks = 0; ks < 8; ++ks) pa[ks] = *(const bf16x8*)(Wsb + (size_t)g * 16384 + (size_t)(32 * rb + r32) * 128 + 16 * ks + 8 * hi);
    __syncthreads();
    f32x16 o[2]; o[0] = f32x16{}; o[1] = f32x16{};
    const int vb = (int)(uintptr_t)V_lds + v_rd_base(lane) + (2 * ch) * 512;
    pv_one<4, 0>(o[0], vb, pa[0], pa[1], pa[2], pa[3]); pv_one<4, 1>(o[1], vb, pa[0], pa[1], pa[2], pa[3]);
    pv_one<4, 0>(o[0], vb + 16384, pa[4], pa[5], pa[6], pa[7]); pv_one<4, 1>(o[1], vb + 16384, pa[4], pa[5], pa[6], pa[7]);
#pragma unroll
    for (int r = 0; r < 16; ++r) { const int i = 32 * rb + crow(r, hi); const float bias = b_s[g * 128 + i]; const size_t row = (size_t)(row0 + i);
#pragma unroll
        for (int dd = 0; dd < 2; ++dd) { const int c = g * 128 + 64 * ch + 32 * dd + r32; const float uu = bf2f(U[row * 512 + c]);
            Y[row * 1536 + 512 + c] = f2bf(uu * (o[dd][r] + bias)); } }
    __syncthreads();
}
#undef KSWZ
#undef SBAR
}

#define XB_TMO      128
#define XB_XCNT(j)  (256  + 64 * (j))
#define XB_XSUB(j)  (1280 + 64 * (j))
#define XB_XGEN(j)  (2304 + 64 * (j))
#define XB_TOP      3328
#define XB_TOPGEN   3392
#define XCD_BAR_WORDS 3456
#define XB_SPIN_CAP (1u << 18)
__device__ __forceinline__ unsigned xb_ld(unsigned* p)              { return __hip_atomic_load((GAS unsigned*)p, __ATOMIC_RELAXED, __HIP_MEMORY_SCOPE_AGENT); }
__device__ __forceinline__ unsigned xb_add(unsigned* p, unsigned v) { return __hip_atomic_fetch_add((GAS unsigned*)p, v, __ATOMIC_RELAXED, __HIP_MEMORY_SCOPE_AGENT); }
__device__ __forceinline__ unsigned xb_xcc_id() { return (unsigned)__builtin_amdgcn_s_getreg((3 << 11) | 20) & 0xFu; }
#define XB_SPIN(cond, bar) do { unsigned _sp = 0; while (cond) { __builtin_amdgcn_s_sleep(1); \
    if ((++_sp & 255u) == 0u) { if (xb_ld(&(bar)[XB_TMO])) break; if (_sp > XB_SPIN_CAP) { xb_add(&(bar)[XB_TMO], 1u); break; } } } } while (0)
struct XcdBarrier { unsigned* bar; unsigned x; volatile LAS unsigned* st; };
__device__ __forceinline__ XcdBarrier xcd_barrier_post(unsigned* bar, volatile LAS unsigned* st) {
    XcdBarrier b; b.bar = bar; b.x = (unsigned)__builtin_amdgcn_readfirstlane((int)xb_xcc_id()); b.st = st;
    if (threadIdx.x == 0) (void)xb_add(&bar[XB_XCNT(b.x)], 1u);
    return b;
}
__device__ __forceinline__ void xcd_barrier_complete(unsigned* bar, unsigned x, unsigned& nloc, unsigned& nx) {
    const unsigned G = gridDim.x * gridDim.y * gridDim.z;
    unsigned sum, cnt, mine, sp = 0u;
    for (;;) {
        sum = 0u; cnt = 0u; mine = 0u;
#pragma unroll
        for (unsigned j = 0; j < 16; ++j) { const unsigned c = xb_ld(&bar[XB_XCNT(j)]); sum += c; cnt += (c > 0u) ? 1u : 0u; mine = (j == x) ? c : mine; }
        if (sum == G) break;
        __builtin_amdgcn_s_sleep(1);
        if ((++sp & 255u) == 0u) { if (xb_ld(&bar[XB_TMO])) break; if (sp > XB_SPIN_CAP) { xb_add(&bar[XB_TMO], 1u); break; } }
    }
    nloc = mine > 0u ? mine : 1u; nx = cnt > 0u ? cnt : 1u;
}
__device__ __forceinline__ void xcd_barrier(const XcdBarrier& b) {
    asm volatile("s_waitcnt vmcnt(0)" ::: "memory");
    __syncthreads();
    if (threadIdx.x == 0) {
        unsigned* bar = b.bar; unsigned bx = b.x; asm volatile("" : "+s"(bar), "+s"(bx));
        __builtin_amdgcn_s_waitcnt(0);
        unsigned nloc = b.st[0], nx = b.st[1];
        if (nloc == 0u) { xcd_barrier_complete(bar, bx, nloc, nx); b.st[0] = nloc; b.st[1] = nx; }
        const unsigned old = xb_add(&bar[XB_XSUB(bx)], 1u);
        const unsigned gen = old / nloc;
        if (old + 1u == (gen + 1u) * nloc) {
            __builtin_amdgcn_fence(__ATOMIC_RELEASE, "agent");
            asm volatile("s_waitcnt vmcnt(0)" ::: "memory");
            const unsigned og = xb_add(&bar[XB_TOP], 1u);
            const unsigned tg = og / nx;
            if (og + 1u == (tg + 1u) * nx) xb_add(&bar[XB_TOPGEN], 1u);
            else XB_SPIN(xb_ld(&bar[XB_TOPGEN]) == tg, bar);
            __builtin_amdgcn_fence(__ATOMIC_ACQUIRE, "agent");
            xb_add(&bar[XB_XGEN(bx)], 1u);
            asm volatile("s_waitcnt vmcnt(0)" ::: "memory");
        } else {
            XB_SPIN(xb_ld(&bar[XB_XGEN(bx)]) == gen, bar);
            __builtin_amdgcn_fence(__ATOMIC_ACQUIRE, "agent");
            asm volatile("s_waitcnt vmcnt(0)" ::: "memory");
        }
    }
    __syncthreads();
}

enum { CV_NAT = 0, CV_WIN = 1, CV_WUQ = 2, CV_W13 = 3 };
__device__ __forceinline__ int ropeperm(int p) { return ((p >> 2) & 1) * 16 + 4 * (p >> 3) + (p & 3); }
__device__ __forceinline__ int cv_map(int kind, int G, int& which, float& scale, bool& perm) {
    which = 0; scale = 1.f; perm = false; const int n = G * 32;
    if (kind == CV_WIN) {
        if (n < 384) return n;
        if (n < 416) { perm = true; return 640; }
        if (n < 512) return -1;
        if (n < 768) return 384 + (n - 512);
        if (n < 1280) return 672 + (n - 768);
        if (n < 1792) return 1184 + (n - 1280);
        if (n < 2304) { scale = XSCALE; return 1696 + (n - 1792); }
        return 2208 + (n - 2304);
    }
    if (kind == CV_WUQ) { scale = QSCALE; perm = (G % 3) == 2; return n; }
    if (kind == CV_W13) { which = (n >> 7) & 1; return 128 * (n >> 8) + (n & 127); }
    return n;
}
struct CvDesc { const float* src; const float* src2; const float* gain; bf16* dst; int K, Nsrc, Nout, kind; };
__device__ __forceinline__ void cv_item(const CvDesc& d, int item, LAS char* tile, int lane) {
    const int nI = d.Nout >> 7, kb = item / nI, nb = item - kb * nI, k0 = 64 * kb, n0 = 128 * nb;
    const int nq = lane & 31, kh = lane >> 5;
    const int nout = n0 + 4 * nq, G = nout >> 5, p = nout & 31;
    int which; float scale; bool perm; const int sc = cv_map(d.kind, G, which, scale, perm);
    const bool zero = sc < 0;
    const float* W = d.src + (ptrdiff_t)which * (d.src2 - d.src) + (size_t)k0 * d.Nsrc + (zero ? 0 : sc + (perm ? ropeperm(p) : p));
#pragma unroll
    for (int half = 0; half < 2; ++half) {
        f32x4 v[16];
#pragma unroll
        for (int i = 0; i < 16; ++i) { const int k = 32 * half + 2 * i + kh; v[i] = zero ? (f32x4){0.f, 0.f, 0.f, 0.f} : *(const f32x4*)(W + (size_t)k * d.Nsrc); }
#pragma unroll
        for (int i = 0; i < 16; ++i) { const int k = 32 * half + 2 * i + kh; const float g = d.gain ? d.gain[k0 + k] * scale : scale; const f32x4 w = v[i] * g;
            *(LAS u32x2*)(tile + att::v_st<4>(k, 4 * nq)) = (u32x2){cvt_pk_bf16(w[0], w[1]), cvt_pk_bf16(w[2], w[3])}; }
    }
    LDS_WAIT(); asm volatile("" ::: "memory");
    const int vb = (int)(uintptr_t)tile + att::v_rd_base(lane);
    bf16* drow = d.dst + (size_t)(n0 >> 8) * 256 * d.K + (size_t)kb * (256 * 64) + (size_t)((n0 & 255) + nq) * 64 + 8 * kh;
#define CV_RD(D0, KS) { const s16x4 l_ = att::tr_read<((2 * KS) * 4 + D0) * 512>(vb), h_ = att::tr_read<((2 * KS + 1) * 4 + D0) * 512>(vb); \
        asm volatile("s_waitcnt lgkmcnt(0)" ::: "memory"); __builtin_amdgcn_sched_barrier(0); \
        *(bf16x8*)(drow + (32 * D0) * 64 + 16 * KS) = (bf16x8){l_[0], l_[1], l_[2], l_[3], h_[0], h_[1], h_[2], h_[3]}; }
#define CV_RD4(D0) CV_RD(D0, 0) CV_RD(D0, 1) CV_RD(D0, 2) CV_RD(D0, 3)
    CV_RD4(0) CV_RD4(1) CV_RD4(2) CV_RD4(3)
#undef CV_RD4
#undef CV_RD
    LDS_WAIT(); asm volatile("" ::: "memory");
}

struct Args {
    const float* x; const float* mem; const int* positions; const float* g_mix; const float* w_in; const float* g_q; const float* g_kv; const float* w_uq; const float* w_uk; const float* w_uv;
    const float* g_sg; const float* w_s; const float* b_s; const float* g_mem; const float* w_mkv; const float* w_br; const float* b_gate; const float* w_out; const float* g_ffn;
    const float* dense_w1; const float* dense_w3; const float* dense_w2; const float* w_router; const float* moe_w1; const float* moe_w3; const float* moe_w2; const float* g_final;
    float* out; unsigned char* ws; int dbg; int pad;
};
typedef const __attribute__((address_space(4))) Args* ArgsP;
#define FRESH(ap) ArgsP ap = kargs; asm volatile("" : "+s"(ap))
__constant__ double INVF[16] = { 1.0, 0.5623413251903491, 0.31622776601683794, 0.1778279410038923, 0.1, 0.05623413251903491, 0.03162277660168379, 0.01778279410038923,
                                 0.01, 0.005623413251903491, 0.003162277660168379, 0.001778279410038923, 0.001, 0.0005623413251903491, 0.00031622776601683794, 0.0001778279410038923 };

struct Frame { LAS unsigned char* lds; int G, NGW, bid; };
#define LOCAL_IDS int tid = threadIdx.x; asm volatile("" : "+v"(tid)); const int lane = tid & 63, wave = __builtin_amdgcn_readfirstlane(tid >> 6), gw = F.bid * NWAVES + wave; (void)lane; (void)gw

__device__ __forceinline__ void conv_run(const Frame& F, const CvDesc& d) {
    LOCAL_IDS;
    LAS char* tile = (LAS char*)(F.lds + wave * 16384);
    const int nitems = (d.K / 64) * (d.Nout / 128);
    for (int it = gw; it < nitems; it += F.NGW) cv_item(d, it, tile, lane);
}
__device__ __forceinline__ void rx_from_stats(const Frame& F, ArgsP kargs) {
    LOCAL_IDS; FRESH(ap); const float* xstat = (const float*)(ap->ws + WS_XSTAT); float* rx = (float*)(ap->ws + WS_RX);
    for (int row = F.bid * 512 + tid; row < M; row += F.G * 512) {
        const f32x4* p = (const f32x4*)(xstat + (size_t)row * 16); const f32x4 a = p[0], b = p[1], c = p[2], d = p[3];
        const float s = ((a[0] + a[1]) + (a[2] + a[3])) + ((b[0] + b[1]) + (b[2] + b[3])) + ((c[0] + c[1]) + (c[2] + c[3])) + ((d[0] + d[1]) + (d[2] + d[3]));
        rx[row] = __builtin_amdgcn_rsqf(s * (1.f / D) + EPS);
    }
}
__device__ __forceinline__ void conv_mixer(const Frame& F, ArgsP kargs, int l) {
    { FRESH(a); CvDesc d{a->w_in + (size_t)l * D * PTOT, nullptr, a->g_mix + l * D, (bf16*)(a->ws + WS_WINT), D, PTOT, PPAD, CV_WIN}; conv_run(F, d); }
    { FRESH(a); CvDesc d{a->w_uq + (size_t)l * QRANK * 768, nullptr, a->g_q + l * QRANK, (bf16*)(a->ws + WS_WUQT), QRANK, 768, 768, CV_WUQ}; conv_run(F, d); }
    { FRESH(a); CvDesc d{a->w_uk + (size_t)l * KVRANK * 512, nullptr, a->g_kv + l * KVRANK, (bf16*)(a->ws + WS_WUKVT), KVRANK, 512, 512, CV_NAT}; conv_run(F, d); }
    { FRESH(a); CvDesc d{a->w_uv + (size_t)l * KVRANK * 512, nullptr, a->g_kv + l * KVRANK, (bf16*)(a->ws + WS_WUKVT) + 512 * KVRANK, KVRANK, 512, 512, CV_NAT}; conv_run(F, d); }
#pragma unroll 1
    for (int n = 0; n < 3; ++n) { FRESH(a); CvDesc d{a->w_br + ((size_t)l * 3 + n) * BW * D, nullptr, nullptr, (bf16*)(a->ws + WS_WBRT) + (size_t)n * D * BW, BW, D, D, CV_NAT}; conv_run(F, d); }
    { FRESH(a); CvDesc d{a->w_out + (size_t)l * D * D, nullptr, nullptr, (bf16*)(a->ws + WS_WOUTT), D, D, D, CV_NAT}; conv_run(F, d); }
    { LOCAL_IDS; FRESH(a); const float* wsrc = a->w_s + (size_t)l * 65536; bf16* wdst = (bf16*)(a->ws + WS_WSB);
      for (int i = F.bid * 512 + tid; i < 4 * 128 * 128 / 4; i += F.G * 512) { const f32x4 v = *(const f32x4*)(wsrc + (size_t)i * 4);
        *(u32x2*)(wdst + (size_t)i * 4) = (u32x2){cvt_pk_bf16(v[0], v[1]), cvt_pk_bf16(v[2], v[3])}; } }
}
__device__ __forceinline__ void phase_prologue(const Frame& F, ArgsP kargs) {
    LOCAL_IDS;
    { FRESH(a); float* ROPE = (float*)(a->ws + WS_ROPE); const int* pos = a->positions;
      for (int idx = F.bid * 512 + tid; idx < M * 16; idx += F.G * 512) { const int row = idx >> 4, i = idx & 15;
        const double t = (double)pos[row] * INVF[i] * 0.15915494309189535; const float fr = (float)(t - rint(t));
        ROPE[(size_t)row * 32 + i] = __builtin_amdgcn_cosf(fr); ROPE[(size_t)row * 32 + 16 + i] = __builtin_amdgcn_sinf(fr); } }
    { FRESH(a); const float* xin = a->x; float* X = a->out; bf16* XB = (bf16*)(a->ws + WS_XB); float* RX = (float*)(a->ws + WS_RX);
      for (int m = gw; m < M; m += F.NGW) { const f32x4* xr = (const f32x4*)(xin + (size_t)m * D) + lane; f32x4 v[4]; float s = 0.f;
#pragma unroll
        for (int j = 0; j < 4; ++j) { v[j] = xr[64 * j]; s += sumsq4(v[j]); }
        s = wave_sum(s);
#pragma unroll
        for (int j = 0; j < 4; ++j) { ((f32x4*)(X + (size_t)m * D) + lane)[64 * j] = v[j]; ((u32x2*)(XB + (size_t)m * D) + lane)[64 * j] = (u32x2){cvt_pk_bf16(v[j][0], v[j][1]), cvt_pk_bf16(v[j][2], v[j][3])}; }
        if (lane == 0) RX[m] = __builtin_amdgcn_rsqf(s * (1.f / D) + EPS); } }
    { FRESH(a); const float* mem = a->mem; const float* g_mem = a->g_mem; bf16* MEMB = (bf16*)(a->ws + WS_MEMB);
      for (int m = gw; m < NMEM; m += F.NGW) { const f32x4* xr = (const f32x4*)(mem + (size_t)m * D) + lane; f32x4 v[4]; float s = 0.f;
#pragma unroll
        for (int j = 0; j < 4; ++j) { v[j] = xr[64 * j]; s += sumsq4(v[j]); }
        const float r = __builtin_amdgcn_rsqf(wave_sum(s) * (1.f / D) + EPS);
#pragma unroll
        for (int j = 0; j < 4; ++j) { const f32x4 g = ((const f32x4*)g_mem + lane)[64 * j]; const f32x4 w = v[j] * r * g;
            ((u32x2*)(MEMB + (size_t)m * D) + lane)[64 * j] = (u32x2){cvt_pk_bf16(w[0], w[1]), cvt_pk_bf16(w[2], w[3])}; } } }
#pragma unroll 1
    for (int l = 0; l < DEPTH; ++l) { FRESH(a); CvDesc d{a->w_mkv + (size_t)l * D * D, nullptr, nullptr, (bf16*)(a->ws + WS_WMKVT) + (size_t)l * D * D, D, D, D, CV_NAT}; conv_run(F, d); }
    conv_mixer(F, kargs, 0);
}
__device__ __forceinline__ void phase_inproj(const Frame& F, ArgsP kargs, int l) {
    if (PH(1)) { FRESH(a); unsigned char* ws = a->ws;
        pg8::TileOrder S{M / 256, PPAD / 256 - 1, F.G, F.bid, (const char*)(ws + WS_XB), (const char*)(ws + WS_WINT), (size_t)256 * D * 2, (size_t)256 * D * 2};
#ifdef DBG_REV
        S.rev = 1;
#endif
        pg8::EpiInProj E{ws, a->b_gate + (size_t)l * 3 * D, l, (l & 1)};
        pg8::gemm_phase(F.lds, D, D, D, S, E); }
    if (l == 0 && PH(2)) { FRESH(a); unsigned char* ws = a->ws;
        struct MemOrder { int c; const char* A; const char* B;
            __device__ __forceinline__ bool next(int i, pg8::Unit& u) const { if (i > 0 || c < 240) return false; const int idx = c - 240; u.pm = 0; u.pn = idx & 3; u.aux = idx >> 2; u.A = A; u.B = B + (size_t)u.aux * D * D * 2 + (size_t)u.pn * 256 * D * 2; return true; } };
        MemOrder S2{F.bid, (const char*)(ws + WS_MEMB), (const char*)(ws + WS_WMKVT)}; pg8::EpiMemKV E2{(bf16*)(ws + WS_KVMEM)};
        pg8::gemm_phase(F.lds, D, D, D, S2, E2); }
}
struct GateTailOrder { int c; const char* A; const char* B;
    __device__ __forceinline__ bool next(int i, pg8::Unit& u) const { if (i > 0 || c < 192) return false; u.pm = c - 192; u.pn = PPAD / 256 - 1; u.aux = 0; u.A = A + (size_t)u.pm * 256 * D * 2; u.B = B + (size_t)u.pn * 256 * D * 2; return true; } };
__device__ __forceinline__ void phase_up(const Frame& F, ArgsP kargs, int l) {
    if (PH(1)) { FRESH(a); unsigned char* ws = a->ws;
        GateTailOrder S{F.bid, (const char*)(ws + WS_XB), (const char*)(ws + WS_WINT)}; pg8::EpiInProj E{ws, a->b_gate + (size_t)l * 3 * D, l, (l & 1)};
        pg8::gemm_phase(F.lds, D, D, D, S, E); }
    if (PH(3)) { FRESH(a); unsigned char* ws = a->ws;
        pg8::TileOrder S{M / 256, 3, F.G, F.bid, (const char*)(ws + WS_CQ), (const char*)(ws + WS_WUQT), (size_t)256 * 512 * 2, (size_t)256 * QRANK * 2};
        pg8::EpiQ E{(const float*)(ws + WS_CQSTAT), (const float*)(ws + WS_ROPE), (bf16*)(ws + WS_Q)}; pg8::gemm_phase(F.lds, 512, QRANK, QRANK, S, E); }
    if (PH(4)) { FRESH(a); unsigned char* ws = a->ws;
        pg8::TileOrder S{M / 256, 4, F.G, F.bid, (const char*)(ws + WS_CKV), (const char*)(ws + WS_WUKVT), (size_t)256 * KVRANK * 2, (size_t)256 * KVRANK * 2};
        pg8::EpiKV E{(const float*)(ws + WS_CKVSTAT), (bf16*)(ws + WS_KN), (bf16*)(ws + WS_V), (unsigned*)(ws + WS_CTL) + CW_KMAX + l * 32}; pg8::gemm_phase(F.lds, KVRANK, KVRANK, KVRANK, S, E); }
    if (PH(5)) { FRESH(a); unsigned char* ws = a->ws;
        for (int un = F.bid; un < 512; un += F.G)
            att::spatial_unit(un >> 2, un & 3, (const bf16*)(ws + WS_U), (const bf16*)(ws + WS_VR), (const float*)(ws + WS_VSTAT), a->g_sg + l * BW, (const bf16*)(ws + WS_WSB), a->b_s + l * 512, (bf16*)(ws + WS_Y), (LAS char*)F.lds); }
    if (PH(6)) { FRESH(a); unsigned char* ws = a->ws;
        for (int un = F.bid; un < 256; un += F.G) { const int h = un & 3, pm = un >> 2; const bf16* kvm = (const bf16*)(ws + WS_KVMEM) + (size_t)l * 256 * 1024;
            att::attn_unit<128, 128, 128, false>((const bf16*)(ws + WS_QX) + (size_t)pm * 256 * 512 + h * 128, 512, kvm + h * 128, 1024, kvm, 1024, kvm + 512 + h * 128, 1024,
                                          (bf16*)(ws + WS_Y) + (size_t)pm * 256 * 1536 + 1024 + h * 128, 1536, NMEM, (LAS char*)F.lds, 0.f); } }
}
__device__ __forceinline__ void phase_attn(const Frame& F, ArgsP kargs, int l) {
    if (PH(7)) { FRESH(a); unsigned char* ws = a->ws;
        for (int un = F.bid; un < 256; un += F.G) { const int h = un & 7, qb = un >> 3;
            const unsigned* km = (const unsigned*)(ws + WS_CTL) + CW_KMAX + l * 32;
            const float kbound = sqrtf(__uint_as_float(km[2 * h]) + __uint_as_float(km[2 * h + 1]) + __uint_as_float(km[16])) * 1.02f;
            att::attn_unit2<96, 64, 64>((const bf16*)(ws + WS_Q) + (size_t)qb * 512 * 768 + h * 96, 768, (const bf16*)(ws + WS_KN) + h * 64, 512, (const bf16*)(ws + WS_KR), 32, (const bf16*)(ws + WS_V) + h * 64, 512,
                                        (bf16*)(ws + WS_Y) + (size_t)qb * 512 * 1536 + h * 64, 1536, M, (LAS char*)F.lds, kbound); } }
}
__device__ __forceinline__ void phase_branch(const Frame& F, ArgsP kargs) {
    if (PH(8)) { FRESH(a); unsigned char* ws = a->ws;
        struct BranchOrder { int c; const char* A; const char* B;
            __device__ __forceinline__ bool next(int i, pg8::Unit& u) const { if (i >= 3 || c >= 256) return false; int pm, pn; pg8::tile_of(c, 64, 4, pm, pn); u.pm = pm; u.pn = pn; u.aux = i;
                u.A = A + (size_t)pm * 256 * 1536 * 2 + (size_t)i * 512 * 2; u.B = B + (size_t)i * D * BW * 2 + (size_t)pn * 256 * BW * 2; return true; } };
        BranchOrder S{F.bid, (const char*)(ws + WS_Y), (const char*)(ws + WS_WBRT)}; pg8::EpiBranch E{(const bf16*)(ws + WS_GATE), (bf16*)(ws + WS_MIX), (bf16*)(ws + WS_MIX1), (bf16*)(ws + WS_MIXB)};
        pg8::gemm_phase(F.lds, 1536, BW, BW, S, E); }
}
__device__ __forceinline__ void phase_outproj(const Frame& F, ArgsP kargs, bool dummy = false) {
    if (PH(9)) { FRESH(a); unsigned char* ws = a->ws;
        pg8::TileOrder S{M / 256, 4, F.G, F.bid, (const char*)(ws + WS_MIXB), (const char*)(ws + WS_WOUTT), (size_t)256 * D * 2, (size_t)256 * D * 2};
        pg8::EpiResid E{a->out, dummy ? (float*)(ws + 700 * MiB) : a->out, (bf16*)(ws + (dummy ? 764 * MiB : WS_XB)), (float*)(ws + (dummy ? 796 * MiB : WS_XSTAT))}; pg8::gemm_phase(F.lds, 0, D, D, S, E); }
}
__device__ __forceinline__ void phase_dense_conv(const Frame& F, ArgsP kargs, int l, int j2) {
    { FRESH(a); CvDesc d{a->dense_w1 + (size_t)j2 * D * DFF, a->dense_w3 + (size_t)j2 * D * DFF, a->g_ffn + l * D, (bf16*)(a->ws + WS_WFFN), D, DFF, 2 * DFF, CV_W13}; conv_run(F, d); }
    { FRESH(a); CvDesc d{a->dense_w2 + (size_t)j2 * DFF * D, nullptr, nullptr, (bf16*)(a->ws + WS_W2D), DFF, D, D, CV_NAT}; conv_run(F, d); }
    rx_from_stats(F, kargs);
    conv_mixer(F, kargs, l + 1);
}
__device__ __forceinline__ void phase_dense_up(const Frame& F, ArgsP kargs) {
    if (PH(10)) { FRESH(a); unsigned char* ws = a->ws;
        pg8::TileOrder S{M / 256, 2 * DFF / 256, F.G, F.bid, (const char*)(ws + WS_XB), (const char*)(ws + WS_WFFN), (size_t)256 * D * 2, (size_t)256 * D * 2};
        pg8::EpiSwiGLU E{(const float*)(ws + WS_RX), (bf16*)(ws + WS_HFF), DFF, 0}; pg8::gemm_phase(F.lds, D, D, D, S, E); }
}
__device__ __forceinline__ void phase_dense_down(const Frame& F, ArgsP kargs, bool dummy = false) {
    if (PH(11)) { FRESH(a); unsigned char* ws = a->ws;
        pg8::TileOrder S{M / 256, 4, F.G, F.bid, (const char*)(ws + WS_HFF), (const char*)(ws + WS_W2D), (size_t)256 * DFF * 2, (size_t)256 * DFF * 2};
        pg8::EpiResid E{a->out, dummy ? (float*)(ws + 700 * MiB) : a->out, (bf16*)(ws + (dummy ? 764 * MiB : WS_XB)), (float*)(ws + (dummy ? 796 * MiB : WS_XSTAT))}; pg8::gemm_phase(F.lds, 0, DFF, DFF, S, E); }
}
__device__ __forceinline__ void phase_moe_route(const Frame& F, ArgsP kargs, int l, int j2) {
    {
        int tid_ = threadIdx.x; asm volatile("" : "+v"(tid_)); const int lane_ = tid_ & 63, wave_ = __builtin_amdgcn_readfirstlane(tid_ >> 6);
        LAS char* tile = (LAS char*)(F.lds + wave_ * 16384);
        constexpr int I13 = (D / 64) * (2 * DFE / 128), I2 = (DFE / 64) * (D / 128), IE = I13 + I2;
#pragma unroll 1
        for (int idx = F.bid * NWAVES + wave_; idx < NE * IE; idx += F.NGW) { const int e = idx / IE, r = idx - e * IE;
            FRESH(a);
            if (r < I13) { CvDesc d{a->moe_w1 + ((size_t)j2 * NE + e) * D * DFE, a->moe_w3 + ((size_t)j2 * NE + e) * D * DFE, a->g_ffn + l * D, (bf16*)(a->ws + WS_WFFN) + (size_t)e * 2 * DFE * D, D, DFE, 2 * DFE, CV_W13}; cv_item(d, r, tile, lane_); }
            else { CvDesc d{a->moe_w2 + ((size_t)j2 * NE + e) * DFE * D, nullptr, nullptr, (bf16*)(a->ws + WS_W2M) + (size_t)e * D * DFE, DFE, D, D, CV_NAT}; cv_item(d, r - I13, tile, lane_); } }
    }
    if (l + 1 < DEPTH) conv_mixer(F, kargs, l + 1);
    __syncthreads();
    LOCAL_IDS; FRESH(a); unsigned char* ws = a->ws; const float* X = a->out;
    float* RX = (float*)(ws + WS_RX); int* TOPI = (int*)(ws + WS_TOPI); float* TOPW = (float*)(ws + WS_TOPW); int* LRANK = (int*)(ws + WS_LRANK); int* BLKCNT = (int*)(ws + WS_BLKCNT);
    LAS int* tope = (LAS int*)(F.lds + 0);
    const float* wr = a->w_router + (size_t)j2 * D * NE; const float* gf = a->g_ffn + l * D;
#pragma unroll 1
    for (int i = 0; i < 8; ++i) { const int rib = wave * 8 + i, row = F.bid * 64 + rib;
        float lg[8]; float ss = 0.f;
#pragma unroll
        for (int e = 0; e < 8; ++e) lg[e] = 0.f;
#pragma unroll
        for (int j = 0; j < 4; ++j) { const int k0 = 4 * lane + 256 * j; const f32x4 xv = *(const f32x4*)(X + (size_t)row * D + k0), gv = *(const f32x4*)(gf + k0); ss += sumsq4(xv);
#pragma unroll
            for (int q = 0; q < 4; ++q) { const float hv = xv[q] * gv[q]; const f32x4 w0 = *(const f32x4*)(wr + (size_t)(k0 + q) * 8), w1 = *(const f32x4*)(wr + (size_t)(k0 + q) * 8 + 4);
                lg[0] += hv * w0[0]; lg[1] += hv * w0[1]; lg[2] += hv * w0[2]; lg[3] += hv * w0[3]; lg[4] += hv * w1[0]; lg[5] += hv * w1[1]; lg[6] += hv * w1[2]; lg[7] += hv * w1[3]; } }
        const float r = __builtin_amdgcn_rsqf(wave_sum(ss) * (1.f / D) + EPS);
#pragma unroll
        for (int e = 0; e < 8; ++e) lg[e] = wave_sum(lg[e]) * r;
        int e0 = 0; float v0 = lg[0];
#pragma unroll
        for (int e = 1; e < 8; ++e) if (lg[e] > v0) { v0 = lg[e]; e0 = e; }
        int e1 = e0 == 0 ? 1 : 0; float v1 = -3.0e38f;
#pragma unroll
        for (int e = 0; e < 8; ++e) if (e != e0 && lg[e] > v1) { v1 = lg[e]; e1 = e; }
        const float w0 = 1.f / (1.f + expf(v1 - v0));
        if (lane == 0) { RX[row] = r; TOPI[row] = e0 | (e1 << 8); TOPW[(size_t)row * 2] = w0; TOPW[(size_t)row * 2 + 1] = 1.f - w0; tope[rib] = e0 | (e1 << 8); } }
    __syncthreads();
    if (wave == 0) { const int te = tope[lane], e0 = te & 255, e1 = te >> 8, row = F.bid * 64 + lane; const unsigned long long below = (1ull << lane) - 1ull;
        int rk0 = 0, rk1 = 0;
#pragma unroll
        for (int e = 0; e < 8; ++e) { const unsigned long long m0 = __ballot(e0 == e), m1 = __ballot(e1 == e); const int c0 = __popcll(m0);
            if (e0 == e) rk0 = __popcll(m0 & below); if (e1 == e) rk1 = c0 + __popcll(m1 & below);
            if (lane == 0) BLKCNT[F.bid * 8 + e] = c0 + __popcll(m1); }
        LRANK[(size_t)row * 2] = rk0; LRANK[(size_t)row * 2 + 1] = rk1; }
    __syncthreads();
}
__device__ __forceinline__ void moe_tiles(const Frame& F, ArgsP kargs, int (&tb)[NE + 1], LAS int* pre) {
    LOCAL_IDS; FRESH(a); const int* BLKCNT = (const int*)(a->ws + WS_BLKCNT);
    __syncthreads();
    if (tid < 16) pre[tid] = 0;
    __syncthreads();
    if (tid < 256) { const i32x4 c0 = *(const i32x4*)(BLKCNT + tid * 8), c1 = *(const i32x4*)(BLKCNT + tid * 8 + 4); const int cc[8] = {c0[0], c0[1], c0[2], c0[3], c1[0], c1[1], c1[2], c1[3]};
#pragma unroll
        for (int e = 0; e < 8; ++e) { const int tot = (int)wave_sum((float)cc[e]); const int bel = (int)wave_sum(tid < F.bid ? (float)cc[e] : 0.f);
            if (lane == 0) { __hip_atomic_fetch_add(pre + 8 + e, tot, __ATOMIC_RELAXED, __HIP_MEMORY_SCOPE_WORKGROUP); __hip_atomic_fetch_add(pre + e, bel, __ATOMIC_RELAXED, __HIP_MEMORY_SCOPE_WORKGROUP); } } }
    __syncthreads();
    int acc_t = 0;
#pragma unroll
    for (int e = 0; e < NE; ++e) { tb[e] = acc_t; acc_t += (__builtin_amdgcn_readfirstlane(pre[8 + e]) + 255) >> 8; }
    tb[NE] = acc_t;
}
__device__ __forceinline__ void phase_moe_gather(const Frame& F, ArgsP kargs) {
    int tb[NE + 1]; LAS int* pre = (LAS int*)(F.lds + 0);
    moe_tiles(F, kargs, tb, pre);
    LOCAL_IDS; FRESH(a); unsigned char* ws = a->ws;
    const int* TOPI = (const int*)(ws + WS_TOPI); const int* LRANK = (const int*)(ws + WS_LRANK); int* POS = (int*)(ws + WS_POS); float* SLOTR = (float*)(ws + WS_SLOTR); const float* RX = (const float*)(ws + WS_RX);
    const bf16* XB = (const bf16*)(ws + WS_XB); bf16* XG = (bf16*)(ws + WS_XG);
#pragma unroll 1
    for (int p = 0; p < 16; ++p) { const int pi = wave * 16 + p, rib = pi >> 1, k = pi & 1, row = F.bid * 64 + rib;
        const int te = TOPI[row], e = __builtin_amdgcn_readfirstlane(k ? (te >> 8) : (te & 255));
        int bs = 0;
#pragma unroll
        for (int q = 0; q < NE; ++q) if (q == e) bs = tb[q] * 256;
        const int slot = bs + __builtin_amdgcn_readfirstlane(pre[e]) + LRANK[(size_t)row * 2 + k];
        const u32x4* s = (const u32x4*)(XB + (size_t)row * D) + lane; u32x4* dd = (u32x4*)(XG + (size_t)slot * D) + lane; dd[0] = s[0]; dd[64] = s[64];
        if (lane == 0) { POS[(size_t)row * 2 + k] = slot; SLOTR[slot] = RX[row]; } }
    if (F.bid < NE) { const int e = F.bid; int b0 = 0, b1 = 0;
#pragma unroll
        for (int q = 0; q < NE; ++q) if (q == e) { b0 = tb[q] * 256; b1 = tb[q + 1] * 256; }
        const int cnt = __builtin_amdgcn_readfirstlane(pre[8 + e]);
        for (int s = b0 + cnt + wave; s < b1; s += NWAVES) { u32x4* dd = (u32x4*)(XG + (size_t)s * D) + lane; dd[0] = (u32x4){0u, 0u, 0u, 0u}; dd[64] = (u32x4){0u, 0u, 0u, 0u}; if (lane == 0) SLOTR[s] = 0.f; } }
    __syncthreads();
}
struct MoeOrder { int nN, G, c, T; int tb[NE + 1]; const char* A; const char* B; size_t astep, estep, bstep; int rev = 0;
    __device__ __forceinline__ bool next(int i, pg8::Unit& u) const { const long L = (long)i * G + c; if (L >= (long)T * nN) return false; int pm, pn; pg8::tile_of((int)L, T, nN, pm, pn); if (rev) pm = T - 1 - pm;
        int e = 0;
#pragma unroll
        for (int q = 1; q < NE; ++q) e += (pm >= tb[q]) ? 1 : 0;
        u.pm = pm; u.pn = pn; u.aux = e; u.A = A + (size_t)pm * astep; u.B = B + (size_t)e * estep + (size_t)pn * bstep; return true; } };
__device__ __forceinline__ void phase_moe_up(const Frame& F, ArgsP kargs) {
    if (PH(12)) { MoeOrder S; LAS int* pre = (LAS int*)(F.lds + RING_BYTES + 64); moe_tiles(F, kargs, S.tb, pre);
        FRESH(a); unsigned char* ws = a->ws; S.nN = 2 * DFE / 256; S.G = F.G; S.c = F.bid; S.T = S.tb[NE];
        S.A = (const char*)(ws + WS_XG); S.B = (const char*)(ws + WS_WFFN); S.astep = (size_t)256 * D * 2; S.estep = (size_t)2 * DFE * D * 2; S.bstep = (size_t)256 * D * 2;
        pg8::EpiSwiGLU E{(const float*)(ws + WS_SLOTR), (bf16*)(ws + WS_HG), DFE, 0}; pg8::gemm_phase(F.lds, D, D, D, S, E); }
}
__device__ __forceinline__ void phase_moe_down(const Frame& F, ArgsP kargs) {
    if (PH(13)) { MoeOrder S; LAS int* pre = (LAS int*)(F.lds + RING_BYTES + 64); moe_tiles(F, kargs, S.tb, pre);
        FRESH(a); unsigned char* ws = a->ws; S.nN = 4; S.G = F.G; S.c = F.bid; S.T = S.tb[NE]; S.rev = 1;
        S.A = (const char*)(ws + WS_HG); S.B = (const char*)(ws + WS_W2M); S.astep = (size_t)256 * DFE * 2; S.estep = (size_t)D * DFE * 2; S.bstep = (size_t)256 * DFE * 2;
        pg8::EpiBf16 E{(bf16*)(ws + WS_OUTG), D}; pg8::gemm_phase(F.lds, 0, DFE, DFE, S, E); }
}
__device__ __forceinline__ void phase_moe_combine(const Frame& F, ArgsP kargs, bool last) {
    LOCAL_IDS; FRESH(a); unsigned char* ws = a->ws; float* X = a->out; const bf16* OUTG = (const bf16*)(ws + WS_OUTG); const int* POS = (const int*)(ws + WS_POS); const float* TOPW = (const float*)(ws + WS_TOPW);
    bf16* XB = (bf16*)(ws + WS_XB); float* RX = (float*)(ws + WS_RX); const float* g_final = a->g_final;
    for (int m = gw; m < M; m += F.NGW) {
        const int s0 = POS[(size_t)m * 2], s1 = POS[(size_t)m * 2 + 1]; const float w0 = TOPW[(size_t)m * 2], w1 = TOPW[(size_t)m * 2 + 1];
        f32x4 v[4]; float s = 0.f;
#pragma unroll
        for (int j = 0; j < 4; ++j) { const u32x2 p0 = ((const u32x2*)(OUTG + (size_t)s0 * D) + lane)[64 * j], p1 = ((const u32x2*)(OUTG + (size_t)s1 * D) + lane)[64 * j];
            const f32x4 o0 = {bflo(p0.x), bfhi(p0.x), bflo(p0.y), bfhi(p0.y)}, o1 = {bflo(p1.x), bfhi(p1.x), bflo(p1.y), bfhi(p1.y)};
            v[j] = ((const f32x4*)(X + (size_t)m * D) + lane)[64 * j] + w0 * o0 + w1 * o1; s += sumsq4(v[j]); }
        const float r = __builtin_amdgcn_rsqf(wave_sum(s) * (1.f / D) + EPS);
        if (last) {
#pragma unroll
            for (int j = 0; j < 4; ++j) ((f32x4*)(X + (size_t)m * D) + lane)[64 * j] = v[j] * r * ((const f32x4*)g_final + lane)[64 * j];
        } else {
#pragma unroll
            for (int j = 0; j < 4; ++j) { ((f32x4*)(X + (size_t)m * D) + lane)[64 * j] = v[j]; ((u32x2*)(XB + (size_t)m * D) + lane)[64 * j] = (u32x2){cvt_pk_bf16(v[j][0], v[j][1]), cvt_pk_bf16(v[j][2], v[j][3])}; }
            if (lane == 0) RX[m] = r;
        }
    }
}


#ifdef DBG_ENABLE
__device__ __forceinline__ float dbg_b(const unsigned char* ws, size_t off, size_t idx) { return bf2f(((const bf16*)(ws + off))[idx]); }
__device__ __forceinline__ void dbg_dump(const Frame& F, ArgsP kargs, int code) {
    LOCAL_IDS; FRESH(a); const unsigned char* ws = a->ws; float* out = a->out;
    unsigned tmo = ((const unsigned*)(ws + WS_CTL))[CW_BAR + XB_TMO];
    for (size_t i = (size_t)F.bid * 512 + tid; i < (size_t)M * D; i += (size_t)F.G * 512) { const size_t row = i >> 10, c = i & 1023; float v = 0.f;
        if (code == 1) v = dbg_b(ws, WS_CQ, row * 512 + (c & 511)) + dbg_b(ws, WS_CKV, row * 256 + (c & 255)) + dbg_b(ws, WS_U, row * 512 + (c & 511)) + dbg_b(ws, WS_VR, row * 512 + (c & 511)) + dbg_b(ws, WS_QX, row * 512 + (c & 511))
                         + dbg_b(ws, WS_GATE, row * 3072 + c) + dbg_b(ws, WS_GATE, row * 3072 + 1024 + c) + dbg_b(ws, WS_GATE, row * 3072 + 2048 + c) + dbg_b(ws, WS_KR, row * 32 + (c & 31));
        else if (code == 2) v = dbg_b(ws, WS_Q, row * 768 + (c % 768)) + dbg_b(ws, WS_KN, row * 512 + (c & 511)) + dbg_b(ws, WS_V, row * 512 + (c & 511)) + dbg_b(ws, WS_Y, row * 1536 + 512 + c);
        else if (code == 3) v = dbg_b(ws, WS_Y, row * 1536 + (c & 511));
        else if (code == 15) v = dbg_b(ws, WS_WINT, i % ((size_t)PPAD * D));
        else if (code == 13 || code == 14) v = dbg_b(ws, WS_GATE, row * 3072 + c) + dbg_b(ws, WS_GATE, row * 3072 + 1024 + c) + dbg_b(ws, WS_GATE, row * 3072 + 2048 + c);
        else if (code == 4) v = dbg_b(ws, WS_MIXB, row * 1024 + c);
        else if (code == 6) v = dbg_b(ws, WS_HFF, row * 2688 + c) + dbg_b(ws, WS_HFF, row * 2688 + 1024 + c) + dbg_b(ws, WS_HFF, row * 2688 + 1664 + c);
        else if (code == 9) { const int s0 = ((const int*)(ws + WS_POS))[row * 2], s1 = ((const int*)(ws + WS_POS))[row * 2 + 1]; v = dbg_b(ws, WS_XG, (size_t)s0 * 1024 + c) + 2.f * dbg_b(ws, WS_XG, (size_t)s1 * 1024 + c) + ((const float*)(ws + WS_TOPW))[row * 2] + (float)s0 * 1e-3f; }
        else if (code == 10) { const int s0 = ((const int*)(ws + WS_POS))[row * 2], s1 = ((const int*)(ws + WS_POS))[row * 2 + 1]; v = dbg_b(ws, WS_HG, (size_t)s0 * 3584 + c) + dbg_b(ws, WS_HG, (size_t)s1 * 3584 + 2560 + c) + dbg_b(ws, WS_HG, (size_t)s0 * 3584 + 1500 + c); }
        else if (code == 11) { const int s0 = ((const int*)(ws + WS_POS))[row * 2], s1 = ((const int*)(ws + WS_POS))[row * 2 + 1]; v = ((const float*)(ws + WS_OUTG))[(size_t)s0 * 1024 + c] + ((const float*)(ws + WS_OUTG))[(size_t)s1 * 1024 + c]; }
        else continue;
        if (tmo) v = __builtin_nanf("");
        out[i] = v; }
}
#define DBG(code) do { if (dbgc == (code)) { dbg_dump(F, kargs, code); return; } } while (0)
#else
#define DBG(code) do { } while (0)
#endif

__global__ void __launch_bounds__(NWAVES * 64, 2) fwd_kernel(Args args_by_value) {
    extern __shared__ __attribute__((aligned(16))) unsigned char lds_raw[];
    const ArgsP kargs = (ArgsP)__builtin_amdgcn_kernarg_segment_ptr();
    Frame F; F.lds = (LAS unsigned char*)lds_raw; F.G = gridDim.x; F.bid = blockIdx.x; F.NGW = F.G * NWAVES;
    for (int u = threadIdx.x; u < (LDS_BYTES - LDSCTL_OFF) / 4; u += NWAVES * 64) ((LAS unsigned*)(F.lds + LDSCTL_OFF))[u] = 0u;
    __syncthreads();
    volatile LAS unsigned* MISC = (volatile LAS unsigned*)(F.lds + MISC_OFF);
    XcdBarrier bar; { FRESH(a); bar = xcd_barrier_post((unsigned*)(a->ws + WS_CTL) + CW_BAR, MISC + 8); }
#define GRID_BAR() xcd_barrier(bar)

#ifdef ONLY_TEST
    ONLY_TEST; GRID_BAR(); return;
#endif
    const Frame F_ = F;
    int dbgc; { FRESH(a); dbgc = a->dbg; } (void)dbgc;
    phase_prologue(F, kargs); GRID_BAR();
#pragma unroll 1
    for (int l_ = 0; l_ < DEPTH; ++l_) {
        Frame F = F_; int l = l_; asm volatile("" : "+s"(F.G), "+s"(F.NGW), "+s"(F.bid), "+s"(l));
        const bool moe = (l & 1) != 0; const int j2 = l >> 1;
        if (l == 0) DBG(15);
#ifdef PROBE_INPROJ2
        { int reps = 2; asm volatile("" : "+s"(reps));
#pragma unroll 1
          for (int rep = 0; rep < reps; ++rep) { phase_inproj(F, kargs, l); GRID_BAR(); } }
#else
        phase_inproj(F, kargs, l); GRID_BAR(); if (l == 0) DBG(1); if (l == 0) DBG(14);
#endif
        phase_up(F, kargs, l); GRID_BAR(); if (l == 0) DBG(2);
        phase_attn(F, kargs, l); GRID_BAR(); if (l == 0) DBG(3); if (l == 0) DBG(13);
#ifdef PROBE_ATTN2
        phase_attn(F, kargs, l); GRID_BAR();
#endif
#ifdef PROBE_UP2
        phase_up(F, kargs, l); GRID_BAR();
#endif
        phase_branch(F, kargs); GRID_BAR(); if (l == 0) DBG(4);
#ifdef PROBE_RESID2
        { int reps = 2; asm volatile("" : "+s"(reps));
#pragma unroll 1
          for (int rep = reps - 1; rep >= 0; --rep) { phase_outproj(F, kargs, rep != 0); GRID_BAR(); } }
#else
        phase_outproj(F, kargs); GRID_BAR(); if (l == 0) DBG(5); if (l == 1) DBG(8);
#endif
        if (!moe) {
            phase_dense_conv(F, kargs, l, j2); GRID_BAR();
            phase_dense_up(F, kargs); GRID_BAR(); if (l == 0) DBG(6);
#ifdef PROBE_DENSE2
            phase_dense_up(F, kargs); GRID_BAR();
#endif
#ifdef PROBE_RESID2
            { int reps = 2; asm volatile("" : "+s"(reps));
#pragma unroll 1
              for (int rep = reps - 1; rep >= 0; --rep) { phase_dense_down(F, kargs, rep != 0); GRID_BAR(); } }
#else
            phase_dense_down(F, kargs); GRID_BAR(); if (l == 0) DBG(7);
#endif
        } else {
            phase_moe_route(F, kargs, l, j2); GRID_BAR();
            phase_moe_gather(F, kargs); GRID_BAR(); if (l == 1) DBG(9);
#ifdef PROBE_AUX2
            phase_moe_gather(F, kargs); GRID_BAR();
#endif
            phase_moe_up(F, kargs); GRID_BAR(); if (l == 1) DBG(10);
            phase_moe_down(F, kargs); GRID_BAR(); if (l == 1) DBG(11);
#ifdef PROBE_MOE2
            phase_moe_up(F, kargs); GRID_BAR();
            phase_moe_down(F, kargs); GRID_BAR();
#endif
            phase_moe_combine(F, kargs, l == DEPTH - 1);
            if (l != DEPTH - 1) GRID_BAR();
            if (l == 1) DBG(12);
        }
    }
}

extern "C" void kernel_launch(void* const* d_in, const int* in_sizes, int n_in, void* d_out, int out_size, void* d_ws, size_t ws_size, hipStream_t stream) {
    static int grid = 0;
    if (grid == 0) {
        if (n_in != 27 || in_sizes[0] != M * D || out_size != M * D || ws_size < WS_END) { fprintf(stderr, "kernel_launch: unexpected shapes (n_in %d, in0 %d, out %d, ws %zu)\n", n_in, n_in > 0 ? in_sizes[0] : -1, out_size, ws_size); grid = -1; return; }
        int dev = 0, cus = 0, per_cu = 0;
        if (hipGetDevice(&dev) != hipSuccess || hipDeviceGetAttribute(&cus, hipDeviceAttributeMultiprocessorCount, dev) != hipSuccess) { grid = -1; return; }
        if (hipFuncSetAttribute((const void*)fwd_kernel, hipFuncAttributeMaxDynamicSharedMemorySize, LDS_BYTES) != hipSuccess) { fprintf(stderr, "kernel_launch: hipFuncSetAttribute failed\n"); grid = -1; return; }
        if (hipOccupancyMaxActiveBlocksPerMultiprocessor(&per_cu, (const void*)fwd_kernel, NWAVES * 64, LDS_BYTES) != hipSuccess || per_cu < 1) { fprintf(stderr, "kernel_launch: occupancy query reports %d\n", per_cu); }
        (void)hipGetLastError();
        if (cus != 256) { fprintf(stderr, "kernel_launch: built for 256 CUs, device has %d\n", cus); grid = -1; return; }
        grid = 256;
    }
    if (grid < 0) return;
    if (hipMemsetAsync((char*)d_ws + WS_CTL, 0, CTL_ZERO_BYTES, stream) != hipSuccess) return;
    Args a{};
    a.x = (const float*)d_in[0]; a.mem = (const float*)d_in[1]; a.positions = (const int*)d_in[2]; a.g_mix = (const float*)d_in[3]; a.w_in = (const float*)d_in[4]; a.g_q = (const float*)d_in[5];
    a.g_kv = (const float*)d_in[6]; a.w_uq = (const float*)d_in[7]; a.w_uk = (const float*)d_in[8]; a.w_uv = (const float*)d_in[9]; a.g_sg = (const float*)d_in[10]; a.w_s = (const float*)d_in[11];
    a.b_s = (const float*)d_in[12]; a.g_mem = (const float*)d_in[13]; a.w_mkv = (const float*)d_in[14]; a.w_br = (const float*)d_in[15]; a.b_gate = (const float*)d_in[16]; a.w_out = (const float*)d_in[17];
    a.g_ffn = (const float*)d_in[18]; a.dense_w1 = (const float*)d_in[19]; a.dense_w3 = (const float*)d_in[20]; a.dense_w2 = (const float*)d_in[21]; a.w_router = (const float*)d_in[22];
    a.moe_w1 = (const float*)d_in[23]; a.moe_w3 = (const float*)d_in[24]; a.moe_w2 = (const float*)d_in[25]; a.g_final = (const float*)d_in[26];
    a.out = (float*)d_out; a.ws = (unsigned char*)d_ws;
#ifdef DBG_STOP
    a.dbg = DBG_STOP;
#endif
    hipLaunchKernelGGL(fwd_kernel, dim3(grid), dim3(NWAVES * 64), LDS_BYTES, stream, a);
    const hipError_t le = hipPeekAtLastError();
    if (le != hipSuccess) fprintf(stderr, "kernel_launch: launch failed: %s\n", hipGetErrorName(le));
}
```

```cpp
#include <hip/hip_runtime.h>
#include <cstdio>
#include <cstdint>

#ifndef PH_MASK
#define PH_MASK 0xffffffffu
#endif
#define PH(k) ((PH_MASK >> (k)) & 1u)
#define LAS __attribute__((address_space(3)))
#define GAS __attribute__((address_space(1)))
typedef unsigned short bf16;
typedef short bf16x8 __attribute__((ext_vector_type(8)));
typedef short s16x4 __attribute__((ext_vector_type(4)));
typedef float f32x4 __attribute__((ext_vector_type(4)));
typedef float f32x2 __attribute__((ext_vector_type(2)));
typedef float f32x16 __attribute__((ext_vector_type(16)));
typedef unsigned u32x4 __attribute__((ext_vector_type(4)));
typedef unsigned u32x2 __attribute__((ext_vector_type(2)));
typedef int i32x4 __attribute__((ext_vector_type(4)));

constexpr int M = 16384, D = 1024, DEPTH = 4, NMEM = 256;
constexpr int QRANK = 384, KVRANK = 256, NH = 8, QKD = 96, VD = 64;
constexpr int XH = 4, XD = 128, BW = 512;
constexpr int PTOT = 5280, PPAD = 5376, DFF = 2688, NE = 8, DFE = 3584;
constexpr float EPS = 1e-6f;
constexpr int MAXSLOT = 34816;
constexpr float LOG2E = 1.4426950408889634f;
constexpr float QSCALE = 0.10206207261596575f * LOG2E;
constexpr float XSCALE = 0.08838834764831845f * LOG2E;

constexpr size_t MiB = 1u << 20, KiB = 1u << 10;
constexpr size_t WS_CTL = 0, CTL_ZERO_BYTES = 1 * MiB;
constexpr size_t WS_ROPE = 2 * MiB;
constexpr size_t WS_XSTAT = 4 * MiB;
constexpr size_t WS_RX = 5 * MiB;
constexpr size_t WS_CQSTAT = 5 * MiB + 256 * KiB;
constexpr size_t WS_CKVSTAT = 5 * MiB + 768 * KiB;
constexpr size_t WS_VSTAT = 6 * MiB;
constexpr size_t WS_MEMB = 6 * MiB + 512 * KiB;
constexpr size_t WS_KVMEM = 7 * MiB;
constexpr size_t WS_TOPI = 9 * MiB;
constexpr size_t WS_TOPW = 9 * MiB + 256 * KiB;
constexpr size_t WS_LRANK = 9 * MiB + 512 * KiB;
constexpr size_t WS_POS = 9 * MiB + 768 * KiB;
constexpr size_t WS_BLKCNT = 10 * MiB;
constexpr size_t WS_SLOTR = 10 * MiB + 512 * KiB;
constexpr size_t WS_WSB = 11 * MiB;
constexpr size_t WS_WMKVT = 12 * MiB;
constexpr size_t WS_WINT = 20 * MiB;
constexpr size_t WS_WUQT = 31 * MiB;
constexpr size_t WS_WUKVT = 32 * MiB;
constexpr size_t WS_WBRT = 33 * MiB;
constexpr size_t WS_WOUTT = 36 * MiB;
constexpr size_t WS_WFFN = 40 * MiB;
constexpr size_t WS_W2D = WS_WFFN + 11 * MiB;
constexpr size_t WS_W2M = WS_WFFN + 112 * MiB;
constexpr size_t WS_XB = 208 * MiB;
constexpr size_t WS_CQ = 240 * MiB;
constexpr size_t WS_CKV = 256 * MiB;
constexpr size_t WS_U = 264 * MiB;
constexpr size_t WS_VR = 280 * MiB;
constexpr size_t WS_QX = 296 * MiB;
constexpr size_t WS_GATE = 312 * MiB;
constexpr size_t WS_Q = 408 * MiB;
constexpr size_t WS_KN = 432 * MiB;
constexpr size_t WS_KR = 448 * MiB;
constexpr size_t WS_V = 450 * MiB;
constexpr size_t WS_Y = 466 * MiB;
constexpr size_t WS_MIX = 514 * MiB;
constexpr size_t WS_MIXB = 578 * MiB;
constexpr size_t WS_MIX1 = 610 * MiB;
constexpr size_t WS_HFF = 240 * MiB;
constexpr size_t WS_XG = 240 * MiB;
constexpr size_t WS_HG = 308 * MiB;
constexpr size_t WS_OUTG = 546 * MiB;
constexpr size_t WS_END = 682 * MiB;
constexpr int CW_TMO = 0, CW_CODE = 1, CW_CHK = 2, CW_BAR = 4096;
constexpr int CW_KMAX = 8192;

constexpr int RING_BYTES = 131072, LDSCTL_OFF = 159744, MISC_OFF = LDSCTL_OFF + 320, LDS_BYTES = 163840;
constexpr int NWAVES = 8;

#define RLX_AGENT __ATOMIC_RELAXED, __HIP_MEMORY_SCOPE_AGENT
#define LDS_WAIT() asm volatile("s_waitcnt lgkmcnt(0)" ::: "memory")
#define VM_WAIT() asm volatile("s_waitcnt vmcnt(0)" ::: "memory")
typedef __bf16 bf16x2_t __attribute__((ext_vector_type(2)));
__device__ __forceinline__ unsigned cvt_pk_bf16(float lo, float hi) { const f32x2 v = {lo, hi}; const bf16x2_t b = __builtin_convertvector(v, bf16x2_t); return __builtin_bit_cast(unsigned, b); }
__device__ __forceinline__ bf16 f2bf(float f) { return (bf16)(cvt_pk_bf16(f, 0.f) & 0xffffu); }
__device__ __forceinline__ float bf2f(bf16 v) { return __uint_as_float((unsigned)v << 16); }
__device__ __forceinline__ float bflo(unsigned w) { return __uint_as_float(w << 16); }
__device__ __forceinline__ float bfhi(unsigned w) { return __uint_as_float(w & 0xffff0000u); }
__device__ __forceinline__ float fast_exp2(float x) { return __builtin_amdgcn_exp2f(x); }
__device__ __forceinline__ float fast_rcp(float x) { return __builtin_amdgcn_rcpf(x); }
__device__ __forceinline__ float sigmoidf_(float z) { return fast_rcp(1.f + fast_exp2(-LOG2E * z)); }
__device__ __forceinline__ float gelu_tanh(float x) { const float t = x + 0.044715f * x * x * x; return x * fast_rcp(1.f + fast_exp2(-2.f * 0.7978845608028654f * LOG2E * t)); }
__device__ __forceinline__ float wave_sum(float v) {
#pragma unroll
    for (int o = 1; o < 64; o <<= 1) v += __shfl_xor(v, o);
    return v;
}
__device__ __forceinline__ float sumsq4(f32x4 v) { return (v[0] * v[0] + v[1] * v[1]) + (v[2] * v[2] + v[3] * v[3]); }
__device__ __forceinline__ u32x2 pack8_u8(f32x4 a, f32x4 b) { unsigned w0 = 0, w1 = 0; a = a * 255.f; b = b * 255.f;
    w0 = __builtin_amdgcn_cvt_pk_u8_f32(a[0], 0, w0); w0 = __builtin_amdgcn_cvt_pk_u8_f32(a[1], 1, w0); w0 = __builtin_amdgcn_cvt_pk_u8_f32(a[2], 2, w0); w0 = __builtin_amdgcn_cvt_pk_u8_f32(a[3], 3, w0);
    w1 = __builtin_amdgcn_cvt_pk_u8_f32(b[0], 0, w1); w1 = __builtin_amdgcn_cvt_pk_u8_f32(b[1], 1, w1); w1 = __builtin_amdgcn_cvt_pk_u8_f32(b[2], 2, w1); w1 = __builtin_amdgcn_cvt_pk_u8_f32(b[3], 3, w1);
    return (u32x2){w0, w1}; }
__device__ __forceinline__ void unpack8_u8(u32x2 w, f32x4& a, f32x4& b) { constexpr float k = 1.f / 255.f;
    a = (f32x4){(float)(w.x & 255u), (float)((w.x >> 8) & 255u), (float)((w.x >> 16) & 255u), (float)(w.x >> 24)} * k;
    b = (f32x4){(float)(w.y & 255u), (float)((w.y >> 8) & 255u), (float)((w.y >> 16) & 255u), (float)(w.y >> 24)} * k; }
__device__ __forceinline__ u32x4 pack8(f32x4 a, f32x4 b) { u32x4 w; w.x = cvt_pk_bf16(a[0], a[1]); w.y = cvt_pk_bf16(a[2], a[3]); w.z = cvt_pk_bf16(b[0], b[1]); w.w = cvt_pk_bf16(b[2], b[3]); return w; }
__device__ __forceinline__ void unpack8(u32x4 w, f32x4& a, f32x4& b) { a = (f32x4){bflo(w.x), bfhi(w.x), bflo(w.y), bfhi(w.y)}; b = (f32x4){bflo(w.z), bfhi(w.z), bflo(w.w), bfhi(w.w)}; }

namespace pg8 {
constexpr int BM = 256, BK = 64, HALF = 128, HTB = HALF * BK * 2, STAGE_BYTES = 8 * HTB, NXCD = 8, WGM = 8;
__host__ __device__ __forceinline__ int lds_byte(int r, int c) { const int st = (r >> 4) * 2 + (c >> 5), rr = r & 15, cc = c & 31, ob = rr * 64 + cc * 2; return st * 1024 + (ob ^ (((ob >> 9) & 1) << 5)); }
__host__ __device__ __forceinline__ void stage_rc(int b, int& R, int& C) { const int st = b / 1024, sb = b % 1024, swz = sb ^ (((sb >> 9) & 1) << 5); R = (st >> 1) * 16 + swz / 64; C = (st & 1) * 32 + (swz % 64) / 2; }
__host__ __device__ __forceinline__ int perm32(int rho) { const int n = rho >> 4, i = rho & 15; return 8 * (i >> 2) + 4 * n + (i & 3); }

struct Unit { const char* A; const char* B; int pm, pn, aux; };
typedef f32x4 Acc[2][2][4][2];

__device__ __forceinline__ void tile_of(int L, int nM, int nN, int& pm, int& pn) {
    const int nwg = nM * nN; int wgid = L;
    { const int q = nwg / NXCD, r = nwg % NXCD, xcd = wgid % NXCD, off = wgid / NXCD; wgid = (xcd < r ? xcd * (q + 1) : r * (q + 1) + (xcd - r) * q) + off; }
    const int nig = WGM * nN, gid = wgid / nig, fm = gid * WGM, gsz = (nM - fm) < WGM ? (nM - fm) : WGM;
    pm = fm + ((wgid % nig) % gsz); pn = (wgid % nig) / gsz;
}
struct TileOrder {
    int nM, nN, G, c; const char* A; const char* B; size_t astep, bstep;
    int rev = 0;
    __device__ __forceinline__ bool next(int i, Unit& u) const {
        if (rev) { const int cnt = (nM * nN - c + G - 1) / G; if (i >= cnt) return false; i = cnt - 1 - i; }
        const long L = (long)i * G + c; if (L >= (long)nM * nN) return false;
        int pm, pn; tile_of((int)L, nM, nN, pm, pn);
        u.pm = pm; u.pn = pn; u.aux = 0; u.A = A + (size_t)pm * astep; u.B = B + (size_t)pn * bstep; return true;
    }
};

template <class Epi, class Sched>
__device__ __forceinline__ void gemm_phase(LAS unsigned char* lds, const int lda, const int ldb, const int K, const Sched& S, const Epi& E) {
    int tid_ = threadIdx.x; asm volatile("" : "+v"(tid_));
    const int tid = tid_, wid = __builtin_amdgcn_readfirstlane(tid >> 6), lane = tid & 63, wr = wid >> 2, wc = wid & 3, fr = lane & 15, fq = lane >> 4;
    const int nt = K / BK;
    unsigned voffA[2], voffB[2];
#pragma unroll
    for (int i = 0; i < 2; ++i) { int R, C; stage_rc(tid * 16 + i * 8192, R, C); const int Rb = (R & ~31) + perm32(R & 31);
        voffA[i] = (unsigned)(R * (lda ? lda : BK) + C) * 2u; voffB[i] = (unsigned)(Rb * BK + C) * 2u; }
    const size_t kstep = lda ? (size_t)(BK * 2) : (size_t)BM * BK * 2;
    const size_t hstepA = (size_t)HALF * (lda ? lda : BK) * 2, hstepB = (size_t)HALF * BK * 2, kstepB = (size_t)BM * BK * 2; (void)ldb;
    const unsigned ldsw = (unsigned)wid * 1024u;
    const int aoff = lds_byte(wr * 64 + fr, fq * 8), boff = lds_byte(wc * 32 + fr, fq * 8);
#define PG8_SA(b, h) (((b) * 2 + (h)) * HTB)
#define PG8_SB(b, h) ((4 + (b) * 2 + (h)) * HTB)
#define PG8_STAGE(bufoff, gbase, voff) do { _Pragma("unroll") for (int _i = 0; _i < 2; ++_i) \
        __builtin_amdgcn_global_load_lds((const unsigned*)((const char*)(gbase) + (voff)[_i]), (LAS unsigned*)(lds + (bufoff) + ldsw + _i * 8192), 16, 0, 0); } while (0)
#define PG8_LDA(dst, b, h) do { _Pragma("unroll") for (int m = 0; m < 4; ++m) _Pragma("unroll") for (int k = 0; k < 2; ++k) dst[m][k] = *(const LAS bf16x8*)(lds + PG8_SA(b, h) + aoff + m * 2048 + k * 1024); } while (0)
#define PG8_LDB(dst, b, h) do { _Pragma("unroll") for (int n = 0; n < 2; ++n) _Pragma("unroll") for (int k = 0; k < 2; ++k) dst[n][k] = *(const LAS bf16x8*)(lds + PG8_SB(b, h) + boff + n * 2048 + k * 1024); } while (0)
#define PG8_MMA(ai, bj, At, Bt) do { __builtin_amdgcn_s_setprio(1); _Pragma("unroll") for (int m = 0; m < 4; ++m) _Pragma("unroll") for (int n = 0; n < 2; ++n) _Pragma("unroll") for (int k = 0; k < 2; ++k) \
        acc[ai][bj][m][n] = __builtin_amdgcn_mfma_f32_16x16x32_bf16(Bt[n][k], At[m][k], acc[ai][bj][m][n], 0, 0, 0); __builtin_amdgcn_s_setprio(0); } while (0)
#define PG8_WAIT_V(n) asm volatile("s_waitcnt vmcnt(" #n ")" ::: "memory")
#define PG8_WAIT_L(n) asm volatile("s_waitcnt lgkmcnt(" #n ")" ::: "memory")
#define PG8_BAR __builtin_amdgcn_s_barrier()
#define PG8_SCHED __builtin_amdgcn_sched_barrier(0)
    Unit cur, nxt; int ui = 0;
    if (!S.next(0, cur)) return;
    typename Epi::Pre pre = E.prefetch(cur, wr, fr);
    Acc acc;
#pragma unroll
    for (int a = 0; a < 2; ++a)
#pragma unroll
        for (int b = 0; b < 2; ++b)
#pragma unroll
            for (int m = 0; m < 4; ++m)
#pragma unroll
                for (int n = 0; n < 2; ++n) acc[a][b][m][n] = (f32x4){0.f, 0.f, 0.f, 0.f};
    bf16x8 At[4][2], B0[2][2], B1[2][2];
    const char* cA = cur.A; const char* cB = cur.B;
    PG8_STAGE(PG8_SB(0, 0), cB, voffB); PG8_STAGE(PG8_SB(0, 1), cB + hstepB, voffB); PG8_STAGE(PG8_SA(0, 0), cA, voffA); PG8_STAGE(PG8_SA(0, 1), cA + hstepA, voffA);
    if (wr == 1) PG8_BAR;
    PG8_WAIT_V(2); PG8_BAR;
    PG8_STAGE(PG8_SB(1, 0), cB + kstepB, voffB); PG8_STAGE(PG8_SA(1, 0), cA + kstep, voffA); PG8_STAGE(PG8_SB(1, 1), cB + hstepB + kstepB, voffB);
    PG8_WAIT_V(6); PG8_BAR;
    for (;;) {
        const bool has_next = S.next(ui + 1, nxt);
        const char* nA = has_next ? nxt.A : cA; const char* nB = has_next ? nxt.B : cB;
        for (int t = 0; t < nt; t += 2) {
            const bool last = (t == nt - 2);
            const char* a1 = cA + (size_t)(t + 1) * kstep;
            const char* a2 = last ? nA : cA + (size_t)(t + 2) * kstep; const char* b2 = last ? nB : cB + (size_t)(t + 2) * kstepB;
            const char* a3 = a2 + kstep; const char* b3 = b2 + kstepB;
            PG8_LDB(B0, 0, 0); PG8_LDB(B1, 0, 1); PG8_SCHED; PG8_LDA(At, 0, 0); PG8_STAGE(PG8_SA(1, 1), a1 + hstepA, voffA);
            PG8_WAIT_V(8); PG8_WAIT_L(0); PG8_BAR; PG8_MMA(0, 0, At, B0); PG8_MMA(0, 1, At, B1); PG8_BAR; PG8_SCHED;
            PG8_LDA(At, 0, 1); PG8_STAGE(PG8_SB(0, 0), b2, voffB); PG8_STAGE(PG8_SB(0, 1), b2 + hstepB, voffB); PG8_STAGE(PG8_SA(0, 0), a2, voffA);
            PG8_WAIT_V(8); PG8_WAIT_L(0); PG8_BAR; PG8_MMA(1, 0, At, B0); PG8_MMA(1, 1, At, B1); PG8_BAR; PG8_SCHED;
            PG8_LDB(B0, 1, 0); PG8_LDB(B1, 1, 1); PG8_SCHED; PG8_LDA(At, 1, 0); PG8_STAGE(PG8_SA(0, 1), a2 + hstepA, voffA);
            PG8_WAIT_V(8); PG8_WAIT_L(0); PG8_BAR; PG8_MMA(0, 0, At, B0); PG8_MMA(0, 1, At, B1); PG8_BAR; PG8_SCHED;
            PG8_LDA(At, 1, 1); PG8_STAGE(PG8_SB(1, 0), b3, voffB); PG8_STAGE(PG8_SB(1, 1), b3 + hstepB, voffB); PG8_STAGE(PG8_SA(1, 0), a3, voffA);
            PG8_WAIT_V(8); PG8_WAIT_L(0); PG8_BAR; PG8_MMA(1, 0, At, B0); PG8_MMA(1, 1, At, B1); PG8_BAR; PG8_SCHED;
        }
        if (wr == 0) PG8_BAR;
        E(acc, cur, wr, wc, fr, fq, pre);
        if (!has_next) break;
        pre = E.prefetch(nxt, wr, fr);
        if constexpr (!Epi::KEEP_ACC)
#pragma unroll
        for (int a = 0; a < 2; ++a)
#pragma unroll
            for (int b = 0; b < 2; ++b)
#pragma unroll
                for (int m = 0; m < 4; ++m)
#pragma unroll
                    for (int n = 0; n < 2; ++n) acc[a][b][m][n] = (f32x4){0.f, 0.f, 0.f, 0.f};
        cur = nxt; cA = nA; cB = nB; ++ui;
        if (wr == 1) PG8_BAR;
    }
    PG8_WAIT_V(0);
    PG8_BAR;
#undef PG8_SA
#undef PG8_SB
#undef PG8_STAGE
#undef PG8_LDA
#undef PG8_LDB
#undef PG8_MMA
#undef PG8_WAIT_V
#undef PG8_WAIT_L
#undef PG8_BAR
#undef PG8_SCHED
}

#define EPI_FOR _Pragma("unroll") for (int ai = 0; ai < 2; ++ai) _Pragma("unroll") for (int m = 0; m < 4; ++m)
#define EPI_ROW (u.pm * BM + ai * HALF + wr * 64 + m * 16 + fr)
#define EPI_C8(bj) (u.pn * BM + (bj) * HALF + wc * 32 + 8 * fq)
#define EPI_LOAD_R(rr, ptr) float rr[2][4]; _Pragma("unroll") for (int ai = 0; ai < 2; ++ai) _Pragma("unroll") for (int m = 0; m < 4; ++m) rr[ai][m] = (ptr)[EPI_ROW]; asm volatile("" ::: "memory")

#define EPI_LOAD_RS(rr, xstat) float rr[2][4]; { f32x4 st_[2][4]; _Pragma("unroll") for (int ai = 0; ai < 2; ++ai) _Pragma("unroll") for (int m = 0; m < 4; ++m) st_[ai][m] = *(const f32x4*)((xstat) + (size_t)EPI_ROW * 16 + 4 * fq); \
    asm volatile("" ::: "memory"); _Pragma("unroll") for (int ai = 0; ai < 2; ++ai) _Pragma("unroll") for (int m = 0; m < 4; ++m) { float t_ = (st_[ai][m][0] + st_[ai][m][1]) + (st_[ai][m][2] + st_[ai][m][3]); \
        t_ += __shfl_xor(t_, 16); t_ += __shfl_xor(t_, 32); rr[ai][m] = __builtin_amdgcn_rsqf(t_ * (1.f / D) + EPS); } }
struct NoPre {};
#define EPI_NOPRE static constexpr bool KEEP_ACC = false; typedef NoPre Pre; __device__ __forceinline__ Pre prefetch(const Unit&, int, int) const { return Pre{}; }
struct RowPre { float r[2][4]; };
struct EpiInProj {
    unsigned char* ws; const float* bgate; int layer; int from_stats;
    static constexpr bool KEEP_ACC = false; typedef RowPre Pre;
    __device__ __forceinline__ Pre prefetch(const Unit& u, int wr, int fr) const { Pre p; const float* rx = (const float*)(ws + WS_RX);
#pragma unroll
        for (int ai = 0; ai < 2; ++ai)
#pragma unroll
            for (int m = 0; m < 4; ++m) p.r[ai][m] = from_stats ? 0.f : rx[EPI_ROW];
        return p; }
    __device__ __forceinline__ void operator()(const Acc& acc, const Unit& u, int wr, int wc, int fr, int fq, const Pre& pre) const {
        const float* rx = (const float*)(ws + WS_RX); const float* rope = (const float*)(ws + WS_ROPE);
        bf16* CQ = (bf16*)(ws + WS_CQ); bf16* KR = (bf16*)(ws + WS_KR); bf16* CKV = (bf16*)(ws + WS_CKV); bf16* U = (bf16*)(ws + WS_U); bf16* VR = (bf16*)(ws + WS_VR); bf16* QX = (bf16*)(ws + WS_QX); bf16* GATE = (bf16*)(ws + WS_GATE);
        float* cqstat = (float*)(ws + WS_CQSTAT); float* ckvstat = (float*)(ws + WS_CKVSTAT); float* vstat = (float*)(ws + WS_VSTAT); unsigned* kmax = (unsigned*)(ws + WS_CTL) + CW_KMAX + layer * 32;
        const int pn = u.pn;
        float rr[2][4];
        if (from_stats) { EPI_LOAD_RS(rs_, (const float*)(ws + WS_XSTAT));
#pragma unroll
            for (int ai = 0; ai < 2; ++ai)
#pragma unroll
                for (int m = 0; m < 4; ++m) rr[ai][m] = rs_[ai][m]; }
        else {
#pragma unroll
            for (int ai = 0; ai < 2; ++ai)
#pragma unroll
                for (int m = 0; m < 4; ++m) rr[ai][m] = pre.r[ai][m]; }
        if (pn < 2) {
            float krmax = 0.f;
            EPI_FOR { const int row = EPI_ROW;
                const float r = rr[ai][m]; float ss = 0.f;
#pragma unroll
                for (int bj = 0; bj < 2; ++bj) { const f32x4 v0 = acc[ai][bj][m][0] * r, v1 = acc[ai][bj][m][1] * r;
                    if (!(pn == 1 && bj == 1)) ss += sumsq4(v0) + sumsq4(v1);
                    *(u32x4*)(CQ + (size_t)row * 512 + pn * 256 + bj * HALF + wc * 32 + 8 * fq) = pack8(v0, v1);
                    if (pn == 1 && bj == 1 && wc == 0) {
                        const f32x4 c = *(const f32x4*)(rope + (size_t)row * 32 + 4 * fq), s = *(const f32x4*)(rope + (size_t)row * 32 + 16 + 4 * fq);
                        const f32x4 o0 = v0 * c - v1 * s, o1 = v0 * s + v1 * c;
                        *(u32x4*)(KR + (size_t)row * 32 + 8 * fq) = pack8(o0, o1);
                        float q2 = sumsq4(o0) + sumsq4(o1); q2 += __shfl_xor(q2, 16); q2 += __shfl_xor(q2, 32); krmax = fmaxf(krmax, q2); } }
                ss += __shfl_xor(ss, 16); ss += __shfl_xor(ss, 32);
                if (fq == 0) cqstat[(size_t)row * 8 + pn * 4 + wc] = ss;
            }
            if (pn == 1 && wc == 0) {
#pragma unroll
                for (int o = 1; o < 16; o <<= 1) krmax = fmaxf(krmax, __shfl_xor(krmax, o));
                if ((fr | fq) == 0) atomicMax(kmax + 16, __float_as_uint(krmax)); }
        } else if (pn == 2) {
            EPI_FOR { const int row = EPI_ROW;
                const float r = rr[ai][m]; float ss = 0.f;
#pragma unroll
                for (int bj = 0; bj < 2; ++bj) { const f32x4 v0 = acc[ai][bj][m][0] * r, v1 = acc[ai][bj][m][1] * r; ss += sumsq4(v0) + sumsq4(v1);
                    *(u32x4*)(CKV + (size_t)row * 256 + bj * HALF + wc * 32 + 8 * fq) = pack8(v0, v1); }
                ss += __shfl_xor(ss, 16); ss += __shfl_xor(ss, 32);
                if (fq == 0) ckvstat[(size_t)row * 4 + wc] = ss;
            }
        } else if (pn < 7) {
            const bool isv = pn >= 5; bf16* dst = isv ? VR : U; const int t = isv ? pn - 5 : pn - 3;
            EPI_FOR { const int row = EPI_ROW;
                const float r = rr[ai][m]; float ss = 0.f;
#pragma unroll
                for (int bj = 0; bj < 2; ++bj) { f32x4 v0 = acc[ai][bj][m][0] * r, v1 = acc[ai][bj][m][1] * r;
#pragma unroll
                    for (int e = 0; e < 4; ++e) { v0[e] = gelu_tanh(v0[e]); v1[e] = gelu_tanh(v1[e]); }
                    ss += sumsq4(v0) + sumsq4(v1);
                    *(u32x4*)(dst + (size_t)row * 512 + t * 256 + bj * HALF + wc * 32 + 8 * fq) = pack8(v0, v1); }
                if (isv) { ss += __shfl_xor(ss, 16); ss += __shfl_xor(ss, 32); if (fq == 0) vstat[(size_t)row * 8 + t * 4 + wc] = ss; }
            }
        } else if (pn < 9) {
            EPI_FOR { const int row = EPI_ROW;
                const float r = rr[ai][m];
#pragma unroll
                for (int bj = 0; bj < 2; ++bj) *(u32x4*)(QX + (size_t)row * 512 + (pn - 7) * 256 + bj * HALF + wc * 32 + 8 * fq) = pack8(acc[ai][bj][m][0] * r, acc[ai][bj][m][1] * r);
            }
        } else {
            const int gc0 = (pn - 9) * 256 + wc * 32 + 8 * fq;
            f32x4 bg[2][2];
#pragma unroll
            for (int bj = 0; bj < 2; ++bj) { bg[bj][0] = *(const f32x4*)(bgate + gc0 + bj * HALF); bg[bj][1] = *(const f32x4*)(bgate + gc0 + bj * HALF + 4); }
            EPI_FOR { const int row = EPI_ROW;
                const float r = rr[ai][m];
#pragma unroll
                for (int bj = 0; bj < 2; ++bj) { f32x4 v0 = acc[ai][bj][m][0] * r + bg[bj][0], v1 = acc[ai][bj][m][1] * r + bg[bj][1];
#pragma unroll
                    for (int e = 0; e < 4; ++e) { v0[e] = sigmoidf_(v0[e]); v1[e] = sigmoidf_(v1[e]); }
#ifdef DBG_CONSTGATE
                    v0 = acc[ai][bj][m][0] * r; v1 = acc[ai][bj][m][1] * r;
#endif
                    *(u32x2*)((unsigned char*)GATE + (size_t)row * 3072 + gc0 + bj * HALF) = pack8_u8(v0, v1); }
            }
        }
    }
};
struct EpiMemKV {
    bf16* KV;
    EPI_NOPRE
    __device__ __forceinline__ void operator()(const Acc& acc, const Unit& u, int wr, int wc, int fr, int fq, const Pre&) const {
        EPI_FOR { const int row = EPI_ROW;
#pragma unroll
            for (int bj = 0; bj < 2; ++bj) *(u32x4*)(KV + (size_t)u.aux * 256 * 1024 + (size_t)row * 1024 + EPI_C8(bj)) = pack8(acc[ai][bj][m][0], acc[ai][bj][m][1]);
        }
    }
};
struct EpiQ {
    const float* cqstat; const float* rope; bf16* Q;
    EPI_NOPRE
    __device__ __forceinline__ void operator()(const Acc& acc, const Unit& u, int wr, int wc, int fr, int fq, const Pre&) const {
        EPI_FOR { const int row = EPI_ROW;
            const f32x4 s0 = *(const f32x4*)(cqstat + (size_t)row * 8), s1 = *(const f32x4*)(cqstat + (size_t)row * 8 + 4);
            const float r = __builtin_amdgcn_rsqf(((s0[0] + s0[1]) + (s0[2] + s0[3]) + (s1[0] + s1[1]) + (s1[2] + s1[3])) * (1.f / QRANK) + EPS);
#pragma unroll
            for (int bj = 0; bj < 2; ++bj) { f32x4 v0 = acc[ai][bj][m][0] * r, v1 = acc[ai][bj][m][1] * r;
                if (((8 * u.pn + 4 * bj + wc) % 3) == 2) {
                    const f32x4 c = *(const f32x4*)(rope + (size_t)row * 32 + 4 * fq), s = *(const f32x4*)(rope + (size_t)row * 32 + 16 + 4 * fq);
                    const f32x4 o0 = v0 * c - v1 * s, o1 = v0 * s + v1 * c; v0 = o0; v1 = o1; }
                *(u32x4*)(Q + (size_t)row * 768 + EPI_C8(bj)) = pack8(v0, v1); }
        }
    }
};
struct EpiKV {
    const float* ckvstat; bf16* KN; bf16* V; unsigned* kmax;
    EPI_NOPRE
    __device__ __forceinline__ void operator()(const Acc& acc, const Unit& u, int wr, int wc, int fr, int fq, const Pre&) const {
        bf16* dst = u.pn < 2 ? KN : V; const int t = u.pn & 1; float hm[2] = {0.f, 0.f};
        EPI_FOR { const int row = EPI_ROW;
            const f32x4 s0 = *(const f32x4*)(ckvstat + (size_t)row * 4);
            const float r = __builtin_amdgcn_rsqf(((s0[0] + s0[1]) + (s0[2] + s0[3])) * (1.f / KVRANK) + EPS);
#pragma unroll
            for (int bj = 0; bj < 2; ++bj) { const f32x4 v0 = acc[ai][bj][m][0] * r, v1 = acc[ai][bj][m][1] * r;
                *(u32x4*)(dst + (size_t)row * 512 + t * 256 + bj * HALF + wc * 32 + 8 * fq) = pack8(v0, v1);
                float q2 = sumsq4(v0) + sumsq4(v1); q2 += __shfl_xor(q2, 16); q2 += __shfl_xor(q2, 32); hm[bj] = fmaxf(hm[bj], q2); }
        }
        if (u.pn < 2) {
#pragma unroll
            for (int bj = 0; bj < 2; ++bj) { float v = hm[bj];
#pragma unroll
                for (int o = 1; o < 16; o <<= 1) v = fmaxf(v, __shfl_xor(v, o));
                if ((fr | fq) == 0) atomicMax(kmax + 2 * (4 * u.pn + 2 * bj + (wc >> 1)) + (wc & 1), __float_as_uint(v)); }
        }
    }
};
struct EpiBranch {
    const unsigned char* GATE; bf16* MIXB;
    static constexpr bool KEEP_ACC = true; typedef NoPre Pre; __device__ __forceinline__ Pre prefetch(const Unit&, int, int) const { return Pre{}; }
    __device__ __forceinline__ void operator()(Acc& acc, const Unit& u, int wr, int wc, int fr, int fq, const Pre&) const {
        const int n = u.aux;
#pragma unroll
        for (int ai = 0; ai < 2; ++ai) {
            u32x2 gw[4][2], gn[4][2];
#pragma unroll
            for (int m = 0; m < 4; ++m)
#pragma unroll
                for (int bj = 0; bj < 2; ++bj) { const unsigned char* gp = GATE + (size_t)EPI_ROW * 3072 + n * 1024 + EPI_C8(bj);
                    gw[m][bj] = *(const u32x2*)gp; if (n < 2) gn[m][bj] = *(const u32x2*)(gp + 1024); }
            asm volatile("" ::: "memory");
#pragma unroll
            for (int m = 0; m < 4; ++m)
#pragma unroll
                for (int bj = 0; bj < 2; ++bj) {
                    f32x4 g0, g1; unpack8_u8(gw[m][bj], g0, g1);
#pragma unroll
                    for (int e = 0; e < 4; ++e) { g0[e] = fmaxf(g0[e], 0.001953125f); g1[e] = fmaxf(g1[e], 0.001953125f); }
                    if (n < 2) { f32x4 h0, h1; unpack8_u8(gn[m][bj], h0, h1);
#pragma unroll
                        for (int e = 0; e < 4; ++e) { g0[e] *= fast_rcp(fmaxf(h0[e], 0.001953125f)); g1[e] *= fast_rcp(fmaxf(h1[e], 0.001953125f)); }
                        acc[ai][bj][m][0] *= g0; acc[ai][bj][m][1] *= g1; }
                    else *(u32x4*)(MIXB + (size_t)u.pm * 256 * 1024 + (size_t)(4 * u.pn + 2 * bj + (wc >> 1)) * 16384 + (ai * HALF + wr * 64 + m * 16 + fr) * 64 + (wc & 1) * 32 + 8 * fq) = pack8(acc[ai][bj][m][0] * g0, acc[ai][bj][m][1] * g1);
                }
        }
        if (n == 2) {
#pragma unroll
            for (int ai = 0; ai < 2; ++ai)
#pragma unroll
                for (int bj = 0; bj < 2; ++bj)
#pragma unroll
                    for (int m = 0; m < 4; ++m) { acc[ai][bj][m][0] = (f32x4){0.f, 0.f, 0.f, 0.f}; acc[ai][bj][m][1] = (f32x4){0.f, 0.f, 0.f, 0.f}; }
        }
    }
};
struct EpiResid {
    const float* X; float* Xo; bf16* XB; float* xstat;
    EPI_NOPRE
    __device__ __forceinline__ void operator()(const Acc& acc, const Unit& u, int wr, int wc, int fr, int fq, const Pre&) const {
#pragma unroll
        for (int ai = 0; ai < 2; ++ai) {
            f32x4 xv[4][2][2];
#pragma unroll
            for (int m = 0; m < 4; ++m)
#pragma unroll
                for (int bj = 0; bj < 2; ++bj) { const float* xp = X + (size_t)EPI_ROW * 1024 + EPI_C8(bj); xv[m][bj][0] = *(const f32x4*)xp; xv[m][bj][1] = *(const f32x4*)(xp + 4); }
            asm volatile("" ::: "memory");
#pragma unroll
            for (int m = 0; m < 4; ++m) { const int row = EPI_ROW; float ss = 0.f;
#pragma unroll
                for (int bj = 0; bj < 2; ++bj) { const int col = EPI_C8(bj); float* xp = Xo + (size_t)row * 1024 + col;
                    const f32x4 v0 = xv[m][bj][0] + acc[ai][bj][m][0], v1 = xv[m][bj][1] + acc[ai][bj][m][1];
                    *(f32x4*)xp = v0; *(f32x4*)(xp + 4) = v1; ss += sumsq4(v0) + sumsq4(v1);
                    *(u32x4*)(XB + (size_t)row * 1024 + col) = pack8(v0, v1); }
                ss += __shfl_xor(ss, 16); ss += __shfl_xor(ss, 32);
                if (fq == 0) xstat[(size_t)row * 16 + u.pn * 4 + wc] = ss; }
        }
    }
};
struct EpiSwiGLU {
    const float* rs; bf16* Hh; int ldh; int from_stats;
    static constexpr bool KEEP_ACC = false; typedef RowPre Pre;
    __device__ __forceinline__ Pre prefetch(const Unit& u, int wr, int fr) const { Pre p;
#pragma unroll
        for (int ai = 0; ai < 2; ++ai)
#pragma unroll
            for (int m = 0; m < 4; ++m) p.r[ai][m] = from_stats ? 0.f : rs[EPI_ROW];
        return p; }
    __device__ __forceinline__ void operator()(const Acc& acc, const Unit& u, int wr, int wc, int fr, int fq, const Pre& pre) const {
        float rr[2][4];
        if (from_stats) { EPI_LOAD_RS(rs_, rs);
#pragma unroll
            for (int ai = 0; ai < 2; ++ai)
#pragma unroll
                for (int m = 0; m < 4; ++m) rr[ai][m] = rs_[ai][m]; }
        else {
#pragma unroll
            for (int ai = 0; ai < 2; ++ai)
#pragma unroll
                for (int m = 0; m < 4; ++m) rr[ai][m] = pre.r[ai][m]; }
        bf16* hbase = Hh + (size_t)u.pm * 256 * ldh + (size_t)(2 * u.pn + (wc >> 1)) * 16384 + (wr * 64 + fr) * 64 + (wc & 1) * 32 + 8 * fq;
        EPI_FOR { const int row = EPI_ROW;
            const float r = rr[ai][m];
            f32x4 a0 = acc[ai][0][m][0] * r, a1 = acc[ai][0][m][1] * r; const f32x4 b0 = acc[ai][1][m][0] * r, b1 = acc[ai][1][m][1] * r;
#pragma unroll
            for (int e = 0; e < 4; ++e) { a0[e] = a0[e] * sigmoidf_(a0[e]) * b0[e]; a1[e] = a1[e] * sigmoidf_(a1[e]) * b1[e]; }
            (void)row; *(u32x4*)(hbase + (ai * HALF + m * 16) * 64) = pack8(a0, a1);
        }
    }
};
struct EpiBf16 {
    bf16* C; int ldc;
    EPI_NOPRE
    __device__ __forceinline__ void operator()(const Acc& acc, const Unit& u, int wr, int wc, int fr, int fq, const Pre&) const {
        EPI_FOR { const int row = EPI_ROW;
#pragma unroll
            for (int bj = 0; bj < 2; ++bj) *(u32x4*)(C + (size_t)row * ldc + EPI_C8(bj)) = pack8(acc[ai][bj][m][0], acc[ai][bj][m][1]);
        }
    }
};
struct EpiF32 {
    float* C; int ldc;
    EPI_NOPRE
    __device__ __forceinline__ void operator()(const Acc& acc, const Unit& u, int wr, int wc, int fr, int fq, const Pre&) const {
        EPI_FOR { const int row = EPI_ROW;
#pragma unroll
            for (int bj = 0; bj < 2; ++bj) { float* cp = C + (size_t)row * ldc + EPI_C8(bj); *(f32x4*)cp = acc[ai][bj][m][0]; *(f32x4*)(cp + 4) = acc[ai][bj][m][1]; }
        }
    }
};
}

namespace att {
#define KSWZ(row, colB) ((row) * 256 + ((colB) ^ (((row) & 7) << 4)))
#define SBAR() __builtin_amdgcn_sched_barrier(0)
constexpr float THR = 8.f;
__device__ __forceinline__ int crow(int r, int hi) { return (r & 3) + 8 * (r >> 2) + 4 * hi; }
template <int NB> __device__ __forceinline__ int v_st(int k, int c) { const int kk = (k & ~0xC) | ((k & 4) << 1) | ((k & 8) >> 1); return ((kk >> 3) * NB + (c >> 5)) * 512 + ((kk & 7) * 32 + (c & 31)) * 2; }
__device__ __forceinline__ int v_rd_base(int lane) { return ((lane & 3) << 3) | (((lane >> 2) & 3) << 6) | (((lane >> 4) & 1) << 5) | (((lane >> 5) & 1) << 8); }
template <int OFF> __device__ __forceinline__ s16x4 tr_read(int vb) { s16x4 r; asm volatile("ds_read_b64_tr_b16 %0, %1 offset:%2" : "=&v"(r) : "v"(vb), "i"(OFF) : "memory"); return r; }

__device__ __forceinline__ void partialSM(f32x16& p0, f32x16& p1, float& m_reg, float& alpha) {
    float pmax = p0[0];
#pragma unroll
    for (int r = 1; r < 16; ++r) pmax = fmaxf(pmax, p0[r]);
#pragma unroll
    for (int r = 0; r < 16; ++r) pmax = fmaxf(pmax, p1[r]);
    { auto rr = __builtin_amdgcn_permlane32_swap(__float_as_uint(pmax), __float_as_uint(pmax), false, false); pmax = fmaxf(__uint_as_float(rr[0]), __uint_as_float(rr[1])); }
    float mn;
    if (__builtin_expect(__all(pmax - m_reg <= THR), 1)) { mn = m_reg; alpha = 1.f; }
    else { mn = fmaxf(m_reg, pmax); alpha = __builtin_amdgcn_exp2f(m_reg - mn); m_reg = mn; }
#pragma unroll
    for (int r = 0; r < 16; ++r) { p0[r] -= mn; p1[r] -= mn; }
#pragma unroll
    for (int r = 0; r < 16; ++r) p0[r] = __builtin_amdgcn_exp2f(p0[r]);
}
__device__ __forceinline__ void finishSM(f32x16& p0, f32x16& p1, float alpha, float& l_reg, bf16x8& pa0, bf16x8& pa1, bf16x8& pa2, bf16x8& pa3) {
#pragma unroll
    for (int r = 0; r < 16; ++r) p1[r] = __builtin_amdgcn_exp2f(p1[r]);
    float ps = 0;
#pragma unroll
    for (int r = 0; r < 16; ++r) ps += p0[r];
#pragma unroll
    for (int r = 0; r < 16; ++r) ps += p1[r];
    { auto rr = __builtin_amdgcn_permlane32_swap(__float_as_uint(ps), __float_as_uint(ps), false, false); ps = __uint_as_float(rr[0]) + __uint_as_float(rr[1]); }
    l_reg = l_reg * alpha + ps;
#define PK4(P, BASE, OUT) do { unsigned a0 = cvt_pk_bf16(P[BASE + 0], P[BASE + 1]), a1 = cvt_pk_bf16(P[BASE + 2], P[BASE + 3]);   \
    unsigned b0 = cvt_pk_bf16(P[BASE + 4], P[BASE + 5]), b1 = cvt_pk_bf16(P[BASE + 6], P[BASE + 7]);                              \
    auto r0 = __builtin_amdgcn_permlane32_swap(a0, b0, false, false); auto r1 = __builtin_amdgcn_permlane32_swap(a1, b1, false, false); \
    u32x4 w = {r0[0], r1[0], r0[1], r1[1]}; OUT = __builtin_bit_cast(bf16x8, w); } while (0)
    PK4(p0, 0, pa0); PK4(p0, 8, pa1); PK4(p1, 0, pa2); PK4(p1, 8, pa3);
#undef PK4
}
template <int ND0> __device__ __forceinline__ void qkt(f32x16& p0, f32x16& p1, const LAS char* Ks, const bf16x8* qr, int r32, int hi, const f32x16& init) {
#pragma unroll
    for (int d0 = 0; d0 < ND0; ++d0) { const int cb = (d0 * 16 + hi * 8) * 2;
        const bf16x8 b0 = *(const LAS bf16x8*)(Ks + KSWZ(r32, cb));
        const bf16x8 b1 = *(const LAS bf16x8*)(Ks + KSWZ(32 + r32, cb));
        p0 = __builtin_amdgcn_mfma_f32_32x32x16_bf16(b0, qr[d0], d0 == 0 ? init : p0, 0, 0, 0);
        p1 = __builtin_amdgcn_mfma_f32_32x32x16_bf16(b1, qr[d0], d0 == 0 ? init : p1, 0, 0, 0); }
}
__device__ __forceinline__ void expA(f32x16& p0) {
#pragma unroll
    for (int r = 0; r < 16; ++r) p0[r] = __builtin_amdgcn_exp2f(p0[r]);
}
template <int NB, int D0> __device__ __forceinline__ void pv_one(f32x16& od, int vb, bf16x8 pa0, bf16x8 pa1, bf16x8 pa2, bf16x8 pa3) {
    const s16x4 l0 = tr_read<(0 * NB + D0) * 512>(vb), h0 = tr_read<(1 * NB + D0) * 512>(vb), l1 = tr_read<(2 * NB + D0) * 512>(vb), h1 = tr_read<(3 * NB + D0) * 512>(vb);
    const s16x4 l2 = tr_read<(4 * NB + D0) * 512>(vb), h2 = tr_read<(5 * NB + D0) * 512>(vb), l3 = tr_read<(6 * NB + D0) * 512>(vb), h3 = tr_read<(7 * NB + D0) * 512>(vb);
    asm volatile("s_waitcnt lgkmcnt(0)" ::: "memory"); SBAR();
#define PK(L, H) (bf16x8){L[0], L[1], L[2], L[3], H[0], H[1], H[2], H[3]}
    od = __builtin_amdgcn_mfma_f32_32x32x16_bf16(pa0, PK(l0, h0), od, 0, 0, 0);
    od = __builtin_amdgcn_mfma_f32_32x32x16_bf16(pa1, PK(l1, h1), od, 0, 0, 0);
    od = __builtin_amdgcn_mfma_f32_32x32x16_bf16(pa2, PK(l2, h2), od, 0, 0, 0);
    od = __builtin_amdgcn_mfma_f32_32x32x16_bf16(pa3, PK(l3, h3), od, 0, 0, 0);
#undef PK
}
template <int NB> __device__ __forceinline__ void pv_all(f32x16* o, int vb, bf16x8 pa0, bf16x8 pa1, bf16x8 pa2, bf16x8 pa3) {
    pv_one<NB, 0>(o[0], vb, pa0, pa1, pa2, pa3); pv_one<NB, 1>(o[1], vb, pa0, pa1, pa2, pa3);
    if constexpr (NB == 4) { pv_one<NB, 2>(o[2], vb, pa0, pa1, pa2, pa3); pv_one<NB, 3>(o[3], vb, pa0, pa1, pa2, pa3); }
}

template <int DQK, int D1, int DVV, bool FIXM>
__device__ __forceinline__ void attn_unit(const bf16* __restrict__ Qb, int ldq, const bf16* __restrict__ K1, int ldk1, const bf16* __restrict__ K2, int ldk2,
                                          const bf16* __restrict__ Vh, int ldv, bf16* __restrict__ Ob, int ldo, int seq, LAS char* lds, float kbound) {
    constexpr int ND0 = DQK / 16, NB = DVV / 32, CK = DQK / 8, CV = DVV / 8;
    constexpr int NKL = (64 * CK + 511) / 512, NVL = (64 * CV) / 512;
    constexpr int SHM_V = 64 * DVV * 2, SHM_K = 64 * 256;
    int tid_ = threadIdx.x; asm volatile("" : "+v"(tid_));
    const int tid = tid_, wid = tid >> 6, lane = tid & 63, r32 = lane & 31, hi = lane >> 5;
    LAS char* V_lds = lds; LAS char* K_lds = lds + 2 * SHM_V;
    LAS float* ws = (LAS float*)(lds + 2 * SHM_V + 2 * SHM_K) + wid * 64; LAS float* li_l = ws; LAS float* al_l = ws + 32;
    float m_reg = -1e30f, l_reg = 0; f32x16 o[NB]; bf16x8 qr[ND0];
#pragma unroll
    for (int d = 0; d < NB; ++d) o[d] = f32x16{};
    const bf16* Qw = Qb + (long)(wid * 32 + r32) * ldq + hi * 8;
#pragma unroll
    for (int d0 = 0; d0 < ND0; ++d0) qr[d0] = *(const bf16x8*)(Qw + d0 * 16);
    f32x16 init = f32x16{};
    if constexpr (FIXM) {
        float q2 = 0.f;
#pragma unroll
        for (int d0 = 0; d0 < ND0; ++d0) { const u32x4 w = __builtin_bit_cast(u32x4, qr[d0]); f32x4 a, b; unpack8(w, a, b); q2 += sumsq4(a) + sumsq4(b); }
        { auto rr = __builtin_amdgcn_permlane32_swap(__float_as_uint(q2), __float_as_uint(q2), false, false); q2 = __uint_as_float(rr[0]) + __uint_as_float(rr[1]); }
        const float nm = -sqrtf(q2) * kbound;
#pragma unroll
        for (int r = 0; r < 16; ++r) init[r] = nm;
        asm volatile("" : "+v"(init));
    }
    const bf16* kp[NKL]; int kstr[NKL], kdst[NKL]; bool kval[NKL];
#pragma unroll
    for (int i = 0; i < NKL; ++i) { const int c = tid + 512 * i; kval[i] = c < 64 * CK; const int cc_ = kval[i] ? c : 0; const int row = cc_ / CK, cc = cc_ % CK;
        if (cc * 8 < D1) { kp[i] = K1 + (long)row * ldk1 + cc * 8; kstr[i] = 64 * ldk1; } else { kp[i] = K2 + (long)row * ldk2 + (cc * 8 - D1); kstr[i] = 64 * ldk2; }
        kdst[i] = KSWZ(row, cc * 16); }
    const bf16* vp[NVL]; int vdst[NVL]; const int vstr = 64 * ldv;
#pragma unroll
    for (int i = 0; i < NVL; ++i) { const int c = tid + 512 * i; const int row = c / CV, cc = c % CV; vp[i] = Vh + (long)row * ldv + cc * 8; vdst[i] = v_st<NB>(row, cc * 8); }
    const int vb0 = (int)(uintptr_t)V_lds + v_rd_base(lane);
    struct { bf16x8 ks[NKL]; bf16x8 vs[NVL]; } sr_[2];
#define SLOAD(i, t) do { _Pragma("unroll") for (int q_ = 0; q_ < NVL; ++q_) sr_[i].vs[q_] = *(const bf16x8*)(vp[q_] + (long)(t) * vstr); \
    _Pragma("unroll") for (int q_ = 0; q_ < NKL; ++q_) { if (kval[q_]) sr_[i].ks[q_] = *(const bf16x8*)(kp[q_] + (long)(t) * kstr[q_]); } } while (0)
#define SWRITE(b, i) do { _Pragma("unroll") for (int q_ = 0; q_ < NVL; ++q_) *(LAS bf16x8*)(V_lds + (b) * SHM_V + vdst[q_]) = sr_[i].vs[q_]; \
    _Pragma("unroll") for (int q_ = 0; q_ < NKL; ++q_) { if (kval[q_]) *(LAS bf16x8*)(K_lds + (b) * SHM_K + kdst[q_]) = sr_[i].ks[q_]; } } while (0)
#define SWAIT() asm volatile("s_waitcnt vmcnt(%0)" :: "n"(NKL + NVL) : "memory")
#define RESC(a) do { if (__any((a) < 1.f)) { if (hi == 0) al_l[r32] = (a); asm volatile("s_waitcnt lgkmcnt(0)" ::: "memory"); \
    _Pragma("unroll") for (int d = 0; d < NB; ++d) _Pragma("unroll") for (int r = 0; r < 16; ++r) o[d][r] *= al_l[crow(r, hi)]; } } while (0)
    f32x16 pA0, pA1, pB0, pB1; float alA = 1.f, alB = 1.f; bf16x8 pa0, pa1, pa2, pa3; const int NT = seq / 64;
#define PSM(P0, P1, AL) do { if constexpr (FIXM) expA(P0); else partialSM(P0, P1, m_reg, AL); } while (0)
#define RSC(AL) do { if constexpr (!FIXM) RESC(AL); } while (0)
    SLOAD(0, 0); asm volatile("s_waitcnt vmcnt(0)" ::: "memory"); SWRITE(0, 0); __syncthreads();
    qkt<ND0>(pA0, pA1, K_lds, qr, r32, hi, init); PSM(pA0, pA1, alA);
    SLOAD(1, 1); if (2 < NT) SLOAD(0, 2);
    SWAIT(); SWRITE(1, 1); __syncthreads();
    for (int j = 1; j + 1 < NT; j += 2) {
        SBAR(); qkt<ND0>(pB0, pB1, K_lds + SHM_K, qr, r32, hi, init);
        finishSM(pA0, pA1, alA, l_reg, pa0, pa1, pa2, pa3); SBAR();
        SLOAD(1, j + 2); SBAR();
        pv_all<NB>(o, vb0, pa0, pa1, pa2, pa3); PSM(pB0, pB1, alB);
        __syncthreads(); SWAIT(); SWRITE(0, 0);
        RSC(alB); __syncthreads();
        SBAR(); qkt<ND0>(pA0, pA1, K_lds, qr, r32, hi, init);
        finishSM(pB0, pB1, alB, l_reg, pa0, pa1, pa2, pa3); SBAR();
        if (j + 3 < NT) SLOAD(0, j + 3); SBAR();
        pv_all<NB>(o, vb0 + SHM_V, pa0, pa1, pa2, pa3); PSM(pA0, pA1, alA);
        __syncthreads(); SWAIT(); SWRITE(1, 1);
        RSC(alA); __syncthreads();
    }
    SBAR(); qkt<ND0>(pB0, pB1, K_lds + SHM_K, qr, r32, hi, init);
    finishSM(pA0, pA1, alA, l_reg, pa0, pa1, pa2, pa3); SBAR();
    pv_all<NB>(o, vb0, pa0, pa1, pa2, pa3); PSM(pB0, pB1, alB);
    __syncthreads(); RSC(alB);
    finishSM(pB0, pB1, alB, l_reg, pa0, pa1, pa2, pa3); SBAR();
    pv_all<NB>(o, vb0 + SHM_V, pa0, pa1, pa2, pa3);
#undef PSM
#undef RSC
    if (hi == 0) li_l[r32] = l_reg; asm volatile("s_waitcnt lgkmcnt(0)" ::: "memory");
    float rli[16];
#pragma unroll
    for (int r = 0; r < 16; ++r) rli[r] = __builtin_amdgcn_rcpf(li_l[crow(r, hi)]);
    bf16* Ow = Ob + (long)(wid * 32) * ldo;
#pragma unroll
    for (int r = 0; r < 16; ++r) { const int orow = crow(r, hi);
#pragma unroll
        for (int d0 = 0; d0 < NB; ++d0) Ow[(long)orow * ldo + d0 * 32 + r32] = f2bf(o[d0][r] * rli[r]); }
    __syncthreads();
#undef SLOAD
#undef SWRITE
#undef SWAIT
#undef RESC
}

#define EXP4(P, B) do { P[B] = __builtin_amdgcn_exp2f(P[B]); P[B + 1] = __builtin_amdgcn_exp2f(P[B + 1]); P[B + 2] = __builtin_amdgcn_exp2f(P[B + 2]); P[B + 3] = __builtin_amdgcn_exp2f(P[B + 3]); } while (0)
#define SUM4(S, P, B) do { S += (P[B] + P[B + 1]) + (P[B + 2] + P[B + 3]); } while (0)
#define PK4X(P, BASE, OUT) do { const u32x4 w_ = {cvt_pk_bf16(P[BASE + 0], P[BASE + 1]), cvt_pk_bf16(P[BASE + 2], P[BASE + 3]), cvt_pk_bf16(P[BASE + 4], P[BASE + 5]), cvt_pk_bf16(P[BASE + 6], P[BASE + 7])}; OUT = __builtin_bit_cast(bf16x8, w_); } while (0)
typedef short v4i16_t __attribute__((ext_vector_type(4)));
__device__ __forceinline__ s16x4 vtr(const LAS char* p) { return __builtin_bit_cast(s16x4, __builtin_amdgcn_ds_read_tr16_b64_v4i16((LAS v4i16_t*)p)); }
#define KSWZ2(row, colB) ((row) * 256 + ((colB) ^ (((row) & 15) << 4)))
template <int DQK, int D1, int DVV>
__device__ __forceinline__ void attn_unit2(const bf16* __restrict__ Qb, int ldq, const bf16* __restrict__ K1, int ldk1, const bf16* __restrict__ K2, int ldk2,
                                           const bf16* __restrict__ Vh, int ldv, bf16* __restrict__ Ob, int ldo, int seq, LAS char* lds, float kbound) {
    constexpr int ND0 = DQK / 16, NB = DVV / 32, CK = DQK / 8;
    constexpr int SHM_V = 64 * DVV * 2, SHM_K = 64 * 256;
    static_assert(NB == 2 && ND0 == 6, "written for QK dim 96 / V dim 64");
    int tid_ = threadIdx.x; asm volatile("" : "+v"(tid_));
    const int tid = tid_, wid = __builtin_amdgcn_readfirstlane(tid >> 6), lane = tid & 63, r32 = lane & 31, hi = lane >> 5;
    LAS char* V_lds = lds; LAS char* K_lds = lds + 3 * SHM_V;
    LAS float* ws = (LAS float*)(lds + 3 * SHM_V + 2 * SHM_K) + wid * 64;
    LAS char* QAL = lds + 3 * SHM_V + 2 * SHM_K + 2048 + wid * (2 * ND0 * 1024) + lane * 16; LAS char* QBL = QAL + ND0 * 1024;
    float nm;
    { bf16x8 qa[ND0], qb[ND0];
      const bf16* QwA = Qb + (long)(wid * 64 + r32) * ldq + hi * 8; const bf16* QwB = QwA + (long)32 * ldq;
#pragma unroll
      for (int d0 = 0; d0 < ND0; ++d0) { qa[d0] = *(const bf16x8*)(QwA + d0 * 16); qb[d0] = *(const bf16x8*)(QwB + d0 * 16); }
      float q2a = 0.f, q2b = 0.f;
#pragma unroll
      for (int d0 = 0; d0 < ND0; ++d0) { f32x4 a, b; unpack8(__builtin_bit_cast(u32x4, qa[d0]), a, b); q2a += sumsq4(a) + sumsq4(b); unpack8(__builtin_bit_cast(u32x4, qb[d0]), a, b); q2b += sumsq4(a) + sumsq4(b);
          *(LAS bf16x8*)(QAL + d0 * 1024) = qa[d0]; *(LAS bf16x8*)(QBL + d0 * 1024) = qb[d0]; }
      { auto rr = __builtin_amdgcn_permlane32_swap(__float_as_uint(q2a), __float_as_uint(q2a), false, false); q2a = __uint_as_float(rr[0]) + __uint_as_float(rr[1]); }
      { auto rr = __builtin_amdgcn_permlane32_swap(__float_as_uint(q2b), __float_as_uint(q2b), false, false); q2b = __uint_as_float(rr[0]) + __uint_as_float(rr[1]); }
      nm = -sqrtf(fmaxf(q2a, q2b)) * kbound; }
    const bf16* kp[2]; int kstr[2];
#pragma unroll
    for (int i = 0; i < 2; ++i) { const int row = 8 * wid + 4 * i + (lane >> 4), cc = (lane & 15) ^ (row & 15);
        if (cc >= 8 && cc < CK) { kp[i] = K2 + (long)row * ldk2 + (cc * 8 - D1); kstr[i] = 64 * ldk2; } else { kp[i] = K1 + (long)row * ldk1 + (cc < 8 ? cc * 8 : 0); kstr[i] = 64 * ldk1; } }
    const bf16* vp; { const int k = 8 * wid + ((lane & 31) >> 2); vp = Vh + (long)k * ldv + (lane >> 5) * 32 + (lane & 3) * 8; }
    const int vstr = 64 * ldv;
    const LAS char* vrd0 = V_lds + v_rd_base(lane);
#define DMA2(t, kb, vbuf) do { \
    __builtin_amdgcn_global_load_lds((const unsigned*)(kp[0] + (long)(t) * kstr[0]), (LAS unsigned*)(K_lds + (kb) * SHM_K + wid * 2048), 16, 0, 0); \
    __builtin_amdgcn_global_load_lds((const unsigned*)(kp[1] + (long)(t) * kstr[1]), (LAS unsigned*)(K_lds + (kb) * SHM_K + wid * 2048 + 1024), 16, 0, 0); \
    __builtin_amdgcn_global_load_lds((const unsigned*)(vp + (long)(t) * vstr), (LAS unsigned*)(V_lds + (vbuf) * SHM_V + wid * 1024), 16, 0, 0); } while (0)
#define VRD8(arr, base, D0) do { _Pragma("unroll") for (int j_ = 0; j_ < 8; ++j_) arr[j_] = vtr((base) + (j_ * NB + (D0)) * 512); } while (0)
#define PKV(arr, ks) (bf16x8){arr[2 * (ks)][0], arr[2 * (ks)][1], arr[2 * (ks)][2], arr[2 * (ks)][3], arr[2 * (ks) + 1][0], arr[2 * (ks) + 1][1], arr[2 * (ks) + 1][2], arr[2 * (ks) + 1][3]}
    f32x16 oA[2], oB[2]; oA[0] = f32x16{}; oA[1] = f32x16{}; oB[0] = f32x16{}; oB[1] = f32x16{};
    float lA = 0.f, lB = 0.f; const int NT = seq / 64;
    f32x16 a0, a1, c0, c1; bf16x8 pa0, pa1, pa2, pa3;
#define HALF1(Kb) do { \
        f32x16 init; { float nmv = nm; asm volatile("" : "+v"(nmv)); _Pragma("unroll") for (int r = 0; r < 16; ++r) init[r] = nmv; } \
        SBAR(); \
        _Pragma("unroll") for (int d0 = 0; d0 < ND0; ++d0) { const int cb = (d0 * 16 + hi * 8) * 2; \
            const bf16x8 k0 = *(const LAS bf16x8*)((Kb) + KSWZ2(r32, cb)), k1 = *(const LAS bf16x8*)((Kb) + KSWZ2(32 + r32, cb)), qv = *(const LAS bf16x8*)(QAL + d0 * 1024); \
            a0 = __builtin_amdgcn_mfma_f32_32x32x16_bf16(k0, qv, d0 == 0 ? init : a0, 0, 0, 0); \
            a1 = __builtin_amdgcn_mfma_f32_32x32x16_bf16(k1, qv, d0 == 0 ? init : a1, 0, 0, 0); } \
        SBAR(); \
        float sA = 0.f; \
        _Pragma("unroll") for (int d0 = 0; d0 < ND0; ++d0) { const int cb = (d0 * 16 + hi * 8) * 2; \
            const bf16x8 k0 = *(const LAS bf16x8*)((Kb) + KSWZ2(r32, cb)), k1 = *(const LAS bf16x8*)((Kb) + KSWZ2(32 + r32, cb)), qv = *(const LAS bf16x8*)(QBL + d0 * 1024); \
            c0 = __builtin_amdgcn_mfma_f32_32x32x16_bf16(k0, qv, d0 == 0 ? init : c0, 0, 0, 0); \
            if (d0 == 3) { EXP4(a0, 0); EXP4(a0, 4); } \
            if (d0 == 4) { EXP4(a0, 12); SUM4(sA, a0, 0); SUM4(sA, a0, 4); EXP4(a1, 0); } \
            if (d0 == 5) { EXP4(a1, 8); SUM4(sA, a1, 0); SUM4(sA, a1, 4); } \
            c1 = __builtin_amdgcn_mfma_f32_32x32x16_bf16(k1, qv, d0 == 0 ? init : c1, 0, 0, 0); \
            if (d0 == 3) { EXP4(a0, 8); } \
            if (d0 == 4) { EXP4(a1, 4); SUM4(sA, a0, 8); SUM4(sA, a0, 12); } \
            if (d0 == 5) { EXP4(a1, 12); SUM4(sA, a1, 8); SUM4(sA, a1, 12); } \
            if (d0 >= 2) SBAR(); } \
        lA += sA; \
        PK4X(a0, 0, pa0); PK4X(a0, 8, pa1); PK4X(a1, 0, pa2); PK4X(a1, 8, pa3); \
        SBAR(); } while (0)
#define HALF2(vbase) do { \
        float sB = 0.f; s16x4 va[8], vb_[8]; \
        VRD8(va, vbase, 0); VRD8(vb_, vbase, 1); \
        oA[0] = __builtin_amdgcn_mfma_f32_32x32x16_bf16(pa0, PKV(va, 0), oA[0], 0, 0, 0); SBAR(); \
        oA[1] = __builtin_amdgcn_mfma_f32_32x32x16_bf16(pa0, PKV(vb_, 0), oA[1], 0, 0, 0); EXP4(c0, 0); EXP4(c0, 4); SBAR(); \
        oA[0] = __builtin_amdgcn_mfma_f32_32x32x16_bf16(pa1, PKV(va, 1), oA[0], 0, 0, 0); EXP4(c0, 8); EXP4(c0, 12); SUM4(sB, c0, 0); SBAR(); \
        oA[1] = __builtin_amdgcn_mfma_f32_32x32x16_bf16(pa1, PKV(vb_, 1), oA[1], 0, 0, 0); EXP4(c1, 0); SUM4(sB, c0, 4); SUM4(sB, c0, 8); SBAR(); \
        oA[0] = __builtin_amdgcn_mfma_f32_32x32x16_bf16(pa2, PKV(va, 2), oA[0], 0, 0, 0); EXP4(c1, 4); SUM4(sB, c0, 12); SBAR(); \
        oA[1] = __builtin_amdgcn_mfma_f32_32x32x16_bf16(pa2, PKV(vb_, 2), oA[1], 0, 0, 0); EXP4(c1, 8); SUM4(sB, c1, 0); SBAR(); \
        oA[0] = __builtin_amdgcn_mfma_f32_32x32x16_bf16(pa3, PKV(va, 3), oA[0], 0, 0, 0); EXP4(c1, 12); SUM4(sB, c1, 4); SBAR(); \
        oA[1] = __builtin_amdgcn_mfma_f32_32x32x16_bf16(pa3, PKV(vb_, 3), oA[1], 0, 0, 0); SUM4(sB, c1, 8); SUM4(sB, c1, 12); SBAR(); \
        lB += sB; \
        PK4X(c0, 0, pa0); PK4X(c0, 8, pa1); PK4X(c1, 0, pa2); PK4X(c1, 8, pa3); \
        SBAR(); \
        VRD8(va, vbase, 0); VRD8(vb_, vbase, 1);                       \
        oB[0] = __builtin_amdgcn_mfma_f32_32x32x16_bf16(pa0, PKV(va, 0), oB[0], 0, 0, 0); \
        oB[1] = __builtin_amdgcn_mfma_f32_32x32x16_bf16(pa0, PKV(vb_, 0), oB[1], 0, 0, 0); \
        oB[0] = __builtin_amdgcn_mfma_f32_32x32x16_bf16(pa1, PKV(va, 1), oB[0], 0, 0, 0); \
        oB[1] = __builtin_amdgcn_mfma_f32_32x32x16_bf16(pa1, PKV(vb_, 1), oB[1], 0, 0, 0); \
        oB[0] = __builtin_amdgcn_mfma_f32_32x32x16_bf16(pa2, PKV(va, 2), oB[0], 0, 0, 0); \
        oB[1] = __builtin_amdgcn_mfma_f32_32x32x16_bf16(pa2, PKV(vb_, 2), oB[1], 0, 0, 0); \
        oB[0] = __builtin_amdgcn_mfma_f32_32x32x16_bf16(pa3, PKV(va, 3), oB[0], 0, 0, 0); \
        oB[1] = __builtin_amdgcn_mfma_f32_32x32x16_bf16(pa3, PKV(vb_, 3), oB[1], 0, 0, 0); \
        SBAR(); } while (0)
#define TILE_BAR() do { asm volatile("s_waitcnt vmcnt(0)" ::: "memory"); __syncthreads(); } while (0)
    DMA2(0, 0, 0);
    if (wid < 4) {
        int vs = 0;
#pragma unroll 1
        for (int t = 0; t < NT; ++t) { TILE_BAR();
            const int vn = vs == 2 ? 0 : vs + 1; if (t + 1 < NT) DMA2(t + 1, (t + 1) & 1, vn);
            HALF1(K_lds + (t & 1) * SHM_K); HALF2(vrd0 + vs * SHM_V); vs = vn; }
        TILE_BAR();
    } else {
        __builtin_amdgcn_s_setprio(1);
        TILE_BAR(); if (1 < NT) DMA2(1, 1, 1);
        HALF1(K_lds);
        int vs = 0;
#pragma unroll 1
        for (int t = 1; t < NT; ++t) { TILE_BAR();
            const int vn = vs == 2 ? 0 : vs + 1; const int vnn = vn == 2 ? 0 : vn + 1; if (t + 1 < NT) DMA2(t + 1, (t + 1) & 1, vnn);
            HALF2(vrd0 + vs * SHM_V); HALF1(K_lds + (t & 1) * SHM_K); vs = vn; }
        TILE_BAR();
        HALF2(vrd0 + vs * SHM_V);
        __builtin_amdgcn_s_setprio(0);
    }
#undef HALF1
#undef HALF2
#undef TILE_BAR
    { auto rr = __builtin_amdgcn_permlane32_swap(__float_as_uint(lA), __float_as_uint(lA), false, false); lA = __uint_as_float(rr[0]) + __uint_as_float(rr[1]); }
    { auto rr = __builtin_amdgcn_permlane32_swap(__float_as_uint(lB), __float_as_uint(lB), false, false); lB = __uint_as_float(rr[0]) + __uint_as_float(rr[1]); }
    if (hi == 0) { ws[r32] = lA; ws[32 + r32] = lB; } asm volatile("s_waitcnt lgkmcnt(0)" ::: "memory");
    bf16* Ow = Ob + (long)(wid * 64) * ldo;
#pragma unroll
    for (int r = 0; r < 16; ++r) { const int orow = crow(r, hi); const float ra = __builtin_amdgcn_rcpf(ws[orow]), rb = __builtin_amdgcn_rcpf(ws[32 + orow]);
#pragma unroll
        for (int d0 = 0; d0 < NB; ++d0) { Ow[(long)orow * ldo + d0 * 32 + r32] = f2bf(oA[d0][r] * ra); Ow[(long)(32 + orow) * ldo + d0 * 32 + r32] = f2bf(oB[d0][r] * rb); } }
    __syncthreads();
#undef DMA2
#undef VRD8
#undef PKV
}
#undef EXP4
#undef SUM4
#undef PK4X

__device__ __forceinline__ void spatial_unit(int chunk, int g, const bf16* __restrict__ U, const bf16* __restrict__ VR, const float* __restrict__ vstat, const float* __restrict__ g_sg,
                                             const bf16* __restrict__ Wsb, const float* __restrict__ b_s, bf16* __restrict__ Y, LAS char* lds) {
    int tid_ = threadIdx.x; asm volatile("" : "+v"(tid_));
    const int tid = tid_, wid = tid >> 6, lane = tid & 63, r32 = lane & 31, hi = lane >> 5, rb = wid & 3, ch = wid >> 2;
    LAS char* V_lds = lds; LAS float* rv = (LAS float*)(lds + 32768);
    const int row0 = chunk * 128;
    if (tid < 128) { const f32x4 s0 = *(const f32x4*)(vstat + (size_t)(row0 + tid) * 8), s1 = *(const f32x4*)(vstat + (size_t)(row0 + tid) * 8 + 4);
        rv[tid] = __builtin_amdgcn_rsqf(((s0[0] + s0[1]) + (s0[2] + s0[3]) + (s1[0] + s1[1]) + (s1[2] + s1[3])) * (1.f / 512.f) + EPS); }
    __syncthreads();
#pragma unroll
    for (int i = 0; i < 4; ++i) { const int c = tid + 512 * i, row = c >> 4, cc = c & 15;
        const u32x4 w = *(const u32x4*)(VR + (size_t)(row0 + row) * 512 + g * 128 + cc * 8); f32x4 a, b; unpack8(w, a, b);
        const f32x4 g0 = *(const f32x4*)(g_sg + g * 128 + cc * 8), g1 = *(const f32x4*)(g_sg + g * 128 + cc * 8 + 4); const float r = rv[row];
        *(LAS u32x4*)(V_lds + (row >> 6) * 16384 + v_st<4>(row & 63, cc * 8)) = pack8(a * r * g0, b * r * g1); }
    bf16x8 pa[8];
#pragma unroll
    for (int ks = 0; ks < 8; ++ks) pa[ks] = *(const bf16x8*)(Wsb + (size_t)g * 16384 + (size_t)(32 * rb + r32) * 128 + 16 * ks + 8 * hi);
    __syncthreads();
    f32x16 o[2]; o[0] = f32x16{}; o[1] = f32x16{};
    const int vb = (int)(uintptr_t)V_lds + v_rd_base(lane) + (2 * ch) * 512;
    pv_one<4, 0>(o[0], vb, pa[0], pa[1], pa[2], pa[3]); pv_one<4, 1>(o[1], vb, pa[0], pa[1], pa[2], pa[3]);
    pv_one<4, 0>(o[0], vb + 16384, pa[4], pa[5], pa[6], pa[7]); pv_one<4, 1>(o[1], vb + 16384, pa[4], pa[5], pa[6], pa[7]);
#pragma unroll
    for (int r = 0; r < 16; ++r) { const int i = 32 * rb + crow(r, hi); const float bias = b_s[g * 128 + i]; const size_t row = (size_t)(row0 + i);
#pragma unroll
        for (int dd = 0; dd < 2; ++dd) { const int c = g * 128 + 64 * ch + 32 * dd + r32; const float uu = bf2f(U[row * 512 + c]);
            Y[row * 1536 + 512 + c] = f2bf(uu * (o[dd][r] + bias)); } }
    __syncthreads();
}
#undef KSWZ
#undef SBAR
}

#define XB_TMO      128
#define XB_XCNT(j)  (256  + 64 * (j))
#define XB_XSUB(j)  (1280 + 64 * (j))
#define XB_XGEN(j)  (2304 + 64 * (j))
#define XB_TOP      3328
#define XB_TOPGEN   3392
#define XCD_BAR_WORDS 3456
#define XB_SPIN_CAP (1u << 18)
__device__ __forceinline__ unsigned xb_ld(unsigned* p)              { return __hip_atomic_load((GAS unsigned*)p, __ATOMIC_RELAXED, __HIP_MEMORY_SCOPE_AGENT); }
__device__ __forceinline__ unsigned xb_add(unsigned* p, unsigned v) { return __hip_atomic_fetch_add((GAS unsigned*)p, v, __ATOMIC_RELAXED, __HIP_MEMORY_SCOPE_AGENT); }
__device__ __forceinline__ unsigned xb_xcc_id() { return (unsigned)__builtin_amdgcn_s_getreg((3 << 11) | 20) & 0xFu; }
#define XB_SPIN(cond, bar) do { unsigned _sp = 0; while (cond) { __builtin_amdgcn_s_sleep(1); \
    if ((++_sp & 255u) == 0u) { if (xb_ld(&(bar)[XB_TMO])) break; if (_sp > XB_SPIN_CAP) { xb_add(&(bar)[XB_TMO], 1u); break; } } } } while (0)
struct XcdBarrier { unsigned* bar; unsigned x; volatile LAS unsigned* st; };
__device__ __forceinline__ XcdBarrier xcd_barrier_post(unsigned* bar, volatile LAS unsigned* st) {
    XcdBarrier b; b.bar = bar; b.x = (unsigned)__builtin_amdgcn_readfirstlane((int)xb_xcc_id()); b.st = st;
    if (threadIdx.x == 0) (void)xb_add(&bar[XB_XCNT(b.x)], 1u);
    return b;
}
__device__ __forceinline__ void xcd_barrier_complete(unsigned* bar, unsigned x, unsigned& nloc, unsigned& nx) {
    const unsigned G = gridDim.x * gridDim.y * gridDim.z;
    unsigned sum, cnt, mine, sp = 0u;
    for (;;) {
        sum = 0u; cnt = 0u; mine = 0u;
#pragma unroll
        for (unsigned j = 0; j < 16; ++j) { const unsigned c = xb_ld(&bar[XB_XCNT(j)]); sum += c; cnt += (c > 0u) ? 1u : 0u; mine = (j == x) ? c : mine; }
        if (sum == G) break;
        __builtin_amdgcn_s_sleep(1);
        if ((++sp & 255u) == 0u) { if (xb_ld(&bar[XB_TMO])) break; if (sp > XB_SPIN_CAP) { xb_add(&bar[XB_TMO], 1u); break; } }
    }
    nloc = mine > 0u ? mine : 1u; nx = cnt > 0u ? cnt : 1u;
}
__device__ __forceinline__ void xcd_barrier(const XcdBarrier& b) {
    asm volatile("s_waitcnt vmcnt(0)" ::: "memory");
    __syncthreads();
    if (threadIdx.x == 0) {
        unsigned* bar = b.bar; unsigned bx = b.x; asm volatile("" : "+s"(bar), "+s"(bx));
        __builtin_amdgcn_s_waitcnt(0);
        unsigned nloc = b.st[0], nx = b.st[1];
        if (nloc == 0u) { xcd_barrier_complete(bar, bx, nloc, nx); b.st[0] = nloc; b.st[1] = nx; }
        const unsigned old = xb_add(&bar[XB_XSUB(bx)], 1u);
        const unsigned gen = old / nloc;
        if (old + 1u == (gen + 1u) * nloc) {
            __builtin_amdgcn_fence(__ATOMIC_RELEASE, "agent");
            asm volatile("s_waitcnt vmcnt(0)" ::: "memory");
            const unsigned og = xb_add(&bar[XB_TOP], 1u);
            const unsigned tg = og / nx;
            if (og + 1u == (tg + 1u) * nx) xb_add(&bar[XB_TOPGEN], 1u);
            else XB_SPIN(xb_ld(&bar[XB_TOPGEN]) == tg, bar);
            __builtin_amdgcn_fence(__ATOMIC_ACQUIRE, "agent");
            xb_add(&bar[XB_XGEN(bx)], 1u);
            asm volatile("s_waitcnt vmcnt(0)" ::: "memory");
        } else {
            XB_SPIN(xb_ld(&bar[XB_XGEN(bx)]) == gen, bar);
            __builtin_amdgcn_fence(__ATOMIC_ACQUIRE, "agent");
            asm volatile("s_waitcnt vmcnt(0)" ::: "memory");
        }
    }
    __syncthreads();
}

enum { CV_NAT = 0, CV_WIN = 1, CV_WUQ = 2, CV_W13 = 3 };
__device__ __forceinline__ int ropeperm(int p) { return ((p >> 2) & 1) * 16 + 4 * (p >> 3) + (p & 3); }
__device__ __forceinline__ int cv_map(int kind, int G, int& which, float& scale, bool& perm) {
    which = 0; scale = 1.f; perm = false; const int n = G * 32;
    if (kind == CV_WIN) {
        if (n < 384) return n;
        if (n < 416) { perm = true; return 640; }
        if (n < 512) return -1;
        if (n < 768) return 384 + (n - 512);
        if (n < 1280) return 672 + (n - 768);
        if (n < 1792) return 1184 + (n - 1280);
        if (n < 2304) { scale = XSCALE; return 1696 + (n - 1792); }
        return 2208 + (n - 2304);
    }
    if (kind == CV_WUQ) { scale = QSCALE; perm = (G % 3) == 2; return n; }
    if (kind == CV_W13) { which = (n >> 7) & 1; return 128 * (n >> 8) + (n & 127); }
    return n;
}
struct CvDesc { const float* src; const float* src2; const float* gain; bf16* dst; int K, Nsrc, Nout, kind; };
__device__ __forceinline__ void cv_item(const CvDesc& d, int item, LAS char* tile, int lane) {
    const int nI = d.Nout >> 7, kb = item / nI, nb = item - kb * nI, k0 = 64 * kb, n0 = 128 * nb;
    const int nq = lane & 31, kh = lane >> 5;
    const int nout = n0 + 4 * nq, G = nout >> 5, p = nout & 31;
    int which; float scale; bool perm; const int sc = cv_map(d.kind, G, which, scale, perm);
    const bool zero = sc < 0;
    const float* W = d.src + (ptrdiff_t)which * (d.src2 - d.src) + (size_t)k0 * d.Nsrc + (zero ? 0 : sc + (perm ? ropeperm(p) : p));
#pragma unroll
    for (int half = 0; half < 2; ++half) {
        f32x4 v[16];
#pragma unroll
        for (int i = 0; i < 16; ++i) { const int k = 32 * half + 2 * i + kh; v[i] = zero ? (f32x4){0.f, 0.f, 0.f, 0.f} : *(const f32x4*)(W + (size_t)k * d.Nsrc); }
#pragma unroll
        for (int i = 0; i < 16; ++i) { const int k = 32 * half + 2 * i + kh; const float g = d.gain ? d.gain[k0 + k] * scale : scale; const f32x4 w = v[i] * g;
            *(LAS u32x2*)(tile + att::v_st<4>(k, 4 * nq)) = (u32x2){cvt_pk_bf16(w[0], w[1]), cvt_pk_bf16(w[2], w[3])}; }
    }
    LDS_WAIT(); asm volatile("" ::: "memory");
    const int vb = (int)(uintptr_t)tile + att::v_rd_base(lane);
    bf16* drow = d.dst + (size_t)(n0 >> 8) * 256 * d.K + (size_t)kb * (256 * 64) + (size_t)((n0 & 255) + nq) * 64 + 8 * kh;
#define CV_RD(D0, KS) { const s16x4 l_ = att::tr_read<((2 * KS) * 4 + D0) * 512>(vb), h_ = att::tr_read<((2 * KS + 1) * 4 + D0) * 512>(vb); \
        asm volatile("s_waitcnt lgkmcnt(0)" ::: "memory"); __builtin_amdgcn_sched_barrier(0); \
        *(bf16x8*)(drow + (32 * D0) * 64 + 16 * KS) = (bf16x8){l_[0], l_[1], l_[2], l_[3], h_[0], h_[1], h_[2], h_[3]}; }
#define CV_RD4(D0) CV_RD(D0, 0) CV_RD(D0, 1) CV_RD(D0, 2) CV_RD(D0, 3)
    CV_RD4(0) CV_RD4(1) CV_RD4(2) CV_RD4(3)
#undef CV_RD4
#undef CV_RD
    LDS_WAIT(); asm volatile("" ::: "memory");
}

struct Args {
    const float* x; const float* mem; const int* positions; const float* g_mix; const float* w_in; const float* g_q; const float* g_kv; const float* w_uq; const float* w_uk; const float* w_uv;
    const float* g_sg; const float* w_s; const float* b_s; const float* g_mem; const float* w_mkv; const float* w_br; const float* b_gate; const float* w_out; const float* g_ffn;
    const float* dense_w1; const float* dense_w3; const float* dense_w2; const float* w_router; const float* moe_w1; const float* moe_w3; const float* moe_w2; const float* g_final;
    float* out; unsigned char* ws; int dbg; int pad;
};
typedef const __attribute__((address_space(4))) Args* ArgsP;
#define FRESH(ap) ArgsP ap = kargs; asm volatile("" : "+s"(ap))
__constant__ double INVF[16] = { 1.0, 0.5623413251903491, 0.31622776601683794, 0.1778279410038923, 0.1, 0.05623413251903491, 0.03162277660168379, 0.01778279410038923,
                                 0.01, 0.005623413251903491, 0.003162277660168379, 0.001778279410038923, 0.001, 0.0005623413251903491, 0.00031622776601683794, 0.0001778279410038923 };

struct Frame { LAS unsigned char* lds; int G, NGW, bid; };
#define LOCAL_IDS int tid = threadIdx.x; asm volatile("" : "+v"(tid)); const int lane = tid & 63, wave = __builtin_amdgcn_readfirstlane(tid >> 6), gw = F.bid * NWAVES + wave; (void)lane; (void)gw

__device__ __forceinline__ void conv_run(const Frame& F, const CvDesc& d) {
    LOCAL_IDS;
    LAS char* tile = (LAS char*)(F.lds + wave * 16384);
    const int nitems = (d.K / 64) * (d.Nout / 128);
    for (int it = gw; it < nitems; it += F.NGW) cv_item(d, it, tile, lane);
}
__device__ __forceinline__ void rx_from_stats(const Frame& F, ArgsP kargs) {
    LOCAL_IDS; FRESH(ap); const float* xstat = (const float*)(ap->ws + WS_XSTAT); float* rx = (float*)(ap->ws + WS_RX);
    for (int row = F.bid * 512 + tid; row < M; row += F.G * 512) {
        const f32x4* p = (const f32x4*)(xstat + (size_t)row * 16); const f32x4 a = p[0], b = p[1], c = p[2], d = p[3];
        const float s = ((a[0] + a[1]) + (a[2] + a[3])) + ((b[0] + b[1]) + (b[2] + b[3])) + ((c[0] + c[1]) + (c[2] + c[3])) + ((d[0] + d[1]) + (d[2] + d[3]));
        rx[row] = __builtin_amdgcn_rsqf(s * (1.f / D) + EPS);
    }
}
__device__ __forceinline__ void conv_mixer(const Frame& F, ArgsP kargs, int l) {
    { FRESH(a); CvDesc d{a->w_in + (size_t)l * D * PTOT, nullptr, a->g_mix + l * D, (bf16*)(a->ws + WS_WINT), D, PTOT, PPAD, CV_WIN}; conv_run(F, d); }
    { FRESH(a); CvDesc d{a->w_uq + (size_t)l * QRANK * 768, nullptr, a->g_q + l * QRANK, (bf16*)(a->ws + WS_WUQT), QRANK, 768, 768, CV_WUQ}; conv_run(F, d); }
    { FRESH(a); CvDesc d{a->w_uk + (size_t)l * KVRANK * 512, nullptr, a->g_kv + l * KVRANK, (bf16*)(a->ws + WS_WUKVT), KVRANK, 512, 512, CV_NAT}; conv_run(F, d); }
    { FRESH(a); CvDesc d{a->w_uv + (size_t)l * KVRANK * 512, nullptr, a->g_kv + l * KVRANK, (bf16*)(a->ws + WS_WUKVT) + 512 * KVRANK, KVRANK, 512, 512, CV_NAT}; conv_run(F, d); }
#pragma unroll 1
    for (int n = 0; n < 3; ++n) { FRESH(a); CvDesc d{a->w_br + ((size_t)l * 3 + n) * BW * D, nullptr, nullptr, (bf16*)(a->ws + WS_WBRT) + (size_t)n * D * BW, BW, D, D, CV_NAT}; conv_run(F, d); }
    { FRESH(a); CvDesc d{a->w_out + (size_t)l * D * D, nullptr, nullptr, (bf16*)(a->ws + WS_WOUTT), D, D, D, CV_NAT}; conv_run(F, d); }
    { LOCAL_IDS; FRESH(a); const float* wsrc = a->w_s + (size_t)l * 65536; bf16* wdst = (bf16*)(a->ws + WS_WSB);
      for (int i = F.bid * 512 + tid; i < 4 * 128 * 128 / 4; i += F.G * 512) { const f32x4 v = *(const f32x4*)(wsrc + (size_t)i * 4);
        *(u32x2*)(wdst + (size_t)i * 4) = (u32x2){cvt_pk_bf16(v[0], v[1]), cvt_pk_bf16(v[2], v[3])}; } }
}
__device__ __forceinline__ void phase_prologue(const Frame& F, ArgsP kargs) {
    LOCAL_IDS;
    { FRESH(a); float* ROPE = (float*)(a->ws + WS_ROPE); const int* pos = a->positions;
      for (int idx = F.bid * 512 + tid; idx < M * 16; idx += F.G * 512) { const int row = idx >> 4, i = idx & 15;
        const double t = (double)pos[row] * INVF[i] * 0.15915494309189535; const float fr = (float)(t - rint(t));
        ROPE[(size_t)row * 32 + i] = __builtin_amdgcn_cosf(fr); ROPE[(size_t)row * 32 + 16 + i] = __builtin_amdgcn_sinf(fr); } }
    { FRESH(a); const float* xin = a->x; float* X = a->out; bf16* XB = (bf16*)(a->ws + WS_XB); float* RX = (float*)(a->ws + WS_RX);
      for (int m = gw; m < M; m += F.NGW) { const f32x4* xr = (const f32x4*)(xin + (size_t)m * D) + lane; f32x4 v[4]; float s = 0.f;
#pragma unroll
        for (int j = 0; j < 4; ++j) { v[j] = xr[64 * j]; s += sumsq4(v[j]); }
        s = wave_sum(s);
#pragma unroll
        for (int j = 0; j < 4; ++j) { ((f32x4*)(X + (size_t)m * D) + lane)[64 * j] = v[j]; ((u32x2*)(XB + (size_t)m * D) + lane)[64 * j] = (u32x2){cvt_pk_bf16(v[j][0], v[j][1]), cvt_pk_bf16(v[j][2], v[j][3])}; }
        if (lane == 0) RX[m] = __builtin_amdgcn_rsqf(s * (1.f / D) + EPS); } }
    { FRESH(a); const float* mem = a->mem; const float* g_mem = a->g_mem; bf16* MEMB = (bf16*)(a->ws + WS_MEMB);
      for (int m = gw; m < NMEM; m += F.NGW) { const f32x4* xr = (const f32x4*)(mem + (size_t)m * D) + lane; f32x4 v[4]; float s = 0.f;
#pragma unroll
        for (int j = 0; j < 4; ++j) { v[j] = xr[64 * j]; s += sumsq4(v[j]); }
        const float r = __builtin_amdgcn_rsqf(wave_sum(s) * (1.f / D) + EPS);
#pragma unroll
        for (int j = 0; j < 4; ++j) { const f32x4 g = ((const f32x4*)g_mem + lane)[64 * j]; const f32x4 w = v[j] * r * g;
            ((u32x2*)(MEMB + (size_t)m * D) + lane)[64 * j] = (u32x2){cvt_pk_bf16(w[0], w[1]), cvt_pk_bf16(w[2], w[3])}; } } }
#pragma unroll 1
    for (int l = 0; l < DEPTH; ++l) { FRESH(a); CvDesc d{a->w_mkv + (size_t)l * D * D, nullptr, nullptr, (bf16*)(a->ws + WS_WMKVT) + (size_t)l * D * D, D, D, D, CV_NAT}; conv_run(F, d); }
    conv_mixer(F, kargs, 0);
}
__device__ __forceinline__ void phase_inproj(const Frame& F, ArgsP kargs, int l) {
    if (PH(1)) { FRESH(a); unsigned char* ws = a->ws;
        pg8::TileOrder S{M / 256, PPAD / 256 - 1, F.G, F.bid, (const char*)(ws + WS_XB), (const char*)(ws + WS_WINT), (size_t)256 * D * 2, (size_t)256 * D * 2};
#ifdef DBG_REV
        S.rev = 1;
#endif
        pg8::EpiInProj E{ws, a->b_gate + (size_t)l * 3 * D, l, (l & 1)};
        pg8::gemm_phase(F.lds, D, D, D, S, E); }
    if (l == 0 && PH(2)) { FRESH(a); unsigned char* ws = a->ws;
        struct MemOrder { int c; const char* A; const char* B;
            __device__ __forceinline__ bool next(int i, pg8::Unit& u) const { if (i > 0 || c < 240) return false; const int idx = c - 240; u.pm = 0; u.pn = idx & 3; u.aux = idx >> 2; u.A = A; u.B = B + (size_t)u.aux * D * D * 2 + (size_t)u.pn * 256 * D * 2; return true; } };
        MemOrder S2{F.bid, (const char*)(ws + WS_MEMB), (const char*)(ws + WS_WMKVT)}; pg8::EpiMemKV E2{(bf16*)(ws + WS_KVMEM)};
        pg8::gemm_phase(F.lds, D, D, D, S2, E2); }
}
struct GateTailOrder { int c; const char* A; const char* B;
    __device__ __forceinline__ bool next(int i, pg8::Unit& u) const { if (i > 0 || c < 192) return false; u.pm = c - 192; u.pn = PPAD / 256 - 1; u.aux = 0; u.A = A + (size_t)u.pm * 256 * D * 2; u.B = B + (size_t)u.pn * 256 * D * 2; return true; } };
__device__ __forceinline__ void phase_up(const Frame& F, ArgsP kargs, int l) {
    if (PH(1)) { FRESH(a); unsigned char* ws = a->ws;
        GateTailOrder S{F.bid, (const char*)(ws + WS_XB), (const char*)(ws + WS_WINT)}; pg8::EpiInProj E{ws, a->b_gate + (size_t)l * 3 * D, l, (l & 1)};
        pg8::gemm_phase(F.lds, D, D, D, S, E); }
    if (PH(3)) { FRESH(a); unsigned char* ws = a->ws;
        pg8::TileOrder S{M / 256, 3, F.G, F.bid, (const char*)(ws + WS_CQ), (const char*)(ws + WS_WUQT), (size_t)256 * 512 * 2, (size_t)256 * QRANK * 2};
        pg8::EpiQ E{(const float*)(ws + WS_CQSTAT), (const float*)(ws + WS_ROPE), (bf16*)(ws + WS_Q)}; pg8::gemm_phase(F.lds, 512, QRANK, QRANK, S, E); }
    if (PH(4)) { FRESH(a); unsigned char* ws = a->ws;
        pg8::TileOrder S{M / 256, 4, F.G, F.bid, (const char*)(ws + WS_CKV), (const char*)(ws + WS_WUKVT), (size_t)256 * KVRANK * 2, (size_t)256 * KVRANK * 2};
        pg8::EpiKV E{(const float*)(ws + WS_CKVSTAT), (bf16*)(ws + WS_KN), (bf16*)(ws + WS_V), (unsigned*)(ws + WS_CTL) + CW_KMAX + l * 32}; pg8::gemm_phase(F.lds, KVRANK, KVRANK, KVRANK, S, E); }
    if (PH(5)) { FRESH(a); unsigned char* ws = a->ws;
        for (int un = F.bid; un < 512; un += F.G)
            att::spatial_unit(un >> 2, un & 3, (const bf16*)(ws + WS_U), (const bf16*)(ws + WS_VR), (const float*)(ws + WS_VSTAT), a->g_sg + l * BW, (const bf16*)(ws + WS_WSB), a->b_s + l * 512, (bf16*)(ws + WS_Y), (LAS char*)F.lds); }
    if (PH(6)) { FRESH(a); unsigned char* ws = a->ws;
        for (int un = F.bid; un < 256; un += F.G) { const int h = un & 3, pm = un >> 2; const bf16* kvm = (const bf16*)(ws + WS_KVMEM) + (size_t)l * 256 * 1024;
            att::attn_unit<128, 128, 128, false>((const bf16*)(ws + WS_QX) + (size_t)pm * 256 * 512 + h * 128, 512, kvm + h * 128, 1024, kvm, 1024, kvm + 512 + h * 128, 1024,
                                          (bf16*)(ws + WS_Y) + (size_t)pm * 256 * 1536 + 1024 + h * 128, 1536, NMEM, (LAS char*)F.lds, 0.f); } }
}
__device__ __forceinline__ void phase_attn(const Frame& F, ArgsP kargs, int l) {
    if (PH(7)) { FRESH(a); unsigned char* ws = a->ws;
        for (int un = F.bid; un < 256; un += F.G) { const int h = un & 7, qb = un >> 3;
            const unsigned* km = (const unsigned*)(ws + WS_CTL) + CW_KMAX + l * 32;
            const float kbound = sqrtf(__uint_as_float(km[2 * h]) + __uint_as_float(km[2 * h + 1]) + __uint_as_float(km[16])) * 1.02f;
            att::attn_unit2<96, 64, 64>((const bf16*)(ws + WS_Q) + (size_t)qb * 512 * 768 + h * 96, 768, (const bf16*)(ws + WS_KN) + h * 64, 512, (const bf16*)(ws + WS_KR), 32, (const bf16*)(ws + WS_V) + h * 64, 512,
                                        (bf16*)(ws + WS_Y) + (size_t)qb * 512 * 1536 + h * 64, 1536, M, (LAS char*)F.lds, kbound); } }
}
__device__ __forceinline__ void phase_branch(const Frame& F, ArgsP kargs) {
    if (PH(8)) { FRESH(a); unsigned char* ws = a->ws;
        struct BranchOrder { int c; const char* A; const char* B;
            __device__ __forceinline__ bool next(int i, pg8::Unit& u) const { if (i >= 3 || c >= 256) return false; int pm, pn; pg8::tile_of(c, 64, 4, pm, pn); u.pm = pm; u.pn = pn; u.aux = i;
                u.A = A + (size_t)pm * 256 * 1536 * 2 + (size_t)i * 512 * 2; u.B = B + (size_t)i * D * BW * 2 + (size_t)pn * 256 * BW * 2; return true; } };
        BranchOrder S{F.bid, (const char*)(ws + WS_Y), (const char*)(ws + WS_WBRT)}; pg8::EpiBranch E{(const unsigned char*)(ws + WS_GATE), (bf16*)(ws + WS_MIXB)};
        pg8::gemm_phase(F.lds, 1536, BW, BW, S, E); }
}
__device__ __forceinline__ void phase_outproj(const Frame& F, ArgsP kargs, bool dummy = false) {
    if (PH(9)) { FRESH(a); unsigned char* ws = a->ws;
        pg8::TileOrder S{M / 256, 4, F.G, F.bid, (const char*)(ws + WS_MIXB), (const char*)(ws + WS_WOUTT), (size_t)256 * D * 2, (size_t)256 * D * 2};
        pg8::EpiResid E{a->out, dummy ? (float*)(ws + 700 * MiB) : a->out, (bf16*)(ws + (dummy ? 764 * MiB : WS_XB)), (float*)(ws + (dummy ? 796 * MiB : WS_XSTAT))}; pg8::gemm_phase(F.lds, 0, D, D, S, E); }
}
__device__ __forceinline__ void phase_dense_conv(const Frame& F, ArgsP kargs, int l, int j2) {
    { FRESH(a); CvDesc d{a->dense_w1 + (size_t)j2 * D * DFF, a->dense_w3 + (size_t)j2 * D * DFF, a->g_ffn + l * D, (bf16*)(a->ws + WS_WFFN), D, DFF, 2 * DFF, CV_W13}; conv_run(F, d); }
    { FRESH(a); CvDesc d{a->dense_w2 + (size_t)j2 * DFF * D, nullptr, nullptr, (bf16*)(a->ws + WS_W2D), DFF, D, D, CV_NAT}; conv_run(F, d); }
    rx_from_stats(F, kargs);
    conv_mixer(F, kargs, l + 1);
}
__device__ __forceinline__ void phase_dense_up(const Frame& F, ArgsP kargs) {
    if (PH(10)) { FRESH(a); unsigned char* ws = a->ws;
        pg8::TileOrder S{M / 256, 2 * DFF / 256, F.G, F.bid, (const char*)(ws + WS_XB), (const char*)(ws + WS_WFFN), (size_t)256 * D * 2, (size_t)256 * D * 2};
        pg8::EpiSwiGLU E{(const float*)(ws + WS_RX), (bf16*)(ws + WS_HFF), DFF, 0}; pg8::gemm_phase(F.lds, D, D, D, S, E); }
}
__device__ __forceinline__ void phase_dense_down(const Frame& F, ArgsP kargs, bool dummy = false) {
    if (PH(11)) { FRESH(a); unsigned char* ws = a->ws;
        pg8::TileOrder S{M / 256, 4, F.G, F.bid, (const char*)(ws + WS_HFF), (const char*)(ws + WS_W2D), (size_t)256 * DFF * 2, (size_t)256 * DFF * 2};
        pg8::EpiResid E{a->out, dummy ? (float*)(ws + 700 * MiB) : a->out, (bf16*)(ws + (dummy ? 764 * MiB : WS_XB)), (float*)(ws + (dummy ? 796 * MiB : WS_XSTAT))}; pg8::gemm_phase(F.lds, 0, DFF, DFF, S, E); }
}
__device__ __forceinline__ void phase_moe_route(const Frame& F, ArgsP kargs, int l, int j2) {
    {
        int tid_ = threadIdx.x; asm volatile("" : "+v"(tid_)); const int lane_ = tid_ & 63, wave_ = __builtin_amdgcn_readfirstlane(tid_ >> 6);
        LAS char* tile = (LAS char*)(F.lds + wave_ * 16384);
        constexpr int I13 = (D / 64) * (2 * DFE / 128), I2 = (DFE / 64) * (D / 128), IE = I13 + I2;
#pragma unroll 1
        for (int idx = F.bid * NWAVES + wave_; idx < NE * IE; idx += F.NGW) { const int e = idx / IE, r = idx - e * IE;
            FRESH(a);
            if (r < I13) { CvDesc d{a->moe_w1 + ((size_t)j2 * NE + e) * D * DFE, a->moe_w3 + ((size_t)j2 * NE + e) * D * DFE, a->g_ffn + l * D, (bf16*)(a->ws + WS_WFFN) + (size_t)e * 2 * DFE * D, D, DFE, 2 * DFE, CV_W13}; cv_item(d, r, tile, lane_); }
            else { CvDesc d{a->moe_w2 + ((size_t)j2 * NE + e) * DFE * D, nullptr, nullptr, (bf16*)(a->ws + WS_W2M) + (size_t)e * D * DFE, DFE, D, D, CV_NAT}; cv_item(d, r - I13, tile, lane_); } }
    }
    if (l + 1 < DEPTH) conv_mixer(F, kargs, l + 1);
    __syncthreads();
    LOCAL_IDS; FRESH(a); unsigned char* ws = a->ws; const float* X = a->out;
    float* RX = (float*)(ws + WS_RX); int* TOPI = (int*)(ws + WS_TOPI); float* TOPW = (float*)(ws + WS_TOPW); int* LRANK = (int*)(ws + WS_LRANK); int* BLKCNT = (int*)(ws + WS_BLKCNT);
    LAS int* tope = (LAS int*)(F.lds + 0);
    const float* wr = a->w_router + (size_t)j2 * D * NE; const float* gf = a->g_ffn + l * D;
#pragma unroll 1
    for (int i = 0; i < 8; ++i) { const int rib = wave * 8 + i, row = F.bid * 64 + rib;
        float lg[8]; float ss = 0.f;
#pragma unroll
        for (int e = 0; e < 8; ++e) lg[e] = 0.f;
#pragma unroll
        for (int j = 0; j < 4; ++j) { const int k0 = 4 * lane + 256 * j; const f32x4 xv = *(const f32x4*)(X + (size_t)row * D + k0), gv = *(const f32x4*)(gf + k0); ss += sumsq4(xv);
#pragma unroll
            for (int q = 0; q < 4; ++q) { const float hv = xv[q] * gv[q]; const f32x4 w0 = *(const f32x4*)(wr + (size_t)(k0 + q) * 8), w1 = *(const f32x4*)(wr + (size_t)(k0 + q) * 8 + 4);
                lg[0] += hv * w0[0]; lg[1] += hv * w0[1]; lg[2] += hv * w0[2]; lg[3] += hv * w0[3]; lg[4] += hv * w1[0]; lg[5] += hv * w1[1]; lg[6] += hv * w1[2]; lg[7] += hv * w1[3]; } }
        const float r = __builtin_amdgcn_rsqf(wave_sum(ss) * (1.f / D) + EPS);
#pragma unroll
        for (int e = 0; e < 8; ++e) lg[e] = wave_sum(lg[e]) * r;
        int e0 = 0; float v0 = lg[0];
#pragma unroll
        for (int e = 1; e < 8; ++e) if (lg[e] > v0) { v0 = lg[e]; e0 = e; }
        int e1 = e0 == 0 ? 1 : 0; float v1 = -3.0e38f;
#pragma unroll
        for (int e = 0; e < 8; ++e) if (e != e0 && lg[e] > v1) { v1 = lg[e]; e1 = e; }
        const float w0 = 1.f / (1.f + expf(v1 - v0));
        if (lane == 0) { RX[row] = r; TOPI[row] = e0 | (e1 << 8); TOPW[(size_t)row * 2] = w0; TOPW[(size_t)row * 2 + 1] = 1.f - w0; tope[rib] = e0 | (e1 << 8); } }
    __syncthreads();
    if (wave == 0) { const int te = tope[lane], e0 = te & 255, e1 = te >> 8, row = F.bid * 64 + lane; const unsigned long long below = (1ull << lane) - 1ull;
        int rk0 = 0, rk1 = 0;
#pragma unroll
        for (int e = 0; e < 8; ++e) { const unsigned long long m0 = __ballot(e0 == e), m1 = __ballot(e1 == e); const int c0 = __popcll(m0);
            if (e0 == e) rk0 = __popcll(m0 & below); if (e1 == e) rk1 = c0 + __popcll(m1 & below);
            if (lane == 0) BLKCNT[F.bid * 8 + e] = c0 + __popcll(m1); }
        LRANK[(size_t)row * 2] = rk0; LRANK[(size_t)row * 2 + 1] = rk1; }
    __syncthreads();
}
__device__ __forceinline__ void moe_tiles(const Frame& F, ArgsP kargs, int (&tb)[NE + 1], LAS int* pre) {
    LOCAL_IDS; FRESH(a); const int* BLKCNT = (const int*)(a->ws + WS_BLKCNT);
    __syncthreads();
    if (tid < 16) pre[tid] = 0;
    __syncthreads();
    if (tid < 256) { const i32x4 c0 = *(const i32x4*)(BLKCNT + tid * 8), c1 = *(const i32x4*)(BLKCNT + tid * 8 + 4); const int cc[8] = {c0[0], c0[1], c0[2], c0[3], c1[0], c1[1], c1[2], c1[3]};
#pragma unroll
        for (int e = 0; e < 8; ++e) { const int tot = (int)wave_sum((float)cc[e]); const int bel = (int)wave_sum(tid < F.bid ? (float)cc[e] : 0.f);
            if (lane == 0) { __hip_atomic_fetch_add(pre + 8 + e, tot, __ATOMIC_RELAXED, __HIP_MEMORY_SCOPE_WORKGROUP); __hip_atomic_fetch_add(pre + e, bel, __ATOMIC_RELAXED, __HIP_MEMORY_SCOPE_WORKGROUP); } } }
    __syncthreads();
    int acc_t = 0;
#pragma unroll
    for (int e = 0; e < NE; ++e) { tb[e] = acc_t; acc_t += (__builtin_amdgcn_readfirstlane(pre[8 + e]) + 255) >> 8; }
    tb[NE] = acc_t;
}
__device__ __forceinline__ void phase_moe_gather(const Frame& F, ArgsP kargs) {
    int tb[NE + 1]; LAS int* pre = (LAS int*)(F.lds + 0);
    moe_tiles(F, kargs, tb, pre);
    LOCAL_IDS; FRESH(a); unsigned char* ws = a->ws;
    const int* TOPI = (const int*)(ws + WS_TOPI); const int* LRANK = (const int*)(ws + WS_LRANK); int* POS = (int*)(ws + WS_POS); float* SLOTR = (float*)(ws + WS_SLOTR); const float* RX = (const float*)(ws + WS_RX);
    const bf16* XB = (const bf16*)(ws + WS_XB); bf16* XG = (bf16*)(ws + WS_XG);
#pragma unroll 1
    for (int p = 0; p < 16; ++p) { const int pi = wave * 16 + p, rib = pi >> 1, k = pi & 1, row = F.bid * 64 + rib;
        const int te = TOPI[row], e = __builtin_amdgcn_readfirstlane(k ? (te >> 8) : (te & 255));
        int bs = 0;
#pragma unroll
        for (int q = 0; q < NE; ++q) if (q == e) bs = tb[q] * 256;
        const int slot = bs + __builtin_amdgcn_readfirstlane(pre[e]) + LRANK[(size_t)row * 2 + k];
        const u32x4* s = (const u32x4*)(XB + (size_t)row * D) + lane; u32x4* dd = (u32x4*)(XG + (size_t)slot * D) + lane; dd[0] = s[0]; dd[64] = s[64];
        if (lane == 0) { POS[(size_t)row * 2 + k] = slot; SLOTR[slot] = RX[row]; } }
    if (F.bid < NE) { const int e = F.bid; int b0 = 0, b1 = 0;
#pragma unroll
        for (int q = 0; q < NE; ++q) if (q == e) { b0 = tb[q] * 256; b1 = tb[q + 1] * 256; }
        const int cnt = __builtin_amdgcn_readfirstlane(pre[8 + e]);
        for (int s = b0 + cnt + wave; s < b1; s += NWAVES) { u32x4* dd = (u32x4*)(XG + (size_t)s * D) + lane; dd[0] = (u32x4){0u, 0u, 0u, 0u}; dd[64] = (u32x4){0u, 0u, 0u, 0u}; if (lane == 0) SLOTR[s] = 0.f; } }
    __syncthreads();
}
struct MoeOrder { int nN, G, c, T; int tb[NE + 1]; const char* A; const char* B; size_t astep, estep, bstep; int rev = 0;
    __device__ __forceinline__ bool next(int i, pg8::Unit& u) const { const long L = (long)i * G + c; if (L >= (long)T * nN) return false; int pm, pn; pg8::tile_of((int)L, T, nN, pm, pn); if (rev) pm = T - 1 - pm;
        int e = 0;
#pragma unroll
        for (int q = 1; q < NE; ++q) e += (pm >= tb[q]) ? 1 : 0;
        u.pm = pm; u.pn = pn; u.aux = e; u.A = A + (size_t)pm * astep; u.B = B + (size_t)e * estep + (size_t)pn * bstep; return true; } };
__device__ __forceinline__ void phase_moe_up(const Frame& F, ArgsP kargs) {
    if (PH(12)) { MoeOrder S; LAS int* pre = (LAS int*)(F.lds + RING_BYTES + 64); moe_tiles(F, kargs, S.tb, pre);
        FRESH(a); unsigned char* ws = a->ws; S.nN = 2 * DFE / 256; S.G = F.G; S.c = F.bid; S.T = S.tb[NE];
        S.A = (const char*)(ws + WS_XG); S.B = (const char*)(ws + WS_WFFN); S.astep = (size_t)256 * D * 2; S.estep = (size_t)2 * DFE * D * 2; S.bstep = (size_t)256 * D * 2;
        pg8::EpiSwiGLU E{(const float*)(ws + WS_SLOTR), (bf16*)(ws + WS_HG), DFE, 0}; pg8::gemm_phase(F.lds, D, D, D, S, E); }
}
__device__ __forceinline__ void phase_moe_down(const Frame& F, ArgsP kargs) {
    if (PH(13)) { MoeOrder S; LAS int* pre = (LAS int*)(F.lds + RING_BYTES + 64); moe_tiles(F, kargs, S.tb, pre);
        FRESH(a); unsigned char* ws = a->ws; S.nN = 4; S.G = F.G; S.c = F.bid; S.T = S.tb[NE]; S.rev = 1;
        S.A = (const char*)(ws + WS_HG); S.B = (const char*)(ws + WS_W2M); S.astep = (size_t)256 * DFE * 2; S.estep = (size_t)D * DFE * 2; S.bstep = (size_t)256 * DFE * 2;
        pg8::EpiBf16 E{(bf16*)(ws + WS_OUTG), D}; pg8::gemm_phase(F.lds, 0, DFE, DFE, S, E); }
}
__device__ __forceinline__ void phase_moe_combine(const Frame& F, ArgsP kargs, bool last) {
    LOCAL_IDS; FRESH(a); unsigned char* ws = a->ws; float* X = a->out; const bf16* OUTG = (const bf16*)(ws + WS_OUTG); const int* POS = (const int*)(ws + WS_POS); const float* TOPW = (const float*)(ws + WS_TOPW);
    bf16* XB = (bf16*)(ws + WS_XB); float* RX = (float*)(ws + WS_RX); const float* g_final = a->g_final;
    int s0n = POS[(size_t)gw * 2], s1n = POS[(size_t)gw * 2 + 1]; float w0n = TOPW[(size_t)gw * 2], w1n = TOPW[(size_t)gw * 2 + 1];
#pragma unroll 1
    for (int m = gw; m < M; m += F.NGW) {
        const int s0 = s0n, s1 = s1n; const float w0 = w0n, w1 = w1n;
        { const int mn = m + F.NGW < M ? m + F.NGW : m; s0n = POS[(size_t)mn * 2]; s1n = POS[(size_t)mn * 2 + 1]; w0n = TOPW[(size_t)mn * 2]; w1n = TOPW[(size_t)mn * 2 + 1]; }
        f32x4 v[4]; float s = 0.f;
#pragma unroll
        for (int j = 0; j < 4; ++j) { const u32x2 p0 = ((const u32x2*)(OUTG + (size_t)s0 * D) + lane)[64 * j], p1 = ((const u32x2*)(OUTG + (size_t)s1 * D) + lane)[64 * j];
            const f32x4 o0 = {bflo(p0.x), bfhi(p0.x), bflo(p0.y), bfhi(p0.y)}, o1 = {bflo(p1.x), bfhi(p1.x), bflo(p1.y), bfhi(p1.y)};
            v[j] = ((const f32x4*)(X + (size_t)m * D) + lane)[64 * j] + w0 * o0 + w1 * o1; s += sumsq4(v[j]); }
        const float r = __builtin_amdgcn_rsqf(wave_sum(s) * (1.f / D) + EPS);
        if (last) {
#pragma unroll
            for (int j = 0; j < 4; ++j) ((f32x4*)(X + (size_t)m * D) + lane)[64 * j] = v[j] * r * ((const f32x4*)g_final + lane)[64 * j];
        } else {
#pragma unroll
            for (int j = 0; j < 4; ++j) { ((f32x4*)(X + (size_t)m * D) + lane)[64 * j] = v[j]; ((u32x2*)(XB + (size_t)m * D) + lane)[64 * j] = (u32x2){cvt_pk_bf16(v[j][0], v[j][1]), cvt_pk_bf16(v[j][2], v[j][3])}; }
            if (lane == 0) RX[m] = r;
        }
    }
}


#ifdef DBG_ENABLE
__device__ __forceinline__ float dbg_b(const unsigned char* ws, size_t off, size_t idx) { return bf2f(((const bf16*)(ws + off))[idx]); }
__device__ __forceinline__ void dbg_dump(const Frame& F, ArgsP kargs, int code) {
    LOCAL_IDS; FRESH(a); const unsigned char* ws = a->ws; float* out = a->out;
    unsigned tmo = ((const unsigned*)(ws + WS_CTL))[CW_BAR + XB_TMO];
    for (size_t i = (size_t)F.bid * 512 + tid; i < (size_t)M * D; i += (size_t)F.G * 512) { const size_t row = i >> 10, c = i & 1023; float v = 0.f;
        if (code == 1) v = dbg_b(ws, WS_CQ, row * 512 + (c & 511)) + dbg_b(ws, WS_CKV, row * 256 + (c & 255)) + dbg_b(ws, WS_U, row * 512 + (c & 511)) + dbg_b(ws, WS_VR, row * 512 + (c & 511)) + dbg_b(ws, WS_QX, row * 512 + (c & 511))
                         + dbg_b(ws, WS_GATE, row * 3072 + c) + dbg_b(ws, WS_GATE, row * 3072 + 1024 + c) + dbg_b(ws, WS_GATE, row * 3072 + 2048 + c) + dbg_b(ws, WS_KR, row * 32 + (c & 31));
        else if (code == 2) v = dbg_b(ws, WS_Q, row * 768 + (c % 768)) + dbg_b(ws, WS_KN, row * 512 + (c & 511)) + dbg_b(ws, WS_V, row * 512 + (c & 511)) + dbg_b(ws, WS_Y, row * 1536 + 512 + c);
        else if (code == 3) v = dbg_b(ws, WS_Y, row * 1536 + (c & 511));
        else if (code == 15) v = dbg_b(ws, WS_WINT, i % ((size_t)PPAD * D));
        else if (code == 13 || code == 14) v = dbg_b(ws, WS_GATE, row * 3072 + c) + dbg_b(ws, WS_GATE, row * 3072 + 1024 + c) + dbg_b(ws, WS_GATE, row * 3072 + 2048 + c);
        else if (code == 4) v = dbg_b(ws, WS_MIXB, row * 1024 + c);
        else if (code == 6) v = dbg_b(ws, WS_HFF, row * 2688 + c) + dbg_b(ws, WS_HFF, row * 2688 + 1024 + c) + dbg_b(ws, WS_HFF, row * 2688 + 1664 + c);
        else if (code == 9) { const int s0 = ((const int*)(ws + WS_POS))[row * 2], s1 = ((const int*)(ws + WS_POS))[row * 2 + 1]; v = dbg_b(ws, WS_XG, (size_t)s0 * 1024 + c) + 2.f * dbg_b(ws, WS_XG, (size_t)s1 * 1024 + c) + ((const float*)(ws + WS_TOPW))[row * 2] + (float)s0 * 1e-3f; }
        else if (code == 10) { const int s0 = ((const int*)(ws + WS_POS))[row * 2], s1 = ((const int*)(ws + WS_POS))[row * 2 + 1]; v = dbg_b(ws, WS_HG, (size_t)s0 * 3584 + c) + dbg_b(ws, WS_HG, (size_t)s1 * 3584 + 2560 + c) + dbg_b(ws, WS_HG, (size_t)s0 * 3584 + 1500 + c); }
        else if (code == 11) { const int s0 = ((const int*)(ws + WS_POS))[row * 2], s1 = ((const int*)(ws + WS_POS))[row * 2 + 1]; v = ((const float*)(ws + WS_OUTG))[(size_t)s0 * 1024 + c] + ((const float*)(ws + WS_OUTG))[(size_t)s1 * 1024 + c]; }
        else continue;
        if (tmo) v = __builtin_nanf("");
        out[i] = v; }
}
#define DBG(code) do { if (dbgc == (code)) { dbg_dump(F, kargs, code); return; } } while (0)
#else
#define DBG(code) do { } while (0)
#endif

__global__ void __launch_bounds__(NWAVES * 64, 2) fwd_kernel(Args args_by_value) {
    extern __shared__ __attribute__((aligned(16))) unsigned char lds_raw[];
    const ArgsP kargs = (ArgsP)__builtin_amdgcn_kernarg_segment_ptr();
    Frame F; F.lds = (LAS unsigned char*)lds_raw; F.G = gridDim.x; F.bid = blockIdx.x; F.NGW = F.G * NWAVES;
    for (int u = threadIdx.x; u < (LDS_BYTES - LDSCTL_OFF) / 4; u += NWAVES * 64) ((LAS unsigned*)(F.lds + LDSCTL_OFF))[u] = 0u;
    __syncthreads();
    volatile LAS unsigned* MISC = (volatile LAS unsigned*)(F.lds + MISC_OFF);
    XcdBarrier bar; { FRESH(a); bar = xcd_barrier_post((unsigned*)(a->ws + WS_CTL) + CW_BAR, MISC + 8); }
#define GRID_BAR() xcd_barrier(bar)

#ifdef ONLY_TEST
    ONLY_TEST; GRID_BAR(); return;
#endif
    const Frame F_ = F;
    int dbgc; { FRESH(a); dbgc = a->dbg; } (void)dbgc;
    phase_prologue(F, kargs); GRID_BAR();
#pragma unroll 1
    for (int l_ = 0; l_ < DEPTH; ++l_) {
        Frame F = F_; int l = l_; asm volatile("" : "+s"(F.G), "+s"(F.NGW), "+s"(F.bid), "+s"(l));
        const bool moe = (l & 1) != 0; const int j2 = l >> 1;
        if (l == 0) DBG(15);
#ifdef PROBE_INPROJ2
        { int reps = 2; asm volatile("" : "+s"(reps));
#pragma unroll 1
          for (int rep = 0; rep < reps; ++rep) { phase_inproj(F, kargs, l); GRID_BAR(); } }
#else
        phase_inproj(F, kargs, l); GRID_BAR(); if (l == 0) DBG(1); if (l == 0) DBG(14);
#endif
        phase_up(F, kargs, l); GRID_BAR(); if (l == 0) DBG(2);
        phase_attn(F, kargs, l); GRID_BAR(); if (l == 0) DBG(3); if (l == 0) DBG(13);
#ifdef PROBE_ATTN2
        phase_attn(F, kargs, l); GRID_BAR();
#endif
#ifdef PROBE_UP2
        phase_up(F, kargs, l); GRID_BAR();
#endif
        phase_branch(F, kargs); GRID_BAR(); if (l == 0) DBG(4);
#ifdef PROBE_RESID2
        { int reps = 2; asm volatile("" : "+s"(reps));
#pragma unroll 1
          for (int rep = reps - 1; rep >= 0; --rep) { phase_outproj(F, kargs, rep != 0); GRID_BAR(); } }
#else
        phase_outproj(F, kargs); GRID_BAR(); if (l == 0) DBG(5); if (l == 1) DBG(8);
#endif
        if (!moe) {
            phase_dense_conv(F, kargs, l, j2); GRID_BAR();
            phase_dense_up(F, kargs); GRID_BAR(); if (l == 0) DBG(6);
#ifdef PROBE_DENSE2
            phase_dense_up(F, kargs); GRID_BAR();
#endif
#ifdef PROBE_RESID2
            { int reps = 2; asm volatile("" : "+s"(reps));
#pragma unroll 1
              for (int rep = reps - 1; rep >= 0; --rep) { phase_dense_down(F, kargs, rep != 0); GRID_BAR(); } }
#else
            phase_dense_down(F, kargs); GRID_BAR(); if (l == 0) DBG(7);
#endif
        } else {
            phase_moe_route(F, kargs, l, j2); GRID_BAR();
            phase_moe_gather(F, kargs); GRID_BAR(); if (l == 1) DBG(9);
#ifdef PROBE_AUX2
            phase_moe_gather(F, kargs); GRID_BAR();
#endif
            phase_moe_up(F, kargs); GRID_BAR(); if (l == 1) DBG(10);
            phase_moe_down(F, kargs); GRID_BAR(); if (l == 1) DBG(11);
#ifdef PROBE_MOE2
            phase_moe_up(F, kargs); GRID_BAR();
            phase_moe_down(F, kargs); GRID_BAR();
#endif
            phase_moe_combine(F, kargs, l == DEPTH - 1);
            if (l != DEPTH - 1) GRID_BAR();
            if (l == 1) DBG(12);
        }
    }
}

extern "C" void kernel_launch(void* const* d_in, const int* in_sizes, int n_in, void* d_out, int out_size, void* d_ws, size_t ws_size, hipStream_t stream) {
    static int grid = 0;
    if (grid == 0) {
        if (n_in != 27 || in_sizes[0] != M * D || out_size != M * D || ws_size < WS_END) { fprintf(stderr, "kernel_launch: unexpected shapes (n_in %d, in0 %d, out %d, ws %zu)\n", n_in, n_in > 0 ? in_sizes[0] : -1, out_size, ws_size); grid = -1; return; }
        int dev = 0, cus = 0, per_cu = 0;
        if (hipGetDevice(&dev) != hipSuccess || hipDeviceGetAttribute(&cus, hipDeviceAttributeMultiprocessorCount, dev) != hipSuccess) { grid = -1; return; }
        if (hipFuncSetAttribute((const void*)fwd_kernel, hipFuncAttributeMaxDynamicSharedMemorySize, LDS_BYTES) != hipSuccess) { fprintf(stderr, "kernel_launch: hipFuncSetAttribute failed\n"); grid = -1; return; }
        if (hipOccupancyMaxActiveBlocksPerMultiprocessor(&per_cu, (const void*)fwd_kernel, NWAVES * 64, LDS_BYTES) != hipSuccess || per_cu < 1) { fprintf(stderr, "kernel_launch: occupancy query reports %d\n", per_cu); }
        (void)hipGetLastError();
        if (cus != 256) { fprintf(stderr, "kernel_launch: built for 256 CUs, device has %d\n", cus); grid = -1; return; }
        grid = 256;
    }
    if (grid < 0) return;
    if (hipMemsetAsync((char*)d_ws + WS_CTL, 0, CTL_ZERO_BYTES, stream) != hipSuccess) return;
    Args a{};
    a.x = (const float*)d_in[0]; a.mem = (const float*)d_in[1]; a.positions = (const int*)d_in[2]; a.g_mix = (const float*)d_in[3]; a.w_in = (const float*)d_in[4]; a.g_q = (const float*)d_in[5];
    a.g_kv = (const float*)d_in[6]; a.w_uq = (const float*)d_in[7]; a.w_uk = (const float*)d_in[8]; a.w_uv = (const float*)d_in[9]; a.g_sg = (const float*)d_in[10]; a.w_s = (const float*)d_in[11];
    a.b_s = (const float*)d_in[12]; a.g_mem = (const float*)d_in[13]; a.w_mkv = (const float*)d_in[14]; a.w_br = (const float*)d_in[15]; a.b_gate = (const float*)d_in[16]; a.w_out = (const float*)d_in[17];
    a.g_ffn = (const float*)d_in[18]; a.dense_w1 = (const float*)d_in[19]; a.dense_w3 = (const float*)d_in[20]; a.dense_w2 = (const float*)d_in[21]; a.w_router = (const float*)d_in[22];
    a.moe_w1 = (const float*)d_in[23]; a.moe_w3 = (const float*)d_in[24]; a.moe_w2 = (const float*)d_in[25]; a.g_final = (const float*)d_in[26];
    a.out = (float*)d_out; a.ws = (unsigned char*)d_ws;
#ifdef DBG_STOP
    a.dbg = DBG_STOP;
#endif
    hipLaunchKernelGGL(fwd_kernel, dim3(grid), dim3(NWAVES * 64), LDS_BYTES, stream, a);
    const hipError_t le = hipPeekAtLastError();
    if (le != hipSuccess) fprintf(stderr, "kernel_launch: launch failed: %s\n", hipGetErrorName(le));
}
```

```cpp
#include <hip/hip_runtime.h>
#include <cstdio>
#include <cstdint>

#ifndef PH_MASK
#define PH_MASK 0xffffffffu
#endif
#define PH(k) ((PH_MASK >> (k)) & 1u)
#define LAS __attribute__((address_space(3)))
#define GAS __attribute__((address_space(1)))
typedef unsigned short bf16;
typedef short bf16x8 __attribute__((ext_vector_type(8)));
typedef short s16x4 __attribute__((ext_vector_type(4)));
typedef float f32x4 __attribute__((ext_vector_type(4)));
typedef float f32x2 __attribute__((ext_vector_type(2)));
typedef float f32x16 __attribute__((ext_vector_type(16)));
typedef unsigned u32x4 __attribute__((ext_vector_type(4)));
typedef unsigned u32x2 __attribute__((ext_vector_type(2)));
typedef int i32x4 __attribute__((ext_vector_type(4)));

constexpr int M = 16384, D = 1024, DEPTH = 4, NMEM = 256;
constexpr int QRANK = 384, KVRANK = 256, NH = 8, QKD = 96, VD = 64;
constexpr int XH = 4, XD = 128, BW = 512;
constexpr int PTOT = 5280, PPAD = 5376, DFF = 2688, NE = 8, DFE = 3584;
constexpr float EPS = 1e-6f;
constexpr int MAXSLOT = 34816;
constexpr float LOG2E = 1.4426950408889634f;
constexpr float QSCALE = 0.10206207261596575f * LOG2E;
constexpr float XSCALE = 0.08838834764831845f * LOG2E;

constexpr size_t MiB = 1u << 20, KiB = 1u << 10;
constexpr size_t WS_CTL = 0, CTL_ZERO_BYTES = 1 * MiB;
constexpr size_t WS_ROPE = 2 * MiB;
constexpr size_t WS_XSTAT = 4 * MiB;
constexpr size_t WS_RX = 5 * MiB;
constexpr size_t WS_CQSTAT = 5 * MiB + 256 * KiB;
constexpr size_t WS_CKVSTAT = 5 * MiB + 768 * KiB;
constexpr size_t WS_VSTAT = 6 * MiB;
constexpr size_t WS_MEMB = 6 * MiB + 512 * KiB;
constexpr size_t WS_KVMEM = 7 * MiB;
constexpr size_t WS_TOPI = 9 * MiB;
constexpr size_t WS_TOPW = 9 * MiB + 256 * KiB;
constexpr size_t WS_LRANK = 9 * MiB + 512 * KiB;
constexpr size_t WS_POS = 9 * MiB + 768 * KiB;
constexpr size_t WS_BLKCNT = 10 * MiB;
constexpr size_t WS_SLOTR = 10 * MiB + 512 * KiB;
constexpr size_t WS_WSB = 11 * MiB;
constexpr size_t WS_WMKVT = 12 * MiB;
constexpr size_t WS_WINT = 20 * MiB;
constexpr size_t WS_WUQT = 31 * MiB;
constexpr size_t WS_WUKVT = 32 * MiB;
constexpr size_t WS_WBRT = 33 * MiB;
constexpr size_t WS_WOUTT = 36 * MiB;
constexpr size_t WS_WFFN = 40 * MiB;
constexpr size_t WS_W2D = WS_WFFN + 11 * MiB;
constexpr size_t WS_W2M = WS_WFFN + 112 * MiB;
constexpr size_t WS_XB = 208 * MiB;
constexpr size_t WS_CQ = 240 * MiB;
constexpr size_t WS_CKV = 256 * MiB;
constexpr size_t WS_U = 264 * MiB;
constexpr size_t WS_VR = 280 * MiB;
constexpr size_t WS_QX = 296 * MiB;
constexpr size_t WS_GATE = 312 * MiB;
constexpr size_t WS_Q = 408 * MiB;
constexpr size_t WS_KN = 432 * MiB;
constexpr size_t WS_KR = 448 * MiB;
constexpr size_t WS_V = 450 * MiB;
constexpr size_t WS_Y = 466 * MiB;
constexpr size_t WS_MIX = 514 * MiB;
constexpr size_t WS_MIXB = 578 * MiB;
constexpr size_t WS_MIX1 = 610 * MiB;
constexpr size_t WS_HFF = 240 * MiB;
constexpr size_t WS_XG = 240 * MiB;
constexpr size_t WS_HG = 308 * MiB;
constexpr size_t WS_OUTG = 546 * MiB;
constexpr size_t WS_END = 682 * MiB;
constexpr int CW_TMO = 0, CW_CODE = 1, CW_CHK = 2, CW_BAR = 4096;
constexpr int CW_SK = 16384;
constexpr size_t WS_SKPART = 700 * MiB;
constexpr int CW_KMAX = 8192;

constexpr int RING_BYTES = 131072, LDSCTL_OFF = 159744, MISC_OFF = LDSCTL_OFF + 320, LDS_BYTES = 163840;
constexpr int NWAVES = 8;

#define RLX_AGENT __ATOMIC_RELAXED, __HIP_MEMORY_SCOPE_AGENT
#define LDS_WAIT() asm volatile("s_waitcnt lgkmcnt(0)" ::: "memory")
#define VM_WAIT() asm volatile("s_waitcnt vmcnt(0)" ::: "memory")
typedef __bf16 bf16x2_t __attribute__((ext_vector_type(2)));
__device__ __forceinline__ unsigned cvt_pk_bf16(float lo, float hi) { const f32x2 v = {lo, hi}; const bf16x2_t b = __builtin_convertvector(v, bf16x2_t); return __builtin_bit_cast(unsigned, b); }
__device__ __forceinline__ bf16 f2bf(float f) { return (bf16)(cvt_pk_bf16(f, 0.f) & 0xffffu); }
__device__ __forceinline__ float bf2f(bf16 v) { return __uint_as_float((unsigned)v << 16); }
__device__ __forceinline__ float bflo(unsigned w) { return __uint_as_float(w << 16); }
__device__ __forceinline__ float bfhi(unsigned w) { return __uint_as_float(w & 0xffff0000u); }
__device__ __forceinline__ float fast_exp2(float x) { return __builtin_amdgcn_exp2f(x); }
__device__ __forceinline__ float fast_rcp(float x) { return __builtin_amdgcn_rcpf(x); }
__device__ __forceinline__ float sigmoidf_(float z) { return fast_rcp(1.f + fast_exp2(-LOG2E * z)); }
__device__ __forceinline__ float gelu_tanh(float x) { const float t = x + 0.044715f * x * x * x; return x * fast_rcp(1.f + fast_exp2(-2.f * 0.7978845608028654f * LOG2E * t)); }
__device__ __forceinline__ float wave_sum(float v) {
#pragma unroll
    for (int o = 1; o < 64; o <<= 1) v += __shfl_xor(v, o);
    return v;
}
__device__ __forceinline__ float sumsq4(f32x4 v) { return (v[0] * v[0] + v[1] * v[1]) + (v[2] * v[2] + v[3] * v[3]); }
__device__ __forceinline__ u32x2 pack8_u8(f32x4 a, f32x4 b) { unsigned w0 = 0, w1 = 0; a = a * 255.f; b = b * 255.f;
    w0 = __builtin_amdgcn_cvt_pk_u8_f32(a[0], 0, w0); w0 = __builtin_amdgcn_cvt_pk_u8_f32(a[1], 1, w0); w0 = __builtin_amdgcn_cvt_pk_u8_f32(a[2], 2, w0); w0 = __builtin_amdgcn_cvt_pk_u8_f32(a[3], 3, w0);
    w1 = __builtin_amdgcn_cvt_pk_u8_f32(b[0], 0, w1); w1 = __builtin_amdgcn_cvt_pk_u8_f32(b[1], 1, w1); w1 = __builtin_amdgcn_cvt_pk_u8_f32(b[2], 2, w1); w1 = __builtin_amdgcn_cvt_pk_u8_f32(b[3], 3, w1);
    return (u32x2){w0, w1}; }
__device__ __forceinline__ void unpack8_u8(u32x2 w, f32x4& a, f32x4& b) { constexpr float k = 1.f / 255.f;
    a = (f32x4){(float)(w.x & 255u), (float)((w.x >> 8) & 255u), (float)((w.x >> 16) & 255u), (float)(w.x >> 24)} * k;
    b = (f32x4){(float)(w.y & 255u), (float)((w.y >> 8) & 255u), (float)((w.y >> 16) & 255u), (float)(w.y >> 24)} * k; }
__device__ __forceinline__ u32x4 pack8(f32x4 a, f32x4 b) { u32x4 w; w.x = cvt_pk_bf16(a[0], a[1]); w.y = cvt_pk_bf16(a[2], a[3]); w.z = cvt_pk_bf16(b[0], b[1]); w.w = cvt_pk_bf16(b[2], b[3]); return w; }
__device__ __forceinline__ void unpack8(u32x4 w, f32x4& a, f32x4& b) { a = (f32x4){bflo(w.x), bfhi(w.x), bflo(w.y), bfhi(w.y)}; b = (f32x4){bflo(w.z), bfhi(w.z), bflo(w.w), bfhi(w.w)}; }

namespace pg8 {
constexpr int BM = 256, BK = 64, HALF = 128, HTB = HALF * BK * 2, STAGE_BYTES = 8 * HTB, NXCD = 8, WGM = 8;
__host__ __device__ __forceinline__ int lds_byte(int r, int c) { const int st = (r >> 4) * 2 + (c >> 5), rr = r & 15, cc = c & 31, ob = rr * 64 + cc * 2; return st * 1024 + (ob ^ (((ob >> 9) & 1) << 5)); }
__host__ __device__ __forceinline__ void stage_rc(int b, int& R, int& C) { const int st = b / 1024, sb = b % 1024, swz = sb ^ (((sb >> 9) & 1) << 5); R = (st >> 1) * 16 + swz / 64; C = (st & 1) * 32 + (swz % 64) / 2; }
__host__ __device__ __forceinline__ int perm32(int rho) { const int n = rho >> 4, i = rho & 15; return 8 * (i >> 2) + 4 * n + (i & 3); }

struct Unit { const char* A; const char* B; int pm, pn, aux, nt; };
typedef f32x4 Acc[2][2][4][2];

__device__ __forceinline__ void tile_of(int L, int nM, int nN, int& pm, int& pn) {
    const int nwg = nM * nN; int wgid = L;
    { const int q = nwg / NXCD, r = nwg % NXCD, xcd = wgid % NXCD, off = wgid / NXCD; wgid = (xcd < r ? xcd * (q + 1) : r * (q + 1) + (xcd - r) * q) + off; }
    const int nig = WGM * nN, gid = wgid / nig, fm = gid * WGM, gsz = (nM - fm) < WGM ? (nM - fm) : WGM;
    pm = fm + ((wgid % nig) % gsz); pn = (wgid % nig) / gsz;
}
struct TileOrder {
    enum { VARK = 0 };
    int nM, nN, G, c; const char* A; const char* B; size_t astep, bstep;
    int rev = 0;
    __device__ __forceinline__ bool next(int i, Unit& u) const {
        if (rev) { const int cnt = (nM * nN - c + G - 1) / G; if (i >= cnt) return false; i = cnt - 1 - i; }
        const long L = (long)i * G + c; if (L >= (long)nM * nN) return false;
        int pm, pn; tile_of((int)L, nM, nN, pm, pn);
        u.pm = pm; u.pn = pn; u.aux = 0; u.A = A + (size_t)pm * astep; u.B = B + (size_t)pn * bstep; return true;
    }
};

template <class Epi, class Sched>
__device__ __forceinline__ void gemm_phase(LAS unsigned char* lds, const int lda, const int ldb, const int K, const Sched& S, const Epi& E) {
    int tid_ = threadIdx.x; asm volatile("" : "+v"(tid_));
    const int tid = tid_, wid = __builtin_amdgcn_readfirstlane(tid >> 6), lane = tid & 63, wr = wid >> 2, wc = wid & 3, fr = lane & 15, fq = lane >> 4;
    int nt = K / BK;
    unsigned voffA[2], voffB[2];
#pragma unroll
    for (int i = 0; i < 2; ++i) { int R, C; stage_rc(tid * 16 + i * 8192, R, C); const int Rb = (R & ~31) + perm32(R & 31);
        voffA[i] = (unsigned)(R * (lda ? lda : BK) + C) * 2u; voffB[i] = (unsigned)(Rb * BK + C) * 2u; }
    const size_t kstep = lda ? (size_t)(BK * 2) : (size_t)BM * BK * 2;
    const size_t hstepA = (size_t)HALF * (lda ? lda : BK) * 2, hstepB = (size_t)HALF * BK * 2, kstepB = (size_t)BM * BK * 2; (void)ldb;
    const unsigned ldsw = (unsigned)wid * 1024u;
    const int aoff = lds_byte(wr * 64 + fr, fq * 8), boff = lds_byte(wc * 32 + fr, fq * 8);
#define PG8_SA(b, h) (((b) * 2 + (h)) * HTB)
#define PG8_SB(b, h) ((4 + (b) * 2 + (h)) * HTB)
#define PG8_STAGE(bufoff, gbase, voff) do { _Pragma("unroll") for (int _i = 0; _i < 2; ++_i) \
        __builtin_amdgcn_global_load_lds((const unsigned*)((const char*)(gbase) + (voff)[_i]), (LAS unsigned*)(lds + (bufoff) + ldsw + _i * 8192), 16, 0, 0); } while (0)
#define PG8_LDA(dst, b, h) do { _Pragma("unroll") for (int m = 0; m < 4; ++m) _Pragma("unroll") for (int k = 0; k < 2; ++k) dst[m][k] = *(const LAS bf16x8*)(lds + PG8_SA(b, h) + aoff + m * 2048 + k * 1024); } while (0)
#define PG8_LDB(dst, b, h) do { _Pragma("unroll") for (int n = 0; n < 2; ++n) _Pragma("unroll") for (int k = 0; k < 2; ++k) dst[n][k] = *(const LAS bf16x8*)(lds + PG8_SB(b, h) + boff + n * 2048 + k * 1024); } while (0)
#define PG8_MMA(ai, bj, At, Bt) do { __builtin_amdgcn_s_setprio(1); _Pragma("unroll") for (int m = 0; m < 4; ++m) _Pragma("unroll") for (int n = 0; n < 2; ++n) _Pragma("unroll") for (int k = 0; k < 2; ++k) \
        acc[ai][bj][m][n] = __builtin_amdgcn_mfma_f32_16x16x32_bf16(Bt[n][k], At[m][k], acc[ai][bj][m][n], 0, 0, 0); __builtin_amdgcn_s_setprio(0); } while (0)
#define PG8_WAIT_V(n) asm volatile("s_waitcnt vmcnt(" #n ")" ::: "memory")
#define PG8_WAIT_L(n) asm volatile("s_waitcnt lgkmcnt(" #n ")" ::: "memory")
#define PG8_BAR __builtin_amdgcn_s_barrier()
#define PG8_SCHED __builtin_amdgcn_sched_barrier(0)
    Unit cur, nxt; int ui = 0;
    if (!S.next(0, cur)) return;
    if constexpr (Sched::VARK) nt = cur.nt;
    typename Epi::Pre pre = E.prefetch(cur, wr, fr);
    Acc acc;
#pragma unroll
    for (int a = 0; a < 2; ++a)
#pragma unroll
        for (int b = 0; b < 2; ++b)
#pragma unroll
            for (int m = 0; m < 4; ++m)
#pragma unroll
                for (int n = 0; n < 2; ++n) acc[a][b][m][n] = (f32x4){0.f, 0.f, 0.f, 0.f};
    bf16x8 At[4][2], B0[2][2], B1[2][2];
    const char* cA = cur.A; const char* cB = cur.B;
    PG8_STAGE(PG8_SB(0, 0), cB, voffB); PG8_STAGE(PG8_SB(0, 1), cB + hstepB, voffB); PG8_STAGE(PG8_SA(0, 0), cA, voffA); PG8_STAGE(PG8_SA(0, 1), cA + hstepA, voffA);
    if (wr == 1) PG8_BAR;
    PG8_WAIT_V(2); PG8_BAR;
    PG8_STAGE(PG8_SB(1, 0), cB + kstepB, voffB); PG8_STAGE(PG8_SA(1, 0), cA + kstep, voffA); PG8_STAGE(PG8_SB(1, 1), cB + hstepB + kstepB, voffB);
    PG8_WAIT_V(6); PG8_BAR;
    for (;;) {
        const bool has_next = S.next(ui + 1, nxt);
        const char* nA = has_next ? nxt.A : cA; const char* nB = has_next ? nxt.B : cB;
        for (int t = 0; t < nt; t += 2) {
            const bool last = (t == nt - 2);
            const char* a1 = cA + (size_t)(t + 1) * kstep;
            const char* a2 = last ? nA : cA + (size_t)(t + 2) * kstep; const char* b2 = last ? nB : cB + (size_t)(t + 2) * kstepB;
            const char* a3 = a2 + kstep; const char* b3 = b2 + kstepB;
            PG8_LDB(B0, 0, 0); PG8_LDB(B1, 0, 1); PG8_SCHED; PG8_LDA(At, 0, 0); PG8_STAGE(PG8_SA(1, 1), a1 + hstepA, voffA);
            PG8_WAIT_V(8); PG8_WAIT_L(0); PG8_BAR; PG8_MMA(0, 0, At, B0); PG8_MMA(0, 1, At, B1); PG8_BAR; PG8_SCHED;
            PG8_LDA(At, 0, 1); PG8_STAGE(PG8_SB(0, 0), b2, voffB); PG8_STAGE(PG8_SB(0, 1), b2 + hstepB, voffB); PG8_STAGE(PG8_SA(0, 0), a2, voffA);
            PG8_WAIT_V(8); PG8_WAIT_L(0); PG8_BAR; PG8_MMA(1, 0, At, B0); PG8_MMA(1, 1, At, B1); PG8_BAR; PG8_SCHED;
            PG8_LDB(B0, 1, 0); PG8_LDB(B1, 1, 1); PG8_SCHED; PG8_LDA(At, 1, 0); PG8_STAGE(PG8_SA(0, 1), a2 + hstepA, voffA);
            PG8_WAIT_V(8); PG8_WAIT_L(0); PG8_BAR; PG8_MMA(0, 0, At, B0); PG8_MMA(0, 1, At, B1); PG8_BAR; PG8_SCHED;
            PG8_LDA(At, 1, 1); PG8_STAGE(PG8_SB(1, 0), b3, voffB); PG8_STAGE(PG8_SB(1, 1), b3 + hstepB, voffB); PG8_STAGE(PG8_SA(1, 0), a3, voffA);
            PG8_WAIT_V(8); PG8_WAIT_L(0); PG8_BAR; PG8_MMA(1, 0, At, B0); PG8_MMA(1, 1, At, B1); PG8_BAR; PG8_SCHED;
        }
        if (wr == 0) PG8_BAR;
        E(acc, cur, wr, wc, fr, fq, pre);
        if (!has_next) break;
        pre = E.prefetch(nxt, wr, fr);
        if constexpr (!Epi::KEEP_ACC)
#pragma unroll
        for (int a = 0; a < 2; ++a)
#pragma unroll
            for (int b = 0; b < 2; ++b)
#pragma unroll
                for (int m = 0; m < 4; ++m)
#pragma unroll
                    for (int n = 0; n < 2; ++n) acc[a][b][m][n] = (f32x4){0.f, 0.f, 0.f, 0.f};
        cur = nxt; cA = nA; cB = nB; ++ui;
        if constexpr (Sched::VARK) nt = cur.nt;
        if (wr == 1) PG8_BAR;
    }
    PG8_WAIT_V(0);
    PG8_BAR;
#undef PG8_SA
#undef PG8_SB
#undef PG8_STAGE
#undef PG8_LDA
#undef PG8_LDB
#undef PG8_MMA
#undef PG8_WAIT_V
#undef PG8_WAIT_L
#undef PG8_BAR
#undef PG8_SCHED
}

#define EPI_FOR _Pragma("unroll") for (int ai = 0; ai < 2; ++ai) _Pragma("unroll") for (int m = 0; m < 4; ++m)
#define EPI_ROW (u.pm * BM + ai * HALF + wr * 64 + m * 16 + fr)
#define EPI_C8(bj) (u.pn * BM + (bj) * HALF + wc * 32 + 8 * fq)
#define EPI_LOAD_R(rr, ptr) float rr[2][4]; _Pragma("unroll") for (int ai = 0; ai < 2; ++ai) _Pragma("unroll") for (int m = 0; m < 4; ++m) rr[ai][m] = (ptr)[EPI_ROW]; asm volatile("" ::: "memory")

#define EPI_LOAD_RS(rr, xstat) float rr[2][4]; { f32x4 st_[2][4]; _Pragma("unroll") for (int ai = 0; ai < 2; ++ai) _Pragma("unroll") for (int m = 0; m < 4; ++m) st_[ai][m] = *(const f32x4*)((xstat) + (size_t)EPI_ROW * 16 + 4 * fq); \
    asm volatile("" ::: "memory"); _Pragma("unroll") for (int ai = 0; ai < 2; ++ai) _Pragma("unroll") for (int m = 0; m < 4; ++m) { float t_ = (st_[ai][m][0] + st_[ai][m][1]) + (st_[ai][m][2] + st_[ai][m][3]); \
        t_ += __shfl_xor(t_, 16); t_ += __shfl_xor(t_, 32); rr[ai][m] = __builtin_amdgcn_rsqf(t_ * (1.f / D) + EPS); } }
struct NoPre {};
#define EPI_NOPRE static constexpr bool KEEP_ACC = false; typedef NoPre Pre; __device__ __forceinline__ Pre prefetch(const Unit&, int, int) const { return Pre{}; }
struct RowPre { float r[2][4]; };
struct EpiInProj {
    unsigned char* ws; const float* bgate; int layer; int from_stats;
    static constexpr bool KEEP_ACC = false; typedef RowPre Pre;
    __device__ __forceinline__ Pre prefetch(const Unit& u, int wr, int fr) const { Pre p; const float* rx = (const float*)(ws + WS_RX);
#pragma unroll
        for (int ai = 0; ai < 2; ++ai)
#pragma unroll
            for (int m = 0; m < 4; ++m) p.r[ai][m] = from_stats ? 0.f : rx[EPI_ROW];
        return p; }
    __device__ __forceinline__ void operator()(const Acc& acc, const Unit& u, int wr, int wc, int fr, int fq, const Pre& pre) const {
        const float* rx = (const float*)(ws + WS_RX); const float* rope = (const float*)(ws + WS_ROPE);
        bf16* CQ = (bf16*)(ws + WS_CQ); bf16* KR = (bf16*)(ws + WS_KR); bf16* CKV = (bf16*)(ws + WS_CKV); bf16* U = (bf16*)(ws + WS_U); bf16* VR = (bf16*)(ws + WS_VR); bf16* QX = (bf16*)(ws + WS_QX); bf16* GATE = (bf16*)(ws + WS_GATE);
        float* cqstat = (float*)(ws + WS_CQSTAT); float* ckvstat = (float*)(ws + WS_CKVSTAT); float* vstat = (float*)(ws + WS_VSTAT); unsigned* kmax = (unsigned*)(ws + WS_CTL) + CW_KMAX + layer * 32;
        const int pn = u.pn;
        float rr[2][4];
        if (from_stats) { EPI_LOAD_RS(rs_, (const float*)(ws + WS_XSTAT));
#pragma unroll
            for (int ai = 0; ai < 2; ++ai)
#pragma unroll
                for (int m = 0; m < 4; ++m) rr[ai][m] = rs_[ai][m]; }
        else {
#pragma unroll
            for (int ai = 0; ai < 2; ++ai)
#pragma unroll
                for (int m = 0; m < 4; ++m) rr[ai][m] = pre.r[ai][m]; }
        if (pn < 2) {
            float krmax = 0.f;
            EPI_FOR { const int row = EPI_ROW;
                const float r = rr[ai][m]; float ss = 0.f;
#pragma unroll
                for (int bj = 0; bj < 2; ++bj) { const f32x4 v0 = acc[ai][bj][m][0] * r, v1 = acc[ai][bj][m][1] * r;
                    if (!(pn == 1 && bj == 1)) ss += sumsq4(v0) + sumsq4(v1);
                    *(u32x4*)(CQ + (size_t)row * 512 + pn * 256 + bj * HALF + wc * 32 + 8 * fq) = pack8(v0, v1);
                    if (pn == 1 && bj == 1 && wc == 0) {
                        const f32x4 c = *(const f32x4*)(rope + (size_t)row * 32 + 4 * fq), s = *(const f32x4*)(rope + (size_t)row * 32 + 16 + 4 * fq);
                        const f32x4 o0 = v0 * c - v1 * s, o1 = v0 * s + v1 * c;
                        *(u32x4*)(KR + (size_t)row * 32 + 8 * fq) = pack8(o0, o1);
                        float q2 = sumsq4(o0) + sumsq4(o1); q2 += __shfl_xor(q2, 16); q2 += __shfl_xor(q2, 32); krmax = fmaxf(krmax, q2); } }
                ss += __shfl_xor(ss, 16); ss += __shfl_xor(ss, 32);
                if (fq == 0) cqstat[(size_t)row * 8 + pn * 4 + wc] = ss;
            }
            if (pn == 1 && wc == 0) {
#pragma unroll
                for (int o = 1; o < 16; o <<= 1) krmax = fmaxf(krmax, __shfl_xor(krmax, o));
                if ((fr | fq) == 0) atomicMax(kmax + 16, __float_as_uint(krmax)); }
        } else if (pn == 2) {
            EPI_FOR { const int row = EPI_ROW;
                const float r = rr[ai][m]; float ss = 0.f;
#pragma unroll
                for (int bj = 0; bj < 2; ++bj) { const f32x4 v0 = acc[ai][bj][m][0] * r, v1 = acc[ai][bj][m][1] * r; ss += sumsq4(v0) + sumsq4(v1);
                    *(u32x4*)(CKV + (size_t)row * 256 + bj * HALF + wc * 32 + 8 * fq) = pack8(v0, v1); }
                ss += __shfl_xor(ss, 16); ss += __shfl_xor(ss, 32);
                if (fq == 0) ckvstat[(size_t)row * 4 + wc] = ss;
            }
        } else if (pn < 7) {
            const bool isv = pn >= 5; bf16* dst = isv ? VR : U; const int t = isv ? pn - 5 : pn - 3;
            EPI_FOR { const int row = EPI_ROW;
                const float r = rr[ai][m]; float ss = 0.f;
#pragma unroll
                for (int bj = 0; bj < 2; ++bj) { f32x4 v0 = acc[ai][bj][m][0] * r, v1 = acc[ai][bj][m][1] * r;
#pragma unroll
                    for (int e = 0; e < 4; ++e) { v0[e] = gelu_tanh(v0[e]); v1[e] = gelu_tanh(v1[e]); }
                    ss += sumsq4(v0) + sumsq4(v1);
                    *(u32x4*)(dst + (size_t)row * 512 + t * 256 + bj * HALF + wc * 32 + 8 * fq) = pack8(v0, v1); }
                if (isv) { ss += __shfl_xor(ss, 16); ss += __shfl_xor(ss, 32); if (fq == 0) vstat[(size_t)row * 8 + t * 4 + wc] = ss; }
            }
        } else if (pn < 9) {
            EPI_FOR { const int row = EPI_ROW;
                const float r = rr[ai][m];
#pragma unroll
                for (int bj = 0; bj < 2; ++bj) *(u32x4*)(QX + (size_t)row * 512 + (pn - 7) * 256 + bj * HALF + wc * 32 + 8 * fq) = pack8(acc[ai][bj][m][0] * r, acc[ai][bj][m][1] * r);
            }
        } else {
            const int gc0 = (pn - 9) * 256 + wc * 32 + 8 * fq;
            f32x4 bg[2][2];
#pragma unroll
            for (int bj = 0; bj < 2; ++bj) { bg[bj][0] = *(const f32x4*)(bgate + gc0 + bj * HALF); bg[bj][1] = *(const f32x4*)(bgate + gc0 + bj * HALF + 4); }
            EPI_FOR { const int row = EPI_ROW;
                const float r = rr[ai][m];
#pragma unroll
                for (int bj = 0; bj < 2; ++bj) { f32x4 v0 = acc[ai][bj][m][0] * r + bg[bj][0], v1 = acc[ai][bj][m][1] * r + bg[bj][1];
#pragma unroll
                    for (int e = 0; e < 4; ++e) { v0[e] = sigmoidf_(v0[e]); v1[e] = sigmoidf_(v1[e]); }
#ifdef DBG_CONSTGATE
                    v0 = acc[ai][bj][m][0] * r; v1 = acc[ai][bj][m][1] * r;
#endif
                    *(u32x2*)((unsigned char*)GATE + (size_t)row * 3072 + gc0 + bj * HALF) = pack8_u8(v0, v1); }
            }
        }
    }
};
struct EpiMemKV {
    bf16* KV;
    EPI_NOPRE
    __device__ __forceinline__ void operator()(const Acc& acc, const Unit& u, int wr, int wc, int fr, int fq, const Pre&) const {
        EPI_FOR { const int row = EPI_ROW;
#pragma unroll
            for (int bj = 0; bj < 2; ++bj) *(u32x4*)(KV + (size_t)u.aux * 256 * 1024 + (size_t)row * 1024 + EPI_C8(bj)) = pack8(acc[ai][bj][m][0], acc[ai][bj][m][1]);
        }
    }
};
struct EpiQ {
    const float* cqstat; const float* rope; bf16* Q;
    EPI_NOPRE
    __device__ __forceinline__ void operator()(const Acc& acc, const Unit& u, int wr, int wc, int fr, int fq, const Pre&) const {
        EPI_FOR { const int row = EPI_ROW;
            const f32x4 s0 = *(const f32x4*)(cqstat + (size_t)row * 8), s1 = *(const f32x4*)(cqstat + (size_t)row * 8 + 4);
            const float r = __builtin_amdgcn_rsqf(((s0[0] + s0[1]) + (s0[2] + s0[3]) + (s1[0] + s1[1]) + (s1[2] + s1[3])) * (1.f / QRANK) + EPS);
#pragma unroll
            for (int bj = 0; bj < 2; ++bj) { f32x4 v0 = acc[ai][bj][m][0] * r, v1 = acc[ai][bj][m][1] * r;
                if (((8 * u.pn + 4 * bj + wc) % 3) == 2) {
                    const f32x4 c = *(const f32x4*)(rope + (size_t)row * 32 + 4 * fq), s = *(const f32x4*)(rope + (size_t)row * 32 + 16 + 4 * fq);
                    const f32x4 o0 = v0 * c - v1 * s, o1 = v0 * s + v1 * c; v0 = o0; v1 = o1; }
                *(u32x4*)(Q + (size_t)row * 768 + EPI_C8(bj)) = pack8(v0, v1); }
        }
    }
};
struct EpiKV {
    const float* ckvstat; bf16* KN; bf16* V; unsigned* kmax;
    EPI_NOPRE
    __device__ __forceinline__ void operator()(const Acc& acc, const Unit& u, int wr, int wc, int fr, int fq, const Pre&) const {
        bf16* dst = u.pn < 2 ? KN : V; const int t = u.pn & 1; float hm[2] = {0.f, 0.f};
        EPI_FOR { const int row = EPI_ROW;
            const f32x4 s0 = *(const f32x4*)(ckvstat + (size_t)row * 4);
            const float r = __builtin_amdgcn_rsqf(((s0[0] + s0[1]) + (s0[2] + s0[3])) * (1.f / KVRANK) + EPS);
#pragma unroll
            for (int bj = 0; bj < 2; ++bj) { const f32x4 v0 = acc[ai][bj][m][0] * r, v1 = acc[ai][bj][m][1] * r;
                *(u32x4*)(dst + (size_t)row * 512 + t * 256 + bj * HALF + wc * 32 + 8 * fq) = pack8(v0, v1);
                float q2 = sumsq4(v0) + sumsq4(v1); q2 += __shfl_xor(q2, 16); q2 += __shfl_xor(q2, 32); hm[bj] = fmaxf(hm[bj], q2); }
        }
        if (u.pn < 2) {
#pragma unroll
            for (int bj = 0; bj < 2; ++bj) { float v = hm[bj];
#pragma unroll
                for (int o = 1; o < 16; o <<= 1) v = fmaxf(v, __shfl_xor(v, o));
                if ((fr | fq) == 0) atomicMax(kmax + 2 * (4 * u.pn + 2 * bj + (wc >> 1)) + (wc & 1), __float_as_uint(v)); }
        }
    }
};
struct EpiBranch {
    const unsigned char* GATE; bf16* MIXB;
    static constexpr bool KEEP_ACC = true; typedef NoPre Pre; __device__ __forceinline__ Pre prefetch(const Unit&, int, int) const { return Pre{}; }
    __device__ __forceinline__ void operator()(Acc& acc, const Unit& u, int wr, int wc, int fr, int fq, const Pre&) const {
        const int n = u.aux;
#pragma unroll
        for (int ai = 0; ai < 2; ++ai) {
            u32x2 gw[4][2], gn[4][2];
#pragma unroll
            for (int m = 0; m < 4; ++m)
#pragma unroll
                for (int bj = 0; bj < 2; ++bj) { const unsigned char* gp = GATE + (size_t)EPI_ROW * 3072 + n * 1024 + EPI_C8(bj);
                    gw[m][bj] = *(const u32x2*)gp; if (n < 2) gn[m][bj] = *(const u32x2*)(gp + 1024); }
            asm volatile("" ::: "memory");
#pragma unroll
            for (int m = 0; m < 4; ++m)
#pragma unroll
                for (int bj = 0; bj < 2; ++bj) {
                    f32x4 g0, g1; unpack8_u8(gw[m][bj], g0, g1);
#pragma unroll
                    for (int e = 0; e < 4; ++e) { g0[e] = fmaxf(g0[e], 0.001953125f); g1[e] = fmaxf(g1[e], 0.001953125f); }
                    if (n < 2) { f32x4 h0, h1; unpack8_u8(gn[m][bj], h0, h1);
#pragma unroll
                        for (int e = 0; e < 4; ++e) { g0[e] *= fast_rcp(fmaxf(h0[e], 0.001953125f)); g1[e] *= fast_rcp(fmaxf(h1[e], 0.001953125f)); }
                        acc[ai][bj][m][0] *= g0; acc[ai][bj][m][1] *= g1; }
                    else *(u32x4*)(MIXB + (size_t)u.pm * 256 * 1024 + (size_t)(4 * u.pn + 2 * bj + (wc >> 1)) * 16384 + (ai * HALF + wr * 64 + m * 16 + fr) * 64 + (wc & 1) * 32 + 8 * fq) = pack8(acc[ai][bj][m][0] * g0, acc[ai][bj][m][1] * g1);
                }
        }
        if (n == 2) {
#pragma unroll
            for (int ai = 0; ai < 2; ++ai)
#pragma unroll
                for (int bj = 0; bj < 2; ++bj)
#pragma unroll
                    for (int m = 0; m < 4; ++m) { acc[ai][bj][m][0] = (f32x4){0.f, 0.f, 0.f, 0.f}; acc[ai][bj][m][1] = (f32x4){0.f, 0.f, 0.f, 0.f}; }
        }
    }
};
struct EpiResid {
    const float* X; float* Xo; bf16* XB; float* xstat;
    EPI_NOPRE
    __device__ __forceinline__ void operator()(const Acc& acc, const Unit& u, int wr, int wc, int fr, int fq, const Pre&) const {
#pragma unroll
        for (int ai = 0; ai < 2; ++ai) {
            f32x4 xv[4][2][2];
#pragma unroll
            for (int m = 0; m < 4; ++m)
#pragma unroll
                for (int bj = 0; bj < 2; ++bj) { const float* xp = X + (size_t)EPI_ROW * 1024 + EPI_C8(bj); xv[m][bj][0] = *(const f32x4*)xp; xv[m][bj][1] = *(const f32x4*)(xp + 4); }
            asm volatile("" ::: "memory");
#pragma unroll
            for (int m = 0; m < 4; ++m) { const int row = EPI_ROW; float ss = 0.f;
#pragma unroll
                for (int bj = 0; bj < 2; ++bj) { const int col = EPI_C8(bj); float* xp = Xo + (size_t)row * 1024 + col;
                    const f32x4 v0 = xv[m][bj][0] + acc[ai][bj][m][0], v1 = xv[m][bj][1] + acc[ai][bj][m][1];
                    *(f32x4*)xp = v0; *(f32x4*)(xp + 4) = v1; ss += sumsq4(v0) + sumsq4(v1);
                    *(u32x4*)(XB + (size_t)row * 1024 + col) = pack8(v0, v1); }
                ss += __shfl_xor(ss, 16); ss += __shfl_xor(ss, 32);
                if (fq == 0) xstat[(size_t)row * 16 + u.pn * 4 + wc] = ss; }
        }
    }
};
struct EpiSwiGLU {
    const float* rs; bf16* Hh; int ldh; int from_stats;
    static constexpr bool KEEP_ACC = false; typedef RowPre Pre;
    __device__ __forceinline__ Pre prefetch(const Unit& u, int wr, int fr) const { Pre p;
#pragma unroll
        for (int ai = 0; ai < 2; ++ai)
#pragma unroll
            for (int m = 0; m < 4; ++m) p.r[ai][m] = from_stats ? 0.f : rs[EPI_ROW];
        return p; }
    __device__ __forceinline__ void operator()(const Acc& acc, const Unit& u, int wr, int wc, int fr, int fq, const Pre& pre) const {
        float rr[2][4];
        if (from_stats) { EPI_LOAD_RS(rs_, rs);
#pragma unroll
            for (int ai = 0; ai < 2; ++ai)
#pragma unroll
                for (int m = 0; m < 4; ++m) rr[ai][m] = rs_[ai][m]; }
        else {
#pragma unroll
            for (int ai = 0; ai < 2; ++ai)
#pragma unroll
                for (int m = 0; m < 4; ++m) rr[ai][m] = pre.r[ai][m]; }
        bf16* hbase = Hh + (size_t)u.pm * 256 * ldh + (size_t)(2 * u.pn + (wc >> 1)) * 16384 + (wr * 64 + fr) * 64 + (wc & 1) * 32 + 8 * fq;
        EPI_FOR { const int row = EPI_ROW;
            const float r = rr[ai][m];
            f32x4 a0 = acc[ai][0][m][0] * r, a1 = acc[ai][0][m][1] * r; const f32x4 b0 = acc[ai][1][m][0] * r, b1 = acc[ai][1][m][1] * r;
#pragma unroll
            for (int e = 0; e < 4; ++e) { a0[e] = a0[e] * sigmoidf_(a0[e]) * b0[e]; a1[e] = a1[e] * sigmoidf_(a1[e]) * b1[e]; }
            (void)row; *(u32x4*)(hbase + (ai * HALF + m * 16) * 64) = pack8(a0, a1);
        }
    }
};
struct EpiBf16 {
    bf16* C; int ldc;
    EPI_NOPRE
    __device__ __forceinline__ void operator()(const Acc& acc, const Unit& u, int wr, int wc, int fr, int fq, const Pre&) const {
        EPI_FOR { const int row = EPI_ROW;
#pragma unroll
            for (int bj = 0; bj < 2; ++bj) *(u32x4*)(C + (size_t)row * ldc + EPI_C8(bj)) = pack8(acc[ai][bj][m][0], acc[ai][bj][m][1]);
        }
    }
};
template <int CC>
__device__ __forceinline__ void ks_reduce(const float* part, int x, int r, int k, int tid, bf16* C, int ldc, const Unit& u, int wr, int wc, int fr, int fq) {
    for (int sp = k; sp < 16; sp += CC) { const int ai = sp >> 3, bj = (sp >> 2) & 1, m = sp & 3;
        f32x4 v0[CC], v1[CC];
#pragma unroll
        for (int kk = 0; kk < CC; ++kk) { const float* q = part + (size_t)(x + 8 * (r * CC + kk)) * 65536 + tid * 4 + sp * 4096; v0[kk] = *(const f32x4*)q; v1[kk] = *(const f32x4*)(q + 2048); }
        f32x4 s0 = v0[0], s1 = v1[0];
#pragma unroll
        for (int kk = 1; kk < CC; ++kk) { s0 += v0[kk]; s1 += v1[kk]; }
        const int row = u.pm * BM + ai * HALF + wr * 64 + m * 16 + fr;
        *(u32x4*)(C + (size_t)row * ldc + u.pn * BM + bj * HALF + wc * 32 + 8 * fq) = pack8(s0, s1); }
}
struct EpiBf16KS {
    bf16* C; int ldc; float* part; unsigned* cnt; int c;
    EPI_NOPRE
    __device__ __forceinline__ void operator()(const Acc& acc, const Unit& u, int wr, int wc, int fr, int fq, const Pre&) const {
        if (((u.aux >> 4) & 3) != 0) {
            int tid_ = threadIdx.x; asm volatile("" : "+v"(tid_));
            const int k = (u.aux >> 8) & 255, CC = (u.aux >> 16) & 255, r = u.aux >> 24, x = c & 7;
            float* p = part + (size_t)c * 65536 + tid_ * 4;
#pragma unroll
            for (int ai = 0; ai < 2; ++ai)
#pragma unroll
                for (int bj = 0; bj < 2; ++bj)
#pragma unroll
                    for (int m = 0; m < 4; ++m)
#pragma unroll
                        for (int n = 0; n < 2; ++n) *(f32x4*)(p + (((ai * 2 + bj) * 4 + m) * 2 + n) * 2048) = acc[ai][bj][m][n];
            __threadfence();
            __syncthreads();
            if (tid_ == 0) { unsigned* w = cnt + x + 8 * r; __hip_atomic_fetch_add(w, 1u, __ATOMIC_RELEASE, __HIP_MEMORY_SCOPE_AGENT);
                while (__hip_atomic_load(w, __ATOMIC_ACQUIRE, __HIP_MEMORY_SCOPE_AGENT) < (unsigned)CC) __builtin_amdgcn_s_sleep(2); }
            __syncthreads(); __builtin_amdgcn_fence(__ATOMIC_ACQUIRE, "agent");
            if (CC == 4) ks_reduce<4>(part, x, r, k, tid_, C, ldc, u, wr, wc, fr, fq);
            else ks_reduce<2>(part, x, r, k, tid_, C, ldc, u, wr, wc, fr, fq);
            return;
        }
        EPI_FOR { const int row = EPI_ROW;
#pragma unroll
            for (int bj = 0; bj < 2; ++bj) *(u32x4*)(C + (size_t)row * ldc + EPI_C8(bj)) = pack8(acc[ai][bj][m][0], acc[ai][bj][m][1]);
        }
    }
};
struct EpiF32 {
    float* C; int ldc;
    EPI_NOPRE
    __device__ __forceinline__ void operator()(const Acc& acc, const Unit& u, int wr, int wc, int fr, int fq, const Pre&) const {
        EPI_FOR { const int row = EPI_ROW;
#pragma unroll
            for (int bj = 0; bj < 2; ++bj) { float* cp = C + (size_t)row * ldc + EPI_C8(bj); *(f32x4*)cp = acc[ai][bj][m][0]; *(f32x4*)(cp + 4) = acc[ai][bj][m][1]; }
        }
    }
};
}

namespace att {
#define KSWZ(row, colB) ((row) * 256 + ((colB) ^ (((row) & 7) << 4)))
#define SBAR() __builtin_amdgcn_sched_barrier(0)
constexpr float THR = 8.f;
__device__ __forceinline__ int crow(int r, int hi) { return (r & 3) + 8 * (r >> 2) + 4 * hi; }
template <int NB> __device__ __forceinline__ int v_st(int k, int c) { const int kk = (k & ~0xC) | ((k & 4) << 1) | ((k & 8) >> 1); return ((kk >> 3) * NB + (c >> 5)) * 512 + ((kk & 7) * 32 + (c & 31)) * 2; }
__device__ __forceinline__ int v_rd_base(int lane) { return ((lane & 3) << 3) | (((lane >> 2) & 3) << 6) | (((lane >> 4) & 1) << 5) | (((lane >> 5) & 1) << 8); }
template <int OFF> __device__ __forceinline__ s16x4 tr_read(int vb) { s16x4 r; asm volatile("ds_read_b64_tr_b16 %0, %1 offset:%2" : "=&v"(r) : "v"(vb), "i"(OFF) : "memory"); return r; }

__device__ __forceinline__ void partialSM(f32x16& p0, f32x16& p1, float& m_reg, float& alpha) {
    float pmax = p0[0];
#pragma unroll
    for (int r = 1; r < 16; ++r) pmax = fmaxf(pmax, p0[r]);
#pragma unroll
    for (int r = 0; r < 16; ++r) pmax = fmaxf(pmax, p1[r]);
    { auto rr = __builtin_amdgcn_permlane32_swap(__float_as_uint(pmax), __float_as_uint(pmax), false, false); pmax = fmaxf(__uint_as_float(rr[0]), __uint_as_float(rr[1])); }
    float mn;
    if (__builtin_expect(__all(pmax - m_reg <= THR), 1)) { mn = m_reg; alpha = 1.f; }
    else { mn = fmaxf(m_reg, pmax); alpha = __builtin_amdgcn_exp2f(m_reg - mn); m_reg = mn; }
#pragma unroll
    for (int r = 0; r < 16; ++r) { p0[r] -= mn; p1[r] -= mn; }
#pragma unroll
    for (int r = 0; r < 16; ++r) p0[r] = __builtin_amdgcn_exp2f(p0[r]);
}
__device__ __forceinline__ void finishSM(f32x16& p0, f32x16& p1, float alpha, float& l_reg, bf16x8& pa0, bf16x8& pa1, bf16x8& pa2, bf16x8& pa3) {
#pragma unroll
    for (int r = 0; r < 16; ++r) p1[r] = __builtin_amdgcn_exp2f(p1[r]);
    float ps = 0;
#pragma unroll
    for (int r = 0; r < 16; ++r) ps += p0[r];
#pragma unroll
    for (int r = 0; r < 16; ++r) ps += p1[r];
    { auto rr = __builtin_amdgcn_permlane32_swap(__float_as_uint(ps), __float_as_uint(ps), false, false); ps = __uint_as_float(rr[0]) + __uint_as_float(rr[1]); }
    l_reg = l_reg * alpha + ps;
#define PK4(P, BASE, OUT) do { unsigned a0 = cvt_pk_bf16(P[BASE + 0], P[BASE + 1]), a1 = cvt_pk_bf16(P[BASE + 2], P[BASE + 3]);   \
    unsigned b0 = cvt_pk_bf16(P[BASE + 4], P[BASE + 5]), b1 = cvt_pk_bf16(P[BASE + 6], P[BASE + 7]);                              \
    auto r0 = __builtin_amdgcn_permlane32_swap(a0, b0, false, false); auto r1 = __builtin_amdgcn_permlane32_swap(a1, b1, false, false); \
    u32x4 w = {r0[0], r1[0], r0[1], r1[1]}; OUT = __builtin_bit_cast(bf16x8, w); } while (0)
    PK4(p0, 0, pa0); PK4(p0, 8, pa1); PK4(p1, 0, pa2); PK4(p1, 8, pa3);
#undef PK4
}
template <int ND0> __device__ __forceinline__ void qkt(f32x16& p0, f32x16& p1, const LAS char* Ks, const bf16x8* qr, int r32, int hi, const f32x16& init) {
#pragma unroll
    for (int d0 = 0; d0 < ND0; ++d0) { const int cb = (d0 * 16 + hi * 8) * 2;
        const bf16x8 b0 = *(const LAS bf16x8*)(Ks + KSWZ(r32, cb));
        const bf16x8 b1 = *(const LAS bf16x8*)(Ks + KSWZ(32 + r32, cb));
        p0 = __builtin_amdgcn_mfma_f32_32x32x16_bf16(b0, qr[d0], d0 == 0 ? init : p0, 0, 0, 0);
        p1 = __builtin_amdgcn_mfma_f32_32x32x16_bf16(b1, qr[d0], d0 == 0 ? init : p1, 0, 0, 0); }
}
__device__ __forceinline__ void expA(f32x16& p0) {
#pragma unroll
    for (int r = 0; r < 16; ++r) p0[r] = __builtin_amdgcn_exp2f(p0[r]);
}
template <int NB, int D0> __device__ __forceinline__ void pv_one(f32x16& od, int vb, bf16x8 pa0, bf16x8 pa1, bf16x8 pa2, bf16x8 pa3) {
    const s16x4 l0 = tr_read<(0 * NB + D0) * 512>(vb), h0 = tr_read<(1 * NB + D0) * 512>(vb), l1 = tr_read<(2 * NB + D0) * 512>(vb), h1 = tr_read<(3 * NB + D0) * 512>(vb);
    const s16x4 l2 = tr_read<(4 * NB + D0) * 512>(vb), h2 = tr_read<(5 * NB + D0) * 512>(vb), l3 = tr_read<(6 * NB + D0) * 512>(vb), h3 = tr_read<(7 * NB + D0) * 512>(vb);
    asm volatile("s_waitcnt lgkmcnt(0)" ::: "memory"); SBAR();
#define PK(L, H) (bf16x8){L[0], L[1], L[2], L[3], H[0], H[1], H[2], H[3]}
    od = __builtin_amdgcn_mfma_f32_32x32x16_bf16(pa0, PK(l0, h0), od, 0, 0, 0);
    od = __builtin_amdgcn_mfma_f32_32x32x16_bf16(pa1, PK(l1, h1), od, 0, 0, 0);
    od = __builtin_amdgcn_mfma_f32_32x32x16_bf16(pa2, PK(l2, h2), od, 0, 0, 0);
    od = __builtin_amdgcn_mfma_f32_32x32x16_bf16(pa3, PK(l3, h3), od, 0, 0, 0);
#undef PK
}
template <int NB> __device__ __forceinline__ void pv_all(f32x16* o, int vb, bf16x8 pa0, bf16x8 pa1, bf16x8 pa2, bf16x8 pa3) {
    pv_one<NB, 0>(o[0], vb, pa0, pa1, pa2, pa3); pv_one<NB, 1>(o[1], vb, pa0, pa1, pa2, pa3);
    if constexpr (NB == 4) { pv_one<NB, 2>(o[2], vb, pa0, pa1, pa2, pa3); pv_one<NB, 3>(o[3], vb, pa0, pa1, pa2, pa3); }
}

template <int DQK, int D1, int DVV, bool FIXM>
__device__ __forceinline__ void attn_unit(const bf16* __restrict__ Qb, int ldq, const bf16* __restrict__ K1, int ldk1, const bf16* __restrict__ K2, int ldk2,
                                          const bf16* __restrict__ Vh, int ldv, bf16* __restrict__ Ob, int ldo, int seq, LAS char* lds, float kbound) {
    constexpr int ND0 = DQK / 16, NB = DVV / 32, CK = DQK / 8, CV = DVV / 8;
    constexpr int NKL = (64 * CK + 511) / 512, NVL = (64 * CV) / 512;
    constexpr int SHM_V = 64 * DVV * 2, SHM_K = 64 * 256;
    int tid_ = threadIdx.x; asm volatile("" : "+v"(tid_));
    const int tid = tid_, wid = tid >> 6, lane = tid & 63, r32 = lane & 31, hi = lane >> 5;
    LAS char* V_lds = lds; LAS char* K_lds = lds + 2 * SHM_V;
    LAS float* ws = (LAS float*)(lds + 2 * SHM_V + 2 * SHM_K) + wid * 64; LAS float* li_l = ws; LAS float* al_l = ws + 32;
    float m_reg = -1e30f, l_reg = 0; f32x16 o[NB]; bf16x8 qr[ND0];
#pragma unroll
    for (int d = 0; d < NB; ++d) o[d] = f32x16{};
    const bf16* Qw = Qb + (long)(wid * 32 + r32) * ldq + hi * 8;
#pragma unroll
    for (int d0 = 0; d0 < ND0; ++d0) qr[d0] = *(const bf16x8*)(Qw + d0 * 16);
    f32x16 init = f32x16{};
    if constexpr (FIXM) {
        float q2 = 0.f;
#pragma unroll
        for (int d0 = 0; d0 < ND0; ++d0) { const u32x4 w = __builtin_bit_cast(u32x4, qr[d0]); f32x4 a, b; unpack8(w, a, b); q2 += sumsq4(a) + sumsq4(b); }
        { auto rr = __builtin_amdgcn_permlane32_swap(__float_as_uint(q2), __float_as_uint(q2), false, false); q2 = __uint_as_float(rr[0]) + __uint_as_float(rr[1]); }
        const float nm = -sqrtf(q2) * kbound;
#pragma unroll
        for (int r = 0; r < 16; ++r) init[r] = nm;
        asm volatile("" : "+v"(init));
    }
    const bf16* kp[NKL]; int kstr[NKL], kdst[NKL]; bool kval[NKL];
#pragma unroll
    for (int i = 0; i < NKL; ++i) { const int c = tid + 512 * i; kval[i] = c < 64 * CK; const int cc_ = kval[i] ? c : 0; const int row = cc_ / CK, cc = cc_ % CK;
        if (cc * 8 < D1) { kp[i] = K1 + (long)row * ldk1 + cc * 8; kstr[i] = 64 * ldk1; } else { kp[i] = K2 + (long)row * ldk2 + (cc * 8 - D1); kstr[i] = 64 * ldk2; }
        kdst[i] = KSWZ(row, cc * 16); }
    const bf16* vp[NVL]; int vdst[NVL]; const int vstr = 64 * ldv;
#pragma unroll
    for (int i = 0; i < NVL; ++i) { const int c = tid + 512 * i; const int row = c / CV, cc = c % CV; vp[i] = Vh + (long)row * ldv + cc * 8; vdst[i] = v_st<NB>(row, cc * 8); }
    const int vb0 = (int)(uintptr_t)V_lds + v_rd_base(lane);
    struct { bf16x8 ks[NKL]; bf16x8 vs[NVL]; } sr_[2];
#define SLOAD(i, t) do { _Pragma("unroll") for (int q_ = 0; q_ < NVL; ++q_) sr_[i].vs[q_] = *(const bf16x8*)(vp[q_] + (long)(t) * vstr); \
    _Pragma("unroll") for (int q_ = 0; q_ < NKL; ++q_) { if (kval[q_]) sr_[i].ks[q_] = *(const bf16x8*)(kp[q_] + (long)(t) * kstr[q_]); } } while (0)
#define SWRITE(b, i) do { _Pragma("unroll") for (int q_ = 0; q_ < NVL; ++q_) *(LAS bf16x8*)(V_lds + (b) * SHM_V + vdst[q_]) = sr_[i].vs[q_]; \
    _Pragma("unroll") for (int q_ = 0; q_ < NKL; ++q_) { if (kval[q_]) *(LAS bf16x8*)(K_lds + (b) * SHM_K + kdst[q_]) = sr_[i].ks[q_]; } } while (0)
#define SWAIT() asm volatile("s_waitcnt vmcnt(%0)" :: "n"(NKL + NVL) : "memory")
#define RESC(a) do { if (__any((a) < 1.f)) { if (hi == 0) al_l[r32] = (a); asm volatile("s_waitcnt lgkmcnt(0)" ::: "memory"); \
    _Pragma("unroll") for (int d = 0; d < NB; ++d) _Pragma("unroll") for (int r = 0; r < 16; ++r) o[d][r] *= al_l[crow(r, hi)]; } } while (0)
    f32x16 pA0, pA1, pB0, pB1; float alA = 1.f, alB = 1.f; bf16x8 pa0, pa1, pa2, pa3; const int NT = seq / 64;
#define PSM(P0, P1, AL) do { if constexpr (FIXM) expA(P0); else partialSM(P0, P1, m_reg, AL); } while (0)
#define RSC(AL) do { if constexpr (!FIXM) RESC(AL); } while (0)
    SLOAD(0, 0); asm volatile("s_waitcnt vmcnt(0)" ::: "memory"); SWRITE(0, 0); __syncthreads();
    qkt<ND0>(pA0, pA1, K_lds, qr, r32, hi, init); PSM(pA0, pA1, alA);
    SLOAD(1, 1); if (2 < NT) SLOAD(0, 2);
    SWAIT(); SWRITE(1, 1); __syncthreads();
    for (int j = 1; j + 1 < NT; j += 2) {
        SBAR(); qkt<ND0>(pB0, pB1, K_lds + SHM_K, qr, r32, hi, init);
        finishSM(pA0, pA1, alA, l_reg, pa0, pa1, pa2, pa3); SBAR();
        SLOAD(1, j + 2); SBAR();
        pv_all<NB>(o, vb0, pa0, pa1, pa2, pa3); PSM(pB0, pB1, alB);
        __syncthreads(); SWAIT(); SWRITE(0, 0);
        RSC(alB); __syncthreads();
        SBAR(); qkt<ND0>(pA0, pA1, K_lds, qr, r32, hi, init);
        finishSM(pB0, pB1, alB, l_reg, pa0, pa1, pa2, pa3); SBAR();
        if (j + 3 < NT) SLOAD(0, j + 3); SBAR();
        pv_all<NB>(o, vb0 + SHM_V, pa0, pa1, pa2, pa3); PSM(pA0, pA1, alA);
        __syncthreads(); SWAIT(); SWRITE(1, 1);
        RSC(alA); __syncthreads();
    }
    SBAR(); qkt<ND0>(pB0, pB1, K_lds + SHM_K, qr, r32, hi, init);
    finishSM(pA0, pA1, alA, l_reg, pa0, pa1, pa2, pa3); SBAR();
    pv_all<NB>(o, vb0, pa0, pa1, pa2, pa3); PSM(pB0, pB1, alB);
    __syncthreads(); RSC(alB);
    finishSM(pB0, pB1, alB, l_reg, pa0, pa1, pa2, pa3); SBAR();
    pv_all<NB>(o, vb0 + SHM_V, pa0, pa1, pa2, pa3);
#undef PSM
#undef RSC
    if (hi == 0) li_l[r32] = l_reg; asm volatile("s_waitcnt lgkmcnt(0)" ::: "memory");
    float rli[16];
#pragma unroll
    for (int r = 0; r < 16; ++r) rli[r] = __builtin_amdgcn_rcpf(li_l[crow(r, hi)]);
    bf16* Ow = Ob + (long)(wid * 32) * ldo;
#pragma unroll
    for (int r = 0; r < 16; ++r) { const int orow = crow(r, hi);
#pragma unroll
        for (int d0 = 0; d0 < NB; ++d0) Ow[(long)orow * ldo + d0 * 32 + r32] = f2bf(o[d0][r] * rli[r]); }
    __syncthreads();
#undef SLOAD
#undef SWRITE
#undef SWAIT
#undef RESC
}

#define EXP4(P, B) do { P[B] = __builtin_amdgcn_exp2f(P[B]); P[B + 1] = __builtin_amdgcn_exp2f(P[B + 1]); P[B + 2] = __builtin_amdgcn_exp2f(P[B + 2]); P[B + 3] = __builtin_amdgcn_exp2f(P[B + 3]); } while (0)
#define SUM4(S, P, B) do { S += (P[B] + P[B + 1]) + (P[B + 2] + P[B + 3]); } while (0)
#define PK4X(P, BASE, OUT) do { const u32x4 w_ = {cvt_pk_bf16(P[BASE + 0], P[BASE + 1]), cvt_pk_bf16(P[BASE + 2], P[BASE + 3]), cvt_pk_bf16(P[BASE + 4], P[BASE + 5]), cvt_pk_bf16(P[BASE + 6], P[BASE + 7])}; OUT = __builtin_bit_cast(bf16x8, w_); } while (0)
typedef short v4i16_t __attribute__((ext_vector_type(4)));
__device__ __forceinline__ s16x4 vtr(const LAS char* p) { return __builtin_bit_cast(s16x4, __builtin_amdgcn_ds_read_tr16_b64_v4i16((LAS v4i16_t*)p)); }
#define KSWZ2(row, colB) ((row) * 256 + ((colB) ^ (((row) & 15) << 4)))
template <int DQK, int D1, int DVV>
__device__ __forceinline__ void attn_unit2(const bf16* __restrict__ Qb, int ldq, const bf16* __restrict__ K1, int ldk1, const bf16* __restrict__ K2, int ldk2,
                                           const bf16* __restrict__ Vh, int ldv, bf16* __restrict__ Ob, int ldo, int seq, LAS char* lds, float kbound) {
    constexpr int ND0 = DQK / 16, NB = DVV / 32, CK = DQK / 8;
    constexpr int SHM_V = 64 * DVV * 2, SHM_K = 64 * 256;
    static_assert(NB == 2 && ND0 == 6, "written for QK dim 96 / V dim 64");
    int tid_ = threadIdx.x; asm volatile("" : "+v"(tid_));
    const int tid = tid_, wid = __builtin_amdgcn_readfirstlane(tid >> 6), lane = tid & 63, r32 = lane & 31, hi = lane >> 5;
    LAS char* V_lds = lds; LAS char* K_lds = lds + 3 * SHM_V;
    LAS float* ws = (LAS float*)(lds + 3 * SHM_V + 2 * SHM_K) + wid * 64;
    LAS char* QAL = lds + 3 * SHM_V + 2 * SHM_K + 2048 + wid * (2 * ND0 * 1024) + lane * 16; LAS char* QBL = QAL + ND0 * 1024;
    float nm;
    { bf16x8 qa[ND0], qb[ND0];
      const bf16* QwA = Qb + (long)(wid * 64 + r32) * ldq + hi * 8; const bf16* QwB = QwA + (long)32 * ldq;
#pragma unroll
      for (int d0 = 0; d0 < ND0; ++d0) { qa[d0] = *(const bf16x8*)(QwA + d0 * 16); qb[d0] = *(const bf16x8*)(QwB + d0 * 16); }
      float q2a = 0.f, q2b = 0.f;
#pragma unroll
      for (int d0 = 0; d0 < ND0; ++d0) { f32x4 a, b; unpack8(__builtin_bit_cast(u32x4, qa[d0]), a, b); q2a += sumsq4(a) + sumsq4(b); unpack8(__builtin_bit_cast(u32x4, qb[d0]), a, b); q2b += sumsq4(a) + sumsq4(b);
          *(LAS bf16x8*)(QAL + d0 * 1024) = qa[d0]; *(LAS bf16x8*)(QBL + d0 * 1024) = qb[d0]; }
      { auto rr = __builtin_amdgcn_permlane32_swap(__float_as_uint(q2a), __float_as_uint(q2a), false, false); q2a = __uint_as_float(rr[0]) + __uint_as_float(rr[1]); }
      { auto rr = __builtin_amdgcn_permlane32_swap(__float_as_uint(q2b), __float_as_uint(q2b), false, false); q2b = __uint_as_float(rr[0]) + __uint_as_float(rr[1]); }
      nm = -sqrtf(fmaxf(q2a, q2b)) * kbound; }
    const bf16* kp[2]; int kstr[2];
#pragma unroll
    for (int i = 0; i < 2; ++i) { const int row = 8 * wid + 4 * i + (lane >> 4), cc = (lane & 15) ^ (row & 15);
        if (cc >= 8 && cc < CK) { kp[i] = K2 + (long)row * ldk2 + (cc * 8 - D1); kstr[i] = 64 * ldk2; } else { kp[i] = K1 + (long)row * ldk1 + (cc < 8 ? cc * 8 : 0); kstr[i] = 64 * ldk1; } }
    const bf16* vp; { const int k = 8 * wid + ((lane & 31) >> 2); vp = Vh + (long)k * ldv + (lane >> 5) * 32 + (lane & 3) * 8; }
    const int vstr = 64 * ldv;
    const LAS char* vrd0 = V_lds + v_rd_base(lane);
#define DMA2(t, kb, vbuf) do { \
    __builtin_amdgcn_global_load_lds((const unsigned*)(kp[0] + (long)(t) * kstr[0]), (LAS unsigned*)(K_lds + (kb) * SHM_K + wid * 2048), 16, 0, 0); \
    __builtin_amdgcn_global_load_lds((const unsigned*)(kp[1] + (long)(t) * kstr[1]), (LAS unsigned*)(K_lds + (kb) * SHM_K + wid * 2048 + 1024), 16, 0, 0); \
    __builtin_amdgcn_global_load_lds((const unsigned*)(vp + (long)(t) * vstr), (LAS unsigned*)(V_lds + (vbuf) * SHM_V + wid * 1024), 16, 0, 0); } while (0)
#define VRD8(arr, base, D0) do { _Pragma("unroll") for (int j_ = 0; j_ < 8; ++j_) arr[j_] = vtr((base) + (j_ * NB + (D0)) * 512); } while (0)
#define PKV(arr, ks) (bf16x8){arr[2 * (ks)][0], arr[2 * (ks)][1], arr[2 * (ks)][2], arr[2 * (ks)][3], arr[2 * (ks) + 1][0], arr[2 * (ks) + 1][1], arr[2 * (ks) + 1][2], arr[2 * (ks) + 1][3]}
    f32x16 oA[2], oB[2]; oA[0] = f32x16{}; oA[1] = f32x16{}; oB[0] = f32x16{}; oB[1] = f32x16{};
    float lA = 0.f, lB = 0.f; const int NT = seq / 64;
    f32x16 a0, a1, c0, c1; bf16x8 pa0, pa1, pa2, pa3;
#define HALF1(Kb) do { \
        f32x16 init; { float nmv = nm; asm volatile("" : "+v"(nmv)); _Pragma("unroll") for (int r = 0; r < 16; ++r) init[r] = nmv; } \
        SBAR(); \
        _Pragma("unroll") for (int d0 = 0; d0 < ND0; ++d0) { const int cb = (d0 * 16 + hi * 8) * 2; \
            const bf16x8 k0 = *(const LAS bf16x8*)((Kb) + KSWZ2(r32, cb)), k1 = *(const LAS bf16x8*)((Kb) + KSWZ2(32 + r32, cb)), qv = *(const LAS bf16x8*)(QAL + d0 * 1024); \
            a0 = __builtin_amdgcn_mfma_f32_32x32x16_bf16(k0, qv, d0 == 0 ? init : a0, 0, 0, 0); \
            a1 = __builtin_amdgcn_mfma_f32_32x32x16_bf16(k1, qv, d0 == 0 ? init : a1, 0, 0, 0); } \
        SBAR(); \
        float sA = 0.f; \
        _Pragma("unroll") for (int d0 = 0; d0 < ND0; ++d0) { const int cb = (d0 * 16 + hi * 8) * 2; \
            const bf16x8 k0 = *(const LAS bf16x8*)((Kb) + KSWZ2(r32, cb)), k1 = *(const LAS bf16x8*)((Kb) + KSWZ2(32 + r32, cb)), qv = *(const LAS bf16x8*)(QBL + d0 * 1024); \
            c0 = __builtin_amdgcn_mfma_f32_32x32x16_bf16(k0, qv, d0 == 0 ? init : c0, 0, 0, 0); \
            if (d0 == 3) { EXP4(a0, 0); EXP4(a0, 4); } \
            if (d0 == 4) { EXP4(a0, 12); SUM4(sA, a0, 0); SUM4(sA, a0, 4); EXP4(a1, 0); } \
            if (d0 == 5) { EXP4(a1, 8); SUM4(sA, a1, 0); SUM4(sA, a1, 4); } \
            c1 = __builtin_amdgcn_mfma_f32_32x32x16_bf16(k1, qv, d0 == 0 ? init : c1, 0, 0, 0); \
            if (d0 == 3) { EXP4(a0, 8); } \
            if (d0 == 4) { EXP4(a1, 4); SUM4(sA, a0, 8); SUM4(sA, a0, 12); } \
            if (d0 == 5) { EXP4(a1, 12); SUM4(sA, a1, 8); SUM4(sA, a1, 12); } \
            if (d0 >= 2) SBAR(); } \
        lA += sA; \
        PK4X(a0, 0, pa0); PK4X(a0, 8, pa1); PK4X(a1, 0, pa2); PK4X(a1, 8, pa3); \
        SBAR(); } while (0)
#define HALF2(vbase) do { \
        float sB = 0.f; s16x4 va[8], vb_[8]; \
        VRD8(va, vbase, 0); VRD8(vb_, vbase, 1); \
        oA[0] = __builtin_amdgcn_mfma_f32_32x32x16_bf16(pa0, PKV(va, 0), oA[0], 0, 0, 0); SBAR(); \
        oA[1] = __builtin_amdgcn_mfma_f32_32x32x16_bf16(pa0, PKV(vb_, 0), oA[1], 0, 0, 0); EXP4(c0, 0); EXP4(c0, 4); SBAR(); \
        oA[0] = __builtin_amdgcn_mfma_f32_32x32x16_bf16(pa1, PKV(va, 1), oA[0], 0, 0, 0); EXP4(c0, 8); EXP4(c0, 12); SUM4(sB, c0, 0); SBAR(); \
        oA[1] = __builtin_amdgcn_mfma_f32_32x32x16_bf16(pa1, PKV(vb_, 1), oA[1], 0, 0, 0); EXP4(c1, 0); SUM4(sB, c0, 4); SUM4(sB, c0, 8); SBAR(); \
        oA[0] = __builtin_amdgcn_mfma_f32_32x32x16_bf16(pa2, PKV(va, 2), oA[0], 0, 0, 0); EXP4(c1, 4); SUM4(sB, c0, 12); SBAR(); \
        oA[1] = __builtin_amdgcn_mfma_f32_32x32x16_bf16(pa2, PKV(vb_, 2), oA[1], 0, 0, 0); EXP4(c1, 8); SUM4(sB, c1, 0); SBAR(); \
        oA[0] = __builtin_amdgcn_mfma_f32_32x32x16_bf16(pa3, PKV(va, 3), oA[0], 0, 0, 0); EXP4(c1, 12); SUM4(sB, c1, 4); SBAR(); \
        oA[1] = __builtin_amdgcn_mfma_f32_32x32x16_bf16(pa3, PKV(vb_, 3), oA[1], 0, 0, 0); SUM4(sB, c1, 8); SUM4(sB, c1, 12); SBAR(); \
        lB += sB; \
        PK4X(c0, 0, pa0); PK4X(c0, 8, pa1); PK4X(c1, 0, pa2); PK4X(c1, 8, pa3); \
        SBAR(); \
        VRD8(va, vbase, 0); VRD8(vb_, vbase, 1);                       \
        oB[0] = __builtin_amdgcn_mfma_f32_32x32x16_bf16(pa0, PKV(va, 0), oB[0], 0, 0, 0); \
        oB[1] = __builtin_amdgcn_mfma_f32_32x32x16_bf16(pa0, PKV(vb_, 0), oB[1], 0, 0, 0); \
        oB[0] = __builtin_amdgcn_mfma_f32_32x32x16_bf16(pa1, PKV(va, 1), oB[0], 0, 0, 0); \
        oB[1] = __builtin_amdgcn_mfma_f32_32x32x16_bf16(pa1, PKV(vb_, 1), oB[1], 0, 0, 0); \
        oB[0] = __builtin_amdgcn_mfma_f32_32x32x16_bf16(pa2, PKV(va, 2), oB[0], 0, 0, 0); \
        oB[1] = __builtin_amdgcn_mfma_f32_32x32x16_bf16(pa2, PKV(vb_, 2), oB[1], 0, 0, 0); \
        oB[0] = __builtin_amdgcn_mfma_f32_32x32x16_bf16(pa3, PKV(va, 3), oB[0], 0, 0, 0); \
        oB[1] = __builtin_amdgcn_mfma_f32_32x32x16_bf16(pa3, PKV(vb_, 3), oB[1], 0, 0, 0); \
        SBAR(); } while (0)
#define TILE_BAR() do { asm volatile("s_waitcnt vmcnt(0)" ::: "memory"); __syncthreads(); } while (0)
    DMA2(0, 0, 0);
    if (wid < 4) {
        int vs = 0;
#pragma unroll 1
        for (int t = 0; t < NT; ++t) { TILE_BAR();
            const int vn = vs == 2 ? 0 : vs + 1; if (t + 1 < NT) DMA2(t + 1, (t + 1) & 1, vn);
            HALF1(K_lds + (t & 1) * SHM_K); HALF2(vrd0 + vs * SHM_V); vs = vn; }
        TILE_BAR();
    } else {
        __builtin_amdgcn_s_setprio(1);
        TILE_BAR(); if (1 < NT) DMA2(1, 1, 1);
        HALF1(K_lds);
        int vs = 0;
#pragma unroll 1
        for (int t = 1; t < NT; ++t) { TILE_BAR();
            const int vn = vs == 2 ? 0 : vs + 1; const int vnn = vn == 2 ? 0 : vn + 1; if (t + 1 < NT) DMA2(t + 1, (t + 1) & 1, vnn);
            HALF2(vrd0 + vs * SHM_V); HALF1(K_lds + (t & 1) * SHM_K); vs = vn; }
        TILE_BAR();
        HALF2(vrd0 + vs * SHM_V);
        __builtin_amdgcn_s_setprio(0);
    }
#undef HALF1
#undef HALF2
#undef TILE_BAR
    { auto rr = __builtin_amdgcn_permlane32_swap(__float_as_uint(lA), __float_as_uint(lA), false, false); lA = __uint_as_float(rr[0]) + __uint_as_float(rr[1]); }
    { auto rr = __builtin_amdgcn_permlane32_swap(__float_as_uint(lB), __float_as_uint(lB), false, false); lB = __uint_as_float(rr[0]) + __uint_as_float(rr[1]); }
    if (hi == 0) { ws[r32] = lA; ws[32 + r32] = lB; } asm volatile("s_waitcnt lgkmcnt(0)" ::: "memory");
    bf16* Ow = Ob + (long)(wid * 64) * ldo;
#pragma unroll
    for (int r = 0; r < 16; ++r) { const int orow = crow(r, hi); const float ra = __builtin_amdgcn_rcpf(ws[orow]), rb = __builtin_amdgcn_rcpf(ws[32 + orow]);
#pragma unroll
        for (int d0 = 0; d0 < NB; ++d0) { Ow[(long)orow * ldo + d0 * 32 + r32] = f2bf(oA[d0][r] * ra); Ow[(long)(32 + orow) * ldo + d0 * 32 + r32] = f2bf(oB[d0][r] * rb); } }
    __syncthreads();
#undef DMA2
#undef VRD8
#undef PKV
}
#undef EXP4
#undef SUM4
#undef PK4X

__device__ __forceinline__ void spatial_unit(int chunk, int g, const bf16* __restrict__ U, const bf16* __restrict__ VR, const float* __restrict__ vstat, const float* __restrict__ g_sg,
                                             const bf16* __restrict__ Wsb, const float* __restrict__ b_s, bf16* __restrict__ Y, LAS char* lds) {
    int tid_ = threadIdx.x; asm volatile("" : "+v"(tid_));
    const int tid = tid_, wid = tid >> 6, lane = tid & 63, r32 = lane & 31, hi = lane >> 5, rb = wid & 3, ch = wid >> 2;
    LAS char* V_lds = lds; LAS float* rv = (LAS float*)(lds + 32768);
    const int row0 = chunk * 128;
    if (tid < 128) { const f32x4 s0 = *(const f32x4*)(vstat + (size_t)(row0 + tid) * 8), s1 = *(const f32x4*)(vstat + (size_t)(row0 + tid) * 8 + 4);
        rv[tid] = __builtin_amdgcn_rsqf(((s0[0] + s0[1]) + (s0[2] + s0[3]) + (s1[0] + s1[1]) + (s1[2] + s1[3])) * (1.f / 512.f) + EPS); }
    __syncthreads();
#pragma unroll
    for (int i = 0; i < 4; ++i) { const int c = tid + 512 * i, row = c >> 4, cc = c & 15;
        const u32x4 w = *(const u32x4*)(VR + (size_t)(row0 + row) * 512 + g * 128 + cc * 8); f32x4 a, b; unpack8(w, a, b);
        const f32x4 g0 = *(const f32x4*)(g_sg + g * 128 + cc * 8), g1 = *(const f32x4*)(g_sg + g * 128 + cc * 8 + 4); const float r = rv[row];
        *(LAS u32x4*)(V_lds + (row >> 6) * 16384 + v_st<4>(row & 63, cc * 8)) = pack8(a * r * g0, b * r * g1); }
    bf16x8 pa[8];
#pragma unroll
    for (int ks = 0; ks < 8; ++ks) pa[ks] = *(const bf16x8*)(Wsb + (size_t)g * 16384 + (size_t)(32 * rb + r32) * 128 + 16 * ks + 8 * hi);
    __syncthreads();
    f32x16 o[2]; o[0] = f32x16{}; o[1] = f32x16{};
    const int vb = (int)(uintptr_t)V_lds + v_rd_base(lane) + (2 * ch) * 512;
    pv_one<4, 0>(o[0], vb, pa[0], pa[1], pa[2], pa[3]); pv_one<4, 1>(o[1], vb, pa[0], pa[1], pa[2], pa[3]);
    pv_one<4, 0>(o[0], vb + 16384, pa[4], pa[5], pa[6], pa[7]); pv_one<4, 1>(o[1], vb + 16384, pa[4], pa[5], pa[6], pa[7]);
#pragma unroll
    for (int r = 0; r < 16; ++r) { const int i = 32 * rb + crow(r, hi); const float bias = b_s[g * 128 + i]; const size_t row = (size_t)(row0 + i);
#pragma unroll
        for (int dd = 0; dd < 2; ++dd) { const int c = g * 128 + 64 * ch + 32 * dd + r32; const float uu = bf2f(U[row * 512 + c]);
            Y[row * 1536 + 512 + c] = f2bf(uu * (o[dd][r] + bias)); } }
    __syncthreads();
}
#undef KSWZ
#undef SBAR
}

#define XB_TMO      128
#define XB_XCNT(j)  (256  + 64 * (j))
#define XB_XSUB(j)  (1280 + 64 * (j))
#define XB_XGEN(j)  (2304 + 64 * (j))
#define XB_TOP      3328
#define XB_TOPGEN   3392
#define XCD_BAR_WORDS 3456
#define XB_SPIN_CAP (1u << 18)
__device__ __forceinline__ unsigned xb_ld(unsigned* p)              { return __hip_atomic_load((GAS unsigned*)p, __ATOMIC_RELAXED, __HIP_MEMORY_SCOPE_AGENT); }
__device__ __forceinline__ unsigned xb_add(unsigned* p, unsigned v) { return __hip_atomic_fetch_add((GAS unsigned*)p, v, __ATOMIC_RELAXED, __HIP_MEMORY_SCOPE_AGENT); }
__device__ __forceinline__ unsigned xb_xcc_id() { return (unsigned)__builtin_amdgcn_s_getreg((3 << 11) | 20) & 0xFu; }
#define XB_SPIN(cond, bar) do { unsigned _sp = 0; while (cond) { __builtin_amdgcn_s_sleep(1); \
    if ((++_sp & 255u) == 0u) { if (xb_ld(&(bar)[XB_TMO])) break; if (_sp > XB_SPIN_CAP) { xb_add(&(bar)[XB_TMO], 1u); break; } } } } while (0)
struct XcdBarrier { unsigned* bar; unsigned x; volatile LAS unsigned* st; };
__device__ __forceinline__ XcdBarrier xcd_barrier_post(unsigned* bar, volatile LAS unsigned* st) {
    XcdBarrier b; b.bar = bar; b.x = (unsigned)__builtin_amdgcn_readfirstlane((int)xb_xcc_id()); b.st = st;
    if (threadIdx.x == 0) (void)xb_add(&bar[XB_XCNT(b.x)], 1u);
    return b;
}
__device__ __forceinline__ void xcd_barrier_complete(unsigned* bar, unsigned x, unsigned& nloc, unsigned& nx) {
    const unsigned G = gridDim.x * gridDim.y * gridDim.z;
    unsigned sum, cnt, mine, sp = 0u;
    for (;;) {
        sum = 0u; cnt = 0u; mine = 0u;
#pragma unroll
        for (unsigned j = 0; j < 16; ++j) { const unsigned c = xb_ld(&bar[XB_XCNT(j)]); sum += c; cnt += (c > 0u) ? 1u : 0u; mine = (j == x) ? c : mine; }
        if (sum == G) break;
        __builtin_amdgcn_s_sleep(1);
        if ((++sp & 255u) == 0u) { if (xb_ld(&bar[XB_TMO])) break; if (sp > XB_SPIN_CAP) { xb_add(&bar[XB_TMO], 1u); break; } }
    }
    nloc = mine > 0u ? mine : 1u; nx = cnt > 0u ? cnt : 1u;
}
__device__ __forceinline__ void xcd_barrier(const XcdBarrier& b) {
    asm volatile("s_waitcnt vmcnt(0)" ::: "memory");
    __syncthreads();
    if (threadIdx.x == 0) {
        unsigned* bar = b.bar; unsigned bx = b.x; asm volatile("" : "+s"(bar), "+s"(bx));
        __builtin_amdgcn_s_waitcnt(0);
        unsigned nloc = b.st[0], nx = b.st[1];
        if (nloc == 0u) { xcd_barrier_complete(bar, bx, nloc, nx); b.st[0] = nloc; b.st[1] = nx; }
        const unsigned old = xb_add(&bar[XB_XSUB(bx)], 1u);
        const unsigned gen = old / nloc;
        if (old + 1u == (gen + 1u) * nloc) {
            __builtin_amdgcn_fence(__ATOMIC_RELEASE, "agent");
            asm volatile("s_waitcnt vmcnt(0)" ::: "memory");
            const unsigned og = xb_add(&bar[XB_TOP], 1u);
            const unsigned tg = og / nx;
            if (og + 1u == (tg + 1u) * nx) xb_add(&bar[XB_TOPGEN], 1u);
            else XB_SPIN(xb_ld(&bar[XB_TOPGEN]) == tg, bar);
            __builtin_amdgcn_fence(__ATOMIC_ACQUIRE, "agent");
            xb_add(&bar[XB_XGEN(bx)], 1u);
            asm volatile("s_waitcnt vmcnt(0)" ::: "memory");
        } else {
            XB_SPIN(xb_ld(&bar[XB_XGEN(bx)]) == gen, bar);
            __builtin_amdgcn_fence(__ATOMIC_ACQUIRE, "agent");
            asm volatile("s_waitcnt vmcnt(0)" ::: "memory");
        }
    }
    __syncthreads();
}

enum { CV_NAT = 0, CV_WIN = 1, CV_WUQ = 2, CV_W13 = 3 };
__device__ __forceinline__ int ropeperm(int p) { return ((p >> 2) & 1) * 16 + 4 * (p >> 3) + (p & 3); }
__device__ __forceinline__ int cv_map(int kind, int G, int& which, float& scale, bool& perm) {
    which = 0; scale = 1.f; perm = false; const int n = G * 32;
    if (kind == CV_WIN) {
        if (n < 384) return n;
        if (n < 416) { perm = true; return 640; }
        if (n < 512) return -1;
        if (n < 768) return 384 + (n - 512);
        if (n < 1280) return 672 + (n - 768);
        if (n < 1792) return 1184 + (n - 1280);
        if (n < 2304) { scale = XSCALE; return 1696 + (n - 1792); }
        return 2208 + (n - 2304);
    }
    if (kind == CV_WUQ) { scale = QSCALE; perm = (G % 3) == 2; return n; }
    if (kind == CV_W13) { which = (n >> 7) & 1; return 128 * (n >> 8) + (n & 127); }
    return n;
}
struct CvDesc { const float* src; const float* src2; const float* gain; bf16* dst; int K, Nsrc, Nout, kind; };
__device__ __forceinline__ void cv_item(const CvDesc& d, int item, LAS char* tile, int lane) {
    const int nI = d.Nout >> 7, kb = item / nI, nb = item - kb * nI, k0 = 64 * kb, n0 = 128 * nb;
    const int nq = lane & 31, kh = lane >> 5;
    const int nout = n0 + 4 * nq, G = nout >> 5, p = nout & 31;
    int which; float scale; bool perm; const int sc = cv_map(d.kind, G, which, scale, perm);
    const bool zero = sc < 0;
    const float* W = d.src + (ptrdiff_t)which * (d.src2 - d.src) + (size_t)k0 * d.Nsrc + (zero ? 0 : sc + (perm ? ropeperm(p) : p));
#pragma unroll
    for (int half = 0; half < 2; ++half) {
        f32x4 v[16];
#pragma unroll
        for (int i = 0; i < 16; ++i) { const int k = 32 * half + 2 * i + kh; v[i] = zero ? (f32x4){0.f, 0.f, 0.f, 0.f} : *(const f32x4*)(W + (size_t)k * d.Nsrc); }
#pragma unroll
        for (int i = 0; i < 16; ++i) { const int k = 32 * half + 2 * i + kh; const float g = d.gain ? d.gain[k0 + k] * scale : scale; const f32x4 w = v[i] * g;
            *(LAS u32x2*)(tile + att::v_st<4>(k, 4 * nq)) = (u32x2){cvt_pk_bf16(w[0], w[1]), cvt_pk_bf16(w[2], w[3])}; }
    }
    LDS_WAIT(); asm volatile("" ::: "memory");
    const int vb = (int)(uintptr_t)tile + att::v_rd_base(lane);
    bf16* drow = d.dst + (size_t)(n0 >> 8) * 256 * d.K + (size_t)kb * (256 * 64) + (size_t)((n0 & 255) + nq) * 64 + 8 * kh;
#define CV_RD(D0, KS) { const s16x4 l_ = att::tr_read<((2 * KS) * 4 + D0) * 512>(vb), h_ = att::tr_read<((2 * KS + 1) * 4 + D0) * 512>(vb); \
        asm volatile("s_waitcnt lgkmcnt(0)" ::: "memory"); __builtin_amdgcn_sched_barrier(0); \
        *(bf16x8*)(drow + (32 * D0) * 64 + 16 * KS) = (bf16x8){l_[0], l_[1], l_[2], l_[3], h_[0], h_[1], h_[2], h_[3]}; }
#define CV_RD4(D0) CV_RD(D0, 0) CV_RD(D0, 1) CV_RD(D0, 2) CV_RD(D0, 3)
    CV_RD4(0) CV_RD4(1) CV_RD4(2) CV_RD4(3)
#undef CV_RD4
#undef CV_RD
    LDS_WAIT(); asm volatile("" ::: "memory");
}

struct Args {
    const float* x; const float* mem; const int* positions; const float* g_mix; const float* w_in; const float* g_q; const float* g_kv; const float* w_uq; const float* w_uk; const float* w_uv;
    const float* g_sg; const float* w_s; const float* b_s; const float* g_mem; const float* w_mkv; const float* w_br; const float* b_gate; const float* w_out; const float* g_ffn;
    const float* dense_w1; const float* dense_w3; const float* dense_w2; const float* w_router; const float* moe_w1; const float* moe_w3; const float* moe_w2; const float* g_final;
    float* out; unsigned char* ws; int dbg; int pad;
};
typedef const __attribute__((address_space(4))) Args* ArgsP;
#define FRESH(ap) ArgsP ap = kargs; asm volatile("" : "+s"(ap))
__constant__ double INVF[16] = { 1.0, 0.5623413251903491, 0.31622776601683794, 0.1778279410038923, 0.1, 0.05623413251903491, 0.03162277660168379, 0.01778279410038923,
                                 0.01, 0.005623413251903491, 0.003162277660168379, 0.001778279410038923, 0.001, 0.0005623413251903491, 0.00031622776601683794, 0.0001778279410038923 };

struct Frame { LAS unsigned char* lds; int G, NGW, bid; };
#define LOCAL_IDS int tid = threadIdx.x; asm volatile("" : "+v"(tid)); const int lane = tid & 63, wave = __builtin_amdgcn_readfirstlane(tid >> 6), gw = F.bid * NWAVES + wave; (void)lane; (void)gw

__device__ __forceinline__ void conv_run(const Frame& F, const CvDesc& d) {
    LOCAL_IDS;
    LAS char* tile = (LAS char*)(F.lds + wave * 16384);
    const int nitems = (d.K / 64) * (d.Nout / 128);
    for (int it = gw; it < nitems; it += F.NGW) cv_item(d, it, tile, lane);
}
__device__ __forceinline__ void rx_from_stats(const Frame& F, ArgsP kargs) {
    LOCAL_IDS; FRESH(ap); const float* xstat = (const float*)(ap->ws + WS_XSTAT); float* rx = (float*)(ap->ws + WS_RX);
    for (int row = F.bid * 512 + tid; row < M; row += F.G * 512) {
        const f32x4* p = (const f32x4*)(xstat + (size_t)row * 16); const f32x4 a = p[0], b = p[1], c = p[2], d = p[3];
        const float s = ((a[0] + a[1]) + (a[2] + a[3])) + ((b[0] + b[1]) + (b[2] + b[3])) + ((c[0] + c[1]) + (c[2] + c[3])) + ((d[0] + d[1]) + (d[2] + d[3]));
        rx[row] = __builtin_amdgcn_rsqf(s * (1.f / D) + EPS);
    }
}
__device__ __forceinline__ void conv_mixer(const Frame& F, ArgsP kargs, int l) {
    { FRESH(a); CvDesc d{a->w_in + (size_t)l * D * PTOT, nullptr, a->g_mix + l * D, (bf16*)(a->ws + WS_WINT), D, PTOT, PPAD, CV_WIN}; conv_run(F, d); }
    { FRESH(a); CvDesc d{a->w_uq + (size_t)l * QRANK * 768, nullptr, a->g_q + l * QRANK, (bf16*)(a->ws + WS_WUQT), QRANK, 768, 768, CV_WUQ}; conv_run(F, d); }
    { FRESH(a); CvDesc d{a->w_uk + (size_t)l * KVRANK * 512, nullptr, a->g_kv + l * KVRANK, (bf16*)(a->ws + WS_WUKVT), KVRANK, 512, 512, CV_NAT}; conv_run(F, d); }
    { FRESH(a); CvDesc d{a->w_uv + (size_t)l * KVRANK * 512, nullptr, a->g_kv + l * KVRANK, (bf16*)(a->ws + WS_WUKVT) + 512 * KVRANK, KVRANK, 512, 512, CV_NAT}; conv_run(F, d); }
#pragma unroll 1
    for (int n = 0; n < 3; ++n) { FRESH(a); CvDesc d{a->w_br + ((size_t)l * 3 + n) * BW * D, nullptr, nullptr, (bf16*)(a->ws + WS_WBRT) + (size_t)n * D * BW, BW, D, D, CV_NAT}; conv_run(F, d); }
    { FRESH(a); CvDesc d{a->w_out + (size_t)l * D * D, nullptr, nullptr, (bf16*)(a->ws + WS_WOUTT), D, D, D, CV_NAT}; conv_run(F, d); }
    { LOCAL_IDS; FRESH(a); const float* wsrc = a->w_s + (size_t)l * 65536; bf16* wdst = (bf16*)(a->ws + WS_WSB);
      for (int i = F.bid * 512 + tid; i < 4 * 128 * 128 / 4; i += F.G * 512) { const f32x4 v = *(const f32x4*)(wsrc + (size_t)i * 4);
        *(u32x2*)(wdst + (size_t)i * 4) = (u32x2){cvt_pk_bf16(v[0], v[1]), cvt_pk_bf16(v[2], v[3])}; } }
}
__device__ __forceinline__ void phase_prologue(const Frame& F, ArgsP kargs) {
    LOCAL_IDS;
    { FRESH(a); float* ROPE = (float*)(a->ws + WS_ROPE); const int* pos = a->positions;
      for (int idx = F.bid * 512 + tid; idx < M * 16; idx += F.G * 512) { const int row = idx >> 4, i = idx & 15;
        const double t = (double)pos[row] * INVF[i] * 0.15915494309189535; const float fr = (float)(t - rint(t));
        ROPE[(size_t)row * 32 + i] = __builtin_amdgcn_cosf(fr); ROPE[(size_t)row * 32 + 16 + i] = __builtin_amdgcn_sinf(fr); } }
    { FRESH(a); const float* xin = a->x; float* X = a->out; bf16* XB = (bf16*)(a->ws + WS_XB); float* RX = (float*)(a->ws + WS_RX);
      for (int m = gw; m < M; m += F.NGW) { const f32x4* xr = (const f32x4*)(xin + (size_t)m * D) + lane; f32x4 v[4]; float s = 0.f;
#pragma unroll
        for (int j = 0; j < 4; ++j) { v[j] = xr[64 * j]; s += sumsq4(v[j]); }
        s = wave_sum(s);
#pragma unroll
        for (int j = 0; j < 4; ++j) { ((f32x4*)(X + (size_t)m * D) + lane)[64 * j] = v[j]; ((u32x2*)(XB + (size_t)m * D) + lane)[64 * j] = (u32x2){cvt_pk_bf16(v[j][0], v[j][1]), cvt_pk_bf16(v[j][2], v[j][3])}; }
        if (lane == 0) RX[m] = __builtin_amdgcn_rsqf(s * (1.f / D) + EPS); } }
    { FRESH(a); const float* mem = a->mem; const float* g_mem = a->g_mem; bf16* MEMB = (bf16*)(a->ws + WS_MEMB);
      for (int m = gw; m < NMEM; m += F.NGW) { const f32x4* xr = (const f32x4*)(mem + (size_t)m * D) + lane; f32x4 v[4]; float s = 0.f;
#pragma unroll
        for (int j = 0; j < 4; ++j) { v[j] = xr[64 * j]; s += sumsq4(v[j]); }
        const float r = __builtin_amdgcn_rsqf(wave_sum(s) * (1.f / D) + EPS);
#pragma unroll
        for (int j = 0; j < 4; ++j) { const f32x4 g = ((const f32x4*)g_mem + lane)[64 * j]; const f32x4 w = v[j] * r * g;
            ((u32x2*)(MEMB + (size_t)m * D) + lane)[64 * j] = (u32x2){cvt_pk_bf16(w[0], w[1]), cvt_pk_bf16(w[2], w[3])}; } } }
#pragma unroll 1
    for (int l = 0; l < DEPTH; ++l) { FRESH(a); CvDesc d{a->w_mkv + (size_t)l * D * D, nullptr, nullptr, (bf16*)(a->ws + WS_WMKVT) + (size_t)l * D * D, D, D, D, CV_NAT}; conv_run(F, d); }
    conv_mixer(F, kargs, 0);
}
__device__ __forceinline__ void phase_inproj(const Frame& F, ArgsP kargs, int l) {
    if (PH(1)) { FRESH(a); unsigned char* ws = a->ws;
        pg8::TileOrder S{M / 256, PPAD / 256 - 1, F.G, F.bid, (const char*)(ws + WS_XB), (const char*)(ws + WS_WINT), (size_t)256 * D * 2, (size_t)256 * D * 2};
#ifdef DBG_REV
        S.rev = 1;
#endif
        pg8::EpiInProj E{ws, a->b_gate + (size_t)l * 3 * D, l, (l & 1)};
        pg8::gemm_phase(F.lds, D, D, D, S, E); }
    if (l == 0 && PH(2)) { FRESH(a); unsigned char* ws = a->ws;
        struct MemOrder { enum { VARK = 0 }; int c; const char* A; const char* B;
            __device__ __forceinline__ bool next(int i, pg8::Unit& u) const { if (i > 0 || c < 240) return false; const int idx = c - 240; u.pm = 0; u.pn = idx & 3; u.aux = idx >> 2; u.A = A; u.B = B + (size_t)u.aux * D * D * 2 + (size_t)u.pn * 256 * D * 2; return true; } };
        MemOrder S2{F.bid, (const char*)(ws + WS_MEMB), (const char*)(ws + WS_WMKVT)}; pg8::EpiMemKV E2{(bf16*)(ws + WS_KVMEM)};
        pg8::gemm_phase(F.lds, D, D, D, S2, E2); }
}
struct GateTailOrder { enum { VARK = 0 }; int c; const char* A; const char* B;
    __device__ __forceinline__ bool next(int i, pg8::Unit& u) const { if (i > 0 || c < 192) return false; u.pm = c - 192; u.pn = PPAD / 256 - 1; u.aux = 0; u.A = A + (size_t)u.pm * 256 * D * 2; u.B = B + (size_t)u.pn * 256 * D * 2; return true; } };
__device__ __forceinline__ void phase_up(const Frame& F, ArgsP kargs, int l) {
    if (PH(1)) { FRESH(a); unsigned char* ws = a->ws;
        GateTailOrder S{F.bid, (const char*)(ws + WS_XB), (const char*)(ws + WS_WINT)}; pg8::EpiInProj E{ws, a->b_gate + (size_t)l * 3 * D, l, (l & 1)};
        pg8::gemm_phase(F.lds, D, D, D, S, E); }
    if (PH(3)) { FRESH(a); unsigned char* ws = a->ws;
        pg8::TileOrder S{M / 256, 3, F.G, F.bid, (const char*)(ws + WS_CQ), (const char*)(ws + WS_WUQT), (size_t)256 * 512 * 2, (size_t)256 * QRANK * 2};
        pg8::EpiQ E{(const float*)(ws + WS_CQSTAT), (const float*)(ws + WS_ROPE), (bf16*)(ws + WS_Q)}; pg8::gemm_phase(F.lds, 512, QRANK, QRANK, S, E); }
    if (PH(4)) { FRESH(a); unsigned char* ws = a->ws;
        pg8::TileOrder S{M / 256, 4, F.G, F.bid, (const char*)(ws + WS_CKV), (const char*)(ws + WS_WUKVT), (size_t)256 * KVRANK * 2, (size_t)256 * KVRANK * 2};
        pg8::EpiKV E{(const float*)(ws + WS_CKVSTAT), (bf16*)(ws + WS_KN), (bf16*)(ws + WS_V), (unsigned*)(ws + WS_CTL) + CW_KMAX + l * 32}; pg8::gemm_phase(F.lds, KVRANK, KVRANK, KVRANK, S, E); }
    if (PH(5)) { FRESH(a); unsigned char* ws = a->ws;
        for (int un = F.bid; un < 512; un += F.G)
            att::spatial_unit(un >> 2, un & 3, (const bf16*)(ws + WS_U), (const bf16*)(ws + WS_VR), (const float*)(ws + WS_VSTAT), a->g_sg + l * BW, (const bf16*)(ws + WS_WSB), a->b_s + l * 512, (bf16*)(ws + WS_Y), (LAS char*)F.lds); }
    if (PH(6)) { FRESH(a); unsigned char* ws = a->ws;
        for (int un = F.bid; un < 256; un += F.G) { const int h = un & 3, pm = un >> 2; const bf16* kvm = (const bf16*)(ws + WS_KVMEM) + (size_t)l * 256 * 1024;
            att::attn_unit<128, 128, 128, false>((const bf16*)(ws + WS_QX) + (size_t)pm * 256 * 512 + h * 128, 512, kvm + h * 128, 1024, kvm, 1024, kvm + 512 + h * 128, 1024,
                                          (bf16*)(ws + WS_Y) + (size_t)pm * 256 * 1536 + 1024 + h * 128, 1536, NMEM, (LAS char*)F.lds, 0.f); } }
}
__device__ __forceinline__ void phase_attn(const Frame& F, ArgsP kargs, int l) {
    if (PH(7)) { FRESH(a); unsigned char* ws = a->ws;
        for (int un = F.bid; un < 256; un += F.G) { const int h = un & 7, qb = un >> 3;
            const unsigned* km = (const unsigned*)(ws + WS_CTL) + CW_KMAX + l * 32;
            const float kbound = sqrtf(__uint_as_float(km[2 * h]) + __uint_as_float(km[2 * h + 1]) + __uint_as_float(km[16])) * 1.02f;
            att::attn_unit2<96, 64, 64>((const bf16*)(ws + WS_Q) + (size_t)qb * 512 * 768 + h * 96, 768, (const bf16*)(ws + WS_KN) + h * 64, 512, (const bf16*)(ws + WS_KR), 32, (const bf16*)(ws + WS_V) + h * 64, 512,
                                        (bf16*)(ws + WS_Y) + (size_t)qb * 512 * 1536 + h * 64, 1536, M, (LAS char*)F.lds, kbound); } }
}
__device__ __forceinline__ void phase_branch(const Frame& F, ArgsP kargs) {
    if (PH(8)) { FRESH(a); unsigned char* ws = a->ws;
        struct BranchOrder { enum { VARK = 0 }; int c; const char* A; const char* B;
            __device__ __forceinline__ bool next(int i, pg8::Unit& u) const { if (i >= 3 || c >= 256) return false; int pm, pn; pg8::tile_of(c, 64, 4, pm, pn); u.pm = pm; u.pn = pn; u.aux = i;
                u.A = A + (size_t)pm * 256 * 1536 * 2 + (size_t)i * 512 * 2; u.B = B + (size_t)i * D * BW * 2 + (size_t)pn * 256 * BW * 2; return true; } };
        BranchOrder S{F.bid, (const char*)(ws + WS_Y), (const char*)(ws + WS_WBRT)}; pg8::EpiBranch E{(const unsigned char*)(ws + WS_GATE), (bf16*)(ws + WS_MIXB)};
        pg8::gemm_phase(F.lds, 1536, BW, BW, S, E); }
}
__device__ __forceinline__ void phase_outproj(const Frame& F, ArgsP kargs, bool dummy = false) {
    if (PH(9)) { FRESH(a); unsigned char* ws = a->ws;
        pg8::TileOrder S{M / 256, 4, F.G, F.bid, (const char*)(ws + WS_MIXB), (const char*)(ws + WS_WOUTT), (size_t)256 * D * 2, (size_t)256 * D * 2};
        pg8::EpiResid E{a->out, dummy ? (float*)(ws + 700 * MiB) : a->out, (bf16*)(ws + (dummy ? 764 * MiB : WS_XB)), (float*)(ws + (dummy ? 796 * MiB : WS_XSTAT))}; pg8::gemm_phase(F.lds, 0, D, D, S, E); }
}
__device__ __forceinline__ void phase_dense_conv(const Frame& F, ArgsP kargs, int l, int j2) {
    { FRESH(a); CvDesc d{a->dense_w1 + (size_t)j2 * D * DFF, a->dense_w3 + (size_t)j2 * D * DFF, a->g_ffn + l * D, (bf16*)(a->ws + WS_WFFN), D, DFF, 2 * DFF, CV_W13}; conv_run(F, d); }
    { FRESH(a); CvDesc d{a->dense_w2 + (size_t)j2 * DFF * D, nullptr, nullptr, (bf16*)(a->ws + WS_W2D), DFF, D, D, CV_NAT}; conv_run(F, d); }
    rx_from_stats(F, kargs);
    conv_mixer(F, kargs, l + 1);
}
__device__ __forceinline__ void phase_dense_up(const Frame& F, ArgsP kargs) {
    if (PH(10)) { FRESH(a); unsigned char* ws = a->ws;
        pg8::TileOrder S{M / 256, 2 * DFF / 256, F.G, F.bid, (const char*)(ws + WS_XB), (const char*)(ws + WS_WFFN), (size_t)256 * D * 2, (size_t)256 * D * 2};
        pg8::EpiSwiGLU E{(const float*)(ws + WS_RX), (bf16*)(ws + WS_HFF), DFF, 0}; pg8::gemm_phase(F.lds, D, D, D, S, E); }
}
__device__ __forceinline__ void phase_dense_down(const Frame& F, ArgsP kargs, bool dummy = false) {
    if (PH(11)) { FRESH(a); unsigned char* ws = a->ws;
        pg8::TileOrder S{M / 256, 4, F.G, F.bid, (const char*)(ws + WS_HFF), (const char*)(ws + WS_W2D), (size_t)256 * DFF * 2, (size_t)256 * DFF * 2};
        pg8::EpiResid E{a->out, dummy ? (float*)(ws + 700 * MiB) : a->out, (bf16*)(ws + (dummy ? 764 * MiB : WS_XB)), (float*)(ws + (dummy ? 796 * MiB : WS_XSTAT))}; pg8::gemm_phase(F.lds, 0, DFF, DFF, S, E); }
}
__device__ __forceinline__ void phase_moe_route(const Frame& F, ArgsP kargs, int l, int j2) {
    {
        int tid_ = threadIdx.x; asm volatile("" : "+v"(tid_)); const int lane_ = tid_ & 63, wave_ = __builtin_amdgcn_readfirstlane(tid_ >> 6);
        LAS char* tile = (LAS char*)(F.lds + wave_ * 16384);
        constexpr int I13 = (D / 64) * (2 * DFE / 128), I2 = (DFE / 64) * (D / 128), IE = I13 + I2;
#pragma unroll 1
        for (int idx = F.bid * NWAVES + wave_; idx < NE * IE; idx += F.NGW) { const int e = idx / IE, r = idx - e * IE;
            FRESH(a);
            if (r < I13) { CvDesc d{a->moe_w1 + ((size_t)j2 * NE + e) * D * DFE, a->moe_w3 + ((size_t)j2 * NE + e) * D * DFE, a->g_ffn + l * D, (bf16*)(a->ws + WS_WFFN) + (size_t)e * 2 * DFE * D, D, DFE, 2 * DFE, CV_W13}; cv_item(d, r, tile, lane_); }
            else { CvDesc d{a->moe_w2 + ((size_t)j2 * NE + e) * DFE * D, nullptr, nullptr, (bf16*)(a->ws + WS_W2M) + (size_t)e * D * DFE, DFE, D, D, CV_NAT}; cv_item(d, r - I13, tile, lane_); } }
    }
    if (l + 1 < DEPTH) conv_mixer(F, kargs, l + 1);
    __syncthreads();
    LOCAL_IDS; FRESH(a); unsigned char* ws = a->ws; const float* X = a->out;
    float* RX = (float*)(ws + WS_RX); int* TOPI = (int*)(ws + WS_TOPI); float* TOPW = (float*)(ws + WS_TOPW); int* LRANK = (int*)(ws + WS_LRANK); int* BLKCNT = (int*)(ws + WS_BLKCNT);
    LAS int* tope = (LAS int*)(F.lds + 0);
    const float* wr = a->w_router + (size_t)j2 * D * NE; const float* gf = a->g_ffn + l * D;
#pragma unroll 1
    for (int i = 0; i < 8; ++i) { const int rib = wave * 8 + i, row = F.bid * 64 + rib;
        float lg[8]; float ss = 0.f;
#pragma unroll
        for (int e = 0; e < 8; ++e) lg[e] = 0.f;
#pragma unroll
        for (int j = 0; j < 4; ++j) { const int k0 = 4 * lane + 256 * j; const f32x4 xv = *(const f32x4*)(X + (size_t)row * D + k0), gv = *(const f32x4*)(gf + k0); ss += sumsq4(xv);
#pragma unroll
            for (int q = 0; q < 4; ++q) { const float hv = xv[q] * gv[q]; const f32x4 w0 = *(const f32x4*)(wr + (size_t)(k0 + q) * 8), w1 = *(const f32x4*)(wr + (size_t)(k0 + q) * 8 + 4);
                lg[0] += hv * w0[0]; lg[1] += hv * w0[1]; lg[2] += hv * w0[2]; lg[3] += hv * w0[3]; lg[4] += hv * w1[0]; lg[5] += hv * w1[1]; lg[6] += hv * w1[2]; lg[7] += hv * w1[3]; } }
        const float r = __builtin_amdgcn_rsqf(wave_sum(ss) * (1.f / D) + EPS);
#pragma unroll
        for (int e = 0; e < 8; ++e) lg[e] = wave_sum(lg[e]) * r;
        int e0 = 0; float v0 = lg[0];
#pragma unroll
        for (int e = 1; e < 8; ++e) if (lg[e] > v0) { v0 = lg[e]; e0 = e; }
        int e1 = e0 == 0 ? 1 : 0; float v1 = -3.0e38f;
#pragma unroll
        for (int e = 0; e < 8; ++e) if (e != e0 && lg[e] > v1) { v1 = lg[e]; e1 = e; }
        const float w0 = 1.f / (1.f + expf(v1 - v0));
        if (lane == 0) { RX[row] = r; TOPI[row] = e0 | (e1 << 8); TOPW[(size_t)row * 2] = w0; TOPW[(size_t)row * 2 + 1] = 1.f - w0; tope[rib] = e0 | (e1 << 8); } }
    __syncthreads();
    if (wave == 0) { const int te = tope[lane], e0 = te & 255, e1 = te >> 8, row = F.bid * 64 + lane; const unsigned long long below = (1ull << lane) - 1ull;
        int rk0 = 0, rk1 = 0;
#pragma unroll
        for (int e = 0; e < 8; ++e) { const unsigned long long m0 = __ballot(e0 == e), m1 = __ballot(e1 == e); const int c0 = __popcll(m0);
            if (e0 == e) rk0 = __popcll(m0 & below); if (e1 == e) rk1 = c0 + __popcll(m1 & below);
            if (lane == 0) BLKCNT[F.bid * 8 + e] = c0 + __popcll(m1); }
        LRANK[(size_t)row * 2] = rk0; LRANK[(size_t)row * 2 + 1] = rk1; }
    __syncthreads();
}
__device__ __forceinline__ void moe_tiles(const Frame& F, ArgsP kargs, int (&tb)[NE + 1], LAS int* pre) {
    LOCAL_IDS; FRESH(a); const int* BLKCNT = (const int*)(a->ws + WS_BLKCNT);
    __syncthreads();
    if (tid < 16) pre[tid] = 0;
    __syncthreads();
    if (tid < 256) { const i32x4 c0 = *(const i32x4*)(BLKCNT + tid * 8), c1 = *(const i32x4*)(BLKCNT + tid * 8 + 4); const int cc[8] = {c0[0], c0[1], c0[2], c0[3], c1[0], c1[1], c1[2], c1[3]};
#pragma unroll
        for (int e = 0; e < 8; ++e) { const int tot = (int)wave_sum((float)cc[e]); const int bel = (int)wave_sum(tid < F.bid ? (float)cc[e] : 0.f);
            if (lane == 0) { __hip_atomic_fetch_add(pre + 8 + e, tot, __ATOMIC_RELAXED, __HIP_MEMORY_SCOPE_WORKGROUP); __hip_atomic_fetch_add(pre + e, bel, __ATOMIC_RELAXED, __HIP_MEMORY_SCOPE_WORKGROUP); } } }
    __syncthreads();
    int acc_t = 0;
#pragma unroll
    for (int e = 0; e < NE; ++e) { tb[e] = acc_t; acc_t += (__builtin_amdgcn_readfirstlane(pre[8 + e]) + 255) >> 8; }
    tb[NE] = acc_t;
}
__device__ __forceinline__ void phase_moe_gather(const Frame& F, ArgsP kargs) {
    int tb[NE + 1]; LAS int* pre = (LAS int*)(F.lds + 0);
    moe_tiles(F, kargs, tb, pre);
    LOCAL_IDS; FRESH(a); unsigned char* ws = a->ws;
    const int* TOPI = (const int*)(ws + WS_TOPI); const int* LRANK = (const int*)(ws + WS_LRANK); int* POS = (int*)(ws + WS_POS); float* SLOTR = (float*)(ws + WS_SLOTR); const float* RX = (const float*)(ws + WS_RX);
    const bf16* XB = (const bf16*)(ws + WS_XB); bf16* XG = (bf16*)(ws + WS_XG);
#pragma unroll 1
    for (int p = 0; p < 16; ++p) { const int pi = wave * 16 + p, rib = pi >> 1, k = pi & 1, row = F.bid * 64 + rib;
        const int te = TOPI[row], e = __builtin_amdgcn_readfirstlane(k ? (te >> 8) : (te & 255));
        int bs = 0;
#pragma unroll
        for (int q = 0; q < NE; ++q) if (q == e) bs = tb[q] * 256;
        const int slot = bs + __builtin_amdgcn_readfirstlane(pre[e]) + LRANK[(size_t)row * 2 + k];
        const u32x4* s = (const u32x4*)(XB + (size_t)row * D) + lane; u32x4* dd = (u32x4*)(XG + (size_t)slot * D) + lane; dd[0] = s[0]; dd[64] = s[64];
        if (lane == 0) { POS[(size_t)row * 2 + k] = slot; SLOTR[slot] = RX[row]; } }
    if (F.bid < NE) { const int e = F.bid; int b0 = 0, b1 = 0;
#pragma unroll
        for (int q = 0; q < NE; ++q) if (q == e) { b0 = tb[q] * 256; b1 = tb[q + 1] * 256; }
        const int cnt = __builtin_amdgcn_readfirstlane(pre[8 + e]);
        for (int s = b0 + cnt + wave; s < b1; s += NWAVES) { u32x4* dd = (u32x4*)(XG + (size_t)s * D) + lane; dd[0] = (u32x4){0u, 0u, 0u, 0u}; dd[64] = (u32x4){0u, 0u, 0u, 0u}; if (lane == 0) SLOTR[s] = 0.f; } }
    __syncthreads();
}
struct MoeOrder { enum { VARK = 0 }; int nN, G, c, T; int tb[NE + 1]; const char* A; const char* B; size_t astep, estep, bstep; int rev = 0;
    __device__ __forceinline__ bool next(int i, pg8::Unit& u) const { const long L = (long)i * G + c; if (L >= (long)T * nN) return false; int pm, pn; pg8::tile_of((int)L, T, nN, pm, pn); if (rev) pm = T - 1 - pm;
        int e = 0;
#pragma unroll
        for (int q = 1; q < NE; ++q) e += (pm >= tb[q]) ? 1 : 0;
        u.pm = pm; u.pn = pn; u.aux = e; u.A = A + (size_t)pm * astep; u.B = B + (size_t)e * estep + (size_t)pn * bstep; return true; } };
struct MoeTailOrder { enum { VARK = 1 }; static constexpr int PPU = DFE / 128;
    int nN, G, c, T; int tb[NE + 1]; const char* A; const char* B; size_t astep, estep, bstep; int rev = 0;
    __device__ __forceinline__ bool next(int i, pg8::Unit& u) const {
        const int U = T * nN, R = U / G, Lf = U - R * G, x = c & 7, j = c >> 3, nj = (G - x + 7) >> 3;
        const int Lfx = Lf > x ? (Lf - x + 7) >> 3 : 0;
        long L; int k0 = 0, np = PPU, part = 0, k = 0, r = 0, C = 1;
        if (i < R) L = (long)i * G + c;
        else if (i == R && Lfx > 0) { const int cap = nj / Lfx; C = cap >= 4 ? 4 : cap >= 2 ? 2 : 1;
            r = j / C; k = j - r * C; if (r >= Lfx) return false;
            L = (long)R * G + x + 8 * r; if (C > 1) { np = PPU / C; k0 = k * np; part = 3; } }
        else return false;
        int pm, pn; pg8::tile_of((int)L, T, nN, pm, pn); if (rev) pm = T - 1 - pm;
        int e = 0;
#pragma unroll
        for (int q = 1; q < NE; ++q) e += (pm >= tb[q]) ? 1 : 0;
        u.pm = pm; u.pn = pn; u.aux = e | (part << 4) | (k << 8) | (C << 16) | (r << 24); u.nt = 2 * np;
        u.A = A + (size_t)pm * astep + (size_t)k0 * 65536; u.B = B + (size_t)e * estep + (size_t)pn * bstep + (size_t)k0 * 65536; return true; } };
__device__ __forceinline__ void phase_moe_up(const Frame& F, ArgsP kargs) {
    if (PH(12)) { MoeOrder S; LAS int* pre = (LAS int*)(F.lds + RING_BYTES + 64); moe_tiles(F, kargs, S.tb, pre);
        FRESH(a); unsigned char* ws = a->ws; S.nN = 2 * DFE / 256; S.G = F.G; S.c = F.bid; S.T = S.tb[NE];
        S.A = (const char*)(ws + WS_XG); S.B = (const char*)(ws + WS_WFFN); S.astep = (size_t)256 * D * 2; S.estep = (size_t)2 * DFE * D * 2; S.bstep = (size_t)256 * D * 2;
        pg8::EpiSwiGLU E{(const float*)(ws + WS_SLOTR), (bf16*)(ws + WS_HG), DFE, 0}; pg8::gemm_phase(F.lds, D, D, D, S, E); }
}
__device__ __forceinline__ void phase_moe_down(const Frame& F, ArgsP kargs, int j2) {
    if (PH(13)) { MoeTailOrder S; LAS int* pre = (LAS int*)(F.lds + RING_BYTES + 64); moe_tiles(F, kargs, S.tb, pre);
        FRESH(a); unsigned char* ws = a->ws; S.nN = 4; S.G = F.G; S.c = F.bid; S.T = S.tb[NE]; S.rev = 1;
        S.A = (const char*)(ws + WS_HG); S.B = (const char*)(ws + WS_W2M); S.astep = (size_t)256 * DFE * 2; S.estep = (size_t)D * DFE * 2; S.bstep = (size_t)256 * DFE * 2;
        pg8::EpiBf16KS E{(bf16*)(ws + WS_OUTG), D, (float*)(ws + WS_SKPART), (unsigned*)(ws + WS_CTL) + CW_SK + j2 * 512, F.bid}; pg8::gemm_phase(F.lds, 0, DFE, DFE, S, E); }
}
__device__ __forceinline__ void phase_moe_combine(const Frame& F, ArgsP kargs, bool last) {
    LOCAL_IDS; FRESH(a); unsigned char* ws = a->ws; float* X = a->out; const bf16* OUTG = (const bf16*)(ws + WS_OUTG); const int* POS = (const int*)(ws + WS_POS); const float* TOPW = (const float*)(ws + WS_TOPW);
    bf16* XB = (bf16*)(ws + WS_XB); float* RX = (float*)(ws + WS_RX); const float* g_final = a->g_final;
    int s0n = POS[(size_t)gw * 2], s1n = POS[(size_t)gw * 2 + 1]; float w0n = TOPW[(size_t)gw * 2], w1n = TOPW[(size_t)gw * 2 + 1];
#pragma unroll 1
    for (int m = gw; m < M; m += F.NGW) {
        const int s0 = s0n, s1 = s1n; const float w0 = w0n, w1 = w1n;
        { const int mn = m + F.NGW < M ? m + F.NGW : m; s0n = POS[(size_t)mn * 2]; s1n = POS[(size_t)mn * 2 + 1]; w0n = TOPW[(size_t)mn * 2]; w1n = TOPW[(size_t)mn * 2 + 1]; }
        f32x4 v[4]; float s = 0.f;
#pragma unroll
        for (int j = 0; j < 4; ++j) { const u32x2 p0 = ((const u32x2*)(OUTG + (size_t)s0 * D) + lane)[64 * j], p1 = ((const u32x2*)(OUTG + (size_t)s1 * D) + lane)[64 * j];
            const f32x4 o0 = {bflo(p0.x), bfhi(p0.x), bflo(p0.y), bfhi(p0.y)}, o1 = {bflo(p1.x), bfhi(p1.x), bflo(p1.y), bfhi(p1.y)};
            v[j] = ((const f32x4*)(X + (size_t)m * D) + lane)[64 * j] + w0 * o0 + w1 * o1; s += sumsq4(v[j]); }
        const float r = __builtin_amdgcn_rsqf(wave_sum(s) * (1.f / D) + EPS);
        if (last) {
#pragma unroll
            for (int j = 0; j < 4; ++j) ((f32x4*)(X + (size_t)m * D) + lane)[64 * j] = v[j] * r * ((const f32x4*)g_final + lane)[64 * j];
        } else {
#pragma unroll
            for (int j = 0; j < 4; ++j) { ((f32x4*)(X + (size_t)m * D) + lane)[64 * j] = v[j]; ((u32x2*)(XB + (size_t)m * D) + lane)[64 * j] = (u32x2){cvt_pk_bf16(v[j][0], v[j][1]), cvt_pk_bf16(v[j][2], v[j][3])}; }
            if (lane == 0) RX[m] = r;
        }
    }
}


#ifdef DBG_ENABLE
__device__ __forceinline__ float dbg_b(const unsigned char* ws, size_t off, size_t idx) { return bf2f(((const bf16*)(ws + off))[idx]); }
__device__ __forceinline__ void dbg_dump(const Frame& F, ArgsP kargs, int code) {
    LOCAL_IDS; FRESH(a); const unsigned char* ws = a->ws; float* out = a->out;
    unsigned tmo = ((const unsigned*)(ws + WS_CTL))[CW_BAR + XB_TMO];
    for (size_t i = (size_t)F.bid * 512 + tid; i < (size_t)M * D; i += (size_t)F.G * 512) { const size_t row = i >> 10, c = i & 1023; float v = 0.f;
        if (code == 1) v = dbg_b(ws, WS_CQ, row * 512 + (c & 511)) + dbg_b(ws, WS_CKV, row * 256 + (c & 255)) + dbg_b(ws, WS_U, row * 512 + (c & 511)) + dbg_b(ws, WS_VR, row * 512 + (c & 511)) + dbg_b(ws, WS_QX, row * 512 + (c & 511))
                         + dbg_b(ws, WS_GATE, row * 3072 + c) + dbg_b(ws, WS_GATE, row * 3072 + 1024 + c) + dbg_b(ws, WS_GATE, row * 3072 + 2048 + c) + dbg_b(ws, WS_KR, row * 32 + (c & 31));
        else if (code == 2) v = dbg_b(ws, WS_Q, row * 768 + (c % 768)) + dbg_b(ws, WS_KN, row * 512 + (c & 511)) + dbg_b(ws, WS_V, row * 512 + (c & 511)) + dbg_b(ws, WS_Y, row * 1536 + 512 + c);
        else if (code == 3) v = dbg_b(ws, WS_Y, row * 1536 + (c & 511));
        else if (code == 15) v = dbg_b(ws, WS_WINT, i % ((size_t)PPAD * D));
        else if (code == 13 || code == 14) v = dbg_b(ws, WS_GATE, row * 3072 + c) + dbg_b(ws, WS_GATE, row * 3072 + 1024 + c) + dbg_b(ws, WS_GATE, row * 3072 + 2048 + c);
        else if (code == 4) v = dbg_b(ws, WS_MIXB, row * 1024 + c);
        else if (code == 6) v = dbg_b(ws, WS_HFF, row * 2688 + c) + dbg_b(ws, WS_HFF, row * 2688 + 1024 + c) + dbg_b(ws, WS_HFF, row * 2688 + 1664 + c);
        else if (code == 9) { const int s0 = ((const int*)(ws + WS_POS))[row * 2], s1 = ((const int*)(ws + WS_POS))[row * 2 + 1]; v = dbg_b(ws, WS_XG, (size_t)s0 * 1024 + c) + 2.f * dbg_b(ws, WS_XG, (size_t)s1 * 1024 + c) + ((const float*)(ws + WS_TOPW))[row * 2] + (float)s0 * 1e-3f; }
        else if (code == 10) { const int s0 = ((const int*)(ws + WS_POS))[row * 2], s1 = ((const int*)(ws + WS_POS))[row * 2 + 1]; v = dbg_b(ws, WS_HG, (size_t)s0 * 3584 + c) + dbg_b(ws, WS_HG, (size_t)s1 * 3584 + 2560 + c) + dbg_b(ws, WS_HG, (size_t)s0 * 3584 + 1500 + c); }
        else if (code == 11) { const int s0 = ((const int*)(ws + WS_POS))[row * 2], s1 = ((const int*)(ws + WS_POS))[row * 2 + 1]; v = ((const float*)(ws + WS_OUTG))[(size_t)s0 * 1024 + c] + ((const float*)(ws + WS_OUTG))[(size_t)s1 * 1024 + c]; }
        else continue;
        if (tmo) v = __builtin_nanf("");
        out[i] = v; }
}
#define DBG(code) do { if (dbgc == (code)) { dbg_dump(F, kargs, code); return; } } while (0)
#else
#define DBG(code) do { } while (0)
#endif

__global__ void __launch_bounds__(NWAVES * 64, 2) fwd_kernel(Args args_by_value) {
    extern __shared__ __attribute__((aligned(16))) unsigned char lds_raw[];
    const ArgsP kargs = (ArgsP)__builtin_amdgcn_kernarg_segment_ptr();
    Frame F; F.lds = (LAS unsigned char*)lds_raw; F.G = gridDim.x; F.bid = blockIdx.x; F.NGW = F.G * NWAVES;
    for (int u = threadIdx.x; u < (LDS_BYTES - LDSCTL_OFF) / 4; u += NWAVES * 64) ((LAS unsigned*)(F.lds + LDSCTL_OFF))[u] = 0u;
    __syncthreads();
    volatile LAS unsigned* MISC = (volatile LAS unsigned*)(F.lds + MISC_OFF);
    XcdBarrier bar; { FRESH(a); bar = xcd_barrier_post((unsigned*)(a->ws + WS_CTL) + CW_BAR, MISC + 8); }
#define GRID_BAR() xcd_barrier(bar)

#ifdef ONLY_TEST
    ONLY_TEST; GRID_BAR(); return;
#endif
    const Frame F_ = F;
    int dbgc; { FRESH(a); dbgc = a->dbg; } (void)dbgc;
    phase_prologue(F, kargs); GRID_BAR();
#pragma unroll 1
    for (int l_ = 0; l_ < DEPTH; ++l_) {
        Frame F = F_; int l = l_; asm volatile("" : "+s"(F.G), "+s"(F.NGW), "+s"(F.bid), "+s"(l));
        const bool moe = (l & 1) != 0; const int j2 = l >> 1;
        if (l == 0) DBG(15);
#ifdef PROBE_INPROJ2
        { int reps = 2; asm volatile("" : "+s"(reps));
#pragma unroll 1
          for (int rep = 0; rep < reps; ++rep) { phase_inproj(F, kargs, l); GRID_BAR(); } }
#else
        phase_inproj(F, kargs, l); GRID_BAR(); if (l == 0) DBG(1); if (l == 0) DBG(14);
#endif
        phase_up(F, kargs, l); GRID_BAR(); if (l == 0) DBG(2);
        phase_attn(F, kargs, l); GRID_BAR(); if (l == 0) DBG(3); if (l == 0) DBG(13);
#ifdef PROBE_ATTN2
        phase_attn(F, kargs, l); GRID_BAR();
#endif
#ifdef PROBE_UP2
        phase_up(F, kargs, l); GRID_BAR();
#endif
        phase_branch(F, kargs); GRID_BAR(); if (l == 0) DBG(4);
#ifdef PROBE_RESID2
        { int reps = 2; asm volatile("" : "+s"(reps));
#pragma unroll 1
          for (int rep = reps - 1; rep >= 0; --rep) { phase_outproj(F, kargs, rep != 0); GRID_BAR(); } }
#else
        phase_outproj(F, kargs); GRID_BAR(); if (l == 0) DBG(5); if (l == 1) DBG(8);
#endif
        if (!moe) {
            phase_dense_conv(F, kargs, l, j2); GRID_BAR();
            phase_dense_up(F, kargs); GRID_BAR(); if (l == 0) DBG(6);
#ifdef PROBE_DENSE2
            phase_dense_up(F, kargs); GRID_BAR();
#endif
#ifdef PROBE_RESID2
            { int reps = 2; asm volatile("" : "+s"(reps));
#pragma unroll 1
              for (int rep = reps - 1; rep >= 0; --rep) { phase_dense_down(F, kargs, rep != 0); GRID_BAR(); } }
#else
            phase_dense_down(F, kargs); GRID_BAR(); if (l == 0) DBG(7);
#endif
        } else {
            phase_moe_route(F, kargs, l, j2); GRID_BAR();
            phase_moe_gather(F, kargs); GRID_BAR(); if (l == 1) DBG(9);
#ifdef PROBE_AUX2
            phase_moe_gather(F, kargs); GRID_BAR();
#endif
            phase_moe_up(F, kargs); GRID_BAR(); if (l == 1) DBG(10);
            phase_moe_down(F, kargs, j2); GRID_BAR(); if (l == 1) DBG(11);
#ifdef PROBE_MOE2
            phase_moe_up(F, kargs); GRID_BAR();
            phase_moe_down(F, kargs, j2); GRID_BAR();
#endif
            phase_moe_combine(F, kargs, l == DEPTH - 1);
            if (l != DEPTH - 1) GRID_BAR();
            if (l == 1) DBG(12);
        }
    }
}

extern "C" void kernel_launch(void* const* d_in, const int* in_sizes, int n_in, void* d_out, int out_size, void* d_ws, size_t ws_size, hipStream_t stream) {
    static int grid = 0;
    if (grid == 0) {
        if (n_in != 27 || in_sizes[0] != M * D || out_size != M * D || ws_size < WS_END) { fprintf(stderr, "kernel_launch: unexpected shapes (n_in %d, in0 %d, out %d, ws %zu)\n", n_in, n_in > 0 ? in_sizes[0] : -1, out_size, ws_size); grid = -1; return; }
        int dev = 0, cus = 0, per_cu = 0;
        if (hipGetDevice(&dev) != hipSuccess || hipDeviceGetAttribute(&cus, hipDeviceAttributeMultiprocessorCount, dev) != hipSuccess) { grid = -1; return; }
        if (hipFuncSetAttribute((const void*)fwd_kernel, hipFuncAttributeMaxDynamicSharedMemorySize, LDS_BYTES) != hipSuccess) { fprintf(stderr, "kernel_launch: hipFuncSetAttribute failed\n"); grid = -1; return; }
        if (hipOccupancyMaxActiveBlocksPerMultiprocessor(&per_cu, (const void*)fwd_kernel, NWAVES * 64, LDS_BYTES) != hipSuccess || per_cu < 1) { fprintf(stderr, "kernel_launch: occupancy query reports %d\n", per_cu); }
        (void)hipGetLastError();
        if (cus != 256) { fprintf(stderr, "kernel_launch: built for 256 CUs, device has %d\n", cus); grid = -1; return; }
        grid = 256;
    }
    if (grid < 0) return;
    if (hipMemsetAsync((char*)d_ws + WS_CTL, 0, CTL_ZERO_BYTES, stream) != hipSuccess) return;
    Args a{};
    a.x = (const float*)d_in[0]; a.mem = (const float*)d_in[1]; a.positions = (const int*)d_in[2]; a.g_mix = (const float*)d_in[3]; a.w_in = (const float*)d_in[4]; a.g_q = (const float*)d_in[5];
    a.g_kv = (const float*)d_in[6]; a.w_uq = (const float*)d_in[7]; a.w_uk = (const float*)d_in[8]; a.w_uv = (const float*)d_in[9]; a.g_sg = (const float*)d_in[10]; a.w_s = (const float*)d_in[11];
    a.b_s = (const float*)d_in[12]; a.g_mem = (const float*)d_in[13]; a.w_mkv = (const float*)d_in[14]; a.w_br = (const float*)d_in[15]; a.b_gate = (const float*)d_in[16]; a.w_out = (const float*)d_in[17];
    a.g_ffn = (const float*)d_in[18]; a.dense_w1 = (const float*)d_in[19]; a.dense_w3 = (const float*)d_in[20]; a.dense_w2 = (const float*)d_in[21]; a.w_router = (const float*)d_in[22];
    a.moe_w1 = (const float*)d_in[23]; a.moe_w3 = (const float*)d_in[24]; a.moe_w2 = (const float*)d_in[25]; a.g_final = (const float*)d_in[26];
    a.out = (float*)d_out; a.ws = (unsigned char*)d_ws;
#ifdef DBG_STOP
    a.dbg = DBG_STOP;
#endif
    hipLaunchKernelGGL(fwd_kernel, dim3(grid), dim3(NWAVES * 64), LDS_BYTES, stream, a);
    const hipError_t le = hipPeekAtLastError();
    if (le != hipSuccess) fprintf(stderr, "kernel_launch: launch failed: %s\n", hipGetErrorName(le));
}
```

```cpp
#include <hip/hip_runtime.h>
#include <cstdio>
#include <cstdint>

#ifndef PH_MASK
#define PH_MASK 0xffffffffu
#endif
#define PH(k) ((PH_MASK >> (k)) & 1u)
#define LAS __attribute__((address_space(3)))
#define GAS __attribute__((address_space(1)))
typedef unsigned short bf16;
typedef short bf16x8 __attribute__((ext_vector_type(8)));
typedef short s16x4 __attribute__((ext_vector_type(4)));
typedef float f32x4 __attribute__((ext_vector_type(4)));
typedef float f32x2 __attribute__((ext_vector_type(2)));
typedef float f32x16 __attribute__((ext_vector_type(16)));
typedef unsigned u32x4 __attribute__((ext_vector_type(4)));
typedef unsigned u32x2 __attribute__((ext_vector_type(2)));
typedef int i32x4 __attribute__((ext_vector_type(4)));

constexpr int M = 16384, D = 1024, DEPTH = 4, NMEM = 256;
constexpr int QRANK = 384, KVRANK = 256, NH = 8, QKD = 96, VD = 64;
constexpr int XH = 4, XD = 128, BW = 512;
constexpr int PTOT = 5280, PPAD = 5376, DFF = 2688, NE = 8, DFE = 3584;
constexpr float EPS = 1e-6f;
constexpr int MAXSLOT = 34816;
constexpr float LOG2E = 1.4426950408889634f;
constexpr float QSCALE = 0.10206207261596575f * LOG2E;
constexpr float XSCALE = 0.08838834764831845f * LOG2E;

constexpr size_t MiB = 1u << 20, KiB = 1u << 10;
constexpr size_t WS_CTL = 0, CTL_ZERO_BYTES = 1 * MiB;
constexpr size_t WS_ROPE = 2 * MiB;
constexpr size_t WS_XSTAT = 4 * MiB;
constexpr size_t WS_RX = 5 * MiB;
constexpr size_t WS_CQSTAT = 5 * MiB + 256 * KiB;
constexpr size_t WS_CKVSTAT = 5 * MiB + 768 * KiB;
constexpr size_t WS_VSTAT = 6 * MiB;
constexpr size_t WS_MEMB = 6 * MiB + 512 * KiB;
constexpr size_t WS_KVMEM = 7 * MiB;
constexpr size_t WS_TOPI = 9 * MiB;
constexpr size_t WS_TOPW = 9 * MiB + 256 * KiB;
constexpr size_t WS_LRANK = 9 * MiB + 512 * KiB;
constexpr size_t WS_POS = 9 * MiB + 768 * KiB;
constexpr size_t WS_BLKCNT = 10 * MiB;
constexpr size_t WS_SLOTR = 10 * MiB + 512 * KiB;
constexpr size_t WS_TOKOF = 10 * MiB + 768 * KiB;
constexpr size_t WS_WSB = 11 * MiB;
constexpr size_t WS_WMKVT = 12 * MiB;
constexpr size_t WS_WINT = 20 * MiB;
constexpr size_t WS_WUQT = 31 * MiB;
constexpr size_t WS_WUKVT = 32 * MiB;
constexpr size_t WS_WBRT = 33 * MiB;
constexpr size_t WS_WOUTT = 36 * MiB;
constexpr size_t WS_WFFN = 40 * MiB;
constexpr size_t WS_W2D = WS_WFFN + 11 * MiB;
constexpr size_t WS_W2M = WS_WFFN + 112 * MiB;
constexpr size_t WS_XB = 208 * MiB;
constexpr size_t WS_CQ = 240 * MiB;
constexpr size_t WS_CKV = 256 * MiB;
constexpr size_t WS_U = 264 * MiB;
constexpr size_t WS_VR = 280 * MiB;
constexpr size_t WS_QX = 296 * MiB;
constexpr size_t WS_GATE = 312 * MiB;
constexpr size_t WS_Q = 408 * MiB;
constexpr size_t WS_KN = 432 * MiB;
constexpr size_t WS_KR = 448 * MiB;
constexpr size_t WS_V = 450 * MiB;
constexpr size_t WS_Y = 466 * MiB;
constexpr size_t WS_MIX = 514 * MiB;
constexpr size_t WS_MIXB = 578 * MiB;
constexpr size_t WS_MIX1 = 610 * MiB;
constexpr size_t WS_HFF = 240 * MiB;
constexpr size_t WS_XG = 240 * MiB;
constexpr size_t WS_HG = 308 * MiB;
constexpr size_t WS_OUTG = 546 * MiB;
constexpr size_t WS_END = 682 * MiB;
constexpr int CW_TMO = 0, CW_CODE = 1, CW_CHK = 2, CW_BAR = 4096;
constexpr int CW_SK = 16384;
constexpr size_t WS_SKPART = 700 * MiB;
constexpr int CW_KMAX = 8192;

constexpr int RING_BYTES = 131072, LDSCTL_OFF = 159744, MISC_OFF = LDSCTL_OFF + 320, LDS_BYTES = 163840;
constexpr int NWAVES = 8;

#define RLX_AGENT __ATOMIC_RELAXED, __HIP_MEMORY_SCOPE_AGENT
#define LDS_WAIT() asm volatile("s_waitcnt lgkmcnt(0)" ::: "memory")
#define VM_WAIT() asm volatile("s_waitcnt vmcnt(0)" ::: "memory")
typedef __bf16 bf16x2_t __attribute__((ext_vector_type(2)));
__device__ __forceinline__ unsigned cvt_pk_bf16(float lo, float hi) { const f32x2 v = {lo, hi}; const bf16x2_t b = __builtin_convertvector(v, bf16x2_t); return __builtin_bit_cast(unsigned, b); }
__device__ __forceinline__ bf16 f2bf(float f) { return (bf16)(cvt_pk_bf16(f, 0.f) & 0xffffu); }
__device__ __forceinline__ float bf2f(bf16 v) { return __uint_as_float((unsigned)v << 16); }
__device__ __forceinline__ float bflo(unsigned w) { return __uint_as_float(w << 16); }
__device__ __forceinline__ float bfhi(unsigned w) { return __uint_as_float(w & 0xffff0000u); }
__device__ __forceinline__ float fast_exp2(float x) { return __builtin_amdgcn_exp2f(x); }
__device__ __forceinline__ float fast_rcp(float x) { return __builtin_amdgcn_rcpf(x); }
__device__ __forceinline__ float sigmoidf_(float z) { return fast_rcp(1.f + fast_exp2(-LOG2E * z)); }
__device__ __forceinline__ float gelu_tanh(float x) { const float t = x + 0.044715f * x * x * x; return x * fast_rcp(1.f + fast_exp2(-2.f * 0.7978845608028654f * LOG2E * t)); }
__device__ __forceinline__ float wave_sum(float v) {
#pragma unroll
    for (int o = 1; o < 64; o <<= 1) v += __shfl_xor(v, o);
    return v;
}
__device__ __forceinline__ float sumsq4(f32x4 v) { return (v[0] * v[0] + v[1] * v[1]) + (v[2] * v[2] + v[3] * v[3]); }
__device__ __forceinline__ u32x2 pack8_u8(f32x4 a, f32x4 b) { unsigned w0 = 0, w1 = 0; a = a * 255.f; b = b * 255.f;
    w0 = __builtin_amdgcn_cvt_pk_u8_f32(a[0], 0, w0); w0 = __builtin_amdgcn_cvt_pk_u8_f32(a[1], 1, w0); w0 = __builtin_amdgcn_cvt_pk_u8_f32(a[2], 2, w0); w0 = __builtin_amdgcn_cvt_pk_u8_f32(a[3], 3, w0);
    w1 = __builtin_amdgcn_cvt_pk_u8_f32(b[0], 0, w1); w1 = __builtin_amdgcn_cvt_pk_u8_f32(b[1], 1, w1); w1 = __builtin_amdgcn_cvt_pk_u8_f32(b[2], 2, w1); w1 = __builtin_amdgcn_cvt_pk_u8_f32(b[3], 3, w1);
    return (u32x2){w0, w1}; }
__device__ __forceinline__ void unpack8_u8(u32x2 w, f32x4& a, f32x4& b) { constexpr float k = 1.f / 255.f;
    a = (f32x4){(float)(w.x & 255u), (float)((w.x >> 8) & 255u), (float)((w.x >> 16) & 255u), (float)(w.x >> 24)} * k;
    b = (f32x4){(float)(w.y & 255u), (float)((w.y >> 8) & 255u), (float)((w.y >> 16) & 255u), (float)(w.y >> 24)} * k; }
__device__ __forceinline__ u32x4 pack8(f32x4 a, f32x4 b) { u32x4 w; w.x = cvt_pk_bf16(a[0], a[1]); w.y = cvt_pk_bf16(a[2], a[3]); w.z = cvt_pk_bf16(b[0], b[1]); w.w = cvt_pk_bf16(b[2], b[3]); return w; }
__device__ __forceinline__ void unpack8(u32x4 w, f32x4& a, f32x4& b) { a = (f32x4){bflo(w.x), bfhi(w.x), bflo(w.y), bfhi(w.y)}; b = (f32x4){bflo(w.z), bfhi(w.z), bflo(w.w), bfhi(w.w)}; }

namespace pg8 {
constexpr int BM = 256, BK = 64, HALF = 128, HTB = HALF * BK * 2, STAGE_BYTES = 8 * HTB, NXCD = 8, WGM = 8;
__host__ __device__ __forceinline__ int lds_byte(int r, int c) { const int st = (r >> 4) * 2 + (c >> 5), rr = r & 15, cc = c & 31, ob = rr * 64 + cc * 2; return st * 1024 + (ob ^ (((ob >> 9) & 1) << 5)); }
__host__ __device__ __forceinline__ void stage_rc(int b, int& R, int& C) { const int st = b / 1024, sb = b % 1024, swz = sb ^ (((sb >> 9) & 1) << 5); R = (st >> 1) * 16 + swz / 64; C = (st & 1) * 32 + (swz % 64) / 2; }
__host__ __device__ __forceinline__ int perm32(int rho) { const int n = rho >> 4, i = rho & 15; return 8 * (i >> 2) + 4 * n + (i & 3); }

struct Unit { const char* A; const char* B; int pm, pn, aux, nt; };
typedef f32x4 Acc[2][2][4][2];

__device__ __forceinline__ void tile_of(int L, int nM, int nN, int& pm, int& pn) {
    const int nwg = nM * nN; int wgid = L;
    { const int q = nwg / NXCD, r = nwg % NXCD, xcd = wgid % NXCD, off = wgid / NXCD; wgid = (xcd < r ? xcd * (q + 1) : r * (q + 1) + (xcd - r) * q) + off; }
    const int nig = WGM * nN, gid = wgid / nig, fm = gid * WGM, gsz = (nM - fm) < WGM ? (nM - fm) : WGM;
    pm = fm + ((wgid % nig) % gsz); pn = (wgid % nig) / gsz;
}
struct TileOrder {
    enum { VARK = 0, GATHER = 0 };
    int nM, nN, G, c; const char* A; const char* B; size_t astep, bstep;
    int rev = 0;
    __device__ __forceinline__ bool next(int i, Unit& u) const {
        if (rev) { const int cnt = (nM * nN - c + G - 1) / G; if (i >= cnt) return false; i = cnt - 1 - i; }
        const long L = (long)i * G + c; if (L >= (long)nM * nN) return false;
        int pm, pn; tile_of((int)L, nM, nN, pm, pn);
        u.pm = pm; u.pn = pn; u.aux = 0; u.A = A + (size_t)pm * astep; u.B = B + (size_t)pn * bstep; return true;
    }
};

template <class Epi, class Sched>
__device__ __forceinline__ void gemm_phase(LAS unsigned char* lds, const int lda, const int ldb, const int K, const Sched& S, const Epi& E) {
    int tid_ = threadIdx.x; asm volatile("" : "+v"(tid_));
    const int tid = tid_, wid = __builtin_amdgcn_readfirstlane(tid >> 6), lane = tid & 63, wr = wid >> 2, wc = wid & 3, fr = lane & 15, fq = lane >> 4;
    int nt = K / BK;
    unsigned voffA[2], voffB[2];
#pragma unroll
    for (int i = 0; i < 2; ++i) { int R, C; stage_rc(tid * 16 + i * 8192, R, C); const int Rb = (R & ~31) + perm32(R & 31);
        voffA[i] = (unsigned)(R * (lda ? lda : BK) + C) * 2u; voffB[i] = (unsigned)(Rb * BK + C) * 2u; }
    const size_t kstep = lda ? (size_t)(BK * 2) : (size_t)BM * BK * 2;
    const size_t hstepA = (size_t)HALF * (lda ? lda : BK) * 2, hstepB = (size_t)HALF * BK * 2, kstepB = (size_t)BM * BK * 2; (void)ldb;
    const unsigned ldsw = (unsigned)wid * 1024u;
    const int aoff = lds_byte(wr * 64 + fr, fq * 8), boff = lds_byte(wc * 32 + fr, fq * 8);
#define PG8_SA(b, h) (((b) * 2 + (h)) * HTB)
#define PG8_SB(b, h) ((4 + (b) * 2 + (h)) * HTB)
#define PG8_STAGE(bufoff, gbase, voff) do { _Pragma("unroll") for (int _i = 0; _i < 2; ++_i) \
        __builtin_amdgcn_global_load_lds((const unsigned*)((const char*)(gbase) + (voff)[_i]), (LAS unsigned*)(lds + (bufoff) + ldsw + _i * 8192), 16, 0, 0); } while (0)
#define PG8_STA(b, h, kptr, VG) do { if constexpr (Sched::GATHER) PG8_STAGE(PG8_SA(b, h), (kptr), VG[h]); else PG8_STAGE(PG8_SA(b, h), (kptr) + (h) * hstepA, voffA); } while (0)
#define PG8_GLOOKUP(VG, ui_) do { _Pragma("unroll") for (int _h = 0; _h < 2; ++_h) _Pragma("unroll") for (int _i = 0; _i < 2; ++_i) { int R_, C_; stage_rc(tid * 16 + _i * 8192, R_, C_); \
        VG[_h][_i] = (unsigned)S.tokL[(ui_) * 256 + _h * 128 + R_] * (unsigned)(lda * 2) + (unsigned)(C_ * 2); } } while (0)
#define PG8_LDA(dst, b, h) do { _Pragma("unroll") for (int m = 0; m < 4; ++m) _Pragma("unroll") for (int k = 0; k < 2; ++k) dst[m][k] = *(const LAS bf16x8*)(lds + PG8_SA(b, h) + aoff + m * 2048 + k * 1024); } while (0)
#define PG8_LDB(dst, b, h) do { _Pragma("unroll") for (int n = 0; n < 2; ++n) _Pragma("unroll") for (int k = 0; k < 2; ++k) dst[n][k] = *(const LAS bf16x8*)(lds + PG8_SB(b, h) + boff + n * 2048 + k * 1024); } while (0)
#define PG8_MMA(ai, bj, At, Bt) do { __builtin_amdgcn_s_setprio(1); _Pragma("unroll") for (int m = 0; m < 4; ++m) _Pragma("unroll") for (int n = 0; n < 2; ++n) _Pragma("unroll") for (int k = 0; k < 2; ++k) \
        acc[ai][bj][m][n] = __builtin_amdgcn_mfma_f32_16x16x32_bf16(Bt[n][k], At[m][k], acc[ai][bj][m][n], 0, 0, 0); __builtin_amdgcn_s_setprio(0); } while (0)
#define PG8_WAIT_V(n) asm volatile("s_waitcnt vmcnt(" #n ")" ::: "memory")
#define PG8_WAIT_L(n) asm volatile("s_waitcnt lgkmcnt(" #n ")" ::: "memory")
#define PG8_BAR __builtin_amdgcn_s_barrier()
#define PG8_SCHED __builtin_amdgcn_sched_barrier(0)
    Unit cur, nxt; int ui = 0;
    if (!S.next(0, cur)) return;
    if constexpr (Sched::VARK) nt = cur.nt;
    typename Epi::Pre pre = E.prefetch(cur, wr, fr);
    Acc acc;
#pragma unroll
    for (int a = 0; a < 2; ++a)
#pragma unroll
        for (int b = 0; b < 2; ++b)
#pragma unroll
            for (int m = 0; m < 4; ++m)
#pragma unroll
                for (int n = 0; n < 2; ++n) acc[a][b][m][n] = (f32x4){0.f, 0.f, 0.f, 0.f};
    bf16x8 At[4][2], B0[2][2], B1[2][2];
    const char* cA = cur.A; const char* cB = cur.B;
    unsigned vg[2][2] = {{0u, 0u}, {0u, 0u}}; if constexpr (Sched::GATHER) PG8_GLOOKUP(vg, 0);
    PG8_STAGE(PG8_SB(0, 0), cB, voffB); PG8_STAGE(PG8_SB(0, 1), cB + hstepB, voffB); PG8_STA(0, 0, cA, vg); PG8_STA(0, 1, cA, vg);
    if (wr == 1) PG8_BAR;
    PG8_WAIT_V(2); PG8_BAR;
    PG8_STAGE(PG8_SB(1, 0), cB + kstepB, voffB); PG8_STA(1, 0, cA + kstep, vg); PG8_STAGE(PG8_SB(1, 1), cB + hstepB + kstepB, voffB);
    PG8_WAIT_V(6); PG8_BAR;
    for (;;) {
        const bool has_next = S.next(ui + 1, nxt);
        const char* nA = has_next ? nxt.A : cA; const char* nB = has_next ? nxt.B : cB;
        for (int t = 0; t < nt; t += 2) {
            const bool last = (t == nt - 2);
            const char* a1 = cA + (size_t)(t + 1) * kstep;
            const char* a2 = last ? nA : cA + (size_t)(t + 2) * kstep; const char* b2 = last ? nB : cB + (size_t)(t + 2) * kstepB;
            const char* a3 = a2 + kstep; const char* b3 = b2 + kstepB;
            PG8_LDB(B0, 0, 0); PG8_LDB(B1, 0, 1); PG8_SCHED; PG8_LDA(At, 0, 0); PG8_STA(1, 1, a1, vg);
            if constexpr (Sched::GATHER) { if (last && has_next) PG8_GLOOKUP(vg, ui + 1); }
            PG8_WAIT_V(8); PG8_WAIT_L(0); PG8_BAR; PG8_MMA(0, 0, At, B0); PG8_MMA(0, 1, At, B1); PG8_BAR; PG8_SCHED;
            PG8_LDA(At, 0, 1); PG8_STAGE(PG8_SB(0, 0), b2, voffB); PG8_STAGE(PG8_SB(0, 1), b2 + hstepB, voffB); PG8_STA(0, 0, a2, vg);
            PG8_WAIT_V(8); PG8_WAIT_L(0); PG8_BAR; PG8_MMA(1, 0, At, B0); PG8_MMA(1, 1, At, B1); PG8_BAR; PG8_SCHED;
            PG8_LDB(B0, 1, 0); PG8_LDB(B1, 1, 1); PG8_SCHED; PG8_LDA(At, 1, 0); PG8_STA(0, 1, a2, vg);
            PG8_WAIT_V(8); PG8_WAIT_L(0); PG8_BAR; PG8_MMA(0, 0, At, B0); PG8_MMA(0, 1, At, B1); PG8_BAR; PG8_SCHED;
            PG8_LDA(At, 1, 1); PG8_STAGE(PG8_SB(1, 0), b3, voffB); PG8_STAGE(PG8_SB(1, 1), b3 + hstepB, voffB); PG8_STA(1, 0, a3, vg);
            PG8_WAIT_V(8); PG8_WAIT_L(0); PG8_BAR; PG8_MMA(1, 0, At, B0); PG8_MMA(1, 1, At, B1); PG8_BAR; PG8_SCHED;
        }
        if (wr == 0) PG8_BAR;
        E(acc, cur, wr, wc, fr, fq, pre);
        if (!has_next) break;
        pre = E.prefetch(nxt, wr, fr);
        if constexpr (!Epi::KEEP_ACC)
#pragma unroll
        for (int a = 0; a < 2; ++a)
#pragma unroll
            for (int b = 0; b < 2; ++b)
#pragma unroll
                for (int m = 0; m < 4; ++m)
#pragma unroll
                    for (int n = 0; n < 2; ++n) acc[a][b][m][n] = (f32x4){0.f, 0.f, 0.f, 0.f};
        cur = nxt; cA = nA; cB = nB; ++ui;
        if constexpr (Sched::VARK) nt = cur.nt;
        if (wr == 1) PG8_BAR;
    }
    PG8_WAIT_V(0);
    PG8_BAR;
#undef PG8_SA
#undef PG8_SB
#undef PG8_STAGE
#undef PG8_LDA
#undef PG8_STA
#undef PG8_GLOOKUP
#undef PG8_LDB
#undef PG8_MMA
#undef PG8_WAIT_V
#undef PG8_WAIT_L
#undef PG8_BAR
#undef PG8_SCHED
}

#define EPI_FOR _Pragma("unroll") for (int ai = 0; ai < 2; ++ai) _Pragma("unroll") for (int m = 0; m < 4; ++m)
#define EPI_ROW (u.pm * BM + ai * HALF + wr * 64 + m * 16 + fr)
#define EPI_C8(bj) (u.pn * BM + (bj) * HALF + wc * 32 + 8 * fq)
#define EPI_LOAD_R(rr, ptr) float rr[2][4]; _Pragma("unroll") for (int ai = 0; ai < 2; ++ai) _Pragma("unroll") for (int m = 0; m < 4; ++m) rr[ai][m] = (ptr)[EPI_ROW]; asm volatile("" ::: "memory")

#define EPI_LOAD_RS(rr, xstat) float rr[2][4]; { f32x4 st_[2][4]; _Pragma("unroll") for (int ai = 0; ai < 2; ++ai) _Pragma("unroll") for (int m = 0; m < 4; ++m) st_[ai][m] = *(const f32x4*)((xstat) + (size_t)EPI_ROW * 16 + 4 * fq); \
    asm volatile("" ::: "memory"); _Pragma("unroll") for (int ai = 0; ai < 2; ++ai) _Pragma("unroll") for (int m = 0; m < 4; ++m) { float t_ = (st_[ai][m][0] + st_[ai][m][1]) + (st_[ai][m][2] + st_[ai][m][3]); \
        t_ += __shfl_xor(t_, 16); t_ += __shfl_xor(t_, 32); rr[ai][m] = __builtin_amdgcn_rsqf(t_ * (1.f / D) + EPS); } }
struct NoPre {};
#define EPI_NOPRE static constexpr bool KEEP_ACC = false; typedef NoPre Pre; __device__ __forceinline__ Pre prefetch(const Unit&, int, int) const { return Pre{}; }
struct RowPre { float r[2][4]; };
struct EpiInProj {
    unsigned char* ws; const float* bgate; int layer; int from_stats;
    static constexpr bool KEEP_ACC = false; typedef RowPre Pre;
    __device__ __forceinline__ Pre prefetch(const Unit& u, int wr, int fr) const { Pre p; const float* rx = (const float*)(ws + WS_RX);
#pragma unroll
        for (int ai = 0; ai < 2; ++ai)
#pragma unroll
            for (int m = 0; m < 4; ++m) p.r[ai][m] = from_stats ? 0.f : rx[EPI_ROW];
        return p; }
    __device__ __forceinline__ void operator()(const Acc& acc, const Unit& u, int wr, int wc, int fr, int fq, const Pre& pre) const {
        const float* rx = (const float*)(ws + WS_RX); const float* rope = (const float*)(ws + WS_ROPE);
        bf16* CQ = (bf16*)(ws + WS_CQ); bf16* KR = (bf16*)(ws + WS_KR); bf16* CKV = (bf16*)(ws + WS_CKV); bf16* U = (bf16*)(ws + WS_U); bf16* VR = (bf16*)(ws + WS_VR); bf16* QX = (bf16*)(ws + WS_QX); bf16* GATE = (bf16*)(ws + WS_GATE);
        float* cqstat = (float*)(ws + WS_CQSTAT); float* ckvstat = (float*)(ws + WS_CKVSTAT); float* vstat = (float*)(ws + WS_VSTAT); unsigned* kmax = (unsigned*)(ws + WS_CTL) + CW_KMAX + layer * 32;
        const int pn = u.pn;
        float rr[2][4];
        if (from_stats) { EPI_LOAD_RS(rs_, (const float*)(ws + WS_XSTAT));
#pragma unroll
            for (int ai = 0; ai < 2; ++ai)
#pragma unroll
                for (int m = 0; m < 4; ++m) rr[ai][m] = rs_[ai][m]; }
        else {
#pragma unroll
            for (int ai = 0; ai < 2; ++ai)
#pragma unroll
                for (int m = 0; m < 4; ++m) rr[ai][m] = pre.r[ai][m]; }
        if (pn < 2) {
            float krmax = 0.f;
            EPI_FOR { const int row = EPI_ROW;
                const float r = rr[ai][m]; float ss = 0.f;
#pragma unroll
                for (int bj = 0; bj < 2; ++bj) { const f32x4 v0 = acc[ai][bj][m][0] * r, v1 = acc[ai][bj][m][1] * r;
                    if (!(pn == 1 && bj == 1)) ss += sumsq4(v0) + sumsq4(v1);
                    *(u32x4*)(CQ + (size_t)row * 512 + pn * 256 + bj * HALF + wc * 32 + 8 * fq) = pack8(v0, v1);
                    if (pn == 1 && bj == 1 && wc == 0) {
                        const f32x4 c = *(const f32x4*)(rope + (size_t)row * 32 + 4 * fq), s = *(const f32x4*)(rope + (size_t)row * 32 + 16 + 4 * fq);
                        const f32x4 o0 = v0 * c - v1 * s, o1 = v0 * s + v1 * c;
                        *(u32x4*)(KR + (size_t)row * 32 + 8 * fq) = pack8(o0, o1);
                        float q2 = sumsq4(o0) + sumsq4(o1); q2 += __shfl_xor(q2, 16); q2 += __shfl_xor(q2, 32); krmax = fmaxf(krmax, q2); } }
                ss += __shfl_xor(ss, 16); ss += __shfl_xor(ss, 32);
                if (fq == 0) cqstat[(size_t)row * 8 + pn * 4 + wc] = ss;
            }
            if (pn == 1 && wc == 0) {
#pragma unroll
                for (int o = 1; o < 16; o <<= 1) krmax = fmaxf(krmax, __shfl_xor(krmax, o));
                if ((fr | fq) == 0) atomicMax(kmax + 16, __float_as_uint(krmax)); }
        } else if (pn == 2) {
            EPI_FOR { const int row = EPI_ROW;
                const float r = rr[ai][m]; float ss = 0.f;
#pragma unroll
                for (int bj = 0; bj < 2; ++bj) { const f32x4 v0 = acc[ai][bj][m][0] * r, v1 = acc[ai][bj][m][1] * r; ss += sumsq4(v0) + sumsq4(v1);
                    *(u32x4*)(CKV + (size_t)row * 256 + bj * HALF + wc * 32 + 8 * fq) = pack8(v0, v1); }
                ss += __shfl_xor(ss, 16); ss += __shfl_xor(ss, 32);
                if (fq == 0) ckvstat[(size_t)row * 4 + wc] = ss;
            }
        } else if (pn < 7) {
            const bool isv = pn >= 5; bf16* dst = isv ? VR : U; const int t = isv ? pn - 5 : pn - 3;
            EPI_FOR { const int row = EPI_ROW;
                const float r = rr[ai][m]; float ss = 0.f;
#pragma unroll
                for (int bj = 0; bj < 2; ++bj) { f32x4 v0 = acc[ai][bj][m][0] * r, v1 = acc[ai][bj][m][1] * r;
#pragma unroll
                    for (int e = 0; e < 4; ++e) { v0[e] = gelu_tanh(v0[e]); v1[e] = gelu_tanh(v1[e]); }
                    ss += sumsq4(v0) + sumsq4(v1);
                    *(u32x4*)(dst + (size_t)row * 512 + t * 256 + bj * HALF + wc * 32 + 8 * fq) = pack8(v0, v1); }
                if (isv) { ss += __shfl_xor(ss, 16); ss += __shfl_xor(ss, 32); if (fq == 0) vstat[(size_t)row * 8 + t * 4 + wc] = ss; }
            }
        } else if (pn < 9) {
            EPI_FOR { const int row = EPI_ROW;
                const float r = rr[ai][m];
#pragma unroll
                for (int bj = 0; bj < 2; ++bj) *(u32x4*)(QX + (size_t)row * 512 + (pn - 7) * 256 + bj * HALF + wc * 32 + 8 * fq) = pack8(acc[ai][bj][m][0] * r, acc[ai][bj][m][1] * r);
            }
        } else {
            const int gc0 = (pn - 9) * 256 + wc * 32 + 8 * fq;
            f32x4 bg[2][2];
#pragma unroll
            for (int bj = 0; bj < 2; ++bj) { bg[bj][0] = *(const f32x4*)(bgate + gc0 + bj * HALF); bg[bj][1] = *(const f32x4*)(bgate + gc0 + bj * HALF + 4); }
            EPI_FOR { const int row = EPI_ROW;
                const float r = rr[ai][m];
#pragma unroll
                for (int bj = 0; bj < 2; ++bj) { f32x4 v0 = acc[ai][bj][m][0] * r + bg[bj][0], v1 = acc[ai][bj][m][1] * r + bg[bj][1];
#pragma unroll
                    for (int e = 0; e < 4; ++e) { v0[e] = sigmoidf_(v0[e]); v1[e] = sigmoidf_(v1[e]); }
#ifdef DBG_CONSTGATE
                    v0 = acc[ai][bj][m][0] * r; v1 = acc[ai][bj][m][1] * r;
#endif
                    *(u32x2*)((unsigned char*)GATE + (size_t)row * 3072 + gc0 + bj * HALF) = pack8_u8(v0, v1); }
            }
        }
    }
};
struct EpiMemKV {
    bf16* KV;
    EPI_NOPRE
    __device__ __forceinline__ void operator()(const Acc& acc, const Unit& u, int wr, int wc, int fr, int fq, const Pre&) const {
        EPI_FOR { const int row = EPI_ROW;
#pragma unroll
            for (int bj = 0; bj < 2; ++bj) *(u32x4*)(KV + (size_t)u.aux * 256 * 1024 + (size_t)row * 1024 + EPI_C8(bj)) = pack8(acc[ai][bj][m][0], acc[ai][bj][m][1]);
        }
    }
};
struct EpiQ {
    const float* cqstat; const float* rope; bf16* Q;
    EPI_NOPRE
    __device__ __forceinline__ void operator()(const Acc& acc, const Unit& u, int wr, int wc, int fr, int fq, const Pre&) const {
        EPI_FOR { const int row = EPI_ROW;
            const f32x4 s0 = *(const f32x4*)(cqstat + (size_t)row * 8), s1 = *(const f32x4*)(cqstat + (size_t)row * 8 + 4);
            const float r = __builtin_amdgcn_rsqf(((s0[0] + s0[1]) + (s0[2] + s0[3]) + (s1[0] + s1[1]) + (s1[2] + s1[3])) * (1.f / QRANK) + EPS);
#pragma unroll
            for (int bj = 0; bj < 2; ++bj) { f32x4 v0 = acc[ai][bj][m][0] * r, v1 = acc[ai][bj][m][1] * r;
                if (((8 * u.pn + 4 * bj + wc) % 3) == 2) {
                    const f32x4 c = *(const f32x4*)(rope + (size_t)row * 32 + 4 * fq), s = *(const f32x4*)(rope + (size_t)row * 32 + 16 + 4 * fq);
                    const f32x4 o0 = v0 * c - v1 * s, o1 = v0 * s + v1 * c; v0 = o0; v1 = o1; }
                *(u32x4*)(Q + (size_t)row * 768 + EPI_C8(bj)) = pack8(v0, v1); }
        }
    }
};
struct EpiKV {
    const float* ckvstat; bf16* KN; bf16* V; unsigned* kmax;
    EPI_NOPRE
    __device__ __forceinline__ void operator()(const Acc& acc, const Unit& u, int wr, int wc, int fr, int fq, const Pre&) const {
        bf16* dst = u.pn < 2 ? KN : V; const int t = u.pn & 1; float hm[2] = {0.f, 0.f};
        EPI_FOR { const int row = EPI_ROW;
            const f32x4 s0 = *(const f32x4*)(ckvstat + (size_t)row * 4);
            const float r = __builtin_amdgcn_rsqf(((s0[0] + s0[1]) + (s0[2] + s0[3])) * (1.f / KVRANK) + EPS);
#pragma unroll
            for (int bj = 0; bj < 2; ++bj) { const f32x4 v0 = acc[ai][bj][m][0] * r, v1 = acc[ai][bj][m][1] * r;
                *(u32x4*)(dst + (size_t)row * 512 + t * 256 + bj * HALF + wc * 32 + 8 * fq) = pack8(v0, v1);
                float q2 = sumsq4(v0) + sumsq4(v1); q2 += __shfl_xor(q2, 16); q2 += __shfl_xor(q2, 32); hm[bj] = fmaxf(hm[bj], q2); }
        }
        if (u.pn < 2) {
#pragma unroll
            for (int bj = 0; bj < 2; ++bj) { float v = hm[bj];
#pragma unroll
                for (int o = 1; o < 16; o <<= 1) v = fmaxf(v, __shfl_xor(v, o));
                if ((fr | fq) == 0) atomicMax(kmax + 2 * (4 * u.pn + 2 * bj + (wc >> 1)) + (wc & 1), __float_as_uint(v)); }
        }
    }
};
struct EpiBranch {
    const unsigned char* GATE; bf16* MIXB;
    static constexpr bool KEEP_ACC = true; typedef NoPre Pre; __device__ __forceinline__ Pre prefetch(const Unit&, int, int) const { return Pre{}; }
    __device__ __forceinline__ void operator()(Acc& acc, const Unit& u, int wr, int wc, int fr, int fq, const Pre&) const {
        const int n = u.aux;
#pragma unroll
        for (int ai = 0; ai < 2; ++ai) {
            u32x2 gw[4][2], gn[4][2];
#pragma unroll
            for (int m = 0; m < 4; ++m)
#pragma unroll
                for (int bj = 0; bj < 2; ++bj) { const unsigned char* gp = GATE + (size_t)EPI_ROW * 3072 + n * 1024 + EPI_C8(bj);
                    gw[m][bj] = *(const u32x2*)gp; if (n < 2) gn[m][bj] = *(const u32x2*)(gp + 1024); }
            asm volatile("" ::: "memory");
#pragma unroll
            for (int m = 0; m < 4; ++m)
#pragma unroll
                for (int bj = 0; bj < 2; ++bj) {
                    f32x4 g0, g1; unpack8_u8(gw[m][bj], g0, g1);
#pragma unroll
                    for (int e = 0; e < 4; ++e) { g0[e] = fmaxf(g0[e], 0.001953125f); g1[e] = fmaxf(g1[e], 0.001953125f); }
                    if (n < 2) { f32x4 h0, h1; unpack8_u8(gn[m][bj], h0, h1);
#pragma unroll
                        for (int e = 0; e < 4; ++e) { g0[e] *= fast_rcp(fmaxf(h0[e], 0.001953125f)); g1[e] *= fast_rcp(fmaxf(h1[e], 0.001953125f)); }
                        acc[ai][bj][m][0] *= g0; acc[ai][bj][m][1] *= g1; }
                    else *(u32x4*)(MIXB + (size_t)u.pm * 256 * 1024 + (size_t)(4 * u.pn + 2 * bj + (wc >> 1)) * 16384 + (ai * HALF + wr * 64 + m * 16 + fr) * 64 + (wc & 1) * 32 + 8 * fq) = pack8(acc[ai][bj][m][0] * g0, acc[ai][bj][m][1] * g1);
                }
        }
        if (n == 2) {
#pragma unroll
            for (int ai = 0; ai < 2; ++ai)
#pragma unroll
                for (int bj = 0; bj < 2; ++bj)
#pragma unroll
                    for (int m = 0; m < 4; ++m) { acc[ai][bj][m][0] = (f32x4){0.f, 0.f, 0.f, 0.f}; acc[ai][bj][m][1] = (f32x4){0.f, 0.f, 0.f, 0.f}; }
        }
    }
};
struct EpiResid {
    const float* X; float* Xo; bf16* XB; float* xstat;
    EPI_NOPRE
    __device__ __forceinline__ void operator()(const Acc& acc, const Unit& u, int wr, int wc, int fr, int fq, const Pre&) const {
#pragma unroll
        for (int ai = 0; ai < 2; ++ai) {
            f32x4 xv[4][2][2];
#pragma unroll
            for (int m = 0; m < 4; ++m)
#pragma unroll
                for (int bj = 0; bj < 2; ++bj) { const float* xp = X + (size_t)EPI_ROW * 1024 + EPI_C8(bj); xv[m][bj][0] = *(const f32x4*)xp; xv[m][bj][1] = *(const f32x4*)(xp + 4); }
            asm volatile("" ::: "memory");
#pragma unroll
            for (int m = 0; m < 4; ++m) { const int row = EPI_ROW; float ss = 0.f;
#pragma unroll
                for (int bj = 0; bj < 2; ++bj) { const int col = EPI_C8(bj); float* xp = Xo + (size_t)row * 1024 + col;
                    const f32x4 v0 = xv[m][bj][0] + acc[ai][bj][m][0], v1 = xv[m][bj][1] + acc[ai][bj][m][1];
                    *(f32x4*)xp = v0; *(f32x4*)(xp + 4) = v1; ss += sumsq4(v0) + sumsq4(v1);
                    *(u32x4*)(XB + (size_t)row * 1024 + col) = pack8(v0, v1); }
                ss += __shfl_xor(ss, 16); ss += __shfl_xor(ss, 32);
                if (fq == 0) xstat[(size_t)row * 16 + u.pn * 4 + wc] = ss; }
        }
    }
};
struct EpiSwiGLU {
    const float* rs; bf16* Hh; int ldh; int from_stats;
    static constexpr bool KEEP_ACC = false; typedef RowPre Pre;
    __device__ __forceinline__ Pre prefetch(const Unit& u, int wr, int fr) const { Pre p;
#pragma unroll
        for (int ai = 0; ai < 2; ++ai)
#pragma unroll
            for (int m = 0; m < 4; ++m) p.r[ai][m] = from_stats ? 0.f : rs[EPI_ROW];
        return p; }
    __device__ __forceinline__ void operator()(const Acc& acc, const Unit& u, int wr, int wc, int fr, int fq, const Pre& pre) const {
        float rr[2][4];
        if (from_stats) { EPI_LOAD_RS(rs_, rs);
#pragma unroll
            for (int ai = 0; ai < 2; ++ai)
#pragma unroll
                for (int m = 0; m < 4; ++m) rr[ai][m] = rs_[ai][m]; }
        else {
#pragma unroll
            for (int ai = 0; ai < 2; ++ai)
#pragma unroll
                for (int m = 0; m < 4; ++m) rr[ai][m] = pre.r[ai][m]; }
        bf16* hbase = Hh + (size_t)u.pm * 256 * ldh + (size_t)(2 * u.pn + (wc >> 1)) * 16384 + (wr * 64 + fr) * 64 + (wc & 1) * 32 + 8 * fq;
        EPI_FOR { const int row = EPI_ROW;
            const float r = rr[ai][m];
            f32x4 a0 = acc[ai][0][m][0] * r, a1 = acc[ai][0][m][1] * r; const f32x4 b0 = acc[ai][1][m][0] * r, b1 = acc[ai][1][m][1] * r;
#pragma unroll
            for (int e = 0; e < 4; ++e) { a0[e] = a0[e] * sigmoidf_(a0[e]) * b0[e]; a1[e] = a1[e] * sigmoidf_(a1[e]) * b1[e]; }
            (void)row; *(u32x4*)(hbase + (ai * HALF + m * 16) * 64) = pack8(a0, a1);
        }
    }
};
struct EpiBf16 {
    bf16* C; int ldc;
    EPI_NOPRE
    __device__ __forceinline__ void operator()(const Acc& acc, const Unit& u, int wr, int wc, int fr, int fq, const Pre&) const {
        EPI_FOR { const int row = EPI_ROW;
#pragma unroll
            for (int bj = 0; bj < 2; ++bj) *(u32x4*)(C + (size_t)row * ldc + EPI_C8(bj)) = pack8(acc[ai][bj][m][0], acc[ai][bj][m][1]);
        }
    }
};
template <int CC>
__device__ __forceinline__ void ks_reduce(const float* part, int x, int r, int k, int tid, bf16* C, int ldc, const Unit& u, int wr, int wc, int fr, int fq) {
    for (int sp = k; sp < 16; sp += CC) { const int ai = sp >> 3, bj = (sp >> 2) & 1, m = sp & 3;
        f32x4 v0[CC], v1[CC];
#pragma unroll
        for (int kk = 0; kk < CC; ++kk) { const float* q = part + (size_t)(x + 8 * (r * CC + kk)) * 65536 + tid * 4 + sp * 4096; v0[kk] = *(const f32x4*)q; v1[kk] = *(const f32x4*)(q + 2048); }
        f32x4 s0 = v0[0], s1 = v1[0];
#pragma unroll
        for (int kk = 1; kk < CC; ++kk) { s0 += v0[kk]; s1 += v1[kk]; }
        const int row = u.pm * BM + ai * HALF + wr * 64 + m * 16 + fr;
        *(u32x4*)(C + (size_t)row * ldc + u.pn * BM + bj * HALF + wc * 32 + 8 * fq) = pack8(s0, s1); }
}
struct EpiBf16KS {
    bf16* C; int ldc; float* part; unsigned* cnt; int c;
    EPI_NOPRE
    __device__ __forceinline__ void operator()(const Acc& acc, const Unit& u, int wr, int wc, int fr, int fq, const Pre&) const {
        if (((u.aux >> 4) & 3) != 0) {
            int tid_ = threadIdx.x; asm volatile("" : "+v"(tid_));
            const int k = (u.aux >> 8) & 255, CC = (u.aux >> 16) & 255, r = u.aux >> 24, x = c & 7;
            float* p = part + (size_t)c * 65536 + tid_ * 4;
#pragma unroll
            for (int ai = 0; ai < 2; ++ai)
#pragma unroll
                for (int bj = 0; bj < 2; ++bj)
#pragma unroll
                    for (int m = 0; m < 4; ++m)
#pragma unroll
                        for (int n = 0; n < 2; ++n) *(f32x4*)(p + (((ai * 2 + bj) * 4 + m) * 2 + n) * 2048) = acc[ai][bj][m][n];
            __threadfence();
            __syncthreads();
            if (tid_ == 0) { unsigned* w = cnt + x + 8 * r; __hip_atomic_fetch_add(w, 1u, __ATOMIC_RELEASE, __HIP_MEMORY_SCOPE_AGENT);
                while (__hip_atomic_load(w, __ATOMIC_ACQUIRE, __HIP_MEMORY_SCOPE_AGENT) < (unsigned)CC) __builtin_amdgcn_s_sleep(2); }
            __syncthreads(); __builtin_amdgcn_fence(__ATOMIC_ACQUIRE, "agent");
            if (CC == 4) ks_reduce<4>(part, x, r, k, tid_, C, ldc, u, wr, wc, fr, fq);
            else ks_reduce<2>(part, x, r, k, tid_, C, ldc, u, wr, wc, fr, fq);
            return;
        }
        EPI_FOR { const int row = EPI_ROW;
#pragma unroll
            for (int bj = 0; bj < 2; ++bj) *(u32x4*)(C + (size_t)row * ldc + EPI_C8(bj)) = pack8(acc[ai][bj][m][0], acc[ai][bj][m][1]);
        }
    }
};
struct EpiF32 {
    float* C; int ldc;
    EPI_NOPRE
    __device__ __forceinline__ void operator()(const Acc& acc, const Unit& u, int wr, int wc, int fr, int fq, const Pre&) const {
        EPI_FOR { const int row = EPI_ROW;
#pragma unroll
            for (int bj = 0; bj < 2; ++bj) { float* cp = C + (size_t)row * ldc + EPI_C8(bj); *(f32x4*)cp = acc[ai][bj][m][0]; *(f32x4*)(cp + 4) = acc[ai][bj][m][1]; }
        }
    }
};
}

namespace att {
#define KSWZ(row, colB) ((row) * 256 + ((colB) ^ (((row) & 7) << 4)))
#define SBAR() __builtin_amdgcn_sched_barrier(0)
constexpr float THR = 8.f;
__device__ __forceinline__ int crow(int r, int hi) { return (r & 3) + 8 * (r >> 2) + 4 * hi; }
template <int NB> __device__ __forceinline__ int v_st(int k, int c) { const int kk = (k & ~0xC) | ((k & 4) << 1) | ((k & 8) >> 1); return ((kk >> 3) * NB + (c >> 5)) * 512 + ((kk & 7) * 32 + (c & 31)) * 2; }
__device__ __forceinline__ int v_rd_base(int lane) { return ((lane & 3) << 3) | (((lane >> 2) & 3) << 6) | (((lane >> 4) & 1) << 5) | (((lane >> 5) & 1) << 8); }
template <int OFF> __device__ __forceinline__ s16x4 tr_read(int vb) { s16x4 r; asm volatile("ds_read_b64_tr_b16 %0, %1 offset:%2" : "=&v"(r) : "v"(vb), "i"(OFF) : "memory"); return r; }

__device__ __forceinline__ void partialSM(f32x16& p0, f32x16& p1, float& m_reg, float& alpha) {
    float pmax = p0[0];
#pragma unroll
    for (int r = 1; r < 16; ++r) pmax = fmaxf(pmax, p0[r]);
#pragma unroll
    for (int r = 0; r < 16; ++r) pmax = fmaxf(pmax, p1[r]);
    { auto rr = __builtin_amdgcn_permlane32_swap(__float_as_uint(pmax), __float_as_uint(pmax), false, false); pmax = fmaxf(__uint_as_float(rr[0]), __uint_as_float(rr[1])); }
    float mn;
    if (__builtin_expect(__all(pmax - m_reg <= THR), 1)) { mn = m_reg; alpha = 1.f; }
    else { mn = fmaxf(m_reg, pmax); alpha = __builtin_amdgcn_exp2f(m_reg - mn); m_reg = mn; }
#pragma unroll
    for (int r = 0; r < 16; ++r) { p0[r] -= mn; p1[r] -= mn; }
#pragma unroll
    for (int r = 0; r < 16; ++r) p0[r] = __builtin_amdgcn_exp2f(p0[r]);
}
__device__ __forceinline__ void finishSM(f32x16& p0, f32x16& p1, float alpha, float& l_reg, bf16x8& pa0, bf16x8& pa1, bf16x8& pa2, bf16x8& pa3) {
#pragma unroll
    for (int r = 0; r < 16; ++r) p1[r] = __builtin_amdgcn_exp2f(p1[r]);
    float ps = 0;
#pragma unroll
    for (int r = 0; r < 16; ++r) ps += p0[r];
#pragma unroll
    for (int r = 0; r < 16; ++r) ps += p1[r];
    { auto rr = __builtin_amdgcn_permlane32_swap(__float_as_uint(ps), __float_as_uint(ps), false, false); ps = __uint_as_float(rr[0]) + __uint_as_float(rr[1]); }
    l_reg = l_reg * alpha + ps;
#define PK4(P, BASE, OUT) do { unsigned a0 = cvt_pk_bf16(P[BASE + 0], P[BASE + 1]), a1 = cvt_pk_bf16(P[BASE + 2], P[BASE + 3]);   \
    unsigned b0 = cvt_pk_bf16(P[BASE + 4], P[BASE + 5]), b1 = cvt_pk_bf16(P[BASE + 6], P[BASE + 7]);                              \
    auto r0 = __builtin_amdgcn_permlane32_swap(a0, b0, false, false); auto r1 = __builtin_amdgcn_permlane32_swap(a1, b1, false, false); \
    u32x4 w = {r0[0], r1[0], r0[1], r1[1]}; OUT = __builtin_bit_cast(bf16x8, w); } while (0)
    PK4(p0, 0, pa0); PK4(p0, 8, pa1); PK4(p1, 0, pa2); PK4(p1, 8, pa3);
#undef PK4
}
template <int ND0> __device__ __forceinline__ void qkt(f32x16& p0, f32x16& p1, const LAS char* Ks, const bf16x8* qr, int r32, int hi, const f32x16& init) {
#pragma unroll
    for (int d0 = 0; d0 < ND0; ++d0) { const int cb = (d0 * 16 + hi * 8) * 2;
        const bf16x8 b0 = *(const LAS bf16x8*)(Ks + KSWZ(r32, cb));
        const bf16x8 b1 = *(const LAS bf16x8*)(Ks + KSWZ(32 + r32, cb));
        p0 = __builtin_amdgcn_mfma_f32_32x32x16_bf16(b0, qr[d0], d0 == 0 ? init : p0, 0, 0, 0);
        p1 = __builtin_amdgcn_mfma_f32_32x32x16_bf16(b1, qr[d0], d0 == 0 ? init : p1, 0, 0, 0); }
}
__device__ __forceinline__ void expA(f32x16& p0) {
#pragma unroll
    for (int r = 0; r < 16; ++r) p0[r] = __builtin_amdgcn_exp2f(p0[r]);
}
template <int NB, int D0> __device__ __forceinline__ void pv_one(f32x16& od, int vb, bf16x8 pa0, bf16x8 pa1, bf16x8 pa2, bf16x8 pa3) {
    const s16x4 l0 = tr_read<(0 * NB + D0) * 512>(vb), h0 = tr_read<(1 * NB + D0) * 512>(vb), l1 = tr_read<(2 * NB + D0) * 512>(vb), h1 = tr_read<(3 * NB + D0) * 512>(vb);
    const s16x4 l2 = tr_read<(4 * NB + D0) * 512>(vb), h2 = tr_read<(5 * NB + D0) * 512>(vb), l3 = tr_read<(6 * NB + D0) * 512>(vb), h3 = tr_read<(7 * NB + D0) * 512>(vb);
    asm volatile("s_waitcnt lgkmcnt(0)" ::: "memory"); SBAR();
#define PK(L, H) (bf16x8){L[0], L[1], L[2], L[3], H[0], H[1], H[2], H[3]}
    od = __builtin_amdgcn_mfma_f32_32x32x16_bf16(pa0, PK(l0, h0), od, 0, 0, 0);
    od = __builtin_amdgcn_mfma_f32_32x32x16_bf16(pa1, PK(l1, h1), od, 0, 0, 0);
    od = __builtin_amdgcn_mfma_f32_32x32x16_bf16(pa2, PK(l2, h2), od, 0, 0, 0);
    od = __builtin_amdgcn_mfma_f32_32x32x16_bf16(pa3, PK(l3, h3), od, 0, 0, 0);
#undef PK
}
template <int NB> __device__ __forceinline__ void pv_all(f32x16* o, int vb, bf16x8 pa0, bf16x8 pa1, bf16x8 pa2, bf16x8 pa3) {
    pv_one<NB, 0>(o[0], vb, pa0, pa1, pa2, pa3); pv_one<NB, 1>(o[1], vb, pa0, pa1, pa2, pa3);
    if constexpr (NB == 4) { pv_one<NB, 2>(o[2], vb, pa0, pa1, pa2, pa3); pv_one<NB, 3>(o[3], vb, pa0, pa1, pa2, pa3); }
}

template <int DQK, int D1, int DVV, bool FIXM>
__device__ __forceinline__ void attn_unit(const bf16* __restrict__ Qb, int ldq, const bf16* __restrict__ K1, int ldk1, const bf16* __restrict__ K2, int ldk2,
                                          const bf16* __restrict__ Vh, int ldv, bf16* __restrict__ Ob, int ldo, int seq, LAS char* lds, float kbound) {
    constexpr int ND0 = DQK / 16, NB = DVV / 32, CK = DQK / 8, CV = DVV / 8;
    constexpr int NKL = (64 * CK + 511) / 512, NVL = (64 * CV) / 512;
    constexpr int SHM_V = 64 * DVV * 2, SHM_K = 64 * 256;
    int tid_ = threadIdx.x; asm volatile("" : "+v"(tid_));
    const int tid = tid_, wid = tid >> 6, lane = tid & 63, r32 = lane & 31, hi = lane >> 5;
    LAS char* V_lds = lds; LAS char* K_lds = lds + 2 * SHM_V;
    LAS float* ws = (LAS float*)(lds + 2 * SHM_V + 2 * SHM_K) + wid * 64; LAS float* li_l = ws; LAS float* al_l = ws + 32;
    float m_reg = -1e30f, l_reg = 0; f32x16 o[NB]; bf16x8 qr[ND0];
#pragma unroll
    for (int d = 0; d < NB; ++d) o[d] = f32x16{};
    const bf16* Qw = Qb + (long)(wid * 32 + r32) * ldq + hi * 8;
#pragma unroll
    for (int d0 = 0; d0 < ND0; ++d0) qr[d0] = *(const bf16x8*)(Qw + d0 * 16);
    f32x16 init = f32x16{};
    if constexpr (FIXM) {
        float q2 = 0.f;
#pragma unroll
        for (int d0 = 0; d0 < ND0; ++d0) { const u32x4 w = __builtin_bit_cast(u32x4, qr[d0]); f32x4 a, b; unpack8(w, a, b); q2 += sumsq4(a) + sumsq4(b); }
        { auto rr = __builtin_amdgcn_permlane32_swap(__float_as_uint(q2), __float_as_uint(q2), false, false); q2 = __uint_as_float(rr[0]) + __uint_as_float(rr[1]); }
        const float nm = -sqrtf(q2) * kbound;
#pragma unroll
        for (int r = 0; r < 16; ++r) init[r] = nm;
        asm volatile("" : "+v"(init));
    }
    const bf16* kp[NKL]; int kstr[NKL], kdst[NKL]; bool kval[NKL];
#pragma unroll
    for (int i = 0; i < NKL; ++i) { const int c = tid + 512 * i; kval[i] = c < 64 * CK; const int cc_ = kval[i] ? c : 0; const int row = cc_ / CK, cc = cc_ % CK;
        if (cc * 8 < D1) { kp[i] = K1 + (long)row * ldk1 + cc * 8; kstr[i] = 64 * ldk1; } else { kp[i] = K2 + (long)row * ldk2 + (cc * 8 - D1); kstr[i] = 64 * ldk2; }
        kdst[i] = KSWZ(row, cc * 16); }
    const bf16* vp[NVL]; int vdst[NVL]; const int vstr = 64 * ldv;
#pragma unroll
    for (int i = 0; i < NVL; ++i) { const int c = tid + 512 * i; const int row = c / CV, cc = c % CV; vp[i] = Vh + (long)row * ldv + cc * 8; vdst[i] = v_st<NB>(row, cc * 8); }
    const int vb0 = (int)(uintptr_t)V_lds + v_rd_base(lane);
    struct { bf16x8 ks[NKL]; bf16x8 vs[NVL]; } sr_[2];
#define SLOAD(i, t) do { _Pragma("unroll") for (int q_ = 0; q_ < NVL; ++q_) sr_[i].vs[q_] = *(const bf16x8*)(vp[q_] + (long)(t) * vstr); \
    _Pragma("unroll") for (int q_ = 0; q_ < NKL; ++q_) { if (kval[q_]) sr_[i].ks[q_] = *(const bf16x8*)(kp[q_] + (long)(t) * kstr[q_]); } } while (0)
#define SWRITE(b, i) do { _Pragma("unroll") for (int q_ = 0; q_ < NVL; ++q_) *(LAS bf16x8*)(V_lds + (b) * SHM_V + vdst[q_]) = sr_[i].vs[q_]; \
    _Pragma("unroll") for (int q_ = 0; q_ < NKL; ++q_) { if (kval[q_]) *(LAS bf16x8*)(K_lds + (b) * SHM_K + kdst[q_]) = sr_[i].ks[q_]; } } while (0)
#define SWAIT() asm volatile("s_waitcnt vmcnt(%0)" :: "n"(NKL + NVL) : "memory")
#define RESC(a) do { if (__any((a) < 1.f)) { if (hi == 0) al_l[r32] = (a); asm volatile("s_waitcnt lgkmcnt(0)" ::: "memory"); \
    _Pragma("unroll") for (int d = 0; d < NB; ++d) _Pragma("unroll") for (int r = 0; r < 16; ++r) o[d][r] *= al_l[crow(r, hi)]; } } while (0)
    f32x16 pA0, pA1, pB0, pB1; float alA = 1.f, alB = 1.f; bf16x8 pa0, pa1, pa2, pa3; const int NT = seq / 64;
#define PSM(P0, P1, AL) do { if constexpr (FIXM) expA(P0); else partialSM(P0, P1, m_reg, AL); } while (0)
#define RSC(AL) do { if constexpr (!FIXM) RESC(AL); } while (0)
    SLOAD(0, 0); asm volatile("s_waitcnt vmcnt(0)" ::: "memory"); SWRITE(0, 0); __syncthreads();
    qkt<ND0>(pA0, pA1, K_lds, qr, r32, hi, init); PSM(pA0, pA1, alA);
    SLOAD(1, 1); if (2 < NT) SLOAD(0, 2);
    SWAIT(); SWRITE(1, 1); __syncthreads();
    for (int j = 1; j + 1 < NT; j += 2) {
        SBAR(); qkt<ND0>(pB0, pB1, K_lds + SHM_K, qr, r32, hi, init);
        finishSM(pA0, pA1, alA, l_reg, pa0, pa1, pa2, pa3); SBAR();
        SLOAD(1, j + 2); SBAR();
        pv_all<NB>(o, vb0, pa0, pa1, pa2, pa3); PSM(pB0, pB1, alB);
        __syncthreads(); SWAIT(); SWRITE(0, 0);
        RSC(alB); __syncthreads();
        SBAR(); qkt<ND0>(pA0, pA1, K_lds, qr, r32, hi, init);
        finishSM(pB0, pB1, alB, l_reg, pa0, pa1, pa2, pa3); SBAR();
        if (j + 3 < NT) SLOAD(0, j + 3); SBAR();
        pv_all<NB>(o, vb0 + SHM_V, pa0, pa1, pa2, pa3); PSM(pA0, pA1, alA);
        __syncthreads(); SWAIT(); SWRITE(1, 1);
        RSC(alA); __syncthreads();
    }
    SBAR(); qkt<ND0>(pB0, pB1, K_lds + SHM_K, qr, r32, hi, init);
    finishSM(pA0, pA1, alA, l_reg, pa0, pa1, pa2, pa3); SBAR();
    pv_all<NB>(o, vb0, pa0, pa1, pa2, pa3); PSM(pB0, pB1, alB);
    __syncthreads(); RSC(alB);
    finishSM(pB0, pB1, alB, l_reg, pa0, pa1, pa2, pa3); SBAR();
    pv_all<NB>(o, vb0 + SHM_V, pa0, pa1, pa2, pa3);
#undef PSM
#undef RSC
    if (hi == 0) li_l[r32] = l_reg; asm volatile("s_waitcnt lgkmcnt(0)" ::: "memory");
    float rli[16];
#pragma unroll
    for (int r = 0; r < 16; ++r) rli[r] = __builtin_amdgcn_rcpf(li_l[crow(r, hi)]);
    bf16* Ow = Ob + (long)(wid * 32) * ldo;
#pragma unroll
    for (int r = 0; r < 16; ++r) { const int orow = crow(r, hi);
#pragma unroll
        for (int d0 = 0; d0 < NB; ++d0) Ow[(long)orow * ldo + d0 * 32 + r32] = f2bf(o[d0][r] * rli[r]); }
    __syncthreads();
#undef SLOAD
#undef SWRITE
#undef SWAIT
#undef RESC
}

#define EXP4(P, B) do { P[B] = __builtin_amdgcn_exp2f(P[B]); P[B + 1] = __builtin_amdgcn_exp2f(P[B + 1]); P[B + 2] = __builtin_amdgcn_exp2f(P[B + 2]); P[B + 3] = __builtin_amdgcn_exp2f(P[B + 3]); } while (0)
#define SUM4(S, P, B) do { S += (P[B] + P[B + 1]) + (P[B + 2] + P[B + 3]); } while (0)
#define PK4X(P, BASE, OUT) do { const u32x4 w_ = {cvt_pk_bf16(P[BASE + 0], P[BASE + 1]), cvt_pk_bf16(P[BASE + 2], P[BASE + 3]), cvt_pk_bf16(P[BASE + 4], P[BASE + 5]), cvt_pk_bf16(P[BASE + 6], P[BASE + 7])}; OUT = __builtin_bit_cast(bf16x8, w_); } while (0)
typedef short v4i16_t __attribute__((ext_vector_type(4)));
__device__ __forceinline__ s16x4 vtr(const LAS char* p) { return __builtin_bit_cast(s16x4, __builtin_amdgcn_ds_read_tr16_b64_v4i16((LAS v4i16_t*)p)); }
#define KSWZ2(row, colB) ((row) * 256 + ((colB) ^ (((row) & 15) << 4)))
template <int DQK, int D1, int DVV>
__device__ __forceinline__ void attn_unit2(const bf16* __restrict__ Qb, int ldq, const bf16* __restrict__ K1, int ldk1, const bf16* __restrict__ K2, int ldk2,
                                           const bf16* __restrict__ Vh, int ldv, bf16* __restrict__ Ob, int ldo, int seq, LAS char* lds, float kbound) {
    constexpr int ND0 = DQK / 16, NB = DVV / 32, CK = DQK / 8;
    constexpr int SHM_V = 64 * DVV * 2, SHM_K = 64 * 256;
    static_assert(NB == 2 && ND0 == 6, "written for QK dim 96 / V dim 64");
    int tid_ = threadIdx.x; asm volatile("" : "+v"(tid_));
    const int tid = tid_, wid = __builtin_amdgcn_readfirstlane(tid >> 6), lane = tid & 63, r32 = lane & 31, hi = lane >> 5;
    LAS char* V_lds = lds; LAS char* K_lds = lds + 3 * SHM_V;
    LAS float* ws = (LAS float*)(lds + 3 * SHM_V + 2 * SHM_K) + wid * 64;
    LAS char* QAL = lds + 3 * SHM_V + 2 * SHM_K + 2048 + wid * (2 * ND0 * 1024) + lane * 16; LAS char* QBL = QAL + ND0 * 1024;
    float nm;
    { bf16x8 qa[ND0], qb[ND0];
      const bf16* QwA = Qb + (long)(wid * 64 + r32) * ldq + hi * 8; const bf16* QwB = QwA + (long)32 * ldq;
#pragma unroll
      for (int d0 = 0; d0 < ND0; ++d0) { qa[d0] = *(const bf16x8*)(QwA + d0 * 16); qb[d0] = *(const bf16x8*)(QwB + d0 * 16); }
      float q2a = 0.f, q2b = 0.f;
#pragma unroll
      for (int d0 = 0; d0 < ND0; ++d0) { f32x4 a, b; unpack8(__builtin_bit_cast(u32x4, qa[d0]), a, b); q2a += sumsq4(a) + sumsq4(b); unpack8(__builtin_bit_cast(u32x4, qb[d0]), a, b); q2b += sumsq4(a) + sumsq4(b);
          *(LAS bf16x8*)(QAL + d0 * 1024) = qa[d0]; *(LAS bf16x8*)(QBL + d0 * 1024) = qb[d0]; }
      { auto rr = __builtin_amdgcn_permlane32_swap(__float_as_uint(q2a), __float_as_uint(q2a), false, false); q2a = __uint_as_float(rr[0]) + __uint_as_float(rr[1]); }
      { auto rr = __builtin_amdgcn_permlane32_swap(__float_as_uint(q2b), __float_as_uint(q2b), false, false); q2b = __uint_as_float(rr[0]) + __uint_as_float(rr[1]); }
      nm = -sqrtf(fmaxf(q2a, q2b)) * kbound; }
    const bf16* kp[2]; int kstr[2];
#pragma unroll
    for (int i = 0; i < 2; ++i) { const int row = 8 * wid + 4 * i + (lane >> 4), cc = (lane & 15) ^ (row & 15);
        if (cc >= 8 && cc < CK) { kp[i] = K2 + (long)row * ldk2 + (cc * 8 - D1); kstr[i] = 64 * ldk2; } else { kp[i] = K1 + (long)row * ldk1 + (cc < 8 ? cc * 8 : 0); kstr[i] = 64 * ldk1; } }
    const bf16* vp; { const int k = 8 * wid + ((lane & 31) >> 2); vp = Vh + (long)k * ldv + (lane >> 5) * 32 + (lane & 3) * 8; }
    const int vstr = 64 * ldv;
    const LAS char* vrd0 = V_lds + v_rd_base(lane);
#define DMA2(t, kb, vbuf) do { \
    __builtin_amdgcn_global_load_lds((const unsigned*)(kp[0] + (long)(t) * kstr[0]), (LAS unsigned*)(K_lds + (kb) * SHM_K + wid * 2048), 16, 0, 0); \
    __builtin_amdgcn_global_load_lds((const unsigned*)(kp[1] + (long)(t) * kstr[1]), (LAS unsigned*)(K_lds + (kb) * SHM_K + wid * 2048 + 1024), 16, 0, 0); \
    __builtin_amdgcn_global_load_lds((const unsigned*)(vp + (long)(t) * vstr), (LAS unsigned*)(V_lds + (vbuf) * SHM_V + wid * 1024), 16, 0, 0); } while (0)
#define VRD8(arr, base, D0) do { _Pragma("unroll") for (int j_ = 0; j_ < 8; ++j_) arr[j_] = vtr((base) + (j_ * NB + (D0)) * 512); } while (0)
#define PKV(arr, ks) (bf16x8){arr[2 * (ks)][0], arr[2 * (ks)][1], arr[2 * (ks)][2], arr[2 * (ks)][3], arr[2 * (ks) + 1][0], arr[2 * (ks) + 1][1], arr[2 * (ks) + 1][2], arr[2 * (ks) + 1][3]}
    f32x16 oA[2], oB[2]; oA[0] = f32x16{}; oA[1] = f32x16{}; oB[0] = f32x16{}; oB[1] = f32x16{};
    float lA = 0.f, lB = 0.f; const int NT = seq / 64;
    f32x16 a0, a1, c0, c1; bf16x8 pa0, pa1, pa2, pa3;
#define HALF1(Kb) do { \
        f32x16 init; { float nmv = nm; asm volatile("" : "+v"(nmv)); _Pragma("unroll") for (int r = 0; r < 16; ++r) init[r] = nmv; } \
        SBAR(); \
        _Pragma("unroll") for (int d0 = 0; d0 < ND0; ++d0) { const int cb = (d0 * 16 + hi * 8) * 2; \
            const bf16x8 k0 = *(const LAS bf16x8*)((Kb) + KSWZ2(r32, cb)), k1 = *(const LAS bf16x8*)((Kb) + KSWZ2(32 + r32, cb)), qv = *(const LAS bf16x8*)(QAL + d0 * 1024); \
            a0 = __builtin_amdgcn_mfma_f32_32x32x16_bf16(k0, qv, d0 == 0 ? init : a0, 0, 0, 0); \
            a1 = __builtin_amdgcn_mfma_f32_32x32x16_bf16(k1, qv, d0 == 0 ? init : a1, 0, 0, 0); } \
        SBAR(); \
        float sA = 0.f; \
        _Pragma("unroll") for (int d0 = 0; d0 < ND0; ++d0) { const int cb = (d0 * 16 + hi * 8) * 2; \
            const bf16x8 k0 = *(const LAS bf16x8*)((Kb) + KSWZ2(r32, cb)), k1 = *(const LAS bf16x8*)((Kb) + KSWZ2(32 + r32, cb)), qv = *(const LAS bf16x8*)(QBL + d0 * 1024); \
            c0 = __builtin_amdgcn_mfma_f32_32x32x16_bf16(k0, qv, d0 == 0 ? init : c0, 0, 0, 0); \
            if (d0 == 3) { EXP4(a0, 0); EXP4(a0, 4); } \
            if (d0 == 4) { EXP4(a0, 12); SUM4(sA, a0, 0); SUM4(sA, a0, 4); EXP4(a1, 0); } \
            if (d0 == 5) { EXP4(a1, 8); SUM4(sA, a1, 0); SUM4(sA, a1, 4); } \
            c1 = __builtin_amdgcn_mfma_f32_32x32x16_bf16(k1, qv, d0 == 0 ? init : c1, 0, 0, 0); \
            if (d0 == 3) { EXP4(a0, 8); } \
            if (d0 == 4) { EXP4(a1, 4); SUM4(sA, a0, 8); SUM4(sA, a0, 12); } \
            if (d0 == 5) { EXP4(a1, 12); SUM4(sA, a1, 8); SUM4(sA, a1, 12); } \
            if (d0 >= 2) SBAR(); } \
        lA += sA; \
        PK4X(a0, 0, pa0); PK4X(a0, 8, pa1); PK4X(a1, 0, pa2); PK4X(a1, 8, pa3); \
        SBAR(); } while (0)
#define HALF2(vbase) do { \
        float sB = 0.f; s16x4 va[8], vb_[8]; \
        VRD8(va, vbase, 0); VRD8(vb_, vbase, 1); \
        oA[0] = __builtin_amdgcn_mfma_f32_32x32x16_bf16(pa0, PKV(va, 0), oA[0], 0, 0, 0); SBAR(); \
        oA[1] = __builtin_amdgcn_mfma_f32_32x32x16_bf16(pa0, PKV(vb_, 0), oA[1], 0, 0, 0); EXP4(c0, 0); EXP4(c0, 4); SBAR(); \
        oA[0] = __builtin_amdgcn_mfma_f32_32x32x16_bf16(pa1, PKV(va, 1), oA[0], 0, 0, 0); EXP4(c0, 8); EXP4(c0, 12); SUM4(sB, c0, 0); SBAR(); \
        oA[1] = __builtin_amdgcn_mfma_f32_32x32x16_bf16(pa1, PKV(vb_, 1), oA[1], 0, 0, 0); EXP4(c1, 0); SUM4(sB, c0, 4); SUM4(sB, c0, 8); SBAR(); \
        oA[0] = __builtin_amdgcn_mfma_f32_32x32x16_bf16(pa2, PKV(va, 2), oA[0], 0, 0, 0); EXP4(c1, 4); SUM4(sB, c0, 12); SBAR(); \
        oA[1] = __builtin_amdgcn_mfma_f32_32x32x16_bf16(pa2, PKV(vb_, 2), oA[1], 0, 0, 0); EXP4(c1, 8); SUM4(sB, c1, 0); SBAR(); \
        oA[0] = __builtin_amdgcn_mfma_f32_32x32x16_bf16(pa3, PKV(va, 3), oA[0], 0, 0, 0); EXP4(c1, 12); SUM4(sB, c1, 4); SBAR(); \
        oA[1] = __builtin_amdgcn_mfma_f32_32x32x16_bf16(pa3, PKV(vb_, 3), oA[1], 0, 0, 0); SUM4(sB, c1, 8); SUM4(sB, c1, 12); SBAR(); \
        lB += sB; \
        PK4X(c0, 0, pa0); PK4X(c0, 8, pa1); PK4X(c1, 0, pa2); PK4X(c1, 8, pa3); \
        SBAR(); \
        VRD8(va, vbase, 0); VRD8(vb_, vbase, 1);                       \
        oB[0] = __builtin_amdgcn_mfma_f32_32x32x16_bf16(pa0, PKV(va, 0), oB[0], 0, 0, 0); \
        oB[1] = __builtin_amdgcn_mfma_f32_32x32x16_bf16(pa0, PKV(vb_, 0), oB[1], 0, 0, 0); \
        oB[0] = __builtin_amdgcn_mfma_f32_32x32x16_bf16(pa1, PKV(va, 1), oB[0], 0, 0, 0); \
        oB[1] = __builtin_amdgcn_mfma_f32_32x32x16_bf16(pa1, PKV(vb_, 1), oB[1], 0, 0, 0); \
        oB[0] = __builtin_amdgcn_mfma_f32_32x32x16_bf16(pa2, PKV(va, 2), oB[0], 0, 0, 0); \
        oB[1] = __builtin_amdgcn_mfma_f32_32x32x16_bf16(pa2, PKV(vb_, 2), oB[1], 0, 0, 0); \
        oB[0] = __builtin_amdgcn_mfma_f32_32x32x16_bf16(pa3, PKV(va, 3), oB[0], 0, 0, 0); \
        oB[1] = __builtin_amdgcn_mfma_f32_32x32x16_bf16(pa3, PKV(vb_, 3), oB[1], 0, 0, 0); \
        SBAR(); } while (0)
#define TILE_BAR() do { asm volatile("s_waitcnt vmcnt(0)" ::: "memory"); __syncthreads(); } while (0)
    DMA2(0, 0, 0);
    if (wid < 4) {
        int vs = 0;
#pragma unroll 1
        for (int t = 0; t < NT; ++t) { TILE_BAR();
            const int vn = vs == 2 ? 0 : vs + 1; if (t + 1 < NT) DMA2(t + 1, (t + 1) & 1, vn);
            HALF1(K_lds + (t & 1) * SHM_K); HALF2(vrd0 + vs * SHM_V); vs = vn; }
        TILE_BAR();
    } else {
        __builtin_amdgcn_s_setprio(1);
        TILE_BAR(); if (1 < NT) DMA2(1, 1, 1);
        HALF1(K_lds);
        int vs = 0;
#pragma unroll 1
        for (int t = 1; t < NT; ++t) { TILE_BAR();
            const int vn = vs == 2 ? 0 : vs + 1; const int vnn = vn == 2 ? 0 : vn + 1; if (t + 1 < NT) DMA2(t + 1, (t + 1) & 1, vnn);
            HALF2(vrd0 + vs * SHM_V); HALF1(K_lds + (t & 1) * SHM_K); vs = vn; }
        TILE_BAR();
        HALF2(vrd0 + vs * SHM_V);
        __builtin_amdgcn_s_setprio(0);
    }
#undef HALF1
#undef HALF2
#undef TILE_BAR
    { auto rr = __builtin_amdgcn_permlane32_swap(__float_as_uint(lA), __float_as_uint(lA), false, false); lA = __uint_as_float(rr[0]) + __uint_as_float(rr[1]); }
    { auto rr = __builtin_amdgcn_permlane32_swap(__float_as_uint(lB), __float_as_uint(lB), false, false); lB = __uint_as_float(rr[0]) + __uint_as_float(rr[1]); }
    if (hi == 0) { ws[r32] = lA; ws[32 + r32] = lB; } asm volatile("s_waitcnt lgkmcnt(0)" ::: "memory");
    bf16* Ow = Ob + (long)(wid * 64) * ldo;
#pragma unroll
    for (int r = 0; r < 16; ++r) { const int orow = crow(r, hi); const float ra = __builtin_amdgcn_rcpf(ws[orow]), rb = __builtin_amdgcn_rcpf(ws[32 + orow]);
#pragma unroll
        for (int d0 = 0; d0 < NB; ++d0) { Ow[(long)orow * ldo + d0 * 32 + r32] = f2bf(oA[d0][r] * ra); Ow[(long)(32 + orow) * ldo + d0 * 32 + r32] = f2bf(oB[d0][r] * rb); } }
    __syncthreads();
#undef DMA2
#undef VRD8
#undef PKV
}
#undef EXP4
#undef SUM4
#undef PK4X

__device__ __forceinline__ void spatial_unit(int chunk, int g, const bf16* __restrict__ U, const bf16* __restrict__ VR, const float* __restrict__ vstat, const float* __restrict__ g_sg,
                                             const bf16* __restrict__ Wsb, const float* __restrict__ b_s, bf16* __restrict__ Y, LAS char* lds) {
    int tid_ = threadIdx.x; asm volatile("" : "+v"(tid_));
    const int tid = tid_, wid = tid >> 6, lane = tid & 63, r32 = lane & 31, hi = lane >> 5, rb = wid & 3, ch = wid >> 2;
    LAS char* V_lds = lds; LAS float* rv = (LAS float*)(lds + 32768);
    const int row0 = chunk * 128;
    if (tid < 128) { const f32x4 s0 = *(const f32x4*)(vstat + (size_t)(row0 + tid) * 8), s1 = *(const f32x4*)(vstat + (size_t)(row0 + tid) * 8 + 4);
        rv[tid] = __builtin_amdgcn_rsqf(((s0[0] + s0[1]) + (s0[2] + s0[3]) + (s1[0] + s1[1]) + (s1[2] + s1[3])) * (1.f / 512.f) + EPS); }
    __syncthreads();
#pragma unroll
    for (int i = 0; i < 4; ++i) { const int c = tid + 512 * i, row = c >> 4, cc = c & 15;
        const u32x4 w = *(const u32x4*)(VR + (size_t)(row0 + row) * 512 + g * 128 + cc * 8); f32x4 a, b; unpack8(w, a, b);
        const f32x4 g0 = *(const f32x4*)(g_sg + g * 128 + cc * 8), g1 = *(const f32x4*)(g_sg + g * 128 + cc * 8 + 4); const float r = rv[row];
        *(LAS u32x4*)(V_lds + (row >> 6) * 16384 + v_st<4>(row & 63, cc * 8)) = pack8(a * r * g0, b * r * g1); }
    bf16x8 pa[8];
#pragma unroll
    for (int ks = 0; ks < 8; ++ks) pa[ks] = *(const bf16x8*)(Wsb + (size_t)g * 16384 + (size_t)(32 * rb + r32) * 128 + 16 * ks + 8 * hi);
    __syncthreads();
    f32x16 o[2]; o[0] = f32x16{}; o[1] = f32x16{};
    const int vb = (int)(uintptr_t)V_lds + v_rd_base(lane) + (2 * ch) * 512;
    pv_one<4, 0>(o[0], vb, pa[0], pa[1], pa[2], pa[3]); pv_one<4, 1>(o[1], vb, pa[0], pa[1], pa[2], pa[3]);
    pv_one<4, 0>(o[0], vb + 16384, pa[4], pa[5], pa[6], pa[7]); pv_one<4, 1>(o[1], vb + 16384, pa[4], pa[5], pa[6], pa[7]);
#pragma unroll
    for (int r = 0; r < 16; ++r) { const int i = 32 * rb + crow(r, hi); const float bias = b_s[g * 128 + i]; const size_t row = (size_t)(row0 + i);
#pragma unroll
        for (int dd = 0; dd < 2; ++dd) { const int c = g * 128 + 64 * ch + 32 * dd + r32; const float uu = bf2f(U[row * 512 + c]);
            Y[row * 1536 + 512 + c] = f2bf(uu * (o[dd][r] + bias)); } }
    __syncthreads();
}
#undef KSWZ
#undef SBAR
}

#define XB_TMO      128
#define XB_XCNT(j)  (256  + 64 * (j))
#define XB_XSUB(j)  (1280 + 64 * (j))
#define XB_XGEN(j)  (2304 + 64 * (j))
#define XB_TOP      3328
#define XB_TOPGEN   3392
#define XCD_BAR_WORDS 3456
#define XB_SPIN_CAP (1u << 18)
__device__ __forceinline__ unsigned xb_ld(unsigned* p)              { return __hip_atomic_load((GAS unsigned*)p, __ATOMIC_RELAXED, __HIP_MEMORY_SCOPE_AGENT); }
__device__ __forceinline__ unsigned xb_add(unsigned* p, unsigned v) { return __hip_atomic_fetch_add((GAS unsigned*)p, v, __ATOMIC_RELAXED, __HIP_MEMORY_SCOPE_AGENT); }
__device__ __forceinline__ unsigned xb_xcc_id() { return (unsigned)__builtin_amdgcn_s_getreg((3 << 11) | 20) & 0xFu; }
#define XB_SPIN(cond, bar) do { unsigned _sp = 0; while (cond) { __builtin_amdgcn_s_sleep(1); \
    if ((++_sp & 255u) == 0u) { if (xb_ld(&(bar)[XB_TMO])) break; if (_sp > XB_SPIN_CAP) { xb_add(&(bar)[XB_TMO], 1u); break; } } } } while (0)
struct XcdBarrier { unsigned* bar; unsigned x; volatile LAS unsigned* st; };
__device__ __forceinline__ XcdBarrier xcd_barrier_post(unsigned* bar, volatile LAS unsigned* st) {
    XcdBarrier b; b.bar = bar; b.x = (unsigned)__builtin_amdgcn_readfirstlane((int)xb_xcc_id()); b.st = st;
    if (threadIdx.x == 0) (void)xb_add(&bar[XB_XCNT(b.x)], 1u);
    return b;
}
__device__ __forceinline__ void xcd_barrier_complete(unsigned* bar, unsigned x, unsigned& nloc, unsigned& nx) {
    const unsigned G = gridDim.x * gridDim.y * gridDim.z;
    unsigned sum, cnt, mine, sp = 0u;
    for (;;) {
        sum = 0u; cnt = 0u; mine = 0u;
#pragma unroll
        for (unsigned j = 0; j < 16; ++j) { const unsigned c = xb_ld(&bar[XB_XCNT(j)]); sum += c; cnt += (c > 0u) ? 1u : 0u; mine = (j == x) ? c : mine; }
        if (sum == G) break;
        __builtin_amdgcn_s_sleep(1);
        if ((++sp & 255u) == 0u) { if (xb_ld(&bar[XB_TMO])) break; if (sp > XB_SPIN_CAP) { xb_add(&bar[XB_TMO], 1u); break; } }
    }
    nloc = mine > 0u ? mine : 1u; nx = cnt > 0u ? cnt : 1u;
}
__device__ __forceinline__ void xcd_barrier(const XcdBarrier& b) {
    asm volatile("s_waitcnt vmcnt(0)" ::: "memory");
    __syncthreads();
    if (threadIdx.x == 0) {
        unsigned* bar = b.bar; unsigned bx = b.x; asm volatile("" : "+s"(bar), "+s"(bx));
        __builtin_amdgcn_s_waitcnt(0);
        unsigned nloc = b.st[0], nx = b.st[1];
        if (nloc == 0u) { xcd_barrier_complete(bar, bx, nloc, nx); b.st[0] = nloc; b.st[1] = nx; }
        const unsigned old = xb_add(&bar[XB_XSUB(bx)], 1u);
        const unsigned gen = old / nloc;
        if (old + 1u == (gen + 1u) * nloc) {
            __builtin_amdgcn_fence(__ATOMIC_RELEASE, "agent");
            asm volatile("s_waitcnt vmcnt(0)" ::: "memory");
            const unsigned og = xb_add(&bar[XB_TOP], 1u);
            const unsigned tg = og / nx;
            if (og + 1u == (tg + 1u) * nx) xb_add(&bar[XB_TOPGEN], 1u);
            else XB_SPIN(xb_ld(&bar[XB_TOPGEN]) == tg, bar);
            __builtin_amdgcn_fence(__ATOMIC_ACQUIRE, "agent");
            xb_add(&bar[XB_XGEN(bx)], 1u);
            asm volatile("s_waitcnt vmcnt(0)" ::: "memory");
        } else {
            XB_SPIN(xb_ld(&bar[XB_XGEN(bx)]) == gen, bar);
            __builtin_amdgcn_fence(__ATOMIC_ACQUIRE, "agent");
            asm volatile("s_waitcnt vmcnt(0)" ::: "memory");
        }
    }
    __syncthreads();
}

enum { CV_NAT = 0, CV_WIN = 1, CV_WUQ = 2, CV_W13 = 3 };
__device__ __forceinline__ int ropeperm(int p) { return ((p >> 2) & 1) * 16 + 4 * (p >> 3) + (p & 3); }
__device__ __forceinline__ int cv_map(int kind, int G, int& which, float& scale, bool& perm) {
    which = 0; scale = 1.f; perm = false; const int n = G * 32;
    if (kind == CV_WIN) {
        if (n < 384) return n;
        if (n < 416) { perm = true; return 640; }
        if (n < 512) return -1;
        if (n < 768) return 384 + (n - 512);
        if (n < 1280) return 672 + (n - 768);
        if (n < 1792) return 1184 + (n - 1280);
        if (n < 2304) { scale = XSCALE; return 1696 + (n - 1792); }
        return 2208 + (n - 2304);
    }
    if (kind == CV_WUQ) { scale = QSCALE; perm = (G % 3) == 2; return n; }
    if (kind == CV_W13) { which = (n >> 7) & 1; return 128 * (n >> 8) + (n & 127); }
    return n;
}
struct CvDesc { const float* src; const float* src2; const float* gain; bf16* dst; int K, Nsrc, Nout, kind; };
__device__ __forceinline__ void cv_item(const CvDesc& d, int item, LAS char* tile, int lane) {
    const int nI = d.Nout >> 7, kb = item / nI, nb = item - kb * nI, k0 = 64 * kb, n0 = 128 * nb;
    const int nq = lane & 31, kh = lane >> 5;
    const int nout = n0 + 4 * nq, G = nout >> 5, p = nout & 31;
    int which; float scale; bool perm; const int sc = cv_map(d.kind, G, which, scale, perm);
    const bool zero = sc < 0;
    const float* W = d.src + (ptrdiff_t)which * (d.src2 - d.src) + (size_t)k0 * d.Nsrc + (zero ? 0 : sc + (perm ? ropeperm(p) : p));
#pragma unroll
    for (int half = 0; half < 2; ++half) {
        f32x4 v[16];
#pragma unroll
        for (int i = 0; i < 16; ++i) { const int k = 32 * half + 2 * i + kh; v[i] = zero ? (f32x4){0.f, 0.f, 0.f, 0.f} : *(const f32x4*)(W + (size_t)k * d.Nsrc); }
#pragma unroll
        for (int i = 0; i < 16; ++i) { const int k = 32 * half + 2 * i + kh; const float g = d.gain ? d.gain[k0 + k] * scale : scale; const f32x4 w = v[i] * g;
            *(LAS u32x2*)(tile + att::v_st<4>(k, 4 * nq)) = (u32x2){cvt_pk_bf16(w[0], w[1]), cvt_pk_bf16(w[2], w[3])}; }
    }
    LDS_WAIT(); asm volatile("" ::: "memory");
    const int vb = (int)(uintptr_t)tile + att::v_rd_base(lane);
    bf16* drow = d.dst + (size_t)(n0 >> 8) * 256 * d.K + (size_t)kb * (256 * 64) + (size_t)((n0 & 255) + nq) * 64 + 8 * kh;
#define CV_RD(D0, KS) { const s16x4 l_ = att::tr_read<((2 * KS) * 4 + D0) * 512>(vb), h_ = att::tr_read<((2 * KS + 1) * 4 + D0) * 512>(vb); \
        asm volatile("s_waitcnt lgkmcnt(0)" ::: "memory"); __builtin_amdgcn_sched_barrier(0); \
        *(bf16x8*)(drow + (32 * D0) * 64 + 16 * KS) = (bf16x8){l_[0], l_[1], l_[2], l_[3], h_[0], h_[1], h_[2], h_[3]}; }
#define CV_RD4(D0) CV_RD(D0, 0) CV_RD(D0, 1) CV_RD(D0, 2) CV_RD(D0, 3)
    CV_RD4(0) CV_RD4(1) CV_RD4(2) CV_RD4(3)
#undef CV_RD4
#undef CV_RD
    LDS_WAIT(); asm volatile("" ::: "memory");
}

struct Args {
    const float* x; const float* mem; const int* positions; const float* g_mix; const float* w_in; const float* g_q; const float* g_kv; const float* w_uq; const float* w_uk; const float* w_uv;
    const float* g_sg; const float* w_s; const float* b_s; const float* g_mem; const float* w_mkv; const float* w_br; const float* b_gate; const float* w_out; const float* g_ffn;
    const float* dense_w1; const float* dense_w3; const float* dense_w2; const float* w_router; const float* moe_w1; const float* moe_w3; const float* moe_w2; const float* g_final;
    float* out; unsigned char* ws; int dbg; int pad;
};
typedef const __attribute__((address_space(4))) Args* ArgsP;
#define FRESH(ap) ArgsP ap = kargs; asm volatile("" : "+s"(ap))
__constant__ double INVF[16] = { 1.0, 0.5623413251903491, 0.31622776601683794, 0.1778279410038923, 0.1, 0.05623413251903491, 0.03162277660168379, 0.01778279410038923,
                                 0.01, 0.005623413251903491, 0.003162277660168379, 0.001778279410038923, 0.001, 0.0005623413251903491, 0.00031622776601683794, 0.0001778279410038923 };

struct Frame { LAS unsigned char* lds; int G, NGW, bid; };
#define LOCAL_IDS int tid = threadIdx.x; asm volatile("" : "+v"(tid)); const int lane = tid & 63, wave = __builtin_amdgcn_readfirstlane(tid >> 6), gw = F.bid * NWAVES + wave; (void)lane; (void)gw

__device__ __forceinline__ void conv_run(const Frame& F, const CvDesc& d) {
    LOCAL_IDS;
    LAS char* tile = (LAS char*)(F.lds + wave * 16384);
    const int nitems = (d.K / 64) * (d.Nout / 128);
    for (int it = gw; it < nitems; it += F.NGW) cv_item(d, it, tile, lane);
}
__device__ __forceinline__ void rx_from_stats(const Frame& F, ArgsP kargs) {
    LOCAL_IDS; FRESH(ap); const float* xstat = (const float*)(ap->ws + WS_XSTAT); float* rx = (float*)(ap->ws + WS_RX);
    for (int row = F.bid * 512 + tid; row < M; row += F.G * 512) {
        const f32x4* p = (const f32x4*)(xstat + (size_t)row * 16); const f32x4 a = p[0], b = p[1], c = p[2], d = p[3];
        const float s = ((a[0] + a[1]) + (a[2] + a[3])) + ((b[0] + b[1]) + (b[2] + b[3])) + ((c[0] + c[1]) + (c[2] + c[3])) + ((d[0] + d[1]) + (d[2] + d[3]));
        rx[row] = __builtin_amdgcn_rsqf(s * (1.f / D) + EPS);
    }
}
__device__ __forceinline__ void conv_mixer(const Frame& F, ArgsP kargs, int l) {
    { FRESH(a); CvDesc d{a->w_in + (size_t)l * D * PTOT, nullptr, a->g_mix + l * D, (bf16*)(a->ws + WS_WINT), D, PTOT, PPAD, CV_WIN}; conv_run(F, d); }
    { FRESH(a); CvDesc d{a->w_uq + (size_t)l * QRANK * 768, nullptr, a->g_q + l * QRANK, (bf16*)(a->ws + WS_WUQT), QRANK, 768, 768, CV_WUQ}; conv_run(F, d); }
    { FRESH(a); CvDesc d{a->w_uk + (size_t)l * KVRANK * 512, nullptr, a->g_kv + l * KVRANK, (bf16*)(a->ws + WS_WUKVT), KVRANK, 512, 512, CV_NAT}; conv_run(F, d); }
    { FRESH(a); CvDesc d{a->w_uv + (size_t)l * KVRANK * 512, nullptr, a->g_kv + l * KVRANK, (bf16*)(a->ws + WS_WUKVT) + 512 * KVRANK, KVRANK, 512, 512, CV_NAT}; conv_run(F, d); }
#pragma unroll 1
    for (int n = 0; n < 3; ++n) { FRESH(a); CvDesc d{a->w_br + ((size_t)l * 3 + n) * BW * D, nullptr, nullptr, (bf16*)(a->ws + WS_WBRT) + (size_t)n * D * BW, BW, D, D, CV_NAT}; conv_run(F, d); }
    { FRESH(a); CvDesc d{a->w_out + (size_t)l * D * D, nullptr, nullptr, (bf16*)(a->ws + WS_WOUTT), D, D, D, CV_NAT}; conv_run(F, d); }
    { LOCAL_IDS; FRESH(a); const float* wsrc = a->w_s + (size_t)l * 65536; bf16* wdst = (bf16*)(a->ws + WS_WSB);
      for (int i = F.bid * 512 + tid; i < 4 * 128 * 128 / 4; i += F.G * 512) { const f32x4 v = *(const f32x4*)(wsrc + (size_t)i * 4);
        *(u32x2*)(wdst + (size_t)i * 4) = (u32x2){cvt_pk_bf16(v[0], v[1]), cvt_pk_bf16(v[2], v[3])}; } }
}
__device__ __forceinline__ void phase_prologue(const Frame& F, ArgsP kargs) {
    LOCAL_IDS;
    { FRESH(a); float* ROPE = (float*)(a->ws + WS_ROPE); const int* pos = a->positions;
      for (int idx = F.bid * 512 + tid; idx < M * 16; idx += F.G * 512) { const int row = idx >> 4, i = idx & 15;
        const double t = (double)pos[row] * INVF[i] * 0.15915494309189535; const float fr = (float)(t - rint(t));
        ROPE[(size_t)row * 32 + i] = __builtin_amdgcn_cosf(fr); ROPE[(size_t)row * 32 + 16 + i] = __builtin_amdgcn_sinf(fr); } }
    { FRESH(a); const float* xin = a->x; float* X = a->out; bf16* XB = (bf16*)(a->ws + WS_XB); float* RX = (float*)(a->ws + WS_RX);
      for (int m = gw; m < M; m += F.NGW) { const f32x4* xr = (const f32x4*)(xin + (size_t)m * D) + lane; f32x4 v[4]; float s = 0.f;
#pragma unroll
        for (int j = 0; j < 4; ++j) { v[j] = xr[64 * j]; s += sumsq4(v[j]); }
        s = wave_sum(s);
#pragma unroll
        for (int j = 0; j < 4; ++j) { ((f32x4*)(X + (size_t)m * D) + lane)[64 * j] = v[j]; ((u32x2*)(XB + (size_t)m * D) + lane)[64 * j] = (u32x2){cvt_pk_bf16(v[j][0], v[j][1]), cvt_pk_bf16(v[j][2], v[j][3])}; }
        if (lane == 0) RX[m] = __builtin_amdgcn_rsqf(s * (1.f / D) + EPS); } }
    { FRESH(a); const float* mem = a->mem; const float* g_mem = a->g_mem; bf16* MEMB = (bf16*)(a->ws + WS_MEMB);
      for (int m = gw; m < NMEM; m += F.NGW) { const f32x4* xr = (const f32x4*)(mem + (size_t)m * D) + lane; f32x4 v[4]; float s = 0.f;
#pragma unroll
        for (int j = 0; j < 4; ++j) { v[j] = xr[64 * j]; s += sumsq4(v[j]); }
        const float r = __builtin_amdgcn_rsqf(wave_sum(s) * (1.f / D) + EPS);
#pragma unroll
        for (int j = 0; j < 4; ++j) { const f32x4 g = ((const f32x4*)g_mem + lane)[64 * j]; const f32x4 w = v[j] * r * g;
            ((u32x2*)(MEMB + (size_t)m * D) + lane)[64 * j] = (u32x2){cvt_pk_bf16(w[0], w[1]), cvt_pk_bf16(w[2], w[3])}; } } }
#pragma unroll 1
    for (int l = 0; l < DEPTH; ++l) { FRESH(a); CvDesc d{a->w_mkv + (size_t)l * D * D, nullptr, nullptr, (bf16*)(a->ws + WS_WMKVT) + (size_t)l * D * D, D, D, D, CV_NAT}; conv_run(F, d); }
    conv_mixer(F, kargs, 0);
}
__device__ __forceinline__ void phase_inproj(const Frame& F, ArgsP kargs, int l) {
    if (PH(1)) { FRESH(a); unsigned char* ws = a->ws;
        pg8::TileOrder S{M / 256, PPAD / 256 - 1, F.G, F.bid, (const char*)(ws + WS_XB), (const char*)(ws + WS_WINT), (size_t)256 * D * 2, (size_t)256 * D * 2};
#ifdef DBG_REV
        S.rev = 1;
#endif
        pg8::EpiInProj E{ws, a->b_gate + (size_t)l * 3 * D, l, (l & 1)};
        pg8::gemm_phase(F.lds, D, D, D, S, E); }
    if (l == 0 && PH(2)) { FRESH(a); unsigned char* ws = a->ws;
        struct MemOrder { enum { VARK = 0, GATHER = 0 }; int c; const char* A; const char* B;
            __device__ __forceinline__ bool next(int i, pg8::Unit& u) const { if (i > 0 || c < 240) return false; const int idx = c - 240; u.pm = 0; u.pn = idx & 3; u.aux = idx >> 2; u.A = A; u.B = B + (size_t)u.aux * D * D * 2 + (size_t)u.pn * 256 * D * 2; return true; } };
        MemOrder S2{F.bid, (const char*)(ws + WS_MEMB), (const char*)(ws + WS_WMKVT)}; pg8::EpiMemKV E2{(bf16*)(ws + WS_KVMEM)};
        pg8::gemm_phase(F.lds, D, D, D, S2, E2); }
}
struct GateTailOrder { enum { VARK = 0, GATHER = 0 }; int c; const char* A; const char* B;
    __device__ __forceinline__ bool next(int i, pg8::Unit& u) const { if (i > 0 || c < 192) return false; u.pm = c - 192; u.pn = PPAD / 256 - 1; u.aux = 0; u.A = A + (size_t)u.pm * 256 * D * 2; u.B = B + (size_t)u.pn * 256 * D * 2; return true; } };
__device__ __forceinline__ void phase_up(const Frame& F, ArgsP kargs, int l) {
    if (PH(1)) { FRESH(a); unsigned char* ws = a->ws;
        GateTailOrder S{F.bid, (const char*)(ws + WS_XB), (const char*)(ws + WS_WINT)}; pg8::EpiInProj E{ws, a->b_gate + (size_t)l * 3 * D, l, (l & 1)};
        pg8::gemm_phase(F.lds, D, D, D, S, E); }
    if (PH(3)) { FRESH(a); unsigned char* ws = a->ws;
        pg8::TileOrder S{M / 256, 3, F.G, F.bid, (const char*)(ws + WS_CQ), (const char*)(ws + WS_WUQT), (size_t)256 * 512 * 2, (size_t)256 * QRANK * 2};
        pg8::EpiQ E{(const float*)(ws + WS_CQSTAT), (const float*)(ws + WS_ROPE), (bf16*)(ws + WS_Q)}; pg8::gemm_phase(F.lds, 512, QRANK, QRANK, S, E); }
    if (PH(4)) { FRESH(a); unsigned char* ws = a->ws;
        pg8::TileOrder S{M / 256, 4, F.G, F.bid, (const char*)(ws + WS_CKV), (const char*)(ws + WS_WUKVT), (size_t)256 * KVRANK * 2, (size_t)256 * KVRANK * 2};
        pg8::EpiKV E{(const float*)(ws + WS_CKVSTAT), (bf16*)(ws + WS_KN), (bf16*)(ws + WS_V), (unsigned*)(ws + WS_CTL) + CW_KMAX + l * 32}; pg8::gemm_phase(F.lds, KVRANK, KVRANK, KVRANK, S, E); }
    if (PH(5)) { FRESH(a); unsigned char* ws = a->ws;
        for (int un = F.bid; un < 512; un += F.G)
            att::spatial_unit(un >> 2, un & 3, (const bf16*)(ws + WS_U), (const bf16*)(ws + WS_VR), (const float*)(ws + WS_VSTAT), a->g_sg + l * BW, (const bf16*)(ws + WS_WSB), a->b_s + l * 512, (bf16*)(ws + WS_Y), (LAS char*)F.lds); }
    if (PH(6)) { FRESH(a); unsigned char* ws = a->ws;
        for (int un = F.bid; un < 256; un += F.G) { const int h = un & 3, pm = un >> 2; const bf16* kvm = (const bf16*)(ws + WS_KVMEM) + (size_t)l * 256 * 1024;
            att::attn_unit<128, 128, 128, false>((const bf16*)(ws + WS_QX) + (size_t)pm * 256 * 512 + h * 128, 512, kvm + h * 128, 1024, kvm, 1024, kvm + 512 + h * 128, 1024,
                                          (bf16*)(ws + WS_Y) + (size_t)pm * 256 * 1536 + 1024 + h * 128, 1536, NMEM, (LAS char*)F.lds, 0.f); } }
}
__device__ __forceinline__ void phase_attn(const Frame& F, ArgsP kargs, int l) {
    if (PH(7)) { FRESH(a); unsigned char* ws = a->ws;
        for (int un = F.bid; un < 256; un += F.G) { const int h = un & 7, qb = un >> 3;
            const unsigned* km = (const unsigned*)(ws + WS_CTL) + CW_KMAX + l * 32;
            const float kbound = sqrtf(__uint_as_float(km[2 * h]) + __uint_as_float(km[2 * h + 1]) + __uint_as_float(km[16])) * 1.02f;
            att::attn_unit2<96, 64, 64>((const bf16*)(ws + WS_Q) + (size_t)qb * 512 * 768 + h * 96, 768, (const bf16*)(ws + WS_KN) + h * 64, 512, (const bf16*)(ws + WS_KR), 32, (const bf16*)(ws + WS_V) + h * 64, 512,
                                        (bf16*)(ws + WS_Y) + (size_t)qb * 512 * 1536 + h * 64, 1536, M, (LAS char*)F.lds, kbound); } }
}
__device__ __forceinline__ void phase_branch(const Frame& F, ArgsP kargs) {
    if (PH(8)) { FRESH(a); unsigned char* ws = a->ws;
        struct BranchOrder { enum { VARK = 0, GATHER = 0 }; int c; const char* A; const char* B;
            __device__ __forceinline__ bool next(int i, pg8::Unit& u) const { if (i >= 3 || c >= 256) return false; int pm, pn; pg8::tile_of(c, 64, 4, pm, pn); u.pm = pm; u.pn = pn; u.aux = i;
                u.A = A + (size_t)pm * 256 * 1536 * 2 + (size_t)i * 512 * 2; u.B = B + (size_t)i * D * BW * 2 + (size_t)pn * 256 * BW * 2; return true; } };
        BranchOrder S{F.bid, (const char*)(ws + WS_Y), (const char*)(ws + WS_WBRT)}; pg8::EpiBranch E{(const unsigned char*)(ws + WS_GATE), (bf16*)(ws + WS_MIXB)};
        pg8::gemm_phase(F.lds, 1536, BW, BW, S, E); }
}
__device__ __forceinline__ void phase_outproj(const Frame& F, ArgsP kargs, bool dummy = false) {
    if (PH(9)) { FRESH(a); unsigned char* ws = a->ws;
        pg8::TileOrder S{M / 256, 4, F.G, F.bid, (const char*)(ws + WS_MIXB), (const char*)(ws + WS_WOUTT), (size_t)256 * D * 2, (size_t)256 * D * 2};
        pg8::EpiResid E{a->out, dummy ? (float*)(ws + 700 * MiB) : a->out, (bf16*)(ws + (dummy ? 764 * MiB : WS_XB)), (float*)(ws + (dummy ? 796 * MiB : WS_XSTAT))}; pg8::gemm_phase(F.lds, 0, D, D, S, E); }
}
__device__ __forceinline__ void phase_dense_conv(const Frame& F, ArgsP kargs, int l, int j2) {
    { FRESH(a); CvDesc d{a->dense_w1 + (size_t)j2 * D * DFF, a->dense_w3 + (size_t)j2 * D * DFF, a->g_ffn + l * D, (bf16*)(a->ws + WS_WFFN), D, DFF, 2 * DFF, CV_W13}; conv_run(F, d); }
    { FRESH(a); CvDesc d{a->dense_w2 + (size_t)j2 * DFF * D, nullptr, nullptr, (bf16*)(a->ws + WS_W2D), DFF, D, D, CV_NAT}; conv_run(F, d); }
    rx_from_stats(F, kargs);
    conv_mixer(F, kargs, l + 1);
}
__device__ __forceinline__ void phase_dense_up(const Frame& F, ArgsP kargs) {
    if (PH(10)) { FRESH(a); unsigned char* ws = a->ws;
        pg8::TileOrder S{M / 256, 2 * DFF / 256, F.G, F.bid, (const char*)(ws + WS_XB), (const char*)(ws + WS_WFFN), (size_t)256 * D * 2, (size_t)256 * D * 2};
        pg8::EpiSwiGLU E{(const float*)(ws + WS_RX), (bf16*)(ws + WS_HFF), DFF, 0}; pg8::gemm_phase(F.lds, D, D, D, S, E); }
}
__device__ __forceinline__ void phase_dense_down(const Frame& F, ArgsP kargs, bool dummy = false) {
    if (PH(11)) { FRESH(a); unsigned char* ws = a->ws;
        pg8::TileOrder S{M / 256, 4, F.G, F.bid, (const char*)(ws + WS_HFF), (const char*)(ws + WS_W2D), (size_t)256 * DFF * 2, (size_t)256 * DFF * 2};
        pg8::EpiResid E{a->out, dummy ? (float*)(ws + 700 * MiB) : a->out, (bf16*)(ws + (dummy ? 764 * MiB : WS_XB)), (float*)(ws + (dummy ? 796 * MiB : WS_XSTAT))}; pg8::gemm_phase(F.lds, 0, DFF, DFF, S, E); }
}
__device__ __forceinline__ void phase_moe_route(const Frame& F, ArgsP kargs, int l, int j2) {
    {
        int tid_ = threadIdx.x; asm volatile("" : "+v"(tid_)); const int lane_ = tid_ & 63, wave_ = __builtin_amdgcn_readfirstlane(tid_ >> 6);
        LAS char* tile = (LAS char*)(F.lds + wave_ * 16384);
        constexpr int I13 = (D / 64) * (2 * DFE / 128), I2 = (DFE / 64) * (D / 128), IE = I13 + I2;
#pragma unroll 1
        for (int idx = F.bid * NWAVES + wave_; idx < NE * IE; idx += F.NGW) { const int e = idx / IE, r = idx - e * IE;
            FRESH(a);
            if (r < I13) { CvDesc d{a->moe_w1 + ((size_t)j2 * NE + e) * D * DFE, a->moe_w3 + ((size_t)j2 * NE + e) * D * DFE, a->g_ffn + l * D, (bf16*)(a->ws + WS_WFFN) + (size_t)e * 2 * DFE * D, D, DFE, 2 * DFE, CV_W13}; cv_item(d, r, tile, lane_); }
            else { CvDesc d{a->moe_w2 + ((size_t)j2 * NE + e) * DFE * D, nullptr, nullptr, (bf16*)(a->ws + WS_W2M) + (size_t)e * D * DFE, DFE, D, D, CV_NAT}; cv_item(d, r - I13, tile, lane_); } }
    }
    if (l + 1 < DEPTH) conv_mixer(F, kargs, l + 1);
    __syncthreads();
    LOCAL_IDS; FRESH(a); unsigned char* ws = a->ws; const float* X = a->out;
    float* RX = (float*)(ws + WS_RX); int* TOPI = (int*)(ws + WS_TOPI); float* TOPW = (float*)(ws + WS_TOPW); int* LRANK = (int*)(ws + WS_LRANK); int* BLKCNT = (int*)(ws + WS_BLKCNT);
    LAS int* tope = (LAS int*)(F.lds + 0);
    const float* wr = a->w_router + (size_t)j2 * D * NE; const float* gf = a->g_ffn + l * D;
#pragma unroll 1
    for (int i = 0; i < 8; ++i) { const int rib = wave * 8 + i, row = F.bid * 64 + rib;
        float lg[8]; float ss = 0.f;
#pragma unroll
        for (int e = 0; e < 8; ++e) lg[e] = 0.f;
#pragma unroll
        for (int j = 0; j < 4; ++j) { const int k0 = 4 * lane + 256 * j; const f32x4 xv = *(const f32x4*)(X + (size_t)row * D + k0), gv = *(const f32x4*)(gf + k0); ss += sumsq4(xv);
#pragma unroll
            for (int q = 0; q < 4; ++q) { const float hv = xv[q] * gv[q]; const f32x4 w0 = *(const f32x4*)(wr + (size_t)(k0 + q) * 8), w1 = *(const f32x4*)(wr + (size_t)(k0 + q) * 8 + 4);
                lg[0] += hv * w0[0]; lg[1] += hv * w0[1]; lg[2] += hv * w0[2]; lg[3] += hv * w0[3]; lg[4] += hv * w1[0]; lg[5] += hv * w1[1]; lg[6] += hv * w1[2]; lg[7] += hv * w1[3]; } }
        const float r = __builtin_amdgcn_rsqf(wave_sum(ss) * (1.f / D) + EPS);
#pragma unroll
        for (int e = 0; e < 8; ++e) lg[e] = wave_sum(lg[e]) * r;
        int e0 = 0; float v0 = lg[0];
#pragma unroll
        for (int e = 1; e < 8; ++e) if (lg[e] > v0) { v0 = lg[e]; e0 = e; }
        int e1 = e0 == 0 ? 1 : 0; float v1 = -3.0e38f;
#pragma unroll
        for (int e = 0; e < 8; ++e) if (e != e0 && lg[e] > v1) { v1 = lg[e]; e1 = e; }
        const float w0 = 1.f / (1.f + expf(v1 - v0));
        if (lane == 0) { RX[row] = r; TOPI[row] = e0 | (e1 << 8); TOPW[(size_t)row * 2] = w0; TOPW[(size_t)row * 2 + 1] = 1.f - w0; tope[rib] = e0 | (e1 << 8); } }
    __syncthreads();
    if (wave == 0) { const int te = tope[lane], e0 = te & 255, e1 = te >> 8, row = F.bid * 64 + lane; const unsigned long long below = (1ull << lane) - 1ull;
        int rk0 = 0, rk1 = 0;
#pragma unroll
        for (int e = 0; e < 8; ++e) { const unsigned long long m0 = __ballot(e0 == e), m1 = __ballot(e1 == e); const int c0 = __popcll(m0);
            if (e0 == e) rk0 = __popcll(m0 & below); if (e1 == e) rk1 = c0 + __popcll(m1 & below);
            if (lane == 0) BLKCNT[F.bid * 8 + e] = c0 + __popcll(m1); }
        LRANK[(size_t)row * 2] = rk0; LRANK[(size_t)row * 2 + 1] = rk1; }
    __syncthreads();
}
__device__ __forceinline__ void moe_tiles(const Frame& F, ArgsP kargs, int (&tb)[NE + 1], LAS int* pre) {
    LOCAL_IDS; FRESH(a); const int* BLKCNT = (const int*)(a->ws + WS_BLKCNT);
    __syncthreads();
    if (tid < 16) pre[tid] = 0;
    __syncthreads();
    if (tid < 256) { const i32x4 c0 = *(const i32x4*)(BLKCNT + tid * 8), c1 = *(const i32x4*)(BLKCNT + tid * 8 + 4); const int cc[8] = {c0[0], c0[1], c0[2], c0[3], c1[0], c1[1], c1[2], c1[3]};
#pragma unroll
        for (int e = 0; e < 8; ++e) { const int tot = (int)wave_sum((float)cc[e]); const int bel = (int)wave_sum(tid < F.bid ? (float)cc[e] : 0.f);
            if (lane == 0) { __hip_atomic_fetch_add(pre + 8 + e, tot, __ATOMIC_RELAXED, __HIP_MEMORY_SCOPE_WORKGROUP); __hip_atomic_fetch_add(pre + e, bel, __ATOMIC_RELAXED, __HIP_MEMORY_SCOPE_WORKGROUP); } } }
    __syncthreads();
    int acc_t = 0;
#pragma unroll
    for (int e = 0; e < NE; ++e) { tb[e] = acc_t; acc_t += (__builtin_amdgcn_readfirstlane(pre[8 + e]) + 255) >> 8; }
    tb[NE] = acc_t;
}
__device__ __forceinline__ void phase_moe_gather(const Frame& F, ArgsP kargs) {
    int tb[NE + 1]; LAS int* pre = (LAS int*)(F.lds + 0);
    moe_tiles(F, kargs, tb, pre);
    LOCAL_IDS; FRESH(a); unsigned char* ws = a->ws;
    const int* TOPI = (const int*)(ws + WS_TOPI); const int* LRANK = (const int*)(ws + WS_LRANK); int* POS = (int*)(ws + WS_POS); float* SLOTR = (float*)(ws + WS_SLOTR); const float* RX = (const float*)(ws + WS_RX);
    int* TOKOF = (int*)(ws + WS_TOKOF);
    if (lane < 16) { const int pi = wave * 16 + lane, rib = pi >> 1, k = pi & 1, row = F.bid * 64 + rib;
        const int te = TOPI[row], e = k ? (te >> 8) : (te & 255); const int lr = LRANK[(size_t)row * 2 + k]; const float rx = RX[row];
        int bs = 0;
#pragma unroll
        for (int q = 0; q < NE; ++q) if (q == e) bs = tb[q] * 256;
        const int slot = bs + pre[e] + lr;
        POS[(size_t)row * 2 + k] = slot; SLOTR[slot] = rx; TOKOF[slot] = row; }
    if (F.bid < NE) { const int e = F.bid; int b0 = 0, b1 = 0;
#pragma unroll
        for (int q = 0; q < NE; ++q) if (q == e) { b0 = tb[q] * 256; b1 = tb[q + 1] * 256; }
        const int cnt = __builtin_amdgcn_readfirstlane(pre[8 + e]);
        for (int s = b0 + cnt + tid; s < b1; s += NWAVES * 64) { SLOTR[s] = 0.f; TOKOF[s] = 0; } }
    __syncthreads();
}
struct MoeOrder { enum { VARK = 0, GATHER = 0 }; int nN, G, c, T; int tb[NE + 1]; const char* A; const char* B; size_t astep, estep, bstep; int rev = 0;
    __device__ __forceinline__ bool next(int i, pg8::Unit& u) const { const long L = (long)i * G + c; if (L >= (long)T * nN) return false; int pm, pn; pg8::tile_of((int)L, T, nN, pm, pn); if (rev) pm = T - 1 - pm;
        int e = 0;
#pragma unroll
        for (int q = 1; q < NE; ++q) e += (pm >= tb[q]) ? 1 : 0;
        u.pm = pm; u.pn = pn; u.aux = e; u.A = A + (size_t)pm * astep; u.B = B + (size_t)e * estep + (size_t)pn * bstep; return true; } };
struct MoeUpOrder { enum { VARK = 0, GATHER = 1 }; int nN, G, c, T; int tb[NE + 1]; const char* A; const char* B; size_t estep, bstep; const LAS int* tokL;
    __device__ __forceinline__ bool next(int i, pg8::Unit& u) const { const long L = (long)i * G + c; if (L >= (long)T * nN) return false; int pm, pn; pg8::tile_of((int)L, T, nN, pm, pn);
        int e = 0;
#pragma unroll
        for (int q = 1; q < NE; ++q) e += (pm >= tb[q]) ? 1 : 0;
        u.pm = pm; u.pn = pn; u.aux = e; u.A = A; u.B = B + (size_t)e * estep + (size_t)pn * bstep; return true; } };
struct MoeTailOrder { enum { VARK = 1, GATHER = 0 }; static constexpr int PPU = DFE / 128;
    int nN, G, c, T; int tb[NE + 1]; const char* A; const char* B; size_t astep, estep, bstep; int rev = 0;
    __device__ __forceinline__ bool next(int i, pg8::Unit& u) const {
        const int U = T * nN, R = U / G, Lf = U - R * G, x = c & 7, j = c >> 3, nj = (G - x + 7) >> 3;
        const int Lfx = Lf > x ? (Lf - x + 7) >> 3 : 0;
        long L; int k0 = 0, np = PPU, part = 0, k = 0, r = 0, C = 1;
        if (i < R) L = (long)i * G + c;
        else if (i == R && Lfx > 0) { const int cap = nj / Lfx; C = cap >= 4 ? 4 : cap >= 2 ? 2 : 1;
            r = j / C; k = j - r * C; if (r >= Lfx) return false;
            L = (long)R * G + x + 8 * r; if (C > 1) { np = PPU / C; k0 = k * np; part = 3; } }
        else return false;
        int pm, pn; pg8::tile_of((int)L, T, nN, pm, pn); if (rev) pm = T - 1 - pm;
        int e = 0;
#pragma unroll
        for (int q = 1; q < NE; ++q) e += (pm >= tb[q]) ? 1 : 0;
        u.pm = pm; u.pn = pn; u.aux = e | (part << 4) | (k << 8) | (C << 16) | (r << 24); u.nt = 2 * np;
        u.A = A + (size_t)pm * astep + (size_t)k0 * 65536; u.B = B + (size_t)e * estep + (size_t)pn * bstep + (size_t)k0 * 65536; return true; } };
__device__ __forceinline__ void phase_moe_up(const Frame& F, ArgsP kargs) {
    if (PH(12)) { MoeUpOrder S; LAS int* pre = (LAS int*)(F.lds + RING_BYTES + 64); moe_tiles(F, kargs, S.tb, pre);
        FRESH(a); unsigned char* ws = a->ws; S.nN = 2 * DFE / 256; S.G = F.G; S.c = F.bid; S.T = S.tb[NE];
        S.A = (const char*)(ws + WS_XB); S.B = (const char*)(ws + WS_WFFN); S.estep = (size_t)2 * DFE * D * 2; S.bstep = (size_t)256 * D * 2;
        { LAS int* tokL = (LAS int*)(F.lds + RING_BYTES + 1024); S.tokL = tokL; const int* TOKOF = (const int*)(ws + WS_TOKOF);
          int tid_ = threadIdx.x; asm volatile("" : "+v"(tid_)); const int half_ = __builtin_amdgcn_readfirstlane(tid_ >> 8); int tkv[8];
#pragma unroll
          for (int j = 0; j < 8; ++j) { pg8::Unit u; const bool ok = S.next(2 * j + half_, u); tkv[j] = ok ? TOKOF[u.pm * 256 + (tid_ & 255)] : 0; }
#pragma unroll
          for (int j = 0; j < 8; ++j) tokL[(2 * j + half_) * 256 + (tid_ & 255)] = tkv[j];
          __syncthreads(); }
        pg8::EpiSwiGLU E{(const float*)(ws + WS_SLOTR), (bf16*)(ws + WS_HG), DFE, 0}; pg8::gemm_phase(F.lds, D, D, D, S, E); }
}
__device__ __forceinline__ void phase_moe_down(const Frame& F, ArgsP kargs, int j2) {
    if (PH(13)) { MoeTailOrder S; LAS int* pre = (LAS int*)(F.lds + RING_BYTES + 64); moe_tiles(F, kargs, S.tb, pre);
        FRESH(a); unsigned char* ws = a->ws; S.nN = 4; S.G = F.G; S.c = F.bid; S.T = S.tb[NE]; S.rev = 1;
        S.A = (const char*)(ws + WS_HG); S.B = (const char*)(ws + WS_W2M); S.astep = (size_t)256 * DFE * 2; S.estep = (size_t)D * DFE * 2; S.bstep = (size_t)256 * DFE * 2;
        pg8::EpiBf16KS E{(bf16*)(ws + WS_OUTG), D, (float*)(ws + WS_SKPART), (unsigned*)(ws + WS_CTL) + CW_SK + j2 * 512, F.bid}; pg8::gemm_phase(F.lds, 0, DFE, DFE, S, E); }
}
__device__ __forceinline__ void phase_moe_combine(const Frame& F, ArgsP kargs, bool last) {
    LOCAL_IDS; FRESH(a); unsigned char* ws = a->ws; float* X = a->out; const bf16* OUTG = (const bf16*)(ws + WS_OUTG); const int* POS = (const int*)(ws + WS_POS); const float* TOPW = (const float*)(ws + WS_TOPW);
    bf16* XB = (bf16*)(ws + WS_XB); float* RX = (float*)(ws + WS_RX); const float* g_final = a->g_final;
    int s0n = POS[(size_t)gw * 2], s1n = POS[(size_t)gw * 2 + 1]; float w0n = TOPW[(size_t)gw * 2], w1n = TOPW[(size_t)gw * 2 + 1];
#pragma unroll 1
    for (int m = gw; m < M; m += F.NGW) {
        const int s0 = s0n, s1 = s1n; const float w0 = w0n, w1 = w1n;
        { const int mn = m + F.NGW < M ? m + F.NGW : m; s0n = POS[(size_t)mn * 2]; s1n = POS[(size_t)mn * 2 + 1]; w0n = TOPW[(size_t)mn * 2]; w1n = TOPW[(size_t)mn * 2 + 1]; }
        f32x4 v[4]; float s = 0.f;
#pragma unroll
        for (int j = 0; j < 4; ++j) { const u32x2 p0 = ((const u32x2*)(OUTG + (size_t)s0 * D) + lane)[64 * j], p1 = ((const u32x2*)(OUTG + (size_t)s1 * D) + lane)[64 * j];
            const f32x4 o0 = {bflo(p0.x), bfhi(p0.x), bflo(p0.y), bfhi(p0.y)}, o1 = {bflo(p1.x), bfhi(p1.x), bflo(p1.y), bfhi(p1.y)};
            v[j] = ((const f32x4*)(X + (size_t)m * D) + lane)[64 * j] + w0 * o0 + w1 * o1; s += sumsq4(v[j]); }
        const float r = __builtin_amdgcn_rsqf(wave_sum(s) * (1.f / D) + EPS);
        if (last) {
#pragma unroll
            for (int j = 0; j < 4; ++j) ((f32x4*)(X + (size_t)m * D) + lane)[64 * j] = v[j] * r * ((const f32x4*)g_final + lane)[64 * j];
        } else {
#pragma unroll
            for (int j = 0; j < 4; ++j) { ((f32x4*)(X + (size_t)m * D) + lane)[64 * j] = v[j]; ((u32x2*)(XB + (size_t)m * D) + lane)[64 * j] = (u32x2){cvt_pk_bf16(v[j][0], v[j][1]), cvt_pk_bf16(v[j][2], v[j][3])}; }
            if (lane == 0) RX[m] = r;
        }
    }
}


#ifdef DBG_ENABLE
__device__ __forceinline__ float dbg_b(const unsigned char* ws, size_t off, size_t idx) { return bf2f(((const bf16*)(ws + off))[idx]); }
__device__ __forceinline__ void dbg_dump(const Frame& F, ArgsP kargs, int code) {
    LOCAL_IDS; FRESH(a); const unsigned char* ws = a->ws; float* out = a->out;
    unsigned tmo = ((const unsigned*)(ws + WS_CTL))[CW_BAR + XB_TMO];
    for (size_t i = (size_t)F.bid * 512 + tid; i < (size_t)M * D; i += (size_t)F.G * 512) { const size_t row = i >> 10, c = i & 1023; float v = 0.f;
        if (code == 1) v = dbg_b(ws, WS_CQ, row * 512 + (c & 511)) + dbg_b(ws, WS_CKV, row * 256 + (c & 255)) + dbg_b(ws, WS_U, row * 512 + (c & 511)) + dbg_b(ws, WS_VR, row * 512 + (c & 511)) + dbg_b(ws, WS_QX, row * 512 + (c & 511))
                         + dbg_b(ws, WS_GATE, row * 3072 + c) + dbg_b(ws, WS_GATE, row * 3072 + 1024 + c) + dbg_b(ws, WS_GATE, row * 3072 + 2048 + c) + dbg_b(ws, WS_KR, row * 32 + (c & 31));
        else if (code == 2) v = dbg_b(ws, WS_Q, row * 768 + (c % 768)) + dbg_b(ws, WS_KN, row * 512 + (c & 511)) + dbg_b(ws, WS_V, row * 512 + (c & 511)) + dbg_b(ws, WS_Y, row * 1536 + 512 + c);
        else if (code == 3) v = dbg_b(ws, WS_Y, row * 1536 + (c & 511));
        else if (code == 15) v = dbg_b(ws, WS_WINT, i % ((size_t)PPAD * D));
        else if (code == 13 || code == 14) v = dbg_b(ws, WS_GATE, row * 3072 + c) + dbg_b(ws, WS_GATE, row * 3072 + 1024 + c) + dbg_b(ws, WS_GATE, row * 3072 + 2048 + c);
        else if (code == 4) v = dbg_b(ws, WS_MIXB, row * 1024 + c);
        else if (code == 6) v = dbg_b(ws, WS_HFF, row * 2688 + c) + dbg_b(ws, WS_HFF, row * 2688 + 1024 + c) + dbg_b(ws, WS_HFF, row * 2688 + 1664 + c);
        else if (code == 9) { const int s0 = ((const int*)(ws + WS_POS))[row * 2], s1 = ((const int*)(ws + WS_POS))[row * 2 + 1]; v = dbg_b(ws, WS_XG, (size_t)s0 * 1024 + c) + 2.f * dbg_b(ws, WS_XG, (size_t)s1 * 1024 + c) + ((const float*)(ws + WS_TOPW))[row * 2] + (float)s0 * 1e-3f; }
        else if (code == 10) { const int s0 = ((const int*)(ws + WS_POS))[row * 2], s1 = ((const int*)(ws + WS_POS))[row * 2 + 1]; v = dbg_b(ws, WS_HG, (size_t)s0 * 3584 + c) + dbg_b(ws, WS_HG, (size_t)s1 * 3584 + 2560 + c) + dbg_b(ws, WS_HG, (size_t)s0 * 3584 + 1500 + c); }
        else if (code == 11) { const int s0 = ((const int*)(ws + WS_POS))[row * 2], s1 = ((const int*)(ws + WS_POS))[row * 2 + 1]; v = ((const float*)(ws + WS_OUTG))[(size_t)s0 * 1024 + c] + ((const float*)(ws + WS_OUTG))[(size_t)s1 * 1024 + c]; }
        else continue;
        if (tmo) v = __builtin_nanf("");
        out[i] = v; }
}
#define DBG(code) do { if (dbgc == (code)) { dbg_dump(F, kargs, code); return; } } while (0)
#else
#define DBG(code) do { } while (0)
#endif

__global__ void __launch_bounds__(NWAVES * 64, 2) fwd_kernel(Args args_by_value) {
    extern __shared__ __attribute__((aligned(16))) unsigned char lds_raw[];
    const ArgsP kargs = (ArgsP)__builtin_amdgcn_kernarg_segment_ptr();
    Frame F; F.lds = (LAS unsigned char*)lds_raw; F.G = gridDim.x; F.bid = blockIdx.x; F.NGW = F.G * NWAVES;
    for (int u = threadIdx.x; u < (LDS_BYTES - LDSCTL_OFF) / 4; u += NWAVES * 64) ((LAS unsigned*)(F.lds + LDSCTL_OFF))[u] = 0u;
    __syncthreads();
    volatile LAS unsigned* MISC = (volatile LAS unsigned*)(F.lds + MISC_OFF);
    XcdBarrier bar; { FRESH(a); bar = xcd_barrier_post((unsigned*)(a->ws + WS_CTL) + CW_BAR, MISC + 8); }
#define GRID_BAR() xcd_barrier(bar)

#ifdef ONLY_TEST
    ONLY_TEST; GRID_BAR(); return;
#endif
    const Frame F_ = F;
    int dbgc; { FRESH(a); dbgc = a->dbg; } (void)dbgc;
    phase_prologue(F, kargs); GRID_BAR();
#pragma unroll 1
    for (int l_ = 0; l_ < DEPTH; ++l_) {
        Frame F = F_; int l = l_; asm volatile("" : "+s"(F.G), "+s"(F.NGW), "+s"(F.bid), "+s"(l));
        const bool moe = (l & 1) != 0; const int j2 = l >> 1;
        if (l == 0) DBG(15);
#ifdef PROBE_INPROJ2
        { int reps = 2; asm volatile("" : "+s"(reps));
#pragma unroll 1
          for (int rep = 0; rep < reps; ++rep) { phase_inproj(F, kargs, l); GRID_BAR(); } }
#else
        phase_inproj(F, kargs, l); GRID_BAR(); if (l == 0) DBG(1); if (l == 0) DBG(14);
#endif
        phase_up(F, kargs, l); GRID_BAR(); if (l == 0) DBG(2);
        phase_attn(F, kargs, l); GRID_BAR(); if (l == 0) DBG(3); if (l == 0) DBG(13);
#ifdef PROBE_ATTN2
        phase_attn(F, kargs, l); GRID_BAR();
#endif
#ifdef PROBE_UP2
        phase_up(F, kargs, l); GRID_BAR();
#endif
        phase_branch(F, kargs); GRID_BAR(); if (l == 0) DBG(4);
#ifdef PROBE_RESID2
        { int reps = 2; asm volatile("" : "+s"(reps));
#pragma unroll 1
          for (int rep = reps - 1; rep >= 0; --rep) { phase_outproj(F, kargs, rep != 0); GRID_BAR(); } }
#else
        phase_outproj(F, kargs); GRID_BAR(); if (l == 0) DBG(5); if (l == 1) DBG(8);
#endif
        if (!moe) {
            phase_dense_conv(F, kargs, l, j2); GRID_BAR();
            phase_dense_up(F, kargs); GRID_BAR(); if (l == 0) DBG(6);
#ifdef PROBE_DENSE2
            phase_dense_up(F, kargs); GRID_BAR();
#endif
#ifdef PROBE_RESID2
            { int reps = 2; asm volatile("" : "+s"(reps));
#pragma unroll 1
              for (int rep = reps - 1; rep >= 0; --rep) { phase_dense_down(F, kargs, rep != 0); GRID_BAR(); } }
#else
            phase_dense_down(F, kargs); GRID_BAR(); if (l == 0) DBG(7);
#endif
        } else {
            phase_moe_route(F, kargs, l, j2); GRID_BAR();
            phase_moe_gather(F, kargs); GRID_BAR(); if (l == 1) DBG(9);
#ifdef PROBE_AUX2
            phase_moe_gather(F, kargs); GRID_BAR();
#endif
            phase_moe_up(F, kargs); GRID_BAR(); if (l == 1) DBG(10);
            phase_moe_down(F, kargs, j2); GRID_BAR(); if (l == 1) DBG(11);
#ifdef PROBE_MOE2
            phase_moe_up(F, kargs); GRID_BAR();
            phase_moe_down(F, kargs, j2); GRID_BAR();
#endif
            phase_moe_combine(F, kargs, l == DEPTH - 1);
            if (l != DEPTH - 1) GRID_BAR();
            if (l == 1) DBG(12);
        }
    }
}

extern "C" void kernel_launch(void* const* d_in, const int* in_sizes, int n_in, void* d_out, int out_size, void* d_ws, size_t ws_size, hipStream_t stream) {
    static int grid = 0;
    if (grid == 0) {
        if (n_in != 27 || in_sizes[0] != M * D || out_size != M * D || ws_size < WS_END) { fprintf(stderr, "kernel_launch: unexpected shapes (n_in %d, in0 %d, out %d, ws %zu)\n", n_in, n_in > 0 ? in_sizes[0] : -1, out_size, ws_size); grid = -1; return; }
        int dev = 0, cus = 0, per_cu = 0;
        if (hipGetDevice(&dev) != hipSuccess || hipDeviceGetAttribute(&cus, hipDeviceAttributeMultiprocessorCount, dev) != hipSuccess) { grid = -1; return; }
        if (hipFuncSetAttribute((const void*)fwd_kernel, hipFuncAttributeMaxDynamicSharedMemorySize, LDS_BYTES) != hipSuccess) { fprintf(stderr, "kernel_launch: hipFuncSetAttribute failed\n"); grid = -1; return; }
        if (hipOccupancyMaxActiveBlocksPerMultiprocessor(&per_cu, (const void*)fwd_kernel, NWAVES * 64, LDS_BYTES) != hipSuccess || per_cu < 1) { fprintf(stderr, "kernel_launch: occupancy query reports %d\n", per_cu); }
        (void)hipGetLastError();
        if (cus != 256) { fprintf(stderr, "kernel_launch: built for 256 CUs, device has %d\n", cus); grid = -1; return; }
        grid = 256;
    }
    if (grid < 0) return;
    if (hipMemsetAsync((char*)d_ws + WS_CTL, 0, CTL_ZERO_BYTES, stream) != hipSuccess) return;
    Args a{};
    a.x = (const float*)d_in[0]; a.mem = (const float*)d_in[1]; a.positions = (const int*)d_in[2]; a.g_mix = (const float*)d_in[3]; a.w_in = (const float*)d_in[4]; a.g_q = (const float*)d_in[5];
    a.g_kv = (const float*)d_in[6]; a.w_uq = (const float*)d_in[7]; a.w_uk = (const float*)d_in[8]; a.w_uv = (const float*)d_in[9]; a.g_sg = (const float*)d_in[10]; a.w_s = (const float*)d_in[11];
    a.b_s = (const float*)d_in[12]; a.g_mem = (const float*)d_in[13]; a.w_mkv = (const float*)d_in[14]; a.w_br = (const float*)d_in[15]; a.b_gate = (const float*)d_in[16]; a.w_out = (const float*)d_in[17];
    a.g_ffn = (const float*)d_in[18]; a.dense_w1 = (const float*)d_in[19]; a.dense_w3 = (const float*)d_in[20]; a.dense_w2 = (const float*)d_in[21]; a.w_router = (const float*)d_in[22];
    a.moe_w1 = (const float*)d_in[23]; a.moe_w3 = (const float*)d_in[24]; a.moe_w2 = (const float*)d_in[25]; a.g_final = (const float*)d_in[26];
    a.out = (float*)d_out; a.ws = (unsigned char*)d_ws;
#ifdef DBG_STOP
    a.dbg = DBG_STOP;
#endif
    hipLaunchKernelGGL(fwd_kernel, dim3(grid), dim3(NWAVES * 64), LDS_BYTES, stream, a);
    const hipError_t le = hipPeekAtLastError();
    if (le != hipSuccess) fprintf(stderr, "kernel_launch: launch failed: %s\n", hipGetErrorName(le));
}
```

```cpp
#include <hip/hip_runtime.h>
#include <cstdio>
#include <cstdint>

#ifndef PH_MASK
#define PH_MASK 0xffffffffu
#endif
#define PH(k) ((PH_MASK >> (k)) & 1u)
#define LAS __attribute__((address_space(3)))
#define GAS __attribute__((address_space(1)))
typedef unsigned short bf16;
typedef short bf16x8 __attribute__((ext_vector_type(8)));
typedef short s16x4 __attribute__((ext_vector_type(4)));
typedef float f32x4 __attribute__((ext_vector_type(4)));
typedef float f32x2 __attribute__((ext_vector_type(2)));
typedef float f32x16 __attribute__((ext_vector_type(16)));
typedef unsigned u32x4 __attribute__((ext_vector_type(4)));
typedef unsigned u32x2 __attribute__((ext_vector_type(2)));
typedef int i32x4 __attribute__((ext_vector_type(4)));

constexpr int M = 16384, D = 1024, DEPTH = 4, NMEM = 256;
constexpr int QRANK = 384, KVRANK = 256, NH = 8, QKD = 96, VD = 64;
constexpr int XH = 4, XD = 128, BW = 512;
constexpr int PTOT = 5280, PPAD = 5376, DFF = 2688, NE = 8, DFE = 3584;
constexpr float EPS = 1e-6f;
constexpr int MAXSLOT = 34816;
constexpr float LOG2E = 1.4426950408889634f;
constexpr float QSCALE = 0.10206207261596575f * LOG2E;
constexpr float XSCALE = 0.08838834764831845f * LOG2E;

constexpr size_t MiB = 1u << 20, KiB = 1u << 10;
constexpr size_t WS_CTL = 0, CTL_ZERO_BYTES = 1 * MiB;
constexpr size_t WS_ROPE = 2 * MiB;
constexpr size_t WS_XSTAT = 4 * MiB;
constexpr size_t WS_RX = 5 * MiB;
constexpr size_t WS_CQSTAT = 5 * MiB + 256 * KiB;
constexpr size_t WS_CKVSTAT = 5 * MiB + 768 * KiB;
constexpr size_t WS_VSTAT = 6 * MiB;
constexpr size_t WS_MEMB = 6 * MiB + 512 * KiB;
constexpr size_t WS_KVMEM = 7 * MiB;
constexpr size_t WS_TOPI = 9 * MiB;
constexpr size_t WS_TOPW = 9 * MiB + 256 * KiB;
constexpr size_t WS_LRANK = 9 * MiB + 512 * KiB;
constexpr size_t WS_POS = 9 * MiB + 768 * KiB;
constexpr size_t WS_BLKCNT = 10 * MiB;
constexpr size_t WS_SLOTR = 10 * MiB + 512 * KiB;
constexpr size_t WS_TOKOF = 10 * MiB + 768 * KiB;
constexpr size_t WS_WSB = 11 * MiB;
constexpr size_t WS_WMKVT = 12 * MiB;
constexpr size_t WS_WINT = 20 * MiB;
constexpr size_t WS_WUQT = 31 * MiB;
constexpr size_t WS_WUKVT = 32 * MiB;
constexpr size_t WS_WBRT = 33 * MiB;
constexpr size_t WS_WOUTT = 36 * MiB;
constexpr size_t WS_WFFN = 40 * MiB;
constexpr size_t WS_W2D = WS_WFFN + 11 * MiB;
constexpr size_t WS_W2M = WS_WFFN + 112 * MiB;
constexpr size_t WS_XB = 208 * MiB;
constexpr size_t WS_CQ = 240 * MiB;
constexpr size_t WS_CKV = 256 * MiB;
constexpr size_t WS_U = 264 * MiB;
constexpr size_t WS_VR = 280 * MiB;
constexpr size_t WS_QX = 296 * MiB;
constexpr size_t WS_GATE = 312 * MiB;
constexpr size_t WS_Q = 408 * MiB;
constexpr size_t WS_KN = 432 * MiB;
constexpr size_t WS_KR = 448 * MiB;
constexpr size_t WS_V = 450 * MiB;
constexpr size_t WS_Y = 466 * MiB;
constexpr size_t WS_MIX = 514 * MiB;
constexpr size_t WS_MIXB = 578 * MiB;
constexpr size_t WS_MIX1 = 610 * MiB;
constexpr size_t WS_HFF = 240 * MiB;
constexpr size_t WS_XG = 240 * MiB;
constexpr size_t WS_HG = 308 * MiB;
constexpr size_t WS_OUTG = 546 * MiB;
constexpr size_t WS_END = 682 * MiB;
constexpr int CW_TMO = 0, CW_CODE = 1, CW_CHK = 2, CW_BAR = 4096;
constexpr int CW_SK = 16384;
constexpr size_t WS_SKPART = 700 * MiB;
constexpr int CW_KMAX = 8192;

constexpr int RING_BYTES = 131072, LDSCTL_OFF = 159744, MISC_OFF = LDSCTL_OFF + 320, LDS_BYTES = 163840;
constexpr int NWAVES = 8;

#define RLX_AGENT __ATOMIC_RELAXED, __HIP_MEMORY_SCOPE_AGENT
#define LDS_WAIT() asm volatile("s_waitcnt lgkmcnt(0)" ::: "memory")
#define VM_WAIT() asm volatile("s_waitcnt vmcnt(0)" ::: "memory")
typedef __bf16 bf16x2_t __attribute__((ext_vector_type(2)));
__device__ __forceinline__ unsigned cvt_pk_bf16(float lo, float hi) { const f32x2 v = {lo, hi}; const bf16x2_t b = __builtin_convertvector(v, bf16x2_t); return __builtin_bit_cast(unsigned, b); }
__device__ __forceinline__ bf16 f2bf(float f) { return (bf16)(cvt_pk_bf16(f, 0.f) & 0xffffu); }
__device__ __forceinline__ float bf2f(bf16 v) { return __uint_as_float((unsigned)v << 16); }
__device__ __forceinline__ float bflo(unsigned w) { return __uint_as_float(w << 16); }
__device__ __forceinline__ float bfhi(unsigned w) { return __uint_as_float(w & 0xffff0000u); }
__device__ __forceinline__ float fast_exp2(float x) { return __builtin_amdgcn_exp2f(x); }
__device__ __forceinline__ float fast_rcp(float x) { return __builtin_amdgcn_rcpf(x); }
__device__ __forceinline__ float sigmoidf_(float z) { return fast_rcp(1.f + fast_exp2(-LOG2E * z)); }
__device__ __forceinline__ float gelu_tanh(float x) { const float t = x + 0.044715f * x * x * x; return x * fast_rcp(1.f + fast_exp2(-2.f * 0.7978845608028654f * LOG2E * t)); }
template <int CTRL> __device__ __forceinline__ float dppf(float v) { return __builtin_bit_cast(float, __builtin_amdgcn_update_dpp(0, __builtin_bit_cast(int, v), CTRL, 0xf, 0xf, true)); }
__device__ __forceinline__ float row_sum16(float v) { v += dppf<0xB1>(v); v += dppf<0x4E>(v); v += dppf<0x124>(v); v += dppf<0x128>(v); return v; }
__device__ __forceinline__ float row_max16(float v) { v = fmaxf(v, dppf<0xB1>(v)); v = fmaxf(v, dppf<0x4E>(v)); v = fmaxf(v, dppf<0x124>(v)); v = fmaxf(v, dppf<0x128>(v)); return v; }
__device__ __forceinline__ float xsum16(float v) { const auto r = __builtin_amdgcn_permlane16_swap(__float_as_uint(v), __float_as_uint(v), false, false); return __uint_as_float(r[0]) + __uint_as_float(r[1]); }
__device__ __forceinline__ float xsum32(float v) { const auto r = __builtin_amdgcn_permlane32_swap(__float_as_uint(v), __float_as_uint(v), false, false); return __uint_as_float(r[0]) + __uint_as_float(r[1]); }
__device__ __forceinline__ float wave_sum(float v) { return xsum32(xsum16(row_sum16(v))); }
__device__ __forceinline__ float sumsq4(f32x4 v) { return (v[0] * v[0] + v[1] * v[1]) + (v[2] * v[2] + v[3] * v[3]); }
__device__ __forceinline__ u32x2 pack8_u8(f32x4 a, f32x4 b) { unsigned w0 = 0, w1 = 0; a = a * 255.f; b = b * 255.f;
    w0 = __builtin_amdgcn_cvt_pk_u8_f32(a[0], 0, w0); w0 = __builtin_amdgcn_cvt_pk_u8_f32(a[1], 1, w0); w0 = __builtin_amdgcn_cvt_pk_u8_f32(a[2], 2, w0); w0 = __builtin_amdgcn_cvt_pk_u8_f32(a[3], 3, w0);
    w1 = __builtin_amdgcn_cvt_pk_u8_f32(b[0], 0, w1); w1 = __builtin_amdgcn_cvt_pk_u8_f32(b[1], 1, w1); w1 = __builtin_amdgcn_cvt_pk_u8_f32(b[2], 2, w1); w1 = __builtin_amdgcn_cvt_pk_u8_f32(b[3], 3, w1);
    return (u32x2){w0, w1}; }
__device__ __forceinline__ void unpack8_u8(u32x2 w, f32x4& a, f32x4& b) { constexpr float k = 1.f / 255.f;
    a = (f32x4){(float)(w.x & 255u), (float)((w.x >> 8) & 255u), (float)((w.x >> 16) & 255u), (float)(w.x >> 24)} * k;
    b = (f32x4){(float)(w.y & 255u), (float)((w.y >> 8) & 255u), (float)((w.y >> 16) & 255u), (float)(w.y >> 24)} * k; }
__device__ __forceinline__ u32x4 pack8(f32x4 a, f32x4 b) { u32x4 w; w.x = cvt_pk_bf16(a[0], a[1]); w.y = cvt_pk_bf16(a[2], a[3]); w.z = cvt_pk_bf16(b[0], b[1]); w.w = cvt_pk_bf16(b[2], b[3]); return w; }
__device__ __forceinline__ void unpack8(u32x4 w, f32x4& a, f32x4& b) { a = (f32x4){bflo(w.x), bfhi(w.x), bflo(w.y), bfhi(w.y)}; b = (f32x4){bflo(w.z), bfhi(w.z), bflo(w.w), bfhi(w.w)}; }

namespace pg8 {
constexpr int BM = 256, BK = 64, HALF = 128, HTB = HALF * BK * 2, STAGE_BYTES = 8 * HTB, NXCD = 8, WGM = 8;
__host__ __device__ __forceinline__ int lds_byte(int r, int c) { const int st = (r >> 4) * 2 + (c >> 5), rr = r & 15, cc = c & 31, ob = rr * 64 + cc * 2; return st * 1024 + (ob ^ (((ob >> 9) & 1) << 5)); }
__host__ __device__ __forceinline__ void stage_rc(int b, int& R, int& C) { const int st = b / 1024, sb = b % 1024, swz = sb ^ (((sb >> 9) & 1) << 5); R = (st >> 1) * 16 + swz / 64; C = (st & 1) * 32 + (swz % 64) / 2; }
__host__ __device__ __forceinline__ int perm32(int rho) { const int n = rho >> 4, i = rho & 15; return 8 * (i >> 2) + 4 * n + (i & 3); }

struct Unit { const char* A; const char* B; int pm, pn, aux, nt; };
typedef f32x4 Acc[2][2][4][2];

__device__ __forceinline__ void tile_of(int L, int nM, int nN, int& pm, int& pn) {
    const int nwg = nM * nN; int wgid = L;
    { const int q = nwg / NXCD, r = nwg % NXCD, xcd = wgid % NXCD, off = wgid / NXCD; wgid = (xcd < r ? xcd * (q + 1) : r * (q + 1) + (xcd - r) * q) + off; }
    const int nig = WGM * nN, gid = wgid / nig, fm = gid * WGM, gsz = (nM - fm) < WGM ? (nM - fm) : WGM;
    pm = fm + ((wgid % nig) % gsz); pn = (wgid % nig) / gsz;
}
struct TileOrder {
    enum { VARK = 0, GATHER = 0 };
    int nM, nN, G, c; const char* A; const char* B; size_t astep, bstep;
    int rev = 0;
    __device__ __forceinline__ bool next(int i, Unit& u) const {
        if (rev) { const int cnt = (nM * nN - c + G - 1) / G; if (i >= cnt) return false; i = cnt - 1 - i; }
        const long L = (long)i * G + c; if (L >= (long)nM * nN) return false;
        int pm, pn; tile_of((int)L, nM, nN, pm, pn);
        u.pm = pm; u.pn = pn; u.aux = 0; u.A = A + (size_t)pm * astep; u.B = B + (size_t)pn * bstep; return true;
    }
};

template <class Epi, class Sched>
__device__ __forceinline__ void gemm_phase(LAS unsigned char* lds, const int lda, const int ldb, const int K, const Sched& S, const Epi& E) {
    int tid_ = threadIdx.x; asm volatile("" : "+v"(tid_));
    const int tid = tid_, wid = __builtin_amdgcn_readfirstlane(tid >> 6), lane = tid & 63, wr = wid >> 2, wc = wid & 3, fr = lane & 15, fq = lane >> 4;
    int nt = K / BK;
    unsigned voffA[2], voffB[2];
#pragma unroll
    for (int i = 0; i < 2; ++i) { int R, C; stage_rc(tid * 16 + i * 8192, R, C); const int Rb = (R & ~31) + perm32(R & 31);
        voffA[i] = (unsigned)(R * (lda ? lda : BK) + C) * 2u; voffB[i] = (unsigned)(Rb * BK + C) * 2u; }
    const size_t kstep = lda ? (size_t)(BK * 2) : (size_t)BM * BK * 2;
    const size_t hstepA = (size_t)HALF * (lda ? lda : BK) * 2, hstepB = (size_t)HALF * BK * 2, kstepB = (size_t)BM * BK * 2; (void)ldb;
    const unsigned ldsw = (unsigned)wid * 1024u;
    const int aoff = lds_byte(wr * 64 + fr, fq * 8), boff = lds_byte(wc * 32 + fr, fq * 8);
#define PG8_SA(b, h) (((b) * 2 + (h)) * HTB)
#define PG8_SB(b, h) ((4 + (b) * 2 + (h)) * HTB)
#define PG8_STAGE(bufoff, gbase, voff) do { _Pragma("unroll") for (int _i = 0; _i < 2; ++_i) \
        __builtin_amdgcn_global_load_lds((const unsigned*)((const char*)(gbase) + (voff)[_i]), (LAS unsigned*)(lds + (bufoff) + ldsw + _i * 8192), 16, 0, 0); } while (0)
#define PG8_STA(b, h, kptr, VG) do { if constexpr (Sched::GATHER) PG8_STAGE(PG8_SA(b, h), (kptr), VG[h]); else PG8_STAGE(PG8_SA(b, h), (kptr) + (h) * hstepA, voffA); } while (0)
#define PG8_GLOOKUP(VG, ui_) do { _Pragma("unroll") for (int _h = 0; _h < 2; ++_h) _Pragma("unroll") for (int _i = 0; _i < 2; ++_i) { int R_, C_; stage_rc(tid * 16 + _i * 8192, R_, C_); \
        VG[_h][_i] = (unsigned)S.tokL[(ui_) * 256 + _h * 128 + R_] * (unsigned)(lda * 2) + (unsigned)(C_ * 2); } } while (0)
#define PG8_LDA(dst, b, h) do { _Pragma("unroll") for (int m = 0; m < 4; ++m) _Pragma("unroll") for (int k = 0; k < 2; ++k) dst[m][k] = *(const LAS bf16x8*)(lds + PG8_SA(b, h) + aoff + m * 2048 + k * 1024); } while (0)
#define PG8_LDB(dst, b, h) do { _Pragma("unroll") for (int n = 0; n < 2; ++n) _Pragma("unroll") for (int k = 0; k < 2; ++k) dst[n][k] = *(const LAS bf16x8*)(lds + PG8_SB(b, h) + boff + n * 2048 + k * 1024); } while (0)
#define PG8_MMA(ai, bj, At, Bt) do { __builtin_amdgcn_s_setprio(1); _Pragma("unroll") for (int m = 0; m < 4; ++m) _Pragma("unroll") for (int n = 0; n < 2; ++n) _Pragma("unroll") for (int k = 0; k < 2; ++k) \
        acc[ai][bj][m][n] = __builtin_amdgcn_mfma_f32_16x16x32_bf16(Bt[n][k], At[m][k], acc[ai][bj][m][n], 0, 0, 0); __builtin_amdgcn_s_setprio(0); } while (0)
#define PG8_WAIT_V(n) asm volatile("s_waitcnt vmcnt(" #n ")" ::: "memory")
#define PG8_WAIT_L(n) asm volatile("s_waitcnt lgkmcnt(" #n ")" ::: "memory")
#define PG8_BAR __builtin_amdgcn_s_barrier()
#define PG8_SCHED __builtin_amdgcn_sched_barrier(0)
    Unit cur, nxt; int ui = 0;
    if (!S.next(0, cur)) return;
    if constexpr (Sched::VARK) nt = cur.nt;
    typename Epi::Pre pre = E.prefetch(cur, wr, fr);
    Acc acc;
#pragma unroll
    for (int a = 0; a < 2; ++a)
#pragma unroll
        for (int b = 0; b < 2; ++b)
#pragma unroll
            for (int m = 0; m < 4; ++m)
#pragma unroll
                for (int n = 0; n < 2; ++n) acc[a][b][m][n] = (f32x4){0.f, 0.f, 0.f, 0.f};
    bf16x8 At[4][2], B0[2][2], B1[2][2];
    const char* cA = cur.A; const char* cB = cur.B;
    unsigned vg[2][2] = {{0u, 0u}, {0u, 0u}}; if constexpr (Sched::GATHER) PG8_GLOOKUP(vg, 0);
    PG8_STAGE(PG8_SB(0, 0), cB, voffB); PG8_STAGE(PG8_SB(0, 1), cB + hstepB, voffB); PG8_STA(0, 0, cA, vg); PG8_STA(0, 1, cA, vg);
    if (wr == 1) PG8_BAR;
    PG8_WAIT_V(2); PG8_BAR;
    PG8_STAGE(PG8_SB(1, 0), cB + kstepB, voffB); PG8_STA(1, 0, cA + kstep, vg); PG8_STAGE(PG8_SB(1, 1), cB + hstepB + kstepB, voffB);
    PG8_WAIT_V(6); PG8_BAR;
    for (;;) {
        const bool has_next = S.next(ui + 1, nxt);
        const char* nA = has_next ? nxt.A : cA; const char* nB = has_next ? nxt.B : cB;
        for (int t = 0; t < nt; t += 2) {
            const bool last = (t == nt - 2);
            const char* a1 = cA + (size_t)(t + 1) * kstep;
            const char* a2 = last ? nA : cA + (size_t)(t + 2) * kstep; const char* b2 = last ? nB : cB + (size_t)(t + 2) * kstepB;
            const char* a3 = a2 + kstep; const char* b3 = b2 + kstepB;
            PG8_LDB(B0, 0, 0); PG8_LDB(B1, 0, 1); PG8_SCHED; PG8_LDA(At, 0, 0); PG8_STA(1, 1, a1, vg);
            if constexpr (Sched::GATHER) { if (last && has_next) PG8_GLOOKUP(vg, ui + 1); }
            PG8_WAIT_V(8); PG8_WAIT_L(0); PG8_BAR; PG8_MMA(0, 0, At, B0); PG8_MMA(0, 1, At, B1); PG8_BAR; PG8_SCHED;
            PG8_LDA(At, 0, 1); PG8_STAGE(PG8_SB(0, 0), b2, voffB); PG8_STAGE(PG8_SB(0, 1), b2 + hstepB, voffB); PG8_STA(0, 0, a2, vg);
            PG8_WAIT_V(8); PG8_WAIT_L(0); PG8_BAR; PG8_MMA(1, 0, At, B0); PG8_MMA(1, 1, At, B1); PG8_BAR; PG8_SCHED;
            PG8_LDB(B0, 1, 0); PG8_LDB(B1, 1, 1); PG8_SCHED; PG8_LDA(At, 1, 0); PG8_STA(0, 1, a2, vg);
            PG8_WAIT_V(8); PG8_WAIT_L(0); PG8_BAR; PG8_MMA(0, 0, At, B0); PG8_MMA(0, 1, At, B1); PG8_BAR; PG8_SCHED;
            PG8_LDA(At, 1, 1); PG8_STAGE(PG8_SB(1, 0), b3, voffB); PG8_STAGE(PG8_SB(1, 1), b3 + hstepB, voffB); PG8_STA(1, 0, a3, vg);
            PG8_WAIT_V(8); PG8_WAIT_L(0); PG8_BAR; PG8_MMA(1, 0, At, B0); PG8_MMA(1, 1, At, B1); PG8_BAR; PG8_SCHED;
        }
        if (wr == 0) PG8_BAR;
        E(acc, cur, wr, wc, fr, fq, pre);
        if (!has_next) break;
        pre = E.prefetch(nxt, wr, fr);
        if constexpr (!Epi::KEEP_ACC)
#pragma unroll
        for (int a = 0; a < 2; ++a)
#pragma unroll
            for (int b = 0; b < 2; ++b)
#pragma unroll
                for (int m = 0; m < 4; ++m)
#pragma unroll
                    for (int n = 0; n < 2; ++n) acc[a][b][m][n] = (f32x4){0.f, 0.f, 0.f, 0.f};
        cur = nxt; cA = nA; cB = nB; ++ui;
        if constexpr (Sched::VARK) nt = cur.nt;
        if (wr == 1) PG8_BAR;
    }
    PG8_WAIT_V(0);
    PG8_BAR;
#undef PG8_SA
#undef PG8_SB
#undef PG8_STAGE
#undef PG8_LDA
#undef PG8_STA
#undef PG8_GLOOKUP
#undef PG8_LDB
#undef PG8_MMA
#undef PG8_WAIT_V
#undef PG8_WAIT_L
#undef PG8_BAR
#undef PG8_SCHED
}

#define EPI_FOR _Pragma("unroll") for (int ai = 0; ai < 2; ++ai) _Pragma("unroll") for (int m = 0; m < 4; ++m)
#define EPI_ROW (u.pm * BM + ai * HALF + wr * 64 + m * 16 + fr)
#define EPI_C8(bj) (u.pn * BM + (bj) * HALF + wc * 32 + 8 * fq)
#define EPI_LOAD_R(rr, ptr) float rr[2][4]; _Pragma("unroll") for (int ai = 0; ai < 2; ++ai) _Pragma("unroll") for (int m = 0; m < 4; ++m) rr[ai][m] = (ptr)[EPI_ROW]; asm volatile("" ::: "memory")

#define EPI_LOAD_RS(rr, xstat) float rr[2][4]; { f32x4 st_[2][4]; _Pragma("unroll") for (int ai = 0; ai < 2; ++ai) _Pragma("unroll") for (int m = 0; m < 4; ++m) st_[ai][m] = *(const f32x4*)((xstat) + (size_t)EPI_ROW * 16 + 4 * fq); \
    asm volatile("" ::: "memory"); _Pragma("unroll") for (int ai = 0; ai < 2; ++ai) _Pragma("unroll") for (int m = 0; m < 4; ++m) { float t_ = (st_[ai][m][0] + st_[ai][m][1]) + (st_[ai][m][2] + st_[ai][m][3]); \
        t_ = xsum32(xsum16(t_)); rr[ai][m] = __builtin_amdgcn_rsqf(t_ * (1.f / D) + EPS); } }
struct NoPre {};
#define EPI_NOPRE static constexpr bool KEEP_ACC = false; typedef NoPre Pre; __device__ __forceinline__ Pre prefetch(const Unit&, int, int) const { return Pre{}; }
struct RowPre { float r[2][4]; };
struct EpiInProj {
    unsigned char* ws; const float* bgate; int layer; int from_stats;
    static constexpr bool KEEP_ACC = false; typedef RowPre Pre;
    __device__ __forceinline__ Pre prefetch(const Unit& u, int wr, int fr) const { Pre p; const float* rx = (const float*)(ws + WS_RX);
#pragma unroll
        for (int ai = 0; ai < 2; ++ai)
#pragma unroll
            for (int m = 0; m < 4; ++m) p.r[ai][m] = from_stats ? 0.f : rx[EPI_ROW];
        return p; }
    __device__ __forceinline__ void operator()(const Acc& acc, const Unit& u, int wr, int wc, int fr, int fq, const Pre& pre) const {
        const float* rx = (const float*)(ws + WS_RX); const float* rope = (const float*)(ws + WS_ROPE);
        bf16* CQ = (bf16*)(ws + WS_CQ); bf16* KR = (bf16*)(ws + WS_KR); bf16* CKV = (bf16*)(ws + WS_CKV); bf16* U = (bf16*)(ws + WS_U); bf16* VR = (bf16*)(ws + WS_VR); bf16* QX = (bf16*)(ws + WS_QX); bf16* GATE = (bf16*)(ws + WS_GATE);
        float* cqstat = (float*)(ws + WS_CQSTAT); float* ckvstat = (float*)(ws + WS_CKVSTAT); float* vstat = (float*)(ws + WS_VSTAT); unsigned* kmax = (unsigned*)(ws + WS_CTL) + CW_KMAX + layer * 32;
        const int pn = u.pn;
        float rr[2][4];
        if (from_stats) { EPI_LOAD_RS(rs_, (const float*)(ws + WS_XSTAT));
#pragma unroll
            for (int ai = 0; ai < 2; ++ai)
#pragma unroll
                for (int m = 0; m < 4; ++m) rr[ai][m] = rs_[ai][m]; }
        else {
#pragma unroll
            for (int ai = 0; ai < 2; ++ai)
#pragma unroll
                for (int m = 0; m < 4; ++m) rr[ai][m] = pre.r[ai][m]; }
        if (pn < 2) {
            float krmax = 0.f;
            EPI_FOR { const int row = EPI_ROW;
                const float r = rr[ai][m]; float ss = 0.f;
#pragma unroll
                for (int bj = 0; bj < 2; ++bj) { const f32x4 v0 = acc[ai][bj][m][0] * r, v1 = acc[ai][bj][m][1] * r;
                    if (!(pn == 1 && bj == 1)) ss += sumsq4(v0) + sumsq4(v1);
                    *(u32x4*)(CQ + (size_t)row * 512 + pn * 256 + bj * HALF + wc * 32 + 8 * fq) = pack8(v0, v1);
                    if (pn == 1 && bj == 1 && wc == 0) {
                        const f32x4 c = *(const f32x4*)(rope + (size_t)row * 32 + 4 * fq), s = *(const f32x4*)(rope + (size_t)row * 32 + 16 + 4 * fq);
                        const f32x4 o0 = v0 * c - v1 * s, o1 = v0 * s + v1 * c;
                        *(u32x4*)(KR + (size_t)row * 32 + 8 * fq) = pack8(o0, o1);
                        float q2 = sumsq4(o0) + sumsq4(o1); q2 = xsum32(xsum16(q2)); krmax = fmaxf(krmax, q2); } }
                ss = xsum32(xsum16(ss));
                if (fq == 0) cqstat[(size_t)row * 8 + pn * 4 + wc] = ss;
            }
            if (pn == 1 && wc == 0) {
                krmax = row_max16(krmax);
                if ((fr | fq) == 0) atomicMax(kmax + 16, __float_as_uint(krmax)); }
        } else if (pn == 2) {
            EPI_FOR { const int row = EPI_ROW;
                const float r = rr[ai][m]; float ss = 0.f;
#pragma unroll
                for (int bj = 0; bj < 2; ++bj) { const f32x4 v0 = acc[ai][bj][m][0] * r, v1 = acc[ai][bj][m][1] * r; ss += sumsq4(v0) + sumsq4(v1);
                    *(u32x4*)(CKV + (size_t)row * 256 + bj * HALF + wc * 32 + 8 * fq) = pack8(v0, v1); }
                ss = xsum32(xsum16(ss));
                if (fq == 0) ckvstat[(size_t)row * 4 + wc] = ss;
            }
        } else if (pn < 7) {
            const bool isv = pn >= 5; bf16* dst = isv ? VR : U; const int t = isv ? pn - 5 : pn - 3;
            EPI_FOR { const int row = EPI_ROW;
                const float r = rr[ai][m]; float ss = 0.f;
#pragma unroll
                for (int bj = 0; bj < 2; ++bj) { f32x4 v0 = acc[ai][bj][m][0] * r, v1 = acc[ai][bj][m][1] * r;
#pragma unroll
                    for (int e = 0; e < 4; ++e) { v0[e] = gelu_tanh(v0[e]); v1[e] = gelu_tanh(v1[e]); }
                    ss += sumsq4(v0) + sumsq4(v1);
                    *(u32x4*)(dst + (size_t)row * 512 + t * 256 + bj * HALF + wc * 32 + 8 * fq) = pack8(v0, v1); }
                if (isv) { ss = xsum32(xsum16(ss)); if (fq == 0) vstat[(size_t)row * 8 + t * 4 + wc] = ss; }
            }
        } else if (pn < 9) {
            EPI_FOR { const int row = EPI_ROW;
                const float r = rr[ai][m];
#pragma unroll
                for (int bj = 0; bj < 2; ++bj) *(u32x4*)(QX + (size_t)row * 512 + (pn - 7) * 256 + bj * HALF + wc * 32 + 8 * fq) = pack8(acc[ai][bj][m][0] * r, acc[ai][bj][m][1] * r);
            }
        } else {
            const int gc0 = (pn - 9) * 256 + wc * 32 + 8 * fq;
            f32x4 bg[2][2];
#pragma unroll
            for (int bj = 0; bj < 2; ++bj) { bg[bj][0] = *(const f32x4*)(bgate + gc0 + bj * HALF); bg[bj][1] = *(const f32x4*)(bgate + gc0 + bj * HALF + 4); }
            EPI_FOR { const int row = EPI_ROW;
                const float r = rr[ai][m];
#pragma unroll
                for (int bj = 0; bj < 2; ++bj) { f32x4 v0 = acc[ai][bj][m][0] * r + bg[bj][0], v1 = acc[ai][bj][m][1] * r + bg[bj][1];
#pragma unroll
                    for (int e = 0; e < 4; ++e) { v0[e] = sigmoidf_(v0[e]); v1[e] = sigmoidf_(v1[e]); }
#ifdef DBG_CONSTGATE
                    v0 = acc[ai][bj][m][0] * r; v1 = acc[ai][bj][m][1] * r;
#endif
                    *(u32x2*)((unsigned char*)GATE + (size_t)row * 3072 + gc0 + bj * HALF) = pack8_u8(v0, v1); }
            }
        }
    }
};
struct EpiMemKV {
    bf16* KV;
    EPI_NOPRE
    __device__ __forceinline__ void operator()(const Acc& acc, const Unit& u, int wr, int wc, int fr, int fq, const Pre&) const {
        EPI_FOR { const int row = EPI_ROW;
#pragma unroll
            for (int bj = 0; bj < 2; ++bj) *(u32x4*)(KV + (size_t)u.aux * 256 * 1024 + (size_t)row * 1024 + EPI_C8(bj)) = pack8(acc[ai][bj][m][0], acc[ai][bj][m][1]);
        }
    }
};
struct EpiQ {
    const float* cqstat; const float* rope; bf16* Q;
    EPI_NOPRE
    __device__ __forceinline__ void operator()(const Acc& acc, const Unit& u, int wr, int wc, int fr, int fq, const Pre&) const {
        EPI_FOR { const int row = EPI_ROW;
            const f32x4 s0 = *(const f32x4*)(cqstat + (size_t)row * 8), s1 = *(const f32x4*)(cqstat + (size_t)row * 8 + 4);
            const float r = __builtin_amdgcn_rsqf(((s0[0] + s0[1]) + (s0[2] + s0[3]) + (s1[0] + s1[1]) + (s1[2] + s1[3])) * (1.f / QRANK) + EPS);
#pragma unroll
            for (int bj = 0; bj < 2; ++bj) { f32x4 v0 = acc[ai][bj][m][0] * r, v1 = acc[ai][bj][m][1] * r;
                if (((8 * u.pn + 4 * bj + wc) % 3) == 2) {
                    const f32x4 c = *(const f32x4*)(rope + (size_t)row * 32 + 4 * fq), s = *(const f32x4*)(rope + (size_t)row * 32 + 16 + 4 * fq);
                    const f32x4 o0 = v0 * c - v1 * s, o1 = v0 * s + v1 * c; v0 = o0; v1 = o1; }
                *(u32x4*)(Q + (size_t)row * 768 + EPI_C8(bj)) = pack8(v0, v1); }
        }
    }
};
struct EpiKV {
    const float* ckvstat; bf16* KN; bf16* V; unsigned* kmax;
    EPI_NOPRE
    __device__ __forceinline__ void operator()(const Acc& acc, const Unit& u, int wr, int wc, int fr, int fq, const Pre&) const {
        bf16* dst = u.pn < 2 ? KN : V; const int t = u.pn & 1; float hm[2] = {0.f, 0.f};
        EPI_FOR { const int row = EPI_ROW;
            const f32x4 s0 = *(const f32x4*)(ckvstat + (size_t)row * 4);
            const float r = __builtin_amdgcn_rsqf(((s0[0] + s0[1]) + (s0[2] + s0[3])) * (1.f / KVRANK) + EPS);
#pragma unroll
            for (int bj = 0; bj < 2; ++bj) { const f32x4 v0 = acc[ai][bj][m][0] * r, v1 = acc[ai][bj][m][1] * r;
                *(u32x4*)(dst + (size_t)row * 512 + t * 256 + bj * HALF + wc * 32 + 8 * fq) = pack8(v0, v1);
                float q2 = sumsq4(v0) + sumsq4(v1); q2 = xsum32(xsum16(q2)); hm[bj] = fmaxf(hm[bj], q2); }
        }
        if (u.pn < 2) {
#pragma unroll
            for (int bj = 0; bj < 2; ++bj) { float v = hm[bj];
                v = row_max16(v);
                if ((fr | fq) == 0) atomicMax(kmax + 2 * (4 * u.pn + 2 * bj + (wc >> 1)) + (wc & 1), __float_as_uint(v)); }
        }
    }
};
struct EpiBranch {
    const unsigned char* GATE; bf16* MIXB;
    static constexpr bool KEEP_ACC = true; typedef NoPre Pre; __device__ __forceinline__ Pre prefetch(const Unit&, int, int) const { return Pre{}; }
    __device__ __forceinline__ void operator()(Acc& acc, const Unit& u, int wr, int wc, int fr, int fq, const Pre&) const {
        const int n = u.aux;
#pragma unroll
        for (int ai = 0; ai < 2; ++ai) {
            u32x2 gw[4][2], gn[4][2];
#pragma unroll
            for (int m = 0; m < 4; ++m)
#pragma unroll
                for (int bj = 0; bj < 2; ++bj) { const unsigned char* gp = GATE + (size_t)EPI_ROW * 3072 + n * 1024 + EPI_C8(bj);
                    gw[m][bj] = *(const u32x2*)gp; if (n < 2) gn[m][bj] = *(const u32x2*)(gp + 1024); }
            asm volatile("" ::: "memory");
#pragma unroll
            for (int m = 0; m < 4; ++m)
#pragma unroll
                for (int bj = 0; bj < 2; ++bj) {
                    f32x4 g0, g1; unpack8_u8(gw[m][bj], g0, g1);
#pragma unroll
                    for (int e = 0; e < 4; ++e) { g0[e] = fmaxf(g0[e], 0.001953125f); g1[e] = fmaxf(g1[e], 0.001953125f); }
                    if (n < 2) { f32x4 h0, h1; unpack8_u8(gn[m][bj], h0, h1);
#pragma unroll
                        for (int e = 0; e < 4; ++e) { g0[e] *= fast_rcp(fmaxf(h0[e], 0.001953125f)); g1[e] *= fast_rcp(fmaxf(h1[e], 0.001953125f)); }
                        acc[ai][bj][m][0] *= g0; acc[ai][bj][m][1] *= g1; }
                    else *(u32x4*)(MIXB + (size_t)u.pm * 256 * 1024 + (size_t)(4 * u.pn + 2 * bj + (wc >> 1)) * 16384 + (ai * HALF + wr * 64 + m * 16 + fr) * 64 + (wc & 1) * 32 + 8 * fq) = pack8(acc[ai][bj][m][0] * g0, acc[ai][bj][m][1] * g1);
                }
        }
        if (n == 2) {
#pragma unroll
            for (int ai = 0; ai < 2; ++ai)
#pragma unroll
                for (int bj = 0; bj < 2; ++bj)
#pragma unroll
                    for (int m = 0; m < 4; ++m) { acc[ai][bj][m][0] = (f32x4){0.f, 0.f, 0.f, 0.f}; acc[ai][bj][m][1] = (f32x4){0.f, 0.f, 0.f, 0.f}; }
        }
    }
};
struct EpiResid {
    const float* X; float* Xo; bf16* XB; float* xstat;
    EPI_NOPRE
    __device__ __forceinline__ void operator()(const Acc& acc, const Unit& u, int wr, int wc, int fr, int fq, const Pre&) const {
#pragma unroll
        for (int ai = 0; ai < 2; ++ai) {
            f32x4 xv[4][2][2];
#pragma unroll
            for (int m = 0; m < 4; ++m)
#pragma unroll
                for (int bj = 0; bj < 2; ++bj) { const float* xp = X + (size_t)EPI_ROW * 1024 + EPI_C8(bj); xv[m][bj][0] = *(const f32x4*)xp; xv[m][bj][1] = *(const f32x4*)(xp + 4); }
            asm volatile("" ::: "memory");
#pragma unroll
            for (int m = 0; m < 4; ++m) { const int row = EPI_ROW; float ss = 0.f;
#pragma unroll
                for (int bj = 0; bj < 2; ++bj) { const int col = EPI_C8(bj); float* xp = Xo + (size_t)row * 1024 + col;
                    const f32x4 v0 = xv[m][bj][0] + acc[ai][bj][m][0], v1 = xv[m][bj][1] + acc[ai][bj][m][1];
                    *(f32x4*)xp = v0; *(f32x4*)(xp + 4) = v1; ss += sumsq4(v0) + sumsq4(v1);
                    *(u32x4*)(XB + (size_t)row * 1024 + col) = pack8(v0, v1); }
                ss = xsum32(xsum16(ss));
                if (fq == 0) xstat[(size_t)row * 16 + u.pn * 4 + wc] = ss; }
        }
    }
};
struct EpiSwiGLU {
    const float* rs; bf16* Hh; int ldh; int from_stats;
    static constexpr bool KEEP_ACC = false; typedef RowPre Pre;
    __device__ __forceinline__ Pre prefetch(const Unit& u, int wr, int fr) const { Pre p;
#pragma unroll
        for (int ai = 0; ai < 2; ++ai)
#pragma unroll
            for (int m = 0; m < 4; ++m) p.r[ai][m] = from_stats ? 0.f : rs[EPI_ROW];
        return p; }
    __device__ __forceinline__ void operator()(const Acc& acc, const Unit& u, int wr, int wc, int fr, int fq, const Pre& pre) const {
        float rr[2][4];
        if (from_stats) { EPI_LOAD_RS(rs_, rs);
#pragma unroll
            for (int ai = 0; ai < 2; ++ai)
#pragma unroll
                for (int m = 0; m < 4; ++m) rr[ai][m] = rs_[ai][m]; }
        else {
#pragma unroll
            for (int ai = 0; ai < 2; ++ai)
#pragma unroll
                for (int m = 0; m < 4; ++m) rr[ai][m] = pre.r[ai][m]; }
        bf16* hbase = Hh + (size_t)u.pm * 256 * ldh + (size_t)(2 * u.pn + (wc >> 1)) * 16384 + (wr * 64 + fr) * 64 + (wc & 1) * 32 + 8 * fq;
        EPI_FOR { const int row = EPI_ROW;
            const float r = rr[ai][m];
            f32x4 a0 = acc[ai][0][m][0] * r, a1 = acc[ai][0][m][1] * r; const f32x4 b0 = acc[ai][1][m][0] * r, b1 = acc[ai][1][m][1] * r;
#pragma unroll
            for (int e = 0; e < 4; ++e) { a0[e] = a0[e] * sigmoidf_(a0[e]) * b0[e]; a1[e] = a1[e] * sigmoidf_(a1[e]) * b1[e]; }
            (void)row; *(u32x4*)(hbase + (ai * HALF + m * 16) * 64) = pack8(a0, a1);
        }
    }
};
struct EpiBf16 {
    bf16* C; int ldc;
    EPI_NOPRE
    __device__ __forceinline__ void operator()(const Acc& acc, const Unit& u, int wr, int wc, int fr, int fq, const Pre&) const {
        EPI_FOR { const int row = EPI_ROW;
#pragma unroll
            for (int bj = 0; bj < 2; ++bj) *(u32x4*)(C + (size_t)row * ldc + EPI_C8(bj)) = pack8(acc[ai][bj][m][0], acc[ai][bj][m][1]);
        }
    }
};
template <int CC>
__device__ __forceinline__ void ks_reduce(const float* part, int x, int r, int k, int tid, bf16* C, int ldc, const Unit& u, int wr, int wc, int fr, int fq) {
    for (int sp = k; sp < 16; sp += CC) { const int ai = sp >> 3, bj = (sp >> 2) & 1, m = sp & 3;
        f32x4 v0[CC], v1[CC];
#pragma unroll
        for (int kk = 0; kk < CC; ++kk) { const float* q = part + (size_t)(x + 8 * (r * CC + kk)) * 65536 + tid * 4 + sp * 4096; v0[kk] = *(const f32x4*)q; v1[kk] = *(const f32x4*)(q + 2048); }
        f32x4 s0 = v0[0], s1 = v1[0];
#pragma unroll
        for (int kk = 1; kk < CC; ++kk) { s0 += v0[kk]; s1 += v1[kk]; }
        const int row = u.pm * BM + ai * HALF + wr * 64 + m * 16 + fr;
        *(u32x4*)(C + (size_t)row * ldc + u.pn * BM + bj * HALF + wc * 32 + 8 * fq) = pack8(s0, s1); }
}
struct EpiBf16KS {
    bf16* C; int ldc; float* part; unsigned* cnt; int c;
    EPI_NOPRE
    __device__ __forceinline__ void operator()(const Acc& acc, const Unit& u, int wr, int wc, int fr, int fq, const Pre&) const {
        if (((u.aux >> 4) & 3) != 0) {
            int tid_ = threadIdx.x; asm volatile("" : "+v"(tid_));
            const int k = (u.aux >> 8) & 255, CC = (u.aux >> 16) & 255, r = u.aux >> 24, x = c & 7;
            float* p = part + (size_t)c * 65536 + tid_ * 4;
#pragma unroll
            for (int ai = 0; ai < 2; ++ai)
#pragma unroll
                for (int bj = 0; bj < 2; ++bj)
#pragma unroll
                    for (int m = 0; m < 4; ++m)
#pragma unroll
                        for (int n = 0; n < 2; ++n) *(f32x4*)(p + (((ai * 2 + bj) * 4 + m) * 2 + n) * 2048) = acc[ai][bj][m][n];
            __threadfence();
            __syncthreads();
            if (tid_ == 0) { unsigned* w = cnt + x + 8 * r; __hip_atomic_fetch_add(w, 1u, __ATOMIC_RELEASE, __HIP_MEMORY_SCOPE_AGENT);
                while (__hip_atomic_load(w, __ATOMIC_ACQUIRE, __HIP_MEMORY_SCOPE_AGENT) < (unsigned)CC) __builtin_amdgcn_s_sleep(2); }
            __syncthreads(); __builtin_amdgcn_fence(__ATOMIC_ACQUIRE, "agent");
            if (CC == 4) ks_reduce<4>(part, x, r, k, tid_, C, ldc, u, wr, wc, fr, fq);
            else ks_reduce<2>(part, x, r, k, tid_, C, ldc, u, wr, wc, fr, fq);
            return;
        }
        EPI_FOR { const int row = EPI_ROW;
#pragma unroll
            for (int bj = 0; bj < 2; ++bj) *(u32x4*)(C + (size_t)row * ldc + EPI_C8(bj)) = pack8(acc[ai][bj][m][0], acc[ai][bj][m][1]);
        }
    }
};
struct EpiF32 {
    float* C; int ldc;
    EPI_NOPRE
    __device__ __forceinline__ void operator()(const Acc& acc, const Unit& u, int wr, int wc, int fr, int fq, const Pre&) const {
        EPI_FOR { const int row = EPI_ROW;
#pragma unroll
            for (int bj = 0; bj < 2; ++bj) { float* cp = C + (size_t)row * ldc + EPI_C8(bj); *(f32x4*)cp = acc[ai][bj][m][0]; *(f32x4*)(cp + 4) = acc[ai][bj][m][1]; }
        }
    }
};
}

namespace att {
#define KSWZ(row, colB) ((row) * 256 + ((colB) ^ (((row) & 7) << 4)))
#define SBAR() __builtin_amdgcn_sched_barrier(0)
constexpr float THR = 8.f;
__device__ __forceinline__ int crow(int r, int hi) { return (r & 3) + 8 * (r >> 2) + 4 * hi; }
template <int NB> __device__ __forceinline__ int v_st(int k, int c) { const int kk = (k & ~0xC) | ((k & 4) << 1) | ((k & 8) >> 1); return ((kk >> 3) * NB + (c >> 5)) * 512 + ((kk & 7) * 32 + (c & 31)) * 2; }
__device__ __forceinline__ int v_rd_base(int lane) { return ((lane & 3) << 3) | (((lane >> 2) & 3) << 6) | (((lane >> 4) & 1) << 5) | (((lane >> 5) & 1) << 8); }
template <int OFF> __device__ __forceinline__ s16x4 tr_read(int vb) { s16x4 r; asm volatile("ds_read_b64_tr_b16 %0, %1 offset:%2" : "=&v"(r) : "v"(vb), "i"(OFF) : "memory"); return r; }

__device__ __forceinline__ void partialSM(f32x16& p0, f32x16& p1, float& m_reg, float& alpha) {
    float pmax = p0[0];
#pragma unroll
    for (int r = 1; r < 16; ++r) pmax = fmaxf(pmax, p0[r]);
#pragma unroll
    for (int r = 0; r < 16; ++r) pmax = fmaxf(pmax, p1[r]);
    { auto rr = __builtin_amdgcn_permlane32_swap(__float_as_uint(pmax), __float_as_uint(pmax), false, false); pmax = fmaxf(__uint_as_float(rr[0]), __uint_as_float(rr[1])); }
    float mn;
    if (__builtin_expect(__all(pmax - m_reg <= THR), 1)) { mn = m_reg; alpha = 1.f; }
    else { mn = fmaxf(m_reg, pmax); alpha = __builtin_amdgcn_exp2f(m_reg - mn); m_reg = mn; }
#pragma unroll
    for (int r = 0; r < 16; ++r) { p0[r] -= mn; p1[r] -= mn; }
#pragma unroll
    for (int r = 0; r < 16; ++r) p0[r] = __builtin_amdgcn_exp2f(p0[r]);
}
__device__ __forceinline__ void finishSM(f32x16& p0, f32x16& p1, float alpha, float& l_reg, bf16x8& pa0, bf16x8& pa1, bf16x8& pa2, bf16x8& pa3) {
#pragma unroll
    for (int r = 0; r < 16; ++r) p1[r] = __builtin_amdgcn_exp2f(p1[r]);
    float ps = 0;
#pragma unroll
    for (int r = 0; r < 16; ++r) ps += p0[r];
#pragma unroll
    for (int r = 0; r < 16; ++r) ps += p1[r];
    { auto rr = __builtin_amdgcn_permlane32_swap(__float_as_uint(ps), __float_as_uint(ps), false, false); ps = __uint_as_float(rr[0]) + __uint_as_float(rr[1]); }
    l_reg = l_reg * alpha + ps;
#define PK4(P, BASE, OUT) do { unsigned a0 = cvt_pk_bf16(P[BASE + 0], P[BASE + 1]), a1 = cvt_pk_bf16(P[BASE + 2], P[BASE + 3]);   \
    unsigned b0 = cvt_pk_bf16(P[BASE + 4], P[BASE + 5]), b1 = cvt_pk_bf16(P[BASE + 6], P[BASE + 7]);                              \
    auto r0 = __builtin_amdgcn_permlane32_swap(a0, b0, false, false); auto r1 = __builtin_amdgcn_permlane32_swap(a1, b1, false, false); \
    u32x4 w = {r0[0], r1[0], r0[1], r1[1]}; OUT = __builtin_bit_cast(bf16x8, w); } while (0)
    PK4(p0, 0, pa0); PK4(p0, 8, pa1); PK4(p1, 0, pa2); PK4(p1, 8, pa3);
#undef PK4
}
template <int ND0> __device__ __forceinline__ void qkt(f32x16& p0, f32x16& p1, const LAS char* Ks, const bf16x8* qr, int r32, int hi, const f32x16& init) {
#pragma unroll
    for (int d0 = 0; d0 < ND0; ++d0) { const int cb = (d0 * 16 + hi * 8) * 2;
        const bf16x8 b0 = *(const LAS bf16x8*)(Ks + KSWZ(r32, cb));
        const bf16x8 b1 = *(const LAS bf16x8*)(Ks + KSWZ(32 + r32, cb));
        p0 = __builtin_amdgcn_mfma_f32_32x32x16_bf16(b0, qr[d0], d0 == 0 ? init : p0, 0, 0, 0);
        p1 = __builtin_amdgcn_mfma_f32_32x32x16_bf16(b1, qr[d0], d0 == 0 ? init : p1, 0, 0, 0); }
}
__device__ __forceinline__ void expA(f32x16& p0) {
#pragma unroll
    for (int r = 0; r < 16; ++r) p0[r] = __builtin_amdgcn_exp2f(p0[r]);
}
template <int NB, int D0> __device__ __forceinline__ void pv_one(f32x16& od, int vb, bf16x8 pa0, bf16x8 pa1, bf16x8 pa2, bf16x8 pa3) {
    const s16x4 l0 = tr_read<(0 * NB + D0) * 512>(vb), h0 = tr_read<(1 * NB + D0) * 512>(vb), l1 = tr_read<(2 * NB + D0) * 512>(vb), h1 = tr_read<(3 * NB + D0) * 512>(vb);
    const s16x4 l2 = tr_read<(4 * NB + D0) * 512>(vb), h2 = tr_read<(5 * NB + D0) * 512>(vb), l3 = tr_read<(6 * NB + D0) * 512>(vb), h3 = tr_read<(7 * NB + D0) * 512>(vb);
    asm volatile("s_waitcnt lgkmcnt(0)" ::: "memory"); SBAR();
#define PK(L, H) (bf16x8){L[0], L[1], L[2], L[3], H[0], H[1], H[2], H[3]}
    od = __builtin_amdgcn_mfma_f32_32x32x16_bf16(pa0, PK(l0, h0), od, 0, 0, 0);
    od = __builtin_amdgcn_mfma_f32_32x32x16_bf16(pa1, PK(l1, h1), od, 0, 0, 0);
    od = __builtin_amdgcn_mfma_f32_32x32x16_bf16(pa2, PK(l2, h2), od, 0, 0, 0);
    od = __builtin_amdgcn_mfma_f32_32x32x16_bf16(pa3, PK(l3, h3), od, 0, 0, 0);
#undef PK
}
template <int NB> __device__ __forceinline__ void pv_all(f32x16* o, int vb, bf16x8 pa0, bf16x8 pa1, bf16x8 pa2, bf16x8 pa3) {
    pv_one<NB, 0>(o[0], vb, pa0, pa1, pa2, pa3); pv_one<NB, 1>(o[1], vb, pa0, pa1, pa2, pa3);
    if constexpr (NB == 4) { pv_one<NB, 2>(o[2], vb, pa0, pa1, pa2, pa3); pv_one<NB, 3>(o[3], vb, pa0, pa1, pa2, pa3); }
}

template <int DQK, int D1, int DVV, bool FIXM>
__device__ __forceinline__ void attn_unit(const bf16* __restrict__ Qb, int ldq, const bf16* __restrict__ K1, int ldk1, const bf16* __restrict__ K2, int ldk2,
                                          const bf16* __restrict__ Vh, int ldv, bf16* __restrict__ Ob, int ldo, int seq, LAS char* lds, float kbound) {
    constexpr int ND0 = DQK / 16, NB = DVV / 32, CK = DQK / 8, CV = DVV / 8;
    constexpr int NKL = (64 * CK + 511) / 512, NVL = (64 * CV) / 512;
    constexpr int SHM_V = 64 * DVV * 2, SHM_K = 64 * 256;
    int tid_ = threadIdx.x; asm volatile("" : "+v"(tid_));
    const int tid = tid_, wid = tid >> 6, lane = tid & 63, r32 = lane & 31, hi = lane >> 5;
    LAS char* V_lds = lds; LAS char* K_lds = lds + 2 * SHM_V;
    LAS float* ws = (LAS float*)(lds + 2 * SHM_V + 2 * SHM_K) + wid * 64; LAS float* li_l = ws; LAS float* al_l = ws + 32;
    float m_reg = -1e30f, l_reg = 0; f32x16 o[NB]; bf16x8 qr[ND0];
#pragma unroll
    for (int d = 0; d < NB; ++d) o[d] = f32x16{};
    const bf16* Qw = Qb + (long)(wid * 32 + r32) * ldq + hi * 8;
#pragma unroll
    for (int d0 = 0; d0 < ND0; ++d0) qr[d0] = *(const bf16x8*)(Qw + d0 * 16);
    f32x16 init = f32x16{};
    if constexpr (FIXM) {
        float q2 = 0.f;
#pragma unroll
        for (int d0 = 0; d0 < ND0; ++d0) { const u32x4 w = __builtin_bit_cast(u32x4, qr[d0]); f32x4 a, b; unpack8(w, a, b); q2 += sumsq4(a) + sumsq4(b); }
        { auto rr = __builtin_amdgcn_permlane32_swap(__float_as_uint(q2), __float_as_uint(q2), false, false); q2 = __uint_as_float(rr[0]) + __uint_as_float(rr[1]); }
        const float nm = -sqrtf(q2) * kbound;
#pragma unroll
        for (int r = 0; r < 16; ++r) init[r] = nm;
        asm volatile("" : "+v"(init));
    }
    const bf16* kp[NKL]; int kstr[NKL], kdst[NKL]; bool kval[NKL];
#pragma unroll
    for (int i = 0; i < NKL; ++i) { const int c = tid + 512 * i; kval[i] = c < 64 * CK; const int cc_ = kval[i] ? c : 0; const int row = cc_ / CK, cc = cc_ % CK;
        if (cc * 8 < D1) { kp[i] = K1 + (long)row * ldk1 + cc * 8; kstr[i] = 64 * ldk1; } else { kp[i] = K2 + (long)row * ldk2 + (cc * 8 - D1); kstr[i] = 64 * ldk2; }
        kdst[i] = KSWZ(row, cc * 16); }
    const bf16* vp[NVL]; int vdst[NVL]; const int vstr = 64 * ldv;
#pragma unroll
    for (int i = 0; i < NVL; ++i) { const int c = tid + 512 * i; const int row = c / CV, cc = c % CV; vp[i] = Vh + (long)row * ldv + cc * 8; vdst[i] = v_st<NB>(row, cc * 8); }
    const int vb0 = (int)(uintptr_t)V_lds + v_rd_base(lane);
    struct { bf16x8 ks[NKL]; bf16x8 vs[NVL]; } sr_[2];
#define SLOAD(i, t) do { _Pragma("unroll") for (int q_ = 0; q_ < NVL; ++q_) sr_[i].vs[q_] = *(const bf16x8*)(vp[q_] + (long)(t) * vstr); \
    _Pragma("unroll") for (int q_ = 0; q_ < NKL; ++q_) { if (kval[q_]) sr_[i].ks[q_] = *(const bf16x8*)(kp[q_] + (long)(t) * kstr[q_]); } } while (0)
#define SWRITE(b, i) do { _Pragma("unroll") for (int q_ = 0; q_ < NVL; ++q_) *(LAS bf16x8*)(V_lds + (b) * SHM_V + vdst[q_]) = sr_[i].vs[q_]; \
    _Pragma("unroll") for (int q_ = 0; q_ < NKL; ++q_) { if (kval[q_]) *(LAS bf16x8*)(K_lds + (b) * SHM_K + kdst[q_]) = sr_[i].ks[q_]; } } while (0)
#define SWAIT() asm volatile("s_waitcnt vmcnt(%0)" :: "n"(NKL + NVL) : "memory")
#define RESC(a) do { if (__any((a) < 1.f)) { if (hi == 0) al_l[r32] = (a); asm volatile("s_waitcnt lgkmcnt(0)" ::: "memory"); \
    _Pragma("unroll") for (int d = 0; d < NB; ++d) _Pragma("unroll") for (int r = 0; r < 16; ++r) o[d][r] *= al_l[crow(r, hi)]; } } while (0)
    f32x16 pA0, pA1, pB0, pB1; float alA = 1.f, alB = 1.f; bf16x8 pa0, pa1, pa2, pa3; const int NT = seq / 64;
#define PSM(P0, P1, AL) do { if constexpr (FIXM) expA(P0); else partialSM(P0, P1, m_reg, AL); } while (0)
#define RSC(AL) do { if constexpr (!FIXM) RESC(AL); } while (0)
    SLOAD(0, 0); asm volatile("s_waitcnt vmcnt(0)" ::: "memory"); SWRITE(0, 0); __syncthreads();
    qkt<ND0>(pA0, pA1, K_lds, qr, r32, hi, init); PSM(pA0, pA1, alA);
    SLOAD(1, 1); if (2 < NT) SLOAD(0, 2);
    SWAIT(); SWRITE(1, 1); __syncthreads();
    for (int j = 1; j + 1 < NT; j += 2) {
        SBAR(); qkt<ND0>(pB0, pB1, K_lds + SHM_K, qr, r32, hi, init);
        finishSM(pA0, pA1, alA, l_reg, pa0, pa1, pa2, pa3); SBAR();
        SLOAD(1, j + 2); SBAR();
        pv_all<NB>(o, vb0, pa0, pa1, pa2, pa3); PSM(pB0, pB1, alB);
        __syncthreads(); SWAIT(); SWRITE(0, 0);
        RSC(alB); __syncthreads();
        SBAR(); qkt<ND0>(pA0, pA1, K_lds, qr, r32, hi, init);
        finishSM(pB0, pB1, alB, l_reg, pa0, pa1, pa2, pa3); SBAR();
        if (j + 3 < NT) SLOAD(0, j + 3); SBAR();
        pv_all<NB>(o, vb0 + SHM_V, pa0, pa1, pa2, pa3); PSM(pA0, pA1, alA);
        __syncthreads(); SWAIT(); SWRITE(1, 1);
        RSC(alA); __syncthreads();
    }
    SBAR(); qkt<ND0>(pB0, pB1, K_lds + SHM_K, qr, r32, hi, init);
    finishSM(pA0, pA1, alA, l_reg, pa0, pa1, pa2, pa3); SBAR();
    pv_all<NB>(o, vb0, pa0, pa1, pa2, pa3); PSM(pB0, pB1, alB);
    __syncthreads(); RSC(alB);
    finishSM(pB0, pB1, alB, l_reg, pa0, pa1, pa2, pa3); SBAR();
    pv_all<NB>(o, vb0 + SHM_V, pa0, pa1, pa2, pa3);
#undef PSM
#undef RSC
    if (hi == 0) li_l[r32] = l_reg; asm volatile("s_waitcnt lgkmcnt(0)" ::: "memory");
    float rli[16];
#pragma unroll
    for (int r = 0; r < 16; ++r) rli[r] = __builtin_amdgcn_rcpf(li_l[crow(r, hi)]);
    bf16* Ow = Ob + (long)(wid * 32) * ldo;
#pragma unroll
    for (int r = 0; r < 16; ++r) { const int orow = crow(r, hi);
#pragma unroll
        for (int d0 = 0; d0 < NB; ++d0) Ow[(long)orow * ldo + d0 * 32 + r32] = f2bf(o[d0][r] * rli[r]); }
    __syncthreads();
#undef SLOAD
#undef SWRITE
#undef SWAIT
#undef RESC
}

#define EXP4(P, B) do { P[B] = __builtin_amdgcn_exp2f(P[B]); P[B + 1] = __builtin_amdgcn_exp2f(P[B + 1]); P[B + 2] = __builtin_amdgcn_exp2f(P[B + 2]); P[B + 3] = __builtin_amdgcn_exp2f(P[B + 3]); } while (0)
#define SUM4(S, P, B) do { S += (P[B] + P[B + 1]) + (P[B + 2] + P[B + 3]); } while (0)
#define PK4X(P, BASE, OUT) do { const u32x4 w_ = {cvt_pk_bf16(P[BASE + 0], P[BASE + 1]), cvt_pk_bf16(P[BASE + 2], P[BASE + 3]), cvt_pk_bf16(P[BASE + 4], P[BASE + 5]), cvt_pk_bf16(P[BASE + 6], P[BASE + 7])}; OUT = __builtin_bit_cast(bf16x8, w_); } while (0)
typedef short v4i16_t __attribute__((ext_vector_type(4)));
__device__ __forceinline__ s16x4 vtr(const LAS char* p) { return __builtin_bit_cast(s16x4, __builtin_amdgcn_ds_read_tr16_b64_v4i16((LAS v4i16_t*)p)); }
#define KSWZ2(row, colB) ((row) * 256 + ((colB) ^ (((row) & 15) << 4)))
template <int DQK, int D1, int DVV>
__device__ __forceinline__ void attn_unit2(const bf16* __restrict__ Qb, int ldq, const bf16* __restrict__ K1, int ldk1, const bf16* __restrict__ K2, int ldk2,
                                           const bf16* __restrict__ Vh, int ldv, bf16* __restrict__ Ob, int ldo, int seq, LAS char* lds, float kbound) {
    constexpr int ND0 = DQK / 16, NB = DVV / 32, CK = DQK / 8;
    constexpr int SHM_V = 64 * DVV * 2, SHM_K = 64 * 256;
    static_assert(NB == 2 && ND0 == 6, "written for QK dim 96 / V dim 64");
    int tid_ = threadIdx.x; asm volatile("" : "+v"(tid_));
    const int tid = tid_, wid = __builtin_amdgcn_readfirstlane(tid >> 6), lane = tid & 63, r32 = lane & 31, hi = lane >> 5;
    LAS char* V_lds = lds; LAS char* K_lds = lds + 3 * SHM_V;
    LAS float* ws = (LAS float*)(lds + 3 * SHM_V + 2 * SHM_K) + wid * 64;
    LAS char* QAL = lds + 3 * SHM_V + 2 * SHM_K + 2048 + wid * (2 * ND0 * 1024) + lane * 16; LAS char* QBL = QAL + ND0 * 1024;
    float nm;
    { bf16x8 qa[ND0], qb[ND0];
      const bf16* QwA = Qb + (long)(wid * 64 + r32) * ldq + hi * 8; const bf16* QwB = QwA + (long)32 * ldq;
#pragma unroll
      for (int d0 = 0; d0 < ND0; ++d0) { qa[d0] = *(const bf16x8*)(QwA + d0 * 16); qb[d0] = *(const bf16x8*)(QwB + d0 * 16); }
      float q2a = 0.f, q2b = 0.f;
#pragma unroll
      for (int d0 = 0; d0 < ND0; ++d0) { f32x4 a, b; unpack8(__builtin_bit_cast(u32x4, qa[d0]), a, b); q2a += sumsq4(a) + sumsq4(b); unpack8(__builtin_bit_cast(u32x4, qb[d0]), a, b); q2b += sumsq4(a) + sumsq4(b);
          *(LAS bf16x8*)(QAL + d0 * 1024) = qa[d0]; *(LAS bf16x8*)(QBL + d0 * 1024) = qb[d0]; }
      { auto rr = __builtin_amdgcn_permlane32_swap(__float_as_uint(q2a), __float_as_uint(q2a), false, false); q2a = __uint_as_float(rr[0]) + __uint_as_float(rr[1]); }
      { auto rr = __builtin_amdgcn_permlane32_swap(__float_as_uint(q2b), __float_as_uint(q2b), false, false); q2b = __uint_as_float(rr[0]) + __uint_as_float(rr[1]); }
      nm = -sqrtf(fmaxf(q2a, q2b)) * kbound; }
    const bf16* kp[2]; int kstr[2];
#pragma unroll
    for (int i = 0; i < 2; ++i) { const int row = 8 * wid + 4 * i + (lane >> 4), cc = (lane & 15) ^ (row & 15);
        if (cc >= 8 && cc < CK) { kp[i] = K2 + (long)row * ldk2 + (cc * 8 - D1); kstr[i] = 64 * ldk2; } else { kp[i] = K1 + (long)row * ldk1 + (cc < 8 ? cc * 8 : 0); kstr[i] = 64 * ldk1; } }
    const bf16* vp; { const int k = 8 * wid + ((lane & 31) >> 2); vp = Vh + (long)k * ldv + (lane >> 5) * 32 + (lane & 3) * 8; }
    const int vstr = 64 * ldv;
    const LAS char* vrd0 = V_lds + v_rd_base(lane);
#define DMA2(t, kb, vbuf) do { \
    __builtin_amdgcn_global_load_lds((const unsigned*)(kp[0] + (long)(t) * kstr[0]), (LAS unsigned*)(K_lds + (kb) * SHM_K + wid * 2048), 16, 0, 0); \
    __builtin_amdgcn_global_load_lds((const unsigned*)(kp[1] + (long)(t) * kstr[1]), (LAS unsigned*)(K_lds + (kb) * SHM_K + wid * 2048 + 1024), 16, 0, 0); \
    __builtin_amdgcn_global_load_lds((const unsigned*)(vp + (long)(t) * vstr), (LAS unsigned*)(V_lds + (vbuf) * SHM_V + wid * 1024), 16, 0, 0); } while (0)
#define VRD8(arr, base, D0) do { _Pragma("unroll") for (int j_ = 0; j_ < 8; ++j_) arr[j_] = vtr((base) + (j_ * NB + (D0)) * 512); } while (0)
#define PKV(arr, ks) (bf16x8){arr[2 * (ks)][0], arr[2 * (ks)][1], arr[2 * (ks)][2], arr[2 * (ks)][3], arr[2 * (ks) + 1][0], arr[2 * (ks) + 1][1], arr[2 * (ks) + 1][2], arr[2 * (ks) + 1][3]}
    f32x16 oA[2], oB[2]; oA[0] = f32x16{}; oA[1] = f32x16{}; oB[0] = f32x16{}; oB[1] = f32x16{};
    float lA = 0.f, lB = 0.f; const int NT = seq / 64;
    f32x16 a0, a1, c0, c1; bf16x8 pa0, pa1, pa2, pa3;
#define HALF1(Kb) do { \
        f32x16 init; { float nmv = nm; asm volatile("" : "+v"(nmv)); _Pragma("unroll") for (int r = 0; r < 16; ++r) init[r] = nmv; } \
        SBAR(); \
        _Pragma("unroll") for (int d0 = 0; d0 < ND0; ++d0) { const int cb = (d0 * 16 + hi * 8) * 2; \
            const bf16x8 k0 = *(const LAS bf16x8*)((Kb) + KSWZ2(r32, cb)), k1 = *(const LAS bf16x8*)((Kb) + KSWZ2(32 + r32, cb)), qv = *(const LAS bf16x8*)(QAL + d0 * 1024); \
            a0 = __builtin_amdgcn_mfma_f32_32x32x16_bf16(k0, qv, d0 == 0 ? init : a0, 0, 0, 0); \
            a1 = __builtin_amdgcn_mfma_f32_32x32x16_bf16(k1, qv, d0 == 0 ? init : a1, 0, 0, 0); } \
        SBAR(); \
        float sA = 0.f; \
        _Pragma("unroll") for (int d0 = 0; d0 < ND0; ++d0) { const int cb = (d0 * 16 + hi * 8) * 2; \
            const bf16x8 k0 = *(const LAS bf16x8*)((Kb) + KSWZ2(r32, cb)), k1 = *(const LAS bf16x8*)((Kb) + KSWZ2(32 + r32, cb)), qv = *(const LAS bf16x8*)(QBL + d0 * 1024); \
            c0 = __builtin_amdgcn_mfma_f32_32x32x16_bf16(k0, qv, d0 == 0 ? init : c0, 0, 0, 0); \
            if (d0 == 3) { EXP4(a0, 0); EXP4(a0, 4); } \
            if (d0 == 4) { EXP4(a0, 12); SUM4(sA, a0, 0); SUM4(sA, a0, 4); EXP4(a1, 0); } \
            if (d0 == 5) { EXP4(a1, 8); SUM4(sA, a1, 0); SUM4(sA, a1, 4); } \
            c1 = __builtin_amdgcn_mfma_f32_32x32x16_bf16(k1, qv, d0 == 0 ? init : c1, 0, 0, 0); \
            if (d0 == 3) { EXP4(a0, 8); } \
            if (d0 == 4) { EXP4(a1, 4); SUM4(sA, a0, 8); SUM4(sA, a0, 12); } \
            if (d0 == 5) { EXP4(a1, 12); SUM4(sA, a1, 8); SUM4(sA, a1, 12); } \
            if (d0 >= 2) SBAR(); } \
        lA += sA; \
        PK4X(a0, 0, pa0); PK4X(a0, 8, pa1); PK4X(a1, 0, pa2); PK4X(a1, 8, pa3); \
        SBAR(); } while (0)
#define HALF2(vbase) do { \
        float sB = 0.f; s16x4 va[8], vb_[8]; \
        VRD8(va, vbase, 0); VRD8(vb_, vbase, 1); \
        oA[0] = __builtin_amdgcn_mfma_f32_32x32x16_bf16(pa0, PKV(va, 0), oA[0], 0, 0, 0); SBAR(); \
        oA[1] = __builtin_amdgcn_mfma_f32_32x32x16_bf16(pa0, PKV(vb_, 0), oA[1], 0, 0, 0); EXP4(c0, 0); EXP4(c0, 4); SBAR(); \
        oA[0] = __builtin_amdgcn_mfma_f32_32x32x16_bf16(pa1, PKV(va, 1), oA[0], 0, 0, 0); EXP4(c0, 8); EXP4(c0, 12); SUM4(sB, c0, 0); SBAR(); \
        oA[1] = __builtin_amdgcn_mfma_f32_32x32x16_bf16(pa1, PKV(vb_, 1), oA[1], 0, 0, 0); EXP4(c1, 0); SUM4(sB, c0, 4); SUM4(sB, c0, 8); SBAR(); \
        oA[0] = __builtin_amdgcn_mfma_f32_32x32x16_bf16(pa2, PKV(va, 2), oA[0], 0, 0, 0); EXP4(c1, 4); SUM4(sB, c0, 12); SBAR(); \
        oA[1] = __builtin_amdgcn_mfma_f32_32x32x16_bf16(pa2, PKV(vb_, 2), oA[1], 0, 0, 0); EXP4(c1, 8); SUM4(sB, c1, 0); SBAR(); \
        oA[0] = __builtin_amdgcn_mfma_f32_32x32x16_bf16(pa3, PKV(va, 3), oA[0], 0, 0, 0); EXP4(c1, 12); SUM4(sB, c1, 4); SBAR(); \
        oA[1] = __builtin_amdgcn_mfma_f32_32x32x16_bf16(pa3, PKV(vb_, 3), oA[1], 0, 0, 0); SUM4(sB, c1, 8); SUM4(sB, c1, 12); SBAR(); \
        lB += sB; \
        PK4X(c0, 0, pa0); PK4X(c0, 8, pa1); PK4X(c1, 0, pa2); PK4X(c1, 8, pa3); \
        SBAR(); \
        VRD8(va, vbase, 0); VRD8(vb_, vbase, 1);                       \
        oB[0] = __builtin_amdgcn_mfma_f32_32x32x16_bf16(pa0, PKV(va, 0), oB[0], 0, 0, 0); \
        oB[1] = __builtin_amdgcn_mfma_f32_32x32x16_bf16(pa0, PKV(vb_, 0), oB[1], 0, 0, 0); \
        oB[0] = __builtin_amdgcn_mfma_f32_32x32x16_bf16(pa1, PKV(va, 1), oB[0], 0, 0, 0); \
        oB[1] = __builtin_amdgcn_mfma_f32_32x32x16_bf16(pa1, PKV(vb_, 1), oB[1], 0, 0, 0); \
        oB[0] = __builtin_amdgcn_mfma_f32_32x32x16_bf16(pa2, PKV(va, 2), oB[0], 0, 0, 0); \
        oB[1] = __builtin_amdgcn_mfma_f32_32x32x16_bf16(pa2, PKV(vb_, 2), oB[1], 0, 0, 0); \
        oB[0] = __builtin_amdgcn_mfma_f32_32x32x16_bf16(pa3, PKV(va, 3), oB[0], 0, 0, 0); \
        oB[1] = __builtin_amdgcn_mfma_f32_32x32x16_bf16(pa3, PKV(vb_, 3), oB[1], 0, 0, 0); \
        SBAR(); } while (0)
#define TILE_BAR() do { asm volatile("s_waitcnt vmcnt(0)" ::: "memory"); __syncthreads(); } while (0)
    DMA2(0, 0, 0);
    if (wid < 4) {
        int vs = 0;
#pragma unroll 1
        for (int t = 0; t < NT; ++t) { TILE_BAR();
            const int vn = vs == 2 ? 0 : vs + 1; if (t + 1 < NT) DMA2(t + 1, (t + 1) & 1, vn);
            HALF1(K_lds + (t & 1) * SHM_K); HALF2(vrd0 + vs * SHM_V); vs = vn; }
        TILE_BAR();
    } else {
        __builtin_amdgcn_s_setprio(1);
        TILE_BAR(); if (1 < NT) DMA2(1, 1, 1);
        HALF1(K_lds);
        int vs = 0;
#pragma unroll 1
        for (int t = 1; t < NT; ++t) { TILE_BAR();
            const int vn = vs == 2 ? 0 : vs + 1; const int vnn = vn == 2 ? 0 : vn + 1; if (t + 1 < NT) DMA2(t + 1, (t + 1) & 1, vnn);
            HALF2(vrd0 + vs * SHM_V); HALF1(K_lds + (t & 1) * SHM_K); vs = vn; }
        TILE_BAR();
        HALF2(vrd0 + vs * SHM_V);
        __builtin_amdgcn_s_setprio(0);
    }
#undef HALF1
#undef HALF2
#undef TILE_BAR
    { auto rr = __builtin_amdgcn_permlane32_swap(__float_as_uint(lA), __float_as_uint(lA), false, false); lA = __uint_as_float(rr[0]) + __uint_as_float(rr[1]); }
    { auto rr = __builtin_amdgcn_permlane32_swap(__float_as_uint(lB), __float_as_uint(lB), false, false); lB = __uint_as_float(rr[0]) + __uint_as_float(rr[1]); }
    if (hi == 0) { ws[r32] = lA; ws[32 + r32] = lB; } asm volatile("s_waitcnt lgkmcnt(0)" ::: "memory");
    bf16* Ow = Ob + (long)(wid * 64) * ldo;
#pragma unroll
    for (int r = 0; r < 16; ++r) { const int orow = crow(r, hi); const float ra = __builtin_amdgcn_rcpf(ws[orow]), rb = __builtin_amdgcn_rcpf(ws[32 + orow]);
#pragma unroll
        for (int d0 = 0; d0 < NB; ++d0) { Ow[(long)orow * ldo + d0 * 32 + r32] = f2bf(oA[d0][r] * ra); Ow[(long)(32 + orow) * ldo + d0 * 32 + r32] = f2bf(oB[d0][r] * rb); } }
    __syncthreads();
#undef DMA2
#undef VRD8
#undef PKV
}
#undef EXP4
#undef SUM4
#undef PK4X

__device__ __forceinline__ void spatial_unit(int chunk, int g, const bf16* __restrict__ U, const bf16* __restrict__ VR, const float* __restrict__ vstat, const float* __restrict__ g_sg,
                                             const bf16* __restrict__ Wsb, const float* __restrict__ b_s, bf16* __restrict__ Y, LAS char* lds) {
    int tid_ = threadIdx.x; asm volatile("" : "+v"(tid_));
    const int tid = tid_, wid = tid >> 6, lane = tid & 63, r32 = lane & 31, hi = lane >> 5, rb = wid & 3, ch = wid >> 2;
    LAS char* V_lds = lds; LAS float* rv = (LAS float*)(lds + 32768);
    const int row0 = chunk * 128;
    if (tid < 128) { const f32x4 s0 = *(const f32x4*)(vstat + (size_t)(row0 + tid) * 8), s1 = *(const f32x4*)(vstat + (size_t)(row0 + tid) * 8 + 4);
        rv[tid] = __builtin_amdgcn_rsqf(((s0[0] + s0[1]) + (s0[2] + s0[3]) + (s1[0] + s1[1]) + (s1[2] + s1[3])) * (1.f / 512.f) + EPS); }
    __syncthreads();
#pragma unroll
    for (int i = 0; i < 4; ++i) { const int c = tid + 512 * i, row = c >> 4, cc = c & 15;
        const u32x4 w = *(const u32x4*)(VR + (size_t)(row0 + row) * 512 + g * 128 + cc * 8); f32x4 a, b; unpack8(w, a, b);
        const f32x4 g0 = *(const f32x4*)(g_sg + g * 128 + cc * 8), g1 = *(const f32x4*)(g_sg + g * 128 + cc * 8 + 4); const float r = rv[row];
        *(LAS u32x4*)(V_lds + (row >> 6) * 16384 + v_st<4>(row & 63, cc * 8)) = pack8(a * r * g0, b * r * g1); }
    bf16x8 pa[8];
#pragma unroll
    for (int ks = 0; ks < 8; ++ks) pa[ks] = *(const bf16x8*)(Wsb + (size_t)g * 16384 + (size_t)(32 * rb + r32) * 128 + 16 * ks + 8 * hi);
    __syncthreads();
    f32x16 o[2]; o[0] = f32x16{}; o[1] = f32x16{};
    const int vb = (int)(uintptr_t)V_lds + v_rd_base(lane) + (2 * ch) * 512;
    pv_one<4, 0>(o[0], vb, pa[0], pa[1], pa[2], pa[3]); pv_one<4, 1>(o[1], vb, pa[0], pa[1], pa[2], pa[3]);
    pv_one<4, 0>(o[0], vb + 16384, pa[4], pa[5], pa[6], pa[7]); pv_one<4, 1>(o[1], vb + 16384, pa[4], pa[5], pa[6], pa[7]);
#pragma unroll
    for (int r = 0; r < 16; ++r) { const int i = 32 * rb + crow(r, hi); const float bias = b_s[g * 128 + i]; const size_t row = (size_t)(row0 + i);
#pragma unroll
        for (int dd = 0; dd < 2; ++dd) { const int c = g * 128 + 64 * ch + 32 * dd + r32; const float uu = bf2f(U[row * 512 + c]);
            Y[row * 1536 + 512 + c] = f2bf(uu * (o[dd][r] + bias)); } }
    __syncthreads();
}
#undef KSWZ
#undef SBAR
}

#define XB_TMO      128
#define XB_XCNT(j)  (256  + 64 * (j))
#define XB_XSUB(j)  (1280 + 64 * (j))
#define XB_XGEN(j)  (2304 + 64 * (j))
#define XB_TOP      3328
#define XB_TOPGEN   3392
#define XCD_BAR_WORDS 3456
#define XB_SPIN_CAP (1u << 18)
__device__ __forceinline__ unsigned xb_ld(unsigned* p)              { return __hip_atomic_load((GAS unsigned*)p, __ATOMIC_RELAXED, __HIP_MEMORY_SCOPE_AGENT); }
__device__ __forceinline__ unsigned xb_add(unsigned* p, unsigned v) { return __hip_atomic_fetch_add((GAS unsigned*)p, v, __ATOMIC_RELAXED, __HIP_MEMORY_SCOPE_AGENT); }
__device__ __forceinline__ unsigned xb_xcc_id() { return (unsigned)__builtin_amdgcn_s_getreg((3 << 11) | 20) & 0xFu; }
#define XB_SPIN(cond, bar) do { unsigned _sp = 0; while (cond) { __builtin_amdgcn_s_sleep(1); \
    if ((++_sp & 255u) == 0u) { if (xb_ld(&(bar)[XB_TMO])) break; if (_sp > XB_SPIN_CAP) { xb_add(&(bar)[XB_TMO], 1u); break; } } } } while (0)
struct XcdBarrier { unsigned* bar; unsigned x; volatile LAS unsigned* st; };
__device__ __forceinline__ XcdBarrier xcd_barrier_post(unsigned* bar, volatile LAS unsigned* st) {
    XcdBarrier b; b.bar = bar; b.x = (unsigned)__builtin_amdgcn_readfirstlane((int)xb_xcc_id()); b.st = st;
    if (threadIdx.x == 0) (void)xb_add(&bar[XB_XCNT(b.x)], 1u);
    return b;
}
__device__ __forceinline__ void xcd_barrier_complete(unsigned* bar, unsigned x, unsigned& nloc, unsigned& nx) {
    const unsigned G = gridDim.x * gridDim.y * gridDim.z;
    unsigned sum, cnt, mine, sp = 0u;
    for (;;) {
        sum = 0u; cnt = 0u; mine = 0u;
#pragma unroll
        for (unsigned j = 0; j < 16; ++j) { const unsigned c = xb_ld(&bar[XB_XCNT(j)]); sum += c; cnt += (c > 0u) ? 1u : 0u; mine = (j == x) ? c : mine; }
        if (sum == G) break;
        __builtin_amdgcn_s_sleep(1);
        if ((++sp & 255u) == 0u) { if (xb_ld(&bar[XB_TMO])) break; if (sp > XB_SPIN_CAP) { xb_add(&bar[XB_TMO], 1u); break; } }
    }
    nloc = mine > 0u ? mine : 1u; nx = cnt > 0u ? cnt : 1u;
}
__device__ __forceinline__ void xcd_barrier(const XcdBarrier& b) {
    asm volatile("s_waitcnt vmcnt(0)" ::: "memory");
    __syncthreads();
    if (threadIdx.x == 0) {
        unsigned* bar = b.bar; unsigned bx = b.x; asm volatile("" : "+s"(bar), "+s"(bx));
        __builtin_amdgcn_s_waitcnt(0);
        unsigned nloc = b.st[0], nx = b.st[1];
        if (nloc == 0u) { xcd_barrier_complete(bar, bx, nloc, nx); b.st[0] = nloc; b.st[1] = nx; }
        const unsigned old = xb_add(&bar[XB_XSUB(bx)], 1u);
        const unsigned gen = old / nloc;
        if (old + 1u == (gen + 1u) * nloc) {
            __builtin_amdgcn_fence(__ATOMIC_RELEASE, "agent");
            asm volatile("s_waitcnt vmcnt(0)" ::: "memory");
            const unsigned og = xb_add(&bar[XB_TOP], 1u);
            const unsigned tg = og / nx;
            if (og + 1u == (tg + 1u) * nx) xb_add(&bar[XB_TOPGEN], 1u);
            else XB_SPIN(xb_ld(&bar[XB_TOPGEN]) == tg, bar);
            __builtin_amdgcn_fence(__ATOMIC_ACQUIRE, "agent");
            xb_add(&bar[XB_XGEN(bx)], 1u);
            asm volatile("s_waitcnt vmcnt(0)" ::: "memory");
        } else {
            XB_SPIN(xb_ld(&bar[XB_XGEN(bx)]) == gen, bar);
            __builtin_amdgcn_fence(__ATOMIC_ACQUIRE, "agent");
            asm volatile("s_waitcnt vmcnt(0)" ::: "memory");
        }
    }
    __syncthreads();
}

enum { CV_NAT = 0, CV_WIN = 1, CV_WUQ = 2, CV_W13 = 3 };
__device__ __forceinline__ int ropeperm(int p) { return ((p >> 2) & 1) * 16 + 4 * (p >> 3) + (p & 3); }
__device__ __forceinline__ int cv_map(int kind, int G, int& which, float& scale, bool& perm) {
    which = 0; scale = 1.f; perm = false; const int n = G * 32;
    if (kind == CV_WIN) {
        if (n < 384) return n;
        if (n < 416) { perm = true; return 640; }
        if (n < 512) return -1;
        if (n < 768) return 384 + (n - 512);
        if (n < 1280) return 672 + (n - 768);
        if (n < 1792) return 1184 + (n - 1280);
        if (n < 2304) { scale = XSCALE; return 1696 + (n - 1792); }
        return 2208 + (n - 2304);
    }
    if (kind == CV_WUQ) { scale = QSCALE; perm = (G % 3) == 2; return n; }
    if (kind == CV_W13) { which = (n >> 7) & 1; return 128 * (n >> 8) + (n & 127); }
    return n;
}
struct CvDesc { const float* src; const float* src2; const float* gain; bf16* dst; int K, Nsrc, Nout, kind; };
__device__ __forceinline__ void cv_item(const CvDesc& d, int item, LAS char* tile, int lane) {
    const int nI = d.Nout >> 7, kb = item / nI, nb = item - kb * nI, k0 = 64 * kb, n0 = 128 * nb;
    const int nq = lane & 31, kh = lane >> 5;
    const int nout = n0 + 4 * nq, G = nout >> 5, p = nout & 31;
    int which; float scale; bool perm; const int sc = cv_map(d.kind, G, which, scale, perm);
    const bool zero = sc < 0;
    const float* W = d.src + (ptrdiff_t)which * (d.src2 - d.src) + (size_t)k0 * d.Nsrc + (zero ? 0 : sc + (perm ? ropeperm(p) : p));
#pragma unroll
    for (int half = 0; half < 2; ++half) {
        f32x4 v[16];
#pragma unroll
        for (int i = 0; i < 16; ++i) { const int k = 32 * half + 2 * i + kh; v[i] = zero ? (f32x4){0.f, 0.f, 0.f, 0.f} : *(const f32x4*)(W + (size_t)k * d.Nsrc); }
#pragma unroll
        for (int i = 0; i < 16; ++i) { const int k = 32 * half + 2 * i + kh; const float g = d.gain ? d.gain[k0 + k] * scale : scale; const f32x4 w = v[i] * g;
            *(LAS u32x2*)(tile + att::v_st<4>(k, 4 * nq)) = (u32x2){cvt_pk_bf16(w[0], w[1]), cvt_pk_bf16(w[2], w[3])}; }
    }
    LDS_WAIT(); asm volatile("" ::: "memory");
    const int vb = (int)(uintptr_t)tile + att::v_rd_base(lane);
    bf16* drow = d.dst + (size_t)(n0 >> 8) * 256 * d.K + (size_t)kb * (256 * 64) + (size_t)((n0 & 255) + nq) * 64 + 8 * kh;
#define CV_RD(D0, KS) { const s16x4 l_ = att::tr_read<((2 * KS) * 4 + D0) * 512>(vb), h_ = att::tr_read<((2 * KS + 1) * 4 + D0) * 512>(vb); \
        asm volatile("s_waitcnt lgkmcnt(0)" ::: "memory"); __builtin_amdgcn_sched_barrier(0); \
        *(bf16x8*)(drow + (32 * D0) * 64 + 16 * KS) = (bf16x8){l_[0], l_[1], l_[2], l_[3], h_[0], h_[1], h_[2], h_[3]}; }
#define CV_RD4(D0) CV_RD(D0, 0) CV_RD(D0, 1) CV_RD(D0, 2) CV_RD(D0, 3)
    CV_RD4(0) CV_RD4(1) CV_RD4(2) CV_RD4(3)
#undef CV_RD4
#undef CV_RD
    LDS_WAIT(); asm volatile("" ::: "memory");
}

struct Args {
    const float* x; const float* mem; const int* positions; const float* g_mix; const float* w_in; const float* g_q; const float* g_kv; const float* w_uq; const float* w_uk; const float* w_uv;
    const float* g_sg; const float* w_s; const float* b_s; const float* g_mem; const float* w_mkv; const float* w_br; const float* b_gate; const float* w_out; const float* g_ffn;
    const float* dense_w1; const float* dense_w3; const float* dense_w2; const float* w_router; const float* moe_w1; const float* moe_w3; const float* moe_w2; const float* g_final;
    float* out; unsigned char* ws; int dbg; int pad;
};
typedef const __attribute__((address_space(4))) Args* ArgsP;
#define FRESH(ap) ArgsP ap = kargs; asm volatile("" : "+s"(ap))
__constant__ double INVF[16] = { 1.0, 0.5623413251903491, 0.31622776601683794, 0.1778279410038923, 0.1, 0.05623413251903491, 0.03162277660168379, 0.01778279410038923,
                                 0.01, 0.005623413251903491, 0.003162277660168379, 0.001778279410038923, 0.001, 0.0005623413251903491, 0.00031622776601683794, 0.0001778279410038923 };

struct Frame { LAS unsigned char* lds; int G, NGW, bid; };
#define LOCAL_IDS int tid = threadIdx.x; asm volatile("" : "+v"(tid)); const int lane = tid & 63, wave = __builtin_amdgcn_readfirstlane(tid >> 6), gw = F.bid * NWAVES + wave; (void)lane; (void)gw

__device__ __forceinline__ void conv_run(const Frame& F, const CvDesc& d) {
    LOCAL_IDS;
    LAS char* tile = (LAS char*)(F.lds + wave * 16384);
    const int nitems = (d.K / 64) * (d.Nout / 128);
    for (int it = gw; it < nitems; it += F.NGW) cv_item(d, it, tile, lane);
}
__device__ __forceinline__ void rx_from_stats(const Frame& F, ArgsP kargs) {
    LOCAL_IDS; FRESH(ap); const float* xstat = (const float*)(ap->ws + WS_XSTAT); float* rx = (float*)(ap->ws + WS_RX);
    for (int row = F.bid * 512 + tid; row < M; row += F.G * 512) {
        const f32x4* p = (const f32x4*)(xstat + (size_t)row * 16); const f32x4 a = p[0], b = p[1], c = p[2], d = p[3];
        const float s = ((a[0] + a[1]) + (a[2] + a[3])) + ((b[0] + b[1]) + (b[2] + b[3])) + ((c[0] + c[1]) + (c[2] + c[3])) + ((d[0] + d[1]) + (d[2] + d[3]));
        rx[row] = __builtin_amdgcn_rsqf(s * (1.f / D) + EPS);
    }
}
__device__ __forceinline__ void conv_mixer(const Frame& F, ArgsP kargs, int l) {
    { FRESH(a); CvDesc d{a->w_in + (size_t)l * D * PTOT, nullptr, a->g_mix + l * D, (bf16*)(a->ws + WS_WINT), D, PTOT, PPAD, CV_WIN}; conv_run(F, d); }
    { FRESH(a); CvDesc d{a->w_uq + (size_t)l * QRANK * 768, nullptr, a->g_q + l * QRANK, (bf16*)(a->ws + WS_WUQT), QRANK, 768, 768, CV_WUQ}; conv_run(F, d); }
    { FRESH(a); CvDesc d{a->w_uk + (size_t)l * KVRANK * 512, nullptr, a->g_kv + l * KVRANK, (bf16*)(a->ws + WS_WUKVT), KVRANK, 512, 512, CV_NAT}; conv_run(F, d); }
    { FRESH(a); CvDesc d{a->w_uv + (size_t)l * KVRANK * 512, nullptr, a->g_kv + l * KVRANK, (bf16*)(a->ws + WS_WUKVT) + 512 * KVRANK, KVRANK, 512, 512, CV_NAT}; conv_run(F, d); }
#pragma unroll 1
    for (int n = 0; n < 3; ++n) { FRESH(a); CvDesc d{a->w_br + ((size_t)l * 3 + n) * BW * D, nullptr, nullptr, (bf16*)(a->ws + WS_WBRT) + (size_t)n * D * BW, BW, D, D, CV_NAT}; conv_run(F, d); }
    { FRESH(a); CvDesc d{a->w_out + (size_t)l * D * D, nullptr, nullptr, (bf16*)(a->ws + WS_WOUTT), D, D, D, CV_NAT}; conv_run(F, d); }
    { LOCAL_IDS; FRESH(a); const float* wsrc = a->w_s + (size_t)l * 65536; bf16* wdst = (bf16*)(a->ws + WS_WSB);
      for (int i = F.bid * 512 + tid; i < 4 * 128 * 128 / 4; i += F.G * 512) { const f32x4 v = *(const f32x4*)(wsrc + (size_t)i * 4);
        *(u32x2*)(wdst + (size_t)i * 4) = (u32x2){cvt_pk_bf16(v[0], v[1]), cvt_pk_bf16(v[2], v[3])}; } }
}
__device__ __forceinline__ void phase_prologue(const Frame& F, ArgsP kargs) {
    LOCAL_IDS;
    { FRESH(a); float* ROPE = (float*)(a->ws + WS_ROPE); const int* pos = a->positions;
      for (int idx = F.bid * 512 + tid; idx < M * 16; idx += F.G * 512) { const int row = idx >> 4, i = idx & 15;
        const double t = (double)pos[row] * INVF[i] * 0.15915494309189535; const float fr = (float)(t - rint(t));
        ROPE[(size_t)row * 32 + i] = __builtin_amdgcn_cosf(fr); ROPE[(size_t)row * 32 + 16 + i] = __builtin_amdgcn_sinf(fr); } }
    { FRESH(a); const float* xin = a->x; float* X = a->out; bf16* XB = (bf16*)(a->ws + WS_XB); float* RX = (float*)(a->ws + WS_RX);
      for (int m = gw; m < M; m += F.NGW) { const f32x4* xr = (const f32x4*)(xin + (size_t)m * D) + lane; f32x4 v[4]; float s = 0.f;
#pragma unroll
        for (int j = 0; j < 4; ++j) { v[j] = xr[64 * j]; s += sumsq4(v[j]); }
        s = wave_sum(s);
#pragma unroll
        for (int j = 0; j < 4; ++j) { ((f32x4*)(X + (size_t)m * D) + lane)[64 * j] = v[j]; ((u32x2*)(XB + (size_t)m * D) + lane)[64 * j] = (u32x2){cvt_pk_bf16(v[j][0], v[j][1]), cvt_pk_bf16(v[j][2], v[j][3])}; }
        if (lane == 0) RX[m] = __builtin_amdgcn_rsqf(s * (1.f / D) + EPS); } }
    { FRESH(a); const float* mem = a->mem; const float* g_mem = a->g_mem; bf16* MEMB = (bf16*)(a->ws + WS_MEMB);
      for (int m = gw; m < NMEM; m += F.NGW) { const f32x4* xr = (const f32x4*)(mem + (size_t)m * D) + lane; f32x4 v[4]; float s = 0.f;
#pragma unroll
        for (int j = 0; j < 4; ++j) { v[j] = xr[64 * j]; s += sumsq4(v[j]); }
        const float r = __builtin_amdgcn_rsqf(wave_sum(s) * (1.f / D) + EPS);
#pragma unroll
        for (int j = 0; j < 4; ++j) { const f32x4 g = ((const f32x4*)g_mem + lane)[64 * j]; const f32x4 w = v[j] * r * g;
            ((u32x2*)(MEMB + (size_t)m * D) + lane)[64 * j] = (u32x2){cvt_pk_bf16(w[0], w[1]), cvt_pk_bf16(w[2], w[3])}; } } }
#pragma unroll 1
    for (int l = 0; l < DEPTH; ++l) { FRESH(a); CvDesc d{a->w_mkv + (size_t)l * D * D, nullptr, nullptr, (bf16*)(a->ws + WS_WMKVT) + (size_t)l * D * D, D, D, D, CV_NAT}; conv_run(F, d); }
    conv_mixer(F, kargs, 0);
}
__device__ __forceinline__ void phase_inproj(const Frame& F, ArgsP kargs, int l) {
    if (PH(1)) { FRESH(a); unsigned char* ws = a->ws;
        pg8::TileOrder S{M / 256, PPAD / 256 - 1, F.G, F.bid, (const char*)(ws + WS_XB), (const char*)(ws + WS_WINT), (size_t)256 * D * 2, (size_t)256 * D * 2};
#ifdef DBG_REV
        S.rev = 1;
#endif
        pg8::EpiInProj E{ws, a->b_gate + (size_t)l * 3 * D, l, (l & 1)};
        pg8::gemm_phase(F.lds, D, D, D, S, E); }
    if (l == 0 && PH(2)) { FRESH(a); unsigned char* ws = a->ws;
        struct MemOrder { enum { VARK = 0, GATHER = 0 }; int c; const char* A; const char* B;
            __device__ __forceinline__ bool next(int i, pg8::Unit& u) const { if (i > 0 || c < 240) return false; const int idx = c - 240; u.pm = 0; u.pn = idx & 3; u.aux = idx >> 2; u.A = A; u.B = B + (size_t)u.aux * D * D * 2 + (size_t)u.pn * 256 * D * 2; return true; } };
        MemOrder S2{F.bid, (const char*)(ws + WS_MEMB), (const char*)(ws + WS_WMKVT)}; pg8::EpiMemKV E2{(bf16*)(ws + WS_KVMEM)};
        pg8::gemm_phase(F.lds, D, D, D, S2, E2); }
}
struct GateTailOrder { enum { VARK = 0, GATHER = 0 }; int c; const char* A; const char* B;
    __device__ __forceinline__ bool next(int i, pg8::Unit& u) const { if (i > 0 || c < 192) return false; u.pm = c - 192; u.pn = PPAD / 256 - 1; u.aux = 0; u.A = A + (size_t)u.pm * 256 * D * 2; u.B = B + (size_t)u.pn * 256 * D * 2; return true; } };
__device__ __forceinline__ void phase_up(const Frame& F, ArgsP kargs, int l) {
    if (PH(1)) { FRESH(a); unsigned char* ws = a->ws;
        GateTailOrder S{F.bid, (const char*)(ws + WS_XB), (const char*)(ws + WS_WINT)}; pg8::EpiInProj E{ws, a->b_gate + (size_t)l * 3 * D, l, (l & 1)};
        pg8::gemm_phase(F.lds, D, D, D, S, E); }
    if (PH(3)) { FRESH(a); unsigned char* ws = a->ws;
        pg8::TileOrder S{M / 256, 3, F.G, F.bid, (const char*)(ws + WS_CQ), (const char*)(ws + WS_WUQT), (size_t)256 * 512 * 2, (size_t)256 * QRANK * 2};
        pg8::EpiQ E{(const float*)(ws + WS_CQSTAT), (const float*)(ws + WS_ROPE), (bf16*)(ws + WS_Q)}; pg8::gemm_phase(F.lds, 512, QRANK, QRANK, S, E); }
    if (PH(4)) { FRESH(a); unsigned char* ws = a->ws;
        pg8::TileOrder S{M / 256, 4, F.G, F.bid, (const char*)(ws + WS_CKV), (const char*)(ws + WS_WUKVT), (size_t)256 * KVRANK * 2, (size_t)256 * KVRANK * 2};
        pg8::EpiKV E{(const float*)(ws + WS_CKVSTAT), (bf16*)(ws + WS_KN), (bf16*)(ws + WS_V), (unsigned*)(ws + WS_CTL) + CW_KMAX + l * 32}; pg8::gemm_phase(F.lds, KVRANK, KVRANK, KVRANK, S, E); }
    if (PH(5)) { FRESH(a); unsigned char* ws = a->ws;
        for (int un = F.bid; un < 512; un += F.G)
            att::spatial_unit(un >> 2, un & 3, (const bf16*)(ws + WS_U), (const bf16*)(ws + WS_VR), (const float*)(ws + WS_VSTAT), a->g_sg + l * BW, (const bf16*)(ws + WS_WSB), a->b_s + l * 512, (bf16*)(ws + WS_Y), (LAS char*)F.lds); }
    if (PH(6)) { FRESH(a); unsigned char* ws = a->ws;
        for (int un = F.bid; un < 256; un += F.G) { const int h = un & 3, pm = un >> 2; const bf16* kvm = (const bf16*)(ws + WS_KVMEM) + (size_t)l * 256 * 1024;
            att::attn_unit<128, 128, 128, false>((const bf16*)(ws + WS_QX) + (size_t)pm * 256 * 512 + h * 128, 512, kvm + h * 128, 1024, kvm, 1024, kvm + 512 + h * 128, 1024,
                                          (bf16*)(ws + WS_Y) + (size_t)pm * 256 * 1536 + 1024 + h * 128, 1536, NMEM, (LAS char*)F.lds, 0.f); } }
}
__device__ __forceinline__ void phase_attn(const Frame& F, ArgsP kargs, int l) {
    if (PH(7)) { FRESH(a); unsigned char* ws = a->ws;
        for (int un = F.bid; un < 256; un += F.G) { const int h = un & 7, qb = un >> 3;
            const unsigned* km = (const unsigned*)(ws + WS_CTL) + CW_KMAX + l * 32;
            const float kbound = sqrtf(__uint_as_float(km[2 * h]) + __uint_as_float(km[2 * h + 1]) + __uint_as_float(km[16])) * 1.02f;
            att::attn_unit2<96, 64, 64>((const bf16*)(ws + WS_Q) + (size_t)qb * 512 * 768 + h * 96, 768, (const bf16*)(ws + WS_KN) + h * 64, 512, (const bf16*)(ws + WS_KR), 32, (const bf16*)(ws + WS_V) + h * 64, 512,
                                        (bf16*)(ws + WS_Y) + (size_t)qb * 512 * 1536 + h * 64, 1536, M, (LAS char*)F.lds, kbound); } }
}
__device__ __forceinline__ void phase_branch(const Frame& F, ArgsP kargs) {
    if (PH(8)) { FRESH(a); unsigned char* ws = a->ws;
        struct BranchOrder { enum { VARK = 0, GATHER = 0 }; int c; const char* A; const char* B;
            __device__ __forceinline__ bool next(int i, pg8::Unit& u) const { if (i >= 3 || c >= 256) return false; int pm, pn; pg8::tile_of(c, 64, 4, pm, pn); u.pm = pm; u.pn = pn; u.aux = i;
                u.A = A + (size_t)pm * 256 * 1536 * 2 + (size_t)i * 512 * 2; u.B = B + (size_t)i * D * BW * 2 + (size_t)pn * 256 * BW * 2; return true; } };
        BranchOrder S{F.bid, (const char*)(ws + WS_Y), (const char*)(ws + WS_WBRT)}; pg8::EpiBranch E{(const unsigned char*)(ws + WS_GATE), (bf16*)(ws + WS_MIXB)};
        pg8::gemm_phase(F.lds, 1536, BW, BW, S, E); }
}
__device__ __forceinline__ void phase_outproj(const Frame& F, ArgsP kargs, bool dummy = false) {
    if (PH(9)) { FRESH(a); unsigned char* ws = a->ws;
        pg8::TileOrder S{M / 256, 4, F.G, F.bid, (const char*)(ws + WS_MIXB), (const char*)(ws + WS_WOUTT), (size_t)256 * D * 2, (size_t)256 * D * 2};
        pg8::EpiResid E{a->out, dummy ? (float*)(ws + 700 * MiB) : a->out, (bf16*)(ws + (dummy ? 764 * MiB : WS_XB)), (float*)(ws + (dummy ? 796 * MiB : WS_XSTAT))}; pg8::gemm_phase(F.lds, 0, D, D, S, E); }
}
__device__ __forceinline__ void phase_dense_conv(const Frame& F, ArgsP kargs, int l, int j2) {
    { FRESH(a); CvDesc d{a->dense_w1 + (size_t)j2 * D * DFF, a->dense_w3 + (size_t)j2 * D * DFF, a->g_ffn + l * D, (bf16*)(a->ws + WS_WFFN), D, DFF, 2 * DFF, CV_W13}; conv_run(F, d); }
    { FRESH(a); CvDesc d{a->dense_w2 + (size_t)j2 * DFF * D, nullptr, nullptr, (bf16*)(a->ws + WS_W2D), DFF, D, D, CV_NAT}; conv_run(F, d); }
    rx_from_stats(F, kargs);
    conv_mixer(F, kargs, l + 1);
}
__device__ __forceinline__ void phase_dense_up(const Frame& F, ArgsP kargs) {
    if (PH(10)) { FRESH(a); unsigned char* ws = a->ws;
        pg8::TileOrder S{M / 256, 2 * DFF / 256, F.G, F.bid, (const char*)(ws + WS_XB), (const char*)(ws + WS_WFFN), (size_t)256 * D * 2, (size_t)256 * D * 2};
        pg8::EpiSwiGLU E{(const float*)(ws + WS_RX), (bf16*)(ws + WS_HFF), DFF, 0}; pg8::gemm_phase(F.lds, D, D, D, S, E); }
}
__device__ __forceinline__ void phase_dense_down(const Frame& F, ArgsP kargs, bool dummy = false) {
    if (PH(11)) { FRESH(a); unsigned char* ws = a->ws;
        pg8::TileOrder S{M / 256, 4, F.G, F.bid, (const char*)(ws + WS_HFF), (const char*)(ws + WS_W2D), (size_t)256 * DFF * 2, (size_t)256 * DFF * 2};
        pg8::EpiResid E{a->out, dummy ? (float*)(ws + 700 * MiB) : a->out, (bf16*)(ws + (dummy ? 764 * MiB : WS_XB)), (float*)(ws + (dummy ? 796 * MiB : WS_XSTAT))}; pg8::gemm_phase(F.lds, 0, DFF, DFF, S, E); }
}
__device__ __forceinline__ void phase_moe_route(const Frame& F, ArgsP kargs, int l, int j2) {
    {
        int tid_ = threadIdx.x; asm volatile("" : "+v"(tid_)); const int lane_ = tid_ & 63, wave_ = __builtin_amdgcn_readfirstlane(tid_ >> 6);
        LAS char* tile = (LAS char*)(F.lds + wave_ * 16384);
        constexpr int I13 = (D / 64) * (2 * DFE / 128), I2 = (DFE / 64) * (D / 128), IE = I13 + I2;
#pragma unroll 1
        for (int idx = F.bid * NWAVES + wave_; idx < NE * IE; idx += F.NGW) { const int e = idx / IE, r = idx - e * IE;
            FRESH(a);
            if (r < I13) { CvDesc d{a->moe_w1 + ((size_t)j2 * NE + e) * D * DFE, a->moe_w3 + ((size_t)j2 * NE + e) * D * DFE, a->g_ffn + l * D, (bf16*)(a->ws + WS_WFFN) + (size_t)e * 2 * DFE * D, D, DFE, 2 * DFE, CV_W13}; cv_item(d, r, tile, lane_); }
            else { CvDesc d{a->moe_w2 + ((size_t)j2 * NE + e) * DFE * D, nullptr, nullptr, (bf16*)(a->ws + WS_W2M) + (size_t)e * D * DFE, DFE, D, D, CV_NAT}; cv_item(d, r - I13, tile, lane_); } }
    }
    if (l + 1 < DEPTH) conv_mixer(F, kargs, l + 1);
    __syncthreads();
    LOCAL_IDS; FRESH(a); unsigned char* ws = a->ws; const float* X = a->out;
    float* RX = (float*)(ws + WS_RX); int* TOPI = (int*)(ws + WS_TOPI); float* TOPW = (float*)(ws + WS_TOPW); int* LRANK = (int*)(ws + WS_LRANK); int* BLKCNT = (int*)(ws + WS_BLKCNT);
    LAS int* tope = (LAS int*)(F.lds + 0);
    const float* wr = a->w_router + (size_t)j2 * D * NE; const float* gf = a->g_ffn + l * D;
#pragma unroll 1
    for (int i = 0; i < 8; ++i) { const int rib = wave * 8 + i, row = F.bid * 64 + rib;
        float lg[8]; float ss = 0.f;
#pragma unroll
        for (int e = 0; e < 8; ++e) lg[e] = 0.f;
#pragma unroll
        for (int j = 0; j < 4; ++j) { const int k0 = 4 * lane + 256 * j; const f32x4 xv = *(const f32x4*)(X + (size_t)row * D + k0), gv = *(const f32x4*)(gf + k0); ss += sumsq4(xv);
#pragma unroll
            for (int q = 0; q < 4; ++q) { const float hv = xv[q] * gv[q]; const f32x4 w0 = *(const f32x4*)(wr + (size_t)(k0 + q) * 8), w1 = *(const f32x4*)(wr + (size_t)(k0 + q) * 8 + 4);
                lg[0] += hv * w0[0]; lg[1] += hv * w0[1]; lg[2] += hv * w0[2]; lg[3] += hv * w0[3]; lg[4] += hv * w1[0]; lg[5] += hv * w1[1]; lg[6] += hv * w1[2]; lg[7] += hv * w1[3]; } }
        const float r = __builtin_amdgcn_rsqf(wave_sum(ss) * (1.f / D) + EPS);
#pragma unroll
        for (int e = 0; e < 8; ++e) lg[e] = wave_sum(lg[e]) * r;
        int e0 = 0; float v0 = lg[0];
#pragma unroll
        for (int e = 1; e < 8; ++e) if (lg[e] > v0) { v0 = lg[e]; e0 = e; }
        int e1 = e0 == 0 ? 1 : 0; float v1 = -3.0e38f;
#pragma unroll
        for (int e = 0; e < 8; ++e) if (e != e0 && lg[e] > v1) { v1 = lg[e]; e1 = e; }
        const float w0 = 1.f / (1.f + expf(v1 - v0));
        if (lane == 0) { RX[row] = r; TOPI[row] = e0 | (e1 << 8); TOPW[(size_t)row * 2] = w0; TOPW[(size_t)row * 2 + 1] = 1.f - w0; tope[rib] = e0 | (e1 << 8); } }
    __syncthreads();
    if (wave == 0) { const int te = tope[lane], e0 = te & 255, e1 = te >> 8, row = F.bid * 64 + lane; const unsigned long long below = (1ull << lane) - 1ull;
        int rk0 = 0, rk1 = 0;
#pragma unroll
        for (int e = 0; e < 8; ++e) { const unsigned long long m0 = __ballot(e0 == e), m1 = __ballot(e1 == e); const int c0 = __popcll(m0);
            if (e0 == e) rk0 = __popcll(m0 & below); if (e1 == e) rk1 = c0 + __popcll(m1 & below);
            if (lane == 0) BLKCNT[F.bid * 8 + e] = c0 + __popcll(m1); }
        LRANK[(size_t)row * 2] = rk0; LRANK[(size_t)row * 2 + 1] = rk1; }
    __syncthreads();
}
__device__ __forceinline__ void moe_tiles(const Frame& F, ArgsP kargs, int (&tb)[NE + 1], LAS int* pre) {
    LOCAL_IDS; FRESH(a); const int* BLKCNT = (const int*)(a->ws + WS_BLKCNT);
    __syncthreads();
    if (tid < 16) pre[tid] = 0;
    __syncthreads();
    if (tid < 256) { const i32x4 c0 = *(const i32x4*)(BLKCNT + tid * 8), c1 = *(const i32x4*)(BLKCNT + tid * 8 + 4); const int cc[8] = {c0[0], c0[1], c0[2], c0[3], c1[0], c1[1], c1[2], c1[3]};
#pragma unroll
        for (int e = 0; e < 8; ++e) { const int tot = (int)wave_sum((float)cc[e]); const int bel = (int)wave_sum(tid < F.bid ? (float)cc[e] : 0.f);
            if (lane == 0) { __hip_atomic_fetch_add(pre + 8 + e, tot, __ATOMIC_RELAXED, __HIP_MEMORY_SCOPE_WORKGROUP); __hip_atomic_fetch_add(pre + e, bel, __ATOMIC_RELAXED, __HIP_MEMORY_SCOPE_WORKGROUP); } } }
    __syncthreads();
    int acc_t = 0;
#pragma unroll
    for (int e = 0; e < NE; ++e) { tb[e] = acc_t; acc_t += (__builtin_amdgcn_readfirstlane(pre[8 + e]) + 255) >> 8; }
    tb[NE] = acc_t;
}
__device__ __forceinline__ void phase_moe_gather(const Frame& F, ArgsP kargs) {
    int tb[NE + 1]; LAS int* pre = (LAS int*)(F.lds + 0);
    moe_tiles(F, kargs, tb, pre);
    LOCAL_IDS; FRESH(a); unsigned char* ws = a->ws;
    const int* TOPI = (const int*)(ws + WS_TOPI); const int* LRANK = (const int*)(ws + WS_LRANK); int* POS = (int*)(ws + WS_POS); float* SLOTR = (float*)(ws + WS_SLOTR); const float* RX = (const float*)(ws + WS_RX);
    int* TOKOF = (int*)(ws + WS_TOKOF);
    if (lane < 16) { const int pi = wave * 16 + lane, rib = pi >> 1, k = pi & 1, row = F.bid * 64 + rib;
        const int te = TOPI[row], e = k ? (te >> 8) : (te & 255); const int lr = LRANK[(size_t)row * 2 + k]; const float rx = RX[row];
        int bs = 0;
#pragma unroll
        for (int q = 0; q < NE; ++q) if (q == e) bs = tb[q] * 256;
        const int slot = bs + pre[e] + lr;
        POS[(size_t)row * 2 + k] = slot; SLOTR[slot] = rx; TOKOF[slot] = row; }
    if (F.bid < NE) { const int e = F.bid; int b0 = 0, b1 = 0;
#pragma unroll
        for (int q = 0; q < NE; ++q) if (q == e) { b0 = tb[q] * 256; b1 = tb[q + 1] * 256; }
        const int cnt = __builtin_amdgcn_readfirstlane(pre[8 + e]);
        for (int s = b0 + cnt + tid; s < b1; s += NWAVES * 64) { SLOTR[s] = 0.f; TOKOF[s] = 0; } }
    __syncthreads();
}
struct MoeOrder { enum { VARK = 0, GATHER = 0 }; int nN, G, c, T; int tb[NE + 1]; const char* A; const char* B; size_t astep, estep, bstep; int rev = 0;
    __device__ __forceinline__ bool next(int i, pg8::Unit& u) const { const long L = (long)i * G + c; if (L >= (long)T * nN) return false; int pm, pn; pg8::tile_of((int)L, T, nN, pm, pn); if (rev) pm = T - 1 - pm;
        int e = 0;
#pragma unroll
        for (int q = 1; q < NE; ++q) e += (pm >= tb[q]) ? 1 : 0;
        u.pm = pm; u.pn = pn; u.aux = e; u.A = A + (size_t)pm * astep; u.B = B + (size_t)e * estep + (size_t)pn * bstep; return true; } };
struct MoeUpOrder { enum { VARK = 0, GATHER = 1 }; int nN, G, c, T; int tb[NE + 1]; const char* A; const char* B; size_t estep, bstep; const LAS int* tokL;
    __device__ __forceinline__ bool next(int i, pg8::Unit& u) const { const long L = (long)i * G + c; if (L >= (long)T * nN) return false; int pm, pn; pg8::tile_of((int)L, T, nN, pm, pn);
        int e = 0;
#pragma unroll
        for (int q = 1; q < NE; ++q) e += (pm >= tb[q]) ? 1 : 0;
        u.pm = pm; u.pn = pn; u.aux = e; u.A = A; u.B = B + (size_t)e * estep + (size_t)pn * bstep; return true; } };
struct MoeTailOrder { enum { VARK = 1, GATHER = 0 }; static constexpr int PPU = DFE / 128;
    int nN, G, c, T; int tb[NE + 1]; const char* A; const char* B; size_t astep, estep, bstep; int rev = 0;
    __device__ __forceinline__ bool next(int i, pg8::Unit& u) const {
        const int U = T * nN, R = U / G, Lf = U - R * G, x = c & 7, j = c >> 3, nj = (G - x + 7) >> 3;
        const int Lfx = Lf > x ? (Lf - x + 7) >> 3 : 0;
        long L; int k0 = 0, np = PPU, part = 0, k = 0, r = 0, C = 1;
        if (i < R) L = (long)i * G + c;
        else if (i == R && Lfx > 0) { const int cap = nj / Lfx; C = cap >= 4 ? 4 : cap >= 2 ? 2 : 1;
            r = j / C; k = j - r * C; if (r >= Lfx) return false;
            L = (long)R * G + x + 8 * r; if (C > 1) { np = PPU / C; k0 = k * np; part = 3; } }
        else return false;
        int pm, pn; pg8::tile_of((int)L, T, nN, pm, pn); if (rev) pm = T - 1 - pm;
        int e = 0;
#pragma unroll
        for (int q = 1; q < NE; ++q) e += (pm >= tb[q]) ? 1 : 0;
        u.pm = pm; u.pn = pn; u.aux = e | (part << 4) | (k << 8) | (C << 16) | (r << 24); u.nt = 2 * np;
        u.A = A + (size_t)pm * astep + (size_t)k0 * 65536; u.B = B + (size_t)e * estep + (size_t)pn * bstep + (size_t)k0 * 65536; return true; } };
__device__ __forceinline__ void phase_moe_up(const Frame& F, ArgsP kargs) {
    if (PH(12)) { MoeUpOrder S; LAS int* pre = (LAS int*)(F.lds + RING_BYTES + 64); moe_tiles(F, kargs, S.tb, pre);
        FRESH(a); unsigned char* ws = a->ws; S.nN = 2 * DFE / 256; S.G = F.G; S.c = F.bid; S.T = S.tb[NE];
        S.A = (const char*)(ws + WS_XB); S.B = (const char*)(ws + WS_WFFN); S.estep = (size_t)2 * DFE * D * 2; S.bstep = (size_t)256 * D * 2;
        { LAS int* tokL = (LAS int*)(F.lds + RING_BYTES + 1024); S.tokL = tokL; const int* TOKOF = (const int*)(ws + WS_TOKOF);
          int tid_ = threadIdx.x; asm volatile("" : "+v"(tid_)); const int half_ = __builtin_amdgcn_readfirstlane(tid_ >> 8); int tkv[8];
#pragma unroll
          for (int j = 0; j < 8; ++j) { pg8::Unit u; const bool ok = S.next(2 * j + half_, u); tkv[j] = ok ? TOKOF[u.pm * 256 + (tid_ & 255)] : 0; }
#pragma unroll
          for (int j = 0; j < 8; ++j) tokL[(2 * j + half_) * 256 + (tid_ & 255)] = tkv[j];
          __syncthreads(); }
        pg8::EpiSwiGLU E{(const float*)(ws + WS_SLOTR), (bf16*)(ws + WS_HG), DFE, 0}; pg8::gemm_phase(F.lds, D, D, D, S, E); }
}
__device__ __forceinline__ void phase_moe_down(const Frame& F, ArgsP kargs, int j2) {
    if (PH(13)) { MoeTailOrder S; LAS int* pre = (LAS int*)(F.lds + RING_BYTES + 64); moe_tiles(F, kargs, S.tb, pre);
        FRESH(a); unsigned char* ws = a->ws; S.nN = 4; S.G = F.G; S.c = F.bid; S.T = S.tb[NE]; S.rev = 1;
        S.A = (const char*)(ws + WS_HG); S.B = (const char*)(ws + WS_W2M); S.astep = (size_t)256 * DFE * 2; S.estep = (size_t)D * DFE * 2; S.bstep = (size_t)256 * DFE * 2;
        pg8::EpiBf16KS E{(bf16*)(ws + WS_OUTG), D, (float*)(ws + WS_SKPART), (unsigned*)(ws + WS_CTL) + CW_SK + j2 * 512, F.bid}; pg8::gemm_phase(F.lds, 0, DFE, DFE, S, E); }
}
__device__ __forceinline__ void phase_moe_combine(const Frame& F, ArgsP kargs, bool last) {
    LOCAL_IDS; FRESH(a); unsigned char* ws = a->ws; float* X = a->out; const bf16* OUTG = (const bf16*)(ws + WS_OUTG); const int* POS = (const int*)(ws + WS_POS); const float* TOPW = (const float*)(ws + WS_TOPW);
    bf16* XB = (bf16*)(ws + WS_XB); float* RX = (float*)(ws + WS_RX); const float* g_final = a->g_final;
    int s0n = POS[(size_t)gw * 2], s1n = POS[(size_t)gw * 2 + 1]; float w0n = TOPW[(size_t)gw * 2], w1n = TOPW[(size_t)gw * 2 + 1];
#pragma unroll 1
    for (int m = gw; m < M; m += F.NGW) {
        const int s0 = s0n, s1 = s1n; const float w0 = w0n, w1 = w1n;
        { const int mn = m + F.NGW < M ? m + F.NGW : m; s0n = POS[(size_t)mn * 2]; s1n = POS[(size_t)mn * 2 + 1]; w0n = TOPW[(size_t)mn * 2]; w1n = TOPW[(size_t)mn * 2 + 1]; }
        f32x4 v[4]; float s = 0.f;
#pragma unroll
        for (int j = 0; j < 4; ++j) { const u32x2 p0 = ((const u32x2*)(OUTG + (size_t)s0 * D) + lane)[64 * j], p1 = ((const u32x2*)(OUTG + (size_t)s1 * D) + lane)[64 * j];
            const f32x4 o0 = {bflo(p0.x), bfhi(p0.x), bflo(p0.y), bfhi(p0.y)}, o1 = {bflo(p1.x), bfhi(p1.x), bflo(p1.y), bfhi(p1.y)};
            v[j] = ((const f32x4*)(X + (size_t)m * D) + lane)[64 * j] + w0 * o0 + w1 * o1; s += sumsq4(v[j]); }
        const float r = __builtin_amdgcn_rsqf(wave_sum(s) * (1.f / D) + EPS);
        if (last) {
#pragma unroll
            for (int j = 0; j < 4; ++j) ((f32x4*)(X + (size_t)m * D) + lane)[64 * j] = v[j] * r * ((const f32x4*)g_final + lane)[64 * j];
        } else {
#pragma unroll
            for (int j = 0; j < 4; ++j) { ((f32x4*)(X + (size_t)m * D) + lane)[64 * j] = v[j]; ((u32x2*)(XB + (size_t)m * D) + lane)[64 * j] = (u32x2){cvt_pk_bf16(v[j][0], v[j][1]), cvt_pk_bf16(v[j][2], v[j][3])}; }
            if (lane == 0) RX[m] = r;
        }
    }
}


#ifdef DBG_ENABLE
__device__ __forceinline__ float dbg_b(const unsigned char* ws, size_t off, size_t idx) { return bf2f(((const bf16*)(ws + off))[idx]); }
__device__ __forceinline__ void dbg_dump(const Frame& F, ArgsP kargs, int code) {
    LOCAL_IDS; FRESH(a); const unsigned char* ws = a->ws; float* out = a->out;
    unsigned tmo = ((const unsigned*)(ws + WS_CTL))[CW_BAR + XB_TMO];
    for (size_t i = (size_t)F.bid * 512 + tid; i < (size_t)M * D; i += (size_t)F.G * 512) { const size_t row = i >> 10, c = i & 1023; float v = 0.f;
        if (code == 1) v = dbg_b(ws, WS_CQ, row * 512 + (c & 511)) + dbg_b(ws, WS_CKV, row * 256 + (c & 255)) + dbg_b(ws, WS_U, row * 512 + (c & 511)) + dbg_b(ws, WS_VR, row * 512 + (c & 511)) + dbg_b(ws, WS_QX, row * 512 + (c & 511))
                         + dbg_b(ws, WS_GATE, row * 3072 + c) + dbg_b(ws, WS_GATE, row * 3072 + 1024 + c) + dbg_b(ws, WS_GATE, row * 3072 + 2048 + c) + dbg_b(ws, WS_KR, row * 32 + (c & 31));
        else if (code == 2) v = dbg_b(ws, WS_Q, row * 768 + (c % 768)) + dbg_b(ws, WS_KN, row * 512 + (c & 511)) + dbg_b(ws, WS_V, row * 512 + (c & 511)) + dbg_b(ws, WS_Y, row * 1536 + 512 + c);
        else if (code == 3) v = dbg_b(ws, WS_Y, row * 1536 + (c & 511));
        else if (code == 15) v = dbg_b(ws, WS_WINT, i % ((size_t)PPAD * D));
        else if (code == 13 || code == 14) v = dbg_b(ws, WS_GATE, row * 3072 + c) + dbg_b(ws, WS_GATE, row * 3072 + 1024 + c) + dbg_b(ws, WS_GATE, row * 3072 + 2048 + c);
        else if (code == 4) v = dbg_b(ws, WS_MIXB, row * 1024 + c);
        else if (code == 6) v = dbg_b(ws, WS_HFF, row * 2688 + c) + dbg_b(ws, WS_HFF, row * 2688 + 1024 + c) + dbg_b(ws, WS_HFF, row * 2688 + 1664 + c);
        else if (code == 9) { const int s0 = ((const int*)(ws + WS_POS))[row * 2], s1 = ((const int*)(ws + WS_POS))[row * 2 + 1]; v = dbg_b(ws, WS_XG, (size_t)s0 * 1024 + c) + 2.f * dbg_b(ws, WS_XG, (size_t)s1 * 1024 + c) + ((const float*)(ws + WS_TOPW))[row * 2] + (float)s0 * 1e-3f; }
        else if (code == 10) { const int s0 = ((const int*)(ws + WS_POS))[row * 2], s1 = ((const int*)(ws + WS_POS))[row * 2 + 1]; v = dbg_b(ws, WS_HG, (size_t)s0 * 3584 + c) + dbg_b(ws, WS_HG, (size_t)s1 * 3584 + 2560 + c) + dbg_b(ws, WS_HG, (size_t)s0 * 3584 + 1500 + c); }
        else if (code == 11) { const int s0 = ((const int*)(ws + WS_POS))[row * 2], s1 = ((const int*)(ws + WS_POS))[row * 2 + 1]; v = ((const float*)(ws + WS_OUTG))[(size_t)s0 * 1024 + c] + ((const float*)(ws + WS_OUTG))[(size_t)s1 * 1024 + c]; }
        else continue;
        if (tmo) v = __builtin_nanf("");
        out[i] = v; }
}
#define DBG(code) do { if (dbgc == (code)) { dbg_dump(F, kargs, code); return; } } while (0)
#else
#define DBG(code) do { } while (0)
#endif

__global__ void __launch_bounds__(NWAVES * 64, 2) fwd_kernel(Args args_by_value) {
    extern __shared__ __attribute__((aligned(16))) unsigned char lds_raw[];
    const ArgsP kargs = (ArgsP)__builtin_amdgcn_kernarg_segment_ptr();
    Frame F; F.lds = (LAS unsigned char*)lds_raw; F.G = gridDim.x; F.bid = blockIdx.x; F.NGW = F.G * NWAVES;
    for (int u = threadIdx.x; u < (LDS_BYTES - LDSCTL_OFF) / 4; u += NWAVES * 64) ((LAS unsigned*)(F.lds + LDSCTL_OFF))[u] = 0u;
    __syncthreads();
    volatile LAS unsigned* MISC = (volatile LAS unsigned*)(F.lds + MISC_OFF);
    XcdBarrier bar; { FRESH(a); bar = xcd_barrier_post((unsigned*)(a->ws + WS_CTL) + CW_BAR, MISC + 8); }
#define GRID_BAR() xcd_barrier(bar)

#ifdef ONLY_TEST
    ONLY_TEST; GRID_BAR(); return;
#endif
    const Frame F_ = F;
    int dbgc; { FRESH(a); dbgc = a->dbg; } (void)dbgc;
    phase_prologue(F, kargs); GRID_BAR();
#pragma unroll 1
    for (int l_ = 0; l_ < DEPTH; ++l_) {
        Frame F = F_; int l = l_; asm volatile("" : "+s"(F.G), "+s"(F.NGW), "+s"(F.bid), "+s"(l));
        const bool moe = (l & 1) != 0; const int j2 = l >> 1;
        if (l == 0) DBG(15);
#ifdef PROBE_INPROJ2
        { int reps = 2; asm volatile("" : "+s"(reps));
#pragma unroll 1
          for (int rep = 0; rep < reps; ++rep) { phase_inproj(F, kargs, l); GRID_BAR(); } }
#else
        phase_inproj(F, kargs, l); GRID_BAR(); if (l == 0) DBG(1); if (l == 0) DBG(14);
#endif
        phase_up(F, kargs, l); GRID_BAR(); if (l == 0) DBG(2);
        phase_attn(F, kargs, l); GRID_BAR(); if (l == 0) DBG(3); if (l == 0) DBG(13);
#ifdef PROBE_ATTN2
        phase_attn(F, kargs, l); GRID_BAR();
#endif
#ifdef PROBE_UP2
        phase_up(F, kargs, l); GRID_BAR();
#endif
        phase_branch(F, kargs); GRID_BAR(); if (l == 0) DBG(4);
#ifdef PROBE_RESID2
        { int reps = 2; asm volatile("" : "+s"(reps));
#pragma unroll 1
          for (int rep = reps - 1; rep >= 0; --rep) { phase_outproj(F, kargs, rep != 0); GRID_BAR(); } }
#else
        phase_outproj(F, kargs); GRID_BAR(); if (l == 0) DBG(5); if (l == 1) DBG(8);
#endif
        if (!moe) {
            phase_dense_conv(F, kargs, l, j2); GRID_BAR();
            phase_dense_up(F, kargs); GRID_BAR(); if (l == 0) DBG(6);
#ifdef PROBE_DENSE2
            phase_dense_up(F, kargs); GRID_BAR();
#endif
#ifdef PROBE_RESID2
            { int reps = 2; asm volatile("" : "+s"(reps));
#pragma unroll 1
              for (int rep = reps - 1; rep >= 0; --rep) { phase_dense_down(F, kargs, rep != 0); GRID_BAR(); } }
#else
            phase_dense_down(F, kargs); GRID_BAR(); if (l == 0) DBG(7);
#endif
        } else {
            phase_moe_route(F, kargs, l, j2); GRID_BAR();
            phase_moe_gather(F, kargs); GRID_BAR(); if (l == 1) DBG(9);
#ifdef PROBE_AUX2
            phase_moe_gather(F, kargs); GRID_BAR();
#endif
            phase_moe_up(F, kargs); GRID_BAR(); if (l == 1) DBG(10);
            phase_moe_down(F, kargs, j2); GRID_BAR(); if (l == 1) DBG(11);
#ifdef PROBE_MOE2
            phase_moe_up(F, kargs); GRID_BAR();
            phase_moe_down(F, kargs, j2); GRID_BAR();
#endif
            phase_moe_combine(F, kargs, l == DEPTH - 1);
            if (l != DEPTH - 1) GRID_BAR();
            if (l == 1) DBG(12);
        }
    }
}

extern "C" void kernel_launch(void* const* d_in, const int* in_sizes, int n_in, void* d_out, int out_size, void* d_ws, size_t ws_size, hipStream_t stream) {
    static int grid = 0;
    if (grid == 0) {
        if (n_in != 27 || in_sizes[0] != M * D || out_size != M * D || ws_size < WS_END) { fprintf(stderr, "kernel_launch: unexpected shapes (n_in %d, in0 %d, out %d, ws %zu)\n", n_in, n_in > 0 ? in_sizes[0] : -1, out_size, ws_size); grid = -1; return; }
        int dev = 0, cus = 0, per_cu = 0;
        if (hipGetDevice(&dev) != hipSuccess || hipDeviceGetAttribute(&cus, hipDeviceAttributeMultiprocessorCount, dev) != hipSuccess) { grid = -1; return; }
        if (hipFuncSetAttribute((const void*)fwd_kernel, hipFuncAttributeMaxDynamicSharedMemorySize, LDS_BYTES) != hipSuccess) { fprintf(stderr, "kernel_launch: hipFuncSetAttribute failed\n"); grid = -1; return; }
        if (hipOccupancyMaxActiveBlocksPerMultiprocessor(&per_cu, (const void*)fwd_kernel, NWAVES * 64, LDS_BYTES) != hipSuccess || per_cu < 1) { fprintf(stderr, "kernel_launch: occupancy query reports %d\n", per_cu); }
        (void)hipGetLastError();
        if (cus != 256) { fprintf(stderr, "kernel_launch: built for 256 CUs, device has %d\n", cus); grid = -1; return; }
        grid = 256;
    }
    if (grid < 0) return;
    if (hipMemsetAsync((char*)d_ws + WS_CTL, 0, CTL_ZERO_BYTES, stream) != hipSuccess) return;
    Args a{};
    a.x = (const float*)d_in[0]; a.mem = (const float*)d_in[1]; a.positions = (const int*)d_in[2]; a.g_mix = (const float*)d_in[3]; a.w_in = (const float*)d_in[4]; a.g_q = (const float*)d_in[5];
    a.g_kv = (const float*)d_in[6]; a.w_uq = (const float*)d_in[7]; a.w_uk = (const float*)d_in[8]; a.w_uv = (const float*)d_in[9]; a.g_sg = (const float*)d_in[10]; a.w_s = (const float*)d_in[11];
    a.b_s = (const float*)d_in[12]; a.g_mem = (const float*)d_in[13]; a.w_mkv = (const float*)d_in[14]; a.w_br = (const float*)d_in[15]; a.b_gate = (const float*)d_in[16]; a.w_out = (const float*)d_in[17];
    a.g_ffn = (const float*)d_in[18]; a.dense_w1 = (const float*)d_in[19]; a.dense_w3 = (const float*)d_in[20]; a.dense_w2 = (const float*)d_in[21]; a.w_router = (const float*)d_in[22];
    a.moe_w1 = (const float*)d_in[23]; a.moe_w3 = (const float*)d_in[24]; a.moe_w2 = (const float*)d_in[25]; a.g_final = (const float*)d_in[26];
    a.out = (float*)d_out; a.ws = (unsigned char*)d_ws;
#ifdef DBG_STOP
    a.dbg = DBG_STOP;
#endif
    hipLaunchKernelGGL(fwd_kernel, dim3(grid), dim3(NWAVES * 64), LDS_BYTES, stream, a);
    const hipError_t le = hipPeekAtLastError();
    if (le != hipSuccess) fprintf(stderr, "kernel_launch: launch failed: %s\n", hipGetErrorName(le));
}
```

```cpp
#include <hip/hip_runtime.h>
#include <cstdio>
#include <cstdint>

#ifndef PH_MASK
#define PH_MASK 0xffffffffu
#endif
#define PH(k) ((PH_MASK >> (k)) & 1u)
#define LAS __attribute__((address_space(3)))
#define GAS __attribute__((address_space(1)))
typedef unsigned short bf16;
typedef short bf16x8 __attribute__((ext_vector_type(8)));
typedef short s16x4 __attribute__((ext_vector_type(4)));
typedef float f32x4 __attribute__((ext_vector_type(4)));
typedef float f32x2 __attribute__((ext_vector_type(2)));
typedef float f32x16 __attribute__((ext_vector_type(16)));
typedef unsigned u32x4 __attribute__((ext_vector_type(4)));
typedef unsigned u32x2 __attribute__((ext_vector_type(2)));
typedef int i32x4 __attribute__((ext_vector_type(4)));

constexpr int M = 16384, D = 1024, DEPTH = 4, NMEM = 256;
constexpr int QRANK = 384, KVRANK = 256, NH = 8, QKD = 96, VD = 64;
constexpr int XH = 4, XD = 128, BW = 512;
constexpr int PTOT = 5280, PPAD = 5376, DFF = 2688, NE = 8, DFE = 3584;
constexpr float EPS = 1e-6f;
constexpr int MAXSLOT = 34816;
constexpr float LOG2E = 1.4426950408889634f;
constexpr float QSCALE = 0.10206207261596575f * LOG2E;
constexpr float XSCALE = 0.08838834764831845f * LOG2E;

constexpr size_t MiB = 1u << 20, KiB = 1u << 10;
constexpr size_t WS_CTL = 0, CTL_ZERO_BYTES = 1 * MiB;
constexpr size_t WS_ROPE = 2 * MiB;
constexpr size_t WS_XSTAT = 4 * MiB;
constexpr size_t WS_RX = 5 * MiB;
constexpr size_t WS_CQSTAT = 5 * MiB + 256 * KiB;
constexpr size_t WS_CKVSTAT = 5 * MiB + 768 * KiB;
constexpr size_t WS_VSTAT = 6 * MiB;
constexpr size_t WS_MEMB = 6 * MiB + 512 * KiB;
constexpr size_t WS_KVMEM = 7 * MiB;
constexpr size_t WS_TOPI = 9 * MiB;
constexpr size_t WS_TOPW = 9 * MiB + 256 * KiB;
constexpr size_t WS_LRANK = 9 * MiB + 512 * KiB;
constexpr size_t WS_POS = 9 * MiB + 768 * KiB;
constexpr size_t WS_BLKCNT = 10 * MiB;
constexpr size_t WS_SLOTR = 10 * MiB + 512 * KiB;
constexpr size_t WS_TOKOF = 10 * MiB + 768 * KiB;
constexpr size_t WS_WSB = 11 * MiB;
constexpr size_t WS_WMKVT = 12 * MiB;
constexpr size_t WS_WINT = 20 * MiB;
constexpr size_t WS_WUQT = 31 * MiB;
constexpr size_t WS_WUKVT = 32 * MiB;
constexpr size_t WS_WBRT = 33 * MiB;
constexpr size_t WS_WOUTT = 36 * MiB;
constexpr size_t WS_WFFN = 40 * MiB;
constexpr size_t WS_W2D = WS_WFFN + 11 * MiB;
constexpr size_t WS_W2M = WS_WFFN + 112 * MiB;
constexpr size_t WS_XB = 208 * MiB;
constexpr size_t WS_CQ = 240 * MiB;
constexpr size_t WS_CKV = 256 * MiB;
constexpr size_t WS_U = 264 * MiB;
constexpr size_t WS_VR = 280 * MiB;
constexpr size_t WS_QX = 296 * MiB;
constexpr size_t WS_GATE = 312 * MiB;
constexpr size_t WS_Q = 408 * MiB;
constexpr size_t WS_KN = 432 * MiB;
constexpr size_t WS_KR = 448 * MiB;
constexpr size_t WS_V = 450 * MiB;
constexpr size_t WS_Y = 466 * MiB;
constexpr size_t WS_MIX = 514 * MiB;
constexpr size_t WS_MIXB = 578 * MiB;
constexpr size_t WS_MIX1 = 610 * MiB;
constexpr size_t WS_HFF = 240 * MiB;
constexpr size_t WS_XG = 240 * MiB;
constexpr size_t WS_HG = 308 * MiB;
constexpr size_t WS_OUTG = 546 * MiB;
constexpr size_t WS_END = 682 * MiB;
constexpr int CW_TMO = 0, CW_CODE = 1, CW_CHK = 2, CW_BAR = 4096;
constexpr int CW_SK = 16384;
constexpr size_t WS_SKPART = 700 * MiB;
constexpr int CW_KMAX = 8192;

constexpr int RING_BYTES = 131072, LDSCTL_OFF = 159744, MISC_OFF = LDSCTL_OFF + 320, LDS_BYTES = 163840;
constexpr int NWAVES = 8;

#define RLX_AGENT __ATOMIC_RELAXED, __HIP_MEMORY_SCOPE_AGENT
#define LDS_WAIT() asm volatile("s_waitcnt lgkmcnt(0)" ::: "memory")
#define VM_WAIT() asm volatile("s_waitcnt vmcnt(0)" ::: "memory")
typedef __bf16 bf16x2_t __attribute__((ext_vector_type(2)));
__device__ __forceinline__ unsigned cvt_pk_bf16(float lo, float hi) { const f32x2 v = {lo, hi}; const bf16x2_t b = __builtin_convertvector(v, bf16x2_t); return __builtin_bit_cast(unsigned, b); }
__device__ __forceinline__ bf16 f2bf(float f) { return (bf16)(cvt_pk_bf16(f, 0.f) & 0xffffu); }
__device__ __forceinline__ float bf2f(bf16 v) { return __uint_as_float((unsigned)v << 16); }
__device__ __forceinline__ float bflo(unsigned w) { return __uint_as_float(w << 16); }
__device__ __forceinline__ float bfhi(unsigned w) { return __uint_as_float(w & 0xffff0000u); }
__device__ __forceinline__ float fast_exp2(float x) { return __builtin_amdgcn_exp2f(x); }
__device__ __forceinline__ float fast_rcp(float x) { return __builtin_amdgcn_rcpf(x); }
__device__ __forceinline__ float sigmoidf_(float z) { return fast_rcp(1.f + fast_exp2(-LOG2E * z)); }
__device__ __forceinline__ float gelu_tanh(float x) { const float t = x + 0.044715f * x * x * x; return x * fast_rcp(1.f + fast_exp2(-2.f * 0.7978845608028654f * LOG2E * t)); }
template <int CTRL> __device__ __forceinline__ float dppf(float v) { return __builtin_bit_cast(float, __builtin_amdgcn_update_dpp(0, __builtin_bit_cast(int, v), CTRL, 0xf, 0xf, true)); }
__device__ __forceinline__ float row_sum16(float v) { v += dppf<0xB1>(v); v += dppf<0x4E>(v); v += dppf<0x124>(v); v += dppf<0x128>(v); return v; }
__device__ __forceinline__ float row_max16(float v) { v = fmaxf(v, dppf<0xB1>(v)); v = fmaxf(v, dppf<0x4E>(v)); v = fmaxf(v, dppf<0x124>(v)); v = fmaxf(v, dppf<0x128>(v)); return v; }
__device__ __forceinline__ float xsum16(float v) { const auto r = __builtin_amdgcn_permlane16_swap(__float_as_uint(v), __float_as_uint(v), false, false); return __uint_as_float(r[0]) + __uint_as_float(r[1]); }
__device__ __forceinline__ float xsum32(float v) { const auto r = __builtin_amdgcn_permlane32_swap(__float_as_uint(v), __float_as_uint(v), false, false); return __uint_as_float(r[0]) + __uint_as_float(r[1]); }
__device__ __forceinline__ float wave_sum(float v) { return xsum32(xsum16(row_sum16(v))); }
__device__ __forceinline__ float sumsq4(f32x4 v) { return (v[0] * v[0] + v[1] * v[1]) + (v[2] * v[2] + v[3] * v[3]); }
__device__ __forceinline__ u32x2 pack8_u8(f32x4 a, f32x4 b) { unsigned w0 = 0, w1 = 0; a = a * 255.f; b = b * 255.f;
    w0 = __builtin_amdgcn_cvt_pk_u8_f32(a[0], 0, w0); w0 = __builtin_amdgcn_cvt_pk_u8_f32(a[1], 1, w0); w0 = __builtin_amdgcn_cvt_pk_u8_f32(a[2], 2, w0); w0 = __builtin_amdgcn_cvt_pk_u8_f32(a[3], 3, w0);
    w1 = __builtin_amdgcn_cvt_pk_u8_f32(b[0], 0, w1); w1 = __builtin_amdgcn_cvt_pk_u8_f32(b[1], 1, w1); w1 = __builtin_amdgcn_cvt_pk_u8_f32(b[2], 2, w1); w1 = __builtin_amdgcn_cvt_pk_u8_f32(b[3], 3, w1);
    return (u32x2){w0, w1}; }
__device__ __forceinline__ void unpack8_u8(u32x2 w, f32x4& a, f32x4& b) { constexpr float k = 1.f / 255.f;
    a = (f32x4){(float)(w.x & 255u), (float)((w.x >> 8) & 255u), (float)((w.x >> 16) & 255u), (float)(w.x >> 24)} * k;
    b = (f32x4){(float)(w.y & 255u), (float)((w.y >> 8) & 255u), (float)((w.y >> 16) & 255u), (float)(w.y >> 24)} * k; }
__device__ __forceinline__ u32x4 pack8(f32x4 a, f32x4 b) { u32x4 w; w.x = cvt_pk_bf16(a[0], a[1]); w.y = cvt_pk_bf16(a[2], a[3]); w.z = cvt_pk_bf16(b[0], b[1]); w.w = cvt_pk_bf16(b[2], b[3]); return w; }
__device__ __forceinline__ void unpack8(u32x4 w, f32x4& a, f32x4& b) { a = (f32x4){bflo(w.x), bfhi(w.x), bflo(w.y), bfhi(w.y)}; b = (f32x4){bflo(w.z), bfhi(w.z), bflo(w.w), bfhi(w.w)}; }

namespace pg8 {
constexpr int BM = 256, BK = 64, HALF = 128, HTB = HALF * BK * 2, STAGE_BYTES = 8 * HTB, NXCD = 8, WGM = 8;
__host__ __device__ __forceinline__ int lds_byte(int r, int c) { const int st = (r >> 4) * 2 + (c >> 5), rr = r & 15, cc = c & 31, ob = rr * 64 + cc * 2; return st * 1024 + (ob ^ (((ob >> 9) & 1) << 5)); }
__host__ __device__ __forceinline__ void stage_rc(int b, int& R, int& C) { const int st = b / 1024, sb = b % 1024, swz = sb ^ (((sb >> 9) & 1) << 5); R = (st >> 1) * 16 + swz / 64; C = (st & 1) * 32 + (swz % 64) / 2; }
__host__ __device__ __forceinline__ int perm32(int rho) { const int n = rho >> 4, i = rho & 15; return 8 * (i >> 2) + 4 * n + (i & 3); }

struct Unit { const char* A; const char* B; int pm, pn, aux, nt; };
typedef f32x4 Acc[2][2][4][2];

__device__ __forceinline__ void tile_of(int L, int nM, int nN, int& pm, int& pn) {
    const int nwg = nM * nN; int wgid = L;
    { const int q = nwg / NXCD, r = nwg % NXCD, xcd = wgid % NXCD, off = wgid / NXCD; wgid = (xcd < r ? xcd * (q + 1) : r * (q + 1) + (xcd - r) * q) + off; }
    const int nig = WGM * nN, gid = wgid / nig, fm = gid * WGM, gsz = (nM - fm) < WGM ? (nM - fm) : WGM;
    pm = fm + ((wgid % nig) % gsz); pn = (wgid % nig) / gsz;
}
struct TileOrder {
    enum { VARK = 0, GATHER = 0 };
    int nM, nN, G, c; const char* A; const char* B; size_t astep, bstep;
    int rev = 0;
    __device__ __forceinline__ bool next(int i, Unit& u) const {
        if (rev) { const int cnt = (nM * nN - c + G - 1) / G; if (i >= cnt) return false; i = cnt - 1 - i; }
        const long L = (long)i * G + c; if (L >= (long)nM * nN) return false;
        int pm, pn; tile_of((int)L, nM, nN, pm, pn);
        u.pm = pm; u.pn = pn; u.aux = 0; u.A = A + (size_t)pm * astep; u.B = B + (size_t)pn * bstep; return true;
    }
};

template <class Epi, class Sched>
__device__ __forceinline__ void gemm_phase(LAS unsigned char* lds, const int lda, const int ldb, const int K, const Sched& S, const Epi& E) {
    int tid_ = threadIdx.x; asm volatile("" : "+v"(tid_));
    const int tid = tid_, wid = __builtin_amdgcn_readfirstlane(tid >> 6), lane = tid & 63, wr = wid >> 2, wc = wid & 3, fr = lane & 15, fq = lane >> 4;
    int nt = K / BK;
    unsigned voffA[2], voffB[2];
#pragma unroll
    for (int i = 0; i < 2; ++i) { int R, C; stage_rc(tid * 16 + i * 8192, R, C); const int Rb = (R & ~31) + perm32(R & 31);
        voffA[i] = (unsigned)(R * (lda ? lda : BK) + C) * 2u; voffB[i] = (unsigned)(Rb * BK + C) * 2u; }
    const size_t kstep = lda ? (size_t)(BK * 2) : (size_t)BM * BK * 2;
    const size_t hstepA = (size_t)HALF * (lda ? lda : BK) * 2, hstepB = (size_t)HALF * BK * 2, kstepB = (size_t)BM * BK * 2; (void)ldb;
    const unsigned ldsw = (unsigned)wid * 1024u;
    const int aoff = lds_byte(wr * 64 + fr, fq * 8), boff = lds_byte(wc * 32 + fr, fq * 8);
#define PG8_SA(b, h) (((b) * 2 + (h)) * HTB)
#define PG8_SB(b, h) ((4 + (b) * 2 + (h)) * HTB)
#define PG8_STAGE(bufoff, gbase, voff) do { _Pragma("unroll") for (int _i = 0; _i < 2; ++_i) \
        __builtin_amdgcn_global_load_lds((const unsigned*)((const char*)(gbase) + (voff)[_i]), (LAS unsigned*)(lds + (bufoff) + ldsw + _i * 8192), 16, 0, 0); } while (0)
#define PG8_STA(b, h, kptr, VG) do { if constexpr (Sched::GATHER) PG8_STAGE(PG8_SA(b, h), (kptr), VG[h]); else PG8_STAGE(PG8_SA(b, h), (kptr) + (h) * hstepA, voffA); } while (0)
#define PG8_GLOOKUP(VG, ui_) do { _Pragma("unroll") for (int _h = 0; _h < 2; ++_h) _Pragma("unroll") for (int _i = 0; _i < 2; ++_i) { int R_, C_; stage_rc(tid * 16 + _i * 8192, R_, C_); \
        VG[_h][_i] = (unsigned)S.tokL[(ui_) * 256 + _h * 128 + R_] * (unsigned)(lda * 2) + (unsigned)(C_ * 2); } } while (0)
#define PG8_LDA(dst, b, h) do { _Pragma("unroll") for (int m = 0; m < 4; ++m) _Pragma("unroll") for (int k = 0; k < 2; ++k) dst[m][k] = *(const LAS bf16x8*)(lds + PG8_SA(b, h) + aoff + m * 2048 + k * 1024); } while (0)
#define PG8_LDB(dst, b, h) do { _Pragma("unroll") for (int n = 0; n < 2; ++n) _Pragma("unroll") for (int k = 0; k < 2; ++k) dst[n][k] = *(const LAS bf16x8*)(lds + PG8_SB(b, h) + boff + n * 2048 + k * 1024); } while (0)
#define PG8_MMA(ai, bj, At, Bt) do { __builtin_amdgcn_s_setprio(1); _Pragma("unroll") for (int m = 0; m < 4; ++m) _Pragma("unroll") for (int n = 0; n < 2; ++n) _Pragma("unroll") for (int k = 0; k < 2; ++k) \
        acc[ai][bj][m][n] = __builtin_amdgcn_mfma_f32_16x16x32_bf16(Bt[n][k], At[m][k], acc[ai][bj][m][n], 0, 0, 0); __builtin_amdgcn_s_setprio(0); } while (0)
#define PG8_WAIT_V(n) asm volatile("s_waitcnt vmcnt(" #n ")" ::: "memory")
#define PG8_WAIT_L(n) asm volatile("s_waitcnt lgkmcnt(" #n ")" ::: "memory")
#define PG8_BAR __builtin_amdgcn_s_barrier()
#define PG8_SCHED __builtin_amdgcn_sched_barrier(0)
    Unit cur, nxt; int ui = 0;
    if (!S.next(0, cur)) return;
    if constexpr (Sched::VARK) nt = cur.nt;
    typename Epi::Pre pre = E.prefetch(cur, wr, fr);
    Acc acc;
#pragma unroll
    for (int a = 0; a < 2; ++a)
#pragma unroll
        for (int b = 0; b < 2; ++b)
#pragma unroll
            for (int m = 0; m < 4; ++m)
#pragma unroll
                for (int n = 0; n < 2; ++n) acc[a][b][m][n] = (f32x4){0.f, 0.f, 0.f, 0.f};
    bf16x8 At[4][2], B0[2][2], B1[2][2];
    const char* cA = cur.A; const char* cB = cur.B;
    unsigned vg[2][2] = {{0u, 0u}, {0u, 0u}}; if constexpr (Sched::GATHER) PG8_GLOOKUP(vg, 0);
    PG8_STAGE(PG8_SB(0, 0), cB, voffB); PG8_STAGE(PG8_SB(0, 1), cB + hstepB, voffB); PG8_STA(0, 0, cA, vg); PG8_STA(0, 1, cA, vg);
    if (wr == 1) PG8_BAR;
    PG8_WAIT_V(2); PG8_BAR;
    PG8_STAGE(PG8_SB(1, 0), cB + kstepB, voffB); PG8_STA(1, 0, cA + kstep, vg); PG8_STAGE(PG8_SB(1, 1), cB + hstepB + kstepB, voffB);
    PG8_WAIT_V(6); PG8_BAR;
    for (;;) {
        const bool has_next = S.next(ui + 1, nxt);
        const char* nA = has_next ? nxt.A : cA; const char* nB = has_next ? nxt.B : cB;
        for (int t = 0; t < nt; t += 2) {
            const bool last = (t == nt - 2);
            const char* a1 = cA + (size_t)(t + 1) * kstep;
            const char* a2 = last ? nA : cA + (size_t)(t + 2) * kstep; const char* b2 = last ? nB : cB + (size_t)(t + 2) * kstepB;
            const char* a3 = a2 + kstep; const char* b3 = b2 + kstepB;
            PG8_LDB(B0, 0, 0); PG8_LDB(B1, 0, 1); PG8_SCHED; PG8_LDA(At, 0, 0); PG8_STA(1, 1, a1, vg);
            if constexpr (Sched::GATHER) { if (last && has_next) PG8_GLOOKUP(vg, ui + 1); }
            PG8_WAIT_V(8); PG8_WAIT_L(0); PG8_BAR; PG8_MMA(0, 0, At, B0); PG8_MMA(0, 1, At, B1); PG8_BAR; PG8_SCHED;
            PG8_LDA(At, 0, 1); PG8_STAGE(PG8_SB(0, 0), b2, voffB); PG8_STAGE(PG8_SB(0, 1), b2 + hstepB, voffB); PG8_STA(0, 0, a2, vg);
            PG8_WAIT_V(8); PG8_WAIT_L(0); PG8_BAR; PG8_MMA(1, 0, At, B0); PG8_MMA(1, 1, At, B1); PG8_BAR; PG8_SCHED;
            PG8_LDB(B0, 1, 0); PG8_LDB(B1, 1, 1); PG8_SCHED; PG8_LDA(At, 1, 0); PG8_STA(0, 1, a2, vg);
            PG8_WAIT_V(8); PG8_WAIT_L(0); PG8_BAR; PG8_MMA(0, 0, At, B0); PG8_MMA(0, 1, At, B1); PG8_BAR; PG8_SCHED;
            PG8_LDA(At, 1, 1); PG8_STAGE(PG8_SB(1, 0), b3, voffB); PG8_STAGE(PG8_SB(1, 1), b3 + hstepB, voffB); PG8_STA(1, 0, a3, vg);
            PG8_WAIT_V(8); PG8_WAIT_L(0); PG8_BAR; PG8_MMA(1, 0, At, B0); PG8_MMA(1, 1, At, B1); PG8_BAR; PG8_SCHED;
        }
        if (wr == 0) PG8_BAR;
        E(acc, cur, wr, wc, fr, fq, pre);
        if (!has_next) break;
        pre = E.prefetch(nxt, wr, fr);
        if constexpr (!Epi::KEEP_ACC)
#pragma unroll
        for (int a = 0; a < 2; ++a)
#pragma unroll
            for (int b = 0; b < 2; ++b)
#pragma unroll
                for (int m = 0; m < 4; ++m)
#pragma unroll
                    for (int n = 0; n < 2; ++n) acc[a][b][m][n] = (f32x4){0.f, 0.f, 0.f, 0.f};
        cur = nxt; cA = nA; cB = nB; ++ui;
        if constexpr (Sched::VARK) nt = cur.nt;
        if (wr == 1) PG8_BAR;
    }
    PG8_WAIT_V(0);
    PG8_BAR;
#undef PG8_SA
#undef PG8_SB
#undef PG8_STAGE
#undef PG8_LDA
#undef PG8_STA
#undef PG8_GLOOKUP
#undef PG8_LDB
#undef PG8_MMA
#undef PG8_WAIT_V
#undef PG8_WAIT_L
#undef PG8_BAR
#undef PG8_SCHED
}

#define EPI_FOR _Pragma("unroll") for (int ai = 0; ai < 2; ++ai) _Pragma("unroll") for (int m = 0; m < 4; ++m)
#define EPI_ROW (u.pm * BM + ai * HALF + wr * 64 + m * 16 + fr)
#define EPI_C8(bj) (u.pn * BM + (bj) * HALF + wc * 32 + 8 * fq)
#define EPI_LOAD_R(rr, ptr) float rr[2][4]; _Pragma("unroll") for (int ai = 0; ai < 2; ++ai) _Pragma("unroll") for (int m = 0; m < 4; ++m) rr[ai][m] = (ptr)[EPI_ROW]; asm volatile("" ::: "memory")

#define EPI_LOAD_RS(rr, xstat) float rr[2][4]; { f32x4 st_[2][4]; _Pragma("unroll") for (int ai = 0; ai < 2; ++ai) _Pragma("unroll") for (int m = 0; m < 4; ++m) st_[ai][m] = *(const f32x4*)((xstat) + (size_t)EPI_ROW * 16 + 4 * fq); \
    asm volatile("" ::: "memory"); _Pragma("unroll") for (int ai = 0; ai < 2; ++ai) _Pragma("unroll") for (int m = 0; m < 4; ++m) { float t_ = (st_[ai][m][0] + st_[ai][m][1]) + (st_[ai][m][2] + st_[ai][m][3]); \
        t_ = xsum32(xsum16(t_)); rr[ai][m] = __builtin_amdgcn_rsqf(t_ * (1.f / D) + EPS); } }
struct NoPre {};
#define EPI_NOPRE static constexpr bool KEEP_ACC = false; typedef NoPre Pre; __device__ __forceinline__ Pre prefetch(const Unit&, int, int) const { return Pre{}; }
struct RowPre { float r[2][4]; };
struct EpiInProj {
    unsigned char* ws; const float* bgate; int layer; int from_stats;
    static constexpr bool KEEP_ACC = false; typedef RowPre Pre;
    __device__ __forceinline__ Pre prefetch(const Unit& u, int wr, int fr) const { Pre p; const float* rx = (const float*)(ws + WS_RX);
#pragma unroll
        for (int ai = 0; ai < 2; ++ai)
#pragma unroll
            for (int m = 0; m < 4; ++m) p.r[ai][m] = from_stats ? 0.f : rx[EPI_ROW];
        return p; }
    __device__ __forceinline__ void operator()(const Acc& acc, const Unit& u, int wr, int wc, int fr, int fq, const Pre& pre) const {
        const float* rx = (const float*)(ws + WS_RX); const float* rope = (const float*)(ws + WS_ROPE);
        bf16* CQ = (bf16*)(ws + WS_CQ); bf16* KR = (bf16*)(ws + WS_KR); bf16* CKV = (bf16*)(ws + WS_CKV); bf16* U = (bf16*)(ws + WS_U); bf16* VR = (bf16*)(ws + WS_VR); bf16* QX = (bf16*)(ws + WS_QX); bf16* GATE = (bf16*)(ws + WS_GATE);
        float* cqstat = (float*)(ws + WS_CQSTAT); float* ckvstat = (float*)(ws + WS_CKVSTAT); float* vstat = (float*)(ws + WS_VSTAT); unsigned* kmax = (unsigned*)(ws + WS_CTL) + CW_KMAX + layer * 32;
        const int pn = u.pn;
        float rr[2][4];
        if (from_stats) { EPI_LOAD_RS(rs_, (const float*)(ws + WS_XSTAT));
#pragma unroll
            for (int ai = 0; ai < 2; ++ai)
#pragma unroll
                for (int m = 0; m < 4; ++m) rr[ai][m] = rs_[ai][m]; }
        else {
#pragma unroll
            for (int ai = 0; ai < 2; ++ai)
#pragma unroll
                for (int m = 0; m < 4; ++m) rr[ai][m] = pre.r[ai][m]; }
        if (pn < 2) {
            float krmax = 0.f;
            EPI_FOR { const int row = EPI_ROW;
                const float r = rr[ai][m]; float ss = 0.f;
#pragma unroll
                for (int bj = 0; bj < 2; ++bj) { const f32x4 v0 = acc[ai][bj][m][0] * r, v1 = acc[ai][bj][m][1] * r;
                    if (!(pn == 1 && bj == 1)) ss += sumsq4(v0) + sumsq4(v1);
                    *(u32x4*)(CQ + (size_t)row * 512 + pn * 256 + bj * HALF + wc * 32 + 8 * fq) = pack8(v0, v1);
                    if (pn == 1 && bj == 1 && wc == 0) {
                        const f32x4 c = *(const f32x4*)(rope + (size_t)row * 32 + 4 * fq), s = *(const f32x4*)(rope + (size_t)row * 32 + 16 + 4 * fq);
                        const f32x4 o0 = v0 * c - v1 * s, o1 = v0 * s + v1 * c;
                        *(u32x4*)(KR + (size_t)row * 32 + 8 * fq) = pack8(o0, o1);
                        float q2 = sumsq4(o0) + sumsq4(o1); q2 = xsum32(xsum16(q2)); krmax = fmaxf(krmax, q2); } }
                ss = xsum32(xsum16(ss));
                if (fq == 0) cqstat[(size_t)row * 8 + pn * 4 + wc] = ss;
            }
            if (pn == 1 && wc == 0) {
                krmax = row_max16(krmax);
                if ((fr | fq) == 0) atomicMax(kmax + 16, __float_as_uint(krmax)); }
        } else if (pn == 2) {
            EPI_FOR { const int row = EPI_ROW;
                const float r = rr[ai][m]; float ss = 0.f;
#pragma unroll
                for (int bj = 0; bj < 2; ++bj) { const f32x4 v0 = acc[ai][bj][m][0] * r, v1 = acc[ai][bj][m][1] * r; ss += sumsq4(v0) + sumsq4(v1);
                    *(u32x4*)(CKV + (size_t)row * 256 + bj * HALF + wc * 32 + 8 * fq) = pack8(v0, v1); }
                ss = xsum32(xsum16(ss));
                if (fq == 0) ckvstat[(size_t)row * 4 + wc] = ss;
            }
        } else if (pn < 7) {
            const bool isv = pn >= 5; bf16* dst = isv ? VR : U; const int t = isv ? pn - 5 : pn - 3;
            EPI_FOR { const int row = EPI_ROW;
                const float r = rr[ai][m]; float ss = 0.f;
#pragma unroll
                for (int bj = 0; bj < 2; ++bj) { f32x4 v0 = acc[ai][bj][m][0] * r, v1 = acc[ai][bj][m][1] * r;
#pragma unroll
                    for (int e = 0; e < 4; ++e) { v0[e] = gelu_tanh(v0[e]); v1[e] = gelu_tanh(v1[e]); }
                    ss += sumsq4(v0) + sumsq4(v1);
                    *(u32x4*)(dst + (size_t)row * 512 + t * 256 + bj * HALF + wc * 32 + 8 * fq) = pack8(v0, v1); }
                if (isv) { ss = xsum32(xsum16(ss)); if (fq == 0) vstat[(size_t)row * 8 + t * 4 + wc] = ss; }
            }
        } else if (pn < 9) {
            EPI_FOR { const int row = EPI_ROW;
                const float r = rr[ai][m];
#pragma unroll
                for (int bj = 0; bj < 2; ++bj) *(u32x4*)(QX + (size_t)row * 512 + (pn - 7) * 256 + bj * HALF + wc * 32 + 8 * fq) = pack8(acc[ai][bj][m][0] * r, acc[ai][bj][m][1] * r);
            }
        } else {
            const int gc0 = (pn - 9) * 256 + wc * 32 + 8 * fq;
            f32x4 bg[2][2];
#pragma unroll
            for (int bj = 0; bj < 2; ++bj) { bg[bj][0] = *(const f32x4*)(bgate + gc0 + bj * HALF); bg[bj][1] = *(const f32x4*)(bgate + gc0 + bj * HALF + 4); }
            EPI_FOR { const int row = EPI_ROW;
                const float r = rr[ai][m];
#pragma unroll
                for (int bj = 0; bj < 2; ++bj) { f32x4 v0 = acc[ai][bj][m][0] * r + bg[bj][0], v1 = acc[ai][bj][m][1] * r + bg[bj][1];
#pragma unroll
                    for (int e = 0; e < 4; ++e) { v0[e] = sigmoidf_(v0[e]); v1[e] = sigmoidf_(v1[e]); }
#ifdef DBG_CONSTGATE
                    v0 = acc[ai][bj][m][0] * r; v1 = acc[ai][bj][m][1] * r;
#endif
                    *(u32x2*)((unsigned char*)GATE + (size_t)row * 3072 + gc0 + bj * HALF) = pack8_u8(v0, v1); }
            }
        }
    }
};
struct EpiMemKV {
    bf16* KV;
    EPI_NOPRE
    __device__ __forceinline__ void operator()(const Acc& acc, const Unit& u, int wr, int wc, int fr, int fq, const Pre&) const {
        EPI_FOR { const int row = EPI_ROW;
#pragma unroll
            for (int bj = 0; bj < 2; ++bj) *(u32x4*)(KV + (size_t)u.aux * 256 * 1024 + (size_t)row * 1024 + EPI_C8(bj)) = pack8(acc[ai][bj][m][0], acc[ai][bj][m][1]);
        }
    }
};
struct EpiQ {
    const float* cqstat; const float* rope; bf16* Q;
    EPI_NOPRE
    __device__ __forceinline__ void operator()(const Acc& acc, const Unit& u, int wr, int wc, int fr, int fq, const Pre&) const {
        EPI_FOR { const int row = EPI_ROW;
            const f32x4 s0 = *(const f32x4*)(cqstat + (size_t)row * 8), s1 = *(const f32x4*)(cqstat + (size_t)row * 8 + 4);
            const float r = __builtin_amdgcn_rsqf(((s0[0] + s0[1]) + (s0[2] + s0[3]) + (s1[0] + s1[1]) + (s1[2] + s1[3])) * (1.f / QRANK) + EPS);
#pragma unroll
            for (int bj = 0; bj < 2; ++bj) { f32x4 v0 = acc[ai][bj][m][0] * r, v1 = acc[ai][bj][m][1] * r;
                if (((8 * u.pn + 4 * bj + wc) % 3) == 2) {
                    const f32x4 c = *(const f32x4*)(rope + (size_t)row * 32 + 4 * fq), s = *(const f32x4*)(rope + (size_t)row * 32 + 16 + 4 * fq);
                    const f32x4 o0 = v0 * c - v1 * s, o1 = v0 * s + v1 * c; v0 = o0; v1 = o1; }
                *(u32x4*)(Q + (size_t)row * 768 + EPI_C8(bj)) = pack8(v0, v1); }
        }
    }
};
struct EpiKV {
    const float* ckvstat; bf16* KN; bf16* V; unsigned* kmax;
    EPI_NOPRE
    __device__ __forceinline__ void operator()(const Acc& acc, const Unit& u, int wr, int wc, int fr, int fq, const Pre&) const {
        bf16* dst = u.pn < 2 ? KN : V; const int t = u.pn & 1; float hm[2] = {0.f, 0.f};
        EPI_FOR { const int row = EPI_ROW;
            const f32x4 s0 = *(const f32x4*)(ckvstat + (size_t)row * 4);
            const float r = __builtin_amdgcn_rsqf(((s0[0] + s0[1]) + (s0[2] + s0[3])) * (1.f / KVRANK) + EPS);
#pragma unroll
            for (int bj = 0; bj < 2; ++bj) { const f32x4 v0 = acc[ai][bj][m][0] * r, v1 = acc[ai][bj][m][1] * r;
                *(u32x4*)(dst + (size_t)row * 512 + t * 256 + bj * HALF + wc * 32 + 8 * fq) = pack8(v0, v1);
                float q2 = sumsq4(v0) + sumsq4(v1); q2 = xsum32(xsum16(q2)); hm[bj] = fmaxf(hm[bj], q2); }
        }
        if (u.pn < 2) {
#pragma unroll
            for (int bj = 0; bj < 2; ++bj) { float v = hm[bj];
                v = row_max16(v);
                if ((fr | fq) == 0) atomicMax(kmax + 2 * (4 * u.pn + 2 * bj + (wc >> 1)) + (wc & 1), __float_as_uint(v)); }
        }
    }
};
struct EpiBranch {
    const unsigned char* GATE; bf16* MIXB;
    static constexpr bool KEEP_ACC = true; typedef NoPre Pre; __device__ __forceinline__ Pre prefetch(const Unit&, int, int) const { return Pre{}; }
    __device__ __forceinline__ void operator()(Acc& acc, const Unit& u, int wr, int wc, int fr, int fq, const Pre&) const {
        const int n = u.aux;
#pragma unroll
        for (int ai = 0; ai < 2; ++ai) {
            u32x2 gw[4][2], gn[4][2];
#pragma unroll
            for (int m = 0; m < 4; ++m)
#pragma unroll
                for (int bj = 0; bj < 2; ++bj) { const unsigned char* gp = GATE + (size_t)EPI_ROW * 3072 + n * 1024 + EPI_C8(bj);
                    gw[m][bj] = *(const u32x2*)gp; if (n < 2) gn[m][bj] = *(const u32x2*)(gp + 1024); }
            asm volatile("" ::: "memory");
#pragma unroll
            for (int m = 0; m < 4; ++m)
#pragma unroll
                for (int bj = 0; bj < 2; ++bj) {
                    f32x4 g0, g1; unpack8_u8(gw[m][bj], g0, g1);
#pragma unroll
                    for (int e = 0; e < 4; ++e) { g0[e] = fmaxf(g0[e], 0.001953125f); g1[e] = fmaxf(g1[e], 0.001953125f); }
                    if (n < 2) { f32x4 h0, h1; unpack8_u8(gn[m][bj], h0, h1);
#pragma unroll
                        for (int e = 0; e < 4; ++e) { g0[e] *= fast_rcp(fmaxf(h0[e], 0.001953125f)); g1[e] *= fast_rcp(fmaxf(h1[e], 0.001953125f)); }
                        acc[ai][bj][m][0] *= g0; acc[ai][bj][m][1] *= g1; }
                    else *(u32x4*)(MIXB + (size_t)u.pm * 256 * 1024 + (size_t)(4 * u.pn + 2 * bj + (wc >> 1)) * 16384 + (ai * HALF + wr * 64 + m * 16 + fr) * 64 + (wc & 1) * 32 + 8 * fq) = pack8(acc[ai][bj][m][0] * g0, acc[ai][bj][m][1] * g1);
                }
        }
        if (n == 2) {
#pragma unroll
            for (int ai = 0; ai < 2; ++ai)
#pragma unroll
                for (int bj = 0; bj < 2; ++bj)
#pragma unroll
                    for (int m = 0; m < 4; ++m) { acc[ai][bj][m][0] = (f32x4){0.f, 0.f, 0.f, 0.f}; acc[ai][bj][m][1] = (f32x4){0.f, 0.f, 0.f, 0.f}; }
        }
    }
};
struct EpiResid {
    const float* X; float* Xo; bf16* XB; float* xstat;
    EPI_NOPRE
    __device__ __forceinline__ void operator()(const Acc& acc, const Unit& u, int wr, int wc, int fr, int fq, const Pre&) const {
#pragma unroll
        for (int ai = 0; ai < 2; ++ai) {
            f32x4 xv[4][2][2];
#pragma unroll
            for (int m = 0; m < 4; ++m)
#pragma unroll
                for (int bj = 0; bj < 2; ++bj) { const float* xp = X + (size_t)EPI_ROW * 1024 + EPI_C8(bj); xv[m][bj][0] = *(const f32x4*)xp; xv[m][bj][1] = *(const f32x4*)(xp + 4); }
            asm volatile("" ::: "memory");
#pragma unroll
            for (int m = 0; m < 4; ++m) { const int row = EPI_ROW; float ss = 0.f;
#pragma unroll
                for (int bj = 0; bj < 2; ++bj) { const int col = EPI_C8(bj); float* xp = Xo + (size_t)row * 1024 + col;
                    const f32x4 v0 = xv[m][bj][0] + acc[ai][bj][m][0], v1 = xv[m][bj][1] + acc[ai][bj][m][1];
                    *(f32x4*)xp = v0; *(f32x4*)(xp + 4) = v1; ss += sumsq4(v0) + sumsq4(v1);
                    *(u32x4*)(XB + (size_t)row * 1024 + col) = pack8(v0, v1); }
                ss = xsum32(xsum16(ss));
                if (fq == 0) xstat[(size_t)row * 16 + u.pn * 4 + wc] = ss; }
        }
    }
};
struct EpiSwiGLU {
    const float* rs; bf16* Hh; int ldh; int from_stats;
    static constexpr bool KEEP_ACC = false; typedef RowPre Pre;
    __device__ __forceinline__ Pre prefetch(const Unit& u, int wr, int fr) const { Pre p;
#pragma unroll
        for (int ai = 0; ai < 2; ++ai)
#pragma unroll
            for (int m = 0; m < 4; ++m) p.r[ai][m] = from_stats ? 0.f : rs[EPI_ROW];
        return p; }
    __device__ __forceinline__ void operator()(const Acc& acc, const Unit& u, int wr, int wc, int fr, int fq, const Pre& pre) const {
        float rr[2][4];
        if (from_stats) { EPI_LOAD_RS(rs_, rs);
#pragma unroll
            for (int ai = 0; ai < 2; ++ai)
#pragma unroll
                for (int m = 0; m < 4; ++m) rr[ai][m] = rs_[ai][m]; }
        else {
#pragma unroll
            for (int ai = 0; ai < 2; ++ai)
#pragma unroll
                for (int m = 0; m < 4; ++m) rr[ai][m] = pre.r[ai][m]; }
        bf16* hbase = Hh + (size_t)u.pm * 256 * ldh + (size_t)(2 * u.pn + (wc >> 1)) * 16384 + (wr * 64 + fr) * 64 + (wc & 1) * 32 + 8 * fq;
        EPI_FOR { const int row = EPI_ROW;
            const float r = rr[ai][m];
            f32x4 a0 = acc[ai][0][m][0] * r, a1 = acc[ai][0][m][1] * r; const f32x4 b0 = acc[ai][1][m][0] * r, b1 = acc[ai][1][m][1] * r;
#pragma unroll
            for (int e = 0; e < 4; ++e) { a0[e] = a0[e] * sigmoidf_(a0[e]) * b0[e]; a1[e] = a1[e] * sigmoidf_(a1[e]) * b1[e]; }
            (void)row; *(u32x4*)(hbase + (ai * HALF + m * 16) * 64) = pack8(a0, a1);
        }
    }
};
struct EpiBf16 {
    bf16* C; int ldc;
    EPI_NOPRE
    __device__ __forceinline__ void operator()(const Acc& acc, const Unit& u, int wr, int wc, int fr, int fq, const Pre&) const {
        EPI_FOR { const int row = EPI_ROW;
#pragma unroll
            for (int bj = 0; bj < 2; ++bj) *(u32x4*)(C + (size_t)row * ldc + EPI_C8(bj)) = pack8(acc[ai][bj][m][0], acc[ai][bj][m][1]);
        }
    }
};
template <int CC>
__device__ __forceinline__ void ks_reduce(const float* part, int x, int r, int k, int tid, bf16* C, int ldc, const Unit& u, int wr, int wc, int fr, int fq) {
    for (int sp = k; sp < 16; sp += CC) { const int ai = sp >> 3, bj = (sp >> 2) & 1, m = sp & 3;
        f32x4 v0[CC], v1[CC];
#pragma unroll
        for (int kk = 0; kk < CC; ++kk) { const float* q = part + (size_t)(x + 8 * (r * CC + kk)) * 65536 + tid * 4 + sp * 4096; v0[kk] = *(const f32x4*)q; v1[kk] = *(const f32x4*)(q + 2048); }
        f32x4 s0 = v0[0], s1 = v1[0];
#pragma unroll
        for (int kk = 1; kk < CC; ++kk) { s0 += v0[kk]; s1 += v1[kk]; }
        const int row = u.pm * BM + ai * HALF + wr * 64 + m * 16 + fr;
        *(u32x4*)(C + (size_t)row * ldc + u.pn * BM + bj * HALF + wc * 32 + 8 * fq) = pack8(s0, s1); }
}
struct EpiBf16KS {
    bf16* C; int ldc; float* part; unsigned* cnt; int c;
    EPI_NOPRE
    __device__ __forceinline__ void operator()(const Acc& acc, const Unit& u, int wr, int wc, int fr, int fq, const Pre&) const {
        if (((u.aux >> 4) & 3) != 0) {
            int tid_ = threadIdx.x; asm volatile("" : "+v"(tid_));
            const int k = (u.aux >> 8) & 255, CC = (u.aux >> 16) & 255, r = u.aux >> 24, x = c & 7;
            float* p = part + (size_t)c * 65536 + tid_ * 4;
#pragma unroll
            for (int ai = 0; ai < 2; ++ai)
#pragma unroll
                for (int bj = 0; bj < 2; ++bj)
#pragma unroll
                    for (int m = 0; m < 4; ++m)
#pragma unroll
                        for (int n = 0; n < 2; ++n) *(f32x4*)(p + (((ai * 2 + bj) * 4 + m) * 2 + n) * 2048) = acc[ai][bj][m][n];
            __threadfence();
            __syncthreads();
            if (tid_ == 0) { unsigned* w = cnt + x + 8 * r; __hip_atomic_fetch_add(w, 1u, __ATOMIC_RELEASE, __HIP_MEMORY_SCOPE_AGENT);
                while (__hip_atomic_load(w, __ATOMIC_ACQUIRE, __HIP_MEMORY_SCOPE_AGENT) < (unsigned)CC) __builtin_amdgcn_s_sleep(2); }
            __syncthreads(); __builtin_amdgcn_fence(__ATOMIC_ACQUIRE, "agent");
            if (CC == 4) ks_reduce<4>(part, x, r, k, tid_, C, ldc, u, wr, wc, fr, fq);
            else ks_reduce<2>(part, x, r, k, tid_, C, ldc, u, wr, wc, fr, fq);
            return;
        }
        EPI_FOR { const int row = EPI_ROW;
#pragma unroll
            for (int bj = 0; bj < 2; ++bj) *(u32x4*)(C + (size_t)row * ldc + EPI_C8(bj)) = pack8(acc[ai][bj][m][0], acc[ai][bj][m][1]);
        }
    }
};
struct EpiF32 {
    float* C; int ldc;
    EPI_NOPRE
    __device__ __forceinline__ void operator()(const Acc& acc, const Unit& u, int wr, int wc, int fr, int fq, const Pre&) const {
        EPI_FOR { const int row = EPI_ROW;
#pragma unroll
            for (int bj = 0; bj < 2; ++bj) { float* cp = C + (size_t)row * ldc + EPI_C8(bj); *(f32x4*)cp = acc[ai][bj][m][0]; *(f32x4*)(cp + 4) = acc[ai][bj][m][1]; }
        }
    }
};
}

namespace att {
#define KSWZ(row, colB) ((row) * 256 + ((colB) ^ (((row) & 7) << 4)))
#define SBAR() __builtin_amdgcn_sched_barrier(0)
constexpr float THR = 8.f;
__device__ __forceinline__ int crow(int r, int hi) { return (r & 3) + 8 * (r >> 2) + 4 * hi; }
template <int NB> __device__ __forceinline__ int v_st(int k, int c) { const int kk = (k & ~0xC) | ((k & 4) << 1) | ((k & 8) >> 1); return ((kk >> 3) * NB + (c >> 5)) * 512 + ((kk & 7) * 32 + (c & 31)) * 2; }
__device__ __forceinline__ int v_rd_base(int lane) { return ((lane & 3) << 3) | (((lane >> 2) & 3) << 6) | (((lane >> 4) & 1) << 5) | (((lane >> 5) & 1) << 8); }
template <int OFF> __device__ __forceinline__ s16x4 tr_read(int vb) { s16x4 r; asm volatile("ds_read_b64_tr_b16 %0, %1 offset:%2" : "=&v"(r) : "v"(vb), "i"(OFF) : "memory"); return r; }

__device__ __forceinline__ void partialSM(f32x16& p0, f32x16& p1, float& m_reg, float& alpha) {
    float pmax = p0[0];
#pragma unroll
    for (int r = 1; r < 16; ++r) pmax = fmaxf(pmax, p0[r]);
#pragma unroll
    for (int r = 0; r < 16; ++r) pmax = fmaxf(pmax, p1[r]);
    { auto rr = __builtin_amdgcn_permlane32_swap(__float_as_uint(pmax), __float_as_uint(pmax), false, false); pmax = fmaxf(__uint_as_float(rr[0]), __uint_as_float(rr[1])); }
    float mn;
    if (__builtin_expect(__all(pmax - m_reg <= THR), 1)) { mn = m_reg; alpha = 1.f; }
    else { mn = fmaxf(m_reg, pmax); alpha = __builtin_amdgcn_exp2f(m_reg - mn); m_reg = mn; }
#pragma unroll
    for (int r = 0; r < 16; ++r) { p0[r] -= mn; p1[r] -= mn; }
#pragma unroll
    for (int r = 0; r < 16; ++r) p0[r] = __builtin_amdgcn_exp2f(p0[r]);
}
__device__ __forceinline__ void finishSM(f32x16& p0, f32x16& p1, float alpha, float& l_reg, bf16x8& pa0, bf16x8& pa1, bf16x8& pa2, bf16x8& pa3) {
#pragma unroll
    for (int r = 0; r < 16; ++r) p1[r] = __builtin_amdgcn_exp2f(p1[r]);
    float ps = 0;
#pragma unroll
    for (int r = 0; r < 16; ++r) ps += p0[r];
#pragma unroll
    for (int r = 0; r < 16; ++r) ps += p1[r];
    { auto rr = __builtin_amdgcn_permlane32_swap(__float_as_uint(ps), __float_as_uint(ps), false, false); ps = __uint_as_float(rr[0]) + __uint_as_float(rr[1]); }
    l_reg = l_reg * alpha + ps;
#define PK4(P, BASE, OUT) do { unsigned a0 = cvt_pk_bf16(P[BASE + 0], P[BASE + 1]), a1 = cvt_pk_bf16(P[BASE + 2], P[BASE + 3]);   \
    unsigned b0 = cvt_pk_bf16(P[BASE + 4], P[BASE + 5]), b1 = cvt_pk_bf16(P[BASE + 6], P[BASE + 7]);                              \
    auto r0 = __builtin_amdgcn_permlane32_swap(a0, b0, false, false); auto r1 = __builtin_amdgcn_permlane32_swap(a1, b1, false, false); \
    u32x4 w = {r0[0], r1[0], r0[1], r1[1]}; OUT = __builtin_bit_cast(bf16x8, w); } while (0)
    PK4(p0, 0, pa0); PK4(p0, 8, pa1); PK4(p1, 0, pa2); PK4(p1, 8, pa3);
#undef PK4
}
template <int ND0> __device__ __forceinline__ void qkt(f32x16& p0, f32x16& p1, const LAS char* Ks, const bf16x8* qr, int r32, int hi, const f32x16& init) {
#pragma unroll
    for (int d0 = 0; d0 < ND0; ++d0) { const int cb = (d0 * 16 + hi * 8) * 2;
        const bf16x8 b0 = *(const LAS bf16x8*)(Ks + KSWZ(r32, cb));
        const bf16x8 b1 = *(const LAS bf16x8*)(Ks + KSWZ(32 + r32, cb));
        p0 = __builtin_amdgcn_mfma_f32_32x32x16_bf16(b0, qr[d0], d0 == 0 ? init : p0, 0, 0, 0);
        p1 = __builtin_amdgcn_mfma_f32_32x32x16_bf16(b1, qr[d0], d0 == 0 ? init : p1, 0, 0, 0); }
}
__device__ __forceinline__ void expA(f32x16& p0) {
#pragma unroll
    for (int r = 0; r < 16; ++r) p0[r] = __builtin_amdgcn_exp2f(p0[r]);
}
template <int NB, int D0> __device__ __forceinline__ void pv_one(f32x16& od, int vb, bf16x8 pa0, bf16x8 pa1, bf16x8 pa2, bf16x8 pa3) {
    const s16x4 l0 = tr_read<(0 * NB + D0) * 512>(vb), h0 = tr_read<(1 * NB + D0) * 512>(vb), l1 = tr_read<(2 * NB + D0) * 512>(vb), h1 = tr_read<(3 * NB + D0) * 512>(vb);
    const s16x4 l2 = tr_read<(4 * NB + D0) * 512>(vb), h2 = tr_read<(5 * NB + D0) * 512>(vb), l3 = tr_read<(6 * NB + D0) * 512>(vb), h3 = tr_read<(7 * NB + D0) * 512>(vb);
    asm volatile("s_waitcnt lgkmcnt(0)" ::: "memory"); SBAR();
#define PK(L, H) (bf16x8){L[0], L[1], L[2], L[3], H[0], H[1], H[2], H[3]}
    od = __builtin_amdgcn_mfma_f32_32x32x16_bf16(pa0, PK(l0, h0), od, 0, 0, 0);
    od = __builtin_amdgcn_mfma_f32_32x32x16_bf16(pa1, PK(l1, h1), od, 0, 0, 0);
    od = __builtin_amdgcn_mfma_f32_32x32x16_bf16(pa2, PK(l2, h2), od, 0, 0, 0);
    od = __builtin_amdgcn_mfma_f32_32x32x16_bf16(pa3, PK(l3, h3), od, 0, 0, 0);
#undef PK
}
template <int NB> __device__ __forceinline__ void pv_all(f32x16* o, int vb, bf16x8 pa0, bf16x8 pa1, bf16x8 pa2, bf16x8 pa3) {
    pv_one<NB, 0>(o[0], vb, pa0, pa1, pa2, pa3); pv_one<NB, 1>(o[1], vb, pa0, pa1, pa2, pa3);
    if constexpr (NB == 4) { pv_one<NB, 2>(o[2], vb, pa0, pa1, pa2, pa3); pv_one<NB, 3>(o[3], vb, pa0, pa1, pa2, pa3); }
}

template <int DQK, int D1, int DVV, bool FIXM>
__device__ __forceinline__ void attn_unit(const bf16* __restrict__ Qb, int ldq, const bf16* __restrict__ K1, int ldk1, const bf16* __restrict__ K2, int ldk2,
                                          const bf16* __restrict__ Vh, int ldv, bf16* __restrict__ Ob, int ldo, int seq, LAS char* lds, float kbound) {
    constexpr int ND0 = DQK / 16, NB = DVV / 32, CK = DQK / 8, CV = DVV / 8;
    constexpr int NKL = (64 * CK + 511) / 512, NVL = (64 * CV) / 512;
    constexpr int SHM_V = 64 * DVV * 2, SHM_K = 64 * 256;
    int tid_ = threadIdx.x; asm volatile("" : "+v"(tid_));
    const int tid = tid_, wid = tid >> 6, lane = tid & 63, r32 = lane & 31, hi = lane >> 5;
    LAS char* V_lds = lds; LAS char* K_lds = lds + 2 * SHM_V;
    LAS float* ws = (LAS float*)(lds + 2 * SHM_V + 2 * SHM_K) + wid * 64; LAS float* li_l = ws; LAS float* al_l = ws + 32;
    float m_reg = -1e30f, l_reg = 0; f32x16 o[NB]; bf16x8 qr[ND0];
#pragma unroll
    for (int d = 0; d < NB; ++d) o[d] = f32x16{};
    const bf16* Qw = Qb + (long)(wid * 32 + r32) * ldq + hi * 8;
#pragma unroll
    for (int d0 = 0; d0 < ND0; ++d0) qr[d0] = *(const bf16x8*)(Qw + d0 * 16);
    f32x16 init = f32x16{};
    if constexpr (FIXM) {
        float q2 = 0.f;
#pragma unroll
        for (int d0 = 0; d0 < ND0; ++d0) { const u32x4 w = __builtin_bit_cast(u32x4, qr[d0]); f32x4 a, b; unpack8(w, a, b); q2 += sumsq4(a) + sumsq4(b); }
        { auto rr = __builtin_amdgcn_permlane32_swap(__float_as_uint(q2), __float_as_uint(q2), false, false); q2 = __uint_as_float(rr[0]) + __uint_as_float(rr[1]); }
        const float nm = -sqrtf(q2) * kbound;
#pragma unroll
        for (int r = 0; r < 16; ++r) init[r] = nm;
        asm volatile("" : "+v"(init));
    }
    const bf16* kp[NKL]; int kstr[NKL], kdst[NKL]; bool kval[NKL];
#pragma unroll
    for (int i = 0; i < NKL; ++i) { const int c = tid + 512 * i; kval[i] = c < 64 * CK; const int cc_ = kval[i] ? c : 0; const int row = cc_ / CK, cc = cc_ % CK;
        if (cc * 8 < D1) { kp[i] = K1 + (long)row * ldk1 + cc * 8; kstr[i] = 64 * ldk1; } else { kp[i] = K2 + (long)row * ldk2 + (cc * 8 - D1); kstr[i] = 64 * ldk2; }
        kdst[i] = KSWZ(row, cc * 16); }
    const bf16* vp[NVL]; int vdst[NVL]; const int vstr = 64 * ldv;
#pragma unroll
    for (int i = 0; i < NVL; ++i) { const int c = tid + 512 * i; const int row = c / CV, cc = c % CV; vp[i] = Vh + (long)row * ldv + cc * 8; vdst[i] = v_st<NB>(row, cc * 8); }
    const int vb0 = (int)(uintptr_t)V_lds + v_rd_base(lane);
    struct { bf16x8 ks[NKL]; bf16x8 vs[NVL]; } sr_[2];
#define SLOAD(i, t) do { _Pragma("unroll") for (int q_ = 0; q_ < NVL; ++q_) sr_[i].vs[q_] = *(const bf16x8*)(vp[q_] + (long)(t) * vstr); \
    _Pragma("unroll") for (int q_ = 0; q_ < NKL; ++q_) { if (kval[q_]) sr_[i].ks[q_] = *(const bf16x8*)(kp[q_] + (long)(t) * kstr[q_]); } } while (0)
#define SWRITE(b, i) do { _Pragma("unroll") for (int q_ = 0; q_ < NVL; ++q_) *(LAS bf16x8*)(V_lds + (b) * SHM_V + vdst[q_]) = sr_[i].vs[q_]; \
    _Pragma("unroll") for (int q_ = 0; q_ < NKL; ++q_) { if (kval[q_]) *(LAS bf16x8*)(K_lds + (b) * SHM_K + kdst[q_]) = sr_[i].ks[q_]; } } while (0)
#define SWAIT() asm volatile("s_waitcnt vmcnt(%0)" :: "n"(NKL + NVL) : "memory")
#define RESC(a) do { if (__any((a) < 1.f)) { if (hi == 0) al_l[r32] = (a); asm volatile("s_waitcnt lgkmcnt(0)" ::: "memory"); \
    _Pragma("unroll") for (int d = 0; d < NB; ++d) _Pragma("unroll") for (int r = 0; r < 16; ++r) o[d][r] *= al_l[crow(r, hi)]; } } while (0)
    f32x16 pA0, pA1, pB0, pB1; float alA = 1.f, alB = 1.f; bf16x8 pa0, pa1, pa2, pa3; const int NT = seq / 64;
#define PSM(P0, P1, AL) do { if constexpr (FIXM) expA(P0); else partialSM(P0, P1, m_reg, AL); } while (0)
#define RSC(AL) do { if constexpr (!FIXM) RESC(AL); } while (0)
    SLOAD(0, 0); asm volatile("s_waitcnt vmcnt(0)" ::: "memory"); SWRITE(0, 0); __syncthreads();
    qkt<ND0>(pA0, pA1, K_lds, qr, r32, hi, init); PSM(pA0, pA1, alA);
    SLOAD(1, 1); if (2 < NT) SLOAD(0, 2);
    SWAIT(); SWRITE(1, 1); __syncthreads();
    for (int j = 1; j + 1 < NT; j += 2) {
        SBAR(); qkt<ND0>(pB0, pB1, K_lds + SHM_K, qr, r32, hi, init);
        finishSM(pA0, pA1, alA, l_reg, pa0, pa1, pa2, pa3); SBAR();
        SLOAD(1, j + 2); SBAR();
        pv_all<NB>(o, vb0, pa0, pa1, pa2, pa3); PSM(pB0, pB1, alB);
        __syncthreads(); SWAIT(); SWRITE(0, 0);
        RSC(alB); __syncthreads();
        SBAR(); qkt<ND0>(pA0, pA1, K_lds, qr, r32, hi, init);
        finishSM(pB0, pB1, alB, l_reg, pa0, pa1, pa2, pa3); SBAR();
        if (j + 3 < NT) SLOAD(0, j + 3); SBAR();
        pv_all<NB>(o, vb0 + SHM_V, pa0, pa1, pa2, pa3); PSM(pA0, pA1, alA);
        __syncthreads(); SWAIT(); SWRITE(1, 1);
        RSC(alA); __syncthreads();
    }
    SBAR(); qkt<ND0>(pB0, pB1, K_lds + SHM_K, qr, r32, hi, init);
    finishSM(pA0, pA1, alA, l_reg, pa0, pa1, pa2, pa3); SBAR();
    pv_all<NB>(o, vb0, pa0, pa1, pa2, pa3); PSM(pB0, pB1, alB);
    __syncthreads(); RSC(alB);
    finishSM(pB0, pB1, alB, l_reg, pa0, pa1, pa2, pa3); SBAR();
    pv_all<NB>(o, vb0 + SHM_V, pa0, pa1, pa2, pa3);
#undef PSM
#undef RSC
    if (hi == 0) li_l[r32] = l_reg; asm volatile("s_waitcnt lgkmcnt(0)" ::: "memory");
    float rli[16];
#pragma unroll
    for (int r = 0; r < 16; ++r) rli[r] = __builtin_amdgcn_rcpf(li_l[crow(r, hi)]);
    bf16* Ow = Ob + (long)(wid * 32) * ldo;
#pragma unroll
    for (int r = 0; r < 16; ++r) { const int orow = crow(r, hi);
#pragma unroll
        for (int d0 = 0; d0 < NB; ++d0) Ow[(long)orow * ldo + d0 * 32 + r32] = f2bf(o[d0][r] * rli[r]); }
    __syncthreads();
#undef SLOAD
#undef SWRITE
#undef SWAIT
#undef RESC
}

#define EXP4(P, B) do { P[B] = __builtin_amdgcn_exp2f(P[B]); P[B + 1] = __builtin_amdgcn_exp2f(P[B + 1]); P[B + 2] = __builtin_amdgcn_exp2f(P[B + 2]); P[B + 3] = __builtin_amdgcn_exp2f(P[B + 3]); } while (0)
#define SUM4(S, P, B) do { S += (P[B] + P[B + 1]) + (P[B + 2] + P[B + 3]); } while (0)
#define PK4X(P, BASE, OUT) do { const u32x4 w_ = {cvt_pk_bf16(P[BASE + 0], P[BASE + 1]), cvt_pk_bf16(P[BASE + 2], P[BASE + 3]), cvt_pk_bf16(P[BASE + 4], P[BASE + 5]), cvt_pk_bf16(P[BASE + 6], P[BASE + 7])}; OUT = __builtin_bit_cast(bf16x8, w_); } while (0)
typedef short v4i16_t __attribute__((ext_vector_type(4)));
__device__ __forceinline__ s16x4 vtr(const LAS char* p) { return __builtin_bit_cast(s16x4, __builtin_amdgcn_ds_read_tr16_b64_v4i16((LAS v4i16_t*)p)); }
#define KSWZ2(row, colB) ((row) * 256 + ((colB) ^ (((row) & 15) << 4)))
template <int DQK, int D1, int DVV>
__device__ __forceinline__ void attn_unit2(const bf16* __restrict__ Qb, int ldq, const bf16* __restrict__ K1, int ldk1, const bf16* __restrict__ K2, int ldk2,
                                           const bf16* __restrict__ Vh, int ldv, bf16* __restrict__ Ob, int ldo, int seq, LAS char* lds, float kbound) {
    constexpr int ND0 = DQK / 16, NB = DVV / 32, CK = DQK / 8;
    constexpr int SHM_V = 64 * DVV * 2, SHM_K = 64 * 256;
    static_assert(NB == 2 && ND0 == 6, "written for QK dim 96 / V dim 64");
    int tid_ = threadIdx.x; asm volatile("" : "+v"(tid_));
    const int tid = tid_, wid = __builtin_amdgcn_readfirstlane(tid >> 6), lane = tid & 63, r32 = lane & 31, hi = lane >> 5;
    LAS char* V_lds = lds; LAS char* K_lds = lds + 3 * SHM_V;
    LAS float* ws = (LAS float*)(lds + 3 * SHM_V + 2 * SHM_K) + wid * 64;
    LAS char* QAL = lds + 3 * SHM_V + 2 * SHM_K + 2048 + wid * (2 * ND0 * 1024) + lane * 16; LAS char* QBL = QAL + ND0 * 1024;
    float nm;
    { bf16x8 qa[ND0], qb[ND0];
      const bf16* QwA = Qb + (long)(wid * 64 + r32) * ldq + hi * 8; const bf16* QwB = QwA + (long)32 * ldq;
#pragma unroll
      for (int d0 = 0; d0 < ND0; ++d0) { qa[d0] = *(const bf16x8*)(QwA + d0 * 16); qb[d0] = *(const bf16x8*)(QwB + d0 * 16); }
      float q2a = 0.f, q2b = 0.f;
#pragma unroll
      for (int d0 = 0; d0 < ND0; ++d0) { f32x4 a, b; unpack8(__builtin_bit_cast(u32x4, qa[d0]), a, b); q2a += sumsq4(a) + sumsq4(b); unpack8(__builtin_bit_cast(u32x4, qb[d0]), a, b); q2b += sumsq4(a) + sumsq4(b);
          *(LAS bf16x8*)(QAL + d0 * 1024) = qa[d0]; *(LAS bf16x8*)(QBL + d0 * 1024) = qb[d0]; }
      { auto rr = __builtin_amdgcn_permlane32_swap(__float_as_uint(q2a), __float_as_uint(q2a), false, false); q2a = __uint_as_float(rr[0]) + __uint_as_float(rr[1]); }
      { auto rr = __builtin_amdgcn_permlane32_swap(__float_as_uint(q2b), __float_as_uint(q2b), false, false); q2b = __uint_as_float(rr[0]) + __uint_as_float(rr[1]); }
      nm = -sqrtf(fmaxf(q2a, q2b)) * kbound; }
    const bf16* kp[2]; int kstr[2];
#pragma unroll
    for (int i = 0; i < 2; ++i) { const int row = 8 * wid + 4 * i + (lane >> 4), cc = (lane & 15) ^ (row & 15);
        if (cc >= 8 && cc < CK) { kp[i] = K2 + (long)row * ldk2 + (cc * 8 - D1); kstr[i] = 64 * ldk2; } else { kp[i] = K1 + (long)row * ldk1 + (cc < 8 ? cc * 8 : 0); kstr[i] = 64 * ldk1; } }
    const bf16* vp; { const int k = 8 * wid + ((lane & 31) >> 2); vp = Vh + (long)k * ldv + (lane >> 5) * 32 + (lane & 3) * 8; }
    const int vstr = 64 * ldv;
    const LAS char* vrd0 = V_lds + v_rd_base(lane);
#define DMA2(t, kb, vbuf) do { \
    __builtin_amdgcn_global_load_lds((const unsigned*)(kp[0] + (long)(t) * kstr[0]), (LAS unsigned*)(K_lds + (kb) * SHM_K + wid * 2048), 16, 0, 0); \
    __builtin_amdgcn_global_load_lds((const unsigned*)(kp[1] + (long)(t) * kstr[1]), (LAS unsigned*)(K_lds + (kb) * SHM_K + wid * 2048 + 1024), 16, 0, 0); \
    __builtin_amdgcn_global_load_lds((const unsigned*)(vp + (long)(t) * vstr), (LAS unsigned*)(V_lds + (vbuf) * SHM_V + wid * 1024), 16, 0, 0); } while (0)
#define VRD8(arr, base, D0) do { _Pragma("unroll") for (int j_ = 0; j_ < 8; ++j_) arr[j_] = vtr((base) + (j_ * NB + (D0)) * 512); } while (0)
#define PKV(arr, ks) (bf16x8){arr[2 * (ks)][0], arr[2 * (ks)][1], arr[2 * (ks)][2], arr[2 * (ks)][3], arr[2 * (ks) + 1][0], arr[2 * (ks) + 1][1], arr[2 * (ks) + 1][2], arr[2 * (ks) + 1][3]}
    f32x16 oA[2], oB[2]; oA[0] = f32x16{}; oA[1] = f32x16{}; oB[0] = f32x16{}; oB[1] = f32x16{};
    float lA = 0.f, lB = 0.f; const int NT = seq / 64;
    f32x16 a0, a1, c0, c1; bf16x8 pa0, pa1, pa2, pa3;
#define HALF1(Kb) do { \
        f32x16 init; { float nmv = nm; asm volatile("" : "+v"(nmv)); _Pragma("unroll") for (int r = 0; r < 16; ++r) init[r] = nmv; } \
        SBAR(); \
        _Pragma("unroll") for (int d0 = 0; d0 < ND0; ++d0) { const int cb = (d0 * 16 + hi * 8) * 2; \
            const bf16x8 k0 = *(const LAS bf16x8*)((Kb) + KSWZ2(r32, cb)), k1 = *(const LAS bf16x8*)((Kb) + KSWZ2(32 + r32, cb)), qv = *(const LAS bf16x8*)(QAL + d0 * 1024); \
            a0 = __builtin_amdgcn_mfma_f32_32x32x16_bf16(k0, qv, d0 == 0 ? init : a0, 0, 0, 0); \
            a1 = __builtin_amdgcn_mfma_f32_32x32x16_bf16(k1, qv, d0 == 0 ? init : a1, 0, 0, 0); } \
        SBAR(); \
        float sA = 0.f; \
        _Pragma("unroll") for (int d0 = 0; d0 < ND0; ++d0) { const int cb = (d0 * 16 + hi * 8) * 2; \
            const bf16x8 k0 = *(const LAS bf16x8*)((Kb) + KSWZ2(r32, cb)), k1 = *(const LAS bf16x8*)((Kb) + KSWZ2(32 + r32, cb)), qv = *(const LAS bf16x8*)(QBL + d0 * 1024); \
            c0 = __builtin_amdgcn_mfma_f32_32x32x16_bf16(k0, qv, d0 == 0 ? init : c0, 0, 0, 0); \
            if (d0 == 3) { EXP4(a0, 0); EXP4(a0, 4); } \
            if (d0 == 4) { EXP4(a0, 12); SUM4(sA, a0, 0); SUM4(sA, a0, 4); EXP4(a1, 0); } \
            if (d0 == 5) { EXP4(a1, 8); SUM4(sA, a1, 0); SUM4(sA, a1, 4); } \
            c1 = __builtin_amdgcn_mfma_f32_32x32x16_bf16(k1, qv, d0 == 0 ? init : c1, 0, 0, 0); \
            if (d0 == 3) { EXP4(a0, 8); } \
            if (d0 == 4) { EXP4(a1, 4); SUM4(sA, a0, 8); SUM4(sA, a0, 12); } \
            if (d0 == 5) { EXP4(a1, 12); SUM4(sA, a1, 8); SUM4(sA, a1, 12); } \
            if (d0 >= 2) SBAR(); } \
        lA += sA; \
        PK4X(a0, 0, pa0); PK4X(a0, 8, pa1); PK4X(a1, 0, pa2); PK4X(a1, 8, pa3); \
        SBAR(); } while (0)
#define HALF2(vbase) do { \
        float sB = 0.f; s16x4 va[8], vb_[8]; \
        VRD8(va, vbase, 0); VRD8(vb_, vbase, 1); \
        oA[0] = __builtin_amdgcn_mfma_f32_32x32x16_bf16(pa0, PKV(va, 0), oA[0], 0, 0, 0); SBAR(); \
        oA[1] = __builtin_amdgcn_mfma_f32_32x32x16_bf16(pa0, PKV(vb_, 0), oA[1], 0, 0, 0); EXP4(c0, 0); EXP4(c0, 4); SBAR(); \
        oA[0] = __builtin_amdgcn_mfma_f32_32x32x16_bf16(pa1, PKV(va, 1), oA[0], 0, 0, 0); EXP4(c0, 8); EXP4(c0, 12); SUM4(sB, c0, 0); SBAR(); \
        oA[1] = __builtin_amdgcn_mfma_f32_32x32x16_bf16(pa1, PKV(vb_, 1), oA[1], 0, 0, 0); EXP4(c1, 0); SUM4(sB, c0, 4); SUM4(sB, c0, 8); SBAR(); \
        oA[0] = __builtin_amdgcn_mfma_f32_32x32x16_bf16(pa2, PKV(va, 2), oA[0], 0, 0, 0); EXP4(c1, 4); SUM4(sB, c0, 12); SBAR(); \
        oA[1] = __builtin_amdgcn_mfma_f32_32x32x16_bf16(pa2, PKV(vb_, 2), oA[1], 0, 0, 0); EXP4(c1, 8); SUM4(sB, c1, 0); SBAR(); \
        oA[0] = __builtin_amdgcn_mfma_f32_32x32x16_bf16(pa3, PKV(va, 3), oA[0], 0, 0, 0); EXP4(c1, 12); SUM4(sB, c1, 4); SBAR(); \
        oA[1] = __builtin_amdgcn_mfma_f32_32x32x16_bf16(pa3, PKV(vb_, 3), oA[1], 0, 0, 0); SUM4(sB, c1, 8); SUM4(sB, c1, 12); SBAR(); \
        lB += sB; \
        PK4X(c0, 0, pa0); PK4X(c0, 8, pa1); PK4X(c1, 0, pa2); PK4X(c1, 8, pa3); \
        SBAR(); \
        VRD8(va, vbase, 0); VRD8(vb_, vbase, 1);                       \
        oB[0] = __builtin_amdgcn_mfma_f32_32x32x16_bf16(pa0, PKV(va, 0), oB[0], 0, 0, 0); \
        oB[1] = __builtin_amdgcn_mfma_f32_32x32x16_bf16(pa0, PKV(vb_, 0), oB[1], 0, 0, 0); \
        oB[0] = __builtin_amdgcn_mfma_f32_32x32x16_bf16(pa1, PKV(va, 1), oB[0], 0, 0, 0); \
        oB[1] = __builtin_amdgcn_mfma_f32_32x32x16_bf16(pa1, PKV(vb_, 1), oB[1], 0, 0, 0); \
        oB[0] = __builtin_amdgcn_mfma_f32_32x32x16_bf16(pa2, PKV(va, 2), oB[0], 0, 0, 0); \
        oB[1] = __builtin_amdgcn_mfma_f32_32x32x16_bf16(pa2, PKV(vb_, 2), oB[1], 0, 0, 0); \
        oB[0] = __builtin_amdgcn_mfma_f32_32x32x16_bf16(pa3, PKV(va, 3), oB[0], 0, 0, 0); \
        oB[1] = __builtin_amdgcn_mfma_f32_32x32x16_bf16(pa3, PKV(vb_, 3), oB[1], 0, 0, 0); \
        SBAR(); } while (0)
#define TILE_BAR() do { asm volatile("s_waitcnt vmcnt(0)" ::: "memory"); __syncthreads(); } while (0)
    DMA2(0, 0, 0);
    if (wid < 4) {
        int vs = 0;
#pragma unroll 1
        for (int t = 0; t < NT; ++t) { TILE_BAR();
            const int vn = vs == 2 ? 0 : vs + 1; if (t + 1 < NT) DMA2(t + 1, (t + 1) & 1, vn);
            HALF1(K_lds + (t & 1) * SHM_K); HALF2(vrd0 + vs * SHM_V); vs = vn; }
        TILE_BAR();
    } else {
        __builtin_amdgcn_s_setprio(1);
        TILE_BAR(); if (1 < NT) DMA2(1, 1, 1);
        HALF1(K_lds);
        int vs = 0;
#pragma unroll 1
        for (int t = 1; t < NT; ++t) { TILE_BAR();
            const int vn = vs == 2 ? 0 : vs + 1; const int vnn = vn == 2 ? 0 : vn + 1; if (t + 1 < NT) DMA2(t + 1, (t + 1) & 1, vnn);
            HALF2(vrd0 + vs * SHM_V); HALF1(K_lds + (t & 1) * SHM_K); vs = vn; }
        TILE_BAR();
        HALF2(vrd0 + vs * SHM_V);
        __builtin_amdgcn_s_setprio(0);
    }
#undef HALF1
#undef HALF2
#undef TILE_BAR
    { auto rr = __builtin_amdgcn_permlane32_swap(__float_as_uint(lA), __float_as_uint(lA), false, false); lA = __uint_as_float(rr[0]) + __uint_as_float(rr[1]); }
    { auto rr = __builtin_amdgcn_permlane32_swap(__float_as_uint(lB), __float_as_uint(lB), false, false); lB = __uint_as_float(rr[0]) + __uint_as_float(rr[1]); }
    if (hi == 0) { ws[r32] = lA; ws[32 + r32] = lB; } asm volatile("s_waitcnt lgkmcnt(0)" ::: "memory");
    bf16* Ow = Ob + (long)(wid * 64) * ldo;
#pragma unroll
    for (int r = 0; r < 16; ++r) { const int orow = crow(r, hi); const float ra = __builtin_amdgcn_rcpf(ws[orow]), rb = __builtin_amdgcn_rcpf(ws[32 + orow]);
#pragma unroll
        for (int d0 = 0; d0 < NB; ++d0) { Ow[(long)orow * ldo + d0 * 32 + r32] = f2bf(oA[d0][r] * ra); Ow[(long)(32 + orow) * ldo + d0 * 32 + r32] = f2bf(oB[d0][r] * rb); } }
    __syncthreads();
#undef DMA2
#undef VRD8
#undef PKV
}
#undef EXP4
#undef SUM4
#undef PK4X

__device__ __forceinline__ void spatial_unit(int chunk, int g, const bf16* __restrict__ U, const bf16* __restrict__ VR, const float* __restrict__ vstat, const float* __restrict__ g_sg,
                                             const bf16* __restrict__ Wsb, const float* __restrict__ b_s, bf16* __restrict__ Y, LAS char* lds) {
    int tid_ = threadIdx.x; asm volatile("" : "+v"(tid_));
    const int tid = tid_, wid = tid >> 6, lane = tid & 63, r32 = lane & 31, hi = lane >> 5, rb = wid & 3, ch = wid >> 2;
    LAS char* V_lds = lds; LAS float* rv = (LAS float*)(lds + 32768);
    const int row0 = chunk * 128;
    if (tid < 128) { const f32x4 s0 = *(const f32x4*)(vstat + (size_t)(row0 + tid) * 8), s1 = *(const f32x4*)(vstat + (size_t)(row0 + tid) * 8 + 4);
        rv[tid] = __builtin_amdgcn_rsqf(((s0[0] + s0[1]) + (s0[2] + s0[3]) + (s1[0] + s1[1]) + (s1[2] + s1[3])) * (1.f / 512.f) + EPS); }
    __syncthreads();
#pragma unroll
    for (int i = 0; i < 4; ++i) { const int c = tid + 512 * i, row = c >> 4, cc = c & 15;
        const u32x4 w = *(const u32x4*)(VR + (size_t)(row0 + row) * 512 + g * 128 + cc * 8); f32x4 a, b; unpack8(w, a, b);
        const f32x4 g0 = *(const f32x4*)(g_sg + g * 128 + cc * 8), g1 = *(const f32x4*)(g_sg + g * 128 + cc * 8 + 4); const float r = rv[row];
        *(LAS u32x4*)(V_lds + (row >> 6) * 16384 + v_st<4>(row & 63, cc * 8)) = pack8(a * r * g0, b * r * g1); }
    bf16x8 pa[8];
#pragma unroll
    for (int ks = 0; ks < 8; ++ks) pa[ks] = *(const bf16x8*)(Wsb + (size_t)g * 16384 + (size_t)(32 * rb + r32) * 128 + 16 * ks + 8 * hi);
    __syncthreads();
    f32x16 o[2]; o[0] = f32x16{}; o[1] = f32x16{};
    const int vb = (int)(uintptr_t)V_lds + v_rd_base(lane) + (2 * ch) * 512;
    pv_one<4, 0>(o[0], vb, pa[0], pa[1], pa[2], pa[3]); pv_one<4, 1>(o[1], vb, pa[0], pa[1], pa[2], pa[3]);
    pv_one<4, 0>(o[0], vb + 16384, pa[4], pa[5], pa[6], pa[7]); pv_one<4, 1>(o[1], vb + 16384, pa[4], pa[5], pa[6], pa[7]);
#pragma unroll
    for (int r = 0; r < 16; ++r) { const int i = 32 * rb + crow(r, hi); const float bias = b_s[g * 128 + i]; const size_t row = (size_t)(row0 + i);
#pragma unroll
        for (int dd = 0; dd < 2; ++dd) { const int c = g * 128 + 64 * ch + 32 * dd + r32; const float uu = bf2f(U[row * 512 + c]);
            Y[row * 1536 + 512 + c] = f2bf(uu * (o[dd][r] + bias)); } }
    __syncthreads();
}
#undef KSWZ
#undef SBAR
}

#define XB_TMO      128
#define XB_XCNT(j)  (256  + 64 * (j))
#define XB_XSUB(j)  (1280 + 64 * (j))
#define XB_XGEN(j)  (2304 + 64 * (j))
#define XB_TOP      3328
#define XB_TOPGEN   3392
#define XCD_BAR_WORDS 3456
#define XB_SPIN_CAP (1u << 18)
__device__ __forceinline__ unsigned xb_ld(unsigned* p)              { return __hip_atomic_load((GAS unsigned*)p, __ATOMIC_RELAXED, __HIP_MEMORY_SCOPE_AGENT); }
__device__ __forceinline__ unsigned xb_add(unsigned* p, unsigned v) { return __hip_atomic_fetch_add((GAS unsigned*)p, v, __ATOMIC_RELAXED, __HIP_MEMORY_SCOPE_AGENT); }
__device__ __forceinline__ unsigned xb_xcc_id() { return (unsigned)__builtin_amdgcn_s_getreg((3 << 11) | 20) & 0xFu; }
#define XB_SPIN(cond, bar) do { unsigned _sp = 0; while (cond) { __builtin_amdgcn_s_sleep(1); \
    if ((++_sp & 255u) == 0u) { if (xb_ld(&(bar)[XB_TMO])) break; if (_sp > XB_SPIN_CAP) { xb_add(&(bar)[XB_TMO], 1u); break; } } } } while (0)
struct XcdBarrier { unsigned* bar; unsigned x; volatile LAS unsigned* st; };
__device__ __forceinline__ XcdBarrier xcd_barrier_post(unsigned* bar, volatile LAS unsigned* st) {
    XcdBarrier b; b.bar = bar; b.x = (unsigned)__builtin_amdgcn_readfirstlane((int)xb_xcc_id()); b.st = st;
    if (threadIdx.x == 0) (void)xb_add(&bar[XB_XCNT(b.x)], 1u);
    return b;
}
__device__ __forceinline__ void xcd_barrier_complete(unsigned* bar, unsigned x, unsigned& nloc, unsigned& nx) {
    const unsigned G = gridDim.x * gridDim.y * gridDim.z;
    unsigned sum, cnt, mine, sp = 0u;
    for (;;) {
        sum = 0u; cnt = 0u; mine = 0u;
#pragma unroll
        for (unsigned j = 0; j < 16; ++j) { const unsigned c = xb_ld(&bar[XB_XCNT(j)]); sum += c; cnt += (c > 0u) ? 1u : 0u; mine = (j == x) ? c : mine; }
        if (sum == G) break;
        __builtin_amdgcn_s_sleep(1);
        if ((++sp & 255u) == 0u) { if (xb_ld(&bar[XB_TMO])) break; if (sp > XB_SPIN_CAP) { xb_add(&bar[XB_TMO], 1u); break; } }
    }
    nloc = mine > 0u ? mine : 1u; nx = cnt > 0u ? cnt : 1u;
}
__device__ __forceinline__ void xcd_barrier(const XcdBarrier& b) {
    asm volatile("s_waitcnt vmcnt(0)" ::: "memory");
    __syncthreads();
    if (threadIdx.x == 0) {
        unsigned* bar = b.bar; unsigned bx = b.x; asm volatile("" : "+s"(bar), "+s"(bx));
        __builtin_amdgcn_s_waitcnt(0);
        unsigned nloc = b.st[0], nx = b.st[1];
        if (nloc == 0u) { xcd_barrier_complete(bar, bx, nloc, nx); b.st[0] = nloc; b.st[1] = nx; }
        const unsigned old = xb_add(&bar[XB_XSUB(bx)], 1u);
        const unsigned gen = old / nloc;
        if (old + 1u == (gen + 1u) * nloc) {
            __builtin_amdgcn_fence(__ATOMIC_RELEASE, "agent");
            asm volatile("s_waitcnt vmcnt(0)" ::: "memory");
            const unsigned og = xb_add(&bar[XB_TOP], 1u);
            const unsigned tg = og / nx;
            if (og + 1u == (tg + 1u) * nx) xb_add(&bar[XB_TOPGEN], 1u);
            else XB_SPIN(xb_ld(&bar[XB_TOPGEN]) == tg, bar);
            __builtin_amdgcn_fence(__ATOMIC_ACQUIRE, "agent");
            xb_add(&bar[XB_XGEN(bx)], 1u);
            asm volatile("s_waitcnt vmcnt(0)" ::: "memory");
        } else {
            XB_SPIN(xb_ld(&bar[XB_XGEN(bx)]) == gen, bar);
            __builtin_amdgcn_fence(__ATOMIC_ACQUIRE, "agent");
            asm volatile("s_waitcnt vmcnt(0)" ::: "memory");
        }
    }
    __syncthreads();
}

enum { CV_NAT = 0, CV_WIN = 1, CV_WUQ = 2, CV_W13 = 3 };
__device__ __forceinline__ int ropeperm(int p) { return ((p >> 2) & 1) * 16 + 4 * (p >> 3) + (p & 3); }
__device__ __forceinline__ int cv_map(int kind, int G, int& which, float& scale, bool& perm) {
    which = 0; scale = 1.f; perm = false; const int n = G * 32;
    if (kind == CV_WIN) {
        if (n < 384) return n;
        if (n < 416) { perm = true; return 640; }
        if (n < 512) return -1;
        if (n < 768) return 384 + (n - 512);
        if (n < 1280) return 672 + (n - 768);
        if (n < 1792) return 1184 + (n - 1280);
        if (n < 2304) { scale = XSCALE; return 1696 + (n - 1792); }
        return 2208 + (n - 2304);
    }
    if (kind == CV_WUQ) { scale = QSCALE; perm = (G % 3) == 2; return n; }
    if (kind == CV_W13) { which = (n >> 7) & 1; return 128 * (n >> 8) + (n & 127); }
    return n;
}
struct CvDesc { const float* src; const float* src2; const float* gain; bf16* dst; int K, Nsrc, Nout, kind; };
__device__ __forceinline__ void cv_item(const CvDesc& d, int item, LAS char* tile, int lane) {
    const int nI = d.Nout >> 7, kb = item / nI, nb = item - kb * nI, k0 = 64 * kb, n0 = 128 * nb;
    const int nq = lane & 31, kh = lane >> 5;
    const int nout = n0 + 4 * nq, G = nout >> 5, p = nout & 31;
    int which; float scale; bool perm; const int sc = cv_map(d.kind, G, which, scale, perm);
    const bool zero = sc < 0;
    const float* W = d.src + (ptrdiff_t)which * (d.src2 - d.src) + (size_t)k0 * d.Nsrc + (zero ? 0 : sc + (perm ? ropeperm(p) : p));
#pragma unroll
    for (int half = 0; half < 2; ++half) {
        f32x4 v[16];
#pragma unroll
        for (int i = 0; i < 16; ++i) { const int k = 32 * half + 2 * i + kh; v[i] = zero ? (f32x4){0.f, 0.f, 0.f, 0.f} : *(const f32x4*)(W + (size_t)k * d.Nsrc); }
#pragma unroll
        for (int i = 0; i < 16; ++i) { const int k = 32 * half + 2 * i + kh; const float g = d.gain ? d.gain[k0 + k] * scale : scale; const f32x4 w = v[i] * g;
            *(LAS u32x2*)(tile + att::v_st<4>(k, 4 * nq)) = (u32x2){cvt_pk_bf16(w[0], w[1]), cvt_pk_bf16(w[2], w[3])}; }
    }
    LDS_WAIT(); asm volatile("" ::: "memory");
    const int vb = (int)(uintptr_t)tile + att::v_rd_base(lane);
    bf16* drow = d.dst + (size_t)(n0 >> 8) * 256 * d.K + (size_t)kb * (256 * 64) + (size_t)((n0 & 255) + nq) * 64 + 8 * kh;
#define CV_RD(D0, KS) { const s16x4 l_ = att::tr_read<((2 * KS) * 4 + D0) * 512>(vb), h_ = att::tr_read<((2 * KS + 1) * 4 + D0) * 512>(vb); \
        asm volatile("s_waitcnt lgkmcnt(0)" ::: "memory"); __builtin_amdgcn_sched_barrier(0); \
        *(bf16x8*)(drow + (32 * D0) * 64 + 16 * KS) = (bf16x8){l_[0], l_[1], l_[2], l_[3], h_[0], h_[1], h_[2], h_[3]}; }
#define CV_RD4(D0) CV_RD(D0, 0) CV_RD(D0, 1) CV_RD(D0, 2) CV_RD(D0, 3)
    CV_RD4(0) CV_RD4(1) CV_RD4(2) CV_RD4(3)
#undef CV_RD4
#undef CV_RD
    LDS_WAIT(); asm volatile("" ::: "memory");
}

struct Args {
    const float* x; const float* mem; const int* positions; const float* g_mix; const float* w_in; const float* g_q; const float* g_kv; const float* w_uq; const float* w_uk; const float* w_uv;
    const float* g_sg; const float* w_s; const float* b_s; const float* g_mem; const float* w_mkv; const float* w_br; const float* b_gate; const float* w_out; const float* g_ffn;
    const float* dense_w1; const float* dense_w3; const float* dense_w2; const float* w_router; const float* moe_w1; const float* moe_w3; const float* moe_w2; const float* g_final;
    float* out; unsigned char* ws; int dbg; int pad;
};
typedef const __attribute__((address_space(4))) Args* ArgsP;
#define FRESH(ap) ArgsP ap = kargs; asm volatile("" : "+s"(ap))
__constant__ double INVF[16] = { 1.0, 0.5623413251903491, 0.31622776601683794, 0.1778279410038923, 0.1, 0.05623413251903491, 0.03162277660168379, 0.01778279410038923,
                                 0.01, 0.005623413251903491, 0.003162277660168379, 0.001778279410038923, 0.001, 0.0005623413251903491, 0.00031622776601683794, 0.0001778279410038923 };

struct Frame { LAS unsigned char* lds; int G, NGW, bid; };
#define LOCAL_IDS int tid = threadIdx.x; asm volatile("" : "+v"(tid)); const int lane = tid & 63, wave = __builtin_amdgcn_readfirstlane(tid >> 6), gw = F.bid * NWAVES + wave; (void)lane; (void)gw

__device__ __forceinline__ void conv_run(const Frame& F, const CvDesc& d) {
    LOCAL_IDS;
    LAS char* tile = (LAS char*)(F.lds + wave * 16384);
    const int nitems = (d.K / 64) * (d.Nout / 128);
    for (int it = gw; it < nitems; it += F.NGW) cv_item(d, it, tile, lane);
}
__device__ __forceinline__ void rx_from_stats(const Frame& F, ArgsP kargs) {
    LOCAL_IDS; FRESH(ap); const float* xstat = (const float*)(ap->ws + WS_XSTAT); float* rx = (float*)(ap->ws + WS_RX);
    for (int row = F.bid * 512 + tid; row < M; row += F.G * 512) {
        const f32x4* p = (const f32x4*)(xstat + (size_t)row * 16); const f32x4 a = p[0], b = p[1], c = p[2], d = p[3];
        const float s = ((a[0] + a[1]) + (a[2] + a[3])) + ((b[0] + b[1]) + (b[2] + b[3])) + ((c[0] + c[1]) + (c[2] + c[3])) + ((d[0] + d[1]) + (d[2] + d[3]));
        rx[row] = __builtin_amdgcn_rsqf(s * (1.f / D) + EPS);
    }
}
template <int MODE>
__device__ __forceinline__ void conv_flat(const Frame& F, ArgsP kargs, int l, int j2, int lmix) {
    int tid_ = threadIdx.x; asm volatile("" : "+v"(tid_)); const int lane_ = tid_ & 63, wave_ = __builtin_amdgcn_readfirstlane(tid_ >> 6);
    LAS char* tile = (LAS char*)(F.lds + wave_ * 16384);
    constexpr int I13D = (D / 64) * (2 * DFF / 128), I2D = (DFF / 64) * (D / 128), I13 = (D / 64) * (2 * DFE / 128), I2 = (DFE / 64) * (D / 128), IE = I13 + I2, IMKV = (D / 64) * (D / 128);
    constexpr int NB_ = MODE == 0 ? DEPTH * IMKV : MODE == 1 ? I13D + I2D : NE * IE;
    constexpr int M_IN = (D / 64) * (PPAD / 128), M_UQ = (QRANK / 64) * (768 / 128), M_UK = (KVRANK / 64) * (512 / 128), M_BR = (BW / 64) * (D / 128), M_OUT = (D / 64) * (D / 128);
    constexpr int O_UQ = M_IN, O_UK = O_UQ + M_UQ, O_UV = O_UK + M_UK, O_BR = O_UV + M_UK, O_OUT = O_BR + 3 * M_BR, NMIX = O_OUT + M_OUT;
    const int total = NB_ + ((lmix >= 0 && lmix < DEPTH) ? NMIX : 0);
#pragma unroll 1
    for (int idx = wave_ * F.G + F.bid; idx < total; idx += F.NGW) { FRESH(a); CvDesc d; int it;
        if (idx < NB_) {
            if constexpr (MODE == 0) { const int lq = idx / IMKV; it = idx - lq * IMKV; d = CvDesc{a->w_mkv + (size_t)lq * D * D, nullptr, nullptr, (bf16*)(a->ws + WS_WMKVT) + (size_t)lq * D * D, D, D, D, CV_NAT}; }
            else if constexpr (MODE == 1) {
                if (idx < I13D) { it = idx; d = CvDesc{a->dense_w1 + (size_t)j2 * D * DFF, a->dense_w3 + (size_t)j2 * D * DFF, a->g_ffn + l * D, (bf16*)(a->ws + WS_WFFN), D, DFF, 2 * DFF, CV_W13}; }
                else { it = idx - I13D; d = CvDesc{a->dense_w2 + (size_t)j2 * DFF * D, nullptr, nullptr, (bf16*)(a->ws + WS_W2D), DFF, D, D, CV_NAT}; } }
            else { const int e = idx / IE, r = idx - e * IE;
                if (r < I13) { it = r; d = CvDesc{a->moe_w1 + ((size_t)j2 * NE + e) * D * DFE, a->moe_w3 + ((size_t)j2 * NE + e) * D * DFE, a->g_ffn + l * D, (bf16*)(a->ws + WS_WFFN) + (size_t)e * 2 * DFE * D, D, DFE, 2 * DFE, CV_W13}; }
                else { it = r - I13; d = CvDesc{a->moe_w2 + ((size_t)j2 * NE + e) * DFE * D, nullptr, nullptr, (bf16*)(a->ws + WS_W2M) + (size_t)e * D * DFE, DFE, D, D, CV_NAT}; } }
        } else { const int r = idx - NB_;
            if (r < O_UQ) { it = r; d = CvDesc{a->w_in + (size_t)lmix * D * PTOT, nullptr, a->g_mix + lmix * D, (bf16*)(a->ws + WS_WINT), D, PTOT, PPAD, CV_WIN}; }
            else if (r < O_UK) { it = r - O_UQ; d = CvDesc{a->w_uq + (size_t)lmix * QRANK * 768, nullptr, a->g_q + lmix * QRANK, (bf16*)(a->ws + WS_WUQT), QRANK, 768, 768, CV_WUQ}; }
            else if (r < O_UV) { it = r - O_UK; d = CvDesc{a->w_uk + (size_t)lmix * KVRANK * 512, nullptr, a->g_kv + lmix * KVRANK, (bf16*)(a->ws + WS_WUKVT), KVRANK, 512, 512, CV_NAT}; }
            else if (r < O_BR) { it = r - O_UV; d = CvDesc{a->w_uv + (size_t)lmix * KVRANK * 512, nullptr, a->g_kv + lmix * KVRANK, (bf16*)(a->ws + WS_WUKVT) + 512 * KVRANK, KVRANK, 512, 512, CV_NAT}; }
            else if (r < O_OUT) { const int n = (r - O_BR) / M_BR; it = (r - O_BR) - n * M_BR; d = CvDesc{a->w_br + ((size_t)lmix * 3 + n) * BW * D, nullptr, nullptr, (bf16*)(a->ws + WS_WBRT) + (size_t)n * D * BW, BW, D, D, CV_NAT}; }
            else { it = r - O_OUT; d = CvDesc{a->w_out + (size_t)lmix * D * D, nullptr, nullptr, (bf16*)(a->ws + WS_WOUTT), D, D, D, CV_NAT}; } }
        cv_item(d, it, tile, lane_); }
    if (lmix >= 0 && lmix < DEPTH) {
        FRESH(a); const float* wsrc = a->w_s + (size_t)lmix * 65536; bf16* wdst = (bf16*)(a->ws + WS_WSB);
        for (int i = F.bid * 512 + tid_; i < 4 * 128 * 128 / 4; i += F.G * 512) { const f32x4 v = *(const f32x4*)(wsrc + (size_t)i * 4);
            *(u32x2*)(wdst + (size_t)i * 4) = (u32x2){cvt_pk_bf16(v[0], v[1]), cvt_pk_bf16(v[2], v[3])}; } }
}
__device__ __forceinline__ void phase_prologue(const Frame& F, ArgsP kargs) {
    LOCAL_IDS;
    { FRESH(a); float* ROPE = (float*)(a->ws + WS_ROPE); const int* pos = a->positions;
      for (int idx = F.bid * 512 + tid; idx < M * 16; idx += F.G * 512) { const int row = idx >> 4, i = idx & 15;
        const double t = (double)pos[row] * INVF[i] * 0.15915494309189535; const float fr = (float)(t - rint(t));
        ROPE[(size_t)row * 32 + i] = __builtin_amdgcn_cosf(fr); ROPE[(size_t)row * 32 + 16 + i] = __builtin_amdgcn_sinf(fr); } }
    { FRESH(a); const float* xin = a->x; float* X = a->out; bf16* XB = (bf16*)(a->ws + WS_XB); float* RX = (float*)(a->ws + WS_RX);
      for (int m = gw; m < M; m += F.NGW) { const f32x4* xr = (const f32x4*)(xin + (size_t)m * D) + lane; f32x4 v[4]; float s = 0.f;
#pragma unroll
        for (int j = 0; j < 4; ++j) { v[j] = xr[64 * j]; s += sumsq4(v[j]); }
        s = wave_sum(s);
#pragma unroll
        for (int j = 0; j < 4; ++j) { ((f32x4*)(X + (size_t)m * D) + lane)[64 * j] = v[j]; ((u32x2*)(XB + (size_t)m * D) + lane)[64 * j] = (u32x2){cvt_pk_bf16(v[j][0], v[j][1]), cvt_pk_bf16(v[j][2], v[j][3])}; }
        if (lane == 0) RX[m] = __builtin_amdgcn_rsqf(s * (1.f / D) + EPS); } }
    { FRESH(a); const float* mem = a->mem; const float* g_mem = a->g_mem; bf16* MEMB = (bf16*)(a->ws + WS_MEMB);
      for (int m = gw; m < NMEM; m += F.NGW) { const f32x4* xr = (const f32x4*)(mem + (size_t)m * D) + lane; f32x4 v[4]; float s = 0.f;
#pragma unroll
        for (int j = 0; j < 4; ++j) { v[j] = xr[64 * j]; s += sumsq4(v[j]); }
        const float r = __builtin_amdgcn_rsqf(wave_sum(s) * (1.f / D) + EPS);
#pragma unroll
        for (int j = 0; j < 4; ++j) { const f32x4 g = ((const f32x4*)g_mem + lane)[64 * j]; const f32x4 w = v[j] * r * g;
            ((u32x2*)(MEMB + (size_t)m * D) + lane)[64 * j] = (u32x2){cvt_pk_bf16(w[0], w[1]), cvt_pk_bf16(w[2], w[3])}; } } }
    conv_flat<0>(F, kargs, 0, 0, 0);
}
__device__ __forceinline__ void phase_inproj(const Frame& F, ArgsP kargs, int l) {
    if (PH(1)) { FRESH(a); unsigned char* ws = a->ws;
        pg8::TileOrder S{M / 256, PPAD / 256 - 1, F.G, F.bid, (const char*)(ws + WS_XB), (const char*)(ws + WS_WINT), (size_t)256 * D * 2, (size_t)256 * D * 2};
#ifdef DBG_REV
        S.rev = 1;
#endif
        pg8::EpiInProj E{ws, a->b_gate + (size_t)l * 3 * D, l, (l & 1)};
        pg8::gemm_phase(F.lds, D, D, D, S, E); }
    if (l == 0 && PH(2)) { FRESH(a); unsigned char* ws = a->ws;
        struct MemOrder { enum { VARK = 0, GATHER = 0 }; int c; const char* A; const char* B;
            __device__ __forceinline__ bool next(int i, pg8::Unit& u) const { if (i > 0 || c < 240) return false; const int idx = c - 240; u.pm = 0; u.pn = idx & 3; u.aux = idx >> 2; u.A = A; u.B = B + (size_t)u.aux * D * D * 2 + (size_t)u.pn * 256 * D * 2; return true; } };
        MemOrder S2{F.bid, (const char*)(ws + WS_MEMB), (const char*)(ws + WS_WMKVT)}; pg8::EpiMemKV E2{(bf16*)(ws + WS_KVMEM)};
        pg8::gemm_phase(F.lds, D, D, D, S2, E2); }
}
struct GateTailOrder { enum { VARK = 0, GATHER = 0 }; int c; const char* A; const char* B;
    __device__ __forceinline__ bool next(int i, pg8::Unit& u) const { if (i > 0 || c < 192) return false; u.pm = c - 192; u.pn = PPAD / 256 - 1; u.aux = 0; u.A = A + (size_t)u.pm * 256 * D * 2; u.B = B + (size_t)u.pn * 256 * D * 2; return true; } };
__device__ __forceinline__ void phase_up(const Frame& F, ArgsP kargs, int l) {
    if (PH(1)) { FRESH(a); unsigned char* ws = a->ws;
        GateTailOrder S{F.bid, (const char*)(ws + WS_XB), (const char*)(ws + WS_WINT)}; pg8::EpiInProj E{ws, a->b_gate + (size_t)l * 3 * D, l, (l & 1)};
        pg8::gemm_phase(F.lds, D, D, D, S, E); }
    if (PH(3)) { FRESH(a); unsigned char* ws = a->ws;
        pg8::TileOrder S{M / 256, 3, F.G, F.bid, (const char*)(ws + WS_CQ), (const char*)(ws + WS_WUQT), (size_t)256 * 512 * 2, (size_t)256 * QRANK * 2};
        pg8::EpiQ E{(const float*)(ws + WS_CQSTAT), (const float*)(ws + WS_ROPE), (bf16*)(ws + WS_Q)}; pg8::gemm_phase(F.lds, 512, QRANK, QRANK, S, E); }
    if (PH(4)) { FRESH(a); unsigned char* ws = a->ws;
        pg8::TileOrder S{M / 256, 4, F.G, F.bid, (const char*)(ws + WS_CKV), (const char*)(ws + WS_WUKVT), (size_t)256 * KVRANK * 2, (size_t)256 * KVRANK * 2};
        pg8::EpiKV E{(const float*)(ws + WS_CKVSTAT), (bf16*)(ws + WS_KN), (bf16*)(ws + WS_V), (unsigned*)(ws + WS_CTL) + CW_KMAX + l * 32}; pg8::gemm_phase(F.lds, KVRANK, KVRANK, KVRANK, S, E); }
    if (PH(5)) { FRESH(a); unsigned char* ws = a->ws;
        for (int un = F.bid; un < 512; un += F.G)
            att::spatial_unit(un >> 2, un & 3, (const bf16*)(ws + WS_U), (const bf16*)(ws + WS_VR), (const float*)(ws + WS_VSTAT), a->g_sg + l * BW, (const bf16*)(ws + WS_WSB), a->b_s + l * 512, (bf16*)(ws + WS_Y), (LAS char*)F.lds); }
    if (PH(6)) { FRESH(a); unsigned char* ws = a->ws;
        for (int un = F.bid; un < 256; un += F.G) { const int h = un & 3, pm = un >> 2; const bf16* kvm = (const bf16*)(ws + WS_KVMEM) + (size_t)l * 256 * 1024;
            att::attn_unit<128, 128, 128, false>((const bf16*)(ws + WS_QX) + (size_t)pm * 256 * 512 + h * 128, 512, kvm + h * 128, 1024, kvm, 1024, kvm + 512 + h * 128, 1024,
                                          (bf16*)(ws + WS_Y) + (size_t)pm * 256 * 1536 + 1024 + h * 128, 1536, NMEM, (LAS char*)F.lds, 0.f); } }
}
__device__ __forceinline__ void phase_attn(const Frame& F, ArgsP kargs, int l) {
    if (PH(7)) { FRESH(a); unsigned char* ws = a->ws;
        for (int un = F.bid; un < 256; un += F.G) { const int h = un & 7, qb = un >> 3;
            const unsigned* km = (const unsigned*)(ws + WS_CTL) + CW_KMAX + l * 32;
            const float kbound = sqrtf(__uint_as_float(km[2 * h]) + __uint_as_float(km[2 * h + 1]) + __uint_as_float(km[16])) * 1.02f;
            att::attn_unit2<96, 64, 64>((const bf16*)(ws + WS_Q) + (size_t)qb * 512 * 768 + h * 96, 768, (const bf16*)(ws + WS_KN) + h * 64, 512, (const bf16*)(ws + WS_KR), 32, (const bf16*)(ws + WS_V) + h * 64, 512,
                                        (bf16*)(ws + WS_Y) + (size_t)qb * 512 * 1536 + h * 64, 1536, M, (LAS char*)F.lds, kbound); } }
}
__device__ __forceinline__ void phase_branch(const Frame& F, ArgsP kargs) {
    if (PH(8)) { FRESH(a); unsigned char* ws = a->ws;
        struct BranchOrder { enum { VARK = 0, GATHER = 0 }; int c; const char* A; const char* B;
            __device__ __forceinline__ bool next(int i, pg8::Unit& u) const { if (i >= 3 || c >= 256) return false; int pm, pn; pg8::tile_of(c, 64, 4, pm, pn); u.pm = pm; u.pn = pn; u.aux = i;
                u.A = A + (size_t)pm * 256 * 1536 * 2 + (size_t)i * 512 * 2; u.B = B + (size_t)i * D * BW * 2 + (size_t)pn * 256 * BW * 2; return true; } };
        BranchOrder S{F.bid, (const char*)(ws + WS_Y), (const char*)(ws + WS_WBRT)}; pg8::EpiBranch E{(const unsigned char*)(ws + WS_GATE), (bf16*)(ws + WS_MIXB)};
        pg8::gemm_phase(F.lds, 1536, BW, BW, S, E); }
}
__device__ __forceinline__ void phase_outproj(const Frame& F, ArgsP kargs, bool dummy = false) {
    if (PH(9)) { FRESH(a); unsigned char* ws = a->ws;
        pg8::TileOrder S{M / 256, 4, F.G, F.bid, (const char*)(ws + WS_MIXB), (const char*)(ws + WS_WOUTT), (size_t)256 * D * 2, (size_t)256 * D * 2};
        pg8::EpiResid E{a->out, dummy ? (float*)(ws + 700 * MiB) : a->out, (bf16*)(ws + (dummy ? 764 * MiB : WS_XB)), (float*)(ws + (dummy ? 796 * MiB : WS_XSTAT))}; pg8::gemm_phase(F.lds, 0, D, D, S, E); }
}
__device__ __forceinline__ void phase_dense_conv(const Frame& F, ArgsP kargs, int l, int j2) {
    rx_from_stats(F, kargs);
    conv_flat<1>(F, kargs, l, j2, l + 1);
}
__device__ __forceinline__ void phase_dense_up(const Frame& F, ArgsP kargs) {
    if (PH(10)) { FRESH(a); unsigned char* ws = a->ws;
        pg8::TileOrder S{M / 256, 2 * DFF / 256, F.G, F.bid, (const char*)(ws + WS_XB), (const char*)(ws + WS_WFFN), (size_t)256 * D * 2, (size_t)256 * D * 2};
        pg8::EpiSwiGLU E{(const float*)(ws + WS_RX), (bf16*)(ws + WS_HFF), DFF, 0}; pg8::gemm_phase(F.lds, D, D, D, S, E); }
}
__device__ __forceinline__ void phase_dense_down(const Frame& F, ArgsP kargs, bool dummy = false) {
    if (PH(11)) { FRESH(a); unsigned char* ws = a->ws;
        pg8::TileOrder S{M / 256, 4, F.G, F.bid, (const char*)(ws + WS_HFF), (const char*)(ws + WS_W2D), (size_t)256 * DFF * 2, (size_t)256 * DFF * 2};
        pg8::EpiResid E{a->out, dummy ? (float*)(ws + 700 * MiB) : a->out, (bf16*)(ws + (dummy ? 764 * MiB : WS_XB)), (float*)(ws + (dummy ? 796 * MiB : WS_XSTAT))}; pg8::gemm_phase(F.lds, 0, DFF, DFF, S, E); }
}
__device__ __forceinline__ void phase_moe_route(const Frame& F, ArgsP kargs, int l, int j2) {
    conv_flat<2>(F, kargs, l, j2, l + 1 < DEPTH ? l + 1 : -1);
    __syncthreads();
    LOCAL_IDS; FRESH(a); unsigned char* ws = a->ws; const float* X = a->out;
    float* RX = (float*)(ws + WS_RX); int* TOPI = (int*)(ws + WS_TOPI); float* TOPW = (float*)(ws + WS_TOPW); int* LRANK = (int*)(ws + WS_LRANK); int* BLKCNT = (int*)(ws + WS_BLKCNT);
    LAS int* tope = (LAS int*)(F.lds + 0);
    const float* wr = a->w_router + (size_t)j2 * D * NE; const float* gf = a->g_ffn + l * D;
    f32x4 gvA[4], wA[4][4][2], xn[4];
#pragma unroll
    for (int j = 0; j < 4; ++j) { const int k0 = 4 * lane + 256 * j; gvA[j] = *(const f32x4*)(gf + k0);
#pragma unroll
        for (int q = 0; q < 4; ++q) { wA[j][q][0] = *(const f32x4*)(wr + (size_t)(k0 + q) * 8); wA[j][q][1] = *(const f32x4*)(wr + (size_t)(k0 + q) * 8 + 4); } }
#pragma unroll
    for (int j = 0; j < 4; ++j) xn[j] = *(const f32x4*)(X + (size_t)(F.bid * 64 + wave * 8) * D + 4 * lane + 256 * j);
#pragma unroll 1
    for (int i = 0; i < 8; ++i) { const int rib = wave * 8 + i, row = F.bid * 64 + rib;
        float lg[8]; float ss = 0.f; f32x4 xc[4];
#pragma unroll
        for (int e = 0; e < 8; ++e) lg[e] = 0.f;
#pragma unroll
        for (int j = 0; j < 4; ++j) xc[j] = xn[j];
        if (i + 1 < 8) {
#pragma unroll
            for (int j = 0; j < 4; ++j) xn[j] = *(const f32x4*)(X + (size_t)(row + 1) * D + 4 * lane + 256 * j); }
#pragma unroll
        for (int j = 0; j < 4; ++j) { const f32x4 xv = xc[j], gv = gvA[j]; ss += sumsq4(xv);
#pragma unroll
            for (int q = 0; q < 4; ++q) { const float hv = xv[q] * gv[q]; const f32x4 w0 = wA[j][q][0], w1 = wA[j][q][1];
                lg[0] += hv * w0[0]; lg[1] += hv * w0[1]; lg[2] += hv * w0[2]; lg[3] += hv * w0[3]; lg[4] += hv * w1[0]; lg[5] += hv * w1[1]; lg[6] += hv * w1[2]; lg[7] += hv * w1[3]; } }
        const float r = __builtin_amdgcn_rsqf(wave_sum(ss) * (1.f / D) + EPS);
#pragma unroll
        for (int e = 0; e < 8; ++e) lg[e] = wave_sum(lg[e]) * r;
        int e0 = 0; float v0 = lg[0];
#pragma unroll
        for (int e = 1; e < 8; ++e) if (lg[e] > v0) { v0 = lg[e]; e0 = e; }
        int e1 = e0 == 0 ? 1 : 0; float v1 = -3.0e38f;
#pragma unroll
        for (int e = 0; e < 8; ++e) if (e != e0 && lg[e] > v1) { v1 = lg[e]; e1 = e; }
        const float w0 = 1.f / (1.f + expf(v1 - v0));
        if (lane == 0) { RX[row] = r; TOPI[row] = e0 | (e1 << 8); TOPW[(size_t)row * 2] = w0; TOPW[(size_t)row * 2 + 1] = 1.f - w0; tope[rib] = e0 | (e1 << 8); } }
    __syncthreads();
    if (wave == 0) { const int te = tope[lane], e0 = te & 255, e1 = te >> 8, row = F.bid * 64 + lane; const unsigned long long below = (1ull << lane) - 1ull;
        int rk0 = 0, rk1 = 0;
#pragma unroll
        for (int e = 0; e < 8; ++e) { const unsigned long long m0 = __ballot(e0 == e), m1 = __ballot(e1 == e); const int c0 = __popcll(m0);
            if (e0 == e) rk0 = __popcll(m0 & below); if (e1 == e) rk1 = c0 + __popcll(m1 & below);
            if (lane == 0) BLKCNT[F.bid * 8 + e] = c0 + __popcll(m1); }
        LRANK[(size_t)row * 2] = rk0; LRANK[(size_t)row * 2 + 1] = rk1; }
    __syncthreads();
}
__device__ __forceinline__ void moe_tiles(const Frame& F, ArgsP kargs, int (&tb)[NE + 1], LAS int* pre) {
    LOCAL_IDS; FRESH(a); const int* BLKCNT = (const int*)(a->ws + WS_BLKCNT);
    __syncthreads();
    if (tid < 16) pre[tid] = 0;
    __syncthreads();
    if (tid < 256) { const i32x4 c0 = *(const i32x4*)(BLKCNT + tid * 8), c1 = *(const i32x4*)(BLKCNT + tid * 8 + 4); const int cc[8] = {c0[0], c0[1], c0[2], c0[3], c1[0], c1[1], c1[2], c1[3]};
#pragma unroll
        for (int e = 0; e < 8; ++e) { const int tot = (int)wave_sum((float)cc[e]); const int bel = (int)wave_sum(tid < F.bid ? (float)cc[e] : 0.f);
            if (lane == 0) { __hip_atomic_fetch_add(pre + 8 + e, tot, __ATOMIC_RELAXED, __HIP_MEMORY_SCOPE_WORKGROUP); __hip_atomic_fetch_add(pre + e, bel, __ATOMIC_RELAXED, __HIP_MEMORY_SCOPE_WORKGROUP); } } }
    __syncthreads();
    int acc_t = 0;
#pragma unroll
    for (int e = 0; e < NE; ++e) { tb[e] = acc_t; acc_t += (__builtin_amdgcn_readfirstlane(pre[8 + e]) + 255) >> 8; }
    tb[NE] = acc_t;
}
__device__ __forceinline__ void phase_moe_gather(const Frame& F, ArgsP kargs) {
    int tb[NE + 1]; LAS int* pre = (LAS int*)(F.lds + 0);
    moe_tiles(F, kargs, tb, pre);
    LOCAL_IDS; FRESH(a); unsigned char* ws = a->ws;
    const int* TOPI = (const int*)(ws + WS_TOPI); const int* LRANK = (const int*)(ws + WS_LRANK); int* POS = (int*)(ws + WS_POS); float* SLOTR = (float*)(ws + WS_SLOTR); const float* RX = (const float*)(ws + WS_RX);
    int* TOKOF = (int*)(ws + WS_TOKOF);
    if (lane < 16) { const int pi = wave * 16 + lane, rib = pi >> 1, k = pi & 1, row = F.bid * 64 + rib;
        const int te = TOPI[row], e = k ? (te >> 8) : (te & 255); const int lr = LRANK[(size_t)row * 2 + k]; const float rx = RX[row];
        int bs = 0;
#pragma unroll
        for (int q = 0; q < NE; ++q) if (q == e) bs = tb[q] * 256;
        const int slot = bs + pre[e] + lr;
        POS[(size_t)row * 2 + k] = slot; SLOTR[slot] = rx; TOKOF[slot] = row; }
    if (F.bid < NE) { const int e = F.bid; int b0 = 0, b1 = 0;
#pragma unroll
        for (int q = 0; q < NE; ++q) if (q == e) { b0 = tb[q] * 256; b1 = tb[q + 1] * 256; }
        const int cnt = __builtin_amdgcn_readfirstlane(pre[8 + e]);
        for (int s = b0 + cnt + tid; s < b1; s += NWAVES * 64) { SLOTR[s] = 0.f; TOKOF[s] = 0; } }
    __syncthreads();
}
struct MoeOrder { enum { VARK = 0, GATHER = 0 }; int nN, G, c, T; int tb[NE + 1]; const char* A; const char* B; size_t astep, estep, bstep; int rev = 0;
    __device__ __forceinline__ bool next(int i, pg8::Unit& u) const { const long L = (long)i * G + c; if (L >= (long)T * nN) return false; int pm, pn; pg8::tile_of((int)L, T, nN, pm, pn); if (rev) pm = T - 1 - pm;
        int e = 0;
#pragma unroll
        for (int q = 1; q < NE; ++q) e += (pm >= tb[q]) ? 1 : 0;
        u.pm = pm; u.pn = pn; u.aux = e; u.A = A + (size_t)pm * astep; u.B = B + (size_t)e * estep + (size_t)pn * bstep; return true; } };
struct MoeUpOrder { enum { VARK = 0, GATHER = 1 }; int nN, G, c, T; int tb[NE + 1]; const char* A; const char* B; size_t estep, bstep; const LAS int* tokL;
    __device__ __forceinline__ bool next(int i, pg8::Unit& u) const { const long L = (long)i * G + c; if (L >= (long)T * nN) return false; int pm, pn; pg8::tile_of((int)L, T, nN, pm, pn);
        int e = 0;
#pragma unroll
        for (int q = 1; q < NE; ++q) e += (pm >= tb[q]) ? 1 : 0;
        u.pm = pm; u.pn = pn; u.aux = e; u.A = A; u.B = B + (size_t)e * estep + (size_t)pn * bstep; return true; } };
struct MoeTailOrder { enum { VARK = 1, GATHER = 0 }; static constexpr int PPU = DFE / 128;
    int nN, G, c, T; int tb[NE + 1]; const char* A; const char* B; size_t astep, estep, bstep; int rev = 0;
    __device__ __forceinline__ bool next(int i, pg8::Unit& u) const {
        const int U = T * nN, R = U / G, Lf = U - R * G, x = c & 7, j = c >> 3, nj = (G - x + 7) >> 3;
        const int Lfx = Lf > x ? (Lf - x + 7) >> 3 : 0;
        long L; int k0 = 0, np = PPU, part = 0, k = 0, r = 0, C = 1;
        if (i < R) L = (long)i * G + c;
        else if (i == R && Lfx > 0) { const int cap = nj / Lfx; C = cap >= 4 ? 4 : cap >= 2 ? 2 : 1;
            r = j / C; k = j - r * C; if (r >= Lfx) return false;
            L = (long)R * G + x + 8 * r; if (C > 1) { np = PPU / C; k0 = k * np; part = 3; } }
        else return false;
        int pm, pn; pg8::tile_of((int)L, T, nN, pm, pn); if (rev) pm = T - 1 - pm;
        int e = 0;
#pragma unroll
        for (int q = 1; q < NE; ++q) e += (pm >= tb[q]) ? 1 : 0;
        u.pm = pm; u.pn = pn; u.aux = e | (part << 4) | (k << 8) | (C << 16) | (r << 24); u.nt = 2 * np;
        u.A = A + (size_t)pm * astep + (size_t)k0 * 65536; u.B = B + (size_t)e * estep + (size_t)pn * bstep + (size_t)k0 * 65536; return true; } };
__device__ __forceinline__ void phase_moe_up(const Frame& F, ArgsP kargs) {
    if (PH(12)) { MoeUpOrder S; LAS int* pre = (LAS int*)(F.lds + RING_BYTES + 64); moe_tiles(F, kargs, S.tb, pre);
        FRESH(a); unsigned char* ws = a->ws; S.nN = 2 * DFE / 256; S.G = F.G; S.c = F.bid; S.T = S.tb[NE];
        S.A = (const char*)(ws + WS_XB); S.B = (const char*)(ws + WS_WFFN); S.estep = (size_t)2 * DFE * D * 2; S.bstep = (size_t)256 * D * 2;
        { LAS int* tokL = (LAS int*)(F.lds + RING_BYTES + 1024); S.tokL = tokL; const int* TOKOF = (const int*)(ws + WS_TOKOF);
          int tid_ = threadIdx.x; asm volatile("" : "+v"(tid_)); const int half_ = __builtin_amdgcn_readfirstlane(tid_ >> 8); int tkv[8];
#pragma unroll
          for (int j = 0; j < 8; ++j) { pg8::Unit u; const bool ok = S.next(2 * j + half_, u); tkv[j] = ok ? TOKOF[u.pm * 256 + (tid_ & 255)] : 0; }
#pragma unroll
          for (int j = 0; j < 8; ++j) tokL[(2 * j + half_) * 256 + (tid_ & 255)] = tkv[j];
          __syncthreads(); }
        pg8::EpiSwiGLU E{(const float*)(ws + WS_SLOTR), (bf16*)(ws + WS_HG), DFE, 0}; pg8::gemm_phase(F.lds, D, D, D, S, E); }
}
__device__ __forceinline__ void phase_moe_down(const Frame& F, ArgsP kargs, int j2) {
    if (PH(13)) { MoeTailOrder S; LAS int* pre = (LAS int*)(F.lds + RING_BYTES + 64); moe_tiles(F, kargs, S.tb, pre);
        FRESH(a); unsigned char* ws = a->ws; S.nN = 4; S.G = F.G; S.c = F.bid; S.T = S.tb[NE]; S.rev = 1;
        S.A = (const char*)(ws + WS_HG); S.B = (const char*)(ws + WS_W2M); S.astep = (size_t)256 * DFE * 2; S.estep = (size_t)D * DFE * 2; S.bstep = (size_t)256 * DFE * 2;
        pg8::EpiBf16KS E{(bf16*)(ws + WS_OUTG), D, (float*)(ws + WS_SKPART), (unsigned*)(ws + WS_CTL) + CW_SK + j2 * 512, F.bid}; pg8::gemm_phase(F.lds, 0, DFE, DFE, S, E); }
}
__device__ __forceinline__ void phase_moe_combine(const Frame& F, ArgsP kargs, bool last) {
    LOCAL_IDS; FRESH(a); unsigned char* ws = a->ws; float* X = a->out; const bf16* OUTG = (const bf16*)(ws + WS_OUTG); const int* POS = (const int*)(ws + WS_POS); const float* TOPW = (const float*)(ws + WS_TOPW);
    bf16* XB = (bf16*)(ws + WS_XB); float* RX = (float*)(ws + WS_RX); const float* g_final = a->g_final;
    int s0n = POS[(size_t)gw * 2], s1n = POS[(size_t)gw * 2 + 1]; float w0n = TOPW[(size_t)gw * 2], w1n = TOPW[(size_t)gw * 2 + 1];
#pragma unroll 1
    for (int m = gw; m < M; m += F.NGW) {
        const int s0 = s0n, s1 = s1n; const float w0 = w0n, w1 = w1n;
        { const int mn = m + F.NGW < M ? m + F.NGW : m; s0n = POS[(size_t)mn * 2]; s1n = POS[(size_t)mn * 2 + 1]; w0n = TOPW[(size_t)mn * 2]; w1n = TOPW[(size_t)mn * 2 + 1]; }
        f32x4 v[4]; float s = 0.f;
#pragma unroll
        for (int j = 0; j < 4; ++j) { const u32x2 p0 = ((const u32x2*)(OUTG + (size_t)s0 * D) + lane)[64 * j], p1 = ((const u32x2*)(OUTG + (size_t)s1 * D) + lane)[64 * j];
            const f32x4 o0 = {bflo(p0.x), bfhi(p0.x), bflo(p0.y), bfhi(p0.y)}, o1 = {bflo(p1.x), bfhi(p1.x), bflo(p1.y), bfhi(p1.y)};
            v[j] = ((const f32x4*)(X + (size_t)m * D) + lane)[64 * j] + w0 * o0 + w1 * o1; s += sumsq4(v[j]); }
        const float r = __builtin_amdgcn_rsqf(wave_sum(s) * (1.f / D) + EPS);
        if (last) {
#pragma unroll
            for (int j = 0; j < 4; ++j) ((f32x4*)(X + (size_t)m * D) + lane)[64 * j] = v[j] * r * ((const f32x4*)g_final + lane)[64 * j];
        } else {
#pragma unroll
            for (int j = 0; j < 4; ++j) { ((f32x4*)(X + (size_t)m * D) + lane)[64 * j] = v[j]; ((u32x2*)(XB + (size_t)m * D) + lane)[64 * j] = (u32x2){cvt_pk_bf16(v[j][0], v[j][1]), cvt_pk_bf16(v[j][2], v[j][3])}; }
            if (lane == 0) RX[m] = r;
        }
    }
}


#ifdef DBG_ENABLE
__device__ __forceinline__ float dbg_b(const unsigned char* ws, size_t off, size_t idx) { return bf2f(((const bf16*)(ws + off))[idx]); }
__device__ __forceinline__ void dbg_dump(const Frame& F, ArgsP kargs, int code) {
    LOCAL_IDS; FRESH(a); const unsigned char* ws = a->ws; float* out = a->out;
    unsigned tmo = ((const unsigned*)(ws + WS_CTL))[CW_BAR + XB_TMO];
    for (size_t i = (size_t)F.bid * 512 + tid; i < (size_t)M * D; i += (size_t)F.G * 512) { const size_t row = i >> 10, c = i & 1023; float v = 0.f;
        if (code == 1) v = dbg_b(ws, WS_CQ, row * 512 + (c & 511)) + dbg_b(ws, WS_CKV, row * 256 + (c & 255)) + dbg_b(ws, WS_U, row * 512 + (c & 511)) + dbg_b(ws, WS_VR, row * 512 + (c & 511)) + dbg_b(ws, WS_QX, row * 512 + (c & 511))
                         + dbg_b(ws, WS_GATE, row * 3072 + c) + dbg_b(ws, WS_GATE, row * 3072 + 1024 + c) + dbg_b(ws, WS_GATE, row * 3072 + 2048 + c) + dbg_b(ws, WS_KR, row * 32 + (c & 31));
        else if (code == 2) v = dbg_b(ws, WS_Q, row * 768 + (c % 768)) + dbg_b(ws, WS_KN, row * 512 + (c & 511)) + dbg_b(ws, WS_V, row * 512 + (c & 511)) + dbg_b(ws, WS_Y, row * 1536 + 512 + c);
        else if (code == 3) v = dbg_b(ws, WS_Y, row * 1536 + (c & 511));
        else if (code == 15) v = dbg_b(ws, WS_WINT, i % ((size_t)PPAD * D));
        else if (code == 13 || code == 14) v = dbg_b(ws, WS_GATE, row * 3072 + c) + dbg_b(ws, WS_GATE, row * 3072 + 1024 + c) + dbg_b(ws, WS_GATE, row * 3072 + 2048 + c);
        else if (code == 4) v = dbg_b(ws, WS_MIXB, row * 1024 + c);
        else if (code == 6) v = dbg_b(ws, WS_HFF, row * 2688 + c) + dbg_b(ws, WS_HFF, row * 2688 + 1024 + c) + dbg_b(ws, WS_HFF, row * 2688 + 1664 + c);
        else if (code == 9) { const int s0 = ((const int*)(ws + WS_POS))[row * 2], s1 = ((const int*)(ws + WS_POS))[row * 2 + 1]; v = dbg_b(ws, WS_XG, (size_t)s0 * 1024 + c) + 2.f * dbg_b(ws, WS_XG, (size_t)s1 * 1024 + c) + ((const float*)(ws + WS_TOPW))[row * 2] + (float)s0 * 1e-3f; }
        else if (code == 10) { const int s0 = ((const int*)(ws + WS_POS))[row * 2], s1 = ((const int*)(ws + WS_POS))[row * 2 + 1]; v = dbg_b(ws, WS_HG, (size_t)s0 * 3584 + c) + dbg_b(ws, WS_HG, (size_t)s1 * 3584 + 2560 + c) + dbg_b(ws, WS_HG, (size_t)s0 * 3584 + 1500 + c); }
        else if (code == 11) { const int s0 = ((const int*)(ws + WS_POS))[row * 2], s1 = ((const int*)(ws + WS_POS))[row * 2 + 1]; v = ((const float*)(ws + WS_OUTG))[(size_t)s0 * 1024 + c] + ((const float*)(ws + WS_OUTG))[(size_t)s1 * 1024 + c]; }
        else continue;
        if (tmo) v = __builtin_nanf("");
        out[i] = v; }
}
#define DBG(code) do { if (dbgc == (code)) { dbg_dump(F, kargs, code); return; } } while (0)
#else
#define DBG(code) do { } while (0)
#endif

__global__ void __launch_bounds__(NWAVES * 64, 2) fwd_kernel(Args args_by_value) {
    extern __shared__ __attribute__((aligned(16))) unsigned char lds_raw[];
    const ArgsP kargs = (ArgsP)__builtin_amdgcn_kernarg_segment_ptr();
    Frame F; F.lds = (LAS unsigned char*)lds_raw; F.G = gridDim.x; F.bid = blockIdx.x; F.NGW = F.G * NWAVES;
    for (int u = threadIdx.x; u < (LDS_BYTES - LDSCTL_OFF) / 4; u += NWAVES * 64) ((LAS unsigned*)(F.lds + LDSCTL_OFF))[u] = 0u;
    __syncthreads();
    volatile LAS unsigned* MISC = (volatile LAS unsigned*)(F.lds + MISC_OFF);
    XcdBarrier bar; { FRESH(a); bar = xcd_barrier_post((unsigned*)(a->ws + WS_CTL) + CW_BAR, MISC + 8); }
#define GRID_BAR() xcd_barrier(bar)

#ifdef ONLY_TEST
    ONLY_TEST; GRID_BAR(); return;
#endif
    const Frame F_ = F;
    int dbgc; { FRESH(a); dbgc = a->dbg; } (void)dbgc;
    phase_prologue(F, kargs); GRID_BAR();
#pragma unroll 1
    for (int l_ = 0; l_ < DEPTH; ++l_) {
        Frame F = F_; int l = l_; asm volatile("" : "+s"(F.G), "+s"(F.NGW), "+s"(F.bid), "+s"(l));
        const bool moe = (l & 1) != 0; const int j2 = l >> 1;
        if (l == 0) DBG(15);
#ifdef PROBE_INPROJ2
        { int reps = 2; asm volatile("" : "+s"(reps));
#pragma unroll 1
          for (int rep = 0; rep < reps; ++rep) { phase_inproj(F, kargs, l); GRID_BAR(); } }
#else
        phase_inproj(F, kargs, l); GRID_BAR(); if (l == 0) DBG(1); if (l == 0) DBG(14);
#endif
        phase_up(F, kargs, l); GRID_BAR(); if (l == 0) DBG(2);
        phase_attn(F, kargs, l); GRID_BAR(); if (l == 0) DBG(3); if (l == 0) DBG(13);
#ifdef PROBE_ATTN2
        phase_attn(F, kargs, l); GRID_BAR();
#endif
#ifdef PROBE_UP2
        phase_up(F, kargs, l); GRID_BAR();
#endif
        phase_branch(F, kargs); GRID_BAR(); if (l == 0) DBG(4);
#ifdef PROBE_RESID2
        { int reps = 2; asm volatile("" : "+s"(reps));
#pragma unroll 1
          for (int rep = reps - 1; rep >= 0; --rep) { phase_outproj(F, kargs, rep != 0); GRID_BAR(); } }
#else
        phase_outproj(F, kargs); GRID_BAR(); if (l == 0) DBG(5); if (l == 1) DBG(8);
#endif
        if (!moe) {
            phase_dense_conv(F, kargs, l, j2); GRID_BAR();
            phase_dense_up(F, kargs); GRID_BAR(); if (l == 0) DBG(6);
#ifdef PROBE_DENSE2
            phase_dense_up(F, kargs); GRID_BAR();
#endif
#ifdef PROBE_RESID2
            { int reps = 2; asm volatile("" : "+s"(reps));
#pragma unroll 1
              for (int rep = reps - 1; rep >= 0; --rep) { phase_dense_down(F, kargs, rep != 0); GRID_BAR(); } }
#else
            phase_dense_down(F, kargs); GRID_BAR(); if (l == 0) DBG(7);
#endif
        } else {
            phase_moe_route(F, kargs, l, j2); GRID_BAR();
            phase_moe_gather(F, kargs); GRID_BAR(); if (l == 1) DBG(9);
#ifdef PROBE_AUX2
            phase_moe_gather(F, kargs); GRID_BAR();
#endif
            phase_moe_up(F, kargs); GRID_BAR(); if (l == 1) DBG(10);
            phase_moe_down(F, kargs, j2); GRID_BAR(); if (l == 1) DBG(11);
#ifdef PROBE_MOE2
            phase_moe_up(F, kargs); GRID_BAR();
            phase_moe_down(F, kargs, j2); GRID_BAR();
#endif
            phase_moe_combine(F, kargs, l == DEPTH - 1);
            if (l != DEPTH - 1) GRID_BAR();
            if (l == 1) DBG(12);
        }
    }
}

extern "C" void kernel_launch(void* const* d_in, const int* in_sizes, int n_in, void* d_out, int out_size, void* d_ws, size_t ws_size, hipStream_t stream) {
    static int grid = 0;
    if (grid == 0) {
        if (n_in != 27 || in_sizes[0] != M * D || out_size != M * D || ws_size < WS_END) { fprintf(stderr, "kernel_launch: unexpected shapes (n_in %d, in0 %d, out %d, ws %zu)\n", n_in, n_in > 0 ? in_sizes[0] : -1, out_size, ws_size); grid = -1; return; }
        int dev = 0, cus = 0, per_cu = 0;
        if (hipGetDevice(&dev) != hipSuccess || hipDeviceGetAttribute(&cus, hipDeviceAttributeMultiprocessorCount, dev) != hipSuccess) { grid = -1; return; }
        if (hipFuncSetAttribute((const void*)fwd_kernel, hipFuncAttributeMaxDynamicSharedMemorySize, LDS_BYTES) != hipSuccess) { fprintf(stderr, "kernel_launch: hipFuncSetAttribute failed\n"); grid = -1; return; }
        if (hipOccupancyMaxActiveBlocksPerMultiprocessor(&per_cu, (const void*)fwd_kernel, NWAVES * 64, LDS_BYTES) != hipSuccess || per_cu < 1) { fprintf(stderr, "kernel_launch: occupancy query reports %d\n", per_cu); }
        (void)hipGetLastError();
        if (cus != 256) { fprintf(stderr, "kernel_launch: built for 256 CUs, device has %d\n", cus); grid = -1; return; }
        grid = 256;
    }
    if (grid < 0) return;
    if (hipMemsetAsync((char*)d_ws + WS_CTL, 0, CTL_ZERO_BYTES, stream) != hipSuccess) return;
    Args a{};
    a.x = (const float*)d_in[0]; a.mem = (const float*)d_in[1]; a.positions = (const int*)d_in[2]; a.g_mix = (const float*)d_in[3]; a.w_in = (const float*)d_in[4]; a.g_q = (const float*)d_in[5];
    a.g_kv = (const float*)d_in[6]; a.w_uq = (const float*)d_in[7]; a.w_uk = (const float*)d_in[8]; a.w_uv = (const float*)d_in[9]; a.g_sg = (const float*)d_in[10]; a.w_s = (const float*)d_in[11];
    a.b_s = (const float*)d_in[12]; a.g_mem = (const float*)d_in[13]; a.w_mkv = (const float*)d_in[14]; a.w_br = (const float*)d_in[15]; a.b_gate = (const float*)d_in[16]; a.w_out = (const float*)d_in[17];
    a.g_ffn = (const float*)d_in[18]; a.dense_w1 = (const float*)d_in[19]; a.dense_w3 = (const float*)d_in[20]; a.dense_w2 = (const float*)d_in[21]; a.w_router = (const float*)d_in[22];
    a.moe_w1 = (const float*)d_in[23]; a.moe_w3 = (const float*)d_in[24]; a.moe_w2 = (const float*)d_in[25]; a.g_final = (const float*)d_in[26];
    a.out = (float*)d_out; a.ws = (unsigned char*)d_ws;
#ifdef DBG_STOP
    a.dbg = DBG_STOP;
#endif
    hipLaunchKernelGGL(fwd_kernel, dim3(grid), dim3(NWAVES * 64), LDS_BYTES, stream, a);
    const hipError_t le = hipPeekAtLastError();
    if (le != hipSuccess) fprintf(stderr, "kernel_launch: launch failed: %s\n", hipGetErrorName(le));
}
```

```cpp
#include <hip/hip_runtime.h>
#include <cstdio>
#include <cstdint>

#ifndef PH_MASK
#define PH_MASK 0xffffffffu
#endif
#define PH(k) ((PH_MASK >> (k)) & 1u)
#define LAS __attribute__((address_space(3)))
#define GAS __attribute__((address_space(1)))
typedef unsigned short bf16;
typedef short bf16x8 __attribute__((ext_vector_type(8)));
typedef short s16x4 __attribute__((ext_vector_type(4)));
typedef float f32x4 __attribute__((ext_vector_type(4)));
typedef float f32x2 __attribute__((ext_vector_type(2)));
typedef float f32x16 __attribute__((ext_vector_type(16)));
typedef unsigned u32x4 __attribute__((ext_vector_type(4)));
typedef unsigned u32x2 __attribute__((ext_vector_type(2)));
typedef int i32x4 __attribute__((ext_vector_type(4)));

constexpr int M = 16384, D = 1024, DEPTH = 4, NMEM = 256;
constexpr int QRANK = 384, KVRANK = 256, NH = 8, QKD = 96, VD = 64;
constexpr int XH = 4, XD = 128, BW = 512;
constexpr int PTOT = 5280, PPAD = 5376, DFF = 2688, NE = 8, DFE = 3584;
constexpr float EPS = 1e-6f;
constexpr int MAXSLOT = 34816;
constexpr float LOG2E = 1.4426950408889634f;
constexpr float QSCALE = 0.10206207261596575f * LOG2E;
constexpr float XSCALE = 0.08838834764831845f * LOG2E;

constexpr size_t MiB = 1u << 20, KiB = 1u << 10;
constexpr size_t WS_CTL = 0, CTL_ZERO_BYTES = 1 * MiB;
constexpr size_t WS_ROPE = 2 * MiB;
constexpr size_t WS_XSTAT = 4 * MiB;
constexpr size_t WS_RX = 5 * MiB;
constexpr size_t WS_CQSTAT = 5 * MiB + 256 * KiB;
constexpr size_t WS_CKVSTAT = 5 * MiB + 768 * KiB;
constexpr size_t WS_VSTAT = 6 * MiB;
constexpr size_t WS_MEMB = 6 * MiB + 512 * KiB;
constexpr size_t WS_KVMEM = 7 * MiB;
constexpr size_t WS_TOPI = 9 * MiB;
constexpr size_t WS_TOPW = 9 * MiB + 256 * KiB;
constexpr size_t WS_LRANK = 9 * MiB + 512 * KiB;
constexpr size_t WS_POS = 9 * MiB + 768 * KiB;
constexpr size_t WS_BLKCNT = 10 * MiB;
constexpr size_t WS_SLOTR = 10 * MiB + 512 * KiB;
constexpr size_t WS_TOKOF = 10 * MiB + 768 * KiB;
constexpr size_t WS_WSB = 11 * MiB;
constexpr size_t WS_WMKVT = 12 * MiB;
constexpr size_t WS_WINT = 20 * MiB;
constexpr size_t WS_WUQT = 31 * MiB;
constexpr size_t WS_WUKVT = 32 * MiB;
constexpr size_t WS_WBRT = 33 * MiB;
constexpr size_t WS_WOUTT = 36 * MiB;
constexpr size_t WS_WFFN = 40 * MiB;
constexpr size_t WS_W2D = WS_WFFN + 11 * MiB;
constexpr size_t WS_W2M = WS_WFFN + 112 * MiB;
constexpr size_t WS_XB = 208 * MiB;
constexpr size_t WS_CQ = 240 * MiB;
constexpr size_t WS_CKV = 256 * MiB;
constexpr size_t WS_U = 264 * MiB;
constexpr size_t WS_VR = 280 * MiB;
constexpr size_t WS_QX = 296 * MiB;
constexpr size_t WS_GATE = 312 * MiB;
constexpr size_t WS_Q = 408 * MiB;
constexpr size_t WS_KN = 432 * MiB;
constexpr size_t WS_KR = 448 * MiB;
constexpr size_t WS_V = 450 * MiB;
constexpr size_t WS_Y = 466 * MiB;
constexpr size_t WS_MIX = 514 * MiB;
constexpr size_t WS_MIXB = 578 * MiB;
constexpr size_t WS_MIX1 = 610 * MiB;
constexpr size_t WS_HFF = 240 * MiB;
constexpr size_t WS_XG = 240 * MiB;
constexpr size_t WS_HG = 308 * MiB;
constexpr size_t WS_OUTG = 546 * MiB;
constexpr size_t WS_END = 682 * MiB;
constexpr int CW_TMO = 0, CW_CODE = 1, CW_CHK = 2, CW_BAR = 4096;
constexpr int CW_SK = 16384;
constexpr size_t WS_SKPART = 700 * MiB;
constexpr int CW_KMAX = 8192;

constexpr int RING_BYTES = 131072, LDSCTL_OFF = 159744, MISC_OFF = LDSCTL_OFF + 320, LDS_BYTES = 163840;
constexpr int NWAVES = 8;

#define RLX_AGENT __ATOMIC_RELAXED, __HIP_MEMORY_SCOPE_AGENT
#define LDS_WAIT() asm volatile("s_waitcnt lgkmcnt(0)" ::: "memory")
#define VM_WAIT() asm volatile("s_waitcnt vmcnt(0)" ::: "memory")
typedef __bf16 bf16x2_t __attribute__((ext_vector_type(2)));
__device__ __forceinline__ unsigned cvt_pk_bf16(float lo, float hi) { const f32x2 v = {lo, hi}; const bf16x2_t b = __builtin_convertvector(v, bf16x2_t); return __builtin_bit_cast(unsigned, b); }
__device__ __forceinline__ bf16 f2bf(float f) { return (bf16)(cvt_pk_bf16(f, 0.f) & 0xffffu); }
__device__ __forceinline__ float bf2f(bf16 v) { return __uint_as_float((unsigned)v << 16); }
__device__ __forceinline__ float bflo(unsigned w) { return __uint_as_float(w << 16); }
__device__ __forceinline__ float bfhi(unsigned w) { return __uint_as_float(w & 0xffff0000u); }
__device__ __forceinline__ float fast_exp2(float x) { return __builtin_amdgcn_exp2f(x); }
__device__ __forceinline__ float fast_rcp(float x) { return __builtin_amdgcn_rcpf(x); }
__device__ __forceinline__ float sigmoidf_(float z) { return fast_rcp(1.f + fast_exp2(-LOG2E * z)); }
__device__ __forceinline__ float gelu_tanh(float x) { const float t = x + 0.044715f * x * x * x; return x * fast_rcp(1.f + fast_exp2(-2.f * 0.7978845608028654f * LOG2E * t)); }
template <int CTRL> __device__ __forceinline__ float dppf(float v) { return __builtin_bit_cast(float, __builtin_amdgcn_update_dpp(0, __builtin_bit_cast(int, v), CTRL, 0xf, 0xf, true)); }
__device__ __forceinline__ float row_sum16(float v) { v += dppf<0xB1>(v); v += dppf<0x4E>(v); v += dppf<0x124>(v); v += dppf<0x128>(v); return v; }
__device__ __forceinline__ float row_max16(float v) { v = fmaxf(v, dppf<0xB1>(v)); v = fmaxf(v, dppf<0x4E>(v)); v = fmaxf(v, dppf<0x124>(v)); v = fmaxf(v, dppf<0x128>(v)); return v; }
__device__ __forceinline__ float xsum16(float v) { const auto r = __builtin_amdgcn_permlane16_swap(__float_as_uint(v), __float_as_uint(v), false, false); return __uint_as_float(r[0]) + __uint_as_float(r[1]); }
__device__ __forceinline__ float xsum32(float v) { const auto r = __builtin_amdgcn_permlane32_swap(__float_as_uint(v), __float_as_uint(v), false, false); return __uint_as_float(r[0]) + __uint_as_float(r[1]); }
__device__ __forceinline__ float wave_sum(float v) { return xsum32(xsum16(row_sum16(v))); }
__device__ __forceinline__ float sumsq4(f32x4 v) { return (v[0] * v[0] + v[1] * v[1]) + (v[2] * v[2] + v[3] * v[3]); }
__device__ __forceinline__ u32x2 pack8_u8(f32x4 a, f32x4 b) { unsigned w0 = 0, w1 = 0; a = a * 255.f; b = b * 255.f;
    w0 = __builtin_amdgcn_cvt_pk_u8_f32(a[0], 0, w0); w0 = __builtin_amdgcn_cvt_pk_u8_f32(a[1], 1, w0); w0 = __builtin_amdgcn_cvt_pk_u8_f32(a[2], 2, w0); w0 = __builtin_amdgcn_cvt_pk_u8_f32(a[3], 3, w0);
    w1 = __builtin_amdgcn_cvt_pk_u8_f32(b[0], 0, w1); w1 = __builtin_amdgcn_cvt_pk_u8_f32(b[1], 1, w1); w1 = __builtin_amdgcn_cvt_pk_u8_f32(b[2], 2, w1); w1 = __builtin_amdgcn_cvt_pk_u8_f32(b[3], 3, w1);
    return (u32x2){w0, w1}; }
__device__ __forceinline__ void unpack8_u8(u32x2 w, f32x4& a, f32x4& b) { constexpr float k = 1.f / 255.f;
    a = (f32x4){(float)(w.x & 255u), (float)((w.x >> 8) & 255u), (float)((w.x >> 16) & 255u), (float)(w.x >> 24)} * k;
    b = (f32x4){(float)(w.y & 255u), (float)((w.y >> 8) & 255u), (float)((w.y >> 16) & 255u), (float)(w.y >> 24)} * k; }
__device__ __forceinline__ u32x4 pack8(f32x4 a, f32x4 b) { u32x4 w; w.x = cvt_pk_bf16(a[0], a[1]); w.y = cvt_pk_bf16(a[2], a[3]); w.z = cvt_pk_bf16(b[0], b[1]); w.w = cvt_pk_bf16(b[2], b[3]); return w; }
__device__ __forceinline__ void unpack8(u32x4 w, f32x4& a, f32x4& b) { a = (f32x4){bflo(w.x), bfhi(w.x), bflo(w.y), bfhi(w.y)}; b = (f32x4){bflo(w.z), bfhi(w.z), bflo(w.w), bfhi(w.w)}; }

namespace pg8 {
constexpr int BM = 256, BK = 64, HALF = 128, HTB = HALF * BK * 2, STAGE_BYTES = 8 * HTB, NXCD = 8, WGM = 8;
__host__ __device__ __forceinline__ int lds_byte(int r, int c) { const int st = (r >> 4) * 2 + (c >> 5), rr = r & 15, cc = c & 31, ob = rr * 64 + cc * 2; return st * 1024 + (ob ^ (((ob >> 9) & 1) << 5)); }
__host__ __device__ __forceinline__ void stage_rc(int b, int& R, int& C) { const int st = b / 1024, sb = b % 1024, swz = sb ^ (((sb >> 9) & 1) << 5); R = (st >> 1) * 16 + swz / 64; C = (st & 1) * 32 + (swz % 64) / 2; }
__host__ __device__ __forceinline__ int perm32(int rho) { const int n = rho >> 4, i = rho & 15; return 8 * (i >> 2) + 4 * n + (i & 3); }

struct Unit { const char* A; const char* B; int pm, pn, aux, nt; };
typedef f32x4 Acc[2][2][4][2];

__device__ __forceinline__ void tile_of(int L, int nM, int nN, int& pm, int& pn) {
    const int nwg = nM * nN; int wgid = L;
    { const int q = nwg / NXCD, r = nwg % NXCD, xcd = wgid % NXCD, off = wgid / NXCD; wgid = (xcd < r ? xcd * (q + 1) : r * (q + 1) + (xcd - r) * q) + off; }
    const int nig = WGM * nN, gid = wgid / nig, fm = gid * WGM, gsz = (nM - fm) < WGM ? (nM - fm) : WGM;
    pm = fm + ((wgid % nig) % gsz); pn = (wgid % nig) / gsz;
}
struct TileOrder {
    enum { VARK = 0, GATHER = 0 };
    int nM, nN, G, c; const char* A; const char* B; size_t astep, bstep;
    int rev = 0;
    __device__ __forceinline__ bool next(int i, Unit& u) const {
        if (rev) { const int cnt = (nM * nN - c + G - 1) / G; if (i >= cnt) return false; i = cnt - 1 - i; }
        const long L = (long)i * G + c; if (L >= (long)nM * nN) return false;
        int pm, pn; tile_of((int)L, nM, nN, pm, pn);
        u.pm = pm; u.pn = pn; u.aux = 0; u.A = A + (size_t)pm * astep; u.B = B + (size_t)pn * bstep; return true;
    }
};

template <class Epi, class Sched>
__device__ __forceinline__ void gemm_phase(LAS unsigned char* lds, const int lda, const int ldb, const int K, const Sched& S, const Epi& E) {
    int tid_ = threadIdx.x; asm volatile("" : "+v"(tid_));
    const int tid = tid_, wid = __builtin_amdgcn_readfirstlane(tid >> 6), lane = tid & 63, wr = wid >> 2, wc = wid & 3, fr = lane & 15, fq = lane >> 4;
    int nt = K / BK;
    unsigned voffA[2], voffB[2];
#pragma unroll
    for (int i = 0; i < 2; ++i) { int R, C; stage_rc(tid * 16 + i * 8192, R, C); const int Rb = (R & ~31) + perm32(R & 31);
        voffA[i] = (unsigned)(R * (lda ? lda : BK) + C) * 2u; voffB[i] = (unsigned)(Rb * BK + C) * 2u; }
    const size_t kstep = lda ? (size_t)(BK * 2) : (size_t)BM * BK * 2;
    const size_t hstepA = (size_t)HALF * (lda ? lda : BK) * 2, hstepB = (size_t)HALF * BK * 2, kstepB = (size_t)BM * BK * 2; (void)ldb;
    const unsigned ldsw = (unsigned)wid * 1024u;
    const int aoff = lds_byte(wr * 64 + fr, fq * 8), boff = lds_byte(wc * 32 + fr, fq * 8);
#define PG8_SA(b, h) (((b) * 2 + (h)) * HTB)
#define PG8_SB(b, h) ((4 + (b) * 2 + (h)) * HTB)
#define PG8_STAGE(bufoff, gbase, voff) do { _Pragma("unroll") for (int _i = 0; _i < 2; ++_i) \
        __builtin_amdgcn_global_load_lds((const unsigned*)((const char*)(gbase) + (voff)[_i]), (LAS unsigned*)(lds + (bufoff) + ldsw + _i * 8192), 16, 0, 0); } while (0)
#define PG8_STA(b, h, kptr, VG) do { if constexpr (Sched::GATHER) PG8_STAGE(PG8_SA(b, h), (kptr), VG[h]); else PG8_STAGE(PG8_SA(b, h), (kptr) + (h) * hstepA, voffA); } while (0)
#define PG8_GLOOKUP(VG, ui_) do { _Pragma("unroll") for (int _h = 0; _h < 2; ++_h) _Pragma("unroll") for (int _i = 0; _i < 2; ++_i) { int R_, C_; stage_rc(tid * 16 + _i * 8192, R_, C_); \
        VG[_h][_i] = (unsigned)S.tokL[(ui_) * 256 + _h * 128 + R_] * (unsigned)(lda * 2) + (unsigned)(C_ * 2); } } while (0)
#define PG8_LDA(dst, b, h) do { _Pragma("unroll") for (int m = 0; m < 4; ++m) _Pragma("unroll") for (int k = 0; k < 2; ++k) dst[m][k] = *(const LAS bf16x8*)(lds + PG8_SA(b, h) + aoff + m * 2048 + k * 1024); } while (0)
#define PG8_LDB(dst, b, h) do { _Pragma("unroll") for (int n = 0; n < 2; ++n) _Pragma("unroll") for (int k = 0; k < 2; ++k) dst[n][k] = *(const LAS bf16x8*)(lds + PG8_SB(b, h) + boff + n * 2048 + k * 1024); } while (0)
#define PG8_MMA(ai, bj, At, Bt) do { __builtin_amdgcn_s_setprio(1); _Pragma("unroll") for (int m = 0; m < 4; ++m) _Pragma("unroll") for (int n = 0; n < 2; ++n) _Pragma("unroll") for (int k = 0; k < 2; ++k) \
        acc[ai][bj][m][n] = __builtin_amdgcn_mfma_f32_16x16x32_bf16(Bt[n][k], At[m][k], acc[ai][bj][m][n], 0, 0, 0); __builtin_amdgcn_s_setprio(0); } while (0)
#define PG8_WAIT_V(n) asm volatile("s_waitcnt vmcnt(" #n ")" ::: "memory")
#define PG8_WAIT_L(n) asm volatile("s_waitcnt lgkmcnt(" #n ")" ::: "memory")
#define PG8_BAR __builtin_amdgcn_s_barrier()
#define PG8_SCHED __builtin_amdgcn_sched_barrier(0)
    Unit cur, nxt; int ui = 0;
    if (!S.next(0, cur)) return;
    if constexpr (Sched::VARK) nt = cur.nt;
    typename Epi::Pre pre = E.prefetch(cur, wr, fr);
    Acc acc;
#pragma unroll
    for (int a = 0; a < 2; ++a)
#pragma unroll
        for (int b = 0; b < 2; ++b)
#pragma unroll
            for (int m = 0; m < 4; ++m)
#pragma unroll
                for (int n = 0; n < 2; ++n) acc[a][b][m][n] = (f32x4){0.f, 0.f, 0.f, 0.f};
    bf16x8 At[4][2], B0[2][2], B1[2][2];
    const char* cA = cur.A; const char* cB = cur.B;
    unsigned vg[2][2] = {{0u, 0u}, {0u, 0u}}; if constexpr (Sched::GATHER) PG8_GLOOKUP(vg, 0);
    PG8_STAGE(PG8_SB(0, 0), cB, voffB); PG8_STAGE(PG8_SB(0, 1), cB + hstepB, voffB); PG8_STA(0, 0, cA, vg); PG8_STA(0, 1, cA, vg);
    if (wr == 1) PG8_BAR;
    PG8_WAIT_V(2); PG8_BAR;
    PG8_STAGE(PG8_SB(1, 0), cB + kstepB, voffB); PG8_STA(1, 0, cA + kstep, vg); PG8_STAGE(PG8_SB(1, 1), cB + hstepB + kstepB, voffB);
    PG8_WAIT_V(6); PG8_BAR;
    for (;;) {
        const bool has_next = S.next(ui + 1, nxt);
        const char* nA = has_next ? nxt.A : cA; const char* nB = has_next ? nxt.B : cB;
        for (int t = 0; t < nt; t += 2) {
            const bool last = (t == nt - 2);
            const char* a1 = cA + (size_t)(t + 1) * kstep;
            const char* a2 = last ? nA : cA + (size_t)(t + 2) * kstep; const char* b2 = last ? nB : cB + (size_t)(t + 2) * kstepB;
            const char* a3 = a2 + kstep; const char* b3 = b2 + kstepB;
            PG8_LDB(B0, 0, 0); PG8_LDB(B1, 0, 1); PG8_SCHED; PG8_LDA(At, 0, 0); PG8_STA(1, 1, a1, vg);
            if constexpr (Sched::GATHER) { if (last && has_next) PG8_GLOOKUP(vg, ui + 1); }
            PG8_WAIT_V(8); PG8_WAIT_L(0); PG8_BAR; PG8_MMA(0, 0, At, B0); PG8_MMA(0, 1, At, B1); PG8_BAR; PG8_SCHED;
            PG8_LDA(At, 0, 1); PG8_STAGE(PG8_SB(0, 0), b2, voffB); PG8_STAGE(PG8_SB(0, 1), b2 + hstepB, voffB); PG8_STA(0, 0, a2, vg);
            PG8_WAIT_V(8); PG8_WAIT_L(0); PG8_BAR; PG8_MMA(1, 0, At, B0); PG8_MMA(1, 1, At, B1); PG8_BAR; PG8_SCHED;
            PG8_LDB(B0, 1, 0); PG8_LDB(B1, 1, 1); PG8_SCHED; PG8_LDA(At, 1, 0); PG8_STA(0, 1, a2, vg);
            PG8_WAIT_V(8); PG8_WAIT_L(0); PG8_BAR; PG8_MMA(0, 0, At, B0); PG8_MMA(0, 1, At, B1); PG8_BAR; PG8_SCHED;
            PG8_LDA(At, 1, 1); PG8_STAGE(PG8_SB(1, 0), b3, voffB); PG8_STAGE(PG8_SB(1, 1), b3 + hstepB, voffB); PG8_STA(1, 0, a3, vg);
            PG8_WAIT_V(8); PG8_WAIT_L(0); PG8_BAR; PG8_MMA(1, 0, At, B0); PG8_MMA(1, 1, At, B1); PG8_BAR; PG8_SCHED;
        }
        if (wr == 0) PG8_BAR;
        E(acc, cur, wr, wc, fr, fq, pre);
        if (!has_next) break;
        pre = E.prefetch(nxt, wr, fr);
        if constexpr (!Epi::KEEP_ACC)
#pragma unroll
        for (int a = 0; a < 2; ++a)
#pragma unroll
            for (int b = 0; b < 2; ++b)
#pragma unroll
                for (int m = 0; m < 4; ++m)
#pragma unroll
                    for (int n = 0; n < 2; ++n) acc[a][b][m][n] = (f32x4){0.f, 0.f, 0.f, 0.f};
        cur = nxt; cA = nA; cB = nB; ++ui;
        if constexpr (Sched::VARK) nt = cur.nt;
        if (wr == 1) PG8_BAR;
    }
    PG8_WAIT_V(0);
    PG8_BAR;
#undef PG8_SA
#undef PG8_SB
#undef PG8_STAGE
#undef PG8_LDA
#undef PG8_STA
#undef PG8_GLOOKUP
#undef PG8_LDB
#undef PG8_MMA
#undef PG8_WAIT_V
#undef PG8_WAIT_L
#undef PG8_BAR
#undef PG8_SCHED
}

#define EPI_FOR _Pragma("unroll") for (int ai = 0; ai < 2; ++ai) _Pragma("unroll") for (int m = 0; m < 4; ++m)
#define EPI_ROW (u.pm * BM + ai * HALF + wr * 64 + m * 16 + fr)
#define EPI_C8(bj) (u.pn * BM + (bj) * HALF + wc * 32 + 8 * fq)
#define EPI_LOAD_R(rr, ptr) float rr[2][4]; _Pragma("unroll") for (int ai = 0; ai < 2; ++ai) _Pragma("unroll") for (int m = 0; m < 4; ++m) rr[ai][m] = (ptr)[EPI_ROW]; asm volatile("" ::: "memory")

#define EPI_LOAD_RS(rr, xstat) float rr[2][4]; { f32x4 st_[2][4]; _Pragma("unroll") for (int ai = 0; ai < 2; ++ai) _Pragma("unroll") for (int m = 0; m < 4; ++m) st_[ai][m] = *(const f32x4*)((xstat) + (size_t)EPI_ROW * 16 + 4 * fq); \
    asm volatile("" ::: "memory"); _Pragma("unroll") for (int ai = 0; ai < 2; ++ai) _Pragma("unroll") for (int m = 0; m < 4; ++m) { float t_ = (st_[ai][m][0] + st_[ai][m][1]) + (st_[ai][m][2] + st_[ai][m][3]); \
        t_ = xsum32(xsum16(t_)); rr[ai][m] = __builtin_amdgcn_rsqf(t_ * (1.f / D) + EPS); } }
struct NoPre {};
#define EPI_NOPRE static constexpr bool KEEP_ACC = false; typedef NoPre Pre; __device__ __forceinline__ Pre prefetch(const Unit&, int, int) const { return Pre{}; }
struct RowPre { float r[2][4]; };
struct EpiInProj {
    unsigned char* ws; const float* bgate; int layer; int from_stats;
    static constexpr bool KEEP_ACC = false; typedef RowPre Pre;
    __device__ __forceinline__ Pre prefetch(const Unit& u, int wr, int fr) const { Pre p; const float* rx = (const float*)(ws + WS_RX);
#pragma unroll
        for (int ai = 0; ai < 2; ++ai)
#pragma unroll
            for (int m = 0; m < 4; ++m) p.r[ai][m] = from_stats ? 0.f : rx[EPI_ROW];
        return p; }
    __device__ __forceinline__ void operator()(const Acc& acc, const Unit& u, int wr, int wc, int fr, int fq, const Pre& pre) const {
        const float* rx = (const float*)(ws + WS_RX); const float* rope = (const float*)(ws + WS_ROPE);
        bf16* CQ = (bf16*)(ws + WS_CQ); bf16* KR = (bf16*)(ws + WS_KR); bf16* CKV = (bf16*)(ws + WS_CKV); bf16* U = (bf16*)(ws + WS_U); bf16* VR = (bf16*)(ws + WS_VR); bf16* QX = (bf16*)(ws + WS_QX); bf16* GATE = (bf16*)(ws + WS_GATE);
        float* cqstat = (float*)(ws + WS_CQSTAT); float* ckvstat = (float*)(ws + WS_CKVSTAT); float* vstat = (float*)(ws + WS_VSTAT); unsigned* kmax = (unsigned*)(ws + WS_CTL) + CW_KMAX + layer * 32;
        const int pn = u.pn;
        float rr[2][4];
        if (from_stats) { EPI_LOAD_RS(rs_, (const float*)(ws + WS_XSTAT));
#pragma unroll
            for (int ai = 0; ai < 2; ++ai)
#pragma unroll
                for (int m = 0; m < 4; ++m) rr[ai][m] = rs_[ai][m]; }
        else {
#pragma unroll
            for (int ai = 0; ai < 2; ++ai)
#pragma unroll
                for (int m = 0; m < 4; ++m) rr[ai][m] = pre.r[ai][m]; }
        if (pn < 2) {
            float krmax = 0.f;
            EPI_FOR { const int row = EPI_ROW;
                const float r = rr[ai][m]; float ss = 0.f;
#pragma unroll
                for (int bj = 0; bj < 2; ++bj) { const f32x4 v0 = acc[ai][bj][m][0] * r, v1 = acc[ai][bj][m][1] * r;
                    if (!(pn == 1 && bj == 1)) ss += sumsq4(v0) + sumsq4(v1);
                    *(u32x4*)(CQ + (size_t)row * 512 + pn * 256 + bj * HALF + wc * 32 + 8 * fq) = pack8(v0, v1);
                    if (pn == 1 && bj == 1 && wc == 0) {
                        const f32x4 c = *(const f32x4*)(rope + (size_t)row * 32 + 4 * fq), s = *(const f32x4*)(rope + (size_t)row * 32 + 16 + 4 * fq);
                        const f32x4 o0 = v0 * c - v1 * s, o1 = v0 * s + v1 * c;
                        *(u32x4*)(KR + (size_t)row * 32 + 8 * fq) = pack8(o0, o1);
                        float q2 = sumsq4(o0) + sumsq4(o1); q2 = xsum32(xsum16(q2)); krmax = fmaxf(krmax, q2); } }
                ss = xsum32(xsum16(ss));
                if (fq == 0) cqstat[(size_t)row * 8 + pn * 4 + wc] = ss;
            }
            if (pn == 1 && wc == 0) {
                krmax = row_max16(krmax);
                if ((fr | fq) == 0) atomicMax(kmax + 16, __float_as_uint(krmax)); }
        } else if (pn == 2) {
            EPI_FOR { const int row = EPI_ROW;
                const float r = rr[ai][m]; float ss = 0.f;
#pragma unroll
                for (int bj = 0; bj < 2; ++bj) { const f32x4 v0 = acc[ai][bj][m][0] * r, v1 = acc[ai][bj][m][1] * r; ss += sumsq4(v0) + sumsq4(v1);
                    *(u32x4*)(CKV + (size_t)row * 256 + bj * HALF + wc * 32 + 8 * fq) = pack8(v0, v1); }
                ss = xsum32(xsum16(ss));
                if (fq == 0) ckvstat[(size_t)row * 4 + wc] = ss;
            }
        } else if (pn < 7) {
            const bool isv = pn >= 5; bf16* dst = isv ? VR : U; const int t = isv ? pn - 5 : pn - 3;
            EPI_FOR { const int row = EPI_ROW;
                const float r = rr[ai][m]; float ss = 0.f;
#pragma unroll
                for (int bj = 0; bj < 2; ++bj) { f32x4 v0 = acc[ai][bj][m][0] * r, v1 = acc[ai][bj][m][1] * r;
#pragma unroll
                    for (int e = 0; e < 4; ++e) { v0[e] = gelu_tanh(v0[e]); v1[e] = gelu_tanh(v1[e]); }
                    ss += sumsq4(v0) + sumsq4(v1);
                    *(u32x4*)(dst + (size_t)row * 512 + t * 256 + bj * HALF + wc * 32 + 8 * fq) = pack8(v0, v1); }
                if (isv) { ss = xsum32(xsum16(ss)); if (fq == 0) vstat[(size_t)row * 8 + t * 4 + wc] = ss; }
            }
        } else if (pn < 9) {
            EPI_FOR { const int row = EPI_ROW;
                const float r = rr[ai][m];
#pragma unroll
                for (int bj = 0; bj < 2; ++bj) *(u32x4*)(QX + (size_t)row * 512 + (pn - 7) * 256 + bj * HALF + wc * 32 + 8 * fq) = pack8(acc[ai][bj][m][0] * r, acc[ai][bj][m][1] * r);
            }
        } else {
            const int gc0 = (pn - 9) * 256 + wc * 32 + 8 * fq;
            f32x4 bg[2][2];
#pragma unroll
            for (int bj = 0; bj < 2; ++bj) { bg[bj][0] = *(const f32x4*)(bgate + gc0 + bj * HALF); bg[bj][1] = *(const f32x4*)(bgate + gc0 + bj * HALF + 4); }
            EPI_FOR { const int row = EPI_ROW;
                const float r = rr[ai][m];
#pragma unroll
                for (int bj = 0; bj < 2; ++bj) { f32x4 v0 = acc[ai][bj][m][0] * r + bg[bj][0], v1 = acc[ai][bj][m][1] * r + bg[bj][1];
#pragma unroll
                    for (int e = 0; e < 4; ++e) { v0[e] = sigmoidf_(v0[e]); v1[e] = sigmoidf_(v1[e]); }
#ifdef DBG_CONSTGATE
                    v0 = acc[ai][bj][m][0] * r; v1 = acc[ai][bj][m][1] * r;
#endif
                    *(u32x2*)((unsigned char*)GATE + (size_t)row * 3072 + gc0 + bj * HALF) = pack8_u8(v0, v1); }
            }
        }
    }
};
struct EpiMemKV {
    bf16* KV;
    EPI_NOPRE
    __device__ __forceinline__ void operator()(const Acc& acc, const Unit& u, int wr, int wc, int fr, int fq, const Pre&) const {
        EPI_FOR { const int row = EPI_ROW;
#pragma unroll
            for (int bj = 0; bj < 2; ++bj) *(u32x4*)(KV + (size_t)u.aux * 256 * 1024 + (size_t)row * 1024 + EPI_C8(bj)) = pack8(acc[ai][bj][m][0], acc[ai][bj][m][1]);
        }
    }
};
struct EpiQ {
    const float* cqstat; const float* rope; bf16* Q;
    EPI_NOPRE
    __device__ __forceinline__ void operator()(const Acc& acc, const Unit& u, int wr, int wc, int fr, int fq, const Pre&) const {
        EPI_FOR { const int row = EPI_ROW;
            const f32x4 s0 = *(const f32x4*)(cqstat + (size_t)row * 8), s1 = *(const f32x4*)(cqstat + (size_t)row * 8 + 4);
            const float r = __builtin_amdgcn_rsqf(((s0[0] + s0[1]) + (s0[2] + s0[3]) + (s1[0] + s1[1]) + (s1[2] + s1[3])) * (1.f / QRANK) + EPS);
#pragma unroll
            for (int bj = 0; bj < 2; ++bj) { f32x4 v0 = acc[ai][bj][m][0] * r, v1 = acc[ai][bj][m][1] * r;
                if (((8 * u.pn + 4 * bj + wc) % 3) == 2) {
                    const f32x4 c = *(const f32x4*)(rope + (size_t)row * 32 + 4 * fq), s = *(const f32x4*)(rope + (size_t)row * 32 + 16 + 4 * fq);
                    const f32x4 o0 = v0 * c - v1 * s, o1 = v0 * s + v1 * c; v0 = o0; v1 = o1; }
                *(u32x4*)(Q + (size_t)row * 768 + EPI_C8(bj)) = pack8(v0, v1); }
        }
    }
};
struct EpiKV {
    const float* ckvstat; bf16* KN; bf16* V; unsigned* kmax;
    EPI_NOPRE
    __device__ __forceinline__ void operator()(const Acc& acc, const Unit& u, int wr, int wc, int fr, int fq, const Pre&) const {
        bf16* dst = u.pn < 2 ? KN : V; const int t = u.pn & 1; float hm[2] = {0.f, 0.f};
        EPI_FOR { const int row = EPI_ROW;
            const f32x4 s0 = *(const f32x4*)(ckvstat + (size_t)row * 4);
            const float r = __builtin_amdgcn_rsqf(((s0[0] + s0[1]) + (s0[2] + s0[3])) * (1.f / KVRANK) + EPS);
#pragma unroll
            for (int bj = 0; bj < 2; ++bj) { const f32x4 v0 = acc[ai][bj][m][0] * r, v1 = acc[ai][bj][m][1] * r;
                *(u32x4*)(dst + (size_t)row * 512 + t * 256 + bj * HALF + wc * 32 + 8 * fq) = pack8(v0, v1);
                float q2 = sumsq4(v0) + sumsq4(v1); q2 = xsum32(xsum16(q2)); hm[bj] = fmaxf(hm[bj], q2); }
        }
        if (u.pn < 2) {
#pragma unroll
            for (int bj = 0; bj < 2; ++bj) { float v = hm[bj];
                v = row_max16(v);
                if ((fr | fq) == 0) atomicMax(kmax + 2 * (4 * u.pn + 2 * bj + (wc >> 1)) + (wc & 1), __float_as_uint(v)); }
        }
    }
};
struct EpiBranch {
    const unsigned char* GATE; bf16* MIXB;
    static constexpr bool KEEP_ACC = true; typedef NoPre Pre; __device__ __forceinline__ Pre prefetch(const Unit&, int, int) const { return Pre{}; }
    __device__ __forceinline__ void operator()(Acc& acc, const Unit& u, int wr, int wc, int fr, int fq, const Pre&) const {
        const int n = u.aux;
#pragma unroll
        for (int ai = 0; ai < 2; ++ai) {
            u32x2 gw[4][2], gn[4][2];
#pragma unroll
            for (int m = 0; m < 4; ++m)
#pragma unroll
                for (int bj = 0; bj < 2; ++bj) { const unsigned char* gp = GATE + (size_t)EPI_ROW * 3072 + n * 1024 + EPI_C8(bj);
                    gw[m][bj] = *(const u32x2*)gp; if (n < 2) gn[m][bj] = *(const u32x2*)(gp + 1024); }
            asm volatile("" ::: "memory");
#pragma unroll
            for (int m = 0; m < 4; ++m)
#pragma unroll
                for (int bj = 0; bj < 2; ++bj) {
                    f32x4 g0, g1; unpack8_u8(gw[m][bj], g0, g1);
#pragma unroll
                    for (int e = 0; e < 4; ++e) { g0[e] = fmaxf(g0[e], 0.001953125f); g1[e] = fmaxf(g1[e], 0.001953125f); }
                    if (n < 2) { f32x4 h0, h1; unpack8_u8(gn[m][bj], h0, h1);
#pragma unroll
                        for (int e = 0; e < 4; ++e) { g0[e] *= fast_rcp(fmaxf(h0[e], 0.001953125f)); g1[e] *= fast_rcp(fmaxf(h1[e], 0.001953125f)); }
                        acc[ai][bj][m][0] *= g0; acc[ai][bj][m][1] *= g1; }
                    else *(u32x4*)(MIXB + (size_t)u.pm * 256 * 1024 + (size_t)(4 * u.pn + 2 * bj + (wc >> 1)) * 16384 + (ai * HALF + wr * 64 + m * 16 + fr) * 64 + (wc & 1) * 32 + 8 * fq) = pack8(acc[ai][bj][m][0] * g0, acc[ai][bj][m][1] * g1);
                }
        }
        if (n == 2) {
#pragma unroll
            for (int ai = 0; ai < 2; ++ai)
#pragma unroll
                for (int bj = 0; bj < 2; ++bj)
#pragma unroll
                    for (int m = 0; m < 4; ++m) { acc[ai][bj][m][0] = (f32x4){0.f, 0.f, 0.f, 0.f}; acc[ai][bj][m][1] = (f32x4){0.f, 0.f, 0.f, 0.f}; }
        }
    }
};
struct EpiResid {
    const float* X; float* Xo; bf16* XB; float* xstat;
    EPI_NOPRE
    __device__ __forceinline__ void operator()(const Acc& acc, const Unit& u, int wr, int wc, int fr, int fq, const Pre&) const {
#pragma unroll
        for (int ai = 0; ai < 2; ++ai) {
            f32x4 xv[4][2][2];
#pragma unroll
            for (int m = 0; m < 4; ++m)
#pragma unroll
                for (int bj = 0; bj < 2; ++bj) { const float* xp = X + (size_t)EPI_ROW * 1024 + EPI_C8(bj); xv[m][bj][0] = *(const f32x4*)xp; xv[m][bj][1] = *(const f32x4*)(xp + 4); }
            asm volatile("" ::: "memory");
#pragma unroll
            for (int m = 0; m < 4; ++m) { const int row = EPI_ROW; float ss = 0.f;
#pragma unroll
                for (int bj = 0; bj < 2; ++bj) { const int col = EPI_C8(bj); float* xp = Xo + (size_t)row * 1024 + col;
                    const f32x4 v0 = xv[m][bj][0] + acc[ai][bj][m][0], v1 = xv[m][bj][1] + acc[ai][bj][m][1];
                    *(f32x4*)xp = v0; *(f32x4*)(xp + 4) = v1; ss += sumsq4(v0) + sumsq4(v1);
                    *(u32x4*)(XB + (size_t)row * 1024 + col) = pack8(v0, v1); }
                ss = xsum32(xsum16(ss));
                if (fq == 0) xstat[(size_t)row * 16 + u.pn * 4 + wc] = ss; }
        }
    }
};
struct EpiSwiGLU {
    const float* rs; bf16* Hh; int ldh; int from_stats;
    static constexpr bool KEEP_ACC = false; typedef RowPre Pre;
    __device__ __forceinline__ Pre prefetch(const Unit& u, int wr, int fr) const { Pre p;
#pragma unroll
        for (int ai = 0; ai < 2; ++ai)
#pragma unroll
            for (int m = 0; m < 4; ++m) p.r[ai][m] = from_stats ? 0.f : rs[EPI_ROW];
        return p; }
    __device__ __forceinline__ void operator()(const Acc& acc, const Unit& u, int wr, int wc, int fr, int fq, const Pre& pre) const {
        float rr[2][4];
        if (from_stats) { EPI_LOAD_RS(rs_, rs);
#pragma unroll
            for (int ai = 0; ai < 2; ++ai)
#pragma unroll
                for (int m = 0; m < 4; ++m) rr[ai][m] = rs_[ai][m]; }
        else {
#pragma unroll
            for (int ai = 0; ai < 2; ++ai)
#pragma unroll
                for (int m = 0; m < 4; ++m) rr[ai][m] = pre.r[ai][m]; }
        bf16* hbase = Hh + (size_t)u.pm * 256 * ldh + (size_t)(2 * u.pn + (wc >> 1)) * 16384 + (wr * 64 + fr) * 64 + (wc & 1) * 32 + 8 * fq;
        EPI_FOR { const int row = EPI_ROW;
            const float r = rr[ai][m];
            f32x4 a0 = acc[ai][0][m][0] * r, a1 = acc[ai][0][m][1] * r; const f32x4 b0 = acc[ai][1][m][0] * r, b1 = acc[ai][1][m][1] * r;
#pragma unroll
            for (int e = 0; e < 4; ++e) { a0[e] = a0[e] * sigmoidf_(a0[e]) * b0[e]; a1[e] = a1[e] * sigmoidf_(a1[e]) * b1[e]; }
            (void)row; *(u32x4*)(hbase + (ai * HALF + m * 16) * 64) = pack8(a0, a1);
        }
    }
};
struct EpiBf16 {
    bf16* C; int ldc;
    EPI_NOPRE
    __device__ __forceinline__ void operator()(const Acc& acc, const Unit& u, int wr, int wc, int fr, int fq, const Pre&) const {
        EPI_FOR { const int row = EPI_ROW;
#pragma unroll
            for (int bj = 0; bj < 2; ++bj) *(u32x4*)(C + (size_t)row * ldc + EPI_C8(bj)) = pack8(acc[ai][bj][m][0], acc[ai][bj][m][1]);
        }
    }
};
__device__ __forceinline__ void ks_reduce(const float* part, int x, int r, int k, int CC, int tid, bf16* C, int ldc, const Unit& u, int wr, int wc, int fr, int fq) {
    for (int sp = k; sp < 16; sp += CC) { const int ai = sp >> 3, bj = (sp >> 2) & 1, m = sp & 3;
        f32x4 s0 = {0.f, 0.f, 0.f, 0.f}, s1 = {0.f, 0.f, 0.f, 0.f};
        for (int kk0 = 0; kk0 < CC; kk0 += 4) {
            f32x4 v0[4], v1[4];
#pragma unroll
            for (int kk = 0; kk < 4; ++kk) { const bool ok = kk0 + kk < CC; const float* q = part + (size_t)(x + 8 * (r * CC + (ok ? kk0 + kk : 0))) * 65536 + tid * 4 + sp * 4096;
                v0[kk] = *(const f32x4*)q; v1[kk] = *(const f32x4*)(q + 2048); if (!ok) { v0[kk] = (f32x4){0.f, 0.f, 0.f, 0.f}; v1[kk] = (f32x4){0.f, 0.f, 0.f, 0.f}; } }
#pragma unroll
            for (int kk = 0; kk < 4; ++kk) { s0 += v0[kk]; s1 += v1[kk]; } }
        const int row = u.pm * BM + ai * HALF + wr * 64 + m * 16 + fr;
        *(u32x4*)(C + (size_t)row * ldc + u.pn * BM + bj * HALF + wc * 32 + 8 * fq) = pack8(s0, s1); }
}
struct EpiBf16KS {
    bf16* C; int ldc; float* part; unsigned* cnt; int c;
    EPI_NOPRE
    __device__ __forceinline__ void operator()(const Acc& acc, const Unit& u, int wr, int wc, int fr, int fq, const Pre&) const {
        if (((u.aux >> 4) & 3) != 0) {
            int tid_ = threadIdx.x; asm volatile("" : "+v"(tid_));
            const int k = (u.aux >> 8) & 255, CC = (u.aux >> 16) & 255, r = u.aux >> 24, x = c & 7;
            float* p = part + (size_t)c * 65536 + tid_ * 4;
#pragma unroll
            for (int ai = 0; ai < 2; ++ai)
#pragma unroll
                for (int bj = 0; bj < 2; ++bj)
#pragma unroll
                    for (int m = 0; m < 4; ++m)
#pragma unroll
                        for (int n = 0; n < 2; ++n) *(f32x4*)(p + (((ai * 2 + bj) * 4 + m) * 2 + n) * 2048) = acc[ai][bj][m][n];
            asm volatile("s_waitcnt vmcnt(0)" ::: "memory");
            __syncthreads();
            if (tid_ == 0) { unsigned* w = cnt + x + 8 * r; __hip_atomic_fetch_add(w, 1u, __ATOMIC_RELEASE, __HIP_MEMORY_SCOPE_AGENT);
                while (__hip_atomic_load(w, __ATOMIC_ACQUIRE, __HIP_MEMORY_SCOPE_AGENT) < (unsigned)CC) __builtin_amdgcn_s_sleep(2); }
            __syncthreads();
            ks_reduce(part, x, r, k, CC, tid_, C, ldc, u, wr, wc, fr, fq);
            return;
        }
        EPI_FOR { const int row = EPI_ROW;
#pragma unroll
            for (int bj = 0; bj < 2; ++bj) *(u32x4*)(C + (size_t)row * ldc + EPI_C8(bj)) = pack8(acc[ai][bj][m][0], acc[ai][bj][m][1]);
        }
    }
};
struct EpiF32 {
    float* C; int ldc;
    EPI_NOPRE
    __device__ __forceinline__ void operator()(const Acc& acc, const Unit& u, int wr, int wc, int fr, int fq, const Pre&) const {
        EPI_FOR { const int row = EPI_ROW;
#pragma unroll
            for (int bj = 0; bj < 2; ++bj) { float* cp = C + (size_t)row * ldc + EPI_C8(bj); *(f32x4*)cp = acc[ai][bj][m][0]; *(f32x4*)(cp + 4) = acc[ai][bj][m][1]; }
        }
    }
};
}

namespace att {
#define KSWZ(row, colB) ((row) * 256 + ((colB) ^ (((row) & 7) << 4)))
#define SBAR() __builtin_amdgcn_sched_barrier(0)
constexpr float THR = 8.f;
__device__ __forceinline__ int crow(int r, int hi) { return (r & 3) + 8 * (r >> 2) + 4 * hi; }
template <int NB> __device__ __forceinline__ int v_st(int k, int c) { const int kk = (k & ~0xC) | ((k & 4) << 1) | ((k & 8) >> 1); return ((kk >> 3) * NB + (c >> 5)) * 512 + ((kk & 7) * 32 + (c & 31)) * 2; }
__device__ __forceinline__ int v_rd_base(int lane) { return ((lane & 3) << 3) | (((lane >> 2) & 3) << 6) | (((lane >> 4) & 1) << 5) | (((lane >> 5) & 1) << 8); }
template <int OFF> __device__ __forceinline__ s16x4 tr_read(int vb) { s16x4 r; asm volatile("ds_read_b64_tr_b16 %0, %1 offset:%2" : "=&v"(r) : "v"(vb), "i"(OFF) : "memory"); return r; }

__device__ __forceinline__ void partialSM(f32x16& p0, f32x16& p1, float& m_reg, float& alpha) {
    float pmax = p0[0];
#pragma unroll
    for (int r = 1; r < 16; ++r) pmax = fmaxf(pmax, p0[r]);
#pragma unroll
    for (int r = 0; r < 16; ++r) pmax = fmaxf(pmax, p1[r]);
    { auto rr = __builtin_amdgcn_permlane32_swap(__float_as_uint(pmax), __float_as_uint(pmax), false, false); pmax = fmaxf(__uint_as_float(rr[0]), __uint_as_float(rr[1])); }
    float mn;
    if (__builtin_expect(__all(pmax - m_reg <= THR), 1)) { mn = m_reg; alpha = 1.f; }
    else { mn = fmaxf(m_reg, pmax); alpha = __builtin_amdgcn_exp2f(m_reg - mn); m_reg = mn; }
#pragma unroll
    for (int r = 0; r < 16; ++r) { p0[r] -= mn; p1[r] -= mn; }
#pragma unroll
    for (int r = 0; r < 16; ++r) p0[r] = __builtin_amdgcn_exp2f(p0[r]);
}
__device__ __forceinline__ void finishSM(f32x16& p0, f32x16& p1, float alpha, float& l_reg, bf16x8& pa0, bf16x8& pa1, bf16x8& pa2, bf16x8& pa3) {
#pragma unroll
    for (int r = 0; r < 16; ++r) p1[r] = __builtin_amdgcn_exp2f(p1[r]);
    float ps = 0;
#pragma unroll
    for (int r = 0; r < 16; ++r) ps += p0[r];
#pragma unroll
    for (int r = 0; r < 16; ++r) ps += p1[r];
    { auto rr = __builtin_amdgcn_permlane32_swap(__float_as_uint(ps), __float_as_uint(ps), false, false); ps = __uint_as_float(rr[0]) + __uint_as_float(rr[1]); }
    l_reg = l_reg * alpha + ps;
#define PK4(P, BASE, OUT) do { unsigned a0 = cvt_pk_bf16(P[BASE + 0], P[BASE + 1]), a1 = cvt_pk_bf16(P[BASE + 2], P[BASE + 3]);   \
    unsigned b0 = cvt_pk_bf16(P[BASE + 4], P[BASE + 5]), b1 = cvt_pk_bf16(P[BASE + 6], P[BASE + 7]);                              \
    auto r0 = __builtin_amdgcn_permlane32_swap(a0, b0, false, false); auto r1 = __builtin_amdgcn_permlane32_swap(a1, b1, false, false); \
    u32x4 w = {r0[0], r1[0], r0[1], r1[1]}; OUT = __builtin_bit_cast(bf16x8, w); } while (0)
    PK4(p0, 0, pa0); PK4(p0, 8, pa1); PK4(p1, 0, pa2); PK4(p1, 8, pa3);
#undef PK4
}
template <int ND0> __device__ __forceinline__ void qkt(f32x16& p0, f32x16& p1, const LAS char* Ks, const bf16x8* qr, int r32, int hi, const f32x16& init) {
#pragma unroll
    for (int d0 = 0; d0 < ND0; ++d0) { const int cb = (d0 * 16 + hi * 8) * 2;
        const bf16x8 b0 = *(const LAS bf16x8*)(Ks + KSWZ(r32, cb));
        const bf16x8 b1 = *(const LAS bf16x8*)(Ks + KSWZ(32 + r32, cb));
        p0 = __builtin_amdgcn_mfma_f32_32x32x16_bf16(b0, qr[d0], d0 == 0 ? init : p0, 0, 0, 0);
        p1 = __builtin_amdgcn_mfma_f32_32x32x16_bf16(b1, qr[d0], d0 == 0 ? init : p1, 0, 0, 0); }
}
__device__ __forceinline__ void expA(f32x16& p0) {
#pragma unroll
    for (int r = 0; r < 16; ++r) p0[r] = __builtin_amdgcn_exp2f(p0[r]);
}
template <int NB, int D0> __device__ __forceinline__ void pv_one(f32x16& od, int vb, bf16x8 pa0, bf16x8 pa1, bf16x8 pa2, bf16x8 pa3) {
    const s16x4 l0 = tr_read<(0 * NB + D0) * 512>(vb), h0 = tr_read<(1 * NB + D0) * 512>(vb), l1 = tr_read<(2 * NB + D0) * 512>(vb), h1 = tr_read<(3 * NB + D0) * 512>(vb);
    const s16x4 l2 = tr_read<(4 * NB + D0) * 512>(vb), h2 = tr_read<(5 * NB + D0) * 512>(vb), l3 = tr_read<(6 * NB + D0) * 512>(vb), h3 = tr_read<(7 * NB + D0) * 512>(vb);
    asm volatile("s_waitcnt lgkmcnt(0)" ::: "memory"); SBAR();
#define PK(L, H) (bf16x8){L[0], L[1], L[2], L[3], H[0], H[1], H[2], H[3]}
    od = __builtin_amdgcn_mfma_f32_32x32x16_bf16(pa0, PK(l0, h0), od, 0, 0, 0);
    od = __builtin_amdgcn_mfma_f32_32x32x16_bf16(pa1, PK(l1, h1), od, 0, 0, 0);
    od = __builtin_amdgcn_mfma_f32_32x32x16_bf16(pa2, PK(l2, h2), od, 0, 0, 0);
    od = __builtin_amdgcn_mfma_f32_32x32x16_bf16(pa3, PK(l3, h3), od, 0, 0, 0);
#undef PK
}
template <int NB> __device__ __forceinline__ void pv_all(f32x16* o, int vb, bf16x8 pa0, bf16x8 pa1, bf16x8 pa2, bf16x8 pa3) {
    pv_one<NB, 0>(o[0], vb, pa0, pa1, pa2, pa3); pv_one<NB, 1>(o[1], vb, pa0, pa1, pa2, pa3);
    if constexpr (NB == 4) { pv_one<NB, 2>(o[2], vb, pa0, pa1, pa2, pa3); pv_one<NB, 3>(o[3], vb, pa0, pa1, pa2, pa3); }
}

template <int DQK, int D1, int DVV, bool FIXM>
__device__ __forceinline__ void attn_unit(const bf16* __restrict__ Qb, int ldq, const bf16* __restrict__ K1, int ldk1, const bf16* __restrict__ K2, int ldk2,
                                          const bf16* __restrict__ Vh, int ldv, bf16* __restrict__ Ob, int ldo, int seq, LAS char* lds, float kbound) {
    constexpr int ND0 = DQK / 16, NB = DVV / 32, CK = DQK / 8, CV = DVV / 8;
    constexpr int NKL = (64 * CK + 511) / 512, NVL = (64 * CV) / 512;
    constexpr int SHM_V = 64 * DVV * 2, SHM_K = 64 * 256;
    int tid_ = threadIdx.x; asm volatile("" : "+v"(tid_));
    const int tid = tid_, wid = tid >> 6, lane = tid & 63, r32 = lane & 31, hi = lane >> 5;
    LAS char* V_lds = lds; LAS char* K_lds = lds + 2 * SHM_V;
    LAS float* ws = (LAS float*)(lds + 2 * SHM_V + 2 * SHM_K) + wid * 64; LAS float* li_l = ws; LAS float* al_l = ws + 32;
    float m_reg = -1e30f, l_reg = 0; f32x16 o[NB]; bf16x8 qr[ND0];
#pragma unroll
    for (int d = 0; d < NB; ++d) o[d] = f32x16{};
    const bf16* Qw = Qb + (long)(wid * 32 + r32) * ldq + hi * 8;
#pragma unroll
    for (int d0 = 0; d0 < ND0; ++d0) qr[d0] = *(const bf16x8*)(Qw + d0 * 16);
    f32x16 init = f32x16{};
    if constexpr (FIXM) {
        float q2 = 0.f;
#pragma unroll
        for (int d0 = 0; d0 < ND0; ++d0) { const u32x4 w = __builtin_bit_cast(u32x4, qr[d0]); f32x4 a, b; unpack8(w, a, b); q2 += sumsq4(a) + sumsq4(b); }
        { auto rr = __builtin_amdgcn_permlane32_swap(__float_as_uint(q2), __float_as_uint(q2), false, false); q2 = __uint_as_float(rr[0]) + __uint_as_float(rr[1]); }
        const float nm = -sqrtf(q2) * kbound;
#pragma unroll
        for (int r = 0; r < 16; ++r) init[r] = nm;
        asm volatile("" : "+v"(init));
    }
    const bf16* kp[NKL]; int kstr[NKL], kdst[NKL]; bool kval[NKL];
#pragma unroll
    for (int i = 0; i < NKL; ++i) { const int c = tid + 512 * i; kval[i] = c < 64 * CK; const int cc_ = kval[i] ? c : 0; const int row = cc_ / CK, cc = cc_ % CK;
        if (cc * 8 < D1) { kp[i] = K1 + (long)row * ldk1 + cc * 8; kstr[i] = 64 * ldk1; } else { kp[i] = K2 + (long)row * ldk2 + (cc * 8 - D1); kstr[i] = 64 * ldk2; }
        kdst[i] = KSWZ(row, cc * 16); }
    const bf16* vp[NVL]; int vdst[NVL]; const int vstr = 64 * ldv;
#pragma unroll
    for (int i = 0; i < NVL; ++i) { const int c = tid + 512 * i; const int row = c / CV, cc = c % CV; vp[i] = Vh + (long)row * ldv + cc * 8; vdst[i] = v_st<NB>(row, cc * 8); }
    const int vb0 = (int)(uintptr_t)V_lds + v_rd_base(lane);
    struct { bf16x8 ks[NKL]; bf16x8 vs[NVL]; } sr_[2];
#define SLOAD(i, t) do { _Pragma("unroll") for (int q_ = 0; q_ < NVL; ++q_) sr_[i].vs[q_] = *(const bf16x8*)(vp[q_] + (long)(t) * vstr); \
    _Pragma("unroll") for (int q_ = 0; q_ < NKL; ++q_) { if (kval[q_]) sr_[i].ks[q_] = *(const bf16x8*)(kp[q_] + (long)(t) * kstr[q_]); } } while (0)
#define SWRITE(b, i) do { _Pragma("unroll") for (int q_ = 0; q_ < NVL; ++q_) *(LAS bf16x8*)(V_lds + (b) * SHM_V + vdst[q_]) = sr_[i].vs[q_]; \
    _Pragma("unroll") for (int q_ = 0; q_ < NKL; ++q_) { if (kval[q_]) *(LAS bf16x8*)(K_lds + (b) * SHM_K + kdst[q_]) = sr_[i].ks[q_]; } } while (0)
#define SWAIT() asm volatile("s_waitcnt vmcnt(%0)" :: "n"(NKL + NVL) : "memory")
#define RESC(a) do { if (__any((a) < 1.f)) { if (hi == 0) al_l[r32] = (a); asm volatile("s_waitcnt lgkmcnt(0)" ::: "memory"); \
    _Pragma("unroll") for (int d = 0; d < NB; ++d) _Pragma("unroll") for (int r = 0; r < 16; ++r) o[d][r] *= al_l[crow(r, hi)]; } } while (0)
    f32x16 pA0, pA1, pB0, pB1; float alA = 1.f, alB = 1.f; bf16x8 pa0, pa1, pa2, pa3; const int NT = seq / 64;
#define PSM(P0, P1, AL) do { if constexpr (FIXM) expA(P0); else partialSM(P0, P1, m_reg, AL); } while (0)
#define RSC(AL) do { if constexpr (!FIXM) RESC(AL); } while (0)
    SLOAD(0, 0); asm volatile("s_waitcnt vmcnt(0)" ::: "memory"); SWRITE(0, 0); __syncthreads();
    qkt<ND0>(pA0, pA1, K_lds, qr, r32, hi, init); PSM(pA0, pA1, alA);
    SLOAD(1, 1); if (2 < NT) SLOAD(0, 2);
    SWAIT(); SWRITE(1, 1); __syncthreads();
    for (int j = 1; j + 1 < NT; j += 2) {
        SBAR(); qkt<ND0>(pB0, pB1, K_lds + SHM_K, qr, r32, hi, init);
        finishSM(pA0, pA1, alA, l_reg, pa0, pa1, pa2, pa3); SBAR();
        SLOAD(1, j + 2); SBAR();
        pv_all<NB>(o, vb0, pa0, pa1, pa2, pa3); PSM(pB0, pB1, alB);
        __syncthreads(); SWAIT(); SWRITE(0, 0);
        RSC(alB); __syncthreads();
        SBAR(); qkt<ND0>(pA0, pA1, K_lds, qr, r32, hi, init);
        finishSM(pB0, pB1, alB, l_reg, pa0, pa1, pa2, pa3); SBAR();
        if (j + 3 < NT) SLOAD(0, j + 3); SBAR();
        pv_all<NB>(o, vb0 + SHM_V, pa0, pa1, pa2, pa3); PSM(pA0, pA1, alA);
        __syncthreads(); SWAIT(); SWRITE(1, 1);
        RSC(alA); __syncthreads();
    }
    SBAR(); qkt<ND0>(pB0, pB1, K_lds + SHM_K, qr, r32, hi, init);
    finishSM(pA0, pA1, alA, l_reg, pa0, pa1, pa2, pa3); SBAR();
    pv_all<NB>(o, vb0, pa0, pa1, pa2, pa3); PSM(pB0, pB1, alB);
    __syncthreads(); RSC(alB);
    finishSM(pB0, pB1, alB, l_reg, pa0, pa1, pa2, pa3); SBAR();
    pv_all<NB>(o, vb0 + SHM_V, pa0, pa1, pa2, pa3);
#undef PSM
#undef RSC
    if (hi == 0) li_l[r32] = l_reg; asm volatile("s_waitcnt lgkmcnt(0)" ::: "memory");
    float rli[16];
#pragma unroll
    for (int r = 0; r < 16; ++r) rli[r] = __builtin_amdgcn_rcpf(li_l[crow(r, hi)]);
    bf16* Ow = Ob + (long)(wid * 32) * ldo;
#pragma unroll
    for (int r = 0; r < 16; ++r) { const int orow = crow(r, hi);
#pragma unroll
        for (int d0 = 0; d0 < NB; ++d0) Ow[(long)orow * ldo + d0 * 32 + r32] = f2bf(o[d0][r] * rli[r]); }
    __syncthreads();
#undef SLOAD
#undef SWRITE
#undef SWAIT
#undef RESC
}

#define EXP4(P, B) do { P[B] = __builtin_amdgcn_exp2f(P[B]); P[B + 1] = __builtin_amdgcn_exp2f(P[B + 1]); P[B + 2] = __builtin_amdgcn_exp2f(P[B + 2]); P[B + 3] = __builtin_amdgcn_exp2f(P[B + 3]); } while (0)
#define SUM4(S, P, B) do { S += (P[B] + P[B + 1]) + (P[B + 2] + P[B + 3]); } while (0)
#define PK4X(P, BASE, OUT) do { const u32x4 w_ = {cvt_pk_bf16(P[BASE + 0], P[BASE + 1]), cvt_pk_bf16(P[BASE + 2], P[BASE + 3]), cvt_pk_bf16(P[BASE + 4], P[BASE + 5]), cvt_pk_bf16(P[BASE + 6], P[BASE + 7])}; OUT = __builtin_bit_cast(bf16x8, w_); } while (0)
typedef short v4i16_t __attribute__((ext_vector_type(4)));
__device__ __forceinline__ s16x4 vtr(const LAS char* p) { return __builtin_bit_cast(s16x4, __builtin_amdgcn_ds_read_tr16_b64_v4i16((LAS v4i16_t*)p)); }
#define KSWZ2(row, colB) ((row) * 256 + ((colB) ^ (((row) & 15) << 4)))
template <int DQK, int D1, int DVV>
__device__ __forceinline__ void attn_unit2(const bf16* __restrict__ Qb, int ldq, const bf16* __restrict__ K1, int ldk1, const bf16* __restrict__ K2, int ldk2,
                                           const bf16* __restrict__ Vh, int ldv, bf16* __restrict__ Ob, int ldo, int seq, LAS char* lds, float kbound) {
    constexpr int ND0 = DQK / 16, NB = DVV / 32, CK = DQK / 8;
    constexpr int SHM_V = 64 * DVV * 2, SHM_K = 64 * 256;
    static_assert(NB == 2 && ND0 == 6, "written for QK dim 96 / V dim 64");
    int tid_ = threadIdx.x; asm volatile("" : "+v"(tid_));
    const int tid = tid_, wid = __builtin_amdgcn_readfirstlane(tid >> 6), lane = tid & 63, r32 = lane & 31, hi = lane >> 5;
    LAS char* V_lds = lds; LAS char* K_lds = lds + 3 * SHM_V;
    LAS float* ws = (LAS float*)(lds + 3 * SHM_V + 2 * SHM_K) + wid * 64;
    LAS char* QAL = lds + 3 * SHM_V + 2 * SHM_K + 2048 + wid * (2 * ND0 * 1024) + lane * 16; LAS char* QBL = QAL + ND0 * 1024;
    float nm;
    { bf16x8 qa[ND0], qb[ND0];
      const bf16* QwA = Qb + (long)(wid * 64 + r32) * ldq + hi * 8; const bf16* QwB = QwA + (long)32 * ldq;
#pragma unroll
      for (int d0 = 0; d0 < ND0; ++d0) { qa[d0] = *(const bf16x8*)(QwA + d0 * 16); qb[d0] = *(const bf16x8*)(QwB + d0 * 16); }
      float q2a = 0.f, q2b = 0.f;
#pragma unroll
      for (int d0 = 0; d0 < ND0; ++d0) { f32x4 a, b; unpack8(__builtin_bit_cast(u32x4, qa[d0]), a, b); q2a += sumsq4(a) + sumsq4(b); unpack8(__builtin_bit_cast(u32x4, qb[d0]), a, b); q2b += sumsq4(a) + sumsq4(b);
          *(LAS bf16x8*)(QAL + d0 * 1024) = qa[d0]; *(LAS bf16x8*)(QBL + d0 * 1024) = qb[d0]; }
      { auto rr = __builtin_amdgcn_permlane32_swap(__float_as_uint(q2a), __float_as_uint(q2a), false, false); q2a = __uint_as_float(rr[0]) + __uint_as_float(rr[1]); }
      { auto rr = __builtin_amdgcn_permlane32_swap(__float_as_uint(q2b), __float_as_uint(q2b), false, false); q2b = __uint_as_float(rr[0]) + __uint_as_float(rr[1]); }
      nm = -sqrtf(fmaxf(q2a, q2b)) * kbound; }
    const bf16* kp[2]; int kstr[2];
#pragma unroll
    for (int i = 0; i < 2; ++i) { const int row = 8 * wid + 4 * i + (lane >> 4), cc = (lane & 15) ^ (row & 15);
        if (cc >= 8 && cc < CK) { kp[i] = K2 + (long)row * ldk2 + (cc * 8 - D1); kstr[i] = 64 * ldk2; } else { kp[i] = K1 + (long)row * ldk1 + (cc < 8 ? cc * 8 : 0); kstr[i] = 64 * ldk1; } }
    const bf16* vp; { const int k = 8 * wid + ((lane & 31) >> 2); vp = Vh + (long)k * ldv + (lane >> 5) * 32 + (lane & 3) * 8; }
    const int vstr = 64 * ldv;
    const LAS char* vrd0 = V_lds + v_rd_base(lane);
#define DMA2(t, kb, vbuf) do { \
    __builtin_amdgcn_global_load_lds((const unsigned*)(kp[0] + (long)(t) * kstr[0]), (LAS unsigned*)(K_lds + (kb) * SHM_K + wid * 2048), 16, 0, 0); \
    __builtin_amdgcn_global_load_lds((const unsigned*)(kp[1] + (long)(t) * kstr[1]), (LAS unsigned*)(K_lds + (kb) * SHM_K + wid * 2048 + 1024), 16, 0, 0); \
    __builtin_amdgcn_global_load_lds((const unsigned*)(vp + (long)(t) * vstr), (LAS unsigned*)(V_lds + (vbuf) * SHM_V + wid * 1024), 16, 0, 0); } while (0)
#define VRD8(arr, base, D0) do { _Pragma("unroll") for (int j_ = 0; j_ < 8; ++j_) arr[j_] = vtr((base) + (j_ * NB + (D0)) * 512); } while (0)
#define PKV(arr, ks) (bf16x8){arr[2 * (ks)][0], arr[2 * (ks)][1], arr[2 * (ks)][2], arr[2 * (ks)][3], arr[2 * (ks) + 1][0], arr[2 * (ks) + 1][1], arr[2 * (ks) + 1][2], arr[2 * (ks) + 1][3]}
    f32x16 oA[2], oB[2]; oA[0] = f32x16{}; oA[1] = f32x16{}; oB[0] = f32x16{}; oB[1] = f32x16{};
    float lA = 0.f, lB = 0.f; const int NT = seq / 64;
    f32x16 a0, a1, c0, c1; bf16x8 pa0, pa1, pa2, pa3;
#define HALF1(Kb) do { \
        f32x16 init; { float nmv = nm; asm volatile("" : "+v"(nmv)); _Pragma("unroll") for (int r = 0; r < 16; ++r) init[r] = nmv; } \
        SBAR(); \
        _Pragma("unroll") for (int d0 = 0; d0 < ND0; ++d0) { const int cb = (d0 * 16 + hi * 8) * 2; \
            const bf16x8 k0 = *(const LAS bf16x8*)((Kb) + KSWZ2(r32, cb)), k1 = *(const LAS bf16x8*)((Kb) + KSWZ2(32 + r32, cb)), qv = *(const LAS bf16x8*)(QAL + d0 * 1024); \
            a0 = __builtin_amdgcn_mfma_f32_32x32x16_bf16(k0, qv, d0 == 0 ? init : a0, 0, 0, 0); \
            a1 = __builtin_amdgcn_mfma_f32_32x32x16_bf16(k1, qv, d0 == 0 ? init : a1, 0, 0, 0); } \
        SBAR(); \
        float sA = 0.f; \
        _Pragma("unroll") for (int d0 = 0; d0 < ND0; ++d0) { const int cb = (d0 * 16 + hi * 8) * 2; \
            const bf16x8 k0 = *(const LAS bf16x8*)((Kb) + KSWZ2(r32, cb)), k1 = *(const LAS bf16x8*)((Kb) + KSWZ2(32 + r32, cb)), qv = *(const LAS bf16x8*)(QBL + d0 * 1024); \
            c0 = __builtin_amdgcn_mfma_f32_32x32x16_bf16(k0, qv, d0 == 0 ? init : c0, 0, 0, 0); \
            if (d0 == 3) { EXP4(a0, 0); EXP4(a0, 4); } \
            if (d0 == 4) { EXP4(a0, 12); SUM4(sA, a0, 0); SUM4(sA, a0, 4); EXP4(a1, 0); } \
            if (d0 == 5) { EXP4(a1, 8); SUM4(sA, a1, 0); SUM4(sA, a1, 4); } \
            c1 = __builtin_amdgcn_mfma_f32_32x32x16_bf16(k1, qv, d0 == 0 ? init : c1, 0, 0, 0); \
            if (d0 == 3) { EXP4(a0, 8); } \
            if (d0 == 4) { EXP4(a1, 4); SUM4(sA, a0, 8); SUM4(sA, a0, 12); } \
            if (d0 == 5) { EXP4(a1, 12); SUM4(sA, a1, 8); SUM4(sA, a1, 12); } \
            if (d0 >= 2) SBAR(); } \
        lA += sA; \
        PK4X(a0, 0, pa0); PK4X(a0, 8, pa1); PK4X(a1, 0, pa2); PK4X(a1, 8, pa3); \
        SBAR(); } while (0)
#define HALF2(vbase) do { \
        float sB = 0.f; s16x4 va[8], vb_[8]; \
        VRD8(va, vbase, 0); VRD8(vb_, vbase, 1); \
        oA[0] = __builtin_amdgcn_mfma_f32_32x32x16_bf16(pa0, PKV(va, 0), oA[0], 0, 0, 0); SBAR(); \
        oA[1] = __builtin_amdgcn_mfma_f32_32x32x16_bf16(pa0, PKV(vb_, 0), oA[1], 0, 0, 0); EXP4(c0, 0); EXP4(c0, 4); SBAR(); \
        oA[0] = __builtin_amdgcn_mfma_f32_32x32x16_bf16(pa1, PKV(va, 1), oA[0], 0, 0, 0); EXP4(c0, 8); EXP4(c0, 12); SUM4(sB, c0, 0); SBAR(); \
        oA[1] = __builtin_amdgcn_mfma_f32_32x32x16_bf16(pa1, PKV(vb_, 1), oA[1], 0, 0, 0); EXP4(c1, 0); SUM4(sB, c0, 4); SUM4(sB, c0, 8); SBAR(); \
        oA[0] = __builtin_amdgcn_mfma_f32_32x32x16_bf16(pa2, PKV(va, 2), oA[0], 0, 0, 0); EXP4(c1, 4); SUM4(sB, c0, 12); SBAR(); \
        oA[1] = __builtin_amdgcn_mfma_f32_32x32x16_bf16(pa2, PKV(vb_, 2), oA[1], 0, 0, 0); EXP4(c1, 8); SUM4(sB, c1, 0); SBAR(); \
        oA[0] = __builtin_amdgcn_mfma_f32_32x32x16_bf16(pa3, PKV(va, 3), oA[0], 0, 0, 0); EXP4(c1, 12); SUM4(sB, c1, 4); SBAR(); \
        oA[1] = __builtin_amdgcn_mfma_f32_32x32x16_bf16(pa3, PKV(vb_, 3), oA[1], 0, 0, 0); SUM4(sB, c1, 8); SUM4(sB, c1, 12); SBAR(); \
        lB += sB; \
        PK4X(c0, 0, pa0); PK4X(c0, 8, pa1); PK4X(c1, 0, pa2); PK4X(c1, 8, pa3); \
        SBAR(); \
        VRD8(va, vbase, 0); VRD8(vb_, vbase, 1);                       \
        oB[0] = __builtin_amdgcn_mfma_f32_32x32x16_bf16(pa0, PKV(va, 0), oB[0], 0, 0, 0); \
        oB[1] = __builtin_amdgcn_mfma_f32_32x32x16_bf16(pa0, PKV(vb_, 0), oB[1], 0, 0, 0); \
        oB[0] = __builtin_amdgcn_mfma_f32_32x32x16_bf16(pa1, PKV(va, 1), oB[0], 0, 0, 0); \
        oB[1] = __builtin_amdgcn_mfma_f32_32x32x16_bf16(pa1, PKV(vb_, 1), oB[1], 0, 0, 0); \
        oB[0] = __builtin_amdgcn_mfma_f32_32x32x16_bf16(pa2, PKV(va, 2), oB[0], 0, 0, 0); \
        oB[1] = __builtin_amdgcn_mfma_f32_32x32x16_bf16(pa2, PKV(vb_, 2), oB[1], 0, 0, 0); \
        oB[0] = __builtin_amdgcn_mfma_f32_32x32x16_bf16(pa3, PKV(va, 3), oB[0], 0, 0, 0); \
        oB[1] = __builtin_amdgcn_mfma_f32_32x32x16_bf16(pa3, PKV(vb_, 3), oB[1], 0, 0, 0); \
        SBAR(); } while (0)
#define TILE_BAR() do { asm volatile("s_waitcnt vmcnt(0)" ::: "memory"); __syncthreads(); } while (0)
    DMA2(0, 0, 0);
    if (wid < 4) {
        int vs = 0;
#pragma unroll 1
        for (int t = 0; t < NT; ++t) { TILE_BAR();
            const int vn = vs == 2 ? 0 : vs + 1; if (t + 1 < NT) DMA2(t + 1, (t + 1) & 1, vn);
            HALF1(K_lds + (t & 1) * SHM_K); HALF2(vrd0 + vs * SHM_V); vs = vn; }
        TILE_BAR();
    } else {
        __builtin_amdgcn_s_setprio(1);
        TILE_BAR(); if (1 < NT) DMA2(1, 1, 1);
        HALF1(K_lds);
        int vs = 0;
#pragma unroll 1
        for (int t = 1; t < NT; ++t) { TILE_BAR();
            const int vn = vs == 2 ? 0 : vs + 1; const int vnn = vn == 2 ? 0 : vn + 1; if (t + 1 < NT) DMA2(t + 1, (t + 1) & 1, vnn);
            HALF2(vrd0 + vs * SHM_V); HALF1(K_lds + (t & 1) * SHM_K); vs = vn; }
        TILE_BAR();
        HALF2(vrd0 + vs * SHM_V);
        __builtin_amdgcn_s_setprio(0);
    }
#undef HALF1
#undef HALF2
#undef TILE_BAR
    { auto rr = __builtin_amdgcn_permlane32_swap(__float_as_uint(lA), __float_as_uint(lA), false, false); lA = __uint_as_float(rr[0]) + __uint_as_float(rr[1]); }
    { auto rr = __builtin_amdgcn_permlane32_swap(__float_as_uint(lB), __float_as_uint(lB), false, false); lB = __uint_as_float(rr[0]) + __uint_as_float(rr[1]); }
    if (hi == 0) { ws[r32] = lA; ws[32 + r32] = lB; } asm volatile("s_waitcnt lgkmcnt(0)" ::: "memory");
    bf16* Ow = Ob + (long)(wid * 64) * ldo;
#pragma unroll
    for (int r = 0; r < 16; ++r) { const int orow = crow(r, hi); const float ra = __builtin_amdgcn_rcpf(ws[orow]), rb = __builtin_amdgcn_rcpf(ws[32 + orow]);
#pragma unroll
        for (int d0 = 0; d0 < NB; ++d0) { Ow[(long)orow * ldo + d0 * 32 + r32] = f2bf(oA[d0][r] * ra); Ow[(long)(32 + orow) * ldo + d0 * 32 + r32] = f2bf(oB[d0][r] * rb); } }
    __syncthreads();
#undef DMA2
#undef VRD8
#undef PKV
}
#undef EXP4
#undef SUM4
#undef PK4X

__device__ __forceinline__ void spatial_unit(int chunk, int g, const bf16* __restrict__ U, const bf16* __restrict__ VR, const float* __restrict__ vstat, const float* __restrict__ g_sg,
                                             const bf16* __restrict__ Wsb, const float* __restrict__ b_s, bf16* __restrict__ Y, LAS char* lds) {
    int tid_ = threadIdx.x; asm volatile("" : "+v"(tid_));
    const int tid = tid_, wid = tid >> 6, lane = tid & 63, r32 = lane & 31, hi = lane >> 5, rb = wid & 3, ch = wid >> 2;
    LAS char* V_lds = lds; LAS float* rv = (LAS float*)(lds + 32768);
    const int row0 = chunk * 128;
    if (tid < 128) { const f32x4 s0 = *(const f32x4*)(vstat + (size_t)(row0 + tid) * 8), s1 = *(const f32x4*)(vstat + (size_t)(row0 + tid) * 8 + 4);
        rv[tid] = __builtin_amdgcn_rsqf(((s0[0] + s0[1]) + (s0[2] + s0[3]) + (s1[0] + s1[1]) + (s1[2] + s1[3])) * (1.f / 512.f) + EPS); }
    __syncthreads();
#pragma unroll
    for (int i = 0; i < 4; ++i) { const int c = tid + 512 * i, row = c >> 4, cc = c & 15;
        const u32x4 w = *(const u32x4*)(VR + (size_t)(row0 + row) * 512 + g * 128 + cc * 8); f32x4 a, b; unpack8(w, a, b);
        const f32x4 g0 = *(const f32x4*)(g_sg + g * 128 + cc * 8), g1 = *(const f32x4*)(g_sg + g * 128 + cc * 8 + 4); const float r = rv[row];
        *(LAS u32x4*)(V_lds + (row >> 6) * 16384 + v_st<4>(row & 63, cc * 8)) = pack8(a * r * g0, b * r * g1); }
    bf16x8 pa[8];
#pragma unroll
    for (int ks = 0; ks < 8; ++ks) pa[ks] = *(const bf16x8*)(Wsb + (size_t)g * 16384 + (size_t)(32 * rb + r32) * 128 + 16 * ks + 8 * hi);
    __syncthreads();
    f32x16 o[2]; o[0] = f32x16{}; o[1] = f32x16{};
    const int vb = (int)(uintptr_t)V_lds + v_rd_base(lane) + (2 * ch) * 512;
    pv_one<4, 0>(o[0], vb, pa[0], pa[1], pa[2], pa[3]); pv_one<4, 1>(o[1], vb, pa[0], pa[1], pa[2], pa[3]);
    pv_one<4, 0>(o[0], vb + 16384, pa[4], pa[5], pa[6], pa[7]); pv_one<4, 1>(o[1], vb + 16384, pa[4], pa[5], pa[6], pa[7]);
#pragma unroll
    for (int r = 0; r < 16; ++r) { const int i = 32 * rb + crow(r, hi); const float bias = b_s[g * 128 + i]; const size_t row = (size_t)(row0 + i);
#pragma unroll
        for (int dd = 0; dd < 2; ++dd) { const int c = g * 128 + 64 * ch + 32 * dd + r32; const float uu = bf2f(U[row * 512 + c]);
            Y[row * 1536 + 512 + c] = f2bf(uu * (o[dd][r] + bias)); } }
    __syncthreads();
}
#undef KSWZ
#undef SBAR
}

#define XB_TMO      128
#define XB_XCNT(j)  (256  + 64 * (j))
#define XB_XSUB(j)  (1280 + 64 * (j))
#define XB_XGEN(j)  (2304 + 64 * (j))
#define XB_TOP      3328
#define XB_TOPGEN   3392
#define XCD_BAR_WORDS 3456
#define XB_SPIN_CAP (1u << 18)
__device__ __forceinline__ unsigned xb_ld(unsigned* p)              { return __hip_atomic_load((GAS unsigned*)p, __ATOMIC_RELAXED, __HIP_MEMORY_SCOPE_AGENT); }
__device__ __forceinline__ unsigned xb_add(unsigned* p, unsigned v) { return __hip_atomic_fetch_add((GAS unsigned*)p, v, __ATOMIC_RELAXED, __HIP_MEMORY_SCOPE_AGENT); }
__device__ __forceinline__ unsigned xb_xcc_id() { return (unsigned)__builtin_amdgcn_s_getreg((3 << 11) | 20) & 0xFu; }
#define XB_SPIN(cond, bar) do { unsigned _sp = 0; while (cond) { __builtin_amdgcn_s_sleep(1); \
    if ((++_sp & 255u) == 0u) { if (xb_ld(&(bar)[XB_TMO])) break; if (_sp > XB_SPIN_CAP) { xb_add(&(bar)[XB_TMO], 1u); break; } } } } while (0)
struct XcdBarrier { unsigned* bar; unsigned x; volatile LAS unsigned* st; };
__device__ __forceinline__ XcdBarrier xcd_barrier_post(unsigned* bar, volatile LAS unsigned* st) {
    XcdBarrier b; b.bar = bar; b.x = (unsigned)__builtin_amdgcn_readfirstlane((int)xb_xcc_id()); b.st = st;
    if (threadIdx.x == 0) (void)xb_add(&bar[XB_XCNT(b.x)], 1u);
    return b;
}
__device__ __forceinline__ void xcd_barrier_complete(unsigned* bar, unsigned x, unsigned& nloc, unsigned& nx) {
    const unsigned G = gridDim.x * gridDim.y * gridDim.z;
    unsigned sum, cnt, mine, sp = 0u;
    for (;;) {
        sum = 0u; cnt = 0u; mine = 0u;
#pragma unroll
        for (unsigned j = 0; j < 16; ++j) { const unsigned c = xb_ld(&bar[XB_XCNT(j)]); sum += c; cnt += (c > 0u) ? 1u : 0u; mine = (j == x) ? c : mine; }
        if (sum == G) break;
        __builtin_amdgcn_s_sleep(1);
        if ((++sp & 255u) == 0u) { if (xb_ld(&bar[XB_TMO])) break; if (sp > XB_SPIN_CAP) { xb_add(&bar[XB_TMO], 1u); break; } }
    }
    nloc = mine > 0u ? mine : 1u; nx = cnt > 0u ? cnt : 1u;
}
__device__ __forceinline__ void xcd_barrier(const XcdBarrier& b) {
    asm volatile("s_waitcnt vmcnt(0)" ::: "memory");
    __syncthreads();
    if (threadIdx.x == 0) {
        unsigned* bar = b.bar; unsigned bx = b.x; asm volatile("" : "+s"(bar), "+s"(bx));
        __builtin_amdgcn_s_waitcnt(0);
        unsigned nloc = b.st[0], nx = b.st[1];
        if (nloc == 0u) { xcd_barrier_complete(bar, bx, nloc, nx); b.st[0] = nloc; b.st[1] = nx; }
        const unsigned old = xb_add(&bar[XB_XSUB(bx)], 1u);
        const unsigned gen = old / nloc;
        if (old + 1u == (gen + 1u) * nloc) {
            __builtin_amdgcn_fence(__ATOMIC_RELEASE, "agent");
            asm volatile("s_waitcnt vmcnt(0)" ::: "memory");
            const unsigned og = xb_add(&bar[XB_TOP], 1u);
            const unsigned tg = og / nx;
            if (og + 1u == (tg + 1u) * nx) xb_add(&bar[XB_TOPGEN], 1u);
            else XB_SPIN(xb_ld(&bar[XB_TOPGEN]) == tg, bar);
            __builtin_amdgcn_fence(__ATOMIC_ACQUIRE, "agent");
            xb_add(&bar[XB_XGEN(bx)], 1u);
            asm volatile("s_waitcnt vmcnt(0)" ::: "memory");
        } else {
            XB_SPIN(xb_ld(&bar[XB_XGEN(bx)]) == gen, bar);
            __builtin_amdgcn_fence(__ATOMIC_ACQUIRE, "agent");
            asm volatile("s_waitcnt vmcnt(0)" ::: "memory");
        }
    }
    __syncthreads();
}

enum { CV_NAT = 0, CV_WIN = 1, CV_WUQ = 2, CV_W13 = 3 };
__device__ __forceinline__ int ropeperm(int p) { return ((p >> 2) & 1) * 16 + 4 * (p >> 3) + (p & 3); }
__device__ __forceinline__ int cv_map(int kind, int G, int& which, float& scale, bool& perm) {
    which = 0; scale = 1.f; perm = false; const int n = G * 32;
    if (kind == CV_WIN) {
        if (n < 384) return n;
        if (n < 416) { perm = true; return 640; }
        if (n < 512) return -1;
        if (n < 768) return 384 + (n - 512);
        if (n < 1280) return 672 + (n - 768);
        if (n < 1792) return 1184 + (n - 1280);
        if (n < 2304) { scale = XSCALE; return 1696 + (n - 1792); }
        return 2208 + (n - 2304);
    }
    if (kind == CV_WUQ) { scale = QSCALE; perm = (G % 3) == 2; return n; }
    if (kind == CV_W13) { which = (n >> 7) & 1; return 128 * (n >> 8) + (n & 127); }
    return n;
}
struct CvDesc { const float* src; const float* src2; const float* gain; bf16* dst; int K, Nsrc, Nout, kind; };
__device__ __forceinline__ void cv_item(const CvDesc& d, int item, LAS char* tile, int lane) {
    const int nI = d.Nout >> 7, kb = item / nI, nb = item - kb * nI, k0 = 64 * kb, n0 = 128 * nb;
    const int nq = lane & 31, kh = lane >> 5;
    const int nout = n0 + 4 * nq, G = nout >> 5, p = nout & 31;
    int which; float scale; bool perm; const int sc = cv_map(d.kind, G, which, scale, perm);
    const bool zero = sc < 0;
    const float* W = d.src + (ptrdiff_t)which * (d.src2 - d.src) + (size_t)k0 * d.Nsrc + (zero ? 0 : sc + (perm ? ropeperm(p) : p));
#pragma unroll
    for (int half = 0; half < 2; ++half) {
        f32x4 v[16];
#pragma unroll
        for (int i = 0; i < 16; ++i) { const int k = 32 * half + 2 * i + kh; v[i] = zero ? (f32x4){0.f, 0.f, 0.f, 0.f} : *(const f32x4*)(W + (size_t)k * d.Nsrc); }
#pragma unroll
        for (int i = 0; i < 16; ++i) { const int k = 32 * half + 2 * i + kh; const float g = d.gain ? d.gain[k0 + k] * scale : scale; const f32x4 w = v[i] * g;
            *(LAS u32x2*)(tile + att::v_st<4>(k, 4 * nq)) = (u32x2){cvt_pk_bf16(w[0], w[1]), cvt_pk_bf16(w[2], w[3])}; }
    }
    LDS_WAIT(); asm volatile("" ::: "memory");
    const int vb = (int)(uintptr_t)tile + att::v_rd_base(lane);
    bf16* drow = d.dst + (size_t)(n0 >> 8) * 256 * d.K + (size_t)kb * (256 * 64) + (size_t)((n0 & 255) + nq) * 64 + 8 * kh;
#define CV_RD(D0, KS) { const s16x4 l_ = att::tr_read<((2 * KS) * 4 + D0) * 512>(vb), h_ = att::tr_read<((2 * KS + 1) * 4 + D0) * 512>(vb); \
        asm volatile("s_waitcnt lgkmcnt(0)" ::: "memory"); __builtin_amdgcn_sched_barrier(0); \
        *(bf16x8*)(drow + (32 * D0) * 64 + 16 * KS) = (bf16x8){l_[0], l_[1], l_[2], l_[3], h_[0], h_[1], h_[2], h_[3]}; }
#define CV_RD4(D0) CV_RD(D0, 0) CV_RD(D0, 1) CV_RD(D0, 2) CV_RD(D0, 3)
    CV_RD4(0) CV_RD4(1) CV_RD4(2) CV_RD4(3)
#undef CV_RD4
#undef CV_RD
    LDS_WAIT(); asm volatile("" ::: "memory");
}

struct Args {
    const float* x; const float* mem; const int* positions; const float* g_mix; const float* w_in; const float* g_q; const float* g_kv; const float* w_uq; const float* w_uk; const float* w_uv;
    const float* g_sg; const float* w_s; const float* b_s; const float* g_mem; const float* w_mkv; const float* w_br; const float* b_gate; const float* w_out; const float* g_ffn;
    const float* dense_w1; const float* dense_w3; const float* dense_w2; const float* w_router; const float* moe_w1; const float* moe_w3; const float* moe_w2; const float* g_final;
    float* out; unsigned char* ws; int dbg; int pad;
};
typedef const __attribute__((address_space(4))) Args* ArgsP;
#define FRESH(ap) ArgsP ap = kargs; asm volatile("" : "+s"(ap))
__constant__ double INVF[16] = { 1.0, 0.5623413251903491, 0.31622776601683794, 0.1778279410038923, 0.1, 0.05623413251903491, 0.03162277660168379, 0.01778279410038923,
                                 0.01, 0.005623413251903491, 0.003162277660168379, 0.001778279410038923, 0.001, 0.0005623413251903491, 0.00031622776601683794, 0.0001778279410038923 };

struct Frame { LAS unsigned char* lds; int G, NGW, bid; };
#define LOCAL_IDS int tid = threadIdx.x; asm volatile("" : "+v"(tid)); const int lane = tid & 63, wave = __builtin_amdgcn_readfirstlane(tid >> 6), gw = F.bid * NWAVES + wave; (void)lane; (void)gw

__device__ __forceinline__ void conv_run(const Frame& F, const CvDesc& d) {
    LOCAL_IDS;
    LAS char* tile = (LAS char*)(F.lds + wave * 16384);
    const int nitems = (d.K / 64) * (d.Nout / 128);
    for (int it = gw; it < nitems; it += F.NGW) cv_item(d, it, tile, lane);
}
__device__ __forceinline__ void rx_from_stats(const Frame& F, ArgsP kargs) {
    LOCAL_IDS; FRESH(ap); const float* xstat = (const float*)(ap->ws + WS_XSTAT); float* rx = (float*)(ap->ws + WS_RX);
    for (int row = F.bid * 512 + tid; row < M; row += F.G * 512) {
        const f32x4* p = (const f32x4*)(xstat + (size_t)row * 16); const f32x4 a = p[0], b = p[1], c = p[2], d = p[3];
        const float s = ((a[0] + a[1]) + (a[2] + a[3])) + ((b[0] + b[1]) + (b[2] + b[3])) + ((c[0] + c[1]) + (c[2] + c[3])) + ((d[0] + d[1]) + (d[2] + d[3]));
        rx[row] = __builtin_amdgcn_rsqf(s * (1.f / D) + EPS);
    }
}
template <int MODE>
__device__ __forceinline__ void conv_flat(const Frame& F, ArgsP kargs, int l, int j2, int lmix) {
    int tid_ = threadIdx.x; asm volatile("" : "+v"(tid_)); const int lane_ = tid_ & 63, wave_ = __builtin_amdgcn_readfirstlane(tid_ >> 6);
    LAS char* tile = (LAS char*)(F.lds + wave_ * 16384);
    constexpr int I13D = (D / 64) * (2 * DFF / 128), I2D = (DFF / 64) * (D / 128), I13 = (D / 64) * (2 * DFE / 128), I2 = (DFE / 64) * (D / 128), IE = I13 + I2, IMKV = (D / 64) * (D / 128);
    constexpr int NB_ = MODE == 0 ? DEPTH * IMKV : MODE == 1 ? I13D + I2D : NE * IE;
    constexpr int M_IN = (D / 64) * (PPAD / 128), M_UQ = (QRANK / 64) * (768 / 128), M_UK = (KVRANK / 64) * (512 / 128), M_BR = (BW / 64) * (D / 128), M_OUT = (D / 64) * (D / 128);
    constexpr int O_UQ = M_IN, O_UK = O_UQ + M_UQ, O_UV = O_UK + M_UK, O_BR = O_UV + M_UK, O_OUT = O_BR + 3 * M_BR, NMIX = O_OUT + M_OUT;
    const int total = NB_ + ((lmix >= 0 && lmix < DEPTH) ? NMIX : 0);
#pragma unroll 1
    for (int idx = wave_ * F.G + F.bid; idx < total; idx += F.NGW) { FRESH(a); CvDesc d; int it;
        if (idx < NB_) {
            if constexpr (MODE == 0) { const int lq = idx / IMKV; it = idx - lq * IMKV; d = CvDesc{a->w_mkv + (size_t)lq * D * D, nullptr, nullptr, (bf16*)(a->ws + WS_WMKVT) + (size_t)lq * D * D, D, D, D, CV_NAT}; }
            else if constexpr (MODE == 1) {
                if (idx < I13D) { it = idx; d = CvDesc{a->dense_w1 + (size_t)j2 * D * DFF, a->dense_w3 + (size_t)j2 * D * DFF, a->g_ffn + l * D, (bf16*)(a->ws + WS_WFFN), D, DFF, 2 * DFF, CV_W13}; }
                else { it = idx - I13D; d = CvDesc{a->dense_w2 + (size_t)j2 * DFF * D, nullptr, nullptr, (bf16*)(a->ws + WS_W2D), DFF, D, D, CV_NAT}; } }
            else { const int e = idx / IE, r = idx - e * IE;
                if (r < I13) { it = r; d = CvDesc{a->moe_w1 + ((size_t)j2 * NE + e) * D * DFE, a->moe_w3 + ((size_t)j2 * NE + e) * D * DFE, a->g_ffn + l * D, (bf16*)(a->ws + WS_WFFN) + (size_t)e * 2 * DFE * D, D, DFE, 2 * DFE, CV_W13}; }
                else { it = r - I13; d = CvDesc{a->moe_w2 + ((size_t)j2 * NE + e) * DFE * D, nullptr, nullptr, (bf16*)(a->ws + WS_W2M) + (size_t)e * D * DFE, DFE, D, D, CV_NAT}; } }
        } else { const int r = idx - NB_;
            if (r < O_UQ) { it = r; d = CvDesc{a->w_in + (size_t)lmix * D * PTOT, nullptr, a->g_mix + lmix * D, (bf16*)(a->ws + WS_WINT), D, PTOT, PPAD, CV_WIN}; }
            else if (r < O_UK) { it = r - O_UQ; d = CvDesc{a->w_uq + (size_t)lmix * QRANK * 768, nullptr, a->g_q + lmix * QRANK, (bf16*)(a->ws + WS_WUQT), QRANK, 768, 768, CV_WUQ}; }
            else if (r < O_UV) { it = r - O_UK; d = CvDesc{a->w_uk + (size_t)lmix * KVRANK * 512, nullptr, a->g_kv + lmix * KVRANK, (bf16*)(a->ws + WS_WUKVT), KVRANK, 512, 512, CV_NAT}; }
            else if (r < O_BR) { it = r - O_UV; d = CvDesc{a->w_uv + (size_t)lmix * KVRANK * 512, nullptr, a->g_kv + lmix * KVRANK, (bf16*)(a->ws + WS_WUKVT) + 512 * KVRANK, KVRANK, 512, 512, CV_NAT}; }
            else if (r < O_OUT) { const int n = (r - O_BR) / M_BR; it = (r - O_BR) - n * M_BR; d = CvDesc{a->w_br + ((size_t)lmix * 3 + n) * BW * D, nullptr, nullptr, (bf16*)(a->ws + WS_WBRT) + (size_t)n * D * BW, BW, D, D, CV_NAT}; }
            else { it = r - O_OUT; d = CvDesc{a->w_out + (size_t)lmix * D * D, nullptr, nullptr, (bf16*)(a->ws + WS_WOUTT), D, D, D, CV_NAT}; } }
        cv_item(d, it, tile, lane_); }
    if (lmix >= 0 && lmix < DEPTH) {
        FRESH(a); const float* wsrc = a->w_s + (size_t)lmix * 65536; bf16* wdst = (bf16*)(a->ws + WS_WSB);
        for (int i = F.bid * 512 + tid_; i < 4 * 128 * 128 / 4; i += F.G * 512) { const f32x4 v = *(const f32x4*)(wsrc + (size_t)i * 4);
            *(u32x2*)(wdst + (size_t)i * 4) = (u32x2){cvt_pk_bf16(v[0], v[1]), cvt_pk_bf16(v[2], v[3])}; } }
}
__device__ __forceinline__ void phase_prologue(const Frame& F, ArgsP kargs) {
    LOCAL_IDS;
    { FRESH(a); float* ROPE = (float*)(a->ws + WS_ROPE); const int* pos = a->positions;
      for (int idx = F.bid * 512 + tid; idx < M * 16; idx += F.G * 512) { const int row = idx >> 4, i = idx & 15;
        const double t = (double)pos[row] * INVF[i] * 0.15915494309189535; const float fr = (float)(t - rint(t));
        ROPE[(size_t)row * 32 + i] = __builtin_amdgcn_cosf(fr); ROPE[(size_t)row * 32 + 16 + i] = __builtin_amdgcn_sinf(fr); } }
    { FRESH(a); const float* xin = a->x; float* X = a->out; bf16* XB = (bf16*)(a->ws + WS_XB); float* RX = (float*)(a->ws + WS_RX);
      f32x4 vn[4];
#pragma unroll
      for (int j = 0; j < 4; ++j) vn[j] = ((const f32x4*)(xin + (size_t)gw * D) + lane)[64 * j];
#pragma unroll 1
      for (int m = gw; m < M; m += F.NGW) { f32x4 v[4]; float s = 0.f; const int mn = m + F.NGW < M ? m + F.NGW : m;
#pragma unroll
        for (int j = 0; j < 4; ++j) { v[j] = vn[j]; s += sumsq4(v[j]); }
#pragma unroll
        for (int j = 0; j < 4; ++j) vn[j] = ((const f32x4*)(xin + (size_t)mn * D) + lane)[64 * j];
        s = wave_sum(s);
#pragma unroll
        for (int j = 0; j < 4; ++j) { ((f32x4*)(X + (size_t)m * D) + lane)[64 * j] = v[j]; ((u32x2*)(XB + (size_t)m * D) + lane)[64 * j] = (u32x2){cvt_pk_bf16(v[j][0], v[j][1]), cvt_pk_bf16(v[j][2], v[j][3])}; }
        if (lane == 0) RX[m] = __builtin_amdgcn_rsqf(s * (1.f / D) + EPS); } }
    { FRESH(a); const float* mem = a->mem; const float* g_mem = a->g_mem; bf16* MEMB = (bf16*)(a->ws + WS_MEMB);
      for (int m = gw; m < NMEM; m += F.NGW) { const f32x4* xr = (const f32x4*)(mem + (size_t)m * D) + lane; f32x4 v[4]; float s = 0.f;
#pragma unroll
        for (int j = 0; j < 4; ++j) { v[j] = xr[64 * j]; s += sumsq4(v[j]); }
        const float r = __builtin_amdgcn_rsqf(wave_sum(s) * (1.f / D) + EPS);
#pragma unroll
        for (int j = 0; j < 4; ++j) { const f32x4 g = ((const f32x4*)g_mem + lane)[64 * j]; const f32x4 w = v[j] * r * g;
            ((u32x2*)(MEMB + (size_t)m * D) + lane)[64 * j] = (u32x2){cvt_pk_bf16(w[0], w[1]), cvt_pk_bf16(w[2], w[3])}; } } }
    conv_flat<0>(F, kargs, 0, 0, 0);
}
__device__ __forceinline__ void phase_inproj(const Frame& F, ArgsP kargs, int l) {
    if (PH(1)) { FRESH(a); unsigned char* ws = a->ws;
        pg8::TileOrder S{M / 256, PPAD / 256 - 1, F.G, F.bid, (const char*)(ws + WS_XB), (const char*)(ws + WS_WINT), (size_t)256 * D * 2, (size_t)256 * D * 2};
#ifdef DBG_REV
        S.rev = 1;
#endif
        pg8::EpiInProj E{ws, a->b_gate + (size_t)l * 3 * D, l, (l & 1)};
        pg8::gemm_phase(F.lds, D, D, D, S, E); }
    if (l == 0 && PH(2)) { FRESH(a); unsigned char* ws = a->ws;
        struct MemOrder { enum { VARK = 0, GATHER = 0 }; int c; const char* A; const char* B;
            __device__ __forceinline__ bool next(int i, pg8::Unit& u) const { if (i > 0 || c < 240) return false; const int idx = c - 240; u.pm = 0; u.pn = idx & 3; u.aux = idx >> 2; u.A = A; u.B = B + (size_t)u.aux * D * D * 2 + (size_t)u.pn * 256 * D * 2; return true; } };
        MemOrder S2{F.bid, (const char*)(ws + WS_MEMB), (const char*)(ws + WS_WMKVT)}; pg8::EpiMemKV E2{(bf16*)(ws + WS_KVMEM)};
        pg8::gemm_phase(F.lds, D, D, D, S2, E2); }
}
struct GateTailOrder { enum { VARK = 0, GATHER = 0 }; int c; const char* A; const char* B;
    __device__ __forceinline__ bool next(int i, pg8::Unit& u) const { if (i > 0 || c < 192) return false; u.pm = c - 192; u.pn = PPAD / 256 - 1; u.aux = 0; u.A = A + (size_t)u.pm * 256 * D * 2; u.B = B + (size_t)u.pn * 256 * D * 2; return true; } };
__device__ __forceinline__ void phase_up(const Frame& F, ArgsP kargs, int l) {
    if (PH(1)) { FRESH(a); unsigned char* ws = a->ws;
        GateTailOrder S{F.bid, (const char*)(ws + WS_XB), (const char*)(ws + WS_WINT)}; pg8::EpiInProj E{ws, a->b_gate + (size_t)l * 3 * D, l, (l & 1)};
        pg8::gemm_phase(F.lds, D, D, D, S, E); }
    if (PH(3)) { FRESH(a); unsigned char* ws = a->ws;
        pg8::TileOrder S{M / 256, 3, F.G, F.bid, (const char*)(ws + WS_CQ), (const char*)(ws + WS_WUQT), (size_t)256 * 512 * 2, (size_t)256 * QRANK * 2};
        pg8::EpiQ E{(const float*)(ws + WS_CQSTAT), (const float*)(ws + WS_ROPE), (bf16*)(ws + WS_Q)}; pg8::gemm_phase(F.lds, 512, QRANK, QRANK, S, E); }
    if (PH(4)) { FRESH(a); unsigned char* ws = a->ws;
        pg8::TileOrder S{M / 256, 4, F.G, F.bid, (const char*)(ws + WS_CKV), (const char*)(ws + WS_WUKVT), (size_t)256 * KVRANK * 2, (size_t)256 * KVRANK * 2};
        pg8::EpiKV E{(const float*)(ws + WS_CKVSTAT), (bf16*)(ws + WS_KN), (bf16*)(ws + WS_V), (unsigned*)(ws + WS_CTL) + CW_KMAX + l * 32}; pg8::gemm_phase(F.lds, KVRANK, KVRANK, KVRANK, S, E); }
    if (PH(5)) { FRESH(a); unsigned char* ws = a->ws;
        for (int un = F.bid; un < 512; un += F.G)
            att::spatial_unit(un >> 2, un & 3, (const bf16*)(ws + WS_U), (const bf16*)(ws + WS_VR), (const float*)(ws + WS_VSTAT), a->g_sg + l * BW, (const bf16*)(ws + WS_WSB), a->b_s + l * 512, (bf16*)(ws + WS_Y), (LAS char*)F.lds); }
    if (PH(6)) { FRESH(a); unsigned char* ws = a->ws;
        for (int un = F.bid; un < 256; un += F.G) { const int h = un & 3, pm = un >> 2; const bf16* kvm = (const bf16*)(ws + WS_KVMEM) + (size_t)l * 256 * 1024;
            att::attn_unit<128, 128, 128, false>((const bf16*)(ws + WS_QX) + (size_t)pm * 256 * 512 + h * 128, 512, kvm + h * 128, 1024, kvm, 1024, kvm + 512 + h * 128, 1024,
                                          (bf16*)(ws + WS_Y) + (size_t)pm * 256 * 1536 + 1024 + h * 128, 1536, NMEM, (LAS char*)F.lds, 0.f); } }
}
__device__ __forceinline__ void phase_attn(const Frame& F, ArgsP kargs, int l) {
    if (PH(7)) { FRESH(a); unsigned char* ws = a->ws;
        for (int un = F.bid; un < 256; un += F.G) { const int h = un & 7, qb = un >> 3;
            const unsigned* km = (const unsigned*)(ws + WS_CTL) + CW_KMAX + l * 32;
            const float kbound = sqrtf(__uint_as_float(km[2 * h]) + __uint_as_float(km[2 * h + 1]) + __uint_as_float(km[16])) * 1.02f;
            att::attn_unit2<96, 64, 64>((const bf16*)(ws + WS_Q) + (size_t)qb * 512 * 768 + h * 96, 768, (const bf16*)(ws + WS_KN) + h * 64, 512, (const bf16*)(ws + WS_KR), 32, (const bf16*)(ws + WS_V) + h * 64, 512,
                                        (bf16*)(ws + WS_Y) + (size_t)qb * 512 * 1536 + h * 64, 1536, M, (LAS char*)F.lds, kbound); } }
}
__device__ __forceinline__ void phase_branch(const Frame& F, ArgsP kargs) {
    if (PH(8)) { FRESH(a); unsigned char* ws = a->ws;
        struct BranchOrder { enum { VARK = 0, GATHER = 0 }; int c; const char* A; const char* B;
            __device__ __forceinline__ bool next(int i, pg8::Unit& u) const { if (i >= 3 || c >= 256) return false; int pm, pn; pg8::tile_of(c, 64, 4, pm, pn); u.pm = pm; u.pn = pn; u.aux = i;
                u.A = A + (size_t)pm * 256 * 1536 * 2 + (size_t)i * 512 * 2; u.B = B + (size_t)i * D * BW * 2 + (size_t)pn * 256 * BW * 2; return true; } };
        BranchOrder S{F.bid, (const char*)(ws + WS_Y), (const char*)(ws + WS_WBRT)}; pg8::EpiBranch E{(const unsigned char*)(ws + WS_GATE), (bf16*)(ws + WS_MIXB)};
        pg8::gemm_phase(F.lds, 1536, BW, BW, S, E); }
}
__device__ __forceinline__ void phase_outproj(const Frame& F, ArgsP kargs, bool dummy = false) {
    if (PH(9)) { FRESH(a); unsigned char* ws = a->ws;
        pg8::TileOrder S{M / 256, 4, F.G, F.bid, (const char*)(ws + WS_MIXB), (const char*)(ws + WS_WOUTT), (size_t)256 * D * 2, (size_t)256 * D * 2};
        pg8::EpiResid E{a->out, dummy ? (float*)(ws + 700 * MiB) : a->out, (bf16*)(ws + (dummy ? 764 * MiB : WS_XB)), (float*)(ws + (dummy ? 796 * MiB : WS_XSTAT))}; pg8::gemm_phase(F.lds, 0, D, D, S, E); }
}
__device__ __forceinline__ void phase_dense_conv(const Frame& F, ArgsP kargs, int l, int j2) {
    rx_from_stats(F, kargs);
    conv_flat<1>(F, kargs, l, j2, l + 1);
}
__device__ __forceinline__ void phase_dense_up(const Frame& F, ArgsP kargs) {
    if (PH(10)) { FRESH(a); unsigned char* ws = a->ws;
        pg8::TileOrder S{M / 256, 2 * DFF / 256, F.G, F.bid, (const char*)(ws + WS_XB), (const char*)(ws + WS_WFFN), (size_t)256 * D * 2, (size_t)256 * D * 2};
        pg8::EpiSwiGLU E{(const float*)(ws + WS_RX), (bf16*)(ws + WS_HFF), DFF, 0}; pg8::gemm_phase(F.lds, D, D, D, S, E); }
}
__device__ __forceinline__ void phase_dense_down(const Frame& F, ArgsP kargs, bool dummy = false) {
    if (PH(11)) { FRESH(a); unsigned char* ws = a->ws;
        pg8::TileOrder S{M / 256, 4, F.G, F.bid, (const char*)(ws + WS_HFF), (const char*)(ws + WS_W2D), (size_t)256 * DFF * 2, (size_t)256 * DFF * 2};
        pg8::EpiResid E{a->out, dummy ? (float*)(ws + 700 * MiB) : a->out, (bf16*)(ws + (dummy ? 764 * MiB : WS_XB)), (float*)(ws + (dummy ? 796 * MiB : WS_XSTAT))}; pg8::gemm_phase(F.lds, 0, DFF, DFF, S, E); }
}
__device__ __forceinline__ void phase_moe_route(const Frame& F, ArgsP kargs, int l, int j2) {
    conv_flat<2>(F, kargs, l, j2, l + 1 < DEPTH ? l + 1 : -1);
    __syncthreads();
    LOCAL_IDS; FRESH(a); unsigned char* ws = a->ws; const float* X = a->out;
    float* RX = (float*)(ws + WS_RX); int* TOPI = (int*)(ws + WS_TOPI); float* TOPW = (float*)(ws + WS_TOPW); int* LRANK = (int*)(ws + WS_LRANK); int* BLKCNT = (int*)(ws + WS_BLKCNT);
    LAS int* tope = (LAS int*)(F.lds + 0);
    const float* wr = a->w_router + (size_t)j2 * D * NE; const float* gf = a->g_ffn + l * D;
    f32x4 gvA[4], wA[4][4][2], xn[4];
#pragma unroll
    for (int j = 0; j < 4; ++j) { const int k0 = 4 * lane + 256 * j; gvA[j] = *(const f32x4*)(gf + k0);
#pragma unroll
        for (int q = 0; q < 4; ++q) { wA[j][q][0] = *(const f32x4*)(wr + (size_t)(k0 + q) * 8); wA[j][q][1] = *(const f32x4*)(wr + (size_t)(k0 + q) * 8 + 4); } }
#pragma unroll
    for (int j = 0; j < 4; ++j) xn[j] = *(const f32x4*)(X + (size_t)(F.bid * 64 + wave * 8) * D + 4 * lane + 256 * j);
#pragma unroll 1
    for (int i = 0; i < 8; ++i) { const int rib = wave * 8 + i, row = F.bid * 64 + rib;
        float lg[8]; float ss = 0.f; f32x4 xc[4];
#pragma unroll
        for (int e = 0; e < 8; ++e) lg[e] = 0.f;
#pragma unroll
        for (int j = 0; j < 4; ++j) xc[j] = xn[j];
        if (i + 1 < 8) {
#pragma unroll
            for (int j = 0; j < 4; ++j) xn[j] = *(const f32x4*)(X + (size_t)(row + 1) * D + 4 * lane + 256 * j); }
#pragma unroll
        for (int j = 0; j < 4; ++j) { const f32x4 xv = xc[j], gv = gvA[j]; ss += sumsq4(xv);
#pragma unroll
            for (int q = 0; q < 4; ++q) { const float hv = xv[q] * gv[q]; const f32x4 w0 = wA[j][q][0], w1 = wA[j][q][1];
                lg[0] += hv * w0[0]; lg[1] += hv * w0[1]; lg[2] += hv * w0[2]; lg[3] += hv * w0[3]; lg[4] += hv * w1[0]; lg[5] += hv * w1[1]; lg[6] += hv * w1[2]; lg[7] += hv * w1[3]; } }
        const float r = __builtin_amdgcn_rsqf(wave_sum(ss) * (1.f / D) + EPS);
#pragma unroll
        for (int e = 0; e < 8; ++e) lg[e] = wave_sum(lg[e]) * r;
        int e0 = 0; float v0 = lg[0];
#pragma unroll
        for (int e = 1; e < 8; ++e) if (lg[e] > v0) { v0 = lg[e]; e0 = e; }
        int e1 = e0 == 0 ? 1 : 0; float v1 = -3.0e38f;
#pragma unroll
        for (int e = 0; e < 8; ++e) if (e != e0 && lg[e] > v1) { v1 = lg[e]; e1 = e; }
        const float w0 = 1.f / (1.f + expf(v1 - v0));
        if (lane == 0) { RX[row] = r; TOPI[row] = e0 | (e1 << 8); TOPW[(size_t)row * 2] = w0; TOPW[(size_t)row * 2 + 1] = 1.f - w0; tope[rib] = e0 | (e1 << 8); } }
    __syncthreads();
    if (wave == 0) { const int te = tope[lane], e0 = te & 255, e1 = te >> 8, row = F.bid * 64 + lane; const unsigned long long below = (1ull << lane) - 1ull;
        int rk0 = 0, rk1 = 0;
#pragma unroll
        for (int e = 0; e < 8; ++e) { const unsigned long long m0 = __ballot(e0 == e), m1 = __ballot(e1 == e); const int c0 = __popcll(m0);
            if (e0 == e) rk0 = __popcll(m0 & below); if (e1 == e) rk1 = c0 + __popcll(m1 & below);
            if (lane == 0) BLKCNT[F.bid * 8 + e] = c0 + __popcll(m1); }
        LRANK[(size_t)row * 2] = rk0; LRANK[(size_t)row * 2 + 1] = rk1; }
    __syncthreads();
}
__device__ __forceinline__ void moe_tiles(const Frame& F, ArgsP kargs, int (&tb)[NE + 1], LAS int* pre) {
    LOCAL_IDS; FRESH(a); const int* BLKCNT = (const int*)(a->ws + WS_BLKCNT);
    __syncthreads();
    if (tid < 16) pre[tid] = 0;
    __syncthreads();
    if (tid < 256) { const i32x4 c0 = *(const i32x4*)(BLKCNT + tid * 8), c1 = *(const i32x4*)(BLKCNT + tid * 8 + 4); const int cc[8] = {c0[0], c0[1], c0[2], c0[3], c1[0], c1[1], c1[2], c1[3]};
#pragma unroll
        for (int e = 0; e < 8; ++e) { const int tot = (int)wave_sum((float)cc[e]); const int bel = (int)wave_sum(tid < F.bid ? (float)cc[e] : 0.f);
            if (lane == 0) { __hip_atomic_fetch_add(pre + 8 + e, tot, __ATOMIC_RELAXED, __HIP_MEMORY_SCOPE_WORKGROUP); __hip_atomic_fetch_add(pre + e, bel, __ATOMIC_RELAXED, __HIP_MEMORY_SCOPE_WORKGROUP); } } }
    __syncthreads();
    int acc_t = 0;
#pragma unroll
    for (int e = 0; e < NE; ++e) { tb[e] = acc_t; acc_t += (__builtin_amdgcn_readfirstlane(pre[8 + e]) + 255) >> 8; }
    tb[NE] = acc_t;
}
__device__ __forceinline__ void phase_moe_gather(const Frame& F, ArgsP kargs) {
    int tb[NE + 1]; LAS int* pre = (LAS int*)(F.lds + 0);
    moe_tiles(F, kargs, tb, pre);
    LOCAL_IDS; FRESH(a); unsigned char* ws = a->ws;
    const int* TOPI = (const int*)(ws + WS_TOPI); const int* LRANK = (const int*)(ws + WS_LRANK); int* POS = (int*)(ws + WS_POS); float* SLOTR = (float*)(ws + WS_SLOTR); const float* RX = (const float*)(ws + WS_RX);
    int* TOKOF = (int*)(ws + WS_TOKOF);
    if (lane < 16) { const int pi = wave * 16 + lane, rib = pi >> 1, k = pi & 1, row = F.bid * 64 + rib;
        const int te = TOPI[row], e = k ? (te >> 8) : (te & 255); const int lr = LRANK[(size_t)row * 2 + k]; const float rx = RX[row];
        int bs = 0;
#pragma unroll
        for (int q = 0; q < NE; ++q) if (q == e) bs = tb[q] * 256;
        const int slot = bs + pre[e] + lr;
        POS[(size_t)row * 2 + k] = slot; SLOTR[slot] = rx; TOKOF[slot] = row; }
    if (F.bid < NE) { const int e = F.bid; int b0 = 0, b1 = 0;
#pragma unroll
        for (int q = 0; q < NE; ++q) if (q == e) { b0 = tb[q] * 256; b1 = tb[q + 1] * 256; }
        const int cnt = __builtin_amdgcn_readfirstlane(pre[8 + e]);
        for (int s = b0 + cnt + tid; s < b1; s += NWAVES * 64) { SLOTR[s] = 0.f; TOKOF[s] = 0; } }
    __syncthreads();
}
struct MoeOrder { enum { VARK = 0, GATHER = 0 }; int nN, G, c, T; int tb[NE + 1]; const char* A; const char* B; size_t astep, estep, bstep; int rev = 0;
    __device__ __forceinline__ bool next(int i, pg8::Unit& u) const { const long L = (long)i * G + c; if (L >= (long)T * nN) return false; int pm, pn; pg8::tile_of((int)L, T, nN, pm, pn); if (rev) pm = T - 1 - pm;
        int e = 0;
#pragma unroll
        for (int q = 1; q < NE; ++q) e += (pm >= tb[q]) ? 1 : 0;
        u.pm = pm; u.pn = pn; u.aux = e; u.A = A + (size_t)pm * astep; u.B = B + (size_t)e * estep + (size_t)pn * bstep; return true; } };
struct MoeUpOrder { enum { VARK = 0, GATHER = 1 }; int nN, G, c, T; int tb[NE + 1]; const char* A; const char* B; size_t estep, bstep; const LAS int* tokL;
    __device__ __forceinline__ bool next(int i, pg8::Unit& u) const { const long L = (long)i * G + c; if (L >= (long)T * nN) return false; int pm, pn; pg8::tile_of((int)L, T, nN, pm, pn);
        int e = 0;
#pragma unroll
        for (int q = 1; q < NE; ++q) e += (pm >= tb[q]) ? 1 : 0;
        u.pm = pm; u.pn = pn; u.aux = e; u.A = A; u.B = B + (size_t)e * estep + (size_t)pn * bstep; return true; } };
struct MoeTailOrder { enum { VARK = 1, GATHER = 0 }; static constexpr int PPU = DFE / 128;
    int nN, G, c, T; int tb[NE + 1]; const char* A; const char* B; size_t astep, estep, bstep; int rev = 0;
    __device__ __forceinline__ bool next(int i, pg8::Unit& u) const {
        const int U = T * nN, R = U / G, Lf = U - R * G, x = c & 7, j = c >> 3, nj = (G - x + 7) >> 3;
        const int Lfx = Lf > x ? (Lf - x + 7) >> 3 : 0;
        long L; int k0 = 0, np = PPU, part = 0, k = 0, r = 0, C = 1;
        if (i < R) L = (long)i * G + c;
        else if (i == R && Lfx > 0) { const int cap = nj / Lfx; C = cap >= 8 ? 8 : cap >= 1 ? cap : 1;
            r = j / C; k = j - r * C; if (r >= Lfx) return false;
            L = (long)R * G + x + 8 * r; if (C > 1) { const int q = PPU / C, rem = PPU - q * C; np = q + (k < rem ? 1 : 0); k0 = k * q + (k < rem ? k : rem); part = 3; } }
        else return false;
        int pm, pn; pg8::tile_of((int)L, T, nN, pm, pn); if (rev) pm = T - 1 - pm;
        int e = 0;
#pragma unroll
        for (int q = 1; q < NE; ++q) e += (pm >= tb[q]) ? 1 : 0;
        u.pm = pm; u.pn = pn; u.aux = e | (part << 4) | (k << 8) | (C << 16) | (r << 24); u.nt = 2 * np;
        u.A = A + (size_t)pm * astep + (size_t)k0 * 65536; u.B = B + (size_t)e * estep + (size_t)pn * bstep + (size_t)k0 * 65536; return true; } };
__device__ __forceinline__ void phase_moe_up(const Frame& F, ArgsP kargs) {
    if (PH(12)) { MoeUpOrder S; LAS int* pre = (LAS int*)(F.lds + RING_BYTES + 64); moe_tiles(F, kargs, S.tb, pre);
        FRESH(a); unsigned char* ws = a->ws; S.nN = 2 * DFE / 256; S.G = F.G; S.c = F.bid; S.T = S.tb[NE];
        S.A = (const char*)(ws + WS_XB); S.B = (const char*)(ws + WS_WFFN); S.estep = (size_t)2 * DFE * D * 2; S.bstep = (size_t)256 * D * 2;
        { LAS int* tokL = (LAS int*)(F.lds + RING_BYTES + 1024); S.tokL = tokL; const int* TOKOF = (const int*)(ws + WS_TOKOF);
          int tid_ = threadIdx.x; asm volatile("" : "+v"(tid_)); const int half_ = __builtin_amdgcn_readfirstlane(tid_ >> 8); int tkv[8];
#pragma unroll
          for (int j = 0; j < 8; ++j) { pg8::Unit u; const bool ok = S.next(2 * j + half_, u); tkv[j] = ok ? TOKOF[u.pm * 256 + (tid_ & 255)] : 0; }
#pragma unroll
          for (int j = 0; j < 8; ++j) tokL[(2 * j + half_) * 256 + (tid_ & 255)] = tkv[j];
          __syncthreads(); }
        pg8::EpiSwiGLU E{(const float*)(ws + WS_SLOTR), (bf16*)(ws + WS_HG), DFE, 0}; pg8::gemm_phase(F.lds, D, D, D, S, E); }
}
__device__ __forceinline__ void phase_moe_down(const Frame& F, ArgsP kargs, int j2) {
    if (PH(13)) { MoeTailOrder S; LAS int* pre = (LAS int*)(F.lds + RING_BYTES + 64); moe_tiles(F, kargs, S.tb, pre);
        FRESH(a); unsigned char* ws = a->ws; S.nN = 4; S.G = F.G; S.c = F.bid; S.T = S.tb[NE]; S.rev = 1;
        S.A = (const char*)(ws + WS_HG); S.B = (const char*)(ws + WS_W2M); S.astep = (size_t)256 * DFE * 2; S.estep = (size_t)D * DFE * 2; S.bstep = (size_t)256 * DFE * 2;
        pg8::EpiBf16KS E{(bf16*)(ws + WS_OUTG), D, (float*)(ws + WS_SKPART), (unsigned*)(ws + WS_CTL) + CW_SK + j2 * 512, F.bid}; pg8::gemm_phase(F.lds, 0, DFE, DFE, S, E); }
}
__device__ __forceinline__ void phase_moe_combine(const Frame& F, ArgsP kargs, bool last) {
    LOCAL_IDS; FRESH(a); unsigned char* ws = a->ws; float* X = a->out; const bf16* OUTG = (const bf16*)(ws + WS_OUTG); const int* POS = (const int*)(ws + WS_POS); const float* TOPW = (const float*)(ws + WS_TOPW);
    bf16* XB = (bf16*)(ws + WS_XB); float* RX = (float*)(ws + WS_RX); const float* g_final = a->g_final;
    int s0n, s1n; float w0n, w1n, w0c, w1c; u32x2 pn0[4], pn1[4]; f32x4 xn[4];
    { const int s0 = POS[(size_t)gw * 2], s1 = POS[(size_t)gw * 2 + 1]; w0c = TOPW[(size_t)gw * 2]; w1c = TOPW[(size_t)gw * 2 + 1];
      const int m1 = gw + F.NGW < M ? gw + F.NGW : gw; s0n = POS[(size_t)m1 * 2]; s1n = POS[(size_t)m1 * 2 + 1]; w0n = TOPW[(size_t)m1 * 2]; w1n = TOPW[(size_t)m1 * 2 + 1];
#pragma unroll
      for (int j = 0; j < 4; ++j) { pn0[j] = ((const u32x2*)(OUTG + (size_t)s0 * D) + lane)[64 * j]; pn1[j] = ((const u32x2*)(OUTG + (size_t)s1 * D) + lane)[64 * j]; xn[j] = ((const f32x4*)(X + (size_t)gw * D) + lane)[64 * j]; } }
#pragma unroll 1
    for (int m = gw; m < M; m += F.NGW) {
        const float w0 = w0c, w1 = w1c; u32x2 p0c[4], p1c[4]; f32x4 xc[4];
#pragma unroll
        for (int j = 0; j < 4; ++j) { p0c[j] = pn0[j]; p1c[j] = pn1[j]; xc[j] = xn[j]; }
        { const int mn = m + F.NGW < M ? m + F.NGW : m, mnn = m + 2 * F.NGW < M ? m + 2 * F.NGW : m; const int s0 = s0n, s1 = s1n; w0c = w0n; w1c = w1n;
#pragma unroll
          for (int j = 0; j < 4; ++j) { pn0[j] = ((const u32x2*)(OUTG + (size_t)s0 * D) + lane)[64 * j]; pn1[j] = ((const u32x2*)(OUTG + (size_t)s1 * D) + lane)[64 * j]; xn[j] = ((const f32x4*)(X + (size_t)mn * D) + lane)[64 * j]; }
          s0n = POS[(size_t)mnn * 2]; s1n = POS[(size_t)mnn * 2 + 1]; w0n = TOPW[(size_t)mnn * 2]; w1n = TOPW[(size_t)mnn * 2 + 1]; }
        f32x4 v[4]; float s = 0.f;
#pragma unroll
        for (int j = 0; j < 4; ++j) { const u32x2 p0 = p0c[j], p1 = p1c[j];
            const f32x4 o0 = {bflo(p0.x), bfhi(p0.x), bflo(p0.y), bfhi(p0.y)}, o1 = {bflo(p1.x), bfhi(p1.x), bflo(p1.y), bfhi(p1.y)};
            v[j] = xc[j] + w0 * o0 + w1 * o1; s += sumsq4(v[j]); }
        const float r = __builtin_amdgcn_rsqf(wave_sum(s) * (1.f / D) + EPS);
        if (last) {
#pragma unroll
            for (int j = 0; j < 4; ++j) ((f32x4*)(X + (size_t)m * D) + lane)[64 * j] = v[j] * r * ((const f32x4*)g_final + lane)[64 * j];
        } else {
#pragma unroll
            for (int j = 0; j < 4; ++j) { ((f32x4*)(X + (size_t)m * D) + lane)[64 * j] = v[j]; ((u32x2*)(XB + (size_t)m * D) + lane)[64 * j] = (u32x2){cvt_pk_bf16(v[j][0], v[j][1]), cvt_pk_bf16(v[j][2], v[j][3])}; }
            if (lane == 0) RX[m] = r;
        }
    }
}


#ifdef DBG_ENABLE
__device__ __forceinline__ float dbg_b(const unsigned char* ws, size_t off, size_t idx) { return bf2f(((const bf16*)(ws + off))[idx]); }
__device__ __forceinline__ void dbg_dump(const Frame& F, ArgsP kargs, int code) {
    LOCAL_IDS; FRESH(a); const unsigned char* ws = a->ws; float* out = a->out;
    unsigned tmo = ((const unsigned*)(ws + WS_CTL))[CW_BAR + XB_TMO];
    for (size_t i = (size_t)F.bid * 512 + tid; i < (size_t)M * D; i += (size_t)F.G * 512) { const size_t row = i >> 10, c = i & 1023; float v = 0.f;
        if (code == 1) v = dbg_b(ws, WS_CQ, row * 512 + (c & 511)) + dbg_b(ws, WS_CKV, row * 256 + (c & 255)) + dbg_b(ws, WS_U, row * 512 + (c & 511)) + dbg_b(ws, WS_VR, row * 512 + (c & 511)) + dbg_b(ws, WS_QX, row * 512 + (c & 511))
                         + dbg_b(ws, WS_GATE, row * 3072 + c) + dbg_b(ws, WS_GATE, row * 3072 + 1024 + c) + dbg_b(ws, WS_GATE, row * 3072 + 2048 + c) + dbg_b(ws, WS_KR, row * 32 + (c & 31));
        else if (code == 2) v = dbg_b(ws, WS_Q, row * 768 + (c % 768)) + dbg_b(ws, WS_KN, row * 512 + (c & 511)) + dbg_b(ws, WS_V, row * 512 + (c & 511)) + dbg_b(ws, WS_Y, row * 1536 + 512 + c);
        else if (code == 3) v = dbg_b(ws, WS_Y, row * 1536 + (c & 511));
        else if (code == 15) v = dbg_b(ws, WS_WINT, i % ((size_t)PPAD * D));
        else if (code == 13 || code == 14) v = dbg_b(ws, WS_GATE, row * 3072 + c) + dbg_b(ws, WS_GATE, row * 3072 + 1024 + c) + dbg_b(ws, WS_GATE, row * 3072 + 2048 + c);
        else if (code == 4) v = dbg_b(ws, WS_MIXB, row * 1024 + c);
        else if (code == 6) v = dbg_b(ws, WS_HFF, row * 2688 + c) + dbg_b(ws, WS_HFF, row * 2688 + 1024 + c) + dbg_b(ws, WS_HFF, row * 2688 + 1664 + c);
        else if (code == 9) { const int s0 = ((const int*)(ws + WS_POS))[row * 2], s1 = ((const int*)(ws + WS_POS))[row * 2 + 1]; v = dbg_b(ws, WS_XG, (size_t)s0 * 1024 + c) + 2.f * dbg_b(ws, WS_XG, (size_t)s1 * 1024 + c) + ((const float*)(ws + WS_TOPW))[row * 2] + (float)s0 * 1e-3f; }
        else if (code == 10) { const int s0 = ((const int*)(ws + WS_POS))[row * 2], s1 = ((const int*)(ws + WS_POS))[row * 2 + 1]; v = dbg_b(ws, WS_HG, (size_t)s0 * 3584 + c) + dbg_b(ws, WS_HG, (size_t)s1 * 3584 + 2560 + c) + dbg_b(ws, WS_HG, (size_t)s0 * 3584 + 1500 + c); }
        else if (code == 11) { const int s0 = ((const int*)(ws + WS_POS))[row * 2], s1 = ((const int*)(ws + WS_POS))[row * 2 + 1]; v = ((const float*)(ws + WS_OUTG))[(size_t)s0 * 1024 + c] + ((const float*)(ws + WS_OUTG))[(size_t)s1 * 1024 + c]; }
        else continue;
        if (tmo) v = __builtin_nanf("");
        out[i] = v; }
}
#define DBG(code) do { if (dbgc == (code)) { dbg_dump(F, kargs, code); return; } } while (0)
#else
#define DBG(code) do { } while (0)
#endif

__global__ void __launch_bounds__(NWAVES * 64, 2) fwd_kernel(Args args_by_value) {
    extern __shared__ __attribute__((aligned(16))) unsigned char lds_raw[];
    const ArgsP kargs = (ArgsP)__builtin_amdgcn_kernarg_segment_ptr();
    Frame F; F.lds = (LAS unsigned char*)lds_raw; F.G = gridDim.x; F.bid = blockIdx.x; F.NGW = F.G * NWAVES;
    for (int u = threadIdx.x; u < (LDS_BYTES - LDSCTL_OFF) / 4; u += NWAVES * 64) ((LAS unsigned*)(F.lds + LDSCTL_OFF))[u] = 0u;
    __syncthreads();
    volatile LAS unsigned* MISC = (volatile LAS unsigned*)(F.lds + MISC_OFF);
    XcdBarrier bar; { FRESH(a); bar = xcd_barrier_post((unsigned*)(a->ws + WS_CTL) + CW_BAR, MISC + 8); }
#define GRID_BAR() xcd_barrier(bar)

#ifdef ONLY_TEST
    ONLY_TEST; GRID_BAR(); return;
#endif
    const Frame F_ = F;
    int dbgc; { FRESH(a); dbgc = a->dbg; } (void)dbgc;
    phase_prologue(F, kargs); GRID_BAR();
#pragma unroll 1
    for (int l_ = 0; l_ < DEPTH; ++l_) {
        Frame F = F_; int l = l_; asm volatile("" : "+s"(F.G), "+s"(F.NGW), "+s"(F.bid), "+s"(l));
        const bool moe = (l & 1) != 0; const int j2 = l >> 1;
        if (l == 0) DBG(15);
#ifdef PROBE_INPROJ2
        { int reps = 2; asm volatile("" : "+s"(reps));
#pragma unroll 1
          for (int rep = 0; rep < reps; ++rep) { phase_inproj(F, kargs, l); GRID_BAR(); } }
#else
        phase_inproj(F, kargs, l); GRID_BAR(); if (l == 0) DBG(1); if (l == 0) DBG(14);
#endif
        phase_up(F, kargs, l); GRID_BAR(); if (l == 0) DBG(2);
        phase_attn(F, kargs, l); GRID_BAR(); if (l == 0) DBG(3); if (l == 0) DBG(13);
#ifdef PROBE_ATTN2
        phase_attn(F, kargs, l); GRID_BAR();
#endif
#ifdef PROBE_UP2
        phase_up(F, kargs, l); GRID_BAR();
#endif
        phase_branch(F, kargs); GRID_BAR(); if (l == 0) DBG(4);
#ifdef PROBE_RESID2
        { int reps = 2; asm volatile("" : "+s"(reps));
#pragma unroll 1
          for (int rep = reps - 1; rep >= 0; --rep) { phase_outproj(F, kargs, rep != 0); GRID_BAR(); } }
#else
        phase_outproj(F, kargs); GRID_BAR(); if (l == 0) DBG(5); if (l == 1) DBG(8);
#endif
        if (!moe) {
            phase_dense_conv(F, kargs, l, j2); GRID_BAR();
            phase_dense_up(F, kargs); GRID_BAR(); if (l == 0) DBG(6);
#ifdef PROBE_DENSE2
            phase_dense_up(F, kargs); GRID_BAR();
#endif
#ifdef PROBE_RESID2
            { int reps = 2; asm volatile("" : "+s"(reps));
#pragma unroll 1
              for (int rep = reps - 1; rep >= 0; --rep) { phase_dense_down(F, kargs, rep != 0); GRID_BAR(); } }
#else
            phase_dense_down(F, kargs); GRID_BAR(); if (l == 0) DBG(7);
#endif
        } else {
            phase_moe_route(F, kargs, l, j2); GRID_BAR();
            phase_moe_gather(F, kargs); GRID_BAR(); if (l == 1) DBG(9);
#ifdef PROBE_AUX2
            phase_moe_gather(F, kargs); GRID_BAR();
#endif
            phase_moe_up(F, kargs); GRID_BAR(); if (l == 1) DBG(10);
            phase_moe_down(F, kargs, j2); GRID_BAR(); if (l == 1) DBG(11);
#ifdef PROBE_MOE2
            phase_moe_up(F, kargs); GRID_BAR();
            phase_moe_down(F, kargs, j2); GRID_BAR();
#endif
            phase_moe_combine(F, kargs, l == DEPTH - 1);
            if (l != DEPTH - 1) GRID_BAR();
            if (l == 1) DBG(12);
        }
    }
}

extern "C" void kernel_launch(void* const* d_in, const int* in_sizes, int n_in, void* d_out, int out_size, void* d_ws, size_t ws_size, hipStream_t stream) {
    static int grid = 0;
    if (grid == 0) {
        if (n_in != 27 || in_sizes[0] != M * D || out_size != M * D || ws_size < WS_END) { fprintf(stderr, "kernel_launch: unexpected shapes (n_in %d, in0 %d, out %d, ws %zu)\n", n_in, n_in > 0 ? in_sizes[0] : -1, out_size, ws_size); grid = -1; return; }
        int dev = 0, cus = 0, per_cu = 0;
        if (hipGetDevice(&dev) != hipSuccess || hipDeviceGetAttribute(&cus, hipDeviceAttributeMultiprocessorCount, dev) != hipSuccess) { grid = -1; return; }
        if (hipFuncSetAttribute((const void*)fwd_kernel, hipFuncAttributeMaxDynamicSharedMemorySize, LDS_BYTES) != hipSuccess) { fprintf(stderr, "kernel_launch: hipFuncSetAttribute failed\n"); grid = -1; return; }
        if (hipOccupancyMaxActiveBlocksPerMultiprocessor(&per_cu, (const void*)fwd_kernel, NWAVES * 64, LDS_BYTES) != hipSuccess || per_cu < 1) { fprintf(stderr, "kernel_launch: occupancy query reports %d\n", per_cu); }
        (void)hipGetLastError();
        if (cus != 256) { fprintf(stderr, "kernel_launch: built for 256 CUs, device has %d\n", cus); grid = -1; return; }
        grid = 256;
    }
    if (grid < 0) return;
    if (hipMemsetAsync((char*)d_ws + WS_CTL, 0, CTL_ZERO_BYTES, stream) != hipSuccess) return;
    Args a{};
    a.x = (const float*)d_in[0]; a.mem = (const float*)d_in[1]; a.positions = (const int*)d_in[2]; a.g_mix = (const float*)d_in[3]; a.w_in = (const float*)d_in[4]; a.g_q = (const float*)d_in[5];
    a.g_kv = (const float*)d_in[6]; a.w_uq = (const float*)d_in[7]; a.w_uk = (const float*)d_in[8]; a.w_uv = (const float*)d_in[9]; a.g_sg = (const float*)d_in[10]; a.w_s = (const float*)d_in[11];
    a.b_s = (const float*)d_in[12]; a.g_mem = (const float*)d_in[13]; a.w_mkv = (const float*)d_in[14]; a.w_br = (const float*)d_in[15]; a.b_gate = (const float*)d_in[16]; a.w_out = (const float*)d_in[17];
    a.g_ffn = (const float*)d_in[18]; a.dense_w1 = (const float*)d_in[19]; a.dense_w3 = (const float*)d_in[20]; a.dense_w2 = (const float*)d_in[21]; a.w_router = (const float*)d_in[22];
    a.moe_w1 = (const float*)d_in[23]; a.moe_w3 = (const float*)d_in[24]; a.moe_w2 = (const float*)d_in[25]; a.g_final = (const float*)d_in[26];
    a.out = (float*)d_out; a.ws = (unsigned char*)d_ws;
#ifdef DBG_STOP
    a.dbg = DBG_STOP;
#endif
    hipLaunchKernelGGL(fwd_kernel, dim3(grid), dim3(NWAVES * 64), LDS_BYTES, stream, a);
    const hipError_t le = hipPeekAtLastError();
    if (le != hipSuccess) fprintf(stderr, "kernel_launch: launch failed: %s\n", hipGetErrorName(le));
}
```

```cpp
#include <hip/hip_runtime.h>
#include <cstdio>
#include <cstdint>

#ifndef PH_MASK
#define PH_MASK 0xffffffffu
#endif
#define PH(k) ((PH_MASK >> (k)) & 1u)
#define LAS __attribute__((address_space(3)))
#define GAS __attribute__((address_space(1)))
typedef unsigned short bf16;
typedef short bf16x8 __attribute__((ext_vector_type(8)));
typedef short s16x4 __attribute__((ext_vector_type(4)));
typedef float f32x4 __attribute__((ext_vector_type(4)));
typedef float f32x2 __attribute__((ext_vector_type(2)));
typedef float f32x16 __attribute__((ext_vector_type(16)));
typedef unsigned u32x4 __attribute__((ext_vector_type(4)));
typedef unsigned u32x2 __attribute__((ext_vector_type(2)));
typedef int i32x4 __attribute__((ext_vector_type(4)));

constexpr int M = 16384, D = 1024, DEPTH = 4, NMEM = 256;
constexpr int QRANK = 384, KVRANK = 256, NH = 8, QKD = 96, VD = 64;
constexpr int XH = 4, XD = 128, BW = 512;
constexpr int PTOT = 5280, PPAD = 5376, DFF = 2688, NE = 8, DFE = 3584;
constexpr float EPS = 1e-6f;
constexpr int MAXSLOT = 34816;
constexpr float LOG2E = 1.4426950408889634f;
constexpr float QSCALE = 0.10206207261596575f * LOG2E;
constexpr float XSCALE = 0.08838834764831845f * LOG2E;

constexpr size_t MiB = 1u << 20, KiB = 1u << 10;
constexpr size_t WS_CTL = 0, CTL_ZERO_BYTES = 1 * MiB;
constexpr size_t WS_ROPE = 2 * MiB;
constexpr size_t WS_XSTAT = 4 * MiB;
constexpr size_t WS_RX = 5 * MiB;
constexpr size_t WS_CQSTAT = 5 * MiB + 256 * KiB;
constexpr size_t WS_CKVSTAT = 5 * MiB + 768 * KiB;
constexpr size_t WS_VSTAT = 6 * MiB;
constexpr size_t WS_MEMB = 6 * MiB + 512 * KiB;
constexpr size_t WS_KVMEM = 7 * MiB;
constexpr size_t WS_TOPI = 9 * MiB;
constexpr size_t WS_TOPW = 9 * MiB + 256 * KiB;
constexpr size_t WS_LRANK = 9 * MiB + 512 * KiB;
constexpr size_t WS_POS = 9 * MiB + 768 * KiB;
constexpr size_t WS_BLKCNT = 10 * MiB;
constexpr size_t WS_SLOTR = 10 * MiB + 512 * KiB;
constexpr size_t WS_TOKOF = 10 * MiB + 768 * KiB;
constexpr size_t WS_WSB = 11 * MiB;
constexpr size_t WS_WMKVT = 12 * MiB;
constexpr size_t WS_WINT = 20 * MiB;
constexpr size_t WS_WUQT = 31 * MiB;
constexpr size_t WS_WUKVT = 32 * MiB;
constexpr size_t WS_WBRT = 33 * MiB;
constexpr size_t WS_WOUTT = 36 * MiB;
constexpr size_t WS_WFFN = 40 * MiB;
constexpr size_t WS_W2D = WS_WFFN + 11 * MiB;
constexpr size_t WS_W2M = WS_WFFN + 112 * MiB;
constexpr size_t WS_XB = 208 * MiB;
constexpr size_t WS_CQ = 240 * MiB;
constexpr size_t WS_CKV = 256 * MiB;
constexpr size_t WS_U = 264 * MiB;
constexpr size_t WS_VR = 280 * MiB;
constexpr size_t WS_QX = 296 * MiB;
constexpr size_t WS_GATE = 312 * MiB;
constexpr size_t WS_Q = 408 * MiB;
constexpr size_t WS_KN = 432 * MiB;
constexpr size_t WS_KR = 448 * MiB;
constexpr size_t WS_V = 450 * MiB;
constexpr size_t WS_Y = 466 * MiB;
constexpr size_t WS_MIX = 514 * MiB;
constexpr size_t WS_MIXB = 578 * MiB;
constexpr size_t WS_MIX1 = 610 * MiB;
constexpr size_t WS_HFF = 240 * MiB;
constexpr size_t WS_XG = 240 * MiB;
constexpr size_t WS_HG = 308 * MiB;
constexpr size_t WS_OUTG = 546 * MiB;
constexpr size_t WS_END = 682 * MiB;
constexpr int CW_TMO = 0, CW_CODE = 1, CW_CHK = 2, CW_BAR = 4096;
constexpr int CW_SK = 16384;
constexpr size_t WS_SKPART = 700 * MiB;
constexpr int CW_KMAX = 8192;

constexpr int RING_BYTES = 131072, LDSCTL_OFF = 159744, MISC_OFF = LDSCTL_OFF + 320, LDS_BYTES = 163840;
constexpr int NWAVES = 8;

#define RLX_AGENT __ATOMIC_RELAXED, __HIP_MEMORY_SCOPE_AGENT
#define LDS_WAIT() asm volatile("s_waitcnt lgkmcnt(0)" ::: "memory")
#define VM_WAIT() asm volatile("s_waitcnt vmcnt(0)" ::: "memory")
typedef __bf16 bf16x2_t __attribute__((ext_vector_type(2)));
__device__ __forceinline__ unsigned cvt_pk_bf16(float lo, float hi) { const f32x2 v = {lo, hi}; const bf16x2_t b = __builtin_convertvector(v, bf16x2_t); return __builtin_bit_cast(unsigned, b); }
__device__ __forceinline__ bf16 f2bf(float f) { return (bf16)(cvt_pk_bf16(f, 0.f) & 0xffffu); }
__device__ __forceinline__ float bf2f(bf16 v) { return __uint_as_float((unsigned)v << 16); }
__device__ __forceinline__ float bflo(unsigned w) { return __uint_as_float(w << 16); }
__device__ __forceinline__ float bfhi(unsigned w) { return __uint_as_float(w & 0xffff0000u); }
__device__ __forceinline__ float fast_exp2(float x) { return __builtin_amdgcn_exp2f(x); }
__device__ __forceinline__ float fast_rcp(float x) { return __builtin_amdgcn_rcpf(x); }
__device__ __forceinline__ float sigmoidf_(float z) { return fast_rcp(1.f + fast_exp2(-LOG2E * z)); }
__device__ __forceinline__ float gelu_tanh(float x) { const float t = x + 0.044715f * x * x * x; return x * fast_rcp(1.f + fast_exp2(-2.f * 0.7978845608028654f * LOG2E * t)); }
template <int CTRL> __device__ __forceinline__ float dppf(float v) { return __builtin_bit_cast(float, __builtin_amdgcn_update_dpp(0, __builtin_bit_cast(int, v), CTRL, 0xf, 0xf, true)); }
__device__ __forceinline__ float row_sum16(float v) { v += dppf<0xB1>(v); v += dppf<0x4E>(v); v += dppf<0x124>(v); v += dppf<0x128>(v); return v; }
__device__ __forceinline__ float row_max16(float v) { v = fmaxf(v, dppf<0xB1>(v)); v = fmaxf(v, dppf<0x4E>(v)); v = fmaxf(v, dppf<0x124>(v)); v = fmaxf(v, dppf<0x128>(v)); return v; }
__device__ __forceinline__ float xsum16(float v) { const auto r = __builtin_amdgcn_permlane16_swap(__float_as_uint(v), __float_as_uint(v), false, false); return __uint_as_float(r[0]) + __uint_as_float(r[1]); }
__device__ __forceinline__ float xsum32(float v) { const auto r = __builtin_amdgcn_permlane32_swap(__float_as_uint(v), __float_as_uint(v), false, false); return __uint_as_float(r[0]) + __uint_as_float(r[1]); }
__device__ __forceinline__ float wave_sum(float v) { return xsum32(xsum16(row_sum16(v))); }
__device__ __forceinline__ float sumsq4(f32x4 v) { return (v[0] * v[0] + v[1] * v[1]) + (v[2] * v[2] + v[3] * v[3]); }
__device__ __forceinline__ u32x2 pack8_u8(f32x4 a, f32x4 b) { unsigned w0 = 0, w1 = 0; a = a * 255.f; b = b * 255.f;
    w0 = __builtin_amdgcn_cvt_pk_u8_f32(a[0], 0, w0); w0 = __builtin_amdgcn_cvt_pk_u8_f32(a[1], 1, w0); w0 = __builtin_amdgcn_cvt_pk_u8_f32(a[2], 2, w0); w0 = __builtin_amdgcn_cvt_pk_u8_f32(a[3], 3, w0);
    w1 = __builtin_amdgcn_cvt_pk_u8_f32(b[0], 0, w1); w1 = __builtin_amdgcn_cvt_pk_u8_f32(b[1], 1, w1); w1 = __builtin_amdgcn_cvt_pk_u8_f32(b[2], 2, w1); w1 = __builtin_amdgcn_cvt_pk_u8_f32(b[3], 3, w1);
    return (u32x2){w0, w1}; }
__device__ __forceinline__ void unpack8_u8(u32x2 w, f32x4& a, f32x4& b) { constexpr float k = 1.f / 255.f;
    a = (f32x4){(float)(w.x & 255u), (float)((w.x >> 8) & 255u), (float)((w.x >> 16) & 255u), (float)(w.x >> 24)} * k;
    b = (f32x4){(float)(w.y & 255u), (float)((w.y >> 8) & 255u), (float)((w.y >> 16) & 255u), (float)(w.y >> 24)} * k; }
__device__ __forceinline__ u32x4 pack8(f32x4 a, f32x4 b) { u32x4 w; w.x = cvt_pk_bf16(a[0], a[1]); w.y = cvt_pk_bf16(a[2], a[3]); w.z = cvt_pk_bf16(b[0], b[1]); w.w = cvt_pk_bf16(b[2], b[3]); return w; }
__device__ __forceinline__ void unpack8(u32x4 w, f32x4& a, f32x4& b) { a = (f32x4){bflo(w.x), bfhi(w.x), bflo(w.y), bfhi(w.y)}; b = (f32x4){bflo(w.z), bfhi(w.z), bflo(w.w), bfhi(w.w)}; }

namespace pg8 {
constexpr int BM = 256, BK = 64, HALF = 128, HTB = HALF * BK * 2, STAGE_BYTES = 8 * HTB, NXCD = 8, WGM = 8;
__host__ __device__ __forceinline__ int lds_byte(int r, int c) { const int st = (r >> 4) * 2 + (c >> 5), rr = r & 15, cc = c & 31, ob = rr * 64 + cc * 2; return st * 1024 + (ob ^ (((ob >> 9) & 1) << 5)); }
__host__ __device__ __forceinline__ void stage_rc(int b, int& R, int& C) { const int st = b / 1024, sb = b % 1024, swz = sb ^ (((sb >> 9) & 1) << 5); R = (st >> 1) * 16 + swz / 64; C = (st & 1) * 32 + (swz % 64) / 2; }
__host__ __device__ __forceinline__ int perm32(int rho) { const int n = rho >> 4, i = rho & 15; return 8 * (i >> 2) + 4 * n + (i & 3); }

struct Unit { const char* A; const char* B; int pm, pn, aux, nt; };
typedef f32x4 Acc[2][2][4][2];

__device__ __forceinline__ void tile_of(int L, int nM, int nN, int& pm, int& pn) {
    const int nwg = nM * nN; int wgid = L;
    { const int q = nwg / NXCD, r = nwg % NXCD, xcd = wgid % NXCD, off = wgid / NXCD; wgid = (xcd < r ? xcd * (q + 1) : r * (q + 1) + (xcd - r) * q) + off; }
    const int nig = WGM * nN, gid = wgid / nig, fm = gid * WGM, gsz = (nM - fm) < WGM ? (nM - fm) : WGM;
    pm = fm + ((wgid % nig) % gsz); pn = (wgid % nig) / gsz;
}
struct TileOrder {
    enum { VARK = 0, GATHER = 0 };
    int nM, nN, G, c; const char* A; const char* B; size_t astep, bstep;
    int rev = 0;
    __device__ __forceinline__ bool next(int i, Unit& u) const {
        if (rev) { const int cnt = (nM * nN - c + G - 1) / G; if (i >= cnt) return false; i = cnt - 1 - i; }
        const long L = (long)i * G + c; if (L >= (long)nM * nN) return false;
        int pm, pn; tile_of((int)L, nM, nN, pm, pn);
        u.pm = pm; u.pn = pn; u.aux = 0; u.A = A + (size_t)pm * astep; u.B = B + (size_t)pn * bstep; return true;
    }
};

template <class Epi, class Sched>
__device__ __forceinline__ void gemm_phase(LAS unsigned char* lds, const int lda, const int ldb, const int K, const Sched& S, const Epi& E) {
    int tid_ = threadIdx.x; asm volatile("" : "+v"(tid_));
    const int tid = tid_, wid = __builtin_amdgcn_readfirstlane(tid >> 6), lane = tid & 63, wr = wid >> 2, wc = wid & 3, fr = lane & 15, fq = lane >> 4;
    int nt = K / BK;
    unsigned voffA[2], voffB[2];
#pragma unroll
    for (int i = 0; i < 2; ++i) { int R, C; stage_rc(tid * 16 + i * 8192, R, C); const int Rb = (R & ~31) + perm32(R & 31);
        voffA[i] = (unsigned)(R * (lda ? lda : BK) + C) * 2u; voffB[i] = (unsigned)(Rb * BK + C) * 2u; }
    const size_t kstep = lda ? (size_t)(BK * 2) : (size_t)BM * BK * 2;
    const size_t hstepA = (size_t)HALF * (lda ? lda : BK) * 2, hstepB = (size_t)HALF * BK * 2, kstepB = (size_t)BM * BK * 2; (void)ldb;
    const unsigned ldsw = (unsigned)wid * 1024u;
    const int aoff = lds_byte(wr * 64 + fr, fq * 8), boff = lds_byte(wc * 32 + fr, fq * 8);
#define PG8_SA(b, h) (((b) * 2 + (h)) * HTB)
#define PG8_SB(b, h) ((4 + (b) * 2 + (h)) * HTB)
#define PG8_STAGE(bufoff, gbase, voff) do { _Pragma("unroll") for (int _i = 0; _i < 2; ++_i) \
        __builtin_amdgcn_global_load_lds((const unsigned*)((const char*)(gbase) + (voff)[_i]), (LAS unsigned*)(lds + (bufoff) + ldsw + _i * 8192), 16, 0, 0); } while (0)
#define PG8_STA(b, h, kptr, VG) do { if constexpr (Sched::GATHER) PG8_STAGE(PG8_SA(b, h), (kptr), VG[h]); else PG8_STAGE(PG8_SA(b, h), (kptr) + (h) * hstepA, voffA); } while (0)
#define PG8_GLOOKUP(VG, ui_) do { _Pragma("unroll") for (int _h = 0; _h < 2; ++_h) _Pragma("unroll") for (int _i = 0; _i < 2; ++_i) { int R_, C_; stage_rc(tid * 16 + _i * 8192, R_, C_); \
        VG[_h][_i] = (unsigned)S.tokL[(ui_) * 256 + _h * 128 + R_] * (unsigned)(lda * 2) + (unsigned)(C_ * 2); } } while (0)
#define PG8_LDA(dst, b, h) do { _Pragma("unroll") for (int m = 0; m < 4; ++m) _Pragma("unroll") for (int k = 0; k < 2; ++k) dst[m][k] = *(const LAS bf16x8*)(lds + PG8_SA(b, h) + aoff + m * 2048 + k * 1024); } while (0)
#define PG8_LDB(dst, b, h) do { _Pragma("unroll") for (int n = 0; n < 2; ++n) _Pragma("unroll") for (int k = 0; k < 2; ++k) dst[n][k] = *(const LAS bf16x8*)(lds + PG8_SB(b, h) + boff + n * 2048 + k * 1024); } while (0)
#define PG8_MMA(ai, bj, At, Bt) do { __builtin_amdgcn_s_setprio(1); _Pragma("unroll") for (int m = 0; m < 4; ++m) _Pragma("unroll") for (int n = 0; n < 2; ++n) _Pragma("unroll") for (int k = 0; k < 2; ++k) \
        acc[ai][bj][m][n] = __builtin_amdgcn_mfma_f32_16x16x32_bf16(Bt[n][k], At[m][k], acc[ai][bj][m][n], 0, 0, 0); __builtin_amdgcn_s_setprio(0); } while (0)
#define PG8_WAIT_V(n) asm volatile("s_waitcnt vmcnt(" #n ")" ::: "memory")
#define PG8_WAIT_L(n) asm volatile("s_waitcnt lgkmcnt(" #n ")" ::: "memory")
#define PG8_BAR __builtin_amdgcn_s_barrier()
#define PG8_SCHED __builtin_amdgcn_sched_barrier(0)
    Unit cur, nxt; int ui = 0;
    if (!S.next(0, cur)) return;
    if constexpr (Sched::VARK) nt = cur.nt;
    typename Epi::Pre pre = E.prefetch(cur, wr, fr);
    Acc acc;
#pragma unroll
    for (int a = 0; a < 2; ++a)
#pragma unroll
        for (int b = 0; b < 2; ++b)
#pragma unroll
            for (int m = 0; m < 4; ++m)
#pragma unroll
                for (int n = 0; n < 2; ++n) acc[a][b][m][n] = (f32x4){0.f, 0.f, 0.f, 0.f};
    bf16x8 At[4][2], B0[2][2], B1[2][2];
    const char* cA = cur.A; const char* cB = cur.B;
    unsigned vg[2][2] = {{0u, 0u}, {0u, 0u}}; if constexpr (Sched::GATHER) PG8_GLOOKUP(vg, 0);
    PG8_STAGE(PG8_SB(0, 0), cB, voffB); PG8_STAGE(PG8_SB(0, 1), cB + hstepB, voffB); PG8_STA(0, 0, cA, vg); PG8_STA(0, 1, cA, vg);
    if (wr == 1) PG8_BAR;
    PG8_WAIT_V(2); PG8_BAR;
    PG8_STAGE(PG8_SB(1, 0), cB + kstepB, voffB); PG8_STA(1, 0, cA + kstep, vg); PG8_STAGE(PG8_SB(1, 1), cB + hstepB + kstepB, voffB);
    PG8_WAIT_V(6); PG8_BAR;
    for (;;) {
        const bool has_next = S.next(ui + 1, nxt);
        const char* nA = has_next ? nxt.A : cA; const char* nB = has_next ? nxt.B : cB;
        for (int t = 0; t < nt; t += 2) {
            const bool last = (t == nt - 2);
            const char* a1 = cA + (size_t)(t + 1) * kstep;
            const char* a2 = last ? nA : cA + (size_t)(t + 2) * kstep; const char* b2 = last ? nB : cB + (size_t)(t + 2) * kstepB;
            const char* a3 = a2 + kstep; const char* b3 = b2 + kstepB;
            PG8_LDB(B0, 0, 0); PG8_LDB(B1, 0, 1); PG8_SCHED; PG8_LDA(At, 0, 0); PG8_STA(1, 1, a1, vg);
            if constexpr (Sched::GATHER) { if (last && has_next) PG8_GLOOKUP(vg, ui + 1); }
            PG8_WAIT_V(8); PG8_WAIT_L(0); PG8_BAR; PG8_MMA(0, 0, At, B0); PG8_MMA(0, 1, At, B1); PG8_BAR; PG8_SCHED;
            PG8_LDA(At, 0, 1); PG8_STAGE(PG8_SB(0, 0), b2, voffB); PG8_STAGE(PG8_SB(0, 1), b2 + hstepB, voffB); PG8_STA(0, 0, a2, vg);
            PG8_WAIT_V(8); PG8_WAIT_L(0); PG8_BAR; PG8_MMA(1, 0, At, B0); PG8_MMA(1, 1, At, B1); PG8_BAR; PG8_SCHED;
            PG8_LDB(B0, 1, 0); PG8_LDB(B1, 1, 1); PG8_SCHED; PG8_LDA(At, 1, 0); PG8_STA(0, 1, a2, vg);
            PG8_WAIT_V(8); PG8_WAIT_L(0); PG8_BAR; PG8_MMA(0, 0, At, B0); PG8_MMA(0, 1, At, B1); PG8_BAR; PG8_SCHED;
            PG8_LDA(At, 1, 1); PG8_STAGE(PG8_SB(1, 0), b3, voffB); PG8_STAGE(PG8_SB(1, 1), b3 + hstepB, voffB); PG8_STA(1, 0, a3, vg);
            PG8_WAIT_V(8); PG8_WAIT_L(0); PG8_BAR; PG8_MMA(1, 0, At, B0); PG8_MMA(1, 1, At, B1); PG8_BAR; PG8_SCHED;
        }
        if (wr == 0) PG8_BAR;
        E(acc, cur, wr, wc, fr, fq, pre);
        if (!has_next) break;
        pre = E.prefetch(nxt, wr, fr);
        if constexpr (!Epi::KEEP_ACC)
#pragma unroll
        for (int a = 0; a < 2; ++a)
#pragma unroll
            for (int b = 0; b < 2; ++b)
#pragma unroll
                for (int m = 0; m < 4; ++m)
#pragma unroll
                    for (int n = 0; n < 2; ++n) acc[a][b][m][n] = (f32x4){0.f, 0.f, 0.f, 0.f};
        cur = nxt; cA = nA; cB = nB; ++ui;
        if constexpr (Sched::VARK) nt = cur.nt;
        if (wr == 1) PG8_BAR;
    }
    PG8_WAIT_V(0);
    PG8_BAR;
#undef PG8_SA
#undef PG8_SB
#undef PG8_STAGE
#undef PG8_LDA
#undef PG8_STA
#undef PG8_GLOOKUP
#undef PG8_LDB
#undef PG8_MMA
#undef PG8_WAIT_V
#undef PG8_WAIT_L
#undef PG8_BAR
#undef PG8_SCHED
}

#define EPI_FOR _Pragma("unroll") for (int ai = 0; ai < 2; ++ai) _Pragma("unroll") for (int m = 0; m < 4; ++m)
#define EPI_ROW (u.pm * BM + ai * HALF + wr * 64 + m * 16 + fr)
#define EPI_C8(bj) (u.pn * BM + (bj) * HALF + wc * 32 + 8 * fq)
#define EPI_LOAD_R(rr, ptr) float rr[2][4]; _Pragma("unroll") for (int ai = 0; ai < 2; ++ai) _Pragma("unroll") for (int m = 0; m < 4; ++m) rr[ai][m] = (ptr)[EPI_ROW]; asm volatile("" ::: "memory")

#define EPI_LOAD_RS(rr, xstat) float rr[2][4]; { f32x4 st_[2][4]; _Pragma("unroll") for (int ai = 0; ai < 2; ++ai) _Pragma("unroll") for (int m = 0; m < 4; ++m) st_[ai][m] = *(const f32x4*)((xstat) + (size_t)EPI_ROW * 16 + 4 * fq); \
    asm volatile("" ::: "memory"); _Pragma("unroll") for (int ai = 0; ai < 2; ++ai) _Pragma("unroll") for (int m = 0; m < 4; ++m) { float t_ = (st_[ai][m][0] + st_[ai][m][1]) + (st_[ai][m][2] + st_[ai][m][3]); \
        t_ = xsum32(xsum16(t_)); rr[ai][m] = __builtin_amdgcn_rsqf(t_ * (1.f / D) + EPS); } }
struct NoPre {};
#define EPI_NOPRE static constexpr bool KEEP_ACC = false; typedef NoPre Pre; __device__ __forceinline__ Pre prefetch(const Unit&, int, int) const { return Pre{}; }
struct RowPre { float r[2][4]; };
struct EpiInProj {
    unsigned char* ws; const float* bgate; int layer; int from_stats;
    static constexpr bool KEEP_ACC = false; typedef RowPre Pre;
    __device__ __forceinline__ Pre prefetch(const Unit& u, int wr, int fr) const { Pre p; const float* rx = (const float*)(ws + WS_RX);
#pragma unroll
        for (int ai = 0; ai < 2; ++ai)
#pragma unroll
            for (int m = 0; m < 4; ++m) p.r[ai][m] = from_stats ? 0.f : rx[EPI_ROW];
        return p; }
    __device__ __forceinline__ void operator()(const Acc& acc, const Unit& u, int wr, int wc, int fr, int fq, const Pre& pre) const {
        const float* rx = (const float*)(ws + WS_RX); const float* rope = (const float*)(ws + WS_ROPE);
        bf16* CQ = (bf16*)(ws + WS_CQ); bf16* KR = (bf16*)(ws + WS_KR); bf16* CKV = (bf16*)(ws + WS_CKV); bf16* U = (bf16*)(ws + WS_U); bf16* VR = (bf16*)(ws + WS_VR); bf16* QX = (bf16*)(ws + WS_QX); bf16* GATE = (bf16*)(ws + WS_GATE);
        float* cqstat = (float*)(ws + WS_CQSTAT); float* ckvstat = (float*)(ws + WS_CKVSTAT); float* vstat = (float*)(ws + WS_VSTAT); unsigned* kmax = (unsigned*)(ws + WS_CTL) + CW_KMAX + layer * 32;
        const int pn = u.pn;
        float rr[2][4];
        if (from_stats) { EPI_LOAD_RS(rs_, (const float*)(ws + WS_XSTAT));
#pragma unroll
            for (int ai = 0; ai < 2; ++ai)
#pragma unroll
                for (int m = 0; m < 4; ++m) rr[ai][m] = rs_[ai][m]; }
        else {
#pragma unroll
            for (int ai = 0; ai < 2; ++ai)
#pragma unroll
                for (int m = 0; m < 4; ++m) rr[ai][m] = pre.r[ai][m]; }
        if (pn < 2) {
            float krmax = 0.f;
            EPI_FOR { const int row = EPI_ROW;
                const float r = rr[ai][m]; float ss = 0.f;
#pragma unroll
                for (int bj = 0; bj < 2; ++bj) { const f32x4 v0 = acc[ai][bj][m][0] * r, v1 = acc[ai][bj][m][1] * r;
                    if (!(pn == 1 && bj == 1)) ss += sumsq4(v0) + sumsq4(v1);
                    *(u32x4*)(CQ + (size_t)row * 512 + pn * 256 + bj * HALF + wc * 32 + 8 * fq) = pack8(v0, v1);
                    if (pn == 1 && bj == 1 && wc == 0) {
                        const f32x4 c = *(const f32x4*)(rope + (size_t)row * 32 + 4 * fq), s = *(const f32x4*)(rope + (size_t)row * 32 + 16 + 4 * fq);
                        const f32x4 o0 = v0 * c - v1 * s, o1 = v0 * s + v1 * c;
                        *(u32x4*)(KR + (size_t)row * 32 + 8 * fq) = pack8(o0, o1);
                        float q2 = sumsq4(o0) + sumsq4(o1); q2 = xsum32(xsum16(q2)); krmax = fmaxf(krmax, q2); } }
                ss = xsum32(xsum16(ss));
                if (fq == 0) cqstat[(size_t)row * 8 + pn * 4 + wc] = ss;
            }
            if (pn == 1 && wc == 0) {
                krmax = row_max16(krmax);
                if ((fr | fq) == 0) atomicMax(kmax + 16, __float_as_uint(krmax)); }
        } else if (pn == 2) {
            EPI_FOR { const int row = EPI_ROW;
                const float r = rr[ai][m]; float ss = 0.f;
#pragma unroll
                for (int bj = 0; bj < 2; ++bj) { const f32x4 v0 = acc[ai][bj][m][0] * r, v1 = acc[ai][bj][m][1] * r; ss += sumsq4(v0) + sumsq4(v1);
                    *(u32x4*)(CKV + (size_t)row * 256 + bj * HALF + wc * 32 + 8 * fq) = pack8(v0, v1); }
                ss = xsum32(xsum16(ss));
                if (fq == 0) ckvstat[(size_t)row * 4 + wc] = ss;
            }
        } else if (pn < 7) {
            const bool isv = pn >= 5; bf16* dst = isv ? VR : U; const int t = isv ? pn - 5 : pn - 3;
            EPI_FOR { const int row = EPI_ROW;
                const float r = rr[ai][m]; float ss = 0.f;
#pragma unroll
                for (int bj = 0; bj < 2; ++bj) { f32x4 v0 = acc[ai][bj][m][0] * r, v1 = acc[ai][bj][m][1] * r;
#pragma unroll
                    for (int e = 0; e < 4; ++e) { v0[e] = gelu_tanh(v0[e]); v1[e] = gelu_tanh(v1[e]); }
                    ss += sumsq4(v0) + sumsq4(v1);
                    *(u32x4*)(dst + (size_t)row * 512 + t * 256 + bj * HALF + wc * 32 + 8 * fq) = pack8(v0, v1); }
                if (isv) { ss = xsum32(xsum16(ss)); if (fq == 0) vstat[(size_t)row * 8 + t * 4 + wc] = ss; }
            }
        } else if (pn < 9) {
            EPI_FOR { const int row = EPI_ROW;
                const float r = rr[ai][m];
#pragma unroll
                for (int bj = 0; bj < 2; ++bj) *(u32x4*)(QX + (size_t)row * 512 + (pn - 7) * 256 + bj * HALF + wc * 32 + 8 * fq) = pack8(acc[ai][bj][m][0] * r, acc[ai][bj][m][1] * r);
            }
        } else {
            const int gc0 = (pn - 9) * 256 + wc * 32 + 8 * fq;
            f32x4 bg[2][2];
#pragma unroll
            for (int bj = 0; bj < 2; ++bj) { bg[bj][0] = *(const f32x4*)(bgate + gc0 + bj * HALF); bg[bj][1] = *(const f32x4*)(bgate + gc0 + bj * HALF + 4); }
            EPI_FOR { const int row = EPI_ROW;
                const float r = rr[ai][m];
#pragma unroll
                for (int bj = 0; bj < 2; ++bj) { f32x4 v0 = acc[ai][bj][m][0] * r + bg[bj][0], v1 = acc[ai][bj][m][1] * r + bg[bj][1];
#pragma unroll
                    for (int e = 0; e < 4; ++e) { v0[e] = sigmoidf_(v0[e]); v1[e] = sigmoidf_(v1[e]); }
#ifdef DBG_CONSTGATE
                    v0 = acc[ai][bj][m][0] * r; v1 = acc[ai][bj][m][1] * r;
#endif
                    *(u32x2*)((unsigned char*)GATE + (size_t)row * 3072 + gc0 + bj * HALF) = pack8_u8(v0, v1); }
            }
        }
    }
};
struct EpiMemKV {
    bf16* KV;
    EPI_NOPRE
    __device__ __forceinline__ void operator()(const Acc& acc, const Unit& u, int wr, int wc, int fr, int fq, const Pre&) const {
        EPI_FOR { const int row = EPI_ROW;
#pragma unroll
            for (int bj = 0; bj < 2; ++bj) *(u32x4*)(KV + (size_t)u.aux * 256 * 1024 + (size_t)row * 1024 + EPI_C8(bj)) = pack8(acc[ai][bj][m][0], acc[ai][bj][m][1]);
        }
    }
};
struct EpiQ {
    const float* cqstat; const float* rope; bf16* Q;
    EPI_NOPRE
    __device__ __forceinline__ void operator()(const Acc& acc, const Unit& u, int wr, int wc, int fr, int fq, const Pre&) const {
        EPI_FOR { const int row = EPI_ROW;
            const f32x4 s0 = *(const f32x4*)(cqstat + (size_t)row * 8), s1 = *(const f32x4*)(cqstat + (size_t)row * 8 + 4);
            const float r = __builtin_amdgcn_rsqf(((s0[0] + s0[1]) + (s0[2] + s0[3]) + (s1[0] + s1[1]) + (s1[2] + s1[3])) * (1.f / QRANK) + EPS);
#pragma unroll
            for (int bj = 0; bj < 2; ++bj) { f32x4 v0 = acc[ai][bj][m][0] * r, v1 = acc[ai][bj][m][1] * r;
                if (((8 * u.pn + 4 * bj + wc) % 3) == 2) {
                    const f32x4 c = *(const f32x4*)(rope + (size_t)row * 32 + 4 * fq), s = *(const f32x4*)(rope + (size_t)row * 32 + 16 + 4 * fq);
                    const f32x4 o0 = v0 * c - v1 * s, o1 = v0 * s + v1 * c; v0 = o0; v1 = o1; }
                *(u32x4*)(Q + (size_t)row * 768 + EPI_C8(bj)) = pack8(v0, v1); }
        }
    }
};
struct EpiKV {
    const float* ckvstat; bf16* KN; bf16* V; unsigned* kmax;
    EPI_NOPRE
    __device__ __forceinline__ void operator()(const Acc& acc, const Unit& u, int wr, int wc, int fr, int fq, const Pre&) const {
        bf16* dst = u.pn < 2 ? KN : V; const int t = u.pn & 1; float hm[2] = {0.f, 0.f};
        EPI_FOR { const int row = EPI_ROW;
            const f32x4 s0 = *(const f32x4*)(ckvstat + (size_t)row * 4);
            const float r = __builtin_amdgcn_rsqf(((s0[0] + s0[1]) + (s0[2] + s0[3])) * (1.f / KVRANK) + EPS);
#pragma unroll
            for (int bj = 0; bj < 2; ++bj) { const f32x4 v0 = acc[ai][bj][m][0] * r, v1 = acc[ai][bj][m][1] * r;
                *(u32x4*)(dst + (size_t)row * 512 + t * 256 + bj * HALF + wc * 32 + 8 * fq) = pack8(v0, v1);
                float q2 = sumsq4(v0) + sumsq4(v1); q2 = xsum32(xsum16(q2)); hm[bj] = fmaxf(hm[bj], q2); }
        }
        if (u.pn < 2) {
#pragma unroll
            for (int bj = 0; bj < 2; ++bj) { float v = hm[bj];
                v = row_max16(v);
                if ((fr | fq) == 0) atomicMax(kmax + 2 * (4 * u.pn + 2 * bj + (wc >> 1)) + (wc & 1), __float_as_uint(v)); }
        }
    }
};
struct EpiBranch {
    const unsigned char* GATE; bf16* MIXB;
    static constexpr bool KEEP_ACC = true; typedef NoPre Pre; __device__ __forceinline__ Pre prefetch(const Unit&, int, int) const { return Pre{}; }
    __device__ __forceinline__ void operator()(Acc& acc, const Unit& u, int wr, int wc, int fr, int fq, const Pre&) const {
        const int n = u.aux;
#pragma unroll
        for (int ai = 0; ai < 2; ++ai) {
            u32x2 gw[4][2], gn[4][2];
#pragma unroll
            for (int m = 0; m < 4; ++m)
#pragma unroll
                for (int bj = 0; bj < 2; ++bj) { const unsigned char* gp = GATE + (size_t)EPI_ROW * 3072 + n * 1024 + EPI_C8(bj);
                    gw[m][bj] = *(const u32x2*)gp; if (n < 2) gn[m][bj] = *(const u32x2*)(gp + 1024); }
            asm volatile("" ::: "memory");
#pragma unroll
            for (int m = 0; m < 4; ++m)
#pragma unroll
                for (int bj = 0; bj < 2; ++bj) {
                    f32x4 g0, g1; unpack8_u8(gw[m][bj], g0, g1);
#pragma unroll
                    for (int e = 0; e < 4; ++e) { g0[e] = fmaxf(g0[e], 0.001953125f); g1[e] = fmaxf(g1[e], 0.001953125f); }
                    if (n < 2) { f32x4 h0, h1; unpack8_u8(gn[m][bj], h0, h1);
#pragma unroll
                        for (int e = 0; e < 4; ++e) { g0[e] *= fast_rcp(fmaxf(h0[e], 0.001953125f)); g1[e] *= fast_rcp(fmaxf(h1[e], 0.001953125f)); }
                        acc[ai][bj][m][0] *= g0; acc[ai][bj][m][1] *= g1; }
                    else *(u32x4*)(MIXB + (size_t)u.pm * 256 * 1024 + (size_t)(4 * u.pn + 2 * bj + (wc >> 1)) * 16384 + (ai * HALF + wr * 64 + m * 16 + fr) * 64 + (wc & 1) * 32 + 8 * fq) = pack8(acc[ai][bj][m][0] * g0, acc[ai][bj][m][1] * g1);
                }
        }
        if (n == 2) {
#pragma unroll
            for (int ai = 0; ai < 2; ++ai)
#pragma unroll
                for (int bj = 0; bj < 2; ++bj)
#pragma unroll
                    for (int m = 0; m < 4; ++m) { acc[ai][bj][m][0] = (f32x4){0.f, 0.f, 0.f, 0.f}; acc[ai][bj][m][1] = (f32x4){0.f, 0.f, 0.f, 0.f}; }
        }
    }
};
struct EpiResid {
    const float* X; float* Xo; bf16* XB; float* xstat;
    EPI_NOPRE
    __device__ __forceinline__ void operator()(const Acc& acc, const Unit& u, int wr, int wc, int fr, int fq, const Pre&) const {
#pragma unroll
        for (int ai = 0; ai < 2; ++ai) {
            f32x4 xv[4][2][2];
#pragma unroll
            for (int m = 0; m < 4; ++m)
#pragma unroll
                for (int bj = 0; bj < 2; ++bj) { const float* xp = X + (size_t)EPI_ROW * 1024 + EPI_C8(bj); xv[m][bj][0] = *(const f32x4*)xp; xv[m][bj][1] = *(const f32x4*)(xp + 4); }
            asm volatile("" ::: "memory");
#pragma unroll
            for (int m = 0; m < 4; ++m) { const int row = EPI_ROW; float ss = 0.f;
#pragma unroll
                for (int bj = 0; bj < 2; ++bj) { const int col = EPI_C8(bj); float* xp = Xo + (size_t)row * 1024 + col;
                    const f32x4 v0 = xv[m][bj][0] + acc[ai][bj][m][0], v1 = xv[m][bj][1] + acc[ai][bj][m][1];
                    *(f32x4*)xp = v0; *(f32x4*)(xp + 4) = v1; ss += sumsq4(v0) + sumsq4(v1);
                    *(u32x4*)(XB + (size_t)row * 1024 + col) = pack8(v0, v1); }
                ss = xsum32(xsum16(ss));
                if (fq == 0) xstat[(size_t)row * 16 + u.pn * 4 + wc] = ss; }
        }
    }
};
struct EpiSwiGLU {
    const float* rs; bf16* Hh; int ldh; int from_stats;
    static constexpr bool KEEP_ACC = false; typedef RowPre Pre;
    __device__ __forceinline__ Pre prefetch(const Unit& u, int wr, int fr) const { Pre p;
#pragma unroll
        for (int ai = 0; ai < 2; ++ai)
#pragma unroll
            for (int m = 0; m < 4; ++m) p.r[ai][m] = from_stats ? 0.f : rs[EPI_ROW];
        return p; }
    __device__ __forceinline__ void operator()(const Acc& acc, const Unit& u, int wr, int wc, int fr, int fq, const Pre& pre) const {
        float rr[2][4];
        if (from_stats) { EPI_LOAD_RS(rs_, rs);
#pragma unroll
            for (int ai = 0; ai < 2; ++ai)
#pragma unroll
                for (int m = 0; m < 4; ++m) rr[ai][m] = rs_[ai][m]; }
        else {
#pragma unroll
            for (int ai = 0; ai < 2; ++ai)
#pragma unroll
                for (int m = 0; m < 4; ++m) rr[ai][m] = pre.r[ai][m]; }
        bf16* hbase = Hh + (size_t)u.pm * 256 * ldh + (size_t)(2 * u.pn + (wc >> 1)) * 16384 + (wr * 64 + fr) * 64 + (wc & 1) * 32 + 8 * fq;
        EPI_FOR { const int row = EPI_ROW;
            const float r = rr[ai][m];
            f32x4 a0 = acc[ai][0][m][0] * r, a1 = acc[ai][0][m][1] * r; const f32x4 b0 = acc[ai][1][m][0] * r, b1 = acc[ai][1][m][1] * r;
#pragma unroll
            for (int e = 0; e < 4; ++e) { a0[e] = a0[e] * sigmoidf_(a0[e]) * b0[e]; a1[e] = a1[e] * sigmoidf_(a1[e]) * b1[e]; }
            (void)row; *(u32x4*)(hbase + (ai * HALF + m * 16) * 64) = pack8(a0, a1);
        }
    }
};
struct EpiBf16 {
    bf16* C; int ldc;
    EPI_NOPRE
    __device__ __forceinline__ void operator()(const Acc& acc, const Unit& u, int wr, int wc, int fr, int fq, const Pre&) const {
        EPI_FOR { const int row = EPI_ROW;
#pragma unroll
            for (int bj = 0; bj < 2; ++bj) *(u32x4*)(C + (size_t)row * ldc + EPI_C8(bj)) = pack8(acc[ai][bj][m][0], acc[ai][bj][m][1]);
        }
    }
};
__device__ __forceinline__ void ks_reduce(const float* part, int x, int r, int k, int CC, int tid, bf16* C, int ldc, const Unit& u, int wr, int wc, int fr, int fq) {
    for (int sp = k; sp < 16; sp += CC) { const int ai = sp >> 3, bj = (sp >> 2) & 1, m = sp & 3;
        f32x4 s0 = {0.f, 0.f, 0.f, 0.f}, s1 = {0.f, 0.f, 0.f, 0.f};
        for (int kk0 = 0; kk0 < CC; kk0 += 4) {
            f32x4 v0[4], v1[4];
#pragma unroll
            for (int kk = 0; kk < 4; ++kk) { const bool ok = kk0 + kk < CC; const float* q = part + (size_t)(x + 8 * (r * CC + (ok ? kk0 + kk : 0))) * 65536 + tid * 4 + sp * 4096;
                v0[kk] = *(const f32x4*)q; v1[kk] = *(const f32x4*)(q + 2048); if (!ok) { v0[kk] = (f32x4){0.f, 0.f, 0.f, 0.f}; v1[kk] = (f32x4){0.f, 0.f, 0.f, 0.f}; } }
#pragma unroll
            for (int kk = 0; kk < 4; ++kk) { s0 += v0[kk]; s1 += v1[kk]; } }
        const int row = u.pm * BM + ai * HALF + wr * 64 + m * 16 + fr;
        *(u32x4*)(C + (size_t)row * ldc + u.pn * BM + bj * HALF + wc * 32 + 8 * fq) = pack8(s0, s1); }
}
struct EpiBf16KS {
    bf16* C; int ldc; float* part; unsigned* cnt; int c;
    EPI_NOPRE
    __device__ __forceinline__ void operator()(const Acc& acc, const Unit& u, int wr, int wc, int fr, int fq, const Pre&) const {
        if (((u.aux >> 4) & 3) != 0) {
            int tid_ = threadIdx.x; asm volatile("" : "+v"(tid_));
            const int k = (u.aux >> 8) & 255, CC = (u.aux >> 16) & 255, r = u.aux >> 24, x = c & 7;
            float* p = part + (size_t)c * 65536 + tid_ * 4;
#pragma unroll
            for (int ai = 0; ai < 2; ++ai)
#pragma unroll
                for (int bj = 0; bj < 2; ++bj)
#pragma unroll
                    for (int m = 0; m < 4; ++m)
#pragma unroll
                        for (int n = 0; n < 2; ++n) *(f32x4*)(p + (((ai * 2 + bj) * 4 + m) * 2 + n) * 2048) = acc[ai][bj][m][n];
            asm volatile("s_waitcnt vmcnt(0)" ::: "memory");
            __syncthreads();
            if (tid_ == 0) { unsigned* w = cnt + x + 8 * r; __hip_atomic_fetch_add(w, 1u, __ATOMIC_RELEASE, __HIP_MEMORY_SCOPE_AGENT);
                while (__hip_atomic_load(w, __ATOMIC_ACQUIRE, __HIP_MEMORY_SCOPE_AGENT) < (unsigned)CC) __builtin_amdgcn_s_sleep(2); }
            __syncthreads();
            ks_reduce(part, x, r, k, CC, tid_, C, ldc, u, wr, wc, fr, fq);
            return;
        }
        EPI_FOR { const int row = EPI_ROW;
#pragma unroll
            for (int bj = 0; bj < 2; ++bj) *(u32x4*)(C + (size_t)row * ldc + EPI_C8(bj)) = pack8(acc[ai][bj][m][0], acc[ai][bj][m][1]);
        }
    }
};
struct EpiF32 {
    float* C; int ldc;
    EPI_NOPRE
    __device__ __forceinline__ void operator()(const Acc& acc, const Unit& u, int wr, int wc, int fr, int fq, const Pre&) const {
        EPI_FOR { const int row = EPI_ROW;
#pragma unroll
            for (int bj = 0; bj < 2; ++bj) { float* cp = C + (size_t)row * ldc + EPI_C8(bj); *(f32x4*)cp = acc[ai][bj][m][0]; *(f32x4*)(cp + 4) = acc[ai][bj][m][1]; }
        }
    }
};
}

namespace att {
#define KSWZ(row, colB) ((row) * 256 + ((colB) ^ (((row) & 7) << 4)))
#define SBAR() __builtin_amdgcn_sched_barrier(0)
constexpr float THR = 8.f;
__device__ __forceinline__ int crow(int r, int hi) { return (r & 3) + 8 * (r >> 2) + 4 * hi; }
template <int NB> __device__ __forceinline__ int v_st(int k, int c) { const int kk = (k & ~0xC) | ((k & 4) << 1) | ((k & 8) >> 1); return ((kk >> 3) * NB + (c >> 5)) * 512 + ((kk & 7) * 32 + (c & 31)) * 2; }
__device__ __forceinline__ int v_rd_base(int lane) { return ((lane & 3) << 3) | (((lane >> 2) & 3) << 6) | (((lane >> 4) & 1) << 5) | (((lane >> 5) & 1) << 8); }
template <int OFF> __device__ __forceinline__ s16x4 tr_read(int vb) { s16x4 r; asm volatile("ds_read_b64_tr_b16 %0, %1 offset:%2" : "=&v"(r) : "v"(vb), "i"(OFF) : "memory"); return r; }

__device__ __forceinline__ void partialSM(f32x16& p0, f32x16& p1, float& m_reg, float& alpha) {
    float pmax = p0[0];
#pragma unroll
    for (int r = 1; r < 16; ++r) pmax = fmaxf(pmax, p0[r]);
#pragma unroll
    for (int r = 0; r < 16; ++r) pmax = fmaxf(pmax, p1[r]);
    { auto rr = __builtin_amdgcn_permlane32_swap(__float_as_uint(pmax), __float_as_uint(pmax), false, false); pmax = fmaxf(__uint_as_float(rr[0]), __uint_as_float(rr[1])); }
    float mn;
    if (__builtin_expect(__all(pmax - m_reg <= THR), 1)) { mn = m_reg; alpha = 1.f; }
    else { mn = fmaxf(m_reg, pmax); alpha = __builtin_amdgcn_exp2f(m_reg - mn); m_reg = mn; }
#pragma unroll
    for (int r = 0; r < 16; ++r) { p0[r] -= mn; p1[r] -= mn; }
#pragma unroll
    for (int r = 0; r < 16; ++r) p0[r] = __builtin_amdgcn_exp2f(p0[r]);
}
__device__ __forceinline__ void finishSM(f32x16& p0, f32x16& p1, float alpha, float& l_reg, bf16x8& pa0, bf16x8& pa1, bf16x8& pa2, bf16x8& pa3) {
#pragma unroll
    for (int r = 0; r < 16; ++r) p1[r] = __builtin_amdgcn_exp2f(p1[r]);
    float ps = 0;
#pragma unroll
    for (int r = 0; r < 16; ++r) ps += p0[r];
#pragma unroll
    for (int r = 0; r < 16; ++r) ps += p1[r];
    { auto rr = __builtin_amdgcn_permlane32_swap(__float_as_uint(ps), __float_as_uint(ps), false, false); ps = __uint_as_float(rr[0]) + __uint_as_float(rr[1]); }
    l_reg = l_reg * alpha + ps;
#define PK4(P, BASE, OUT) do { unsigned a0 = cvt_pk_bf16(P[BASE + 0], P[BASE + 1]), a1 = cvt_pk_bf16(P[BASE + 2], P[BASE + 3]);   \
    unsigned b0 = cvt_pk_bf16(P[BASE + 4], P[BASE + 5]), b1 = cvt_pk_bf16(P[BASE + 6], P[BASE + 7]);                              \
    auto r0 = __builtin_amdgcn_permlane32_swap(a0, b0, false, false); auto r1 = __builtin_amdgcn_permlane32_swap(a1, b1, false, false); \
    u32x4 w = {r0[0], r1[0], r0[1], r1[1]}; OUT = __builtin_bit_cast(bf16x8, w); } while (0)
    PK4(p0, 0, pa0); PK4(p0, 8, pa1); PK4(p1, 0, pa2); PK4(p1, 8, pa3);
#undef PK4
}
template <int ND0> __device__ __forceinline__ void qkt(f32x16& p0, f32x16& p1, const LAS char* Ks, const bf16x8* qr, int r32, int hi, const f32x16& init) {
#pragma unroll
    for (int d0 = 0; d0 < ND0; ++d0) { const int cb = (d0 * 16 + hi * 8) * 2;
        const bf16x8 b0 = *(const LAS bf16x8*)(Ks + KSWZ(r32, cb));
        const bf16x8 b1 = *(const LAS bf16x8*)(Ks + KSWZ(32 + r32, cb));
        p0 = __builtin_amdgcn_mfma_f32_32x32x16_bf16(b0, qr[d0], d0 == 0 ? init : p0, 0, 0, 0);
        p1 = __builtin_amdgcn_mfma_f32_32x32x16_bf16(b1, qr[d0], d0 == 0 ? init : p1, 0, 0, 0); }
}
__device__ __forceinline__ void expA(f32x16& p0) {
#pragma unroll
    for (int r = 0; r < 16; ++r) p0[r] = __builtin_amdgcn_exp2f(p0[r]);
}
template <int NB, int D0> __device__ __forceinline__ void pv_one(f32x16& od, int vb, bf16x8 pa0, bf16x8 pa1, bf16x8 pa2, bf16x8 pa3) {
    const s16x4 l0 = tr_read<(0 * NB + D0) * 512>(vb), h0 = tr_read<(1 * NB + D0) * 512>(vb), l1 = tr_read<(2 * NB + D0) * 512>(vb), h1 = tr_read<(3 * NB + D0) * 512>(vb);
    const s16x4 l2 = tr_read<(4 * NB + D0) * 512>(vb), h2 = tr_read<(5 * NB + D0) * 512>(vb), l3 = tr_read<(6 * NB + D0) * 512>(vb), h3 = tr_read<(7 * NB + D0) * 512>(vb);
    asm volatile("s_waitcnt lgkmcnt(0)" ::: "memory"); SBAR();
#define PK(L, H) (bf16x8){L[0], L[1], L[2], L[3], H[0], H[1], H[2], H[3]}
    od = __builtin_amdgcn_mfma_f32_32x32x16_bf16(pa0, PK(l0, h0), od, 0, 0, 0);
    od = __builtin_amdgcn_mfma_f32_32x32x16_bf16(pa1, PK(l1, h1), od, 0, 0, 0);
    od = __builtin_amdgcn_mfma_f32_32x32x16_bf16(pa2, PK(l2, h2), od, 0, 0, 0);
    od = __builtin_amdgcn_mfma_f32_32x32x16_bf16(pa3, PK(l3, h3), od, 0, 0, 0);
#undef PK
}
template <int NB> __device__ __forceinline__ void pv_all(f32x16* o, int vb, bf16x8 pa0, bf16x8 pa1, bf16x8 pa2, bf16x8 pa3) {
    pv_one<NB, 0>(o[0], vb, pa0, pa1, pa2, pa3); pv_one<NB, 1>(o[1], vb, pa0, pa1, pa2, pa3);
    if constexpr (NB == 4) { pv_one<NB, 2>(o[2], vb, pa0, pa1, pa2, pa3); pv_one<NB, 3>(o[3], vb, pa0, pa1, pa2, pa3); }
}

template <int DQK, int D1, int DVV, bool FIXM>
__device__ __forceinline__ void attn_unit(const bf16* __restrict__ Qb, int ldq, const bf16* __restrict__ K1, int ldk1, const bf16* __restrict__ K2, int ldk2,
                                          const bf16* __restrict__ Vh, int ldv, bf16* __restrict__ Ob, int ldo, int seq, LAS char* lds, float kbound) {
    constexpr int ND0 = DQK / 16, NB = DVV / 32, CK = DQK / 8, CV = DVV / 8;
    constexpr int NKL = (64 * CK + 511) / 512, NVL = (64 * CV) / 512;
    constexpr int SHM_V = 64 * DVV * 2, SHM_K = 64 * 256;
    int tid_ = threadIdx.x; asm volatile("" : "+v"(tid_));
    const int tid = tid_, wid = tid >> 6, lane = tid & 63, r32 = lane & 31, hi = lane >> 5;
    LAS char* V_lds = lds; LAS char* K_lds = lds + 2 * SHM_V;
    LAS float* ws = (LAS float*)(lds + 2 * SHM_V + 2 * SHM_K) + wid * 64; LAS float* li_l = ws; LAS float* al_l = ws + 32;
    float m_reg = -1e30f, l_reg = 0; f32x16 o[NB]; bf16x8 qr[ND0];
#pragma unroll
    for (int d = 0; d < NB; ++d) o[d] = f32x16{};
    const bf16* Qw = Qb + (long)(wid * 32 + r32) * ldq + hi * 8;
#pragma unroll
    for (int d0 = 0; d0 < ND0; ++d0) qr[d0] = *(const bf16x8*)(Qw + d0 * 16);
    f32x16 init = f32x16{};
    if constexpr (FIXM) {
        float q2 = 0.f;
#pragma unroll
        for (int d0 = 0; d0 < ND0; ++d0) { const u32x4 w = __builtin_bit_cast(u32x4, qr[d0]); f32x4 a, b; unpack8(w, a, b); q2 += sumsq4(a) + sumsq4(b); }
        { auto rr = __builtin_amdgcn_permlane32_swap(__float_as_uint(q2), __float_as_uint(q2), false, false); q2 = __uint_as_float(rr[0]) + __uint_as_float(rr[1]); }
        const float nm = -sqrtf(q2) * kbound;
#pragma unroll
        for (int r = 0; r < 16; ++r) init[r] = nm;
        asm volatile("" : "+v"(init));
    }
    const bf16* kp[NKL]; int kstr[NKL], kdst[NKL]; bool kval[NKL];
#pragma unroll
    for (int i = 0; i < NKL; ++i) { const int c = tid + 512 * i; kval[i] = c < 64 * CK; const int cc_ = kval[i] ? c : 0; const int row = cc_ / CK, cc = cc_ % CK;
        if (cc * 8 < D1) { kp[i] = K1 + (long)row * ldk1 + cc * 8; kstr[i] = 64 * ldk1; } else { kp[i] = K2 + (long)row * ldk2 + (cc * 8 - D1); kstr[i] = 64 * ldk2; }
        kdst[i] = KSWZ(row, cc * 16); }
    const bf16* vp[NVL]; int vdst[NVL]; const int vstr = 64 * ldv;
#pragma unroll
    for (int i = 0; i < NVL; ++i) { const int c = tid + 512 * i; const int row = c / CV, cc = c % CV; vp[i] = Vh + (long)row * ldv + cc * 8; vdst[i] = v_st<NB>(row, cc * 8); }
    const int vb0 = (int)(uintptr_t)V_lds + v_rd_base(lane);
    struct { bf16x8 ks[NKL]; bf16x8 vs[NVL]; } sr_[2];
#define SLOAD(i, t) do { _Pragma("unroll") for (int q_ = 0; q_ < NVL; ++q_) sr_[i].vs[q_] = *(const bf16x8*)(vp[q_] + (long)(t) * vstr); \
    _Pragma("unroll") for (int q_ = 0; q_ < NKL; ++q_) { if (kval[q_]) sr_[i].ks[q_] = *(const bf16x8*)(kp[q_] + (long)(t) * kstr[q_]); } } while (0)
#define SWRITE(b, i) do { _Pragma("unroll") for (int q_ = 0; q_ < NVL; ++q_) *(LAS bf16x8*)(V_lds + (b) * SHM_V + vdst[q_]) = sr_[i].vs[q_]; \
    _Pragma("unroll") for (int q_ = 0; q_ < NKL; ++q_) { if (kval[q_]) *(LAS bf16x8*)(K_lds + (b) * SHM_K + kdst[q_]) = sr_[i].ks[q_]; } } while (0)
#define SWAIT() asm volatile("s_waitcnt vmcnt(%0)" :: "n"(NKL + NVL) : "memory")
#define RESC(a) do { if (__any((a) < 1.f)) { if (hi == 0) al_l[r32] = (a); asm volatile("s_waitcnt lgkmcnt(0)" ::: "memory"); \
    _Pragma("unroll") for (int d = 0; d < NB; ++d) _Pragma("unroll") for (int r = 0; r < 16; ++r) o[d][r] *= al_l[crow(r, hi)]; } } while (0)
    f32x16 pA0, pA1, pB0, pB1; float alA = 1.f, alB = 1.f; bf16x8 pa0, pa1, pa2, pa3; const int NT = seq / 64;
#define PSM(P0, P1, AL) do { if constexpr (FIXM) expA(P0); else partialSM(P0, P1, m_reg, AL); } while (0)
#define RSC(AL) do { if constexpr (!FIXM) RESC(AL); } while (0)
    SLOAD(0, 0); asm volatile("s_waitcnt vmcnt(0)" ::: "memory"); SWRITE(0, 0); __syncthreads();
    qkt<ND0>(pA0, pA1, K_lds, qr, r32, hi, init); PSM(pA0, pA1, alA);
    SLOAD(1, 1); if (2 < NT) SLOAD(0, 2);
    SWAIT(); SWRITE(1, 1); __syncthreads();
    for (int j = 1; j + 1 < NT; j += 2) {
        SBAR(); qkt<ND0>(pB0, pB1, K_lds + SHM_K, qr, r32, hi, init);
        finishSM(pA0, pA1, alA, l_reg, pa0, pa1, pa2, pa3); SBAR();
        SLOAD(1, j + 2); SBAR();
        pv_all<NB>(o, vb0, pa0, pa1, pa2, pa3); PSM(pB0, pB1, alB);
        __syncthreads(); SWAIT(); SWRITE(0, 0);
        RSC(alB); __syncthreads();
        SBAR(); qkt<ND0>(pA0, pA1, K_lds, qr, r32, hi, init);
        finishSM(pB0, pB1, alB, l_reg, pa0, pa1, pa2, pa3); SBAR();
        if (j + 3 < NT) SLOAD(0, j + 3); SBAR();
        pv_all<NB>(o, vb0 + SHM_V, pa0, pa1, pa2, pa3); PSM(pA0, pA1, alA);
        __syncthreads(); SWAIT(); SWRITE(1, 1);
        RSC(alA); __syncthreads();
    }
    SBAR(); qkt<ND0>(pB0, pB1, K_lds + SHM_K, qr, r32, hi, init);
    finishSM(pA0, pA1, alA, l_reg, pa0, pa1, pa2, pa3); SBAR();
    pv_all<NB>(o, vb0, pa0, pa1, pa2, pa3); PSM(pB0, pB1, alB);
    __syncthreads(); RSC(alB);
    finishSM(pB0, pB1, alB, l_reg, pa0, pa1, pa2, pa3); SBAR();
    pv_all<NB>(o, vb0 + SHM_V, pa0, pa1, pa2, pa3);
#undef PSM
#undef RSC
    if (hi == 0) li_l[r32] = l_reg; asm volatile("s_waitcnt lgkmcnt(0)" ::: "memory");
    float rli[16];
#pragma unroll
    for (int r = 0; r < 16; ++r) rli[r] = __builtin_amdgcn_rcpf(li_l[crow(r, hi)]);
    bf16* Ow = Ob + (long)(wid * 32) * ldo;
#pragma unroll
    for (int r = 0; r < 16; ++r) { const int orow = crow(r, hi);
#pragma unroll
        for (int d0 = 0; d0 < NB; ++d0) Ow[(long)orow * ldo + d0 * 32 + r32] = f2bf(o[d0][r] * rli[r]); }
    __syncthreads();
#undef SLOAD
#undef SWRITE
#undef SWAIT
#undef RESC
}

#define EXP4(P, B) do { P[B] = __builtin_amdgcn_exp2f(P[B]); P[B + 1] = __builtin_amdgcn_exp2f(P[B + 1]); P[B + 2] = __builtin_amdgcn_exp2f(P[B + 2]); P[B + 3] = __builtin_amdgcn_exp2f(P[B + 3]); } while (0)
#define SUM4(S, P, B) do { S += (P[B] + P[B + 1]) + (P[B + 2] + P[B + 3]); } while (0)
#define PK4X(P, BASE, OUT) do { const u32x4 w_ = {cvt_pk_bf16(P[BASE + 0], P[BASE + 1]), cvt_pk_bf16(P[BASE + 2], P[BASE + 3]), cvt_pk_bf16(P[BASE + 4], P[BASE + 5]), cvt_pk_bf16(P[BASE + 6], P[BASE + 7])}; OUT = __builtin_bit_cast(bf16x8, w_); } while (0)
typedef short v4i16_t __attribute__((ext_vector_type(4)));
__device__ __forceinline__ s16x4 vtr(const LAS char* p) { return __builtin_bit_cast(s16x4, __builtin_amdgcn_ds_read_tr16_b64_v4i16((LAS v4i16_t*)p)); }
#define KSWZ2(row, colB) ((row) * 256 + ((colB) ^ (((row) & 15) << 4)))
template <int DQK, int D1, int DVV>
__device__ __forceinline__ void attn_unit2(const bf16* __restrict__ Qb, int ldq, const bf16* __restrict__ K1, int ldk1, const bf16* __restrict__ K2, int ldk2,
                                           const bf16* __restrict__ Vh, int ldv, bf16* __restrict__ Ob, int ldo, int seq, LAS char* lds, float kbound) {
    constexpr int ND0 = DQK / 16, NB = DVV / 32, CK = DQK / 8;
    constexpr int SHM_V = 64 * DVV * 2, SHM_K = 64 * 256;
    static_assert(NB == 2 && ND0 == 6, "written for QK dim 96 / V dim 64");
    int tid_ = threadIdx.x; asm volatile("" : "+v"(tid_));
    const int tid = tid_, wid = __builtin_amdgcn_readfirstlane(tid >> 6), lane = tid & 63, r32 = lane & 31, hi = lane >> 5;
    LAS char* V_lds = lds; LAS char* K_lds = lds + 3 * SHM_V;
    LAS float* ws = (LAS float*)(lds + 3 * SHM_V + 2 * SHM_K) + wid * 64;
    LAS char* QAL = lds + 3 * SHM_V + 2 * SHM_K + 2048 + wid * (2 * ND0 * 1024) + lane * 16; LAS char* QBL = QAL + ND0 * 1024;
    float nm;
    { bf16x8 qa[ND0], qb[ND0];
      const bf16* QwA = Qb + (long)(wid * 64 + r32) * ldq + hi * 8; const bf16* QwB = QwA + (long)32 * ldq;
#pragma unroll
      for (int d0 = 0; d0 < ND0; ++d0) { qa[d0] = *(const bf16x8*)(QwA + d0 * 16); qb[d0] = *(const bf16x8*)(QwB + d0 * 16); }
      float q2a = 0.f, q2b = 0.f;
#pragma unroll
      for (int d0 = 0; d0 < ND0; ++d0) { f32x4 a, b; unpack8(__builtin_bit_cast(u32x4, qa[d0]), a, b); q2a += sumsq4(a) + sumsq4(b); unpack8(__builtin_bit_cast(u32x4, qb[d0]), a, b); q2b += sumsq4(a) + sumsq4(b);
          *(LAS bf16x8*)(QAL + d0 * 1024) = qa[d0]; *(LAS bf16x8*)(QBL + d0 * 1024) = qb[d0]; }
      { auto rr = __builtin_amdgcn_permlane32_swap(__float_as_uint(q2a), __float_as_uint(q2a), false, false); q2a = __uint_as_float(rr[0]) + __uint_as_float(rr[1]); }
      { auto rr = __builtin_amdgcn_permlane32_swap(__float_as_uint(q2b), __float_as_uint(q2b), false, false); q2b = __uint_as_float(rr[0]) + __uint_as_float(rr[1]); }
      nm = -sqrtf(fmaxf(q2a, q2b)) * kbound; }
    const bf16* kp[2]; int kstr[2];
#pragma unroll
    for (int i = 0; i < 2; ++i) { const int row = 8 * wid + 4 * i + (lane >> 4), cc = (lane & 15) ^ (row & 15);
        if (cc >= 8 && cc < CK) { kp[i] = K2 + (long)row * ldk2 + (cc * 8 - D1); kstr[i] = 64 * ldk2; } else { kp[i] = K1 + (long)row * ldk1 + (cc < 8 ? cc * 8 : 0); kstr[i] = 64 * ldk1; } }
    const bf16* vp; { const int k = 8 * wid + ((lane & 31) >> 2); vp = Vh + (long)k * ldv + (lane >> 5) * 32 + (lane & 3) * 8; }
    const int vstr = 64 * ldv;
    const LAS char* vrd0 = V_lds + v_rd_base(lane);
#define DMA2(t, kb, vbuf) do { \
    __builtin_amdgcn_global_load_lds((const unsigned*)(kp[0] + (long)(t) * kstr[0]), (LAS unsigned*)(K_lds + (kb) * SHM_K + wid * 2048), 16, 0, 0); \
    __builtin_amdgcn_global_load_lds((const unsigned*)(kp[1] + (long)(t) * kstr[1]), (LAS unsigned*)(K_lds + (kb) * SHM_K + wid * 2048 + 1024), 16, 0, 0); \
    __builtin_amdgcn_global_load_lds((const unsigned*)(vp + (long)(t) * vstr), (LAS unsigned*)(V_lds + (vbuf) * SHM_V + wid * 1024), 16, 0, 0); } while (0)
#define VRD8(arr, base, D0) do { _Pragma("unroll") for (int j_ = 0; j_ < 8; ++j_) arr[j_] = vtr((base) + (j_ * NB + (D0)) * 512); } while (0)
#define PKV(arr, ks) (bf16x8){arr[2 * (ks)][0], arr[2 * (ks)][1], arr[2 * (ks)][2], arr[2 * (ks)][3], arr[2 * (ks) + 1][0], arr[2 * (ks) + 1][1], arr[2 * (ks) + 1][2], arr[2 * (ks) + 1][3]}
    f32x16 oA[2], oB[2]; oA[0] = f32x16{}; oA[1] = f32x16{}; oB[0] = f32x16{}; oB[1] = f32x16{};
    float lA = 0.f, lB = 0.f; const int NT = seq / 64;
    f32x16 a0, a1, c0, c1; bf16x8 pa0, pa1, pa2, pa3;
#define HALF1(Kb) do { \
        f32x16 init; { float nmv = nm; asm volatile("" : "+v"(nmv)); _Pragma("unroll") for (int r = 0; r < 16; ++r) init[r] = nmv; } \
        SBAR(); \
        _Pragma("unroll") for (int d0 = 0; d0 < ND0; ++d0) { const int cb = (d0 * 16 + hi * 8) * 2; \
            const bf16x8 k0 = *(const LAS bf16x8*)((Kb) + KSWZ2(r32, cb)), k1 = *(const LAS bf16x8*)((Kb) + KSWZ2(32 + r32, cb)), qv = *(const LAS bf16x8*)(QAL + d0 * 1024); \
            a0 = __builtin_amdgcn_mfma_f32_32x32x16_bf16(k0, qv, d0 == 0 ? init : a0, 0, 0, 0); \
            a1 = __builtin_amdgcn_mfma_f32_32x32x16_bf16(k1, qv, d0 == 0 ? init : a1, 0, 0, 0); } \
        SBAR(); \
        float sA = 0.f; \
        _Pragma("unroll") for (int d0 = 0; d0 < ND0; ++d0) { const int cb = (d0 * 16 + hi * 8) * 2; \
            const bf16x8 k0 = *(const LAS bf16x8*)((Kb) + KSWZ2(r32, cb)), k1 = *(const LAS bf16x8*)((Kb) + KSWZ2(32 + r32, cb)), qv = *(const LAS bf16x8*)(QBL + d0 * 1024); \
            c0 = __builtin_amdgcn_mfma_f32_32x32x16_bf16(k0, qv, d0 == 0 ? init : c0, 0, 0, 0); \
            if (d0 == 3) { EXP4(a0, 0); EXP4(a0, 4); } \
            if (d0 == 4) { EXP4(a0, 12); SUM4(sA, a0, 0); SUM4(sA, a0, 4); EXP4(a1, 0); } \
            if (d0 == 5) { EXP4(a1, 8); SUM4(sA, a1, 0); SUM4(sA, a1, 4); } \
            c1 = __builtin_amdgcn_mfma_f32_32x32x16_bf16(k1, qv, d0 == 0 ? init : c1, 0, 0, 0); \
            if (d0 == 3) { EXP4(a0, 8); } \
            if (d0 == 4) { EXP4(a1, 4); SUM4(sA, a0, 8); SUM4(sA, a0, 12); } \
            if (d0 == 5) { EXP4(a1, 12); SUM4(sA, a1, 8); SUM4(sA, a1, 12); } \
            if (d0 >= 2) SBAR(); } \
        lA += sA; \
        PK4X(a0, 0, pa0); PK4X(a0, 8, pa1); PK4X(a1, 0, pa2); PK4X(a1, 8, pa3); \
        SBAR(); } while (0)
#define HALF2(vbase) do { \
        float sB = 0.f; s16x4 va[8], vb_[8]; \
        VRD8(va, vbase, 0); VRD8(vb_, vbase, 1); \
        oA[0] = __builtin_amdgcn_mfma_f32_32x32x16_bf16(pa0, PKV(va, 0), oA[0], 0, 0, 0); SBAR(); \
        oA[1] = __builtin_amdgcn_mfma_f32_32x32x16_bf16(pa0, PKV(vb_, 0), oA[1], 0, 0, 0); EXP4(c0, 0); EXP4(c0, 4); SBAR(); \
        oA[0] = __builtin_amdgcn_mfma_f32_32x32x16_bf16(pa1, PKV(va, 1), oA[0], 0, 0, 0); EXP4(c0, 8); EXP4(c0, 12); SUM4(sB, c0, 0); SBAR(); \
        oA[1] = __builtin_amdgcn_mfma_f32_32x32x16_bf16(pa1, PKV(vb_, 1), oA[1], 0, 0, 0); EXP4(c1, 0); SUM4(sB, c0, 4); SUM4(sB, c0, 8); SBAR(); \
        oA[0] = __builtin_amdgcn_mfma_f32_32x32x16_bf16(pa2, PKV(va, 2), oA[0], 0, 0, 0); EXP4(c1, 4); SUM4(sB, c0, 12); SBAR(); \
        oA[1] = __builtin_amdgcn_mfma_f32_32x32x16_bf16(pa2, PKV(vb_, 2), oA[1], 0, 0, 0); EXP4(c1, 8); SUM4(sB, c1, 0); SBAR(); \
        oA[0] = __builtin_amdgcn_mfma_f32_32x32x16_bf16(pa3, PKV(va, 3), oA[0], 0, 0, 0); EXP4(c1, 12); SUM4(sB, c1, 4); SBAR(); \
        oA[1] = __builtin_amdgcn_mfma_f32_32x32x16_bf16(pa3, PKV(vb_, 3), oA[1], 0, 0, 0); SUM4(sB, c1, 8); SUM4(sB, c1, 12); SBAR(); \
        lB += sB; \
        PK4X(c0, 0, pa0); PK4X(c0, 8, pa1); PK4X(c1, 0, pa2); PK4X(c1, 8, pa3); \
        SBAR(); \
        VRD8(va, vbase, 0); VRD8(vb_, vbase, 1);                       \
        oB[0] = __builtin_amdgcn_mfma_f32_32x32x16_bf16(pa0, PKV(va, 0), oB[0], 0, 0, 0); \
        oB[1] = __builtin_amdgcn_mfma_f32_32x32x16_bf16(pa0, PKV(vb_, 0), oB[1], 0, 0, 0); \
        oB[0] = __builtin_amdgcn_mfma_f32_32x32x16_bf16(pa1, PKV(va, 1), oB[0], 0, 0, 0); \
        oB[1] = __builtin_amdgcn_mfma_f32_32x32x16_bf16(pa1, PKV(vb_, 1), oB[1], 0, 0, 0); \
        oB[0] = __builtin_amdgcn_mfma_f32_32x32x16_bf16(pa2, PKV(va, 2), oB[0], 0, 0, 0); \
        oB[1] = __builtin_amdgcn_mfma_f32_32x32x16_bf16(pa2, PKV(vb_, 2), oB[1], 0, 0, 0); \
        oB[0] = __builtin_amdgcn_mfma_f32_32x32x16_bf16(pa3, PKV(va, 3), oB[0], 0, 0, 0); \
        oB[1] = __builtin_amdgcn_mfma_f32_32x32x16_bf16(pa3, PKV(vb_, 3), oB[1], 0, 0, 0); \
        SBAR(); } while (0)
#define TILE_BAR() do { asm volatile("s_waitcnt vmcnt(0)" ::: "memory"); __syncthreads(); } while (0)
    DMA2(0, 0, 0);
    if (wid < 4) {
        int vs = 0;
#pragma unroll 1
        for (int t = 0; t < NT; ++t) { TILE_BAR();
            const int vn = vs == 2 ? 0 : vs + 1; if (t + 1 < NT) DMA2(t + 1, (t + 1) & 1, vn);
            HALF1(K_lds + (t & 1) * SHM_K); HALF2(vrd0 + vs * SHM_V); vs = vn; }
        TILE_BAR();
    } else {
        __builtin_amdgcn_s_setprio(1);
        TILE_BAR(); if (1 < NT) DMA2(1, 1, 1);
        HALF1(K_lds);
        int vs = 0;
#pragma unroll 1
        for (int t = 1; t < NT; ++t) { TILE_BAR();
            const int vn = vs == 2 ? 0 : vs + 1; const int vnn = vn == 2 ? 0 : vn + 1; if (t + 1 < NT) DMA2(t + 1, (t + 1) & 1, vnn);
            HALF2(vrd0 + vs * SHM_V); HALF1(K_lds + (t & 1) * SHM_K); vs = vn; }
        TILE_BAR();
        HALF2(vrd0 + vs * SHM_V);
        __builtin_amdgcn_s_setprio(0);
    }
#undef HALF1
#undef HALF2
#undef TILE_BAR
    { auto rr = __builtin_amdgcn_permlane32_swap(__float_as_uint(lA), __float_as_uint(lA), false, false); lA = __uint_as_float(rr[0]) + __uint_as_float(rr[1]); }
    { auto rr = __builtin_amdgcn_permlane32_swap(__float_as_uint(lB), __float_as_uint(lB), false, false); lB = __uint_as_float(rr[0]) + __uint_as_float(rr[1]); }
    if (hi == 0) { ws[r32] = lA; ws[32 + r32] = lB; } asm volatile("s_waitcnt lgkmcnt(0)" ::: "memory");
    bf16* Ow = Ob + (long)(wid * 64) * ldo;
#pragma unroll
    for (int r = 0; r < 16; ++r) { const int orow = crow(r, hi); const float ra = __builtin_amdgcn_rcpf(ws[orow]), rb = __builtin_amdgcn_rcpf(ws[32 + orow]);
#pragma unroll
        for (int d0 = 0; d0 < NB; ++d0) { Ow[(long)orow * ldo + d0 * 32 + r32] = f2bf(oA[d0][r] * ra); Ow[(long)(32 + orow) * ldo + d0 * 32 + r32] = f2bf(oB[d0][r] * rb); } }
    __syncthreads();
#undef DMA2
#undef VRD8
#undef PKV
}
#undef EXP4
#undef SUM4
#undef PK4X

__device__ __forceinline__ void spatial_unit(int chunk, int g, const bf16* __restrict__ U, const bf16* __restrict__ VR, const float* __restrict__ vstat, const float* __restrict__ g_sg,
                                             const bf16* __restrict__ Wsb, const float* __restrict__ b_s, bf16* __restrict__ Y, LAS char* lds) {
    int tid_ = threadIdx.x; asm volatile("" : "+v"(tid_));
    const int tid = tid_, wid = tid >> 6, lane = tid & 63, r32 = lane & 31, hi = lane >> 5, rb = wid & 3, ch = wid >> 2;
    LAS char* V_lds = lds; LAS float* rv = (LAS float*)(lds + 32768);
    const int row0 = chunk * 128;
    f32x4 s0 = {0.f, 0.f, 0.f, 0.f}, s1 = {0.f, 0.f, 0.f, 0.f};
    if (tid < 128) { s0 = *(const f32x4*)(vstat + (size_t)(row0 + tid) * 8); s1 = *(const f32x4*)(vstat + (size_t)(row0 + tid) * 8 + 4); }
    u32x4 wv[4];
#pragma unroll
    for (int i = 0; i < 4; ++i) { const int c = tid + 512 * i, row = c >> 4, cc = c & 15; wv[i] = *(const u32x4*)(VR + (size_t)(row0 + row) * 512 + g * 128 + cc * 8); }
    const f32x4 g0 = *(const f32x4*)(g_sg + g * 128 + (tid & 15) * 8), g1 = *(const f32x4*)(g_sg + g * 128 + (tid & 15) * 8 + 4);
    bf16x8 pa[8];
#pragma unroll
    for (int ks = 0; ks < 8; ++ks) pa[ks] = *(const bf16x8*)(Wsb + (size_t)g * 16384 + (size_t)(32 * rb + r32) * 128 + 16 * ks + 8 * hi);
    bf16 ur[16][2]; float bias[16];
#pragma unroll
    for (int r = 0; r < 16; ++r) { const int i = 32 * rb + crow(r, hi); bias[r] = b_s[g * 128 + i];
#pragma unroll
        for (int dd = 0; dd < 2; ++dd) ur[r][dd] = U[(size_t)(row0 + i) * 512 + g * 128 + 64 * ch + 32 * dd + r32]; }
    if (tid < 128) rv[tid] = __builtin_amdgcn_rsqf(((s0[0] + s0[1]) + (s0[2] + s0[3]) + (s1[0] + s1[1]) + (s1[2] + s1[3])) * (1.f / 512.f) + EPS);
    __syncthreads();
#pragma unroll
    for (int i = 0; i < 4; ++i) { const int c = tid + 512 * i, row = c >> 4, cc = c & 15; f32x4 a, b; unpack8(wv[i], a, b); const float r = rv[row];
        *(LAS u32x4*)(V_lds + (row >> 6) * 16384 + v_st<4>(row & 63, cc * 8)) = pack8(a * r * g0, b * r * g1); }
    __syncthreads();
    f32x16 o[2]; o[0] = f32x16{}; o[1] = f32x16{};
    const int vb = (int)(uintptr_t)V_lds + v_rd_base(lane) + (2 * ch) * 512;
    pv_one<4, 0>(o[0], vb, pa[0], pa[1], pa[2], pa[3]); pv_one<4, 1>(o[1], vb, pa[0], pa[1], pa[2], pa[3]);
    pv_one<4, 0>(o[0], vb + 16384, pa[4], pa[5], pa[6], pa[7]); pv_one<4, 1>(o[1], vb + 16384, pa[4], pa[5], pa[6], pa[7]);
#pragma unroll
    for (int r = 0; r < 16; ++r) { const int i = 32 * rb + crow(r, hi); const size_t row = (size_t)(row0 + i);
#pragma unroll
        for (int dd = 0; dd < 2; ++dd) { const int c = g * 128 + 64 * ch + 32 * dd + r32; const float uu = bf2f(ur[r][dd]);
            Y[row * 1536 + 512 + c] = f2bf(uu * (o[dd][r] + bias[r])); } }
    __syncthreads();
}
#undef KSWZ
#undef SBAR
}

#define XB_TMO      128
#define XB_XCNT(j)  (256  + 64 * (j))
#define XB_XSUB(j)  (1280 + 64 * (j))
#define XB_XGEN(j)  (2304 + 64 * (j))
#define XB_TOP      3328
#define XB_TOPGEN   3392
#define XCD_BAR_WORDS 3456
#define XB_SPIN_CAP (1u << 18)
__device__ __forceinline__ unsigned xb_ld(unsigned* p)              { return __hip_atomic_load((GAS unsigned*)p, __ATOMIC_RELAXED, __HIP_MEMORY_SCOPE_AGENT); }
__device__ __forceinline__ unsigned xb_add(unsigned* p, unsigned v) { return __hip_atomic_fetch_add((GAS unsigned*)p, v, __ATOMIC_RELAXED, __HIP_MEMORY_SCOPE_AGENT); }
__device__ __forceinline__ unsigned xb_xcc_id() { return (unsigned)__builtin_amdgcn_s_getreg((3 << 11) | 20) & 0xFu; }
#define XB_SPIN(cond, bar) do { unsigned _sp = 0; while (cond) { __builtin_amdgcn_s_sleep(1); \
    if ((++_sp & 255u) == 0u) { if (xb_ld(&(bar)[XB_TMO])) break; if (_sp > XB_SPIN_CAP) { xb_add(&(bar)[XB_TMO], 1u); break; } } } } while (0)
struct XcdBarrier { unsigned* bar; unsigned x; volatile LAS unsigned* st; };
__device__ __forceinline__ XcdBarrier xcd_barrier_post(unsigned* bar, volatile LAS unsigned* st) {
    XcdBarrier b; b.bar = bar; b.x = (unsigned)__builtin_amdgcn_readfirstlane((int)xb_xcc_id()); b.st = st;
    if (threadIdx.x == 0) (void)xb_add(&bar[XB_XCNT(b.x)], 1u);
    return b;
}
__device__ __forceinline__ void xcd_barrier_complete(unsigned* bar, unsigned x, unsigned& nloc, unsigned& nx) {
    const unsigned G = gridDim.x * gridDim.y * gridDim.z;
    unsigned sum, cnt, mine, sp = 0u;
    for (;;) {
        sum = 0u; cnt = 0u; mine = 0u;
#pragma unroll
        for (unsigned j = 0; j < 16; ++j) { const unsigned c = xb_ld(&bar[XB_XCNT(j)]); sum += c; cnt += (c > 0u) ? 1u : 0u; mine = (j == x) ? c : mine; }
        if (sum == G) break;
        __builtin_amdgcn_s_sleep(1);
        if ((++sp & 255u) == 0u) { if (xb_ld(&bar[XB_TMO])) break; if (sp > XB_SPIN_CAP) { xb_add(&bar[XB_TMO], 1u); break; } }
    }
    nloc = mine > 0u ? mine : 1u; nx = cnt > 0u ? cnt : 1u;
}
__device__ __forceinline__ void xcd_barrier(const XcdBarrier& b) {
    asm volatile("s_waitcnt vmcnt(0)" ::: "memory");
    __syncthreads();
    if (threadIdx.x == 0) {
        unsigned* bar = b.bar; unsigned bx = b.x; asm volatile("" : "+s"(bar), "+s"(bx));
        __builtin_amdgcn_s_waitcnt(0);
        unsigned nloc = b.st[0], nx = b.st[1];
        if (nloc == 0u) { xcd_barrier_complete(bar, bx, nloc, nx); b.st[0] = nloc; b.st[1] = nx; }
        const unsigned old = xb_add(&bar[XB_XSUB(bx)], 1u);
        const unsigned gen = old / nloc;
        if (old + 1u == (gen + 1u) * nloc) {
            __builtin_amdgcn_fence(__ATOMIC_RELEASE, "agent");
            asm volatile("s_waitcnt vmcnt(0)" ::: "memory");
            const unsigned og = xb_add(&bar[XB_TOP], 1u);
            const unsigned tg = og / nx;
            if (og + 1u == (tg + 1u) * nx) xb_add(&bar[XB_TOPGEN], 1u);
            else XB_SPIN(xb_ld(&bar[XB_TOPGEN]) == tg, bar);
            __builtin_amdgcn_fence(__ATOMIC_ACQUIRE, "agent");
            xb_add(&bar[XB_XGEN(bx)], 1u);
            asm volatile("s_waitcnt vmcnt(0)" ::: "memory");
        } else {
            XB_SPIN(xb_ld(&bar[XB_XGEN(bx)]) == gen, bar);
            __builtin_amdgcn_fence(__ATOMIC_ACQUIRE, "agent");
            asm volatile("s_waitcnt vmcnt(0)" ::: "memory");
        }
    }
    __syncthreads();
}

enum { CV_NAT = 0, CV_WIN = 1, CV_WUQ = 2, CV_W13 = 3 };
__device__ __forceinline__ int ropeperm(int p) { return ((p >> 2) & 1) * 16 + 4 * (p >> 3) + (p & 3); }
__device__ __forceinline__ int cv_map(int kind, int G, int& which, float& scale, bool& perm) {
    which = 0; scale = 1.f; perm = false; const int n = G * 32;
    if (kind == CV_WIN) {
        if (n < 384) return n;
        if (n < 416) { perm = true; return 640; }
        if (n < 512) return -1;
        if (n < 768) return 384 + (n - 512);
        if (n < 1280) return 672 + (n - 768);
        if (n < 1792) return 1184 + (n - 1280);
        if (n < 2304) { scale = XSCALE; return 1696 + (n - 1792); }
        return 2208 + (n - 2304);
    }
    if (kind == CV_WUQ) { scale = QSCALE; perm = (G % 3) == 2; return n; }
    if (kind == CV_W13) { which = (n >> 7) & 1; return 128 * (n >> 8) + (n & 127); }
    return n;
}
struct CvDesc { const float* src; const float* src2; const float* gain; bf16* dst; int K, Nsrc, Nout, kind; };
__device__ __forceinline__ void cv_item(const CvDesc& d, int item, LAS char* tile, int lane) {
    const int nI = d.Nout >> 7, kb = item / nI, nb = item - kb * nI, k0 = 64 * kb, n0 = 128 * nb;
    const int nq = lane & 31, kh = lane >> 5;
    const int nout = n0 + 4 * nq, G = nout >> 5, p = nout & 31;
    int which; float scale; bool perm; const int sc = cv_map(d.kind, G, which, scale, perm);
    const bool zero = sc < 0;
    const float* W = d.src + (ptrdiff_t)which * (d.src2 - d.src) + (size_t)k0 * d.Nsrc + (zero ? 0 : sc + (perm ? ropeperm(p) : p));
#pragma unroll
    for (int half = 0; half < 2; ++half) {
        f32x4 v[16];
#pragma unroll
        for (int i = 0; i < 16; ++i) { const int k = 32 * half + 2 * i + kh; v[i] = zero ? (f32x4){0.f, 0.f, 0.f, 0.f} : *(const f32x4*)(W + (size_t)k * d.Nsrc); }
#pragma unroll
        for (int i = 0; i < 16; ++i) { const int k = 32 * half + 2 * i + kh; const float g = d.gain ? d.gain[k0 + k] * scale : scale; const f32x4 w = v[i] * g;
            *(LAS u32x2*)(tile + att::v_st<4>(k, 4 * nq)) = (u32x2){cvt_pk_bf16(w[0], w[1]), cvt_pk_bf16(w[2], w[3])}; }
    }
    LDS_WAIT(); asm volatile("" ::: "memory");
    const int vb = (int)(uintptr_t)tile + att::v_rd_base(lane);
    bf16* drow = d.dst + (size_t)(n0 >> 8) * 256 * d.K + (size_t)kb * (256 * 64) + (size_t)((n0 & 255) + nq) * 64 + 8 * kh;
#define CV_RD(D0, KS) { const s16x4 l_ = att::tr_read<((2 * KS) * 4 + D0) * 512>(vb), h_ = att::tr_read<((2 * KS + 1) * 4 + D0) * 512>(vb); \
        asm volatile("s_waitcnt lgkmcnt(0)" ::: "memory"); __builtin_amdgcn_sched_barrier(0); \
        *(bf16x8*)(drow + (32 * D0) * 64 + 16 * KS) = (bf16x8){l_[0], l_[1], l_[2], l_[3], h_[0], h_[1], h_[2], h_[3]}; }
#define CV_RD4(D0) CV_RD(D0, 0) CV_RD(D0, 1) CV_RD(D0, 2) CV_RD(D0, 3)
    CV_RD4(0) CV_RD4(1) CV_RD4(2) CV_RD4(3)
#undef CV_RD4
#undef CV_RD
    LDS_WAIT(); asm volatile("" ::: "memory");
}

struct Args {
    const float* x; const float* mem; const int* positions; const float* g_mix; const float* w_in; const float* g_q; const float* g_kv; const float* w_uq; const float* w_uk; const float* w_uv;
    const float* g_sg; const float* w_s; const float* b_s; const float* g_mem; const float* w_mkv; const float* w_br; const float* b_gate; const float* w_out; const float* g_ffn;
    const float* dense_w1; const float* dense_w3; const float* dense_w2; const float* w_router; const float* moe_w1; const float* moe_w3; const float* moe_w2; const float* g_final;
    float* out; unsigned char* ws; int dbg; int pad;
};
typedef const __attribute__((address_space(4))) Args* ArgsP;
#define FRESH(ap) ArgsP ap = kargs; asm volatile("" : "+s"(ap))
__constant__ double INVF[16] = { 1.0, 0.5623413251903491, 0.31622776601683794, 0.1778279410038923, 0.1, 0.05623413251903491, 0.03162277660168379, 0.01778279410038923,
                                 0.01, 0.005623413251903491, 0.003162277660168379, 0.001778279410038923, 0.001, 0.0005623413251903491, 0.00031622776601683794, 0.0001778279410038923 };

struct Frame { LAS unsigned char* lds; int G, NGW, bid; };
#define LOCAL_IDS int tid = threadIdx.x; asm volatile("" : "+v"(tid)); const int lane = tid & 63, wave = __builtin_amdgcn_readfirstlane(tid >> 6), gw = F.bid * NWAVES + wave; (void)lane; (void)gw

__device__ __forceinline__ void conv_run(const Frame& F, const CvDesc& d) {
    LOCAL_IDS;
    LAS char* tile = (LAS char*)(F.lds + wave * 16384);
    const int nitems = (d.K / 64) * (d.Nout / 128);
    for (int it = gw; it < nitems; it += F.NGW) cv_item(d, it, tile, lane);
}
__device__ __forceinline__ void rx_from_stats(const Frame& F, ArgsP kargs) {
    LOCAL_IDS; FRESH(ap); const float* xstat = (const float*)(ap->ws + WS_XSTAT); float* rx = (float*)(ap->ws + WS_RX);
    for (int row = F.bid * 512 + tid; row < M; row += F.G * 512) {
        const f32x4* p = (const f32x4*)(xstat + (size_t)row * 16); const f32x4 a = p[0], b = p[1], c = p[2], d = p[3];
        const float s = ((a[0] + a[1]) + (a[2] + a[3])) + ((b[0] + b[1]) + (b[2] + b[3])) + ((c[0] + c[1]) + (c[2] + c[3])) + ((d[0] + d[1]) + (d[2] + d[3]));
        rx[row] = __builtin_amdgcn_rsqf(s * (1.f / D) + EPS);
    }
}
template <int MODE>
__device__ __forceinline__ void conv_flat(const Frame& F, ArgsP kargs, int l, int j2, int lmix) {
    int tid_ = threadIdx.x; asm volatile("" : "+v"(tid_)); const int lane_ = tid_ & 63, wave_ = __builtin_amdgcn_readfirstlane(tid_ >> 6);
    LAS char* tile = (LAS char*)(F.lds + wave_ * 16384);
    constexpr int I13D = (D / 64) * (2 * DFF / 128), I2D = (DFF / 64) * (D / 128), I13 = (D / 64) * (2 * DFE / 128), I2 = (DFE / 64) * (D / 128), IE = I13 + I2, IMKV = (D / 64) * (D / 128);
    constexpr int NB_ = MODE == 0 ? DEPTH * IMKV : MODE == 1 ? I13D + I2D : NE * IE;
    constexpr int M_IN = (D / 64) * (PPAD / 128), M_UQ = (QRANK / 64) * (768 / 128), M_UK = (KVRANK / 64) * (512 / 128), M_BR = (BW / 64) * (D / 128), M_OUT = (D / 64) * (D / 128);
    constexpr int O_UQ = M_IN, O_UK = O_UQ + M_UQ, O_UV = O_UK + M_UK, O_BR = O_UV + M_UK, O_OUT = O_BR + 3 * M_BR, NMIX = O_OUT + M_OUT;
    const int total = NB_ + ((lmix >= 0 && lmix < DEPTH) ? NMIX : 0);
#pragma unroll 1
    for (int idx = wave_ * F.G + F.bid; idx < total; idx += F.NGW) { FRESH(a); CvDesc d; int it;
        if (idx < NB_) {
            if constexpr (MODE == 0) { const int lq = idx / IMKV; it = idx - lq * IMKV; d = CvDesc{a->w_mkv + (size_t)lq * D * D, nullptr, nullptr, (bf16*)(a->ws + WS_WMKVT) + (size_t)lq * D * D, D, D, D, CV_NAT}; }
            else if constexpr (MODE == 1) {
                if (idx < I13D) { it = idx; d = CvDesc{a->dense_w1 + (size_t)j2 * D * DFF, a->dense_w3 + (size_t)j2 * D * DFF, a->g_ffn + l * D, (bf16*)(a->ws + WS_WFFN), D, DFF, 2 * DFF, CV_W13}; }
                else { it = idx - I13D; d = CvDesc{a->dense_w2 + (size_t)j2 * DFF * D, nullptr, nullptr, (bf16*)(a->ws + WS_W2D), DFF, D, D, CV_NAT}; } }
            else { const int e = idx / IE, r = idx - e * IE;
                if (r < I13) { it = r; d = CvDesc{a->moe_w1 + ((size_t)j2 * NE + e) * D * DFE, a->moe_w3 + ((size_t)j2 * NE + e) * D * DFE, a->g_ffn + l * D, (bf16*)(a->ws + WS_WFFN) + (size_t)e * 2 * DFE * D, D, DFE, 2 * DFE, CV_W13}; }
                else { it = r - I13; d = CvDesc{a->moe_w2 + ((size_t)j2 * NE + e) * DFE * D, nullptr, nullptr, (bf16*)(a->ws + WS_W2M) + (size_t)e * D * DFE, DFE, D, D, CV_NAT}; } }
        } else { const int r = idx - NB_;
            if (r < O_UQ) { it = r; d = CvDesc{a->w_in + (size_t)lmix * D * PTOT, nullptr, a->g_mix + lmix * D, (bf16*)(a->ws + WS_WINT), D, PTOT, PPAD, CV_WIN}; }
            else if (r < O_UK) { it = r - O_UQ; d = CvDesc{a->w_uq + (size_t)lmix * QRANK * 768, nullptr, a->g_q + lmix * QRANK, (bf16*)(a->ws + WS_WUQT), QRANK, 768, 768, CV_WUQ}; }
            else if (r < O_UV) { it = r - O_UK; d = CvDesc{a->w_uk + (size_t)lmix * KVRANK * 512, nullptr, a->g_kv + lmix * KVRANK, (bf16*)(a->ws + WS_WUKVT), KVRANK, 512, 512, CV_NAT}; }
            else if (r < O_BR) { it = r - O_UV; d = CvDesc{a->w_uv + (size_t)lmix * KVRANK * 512, nullptr, a->g_kv + lmix * KVRANK, (bf16*)(a->ws + WS_WUKVT) + 512 * KVRANK, KVRANK, 512, 512, CV_NAT}; }
            else if (r < O_OUT) { const int n = (r - O_BR) / M_BR; it = (r - O_BR) - n * M_BR; d = CvDesc{a->w_br + ((size_t)lmix * 3 + n) * BW * D, nullptr, nullptr, (bf16*)(a->ws + WS_WBRT) + (size_t)n * D * BW, BW, D, D, CV_NAT}; }
            else { it = r - O_OUT; d = CvDesc{a->w_out + (size_t)lmix * D * D, nullptr, nullptr, (bf16*)(a->ws + WS_WOUTT), D, D, D, CV_NAT}; } }
        cv_item(d, it, tile, lane_); }
    if (lmix >= 0 && lmix < DEPTH) {
        FRESH(a); const float* wsrc = a->w_s + (size_t)lmix * 65536; bf16* wdst = (bf16*)(a->ws + WS_WSB);
        for (int i = F.bid * 512 + tid_; i < 4 * 128 * 128 / 4; i += F.G * 512) { const f32x4 v = *(const f32x4*)(wsrc + (size_t)i * 4);
            *(u32x2*)(wdst + (size_t)i * 4) = (u32x2){cvt_pk_bf16(v[0], v[1]), cvt_pk_bf16(v[2], v[3])}; } }
}
__device__ __forceinline__ void phase_prologue(const Frame& F, ArgsP kargs) {
    LOCAL_IDS;
    { FRESH(a); float* ROPE = (float*)(a->ws + WS_ROPE); const int* pos = a->positions;
      for (int idx = F.bid * 512 + tid; idx < M * 16; idx += F.G * 512) { const int row = idx >> 4, i = idx & 15;
        const double t = (double)pos[row] * INVF[i] * 0.15915494309189535; const float fr = (float)(t - rint(t));
        ROPE[(size_t)row * 32 + i] = __builtin_amdgcn_cosf(fr); ROPE[(size_t)row * 32 + 16 + i] = __builtin_amdgcn_sinf(fr); } }
    { FRESH(a); const float* xin = a->x; float* X = a->out; bf16* XB = (bf16*)(a->ws + WS_XB); float* RX = (float*)(a->ws + WS_RX);
      f32x4 vn[4];
#pragma unroll
      for (int j = 0; j < 4; ++j) vn[j] = ((const f32x4*)(xin + (size_t)gw * D) + lane)[64 * j];
#pragma unroll 1
      for (int m = gw; m < M; m += F.NGW) { f32x4 v[4]; float s = 0.f; const int mn = m + F.NGW < M ? m + F.NGW : m;
#pragma unroll
        for (int j = 0; j < 4; ++j) { v[j] = vn[j]; s += sumsq4(v[j]); }
#pragma unroll
        for (int j = 0; j < 4; ++j) vn[j] = ((const f32x4*)(xin + (size_t)mn * D) + lane)[64 * j];
        s = wave_sum(s);
#pragma unroll
        for (int j = 0; j < 4; ++j) { ((f32x4*)(X + (size_t)m * D) + lane)[64 * j] = v[j]; ((u32x2*)(XB + (size_t)m * D) + lane)[64 * j] = (u32x2){cvt_pk_bf16(v[j][0], v[j][1]), cvt_pk_bf16(v[j][2], v[j][3])}; }
        if (lane == 0) RX[m] = __builtin_amdgcn_rsqf(s * (1.f / D) + EPS); } }
    { FRESH(a); const float* mem = a->mem; const float* g_mem = a->g_mem; bf16* MEMB = (bf16*)(a->ws + WS_MEMB);
      for (int m = gw; m < NMEM; m += F.NGW) { const f32x4* xr = (const f32x4*)(mem + (size_t)m * D) + lane; f32x4 v[4]; float s = 0.f;
#pragma unroll
        for (int j = 0; j < 4; ++j) { v[j] = xr[64 * j]; s += sumsq4(v[j]); }
        const float r = __builtin_amdgcn_rsqf(wave_sum(s) * (1.f / D) + EPS);
#pragma unroll
        for (int j = 0; j < 4; ++j) { const f32x4 g = ((const f32x4*)g_mem + lane)[64 * j]; const f32x4 w = v[j] * r * g;
            ((u32x2*)(MEMB + (size_t)m * D) + lane)[64 * j] = (u32x2){cvt_pk_bf16(w[0], w[1]), cvt_pk_bf16(w[2], w[3])}; } } }
    conv_flat<0>(F, kargs, 0, 0, 0);
}
__device__ __forceinline__ void phase_inproj(const Frame& F, ArgsP kargs, int l) {
    if (PH(1)) { FRESH(a); unsigned char* ws = a->ws;
        pg8::TileOrder S{M / 256, PPAD / 256 - 1, F.G, F.bid, (const char*)(ws + WS_XB), (const char*)(ws + WS_WINT), (size_t)256 * D * 2, (size_t)256 * D * 2};
#ifdef DBG_REV
        S.rev = 1;
#endif
        pg8::EpiInProj E{ws, a->b_gate + (size_t)l * 3 * D, l, (l & 1)};
        pg8::gemm_phase(F.lds, D, D, D, S, E); }
    if (l == 0 && PH(2)) { FRESH(a); unsigned char* ws = a->ws;
        struct MemOrder { enum { VARK = 0, GATHER = 0 }; int c; const char* A; const char* B;
            __device__ __forceinline__ bool next(int i, pg8::Unit& u) const { if (i > 0 || c < 240) return false; const int idx = c - 240; u.pm = 0; u.pn = idx & 3; u.aux = idx >> 2; u.A = A; u.B = B + (size_t)u.aux * D * D * 2 + (size_t)u.pn * 256 * D * 2; return true; } };
        MemOrder S2{F.bid, (const char*)(ws + WS_MEMB), (const char*)(ws + WS_WMKVT)}; pg8::EpiMemKV E2{(bf16*)(ws + WS_KVMEM)};
        pg8::gemm_phase(F.lds, D, D, D, S2, E2); }
}
struct GateTailOrder { enum { VARK = 0, GATHER = 0 }; int c; const char* A; const char* B;
    __device__ __forceinline__ bool next(int i, pg8::Unit& u) const { if (i > 0 || c < 192) return false; u.pm = c - 192; u.pn = PPAD / 256 - 1; u.aux = 0; u.A = A + (size_t)u.pm * 256 * D * 2; u.B = B + (size_t)u.pn * 256 * D * 2; return true; } };
__device__ __forceinline__ void phase_up(const Frame& F, ArgsP kargs, int l) {
    if (PH(1)) { FRESH(a); unsigned char* ws = a->ws;
        GateTailOrder S{F.bid, (const char*)(ws + WS_XB), (const char*)(ws + WS_WINT)}; pg8::EpiInProj E{ws, a->b_gate + (size_t)l * 3 * D, l, (l & 1)};
        pg8::gemm_phase(F.lds, D, D, D, S, E); }
    if (PH(3)) { FRESH(a); unsigned char* ws = a->ws;
        pg8::TileOrder S{M / 256, 3, F.G, F.bid, (const char*)(ws + WS_CQ), (const char*)(ws + WS_WUQT), (size_t)256 * 512 * 2, (size_t)256 * QRANK * 2};
        pg8::EpiQ E{(const float*)(ws + WS_CQSTAT), (const float*)(ws + WS_ROPE), (bf16*)(ws + WS_Q)}; pg8::gemm_phase(F.lds, 512, QRANK, QRANK, S, E); }
    if (PH(4)) { FRESH(a); unsigned char* ws = a->ws;
        pg8::TileOrder S{M / 256, 4, F.G, F.bid, (const char*)(ws + WS_CKV), (const char*)(ws + WS_WUKVT), (size_t)256 * KVRANK * 2, (size_t)256 * KVRANK * 2};
        pg8::EpiKV E{(const float*)(ws + WS_CKVSTAT), (bf16*)(ws + WS_KN), (bf16*)(ws + WS_V), (unsigned*)(ws + WS_CTL) + CW_KMAX + l * 32}; pg8::gemm_phase(F.lds, KVRANK, KVRANK, KVRANK, S, E); }
    if (PH(5)) { FRESH(a); unsigned char* ws = a->ws;
        for (int un = F.bid; un < 512; un += F.G)
            att::spatial_unit(un >> 2, un & 3, (const bf16*)(ws + WS_U), (const bf16*)(ws + WS_VR), (const float*)(ws + WS_VSTAT), a->g_sg + l * BW, (const bf16*)(ws + WS_WSB), a->b_s + l * 512, (bf16*)(ws + WS_Y), (LAS char*)F.lds); }
    if (PH(6)) { FRESH(a); unsigned char* ws = a->ws;
        for (int un = F.bid; un < 256; un += F.G) { const int h = un & 3, pm = un >> 2; const bf16* kvm = (const bf16*)(ws + WS_KVMEM) + (size_t)l * 256 * 1024;
            att::attn_unit<128, 128, 128, false>((const bf16*)(ws + WS_QX) + (size_t)pm * 256 * 512 + h * 128, 512, kvm + h * 128, 1024, kvm, 1024, kvm + 512 + h * 128, 1024,
                                          (bf16*)(ws + WS_Y) + (size_t)pm * 256 * 1536 + 1024 + h * 128, 1536, NMEM, (LAS char*)F.lds, 0.f); } }
}
__device__ __forceinline__ void phase_attn(const Frame& F, ArgsP kargs, int l) {
    if (PH(7)) { FRESH(a); unsigned char* ws = a->ws;
        for (int un = F.bid; un < 256; un += F.G) { const int h = un & 7, qb = un >> 3;
            const unsigned* km = (const unsigned*)(ws + WS_CTL) + CW_KMAX + l * 32;
            const float kbound = sqrtf(__uint_as_float(km[2 * h]) + __uint_as_float(km[2 * h + 1]) + __uint_as_float(km[16])) * 1.02f;
            att::attn_unit2<96, 64, 64>((const bf16*)(ws + WS_Q) + (size_t)qb * 512 * 768 + h * 96, 768, (const bf16*)(ws + WS_KN) + h * 64, 512, (const bf16*)(ws + WS_KR), 32, (const bf16*)(ws + WS_V) + h * 64, 512,
                                        (bf16*)(ws + WS_Y) + (size_t)qb * 512 * 1536 + h * 64, 1536, M, (LAS char*)F.lds, kbound); } }
}
__device__ __forceinline__ void phase_branch(const Frame& F, ArgsP kargs) {
    if (PH(8)) { FRESH(a); unsigned char* ws = a->ws;
        struct BranchOrder { enum { VARK = 0, GATHER = 0 }; int c; const char* A; const char* B;
            __device__ __forceinline__ bool next(int i, pg8::Unit& u) const { if (i >= 3 || c >= 256) return false; int pm, pn; pg8::tile_of(c, 64, 4, pm, pn); u.pm = pm; u.pn = pn; u.aux = i;
                u.A = A + (size_t)pm * 256 * 1536 * 2 + (size_t)i * 512 * 2; u.B = B + (size_t)i * D * BW * 2 + (size_t)pn * 256 * BW * 2; return true; } };
        BranchOrder S{F.bid, (const char*)(ws + WS_Y), (const char*)(ws + WS_WBRT)}; pg8::EpiBranch E{(const unsigned char*)(ws + WS_GATE), (bf16*)(ws + WS_MIXB)};
        pg8::gemm_phase(F.lds, 1536, BW, BW, S, E); }
}
__device__ __forceinline__ void phase_outproj(const Frame& F, ArgsP kargs, bool dummy = false) {
    if (PH(9)) { FRESH(a); unsigned char* ws = a->ws;
        pg8::TileOrder S{M / 256, 4, F.G, F.bid, (const char*)(ws + WS_MIXB), (const char*)(ws + WS_WOUTT), (size_t)256 * D * 2, (size_t)256 * D * 2};
        pg8::EpiResid E{a->out, dummy ? (float*)(ws + 700 * MiB) : a->out, (bf16*)(ws + (dummy ? 764 * MiB : WS_XB)), (float*)(ws + (dummy ? 796 * MiB : WS_XSTAT))}; pg8::gemm_phase(F.lds, 0, D, D, S, E); }
}
__device__ __forceinline__ void phase_dense_conv(const Frame& F, ArgsP kargs, int l, int j2) {
    rx_from_stats(F, kargs);
    conv_flat<1>(F, kargs, l, j2, l + 1);
}
__device__ __forceinline__ void phase_dense_up(const Frame& F, ArgsP kargs) {
    if (PH(10)) { FRESH(a); unsigned char* ws = a->ws;
        pg8::TileOrder S{M / 256, 2 * DFF / 256, F.G, F.bid, (const char*)(ws + WS_XB), (const char*)(ws + WS_WFFN), (size_t)256 * D * 2, (size_t)256 * D * 2};
        pg8::EpiSwiGLU E{(const float*)(ws + WS_RX), (bf16*)(ws + WS_HFF), DFF, 0}; pg8::gemm_phase(F.lds, D, D, D, S, E); }
}
__device__ __forceinline__ void phase_dense_down(const Frame& F, ArgsP kargs, bool dummy = false) {
    if (PH(11)) { FRESH(a); unsigned char* ws = a->ws;
        pg8::TileOrder S{M / 256, 4, F.G, F.bid, (const char*)(ws + WS_HFF), (const char*)(ws + WS_W2D), (size_t)256 * DFF * 2, (size_t)256 * DFF * 2};
        pg8::EpiResid E{a->out, dummy ? (float*)(ws + 700 * MiB) : a->out, (bf16*)(ws + (dummy ? 764 * MiB : WS_XB)), (float*)(ws + (dummy ? 796 * MiB : WS_XSTAT))}; pg8::gemm_phase(F.lds, 0, DFF, DFF, S, E); }
}
__device__ __forceinline__ void phase_moe_route(const Frame& F, ArgsP kargs, int l, int j2) {
    conv_flat<2>(F, kargs, l, j2, l + 1 < DEPTH ? l + 1 : -1);
    __syncthreads();
    LOCAL_IDS; FRESH(a); unsigned char* ws = a->ws; const float* X = a->out;
    float* RX = (float*)(ws + WS_RX); int* TOPI = (int*)(ws + WS_TOPI); float* TOPW = (float*)(ws + WS_TOPW); int* LRANK = (int*)(ws + WS_LRANK); int* BLKCNT = (int*)(ws + WS_BLKCNT);
    LAS int* tope = (LAS int*)(F.lds + 0);
    const float* wr = a->w_router + (size_t)j2 * D * NE; const float* gf = a->g_ffn + l * D;
    f32x4 gvA[4], wA[4][4][2], xn[4];
#pragma unroll
    for (int j = 0; j < 4; ++j) { const int k0 = 4 * lane + 256 * j; gvA[j] = *(const f32x4*)(gf + k0);
#pragma unroll
        for (int q = 0; q < 4; ++q) { wA[j][q][0] = *(const f32x4*)(wr + (size_t)(k0 + q) * 8); wA[j][q][1] = *(const f32x4*)(wr + (size_t)(k0 + q) * 8 + 4); } }
#pragma unroll
    for (int j = 0; j < 4; ++j) xn[j] = *(const f32x4*)(X + (size_t)(F.bid * 64 + wave * 8) * D + 4 * lane + 256 * j);
#pragma unroll 1
    for (int i = 0; i < 8; ++i) { const int rib = wave * 8 + i, row = F.bid * 64 + rib;
        float lg[8]; float ss = 0.f; f32x4 xc[4];
#pragma unroll
        for (int e = 0; e < 8; ++e) lg[e] = 0.f;
#pragma unroll
        for (int j = 0; j < 4; ++j) xc[j] = xn[j];
        if (i + 1 < 8) {
#pragma unroll
            for (int j = 0; j < 4; ++j) xn[j] = *(const f32x4*)(X + (size_t)(row + 1) * D + 4 * lane + 256 * j); }
#pragma unroll
        for (int j = 0; j < 4; ++j) { const f32x4 xv = xc[j], gv = gvA[j]; ss += sumsq4(xv);
#pragma unroll
            for (int q = 0; q < 4; ++q) { const float hv = xv[q] * gv[q]; const f32x4 w0 = wA[j][q][0], w1 = wA[j][q][1];
                lg[0] += hv * w0[0]; lg[1] += hv * w0[1]; lg[2] += hv * w0[2]; lg[3] += hv * w0[3]; lg[4] += hv * w1[0]; lg[5] += hv * w1[1]; lg[6] += hv * w1[2]; lg[7] += hv * w1[3]; } }
        const float r = __builtin_amdgcn_rsqf(wave_sum(ss) * (1.f / D) + EPS);
#pragma unroll
        for (int e = 0; e < 8; ++e) lg[e] = wave_sum(lg[e]) * r;
        int e0 = 0; float v0 = lg[0];
#pragma unroll
        for (int e = 1; e < 8; ++e) if (lg[e] > v0) { v0 = lg[e]; e0 = e; }
        int e1 = e0 == 0 ? 1 : 0; float v1 = -3.0e38f;
#pragma unroll
        for (int e = 0; e < 8; ++e) if (e != e0 && lg[e] > v1) { v1 = lg[e]; e1 = e; }
        const float w0 = 1.f / (1.f + expf(v1 - v0));
        if (lane == 0) { RX[row] = r; TOPI[row] = e0 | (e1 << 8); TOPW[(size_t)row * 2] = w0; TOPW[(size_t)row * 2 + 1] = 1.f - w0; tope[rib] = e0 | (e1 << 8); } }
    __syncthreads();
    if (wave == 0) { const int te = tope[lane], e0 = te & 255, e1 = te >> 8, row = F.bid * 64 + lane; const unsigned long long below = (1ull << lane) - 1ull;
        int rk0 = 0, rk1 = 0;
#pragma unroll
        for (int e = 0; e < 8; ++e) { const unsigned long long m0 = __ballot(e0 == e), m1 = __ballot(e1 == e); const int c0 = __popcll(m0);
            if (e0 == e) rk0 = __popcll(m0 & below); if (e1 == e) rk1 = c0 + __popcll(m1 & below);
            if (lane == 0) BLKCNT[F.bid * 8 + e] = c0 + __popcll(m1); }
        LRANK[(size_t)row * 2] = rk0; LRANK[(size_t)row * 2 + 1] = rk1; }
    __syncthreads();
}
__device__ __forceinline__ void moe_tiles(const Frame& F, ArgsP kargs, int (&tb)[NE + 1], LAS int* pre) {
    LOCAL_IDS; FRESH(a); const int* BLKCNT = (const int*)(a->ws + WS_BLKCNT);
    __syncthreads();
    if (tid < 16) pre[tid] = 0;
    __syncthreads();
    if (tid < 256) { const i32x4 c0 = *(const i32x4*)(BLKCNT + tid * 8), c1 = *(const i32x4*)(BLKCNT + tid * 8 + 4); const int cc[8] = {c0[0], c0[1], c0[2], c0[3], c1[0], c1[1], c1[2], c1[3]};
#pragma unroll
        for (int e = 0; e < 8; ++e) { const int tot = (int)wave_sum((float)cc[e]); const int bel = (int)wave_sum(tid < F.bid ? (float)cc[e] : 0.f);
            if (lane == 0) { __hip_atomic_fetch_add(pre + 8 + e, tot, __ATOMIC_RELAXED, __HIP_MEMORY_SCOPE_WORKGROUP); __hip_atomic_fetch_add(pre + e, bel, __ATOMIC_RELAXED, __HIP_MEMORY_SCOPE_WORKGROUP); } } }
    __syncthreads();
    int acc_t = 0;
#pragma unroll
    for (int e = 0; e < NE; ++e) { tb[e] = acc_t; acc_t += (__builtin_amdgcn_readfirstlane(pre[8 + e]) + 255) >> 8; }
    tb[NE] = acc_t;
}
__device__ __forceinline__ void phase_moe_gather(const Frame& F, ArgsP kargs) {
    int tb[NE + 1]; LAS int* pre = (LAS int*)(F.lds + 0);
    moe_tiles(F, kargs, tb, pre);
    LOCAL_IDS; FRESH(a); unsigned char* ws = a->ws;
    const int* TOPI = (const int*)(ws + WS_TOPI); const int* LRANK = (const int*)(ws + WS_LRANK); int* POS = (int*)(ws + WS_POS); float* SLOTR = (float*)(ws + WS_SLOTR); const float* RX = (const float*)(ws + WS_RX);
    int* TOKOF = (int*)(ws + WS_TOKOF);
    if (lane < 16) { const int pi = wave * 16 + lane, rib = pi >> 1, k = pi & 1, row = F.bid * 64 + rib;
        const int te = TOPI[row], e = k ? (te >> 8) : (te & 255); const int lr = LRANK[(size_t)row * 2 + k]; const float rx = RX[row];
        int bs = 0;
#pragma unroll
        for (int q = 0; q < NE; ++q) if (q == e) bs = tb[q] * 256;
        const int slot = bs + pre[e] + lr;
        POS[(size_t)row * 2 + k] = slot; SLOTR[slot] = rx; TOKOF[slot] = row; }
    if (F.bid < NE) { const int e = F.bid; int b0 = 0, b1 = 0;
#pragma unroll
        for (int q = 0; q < NE; ++q) if (q == e) { b0 = tb[q] * 256; b1 = tb[q + 1] * 256; }
        const int cnt = __builtin_amdgcn_readfirstlane(pre[8 + e]);
        for (int s = b0 + cnt + tid; s < b1; s += NWAVES * 64) { SLOTR[s] = 0.f; TOKOF[s] = 0; } }
    __syncthreads();
}
struct MoeOrder { enum { VARK = 0, GATHER = 0 }; int nN, G, c, T; int tb[NE + 1]; const char* A; const char* B; size_t astep, estep, bstep; int rev = 0;
    __device__ __forceinline__ bool next(int i, pg8::Unit& u) const { const long L = (long)i * G + c; if (L >= (long)T * nN) return false; int pm, pn; pg8::tile_of((int)L, T, nN, pm, pn); if (rev) pm = T - 1 - pm;
        int e = 0;
#pragma unroll
        for (int q = 1; q < NE; ++q) e += (pm >= tb[q]) ? 1 : 0;
        u.pm = pm; u.pn = pn; u.aux = e; u.A = A + (size_t)pm * astep; u.B = B + (size_t)e * estep + (size_t)pn * bstep; return true; } };
struct MoeUpOrder { enum { VARK = 0, GATHER = 1 }; int nN, G, c, T; int tb[NE + 1]; const char* A; const char* B; size_t estep, bstep; const LAS int* tokL;
    __device__ __forceinline__ bool next(int i, pg8::Unit& u) const { const long L = (long)i * G + c; if (L >= (long)T * nN) return false; int pm, pn; pg8::tile_of((int)L, T, nN, pm, pn);
        int e = 0;
#pragma unroll
        for (int q = 1; q < NE; ++q) e += (pm >= tb[q]) ? 1 : 0;
        u.pm = pm; u.pn = pn; u.aux = e; u.A = A; u.B = B + (size_t)e * estep + (size_t)pn * bstep; return true; } };
struct MoeTailOrder { enum { VARK = 1, GATHER = 0 }; static constexpr int PPU = DFE / 128;
    int nN, G, c, T; int tb[NE + 1]; const char* A; const char* B; size_t astep, estep, bstep; int rev = 0;
    __device__ __forceinline__ bool next(int i, pg8::Unit& u) const {
        const int U = T * nN, R = U / G, Lf = U - R * G, x = c & 7, j = c >> 3, nj = (G - x + 7) >> 3;
        const int Lfx = Lf > x ? (Lf - x + 7) >> 3 : 0;
        long L; int k0 = 0, np = PPU, part = 0, k = 0, r = 0, C = 1;
        if (i < R) L = (long)i * G + c;
        else if (i == R && Lfx > 0) { const int cap = nj / Lfx; C = cap >= 8 ? 8 : cap >= 1 ? cap : 1;
            r = j / C; k = j - r * C; if (r >= Lfx) return false;
            L = (long)R * G + x + 8 * r; if (C > 1) { const int q = PPU / C, rem = PPU - q * C; np = q + (k < rem ? 1 : 0); k0 = k * q + (k < rem ? k : rem); part = 3; } }
        else return false;
        int pm, pn; pg8::tile_of((int)L, T, nN, pm, pn); if (rev) pm = T - 1 - pm;
        int e = 0;
#pragma unroll
        for (int q = 1; q < NE; ++q) e += (pm >= tb[q]) ? 1 : 0;
        u.pm = pm; u.pn = pn; u.aux = e | (part << 4) | (k << 8) | (C << 16) | (r << 24); u.nt = 2 * np;
        u.A = A + (size_t)pm * astep + (size_t)k0 * 65536; u.B = B + (size_t)e * estep + (size_t)pn * bstep + (size_t)k0 * 65536; return true; } };
__device__ __forceinline__ void phase_moe_up(const Frame& F, ArgsP kargs) {
    if (PH(12)) { MoeUpOrder S; LAS int* pre = (LAS int*)(F.lds + RING_BYTES + 64); moe_tiles(F, kargs, S.tb, pre);
        FRESH(a); unsigned char* ws = a->ws; S.nN = 2 * DFE / 256; S.G = F.G; S.c = F.bid; S.T = S.tb[NE];
        S.A = (const char*)(ws + WS_XB); S.B = (const char*)(ws + WS_WFFN); S.estep = (size_t)2 * DFE * D * 2; S.bstep = (size_t)256 * D * 2;
        { LAS int* tokL = (LAS int*)(F.lds + RING_BYTES + 1024); S.tokL = tokL; const int* TOKOF = (const int*)(ws + WS_TOKOF);
          int tid_ = threadIdx.x; asm volatile("" : "+v"(tid_)); const int half_ = __builtin_amdgcn_readfirstlane(tid_ >> 8); int tkv[8];
#pragma unroll
          for (int j = 0; j < 8; ++j) { pg8::Unit u; const bool ok = S.next(2 * j + half_, u); tkv[j] = ok ? TOKOF[u.pm * 256 + (tid_ & 255)] : 0; }
#pragma unroll
          for (int j = 0; j < 8; ++j) tokL[(2 * j + half_) * 256 + (tid_ & 255)] = tkv[j];
          __syncthreads(); }
        pg8::EpiSwiGLU E{(const float*)(ws + WS_SLOTR), (bf16*)(ws + WS_HG), DFE, 0}; pg8::gemm_phase(F.lds, D, D, D, S, E); }
}
__device__ __forceinline__ void phase_moe_down(const Frame& F, ArgsP kargs, int j2) {
    if (PH(13)) { MoeTailOrder S; LAS int* pre = (LAS int*)(F.lds + RING_BYTES + 64); moe_tiles(F, kargs, S.tb, pre);
        FRESH(a); unsigned char* ws = a->ws; S.nN = 4; S.G = F.G; S.c = F.bid; S.T = S.tb[NE]; S.rev = 1;
        S.A = (const char*)(ws + WS_HG); S.B = (const char*)(ws + WS_W2M); S.astep = (size_t)256 * DFE * 2; S.estep = (size_t)D * DFE * 2; S.bstep = (size_t)256 * DFE * 2;
        pg8::EpiBf16KS E{(bf16*)(ws + WS_OUTG), D, (float*)(ws + WS_SKPART), (unsigned*)(ws + WS_CTL) + CW_SK + j2 * 512, F.bid}; pg8::gemm_phase(F.lds, 0, DFE, DFE, S, E); }
}
__device__ __forceinline__ void phase_moe_combine(const Frame& F, ArgsP kargs, bool last) {
    LOCAL_IDS; FRESH(a); unsigned char* ws = a->ws; float* X = a->out; const bf16* OUTG = (const bf16*)(ws + WS_OUTG); const int* POS = (const int*)(ws + WS_POS); const float* TOPW = (const float*)(ws + WS_TOPW);
    bf16* XB = (bf16*)(ws + WS_XB); float* RX = (float*)(ws + WS_RX); const float* g_final = a->g_final;
    int s0n, s1n; float w0n, w1n, w0c, w1c; u32x2 pn0[4], pn1[4]; f32x4 xn[4];
    { const int s0 = POS[(size_t)gw * 2], s1 = POS[(size_t)gw * 2 + 1]; w0c = TOPW[(size_t)gw * 2]; w1c = TOPW[(size_t)gw * 2 + 1];
      const int m1 = gw + F.NGW < M ? gw + F.NGW : gw; s0n = POS[(size_t)m1 * 2]; s1n = POS[(size_t)m1 * 2 + 1]; w0n = TOPW[(size_t)m1 * 2]; w1n = TOPW[(size_t)m1 * 2 + 1];
#pragma unroll
      for (int j = 0; j < 4; ++j) { pn0[j] = ((const u32x2*)(OUTG + (size_t)s0 * D) + lane)[64 * j]; pn1[j] = ((const u32x2*)(OUTG + (size_t)s1 * D) + lane)[64 * j]; xn[j] = ((const f32x4*)(X + (size_t)gw * D) + lane)[64 * j]; } }
#pragma unroll 1
    for (int m = gw; m < M; m += F.NGW) {
        const float w0 = w0c, w1 = w1c; u32x2 p0c[4], p1c[4]; f32x4 xc[4];
#pragma unroll
        for (int j = 0; j < 4; ++j) { p0c[j] = pn0[j]; p1c[j] = pn1[j]; xc[j] = xn[j]; }
        { const int mn = m + F.NGW < M ? m + F.NGW : m, mnn = m + 2 * F.NGW < M ? m + 2 * F.NGW : m; const int s0 = s0n, s1 = s1n; w0c = w0n; w1c = w1n;
#pragma unroll
          for (int j = 0; j < 4; ++j) { pn0[j] = ((const u32x2*)(OUTG + (size_t)s0 * D) + lane)[64 * j]; pn1[j] = ((const u32x2*)(OUTG + (size_t)s1 * D) + lane)[64 * j]; xn[j] = ((const f32x4*)(X + (size_t)mn * D) + lane)[64 * j]; }
          s0n = POS[(size_t)mnn * 2]; s1n = POS[(size_t)mnn * 2 + 1]; w0n = TOPW[(size_t)mnn * 2]; w1n = TOPW[(size_t)mnn * 2 + 1]; }
        f32x4 v[4]; float s = 0.f;
#pragma unroll
        for (int j = 0; j < 4; ++j) { const u32x2 p0 = p0c[j], p1 = p1c[j];
            const f32x4 o0 = {bflo(p0.x), bfhi(p0.x), bflo(p0.y), bfhi(p0.y)}, o1 = {bflo(p1.x), bfhi(p1.x), bflo(p1.y), bfhi(p1.y)};
            v[j] = xc[j] + w0 * o0 + w1 * o1; s += sumsq4(v[j]); }
        const float r = __builtin_amdgcn_rsqf(wave_sum(s) * (1.f / D) + EPS);
        if (last) {
#pragma unroll
            for (int j = 0; j < 4; ++j) ((f32x4*)(X + (size_t)m * D) + lane)[64 * j] = v[j] * r * ((const f32x4*)g_final + lane)[64 * j];
        } else {
#pragma unroll
            for (int j = 0; j < 4; ++j) { ((f32x4*)(X + (size_t)m * D) + lane)[64 * j] = v[j]; ((u32x2*)(XB + (size_t)m * D) + lane)[64 * j] = (u32x2){cvt_pk_bf16(v[j][0], v[j][1]), cvt_pk_bf16(v[j][2], v[j][3])}; }
            if (lane == 0) RX[m] = r;
        }
    }
}


#ifdef DBG_ENABLE
__device__ __forceinline__ float dbg_b(const unsigned char* ws, size_t off, size_t idx) { return bf2f(((const bf16*)(ws + off))[idx]); }
__device__ __forceinline__ void dbg_dump(const Frame& F, ArgsP kargs, int code) {
    LOCAL_IDS; FRESH(a); const unsigned char* ws = a->ws; float* out = a->out;
    unsigned tmo = ((const unsigned*)(ws + WS_CTL))[CW_BAR + XB_TMO];
    for (size_t i = (size_t)F.bid * 512 + tid; i < (size_t)M * D; i += (size_t)F.G * 512) { const size_t row = i >> 10, c = i & 1023; float v = 0.f;
        if (code == 1) v = dbg_b(ws, WS_CQ, row * 512 + (c & 511)) + dbg_b(ws, WS_CKV, row * 256 + (c & 255)) + dbg_b(ws, WS_U, row * 512 + (c & 511)) + dbg_b(ws, WS_VR, row * 512 + (c & 511)) + dbg_b(ws, WS_QX, row * 512 + (c & 511))
                         + dbg_b(ws, WS_GATE, row * 3072 + c) + dbg_b(ws, WS_GATE, row * 3072 + 1024 + c) + dbg_b(ws, WS_GATE, row * 3072 + 2048 + c) + dbg_b(ws, WS_KR, row * 32 + (c & 31));
        else if (code == 2) v = dbg_b(ws, WS_Q, row * 768 + (c % 768)) + dbg_b(ws, WS_KN, row * 512 + (c & 511)) + dbg_b(ws, WS_V, row * 512 + (c & 511)) + dbg_b(ws, WS_Y, row * 1536 + 512 + c);
        else if (code == 3) v = dbg_b(ws, WS_Y, row * 1536 + (c & 511));
        else if (code == 15) v = dbg_b(ws, WS_WINT, i % ((size_t)PPAD * D));
        else if (code == 13 || code == 14) v = dbg_b(ws, WS_GATE, row * 3072 + c) + dbg_b(ws, WS_GATE, row * 3072 + 1024 + c) + dbg_b(ws, WS_GATE, row * 3072 + 2048 + c);
        else if (code == 4) v = dbg_b(ws, WS_MIXB, row * 1024 + c);
        else if (code == 6) v = dbg_b(ws, WS_HFF, row * 2688 + c) + dbg_b(ws, WS_HFF, row * 2688 + 1024 + c) + dbg_b(ws, WS_HFF, row * 2688 + 1664 + c);
        else if (code == 9) { const int s0 = ((const int*)(ws + WS_POS))[row * 2], s1 = ((const int*)(ws + WS_POS))[row * 2 + 1]; v = dbg_b(ws, WS_XG, (size_t)s0 * 1024 + c) + 2.f * dbg_b(ws, WS_XG, (size_t)s1 * 1024 + c) + ((const float*)(ws + WS_TOPW))[row * 2] + (float)s0 * 1e-3f; }
        else if (code == 10) { const int s0 = ((const int*)(ws + WS_POS))[row * 2], s1 = ((const int*)(ws + WS_POS))[row * 2 + 1]; v = dbg_b(ws, WS_HG, (size_t)s0 * 3584 + c) + dbg_b(ws, WS_HG, (size_t)s1 * 3584 + 2560 + c) + dbg_b(ws, WS_HG, (size_t)s0 * 3584 + 1500 + c); }
        else if (code == 11) { const int s0 = ((const int*)(ws + WS_POS))[row * 2], s1 = ((const int*)(ws + WS_POS))[row * 2 + 1]; v = ((const float*)(ws + WS_OUTG))[(size_t)s0 * 1024 + c] + ((const float*)(ws + WS_OUTG))[(size_t)s1 * 1024 + c]; }
        else continue;
        if (tmo) v = __builtin_nanf("");
        out[i] = v; }
}
#define DBG(code) do { if (dbgc == (code)) { dbg_dump(F, kargs, code); return; } } while (0)
#else
#define DBG(code) do { } while (0)
#endif

__global__ void __launch_bounds__(NWAVES * 64, 2) fwd_kernel(Args args_by_value) {
    extern __shared__ __attribute__((aligned(16))) unsigned char lds_raw[];
    const ArgsP kargs = (ArgsP)__builtin_amdgcn_kernarg_segment_ptr();
    Frame F; F.lds = (LAS unsigned char*)lds_raw; F.G = gridDim.x; F.bid = blockIdx.x; F.NGW = F.G * NWAVES;
    for (int u = threadIdx.x; u < (LDS_BYTES - LDSCTL_OFF) / 4; u += NWAVES * 64) ((LAS unsigned*)(F.lds + LDSCTL_OFF))[u] = 0u;
    __syncthreads();
    volatile LAS unsigned* MISC = (volatile LAS unsigned*)(F.lds + MISC_OFF);
    XcdBarrier bar; { FRESH(a); bar = xcd_barrier_post((unsigned*)(a->ws + WS_CTL) + CW_BAR, MISC + 8); }
#define GRID_BAR() xcd_barrier(bar)

#ifdef ONLY_TEST
    ONLY_TEST; GRID_BAR(); return;
#endif
    const Frame F_ = F;
    int dbgc; { FRESH(a); dbgc = a->dbg; } (void)dbgc;
    phase_prologue(F, kargs); GRID_BAR();
#pragma unroll 1
    for (int l_ = 0; l_ < DEPTH; ++l_) {
        Frame F = F_; int l = l_; asm volatile("" : "+s"(F.G), "+s"(F.NGW), "+s"(F.bid), "+s"(l));
        const bool moe = (l & 1) != 0; const int j2 = l >> 1;
        if (l == 0) DBG(15);
#ifdef PROBE_INPROJ2
        { int reps = 2; asm volatile("" : "+s"(reps));
#pragma unroll 1
          for (int rep = 0; rep < reps; ++rep) { phase_inproj(F, kargs, l); GRID_BAR(); } }
#else
        phase_inproj(F, kargs, l); GRID_BAR(); if (l == 0) DBG(1); if (l == 0) DBG(14);
#endif
        phase_up(F, kargs, l); GRID_BAR(); if (l == 0) DBG(2);
        phase_attn(F, kargs, l); GRID_BAR(); if (l == 0) DBG(3); if (l == 0) DBG(13);
#ifdef PROBE_ATTN2
        phase_attn(F, kargs, l); GRID_BAR();
#endif
#ifdef PROBE_UP2
        phase_up(F, kargs, l); GRID_BAR();
#endif
        phase_branch(F, kargs); GRID_BAR(); if (l == 0) DBG(4);
#ifdef PROBE_RESID2
        { int reps = 2; asm volatile("" : "+s"(reps));
#pragma unroll 1
          for (int rep = reps - 1; rep >= 0; --rep) { phase_outproj(F, kargs, rep != 0); GRID_BAR(); } }
#else
        phase_outproj(F, kargs); GRID_BAR(); if (l == 0) DBG(5); if (l == 1) DBG(8);
#endif
        if (!moe) {
            phase_dense_conv(F, kargs, l, j2); GRID_BAR();
            phase_dense_up(F, kargs); GRID_BAR(); if (l == 0) DBG(6);
#ifdef PROBE_DENSE2
            phase_dense_up(F, kargs); GRID_BAR();
#endif
#ifdef PROBE_RESID2
            { int reps = 2; asm volatile("" : "+s"(reps));
#pragma unroll 1
              for (int rep = reps - 1; rep >= 0; --rep) { phase_dense_down(F, kargs, rep != 0); GRID_BAR(); } }
#else
            phase_dense_down(F, kargs); GRID_BAR(); if (l == 0) DBG(7);
#endif
        } else {
            phase_moe_route(F, kargs, l, j2); GRID_BAR();
            phase_moe_gather(F, kargs); GRID_BAR(); if (l == 1) DBG(9);
#ifdef PROBE_AUX2
            phase_moe_gather(F, kargs); GRID_BAR();
#endif
            phase_moe_up(F, kargs); GRID_BAR(); if (l == 1) DBG(10);
            phase_moe_down(F, kargs, j2); GRID_BAR(); if (l == 1) DBG(11);
#ifdef PROBE_MOE2
            phase_moe_up(F, kargs); GRID_BAR();
            phase_moe_down(F, kargs, j2); GRID_BAR();
#endif
            phase_moe_combine(F, kargs, l == DEPTH - 1);
            if (l != DEPTH - 1) GRID_BAR();
            if (l == 1) DBG(12);
        }
    }
}

extern "C" void kernel_launch(void* const* d_in, const int* in_sizes, int n_in, void* d_out, int out_size, void* d_ws, size_t ws_size, hipStream_t stream) {
    static int grid = 0;
    if (grid == 0) {
        if (n_in != 27 || in_sizes[0] != M * D || out_size != M * D || ws_size < WS_END) { fprintf(stderr, "kernel_launch: unexpected shapes (n_in %d, in0 %d, out %d, ws %zu)\n", n_in, n_in > 0 ? in_sizes[0] : -1, out_size, ws_size); grid = -1; return; }
        int dev = 0, cus = 0, per_cu = 0;
        if (hipGetDevice(&dev) != hipSuccess || hipDeviceGetAttribute(&cus, hipDeviceAttributeMultiprocessorCount, dev) != hipSuccess) { grid = -1; return; }
        if (hipFuncSetAttribute((const void*)fwd_kernel, hipFuncAttributeMaxDynamicSharedMemorySize, LDS_BYTES) != hipSuccess) { fprintf(stderr, "kernel_launch: hipFuncSetAttribute failed\n"); grid = -1; return; }
        if (hipOccupancyMaxActiveBlocksPerMultiprocessor(&per_cu, (const void*)fwd_kernel, NWAVES * 64, LDS_BYTES) != hipSuccess || per_cu < 1) { fprintf(stderr, "kernel_launch: occupancy query reports %d\n", per_cu); }
        (void)hipGetLastError();
        if (cus != 256) { fprintf(stderr, "kernel_launch: built for 256 CUs, device has %d\n", cus); grid = -1; return; }
        grid = 256;
    }
    if (grid < 0) return;
    if (hipMemsetAsync((char*)d_ws + WS_CTL, 0, CTL_ZERO_BYTES, stream) != hipSuccess) return;
    Args a{};
    a.x = (const float*)d_in[0]; a.mem = (const float*)d_in[1]; a.positions = (const int*)d_in[2]; a.g_mix = (const float*)d_in[3]; a.w_in = (const float*)d_in[4]; a.g_q = (const float*)d_in[5];
    a.g_kv = (const float*)d_in[6]; a.w_uq = (const float*)d_in[7]; a.w_uk = (const float*)d_in[8]; a.w_uv = (const float*)d_in[9]; a.g_sg = (const float*)d_in[10]; a.w_s = (const float*)d_in[11];
    a.b_s = (const float*)d_in[12]; a.g_mem = (const float*)d_in[13]; a.w_mkv = (const float*)d_in[14]; a.w_br = (const float*)d_in[15]; a.b_gate = (const float*)d_in[16]; a.w_out = (const float*)d_in[17];
    a.g_ffn = (const float*)d_in[18]; a.dense_w1 = (const float*)d_in[19]; a.dense_w3 = (const float*)d_in[20]; a.dense_w2 = (const float*)d_in[21]; a.w_router = (const float*)d_in[22];
    a.moe_w1 = (const float*)d_in[23]; a.moe_w3 = (const float*)d_in[24]; a.moe_w2 = (const float*)d_in[25]; a.g_final = (const float*)d_in[26];
    a.out = (float*)d_out; a.ws = (unsigned char*)d_ws;
#ifdef DBG_STOP
    a.dbg = DBG_STOP;
#endif
    hipLaunchKernelGGL(fwd_kernel, dim3(grid), dim3(NWAVES * 64), LDS_BYTES, stream, a);
    const hipError_t le = hipPeekAtLastError();
    if (le != hipSuccess) fprintf(stderr, "kernel_launch: launch failed: %s\n", hipGetErrorName(le));
}
```

```cpp
#include <hip/hip_runtime.h>
#include <cstdio>
#include <cstdint>

#ifndef PH_MASK
#define PH_MASK 0xffffffffu
#endif
#define PH(k) ((PH_MASK >> (k)) & 1u)
#define LAS __attribute__((address_space(3)))
#define GAS __attribute__((address_space(1)))
typedef unsigned short bf16;
typedef short bf16x8 __attribute__((ext_vector_type(8)));
typedef short s16x4 __attribute__((ext_vector_type(4)));
typedef float f32x4 __attribute__((ext_vector_type(4)));
typedef float f32x2 __attribute__((ext_vector_type(2)));
typedef float f32x16 __attribute__((ext_vector_type(16)));
typedef unsigned u32x4 __attribute__((ext_vector_type(4)));
typedef unsigned u32x2 __attribute__((ext_vector_type(2)));
typedef int i32x4 __attribute__((ext_vector_type(4)));

constexpr int M = 16384, D = 1024, DEPTH = 4, NMEM = 256;
constexpr int QRANK = 384, KVRANK = 256, NH = 8, QKD = 96, VD = 64;
constexpr int XH = 4, XD = 128, BW = 512;
constexpr int PTOT = 5280, PPAD = 5376, DFF = 2688, NE = 8, DFE = 3584;
constexpr float EPS = 1e-6f;
constexpr int MAXSLOT = 34816;
constexpr float LOG2E = 1.4426950408889634f;
constexpr float QSCALE = 0.10206207261596575f * LOG2E;
constexpr float XSCALE = 0.08838834764831845f * LOG2E;

constexpr size_t MiB = 1u << 20, KiB = 1u << 10;
constexpr size_t WS_CTL = 0, CTL_ZERO_BYTES = 1 * MiB;
constexpr size_t WS_ROPE = 2 * MiB;
constexpr size_t WS_XSTAT = 4 * MiB;
constexpr size_t WS_RX = 5 * MiB;
constexpr size_t WS_CQSTAT = 5 * MiB + 256 * KiB;
constexpr size_t WS_CKVSTAT = 5 * MiB + 768 * KiB;
constexpr size_t WS_VSTAT = 6 * MiB;
constexpr size_t WS_MEMB = 6 * MiB + 512 * KiB;
constexpr size_t WS_KVMEM = 7 * MiB;
constexpr size_t WS_TOPI = 9 * MiB;
constexpr size_t WS_TOPW = 9 * MiB + 256 * KiB;
constexpr size_t WS_LRANK = 9 * MiB + 512 * KiB;
constexpr size_t WS_POS = 9 * MiB + 768 * KiB;
constexpr size_t WS_BLKCNT = 10 * MiB;
constexpr size_t WS_SLOTR = 10 * MiB + 512 * KiB;
constexpr size_t WS_TOKOF = 10 * MiB + 768 * KiB;
constexpr size_t WS_WSB = 11 * MiB;
constexpr size_t WS_WMKVT = 12 * MiB;
constexpr size_t WS_WINT = 20 * MiB;
constexpr size_t WS_WUQT = 31 * MiB;
constexpr size_t WS_WUKVT = 32 * MiB;
constexpr size_t WS_WBRT = 33 * MiB;
constexpr size_t WS_WOUTT = 36 * MiB;
constexpr size_t WS_WFFN = 40 * MiB;
constexpr size_t WS_W2D = WS_WFFN + 11 * MiB;
constexpr size_t WS_W2M = WS_WFFN + 112 * MiB;
constexpr size_t WS_XB = 208 * MiB;
constexpr size_t WS_CQ = 240 * MiB;
constexpr size_t WS_CKV = 256 * MiB;
constexpr size_t WS_U = 264 * MiB;
constexpr size_t WS_VR = 280 * MiB;
constexpr size_t WS_QX = 296 * MiB;
constexpr size_t WS_GATE = 312 * MiB;
constexpr size_t WS_Q = 408 * MiB;
constexpr size_t WS_KN = 432 * MiB;
constexpr size_t WS_KR = 448 * MiB;
constexpr size_t WS_V = 450 * MiB;
constexpr size_t WS_Y = 466 * MiB;
constexpr size_t WS_MIX = 514 * MiB;
constexpr size_t WS_MIXB = 578 * MiB;
constexpr size_t WS_MIX1 = 610 * MiB;
constexpr size_t WS_HFF = 240 * MiB;
constexpr size_t WS_XG = 240 * MiB;
constexpr size_t WS_HG = 308 * MiB;
constexpr size_t WS_OUTG = 546 * MiB;
constexpr size_t WS_END = 682 * MiB;
constexpr int CW_TMO = 0, CW_CODE = 1, CW_CHK = 2, CW_BAR = 4096;
constexpr int CW_SK = 16384;
constexpr size_t WS_SKPART = 700 * MiB;
constexpr int CW_KMAX = 8192;

constexpr int RING_BYTES = 131072, LDSCTL_OFF = 159744, MISC_OFF = LDSCTL_OFF + 320, LDS_BYTES = 163840;
constexpr int NWAVES = 8;

#define RLX_AGENT __ATOMIC_RELAXED, __HIP_MEMORY_SCOPE_AGENT
#define LDS_WAIT() asm volatile("s_waitcnt lgkmcnt(0)" ::: "memory")
#define VM_WAIT() asm volatile("s_waitcnt vmcnt(0)" ::: "memory")
typedef __bf16 bf16x2_t __attribute__((ext_vector_type(2)));
__device__ __forceinline__ unsigned cvt_pk_bf16(float lo, float hi) { const f32x2 v = {lo, hi}; const bf16x2_t b = __builtin_convertvector(v, bf16x2_t); return __builtin_bit_cast(unsigned, b); }
__device__ __forceinline__ bf16 f2bf(float f) { return (bf16)(cvt_pk_bf16(f, 0.f) & 0xffffu); }
__device__ __forceinline__ float bf2f(bf16 v) { return __uint_as_float((unsigned)v << 16); }
__device__ __forceinline__ float bflo(unsigned w) { return __uint_as_float(w << 16); }
__device__ __forceinline__ float bfhi(unsigned w) { return __uint_as_float(w & 0xffff0000u); }
__device__ __forceinline__ float fast_exp2(float x) { return __builtin_amdgcn_exp2f(x); }
__device__ __forceinline__ float fast_rcp(float x) { return __builtin_amdgcn_rcpf(x); }
__device__ __forceinline__ float sigmoidf_(float z) { return fast_rcp(1.f + fast_exp2(-LOG2E * z)); }
__device__ __forceinline__ float gelu_tanh(float x) { const float t = x + 0.044715f * x * x * x; return x * fast_rcp(1.f + fast_exp2(-2.f * 0.7978845608028654f * LOG2E * t)); }
template <int CTRL> __device__ __forceinline__ float dppf(float v) { return __builtin_bit_cast(float, __builtin_amdgcn_update_dpp(0, __builtin_bit_cast(int, v), CTRL, 0xf, 0xf, true)); }
__device__ __forceinline__ float row_sum16(float v) { v += dppf<0xB1>(v); v += dppf<0x4E>(v); v += dppf<0x124>(v); v += dppf<0x128>(v); return v; }
__device__ __forceinline__ float row_max16(float v) { v = fmaxf(v, dppf<0xB1>(v)); v = fmaxf(v, dppf<0x4E>(v)); v = fmaxf(v, dppf<0x124>(v)); v = fmaxf(v, dppf<0x128>(v)); return v; }
__device__ __forceinline__ float xsum16(float v) { const auto r = __builtin_amdgcn_permlane16_swap(__float_as_uint(v), __float_as_uint(v), false, false); return __uint_as_float(r[0]) + __uint_as_float(r[1]); }
__device__ __forceinline__ float xsum32(float v) { const auto r = __builtin_amdgcn_permlane32_swap(__float_as_uint(v), __float_as_uint(v), false, false); return __uint_as_float(r[0]) + __uint_as_float(r[1]); }
__device__ __forceinline__ float wave_sum(float v) { return xsum32(xsum16(row_sum16(v))); }
__device__ __forceinline__ float sumsq4(f32x4 v) { return (v[0] * v[0] + v[1] * v[1]) + (v[2] * v[2] + v[3] * v[3]); }
__device__ __forceinline__ u32x2 pack8_u8(f32x4 a, f32x4 b) { unsigned w0 = 0, w1 = 0; a = a * 255.f; b = b * 255.f;
    w0 = __builtin_amdgcn_cvt_pk_u8_f32(a[0], 0, w0); w0 = __builtin_amdgcn_cvt_pk_u8_f32(a[1], 1, w0); w0 = __builtin_amdgcn_cvt_pk_u8_f32(a[2], 2, w0); w0 = __builtin_amdgcn_cvt_pk_u8_f32(a[3], 3, w0);
    w1 = __builtin_amdgcn_cvt_pk_u8_f32(b[0], 0, w1); w1 = __builtin_amdgcn_cvt_pk_u8_f32(b[1], 1, w1); w1 = __builtin_amdgcn_cvt_pk_u8_f32(b[2], 2, w1); w1 = __builtin_amdgcn_cvt_pk_u8_f32(b[3], 3, w1);
    return (u32x2){w0, w1}; }
__device__ __forceinline__ void unpack8_u8(u32x2 w, f32x4& a, f32x4& b) { constexpr float k = 1.f / 255.f;
    a = (f32x4){(float)(w.x & 255u), (float)((w.x >> 8) & 255u), (float)((w.x >> 16) & 255u), (float)(w.x >> 24)} * k;
    b = (f32x4){(float)(w.y & 255u), (float)((w.y >> 8) & 255u), (float)((w.y >> 16) & 255u), (float)(w.y >> 24)} * k; }
__device__ __forceinline__ u32x4 pack8(f32x4 a, f32x4 b) { u32x4 w; w.x = cvt_pk_bf16(a[0], a[1]); w.y = cvt_pk_bf16(a[2], a[3]); w.z = cvt_pk_bf16(b[0], b[1]); w.w = cvt_pk_bf16(b[2], b[3]); return w; }
__device__ __forceinline__ void unpack8(u32x4 w, f32x4& a, f32x4& b) { a = (f32x4){bflo(w.x), bfhi(w.x), bflo(w.y), bfhi(w.y)}; b = (f32x4){bflo(w.z), bfhi(w.z), bflo(w.w), bfhi(w.w)}; }

namespace pg8 {
constexpr int BM = 256, BK = 64, HALF = 128, HTB = HALF * BK * 2, STAGE_BYTES = 8 * HTB, NXCD = 8, WGM = 8;
__host__ __device__ __forceinline__ int lds_byte(int r, int c) { const int st = (r >> 4) * 2 + (c >> 5), rr = r & 15, cc = c & 31, ob = rr * 64 + cc * 2; return st * 1024 + (ob ^ (((ob >> 9) & 1) << 5)); }
__host__ __device__ __forceinline__ void stage_rc(int b, int& R, int& C) { const int st = b / 1024, sb = b % 1024, swz = sb ^ (((sb >> 9) & 1) << 5); R = (st >> 1) * 16 + swz / 64; C = (st & 1) * 32 + (swz % 64) / 2; }
__host__ __device__ __forceinline__ int perm32(int rho) { const int n = rho >> 4, i = rho & 15; return 8 * (i >> 2) + 4 * n + (i & 3); }

struct Unit { const char* A; const char* B; int pm, pn, aux, nt; };
typedef f32x4 Acc[2][2][4][2];

__device__ __forceinline__ void tile_of(int L, int nM, int nN, int& pm, int& pn) {
    const int nwg = nM * nN; int wgid = L;
    { const int q = nwg / NXCD, r = nwg % NXCD, xcd = wgid % NXCD, off = wgid / NXCD; wgid = (xcd < r ? xcd * (q + 1) : r * (q + 1) + (xcd - r) * q) + off; }
    const int nig = WGM * nN, gid = wgid / nig, fm = gid * WGM, gsz = (nM - fm) < WGM ? (nM - fm) : WGM;
    pm = fm + ((wgid % nig) % gsz); pn = (wgid % nig) / gsz;
}
struct TileOrder {
    enum { VARK = 0, GATHER = 0 };
    int nM, nN, G, c; const char* A; const char* B; size_t astep, bstep;
    int rev = 0;
    __device__ __forceinline__ bool next(int i, Unit& u) const {
        if (rev) { const int cnt = (nM * nN - c + G - 1) / G; if (i >= cnt) return false; i = cnt - 1 - i; }
        const long L = (long)i * G + c; if (L >= (long)nM * nN) return false;
        int pm, pn; tile_of((int)L, nM, nN, pm, pn);
        u.pm = pm; u.pn = pn; u.aux = 0; u.A = A + (size_t)pm * astep; u.B = B + (size_t)pn * bstep; return true;
    }
};

template <class Epi, class Sched>
__device__ __forceinline__ void gemm_phase(LAS unsigned char* lds, const int lda, const int ldb, const int K, const Sched& S, const Epi& E) {
    int tid_ = threadIdx.x; asm volatile("" : "+v"(tid_));
    const int tid = tid_, wid = __builtin_amdgcn_readfirstlane(tid >> 6), lane = tid & 63, wr = wid >> 2, wc = wid & 3, fr = lane & 15, fq = lane >> 4;
    int nt = K / BK;
    unsigned voffA[2], voffB[2];
#pragma unroll
    for (int i = 0; i < 2; ++i) { int R, C; stage_rc(tid * 16 + i * 8192, R, C); const int Rb = (R & ~31) + perm32(R & 31);
        voffA[i] = (unsigned)(R * (lda ? lda : BK) + C) * 2u; voffB[i] = (unsigned)(Rb * BK + C) * 2u; }
    const size_t kstep = lda ? (size_t)(BK * 2) : (size_t)BM * BK * 2;
    const size_t hstepA = (size_t)HALF * (lda ? lda : BK) * 2, hstepB = (size_t)HALF * BK * 2, kstepB = (size_t)BM * BK * 2; (void)ldb;
    const unsigned ldsw = (unsigned)wid * 1024u;
    const int aoff = lds_byte(wr * 64 + fr, fq * 8), boff = lds_byte(wc * 32 + fr, fq * 8);
#define PG8_SA(b, h) (((b) * 2 + (h)) * HTB)
#define PG8_SB(b, h) ((4 + (b) * 2 + (h)) * HTB)
#define PG8_STAGE(bufoff, gbase, voff) do { _Pragma("unroll") for (int _i = 0; _i < 2; ++_i) \
        __builtin_amdgcn_global_load_lds((const unsigned*)((const char*)(gbase) + (voff)[_i]), (LAS unsigned*)(lds + (bufoff) + ldsw + _i * 8192), 16, 0, 0); } while (0)
#define PG8_STA(b, h, kptr, VG) do { if constexpr (Sched::GATHER) PG8_STAGE(PG8_SA(b, h), (kptr), VG[h]); else PG8_STAGE(PG8_SA(b, h), (kptr) + (h) * hstepA, voffA); } while (0)
#define PG8_GLOOKUP(VG, ui_) do { _Pragma("unroll") for (int _h = 0; _h < 2; ++_h) _Pragma("unroll") for (int _i = 0; _i < 2; ++_i) { int R_, C_; stage_rc(tid * 16 + _i * 8192, R_, C_); \
        VG[_h][_i] = (unsigned)S.tokL[(ui_) * 256 + _h * 128 + R_] * (unsigned)(lda * 2) + (unsigned)(C_ * 2); } } while (0)
#define PG8_LDA(dst, b, h) do { _Pragma("unroll") for (int m = 0; m < 4; ++m) _Pragma("unroll") for (int k = 0; k < 2; ++k) dst[m][k] = *(const LAS bf16x8*)(lds + PG8_SA(b, h) + aoff + m * 2048 + k * 1024); } while (0)
#define PG8_LDB(dst, b, h) do { _Pragma("unroll") for (int n = 0; n < 2; ++n) _Pragma("unroll") for (int k = 0; k < 2; ++k) dst[n][k] = *(const LAS bf16x8*)(lds + PG8_SB(b, h) + boff + n * 2048 + k * 1024); } while (0)
#define PG8_MMA(ai, bj, At, Bt) do { __builtin_amdgcn_s_setprio(1); _Pragma("unroll") for (int m = 0; m < 4; ++m) _Pragma("unroll") for (int n = 0; n < 2; ++n) _Pragma("unroll") for (int k = 0; k < 2; ++k) \
        acc[ai][bj][m][n] = __builtin_amdgcn_mfma_f32_16x16x32_bf16(Bt[n][k], At[m][k], acc[ai][bj][m][n], 0, 0, 0); __builtin_amdgcn_s_setprio(0); } while (0)
#define PG8_WAIT_V(n) asm volatile("s_waitcnt vmcnt(" #n ")" ::: "memory")
#define PG8_WAIT_L(n) asm volatile("s_waitcnt lgkmcnt(" #n ")" ::: "memory")
#define PG8_BAR __builtin_amdgcn_s_barrier()
#define PG8_SCHED __builtin_amdgcn_sched_barrier(0)
    Unit cur, nxt; int ui = 0;
    if (!S.next(0, cur)) return;
    if constexpr (Sched::VARK) nt = cur.nt;
    typename Epi::Pre pre = E.prefetch(cur, wr, fr);
    Acc acc;
#pragma unroll
    for (int a = 0; a < 2; ++a)
#pragma unroll
        for (int b = 0; b < 2; ++b)
#pragma unroll
            for (int m = 0; m < 4; ++m)
#pragma unroll
                for (int n = 0; n < 2; ++n) acc[a][b][m][n] = (f32x4){0.f, 0.f, 0.f, 0.f};
    bf16x8 At[4][2], B0[2][2], B1[2][2];
    const char* cA = cur.A; const char* cB = cur.B;
    unsigned vg[2][2] = {{0u, 0u}, {0u, 0u}}; if constexpr (Sched::GATHER) PG8_GLOOKUP(vg, 0);
    PG8_STAGE(PG8_SB(0, 0), cB, voffB); PG8_STAGE(PG8_SB(0, 1), cB + hstepB, voffB); PG8_STA(0, 0, cA, vg); PG8_STA(0, 1, cA, vg);
    if (wr == 1) PG8_BAR;
    PG8_WAIT_V(2); PG8_BAR;
    PG8_STAGE(PG8_SB(1, 0), cB + kstepB, voffB); PG8_STA(1, 0, cA + kstep, vg); PG8_STAGE(PG8_SB(1, 1), cB + hstepB + kstepB, voffB);
    PG8_WAIT_V(6); PG8_BAR;
    for (;;) {
        const bool has_next = S.next(ui + 1, nxt);
        const char* nA = has_next ? nxt.A : cA; const char* nB = has_next ? nxt.B : cB;
        for (int t = 0; t < nt; t += 2) {
            const bool last = (t == nt - 2);
            const char* a1 = cA + (size_t)(t + 1) * kstep;
            const char* a2 = last ? nA : cA + (size_t)(t + 2) * kstep; const char* b2 = last ? nB : cB + (size_t)(t + 2) * kstepB;
            const char* a3 = a2 + kstep; const char* b3 = b2 + kstepB;
            PG8_LDB(B0, 0, 0); PG8_LDB(B1, 0, 1); PG8_SCHED; PG8_LDA(At, 0, 0); PG8_STA(1, 1, a1, vg);
            if constexpr (Sched::GATHER) { if (last && has_next) PG8_GLOOKUP(vg, ui + 1); }
            PG8_WAIT_V(8); PG8_WAIT_L(0); PG8_BAR; PG8_MMA(0, 0, At, B0); PG8_MMA(0, 1, At, B1); PG8_BAR; PG8_SCHED;
            PG8_LDA(At, 0, 1); PG8_STAGE(PG8_SB(0, 0), b2, voffB); PG8_STAGE(PG8_SB(0, 1), b2 + hstepB, voffB); PG8_STA(0, 0, a2, vg);
            PG8_WAIT_V(8); PG8_WAIT_L(0); PG8_BAR; PG8_MMA(1, 0, At, B0); PG8_MMA(1, 1, At, B1); PG8_BAR; PG8_SCHED;
            PG8_LDB(B0, 1, 0); PG8_LDB(B1, 1, 1); PG8_SCHED; PG8_LDA(At, 1, 0); PG8_STA(0, 1, a2, vg);
            PG8_WAIT_V(8); PG8_WAIT_L(0); PG8_BAR; PG8_MMA(0, 0, At, B0); PG8_MMA(0, 1, At, B1); PG8_BAR; PG8_SCHED;
            PG8_LDA(At, 1, 1); PG8_STAGE(PG8_SB(1, 0), b3, voffB); PG8_STAGE(PG8_SB(1, 1), b3 + hstepB, voffB); PG8_STA(1, 0, a3, vg);
            PG8_WAIT_V(8); PG8_WAIT_L(0); PG8_BAR; PG8_MMA(1, 0, At, B0); PG8_MMA(1, 1, At, B1); PG8_BAR; PG8_SCHED;
        }
        if (wr == 0) PG8_BAR;
        E(acc, cur, wr, wc, fr, fq, pre);
        if (!has_next) break;
        pre = E.prefetch(nxt, wr, fr);
        if constexpr (!Epi::KEEP_ACC)
#pragma unroll
        for (int a = 0; a < 2; ++a)
#pragma unroll
            for (int b = 0; b < 2; ++b)
#pragma unroll
                for (int m = 0; m < 4; ++m)
#pragma unroll
                    for (int n = 0; n < 2; ++n) acc[a][b][m][n] = (f32x4){0.f, 0.f, 0.f, 0.f};
        cur = nxt; cA = nA; cB = nB; ++ui;
        if constexpr (Sched::VARK) nt = cur.nt;
        if (wr == 1) PG8_BAR;
    }
    PG8_WAIT_V(0);
    PG8_BAR;
#undef PG8_SA
#undef PG8_SB
#undef PG8_STAGE
#undef PG8_LDA
#undef PG8_STA
#undef PG8_GLOOKUP
#undef PG8_LDB
#undef PG8_MMA
#undef PG8_WAIT_V
#undef PG8_WAIT_L
#undef PG8_BAR
#undef PG8_SCHED
}

#define EPI_FOR _Pragma("unroll") for (int ai = 0; ai < 2; ++ai) _Pragma("unroll") for (int m = 0; m < 4; ++m)
#define EPI_ROW (u.pm * BM + ai * HALF + wr * 64 + m * 16 + fr)
#define EPI_C8(bj) (u.pn * BM + (bj) * HALF + wc * 32 + 8 * fq)
#define EPI_LOAD_R(rr, ptr) float rr[2][4]; _Pragma("unroll") for (int ai = 0; ai < 2; ++ai) _Pragma("unroll") for (int m = 0; m < 4; ++m) rr[ai][m] = (ptr)[EPI_ROW]; asm volatile("" ::: "memory")

#define EPI_LOAD_RS(rr, xstat) float rr[2][4]; { f32x4 st_[2][4]; _Pragma("unroll") for (int ai = 0; ai < 2; ++ai) _Pragma("unroll") for (int m = 0; m < 4; ++m) st_[ai][m] = *(const f32x4*)((xstat) + (size_t)EPI_ROW * 16 + 4 * fq); \
    asm volatile("" ::: "memory"); _Pragma("unroll") for (int ai = 0; ai < 2; ++ai) _Pragma("unroll") for (int m = 0; m < 4; ++m) { float t_ = (st_[ai][m][0] + st_[ai][m][1]) + (st_[ai][m][2] + st_[ai][m][3]); \
        t_ = xsum32(xsum16(t_)); rr[ai][m] = __builtin_amdgcn_rsqf(t_ * (1.f / D) + EPS); } }
struct NoPre {};
#define EPI_NOPRE static constexpr bool KEEP_ACC = false; typedef NoPre Pre; __device__ __forceinline__ Pre prefetch(const Unit&, int, int) const { return Pre{}; }
struct RowPre { float r[2][4]; };
struct EpiInProj {
    unsigned char* ws; const float* bgate; int layer; int from_stats;
    static constexpr bool KEEP_ACC = false; typedef RowPre Pre;
    __device__ __forceinline__ Pre prefetch(const Unit& u, int wr, int fr) const { Pre p; const float* rx = (const float*)(ws + WS_RX);
#pragma unroll
        for (int ai = 0; ai < 2; ++ai)
#pragma unroll
            for (int m = 0; m < 4; ++m) p.r[ai][m] = from_stats ? 0.f : rx[EPI_ROW];
        return p; }
    __device__ __forceinline__ void operator()(const Acc& acc, const Unit& u, int wr, int wc, int fr, int fq, const Pre& pre) const {
        const float* rx = (const float*)(ws + WS_RX); const float* rope = (const float*)(ws + WS_ROPE);
        bf16* CQ = (bf16*)(ws + WS_CQ); bf16* KR = (bf16*)(ws + WS_KR); bf16* CKV = (bf16*)(ws + WS_CKV); bf16* U = (bf16*)(ws + WS_U); bf16* VR = (bf16*)(ws + WS_VR); bf16* QX = (bf16*)(ws + WS_QX); bf16* GATE = (bf16*)(ws + WS_GATE);
        float* cqstat = (float*)(ws + WS_CQSTAT); float* ckvstat = (float*)(ws + WS_CKVSTAT); float* vstat = (float*)(ws + WS_VSTAT); unsigned* kmax = (unsigned*)(ws + WS_CTL) + CW_KMAX + layer * 32;
        const int pn = u.pn;
        float rr[2][4];
        if (from_stats) { EPI_LOAD_RS(rs_, (const float*)(ws + WS_XSTAT));
#pragma unroll
            for (int ai = 0; ai < 2; ++ai)
#pragma unroll
                for (int m = 0; m < 4; ++m) rr[ai][m] = rs_[ai][m]; }
        else {
#pragma unroll
            for (int ai = 0; ai < 2; ++ai)
#pragma unroll
                for (int m = 0; m < 4; ++m) rr[ai][m] = pre.r[ai][m]; }
        if (pn < 2) {
            float krmax = 0.f;
            EPI_FOR { const int row = EPI_ROW;
                const float r = rr[ai][m]; float ss = 0.f;
#pragma unroll
                for (int bj = 0; bj < 2; ++bj) { const f32x4 v0 = acc[ai][bj][m][0] * r, v1 = acc[ai][bj][m][1] * r;
                    if (!(pn == 1 && bj == 1)) ss += sumsq4(v0) + sumsq4(v1);
                    *(u32x4*)(CQ + (size_t)row * 512 + pn * 256 + bj * HALF + wc * 32 + 8 * fq) = pack8(v0, v1);
                    if (pn == 1 && bj == 1 && wc == 0) {
                        const f32x4 c = *(const f32x4*)(rope + (size_t)row * 32 + 4 * fq), s = *(const f32x4*)(rope + (size_t)row * 32 + 16 + 4 * fq);
                        const f32x4 o0 = v0 * c - v1 * s, o1 = v0 * s + v1 * c;
                        *(u32x4*)(KR + (size_t)row * 32 + 8 * fq) = pack8(o0, o1);
                        float q2 = sumsq4(o0) + sumsq4(o1); q2 = xsum32(xsum16(q2)); krmax = fmaxf(krmax, q2); } }
                ss = xsum32(xsum16(ss));
                if (fq == 0) cqstat[(size_t)row * 8 + pn * 4 + wc] = ss;
            }
            if (pn == 1 && wc == 0) {
                krmax = row_max16(krmax);
                if ((fr | fq) == 0) atomicMax(kmax + 16, __float_as_uint(krmax)); }
        } else if (pn == 2) {
            EPI_FOR { const int row = EPI_ROW;
                const float r = rr[ai][m]; float ss = 0.f;
#pragma unroll
                for (int bj = 0; bj < 2; ++bj) { const f32x4 v0 = acc[ai][bj][m][0] * r, v1 = acc[ai][bj][m][1] * r; ss += sumsq4(v0) + sumsq4(v1);
                    *(u32x4*)(CKV + (size_t)row * 256 + bj * HALF + wc * 32 + 8 * fq) = pack8(v0, v1); }
                ss = xsum32(xsum16(ss));
                if (fq == 0) ckvstat[(size_t)row * 4 + wc] = ss;
            }
        } else if (pn < 7) {
            const bool isv = pn >= 5; bf16* dst = isv ? VR : U; const int t = isv ? pn - 5 : pn - 3;
            EPI_FOR { const int row = EPI_ROW;
                const float r = rr[ai][m]; float ss = 0.f;
#pragma unroll
                for (int bj = 0; bj < 2; ++bj) { f32x4 v0 = acc[ai][bj][m][0] * r, v1 = acc[ai][bj][m][1] * r;
#pragma unroll
                    for (int e = 0; e < 4; ++e) { v0[e] = gelu_tanh(v0[e]); v1[e] = gelu_tanh(v1[e]); }
                    ss += sumsq4(v0) + sumsq4(v1);
                    *(u32x4*)(dst + (size_t)row * 512 + t * 256 + bj * HALF + wc * 32 + 8 * fq) = pack8(v0, v1); }
                if (isv) { ss = xsum32(xsum16(ss)); if (fq == 0) vstat[(size_t)row * 8 + t * 4 + wc] = ss; }
            }
        } else if (pn < 9) {
            EPI_FOR { const int row = EPI_ROW;
                const float r = rr[ai][m];
#pragma unroll
                for (int bj = 0; bj < 2; ++bj) *(u32x4*)(QX + (size_t)row * 512 + (pn - 7) * 256 + bj * HALF + wc * 32 + 8 * fq) = pack8(acc[ai][bj][m][0] * r, acc[ai][bj][m][1] * r);
            }
        } else {
            const int gc0 = (pn - 9) * 256 + wc * 32 + 8 * fq;
            f32x4 bg[2][2];
#pragma unroll
            for (int bj = 0; bj < 2; ++bj) { bg[bj][0] = *(const f32x4*)(bgate + gc0 + bj * HALF); bg[bj][1] = *(const f32x4*)(bgate + gc0 + bj * HALF + 4); }
            EPI_FOR { const int row = EPI_ROW;
                const float r = rr[ai][m];
#pragma unroll
                for (int bj = 0; bj < 2; ++bj) { f32x4 v0 = acc[ai][bj][m][0] * r + bg[bj][0], v1 = acc[ai][bj][m][1] * r + bg[bj][1];
#pragma unroll
                    for (int e = 0; e < 4; ++e) { v0[e] = sigmoidf_(v0[e]); v1[e] = sigmoidf_(v1[e]); }
#ifdef DBG_CONSTGATE
                    v0 = acc[ai][bj][m][0] * r; v1 = acc[ai][bj][m][1] * r;
#endif
                    *(u32x2*)((unsigned char*)GATE + (size_t)row * 3072 + gc0 + bj * HALF) = pack8_u8(v0, v1); }
            }
        }
    }
};
struct EpiMemKV {
    bf16* KV;
    EPI_NOPRE
    __device__ __forceinline__ void operator()(const Acc& acc, const Unit& u, int wr, int wc, int fr, int fq, const Pre&) const {
        EPI_FOR { const int row = EPI_ROW;
#pragma unroll
            for (int bj = 0; bj < 2; ++bj) *(u32x4*)(KV + (size_t)u.aux * 256 * 1024 + (size_t)row * 1024 + EPI_C8(bj)) = pack8(acc[ai][bj][m][0], acc[ai][bj][m][1]);
        }
    }
};
struct EpiQ {
    const float* cqstat; const float* rope; bf16* Q;
    EPI_NOPRE
    __device__ __forceinline__ void operator()(const Acc& acc, const Unit& u, int wr, int wc, int fr, int fq, const Pre&) const {
        EPI_FOR { const int row = EPI_ROW;
            const f32x4 s0 = *(const f32x4*)(cqstat + (size_t)row * 8), s1 = *(const f32x4*)(cqstat + (size_t)row * 8 + 4);
            const float r = __builtin_amdgcn_rsqf(((s0[0] + s0[1]) + (s0[2] + s0[3]) + (s1[0] + s1[1]) + (s1[2] + s1[3])) * (1.f / QRANK) + EPS);
#pragma unroll
            for (int bj = 0; bj < 2; ++bj) { f32x4 v0 = acc[ai][bj][m][0] * r, v1 = acc[ai][bj][m][1] * r;
                if (((8 * u.pn + 4 * bj + wc) % 3) == 2) {
                    const f32x4 c = *(const f32x4*)(rope + (size_t)row * 32 + 4 * fq), s = *(const f32x4*)(rope + (size_t)row * 32 + 16 + 4 * fq);
                    const f32x4 o0 = v0 * c - v1 * s, o1 = v0 * s + v1 * c; v0 = o0; v1 = o1; }
                *(u32x4*)(Q + (size_t)row * 768 + EPI_C8(bj)) = pack8(v0, v1); }
        }
    }
};
struct EpiKV {
    const float* ckvstat; bf16* KN; bf16* V; unsigned* kmax;
    EPI_NOPRE
    __device__ __forceinline__ void operator()(const Acc& acc, const Unit& u, int wr, int wc, int fr, int fq, const Pre&) const {
        bf16* dst = u.pn < 2 ? KN : V; const int t = u.pn & 1; float hm[2] = {0.f, 0.f};
        EPI_FOR { const int row = EPI_ROW;
            const f32x4 s0 = *(const f32x4*)(ckvstat + (size_t)row * 4);
            const float r = __builtin_amdgcn_rsqf(((s0[0] + s0[1]) + (s0[2] + s0[3])) * (1.f / KVRANK) + EPS);
#pragma unroll
            for (int bj = 0; bj < 2; ++bj) { const f32x4 v0 = acc[ai][bj][m][0] * r, v1 = acc[ai][bj][m][1] * r;
                *(u32x4*)(dst + (size_t)row * 512 + t * 256 + bj * HALF + wc * 32 + 8 * fq) = pack8(v0, v1);
                float q2 = sumsq4(v0) + sumsq4(v1); q2 = xsum32(xsum16(q2)); hm[bj] = fmaxf(hm[bj], q2); }
        }
        if (u.pn < 2) {
#pragma unroll
            for (int bj = 0; bj < 2; ++bj) { float v = hm[bj];
                v = row_max16(v);
                if ((fr | fq) == 0) atomicMax(kmax + 2 * (4 * u.pn + 2 * bj + (wc >> 1)) + (wc & 1), __float_as_uint(v)); }
        }
    }
};
struct EpiBranch {
    const unsigned char* GATE; bf16* MIXB;
    static constexpr bool KEEP_ACC = true; typedef NoPre Pre; __device__ __forceinline__ Pre prefetch(const Unit&, int, int) const { return Pre{}; }
    __device__ __forceinline__ void operator()(Acc& acc, const Unit& u, int wr, int wc, int fr, int fq, const Pre&) const {
        const int n = u.aux;
#pragma unroll
        for (int ai = 0; ai < 2; ++ai) {
            u32x2 gw[4][2], gn[4][2];
#pragma unroll
            for (int m = 0; m < 4; ++m)
#pragma unroll
                for (int bj = 0; bj < 2; ++bj) { const unsigned char* gp = GATE + (size_t)EPI_ROW * 3072 + n * 1024 + EPI_C8(bj);
                    gw[m][bj] = *(const u32x2*)gp; if (n < 2) gn[m][bj] = *(const u32x2*)(gp + 1024); }
            asm volatile("" ::: "memory");
#pragma unroll
            for (int m = 0; m < 4; ++m)
#pragma unroll
                for (int bj = 0; bj < 2; ++bj) {
                    f32x4 g0, g1; unpack8_u8(gw[m][bj], g0, g1);
#pragma unroll
                    for (int e = 0; e < 4; ++e) { g0[e] = fmaxf(g0[e], 0.001953125f); g1[e] = fmaxf(g1[e], 0.001953125f); }
                    if (n < 2) { f32x4 h0, h1; unpack8_u8(gn[m][bj], h0, h1);
#pragma unroll
                        for (int e = 0; e < 4; ++e) { g0[e] *= fast_rcp(fmaxf(h0[e], 0.001953125f)); g1[e] *= fast_rcp(fmaxf(h1[e], 0.001953125f)); }
                        acc[ai][bj][m][0] *= g0; acc[ai][bj][m][1] *= g1; }
                    else *(u32x4*)(MIXB + (size_t)u.pm * 256 * 1024 + (size_t)(4 * u.pn + 2 * bj + (wc >> 1)) * 16384 + (ai * HALF + wr * 64 + m * 16 + fr) * 64 + (wc & 1) * 32 + 8 * fq) = pack8(acc[ai][bj][m][0] * g0, acc[ai][bj][m][1] * g1);
                }
        }
        if (n == 2) {
#pragma unroll
            for (int ai = 0; ai < 2; ++ai)
#pragma unroll
                for (int bj = 0; bj < 2; ++bj)
#pragma unroll
                    for (int m = 0; m < 4; ++m) { acc[ai][bj][m][0] = (f32x4){0.f, 0.f, 0.f, 0.f}; acc[ai][bj][m][1] = (f32x4){0.f, 0.f, 0.f, 0.f}; }
        }
    }
};
struct EpiResid {
    bf16* XB; float* xstat;
    EPI_NOPRE
    __device__ __forceinline__ void operator()(const Acc& acc, const Unit& u, int wr, int wc, int fr, int fq, const Pre&) const {
#pragma unroll
        for (int ai = 0; ai < 2; ++ai) {
            u32x4 xv[4][2];
#pragma unroll
            for (int m = 0; m < 4; ++m)
#pragma unroll
                for (int bj = 0; bj < 2; ++bj) xv[m][bj] = *(const u32x4*)(XB + (size_t)EPI_ROW * 1024 + EPI_C8(bj));
            asm volatile("" ::: "memory");
#pragma unroll
            for (int m = 0; m < 4; ++m) { const int row = EPI_ROW; float ss = 0.f;
#pragma unroll
                for (int bj = 0; bj < 2; ++bj) { const int col = EPI_C8(bj); f32x4 x0, x1; unpack8(xv[m][bj], x0, x1);
                    const f32x4 v0 = x0 + acc[ai][bj][m][0], v1 = x1 + acc[ai][bj][m][1];
                    ss += sumsq4(v0) + sumsq4(v1);
                    *(u32x4*)(XB + (size_t)row * 1024 + col) = pack8(v0, v1); }
                ss = xsum32(xsum16(ss));
                if (fq == 0) xstat[(size_t)row * 16 + u.pn * 4 + wc] = ss; }
        }
    }
};
struct EpiSwiGLU {
    const float* rs; bf16* Hh; int ldh; int from_stats;
    static constexpr bool KEEP_ACC = false; typedef RowPre Pre;
    __device__ __forceinline__ Pre prefetch(const Unit& u, int wr, int fr) const { Pre p;
#pragma unroll
        for (int ai = 0; ai < 2; ++ai)
#pragma unroll
            for (int m = 0; m < 4; ++m) p.r[ai][m] = from_stats ? 0.f : rs[EPI_ROW];
        return p; }
    __device__ __forceinline__ void operator()(const Acc& acc, const Unit& u, int wr, int wc, int fr, int fq, const Pre& pre) const {
        float rr[2][4];
        if (from_stats) { EPI_LOAD_RS(rs_, rs);
#pragma unroll
            for (int ai = 0; ai < 2; ++ai)
#pragma unroll
                for (int m = 0; m < 4; ++m) rr[ai][m] = rs_[ai][m]; }
        else {
#pragma unroll
            for (int ai = 0; ai < 2; ++ai)
#pragma unroll
                for (int m = 0; m < 4; ++m) rr[ai][m] = pre.r[ai][m]; }
        bf16* hbase = Hh + (size_t)u.pm * 256 * ldh + (size_t)(2 * u.pn + (wc >> 1)) * 16384 + (wr * 64 + fr) * 64 + (wc & 1) * 32 + 8 * fq;
        EPI_FOR { const int row = EPI_ROW;
            const float r = rr[ai][m];
            f32x4 a0 = acc[ai][0][m][0] * r, a1 = acc[ai][0][m][1] * r; const f32x4 b0 = acc[ai][1][m][0] * r, b1 = acc[ai][1][m][1] * r;
#pragma unroll
            for (int e = 0; e < 4; ++e) { a0[e] = a0[e] * sigmoidf_(a0[e]) * b0[e]; a1[e] = a1[e] * sigmoidf_(a1[e]) * b1[e]; }
            (void)row; *(u32x4*)(hbase + (ai * HALF + m * 16) * 64) = pack8(a0, a1);
        }
    }
};
struct EpiBf16 {
    bf16* C; int ldc;
    EPI_NOPRE
    __device__ __forceinline__ void operator()(const Acc& acc, const Unit& u, int wr, int wc, int fr, int fq, const Pre&) const {
        EPI_FOR { const int row = EPI_ROW;
#pragma unroll
            for (int bj = 0; bj < 2; ++bj) *(u32x4*)(C + (size_t)row * ldc + EPI_C8(bj)) = pack8(acc[ai][bj][m][0], acc[ai][bj][m][1]);
        }
    }
};
__device__ __forceinline__ void ks_reduce(const float* part, int x, int r, int k, int CC, int tid, bf16* C, int ldc, const Unit& u, int wr, int wc, int fr, int fq) {
    for (int sp = k; sp < 16; sp += CC) { const int ai = sp >> 3, bj = (sp >> 2) & 1, m = sp & 3;
        f32x4 s0 = {0.f, 0.f, 0.f, 0.f}, s1 = {0.f, 0.f, 0.f, 0.f};
        for (int kk0 = 0; kk0 < CC; kk0 += 4) {
            f32x4 v0[4], v1[4];
#pragma unroll
            for (int kk = 0; kk < 4; ++kk) { const bool ok = kk0 + kk < CC; const float* q = part + (size_t)(x + 8 * (r * CC + (ok ? kk0 + kk : 0))) * 65536 + tid * 4 + sp * 4096;
                v0[kk] = *(const f32x4*)q; v1[kk] = *(const f32x4*)(q + 2048); if (!ok) { v0[kk] = (f32x4){0.f, 0.f, 0.f, 0.f}; v1[kk] = (f32x4){0.f, 0.f, 0.f, 0.f}; } }
#pragma unroll
            for (int kk = 0; kk < 4; ++kk) { s0 += v0[kk]; s1 += v1[kk]; } }
        const int row = u.pm * BM + ai * HALF + wr * 64 + m * 16 + fr;
        *(u32x4*)(C + (size_t)row * ldc + u.pn * BM + bj * HALF + wc * 32 + 8 * fq) = pack8(s0, s1); }
}
struct EpiBf16KS {
    bf16* C; int ldc; float* part; unsigned* cnt; int c;
    EPI_NOPRE
    __device__ __forceinline__ void operator()(const Acc& acc, const Unit& u, int wr, int wc, int fr, int fq, const Pre&) const {
        if (((u.aux >> 4) & 3) != 0) {
            int tid_ = threadIdx.x; asm volatile("" : "+v"(tid_));
            const int k = (u.aux >> 8) & 255, CC = (u.aux >> 16) & 255, r = u.aux >> 24, x = c & 7;
            float* p = part + (size_t)c * 65536 + tid_ * 4;
#pragma unroll
            for (int ai = 0; ai < 2; ++ai)
#pragma unroll
                for (int bj = 0; bj < 2; ++bj)
#pragma unroll
                    for (int m = 0; m < 4; ++m)
#pragma unroll
                        for (int n = 0; n < 2; ++n) *(f32x4*)(p + (((ai * 2 + bj) * 4 + m) * 2 + n) * 2048) = acc[ai][bj][m][n];
            asm volatile("s_waitcnt vmcnt(0)" ::: "memory");
            __syncthreads();
            if (tid_ == 0) { unsigned* w = cnt + x + 8 * r; __hip_atomic_fetch_add(w, 1u, __ATOMIC_RELEASE, __HIP_MEMORY_SCOPE_AGENT);
                while (__hip_atomic_load(w, __ATOMIC_ACQUIRE, __HIP_MEMORY_SCOPE_AGENT) < (unsigned)CC) __builtin_amdgcn_s_sleep(2); }
            __syncthreads();
            ks_reduce(part, x, r, k, CC, tid_, C, ldc, u, wr, wc, fr, fq);
            return;
        }
        EPI_FOR { const int row = EPI_ROW;
#pragma unroll
            for (int bj = 0; bj < 2; ++bj) *(u32x4*)(C + (size_t)row * ldc + EPI_C8(bj)) = pack8(acc[ai][bj][m][0], acc[ai][bj][m][1]);
        }
    }
};
struct EpiF32 {
    float* C; int ldc;
    EPI_NOPRE
    __device__ __forceinline__ void operator()(const Acc& acc, const Unit& u, int wr, int wc, int fr, int fq, const Pre&) const {
        EPI_FOR { const int row = EPI_ROW;
#pragma unroll
            for (int bj = 0; bj < 2; ++bj) { float* cp = C + (size_t)row * ldc + EPI_C8(bj); *(f32x4*)cp = acc[ai][bj][m][0]; *(f32x4*)(cp + 4) = acc[ai][bj][m][1]; }
        }
    }
};
}

namespace att {
#define KSWZ(row, colB) ((row) * 256 + ((colB) ^ (((row) & 7) << 4)))
#define SBAR() __builtin_amdgcn_sched_barrier(0)
constexpr float THR = 8.f;
__device__ __forceinline__ int crow(int r, int hi) { return (r & 3) + 8 * (r >> 2) + 4 * hi; }
template <int NB> __device__ __forceinline__ int v_st(int k, int c) { const int kk = (k & ~0xC) | ((k & 4) << 1) | ((k & 8) >> 1); return ((kk >> 3) * NB + (c >> 5)) * 512 + ((kk & 7) * 32 + (c & 31)) * 2; }
__device__ __forceinline__ int v_rd_base(int lane) { return ((lane & 3) << 3) | (((lane >> 2) & 3) << 6) | (((lane >> 4) & 1) << 5) | (((lane >> 5) & 1) << 8); }
template <int OFF> __device__ __forceinline__ s16x4 tr_read(int vb) { s16x4 r; asm volatile("ds_read_b64_tr_b16 %0, %1 offset:%2" : "=&v"(r) : "v"(vb), "i"(OFF) : "memory"); return r; }

__device__ __forceinline__ void partialSM(f32x16& p0, f32x16& p1, float& m_reg, float& alpha) {
    float pmax = p0[0];
#pragma unroll
    for (int r = 1; r < 16; ++r) pmax = fmaxf(pmax, p0[r]);
#pragma unroll
    for (int r = 0; r < 16; ++r) pmax = fmaxf(pmax, p1[r]);
    { auto rr = __builtin_amdgcn_permlane32_swap(__float_as_uint(pmax), __float_as_uint(pmax), false, false); pmax = fmaxf(__uint_as_float(rr[0]), __uint_as_float(rr[1])); }
    float mn;
    if (__builtin_expect(__all(pmax - m_reg <= THR), 1)) { mn = m_reg; alpha = 1.f; }
    else { mn = fmaxf(m_reg, pmax); alpha = __builtin_amdgcn_exp2f(m_reg - mn); m_reg = mn; }
#pragma unroll
    for (int r = 0; r < 16; ++r) { p0[r] -= mn; p1[r] -= mn; }
#pragma unroll
    for (int r = 0; r < 16; ++r) p0[r] = __builtin_amdgcn_exp2f(p0[r]);
}
__device__ __forceinline__ void finishSM(f32x16& p0, f32x16& p1, float alpha, float& l_reg, bf16x8& pa0, bf16x8& pa1, bf16x8& pa2, bf16x8& pa3) {
#pragma unroll
    for (int r = 0; r < 16; ++r) p1[r] = __builtin_amdgcn_exp2f(p1[r]);
    float ps = 0;
#pragma unroll
    for (int r = 0; r < 16; ++r) ps += p0[r];
#pragma unroll
    for (int r = 0; r < 16; ++r) ps += p1[r];
    { auto rr = __builtin_amdgcn_permlane32_swap(__float_as_uint(ps), __float_as_uint(ps), false, false); ps = __uint_as_float(rr[0]) + __uint_as_float(rr[1]); }
    l_reg = l_reg * alpha + ps;
#define PK4(P, BASE, OUT) do { unsigned a0 = cvt_pk_bf16(P[BASE + 0], P[BASE + 1]), a1 = cvt_pk_bf16(P[BASE + 2], P[BASE + 3]);   \
    unsigned b0 = cvt_pk_bf16(P[BASE + 4], P[BASE + 5]), b1 = cvt_pk_bf16(P[BASE + 6], P[BASE + 7]);                              \
    auto r0 = __builtin_amdgcn_permlane32_swap(a0, b0, false, false); auto r1 = __builtin_amdgcn_permlane32_swap(a1, b1, false, false); \
    u32x4 w = {r0[0], r1[0], r0[1], r1[1]}; OUT = __builtin_bit_cast(bf16x8, w); } while (0)
    PK4(p0, 0, pa0); PK4(p0, 8, pa1); PK4(p1, 0, pa2); PK4(p1, 8, pa3);
#undef PK4
}
template <int ND0> __device__ __forceinline__ void qkt(f32x16& p0, f32x16& p1, const LAS char* Ks, const bf16x8* qr, int r32, int hi, const f32x16& init) {
#pragma unroll
    for (int d0 = 0; d0 < ND0; ++d0) { const int cb = (d0 * 16 + hi * 8) * 2;
        const bf16x8 b0 = *(const LAS bf16x8*)(Ks + KSWZ(r32, cb));
        const bf16x8 b1 = *(const LAS bf16x8*)(Ks + KSWZ(32 + r32, cb));
        p0 = __builtin_amdgcn_mfma_f32_32x32x16_bf16(b0, qr[d0], d0 == 0 ? init : p0, 0, 0, 0);
        p1 = __builtin_amdgcn_mfma_f32_32x32x16_bf16(b1, qr[d0], d0 == 0 ? init : p1, 0, 0, 0); }
}
__device__ __forceinline__ void expA(f32x16& p0) {
#pragma unroll
    for (int r = 0; r < 16; ++r) p0[r] = __builtin_amdgcn_exp2f(p0[r]);
}
template <int NB, int D0> __device__ __forceinline__ void pv_one(f32x16& od, int vb, bf16x8 pa0, bf16x8 pa1, bf16x8 pa2, bf16x8 pa3) {
    const s16x4 l0 = tr_read<(0 * NB + D0) * 512>(vb), h0 = tr_read<(1 * NB + D0) * 512>(vb), l1 = tr_read<(2 * NB + D0) * 512>(vb), h1 = tr_read<(3 * NB + D0) * 512>(vb);
    const s16x4 l2 = tr_read<(4 * NB + D0) * 512>(vb), h2 = tr_read<(5 * NB + D0) * 512>(vb), l3 = tr_read<(6 * NB + D0) * 512>(vb), h3 = tr_read<(7 * NB + D0) * 512>(vb);
    asm volatile("s_waitcnt lgkmcnt(0)" ::: "memory"); SBAR();
#define PK(L, H) (bf16x8){L[0], L[1], L[2], L[3], H[0], H[1], H[2], H[3]}
    od = __builtin_amdgcn_mfma_f32_32x32x16_bf16(pa0, PK(l0, h0), od, 0, 0, 0);
    od = __builtin_amdgcn_mfma_f32_32x32x16_bf16(pa1, PK(l1, h1), od, 0, 0, 0);
    od = __builtin_amdgcn_mfma_f32_32x32x16_bf16(pa2, PK(l2, h2), od, 0, 0, 0);
    od = __builtin_amdgcn_mfma_f32_32x32x16_bf16(pa3, PK(l3, h3), od, 0, 0, 0);
#undef PK
}
template <int NB> __device__ __forceinline__ void pv_all(f32x16* o, int vb, bf16x8 pa0, bf16x8 pa1, bf16x8 pa2, bf16x8 pa3) {
    pv_one<NB, 0>(o[0], vb, pa0, pa1, pa2, pa3); pv_one<NB, 1>(o[1], vb, pa0, pa1, pa2, pa3);
    if constexpr (NB == 4) { pv_one<NB, 2>(o[2], vb, pa0, pa1, pa2, pa3); pv_one<NB, 3>(o[3], vb, pa0, pa1, pa2, pa3); }
}

template <int DQK, int D1, int DVV, bool FIXM>
__device__ __forceinline__ void attn_unit(const bf16* __restrict__ Qb, int ldq, const bf16* __restrict__ K1, int ldk1, const bf16* __restrict__ K2, int ldk2,
                                          const bf16* __restrict__ Vh, int ldv, bf16* __restrict__ Ob, int ldo, int seq, LAS char* lds, float kbound) {
    constexpr int ND0 = DQK / 16, NB = DVV / 32, CK = DQK / 8, CV = DVV / 8;
    constexpr int NKL = (64 * CK + 511) / 512, NVL = (64 * CV) / 512;
    constexpr int SHM_V = 64 * DVV * 2, SHM_K = 64 * 256;
    int tid_ = threadIdx.x; asm volatile("" : "+v"(tid_));
    const int tid = tid_, wid = tid >> 6, lane = tid & 63, r32 = lane & 31, hi = lane >> 5;
    LAS char* V_lds = lds; LAS char* K_lds = lds + 2 * SHM_V;
    LAS float* ws = (LAS float*)(lds + 2 * SHM_V + 2 * SHM_K) + wid * 64; LAS float* li_l = ws; LAS float* al_l = ws + 32;
    float m_reg = -1e30f, l_reg = 0; f32x16 o[NB]; bf16x8 qr[ND0];
#pragma unroll
    for (int d = 0; d < NB; ++d) o[d] = f32x16{};
    const bf16* Qw = Qb + (long)(wid * 32 + r32) * ldq + hi * 8;
#pragma unroll
    for (int d0 = 0; d0 < ND0; ++d0) qr[d0] = *(const bf16x8*)(Qw + d0 * 16);
    f32x16 init = f32x16{};
    if constexpr (FIXM) {
        float q2 = 0.f;
#pragma unroll
        for (int d0 = 0; d0 < ND0; ++d0) { const u32x4 w = __builtin_bit_cast(u32x4, qr[d0]); f32x4 a, b; unpack8(w, a, b); q2 += sumsq4(a) + sumsq4(b); }
        { auto rr = __builtin_amdgcn_permlane32_swap(__float_as_uint(q2), __float_as_uint(q2), false, false); q2 = __uint_as_float(rr[0]) + __uint_as_float(rr[1]); }
        const float nm = -sqrtf(q2) * kbound;
#pragma unroll
        for (int r = 0; r < 16; ++r) init[r] = nm;
        asm volatile("" : "+v"(init));
    }
    const bf16* kp[NKL]; int kstr[NKL], kdst[NKL]; bool kval[NKL];
#pragma unroll
    for (int i = 0; i < NKL; ++i) { const int c = tid + 512 * i; kval[i] = c < 64 * CK; const int cc_ = kval[i] ? c : 0; const int row = cc_ / CK, cc = cc_ % CK;
        if (cc * 8 < D1) { kp[i] = K1 + (long)row * ldk1 + cc * 8; kstr[i] = 64 * ldk1; } else { kp[i] = K2 + (long)row * ldk2 + (cc * 8 - D1); kstr[i] = 64 * ldk2; }
        kdst[i] = KSWZ(row, cc * 16); }
    const bf16* vp[NVL]; int vdst[NVL]; const int vstr = 64 * ldv;
#pragma unroll
    for (int i = 0; i < NVL; ++i) { const int c = tid + 512 * i; const int row = c / CV, cc = c % CV; vp[i] = Vh + (long)row * ldv + cc * 8; vdst[i] = v_st<NB>(row, cc * 8); }
    const int vb0 = (int)(uintptr_t)V_lds + v_rd_base(lane);
    struct { bf16x8 ks[NKL]; bf16x8 vs[NVL]; } sr_[2];
#define SLOAD(i, t) do { _Pragma("unroll") for (int q_ = 0; q_ < NVL; ++q_) sr_[i].vs[q_] = *(const bf16x8*)(vp[q_] + (long)(t) * vstr); \
    _Pragma("unroll") for (int q_ = 0; q_ < NKL; ++q_) { if (kval[q_]) sr_[i].ks[q_] = *(const bf16x8*)(kp[q_] + (long)(t) * kstr[q_]); } } while (0)
#define SWRITE(b, i) do { _Pragma("unroll") for (int q_ = 0; q_ < NVL; ++q_) *(LAS bf16x8*)(V_lds + (b) * SHM_V + vdst[q_]) = sr_[i].vs[q_]; \
    _Pragma("unroll") for (int q_ = 0; q_ < NKL; ++q_) { if (kval[q_]) *(LAS bf16x8*)(K_lds + (b) * SHM_K + kdst[q_]) = sr_[i].ks[q_]; } } while (0)
#define SWAIT() asm volatile("s_waitcnt vmcnt(%0)" :: "n"(NKL + NVL) : "memory")
#define RESC(a) do { if (__any((a) < 1.f)) { if (hi == 0) al_l[r32] = (a); asm volatile("s_waitcnt lgkmcnt(0)" ::: "memory"); \
    _Pragma("unroll") for (int d = 0; d < NB; ++d) _Pragma("unroll") for (int r = 0; r < 16; ++r) o[d][r] *= al_l[crow(r, hi)]; } } while (0)
    f32x16 pA0, pA1, pB0, pB1; float alA = 1.f, alB = 1.f; bf16x8 pa0, pa1, pa2, pa3; const int NT = seq / 64;
#define PSM(P0, P1, AL) do { if constexpr (FIXM) expA(P0); else partialSM(P0, P1, m_reg, AL); } while (0)
#define RSC(AL) do { if constexpr (!FIXM) RESC(AL); } while (0)
    SLOAD(0, 0); asm volatile("s_waitcnt vmcnt(0)" ::: "memory"); SWRITE(0, 0); __syncthreads();
    qkt<ND0>(pA0, pA1, K_lds, qr, r32, hi, init); PSM(pA0, pA1, alA);
    SLOAD(1, 1); if (2 < NT) SLOAD(0, 2);
    SWAIT(); SWRITE(1, 1); __syncthreads();
    for (int j = 1; j + 1 < NT; j += 2) {
        SBAR(); qkt<ND0>(pB0, pB1, K_lds + SHM_K, qr, r32, hi, init);
        finishSM(pA0, pA1, alA, l_reg, pa0, pa1, pa2, pa3); SBAR();
        SLOAD(1, j + 2); SBAR();
        pv_all<NB>(o, vb0, pa0, pa1, pa2, pa3); PSM(pB0, pB1, alB);
        __syncthreads(); SWAIT(); SWRITE(0, 0);
        RSC(alB); __syncthreads();
        SBAR(); qkt<ND0>(pA0, pA1, K_lds, qr, r32, hi, init);
        finishSM(pB0, pB1, alB, l_reg, pa0, pa1, pa2, pa3); SBAR();
        if (j + 3 < NT) SLOAD(0, j + 3); SBAR();
        pv_all<NB>(o, vb0 + SHM_V, pa0, pa1, pa2, pa3); PSM(pA0, pA1, alA);
        __syncthreads(); SWAIT(); SWRITE(1, 1);
        RSC(alA); __syncthreads();
    }
    SBAR(); qkt<ND0>(pB0, pB1, K_lds + SHM_K, qr, r32, hi, init);
    finishSM(pA0, pA1, alA, l_reg, pa0, pa1, pa2, pa3); SBAR();
    pv_all<NB>(o, vb0, pa0, pa1, pa2, pa3); PSM(pB0, pB1, alB);
    __syncthreads(); RSC(alB);
    finishSM(pB0, pB1, alB, l_reg, pa0, pa1, pa2, pa3); SBAR();
    pv_all<NB>(o, vb0 + SHM_V, pa0, pa1, pa2, pa3);
#undef PSM
#undef RSC
    if (hi == 0) li_l[r32] = l_reg; asm volatile("s_waitcnt lgkmcnt(0)" ::: "memory");
    float rli[16];
#pragma unroll
    for (int r = 0; r < 16; ++r) rli[r] = __builtin_amdgcn_rcpf(li_l[crow(r, hi)]);
    bf16* Ow = Ob + (long)(wid * 32) * ldo;
#pragma unroll
    for (int r = 0; r < 16; ++r) { const int orow = crow(r, hi);
#pragma unroll
        for (int d0 = 0; d0 < NB; ++d0) Ow[(long)orow * ldo + d0 * 32 + r32] = f2bf(o[d0][r] * rli[r]); }
    __syncthreads();
#undef SLOAD
#undef SWRITE
#undef SWAIT
#undef RESC
}

#define EXP4(P, B) do { P[B] = __builtin_amdgcn_exp2f(P[B]); P[B + 1] = __builtin_amdgcn_exp2f(P[B + 1]); P[B + 2] = __builtin_amdgcn_exp2f(P[B + 2]); P[B + 3] = __builtin_amdgcn_exp2f(P[B + 3]); } while (0)
#define SUM4(S, P, B) do { S += (P[B] + P[B + 1]) + (P[B + 2] + P[B + 3]); } while (0)
#define PK4X(P, BASE, OUT) do { const u32x4 w_ = {cvt_pk_bf16(P[BASE + 0], P[BASE + 1]), cvt_pk_bf16(P[BASE + 2], P[BASE + 3]), cvt_pk_bf16(P[BASE + 4], P[BASE + 5]), cvt_pk_bf16(P[BASE + 6], P[BASE + 7])}; OUT = __builtin_bit_cast(bf16x8, w_); } while (0)
typedef short v4i16_t __attribute__((ext_vector_type(4)));
__device__ __forceinline__ s16x4 vtr(const LAS char* p) { return __builtin_bit_cast(s16x4, __builtin_amdgcn_ds_read_tr16_b64_v4i16((LAS v4i16_t*)p)); }
#define KSWZ2(row, colB) ((row) * 256 + ((colB) ^ (((row) & 15) << 4)))
template <int DQK, int D1, int DVV>
__device__ __forceinline__ void attn_unit2(const bf16* __restrict__ Qb, int ldq, const bf16* __restrict__ K1, int ldk1, const bf16* __restrict__ K2, int ldk2,
                                           const bf16* __restrict__ Vh, int ldv, bf16* __restrict__ Ob, int ldo, int seq, LAS char* lds, float kbound) {
    constexpr int ND0 = DQK / 16, NB = DVV / 32, CK = DQK / 8;
    constexpr int SHM_V = 64 * DVV * 2, SHM_K = 64 * 256;
    static_assert(NB == 2 && ND0 == 6, "written for QK dim 96 / V dim 64");
    int tid_ = threadIdx.x; asm volatile("" : "+v"(tid_));
    const int tid = tid_, wid = __builtin_amdgcn_readfirstlane(tid >> 6), lane = tid & 63, r32 = lane & 31, hi = lane >> 5;
    LAS char* V_lds = lds; LAS char* K_lds = lds + 3 * SHM_V;
    LAS float* ws = (LAS float*)(lds + 3 * SHM_V + 2 * SHM_K) + wid * 64;
    LAS char* QAL = lds + 3 * SHM_V + 2 * SHM_K + 2048 + wid * (2 * ND0 * 1024) + lane * 16; LAS char* QBL = QAL + ND0 * 1024;
    float nm;
    { bf16x8 qa[ND0], qb[ND0];
      const bf16* QwA = Qb + (long)(wid * 64 + r32) * ldq + hi * 8; const bf16* QwB = QwA + (long)32 * ldq;
#pragma unroll
      for (int d0 = 0; d0 < ND0; ++d0) { qa[d0] = *(const bf16x8*)(QwA + d0 * 16); qb[d0] = *(const bf16x8*)(QwB + d0 * 16); }
      float q2a = 0.f, q2b = 0.f;
#pragma unroll
      for (int d0 = 0; d0 < ND0; ++d0) { f32x4 a, b; unpack8(__builtin_bit_cast(u32x4, qa[d0]), a, b); q2a += sumsq4(a) + sumsq4(b); unpack8(__builtin_bit_cast(u32x4, qb[d0]), a, b); q2b += sumsq4(a) + sumsq4(b);
          *(LAS bf16x8*)(QAL + d0 * 1024) = qa[d0]; *(LAS bf16x8*)(QBL + d0 * 1024) = qb[d0]; }
      { auto rr = __builtin_amdgcn_permlane32_swap(__float_as_uint(q2a), __float_as_uint(q2a), false, false); q2a = __uint_as_float(rr[0]) + __uint_as_float(rr[1]); }
      { auto rr = __builtin_amdgcn_permlane32_swap(__float_as_uint(q2b), __float_as_uint(q2b), false, false); q2b = __uint_as_float(rr[0]) + __uint_as_float(rr[1]); }
      nm = -sqrtf(fmaxf(q2a, q2b)) * kbound; }
    const bf16* kp[2]; int kstr[2];
#pragma unroll
    for (int i = 0; i < 2; ++i) { const int row = 8 * wid + 4 * i + (lane >> 4), cc = (lane & 15) ^ (row & 15);
        if (cc >= 8 && cc < CK) { kp[i] = K2 + (long)row * ldk2 + (cc * 8 - D1); kstr[i] = 64 * ldk2; } else { kp[i] = K1 + (long)row * ldk1 + (cc < 8 ? cc * 8 : 0); kstr[i] = 64 * ldk1; } }
    const bf16* vp; { const int k = 8 * wid + ((lane & 31) >> 2); vp = Vh + (long)k * ldv + (lane >> 5) * 32 + (lane & 3) * 8; }
    const int vstr = 64 * ldv;
    const LAS char* vrd0 = V_lds + v_rd_base(lane);
#define DMA2(t, kb, vbuf) do { \
    __builtin_amdgcn_global_load_lds((const unsigned*)(kp[0] + (long)(t) * kstr[0]), (LAS unsigned*)(K_lds + (kb) * SHM_K + wid * 2048), 16, 0, 0); \
    __builtin_amdgcn_global_load_lds((const unsigned*)(kp[1] + (long)(t) * kstr[1]), (LAS unsigned*)(K_lds + (kb) * SHM_K + wid * 2048 + 1024), 16, 0, 0); \
    __builtin_amdgcn_global_load_lds((const unsigned*)(vp + (long)(t) * vstr), (LAS unsigned*)(V_lds + (vbuf) * SHM_V + wid * 1024), 16, 0, 0); } while (0)
#define VRD8(arr, base, D0) do { _Pragma("unroll") for (int j_ = 0; j_ < 8; ++j_) arr[j_] = vtr((base) + (j_ * NB + (D0)) * 512); } while (0)
#define PKV(arr, ks) (bf16x8){arr[2 * (ks)][0], arr[2 * (ks)][1], arr[2 * (ks)][2], arr[2 * (ks)][3], arr[2 * (ks) + 1][0], arr[2 * (ks) + 1][1], arr[2 * (ks) + 1][2], arr[2 * (ks) + 1][3]}
    f32x16 oA[2], oB[2]; oA[0] = f32x16{}; oA[1] = f32x16{}; oB[0] = f32x16{}; oB[1] = f32x16{};
    float lA = 0.f, lB = 0.f; const int NT = seq / 64;
    f32x16 a0, a1, c0, c1; bf16x8 pa0, pa1, pa2, pa3;
#define HALF1(Kb) do { \
        f32x16 init; { float nmv = nm; asm volatile("" : "+v"(nmv)); _Pragma("unroll") for (int r = 0; r < 16; ++r) init[r] = nmv; } \
        SBAR(); \
        _Pragma("unroll") for (int d0 = 0; d0 < ND0; ++d0) { const int cb = (d0 * 16 + hi * 8) * 2; \
            const bf16x8 k0 = *(const LAS bf16x8*)((Kb) + KSWZ2(r32, cb)), k1 = *(const LAS bf16x8*)((Kb) + KSWZ2(32 + r32, cb)), qv = *(const LAS bf16x8*)(QAL + d0 * 1024); \
            a0 = __builtin_amdgcn_mfma_f32_32x32x16_bf16(k0, qv, d0 == 0 ? init : a0, 0, 0, 0); \
            a1 = __builtin_amdgcn_mfma_f32_32x32x16_bf16(k1, qv, d0 == 0 ? init : a1, 0, 0, 0); } \
        SBAR(); \
        float sA = 0.f; \
        _Pragma("unroll") for (int d0 = 0; d0 < ND0; ++d0) { const int cb = (d0 * 16 + hi * 8) * 2; \
            const bf16x8 k0 = *(const LAS bf16x8*)((Kb) + KSWZ2(r32, cb)), k1 = *(const LAS bf16x8*)((Kb) + KSWZ2(32 + r32, cb)), qv = *(const LAS bf16x8*)(QBL + d0 * 1024); \
            c0 = __builtin_amdgcn_mfma_f32_32x32x16_bf16(k0, qv, d0 == 0 ? init : c0, 0, 0, 0); \
            if (d0 == 3) { EXP4(a0, 0); EXP4(a0, 4); } \
            if (d0 == 4) { EXP4(a0, 12); SUM4(sA, a0, 0); SUM4(sA, a0, 4); EXP4(a1, 0); } \
            if (d0 == 5) { EXP4(a1, 8); SUM4(sA, a1, 0); SUM4(sA, a1, 4); } \
            c1 = __builtin_amdgcn_mfma_f32_32x32x16_bf16(k1, qv, d0 == 0 ? init : c1, 0, 0, 0); \
            if (d0 == 3) { EXP4(a0, 8); } \
            if (d0 == 4) { EXP4(a1, 4); SUM4(sA, a0, 8); SUM4(sA, a0, 12); } \
            if (d0 == 5) { EXP4(a1, 12); SUM4(sA, a1, 8); SUM4(sA, a1, 12); } \
            if (d0 >= 2) SBAR(); } \
        lA += sA; \
        PK4X(a0, 0, pa0); PK4X(a0, 8, pa1); PK4X(a1, 0, pa2); PK4X(a1, 8, pa3); \
        SBAR(); } while (0)
#define HALF2(vbase) do { \
        float sB = 0.f; s16x4 va[8], vb_[8]; \
        VRD8(va, vbase, 0); VRD8(vb_, vbase, 1); \
        oA[0] = __builtin_amdgcn_mfma_f32_32x32x16_bf16(pa0, PKV(va, 0), oA[0], 0, 0, 0); SBAR(); \
        oA[1] = __builtin_amdgcn_mfma_f32_32x32x16_bf16(pa0, PKV(vb_, 0), oA[1], 0, 0, 0); EXP4(c0, 0); EXP4(c0, 4); SBAR(); \
        oA[0] = __builtin_amdgcn_mfma_f32_32x32x16_bf16(pa1, PKV(va, 1), oA[0], 0, 0, 0); EXP4(c0, 8); EXP4(c0, 12); SUM4(sB, c0, 0); SBAR(); \
        oA[1] = __builtin_amdgcn_mfma_f32_32x32x16_bf16(pa1, PKV(vb_, 1), oA[1], 0, 0, 0); EXP4(c1, 0); SUM4(sB, c0, 4); SUM4(sB, c0, 8); SBAR(); \
        oA[0] = __builtin_amdgcn_mfma_f32_32x32x16_bf16(pa2, PKV(va, 2), oA[0], 0, 0, 0); EXP4(c1, 4); SUM4(sB, c0, 12); SBAR(); \
        oA[1] = __builtin_amdgcn_mfma_f32_32x32x16_bf16(pa2, PKV(vb_, 2), oA[1], 0, 0, 0); EXP4(c1, 8); SUM4(sB, c1, 0); SBAR(); \
        oA[0] = __builtin_amdgcn_mfma_f32_32x32x16_bf16(pa3, PKV(va, 3), oA[0], 0, 0, 0); EXP4(c1, 12); SUM4(sB, c1, 4); SBAR(); \
        oA[1] = __builtin_amdgcn_mfma_f32_32x32x16_bf16(pa3, PKV(vb_, 3), oA[1], 0, 0, 0); SUM4(sB, c1, 8); SUM4(sB, c1, 12); SBAR(); \
        lB += sB; \
        PK4X(c0, 0, pa0); PK4X(c0, 8, pa1); PK4X(c1, 0, pa2); PK4X(c1, 8, pa3); \
        SBAR(); \
        VRD8(va, vbase, 0); VRD8(vb_, vbase, 1);                       \
        oB[0] = __builtin_amdgcn_mfma_f32_32x32x16_bf16(pa0, PKV(va, 0), oB[0], 0, 0, 0); \
        oB[1] = __builtin_amdgcn_mfma_f32_32x32x16_bf16(pa0, PKV(vb_, 0), oB[1], 0, 0, 0); \
        oB[0] = __builtin_amdgcn_mfma_f32_32x32x16_bf16(pa1, PKV(va, 1), oB[0], 0, 0, 0); \
        oB[1] = __builtin_amdgcn_mfma_f32_32x32x16_bf16(pa1, PKV(vb_, 1), oB[1], 0, 0, 0); \
        oB[0] = __builtin_amdgcn_mfma_f32_32x32x16_bf16(pa2, PKV(va, 2), oB[0], 0, 0, 0); \
        oB[1] = __builtin_amdgcn_mfma_f32_32x32x16_bf16(pa2, PKV(vb_, 2), oB[1], 0, 0, 0); \
        oB[0] = __builtin_amdgcn_mfma_f32_32x32x16_bf16(pa3, PKV(va, 3), oB[0], 0, 0, 0); \
        oB[1] = __builtin_amdgcn_mfma_f32_32x32x16_bf16(pa3, PKV(vb_, 3), oB[1], 0, 0, 0); \
        SBAR(); } while (0)
#define TILE_BAR() do { asm volatile("s_waitcnt vmcnt(0)" ::: "memory"); __syncthreads(); } while (0)
    DMA2(0, 0, 0);
    if (wid < 4) {
        int vs = 0;
#pragma unroll 1
        for (int t = 0; t < NT; ++t) { TILE_BAR();
            const int vn = vs == 2 ? 0 : vs + 1; if (t + 1 < NT) DMA2(t + 1, (t + 1) & 1, vn);
            HALF1(K_lds + (t & 1) * SHM_K); HALF2(vrd0 + vs * SHM_V); vs = vn; }
        TILE_BAR();
    } else {
        __builtin_amdgcn_s_setprio(1);
        TILE_BAR(); if (1 < NT) DMA2(1, 1, 1);
        HALF1(K_lds);
        int vs = 0;
#pragma unroll 1
        for (int t = 1; t < NT; ++t) { TILE_BAR();
            const int vn = vs == 2 ? 0 : vs + 1; const int vnn = vn == 2 ? 0 : vn + 1; if (t + 1 < NT) DMA2(t + 1, (t + 1) & 1, vnn);
            HALF2(vrd0 + vs * SHM_V); HALF1(K_lds + (t & 1) * SHM_K); vs = vn; }
        TILE_BAR();
        HALF2(vrd0 + vs * SHM_V);
        __builtin_amdgcn_s_setprio(0);
    }
#undef HALF1
#undef HALF2
#undef TILE_BAR
    { auto rr = __builtin_amdgcn_permlane32_swap(__float_as_uint(lA), __float_as_uint(lA), false, false); lA = __uint_as_float(rr[0]) + __uint_as_float(rr[1]); }
    { auto rr = __builtin_amdgcn_permlane32_swap(__float_as_uint(lB), __float_as_uint(lB), false, false); lB = __uint_as_float(rr[0]) + __uint_as_float(rr[1]); }
    if (hi == 0) { ws[r32] = lA; ws[32 + r32] = lB; } asm volatile("s_waitcnt lgkmcnt(0)" ::: "memory");
    bf16* Ow = Ob + (long)(wid * 64) * ldo;
#pragma unroll
    for (int r = 0; r < 16; ++r) { const int orow = crow(r, hi); const float ra = __builtin_amdgcn_rcpf(ws[orow]), rb = __builtin_amdgcn_rcpf(ws[32 + orow]);
#pragma unroll
        for (int d0 = 0; d0 < NB; ++d0) { Ow[(long)orow * ldo + d0 * 32 + r32] = f2bf(oA[d0][r] * ra); Ow[(long)(32 + orow) * ldo + d0 * 32 + r32] = f2bf(oB[d0][r] * rb); } }
    __syncthreads();
#undef DMA2
#undef VRD8
#undef PKV
}
#undef EXP4
#undef SUM4
#undef PK4X

__device__ __forceinline__ void spatial_unit(int chunk, int g, const bf16* __restrict__ U, const bf16* __restrict__ VR, const float* __restrict__ vstat, const float* __restrict__ g_sg,
                                             const bf16* __restrict__ Wsb, const float* __restrict__ b_s, bf16* __restrict__ Y, LAS char* lds) {
    int tid_ = threadIdx.x; asm volatile("" : "+v"(tid_));
    const int tid = tid_, wid = tid >> 6, lane = tid & 63, r32 = lane & 31, hi = lane >> 5, rb = wid & 3, ch = wid >> 2;
    LAS char* V_lds = lds; LAS float* rv = (LAS float*)(lds + 32768);
    const int row0 = chunk * 128;
    f32x4 s0 = {0.f, 0.f, 0.f, 0.f}, s1 = {0.f, 0.f, 0.f, 0.f};
    if (tid < 128) { s0 = *(const f32x4*)(vstat + (size_t)(row0 + tid) * 8); s1 = *(const f32x4*)(vstat + (size_t)(row0 + tid) * 8 + 4); }
    u32x4 wv[4];
#pragma unroll
    for (int i = 0; i < 4; ++i) { const int c = tid + 512 * i, row = c >> 4, cc = c & 15; wv[i] = *(const u32x4*)(VR + (size_t)(row0 + row) * 512 + g * 128 + cc * 8); }
    const f32x4 g0 = *(const f32x4*)(g_sg + g * 128 + (tid & 15) * 8), g1 = *(const f32x4*)(g_sg + g * 128 + (tid & 15) * 8 + 4);
    bf16x8 pa[8];
#pragma unroll
    for (int ks = 0; ks < 8; ++ks) pa[ks] = *(const bf16x8*)(Wsb + (size_t)g * 16384 + (size_t)(32 * rb + r32) * 128 + 16 * ks + 8 * hi);
    bf16 ur[16][2]; float bias[16];
#pragma unroll
    for (int r = 0; r < 16; ++r) { const int i = 32 * rb + crow(r, hi); bias[r] = b_s[g * 128 + i];
#pragma unroll
        for (int dd = 0; dd < 2; ++dd) ur[r][dd] = U[(size_t)(row0 + i) * 512 + g * 128 + 64 * ch + 32 * dd + r32]; }
    if (tid < 128) rv[tid] = __builtin_amdgcn_rsqf(((s0[0] + s0[1]) + (s0[2] + s0[3]) + (s1[0] + s1[1]) + (s1[2] + s1[3])) * (1.f / 512.f) + EPS);
    __syncthreads();
#pragma unroll
    for (int i = 0; i < 4; ++i) { const int c = tid + 512 * i, row = c >> 4, cc = c & 15; f32x4 a, b; unpack8(wv[i], a, b); const float r = rv[row];
        *(LAS u32x4*)(V_lds + (row >> 6) * 16384 + v_st<4>(row & 63, cc * 8)) = pack8(a * r * g0, b * r * g1); }
    __syncthreads();
    f32x16 o[2]; o[0] = f32x16{}; o[1] = f32x16{};
    const int vb = (int)(uintptr_t)V_lds + v_rd_base(lane) + (2 * ch) * 512;
    pv_one<4, 0>(o[0], vb, pa[0], pa[1], pa[2], pa[3]); pv_one<4, 1>(o[1], vb, pa[0], pa[1], pa[2], pa[3]);
    pv_one<4, 0>(o[0], vb + 16384, pa[4], pa[5], pa[6], pa[7]); pv_one<4, 1>(o[1], vb + 16384, pa[4], pa[5], pa[6], pa[7]);
#pragma unroll
    for (int r = 0; r < 16; ++r) { const int i = 32 * rb + crow(r, hi); const size_t row = (size_t)(row0 + i);
#pragma unroll
        for (int dd = 0; dd < 2; ++dd) { const int c = g * 128 + 64 * ch + 32 * dd + r32; const float uu = bf2f(ur[r][dd]);
            Y[row * 1536 + 512 + c] = f2bf(uu * (o[dd][r] + bias[r])); } }
    __syncthreads();
}
#undef KSWZ
#undef SBAR
}

#define XB_TMO      128
#define XB_XCNT(j)  (256  + 64 * (j))
#define XB_XSUB(j)  (1280 + 64 * (j))
#define XB_XGEN(j)  (2304 + 64 * (j))
#define XB_TOP      3328
#define XB_TOPGEN   3392
#define XCD_BAR_WORDS 3456
#define XB_SPIN_CAP (1u << 18)
__device__ __forceinline__ unsigned xb_ld(unsigned* p)              { return __hip_atomic_load((GAS unsigned*)p, __ATOMIC_RELAXED, __HIP_MEMORY_SCOPE_AGENT); }
__device__ __forceinline__ unsigned xb_add(unsigned* p, unsigned v) { return __hip_atomic_fetch_add((GAS unsigned*)p, v, __ATOMIC_RELAXED, __HIP_MEMORY_SCOPE_AGENT); }
__device__ __forceinline__ unsigned xb_xcc_id() { return (unsigned)__builtin_amdgcn_s_getreg((3 << 11) | 20) & 0xFu; }
#define XB_SPIN(cond, bar) do { unsigned _sp = 0; while (cond) { __builtin_amdgcn_s_sleep(1); \
    if ((++_sp & 255u) == 0u) { if (xb_ld(&(bar)[XB_TMO])) break; if (_sp > XB_SPIN_CAP) { xb_add(&(bar)[XB_TMO], 1u); break; } } } } while (0)
struct XcdBarrier { unsigned* bar; unsigned x; volatile LAS unsigned* st; };
__device__ __forceinline__ XcdBarrier xcd_barrier_post(unsigned* bar, volatile LAS unsigned* st) {
    XcdBarrier b; b.bar = bar; b.x = (unsigned)__builtin_amdgcn_readfirstlane((int)xb_xcc_id()); b.st = st;
    if (threadIdx.x == 0) (void)xb_add(&bar[XB_XCNT(b.x)], 1u);
    return b;
}
__device__ __forceinline__ void xcd_barrier_complete(unsigned* bar, unsigned x, unsigned& nloc, unsigned& nx) {
    const unsigned G = gridDim.x * gridDim.y * gridDim.z;
    unsigned sum, cnt, mine, sp = 0u;
    for (;;) {
        sum = 0u; cnt = 0u; mine = 0u;
#pragma unroll
        for (unsigned j = 0; j < 16; ++j) { const unsigned c = xb_ld(&bar[XB_XCNT(j)]); sum += c; cnt += (c > 0u) ? 1u : 0u; mine = (j == x) ? c : mine; }
        if (sum == G) break;
        __builtin_amdgcn_s_sleep(1);
        if ((++sp & 255u) == 0u) { if (xb_ld(&bar[XB_TMO])) break; if (sp > XB_SPIN_CAP) { xb_add(&bar[XB_TMO], 1u); break; } }
    }
    nloc = mine > 0u ? mine : 1u; nx = cnt > 0u ? cnt : 1u;
}
__device__ __forceinline__ void xcd_barrier(const XcdBarrier& b) {
    asm volatile("s_waitcnt vmcnt(0)" ::: "memory");
    __syncthreads();
    if (threadIdx.x == 0) {
        unsigned* bar = b.bar; unsigned bx = b.x; asm volatile("" : "+s"(bar), "+s"(bx));
        __builtin_amdgcn_s_waitcnt(0);
        unsigned nloc = b.st[0], nx = b.st[1];
        if (nloc == 0u) { xcd_barrier_complete(bar, bx, nloc, nx); b.st[0] = nloc; b.st[1] = nx; }
        const unsigned old = xb_add(&bar[XB_XSUB(bx)], 1u);
        const unsigned gen = old / nloc;
        if (old + 1u == (gen + 1u) * nloc) {
            __builtin_amdgcn_fence(__ATOMIC_RELEASE, "agent");
            asm volatile("s_waitcnt vmcnt(0)" ::: "memory");
            const unsigned og = xb_add(&bar[XB_TOP], 1u);
            const unsigned tg = og / nx;
            if (og + 1u == (tg + 1u) * nx) xb_add(&bar[XB_TOPGEN], 1u);
            else XB_SPIN(xb_ld(&bar[XB_TOPGEN]) == tg, bar);
            __builtin_amdgcn_fence(__ATOMIC_ACQUIRE, "agent");
            xb_add(&bar[XB_XGEN(bx)], 1u);
            asm volatile("s_waitcnt vmcnt(0)" ::: "memory");
        } else {
            XB_SPIN(xb_ld(&bar[XB_XGEN(bx)]) == gen, bar);
            __builtin_amdgcn_fence(__ATOMIC_ACQUIRE, "agent");
            asm volatile("s_waitcnt vmcnt(0)" ::: "memory");
        }
    }
    __syncthreads();
}

enum { CV_NAT = 0, CV_WIN = 1, CV_WUQ = 2, CV_W13 = 3 };
__device__ __forceinline__ int ropeperm(int p) { return ((p >> 2) & 1) * 16 + 4 * (p >> 3) + (p & 3); }
__device__ __forceinline__ int cv_map(int kind, int G, int& which, float& scale, bool& perm) {
    which = 0; scale = 1.f; perm = false; const int n = G * 32;
    if (kind == CV_WIN) {
        if (n < 384) return n;
        if (n < 416) { perm = true; return 640; }
        if (n < 512) return -1;
        if (n < 768) return 384 + (n - 512);
        if (n < 1280) return 672 + (n - 768);
        if (n < 1792) return 1184 + (n - 1280);
        if (n < 2304) { scale = XSCALE; return 1696 + (n - 1792); }
        return 2208 + (n - 2304);
    }
    if (kind == CV_WUQ) { scale = QSCALE; perm = (G % 3) == 2; return n; }
    if (kind == CV_W13) { which = (n >> 7) & 1; return 128 * (n >> 8) + (n & 127); }
    return n;
}
struct CvDesc { const float* src; const float* src2; const float* gain; bf16* dst; int K, Nsrc, Nout, kind; };
__device__ __forceinline__ void cv_item(const CvDesc& d, int item, LAS char* tile, int lane) {
    const int nI = d.Nout >> 7, kb = item / nI, nb = item - kb * nI, k0 = 64 * kb, n0 = 128 * nb;
    const int nq = lane & 31, kh = lane >> 5;
    const int nout = n0 + 4 * nq, G = nout >> 5, p = nout & 31;
    int which; float scale; bool perm; const int sc = cv_map(d.kind, G, which, scale, perm);
    const bool zero = sc < 0;
    const float* W = d.src + (ptrdiff_t)which * (d.src2 - d.src) + (size_t)k0 * d.Nsrc + (zero ? 0 : sc + (perm ? ropeperm(p) : p));
#pragma unroll
    for (int half = 0; half < 2; ++half) {
        f32x4 v[16];
#pragma unroll
        for (int i = 0; i < 16; ++i) { const int k = 32 * half + 2 * i + kh; v[i] = zero ? (f32x4){0.f, 0.f, 0.f, 0.f} : *(const f32x4*)(W + (size_t)k * d.Nsrc); }
#pragma unroll
        for (int i = 0; i < 16; ++i) { const int k = 32 * half + 2 * i + kh; const float g = d.gain ? d.gain[k0 + k] * scale : scale; const f32x4 w = v[i] * g;
            *(LAS u32x2*)(tile + att::v_st<4>(k, 4 * nq)) = (u32x2){cvt_pk_bf16(w[0], w[1]), cvt_pk_bf16(w[2], w[3])}; }
    }
    LDS_WAIT(); asm volatile("" ::: "memory");
    const int vb = (int)(uintptr_t)tile + att::v_rd_base(lane);
    bf16* drow = d.dst + (size_t)(n0 >> 8) * 256 * d.K + (size_t)kb * (256 * 64) + (size_t)((n0 & 255) + nq) * 64 + 8 * kh;
#define CV_RD(D0, KS) { const s16x4 l_ = att::tr_read<((2 * KS) * 4 + D0) * 512>(vb), h_ = att::tr_read<((2 * KS + 1) * 4 + D0) * 512>(vb); \
        asm volatile("s_waitcnt lgkmcnt(0)" ::: "memory"); __builtin_amdgcn_sched_barrier(0); \
        *(bf16x8*)(drow + (32 * D0) * 64 + 16 * KS) = (bf16x8){l_[0], l_[1], l_[2], l_[3], h_[0], h_[1], h_[2], h_[3]}; }
#define CV_RD4(D0) CV_RD(D0, 0) CV_RD(D0, 1) CV_RD(D0, 2) CV_RD(D0, 3)
    CV_RD4(0) CV_RD4(1) CV_RD4(2) CV_RD4(3)
#undef CV_RD4
#undef CV_RD
    LDS_WAIT(); asm volatile("" ::: "memory");
}

struct Args {
    const float* x; const float* mem; const int* positions; const float* g_mix; const float* w_in; const float* g_q; const float* g_kv; const float* w_uq; const float* w_uk; const float* w_uv;
    const float* g_sg; const float* w_s; const float* b_s; const float* g_mem; const float* w_mkv; const float* w_br; const float* b_gate; const float* w_out; const float* g_ffn;
    const float* dense_w1; const float* dense_w3; const float* dense_w2; const float* w_router; const float* moe_w1; const float* moe_w3; const float* moe_w2; const float* g_final;
    float* out; unsigned char* ws; int dbg; int pad;
};
typedef const __attribute__((address_space(4))) Args* ArgsP;
#define FRESH(ap) ArgsP ap = kargs; asm volatile("" : "+s"(ap))
__constant__ double INVF[16] = { 1.0, 0.5623413251903491, 0.31622776601683794, 0.1778279410038923, 0.1, 0.05623413251903491, 0.03162277660168379, 0.01778279410038923,
                                 0.01, 0.005623413251903491, 0.003162277660168379, 0.001778279410038923, 0.001, 0.0005623413251903491, 0.00031622776601683794, 0.0001778279410038923 };

struct Frame { LAS unsigned char* lds; int G, NGW, bid; };
#define LOCAL_IDS int tid = threadIdx.x; asm volatile("" : "+v"(tid)); const int lane = tid & 63, wave = __builtin_amdgcn_readfirstlane(tid >> 6), gw = F.bid * NWAVES + wave; (void)lane; (void)gw

__device__ __forceinline__ void conv_run(const Frame& F, const CvDesc& d) {
    LOCAL_IDS;
    LAS char* tile = (LAS char*)(F.lds + wave * 16384);
    const int nitems = (d.K / 64) * (d.Nout / 128);
    for (int it = gw; it < nitems; it += F.NGW) cv_item(d, it, tile, lane);
}
__device__ __forceinline__ void rx_from_stats(const Frame& F, ArgsP kargs) {
    LOCAL_IDS; FRESH(ap); const float* xstat = (const float*)(ap->ws + WS_XSTAT); float* rx = (float*)(ap->ws + WS_RX);
    for (int row = F.bid * 512 + tid; row < M; row += F.G * 512) {
        const f32x4* p = (const f32x4*)(xstat + (size_t)row * 16); const f32x4 a = p[0], b = p[1], c = p[2], d = p[3];
        const float s = ((a[0] + a[1]) + (a[2] + a[3])) + ((b[0] + b[1]) + (b[2] + b[3])) + ((c[0] + c[1]) + (c[2] + c[3])) + ((d[0] + d[1]) + (d[2] + d[3]));
        rx[row] = __builtin_amdgcn_rsqf(s * (1.f / D) + EPS);
    }
}
template <int MODE>
__device__ __forceinline__ void conv_flat(const Frame& F, ArgsP kargs, int l, int j2, int lmix) {
    int tid_ = threadIdx.x; asm volatile("" : "+v"(tid_)); const int lane_ = tid_ & 63, wave_ = __builtin_amdgcn_readfirstlane(tid_ >> 6);
    LAS char* tile = (LAS char*)(F.lds + wave_ * 16384);
    constexpr int I13D = (D / 64) * (2 * DFF / 128), I2D = (DFF / 64) * (D / 128), I13 = (D / 64) * (2 * DFE / 128), I2 = (DFE / 64) * (D / 128), IE = I13 + I2, IMKV = (D / 64) * (D / 128);
    constexpr int NB_ = MODE == 0 ? DEPTH * IMKV : MODE == 1 ? I13D + I2D : NE * IE;
    constexpr int M_IN = (D / 64) * (PPAD / 128), M_UQ = (QRANK / 64) * (768 / 128), M_UK = (KVRANK / 64) * (512 / 128), M_BR = (BW / 64) * (D / 128), M_OUT = (D / 64) * (D / 128);
    constexpr int O_UQ = M_IN, O_UK = O_UQ + M_UQ, O_UV = O_UK + M_UK, O_BR = O_UV + M_UK, O_OUT = O_BR + 3 * M_BR, NMIX = O_OUT + M_OUT;
    const int total = NB_ + ((lmix >= 0 && lmix < DEPTH) ? NMIX : 0);
#pragma unroll 1
    for (int idx = wave_ * F.G + F.bid; idx < total; idx += F.NGW) { FRESH(a); CvDesc d; int it;
        if (idx < NB_) {
            if constexpr (MODE == 0) { const int lq = idx / IMKV; it = idx - lq * IMKV; d = CvDesc{a->w_mkv + (size_t)lq * D * D, nullptr, nullptr, (bf16*)(a->ws + WS_WMKVT) + (size_t)lq * D * D, D, D, D, CV_NAT}; }
            else if constexpr (MODE == 1) {
                if (idx < I13D) { it = idx; d = CvDesc{a->dense_w1 + (size_t)j2 * D * DFF, a->dense_w3 + (size_t)j2 * D * DFF, a->g_ffn + l * D, (bf16*)(a->ws + WS_WFFN), D, DFF, 2 * DFF, CV_W13}; }
                else { it = idx - I13D; d = CvDesc{a->dense_w2 + (size_t)j2 * DFF * D, nullptr, nullptr, (bf16*)(a->ws + WS_W2D), DFF, D, D, CV_NAT}; } }
            else { const int e = idx / IE, r = idx - e * IE;
                if (r < I13) { it = r; d = CvDesc{a->moe_w1 + ((size_t)j2 * NE + e) * D * DFE, a->moe_w3 + ((size_t)j2 * NE + e) * D * DFE, a->g_ffn + l * D, (bf16*)(a->ws + WS_WFFN) + (size_t)e * 2 * DFE * D, D, DFE, 2 * DFE, CV_W13}; }
                else { it = r - I13; d = CvDesc{a->moe_w2 + ((size_t)j2 * NE + e) * DFE * D, nullptr, nullptr, (bf16*)(a->ws + WS_W2M) + (size_t)e * D * DFE, DFE, D, D, CV_NAT}; } }
        } else { const int r = idx - NB_;
            if (r < O_UQ) { it = r; d = CvDesc{a->w_in + (size_t)lmix * D * PTOT, nullptr, a->g_mix + lmix * D, (bf16*)(a->ws + WS_WINT), D, PTOT, PPAD, CV_WIN}; }
            else if (r < O_UK) { it = r - O_UQ; d = CvDesc{a->w_uq + (size_t)lmix * QRANK * 768, nullptr, a->g_q + lmix * QRANK, (bf16*)(a->ws + WS_WUQT), QRANK, 768, 768, CV_WUQ}; }
            else if (r < O_UV) { it = r - O_UK; d = CvDesc{a->w_uk + (size_t)lmix * KVRANK * 512, nullptr, a->g_kv + lmix * KVRANK, (bf16*)(a->ws + WS_WUKVT), KVRANK, 512, 512, CV_NAT}; }
            else if (r < O_BR) { it = r - O_UV; d = CvDesc{a->w_uv + (size_t)lmix * KVRANK * 512, nullptr, a->g_kv + lmix * KVRANK, (bf16*)(a->ws + WS_WUKVT) + 512 * KVRANK, KVRANK, 512, 512, CV_NAT}; }
            else if (r < O_OUT) { const int n = (r - O_BR) / M_BR; it = (r - O_BR) - n * M_BR; d = CvDesc{a->w_br + ((size_t)lmix * 3 + n) * BW * D, nullptr, nullptr, (bf16*)(a->ws + WS_WBRT) + (size_t)n * D * BW, BW, D, D, CV_NAT}; }
            else { it = r - O_OUT; d = CvDesc{a->w_out + (size_t)lmix * D * D, nullptr, nullptr, (bf16*)(a->ws + WS_WOUTT), D, D, D, CV_NAT}; } }
        cv_item(d, it, tile, lane_); }
    if (lmix >= 0 && lmix < DEPTH) {
        FRESH(a); const float* wsrc = a->w_s + (size_t)lmix * 65536; bf16* wdst = (bf16*)(a->ws + WS_WSB);
        for (int i = F.bid * 512 + tid_; i < 4 * 128 * 128 / 4; i += F.G * 512) { const f32x4 v = *(const f32x4*)(wsrc + (size_t)i * 4);
            *(u32x2*)(wdst + (size_t)i * 4) = (u32x2){cvt_pk_bf16(v[0], v[1]), cvt_pk_bf16(v[2], v[3])}; } }
}
__device__ __forceinline__ void phase_prologue(const Frame& F, ArgsP kargs) {
    LOCAL_IDS;
    { FRESH(a); float* ROPE = (float*)(a->ws + WS_ROPE); const int* pos = a->positions;
      for (int idx = F.bid * 512 + tid; idx < M * 16; idx += F.G * 512) { const int row = idx >> 4, i = idx & 15;
        const double t = (double)pos[row] * INVF[i] * 0.15915494309189535; const float fr = (float)(t - rint(t));
        ROPE[(size_t)row * 32 + i] = __builtin_amdgcn_cosf(fr); ROPE[(size_t)row * 32 + 16 + i] = __builtin_amdgcn_sinf(fr); } }
    { FRESH(a); const float* xin = a->x; bf16* XB = (bf16*)(a->ws + WS_XB); float* RX = (float*)(a->ws + WS_RX);
      f32x4 vn[4];
#pragma unroll
      for (int j = 0; j < 4; ++j) vn[j] = ((const f32x4*)(xin + (size_t)gw * D) + lane)[64 * j];
#pragma unroll 1
      for (int m = gw; m < M; m += F.NGW) { f32x4 v[4]; float s = 0.f; const int mn = m + F.NGW < M ? m + F.NGW : m;
#pragma unroll
        for (int j = 0; j < 4; ++j) { v[j] = vn[j]; s += sumsq4(v[j]); }
#pragma unroll
        for (int j = 0; j < 4; ++j) vn[j] = ((const f32x4*)(xin + (size_t)mn * D) + lane)[64 * j];
        s = wave_sum(s);
#pragma unroll
        for (int j = 0; j < 4; ++j) ((u32x2*)(XB + (size_t)m * D) + lane)[64 * j] = (u32x2){cvt_pk_bf16(v[j][0], v[j][1]), cvt_pk_bf16(v[j][2], v[j][3])};
        if (lane == 0) RX[m] = __builtin_amdgcn_rsqf(s * (1.f / D) + EPS); } }
    { FRESH(a); const float* mem = a->mem; const float* g_mem = a->g_mem; bf16* MEMB = (bf16*)(a->ws + WS_MEMB);
      for (int m = gw; m < NMEM; m += F.NGW) { const f32x4* xr = (const f32x4*)(mem + (size_t)m * D) + lane; f32x4 v[4]; float s = 0.f;
#pragma unroll
        for (int j = 0; j < 4; ++j) { v[j] = xr[64 * j]; s += sumsq4(v[j]); }
        const float r = __builtin_amdgcn_rsqf(wave_sum(s) * (1.f / D) + EPS);
#pragma unroll
        for (int j = 0; j < 4; ++j) { const f32x4 g = ((const f32x4*)g_mem + lane)[64 * j]; const f32x4 w = v[j] * r * g;
            ((u32x2*)(MEMB + (size_t)m * D) + lane)[64 * j] = (u32x2){cvt_pk_bf16(w[0], w[1]), cvt_pk_bf16(w[2], w[3])}; } } }
    conv_flat<0>(F, kargs, 0, 0, 0);
}
__device__ __forceinline__ void phase_inproj(const Frame& F, ArgsP kargs, int l) {
    if (PH(1)) { FRESH(a); unsigned char* ws = a->ws;
        pg8::TileOrder S{M / 256, PPAD / 256 - 1, F.G, F.bid, (const char*)(ws + WS_XB), (const char*)(ws + WS_WINT), (size_t)256 * D * 2, (size_t)256 * D * 2};
#ifdef DBG_REV
        S.rev = 1;
#endif
        pg8::EpiInProj E{ws, a->b_gate + (size_t)l * 3 * D, l, (l & 1)};
        pg8::gemm_phase(F.lds, D, D, D, S, E); }
    if (l == 0 && PH(2)) { FRESH(a); unsigned char* ws = a->ws;
        struct MemOrder { enum { VARK = 0, GATHER = 0 }; int c; const char* A; const char* B;
            __device__ __forceinline__ bool next(int i, pg8::Unit& u) const { if (i > 0 || c < 240) return false; const int idx = c - 240; u.pm = 0; u.pn = idx & 3; u.aux = idx >> 2; u.A = A; u.B = B + (size_t)u.aux * D * D * 2 + (size_t)u.pn * 256 * D * 2; return true; } };
        MemOrder S2{F.bid, (const char*)(ws + WS_MEMB), (const char*)(ws + WS_WMKVT)}; pg8::EpiMemKV E2{(bf16*)(ws + WS_KVMEM)};
        pg8::gemm_phase(F.lds, D, D, D, S2, E2); }
}
struct GateTailOrder { enum { VARK = 0, GATHER = 0 }; int c; const char* A; const char* B;
    __device__ __forceinline__ bool next(int i, pg8::Unit& u) const { if (i > 0 || c < 192) return false; u.pm = c - 192; u.pn = PPAD / 256 - 1; u.aux = 0; u.A = A + (size_t)u.pm * 256 * D * 2; u.B = B + (size_t)u.pn * 256 * D * 2; return true; } };
__device__ __forceinline__ void phase_up(const Frame& F, ArgsP kargs, int l) {
    if (PH(1)) { FRESH(a); unsigned char* ws = a->ws;
        GateTailOrder S{F.bid, (const char*)(ws + WS_XB), (const char*)(ws + WS_WINT)}; pg8::EpiInProj E{ws, a->b_gate + (size_t)l * 3 * D, l, (l & 1)};
        pg8::gemm_phase(F.lds, D, D, D, S, E); }
    if (PH(3)) { FRESH(a); unsigned char* ws = a->ws;
        pg8::TileOrder S{M / 256, 3, F.G, F.bid, (const char*)(ws + WS_CQ), (const char*)(ws + WS_WUQT), (size_t)256 * 512 * 2, (size_t)256 * QRANK * 2};
        pg8::EpiQ E{(const float*)(ws + WS_CQSTAT), (const float*)(ws + WS_ROPE), (bf16*)(ws + WS_Q)}; pg8::gemm_phase(F.lds, 512, QRANK, QRANK, S, E); }
    if (PH(4)) { FRESH(a); unsigned char* ws = a->ws;
        pg8::TileOrder S{M / 256, 4, F.G, F.bid, (const char*)(ws + WS_CKV), (const char*)(ws + WS_WUKVT), (size_t)256 * KVRANK * 2, (size_t)256 * KVRANK * 2};
        pg8::EpiKV E{(const float*)(ws + WS_CKVSTAT), (bf16*)(ws + WS_KN), (bf16*)(ws + WS_V), (unsigned*)(ws + WS_CTL) + CW_KMAX + l * 32}; pg8::gemm_phase(F.lds, KVRANK, KVRANK, KVRANK, S, E); }
    if (PH(5)) { FRESH(a); unsigned char* ws = a->ws;
        for (int un = F.bid; un < 512; un += F.G)
            att::spatial_unit(un >> 2, un & 3, (const bf16*)(ws + WS_U), (const bf16*)(ws + WS_VR), (const float*)(ws + WS_VSTAT), a->g_sg + l * BW, (const bf16*)(ws + WS_WSB), a->b_s + l * 512, (bf16*)(ws + WS_Y), (LAS char*)F.lds); }
    if (PH(6)) { FRESH(a); unsigned char* ws = a->ws;
        for (int un = F.bid; un < 256; un += F.G) { const int h = un & 3, pm = un >> 2; const bf16* kvm = (const bf16*)(ws + WS_KVMEM) + (size_t)l * 256 * 1024;
            att::attn_unit<128, 128, 128, false>((const bf16*)(ws + WS_QX) + (size_t)pm * 256 * 512 + h * 128, 512, kvm + h * 128, 1024, kvm, 1024, kvm + 512 + h * 128, 1024,
                                          (bf16*)(ws + WS_Y) + (size_t)pm * 256 * 1536 + 1024 + h * 128, 1536, NMEM, (LAS char*)F.lds, 0.f); } }
}
__device__ __forceinline__ void phase_attn(const Frame& F, ArgsP kargs, int l) {
    if (PH(7)) { FRESH(a); unsigned char* ws = a->ws;
        for (int un = F.bid; un < 256; un += F.G) { const int h = un & 7, qb = un >> 3;
            const unsigned* km = (const unsigned*)(ws + WS_CTL) + CW_KMAX + l * 32;
            const float kbound = sqrtf(__uint_as_float(km[2 * h]) + __uint_as_float(km[2 * h + 1]) + __uint_as_float(km[16])) * 1.02f;
            att::attn_unit2<96, 64, 64>((const bf16*)(ws + WS_Q) + (size_t)qb * 512 * 768 + h * 96, 768, (const bf16*)(ws + WS_KN) + h * 64, 512, (const bf16*)(ws + WS_KR), 32, (const bf16*)(ws + WS_V) + h * 64, 512,
                                        (bf16*)(ws + WS_Y) + (size_t)qb * 512 * 1536 + h * 64, 1536, M, (LAS char*)F.lds, kbound); } }
}
__device__ __forceinline__ void phase_branch(const Frame& F, ArgsP kargs) {
    if (PH(8)) { FRESH(a); unsigned char* ws = a->ws;
        struct BranchOrder { enum { VARK = 0, GATHER = 0 }; int c; const char* A; const char* B;
            __device__ __forceinline__ bool next(int i, pg8::Unit& u) const { if (i >= 3 || c >= 256) return false; int pm, pn; pg8::tile_of(c, 64, 4, pm, pn); u.pm = pm; u.pn = pn; u.aux = i;
                u.A = A + (size_t)pm * 256 * 1536 * 2 + (size_t)i * 512 * 2; u.B = B + (size_t)i * D * BW * 2 + (size_t)pn * 256 * BW * 2; return true; } };
        BranchOrder S{F.bid, (const char*)(ws + WS_Y), (const char*)(ws + WS_WBRT)}; pg8::EpiBranch E{(const unsigned char*)(ws + WS_GATE), (bf16*)(ws + WS_MIXB)};
        pg8::gemm_phase(F.lds, 1536, BW, BW, S, E); }
}
__device__ __forceinline__ void phase_outproj(const Frame& F, ArgsP kargs, bool dummy = false) {
    if (PH(9)) { FRESH(a); unsigned char* ws = a->ws;
        pg8::TileOrder S{M / 256, 4, F.G, F.bid, (const char*)(ws + WS_MIXB), (const char*)(ws + WS_WOUTT), (size_t)256 * D * 2, (size_t)256 * D * 2};
        (void)dummy; pg8::EpiResid E{(bf16*)(ws + WS_XB), (float*)(ws + WS_XSTAT)}; pg8::gemm_phase(F.lds, 0, D, D, S, E); }
}
__device__ __forceinline__ void phase_dense_conv(const Frame& F, ArgsP kargs, int l, int j2) {
    rx_from_stats(F, kargs);
    conv_flat<1>(F, kargs, l, j2, l + 1);
}
__device__ __forceinline__ void phase_dense_up(const Frame& F, ArgsP kargs) {
    if (PH(10)) { FRESH(a); unsigned char* ws = a->ws;
        pg8::TileOrder S{M / 256, 2 * DFF / 256, F.G, F.bid, (const char*)(ws + WS_XB), (const char*)(ws + WS_WFFN), (size_t)256 * D * 2, (size_t)256 * D * 2};
        pg8::EpiSwiGLU E{(const float*)(ws + WS_RX), (bf16*)(ws + WS_HFF), DFF, 0}; pg8::gemm_phase(F.lds, D, D, D, S, E); }
}
__device__ __forceinline__ void phase_dense_down(const Frame& F, ArgsP kargs, bool dummy = false) {
    if (PH(11)) { FRESH(a); unsigned char* ws = a->ws;
        pg8::TileOrder S{M / 256, 4, F.G, F.bid, (const char*)(ws + WS_HFF), (const char*)(ws + WS_W2D), (size_t)256 * DFF * 2, (size_t)256 * DFF * 2};
        (void)dummy; pg8::EpiResid E{(bf16*)(ws + WS_XB), (float*)(ws + WS_XSTAT)}; pg8::gemm_phase(F.lds, 0, DFF, DFF, S, E); }
}
__device__ __forceinline__ void phase_moe_route(const Frame& F, ArgsP kargs, int l, int j2) {
    conv_flat<2>(F, kargs, l, j2, l + 1 < DEPTH ? l + 1 : -1);
    __syncthreads();
    LOCAL_IDS; FRESH(a); unsigned char* ws = a->ws; const bf16* X = (const bf16*)(ws + WS_XB);
    float* RX = (float*)(ws + WS_RX); int* TOPI = (int*)(ws + WS_TOPI); float* TOPW = (float*)(ws + WS_TOPW); int* LRANK = (int*)(ws + WS_LRANK); int* BLKCNT = (int*)(ws + WS_BLKCNT);
    LAS int* tope = (LAS int*)(F.lds + 0);
    const float* wr = a->w_router + (size_t)j2 * D * NE; const float* gf = a->g_ffn + l * D;
    f32x4 gvA[4], wA[4][4][2]; u32x2 xn[4];
#pragma unroll
    for (int j = 0; j < 4; ++j) { const int k0 = 4 * lane + 256 * j; gvA[j] = *(const f32x4*)(gf + k0);
#pragma unroll
        for (int q = 0; q < 4; ++q) { wA[j][q][0] = *(const f32x4*)(wr + (size_t)(k0 + q) * 8); wA[j][q][1] = *(const f32x4*)(wr + (size_t)(k0 + q) * 8 + 4); } }
#pragma unroll
    for (int j = 0; j < 4; ++j) xn[j] = *(const u32x2*)(X + (size_t)(F.bid * 64 + wave * 8) * D + 4 * lane + 256 * j);
#pragma unroll 1
    for (int i = 0; i < 8; ++i) { const int rib = wave * 8 + i, row = F.bid * 64 + rib;
        float lg[8]; float ss = 0.f; f32x4 xc[4];
#pragma unroll
        for (int e = 0; e < 8; ++e) lg[e] = 0.f;
#pragma unroll
        for (int j = 0; j < 4; ++j) xc[j] = (f32x4){bflo(xn[j].x), bfhi(xn[j].x), bflo(xn[j].y), bfhi(xn[j].y)};
        if (i + 1 < 8) {
#pragma unroll
            for (int j = 0; j < 4; ++j) xn[j] = *(const u32x2*)(X + (size_t)(row + 1) * D + 4 * lane + 256 * j); }
#pragma unroll
        for (int j = 0; j < 4; ++j) { const f32x4 xv = xc[j], gv = gvA[j]; ss += sumsq4(xv);
#pragma unroll
            for (int q = 0; q < 4; ++q) { const float hv = xv[q] * gv[q]; const f32x4 w0 = wA[j][q][0], w1 = wA[j][q][1];
                lg[0] += hv * w0[0]; lg[1] += hv * w0[1]; lg[2] += hv * w0[2]; lg[3] += hv * w0[3]; lg[4] += hv * w1[0]; lg[5] += hv * w1[1]; lg[6] += hv * w1[2]; lg[7] += hv * w1[3]; } }
        const float r = __builtin_amdgcn_rsqf(wave_sum(ss) * (1.f / D) + EPS);
#pragma unroll
        for (int e = 0; e < 8; ++e) lg[e] = wave_sum(lg[e]) * r;
        int e0 = 0; float v0 = lg[0];
#pragma unroll
        for (int e = 1; e < 8; ++e) if (lg[e] > v0) { v0 = lg[e]; e0 = e; }
        int e1 = e0 == 0 ? 1 : 0; float v1 = -3.0e38f;
#pragma unroll
        for (int e = 0; e < 8; ++e) if (e != e0 && lg[e] > v1) { v1 = lg[e]; e1 = e; }
        const float w0 = 1.f / (1.f + expf(v1 - v0));
        if (lane == 0) { RX[row] = r; TOPI[row] = e0 | (e1 << 8); TOPW[(size_t)row * 2] = w0; TOPW[(size_t)row * 2 + 1] = 1.f - w0; tope[rib] = e0 | (e1 << 8); } }
    __syncthreads();
    if (wave == 0) { const int te = tope[lane], e0 = te & 255, e1 = te >> 8, row = F.bid * 64 + lane; const unsigned long long below = (1ull << lane) - 1ull;
        int rk0 = 0, rk1 = 0;
#pragma unroll
        for (int e = 0; e < 8; ++e) { const unsigned long long m0 = __ballot(e0 == e), m1 = __ballot(e1 == e); const int c0 = __popcll(m0);
            if (e0 == e) rk0 = __popcll(m0 & below); if (e1 == e) rk1 = c0 + __popcll(m1 & below);
            if (lane == 0) BLKCNT[F.bid * 8 + e] = c0 + __popcll(m1); }
        LRANK[(size_t)row * 2] = rk0; LRANK[(size_t)row * 2 + 1] = rk1; }
    __syncthreads();
}
__device__ __forceinline__ void moe_tiles(const Frame& F, ArgsP kargs, int (&tb)[NE + 1], LAS int* pre) {
    LOCAL_IDS; FRESH(a); const int* BLKCNT = (const int*)(a->ws + WS_BLKCNT);
    __syncthreads();
    if (tid < 16) pre[tid] = 0;
    __syncthreads();
    if (tid < 256) { const i32x4 c0 = *(const i32x4*)(BLKCNT + tid * 8), c1 = *(const i32x4*)(BLKCNT + tid * 8 + 4); const int cc[8] = {c0[0], c0[1], c0[2], c0[3], c1[0], c1[1], c1[2], c1[3]};
#pragma unroll
        for (int e = 0; e < 8; ++e) { const int tot = (int)wave_sum((float)cc[e]); const int bel = (int)wave_sum(tid < F.bid ? (float)cc[e] : 0.f);
            if (lane == 0) { __hip_atomic_fetch_add(pre + 8 + e, tot, __ATOMIC_RELAXED, __HIP_MEMORY_SCOPE_WORKGROUP); __hip_atomic_fetch_add(pre + e, bel, __ATOMIC_RELAXED, __HIP_MEMORY_SCOPE_WORKGROUP); } } }
    __syncthreads();
    int acc_t = 0;
#pragma unroll
    for (int e = 0; e < NE; ++e) { tb[e] = acc_t; acc_t += (__builtin_amdgcn_readfirstlane(pre[8 + e]) + 255) >> 8; }
    tb[NE] = acc_t;
}
__device__ __forceinline__ void phase_moe_gather(const Frame& F, ArgsP kargs) {
    int tb[NE + 1]; LAS int* pre = (LAS int*)(F.lds + 0);
    moe_tiles(F, kargs, tb, pre);
    LOCAL_IDS; FRESH(a); unsigned char* ws = a->ws;
    const int* TOPI = (const int*)(ws + WS_TOPI); const int* LRANK = (const int*)(ws + WS_LRANK); int* POS = (int*)(ws + WS_POS); float* SLOTR = (float*)(ws + WS_SLOTR); const float* RX = (const float*)(ws + WS_RX);
    int* TOKOF = (int*)(ws + WS_TOKOF);
    if (lane < 16) { const int pi = wave * 16 + lane, rib = pi >> 1, k = pi & 1, row = F.bid * 64 + rib;
        const int te = TOPI[row], e = k ? (te >> 8) : (te & 255); const int lr = LRANK[(size_t)row * 2 + k]; const float rx = RX[row];
        int bs = 0;
#pragma unroll
        for (int q = 0; q < NE; ++q) if (q == e) bs = tb[q] * 256;
        const int slot = bs + pre[e] + lr;
        POS[(size_t)row * 2 + k] = slot; SLOTR[slot] = rx; TOKOF[slot] = row; }
    if (F.bid < NE) { const int e = F.bid; int b0 = 0, b1 = 0;
#pragma unroll
        for (int q = 0; q < NE; ++q) if (q == e) { b0 = tb[q] * 256; b1 = tb[q + 1] * 256; }
        const int cnt = __builtin_amdgcn_readfirstlane(pre[8 + e]);
        for (int s = b0 + cnt + tid; s < b1; s += NWAVES * 64) { SLOTR[s] = 0.f; TOKOF[s] = 0; } }
    __syncthreads();
}
struct MoeOrder { enum { VARK = 0, GATHER = 0 }; int nN, G, c, T; int tb[NE + 1]; const char* A; const char* B; size_t astep, estep, bstep; int rev = 0;
    __device__ __forceinline__ bool next(int i, pg8::Unit& u) const { const long L = (long)i * G + c; if (L >= (long)T * nN) return false; int pm, pn; pg8::tile_of((int)L, T, nN, pm, pn); if (rev) pm = T - 1 - pm;
        int e = 0;
#pragma unroll
        for (int q = 1; q < NE; ++q) e += (pm >= tb[q]) ? 1 : 0;
        u.pm = pm; u.pn = pn; u.aux = e; u.A = A + (size_t)pm * astep; u.B = B + (size_t)e * estep + (size_t)pn * bstep; return true; } };
struct MoeUpOrder { enum { VARK = 0, GATHER = 1 }; int nN, G, c, T; int tb[NE + 1]; const char* A; const char* B; size_t estep, bstep; const LAS int* tokL;
    __device__ __forceinline__ bool next(int i, pg8::Unit& u) const { const long L = (long)i * G + c; if (L >= (long)T * nN) return false; int pm, pn; pg8::tile_of((int)L, T, nN, pm, pn);
        int e = 0;
#pragma unroll
        for (int q = 1; q < NE; ++q) e += (pm >= tb[q]) ? 1 : 0;
        u.pm = pm; u.pn = pn; u.aux = e; u.A = A; u.B = B + (size_t)e * estep + (size_t)pn * bstep; return true; } };
struct MoeTailOrder { enum { VARK = 1, GATHER = 0 }; static constexpr int PPU = DFE / 128;
    int nN, G, c, T; int tb[NE + 1]; const char* A; const char* B; size_t astep, estep, bstep; int rev = 0;
    __device__ __forceinline__ bool next(int i, pg8::Unit& u) const {
        const int U = T * nN, R = U / G, Lf = U - R * G, x = c & 7, j = c >> 3, nj = (G - x + 7) >> 3;
        const int Lfx = Lf > x ? (Lf - x + 7) >> 3 : 0;
        long L; int k0 = 0, np = PPU, part = 0, k = 0, r = 0, C = 1;
        if (i < R) L = (long)i * G + c;
        else if (i == R && Lfx > 0) { const int cap = nj / Lfx; C = cap >= 8 ? 8 : cap >= 1 ? cap : 1;
            r = j / C; k = j - r * C; if (r >= Lfx) return false;
            L = (long)R * G + x + 8 * r; if (C > 1) { const int q = PPU / C, rem = PPU - q * C; np = q + (k < rem ? 1 : 0); k0 = k * q + (k < rem ? k : rem); part = 3; } }
        else return false;
        int pm, pn; pg8::tile_of((int)L, T, nN, pm, pn); if (rev) pm = T - 1 - pm;
        int e = 0;
#pragma unroll
        for (int q = 1; q < NE; ++q) e += (pm >= tb[q]) ? 1 : 0;
        u.pm = pm; u.pn = pn; u.aux = e | (part << 4) | (k << 8) | (C << 16) | (r << 24); u.nt = 2 * np;
        u.A = A + (size_t)pm * astep + (size_t)k0 * 65536; u.B = B + (size_t)e * estep + (size_t)pn * bstep + (size_t)k0 * 65536; return true; } };
__device__ __forceinline__ void phase_moe_up(const Frame& F, ArgsP kargs) {
    if (PH(12)) { MoeUpOrder S; LAS int* pre = (LAS int*)(F.lds + RING_BYTES + 64); moe_tiles(F, kargs, S.tb, pre);
        FRESH(a); unsigned char* ws = a->ws; S.nN = 2 * DFE / 256; S.G = F.G; S.c = F.bid; S.T = S.tb[NE];
        S.A = (const char*)(ws + WS_XB); S.B = (const char*)(ws + WS_WFFN); S.estep = (size_t)2 * DFE * D * 2; S.bstep = (size_t)256 * D * 2;
        { LAS int* tokL = (LAS int*)(F.lds + RING_BYTES + 1024); S.tokL = tokL; const int* TOKOF = (const int*)(ws + WS_TOKOF);
          int tid_ = threadIdx.x; asm volatile("" : "+v"(tid_)); const int half_ = __builtin_amdgcn_readfirstlane(tid_ >> 8); int tkv[8];
#pragma unroll
          for (int j = 0; j < 8; ++j) { pg8::Unit u; const bool ok = S.next(2 * j + half_, u); tkv[j] = ok ? TOKOF[u.pm * 256 + (tid_ & 255)] : 0; }
#pragma unroll
          for (int j = 0; j < 8; ++j) tokL[(2 * j + half_) * 256 + (tid_ & 255)] = tkv[j];
          __syncthreads(); }
        pg8::EpiSwiGLU E{(const float*)(ws + WS_SLOTR), (bf16*)(ws + WS_HG), DFE, 0}; pg8::gemm_phase(F.lds, D, D, D, S, E); }
}
__device__ __forceinline__ void phase_moe_down(const Frame& F, ArgsP kargs, int j2) {
    if (PH(13)) { MoeTailOrder S; LAS int* pre = (LAS int*)(F.lds + RING_BYTES + 64); moe_tiles(F, kargs, S.tb, pre);
        FRESH(a); unsigned char* ws = a->ws; S.nN = 4; S.G = F.G; S.c = F.bid; S.T = S.tb[NE]; S.rev = 1;
        S.A = (const char*)(ws + WS_HG); S.B = (const char*)(ws + WS_W2M); S.astep = (size_t)256 * DFE * 2; S.estep = (size_t)D * DFE * 2; S.bstep = (size_t)256 * DFE * 2;
        pg8::EpiBf16KS E{(bf16*)(ws + WS_OUTG), D, (float*)(ws + WS_SKPART), (unsigned*)(ws + WS_CTL) + CW_SK + j2 * 512, F.bid}; pg8::gemm_phase(F.lds, 0, DFE, DFE, S, E); }
}
__device__ __forceinline__ void phase_moe_combine(const Frame& F, ArgsP kargs, bool last) {
    LOCAL_IDS; FRESH(a); unsigned char* ws = a->ws; float* OUT = a->out; const bf16* OUTG = (const bf16*)(ws + WS_OUTG); const int* POS = (const int*)(ws + WS_POS); const float* TOPW = (const float*)(ws + WS_TOPW);
    bf16* XB = (bf16*)(ws + WS_XB); float* RX = (float*)(ws + WS_RX); const float* g_final = a->g_final;
    int s0n, s1n; float w0n, w1n, w0c, w1c; u32x2 pn0[4], pn1[4], xn[4];
    { const int s0 = POS[(size_t)gw * 2], s1 = POS[(size_t)gw * 2 + 1]; w0c = TOPW[(size_t)gw * 2]; w1c = TOPW[(size_t)gw * 2 + 1];
      const int m1 = gw + F.NGW < M ? gw + F.NGW : gw; s0n = POS[(size_t)m1 * 2]; s1n = POS[(size_t)m1 * 2 + 1]; w0n = TOPW[(size_t)m1 * 2]; w1n = TOPW[(size_t)m1 * 2 + 1];
#pragma unroll
      for (int j = 0; j < 4; ++j) { pn0[j] = ((const u32x2*)(OUTG + (size_t)s0 * D) + lane)[64 * j]; pn1[j] = ((const u32x2*)(OUTG + (size_t)s1 * D) + lane)[64 * j]; xn[j] = ((const u32x2*)(XB + (size_t)gw * D) + lane)[64 * j]; } }
#pragma unroll 1
    for (int m = gw; m < M; m += F.NGW) {
        const float w0 = w0c, w1 = w1c; u32x2 p0c[4], p1c[4], xc[4];
#pragma unroll
        for (int j = 0; j < 4; ++j) { p0c[j] = pn0[j]; p1c[j] = pn1[j]; xc[j] = xn[j]; }
        { const int mn = m + F.NGW < M ? m + F.NGW : m, mnn = m + 2 * F.NGW < M ? m + 2 * F.NGW : m; const int s0 = s0n, s1 = s1n; w0c = w0n; w1c = w1n;
#pragma unroll
          for (int j = 0; j < 4; ++j) { pn0[j] = ((const u32x2*)(OUTG + (size_t)s0 * D) + lane)[64 * j]; pn1[j] = ((const u32x2*)(OUTG + (size_t)s1 * D) + lane)[64 * j]; xn[j] = ((const u32x2*)(XB + (size_t)mn * D) + lane)[64 * j]; }
          s0n = POS[(size_t)mnn * 2]; s1n = POS[(size_t)mnn * 2 + 1]; w0n = TOPW[(size_t)mnn * 2]; w1n = TOPW[(size_t)mnn * 2 + 1]; }
        f32x4 v[4]; float s = 0.f;
#pragma unroll
        for (int j = 0; j < 4; ++j) { const u32x2 p0 = p0c[j], p1 = p1c[j];
            const f32x4 o0 = {bflo(p0.x), bfhi(p0.x), bflo(p0.y), bfhi(p0.y)}, o1 = {bflo(p1.x), bfhi(p1.x), bflo(p1.y), bfhi(p1.y)};
            const f32x4 xf = {bflo(xc[j].x), bfhi(xc[j].x), bflo(xc[j].y), bfhi(xc[j].y)}; v[j] = xf + w0 * o0 + w1 * o1; s += sumsq4(v[j]); }
        const float r = __builtin_amdgcn_rsqf(wave_sum(s) * (1.f / D) + EPS);
        if (last) {
#pragma unroll
            for (int j = 0; j < 4; ++j) ((f32x4*)(OUT + (size_t)m * D) + lane)[64 * j] = v[j] * r * ((const f32x4*)g_final + lane)[64 * j];
        } else {
#pragma unroll
            for (int j = 0; j < 4; ++j) ((u32x2*)(XB + (size_t)m * D) + lane)[64 * j] = (u32x2){cvt_pk_bf16(v[j][0], v[j][1]), cvt_pk_bf16(v[j][2], v[j][3])};
            if (lane == 0) RX[m] = r;
        }
    }
}


#ifdef DBG_ENABLE
__device__ __forceinline__ float dbg_b(const unsigned char* ws, size_t off, size_t idx) { return bf2f(((const bf16*)(ws + off))[idx]); }
__device__ __forceinline__ void dbg_dump(const Frame& F, ArgsP kargs, int code) {
    LOCAL_IDS; FRESH(a); const unsigned char* ws = a->ws; float* out = a->out;
    unsigned tmo = ((const unsigned*)(ws + WS_CTL))[CW_BAR + XB_TMO];
    for (size_t i = (size_t)F.bid * 512 + tid; i < (size_t)M * D; i += (size_t)F.G * 512) { const size_t row = i >> 10, c = i & 1023; float v = 0.f;
        if (code == 1) v = dbg_b(ws, WS_CQ, row * 512 + (c & 511)) + dbg_b(ws, WS_CKV, row * 256 + (c & 255)) + dbg_b(ws, WS_U, row * 512 + (c & 511)) + dbg_b(ws, WS_VR, row * 512 + (c & 511)) + dbg_b(ws, WS_QX, row * 512 + (c & 511))
                         + dbg_b(ws, WS_GATE, row * 3072 + c) + dbg_b(ws, WS_GATE, row * 3072 + 1024 + c) + dbg_b(ws, WS_GATE, row * 3072 + 2048 + c) + dbg_b(ws, WS_KR, row * 32 + (c & 31));
        else if (code == 2) v = dbg_b(ws, WS_Q, row * 768 + (c % 768)) + dbg_b(ws, WS_KN, row * 512 + (c & 511)) + dbg_b(ws, WS_V, row * 512 + (c & 511)) + dbg_b(ws, WS_Y, row * 1536 + 512 + c);
        else if (code == 3) v = dbg_b(ws, WS_Y, row * 1536 + (c & 511));
        else if (code == 15) v = dbg_b(ws, WS_WINT, i % ((size_t)PPAD * D));
        else if (code == 13 || code == 14) v = dbg_b(ws, WS_GATE, row * 3072 + c) + dbg_b(ws, WS_GATE, row * 3072 + 1024 + c) + dbg_b(ws, WS_GATE, row * 3072 + 2048 + c);
        else if (code == 4) v = dbg_b(ws, WS_MIXB, row * 1024 + c);
        else if (code == 6) v = dbg_b(ws, WS_HFF, row * 2688 + c) + dbg_b(ws, WS_HFF, row * 2688 + 1024 + c) + dbg_b(ws, WS_HFF, row * 2688 + 1664 + c);
        else if (code == 9) { const int s0 = ((const int*)(ws + WS_POS))[row * 2], s1 = ((const int*)(ws + WS_POS))[row * 2 + 1]; v = dbg_b(ws, WS_XG, (size_t)s0 * 1024 + c) + 2.f * dbg_b(ws, WS_XG, (size_t)s1 * 1024 + c) + ((const float*)(ws + WS_TOPW))[row * 2] + (float)s0 * 1e-3f; }
        else if (code == 10) { const int s0 = ((const int*)(ws + WS_POS))[row * 2], s1 = ((const int*)(ws + WS_POS))[row * 2 + 1]; v = dbg_b(ws, WS_HG, (size_t)s0 * 3584 + c) + dbg_b(ws, WS_HG, (size_t)s1 * 3584 + 2560 + c) + dbg_b(ws, WS_HG, (size_t)s0 * 3584 + 1500 + c); }
        else if (code == 11) { const int s0 = ((const int*)(ws + WS_POS))[row * 2], s1 = ((const int*)(ws + WS_POS))[row * 2 + 1]; v = ((const float*)(ws + WS_OUTG))[(size_t)s0 * 1024 + c] + ((const float*)(ws + WS_OUTG))[(size_t)s1 * 1024 + c]; }
        else continue;
        if (tmo) v = __builtin_nanf("");
        out[i] = v; }
}
#define DBG(code) do { if (dbgc == (code)) { dbg_dump(F, kargs, code); return; } } while (0)
#else
#define DBG(code) do { } while (0)
#endif

__global__ void __launch_bounds__(NWAVES * 64, 2) fwd_kernel(Args args_by_value) {
    extern __shared__ __attribute__((aligned(16))) unsigned char lds_raw[];
    const ArgsP kargs = (ArgsP)__builtin_amdgcn_kernarg_segment_ptr();
    Frame F; F.lds = (LAS unsigned char*)lds_raw; F.G = gridDim.x; F.bid = blockIdx.x; F.NGW = F.G * NWAVES;
    for (int u = threadIdx.x; u < (LDS_BYTES - LDSCTL_OFF) / 4; u += NWAVES * 64) ((LAS unsigned*)(F.lds + LDSCTL_OFF))[u] = 0u;
    __syncthreads();
    volatile LAS unsigned* MISC = (volatile LAS unsigned*)(F.lds + MISC_OFF);
    XcdBarrier bar; { FRESH(a); bar = xcd_barrier_post((unsigned*)(a->ws + WS_CTL) + CW_BAR, MISC + 8); }
#define GRID_BAR() xcd_barrier(bar)

#ifdef ONLY_TEST
    ONLY_TEST; GRID_BAR(); return;
#endif
    const Frame F_ = F;
    int dbgc; { FRESH(a); dbgc = a->dbg; } (void)dbgc;
    phase_prologue(F, kargs); GRID_BAR();
#pragma unroll 1
    for (int l_ = 0; l_ < DEPTH; ++l_) {
        Frame F = F_; int l = l_; asm volatile("" : "+s"(F.G), "+s"(F.NGW), "+s"(F.bid), "+s"(l));
        const bool moe = (l & 1) != 0; const int j2 = l >> 1;
        if (l == 0) DBG(15);
#ifdef PROBE_INPROJ2
        { int reps = 2; asm volatile("" : "+s"(reps));
#pragma unroll 1
          for (int rep = 0; rep < reps; ++rep) { phase_inproj(F, kargs, l); GRID_BAR(); } }
#else
        phase_inproj(F, kargs, l); GRID_BAR(); if (l == 0) DBG(1); if (l == 0) DBG(14);
#endif
        phase_up(F, kargs, l); GRID_BAR(); if (l == 0) DBG(2);
        phase_attn(F, kargs, l); GRID_BAR(); if (l == 0) DBG(3); if (l == 0) DBG(13);
#ifdef PROBE_ATTN2
        phase_attn(F, kargs, l); GRID_BAR();
#endif
#ifdef PROBE_UP2
        phase_up(F, kargs, l); GRID_BAR();
#endif
        phase_branch(F, kargs); GRID_BAR(); if (l == 0) DBG(4);
#ifdef PROBE_RESID2
        { int reps = 2; asm volatile("" : "+s"(reps));
#pragma unroll 1
          for (int rep = reps - 1; rep >= 0; --rep) { phase_outproj(F, kargs, rep != 0); GRID_BAR(); } }
#else
        phase_outproj(F, kargs); GRID_BAR(); if (l == 0) DBG(5); if (l == 1) DBG(8);
#endif
        if (!moe) {
            phase_dense_conv(F, kargs, l, j2); GRID_BAR();
            phase_dense_up(F, kargs); GRID_BAR(); if (l == 0) DBG(6);
#ifdef PROBE_DENSE2
            phase_dense_up(F, kargs); GRID_BAR();
#endif
#ifdef PROBE_RESID2
            { int reps = 2; asm volatile("" : "+s"(reps));
#pragma unroll 1
              for (int rep = reps - 1; rep >= 0; --rep) { phase_dense_down(F, kargs, rep != 0); GRID_BAR(); } }
#else
            phase_dense_down(F, kargs); GRID_BAR(); if (l == 0) DBG(7);
#endif
        } else {
            phase_moe_route(F, kargs, l, j2); GRID_BAR();
            phase_moe_gather(F, kargs); GRID_BAR(); if (l == 1) DBG(9);
#ifdef PROBE_AUX2
            phase_moe_gather(F, kargs); GRID_BAR();
#endif
            phase_moe_up(F, kargs); GRID_BAR(); if (l == 1) DBG(10);
            phase_moe_down(F, kargs, j2); GRID_BAR(); if (l == 1) DBG(11);
#ifdef PROBE_MOE2
            phase_moe_up(F, kargs); GRID_BAR();
            phase_moe_down(F, kargs, j2); GRID_BAR();
#endif
            phase_moe_combine(F, kargs, l == DEPTH - 1);
            if (l != DEPTH - 1) GRID_BAR();
            if (l == 1) DBG(12);
        }
    }
}

extern "C" void kernel_launch(void* const* d_in, const int* in_sizes, int n_in, void* d_out, int out_size, void* d_ws, size_t ws_size, hipStream_t stream) {
    static int grid = 0;
    if (grid == 0) {
        if (n_in != 27 || in_sizes[0] != M * D || out_size != M * D || ws_size < WS_END) { fprintf(stderr, "kernel_launch: unexpected shapes (n_in %d, in0 %d, out %d, ws %zu)\n", n_in, n_in > 0 ? in_sizes[0] : -1, out_size, ws_size); grid = -1; return; }
        int dev = 0, cus = 0, per_cu = 0;
        if (hipGetDevice(&dev) != hipSuccess || hipDeviceGetAttribute(&cus, hipDeviceAttributeMultiprocessorCount, dev) != hipSuccess) { grid = -1; return; }
        if (hipFuncSetAttribute((const void*)fwd_kernel, hipFuncAttributeMaxDynamicSharedMemorySize, LDS_BYTES) != hipSuccess) { fprintf(stderr, "kernel_launch: hipFuncSetAttribute failed\n"); grid = -1; return; }
        if (hipOccupancyMaxActiveBlocksPerMultiprocessor(&per_cu, (const void*)fwd_kernel, NWAVES * 64, LDS_BYTES) != hipSuccess || per_cu < 1) { fprintf(stderr, "kernel_launch: occupancy query reports %d\n", per_cu); }
        (void)hipGetLastError();
        if (cus != 256) { fprintf(stderr, "kernel_launch: built for 256 CUs, device has %d\n", cus); grid = -1; return; }
        grid = 256;
    }
    if (grid < 0) return;
    if (hipMemsetAsync((char*)d_ws + WS_CTL, 0, CTL_ZERO_BYTES, stream) != hipSuccess) return;
    Args a{};
    a.x = (const float*)d_in[0]; a.mem = (const float*)d_in[1]; a.positions = (const int*)d_in[2]; a.g_mix = (const float*)d_in[3]; a.w_in = (const float*)d_in[4]; a.g_q = (const float*)d_in[5];
    a.g_kv = (const float*)d_in[6]; a.w_uq = (const float*)d_in[7]; a.w_uk = (const float*)d_in[8]; a.w_uv = (const float*)d_in[9]; a.g_sg = (const float*)d_in[10]; a.w_s = (const float*)d_in[11];
    a.b_s = (const float*)d_in[12]; a.g_mem = (const float*)d_in[13]; a.w_mkv = (const float*)d_in[14]; a.w_br = (const float*)d_in[15]; a.b_gate = (const float*)d_in[16]; a.w_out = (const float*)d_in[17];
    a.g_ffn = (const float*)d_in[18]; a.dense_w1 = (const float*)d_in[19]; a.dense_w3 = (const float*)d_in[20]; a.dense_w2 = (const float*)d_in[21]; a.w_router = (const float*)d_in[22];
    a.moe_w1 = (const float*)d_in[23]; a.moe_w3 = (const float*)d_in[24]; a.moe_w2 = (const float*)d_in[25]; a.g_final = (const float*)d_in[26];
    a.out = (float*)d_out; a.ws = (unsigned char*)d_ws;
#ifdef DBG_STOP
    a.dbg = DBG_STOP;
#endif
    hipLaunchKernelGGL(fwd_kernel, dim3(grid), dim3(NWAVES * 64), LDS_BYTES, stream, a);
    const hipError_t le = hipPeekAtLastError();
    if (le != hipSuccess) fprintf(stderr, "kernel_launch: launch failed: %s\n", hipGetErrorName(le));
}
```

```cpp
#include <hip/hip_runtime.h>
#include <cstdio>
#include <cstdint>

#ifndef PH_MASK
#define PH_MASK 0xffffffffu
#endif
#define PH(k) ((PH_MASK >> (k)) & 1u)
#define LAS __attribute__((address_space(3)))
#define GAS __attribute__((address_space(1)))
typedef unsigned short bf16;
typedef short bf16x8 __attribute__((ext_vector_type(8)));
typedef short s16x4 __attribute__((ext_vector_type(4)));
typedef float f32x4 __attribute__((ext_vector_type(4)));
typedef float f32x2 __attribute__((ext_vector_type(2)));
typedef float f32x16 __attribute__((ext_vector_type(16)));
typedef unsigned u32x4 __attribute__((ext_vector_type(4)));
typedef unsigned u32x2 __attribute__((ext_vector_type(2)));
typedef int i32x4 __attribute__((ext_vector_type(4)));

constexpr int M = 16384, D = 1024, DEPTH = 4, NMEM = 256;
constexpr int QRANK = 384, KVRANK = 256, NH = 8, QKD = 96, VD = 64;
constexpr int XH = 4, XD = 128, BW = 512;
constexpr int PTOT = 5280, PPAD = 5376, DFF = 2688, NE = 8, DFE = 3584;
constexpr float EPS = 1e-6f;
constexpr int MAXSLOT = 34816;
constexpr float LOG2E = 1.4426950408889634f;
constexpr float QSCALE = 0.10206207261596575f * LOG2E;
constexpr float XSCALE = 0.08838834764831845f * LOG2E;

constexpr size_t MiB = 1u << 20, KiB = 1u << 10;
constexpr size_t WS_CTL = 0, CTL_ZERO_BYTES = 128 * KiB;
constexpr size_t WS_ROPE = 2 * MiB;
constexpr size_t WS_XSTAT = 4 * MiB;
constexpr size_t WS_RX = 5 * MiB;
constexpr size_t WS_CQSTAT = 5 * MiB + 256 * KiB;
constexpr size_t WS_CKVSTAT = 5 * MiB + 768 * KiB;
constexpr size_t WS_VSTAT = 6 * MiB;
constexpr size_t WS_MEMB = 6 * MiB + 512 * KiB;
constexpr size_t WS_KVMEM = 7 * MiB;
constexpr size_t WS_TOPI = 9 * MiB;
constexpr size_t WS_TOPW = 9 * MiB + 256 * KiB;
constexpr size_t WS_LRANK = 9 * MiB + 512 * KiB;
constexpr size_t WS_POS = 9 * MiB + 768 * KiB;
constexpr size_t WS_BLKCNT = 10 * MiB;
constexpr size_t WS_SLOTR = 10 * MiB + 512 * KiB;
constexpr size_t WS_TOKOF = 10 * MiB + 768 * KiB;
constexpr size_t WS_WSB = 11 * MiB;
constexpr size_t WS_WMKVT = 12 * MiB;
constexpr size_t WS_WINT = 20 * MiB;
constexpr size_t WS_WUQT = 31 * MiB;
constexpr size_t WS_WUKVT = 32 * MiB;
constexpr size_t WS_WBRT = 33 * MiB;
constexpr size_t WS_WOUTT = 36 * MiB;
constexpr size_t WS_WFFN = 40 * MiB;
constexpr size_t WS_W2D = WS_WFFN + 11 * MiB;
constexpr size_t WS_W2M = WS_WFFN + 112 * MiB;
constexpr size_t WS_XB = 208 * MiB;
constexpr size_t WS_CQ = 240 * MiB;
constexpr size_t WS_CKV = 256 * MiB;
constexpr size_t WS_U = 264 * MiB;
constexpr size_t WS_VR = 280 * MiB;
constexpr size_t WS_QX = 296 * MiB;
constexpr size_t WS_GATE = 312 * MiB;
constexpr size_t WS_Q = 408 * MiB;
constexpr size_t WS_KN = 432 * MiB;
constexpr size_t WS_KR = 448 * MiB;
constexpr size_t WS_V = 450 * MiB;
constexpr size_t WS_Y = 466 * MiB;
constexpr size_t WS_MIX = 514 * MiB;
constexpr size_t WS_MIXB = 578 * MiB;
constexpr size_t WS_MIX1 = 610 * MiB;
constexpr size_t WS_HFF = 240 * MiB;
constexpr size_t WS_XG = 240 * MiB;
constexpr size_t WS_HG = 308 * MiB;
constexpr size_t WS_OUTG = 546 * MiB;
constexpr size_t WS_END = 682 * MiB;
constexpr int CW_TMO = 0, CW_CODE = 1, CW_CHK = 2, CW_BAR = 4096;
constexpr int CW_SK = 16384;
constexpr size_t WS_SKPART = 700 * MiB;
constexpr int CW_KMAX = 8192;

constexpr int RING_BYTES = 131072, LDSCTL_OFF = 159744, MISC_OFF = LDSCTL_OFF + 320, LDS_BYTES = 163840;
constexpr int NWAVES = 8;

#define RLX_AGENT __ATOMIC_RELAXED, __HIP_MEMORY_SCOPE_AGENT
#define LDS_WAIT() asm volatile("s_waitcnt lgkmcnt(0)" ::: "memory")
#define VM_WAIT() asm volatile("s_waitcnt vmcnt(0)" ::: "memory")
typedef __bf16 bf16x2_t __attribute__((ext_vector_type(2)));
__device__ __forceinline__ unsigned cvt_pk_bf16(float lo, float hi) { const f32x2 v = {lo, hi}; const bf16x2_t b = __builtin_convertvector(v, bf16x2_t); return __builtin_bit_cast(unsigned, b); }
__device__ __forceinline__ bf16 f2bf(float f) { return (bf16)(cvt_pk_bf16(f, 0.f) & 0xffffu); }
__device__ __forceinline__ float bf2f(bf16 v) { return __uint_as_float((unsigned)v << 16); }
__device__ __forceinline__ float bflo(unsigned w) { return __uint_as_float(w << 16); }
__device__ __forceinline__ float bfhi(unsigned w) { return __uint_as_float(w & 0xffff0000u); }
__device__ __forceinline__ float fast_exp2(float x) { return __builtin_amdgcn_exp2f(x); }
__device__ __forceinline__ float fast_rcp(float x) { return __builtin_amdgcn_rcpf(x); }
__device__ __forceinline__ float sigmoidf_(float z) { return fast_rcp(1.f + fast_exp2(-LOG2E * z)); }
__device__ __forceinline__ float gelu_tanh(float x) { const float t = x + 0.044715f * x * x * x; return x * fast_rcp(1.f + fast_exp2(-2.f * 0.7978845608028654f * LOG2E * t)); }
template <int CTRL> __device__ __forceinline__ float dppf(float v) { return __builtin_bit_cast(float, __builtin_amdgcn_update_dpp(0, __builtin_bit_cast(int, v), CTRL, 0xf, 0xf, true)); }
__device__ __forceinline__ float row_sum16(float v) { v += dppf<0xB1>(v); v += dppf<0x4E>(v); v += dppf<0x124>(v); v += dppf<0x128>(v); return v; }
__device__ __forceinline__ float row_max16(float v) { v = fmaxf(v, dppf<0xB1>(v)); v = fmaxf(v, dppf<0x4E>(v)); v = fmaxf(v, dppf<0x124>(v)); v = fmaxf(v, dppf<0x128>(v)); return v; }
__device__ __forceinline__ float xsum16(float v) { const auto r = __builtin_amdgcn_permlane16_swap(__float_as_uint(v), __float_as_uint(v), false, false); return __uint_as_float(r[0]) + __uint_as_float(r[1]); }
__device__ __forceinline__ float xsum32(float v) { const auto r = __builtin_amdgcn_permlane32_swap(__float_as_uint(v), __float_as_uint(v), false, false); return __uint_as_float(r[0]) + __uint_as_float(r[1]); }
__device__ __forceinline__ float wave_sum(float v) { return xsum32(xsum16(row_sum16(v))); }
__device__ __forceinline__ float sumsq4(f32x4 v) { return (v[0] * v[0] + v[1] * v[1]) + (v[2] * v[2] + v[3] * v[3]); }
__device__ __forceinline__ u32x2 pack8_u8(f32x4 a, f32x4 b) { unsigned w0 = 0, w1 = 0; a = a * 255.f; b = b * 255.f;
    w0 = __builtin_amdgcn_cvt_pk_u8_f32(a[0], 0, w0); w0 = __builtin_amdgcn_cvt_pk_u8_f32(a[1], 1, w0); w0 = __builtin_amdgcn_cvt_pk_u8_f32(a[2], 2, w0); w0 = __builtin_amdgcn_cvt_pk_u8_f32(a[3], 3, w0);
    w1 = __builtin_amdgcn_cvt_pk_u8_f32(b[0], 0, w1); w1 = __builtin_amdgcn_cvt_pk_u8_f32(b[1], 1, w1); w1 = __builtin_amdgcn_cvt_pk_u8_f32(b[2], 2, w1); w1 = __builtin_amdgcn_cvt_pk_u8_f32(b[3], 3, w1);
    return (u32x2){w0, w1}; }
__device__ __forceinline__ void unpack8_u8(u32x2 w, f32x4& a, f32x4& b) { constexpr float k = 1.f / 255.f;
    a = (f32x4){(float)(w.x & 255u), (float)((w.x >> 8) & 255u), (float)((w.x >> 16) & 255u), (float)(w.x >> 24)} * k;
    b = (f32x4){(float)(w.y & 255u), (float)((w.y >> 8) & 255u), (float)((w.y >> 16) & 255u), (float)(w.y >> 24)} * k; }
__device__ __forceinline__ u32x4 pack8(f32x4 a, f32x4 b) { u32x4 w; w.x = cvt_pk_bf16(a[0], a[1]); w.y = cvt_pk_bf16(a[2], a[3]); w.z = cvt_pk_bf16(b[0], b[1]); w.w = cvt_pk_bf16(b[2], b[3]); return w; }
__device__ __forceinline__ void unpack8(u32x4 w, f32x4& a, f32x4& b) { a = (f32x4){bflo(w.x), bfhi(w.x), bflo(w.y), bfhi(w.y)}; b = (f32x4){bflo(w.z), bfhi(w.z), bflo(w.w), bfhi(w.w)}; }

namespace pg8 {
constexpr int BM = 256, BK = 64, HALF = 128, HTB = HALF * BK * 2, STAGE_BYTES = 8 * HTB, NXCD = 8, WGM = 8;
__host__ __device__ __forceinline__ int lds_byte(int r, int c) { const int st = (r >> 4) * 2 + (c >> 5), rr = r & 15, cc = c & 31, ob = rr * 64 + cc * 2; return st * 1024 + (ob ^ (((ob >> 9) & 1) << 5)); }
__host__ __device__ __forceinline__ void stage_rc(int b, int& R, int& C) { const int st = b / 1024, sb = b % 1024, swz = sb ^ (((sb >> 9) & 1) << 5); R = (st >> 1) * 16 + swz / 64; C = (st & 1) * 32 + (swz % 64) / 2; }
__host__ __device__ __forceinline__ int perm32(int rho) { const int n = rho >> 4, i = rho & 15; return 8 * (i >> 2) + 4 * n + (i & 3); }

struct Unit { const char* A; const char* B; int pm, pn, aux, nt; };
typedef f32x4 Acc[2][2][4][2];

__device__ __forceinline__ void tile_of(int L, int nM, int nN, int& pm, int& pn) {
    const int nwg = nM * nN; int wgid = L;
    { const int q = nwg / NXCD, r = nwg % NXCD, xcd = wgid % NXCD, off = wgid / NXCD; wgid = (xcd < r ? xcd * (q + 1) : r * (q + 1) + (xcd - r) * q) + off; }
    const int nig = WGM * nN, gid = wgid / nig, fm = gid * WGM, gsz = (nM - fm) < WGM ? (nM - fm) : WGM;
    pm = fm + ((wgid % nig) % gsz); pn = (wgid % nig) / gsz;
}
struct TileOrder {
    enum { VARK = 0, GATHER = 0 };
    int nM, nN, G, c; const char* A; const char* B; size_t astep, bstep;
    int rev = 0;
    __device__ __forceinline__ bool next(int i, Unit& u) const {
        if (rev) { const int cnt = (nM * nN - c + G - 1) / G; if (i >= cnt) return false; i = cnt - 1 - i; }
        const long L = (long)i * G + c; if (L >= (long)nM * nN) return false;
        int pm, pn; tile_of((int)L, nM, nN, pm, pn);
        u.pm = pm; u.pn = pn; u.aux = 0; u.A = A + (size_t)pm * astep; u.B = B + (size_t)pn * bstep; return true;
    }
};

template <class Epi, class Sched>
__device__ __forceinline__ void gemm_phase(LAS unsigned char* lds, const int lda, const int ldb, const int K, const Sched& S, const Epi& E) {
    int tid_ = threadIdx.x; asm volatile("" : "+v"(tid_));
    const int tid = tid_, wid = __builtin_amdgcn_readfirstlane(tid >> 6), lane = tid & 63, wr = wid >> 2, wc = wid & 3, fr = lane & 15, fq = lane >> 4;
    int nt = K / BK;
    unsigned voffA[2], voffB[2];
#pragma unroll
    for (int i = 0; i < 2; ++i) { int R, C; stage_rc(tid * 16 + i * 8192, R, C); const int Rb = (R & ~31) + perm32(R & 31);
        voffA[i] = (unsigned)(R * (lda ? lda : BK) + C) * 2u; voffB[i] = (unsigned)(Rb * BK + C) * 2u; }
    const size_t kstep = lda ? (size_t)(BK * 2) : (size_t)BM * BK * 2;
    const size_t hstepA = (size_t)HALF * (lda ? lda : BK) * 2, hstepB = (size_t)HALF * BK * 2, kstepB = (size_t)BM * BK * 2; (void)ldb;
    const unsigned ldsw = (unsigned)wid * 1024u;
    const int aoff = lds_byte(wr * 64 + fr, fq * 8), boff = lds_byte(wc * 32 + fr, fq * 8);
#define PG8_SA(b, h) (((b) * 2 + (h)) * HTB)
#define PG8_SB(b, h) ((4 + (b) * 2 + (h)) * HTB)
#define PG8_STAGE(bufoff, gbase, voff) do { _Pragma("unroll") for (int _i = 0; _i < 2; ++_i) \
        __builtin_amdgcn_global_load_lds((const unsigned*)((const char*)(gbase) + (voff)[_i]), (LAS unsigned*)(lds + (bufoff) + ldsw + _i * 8192), 16, 0, 0); } while (0)
#define PG8_STA(b, h, kptr, VG) do { if constexpr (Sched::GATHER) PG8_STAGE(PG8_SA(b, h), (kptr), VG[h]); else PG8_STAGE(PG8_SA(b, h), (kptr) + (h) * hstepA, voffA); } while (0)
#define PG8_GLOOKUP(VG, ui_) do { _Pragma("unroll") for (int _h = 0; _h < 2; ++_h) _Pragma("unroll") for (int _i = 0; _i < 2; ++_i) { int R_, C_; stage_rc(tid * 16 + _i * 8192, R_, C_); \
        VG[_h][_i] = (unsigned)S.tokL[(ui_) * 256 + _h * 128 + R_] * (unsigned)(lda * 2) + (unsigned)(C_ * 2); } } while (0)
#define PG8_LDA(dst, b, h) do { _Pragma("unroll") for (int m = 0; m < 4; ++m) _Pragma("unroll") for (int k = 0; k < 2; ++k) dst[m][k] = *(const LAS bf16x8*)(lds + PG8_SA(b, h) + aoff + m * 2048 + k * 1024); } while (0)
#define PG8_LDB(dst, b, h) do { _Pragma("unroll") for (int n = 0; n < 2; ++n) _Pragma("unroll") for (int k = 0; k < 2; ++k) dst[n][k] = *(const LAS bf16x8*)(lds + PG8_SB(b, h) + boff + n * 2048 + k * 1024); } while (0)
#define PG8_MMA(ai, bj, At, Bt) do { __builtin_amdgcn_s_setprio(1); _Pragma("unroll") for (int m = 0; m < 4; ++m) _Pragma("unroll") for (int n = 0; n < 2; ++n) _Pragma("unroll") for (int k = 0; k < 2; ++k) \
        acc[ai][bj][m][n] = __builtin_amdgcn_mfma_f32_16x16x32_bf16(Bt[n][k], At[m][k], acc[ai][bj][m][n], 0, 0, 0); __builtin_amdgcn_s_setprio(0); } while (0)
#define PG8_WAIT_V(n) asm volatile("s_waitcnt vmcnt(" #n ")" ::: "memory")
#define PG8_WAIT_L(n) asm volatile("s_waitcnt lgkmcnt(" #n ")" ::: "memory")
#define PG8_BAR __builtin_amdgcn_s_barrier()
#define PG8_SCHED __builtin_amdgcn_sched_barrier(0)
    Unit cur, nxt; int ui = 0;
    if (!S.next(0, cur)) return;
    if constexpr (Sched::VARK) nt = cur.nt;
    typename Epi::Pre pre = E.prefetch(cur, wr, fr);
    Acc acc;
#pragma unroll
    for (int a = 0; a < 2; ++a)
#pragma unroll
        for (int b = 0; b < 2; ++b)
#pragma unroll
            for (int m = 0; m < 4; ++m)
#pragma unroll
                for (int n = 0; n < 2; ++n) acc[a][b][m][n] = (f32x4){0.f, 0.f, 0.f, 0.f};
    bf16x8 At[4][2], B0[2][2], B1[2][2];
    const char* cA = cur.A; const char* cB = cur.B;
    unsigned vg[2][2] = {{0u, 0u}, {0u, 0u}}; if constexpr (Sched::GATHER) PG8_GLOOKUP(vg, 0);
    PG8_STAGE(PG8_SB(0, 0), cB, voffB); PG8_STAGE(PG8_SB(0, 1), cB + hstepB, voffB); PG8_STA(0, 0, cA, vg); PG8_STA(0, 1, cA, vg);
    if (wr == 1) PG8_BAR;
    PG8_WAIT_V(2); PG8_BAR;
    PG8_STAGE(PG8_SB(1, 0), cB + kstepB, voffB); PG8_STA(1, 0, cA + kstep, vg); PG8_STAGE(PG8_SB(1, 1), cB + hstepB + kstepB, voffB);
    PG8_WAIT_V(6); PG8_BAR;
    for (;;) {
        const bool has_next = S.next(ui + 1, nxt);
        const char* nA = has_next ? nxt.A : cA; const char* nB = has_next ? nxt.B : cB;
        for (int t = 0; t < nt; t += 2) {
            const bool last = (t == nt - 2);
            const char* a1 = cA + (size_t)(t + 1) * kstep;
            const char* a2 = last ? nA : cA + (size_t)(t + 2) * kstep; const char* b2 = last ? nB : cB + (size_t)(t + 2) * kstepB;
            const char* a3 = a2 + kstep; const char* b3 = b2 + kstepB;
            PG8_LDB(B0, 0, 0); PG8_LDB(B1, 0, 1); PG8_SCHED; PG8_LDA(At, 0, 0); PG8_STA(1, 1, a1, vg);
            if constexpr (Sched::GATHER) { if (last && has_next) PG8_GLOOKUP(vg, ui + 1); }
            PG8_WAIT_V(8); PG8_WAIT_L(0); PG8_BAR; PG8_MMA(0, 0, At, B0); PG8_MMA(0, 1, At, B1); PG8_BAR; PG8_SCHED;
            PG8_LDA(At, 0, 1); PG8_STAGE(PG8_SB(0, 0), b2, voffB); PG8_STAGE(PG8_SB(0, 1), b2 + hstepB, voffB); PG8_STA(0, 0, a2, vg);
            PG8_WAIT_V(8); PG8_WAIT_L(0); PG8_BAR; PG8_MMA(1, 0, At, B0); PG8_MMA(1, 1, At, B1); PG8_BAR; PG8_SCHED;
            PG8_LDB(B0, 1, 0); PG8_LDB(B1, 1, 1); PG8_SCHED; PG8_LDA(At, 1, 0); PG8_STA(0, 1, a2, vg);
            PG8_WAIT_V(8); PG8_WAIT_L(0); PG8_BAR; PG8_MMA(0, 0, At, B0); PG8_MMA(0, 1, At, B1); PG8_BAR; PG8_SCHED;
            PG8_LDA(At, 1, 1); PG8_STAGE(PG8_SB(1, 0), b3, voffB); PG8_STAGE(PG8_SB(1, 1), b3 + hstepB, voffB); PG8_STA(1, 0, a3, vg);
            PG8_WAIT_V(8); PG8_WAIT_L(0); PG8_BAR; PG8_MMA(1, 0, At, B0); PG8_MMA(1, 1, At, B1); PG8_BAR; PG8_SCHED;
        }
        if (wr == 0) PG8_BAR;
        E(acc, cur, wr, wc, fr, fq, pre);
        if (!has_next) break;
        pre = E.prefetch(nxt, wr, fr);
        if constexpr (!Epi::KEEP_ACC)
#pragma unroll
        for (int a = 0; a < 2; ++a)
#pragma unroll
            for (int b = 0; b < 2; ++b)
#pragma unroll
                for (int m = 0; m < 4; ++m)
#pragma unroll
                    for (int n = 0; n < 2; ++n) acc[a][b][m][n] = (f32x4){0.f, 0.f, 0.f, 0.f};
        cur = nxt; cA = nA; cB = nB; ++ui;
        if constexpr (Sched::VARK) nt = cur.nt;
        if (wr == 1) PG8_BAR;
    }
    PG8_WAIT_V(0);
    PG8_BAR;
#undef PG8_SA
#undef PG8_SB
#undef PG8_STAGE
#undef PG8_LDA
#undef PG8_STA
#undef PG8_GLOOKUP
#undef PG8_LDB
#undef PG8_MMA
#undef PG8_WAIT_V
#undef PG8_WAIT_L
#undef PG8_BAR
#undef PG8_SCHED
}

#define EPI_FOR _Pragma("unroll") for (int ai = 0; ai < 2; ++ai) _Pragma("unroll") for (int m = 0; m < 4; ++m)
#define EPI_ROW (u.pm * BM + ai * HALF + wr * 64 + m * 16 + fr)
#define EPI_C8(bj) (u.pn * BM + (bj) * HALF + wc * 32 + 8 * fq)
#define EPI_LOAD_R(rr, ptr) float rr[2][4]; _Pragma("unroll") for (int ai = 0; ai < 2; ++ai) _Pragma("unroll") for (int m = 0; m < 4; ++m) rr[ai][m] = (ptr)[EPI_ROW]; asm volatile("" ::: "memory")

#define EPI_LOAD_RS(rr, xstat) float rr[2][4]; { f32x4 st_[2][4]; _Pragma("unroll") for (int ai = 0; ai < 2; ++ai) _Pragma("unroll") for (int m = 0; m < 4; ++m) st_[ai][m] = *(const f32x4*)((xstat) + (size_t)EPI_ROW * 16 + 4 * fq); \
    asm volatile("" ::: "memory"); _Pragma("unroll") for (int ai = 0; ai < 2; ++ai) _Pragma("unroll") for (int m = 0; m < 4; ++m) { float t_ = (st_[ai][m][0] + st_[ai][m][1]) + (st_[ai][m][2] + st_[ai][m][3]); \
        t_ = xsum32(xsum16(t_)); rr[ai][m] = __builtin_amdgcn_rsqf(t_ * (1.f / D) + EPS); } }
struct NoPre {};
#define EPI_NOPRE static constexpr bool KEEP_ACC = false; typedef NoPre Pre; __device__ __forceinline__ Pre prefetch(const Unit&, int, int) const { return Pre{}; }
struct RowPre { float r[2][4]; };
struct EpiInProj {
    unsigned char* ws; const float* bgate; int layer; int from_stats;
    static constexpr bool KEEP_ACC = false; typedef RowPre Pre;
    __device__ __forceinline__ Pre prefetch(const Unit& u, int wr, int fr) const { Pre p; const float* rx = (const float*)(ws + WS_RX);
#pragma unroll
        for (int ai = 0; ai < 2; ++ai)
#pragma unroll
            for (int m = 0; m < 4; ++m) p.r[ai][m] = from_stats ? 0.f : rx[EPI_ROW];
        return p; }
    __device__ __forceinline__ void operator()(const Acc& acc, const Unit& u, int wr, int wc, int fr, int fq, const Pre& pre) const {
        const float* rx = (const float*)(ws + WS_RX); const float* rope = (const float*)(ws + WS_ROPE);
        bf16* CQ = (bf16*)(ws + WS_CQ); bf16* KR = (bf16*)(ws + WS_KR); bf16* CKV = (bf16*)(ws + WS_CKV); bf16* U = (bf16*)(ws + WS_U); bf16* VR = (bf16*)(ws + WS_VR); bf16* QX = (bf16*)(ws + WS_QX); bf16* GATE = (bf16*)(ws + WS_GATE);
        float* cqstat = (float*)(ws + WS_CQSTAT); float* ckvstat = (float*)(ws + WS_CKVSTAT); float* vstat = (float*)(ws + WS_VSTAT); unsigned* kmax = (unsigned*)(ws + WS_CTL) + CW_KMAX + layer * 32;
        const int pn = u.pn;
        float rr[2][4];
        if (from_stats) { EPI_LOAD_RS(rs_, (const float*)(ws + WS_XSTAT));
#pragma unroll
            for (int ai = 0; ai < 2; ++ai)
#pragma unroll
                for (int m = 0; m < 4; ++m) rr[ai][m] = rs_[ai][m]; }
        else {
#pragma unroll
            for (int ai = 0; ai < 2; ++ai)
#pragma unroll
                for (int m = 0; m < 4; ++m) rr[ai][m] = pre.r[ai][m]; }
        if (pn < 2) {
            float krmax = 0.f;
            EPI_FOR { const int row = EPI_ROW;
                const float r = rr[ai][m]; float ss = 0.f;
#pragma unroll
                for (int bj = 0; bj < 2; ++bj) { const f32x4 v0 = acc[ai][bj][m][0] * r, v1 = acc[ai][bj][m][1] * r;
                    if (!(pn == 1 && bj == 1)) ss += sumsq4(v0) + sumsq4(v1);
                    *(u32x4*)(CQ + (size_t)row * 512 + pn * 256 + bj * HALF + wc * 32 + 8 * fq) = pack8(v0, v1);
                    if (pn == 1 && bj == 1 && wc == 0) {
                        const f32x4 c = *(const f32x4*)(rope + (size_t)row * 32 + 4 * fq), s = *(const f32x4*)(rope + (size_t)row * 32 + 16 + 4 * fq);
                        const f32x4 o0 = v0 * c - v1 * s, o1 = v0 * s + v1 * c;
                        *(u32x4*)(KR + (size_t)row * 32 + 8 * fq) = pack8(o0, o1);
                        float q2 = sumsq4(o0) + sumsq4(o1); q2 = xsum32(xsum16(q2)); krmax = fmaxf(krmax, q2); } }
                ss = xsum32(xsum16(ss));
                if (fq == 0) cqstat[(size_t)row * 8 + pn * 4 + wc] = ss;
            }
            if (pn == 1 && wc == 0) {
                krmax = row_max16(krmax);
                if ((fr | fq) == 0) atomicMax(kmax + 16, __float_as_uint(krmax)); }
        } else if (pn == 2) {
            EPI_FOR { const int row = EPI_ROW;
                const float r = rr[ai][m]; float ss = 0.f;
#pragma unroll
                for (int bj = 0; bj < 2; ++bj) { const f32x4 v0 = acc[ai][bj][m][0] * r, v1 = acc[ai][bj][m][1] * r; ss += sumsq4(v0) + sumsq4(v1);
                    *(u32x4*)(CKV + (size_t)row * 256 + bj * HALF + wc * 32 + 8 * fq) = pack8(v0, v1); }
                ss = xsum32(xsum16(ss));
                if (fq == 0) ckvstat[(size_t)row * 4 + wc] = ss;
            }
        } else if (pn < 7) {
            const bool isv = pn >= 5; bf16* dst = isv ? VR : U; const int t = isv ? pn - 5 : pn - 3;
            EPI_FOR { const int row = EPI_ROW;
                const float r = rr[ai][m]; float ss = 0.f;
#pragma unroll
                for (int bj = 0; bj < 2; ++bj) { f32x4 v0 = acc[ai][bj][m][0] * r, v1 = acc[ai][bj][m][1] * r;
#pragma unroll
                    for (int e = 0; e < 4; ++e) { v0[e] = gelu_tanh(v0[e]); v1[e] = gelu_tanh(v1[e]); }
                    ss += sumsq4(v0) + sumsq4(v1);
                    *(u32x4*)(dst + (size_t)row * 512 + t * 256 + bj * HALF + wc * 32 + 8 * fq) = pack8(v0, v1); }
                if (isv) { ss = xsum32(xsum16(ss)); if (fq == 0) vstat[(size_t)row * 8 + t * 4 + wc] = ss; }
            }
        } else if (pn < 9) {
            EPI_FOR { const int row = EPI_ROW;
                const float r = rr[ai][m];
#pragma unroll
                for (int bj = 0; bj < 2; ++bj) *(u32x4*)(QX + (size_t)row * 512 + (pn - 7) * 256 + bj * HALF + wc * 32 + 8 * fq) = pack8(acc[ai][bj][m][0] * r, acc[ai][bj][m][1] * r);
            }
        } else {
            const int gc0 = (pn - 9) * 256 + wc * 32 + 8 * fq;
            f32x4 bg[2][2];
#pragma unroll
            for (int bj = 0; bj < 2; ++bj) { bg[bj][0] = *(const f32x4*)(bgate + gc0 + bj * HALF); bg[bj][1] = *(const f32x4*)(bgate + gc0 + bj * HALF + 4); }
            EPI_FOR { const int row = EPI_ROW;
                const float r = rr[ai][m];
#pragma unroll
                for (int bj = 0; bj < 2; ++bj) { f32x4 v0 = acc[ai][bj][m][0] * r + bg[bj][0], v1 = acc[ai][bj][m][1] * r + bg[bj][1];
#pragma unroll
                    for (int e = 0; e < 4; ++e) { v0[e] = sigmoidf_(v0[e]); v1[e] = sigmoidf_(v1[e]); }
#ifdef DBG_CONSTGATE
                    v0 = acc[ai][bj][m][0] * r; v1 = acc[ai][bj][m][1] * r;
#endif
                    *(u32x2*)((unsigned char*)GATE + (size_t)row * 3072 + gc0 + bj * HALF) = pack8_u8(v0, v1); }
            }
        }
    }
};
struct EpiMemKV {
    bf16* KV;
    EPI_NOPRE
    __device__ __forceinline__ void operator()(const Acc& acc, const Unit& u, int wr, int wc, int fr, int fq, const Pre&) const {
        EPI_FOR { const int row = EPI_ROW;
#pragma unroll
            for (int bj = 0; bj < 2; ++bj) *(u32x4*)(KV + (size_t)u.aux * 256 * 1024 + (size_t)row * 1024 + EPI_C8(bj)) = pack8(acc[ai][bj][m][0], acc[ai][bj][m][1]);
        }
    }
};
struct EpiQ {
    const float* cqstat; const float* rope; bf16* Q;
    EPI_NOPRE
    __device__ __forceinline__ void operator()(const Acc& acc, const Unit& u, int wr, int wc, int fr, int fq, const Pre&) const {
        EPI_FOR { const int row = EPI_ROW;
            const f32x4 s0 = *(const f32x4*)(cqstat + (size_t)row * 8), s1 = *(const f32x4*)(cqstat + (size_t)row * 8 + 4);
            const float r = __builtin_amdgcn_rsqf(((s0[0] + s0[1]) + (s0[2] + s0[3]) + (s1[0] + s1[1]) + (s1[2] + s1[3])) * (1.f / QRANK) + EPS);
#pragma unroll
            for (int bj = 0; bj < 2; ++bj) { f32x4 v0 = acc[ai][bj][m][0] * r, v1 = acc[ai][bj][m][1] * r;
                if (((8 * u.pn + 4 * bj + wc) % 3) == 2) {
                    const f32x4 c = *(const f32x4*)(rope + (size_t)row * 32 + 4 * fq), s = *(const f32x4*)(rope + (size_t)row * 32 + 16 + 4 * fq);
                    const f32x4 o0 = v0 * c - v1 * s, o1 = v0 * s + v1 * c; v0 = o0; v1 = o1; }
                *(u32x4*)(Q + (size_t)row * 768 + EPI_C8(bj)) = pack8(v0, v1); }
        }
    }
};
struct EpiKV {
    const float* ckvstat; bf16* KN; bf16* V; unsigned* kmax;
    EPI_NOPRE
    __device__ __forceinline__ void operator()(const Acc& acc, const Unit& u, int wr, int wc, int fr, int fq, const Pre&) const {
        bf16* dst = u.pn < 2 ? KN : V; const int t = u.pn & 1; float hm[2] = {0.f, 0.f};
        EPI_FOR { const int row = EPI_ROW;
            const f32x4 s0 = *(const f32x4*)(ckvstat + (size_t)row * 4);
            const float r = __builtin_amdgcn_rsqf(((s0[0] + s0[1]) + (s0[2] + s0[3])) * (1.f / KVRANK) + EPS);
#pragma unroll
            for (int bj = 0; bj < 2; ++bj) { const f32x4 v0 = acc[ai][bj][m][0] * r, v1 = acc[ai][bj][m][1] * r;
                *(u32x4*)(dst + (size_t)row * 512 + t * 256 + bj * HALF + wc * 32 + 8 * fq) = pack8(v0, v1);
                float q2 = sumsq4(v0) + sumsq4(v1); q2 = xsum32(xsum16(q2)); hm[bj] = fmaxf(hm[bj], q2); }
        }
        if (u.pn < 2) {
#pragma unroll
            for (int bj = 0; bj < 2; ++bj) { float v = hm[bj];
                v = row_max16(v);
                if ((fr | fq) == 0) atomicMax(kmax + 2 * (4 * u.pn + 2 * bj + (wc >> 1)) + (wc & 1), __float_as_uint(v)); }
        }
    }
};
struct EpiBranch {
    const unsigned char* GATE; bf16* MIXB;
    static constexpr bool KEEP_ACC = true; typedef NoPre Pre; __device__ __forceinline__ Pre prefetch(const Unit&, int, int) const { return Pre{}; }
    __device__ __forceinline__ void operator()(Acc& acc, const Unit& u, int wr, int wc, int fr, int fq, const Pre&) const {
        const int n = u.aux;
#pragma unroll
        for (int ai = 0; ai < 2; ++ai) {
            u32x2 gw[4][2], gn[4][2];
#pragma unroll
            for (int m = 0; m < 4; ++m)
#pragma unroll
                for (int bj = 0; bj < 2; ++bj) { const unsigned char* gp = GATE + (size_t)EPI_ROW * 3072 + n * 1024 + EPI_C8(bj);
                    gw[m][bj] = *(const u32x2*)gp; if (n < 2) gn[m][bj] = *(const u32x2*)(gp + 1024); }
            asm volatile("" ::: "memory");
#pragma unroll
            for (int m = 0; m < 4; ++m)
#pragma unroll
                for (int bj = 0; bj < 2; ++bj) {
                    f32x4 g0, g1; unpack8_u8(gw[m][bj], g0, g1);
#pragma unroll
                    for (int e = 0; e < 4; ++e) { g0[e] = fmaxf(g0[e], 0.001953125f); g1[e] = fmaxf(g1[e], 0.001953125f); }
                    if (n < 2) { f32x4 h0, h1; unpack8_u8(gn[m][bj], h0, h1);
#pragma unroll
                        for (int e = 0; e < 4; ++e) { g0[e] *= fast_rcp(fmaxf(h0[e], 0.001953125f)); g1[e] *= fast_rcp(fmaxf(h1[e], 0.001953125f)); }
                        acc[ai][bj][m][0] *= g0; acc[ai][bj][m][1] *= g1; }
                    else *(u32x4*)(MIXB + (size_t)u.pm * 256 * 1024 + (size_t)(4 * u.pn + 2 * bj + (wc >> 1)) * 16384 + (ai * HALF + wr * 64 + m * 16 + fr) * 64 + (wc & 1) * 32 + 8 * fq) = pack8(acc[ai][bj][m][0] * g0, acc[ai][bj][m][1] * g1);
                }
        }
        if (n == 2) {
#pragma unroll
            for (int ai = 0; ai < 2; ++ai)
#pragma unroll
                for (int bj = 0; bj < 2; ++bj)
#pragma unroll
                    for (int m = 0; m < 4; ++m) { acc[ai][bj][m][0] = (f32x4){0.f, 0.f, 0.f, 0.f}; acc[ai][bj][m][1] = (f32x4){0.f, 0.f, 0.f, 0.f}; }
        }
    }
};
struct EpiResid {
    bf16* XB; float* xstat;
    EPI_NOPRE
    __device__ __forceinline__ void operator()(const Acc& acc, const Unit& u, int wr, int wc, int fr, int fq, const Pre&) const {
        u32x4 xv[2][4][2];
#pragma unroll
        for (int ai = 0; ai < 2; ++ai)
#pragma unroll
            for (int m = 0; m < 4; ++m)
#pragma unroll
                for (int bj = 0; bj < 2; ++bj) xv[ai][m][bj] = *(const u32x4*)(XB + (size_t)EPI_ROW * 1024 + EPI_C8(bj));
        asm volatile("" ::: "memory");
#pragma unroll
        for (int ai = 0; ai < 2; ++ai) {
#pragma unroll
            for (int m = 0; m < 4; ++m) { const int row = EPI_ROW; float ss = 0.f;
#pragma unroll
                for (int bj = 0; bj < 2; ++bj) { const int col = EPI_C8(bj); f32x4 x0, x1; unpack8(xv[ai][m][bj], x0, x1);
                    const f32x4 v0 = x0 + acc[ai][bj][m][0], v1 = x1 + acc[ai][bj][m][1];
                    ss += sumsq4(v0) + sumsq4(v1);
                    *(u32x4*)(XB + (size_t)row * 1024 + col) = pack8(v0, v1); }
                ss = xsum32(xsum16(ss));
                if (fq == 0) xstat[(size_t)row * 16 + u.pn * 4 + wc] = ss; }
        }
    }
};
struct EpiSwiGLU {
    const float* rs; bf16* Hh; int ldh; int from_stats;
    static constexpr bool KEEP_ACC = false; typedef RowPre Pre;
    __device__ __forceinline__ Pre prefetch(const Unit& u, int wr, int fr) const { Pre p;
#pragma unroll
        for (int ai = 0; ai < 2; ++ai)
#pragma unroll
            for (int m = 0; m < 4; ++m) p.r[ai][m] = from_stats ? 0.f : rs[EPI_ROW];
        return p; }
    __device__ __forceinline__ void operator()(const Acc& acc, const Unit& u, int wr, int wc, int fr, int fq, const Pre& pre) const {
        float rr[2][4];
        if (from_stats) { EPI_LOAD_RS(rs_, rs);
#pragma unroll
            for (int ai = 0; ai < 2; ++ai)
#pragma unroll
                for (int m = 0; m < 4; ++m) rr[ai][m] = rs_[ai][m]; }
        else {
#pragma unroll
            for (int ai = 0; ai < 2; ++ai)
#pragma unroll
                for (int m = 0; m < 4; ++m) rr[ai][m] = pre.r[ai][m]; }
        bf16* hbase = Hh + (size_t)u.pm * 256 * ldh + (size_t)(2 * u.pn + (wc >> 1)) * 16384 + (wr * 64 + fr) * 64 + (wc & 1) * 32 + 8 * fq;
        EPI_FOR { const int row = EPI_ROW;
            const float r = rr[ai][m];
            f32x4 a0 = acc[ai][0][m][0] * r, a1 = acc[ai][0][m][1] * r; const f32x4 b0 = acc[ai][1][m][0] * r, b1 = acc[ai][1][m][1] * r;
#pragma unroll
            for (int e = 0; e < 4; ++e) { a0[e] = a0[e] * sigmoidf_(a0[e]) * b0[e]; a1[e] = a1[e] * sigmoidf_(a1[e]) * b1[e]; }
            (void)row; *(u32x4*)(hbase + (ai * HALF + m * 16) * 64) = pack8(a0, a1);
        }
    }
};
struct EpiBf16 {
    bf16* C; int ldc;
    EPI_NOPRE
    __device__ __forceinline__ void operator()(const Acc& acc, const Unit& u, int wr, int wc, int fr, int fq, const Pre&) const {
        EPI_FOR { const int row = EPI_ROW;
#pragma unroll
            for (int bj = 0; bj < 2; ++bj) *(u32x4*)(C + (size_t)row * ldc + EPI_C8(bj)) = pack8(acc[ai][bj][m][0], acc[ai][bj][m][1]);
        }
    }
};
__device__ __forceinline__ void ks_reduce(const float* part, int x, int r, int k, int CC, int tid, bf16* C, int ldc, const Unit& u, int wr, int wc, int fr, int fq) {
    for (int sp = k; sp < 16; sp += CC) { const int ai = sp >> 3, bj = (sp >> 2) & 1, m = sp & 3;
        f32x4 s0 = {0.f, 0.f, 0.f, 0.f}, s1 = {0.f, 0.f, 0.f, 0.f};
        for (int kk0 = 0; kk0 < CC; kk0 += 4) {
            f32x4 v0[4], v1[4];
#pragma unroll
            for (int kk = 0; kk < 4; ++kk) { const bool ok = kk0 + kk < CC; const float* q = part + (size_t)(x + 8 * (r * CC + (ok ? kk0 + kk : 0))) * 65536 + tid * 4 + sp * 4096;
                v0[kk] = *(const f32x4*)q; v1[kk] = *(const f32x4*)(q + 2048); if (!ok) { v0[kk] = (f32x4){0.f, 0.f, 0.f, 0.f}; v1[kk] = (f32x4){0.f, 0.f, 0.f, 0.f}; } }
#pragma unroll
            for (int kk = 0; kk < 4; ++kk) { s0 += v0[kk]; s1 += v1[kk]; } }
        const int row = u.pm * BM + ai * HALF + wr * 64 + m * 16 + fr;
        *(u32x4*)(C + (size_t)row * ldc + u.pn * BM + bj * HALF + wc * 32 + 8 * fq) = pack8(s0, s1); }
}
struct EpiBf16KS {
    bf16* C; int ldc; float* part; unsigned* cnt; int c;
    EPI_NOPRE
    __device__ __forceinline__ void operator()(const Acc& acc, const Unit& u, int wr, int wc, int fr, int fq, const Pre&) const {
        if (((u.aux >> 4) & 3) != 0) {
            int tid_ = threadIdx.x; asm volatile("" : "+v"(tid_));
            const int k = (u.aux >> 8) & 255, CC = (u.aux >> 16) & 255, r = u.aux >> 24, x = c & 7;
            float* p = part + (size_t)c * 65536 + tid_ * 4;
#pragma unroll
            for (int ai = 0; ai < 2; ++ai)
#pragma unroll
                for (int bj = 0; bj < 2; ++bj)
#pragma unroll
                    for (int m = 0; m < 4; ++m)
#pragma unroll
                        for (int n = 0; n < 2; ++n) *(f32x4*)(p + (((ai * 2 + bj) * 4 + m) * 2 + n) * 2048) = acc[ai][bj][m][n];
            asm volatile("s_waitcnt vmcnt(0)" ::: "memory");
            __syncthreads();
            if (tid_ == 0) { unsigned* w = cnt + x + 8 * r; __hip_atomic_fetch_add(w, 1u, __ATOMIC_RELEASE, __HIP_MEMORY_SCOPE_AGENT);
                while (__hip_atomic_load(w, __ATOMIC_ACQUIRE, __HIP_MEMORY_SCOPE_AGENT) < (unsigned)CC) __builtin_amdgcn_s_sleep(2); }
            __syncthreads();
            ks_reduce(part, x, r, k, CC, tid_, C, ldc, u, wr, wc, fr, fq);
            return;
        }
        EPI_FOR { const int row = EPI_ROW;
#pragma unroll
            for (int bj = 0; bj < 2; ++bj) *(u32x4*)(C + (size_t)row * ldc + EPI_C8(bj)) = pack8(acc[ai][bj][m][0], acc[ai][bj][m][1]);
        }
    }
};
struct EpiF32 {
    float* C; int ldc;
    EPI_NOPRE
    __device__ __forceinline__ void operator()(const Acc& acc, const Unit& u, int wr, int wc, int fr, int fq, const Pre&) const {
        EPI_FOR { const int row = EPI_ROW;
#pragma unroll
            for (int bj = 0; bj < 2; ++bj) { float* cp = C + (size_t)row * ldc + EPI_C8(bj); *(f32x4*)cp = acc[ai][bj][m][0]; *(f32x4*)(cp + 4) = acc[ai][bj][m][1]; }
        }
    }
};
}

namespace att {
#define KSWZ(row, colB) ((row) * 256 + ((colB) ^ (((row) & 7) << 4)))
#define SBAR() __builtin_amdgcn_sched_barrier(0)
constexpr float THR = 8.f;
__device__ __forceinline__ int crow(int r, int hi) { return (r & 3) + 8 * (r >> 2) + 4 * hi; }
template <int NB> __device__ __forceinline__ int v_st(int k, int c) { const int kk = (k & ~0xC) | ((k & 4) << 1) | ((k & 8) >> 1); return ((kk >> 3) * NB + (c >> 5)) * 512 + ((kk & 7) * 32 + (c & 31)) * 2; }
__device__ __forceinline__ int v_rd_base(int lane) { return ((lane & 3) << 3) | (((lane >> 2) & 3) << 6) | (((lane >> 4) & 1) << 5) | (((lane >> 5) & 1) << 8); }
template <int OFF> __device__ __forceinline__ s16x4 tr_read(int vb) { s16x4 r; asm volatile("ds_read_b64_tr_b16 %0, %1 offset:%2" : "=&v"(r) : "v"(vb), "i"(OFF) : "memory"); return r; }

__device__ __forceinline__ void partialSM(f32x16& p0, f32x16& p1, float& m_reg, float& alpha) {
    float pmax = p0[0];
#pragma unroll
    for (int r = 1; r < 16; ++r) pmax = fmaxf(pmax, p0[r]);
#pragma unroll
    for (int r = 0; r < 16; ++r) pmax = fmaxf(pmax, p1[r]);
    { auto rr = __builtin_amdgcn_permlane32_swap(__float_as_uint(pmax), __float_as_uint(pmax), false, false); pmax = fmaxf(__uint_as_float(rr[0]), __uint_as_float(rr[1])); }
    float mn;
    if (__builtin_expect(__all(pmax - m_reg <= THR), 1)) { mn = m_reg; alpha = 1.f; }
    else { mn = fmaxf(m_reg, pmax); alpha = __builtin_amdgcn_exp2f(m_reg - mn); m_reg = mn; }
#pragma unroll
    for (int r = 0; r < 16; ++r) { p0[r] -= mn; p1[r] -= mn; }
#pragma unroll
    for (int r = 0; r < 16; ++r) p0[r] = __builtin_amdgcn_exp2f(p0[r]);
}
__device__ __forceinline__ void finishSM(f32x16& p0, f32x16& p1, float alpha, float& l_reg, bf16x8& pa0, bf16x8& pa1, bf16x8& pa2, bf16x8& pa3) {
#pragma unroll
    for (int r = 0; r < 16; ++r) p1[r] = __builtin_amdgcn_exp2f(p1[r]);
    float ps = 0;
#pragma unroll
    for (int r = 0; r < 16; ++r) ps += p0[r];
#pragma unroll
    for (int r = 0; r < 16; ++r) ps += p1[r];
    { auto rr = __builtin_amdgcn_permlane32_swap(__float_as_uint(ps), __float_as_uint(ps), false, false); ps = __uint_as_float(rr[0]) + __uint_as_float(rr[1]); }
    l_reg = l_reg * alpha + ps;
#define PK4(P, BASE, OUT) do { unsigned a0 = cvt_pk_bf16(P[BASE + 0], P[BASE + 1]), a1 = cvt_pk_bf16(P[BASE + 2], P[BASE + 3]);   \
    unsigned b0 = cvt_pk_bf16(P[BASE + 4], P[BASE + 5]), b1 = cvt_pk_bf16(P[BASE + 6], P[BASE + 7]);                              \
    auto r0 = __builtin_amdgcn_permlane32_swap(a0, b0, false, false); auto r1 = __builtin_amdgcn_permlane32_swap(a1, b1, false, false); \
    u32x4 w = {r0[0], r1[0], r0[1], r1[1]}; OUT = __builtin_bit_cast(bf16x8, w); } while (0)
    PK4(p0, 0, pa0); PK4(p0, 8, pa1); PK4(p1, 0, pa2); PK4(p1, 8, pa3);
#undef PK4
}
template <int ND0> __device__ __forceinline__ void qkt(f32x16& p0, f32x16& p1, const LAS char* Ks, const bf16x8* qr, int r32, int hi, const f32x16& init) {
#pragma unroll
    for (int d0 = 0; d0 < ND0; ++d0) { const int cb = (d0 * 16 + hi * 8) * 2;
        const bf16x8 b0 = *(const LAS bf16x8*)(Ks + KSWZ(r32, cb));
        const bf16x8 b1 = *(const LAS bf16x8*)(Ks + KSWZ(32 + r32, cb));
        p0 = __builtin_amdgcn_mfma_f32_32x32x16_bf16(b0, qr[d0], d0 == 0 ? init : p0, 0, 0, 0);
        p1 = __builtin_amdgcn_mfma_f32_32x32x16_bf16(b1, qr[d0], d0 == 0 ? init : p1, 0, 0, 0); }
}
__device__ __forceinline__ void expA(f32x16& p0) {
#pragma unroll
    for (int r = 0; r < 16; ++r) p0[r] = __builtin_amdgcn_exp2f(p0[r]);
}
template <int NB, int D0> __device__ __forceinline__ void pv_one(f32x16& od, int vb, bf16x8 pa0, bf16x8 pa1, bf16x8 pa2, bf16x8 pa3) {
    const s16x4 l0 = tr_read<(0 * NB + D0) * 512>(vb), h0 = tr_read<(1 * NB + D0) * 512>(vb), l1 = tr_read<(2 * NB + D0) * 512>(vb), h1 = tr_read<(3 * NB + D0) * 512>(vb);
    const s16x4 l2 = tr_read<(4 * NB + D0) * 512>(vb), h2 = tr_read<(5 * NB + D0) * 512>(vb), l3 = tr_read<(6 * NB + D0) * 512>(vb), h3 = tr_read<(7 * NB + D0) * 512>(vb);
    asm volatile("s_waitcnt lgkmcnt(0)" ::: "memory"); SBAR();
#define PK(L, H) (bf16x8){L[0], L[1], L[2], L[3], H[0], H[1], H[2], H[3]}
    od = __builtin_amdgcn_mfma_f32_32x32x16_bf16(pa0, PK(l0, h0), od, 0, 0, 0);
    od = __builtin_amdgcn_mfma_f32_32x32x16_bf16(pa1, PK(l1, h1), od, 0, 0, 0);
    od = __builtin_amdgcn_mfma_f32_32x32x16_bf16(pa2, PK(l2, h2), od, 0, 0, 0);
    od = __builtin_amdgcn_mfma_f32_32x32x16_bf16(pa3, PK(l3, h3), od, 0, 0, 0);
#undef PK
}
template <int NB> __device__ __forceinline__ void pv_all(f32x16* o, int vb, bf16x8 pa0, bf16x8 pa1, bf16x8 pa2, bf16x8 pa3) {
    pv_one<NB, 0>(o[0], vb, pa0, pa1, pa2, pa3); pv_one<NB, 1>(o[1], vb, pa0, pa1, pa2, pa3);
    if constexpr (NB == 4) { pv_one<NB, 2>(o[2], vb, pa0, pa1, pa2, pa3); pv_one<NB, 3>(o[3], vb, pa0, pa1, pa2, pa3); }
}

template <int DQK, int D1, int DVV, bool FIXM>
__device__ __forceinline__ void attn_unit(const bf16* __restrict__ Qb, int ldq, const bf16* __restrict__ K1, int ldk1, const bf16* __restrict__ K2, int ldk2,
                                          const bf16* __restrict__ Vh, int ldv, bf16* __restrict__ Ob, int ldo, int seq, LAS char* lds, float kbound) {
    constexpr int ND0 = DQK / 16, NB = DVV / 32, CK = DQK / 8, CV = DVV / 8;
    constexpr int NKL = (64 * CK + 511) / 512, NVL = (64 * CV) / 512;
    constexpr int SHM_V = 64 * DVV * 2, SHM_K = 64 * 256;
    int tid_ = threadIdx.x; asm volatile("" : "+v"(tid_));
    const int tid = tid_, wid = tid >> 6, lane = tid & 63, r32 = lane & 31, hi = lane >> 5;
    LAS char* V_lds = lds; LAS char* K_lds = lds + 2 * SHM_V;
    LAS float* ws = (LAS float*)(lds + 2 * SHM_V + 2 * SHM_K) + wid * 64; LAS float* li_l = ws; LAS float* al_l = ws + 32;
    float m_reg = -1e30f, l_reg = 0; f32x16 o[NB]; bf16x8 qr[ND0];
#pragma unroll
    for (int d = 0; d < NB; ++d) o[d] = f32x16{};
    const bf16* Qw = Qb + (long)(wid * 32 + r32) * ldq + hi * 8;
#pragma unroll
    for (int d0 = 0; d0 < ND0; ++d0) qr[d0] = *(const bf16x8*)(Qw + d0 * 16);
    f32x16 init = f32x16{};
    if constexpr (FIXM) {
        float q2 = 0.f;
#pragma unroll
        for (int d0 = 0; d0 < ND0; ++d0) { const u32x4 w = __builtin_bit_cast(u32x4, qr[d0]); f32x4 a, b; unpack8(w, a, b); q2 += sumsq4(a) + sumsq4(b); }
        { auto rr = __builtin_amdgcn_permlane32_swap(__float_as_uint(q2), __float_as_uint(q2), false, false); q2 = __uint_as_float(rr[0]) + __uint_as_float(rr[1]); }
        const float nm = -sqrtf(q2) * kbound;
#pragma unroll
        for (int r = 0; r < 16; ++r) init[r] = nm;
        asm volatile("" : "+v"(init));
    }
    const bf16* kp[NKL]; int kstr[NKL], kdst[NKL]; bool kval[NKL];
#pragma unroll
    for (int i = 0; i < NKL; ++i) { const int c = tid + 512 * i; kval[i] = c < 64 * CK; const int cc_ = kval[i] ? c : 0; const int row = cc_ / CK, cc = cc_ % CK;
        if (cc * 8 < D1) { kp[i] = K1 + (long)row * ldk1 + cc * 8; kstr[i] = 64 * ldk1; } else { kp[i] = K2 + (long)row * ldk2 + (cc * 8 - D1); kstr[i] = 64 * ldk2; }
        kdst[i] = KSWZ(row, cc * 16); }
    const bf16* vp[NVL]; int vdst[NVL]; const int vstr = 64 * ldv;
#pragma unroll
    for (int i = 0; i < NVL; ++i) { const int c = tid + 512 * i; const int row = c / CV, cc = c % CV; vp[i] = Vh + (long)row * ldv + cc * 8; vdst[i] = v_st<NB>(row, cc * 8); }
    const int vb0 = (int)(uintptr_t)V_lds + v_rd_base(lane);
    struct { bf16x8 ks[NKL]; bf16x8 vs[NVL]; } sr_[2];
#define SLOAD(i, t) do { _Pragma("unroll") for (int q_ = 0; q_ < NVL; ++q_) sr_[i].vs[q_] = *(const bf16x8*)(vp[q_] + (long)(t) * vstr); \
    _Pragma("unroll") for (int q_ = 0; q_ < NKL; ++q_) { if (kval[q_]) sr_[i].ks[q_] = *(const bf16x8*)(kp[q_] + (long)(t) * kstr[q_]); } } while (0)
#define SWRITE(b, i) do { _Pragma("unroll") for (int q_ = 0; q_ < NVL; ++q_) *(LAS bf16x8*)(V_lds + (b) * SHM_V + vdst[q_]) = sr_[i].vs[q_]; \
    _Pragma("unroll") for (int q_ = 0; q_ < NKL; ++q_) { if (kval[q_]) *(LAS bf16x8*)(K_lds + (b) * SHM_K + kdst[q_]) = sr_[i].ks[q_]; } } while (0)
#define SWAIT() asm volatile("s_waitcnt vmcnt(%0)" :: "n"(NKL + NVL) : "memory")
#define RESC(a) do { if (__any((a) < 1.f)) { if (hi == 0) al_l[r32] = (a); asm volatile("s_waitcnt lgkmcnt(0)" ::: "memory"); \
    _Pragma("unroll") for (int d = 0; d < NB; ++d) _Pragma("unroll") for (int r = 0; r < 16; ++r) o[d][r] *= al_l[crow(r, hi)]; } } while (0)
    f32x16 pA0, pA1, pB0, pB1; float alA = 1.f, alB = 1.f; bf16x8 pa0, pa1, pa2, pa3; const int NT = seq / 64;
#define PSM(P0, P1, AL) do { if constexpr (FIXM) expA(P0); else partialSM(P0, P1, m_reg, AL); } while (0)
#define RSC(AL) do { if constexpr (!FIXM) RESC(AL); } while (0)
    SLOAD(0, 0); asm volatile("s_waitcnt vmcnt(0)" ::: "memory"); SWRITE(0, 0); __syncthreads();
    qkt<ND0>(pA0, pA1, K_lds, qr, r32, hi, init); PSM(pA0, pA1, alA);
    SLOAD(1, 1); if (2 < NT) SLOAD(0, 2);
    SWAIT(); SWRITE(1, 1); __syncthreads();
    for (int j = 1; j + 1 < NT; j += 2) {
        SBAR(); qkt<ND0>(pB0, pB1, K_lds + SHM_K, qr, r32, hi, init);
        finishSM(pA0, pA1, alA, l_reg, pa0, pa1, pa2, pa3); SBAR();
        SLOAD(1, j + 2); SBAR();
        pv_all<NB>(o, vb0, pa0, pa1, pa2, pa3); PSM(pB0, pB1, alB);
        __syncthreads(); SWAIT(); SWRITE(0, 0);
        RSC(alB); __syncthreads();
        SBAR(); qkt<ND0>(pA0, pA1, K_lds, qr, r32, hi, init);
        finishSM(pB0, pB1, alB, l_reg, pa0, pa1, pa2, pa3); SBAR();
        if (j + 3 < NT) SLOAD(0, j + 3); SBAR();
        pv_all<NB>(o, vb0 + SHM_V, pa0, pa1, pa2, pa3); PSM(pA0, pA1, alA);
        __syncthreads(); SWAIT(); SWRITE(1, 1);
        RSC(alA); __syncthreads();
    }
    SBAR(); qkt<ND0>(pB0, pB1, K_lds + SHM_K, qr, r32, hi, init);
    finishSM(pA0, pA1, alA, l_reg, pa0, pa1, pa2, pa3); SBAR();
    pv_all<NB>(o, vb0, pa0, pa1, pa2, pa3); PSM(pB0, pB1, alB);
    __syncthreads(); RSC(alB);
    finishSM(pB0, pB1, alB, l_reg, pa0, pa1, pa2, pa3); SBAR();
    pv_all<NB>(o, vb0 + SHM_V, pa0, pa1, pa2, pa3);
#undef PSM
#undef RSC
    if (hi == 0) li_l[r32] = l_reg; asm volatile("s_waitcnt lgkmcnt(0)" ::: "memory");
    float rli[16];
#pragma unroll
    for (int r = 0; r < 16; ++r) rli[r] = __builtin_amdgcn_rcpf(li_l[crow(r, hi)]);
    bf16* Ow = Ob + (long)(wid * 32) * ldo;
#pragma unroll
    for (int r = 0; r < 16; ++r) { const int orow = crow(r, hi);
#pragma unroll
        for (int d0 = 0; d0 < NB; ++d0) Ow[(long)orow * ldo + d0 * 32 + r32] = f2bf(o[d0][r] * rli[r]); }
    __syncthreads();
#undef SLOAD
#undef SWRITE
#undef SWAIT
#undef RESC
}

#define EXP4(P, B) do { P[B] = __builtin_amdgcn_exp2f(P[B]); P[B + 1] = __builtin_amdgcn_exp2f(P[B + 1]); P[B + 2] = __builtin_amdgcn_exp2f(P[B + 2]); P[B + 3] = __builtin_amdgcn_exp2f(P[B + 3]); } while (0)
#define SUM4(S, P, B) do { S += (P[B] + P[B + 1]) + (P[B + 2] + P[B + 3]); } while (0)
#define PK4X(P, BASE, OUT) do { const u32x4 w_ = {cvt_pk_bf16(P[BASE + 0], P[BASE + 1]), cvt_pk_bf16(P[BASE + 2], P[BASE + 3]), cvt_pk_bf16(P[BASE + 4], P[BASE + 5]), cvt_pk_bf16(P[BASE + 6], P[BASE + 7])}; OUT = __builtin_bit_cast(bf16x8, w_); } while (0)
typedef short v4i16_t __attribute__((ext_vector_type(4)));
__device__ __forceinline__ s16x4 vtr(const LAS char* p) { return __builtin_bit_cast(s16x4, __builtin_amdgcn_ds_read_tr16_b64_v4i16((LAS v4i16_t*)p)); }
#define KSWZ2(row, colB) ((row) * 256 + ((colB) ^ (((row) & 15) << 4)))
template <int DQK, int D1, int DVV>
__device__ __forceinline__ void attn_unit2(const bf16* __restrict__ Qb, int ldq, const bf16* __restrict__ K1, int ldk1, const bf16* __restrict__ K2, int ldk2,
                                           const bf16* __restrict__ Vh, int ldv, bf16* __restrict__ Ob, int ldo, int seq, LAS char* lds, float kbound) {
    constexpr int ND0 = DQK / 16, NB = DVV / 32, CK = DQK / 8;
    constexpr int SHM_V = 64 * DVV * 2, SHM_K = 64 * 256;
    static_assert(NB == 2 && ND0 == 6, "written for QK dim 96 / V dim 64");
    int tid_ = threadIdx.x; asm volatile("" : "+v"(tid_));
    const int tid = tid_, wid = __builtin_amdgcn_readfirstlane(tid >> 6), lane = tid & 63, r32 = lane & 31, hi = lane >> 5;
    LAS char* V_lds = lds; LAS char* K_lds = lds + 3 * SHM_V;
    LAS float* ws = (LAS float*)(lds + 3 * SHM_V + 2 * SHM_K) + wid * 64;
    LAS char* QAL = lds + 3 * SHM_V + 2 * SHM_K + 2048 + wid * (2 * ND0 * 1024) + lane * 16; LAS char* QBL = QAL + ND0 * 1024;
    float nm;
    { bf16x8 qa[ND0], qb[ND0];
      const bf16* QwA = Qb + (long)(wid * 64 + r32) * ldq + hi * 8; const bf16* QwB = QwA + (long)32 * ldq;
#pragma unroll
      for (int d0 = 0; d0 < ND0; ++d0) { qa[d0] = *(const bf16x8*)(QwA + d0 * 16); qb[d0] = *(const bf16x8*)(QwB + d0 * 16); }
      float q2a = 0.f, q2b = 0.f;
#pragma unroll
      for (int d0 = 0; d0 < ND0; ++d0) { f32x4 a, b; unpack8(__builtin_bit_cast(u32x4, qa[d0]), a, b); q2a += sumsq4(a) + sumsq4(b); unpack8(__builtin_bit_cast(u32x4, qb[d0]), a, b); q2b += sumsq4(a) + sumsq4(b);
          *(LAS bf16x8*)(QAL + d0 * 1024) = qa[d0]; *(LAS bf16x8*)(QBL + d0 * 1024) = qb[d0]; }
      { auto rr = __builtin_amdgcn_permlane32_swap(__float_as_uint(q2a), __float_as_uint(q2a), false, false); q2a = __uint_as_float(rr[0]) + __uint_as_float(rr[1]); }
      { auto rr = __builtin_amdgcn_permlane32_swap(__float_as_uint(q2b), __float_as_uint(q2b), false, false); q2b = __uint_as_float(rr[0]) + __uint_as_float(rr[1]); }
      nm = -sqrtf(fmaxf(q2a, q2b)) * kbound; }
    const bf16* kp[2]; int kstr[2];
#pragma unroll
    for (int i = 0; i < 2; ++i) { const int row = 8 * wid + 4 * i + (lane >> 4), cc = (lane & 15) ^ (row & 15);
        if (cc >= 8 && cc < CK) { kp[i] = K2 + (long)row * ldk2 + (cc * 8 - D1); kstr[i] = 64 * ldk2; } else { kp[i] = K1 + (long)row * ldk1 + (cc < 8 ? cc * 8 : 0); kstr[i] = 64 * ldk1; } }
    const bf16* vp; { const int k = 8 * wid + ((lane & 31) >> 2); vp = Vh + (long)k * ldv + (lane >> 5) * 32 + (lane & 3) * 8; }
    const int vstr = 64 * ldv;
    const LAS char* vrd0 = V_lds + v_rd_base(lane);
#define DMA2(t, kb, vbuf) do { \
    __builtin_amdgcn_global_load_lds((const unsigned*)(kp[0] + (long)(t) * kstr[0]), (LAS unsigned*)(K_lds + (kb) * SHM_K + wid * 2048), 16, 0, 0); \
    __builtin_amdgcn_global_load_lds((const unsigned*)(kp[1] + (long)(t) * kstr[1]), (LAS unsigned*)(K_lds + (kb) * SHM_K + wid * 2048 + 1024), 16, 0, 0); \
    __builtin_amdgcn_global_load_lds((const unsigned*)(vp + (long)(t) * vstr), (LAS unsigned*)(V_lds + (vbuf) * SHM_V + wid * 1024), 16, 0, 0); } while (0)
#define VRD8(arr, base, D0) do { _Pragma("unroll") for (int j_ = 0; j_ < 8; ++j_) arr[j_] = vtr((base) + (j_ * NB + (D0)) * 512); } while (0)
#define PKV(arr, ks) (bf16x8){arr[2 * (ks)][0], arr[2 * (ks)][1], arr[2 * (ks)][2], arr[2 * (ks)][3], arr[2 * (ks) + 1][0], arr[2 * (ks) + 1][1], arr[2 * (ks) + 1][2], arr[2 * (ks) + 1][3]}
    f32x16 oA[2], oB[2]; oA[0] = f32x16{}; oA[1] = f32x16{}; oB[0] = f32x16{}; oB[1] = f32x16{};
    float lA = 0.f, lB = 0.f; const int NT = seq / 64;
    f32x16 a0, a1, c0, c1; bf16x8 pa0, pa1, pa2, pa3;
#define HALF1(Kb) do { \
        f32x16 init; { float nmv = nm; asm volatile("" : "+v"(nmv)); _Pragma("unroll") for (int r = 0; r < 16; ++r) init[r] = nmv; } \
        SBAR(); \
        _Pragma("unroll") for (int d0 = 0; d0 < ND0; ++d0) { const int cb = (d0 * 16 + hi * 8) * 2; \
            const bf16x8 k0 = *(const LAS bf16x8*)((Kb) + KSWZ2(r32, cb)), k1 = *(const LAS bf16x8*)((Kb) + KSWZ2(32 + r32, cb)), qv = *(const LAS bf16x8*)(QAL + d0 * 1024); \
            a0 = __builtin_amdgcn_mfma_f32_32x32x16_bf16(k0, qv, d0 == 0 ? init : a0, 0, 0, 0); \
            a1 = __builtin_amdgcn_mfma_f32_32x32x16_bf16(k1, qv, d0 == 0 ? init : a1, 0, 0, 0); } \
        SBAR(); \
        float sA = 0.f; \
        _Pragma("unroll") for (int d0 = 0; d0 < ND0; ++d0) { const int cb = (d0 * 16 + hi * 8) * 2; \
            const bf16x8 k0 = *(const LAS bf16x8*)((Kb) + KSWZ2(r32, cb)), k1 = *(const LAS bf16x8*)((Kb) + KSWZ2(32 + r32, cb)), qv = *(const LAS bf16x8*)(QBL + d0 * 1024); \
            c0 = __builtin_amdgcn_mfma_f32_32x32x16_bf16(k0, qv, d0 == 0 ? init : c0, 0, 0, 0); \
            if (d0 == 3) { EXP4(a0, 0); EXP4(a0, 4); } \
            if (d0 == 4) { EXP4(a0, 12); SUM4(sA, a0, 0); SUM4(sA, a0, 4); EXP4(a1, 0); } \
            if (d0 == 5) { EXP4(a1, 8); SUM4(sA, a1, 0); SUM4(sA, a1, 4); } \
            c1 = __builtin_amdgcn_mfma_f32_32x32x16_bf16(k1, qv, d0 == 0 ? init : c1, 0, 0, 0); \
            if (d0 == 3) { EXP4(a0, 8); } \
            if (d0 == 4) { EXP4(a1, 4); SUM4(sA, a0, 8); SUM4(sA, a0, 12); } \
            if (d0 == 5) { EXP4(a1, 12); SUM4(sA, a1, 8); SUM4(sA, a1, 12); } \
            if (d0 >= 2) SBAR(); } \
        lA += sA; \
        PK4X(a0, 0, pa0); PK4X(a0, 8, pa1); PK4X(a1, 0, pa2); PK4X(a1, 8, pa3); \
        SBAR(); } while (0)
#define HALF2(vbase) do { \
        float sB = 0.f; s16x4 va[8], vb_[8]; \
        VRD8(va, vbase, 0); VRD8(vb_, vbase, 1); \
        oA[0] = __builtin_amdgcn_mfma_f32_32x32x16_bf16(pa0, PKV(va, 0), oA[0], 0, 0, 0); SBAR(); \
        oA[1] = __builtin_amdgcn_mfma_f32_32x32x16_bf16(pa0, PKV(vb_, 0), oA[1], 0, 0, 0); EXP4(c0, 0); EXP4(c0, 4); SBAR(); \
        oA[0] = __builtin_amdgcn_mfma_f32_32x32x16_bf16(pa1, PKV(va, 1), oA[0], 0, 0, 0); EXP4(c0, 8); EXP4(c0, 12); SUM4(sB, c0, 0); SBAR(); \
        oA[1] = __builtin_amdgcn_mfma_f32_32x32x16_bf16(pa1, PKV(vb_, 1), oA[1], 0, 0, 0); EXP4(c1, 0); SUM4(sB, c0, 4); SUM4(sB, c0, 8); SBAR(); \
        oA[0] = __builtin_amdgcn_mfma_f32_32x32x16_bf16(pa2, PKV(va, 2), oA[0], 0, 0, 0); EXP4(c1, 4); SUM4(sB, c0, 12); SBAR(); \
        oA[1] = __builtin_amdgcn_mfma_f32_32x32x16_bf16(pa2, PKV(vb_, 2), oA[1], 0, 0, 0); EXP4(c1, 8); SUM4(sB, c1, 0); SBAR(); \
        oA[0] = __builtin_amdgcn_mfma_f32_32x32x16_bf16(pa3, PKV(va, 3), oA[0], 0, 0, 0); EXP4(c1, 12); SUM4(sB, c1, 4); SBAR(); \
        oA[1] = __builtin_amdgcn_mfma_f32_32x32x16_bf16(pa3, PKV(vb_, 3), oA[1], 0, 0, 0); SUM4(sB, c1, 8); SUM4(sB, c1, 12); SBAR(); \
        lB += sB; \
        PK4X(c0, 0, pa0); PK4X(c0, 8, pa1); PK4X(c1, 0, pa2); PK4X(c1, 8, pa3); \
        SBAR(); \
        VRD8(va, vbase, 0); VRD8(vb_, vbase, 1);                       \
        oB[0] = __builtin_amdgcn_mfma_f32_32x32x16_bf16(pa0, PKV(va, 0), oB[0], 0, 0, 0); \
        oB[1] = __builtin_amdgcn_mfma_f32_32x32x16_bf16(pa0, PKV(vb_, 0), oB[1], 0, 0, 0); \
        oB[0] = __builtin_amdgcn_mfma_f32_32x32x16_bf16(pa1, PKV(va, 1), oB[0], 0, 0, 0); \
        oB[1] = __builtin_amdgcn_mfma_f32_32x32x16_bf16(pa1, PKV(vb_, 1), oB[1], 0, 0, 0); \
        oB[0] = __builtin_amdgcn_mfma_f32_32x32x16_bf16(pa2, PKV(va, 2), oB[0], 0, 0, 0); \
        oB[1] = __builtin_amdgcn_mfma_f32_32x32x16_bf16(pa2, PKV(vb_, 2), oB[1], 0, 0, 0); \
        oB[0] = __builtin_amdgcn_mfma_f32_32x32x16_bf16(pa3, PKV(va, 3), oB[0], 0, 0, 0); \
        oB[1] = __builtin_amdgcn_mfma_f32_32x32x16_bf16(pa3, PKV(vb_, 3), oB[1], 0, 0, 0); \
        SBAR(); } while (0)
#define TILE_BAR() do { asm volatile("s_waitcnt vmcnt(0)" ::: "memory"); __syncthreads(); } while (0)
    DMA2(0, 0, 0);
    if (wid < 4) {
        int vs = 0;
#pragma unroll 1
        for (int t = 0; t < NT; ++t) { TILE_BAR();
            const int vn = vs == 2 ? 0 : vs + 1; if (t + 1 < NT) DMA2(t + 1, (t + 1) & 1, vn);
            HALF1(K_lds + (t & 1) * SHM_K); HALF2(vrd0 + vs * SHM_V); vs = vn; }
        TILE_BAR();
    } else {
        __builtin_amdgcn_s_setprio(1);
        TILE_BAR(); if (1 < NT) DMA2(1, 1, 1);
        HALF1(K_lds);
        int vs = 0;
#pragma unroll 1
        for (int t = 1; t < NT; ++t) { TILE_BAR();
            const int vn = vs == 2 ? 0 : vs + 1; const int vnn = vn == 2 ? 0 : vn + 1; if (t + 1 < NT) DMA2(t + 1, (t + 1) & 1, vnn);
            HALF2(vrd0 + vs * SHM_V); HALF1(K_lds + (t & 1) * SHM_K); vs = vn; }
        TILE_BAR();
        HALF2(vrd0 + vs * SHM_V);
        __builtin_amdgcn_s_setprio(0);
    }
#undef HALF1
#undef HALF2
#undef TILE_BAR
    { auto rr = __builtin_amdgcn_permlane32_swap(__float_as_uint(lA), __float_as_uint(lA), false, false); lA = __uint_as_float(rr[0]) + __uint_as_float(rr[1]); }
    { auto rr = __builtin_amdgcn_permlane32_swap(__float_as_uint(lB), __float_as_uint(lB), false, false); lB = __uint_as_float(rr[0]) + __uint_as_float(rr[1]); }
    if (hi == 0) { ws[r32] = lA; ws[32 + r32] = lB; } asm volatile("s_waitcnt lgkmcnt(0)" ::: "memory");
    bf16* Ow = Ob + (long)(wid * 64) * ldo;
#pragma unroll
    for (int r = 0; r < 16; ++r) { const int orow = crow(r, hi); const float ra = __builtin_amdgcn_rcpf(ws[orow]), rb = __builtin_amdgcn_rcpf(ws[32 + orow]);
#pragma unroll
        for (int d0 = 0; d0 < NB; ++d0) { Ow[(long)orow * ldo + d0 * 32 + r32] = f2bf(oA[d0][r] * ra); Ow[(long)(32 + orow) * ldo + d0 * 32 + r32] = f2bf(oB[d0][r] * rb); } }
    __syncthreads();
#undef DMA2
#undef VRD8
#undef PKV
}
#undef EXP4
#undef SUM4
#undef PK4X

__device__ __forceinline__ void spatial_unit(int chunk, int g, const bf16* __restrict__ U, const bf16* __restrict__ VR, const float* __restrict__ vstat, const float* __restrict__ g_sg,
                                             const bf16* __restrict__ Wsb, const float* __restrict__ b_s, bf16* __restrict__ Y, LAS char* lds) {
    int tid_ = threadIdx.x; asm volatile("" : "+v"(tid_));
    const int tid = tid_, wid = tid >> 6, lane = tid & 63, r32 = lane & 31, hi = lane >> 5, rb = wid & 3, ch = wid >> 2;
    LAS char* V_lds = lds; LAS float* rv = (LAS float*)(lds + 32768);
    const int row0 = chunk * 128;
    f32x4 s0 = {0.f, 0.f, 0.f, 0.f}, s1 = {0.f, 0.f, 0.f, 0.f};
    if (tid < 128) { s0 = *(const f32x4*)(vstat + (size_t)(row0 + tid) * 8); s1 = *(const f32x4*)(vstat + (size_t)(row0 + tid) * 8 + 4); }
    u32x4 wv[4];
#pragma unroll
    for (int i = 0; i < 4; ++i) { const int c = tid + 512 * i, row = c >> 4, cc = c & 15; wv[i] = *(const u32x4*)(VR + (size_t)(row0 + row) * 512 + g * 128 + cc * 8); }
    const f32x4 g0 = *(const f32x4*)(g_sg + g * 128 + (tid & 15) * 8), g1 = *(const f32x4*)(g_sg + g * 128 + (tid & 15) * 8 + 4);
    bf16x8 pa[8];
#pragma unroll
    for (int ks = 0; ks < 8; ++ks) pa[ks] = *(const bf16x8*)(Wsb + (size_t)g * 16384 + (size_t)(32 * rb + r32) * 128 + 16 * ks + 8 * hi);
    bf16 ur[16][2]; float bias[16];
#pragma unroll
    for (int r = 0; r < 16; ++r) { const int i = 32 * rb + crow(r, hi); bias[r] = b_s[g * 128 + i];
#pragma unroll
        for (int dd = 0; dd < 2; ++dd) ur[r][dd] = U[(size_t)(row0 + i) * 512 + g * 128 + 64 * ch + 32 * dd + r32]; }
    if (tid < 128) rv[tid] = __builtin_amdgcn_rsqf(((s0[0] + s0[1]) + (s0[2] + s0[3]) + (s1[0] + s1[1]) + (s1[2] + s1[3])) * (1.f / 512.f) + EPS);
    __syncthreads();
#pragma unroll
    for (int i = 0; i < 4; ++i) { const int c = tid + 512 * i, row = c >> 4, cc = c & 15; f32x4 a, b; unpack8(wv[i], a, b); const float r = rv[row];
        *(LAS u32x4*)(V_lds + (row >> 6) * 16384 + v_st<4>(row & 63, cc * 8)) = pack8(a * r * g0, b * r * g1); }
    __syncthreads();
    f32x16 o[2]; o[0] = f32x16{}; o[1] = f32x16{};
    const int vb = (int)(uintptr_t)V_lds + v_rd_base(lane) + (2 * ch) * 512;
    pv_one<4, 0>(o[0], vb, pa[0], pa[1], pa[2], pa[3]); pv_one<4, 1>(o[1], vb, pa[0], pa[1], pa[2], pa[3]);
    pv_one<4, 0>(o[0], vb + 16384, pa[4], pa[5], pa[6], pa[7]); pv_one<4, 1>(o[1], vb + 16384, pa[4], pa[5], pa[6], pa[7]);
#pragma unroll
    for (int r = 0; r < 16; ++r) { const int i = 32 * rb + crow(r, hi); const size_t row = (size_t)(row0 + i);
#pragma unroll
        for (int dd = 0; dd < 2; ++dd) { const int c = g * 128 + 64 * ch + 32 * dd + r32; const float uu = bf2f(ur[r][dd]);
            Y[row * 1536 + 512 + c] = f2bf(uu * (o[dd][r] + bias[r])); } }
    __syncthreads();
}
#undef KSWZ
#undef SBAR
}

#define XB_TMO      128
#define XB_XCNT(j)  (256  + 64 * (j))
#define XB_XSUB(j)  (1280 + 64 * (j))
#define XB_XGEN(j)  (2304 + 64 * (j))
#define XB_TOP      3328
#define XB_TOPGEN   3392
#define XCD_BAR_WORDS 3456
#define XB_SPIN_CAP (1u << 18)
__device__ __forceinline__ unsigned xb_ld(unsigned* p)              { return __hip_atomic_load((GAS unsigned*)p, __ATOMIC_RELAXED, __HIP_MEMORY_SCOPE_AGENT); }
__device__ __forceinline__ unsigned xb_add(unsigned* p, unsigned v) { return __hip_atomic_fetch_add((GAS unsigned*)p, v, __ATOMIC_RELAXED, __HIP_MEMORY_SCOPE_AGENT); }
__device__ __forceinline__ unsigned xb_xcc_id() { return (unsigned)__builtin_amdgcn_s_getreg((3 << 11) | 20) & 0xFu; }
#define XB_SPIN(cond, bar) do { unsigned _sp = 0; while (cond) { __builtin_amdgcn_s_sleep(1); \
    if ((++_sp & 255u) == 0u) { if (xb_ld(&(bar)[XB_TMO])) break; if (_sp > XB_SPIN_CAP) { xb_add(&(bar)[XB_TMO], 1u); break; } } } } while (0)
struct XcdBarrier { unsigned* bar; unsigned x; volatile LAS unsigned* st; };
__device__ __forceinline__ XcdBarrier xcd_barrier_post(unsigned* bar, volatile LAS unsigned* st) {
    XcdBarrier b; b.bar = bar; b.x = (unsigned)__builtin_amdgcn_readfirstlane((int)xb_xcc_id()); b.st = st;
    if (threadIdx.x == 0) (void)xb_add(&bar[XB_XCNT(b.x)], 1u);
    return b;
}
__device__ __forceinline__ void xcd_barrier_complete(unsigned* bar, unsigned x, unsigned& nloc, unsigned& nx) {
    const unsigned G = gridDim.x * gridDim.y * gridDim.z;
    unsigned sum, cnt, mine, sp = 0u;
    for (;;) {
        sum = 0u; cnt = 0u; mine = 0u;
#pragma unroll
        for (unsigned j = 0; j < 16; ++j) { const unsigned c = xb_ld(&bar[XB_XCNT(j)]); sum += c; cnt += (c > 0u) ? 1u : 0u; mine = (j == x) ? c : mine; }
        if (sum == G) break;
        __builtin_amdgcn_s_sleep(1);
        if ((++sp & 255u) == 0u) { if (xb_ld(&bar[XB_TMO])) break; if (sp > XB_SPIN_CAP) { xb_add(&bar[XB_TMO], 1u); break; } }
    }
    nloc = mine > 0u ? mine : 1u; nx = cnt > 0u ? cnt : 1u;
}
__device__ __forceinline__ void xcd_barrier(const XcdBarrier& b) {
    asm volatile("s_waitcnt vmcnt(0)" ::: "memory");
    __syncthreads();
    if (threadIdx.x == 0) {
        unsigned* bar = b.bar; unsigned bx = b.x; asm volatile("" : "+s"(bar), "+s"(bx));
        __builtin_amdgcn_s_waitcnt(0);
        unsigned nloc = b.st[0], nx = b.st[1];
        if (nloc == 0u) { xcd_barrier_complete(bar, bx, nloc, nx); b.st[0] = nloc; b.st[1] = nx; }
        const unsigned old = xb_add(&bar[XB_XSUB(bx)], 1u);
        const unsigned gen = old / nloc;
        if (old + 1u == (gen + 1u) * nloc) {
            __builtin_amdgcn_fence(__ATOMIC_RELEASE, "agent");
            asm volatile("s_waitcnt vmcnt(0)" ::: "memory");
            const unsigned og = xb_add(&bar[XB_TOP], 1u);
            const unsigned tg = og / nx;
            if (og + 1u == (tg + 1u) * nx) xb_add(&bar[XB_TOPGEN], 1u);
            else XB_SPIN(xb_ld(&bar[XB_TOPGEN]) == tg, bar);
            __builtin_amdgcn_fence(__ATOMIC_ACQUIRE, "agent");
            xb_add(&bar[XB_XGEN(bx)], 1u);
            asm volatile("s_waitcnt vmcnt(0)" ::: "memory");
        } else {
            XB_SPIN(xb_ld(&bar[XB_XGEN(bx)]) == gen, bar);
            __builtin_amdgcn_fence(__ATOMIC_ACQUIRE, "agent");
            asm volatile("s_waitcnt vmcnt(0)" ::: "memory");
        }
    }
    __syncthreads();
}

enum { CV_NAT = 0, CV_WIN = 1, CV_WUQ = 2, CV_W13 = 3 };
__device__ __forceinline__ int ropeperm(int p) { return ((p >> 2) & 1) * 16 + 4 * (p >> 3) + (p & 3); }
__device__ __forceinline__ int cv_map(int kind, int G, int& which, float& scale, bool& perm) {
    which = 0; scale = 1.f; perm = false; const int n = G * 32;
    if (kind == CV_WIN) {
        if (n < 384) return n;
        if (n < 416) { perm = true; return 640; }
        if (n < 512) return -1;
        if (n < 768) return 384 + (n - 512);
        if (n < 1280) return 672 + (n - 768);
        if (n < 1792) return 1184 + (n - 1280);
        if (n < 2304) { scale = XSCALE; return 1696 + (n - 1792); }
        return 2208 + (n - 2304);
    }
    if (kind == CV_WUQ) { scale = QSCALE; perm = (G % 3) == 2; return n; }
    if (kind == CV_W13) { which = (n >> 7) & 1; return 128 * (n >> 8) + (n & 127); }
    return n;
}
struct CvDesc { const float* src; const float* src2; const float* gain; bf16* dst; int K, Nsrc, Nout, kind; };
__device__ __forceinline__ void cv_item(const CvDesc& d, int item, LAS char* tile, int lane) {
    const int nI = d.Nout >> 7, kb = item / nI, nb = item - kb * nI, k0 = 64 * kb, n0 = 128 * nb;
    const int nq = lane & 31, kh = lane >> 5;
    const int nout = n0 + 4 * nq, G = nout >> 5, p = nout & 31;
    int which; float scale; bool perm; const int sc = cv_map(d.kind, G, which, scale, perm);
    const bool zero = sc < 0;
    const float* W = d.src + (ptrdiff_t)which * (d.src2 - d.src) + (size_t)k0 * d.Nsrc + (zero ? 0 : sc + (perm ? ropeperm(p) : p));
#pragma unroll
    for (int half = 0; half < 2; ++half) {
        f32x4 v[16];
#pragma unroll
        for (int i = 0; i < 16; ++i) { const int k = 32 * half + 2 * i + kh; v[i] = zero ? (f32x4){0.f, 0.f, 0.f, 0.f} : *(const f32x4*)(W + (size_t)k * d.Nsrc); }
#pragma unroll
        for (int i = 0; i < 16; ++i) { const int k = 32 * half + 2 * i + kh; const float g = d.gain ? d.gain[k0 + k] * scale : scale; const f32x4 w = v[i] * g;
            *(LAS u32x2*)(tile + att::v_st<4>(k, 4 * nq)) = (u32x2){cvt_pk_bf16(w[0], w[1]), cvt_pk_bf16(w[2], w[3])}; }
    }
    LDS_WAIT(); asm volatile("" ::: "memory");
    const int vb = (int)(uintptr_t)tile + att::v_rd_base(lane);
    bf16* drow = d.dst + (size_t)(n0 >> 8) * 256 * d.K + (size_t)kb * (256 * 64) + (size_t)((n0 & 255) + nq) * 64 + 8 * kh;
#define CV_RD(D0, KS) { const s16x4 l_ = att::tr_read<((2 * KS) * 4 + D0) * 512>(vb), h_ = att::tr_read<((2 * KS + 1) * 4 + D0) * 512>(vb); \
        asm volatile("s_waitcnt lgkmcnt(0)" ::: "memory"); __builtin_amdgcn_sched_barrier(0); \
        *(bf16x8*)(drow + (32 * D0) * 64 + 16 * KS) = (bf16x8){l_[0], l_[1], l_[2], l_[3], h_[0], h_[1], h_[2], h_[3]}; }
#define CV_RD4(D0) CV_RD(D0, 0) CV_RD(D0, 1) CV_RD(D0, 2) CV_RD(D0, 3)
    CV_RD4(0) CV_RD4(1) CV_RD4(2) CV_RD4(3)
#undef CV_RD4
#undef CV_RD
    LDS_WAIT(); asm volatile("" ::: "memory");
}

struct Args {
    const float* x; const float* mem; const int* positions; const float* g_mix; const float* w_in; const float* g_q; const float* g_kv; const float* w_uq; const float* w_uk; const float* w_uv;
    const float* g_sg; const float* w_s; const float* b_s; const float* g_mem; const float* w_mkv; const float* w_br; const float* b_gate; const float* w_out; const float* g_ffn;
    const float* dense_w1; const float* dense_w3; const float* dense_w2; const float* w_router; const float* moe_w1; const float* moe_w3; const float* moe_w2; const float* g_final;
    float* out; unsigned char* ws; int dbg; int pad;
};
typedef const __attribute__((address_space(4))) Args* ArgsP;
#define FRESH(ap) ArgsP ap = kargs; asm volatile("" : "+s"(ap))
__constant__ double INVF[16] = { 1.0, 0.5623413251903491, 0.31622776601683794, 0.1778279410038923, 0.1, 0.05623413251903491, 0.03162277660168379, 0.01778279410038923,
                                 0.01, 0.005623413251903491, 0.003162277660168379, 0.001778279410038923, 0.001, 0.0005623413251903491, 0.00031622776601683794, 0.0001778279410038923 };

struct Frame { LAS unsigned char* lds; int G, NGW, bid; };
#define LOCAL_IDS int tid = threadIdx.x; asm volatile("" : "+v"(tid)); const int lane = tid & 63, wave = __builtin_amdgcn_readfirstlane(tid >> 6), gw = F.bid * NWAVES + wave; (void)lane; (void)gw

__device__ __forceinline__ void conv_run(const Frame& F, const CvDesc& d) {
    LOCAL_IDS;
    LAS char* tile = (LAS char*)(F.lds + wave * 16384);
    const int nitems = (d.K / 64) * (d.Nout / 128);
    for (int it = gw; it < nitems; it += F.NGW) cv_item(d, it, tile, lane);
}
__device__ __forceinline__ void rx_from_stats(const Frame& F, ArgsP kargs) {
    LOCAL_IDS; FRESH(ap); const float* xstat = (const float*)(ap->ws + WS_XSTAT); float* rx = (float*)(ap->ws + WS_RX);
    for (int row = F.bid * 512 + tid; row < M; row += F.G * 512) {
        const f32x4* p = (const f32x4*)(xstat + (size_t)row * 16); const f32x4 a = p[0], b = p[1], c = p[2], d = p[3];
        const float s = ((a[0] + a[1]) + (a[2] + a[3])) + ((b[0] + b[1]) + (b[2] + b[3])) + ((c[0] + c[1]) + (c[2] + c[3])) + ((d[0] + d[1]) + (d[2] + d[3]));
        rx[row] = __builtin_amdgcn_rsqf(s * (1.f / D) + EPS);
    }
}
template <int MODE>
__device__ __forceinline__ void conv_flat(const Frame& F, ArgsP kargs, int l, int j2, int lmix) {
    int tid_ = threadIdx.x; asm volatile("" : "+v"(tid_)); const int lane_ = tid_ & 63, wave_ = __builtin_amdgcn_readfirstlane(tid_ >> 6);
    LAS char* tile = (LAS char*)(F.lds + wave_ * 16384);
    constexpr int I13D = (D / 64) * (2 * DFF / 128), I2D = (DFF / 64) * (D / 128), I13 = (D / 64) * (2 * DFE / 128), I2 = (DFE / 64) * (D / 128), IE = I13 + I2, IMKV = (D / 64) * (D / 128);
    constexpr int NB_ = MODE == 0 ? DEPTH * IMKV : MODE == 1 ? I13D + I2D : MODE == 2 ? NE * IE : 0;
    constexpr int M_IN = (D / 64) * (PPAD / 128), M_UQ = (QRANK / 64) * (768 / 128), M_UK = (KVRANK / 64) * (512 / 128), M_BR = (BW / 64) * (D / 128), M_OUT = (D / 64) * (D / 128);
    constexpr int O_UQ = M_IN, O_UK = O_UQ + M_UQ, O_UV = O_UK + M_UK, O_BR = O_UV + M_UK, O_OUT = O_BR + 3 * M_BR, NMIX = O_OUT + M_OUT;
    const int total = NB_ + ((lmix >= 0 && lmix < DEPTH) ? NMIX : 0);
#pragma unroll 1
    for (int idx = wave_ * F.G + F.bid; idx < total; idx += F.NGW) { FRESH(a); CvDesc d; int it;
        if (idx < NB_) {
            if constexpr (MODE == 0) { const int lq = idx / IMKV; it = idx - lq * IMKV; d = CvDesc{a->w_mkv + (size_t)lq * D * D, nullptr, nullptr, (bf16*)(a->ws + WS_WMKVT) + (size_t)lq * D * D, D, D, D, CV_NAT}; }
            else if constexpr (MODE == 1) {
                if (idx < I13D) { it = idx; d = CvDesc{a->dense_w1 + (size_t)j2 * D * DFF, a->dense_w3 + (size_t)j2 * D * DFF, a->g_ffn + l * D, (bf16*)(a->ws + WS_WFFN), D, DFF, 2 * DFF, CV_W13}; }
                else { it = idx - I13D; d = CvDesc{a->dense_w2 + (size_t)j2 * DFF * D, nullptr, nullptr, (bf16*)(a->ws + WS_W2D), DFF, D, D, CV_NAT}; } }
            else { const int e = idx / IE, r = idx - e * IE;
                if (r < I13) { it = r; d = CvDesc{a->moe_w1 + ((size_t)j2 * NE + e) * D * DFE, a->moe_w3 + ((size_t)j2 * NE + e) * D * DFE, a->g_ffn + l * D, (bf16*)(a->ws + WS_WFFN) + (size_t)e * 2 * DFE * D, D, DFE, 2 * DFE, CV_W13}; }
                else { it = r - I13; d = CvDesc{a->moe_w2 + ((size_t)j2 * NE + e) * DFE * D, nullptr, nullptr, (bf16*)(a->ws + WS_W2M) + (size_t)e * D * DFE, DFE, D, D, CV_NAT}; } }
        } else { const int r = idx - NB_;
            if (r < O_UQ) { it = r; d = CvDesc{a->w_in + (size_t)lmix * D * PTOT, nullptr, a->g_mix + lmix * D, (bf16*)(a->ws + WS_WINT), D, PTOT, PPAD, CV_WIN}; }
            else if (r < O_UK) { it = r - O_UQ; d = CvDesc{a->w_uq + (size_t)lmix * QRANK * 768, nullptr, a->g_q + lmix * QRANK, (bf16*)(a->ws + WS_WUQT), QRANK, 768, 768, CV_WUQ}; }
            else if (r < O_UV) { it = r - O_UK; d = CvDesc{a->w_uk + (size_t)lmix * KVRANK * 512, nullptr, a->g_kv + lmix * KVRANK, (bf16*)(a->ws + WS_WUKVT), KVRANK, 512, 512, CV_NAT}; }
            else if (r < O_BR) { it = r - O_UV; d = CvDesc{a->w_uv + (size_t)lmix * KVRANK * 512, nullptr, a->g_kv + lmix * KVRANK, (bf16*)(a->ws + WS_WUKVT) + 512 * KVRANK, KVRANK, 512, 512, CV_NAT}; }
            else if (r < O_OUT) { const int n = (r - O_BR) / M_BR; it = (r - O_BR) - n * M_BR; d = CvDesc{a->w_br + ((size_t)lmix * 3 + n) * BW * D, nullptr, nullptr, (bf16*)(a->ws + WS_WBRT) + (size_t)n * D * BW, BW, D, D, CV_NAT}; }
            else { it = r - O_OUT; d = CvDesc{a->w_out + (size_t)lmix * D * D, nullptr, nullptr, (bf16*)(a->ws + WS_WOUTT), D, D, D, CV_NAT}; } }
        cv_item(d, it, tile, lane_); }
    if (lmix >= 0 && lmix < DEPTH) {
        FRESH(a); const float* wsrc = a->w_s + (size_t)lmix * 65536; bf16* wdst = (bf16*)(a->ws + WS_WSB);
        for (int i = F.bid * 512 + tid_; i < 4 * 128 * 128 / 4; i += F.G * 512) { const f32x4 v = *(const f32x4*)(wsrc + (size_t)i * 4);
            *(u32x2*)(wdst + (size_t)i * 4) = (u32x2){cvt_pk_bf16(v[0], v[1]), cvt_pk_bf16(v[2], v[3])}; } }
}
__device__ __forceinline__ void phase_prologue(const Frame& F, ArgsP kargs) {
    LOCAL_IDS;
    { FRESH(a); float* ROPE = (float*)(a->ws + WS_ROPE); const int* pos = a->positions;
      for (int idx = F.bid * 512 + tid; idx < M * 16; idx += F.G * 512) { const int row = idx >> 4, i = idx & 15;
        const double t = (double)pos[row] * INVF[i] * 0.15915494309189535; const float fr = (float)(t - rint(t));
        ROPE[(size_t)row * 32 + i] = __builtin_amdgcn_cosf(fr); ROPE[(size_t)row * 32 + 16 + i] = __builtin_amdgcn_sinf(fr); } }
    { FRESH(a); const float* xin = a->x; bf16* XB = (bf16*)(a->ws + WS_XB); float* RX = (float*)(a->ws + WS_RX);
      f32x4 vn[4];
#pragma unroll
      for (int j = 0; j < 4; ++j) vn[j] = ((const f32x4*)(xin + (size_t)gw * D) + lane)[64 * j];
#pragma unroll 1
      for (int m = gw; m < M; m += F.NGW) { f32x4 v[4]; float s = 0.f; const int mn = m + F.NGW < M ? m + F.NGW : m;
#pragma unroll
        for (int j = 0; j < 4; ++j) { v[j] = vn[j]; s += sumsq4(v[j]); }
#pragma unroll
        for (int j = 0; j < 4; ++j) vn[j] = ((const f32x4*)(xin + (size_t)mn * D) + lane)[64 * j];
        s = wave_sum(s);
#pragma unroll
        for (int j = 0; j < 4; ++j) ((u32x2*)(XB + (size_t)m * D) + lane)[64 * j] = (u32x2){cvt_pk_bf16(v[j][0], v[j][1]), cvt_pk_bf16(v[j][2], v[j][3])};
        if (lane == 0) RX[m] = __builtin_amdgcn_rsqf(s * (1.f / D) + EPS); } }
    { FRESH(a); const float* mem = a->mem; const float* g_mem = a->g_mem; bf16* MEMB = (bf16*)(a->ws + WS_MEMB);
      for (int m = gw; m < NMEM; m += F.NGW) { const f32x4* xr = (const f32x4*)(mem + (size_t)m * D) + lane; f32x4 v[4]; float s = 0.f;
#pragma unroll
        for (int j = 0; j < 4; ++j) { v[j] = xr[64 * j]; s += sumsq4(v[j]); }
        const float r = __builtin_amdgcn_rsqf(wave_sum(s) * (1.f / D) + EPS);
#pragma unroll
        for (int j = 0; j < 4; ++j) { const f32x4 g = ((const f32x4*)g_mem + lane)[64 * j]; const f32x4 w = v[j] * r * g;
            ((u32x2*)(MEMB + (size_t)m * D) + lane)[64 * j] = (u32x2){cvt_pk_bf16(w[0], w[1]), cvt_pk_bf16(w[2], w[3])}; } } }
    conv_flat<0>(F, kargs, 0, 0, 0);
}
__device__ __forceinline__ void phase_inproj(const Frame& F, ArgsP kargs, int l) {
    if (PH(1)) { FRESH(a); unsigned char* ws = a->ws;
        pg8::TileOrder S{M / 256, PPAD / 256 - 1, F.G, F.bid, (const char*)(ws + WS_XB), (const char*)(ws + WS_WINT), (size_t)256 * D * 2, (size_t)256 * D * 2};
#ifdef DBG_REV
        S.rev = 1;
#endif
        pg8::EpiInProj E{ws, a->b_gate + (size_t)l * 3 * D, l, (l & 1)};
        pg8::gemm_phase(F.lds, D, D, D, S, E); }
    if (l == 0 && PH(2)) { FRESH(a); unsigned char* ws = a->ws;
        struct MemOrder { enum { VARK = 0, GATHER = 0 }; int c; const char* A; const char* B;
            __device__ __forceinline__ bool next(int i, pg8::Unit& u) const { if (i > 0 || c < 240) return false; const int idx = c - 240; u.pm = 0; u.pn = idx & 3; u.aux = idx >> 2; u.A = A; u.B = B + (size_t)u.aux * D * D * 2 + (size_t)u.pn * 256 * D * 2; return true; } };
        MemOrder S2{F.bid, (const char*)(ws + WS_MEMB), (const char*)(ws + WS_WMKVT)}; pg8::EpiMemKV E2{(bf16*)(ws + WS_KVMEM)};
        pg8::gemm_phase(F.lds, D, D, D, S2, E2); }
}
struct GateTailOrder { enum { VARK = 0, GATHER = 0 }; int c; const char* A; const char* B;
    __device__ __forceinline__ bool next(int i, pg8::Unit& u) const { if (i > 0 || c < 192) return false; u.pm = c - 192; u.pn = PPAD / 256 - 1; u.aux = 0; u.A = A + (size_t)u.pm * 256 * D * 2; u.B = B + (size_t)u.pn * 256 * D * 2; return true; } };
__device__ __forceinline__ void phase_up(const Frame& F, ArgsP kargs, int l) {
    if (PH(1)) { FRESH(a); unsigned char* ws = a->ws;
        GateTailOrder S{F.bid, (const char*)(ws + WS_XB), (const char*)(ws + WS_WINT)}; pg8::EpiInProj E{ws, a->b_gate + (size_t)l * 3 * D, l, (l & 1)};
        pg8::gemm_phase(F.lds, D, D, D, S, E); }
    if (PH(3)) { FRESH(a); unsigned char* ws = a->ws;
        pg8::TileOrder S{M / 256, 3, F.G, F.bid, (const char*)(ws + WS_CQ), (const char*)(ws + WS_WUQT), (size_t)256 * 512 * 2, (size_t)256 * QRANK * 2};
        pg8::EpiQ E{(const float*)(ws + WS_CQSTAT), (const float*)(ws + WS_ROPE), (bf16*)(ws + WS_Q)}; pg8::gemm_phase(F.lds, 512, QRANK, QRANK, S, E); }
    if (PH(4)) { FRESH(a); unsigned char* ws = a->ws;
        pg8::TileOrder S{M / 256, 4, F.G, F.bid, (const char*)(ws + WS_CKV), (const char*)(ws + WS_WUKVT), (size_t)256 * KVRANK * 2, (size_t)256 * KVRANK * 2};
        pg8::EpiKV E{(const float*)(ws + WS_CKVSTAT), (bf16*)(ws + WS_KN), (bf16*)(ws + WS_V), (unsigned*)(ws + WS_CTL) + CW_KMAX + l * 32}; pg8::gemm_phase(F.lds, KVRANK, KVRANK, KVRANK, S, E); }
    if (PH(5)) { FRESH(a); unsigned char* ws = a->ws;
        for (int un = F.bid; un < 512; un += F.G)
            att::spatial_unit(un >> 2, un & 3, (const bf16*)(ws + WS_U), (const bf16*)(ws + WS_VR), (const float*)(ws + WS_VSTAT), a->g_sg + l * BW, (const bf16*)(ws + WS_WSB), a->b_s + l * 512, (bf16*)(ws + WS_Y), (LAS char*)F.lds); }
    if (PH(6)) { FRESH(a); unsigned char* ws = a->ws;
        for (int un = F.bid; un < 256; un += F.G) { const int h = un & 3, pm = un >> 2; const bf16* kvm = (const bf16*)(ws + WS_KVMEM) + (size_t)l * 256 * 1024;
            att::attn_unit<128, 128, 128, false>((const bf16*)(ws + WS_QX) + (size_t)pm * 256 * 512 + h * 128, 512, kvm + h * 128, 1024, kvm, 1024, kvm + 512 + h * 128, 1024,
                                          (bf16*)(ws + WS_Y) + (size_t)pm * 256 * 1536 + 1024 + h * 128, 1536, NMEM, (LAS char*)F.lds, 0.f); } }
}
__device__ __forceinline__ void phase_attn(const Frame& F, ArgsP kargs, int l) {
    if (PH(7)) { FRESH(a); unsigned char* ws = a->ws;
        for (int un = F.bid; un < 256; un += F.G) { const int h = un & 7, qb = un >> 3;
            const unsigned* km = (const unsigned*)(ws + WS_CTL) + CW_KMAX + l * 32;
            const float kbound = sqrtf(__uint_as_float(km[2 * h]) + __uint_as_float(km[2 * h + 1]) + __uint_as_float(km[16])) * 1.02f;
            att::attn_unit2<96, 64, 64>((const bf16*)(ws + WS_Q) + (size_t)qb * 512 * 768 + h * 96, 768, (const bf16*)(ws + WS_KN) + h * 64, 512, (const bf16*)(ws + WS_KR), 32, (const bf16*)(ws + WS_V) + h * 64, 512,
                                        (bf16*)(ws + WS_Y) + (size_t)qb * 512 * 1536 + h * 64, 1536, M, (LAS char*)F.lds, kbound); } }
}
__device__ __forceinline__ void phase_branch(const Frame& F, ArgsP kargs) {
    if (PH(8)) { FRESH(a); unsigned char* ws = a->ws;
        struct BranchOrder { enum { VARK = 0, GATHER = 0 }; int c; const char* A; const char* B;
            __device__ __forceinline__ bool next(int i, pg8::Unit& u) const { if (i >= 3 || c >= 256) return false; int pm, pn; pg8::tile_of(c, 64, 4, pm, pn); u.pm = pm; u.pn = pn; u.aux = i;
                u.A = A + (size_t)pm * 256 * 1536 * 2 + (size_t)i * 512 * 2; u.B = B + (size_t)i * D * BW * 2 + (size_t)pn * 256 * BW * 2; return true; } };
        BranchOrder S{F.bid, (const char*)(ws + WS_Y), (const char*)(ws + WS_WBRT)}; pg8::EpiBranch E{(const unsigned char*)(ws + WS_GATE), (bf16*)(ws + WS_MIXB)};
        pg8::gemm_phase(F.lds, 1536, BW, BW, S, E); }
}
__device__ __forceinline__ void phase_outproj(const Frame& F, ArgsP kargs, bool dummy = false) {
    if (PH(9)) { FRESH(a); unsigned char* ws = a->ws;
        pg8::TileOrder S{M / 256, 4, F.G, F.bid, (const char*)(ws + WS_MIXB), (const char*)(ws + WS_WOUTT), (size_t)256 * D * 2, (size_t)256 * D * 2};
        (void)dummy; pg8::EpiResid E{(bf16*)(ws + WS_XB), (float*)(ws + WS_XSTAT)}; pg8::gemm_phase(F.lds, 0, D, D, S, E); }
}
__device__ __forceinline__ void phase_dense_conv(const Frame& F, ArgsP kargs, int l, int j2) {
    rx_from_stats(F, kargs);
    conv_flat<1>(F, kargs, l, j2, -1);
}
__device__ __forceinline__ void phase_dense_up(const Frame& F, ArgsP kargs, int l) {
    if (PH(10)) { FRESH(a); unsigned char* ws = a->ws;
        pg8::TileOrder S{M / 256, 2 * DFF / 256, F.G, F.bid, (const char*)(ws + WS_XB), (const char*)(ws + WS_WFFN), (size_t)256 * D * 2, (size_t)256 * D * 2};
        pg8::EpiSwiGLU E{(const float*)(ws + WS_RX), (bf16*)(ws + WS_HFF), DFF, 0}; pg8::gemm_phase(F.lds, D, D, D, S, E); }
    { const int rem = ((M / 256) * (2 * DFF / 256)) % F.G; Frame F2 = F; if (rem != 0) { F2.G = F.G - rem; F2.bid = F.bid - rem; F2.NGW = F2.G * NWAVES; }
      if (rem == 0 || F.bid >= rem) { __syncthreads(); conv_flat<3>(F2, kargs, l, 0, l + 1); } }
}
__device__ __forceinline__ void phase_dense_down(const Frame& F, ArgsP kargs, bool dummy = false) {
    if (PH(11)) { FRESH(a); unsigned char* ws = a->ws;
        pg8::TileOrder S{M / 256, 4, F.G, F.bid, (const char*)(ws + WS_HFF), (const char*)(ws + WS_W2D), (size_t)256 * DFF * 2, (size_t)256 * DFF * 2};
        (void)dummy; pg8::EpiResid E{(bf16*)(ws + WS_XB), (float*)(ws + WS_XSTAT)}; pg8::gemm_phase(F.lds, 0, DFF, DFF, S, E); }
}
__device__ __forceinline__ void phase_moe_route(const Frame& F, ArgsP kargs, int l, int j2) {
    conv_flat<2>(F, kargs, l, j2, l + 1 < DEPTH ? l + 1 : -1);
    __syncthreads();
    LOCAL_IDS; FRESH(a); unsigned char* ws = a->ws; const bf16* X = (const bf16*)(ws + WS_XB);
    float* RX = (float*)(ws + WS_RX); int* TOPI = (int*)(ws + WS_TOPI); float* TOPW = (float*)(ws + WS_TOPW); int* LRANK = (int*)(ws + WS_LRANK); int* BLKCNT = (int*)(ws + WS_BLKCNT);
    LAS int* tope = (LAS int*)(F.lds + 0);
    const float* wr = a->w_router + (size_t)j2 * D * NE; const float* gf = a->g_ffn + l * D;
    f32x4 gvA[4], wA[4][4][2]; u32x2 xn[4];
#pragma unroll
    for (int j = 0; j < 4; ++j) { const int k0 = 4 * lane + 256 * j; gvA[j] = *(const f32x4*)(gf + k0);
#pragma unroll
        for (int q = 0; q < 4; ++q) { wA[j][q][0] = *(const f32x4*)(wr + (size_t)(k0 + q) * 8); wA[j][q][1] = *(const f32x4*)(wr + (size_t)(k0 + q) * 8 + 4); } }
#pragma unroll
    for (int j = 0; j < 4; ++j) xn[j] = *(const u32x2*)(X + (size_t)(F.bid * 64 + wave * 8) * D + 4 * lane + 256 * j);
#pragma unroll 1
    for (int i = 0; i < 8; ++i) { const int rib = wave * 8 + i, row = F.bid * 64 + rib;
        float lg[8]; float ss = 0.f; f32x4 xc[4];
#pragma unroll
        for (int e = 0; e < 8; ++e) lg[e] = 0.f;
#pragma unroll
        for (int j = 0; j < 4; ++j) xc[j] = (f32x4){bflo(xn[j].x), bfhi(xn[j].x), bflo(xn[j].y), bfhi(xn[j].y)};
        if (i + 1 < 8) {
#pragma unroll
            for (int j = 0; j < 4; ++j) xn[j] = *(const u32x2*)(X + (size_t)(row + 1) * D + 4 * lane + 256 * j); }
#pragma unroll
        for (int j = 0; j < 4; ++j) { const f32x4 xv = xc[j], gv = gvA[j]; ss += sumsq4(xv);
#pragma unroll
            for (int q = 0; q < 4; ++q) { const float hv = xv[q] * gv[q]; const f32x4 w0 = wA[j][q][0], w1 = wA[j][q][1];
                lg[0] += hv * w0[0]; lg[1] += hv * w0[1]; lg[2] += hv * w0[2]; lg[3] += hv * w0[3]; lg[4] += hv * w1[0]; lg[5] += hv * w1[1]; lg[6] += hv * w1[2]; lg[7] += hv * w1[3]; } }
        const float r = __builtin_amdgcn_rsqf(wave_sum(ss) * (1.f / D) + EPS);
#pragma unroll
        for (int e = 0; e < 8; ++e) lg[e] = wave_sum(lg[e]) * r;
        int e0 = 0; float v0 = lg[0];
#pragma unroll
        for (int e = 1; e < 8; ++e) if (lg[e] > v0) { v0 = lg[e]; e0 = e; }
        int e1 = e0 == 0 ? 1 : 0; float v1 = -3.0e38f;
#pragma unroll
        for (int e = 0; e < 8; ++e) if (e != e0 && lg[e] > v1) { v1 = lg[e]; e1 = e; }
        const float w0 = 1.f / (1.f + expf(v1 - v0));
        if (lane == 0) { RX[row] = r; TOPI[row] = e0 | (e1 << 8); TOPW[(size_t)row * 2] = w0; TOPW[(size_t)row * 2 + 1] = 1.f - w0; tope[rib] = e0 | (e1 << 8); } }
    __syncthreads();
    if (wave == 0) { const int te = tope[lane], e0 = te & 255, e1 = te >> 8, row = F.bid * 64 + lane; const unsigned long long below = (1ull << lane) - 1ull;
        int rk0 = 0, rk1 = 0;
#pragma unroll
        for (int e = 0; e < 8; ++e) { const unsigned long long m0 = __ballot(e0 == e), m1 = __ballot(e1 == e); const int c0 = __popcll(m0);
            if (e0 == e) rk0 = __popcll(m0 & below); if (e1 == e) rk1 = c0 + __popcll(m1 & below);
            if (lane == 0) BLKCNT[F.bid * 8 + e] = c0 + __popcll(m1); }
        LRANK[(size_t)row * 2] = rk0; LRANK[(size_t)row * 2 + 1] = rk1; }
    __syncthreads();
}
__device__ __forceinline__ void moe_tiles(const Frame& F, ArgsP kargs, int (&tb)[NE + 1], LAS int* pre) {
    LOCAL_IDS; FRESH(a); const int* BLKCNT = (const int*)(a->ws + WS_BLKCNT);
    __syncthreads();
    if (tid < 16) pre[tid] = 0;
    __syncthreads();
    if (tid < 256) { const i32x4 c0 = *(const i32x4*)(BLKCNT + tid * 8), c1 = *(const i32x4*)(BLKCNT + tid * 8 + 4); const int cc[8] = {c0[0], c0[1], c0[2], c0[3], c1[0], c1[1], c1[2], c1[3]};
#pragma unroll
        for (int e = 0; e < 8; ++e) { const int tot = (int)wave_sum((float)cc[e]); const int bel = (int)wave_sum(tid < F.bid ? (float)cc[e] : 0.f);
            if (lane == 0) { __hip_atomic_fetch_add(pre + 8 + e, tot, __ATOMIC_RELAXED, __HIP_MEMORY_SCOPE_WORKGROUP); __hip_atomic_fetch_add(pre + e, bel, __ATOMIC_RELAXED, __HIP_MEMORY_SCOPE_WORKGROUP); } } }
    __syncthreads();
    int acc_t = 0;
#pragma unroll
    for (int e = 0; e < NE; ++e) { tb[e] = acc_t; acc_t += (__builtin_amdgcn_readfirstlane(pre[8 + e]) + 255) >> 8; }
    tb[NE] = acc_t;
}
__device__ __forceinline__ void phase_moe_gather(const Frame& F, ArgsP kargs) {
    int tb[NE + 1]; LAS int* pre = (LAS int*)(F.lds + 0);
    moe_tiles(F, kargs, tb, pre);
    LOCAL_IDS; FRESH(a); unsigned char* ws = a->ws;
    const int* TOPI = (const int*)(ws + WS_TOPI); const int* LRANK = (const int*)(ws + WS_LRANK); int* POS = (int*)(ws + WS_POS); float* SLOTR = (float*)(ws + WS_SLOTR); const float* RX = (const float*)(ws + WS_RX);
    int* TOKOF = (int*)(ws + WS_TOKOF);
    if (lane < 16) { const int pi = wave * 16 + lane, rib = pi >> 1, k = pi & 1, row = F.bid * 64 + rib;
        const int te = TOPI[row], e = k ? (te >> 8) : (te & 255); const int lr = LRANK[(size_t)row * 2 + k]; const float rx = RX[row];
        int bs = 0;
#pragma unroll
        for (int q = 0; q < NE; ++q) if (q == e) bs = tb[q] * 256;
        const int slot = bs + pre[e] + lr;
        POS[(size_t)row * 2 + k] = slot; SLOTR[slot] = rx; TOKOF[slot] = row; }
    if (F.bid < NE) { const int e = F.bid; int b0 = 0, b1 = 0;
#pragma unroll
        for (int q = 0; q < NE; ++q) if (q == e) { b0 = tb[q] * 256; b1 = tb[q + 1] * 256; }
        const int cnt = __builtin_amdgcn_readfirstlane(pre[8 + e]);
        for (int s = b0 + cnt + tid; s < b1; s += NWAVES * 64) { SLOTR[s] = 0.f; TOKOF[s] = 0; } }
    __syncthreads();
}
struct MoeOrder { enum { VARK = 0, GATHER = 0 }; int nN, G, c, T; int tb[NE + 1]; const char* A; const char* B; size_t astep, estep, bstep; int rev = 0;
    __device__ __forceinline__ bool next(int i, pg8::Unit& u) const { const long L = (long)i * G + c; if (L >= (long)T * nN) return false; int pm, pn; pg8::tile_of((int)L, T, nN, pm, pn); if (rev) pm = T - 1 - pm;
        int e = 0;
#pragma unroll
        for (int q = 1; q < NE; ++q) e += (pm >= tb[q]) ? 1 : 0;
        u.pm = pm; u.pn = pn; u.aux = e; u.A = A + (size_t)pm * astep; u.B = B + (size_t)e * estep + (size_t)pn * bstep; return true; } };
struct MoeUpOrder { enum { VARK = 0, GATHER = 1 }; int nN, G, c, T; int tb[NE + 1]; const char* A; const char* B; size_t estep, bstep; const LAS int* tokL;
    __device__ __forceinline__ bool next(int i, pg8::Unit& u) const { const long L = (long)i * G + c; if (L >= (long)T * nN) return false; int pm, pn; pg8::tile_of((int)L, T, nN, pm, pn);
        int e = 0;
#pragma unroll
        for (int q = 1; q < NE; ++q) e += (pm >= tb[q]) ? 1 : 0;
        u.pm = pm; u.pn = pn; u.aux = e; u.A = A; u.B = B + (size_t)e * estep + (size_t)pn * bstep; return true; } };
struct MoeTailOrder { enum { VARK = 1, GATHER = 0 }; static constexpr int PPU = DFE / 128;
    int nN, G, c, T; int tb[NE + 1]; const char* A; const char* B; size_t astep, estep, bstep; int rev = 0;
    __device__ __forceinline__ bool next(int i, pg8::Unit& u) const {
        const int U = T * nN, R = U / G, Lf = U - R * G, x = c & 7, j = c >> 3, nj = (G - x + 7) >> 3;
        const int Lfx = Lf > x ? (Lf - x + 7) >> 3 : 0;
        long L; int k0 = 0, np = PPU, part = 0, k = 0, r = 0, C = 1;
        if (i < R) L = (long)i * G + c;
        else if (i == R && Lfx > 0) { const int cap = nj / Lfx; C = cap >= 8 ? 8 : cap >= 1 ? cap : 1;
            r = j / C; k = j - r * C; if (r >= Lfx) return false;
            L = (long)R * G + x + 8 * r; if (C > 1) { const int q = PPU / C, rem = PPU - q * C; np = q + (k < rem ? 1 : 0); k0 = k * q + (k < rem ? k : rem); part = 3; } }
        else return false;
        int pm, pn; pg8::tile_of((int)L, T, nN, pm, pn); if (rev) pm = T - 1 - pm;
        int e = 0;
#pragma unroll
        for (int q = 1; q < NE; ++q) e += (pm >= tb[q]) ? 1 : 0;
        u.pm = pm; u.pn = pn; u.aux = e | (part << 4) | (k << 8) | (C << 16) | (r << 24); u.nt = 2 * np;
        u.A = A + (size_t)pm * astep + (size_t)k0 * 65536; u.B = B + (size_t)e * estep + (size_t)pn * bstep + (size_t)k0 * 65536; return true; } };
__device__ __forceinline__ void phase_moe_up(const Frame& F, ArgsP kargs) {
    if (PH(12)) { MoeUpOrder S; LAS int* pre = (LAS int*)(F.lds + RING_BYTES + 64); moe_tiles(F, kargs, S.tb, pre);
        FRESH(a); unsigned char* ws = a->ws; S.nN = 2 * DFE / 256; S.G = F.G; S.c = F.bid; S.T = S.tb[NE];
        S.A = (const char*)(ws + WS_XB); S.B = (const char*)(ws + WS_WFFN); S.estep = (size_t)2 * DFE * D * 2; S.bstep = (size_t)256 * D * 2;
        { LAS int* tokL = (LAS int*)(F.lds + RING_BYTES + 1024); S.tokL = tokL; const int* TOKOF = (const int*)(ws + WS_TOKOF);
          int tid_ = threadIdx.x; asm volatile("" : "+v"(tid_)); const int half_ = __builtin_amdgcn_readfirstlane(tid_ >> 8); int tkv[8];
#pragma unroll
          for (int j = 0; j < 8; ++j) { pg8::Unit u; const bool ok = S.next(2 * j + half_, u); tkv[j] = ok ? TOKOF[u.pm * 256 + (tid_ & 255)] : 0; }
#pragma unroll
          for (int j = 0; j < 8; ++j) tokL[(2 * j + half_) * 256 + (tid_ & 255)] = tkv[j];
          __syncthreads(); }
        pg8::EpiSwiGLU E{(const float*)(ws + WS_SLOTR), (bf16*)(ws + WS_HG), DFE, 0}; pg8::gemm_phase(F.lds, D, D, D, S, E); }
}
__device__ __forceinline__ void phase_moe_down(const Frame& F, ArgsP kargs, int j2) {
    if (PH(13)) { MoeTailOrder S; LAS int* pre = (LAS int*)(F.lds + RING_BYTES + 64); moe_tiles(F, kargs, S.tb, pre);
        FRESH(a); unsigned char* ws = a->ws; S.nN = 4; S.G = F.G; S.c = F.bid; S.T = S.tb[NE]; S.rev = 1;
        S.A = (const char*)(ws + WS_HG); S.B = (const char*)(ws + WS_W2M); S.astep = (size_t)256 * DFE * 2; S.estep = (size_t)D * DFE * 2; S.bstep = (size_t)256 * DFE * 2;
        pg8::EpiBf16KS E{(bf16*)(ws + WS_OUTG), D, (float*)(ws + WS_SKPART), (unsigned*)(ws + WS_CTL) + CW_SK + j2 * 512, F.bid}; pg8::gemm_phase(F.lds, 0, DFE, DFE, S, E); }
}
__device__ __forceinline__ void phase_moe_combine(const Frame& F, ArgsP kargs, bool last) {
    LOCAL_IDS; FRESH(a); unsigned char* ws = a->ws; float* OUT = a->out; const bf16* OUTG = (const bf16*)(ws + WS_OUTG); const int* POS = (const int*)(ws + WS_POS); const float* TOPW = (const float*)(ws + WS_TOPW);
    bf16* XB = (bf16*)(ws + WS_XB); float* RX = (float*)(ws + WS_RX); const float* g_final = a->g_final;
    int s0n, s1n; float w0n, w1n, w0c, w1c; u32x2 pn0[4], pn1[4], xn[4];
    { const int s0 = POS[(size_t)gw * 2], s1 = POS[(size_t)gw * 2 + 1]; w0c = TOPW[(size_t)gw * 2]; w1c = TOPW[(size_t)gw * 2 + 1];
      const int m1 = gw + F.NGW < M ? gw + F.NGW : gw; s0n = POS[(size_t)m1 * 2]; s1n = POS[(size_t)m1 * 2 + 1]; w0n = TOPW[(size_t)m1 * 2]; w1n = TOPW[(size_t)m1 * 2 + 1];
#pragma unroll
      for (int j = 0; j < 4; ++j) { pn0[j] = ((const u32x2*)(OUTG + (size_t)s0 * D) + lane)[64 * j]; pn1[j] = ((const u32x2*)(OUTG + (size_t)s1 * D) + lane)[64 * j]; xn[j] = ((const u32x2*)(XB + (size_t)gw * D) + lane)[64 * j]; } }
#pragma unroll 1
    for (int m = gw; m < M; m += F.NGW) {
        const float w0 = w0c, w1 = w1c; u32x2 p0c[4], p1c[4], xc[4];
#pragma unroll
        for (int j = 0; j < 4; ++j) { p0c[j] = pn0[j]; p1c[j] = pn1[j]; xc[j] = xn[j]; }
        { const int mn = m + F.NGW < M ? m + F.NGW : m, mnn = m + 2 * F.NGW < M ? m + 2 * F.NGW : m; const int s0 = s0n, s1 = s1n; w0c = w0n; w1c = w1n;
#pragma unroll
          for (int j = 0; j < 4; ++j) { pn0[j] = ((const u32x2*)(OUTG + (size_t)s0 * D) + lane)[64 * j]; pn1[j] = ((const u32x2*)(OUTG + (size_t)s1 * D) + lane)[64 * j]; xn[j] = ((const u32x2*)(XB + (size_t)mn * D) + lane)[64 * j]; }
          s0n = POS[(size_t)mnn * 2]; s1n = POS[(size_t)mnn * 2 + 1]; w0n = TOPW[(size_t)mnn * 2]; w1n = TOPW[(size_t)mnn * 2 + 1]; }
        f32x4 v[4]; float s = 0.f;
#pragma unroll
        for (int j = 0; j < 4; ++j) { const u32x2 p0 = p0c[j], p1 = p1c[j];
            const f32x4 o0 = {bflo(p0.x), bfhi(p0.x), bflo(p0.y), bfhi(p0.y)}, o1 = {bflo(p1.x), bfhi(p1.x), bflo(p1.y), bfhi(p1.y)};
            const f32x4 xf = {bflo(xc[j].x), bfhi(xc[j].x), bflo(xc[j].y), bfhi(xc[j].y)}; v[j] = xf + w0 * o0 + w1 * o1; s += sumsq4(v[j]); }
        const float r = __builtin_amdgcn_rsqf(wave_sum(s) * (1.f / D) + EPS);
        if (last) {
#pragma unroll
            for (int j = 0; j < 4; ++j) ((f32x4*)(OUT + (size_t)m * D) + lane)[64 * j] = v[j] * r * ((const f32x4*)g_final + lane)[64 * j];
        } else {
#pragma unroll
            for (int j = 0; j < 4; ++j) ((u32x2*)(XB + (size_t)m * D) + lane)[64 * j] = (u32x2){cvt_pk_bf16(v[j][0], v[j][1]), cvt_pk_bf16(v[j][2], v[j][3])};
            if (lane == 0) RX[m] = r;
        }
    }
}


#ifdef DBG_ENABLE
__device__ __forceinline__ float dbg_b(const unsigned char* ws, size_t off, size_t idx) { return bf2f(((const bf16*)(ws + off))[idx]); }
__device__ __forceinline__ void dbg_dump(const Frame& F, ArgsP kargs, int code) {
    LOCAL_IDS; FRESH(a); const unsigned char* ws = a->ws; float* out = a->out;
    unsigned tmo = ((const unsigned*)(ws + WS_CTL))[CW_BAR + XB_TMO];
    for (size_t i = (size_t)F.bid * 512 + tid; i < (size_t)M * D; i += (size_t)F.G * 512) { const size_t row = i >> 10, c = i & 1023; float v = 0.f;
        if (code == 1) v = dbg_b(ws, WS_CQ, row * 512 + (c & 511)) + dbg_b(ws, WS_CKV, row * 256 + (c & 255)) + dbg_b(ws, WS_U, row * 512 + (c & 511)) + dbg_b(ws, WS_VR, row * 512 + (c & 511)) + dbg_b(ws, WS_QX, row * 512 + (c & 511))
                         + dbg_b(ws, WS_GATE, row * 3072 + c) + dbg_b(ws, WS_GATE, row * 3072 + 1024 + c) + dbg_b(ws, WS_GATE, row * 3072 + 2048 + c) + dbg_b(ws, WS_KR, row * 32 + (c & 31));
        else if (code == 2) v = dbg_b(ws, WS_Q, row * 768 + (c % 768)) + dbg_b(ws, WS_KN, row * 512 + (c & 511)) + dbg_b(ws, WS_V, row * 512 + (c & 511)) + dbg_b(ws, WS_Y, row * 1536 + 512 + c);
        else if (code == 3) v = dbg_b(ws, WS_Y, row * 1536 + (c & 511));
        else if (code == 15) v = dbg_b(ws, WS_WINT, i % ((size_t)PPAD * D));
        else if (code == 13 || code == 14) v = dbg_b(ws, WS_GATE, row * 3072 + c) + dbg_b(ws, WS_GATE, row * 3072 + 1024 + c) + dbg_b(ws, WS_GATE, row * 3072 + 2048 + c);
        else if (code == 4) v = dbg_b(ws, WS_MIXB, row * 1024 + c);
        else if (code == 6) v = dbg_b(ws, WS_HFF, row * 2688 + c) + dbg_b(ws, WS_HFF, row * 2688 + 1024 + c) + dbg_b(ws, WS_HFF, row * 2688 + 1664 + c);
        else if (code == 9) { const int s0 = ((const int*)(ws + WS_POS))[row * 2], s1 = ((const int*)(ws + WS_POS))[row * 2 + 1]; v = dbg_b(ws, WS_XG, (size_t)s0 * 1024 + c) + 2.f * dbg_b(ws, WS_XG, (size_t)s1 * 1024 + c) + ((const float*)(ws + WS_TOPW))[row * 2] + (float)s0 * 1e-3f; }
        else if (code == 10) { const int s0 = ((const int*)(ws + WS_POS))[row * 2], s1 = ((const int*)(ws + WS_POS))[row * 2 + 1]; v = dbg_b(ws, WS_HG, (size_t)s0 * 3584 + c) + dbg_b(ws, WS_HG, (size_t)s1 * 3584 + 2560 + c) + dbg_b(ws, WS_HG, (size_t)s0 * 3584 + 1500 + c); }
        else if (code == 11) { const int s0 = ((const int*)(ws + WS_POS))[row * 2], s1 = ((const int*)(ws + WS_POS))[row * 2 + 1]; v = ((const float*)(ws + WS_OUTG))[(size_t)s0 * 1024 + c] + ((const float*)(ws + WS_OUTG))[(size_t)s1 * 1024 + c]; }
        else continue;
        if (tmo) v = __builtin_nanf("");
        out[i] = v; }
}
#define DBG(code) do { if (dbgc == (code)) { dbg_dump(F, kargs, code); return; } } while (0)
#else
#define DBG(code) do { } while (0)
#endif

__global__ void __launch_bounds__(NWAVES * 64, 2) fwd_kernel(Args args_by_value) {
    extern __shared__ __attribute__((aligned(16))) unsigned char lds_raw[];
    const ArgsP kargs = (ArgsP)__builtin_amdgcn_kernarg_segment_ptr();
    Frame F; F.lds = (LAS unsigned char*)lds_raw; F.G = gridDim.x; F.bid = blockIdx.x; F.NGW = F.G * NWAVES;
    for (int u = threadIdx.x; u < (LDS_BYTES - LDSCTL_OFF) / 4; u += NWAVES * 64) ((LAS unsigned*)(F.lds + LDSCTL_OFF))[u] = 0u;
    __syncthreads();
    volatile LAS unsigned* MISC = (volatile LAS unsigned*)(F.lds + MISC_OFF);
    XcdBarrier bar; { FRESH(a); bar = xcd_barrier_post((unsigned*)(a->ws + WS_CTL) + CW_BAR, MISC + 8); }
#define GRID_BAR() xcd_barrier(bar)

#ifdef ONLY_TEST
    ONLY_TEST; GRID_BAR(); return;
#endif
    const Frame F_ = F;
    int dbgc; { FRESH(a); dbgc = a->dbg; } (void)dbgc;
    phase_prologue(F, kargs); GRID_BAR();
#pragma unroll 1
    for (int l_ = 0; l_ < DEPTH; ++l_) {
        Frame F = F_; int l = l_; asm volatile("" : "+s"(F.G), "+s"(F.NGW), "+s"(F.bid), "+s"(l));
        const bool moe = (l & 1) != 0; const int j2 = l >> 1;
        if (l == 0) DBG(15);
#ifdef PROBE_INPROJ2
        { int reps = 2; asm volatile("" : "+s"(reps));
#pragma unroll 1
          for (int rep = 0; rep < reps; ++rep) { phase_inproj(F, kargs, l); GRID_BAR(); } }
#else
        phase_inproj(F, kargs, l); GRID_BAR(); if (l == 0) DBG(1); if (l == 0) DBG(14);
#endif
        phase_up(F, kargs, l); GRID_BAR(); if (l == 0) DBG(2);
        phase_attn(F, kargs, l); GRID_BAR(); if (l == 0) DBG(3); if (l == 0) DBG(13);
#ifdef PROBE_ATTN2
        phase_attn(F, kargs, l); GRID_BAR();
#endif
#ifdef PROBE_UP2
        phase_up(F, kargs, l); GRID_BAR();
#endif
        phase_branch(F, kargs); GRID_BAR(); if (l == 0) DBG(4);
#ifdef PROBE_RESID2
        { int reps = 2; asm volatile("" : "+s"(reps));
#pragma unroll 1
          for (int rep = reps - 1; rep >= 0; --rep) { phase_outproj(F, kargs, rep != 0); GRID_BAR(); } }
#else
        phase_outproj(F, kargs); GRID_BAR(); if (l == 0) DBG(5); if (l == 1) DBG(8);
#endif
        if (!moe) {
            phase_dense_conv(F, kargs, l, j2); GRID_BAR();
            phase_dense_up(F, kargs, l); GRID_BAR(); if (l == 0) DBG(6);
#ifdef PROBE_DENSE2
            phase_dense_up(F, kargs, l); GRID_BAR();
#endif
#ifdef PROBE_RESID2
            { int reps = 2; asm volatile("" : "+s"(reps));
#pragma unroll 1
              for (int rep = reps - 1; rep >= 0; --rep) { phase_dense_down(F, kargs, rep != 0); GRID_BAR(); } }
#else
            phase_dense_down(F, kargs); GRID_BAR(); if (l == 0) DBG(7);
#endif
        } else {
            phase_moe_route(F, kargs, l, j2); GRID_BAR();
            phase_moe_gather(F, kargs); GRID_BAR(); if (l == 1) DBG(9);
#ifdef PROBE_AUX2
            phase_moe_gather(F, kargs); GRID_BAR();
#endif
            phase_moe_up(F, kargs); GRID_BAR(); if (l == 1) DBG(10);
            phase_moe_down(F, kargs, j2); GRID_BAR(); if (l == 1) DBG(11);
#ifdef PROBE_MOE2
            phase_moe_up(F, kargs); GRID_BAR();
            phase_moe_down(F, kargs, j2); GRID_BAR();
#endif
            phase_moe_combine(F, kargs, l == DEPTH - 1);
            if (l != DEPTH - 1) GRID_BAR();
            if (l == 1) DBG(12);
        }
    }
}

extern "C" void kernel_launch(void* const* d_in, const int* in_sizes, int n_in, void* d_out, int out_size, void* d_ws, size_t ws_size, hipStream_t stream) {
    static int grid = 0;
    if (grid == 0) {
        if (n_in != 27 || in_sizes[0] != M * D || out_size != M * D || ws_size < WS_END) { fprintf(stderr, "kernel_launch: unexpected shapes (n_in %d, in0 %d, out %d, ws %zu)\n", n_in, n_in > 0 ? in_sizes[0] : -1, out_size, ws_size); grid = -1; return; }
        int dev = 0, cus = 0, per_cu = 0;
        if (hipGetDevice(&dev) != hipSuccess || hipDeviceGetAttribute(&cus, hipDeviceAttributeMultiprocessorCount, dev) != hipSuccess) { grid = -1; return; }
        if (hipFuncSetAttribute((const void*)fwd_kernel, hipFuncAttributeMaxDynamicSharedMemorySize, LDS_BYTES) != hipSuccess) { fprintf(stderr, "kernel_launch: hipFuncSetAttribute failed\n"); grid = -1; return; }
        if (hipOccupancyMaxActiveBlocksPerMultiprocessor(&per_cu, (const void*)fwd_kernel, NWAVES * 64, LDS_BYTES) != hipSuccess || per_cu < 1) { fprintf(stderr, "kernel_launch: occupancy query reports %d\n", per_cu); }
        (void)hipGetLastError();
        if (cus != 256) { fprintf(stderr, "kernel_launch: built for 256 CUs, device has %d\n", cus); grid = -1; return; }
        grid = 256;
    }
    if (grid < 0) return;
    if (hipMemsetAsync((char*)d_ws + WS_CTL, 0, CTL_ZERO_BYTES, stream) != hipSuccess) return;
    Args a{};
    a.x = (const float*)d_in[0]; a.mem = (const float*)d_in[1]; a.positions = (const int*)d_in[2]; a.g_mix = (const float*)d_in[3]; a.w_in = (const float*)d_in[4]; a.g_q = (const float*)d_in[5];
    a.g_kv = (const float*)d_in[6]; a.w_uq = (const float*)d_in[7]; a.w_uk = (const float*)d_in[8]; a.w_uv = (const float*)d_in[9]; a.g_sg = (const float*)d_in[10]; a.w_s = (const float*)d_in[11];
    a.b_s = (const float*)d_in[12]; a.g_mem = (const float*)d_in[13]; a.w_mkv = (const float*)d_in[14]; a.w_br = (const float*)d_in[15]; a.b_gate = (const float*)d_in[16]; a.w_out = (const float*)d_in[17];
    a.g_ffn = (const float*)d_in[18]; a.dense_w1 = (const float*)d_in[19]; a.dense_w3 = (const float*)d_in[20]; a.dense_w2 = (const float*)d_in[21]; a.w_router = (const float*)d_in[22];
    a.moe_w1 = (const float*)d_in[23]; a.moe_w3 = (const float*)d_in[24]; a.moe_w2 = (const float*)d_in[25]; a.g_final = (const float*)d_in[26];
    a.out = (float*)d_out; a.ws = (unsigned char*)d_ws;
#ifdef DBG_STOP
    a.dbg = DBG_STOP;
#endif
    hipLaunchKernelGGL(fwd_kernel, dim3(grid), dim3(NWAVES * 64), LDS_BYTES, stream, a);
    const hipError_t le = hipPeekAtLastError();
    if (le != hipSuccess) fprintf(stderr, "kernel_launch: launch failed: %s\n", hipGetErrorName(le));
}
```

```cpp
#include <hip/hip_runtime.h>
#include <cstdio>
#include <cstdint>

#ifndef PH_MASK
#define PH_MASK 0xffffffffu
#endif
#define PH(k) ((PH_MASK >> (k)) & 1u)
#define LAS __attribute__((address_space(3)))
#define GAS __attribute__((address_space(1)))
typedef unsigned short bf16;
typedef short bf16x8 __attribute__((ext_vector_type(8)));
typedef short s16x4 __attribute__((ext_vector_type(4)));
typedef float f32x4 __attribute__((ext_vector_type(4)));
typedef float f32x2 __attribute__((ext_vector_type(2)));
typedef float f32x16 __attribute__((ext_vector_type(16)));
typedef unsigned u32x4 __attribute__((ext_vector_type(4)));
typedef unsigned u32x2 __attribute__((ext_vector_type(2)));
typedef int i32x4 __attribute__((ext_vector_type(4)));

constexpr int M = 16384, D = 1024, DEPTH = 4, NMEM = 256;
constexpr int QRANK = 384, KVRANK = 256, NH = 8, QKD = 96, VD = 64;
constexpr int XH = 4, XD = 128, BW = 512;
constexpr int PTOT = 5280, PPAD = 5376, DFF = 2688, NE = 8, DFE = 3584;
constexpr float EPS = 1e-6f;
constexpr int MAXSLOT = 34816;
constexpr float LOG2E = 1.4426950408889634f;
constexpr float QSCALE = 0.10206207261596575f * LOG2E;
constexpr float XSCALE = 0.08838834764831845f * LOG2E;

constexpr size_t MiB = 1u << 20, KiB = 1u << 10;
constexpr size_t WS_CTL = 0, CTL_ZERO_BYTES = 128 * KiB;
constexpr size_t WS_ROPE = 2 * MiB;
constexpr size_t WS_XSTAT = 4 * MiB;
constexpr size_t WS_RX = 5 * MiB;
constexpr size_t WS_CQSTAT = 5 * MiB + 256 * KiB;
constexpr size_t WS_CKVSTAT = 5 * MiB + 768 * KiB;
constexpr size_t WS_VSTAT = 6 * MiB;
constexpr size_t WS_MEMB = 6 * MiB + 512 * KiB;
constexpr size_t WS_KVMEM = 7 * MiB;
constexpr size_t WS_TOPI = 9 * MiB;
constexpr size_t WS_TOPW = 9 * MiB + 256 * KiB;
constexpr size_t WS_LRANK = 9 * MiB + 512 * KiB;
constexpr size_t WS_POS = 9 * MiB + 768 * KiB;
constexpr size_t WS_BLKCNT = 10 * MiB;
constexpr size_t WS_SLOTR = 10 * MiB + 512 * KiB;
constexpr size_t WS_TOKOF = 10 * MiB + 768 * KiB;
constexpr size_t WS_WSB = 11 * MiB;
constexpr size_t WS_WMKVT = 12 * MiB;
constexpr size_t WS_WINT = 20 * MiB;
constexpr size_t WS_WUQT = 31 * MiB;
constexpr size_t WS_WUKVT = 32 * MiB;
constexpr size_t WS_WBRT = 33 * MiB;
constexpr size_t WS_WOUTT = 36 * MiB;
constexpr size_t WS_WFFN = 40 * MiB;
constexpr size_t WS_W2D = WS_WFFN + 11 * MiB;
constexpr size_t WS_W2M = WS_WFFN + 112 * MiB;
constexpr size_t WS_XB = 208 * MiB;
constexpr size_t WS_CQ = 240 * MiB;
constexpr size_t WS_CKV = 256 * MiB;
constexpr size_t WS_U = 264 * MiB;
constexpr size_t WS_VR = 280 * MiB;
constexpr size_t WS_QX = 296 * MiB;
constexpr size_t WS_GATE = 312 * MiB;
constexpr size_t WS_Q = 408 * MiB;
constexpr size_t WS_KN = 432 * MiB;
constexpr size_t WS_KR = 448 * MiB;
constexpr size_t WS_V = 450 * MiB;
constexpr size_t WS_Y = 466 * MiB;
constexpr size_t WS_MIX = 514 * MiB;
constexpr size_t WS_MIXB = 578 * MiB;
constexpr size_t WS_MIX1 = 610 * MiB;
constexpr size_t WS_HFF = 240 * MiB;
constexpr size_t WS_XG = 240 * MiB;
constexpr size_t WS_HG = 308 * MiB;
constexpr size_t WS_OUTG = 546 * MiB;
constexpr size_t WS_END = 682 * MiB;
constexpr int CW_TMO = 0, CW_CODE = 1, CW_CHK = 2, CW_BAR = 4096;
constexpr int CW_SK = 16384;
constexpr size_t WS_SKPART = 700 * MiB;
constexpr int CW_KMAX = 8192;

constexpr int RING_BYTES = 131072, LDSCTL_OFF = 159744, MISC_OFF = LDSCTL_OFF + 320, LDS_BYTES = 163840;
constexpr int NWAVES = 8;

#define RLX_AGENT __ATOMIC_RELAXED, __HIP_MEMORY_SCOPE_AGENT
#define LDS_WAIT() asm volatile("s_waitcnt lgkmcnt(0)" ::: "memory")
#define VM_WAIT() asm volatile("s_waitcnt vmcnt(0)" ::: "memory")
typedef __bf16 bf16x2_t __attribute__((ext_vector_type(2)));
__device__ __forceinline__ unsigned cvt_pk_bf16(float lo, float hi) { const f32x2 v = {lo, hi}; const bf16x2_t b = __builtin_convertvector(v, bf16x2_t); return __builtin_bit_cast(unsigned, b); }
__device__ __forceinline__ bf16 f2bf(float f) { return (bf16)(cvt_pk_bf16(f, 0.f) & 0xffffu); }
__device__ __forceinline__ float bf2f(bf16 v) { return __uint_as_float((unsigned)v << 16); }
__device__ __forceinline__ float bflo(unsigned w) { return __uint_as_float(w << 16); }
__device__ __forceinline__ float bfhi(unsigned w) { return __uint_as_float(w & 0xffff0000u); }
__device__ __forceinline__ float fast_exp2(float x) { return __builtin_amdgcn_exp2f(x); }
__device__ __forceinline__ float fast_rcp(float x) { return __builtin_amdgcn_rcpf(x); }
__device__ __forceinline__ float sigmoidf_(float z) { return fast_rcp(1.f + fast_exp2(-LOG2E * z)); }
__device__ __forceinline__ float gelu_tanh(float x) { const float t = x + 0.044715f * x * x * x; return x * fast_rcp(1.f + fast_exp2(-2.f * 0.7978845608028654f * LOG2E * t)); }
template <int CTRL> __device__ __forceinline__ float dppf(float v) { return __builtin_bit_cast(float, __builtin_amdgcn_update_dpp(0, __builtin_bit_cast(int, v), CTRL, 0xf, 0xf, true)); }
__device__ __forceinline__ float row_sum16(float v) { v += dppf<0xB1>(v); v += dppf<0x4E>(v); v += dppf<0x124>(v); v += dppf<0x128>(v); return v; }
__device__ __forceinline__ float row_max16(float v) { v = fmaxf(v, dppf<0xB1>(v)); v = fmaxf(v, dppf<0x4E>(v)); v = fmaxf(v, dppf<0x124>(v)); v = fmaxf(v, dppf<0x128>(v)); return v; }
__device__ __forceinline__ float xsum16(float v) { const auto r = __builtin_amdgcn_permlane16_swap(__float_as_uint(v), __float_as_uint(v), false, false); return __uint_as_float(r[0]) + __uint_as_float(r[1]); }
__device__ __forceinline__ float xsum32(float v) { const auto r = __builtin_amdgcn_permlane32_swap(__float_as_uint(v), __float_as_uint(v), false, false); return __uint_as_float(r[0]) + __uint_as_float(r[1]); }
__device__ __forceinline__ float wave_sum(float v) { return xsum32(xsum16(row_sum16(v))); }
__device__ __forceinline__ float sumsq4(f32x4 v) { return (v[0] * v[0] + v[1] * v[1]) + (v[2] * v[2] + v[3] * v[3]); }
__device__ __forceinline__ u32x2 pack8_u8(f32x4 a, f32x4 b) { unsigned w0 = 0, w1 = 0; a = a * 255.f; b = b * 255.f;
    w0 = __builtin_amdgcn_cvt_pk_u8_f32(a[0], 0, w0); w0 = __builtin_amdgcn_cvt_pk_u8_f32(a[1], 1, w0); w0 = __builtin_amdgcn_cvt_pk_u8_f32(a[2], 2, w0); w0 = __builtin_amdgcn_cvt_pk_u8_f32(a[3], 3, w0);
    w1 = __builtin_amdgcn_cvt_pk_u8_f32(b[0], 0, w1); w1 = __builtin_amdgcn_cvt_pk_u8_f32(b[1], 1, w1); w1 = __builtin_amdgcn_cvt_pk_u8_f32(b[2], 2, w1); w1 = __builtin_amdgcn_cvt_pk_u8_f32(b[3], 3, w1);
    return (u32x2){w0, w1}; }
__device__ __forceinline__ void unpack8_u8(u32x2 w, f32x4& a, f32x4& b) { constexpr float k = 1.f / 255.f;
    a = (f32x4){(float)(w.x & 255u), (float)((w.x >> 8) & 255u), (float)((w.x >> 16) & 255u), (float)(w.x >> 24)} * k;
    b = (f32x4){(float)(w.y & 255u), (float)((w.y >> 8) & 255u), (float)((w.y >> 16) & 255u), (float)(w.y >> 24)} * k; }
__device__ __forceinline__ u32x4 pack8(f32x4 a, f32x4 b) { u32x4 w; w.x = cvt_pk_bf16(a[0], a[1]); w.y = cvt_pk_bf16(a[2], a[3]); w.z = cvt_pk_bf16(b[0], b[1]); w.w = cvt_pk_bf16(b[2], b[3]); return w; }
__device__ __forceinline__ void unpack8(u32x4 w, f32x4& a, f32x4& b) { a = (f32x4){bflo(w.x), bfhi(w.x), bflo(w.y), bfhi(w.y)}; b = (f32x4){bflo(w.z), bfhi(w.z), bflo(w.w), bfhi(w.w)}; }

namespace pg8 {
constexpr int BM = 256, BK = 64, HALF = 128, HTB = HALF * BK * 2, STAGE_BYTES = 8 * HTB, NXCD = 8, WGM = 8;
__host__ __device__ __forceinline__ int lds_byte(int r, int c) { const int st = (r >> 4) * 2 + (c >> 5), rr = r & 15, cc = c & 31, ob = rr * 64 + cc * 2; return st * 1024 + (ob ^ (((ob >> 9) & 1) << 5)); }
__host__ __device__ __forceinline__ void stage_rc(int b, int& R, int& C) { const int st = b / 1024, sb = b % 1024, swz = sb ^ (((sb >> 9) & 1) << 5); R = (st >> 1) * 16 + swz / 64; C = (st & 1) * 32 + (swz % 64) / 2; }
__host__ __device__ __forceinline__ int perm32(int rho) { const int n = rho >> 4, i = rho & 15; return 8 * (i >> 2) + 4 * n + (i & 3); }

struct Unit { const char* A; const char* B; int pm, pn, aux, nt; };
typedef f32x4 Acc[2][2][4][2];

__device__ __forceinline__ void tile_of(int L, int nM, int nN, int& pm, int& pn) {
    const int nwg = nM * nN; int wgid = L;
    { const int q = nwg / NXCD, r = nwg % NXCD, xcd = wgid % NXCD, off = wgid / NXCD; wgid = (xcd < r ? xcd * (q + 1) : r * (q + 1) + (xcd - r) * q) + off; }
    const int nig = WGM * nN, gid = wgid / nig, fm = gid * WGM, gsz = (nM - fm) < WGM ? (nM - fm) : WGM;
    pm = fm + ((wgid % nig) % gsz); pn = (wgid % nig) / gsz;
}
struct TileOrder {
    enum { VARK = 0, GATHER = 0 };
    int nM, nN, G, c; const char* A; const char* B; size_t astep, bstep;
    int rev = 0;
    __device__ __forceinline__ bool next(int i, Unit& u) const {
        if (rev) { const int cnt = (nM * nN - c + G - 1) / G; if (i >= cnt) return false; i = cnt - 1 - i; }
        const long L = (long)i * G + c; if (L >= (long)nM * nN) return false;
        int pm, pn; tile_of((int)L, nM, nN, pm, pn);
        u.pm = pm; u.pn = pn; u.aux = i; u.A = A + (size_t)pm * astep; u.B = B + (size_t)pn * bstep; return true;
    }
};

template <class Epi, class Sched>
__device__ __forceinline__ void gemm_phase(LAS unsigned char* lds, const int lda, const int ldb, const int K, const Sched& S, const Epi& E) {
    int tid_ = threadIdx.x; asm volatile("" : "+v"(tid_));
    const int tid = tid_, wid = __builtin_amdgcn_readfirstlane(tid >> 6), lane = tid & 63, wr = wid >> 2, wc = wid & 3, fr = lane & 15, fq = lane >> 4;
    int nt = K / BK;
    unsigned voffA[2], voffB[2];
#pragma unroll
    for (int i = 0; i < 2; ++i) { int R, C; stage_rc(tid * 16 + i * 8192, R, C); const int Rb = (R & ~31) + perm32(R & 31);
        voffA[i] = (unsigned)(R * (lda ? lda : BK) + C) * 2u; voffB[i] = (unsigned)(Rb * BK + C) * 2u; }
    const size_t kstep = lda ? (size_t)(BK * 2) : (size_t)BM * BK * 2;
    const size_t hstepA = (size_t)HALF * (lda ? lda : BK) * 2, hstepB = (size_t)HALF * BK * 2, kstepB = (size_t)BM * BK * 2; (void)ldb;
    const unsigned ldsw = (unsigned)wid * 1024u;
    const int aoff = lds_byte(wr * 64 + fr, fq * 8), boff = lds_byte(wc * 32 + fr, fq * 8);
#define PG8_SA(b, h) (((b) * 2 + (h)) * HTB)
#define PG8_SB(b, h) ((4 + (b) * 2 + (h)) * HTB)
#define PG8_STAGE(bufoff, gbase, voff) do { _Pragma("unroll") for (int _i = 0; _i < 2; ++_i) \
        __builtin_amdgcn_global_load_lds((const unsigned*)((const char*)(gbase) + (voff)[_i]), (LAS unsigned*)(lds + (bufoff) + ldsw + _i * 8192), 16, 0, 0); } while (0)
#define PG8_STA(b, h, kptr, VG) do { if constexpr (Sched::GATHER) PG8_STAGE(PG8_SA(b, h), (kptr), VG[h]); else PG8_STAGE(PG8_SA(b, h), (kptr) + (h) * hstepA, voffA); } while (0)
#define PG8_GLOOKUP(VG, ui_) do { _Pragma("unroll") for (int _h = 0; _h < 2; ++_h) _Pragma("unroll") for (int _i = 0; _i < 2; ++_i) { int R_, C_; stage_rc(tid * 16 + _i * 8192, R_, C_); \
        VG[_h][_i] = (unsigned)S.tokL[(ui_) * 256 + _h * 128 + R_] * (unsigned)(lda * 2) + (unsigned)(C_ * 2); } } while (0)
#define PG8_LDA(dst, b, h) do { _Pragma("unroll") for (int m = 0; m < 4; ++m) _Pragma("unroll") for (int k = 0; k < 2; ++k) dst[m][k] = *(const LAS bf16x8*)(lds + PG8_SA(b, h) + aoff + m * 2048 + k * 1024); } while (0)
#define PG8_LDB(dst, b, h) do { _Pragma("unroll") for (int n = 0; n < 2; ++n) _Pragma("unroll") for (int k = 0; k < 2; ++k) dst[n][k] = *(const LAS bf16x8*)(lds + PG8_SB(b, h) + boff + n * 2048 + k * 1024); } while (0)
#define PG8_MMA(ai, bj, At, Bt) do { __builtin_amdgcn_s_setprio(1); _Pragma("unroll") for (int m = 0; m < 4; ++m) _Pragma("unroll") for (int n = 0; n < 2; ++n) _Pragma("unroll") for (int k = 0; k < 2; ++k) \
        acc[ai][bj][m][n] = __builtin_amdgcn_mfma_f32_16x16x32_bf16(Bt[n][k], At[m][k], acc[ai][bj][m][n], 0, 0, 0); __builtin_amdgcn_s_setprio(0); } while (0)
#define PG8_WAIT_V(n) asm volatile("s_waitcnt vmcnt(" #n ")" ::: "memory")
#define PG8_WAIT_L(n) asm volatile("s_waitcnt lgkmcnt(" #n ")" ::: "memory")
#define PG8_BAR __builtin_amdgcn_s_barrier()
#define PG8_SCHED __builtin_amdgcn_sched_barrier(0)
    Unit cur, nxt; int ui = 0;
    if (!S.next(0, cur)) return;
    if constexpr (Sched::VARK) nt = cur.nt;
    typename Epi::Pre pre = E.prefetch(cur, wr, fr);
    Acc acc;
#pragma unroll
    for (int a = 0; a < 2; ++a)
#pragma unroll
        for (int b = 0; b < 2; ++b)
#pragma unroll
            for (int m = 0; m < 4; ++m)
#pragma unroll
                for (int n = 0; n < 2; ++n) acc[a][b][m][n] = (f32x4){0.f, 0.f, 0.f, 0.f};
    bf16x8 At[4][2], B0[2][2], B1[2][2];
    const char* cA = cur.A; const char* cB = cur.B;
    unsigned vg[2][2] = {{0u, 0u}, {0u, 0u}}; if constexpr (Sched::GATHER) PG8_GLOOKUP(vg, 0);
    PG8_STAGE(PG8_SB(0, 0), cB, voffB); PG8_STAGE(PG8_SB(0, 1), cB + hstepB, voffB); PG8_STA(0, 0, cA, vg); PG8_STA(0, 1, cA, vg);
    if (wr == 1) PG8_BAR;
    PG8_WAIT_V(2); PG8_BAR;
    PG8_STAGE(PG8_SB(1, 0), cB + kstepB, voffB); PG8_STA(1, 0, cA + kstep, vg); PG8_STAGE(PG8_SB(1, 1), cB + hstepB + kstepB, voffB);
    PG8_WAIT_V(6); PG8_BAR;
    for (;;) {
        const bool has_next = S.next(ui + 1, nxt);
        const char* nA = has_next ? nxt.A : cA; const char* nB = has_next ? nxt.B : cB;
        for (int t = 0; t < nt; t += 2) {
            const bool last = (t == nt - 2);
            const char* a1 = cA + (size_t)(t + 1) * kstep;
            const char* a2 = last ? nA : cA + (size_t)(t + 2) * kstep; const char* b2 = last ? nB : cB + (size_t)(t + 2) * kstepB;
            const char* a3 = a2 + kstep; const char* b3 = b2 + kstepB;
            PG8_LDB(B0, 0, 0); PG8_LDB(B1, 0, 1); PG8_SCHED; PG8_LDA(At, 0, 0); PG8_STA(1, 1, a1, vg);
            if constexpr (Sched::GATHER) { if (last && has_next) PG8_GLOOKUP(vg, ui + 1); }
            PG8_WAIT_V(8); PG8_WAIT_L(0); PG8_BAR; PG8_MMA(0, 0, At, B0); PG8_MMA(0, 1, At, B1); PG8_BAR; PG8_SCHED;
            PG8_LDA(At, 0, 1); PG8_STAGE(PG8_SB(0, 0), b2, voffB); PG8_STAGE(PG8_SB(0, 1), b2 + hstepB, voffB); PG8_STA(0, 0, a2, vg);
            PG8_WAIT_V(8); PG8_WAIT_L(0); PG8_BAR; PG8_MMA(1, 0, At, B0); PG8_MMA(1, 1, At, B1); PG8_BAR; PG8_SCHED;
            PG8_LDB(B0, 1, 0); PG8_LDB(B1, 1, 1); PG8_SCHED; PG8_LDA(At, 1, 0); PG8_STA(0, 1, a2, vg);
            PG8_WAIT_V(8); PG8_WAIT_L(0); PG8_BAR; PG8_MMA(0, 0, At, B0); PG8_MMA(0, 1, At, B1); PG8_BAR; PG8_SCHED;
            PG8_LDA(At, 1, 1); PG8_STAGE(PG8_SB(1, 0), b3, voffB); PG8_STAGE(PG8_SB(1, 1), b3 + hstepB, voffB); PG8_STA(1, 0, a3, vg);
            PG8_WAIT_V(8); PG8_WAIT_L(0); PG8_BAR; PG8_MMA(1, 0, At, B0); PG8_MMA(1, 1, At, B1); PG8_BAR; PG8_SCHED;
        }
        if (wr == 0) PG8_BAR;
        E(acc, cur, wr, wc, fr, fq, pre);
        if (!has_next) break;
        pre = E.prefetch(nxt, wr, fr);
        if constexpr (!Epi::KEEP_ACC)
#pragma unroll
        for (int a = 0; a < 2; ++a)
#pragma unroll
            for (int b = 0; b < 2; ++b)
#pragma unroll
                for (int m = 0; m < 4; ++m)
#pragma unroll
                    for (int n = 0; n < 2; ++n) acc[a][b][m][n] = (f32x4){0.f, 0.f, 0.f, 0.f};
        cur = nxt; cA = nA; cB = nB; ++ui;
        if constexpr (Sched::VARK) nt = cur.nt;
        if (wr == 1) PG8_BAR;
    }
    PG8_WAIT_V(0);
    PG8_BAR;
#undef PG8_SA
#undef PG8_SB
#undef PG8_STAGE
#undef PG8_LDA
#undef PG8_STA
#undef PG8_GLOOKUP
#undef PG8_LDB
#undef PG8_MMA
#undef PG8_WAIT_V
#undef PG8_WAIT_L
#undef PG8_BAR
#undef PG8_SCHED
}

#define EPI_FOR _Pragma("unroll") for (int ai = 0; ai < 2; ++ai) _Pragma("unroll") for (int m = 0; m < 4; ++m)
#define EPI_ROW (u.pm * BM + ai * HALF + wr * 64 + m * 16 + fr)
#define EPI_C8(bj) (u.pn * BM + (bj) * HALF + wc * 32 + 8 * fq)
#define EPI_LOAD_R(rr, ptr) float rr[2][4]; _Pragma("unroll") for (int ai = 0; ai < 2; ++ai) _Pragma("unroll") for (int m = 0; m < 4; ++m) rr[ai][m] = (ptr)[EPI_ROW]; asm volatile("" ::: "memory")

#define EPI_LOAD_RS(rr, xstat) float rr[2][4]; { f32x4 st_[2][4]; _Pragma("unroll") for (int ai = 0; ai < 2; ++ai) _Pragma("unroll") for (int m = 0; m < 4; ++m) st_[ai][m] = *(const f32x4*)((xstat) + (size_t)EPI_ROW * 16 + 4 * fq); \
    asm volatile("" ::: "memory"); _Pragma("unroll") for (int ai = 0; ai < 2; ++ai) _Pragma("unroll") for (int m = 0; m < 4; ++m) { float t_ = (st_[ai][m][0] + st_[ai][m][1]) + (st_[ai][m][2] + st_[ai][m][3]); \
        t_ = xsum32(xsum16(t_)); rr[ai][m] = __builtin_amdgcn_rsqf(t_ * (1.f / D) + EPS); } }
struct NoPre {};
#define EPI_NOPRE static constexpr bool KEEP_ACC = false; typedef NoPre Pre; __device__ __forceinline__ Pre prefetch(const Unit&, int, int) const { return Pre{}; }
struct RowPre { float r[2][4]; };
struct EpiInProj {
    unsigned char* ws; const float* bgate; int layer; int from_stats; const LAS float* rtab;
    static constexpr bool KEEP_ACC = false; typedef RowPre Pre;
    __device__ __forceinline__ Pre prefetch(const Unit& u, int wr, int fr) const { Pre p; const float* rx = (const float*)(ws + WS_RX);
#pragma unroll
        for (int ai = 0; ai < 2; ++ai)
#pragma unroll
            for (int m = 0; m < 4; ++m) p.r[ai][m] = from_stats ? rtab[u.aux * 256 + ai * HALF + wr * 64 + m * 16 + fr] : rx[EPI_ROW];
        return p; }
    __device__ __forceinline__ void operator()(const Acc& acc, const Unit& u, int wr, int wc, int fr, int fq, const Pre& pre) const {
        const float* rope = (const float*)(ws + WS_ROPE);
        bf16* CQ = (bf16*)(ws + WS_CQ); bf16* KR = (bf16*)(ws + WS_KR); bf16* CKV = (bf16*)(ws + WS_CKV); bf16* U = (bf16*)(ws + WS_U); bf16* VR = (bf16*)(ws + WS_VR); bf16* QX = (bf16*)(ws + WS_QX); bf16* GATE = (bf16*)(ws + WS_GATE);
        float* cqstat = (float*)(ws + WS_CQSTAT); float* ckvstat = (float*)(ws + WS_CKVSTAT); float* vstat = (float*)(ws + WS_VSTAT); unsigned* kmax = (unsigned*)(ws + WS_CTL) + CW_KMAX + layer * 32;
        const int pn = u.pn;
        float rr[2][4];
#pragma unroll
        for (int ai = 0; ai < 2; ++ai)
#pragma unroll
            for (int m = 0; m < 4; ++m) rr[ai][m] = pre.r[ai][m];
        if (pn < 2) {
            float krmax = 0.f;
            EPI_FOR { const int row = EPI_ROW;
                const float r = rr[ai][m]; float ss = 0.f;
#pragma unroll
                for (int bj = 0; bj < 2; ++bj) { const f32x4 v0 = acc[ai][bj][m][0] * r, v1 = acc[ai][bj][m][1] * r;
                    if (!(pn == 1 && bj == 1)) ss += sumsq4(v0) + sumsq4(v1);
                    *(u32x4*)(CQ + (size_t)row * 512 + pn * 256 + bj * HALF + wc * 32 + 8 * fq) = pack8(v0, v1);
                    if (pn == 1 && bj == 1 && wc == 0) {
                        const f32x4 c = *(const f32x4*)(rope + (size_t)row * 32 + 4 * fq), s = *(const f32x4*)(rope + (size_t)row * 32 + 16 + 4 * fq);
                        const f32x4 o0 = v0 * c - v1 * s, o1 = v0 * s + v1 * c;
                        *(u32x4*)(KR + (size_t)row * 32 + 8 * fq) = pack8(o0, o1);
                        float q2 = sumsq4(o0) + sumsq4(o1); q2 = xsum32(xsum16(q2)); krmax = fmaxf(krmax, q2); } }
                ss = xsum32(xsum16(ss));
                if (fq == 0) cqstat[(size_t)row * 8 + pn * 4 + wc] = ss;
            }
            if (pn == 1 && wc == 0) {
                krmax = row_max16(krmax);
                if ((fr | fq) == 0) atomicMax(kmax + 16, __float_as_uint(krmax)); }
        } else if (pn == 2) {
            EPI_FOR { const int row = EPI_ROW;
                const float r = rr[ai][m]; float ss = 0.f;
#pragma unroll
                for (int bj = 0; bj < 2; ++bj) { const f32x4 v0 = acc[ai][bj][m][0] * r, v1 = acc[ai][bj][m][1] * r; ss += sumsq4(v0) + sumsq4(v1);
                    *(u32x4*)(CKV + (size_t)row * 256 + bj * HALF + wc * 32 + 8 * fq) = pack8(v0, v1); }
                ss = xsum32(xsum16(ss));
                if (fq == 0) ckvstat[(size_t)row * 4 + wc] = ss;
            }
        } else if (pn < 7) {
            const bool isv = pn >= 5; bf16* dst = isv ? VR : U; const int t = isv ? pn - 5 : pn - 3;
            EPI_FOR { const int row = EPI_ROW;
                const float r = rr[ai][m]; float ss = 0.f;
#pragma unroll
                for (int bj = 0; bj < 2; ++bj) { f32x4 v0 = acc[ai][bj][m][0] * r, v1 = acc[ai][bj][m][1] * r;
#pragma unroll
                    for (int e = 0; e < 4; ++e) { v0[e] = gelu_tanh(v0[e]); v1[e] = gelu_tanh(v1[e]); }
                    ss += sumsq4(v0) + sumsq4(v1);
                    *(u32x4*)(dst + (size_t)row * 512 + t * 256 + bj * HALF + wc * 32 + 8 * fq) = pack8(v0, v1); }
                if (isv) { ss = xsum32(xsum16(ss)); if (fq == 0) vstat[(size_t)row * 8 + t * 4 + wc] = ss; }
            }
        } else if (pn < 9) {
            EPI_FOR { const int row = EPI_ROW;
                const float r = rr[ai][m];
#pragma unroll
                for (int bj = 0; bj < 2; ++bj) *(u32x4*)(QX + (size_t)row * 512 + (pn - 7) * 256 + bj * HALF + wc * 32 + 8 * fq) = pack8(acc[ai][bj][m][0] * r, acc[ai][bj][m][1] * r);
            }
        } else {
            const int gc0 = (pn - 9) * 256 + wc * 32 + 8 * fq;
            f32x4 bg[2][2];
#pragma unroll
            for (int bj = 0; bj < 2; ++bj) { bg[bj][0] = *(const f32x4*)(bgate + gc0 + bj * HALF); bg[bj][1] = *(const f32x4*)(bgate + gc0 + bj * HALF + 4); }
            EPI_FOR { const int row = EPI_ROW;
                const float r = rr[ai][m];
#pragma unroll
                for (int bj = 0; bj < 2; ++bj) { f32x4 v0 = acc[ai][bj][m][0] * r + bg[bj][0], v1 = acc[ai][bj][m][1] * r + bg[bj][1];
#pragma unroll
                    for (int e = 0; e < 4; ++e) { v0[e] = sigmoidf_(v0[e]); v1[e] = sigmoidf_(v1[e]); }
#ifdef DBG_CONSTGATE
                    v0 = acc[ai][bj][m][0] * r; v1 = acc[ai][bj][m][1] * r;
#endif
                    *(u32x2*)((unsigned char*)GATE + (size_t)row * 3072 + gc0 + bj * HALF) = pack8_u8(v0, v1); }
            }
        }
    }
};
struct EpiMemKV {
    bf16* KV;
    EPI_NOPRE
    __device__ __forceinline__ void operator()(const Acc& acc, const Unit& u, int wr, int wc, int fr, int fq, const Pre&) const {
        EPI_FOR { const int row = EPI_ROW;
#pragma unroll
            for (int bj = 0; bj < 2; ++bj) *(u32x4*)(KV + (size_t)u.aux * 256 * 1024 + (size_t)row * 1024 + EPI_C8(bj)) = pack8(acc[ai][bj][m][0], acc[ai][bj][m][1]);
        }
    }
};
struct EpiQ {
    const float* cqstat; const float* rope; bf16* Q;
    EPI_NOPRE
    __device__ __forceinline__ void operator()(const Acc& acc, const Unit& u, int wr, int wc, int fr, int fq, const Pre&) const {
        EPI_FOR { const int row = EPI_ROW;
            const f32x4 s0 = *(const f32x4*)(cqstat + (size_t)row * 8), s1 = *(const f32x4*)(cqstat + (size_t)row * 8 + 4);
            const float r = __builtin_amdgcn_rsqf(((s0[0] + s0[1]) + (s0[2] + s0[3]) + (s1[0] + s1[1]) + (s1[2] + s1[3])) * (1.f / QRANK) + EPS);
#pragma unroll
            for (int bj = 0; bj < 2; ++bj) { f32x4 v0 = acc[ai][bj][m][0] * r, v1 = acc[ai][bj][m][1] * r;
                if (((8 * u.pn + 4 * bj + wc) % 3) == 2) {
                    const f32x4 c = *(const f32x4*)(rope + (size_t)row * 32 + 4 * fq), s = *(const f32x4*)(rope + (size_t)row * 32 + 16 + 4 * fq);
                    const f32x4 o0 = v0 * c - v1 * s, o1 = v0 * s + v1 * c; v0 = o0; v1 = o1; }
                *(u32x4*)(Q + (size_t)row * 768 + EPI_C8(bj)) = pack8(v0, v1); }
        }
    }
};
struct EpiKV {
    const float* ckvstat; bf16* KN; bf16* V; unsigned* kmax;
    EPI_NOPRE
    __device__ __forceinline__ void operator()(const Acc& acc, const Unit& u, int wr, int wc, int fr, int fq, const Pre&) const {
        bf16* dst = u.pn < 2 ? KN : V; const int t = u.pn & 1; float hm[2] = {0.f, 0.f};
        EPI_FOR { const int row = EPI_ROW;
            const f32x4 s0 = *(const f32x4*)(ckvstat + (size_t)row * 4);
            const float r = __builtin_amdgcn_rsqf(((s0[0] + s0[1]) + (s0[2] + s0[3])) * (1.f / KVRANK) + EPS);
#pragma unroll
            for (int bj = 0; bj < 2; ++bj) { const f32x4 v0 = acc[ai][bj][m][0] * r, v1 = acc[ai][bj][m][1] * r;
                *(u32x4*)(dst + (size_t)row * 512 + t * 256 + bj * HALF + wc * 32 + 8 * fq) = pack8(v0, v1);
                float q2 = sumsq4(v0) + sumsq4(v1); q2 = xsum32(xsum16(q2)); hm[bj] = fmaxf(hm[bj], q2); }
        }
        if (u.pn < 2) {
#pragma unroll
            for (int bj = 0; bj < 2; ++bj) { float v = hm[bj];
                v = row_max16(v);
                if ((fr | fq) == 0) atomicMax(kmax + 2 * (4 * u.pn + 2 * bj + (wc >> 1)) + (wc & 1), __float_as_uint(v)); }
        }
    }
};
struct EpiBranch {
    const unsigned char* GATE; bf16* MIXB;
    static constexpr bool KEEP_ACC = true; typedef NoPre Pre; __device__ __forceinline__ Pre prefetch(const Unit&, int, int) const { return Pre{}; }
    __device__ __forceinline__ void operator()(Acc& acc, const Unit& u, int wr, int wc, int fr, int fq, const Pre&) const {
        const int n = u.aux;
#pragma unroll
        for (int ai = 0; ai < 2; ++ai) {
            u32x2 gw[4][2], gn[4][2];
#pragma unroll
            for (int m = 0; m < 4; ++m)
#pragma unroll
                for (int bj = 0; bj < 2; ++bj) { const unsigned char* gp = GATE + (size_t)EPI_ROW * 3072 + n * 1024 + EPI_C8(bj);
                    gw[m][bj] = *(const u32x2*)gp; if (n < 2) gn[m][bj] = *(const u32x2*)(gp + 1024); }
            asm volatile("" ::: "memory");
#pragma unroll
            for (int m = 0; m < 4; ++m)
#pragma unroll
                for (int bj = 0; bj < 2; ++bj) {
                    f32x4 g0, g1; unpack8_u8(gw[m][bj], g0, g1);
#pragma unroll
                    for (int e = 0; e < 4; ++e) { g0[e] = fmaxf(g0[e], 0.001953125f); g1[e] = fmaxf(g1[e], 0.001953125f); }
                    if (n < 2) { f32x4 h0, h1; unpack8_u8(gn[m][bj], h0, h1);
#pragma unroll
                        for (int e = 0; e < 4; ++e) { g0[e] *= fast_rcp(fmaxf(h0[e], 0.001953125f)); g1[e] *= fast_rcp(fmaxf(h1[e], 0.001953125f)); }
                        acc[ai][bj][m][0] *= g0; acc[ai][bj][m][1] *= g1; }
                    else *(u32x4*)(MIXB + (size_t)u.pm * 256 * 1024 + (size_t)(4 * u.pn + 2 * bj + (wc >> 1)) * 16384 + (ai * HALF + wr * 64 + m * 16 + fr) * 64 + (wc & 1) * 32 + 8 * fq) = pack8(acc[ai][bj][m][0] * g0, acc[ai][bj][m][1] * g1);
                }
        }
        if (n == 2) {
#pragma unroll
            for (int ai = 0; ai < 2; ++ai)
#pragma unroll
                for (int bj = 0; bj < 2; ++bj)
#pragma unroll
                    for (int m = 0; m < 4; ++m) { acc[ai][bj][m][0] = (f32x4){0.f, 0.f, 0.f, 0.f}; acc[ai][bj][m][1] = (f32x4){0.f, 0.f, 0.f, 0.f}; }
        }
    }
};
struct EpiResid {
    bf16* XB; float* xstat;
    EPI_NOPRE
    __device__ __forceinline__ void operator()(const Acc& acc, const Unit& u, int wr, int wc, int fr, int fq, const Pre&) const {
        u32x4 xv[2][4][2];
#pragma unroll
        for (int ai = 0; ai < 2; ++ai)
#pragma unroll
            for (int m = 0; m < 4; ++m)
#pragma unroll
                for (int bj = 0; bj < 2; ++bj) xv[ai][m][bj] = *(const u32x4*)(XB + (size_t)EPI_ROW * 1024 + EPI_C8(bj));
        asm volatile("" ::: "memory");
#pragma unroll
        for (int ai = 0; ai < 2; ++ai) {
#pragma unroll
            for (int m = 0; m < 4; ++m) { const int row = EPI_ROW; float ss = 0.f;
#pragma unroll
                for (int bj = 0; bj < 2; ++bj) { const int col = EPI_C8(bj); f32x4 x0, x1; unpack8(xv[ai][m][bj], x0, x1);
                    const f32x4 v0 = x0 + acc[ai][bj][m][0], v1 = x1 + acc[ai][bj][m][1];
                    ss += sumsq4(v0) + sumsq4(v1);
                    *(u32x4*)(XB + (size_t)row * 1024 + col) = pack8(v0, v1); }
                ss = xsum32(xsum16(ss));
                if (fq == 0) xstat[(size_t)row * 16 + u.pn * 4 + wc] = ss; }
        }
    }
};
struct EpiSwiGLU {
    const float* rs; bf16* Hh; int ldh; int from_stats;
    static constexpr bool KEEP_ACC = false; typedef RowPre Pre;
    __device__ __forceinline__ Pre prefetch(const Unit& u, int wr, int fr) const { Pre p;
#pragma unroll
        for (int ai = 0; ai < 2; ++ai)
#pragma unroll
            for (int m = 0; m < 4; ++m) p.r[ai][m] = from_stats ? 0.f : rs[EPI_ROW];
        return p; }
    __device__ __forceinline__ void operator()(const Acc& acc, const Unit& u, int wr, int wc, int fr, int fq, const Pre& pre) const {
        float rr[2][4];
        if (from_stats) { EPI_LOAD_RS(rs_, rs);
#pragma unroll
            for (int ai = 0; ai < 2; ++ai)
#pragma unroll
                for (int m = 0; m < 4; ++m) rr[ai][m] = rs_[ai][m]; }
        else {
#pragma unroll
            for (int ai = 0; ai < 2; ++ai)
#pragma unroll
                for (int m = 0; m < 4; ++m) rr[ai][m] = pre.r[ai][m]; }
        bf16* hbase = Hh + (size_t)u.pm * 256 * ldh + (size_t)(2 * u.pn + (wc >> 1)) * 16384 + (wr * 64 + fr) * 64 + (wc & 1) * 32 + 8 * fq;
        EPI_FOR { const int row = EPI_ROW;
            const float r = rr[ai][m];
            f32x4 a0 = acc[ai][0][m][0] * r, a1 = acc[ai][0][m][1] * r; const f32x4 b0 = acc[ai][1][m][0] * r, b1 = acc[ai][1][m][1] * r;
#pragma unroll
            for (int e = 0; e < 4; ++e) { a0[e] = a0[e] * sigmoidf_(a0[e]) * b0[e]; a1[e] = a1[e] * sigmoidf_(a1[e]) * b1[e]; }
            (void)row; *(u32x4*)(hbase + (ai * HALF + m * 16) * 64) = pack8(a0, a1);
        }
    }
};
struct EpiBf16 {
    bf16* C; int ldc;
    EPI_NOPRE
    __device__ __forceinline__ void operator()(const Acc& acc, const Unit& u, int wr, int wc, int fr, int fq, const Pre&) const {
        EPI_FOR { const int row = EPI_ROW;
#pragma unroll
            for (int bj = 0; bj < 2; ++bj) *(u32x4*)(C + (size_t)row * ldc + EPI_C8(bj)) = pack8(acc[ai][bj][m][0], acc[ai][bj][m][1]);
        }
    }
};
__device__ __forceinline__ void ks_reduce(const float* part, int x, int r, int k, int CC, int tid, bf16* C, int ldc, const Unit& u, int wr, int wc, int fr, int fq) {
    for (int sp = k; sp < 16; sp += CC) { const int ai = sp >> 3, bj = (sp >> 2) & 1, m = sp & 3;
        f32x4 s0 = {0.f, 0.f, 0.f, 0.f}, s1 = {0.f, 0.f, 0.f, 0.f};
        for (int kk0 = 0; kk0 < CC; kk0 += 4) {
            f32x4 v0[4], v1[4];
#pragma unroll
            for (int kk = 0; kk < 4; ++kk) { const bool ok = kk0 + kk < CC; const float* q = part + (size_t)(x + 8 * (r * CC + (ok ? kk0 + kk : 0))) * 65536 + tid * 4 + sp * 4096;
                v0[kk] = *(const f32x4*)q; v1[kk] = *(const f32x4*)(q + 2048); if (!ok) { v0[kk] = (f32x4){0.f, 0.f, 0.f, 0.f}; v1[kk] = (f32x4){0.f, 0.f, 0.f, 0.f}; } }
#pragma unroll
            for (int kk = 0; kk < 4; ++kk) { s0 += v0[kk]; s1 += v1[kk]; } }
        const int row = u.pm * BM + ai * HALF + wr * 64 + m * 16 + fr;
        *(u32x4*)(C + (size_t)row * ldc + u.pn * BM + bj * HALF + wc * 32 + 8 * fq) = pack8(s0, s1); }
}
struct EpiBf16KS {
    bf16* C; int ldc; float* part; unsigned* cnt; int c;
    EPI_NOPRE
    __device__ __forceinline__ void operator()(const Acc& acc, const Unit& u, int wr, int wc, int fr, int fq, const Pre&) const {
        if (((u.aux >> 4) & 3) != 0) {
            int tid_ = threadIdx.x; asm volatile("" : "+v"(tid_));
            const int k = (u.aux >> 8) & 255, CC = (u.aux >> 16) & 255, r = u.aux >> 24, x = c & 7;
            float* p = part + (size_t)c * 65536 + tid_ * 4;
#pragma unroll
            for (int ai = 0; ai < 2; ++ai)
#pragma unroll
                for (int bj = 0; bj < 2; ++bj)
#pragma unroll
                    for (int m = 0; m < 4; ++m)
#pragma unroll
                        for (int n = 0; n < 2; ++n) *(f32x4*)(p + (((ai * 2 + bj) * 4 + m) * 2 + n) * 2048) = acc[ai][bj][m][n];
            asm volatile("s_waitcnt vmcnt(0)" ::: "memory");
            __syncthreads();
            if (tid_ == 0) { unsigned* w = cnt + x + 8 * r; __hip_atomic_fetch_add(w, 1u, __ATOMIC_RELEASE, __HIP_MEMORY_SCOPE_AGENT);
                while (__hip_atomic_load(w, __ATOMIC_ACQUIRE, __HIP_MEMORY_SCOPE_AGENT) < (unsigned)CC) __builtin_amdgcn_s_sleep(2); }
            __syncthreads();
            ks_reduce(part, x, r, k, CC, tid_, C, ldc, u, wr, wc, fr, fq);
            return;
        }
        EPI_FOR { const int row = EPI_ROW;
#pragma unroll
            for (int bj = 0; bj < 2; ++bj) *(u32x4*)(C + (size_t)row * ldc + EPI_C8(bj)) = pack8(acc[ai][bj][m][0], acc[ai][bj][m][1]);
        }
    }
};
struct EpiF32 {
    float* C; int ldc;
    EPI_NOPRE
    __device__ __forceinline__ void operator()(const Acc& acc, const Unit& u, int wr, int wc, int fr, int fq, const Pre&) const {
        EPI_FOR { const int row = EPI_ROW;
#pragma unroll
            for (int bj = 0; bj < 2; ++bj) { float* cp = C + (size_t)row * ldc + EPI_C8(bj); *(f32x4*)cp = acc[ai][bj][m][0]; *(f32x4*)(cp + 4) = acc[ai][bj][m][1]; }
        }
    }
};
}

namespace att {
#define KSWZ(row, colB) ((row) * 256 + ((colB) ^ (((row) & 7) << 4)))
#define SBAR() __builtin_amdgcn_sched_barrier(0)
constexpr float THR = 8.f;
__device__ __forceinline__ int crow(int r, int hi) { return (r & 3) + 8 * (r >> 2) + 4 * hi; }
template <int NB> __device__ __forceinline__ int v_st(int k, int c) { const int kk = (k & ~0xC) | ((k & 4) << 1) | ((k & 8) >> 1); return ((kk >> 3) * NB + (c >> 5)) * 512 + ((kk & 7) * 32 + (c & 31)) * 2; }
__device__ __forceinline__ int v_rd_base(int lane) { return ((lane & 3) << 3) | (((lane >> 2) & 3) << 6) | (((lane >> 4) & 1) << 5) | (((lane >> 5) & 1) << 8); }
template <int OFF> __device__ __forceinline__ s16x4 tr_read(int vb) { s16x4 r; asm volatile("ds_read_b64_tr_b16 %0, %1 offset:%2" : "=&v"(r) : "v"(vb), "i"(OFF) : "memory"); return r; }

__device__ __forceinline__ void partialSM(f32x16& p0, f32x16& p1, float& m_reg, float& alpha) {
    float pmax = p0[0];
#pragma unroll
    for (int r = 1; r < 16; ++r) pmax = fmaxf(pmax, p0[r]);
#pragma unroll
    for (int r = 0; r < 16; ++r) pmax = fmaxf(pmax, p1[r]);
    { auto rr = __builtin_amdgcn_permlane32_swap(__float_as_uint(pmax), __float_as_uint(pmax), false, false); pmax = fmaxf(__uint_as_float(rr[0]), __uint_as_float(rr[1])); }
    float mn;
    if (__builtin_expect(__all(pmax - m_reg <= THR), 1)) { mn = m_reg; alpha = 1.f; }
    else { mn = fmaxf(m_reg, pmax); alpha = __builtin_amdgcn_exp2f(m_reg - mn); m_reg = mn; }
#pragma unroll
    for (int r = 0; r < 16; ++r) { p0[r] -= mn; p1[r] -= mn; }
#pragma unroll
    for (int r = 0; r < 16; ++r) p0[r] = __builtin_amdgcn_exp2f(p0[r]);
}
__device__ __forceinline__ void finishSM(f32x16& p0, f32x16& p1, float alpha, float& l_reg, bf16x8& pa0, bf16x8& pa1, bf16x8& pa2, bf16x8& pa3) {
#pragma unroll
    for (int r = 0; r < 16; ++r) p1[r] = __builtin_amdgcn_exp2f(p1[r]);
    float ps = 0;
#pragma unroll
    for (int r = 0; r < 16; ++r) ps += p0[r];
#pragma unroll
    for (int r = 0; r < 16; ++r) ps += p1[r];
    { auto rr = __builtin_amdgcn_permlane32_swap(__float_as_uint(ps), __float_as_uint(ps), false, false); ps = __uint_as_float(rr[0]) + __uint_as_float(rr[1]); }
    l_reg = l_reg * alpha + ps;
#define PK4(P, BASE, OUT) do { unsigned a0 = cvt_pk_bf16(P[BASE + 0], P[BASE + 1]), a1 = cvt_pk_bf16(P[BASE + 2], P[BASE + 3]);   \
    unsigned b0 = cvt_pk_bf16(P[BASE + 4], P[BASE + 5]), b1 = cvt_pk_bf16(P[BASE + 6], P[BASE + 7]);                              \
    auto r0 = __builtin_amdgcn_permlane32_swap(a0, b0, false, false); auto r1 = __builtin_amdgcn_permlane32_swap(a1, b1, false, false); \
    u32x4 w = {r0[0], r1[0], r0[1], r1[1]}; OUT = __builtin_bit_cast(bf16x8, w); } while (0)
    PK4(p0, 0, pa0); PK4(p0, 8, pa1); PK4(p1, 0, pa2); PK4(p1, 8, pa3);
#undef PK4
}
template <int ND0> __device__ __forceinline__ void qkt(f32x16& p0, f32x16& p1, const LAS char* Ks, const bf16x8* qr, int r32, int hi, const f32x16& init) {
#pragma unroll
    for (int d0 = 0; d0 < ND0; ++d0) { const int cb = (d0 * 16 + hi * 8) * 2;
        const bf16x8 b0 = *(const LAS bf16x8*)(Ks + KSWZ(r32, cb));
        const bf16x8 b1 = *(const LAS bf16x8*)(Ks + KSWZ(32 + r32, cb));
        p0 = __builtin_amdgcn_mfma_f32_32x32x16_bf16(b0, qr[d0], d0 == 0 ? init : p0, 0, 0, 0);
        p1 = __builtin_amdgcn_mfma_f32_32x32x16_bf16(b1, qr[d0], d0 == 0 ? init : p1, 0, 0, 0); }
}
__device__ __forceinline__ void expA(f32x16& p0) {
#pragma unroll
    for (int r = 0; r < 16; ++r) p0[r] = __builtin_amdgcn_exp2f(p0[r]);
}
template <int NB, int D0> __device__ __forceinline__ void pv_one(f32x16& od, int vb, bf16x8 pa0, bf16x8 pa1, bf16x8 pa2, bf16x8 pa3) {
    const s16x4 l0 = tr_read<(0 * NB + D0) * 512>(vb), h0 = tr_read<(1 * NB + D0) * 512>(vb), l1 = tr_read<(2 * NB + D0) * 512>(vb), h1 = tr_read<(3 * NB + D0) * 512>(vb);
    const s16x4 l2 = tr_read<(4 * NB + D0) * 512>(vb), h2 = tr_read<(5 * NB + D0) * 512>(vb), l3 = tr_read<(6 * NB + D0) * 512>(vb), h3 = tr_read<(7 * NB + D0) * 512>(vb);
    asm volatile("s_waitcnt lgkmcnt(0)" ::: "memory"); SBAR();
#define PK(L, H) (bf16x8){L[0], L[1], L[2], L[3], H[0], H[1], H[2], H[3]}
    od = __builtin_amdgcn_mfma_f32_32x32x16_bf16(pa0, PK(l0, h0), od, 0, 0, 0);
    od = __builtin_amdgcn_mfma_f32_32x32x16_bf16(pa1, PK(l1, h1), od, 0, 0, 0);
    od = __builtin_amdgcn_mfma_f32_32x32x16_bf16(pa2, PK(l2, h2), od, 0, 0, 0);
    od = __builtin_amdgcn_mfma_f32_32x32x16_bf16(pa3, PK(l3, h3), od, 0, 0, 0);
#undef PK
}
template <int NB> __device__ __forceinline__ void pv_all(f32x16* o, int vb, bf16x8 pa0, bf16x8 pa1, bf16x8 pa2, bf16x8 pa3) {
    pv_one<NB, 0>(o[0], vb, pa0, pa1, pa2, pa3); pv_one<NB, 1>(o[1], vb, pa0, pa1, pa2, pa3);
    if constexpr (NB == 4) { pv_one<NB, 2>(o[2], vb, pa0, pa1, pa2, pa3); pv_one<NB, 3>(o[3], vb, pa0, pa1, pa2, pa3); }
}

template <int DQK, int D1, int DVV, bool FIXM>
__device__ __forceinline__ void attn_unit(const bf16* __restrict__ Qb, int ldq, const bf16* __restrict__ K1, int ldk1, const bf16* __restrict__ K2, int ldk2,
                                          const bf16* __restrict__ Vh, int ldv, bf16* __restrict__ Ob, int ldo, int seq, LAS char* lds, float kbound) {
    constexpr int ND0 = DQK / 16, NB = DVV / 32, CK = DQK / 8, CV = DVV / 8;
    constexpr int NKL = (64 * CK + 511) / 512, NVL = (64 * CV) / 512;
    constexpr int SHM_V = 64 * DVV * 2, SHM_K = 64 * 256;
    int tid_ = threadIdx.x; asm volatile("" : "+v"(tid_));
    const int tid = tid_, wid = tid >> 6, lane = tid & 63, r32 = lane & 31, hi = lane >> 5;
    LAS char* V_lds = lds; LAS char* K_lds = lds + 2 * SHM_V;
    LAS float* ws = (LAS float*)(lds + 2 * SHM_V + 2 * SHM_K) + wid * 64; LAS float* li_l = ws; LAS float* al_l = ws + 32;
    float m_reg = -1e30f, l_reg = 0; f32x16 o[NB]; bf16x8 qr[ND0];
#pragma unroll
    for (int d = 0; d < NB; ++d) o[d] = f32x16{};
    const bf16* Qw = Qb + (long)(wid * 32 + r32) * ldq + hi * 8;
#pragma unroll
    for (int d0 = 0; d0 < ND0; ++d0) qr[d0] = *(const bf16x8*)(Qw + d0 * 16);
    f32x16 init = f32x16{};
    if constexpr (FIXM) {
        float q2 = 0.f;
#pragma unroll
        for (int d0 = 0; d0 < ND0; ++d0) { const u32x4 w = __builtin_bit_cast(u32x4, qr[d0]); f32x4 a, b; unpack8(w, a, b); q2 += sumsq4(a) + sumsq4(b); }
        { auto rr = __builtin_amdgcn_permlane32_swap(__float_as_uint(q2), __float_as_uint(q2), false, false); q2 = __uint_as_float(rr[0]) + __uint_as_float(rr[1]); }
        const float nm = -sqrtf(q2) * kbound;
#pragma unroll
        for (int r = 0; r < 16; ++r) init[r] = nm;
        asm volatile("" : "+v"(init));
    }
    const bf16* kp[NKL]; int kstr[NKL], kdst[NKL]; bool kval[NKL];
#pragma unroll
    for (int i = 0; i < NKL; ++i) { const int c = tid + 512 * i; kval[i] = c < 64 * CK; const int cc_ = kval[i] ? c : 0; const int row = cc_ / CK, cc = cc_ % CK;
        if (cc * 8 < D1) { kp[i] = K1 + (long)row * ldk1 + cc * 8; kstr[i] = 64 * ldk1; } else { kp[i] = K2 + (long)row * ldk2 + (cc * 8 - D1); kstr[i] = 64 * ldk2; }
        kdst[i] = KSWZ(row, cc * 16); }
    const bf16* vp[NVL]; int vdst[NVL]; const int vstr = 64 * ldv;
#pragma unroll
    for (int i = 0; i < NVL; ++i) { const int c = tid + 512 * i; const int row = c / CV, cc = c % CV; vp[i] = Vh + (long)row * ldv + cc * 8; vdst[i] = v_st<NB>(row, cc * 8); }
    const int vb0 = (int)(uintptr_t)V_lds + v_rd_base(lane);
    struct { bf16x8 ks[NKL]; bf16x8 vs[NVL]; } sr_[2];
#define SLOAD(i, t) do { _Pragma("unroll") for (int q_ = 0; q_ < NVL; ++q_) sr_[i].vs[q_] = *(const bf16x8*)(vp[q_] + (long)(t) * vstr); \
    _Pragma("unroll") for (int q_ = 0; q_ < NKL; ++q_) { if (kval[q_]) sr_[i].ks[q_] = *(const bf16x8*)(kp[q_] + (long)(t) * kstr[q_]); } } while (0)
#define SWRITE(b, i) do { _Pragma("unroll") for (int q_ = 0; q_ < NVL; ++q_) *(LAS bf16x8*)(V_lds + (b) * SHM_V + vdst[q_]) = sr_[i].vs[q_]; \
    _Pragma("unroll") for (int q_ = 0; q_ < NKL; ++q_) { if (kval[q_]) *(LAS bf16x8*)(K_lds + (b) * SHM_K + kdst[q_]) = sr_[i].ks[q_]; } } while (0)
#define SWAIT() asm volatile("s_waitcnt vmcnt(%0)" :: "n"(NKL + NVL) : "memory")
#define RESC(a) do { if (__any((a) < 1.f)) { if (hi == 0) al_l[r32] = (a); asm volatile("s_waitcnt lgkmcnt(0)" ::: "memory"); \
    _Pragma("unroll") for (int d = 0; d < NB; ++d) _Pragma("unroll") for (int r = 0; r < 16; ++r) o[d][r] *= al_l[crow(r, hi)]; } } while (0)
    f32x16 pA0, pA1, pB0, pB1; float alA = 1.f, alB = 1.f; bf16x8 pa0, pa1, pa2, pa3; const int NT = seq / 64;
#define PSM(P0, P1, AL) do { if constexpr (FIXM) expA(P0); else partialSM(P0, P1, m_reg, AL); } while (0)
#define RSC(AL) do { if constexpr (!FIXM) RESC(AL); } while (0)
    SLOAD(0, 0); asm volatile("s_waitcnt vmcnt(0)" ::: "memory"); SWRITE(0, 0); __syncthreads();
    qkt<ND0>(pA0, pA1, K_lds, qr, r32, hi, init); PSM(pA0, pA1, alA);
    SLOAD(1, 1); if (2 < NT) SLOAD(0, 2);
    SWAIT(); SWRITE(1, 1); __syncthreads();
    for (int j = 1; j + 1 < NT; j += 2) {
        SBAR(); qkt<ND0>(pB0, pB1, K_lds + SHM_K, qr, r32, hi, init);
        finishSM(pA0, pA1, alA, l_reg, pa0, pa1, pa2, pa3); SBAR();
        SLOAD(1, j + 2); SBAR();
        pv_all<NB>(o, vb0, pa0, pa1, pa2, pa3); PSM(pB0, pB1, alB);
        __syncthreads(); SWAIT(); SWRITE(0, 0);
        RSC(alB); __syncthreads();
        SBAR(); qkt<ND0>(pA0, pA1, K_lds, qr, r32, hi, init);
        finishSM(pB0, pB1, alB, l_reg, pa0, pa1, pa2, pa3); SBAR();
        if (j + 3 < NT) SLOAD(0, j + 3); SBAR();
        pv_all<NB>(o, vb0 + SHM_V, pa0, pa1, pa2, pa3); PSM(pA0, pA1, alA);
        __syncthreads(); SWAIT(); SWRITE(1, 1);
        RSC(alA); __syncthreads();
    }
    SBAR(); qkt<ND0>(pB0, pB1, K_lds + SHM_K, qr, r32, hi, init);
    finishSM(pA0, pA1, alA, l_reg, pa0, pa1, pa2, pa3); SBAR();
    pv_all<NB>(o, vb0, pa0, pa1, pa2, pa3); PSM(pB0, pB1, alB);
    __syncthreads(); RSC(alB);
    finishSM(pB0, pB1, alB, l_reg, pa0, pa1, pa2, pa3); SBAR();
    pv_all<NB>(o, vb0 + SHM_V, pa0, pa1, pa2, pa3);
#undef PSM
#undef RSC
    if (hi == 0) li_l[r32] = l_reg; asm volatile("s_waitcnt lgkmcnt(0)" ::: "memory");
    float rli[16];
#pragma unroll
    for (int r = 0; r < 16; ++r) rli[r] = __builtin_amdgcn_rcpf(li_l[crow(r, hi)]);
    bf16* Ow = Ob + (long)(wid * 32) * ldo;
#pragma unroll
    for (int r = 0; r < 16; ++r) { const int orow = crow(r, hi);
#pragma unroll
        for (int d0 = 0; d0 < NB; ++d0) Ow[(long)orow * ldo + d0 * 32 + r32] = f2bf(o[d0][r] * rli[r]); }
    __syncthreads();
#undef SLOAD
#undef SWRITE
#undef SWAIT
#undef RESC
}

#define EXP4(P, B) do { P[B] = __builtin_amdgcn_exp2f(P[B]); P[B + 1] = __builtin_amdgcn_exp2f(P[B + 1]); P[B + 2] = __builtin_amdgcn_exp2f(P[B + 2]); P[B + 3] = __builtin_amdgcn_exp2f(P[B + 3]); } while (0)
#define SUM4(S, P, B) do { S += (P[B] + P[B + 1]) + (P[B + 2] + P[B + 3]); } while (0)
#define PK4X(P, BASE, OUT) do { const u32x4 w_ = {cvt_pk_bf16(P[BASE + 0], P[BASE + 1]), cvt_pk_bf16(P[BASE + 2], P[BASE + 3]), cvt_pk_bf16(P[BASE + 4], P[BASE + 5]), cvt_pk_bf16(P[BASE + 6], P[BASE + 7])}; OUT = __builtin_bit_cast(bf16x8, w_); } while (0)
typedef short v4i16_t __attribute__((ext_vector_type(4)));
__device__ __forceinline__ s16x4 vtr(const LAS char* p) { return __builtin_bit_cast(s16x4, __builtin_amdgcn_ds_read_tr16_b64_v4i16((LAS v4i16_t*)p)); }
#define KSWZ2(row, colB) ((row) * 256 + ((colB) ^ (((row) & 15) << 4)))
template <int DQK, int D1, int DVV>
__device__ __forceinline__ void attn_unit2(const bf16* __restrict__ Qb, int ldq, const bf16* __restrict__ K1, int ldk1, const bf16* __restrict__ K2, int ldk2,
                                           const bf16* __restrict__ Vh, int ldv, bf16* __restrict__ Ob, int ldo, int seq, LAS char* lds, float kbound) {
    constexpr int ND0 = DQK / 16, NB = DVV / 32, CK = DQK / 8;
    constexpr int SHM_V = 64 * DVV * 2, SHM_K = 64 * 256;
    static_assert(NB == 2 && ND0 == 6, "written for QK dim 96 / V dim 64");
    int tid_ = threadIdx.x; asm volatile("" : "+v"(tid_));
    const int tid = tid_, wid = __builtin_amdgcn_readfirstlane(tid >> 6), lane = tid & 63, r32 = lane & 31, hi = lane >> 5;
    LAS char* V_lds = lds; LAS char* K_lds = lds + 3 * SHM_V;
    LAS float* ws = (LAS float*)(lds + 3 * SHM_V + 2 * SHM_K) + wid * 64;
    LAS char* QAL = lds + 3 * SHM_V + 2 * SHM_K + 2048 + wid * (2 * ND0 * 1024) + lane * 16; LAS char* QBL = QAL + ND0 * 1024;
    float nm;
    { bf16x8 qa[ND0], qb[ND0];
      const bf16* QwA = Qb + (long)(wid * 64 + r32) * ldq + hi * 8; const bf16* QwB = QwA + (long)32 * ldq;
#pragma unroll
      for (int d0 = 0; d0 < ND0; ++d0) { qa[d0] = *(const bf16x8*)(QwA + d0 * 16); qb[d0] = *(const bf16x8*)(QwB + d0 * 16); }
      float q2a = 0.f, q2b = 0.f;
#pragma unroll
      for (int d0 = 0; d0 < ND0; ++d0) { f32x4 a, b; unpack8(__builtin_bit_cast(u32x4, qa[d0]), a, b); q2a += sumsq4(a) + sumsq4(b); unpack8(__builtin_bit_cast(u32x4, qb[d0]), a, b); q2b += sumsq4(a) + sumsq4(b);
          *(LAS bf16x8*)(QAL + d0 * 1024) = qa[d0]; *(LAS bf16x8*)(QBL + d0 * 1024) = qb[d0]; }
      { auto rr = __builtin_amdgcn_permlane32_swap(__float_as_uint(q2a), __float_as_uint(q2a), false, false); q2a = __uint_as_float(rr[0]) + __uint_as_float(rr[1]); }
      { auto rr = __builtin_amdgcn_permlane32_swap(__float_as_uint(q2b), __float_as_uint(q2b), false, false); q2b = __uint_as_float(rr[0]) + __uint_as_float(rr[1]); }
      nm = -sqrtf(fmaxf(q2a, q2b)) * kbound; }
    const bf16* kp[2]; int kstr[2];
#pragma unroll
    for (int i = 0; i < 2; ++i) { const int row = 8 * wid + 4 * i + (lane >> 4), cc = (lane & 15) ^ (row & 15);
        if (cc >= 8 && cc < CK) { kp[i] = K2 + (long)row * ldk2 + (cc * 8 - D1); kstr[i] = 64 * ldk2; } else { kp[i] = K1 + (long)row * ldk1 + (cc < 8 ? cc * 8 : 0); kstr[i] = 64 * ldk1; } }
    const bf16* vp; { const int k = 8 * wid + ((lane & 31) >> 2); vp = Vh + (long)k * ldv + (lane >> 5) * 32 + (lane & 3) * 8; }
    const int vstr = 64 * ldv;
    const LAS char* vrd0 = V_lds + v_rd_base(lane);
#define DMA2(t, kb, vbuf) do { \
    __builtin_amdgcn_global_load_lds((const unsigned*)(kp[0] + (long)(t) * kstr[0]), (LAS unsigned*)(K_lds + (kb) * SHM_K + wid * 2048), 16, 0, 0); \
    __builtin_amdgcn_global_load_lds((const unsigned*)(kp[1] + (long)(t) * kstr[1]), (LAS unsigned*)(K_lds + (kb) * SHM_K + wid * 2048 + 1024), 16, 0, 0); \
    __builtin_amdgcn_global_load_lds((const unsigned*)(vp + (long)(t) * vstr), (LAS unsigned*)(V_lds + (vbuf) * SHM_V + wid * 1024), 16, 0, 0); } while (0)
#define VRD8(arr, base, D0) do { _Pragma("unroll") for (int j_ = 0; j_ < 8; ++j_) arr[j_] = vtr((base) + (j_ * NB + (D0)) * 512); } while (0)
#define PKV(arr, ks) (bf16x8){arr[2 * (ks)][0], arr[2 * (ks)][1], arr[2 * (ks)][2], arr[2 * (ks)][3], arr[2 * (ks) + 1][0], arr[2 * (ks) + 1][1], arr[2 * (ks) + 1][2], arr[2 * (ks) + 1][3]}
    f32x16 oA[2], oB[2]; oA[0] = f32x16{}; oA[1] = f32x16{}; oB[0] = f32x16{}; oB[1] = f32x16{};
    float lA = 0.f, lB = 0.f; const int NT = seq / 64;
    f32x16 a0, a1, c0, c1; bf16x8 pa0, pa1, pa2, pa3;
#define HALF1(Kb) do { \
        f32x16 init; { float nmv = nm; asm volatile("" : "+v"(nmv)); _Pragma("unroll") for (int r = 0; r < 16; ++r) init[r] = nmv; } \
        SBAR(); \
        _Pragma("unroll") for (int d0 = 0; d0 < ND0; ++d0) { const int cb = (d0 * 16 + hi * 8) * 2; \
            const bf16x8 k0 = *(const LAS bf16x8*)((Kb) + KSWZ2(r32, cb)), k1 = *(const LAS bf16x8*)((Kb) + KSWZ2(32 + r32, cb)), qv = *(const LAS bf16x8*)(QAL + d0 * 1024); \
            a0 = __builtin_amdgcn_mfma_f32_32x32x16_bf16(k0, qv, d0 == 0 ? init : a0, 0, 0, 0); \
            a1 = __builtin_amdgcn_mfma_f32_32x32x16_bf16(k1, qv, d0 == 0 ? init : a1, 0, 0, 0); } \
        SBAR(); \
        float sA = 0.f; \
        _Pragma("unroll") for (int d0 = 0; d0 < ND0; ++d0) { const int cb = (d0 * 16 + hi * 8) * 2; \
            const bf16x8 k0 = *(const LAS bf16x8*)((Kb) + KSWZ2(r32, cb)), k1 = *(const LAS bf16x8*)((Kb) + KSWZ2(32 + r32, cb)), qv = *(const LAS bf16x8*)(QBL + d0 * 1024); \
            c0 = __builtin_amdgcn_mfma_f32_32x32x16_bf16(k0, qv, d0 == 0 ? init : c0, 0, 0, 0); \
            if (d0 == 3) { EXP4(a0, 0); EXP4(a0, 4); } \
            if (d0 == 4) { EXP4(a0, 12); SUM4(sA, a0, 0); SUM4(sA, a0, 4); EXP4(a1, 0); } \
            if (d0 == 5) { EXP4(a1, 8); SUM4(sA, a1, 0); SUM4(sA, a1, 4); } \
            c1 = __builtin_amdgcn_mfma_f32_32x32x16_bf16(k1, qv, d0 == 0 ? init : c1, 0, 0, 0); \
            if (d0 == 3) { EXP4(a0, 8); } \
            if (d0 == 4) { EXP4(a1, 4); SUM4(sA, a0, 8); SUM4(sA, a0, 12); } \
            if (d0 == 5) { EXP4(a1, 12); SUM4(sA, a1, 8); SUM4(sA, a1, 12); } \
            if (d0 >= 2) SBAR(); } \
        lA += sA; \
        PK4X(a0, 0, pa0); PK4X(a0, 8, pa1); PK4X(a1, 0, pa2); PK4X(a1, 8, pa3); \
        SBAR(); } while (0)
#define HALF2(vbase) do { \
        float sB = 0.f; s16x4 va[8], vb_[8]; \
        VRD8(va, vbase, 0); VRD8(vb_, vbase, 1); \
        oA[0] = __builtin_amdgcn_mfma_f32_32x32x16_bf16(pa0, PKV(va, 0), oA[0], 0, 0, 0); SBAR(); \
        oA[1] = __builtin_amdgcn_mfma_f32_32x32x16_bf16(pa0, PKV(vb_, 0), oA[1], 0, 0, 0); EXP4(c0, 0); EXP4(c0, 4); SBAR(); \
        oA[0] = __builtin_amdgcn_mfma_f32_32x32x16_bf16(pa1, PKV(va, 1), oA[0], 0, 0, 0); EXP4(c0, 8); EXP4(c0, 12); SUM4(sB, c0, 0); SBAR(); \
        oA[1] = __builtin_amdgcn_mfma_f32_32x32x16_bf16(pa1, PKV(vb_, 1), oA[1], 0, 0, 0); EXP4(c1, 0); SUM4(sB, c0, 4); SUM4(sB, c0, 8); SBAR(); \
        oA[0] = __builtin_amdgcn_mfma_f32_32x32x16_bf16(pa2, PKV(va, 2), oA[0], 0, 0, 0); EXP4(c1, 4); SUM4(sB, c0, 12); SBAR(); \
        oA[1] = __builtin_amdgcn_mfma_f32_32x32x16_bf16(pa2, PKV(vb_, 2), oA[1], 0, 0, 0); EXP4(c1, 8); SUM4(sB, c1, 0); SBAR(); \
        oA[0] = __builtin_amdgcn_mfma_f32_32x32x16_bf16(pa3, PKV(va, 3), oA[0], 0, 0, 0); EXP4(c1, 12); SUM4(sB, c1, 4); SBAR(); \
        oA[1] = __builtin_amdgcn_mfma_f32_32x32x16_bf16(pa3, PKV(vb_, 3), oA[1], 0, 0, 0); SUM4(sB, c1, 8); SUM4(sB, c1, 12); SBAR(); \
        lB += sB; \
        PK4X(c0, 0, pa0); PK4X(c0, 8, pa1); PK4X(c1, 0, pa2); PK4X(c1, 8, pa3); \
        SBAR(); \
        VRD8(va, vbase, 0); VRD8(vb_, vbase, 1);                       \
        oB[0] = __builtin_amdgcn_mfma_f32_32x32x16_bf16(pa0, PKV(va, 0), oB[0], 0, 0, 0); \
        oB[1] = __builtin_amdgcn_mfma_f32_32x32x16_bf16(pa0, PKV(vb_, 0), oB[1], 0, 0, 0); \
        oB[0] = __builtin_amdgcn_mfma_f32_32x32x16_bf16(pa1, PKV(va, 1), oB[0], 0, 0, 0); \
        oB[1] = __builtin_amdgcn_mfma_f32_32x32x16_bf16(pa1, PKV(vb_, 1), oB[1], 0, 0, 0); \
        oB[0] = __builtin_amdgcn_mfma_f32_32x32x16_bf16(pa2, PKV(va, 2), oB[0], 0, 0, 0); \
        oB[1] = __builtin_amdgcn_mfma_f32_32x32x16_bf16(pa2, PKV(vb_, 2), oB[1], 0, 0, 0); \
        oB[0] = __builtin_amdgcn_mfma_f32_32x32x16_bf16(pa3, PKV(va, 3), oB[0], 0, 0, 0); \
        oB[1] = __builtin_amdgcn_mfma_f32_32x32x16_bf16(pa3, PKV(vb_, 3), oB[1], 0, 0, 0); \
        SBAR(); } while (0)
#define TILE_BAR() do { asm volatile("s_waitcnt vmcnt(0)" ::: "memory"); __syncthreads(); } while (0)
    DMA2(0, 0, 0);
    if (wid < 4) {
        int vs = 0;
#pragma unroll 1
        for (int t = 0; t < NT; ++t) { TILE_BAR();
            const int vn = vs == 2 ? 0 : vs + 1; if (t + 1 < NT) DMA2(t + 1, (t + 1) & 1, vn);
            HALF1(K_lds + (t & 1) * SHM_K); HALF2(vrd0 + vs * SHM_V); vs = vn; }
        TILE_BAR();
    } else {
        __builtin_amdgcn_s_setprio(1);
        TILE_BAR(); if (1 < NT) DMA2(1, 1, 1);
        HALF1(K_lds);
        int vs = 0;
#pragma unroll 1
        for (int t = 1; t < NT; ++t) { TILE_BAR();
            const int vn = vs == 2 ? 0 : vs + 1; const int vnn = vn == 2 ? 0 : vn + 1; if (t + 1 < NT) DMA2(t + 1, (t + 1) & 1, vnn);
            HALF2(vrd0 + vs * SHM_V); HALF1(K_lds + (t & 1) * SHM_K); vs = vn; }
        TILE_BAR();
        HALF2(vrd0 + vs * SHM_V);
        __builtin_amdgcn_s_setprio(0);
    }
#undef HALF1
#undef HALF2
#undef TILE_BAR
    { auto rr = __builtin_amdgcn_permlane32_swap(__float_as_uint(lA), __float_as_uint(lA), false, false); lA = __uint_as_float(rr[0]) + __uint_as_float(rr[1]); }
    { auto rr = __builtin_amdgcn_permlane32_swap(__float_as_uint(lB), __float_as_uint(lB), false, false); lB = __uint_as_float(rr[0]) + __uint_as_float(rr[1]); }
    if (hi == 0) { ws[r32] = lA; ws[32 + r32] = lB; } asm volatile("s_waitcnt lgkmcnt(0)" ::: "memory");
    bf16* Ow = Ob + (long)(wid * 64) * ldo;
#pragma unroll
    for (int r = 0; r < 16; ++r) { const int orow = crow(r, hi); const float ra = __builtin_amdgcn_rcpf(ws[orow]), rb = __builtin_amdgcn_rcpf(ws[32 + orow]);
#pragma unroll
        for (int d0 = 0; d0 < NB; ++d0) { Ow[(long)orow * ldo + d0 * 32 + r32] = f2bf(oA[d0][r] * ra); Ow[(long)(32 + orow) * ldo + d0 * 32 + r32] = f2bf(oB[d0][r] * rb); } }
    __syncthreads();
#undef DMA2
#undef VRD8
#undef PKV
}
#undef EXP4
#undef SUM4
#undef PK4X

__device__ __forceinline__ void spatial_unit(int chunk, int g, const bf16* __restrict__ U, const bf16* __restrict__ VR, const float* __restrict__ vstat, const float* __restrict__ g_sg,
                                             const bf16* __restrict__ Wsb, const float* __restrict__ b_s, bf16* __restrict__ Y, LAS char* lds) {
    int tid_ = threadIdx.x; asm volatile("" : "+v"(tid_));
    const int tid = tid_, wid = tid >> 6, lane = tid & 63, r32 = lane & 31, hi = lane >> 5, rb = wid & 3, ch = wid >> 2;
    LAS char* V_lds = lds; LAS float* rv = (LAS float*)(lds + 32768);
    const int row0 = chunk * 128;
    f32x4 s0 = {0.f, 0.f, 0.f, 0.f}, s1 = {0.f, 0.f, 0.f, 0.f};
    if (tid < 128) { s0 = *(const f32x4*)(vstat + (size_t)(row0 + tid) * 8); s1 = *(const f32x4*)(vstat + (size_t)(row0 + tid) * 8 + 4); }
    u32x4 wv[4];
#pragma unroll
    for (int i = 0; i < 4; ++i) { const int c = tid + 512 * i, row = c >> 4, cc = c & 15; wv[i] = *(const u32x4*)(VR + (size_t)(row0 + row) * 512 + g * 128 + cc * 8); }
    const f32x4 g0 = *(const f32x4*)(g_sg + g * 128 + (tid & 15) * 8), g1 = *(const f32x4*)(g_sg + g * 128 + (tid & 15) * 8 + 4);
    bf16x8 pa[8];
#pragma unroll
    for (int ks = 0; ks < 8; ++ks) pa[ks] = *(const bf16x8*)(Wsb + (size_t)g * 16384 + (size_t)(32 * rb + r32) * 128 + 16 * ks + 8 * hi);
    bf16 ur[16][2]; float bias[16];
#pragma unroll
    for (int r = 0; r < 16; ++r) { const int i = 32 * rb + crow(r, hi); bias[r] = b_s[g * 128 + i];
#pragma unroll
        for (int dd = 0; dd < 2; ++dd) ur[r][dd] = U[(size_t)(row0 + i) * 512 + g * 128 + 64 * ch + 32 * dd + r32]; }
    if (tid < 128) rv[tid] = __builtin_amdgcn_rsqf(((s0[0] + s0[1]) + (s0[2] + s0[3]) + (s1[0] + s1[1]) + (s1[2] + s1[3])) * (1.f / 512.f) + EPS);
    __syncthreads();
#pragma unroll
    for (int i = 0; i < 4; ++i) { const int c = tid + 512 * i, row = c >> 4, cc = c & 15; f32x4 a, b; unpack8(wv[i], a, b); const float r = rv[row];
        *(LAS u32x4*)(V_lds + (row >> 6) * 16384 + v_st<4>(row & 63, cc * 8)) = pack8(a * r * g0, b * r * g1); }
    __syncthreads();
    f32x16 o[2]; o[0] = f32x16{}; o[1] = f32x16{};
    const int vb = (int)(uintptr_t)V_lds + v_rd_base(lane) + (2 * ch) * 512;
    pv_one<4, 0>(o[0], vb, pa[0], pa[1], pa[2], pa[3]); pv_one<4, 1>(o[1], vb, pa[0], pa[1], pa[2], pa[3]);
    pv_one<4, 0>(o[0], vb + 16384, pa[4], pa[5], pa[6], pa[7]); pv_one<4, 1>(o[1], vb + 16384, pa[4], pa[5], pa[6], pa[7]);
#pragma unroll
    for (int r = 0; r < 16; ++r) { const int i = 32 * rb + crow(r, hi); const size_t row = (size_t)(row0 + i);
#pragma unroll
        for (int dd = 0; dd < 2; ++dd) { const int c = g * 128 + 64 * ch + 32 * dd + r32; const float uu = bf2f(ur[r][dd]);
            Y[row * 1536 + 512 + c] = f2bf(uu * (o[dd][r] + bias[r])); } }
    __syncthreads();
}
#undef KSWZ
#undef SBAR
}

#define XB_TMO      128
#define XB_XCNT(j)  (256  + 64 * (j))
#define XB_XSUB(j)  (1280 + 64 * (j))
#define XB_XGEN(j)  (2304 + 64 * (j))
#define XB_TOP      3328
#define XB_TOPGEN   3392
#define XCD_BAR_WORDS 3456
#define XB_SPIN_CAP (1u << 18)
__device__ __forceinline__ unsigned xb_ld(unsigned* p)              { return __hip_atomic_load((GAS unsigned*)p, __ATOMIC_RELAXED, __HIP_MEMORY_SCOPE_AGENT); }
__device__ __forceinline__ unsigned xb_add(unsigned* p, unsigned v) { return __hip_atomic_fetch_add((GAS unsigned*)p, v, __ATOMIC_RELAXED, __HIP_MEMORY_SCOPE_AGENT); }
__device__ __forceinline__ unsigned xb_xcc_id() { return (unsigned)__builtin_amdgcn_s_getreg((3 << 11) | 20) & 0xFu; }
#define XB_SPIN(cond, bar) do { unsigned _sp = 0; while (cond) { __builtin_amdgcn_s_sleep(1); \
    if ((++_sp & 255u) == 0u) { if (xb_ld(&(bar)[XB_TMO])) break; if (_sp > XB_SPIN_CAP) { xb_add(&(bar)[XB_TMO], 1u); break; } } } } while (0)
struct XcdBarrier { unsigned* bar; unsigned x; volatile LAS unsigned* st; };
__device__ __forceinline__ XcdBarrier xcd_barrier_post(unsigned* bar, volatile LAS unsigned* st) {
    XcdBarrier b; b.bar = bar; b.x = (unsigned)__builtin_amdgcn_readfirstlane((int)xb_xcc_id()); b.st = st;
    if (threadIdx.x == 0) (void)xb_add(&bar[XB_XCNT(b.x)], 1u);
    return b;
}
__device__ __forceinline__ void xcd_barrier_complete(unsigned* bar, unsigned x, unsigned& nloc, unsigned& nx) {
    const unsigned G = gridDim.x * gridDim.y * gridDim.z;
    unsigned sum, cnt, mine, sp = 0u;
    for (;;) {
        sum = 0u; cnt = 0u; mine = 0u;
#pragma unroll
        for (unsigned j = 0; j < 16; ++j) { const unsigned c = xb_ld(&bar[XB_XCNT(j)]); sum += c; cnt += (c > 0u) ? 1u : 0u; mine = (j == x) ? c : mine; }
        if (sum == G) break;
        __builtin_amdgcn_s_sleep(1);
        if ((++sp & 255u) == 0u) { if (xb_ld(&bar[XB_TMO])) break; if (sp > XB_SPIN_CAP) { xb_add(&bar[XB_TMO], 1u); break; } }
    }
    nloc = mine > 0u ? mine : 1u; nx = cnt > 0u ? cnt : 1u;
}
__device__ __forceinline__ void xcd_barrier(const XcdBarrier& b) {
    asm volatile("s_waitcnt vmcnt(0)" ::: "memory");
    __syncthreads();
    if (threadIdx.x == 0) {
        unsigned* bar = b.bar; unsigned bx = b.x; asm volatile("" : "+s"(bar), "+s"(bx));
        __builtin_amdgcn_s_waitcnt(0);
        unsigned nloc = b.st[0], nx = b.st[1];
        if (nloc == 0u) { xcd_barrier_complete(bar, bx, nloc, nx); b.st[0] = nloc; b.st[1] = nx; }
        const unsigned old = xb_add(&bar[XB_XSUB(bx)], 1u);
        const unsigned gen = old / nloc;
        if (old + 1u == (gen + 1u) * nloc) {
            __builtin_amdgcn_fence(__ATOMIC_RELEASE, "agent");
            asm volatile("s_waitcnt vmcnt(0)" ::: "memory");
            const unsigned og = xb_add(&bar[XB_TOP], 1u);
            const unsigned tg = og / nx;
            if (og + 1u == (tg + 1u) * nx) xb_add(&bar[XB_TOPGEN], 1u);
            else XB_SPIN(xb_ld(&bar[XB_TOPGEN]) == tg, bar);
            __builtin_amdgcn_fence(__ATOMIC_ACQUIRE, "agent");
            xb_add(&bar[XB_XGEN(bx)], 1u);
            asm volatile("s_waitcnt vmcnt(0)" ::: "memory");
        } else {
            XB_SPIN(xb_ld(&bar[XB_XGEN(bx)]) == gen, bar);
            __builtin_amdgcn_fence(__ATOMIC_ACQUIRE, "agent");
            asm volatile("s_waitcnt vmcnt(0)" ::: "memory");
        }
    }
    __syncthreads();
}

enum { CV_NAT = 0, CV_WIN = 1, CV_WUQ = 2, CV_W13 = 3 };
__device__ __forceinline__ int ropeperm(int p) { return ((p >> 2) & 1) * 16 + 4 * (p >> 3) + (p & 3); }
__device__ __forceinline__ int cv_map(int kind, int G, int& which, float& scale, bool& perm) {
    which = 0; scale = 1.f; perm = false; const int n = G * 32;
    if (kind == CV_WIN) {
        if (n < 384) return n;
        if (n < 416) { perm = true; return 640; }
        if (n < 512) return -1;
        if (n < 768) return 384 + (n - 512);
        if (n < 1280) return 672 + (n - 768);
        if (n < 1792) return 1184 + (n - 1280);
        if (n < 2304) { scale = XSCALE; return 1696 + (n - 1792); }
        return 2208 + (n - 2304);
    }
    if (kind == CV_WUQ) { scale = QSCALE; perm = (G % 3) == 2; return n; }
    if (kind == CV_W13) { which = (n >> 7) & 1; return 128 * (n >> 8) + (n & 127); }
    return n;
}
struct CvDesc { const float* src; const float* src2; const float* gain; bf16* dst; int K, Nsrc, Nout, kind; };
__device__ __forceinline__ void cv_item(const CvDesc& d, int item, LAS char* tile, int lane) {
    const int nI = d.Nout >> 7, kb = item / nI, nb = item - kb * nI, k0 = 64 * kb, n0 = 128 * nb;
    const int nq = lane & 31, kh = lane >> 5;
    const int nout = n0 + 4 * nq, G = nout >> 5, p = nout & 31;
    int which; float scale; bool perm; const int sc = cv_map(d.kind, G, which, scale, perm);
    const bool zero = sc < 0;
    const float* W = d.src + (ptrdiff_t)which * (d.src2 - d.src) + (size_t)k0 * d.Nsrc + (zero ? 0 : sc + (perm ? ropeperm(p) : p));
#pragma unroll
    for (int half = 0; half < 2; ++half) {
        f32x4 v[16];
#pragma unroll
        for (int i = 0; i < 16; ++i) { const int k = 32 * half + 2 * i + kh; v[i] = zero ? (f32x4){0.f, 0.f, 0.f, 0.f} : *(const f32x4*)(W + (size_t)k * d.Nsrc); }
#pragma unroll
        for (int i = 0; i < 16; ++i) { const int k = 32 * half + 2 * i + kh; const float g = d.gain ? d.gain[k0 + k] * scale : scale; const f32x4 w = v[i] * g;
            *(LAS u32x2*)(tile + att::v_st<4>(k, 4 * nq)) = (u32x2){cvt_pk_bf16(w[0], w[1]), cvt_pk_bf16(w[2], w[3])}; }
    }
    LDS_WAIT(); asm volatile("" ::: "memory");
    const int vb = (int)(uintptr_t)tile + att::v_rd_base(lane);
    bf16* drow = d.dst + (size_t)(n0 >> 8) * 256 * d.K + (size_t)kb * (256 * 64) + (size_t)((n0 & 255) + nq) * 64 + 8 * kh;
#define CV_RD(D0, KS) { const s16x4 l_ = att::tr_read<((2 * KS) * 4 + D0) * 512>(vb), h_ = att::tr_read<((2 * KS + 1) * 4 + D0) * 512>(vb); \
        asm volatile("s_waitcnt lgkmcnt(0)" ::: "memory"); __builtin_amdgcn_sched_barrier(0); \
        *(bf16x8*)(drow + (32 * D0) * 64 + 16 * KS) = (bf16x8){l_[0], l_[1], l_[2], l_[3], h_[0], h_[1], h_[2], h_[3]}; }
#define CV_RD4(D0) CV_RD(D0, 0) CV_RD(D0, 1) CV_RD(D0, 2) CV_RD(D0, 3)
    CV_RD4(0) CV_RD4(1) CV_RD4(2) CV_RD4(3)
#undef CV_RD4
#undef CV_RD
    LDS_WAIT(); asm volatile("" ::: "memory");
}

struct Args {
    const float* x; const float* mem; const int* positions; const float* g_mix; const float* w_in; const float* g_q; const float* g_kv; const float* w_uq; const float* w_uk; const float* w_uv;
    const float* g_sg; const float* w_s; const float* b_s; const float* g_mem; const float* w_mkv; const float* w_br; const float* b_gate; const float* w_out; const float* g_ffn;
    const float* dense_w1; const float* dense_w3; const float* dense_w2; const float* w_router; const float* moe_w1; const float* moe_w3; const float* moe_w2; const float* g_final;
    float* out; unsigned char* ws; int dbg; int pad;
};
typedef const __attribute__((address_space(4))) Args* ArgsP;
#define FRESH(ap) ArgsP ap = kargs; asm volatile("" : "+s"(ap))
__constant__ double INVF[16] = { 1.0, 0.5623413251903491, 0.31622776601683794, 0.1778279410038923, 0.1, 0.05623413251903491, 0.03162277660168379, 0.01778279410038923,
                                 0.01, 0.005623413251903491, 0.003162277660168379, 0.001778279410038923, 0.001, 0.0005623413251903491, 0.00031622776601683794, 0.0001778279410038923 };

struct Frame { LAS unsigned char* lds; int G, NGW, bid; };
#define LOCAL_IDS int tid = threadIdx.x; asm volatile("" : "+v"(tid)); const int lane = tid & 63, wave = __builtin_amdgcn_readfirstlane(tid >> 6), gw = F.bid * NWAVES + wave; (void)lane; (void)gw

__device__ __forceinline__ void conv_run(const Frame& F, const CvDesc& d) {
    LOCAL_IDS;
    LAS char* tile = (LAS char*)(F.lds + wave * 16384);
    const int nitems = (d.K / 64) * (d.Nout / 128);
    for (int it = gw; it < nitems; it += F.NGW) cv_item(d, it, tile, lane);
}
__device__ __forceinline__ void rx_from_stats(const Frame& F, ArgsP kargs) {
    LOCAL_IDS; FRESH(ap); const float* xstat = (const float*)(ap->ws + WS_XSTAT); float* rx = (float*)(ap->ws + WS_RX);
    for (int row = F.bid * 512 + tid; row < M; row += F.G * 512) {
        const f32x4* p = (const f32x4*)(xstat + (size_t)row * 16); const f32x4 a = p[0], b = p[1], c = p[2], d = p[3];
        const float s = ((a[0] + a[1]) + (a[2] + a[3])) + ((b[0] + b[1]) + (b[2] + b[3])) + ((c[0] + c[1]) + (c[2] + c[3])) + ((d[0] + d[1]) + (d[2] + d[3]));
        rx[row] = __builtin_amdgcn_rsqf(s * (1.f / D) + EPS);
    }
}
template <int MODE>
__device__ __forceinline__ void conv_flat(const Frame& F, ArgsP kargs, int l, int j2, int lmix) {
    int tid_ = threadIdx.x; asm volatile("" : "+v"(tid_)); const int lane_ = tid_ & 63, wave_ = __builtin_amdgcn_readfirstlane(tid_ >> 6);
    LAS char* tile = (LAS char*)(F.lds + wave_ * 16384);
    constexpr int I13D = (D / 64) * (2 * DFF / 128), I2D = (DFF / 64) * (D / 128), I13 = (D / 64) * (2 * DFE / 128), I2 = (DFE / 64) * (D / 128), IE = I13 + I2, IMKV = (D / 64) * (D / 128);
    constexpr int NB_ = MODE == 0 ? DEPTH * IMKV : MODE == 1 ? I13D + I2D : MODE == 2 ? NE * IE : 0;
    constexpr int M_IN = (D / 64) * (PPAD / 128), M_UQ = (QRANK / 64) * (768 / 128), M_UK = (KVRANK / 64) * (512 / 128), M_BR = (BW / 64) * (D / 128), M_OUT = (D / 64) * (D / 128);
    constexpr int O_UQ = M_IN, O_UK = O_UQ + M_UQ, O_UV = O_UK + M_UK, O_BR = O_UV + M_UK, O_OUT = O_BR + 3 * M_BR, NMIX = O_OUT + M_OUT;
    const int total = NB_ + ((lmix >= 0 && lmix < DEPTH) ? NMIX : 0);
#pragma unroll 1
    for (int idx = wave_ * F.G + F.bid; idx < total; idx += F.NGW) { FRESH(a); CvDesc d; int it;
        if (idx < NB_) {
            if constexpr (MODE == 0) { const int lq = idx / IMKV; it = idx - lq * IMKV; d = CvDesc{a->w_mkv + (size_t)lq * D * D, nullptr, nullptr, (bf16*)(a->ws + WS_WMKVT) + (size_t)lq * D * D, D, D, D, CV_NAT}; }
            else if constexpr (MODE == 1) {
                if (idx < I13D) { it = idx; d = CvDesc{a->dense_w1 + (size_t)j2 * D * DFF, a->dense_w3 + (size_t)j2 * D * DFF, a->g_ffn + l * D, (bf16*)(a->ws + WS_WFFN), D, DFF, 2 * DFF, CV_W13}; }
                else { it = idx - I13D; d = CvDesc{a->dense_w2 + (size_t)j2 * DFF * D, nullptr, nullptr, (bf16*)(a->ws + WS_W2D), DFF, D, D, CV_NAT}; } }
            else { const int e = idx / IE, r = idx - e * IE;
                if (r < I13) { it = r; d = CvDesc{a->moe_w1 + ((size_t)j2 * NE + e) * D * DFE, a->moe_w3 + ((size_t)j2 * NE + e) * D * DFE, a->g_ffn + l * D, (bf16*)(a->ws + WS_WFFN) + (size_t)e * 2 * DFE * D, D, DFE, 2 * DFE, CV_W13}; }
                else { it = r - I13; d = CvDesc{a->moe_w2 + ((size_t)j2 * NE + e) * DFE * D, nullptr, nullptr, (bf16*)(a->ws + WS_W2M) + (size_t)e * D * DFE, DFE, D, D, CV_NAT}; } }
        } else { const int r = idx - NB_;
            if (r < O_UQ) { it = r; d = CvDesc{a->w_in + (size_t)lmix * D * PTOT, nullptr, a->g_mix + lmix * D, (bf16*)(a->ws + WS_WINT), D, PTOT, PPAD, CV_WIN}; }
            else if (r < O_UK) { it = r - O_UQ; d = CvDesc{a->w_uq + (size_t)lmix * QRANK * 768, nullptr, a->g_q + lmix * QRANK, (bf16*)(a->ws + WS_WUQT), QRANK, 768, 768, CV_WUQ}; }
            else if (r < O_UV) { it = r - O_UK; d = CvDesc{a->w_uk + (size_t)lmix * KVRANK * 512, nullptr, a->g_kv + lmix * KVRANK, (bf16*)(a->ws + WS_WUKVT), KVRANK, 512, 512, CV_NAT}; }
            else if (r < O_BR) { it = r - O_UV; d = CvDesc{a->w_uv + (size_t)lmix * KVRANK * 512, nullptr, a->g_kv + lmix * KVRANK, (bf16*)(a->ws + WS_WUKVT) + 512 * KVRANK, KVRANK, 512, 512, CV_NAT}; }
            else if (r < O_OUT) { const int n = (r - O_BR) / M_BR; it = (r - O_BR) - n * M_BR; d = CvDesc{a->w_br + ((size_t)lmix * 3 + n) * BW * D, nullptr, nullptr, (bf16*)(a->ws + WS_WBRT) + (size_t)n * D * BW, BW, D, D, CV_NAT}; }
            else { it = r - O_OUT; d = CvDesc{a->w_out + (size_t)lmix * D * D, nullptr, nullptr, (bf16*)(a->ws + WS_WOUTT), D, D, D, CV_NAT}; } }
        cv_item(d, it, tile, lane_); }
    if (lmix >= 0 && lmix < DEPTH) {
        FRESH(a); const float* wsrc = a->w_s + (size_t)lmix * 65536; bf16* wdst = (bf16*)(a->ws + WS_WSB);
        for (int i = F.bid * 512 + tid_; i < 4 * 128 * 128 / 4; i += F.G * 512) { const f32x4 v = *(const f32x4*)(wsrc + (size_t)i * 4);
            *(u32x2*)(wdst + (size_t)i * 4) = (u32x2){cvt_pk_bf16(v[0], v[1]), cvt_pk_bf16(v[2], v[3])}; } }
}
__device__ __forceinline__ void phase_prologue(const Frame& F, ArgsP kargs) {
    LOCAL_IDS;
    { FRESH(a); float* ROPE = (float*)(a->ws + WS_ROPE); const int* pos = a->positions;
      for (int idx = F.bid * 512 + tid; idx < M * 16; idx += F.G * 512) { const int row = idx >> 4, i = idx & 15;
        const double t = (double)pos[row] * INVF[i] * 0.15915494309189535; const float fr = (float)(t - rint(t));
        ROPE[(size_t)row * 32 + i] = __builtin_amdgcn_cosf(fr); ROPE[(size_t)row * 32 + 16 + i] = __builtin_amdgcn_sinf(fr); } }
    { FRESH(a); const float* xin = a->x; bf16* XB = (bf16*)(a->ws + WS_XB); float* RX = (float*)(a->ws + WS_RX);
      f32x4 vn[4];
#pragma unroll
      for (int j = 0; j < 4; ++j) vn[j] = ((const f32x4*)(xin + (size_t)gw * D) + lane)[64 * j];
#pragma unroll 1
      for (int m = gw; m < M; m += F.NGW) { f32x4 v[4]; float s = 0.f; const int mn = m + F.NGW < M ? m + F.NGW : m;
#pragma unroll
        for (int j = 0; j < 4; ++j) { v[j] = vn[j]; s += sumsq4(v[j]); }
#pragma unroll
        for (int j = 0; j < 4; ++j) vn[j] = ((const f32x4*)(xin + (size_t)mn * D) + lane)[64 * j];
        s = wave_sum(s);
#pragma unroll
        for (int j = 0; j < 4; ++j) ((u32x2*)(XB + (size_t)m * D) + lane)[64 * j] = (u32x2){cvt_pk_bf16(v[j][0], v[j][1]), cvt_pk_bf16(v[j][2], v[j][3])};
        if (lane == 0) RX[m] = __builtin_amdgcn_rsqf(s * (1.f / D) + EPS); } }
    { FRESH(a); const float* mem = a->mem; const float* g_mem = a->g_mem; bf16* MEMB = (bf16*)(a->ws + WS_MEMB);
      for (int m = gw; m < NMEM; m += F.NGW) { const f32x4* xr = (const f32x4*)(mem + (size_t)m * D) + lane; f32x4 v[4]; float s = 0.f;
#pragma unroll
        for (int j = 0; j < 4; ++j) { v[j] = xr[64 * j]; s += sumsq4(v[j]); }
        const float r = __builtin_amdgcn_rsqf(wave_sum(s) * (1.f / D) + EPS);
#pragma unroll
        for (int j = 0; j < 4; ++j) { const f32x4 g = ((const f32x4*)g_mem + lane)[64 * j]; const f32x4 w = v[j] * r * g;
            ((u32x2*)(MEMB + (size_t)m * D) + lane)[64 * j] = (u32x2){cvt_pk_bf16(w[0], w[1]), cvt_pk_bf16(w[2], w[3])}; } } }
    conv_flat<0>(F, kargs, 0, 0, 0);
}
__device__ __forceinline__ void phase_inproj(const Frame& F, ArgsP kargs, int l) {
    if (PH(1)) { FRESH(a); unsigned char* ws = a->ws;
        pg8::TileOrder S{M / 256, PPAD / 256 - 1, F.G, F.bid, (const char*)(ws + WS_XB), (const char*)(ws + WS_WINT), (size_t)256 * D * 2, (size_t)256 * D * 2};
#ifdef DBG_REV
        S.rev = 1;
#endif
        LAS float* rtab = (LAS float*)(F.lds + RING_BYTES + 1024);
        if (l & 1) { int tid_ = threadIdx.x; asm volatile("" : "+v"(tid_)); const float* xstat = (const float*)(ws + WS_XSTAT); f32x4 st[6][4]; bool ok[6];
#pragma unroll
            for (int i = 0; i < 6; ++i) { pg8::Unit u; ok[i] = S.next(i, u) && tid_ < 256; const f32x4* p4 = (const f32x4*)(xstat + (size_t)(ok[i] ? u.pm * 256 + tid_ : 0) * 16);
#pragma unroll
                for (int q = 0; q < 4; ++q) st[i][q] = p4[q]; }
#pragma unroll
            for (int i = 0; i < 6; ++i) if (ok[i]) { float t_ = 0.f;
#pragma unroll
                for (int q = 0; q < 4; ++q) t_ += (st[i][q][0] + st[i][q][1]) + (st[i][q][2] + st[i][q][3]);
                rtab[i * 256 + tid_] = __builtin_amdgcn_rsqf(t_ * (1.f / D) + EPS); }
            __syncthreads(); }
        pg8::EpiInProj E{ws, a->b_gate + (size_t)l * 3 * D, l, (l & 1), rtab};
        pg8::gemm_phase(F.lds, D, D, D, S, E); }
    if (l == 0 && PH(2)) { FRESH(a); unsigned char* ws = a->ws;
        struct MemOrder { enum { VARK = 0, GATHER = 0 }; int c; const char* A; const char* B;
            __device__ __forceinline__ bool next(int i, pg8::Unit& u) const { if (i > 0 || c < 240) return false; const int idx = c - 240; u.pm = 0; u.pn = idx & 3; u.aux = idx >> 2; u.A = A; u.B = B + (size_t)u.aux * D * D * 2 + (size_t)u.pn * 256 * D * 2; return true; } };
        MemOrder S2{F.bid, (const char*)(ws + WS_MEMB), (const char*)(ws + WS_WMKVT)}; pg8::EpiMemKV E2{(bf16*)(ws + WS_KVMEM)};
        pg8::gemm_phase(F.lds, D, D, D, S2, E2); }
}
struct GateTailOrder { enum { VARK = 0, GATHER = 0 }; int c; const char* A; const char* B;
    __device__ __forceinline__ bool next(int i, pg8::Unit& u) const { if (i > 0 || c < 192) return false; u.pm = c - 192; u.pn = PPAD / 256 - 1; u.aux = 0; u.A = A + (size_t)u.pm * 256 * D * 2; u.B = B + (size_t)u.pn * 256 * D * 2; return true; } };
__device__ __forceinline__ void phase_up(const Frame& F, ArgsP kargs, int l) {
    if (PH(1)) { FRESH(a); unsigned char* ws = a->ws;
        GateTailOrder S{F.bid, (const char*)(ws + WS_XB), (const char*)(ws + WS_WINT)}; LAS float* rtab = (LAS float*)(F.lds + RING_BYTES + 1024);
        if (l & 1) { int tid_ = threadIdx.x; asm volatile("" : "+v"(tid_)); pg8::Unit u;
            if (S.next(0, u) && tid_ < 256) { const f32x4* p4 = (const f32x4*)((const float*)(ws + WS_XSTAT) + (size_t)(u.pm * 256 + tid_) * 16); float t_ = 0.f;
#pragma unroll
                for (int q = 0; q < 4; ++q) { const f32x4 v = p4[q]; t_ += (v[0] + v[1]) + (v[2] + v[3]); }
                rtab[tid_] = __builtin_amdgcn_rsqf(t_ * (1.f / D) + EPS); }
            __syncthreads(); }
        pg8::EpiInProj E{ws, a->b_gate + (size_t)l * 3 * D, l, (l & 1), rtab};
        pg8::gemm_phase(F.lds, D, D, D, S, E); }
    if (PH(3)) { FRESH(a); unsigned char* ws = a->ws;
        pg8::TileOrder S{M / 256, 3, F.G, F.bid, (const char*)(ws + WS_CQ), (const char*)(ws + WS_WUQT), (size_t)256 * 512 * 2, (size_t)256 * QRANK * 2};
        pg8::EpiQ E{(const float*)(ws + WS_CQSTAT), (const float*)(ws + WS_ROPE), (bf16*)(ws + WS_Q)}; pg8::gemm_phase(F.lds, 512, QRANK, QRANK, S, E); }
    if (PH(4)) { FRESH(a); unsigned char* ws = a->ws;
        pg8::TileOrder S{M / 256, 4, F.G, F.bid, (const char*)(ws + WS_CKV), (const char*)(ws + WS_WUKVT), (size_t)256 * KVRANK * 2, (size_t)256 * KVRANK * 2};
        pg8::EpiKV E{(const float*)(ws + WS_CKVSTAT), (bf16*)(ws + WS_KN), (bf16*)(ws + WS_V), (unsigned*)(ws + WS_CTL) + CW_KMAX + l * 32}; pg8::gemm_phase(F.lds, KVRANK, KVRANK, KVRANK, S, E); }
    if (PH(5)) { FRESH(a); unsigned char* ws = a->ws;
        for (int un = F.bid; un < 512; un += F.G)
            att::spatial_unit(un >> 2, un & 3, (const bf16*)(ws + WS_U), (const bf16*)(ws + WS_VR), (const float*)(ws + WS_VSTAT), a->g_sg + l * BW, (const bf16*)(ws + WS_WSB), a->b_s + l * 512, (bf16*)(ws + WS_Y), (LAS char*)F.lds); }
    if (PH(6)) { FRESH(a); unsigned char* ws = a->ws;
        for (int un = F.bid; un < 256; un += F.G) { const int h = un & 3, pm = un >> 2; const bf16* kvm = (const bf16*)(ws + WS_KVMEM) + (size_t)l * 256 * 1024;
            att::attn_unit<128, 128, 128, false>((const bf16*)(ws + WS_QX) + (size_t)pm * 256 * 512 + h * 128, 512, kvm + h * 128, 1024, kvm, 1024, kvm + 512 + h * 128, 1024,
                                          (bf16*)(ws + WS_Y) + (size_t)pm * 256 * 1536 + 1024 + h * 128, 1536, NMEM, (LAS char*)F.lds, 0.f); } }
}
__device__ __forceinline__ void phase_attn(const Frame& F, ArgsP kargs, int l) {
    if (PH(7)) { FRESH(a); unsigned char* ws = a->ws;
        for (int un = F.bid; un < 256; un += F.G) { const int h = un & 7, qb = un >> 3;
            const unsigned* km = (const unsigned*)(ws + WS_CTL) + CW_KMAX + l * 32;
            const float kbound = sqrtf(__uint_as_float(km[2 * h]) + __uint_as_float(km[2 * h + 1]) + __uint_as_float(km[16])) * 1.02f;
            att::attn_unit2<96, 64, 64>((const bf16*)(ws + WS_Q) + (size_t)qb * 512 * 768 + h * 96, 768, (const bf16*)(ws + WS_KN) + h * 64, 512, (const bf16*)(ws + WS_KR), 32, (const bf16*)(ws + WS_V) + h * 64, 512,
                                        (bf16*)(ws + WS_Y) + (size_t)qb * 512 * 1536 + h * 64, 1536, M, (LAS char*)F.lds, kbound); } }
}
__device__ __forceinline__ void phase_branch(const Frame& F, ArgsP kargs) {
    if (PH(8)) { FRESH(a); unsigned char* ws = a->ws;
        struct BranchOrder { enum { VARK = 0, GATHER = 0 }; int c; const char* A; const char* B;
            __device__ __forceinline__ bool next(int i, pg8::Unit& u) const { if (i >= 3 || c >= 256) return false; int pm, pn; pg8::tile_of(c, 64, 4, pm, pn); u.pm = pm; u.pn = pn; u.aux = i;
                u.A = A + (size_t)pm * 256 * 1536 * 2 + (size_t)i * 512 * 2; u.B = B + (size_t)i * D * BW * 2 + (size_t)pn * 256 * BW * 2; return true; } };
        BranchOrder S{F.bid, (const char*)(ws + WS_Y), (const char*)(ws + WS_WBRT)}; pg8::EpiBranch E{(const unsigned char*)(ws + WS_GATE), (bf16*)(ws + WS_MIXB)};
        pg8::gemm_phase(F.lds, 1536, BW, BW, S, E); }
}
__device__ __forceinline__ void phase_outproj(const Frame& F, ArgsP kargs, bool dummy = false) {
    if (PH(9)) { FRESH(a); unsigned char* ws = a->ws;
        pg8::TileOrder S{M / 256, 4, F.G, F.bid, (const char*)(ws + WS_MIXB), (const char*)(ws + WS_WOUTT), (size_t)256 * D * 2, (size_t)256 * D * 2};
        (void)dummy; pg8::EpiResid E{(bf16*)(ws + WS_XB), (float*)(ws + WS_XSTAT)}; pg8::gemm_phase(F.lds, 0, D, D, S, E); }
}
__device__ __forceinline__ void phase_dense_conv(const Frame& F, ArgsP kargs, int l, int j2) {
    rx_from_stats(F, kargs);
    conv_flat<1>(F, kargs, l, j2, -1);
}
__device__ __forceinline__ void phase_dense_up(const Frame& F, ArgsP kargs, int l) {
    if (PH(10)) { FRESH(a); unsigned char* ws = a->ws;
        pg8::TileOrder S{M / 256, 2 * DFF / 256, F.G, F.bid, (const char*)(ws + WS_XB), (const char*)(ws + WS_WFFN), (size_t)256 * D * 2, (size_t)256 * D * 2};
        pg8::EpiSwiGLU E{(const float*)(ws + WS_RX), (bf16*)(ws + WS_HFF), DFF, 0}; pg8::gemm_phase(F.lds, D, D, D, S, E); }
    { const int rem = ((M / 256) * (2 * DFF / 256)) % F.G; Frame F2 = F; if (rem != 0) { F2.G = F.G - rem; F2.bid = F.bid - rem; F2.NGW = F2.G * NWAVES; }
      if (rem == 0 || F.bid >= rem) { __syncthreads(); conv_flat<3>(F2, kargs, l, 0, l + 1); } }
}
__device__ __forceinline__ void phase_dense_down(const Frame& F, ArgsP kargs, bool dummy = false) {
    if (PH(11)) { FRESH(a); unsigned char* ws = a->ws;
        pg8::TileOrder S{M / 256, 4, F.G, F.bid, (const char*)(ws + WS_HFF), (const char*)(ws + WS_W2D), (size_t)256 * DFF * 2, (size_t)256 * DFF * 2};
        (void)dummy; pg8::EpiResid E{(bf16*)(ws + WS_XB), (float*)(ws + WS_XSTAT)}; pg8::gemm_phase(F.lds, 0, DFF, DFF, S, E); }
}
__device__ __forceinline__ void phase_moe_route(const Frame& F, ArgsP kargs, int l, int j2) {
    conv_flat<2>(F, kargs, l, j2, l + 1 < DEPTH ? l + 1 : -1);
    __syncthreads();
    LOCAL_IDS; FRESH(a); unsigned char* ws = a->ws; const bf16* X = (const bf16*)(ws + WS_XB);
    float* RX = (float*)(ws + WS_RX); int* TOPI = (int*)(ws + WS_TOPI); float* TOPW = (float*)(ws + WS_TOPW); int* LRANK = (int*)(ws + WS_LRANK); int* BLKCNT = (int*)(ws + WS_BLKCNT);
    LAS int* tope = (LAS int*)(F.lds + 0);
    const float* wr = a->w_router + (size_t)j2 * D * NE; const float* gf = a->g_ffn + l * D;
    f32x4 gvA[4], wA[4][4][2]; u32x2 xn[4];
#pragma unroll
    for (int j = 0; j < 4; ++j) { const int k0 = 4 * lane + 256 * j; gvA[j] = *(const f32x4*)(gf + k0);
#pragma unroll
        for (int q = 0; q < 4; ++q) { wA[j][q][0] = *(const f32x4*)(wr + (size_t)(k0 + q) * 8); wA[j][q][1] = *(const f32x4*)(wr + (size_t)(k0 + q) * 8 + 4); } }
#pragma unroll
    for (int j = 0; j < 4; ++j) xn[j] = *(const u32x2*)(X + (size_t)(F.bid * 64 + wave * 8) * D + 4 * lane + 256 * j);
#pragma unroll 1
    for (int i = 0; i < 8; ++i) { const int rib = wave * 8 + i, row = F.bid * 64 + rib;
        float lg[8]; float ss = 0.f; f32x4 xc[4];
#pragma unroll
        for (int e = 0; e < 8; ++e) lg[e] = 0.f;
#pragma unroll
        for (int j = 0; j < 4; ++j) xc[j] = (f32x4){bflo(xn[j].x), bfhi(xn[j].x), bflo(xn[j].y), bfhi(xn[j].y)};
        if (i + 1 < 8) {
#pragma unroll
            for (int j = 0; j < 4; ++j) xn[j] = *(const u32x2*)(X + (size_t)(row + 1) * D + 4 * lane + 256 * j); }
#pragma unroll
        for (int j = 0; j < 4; ++j) { const f32x4 xv = xc[j], gv = gvA[j]; ss += sumsq4(xv);
#pragma unroll
            for (int q = 0; q < 4; ++q) { const float hv = xv[q] * gv[q]; const f32x4 w0 = wA[j][q][0], w1 = wA[j][q][1];
                lg[0] += hv * w0[0]; lg[1] += hv * w0[1]; lg[2] += hv * w0[2]; lg[3] += hv * w0[3]; lg[4] += hv * w1[0]; lg[5] += hv * w1[1]; lg[6] += hv * w1[2]; lg[7] += hv * w1[3]; } }
        const float r = __builtin_amdgcn_rsqf(wave_sum(ss) * (1.f / D) + EPS);
#pragma unroll
        for (int e = 0; e < 8; ++e) lg[e] = wave_sum(lg[e]) * r;
        int e0 = 0; float v0 = lg[0];
#pragma unroll
        for (int e = 1; e < 8; ++e) if (lg[e] > v0) { v0 = lg[e]; e0 = e; }
        int e1 = e0 == 0 ? 1 : 0; float v1 = -3.0e38f;
#pragma unroll
        for (int e = 0; e < 8; ++e) if (e != e0 && lg[e] > v1) { v1 = lg[e]; e1 = e; }
        const float w0 = 1.f / (1.f + expf(v1 - v0));
        if (lane == 0) { RX[row] = r; TOPI[row] = e0 | (e1 << 8); TOPW[(size_t)row * 2] = w0; TOPW[(size_t)row * 2 + 1] = 1.f - w0; tope[rib] = e0 | (e1 << 8); } }
    __syncthreads();
    if (wave == 0) { const int te = tope[lane], e0 = te & 255, e1 = te >> 8, row = F.bid * 64 + lane; const unsigned long long below = (1ull << lane) - 1ull;
        int rk0 = 0, rk1 = 0;
#pragma unroll
        for (int e = 0; e < 8; ++e) { const unsigned long long m0 = __ballot(e0 == e), m1 = __ballot(e1 == e); const int c0 = __popcll(m0);
            if (e0 == e) rk0 = __popcll(m0 & below); if (e1 == e) rk1 = c0 + __popcll(m1 & below);
            if (lane == 0) BLKCNT[F.bid * 8 + e] = c0 + __popcll(m1); }
        LRANK[(size_t)row * 2] = rk0; LRANK[(size_t)row * 2 + 1] = rk1; }
    __syncthreads();
}
__device__ __forceinline__ void moe_tiles(const Frame& F, ArgsP kargs, int (&tb)[NE + 1], LAS int* pre) {
    LOCAL_IDS; FRESH(a); const int* BLKCNT = (const int*)(a->ws + WS_BLKCNT);
    __syncthreads();
    if (tid < 16) pre[tid] = 0;
    __syncthreads();
    if (tid < 256) { const i32x4 c0 = *(const i32x4*)(BLKCNT + tid * 8), c1 = *(const i32x4*)(BLKCNT + tid * 8 + 4); const int cc[8] = {c0[0], c0[1], c0[2], c0[3], c1[0], c1[1], c1[2], c1[3]};
#pragma unroll
        for (int e = 0; e < 8; ++e) { const int tot = (int)wave_sum((float)cc[e]); const int bel = (int)wave_sum(tid < F.bid ? (float)cc[e] : 0.f);
            if (lane == 0) { __hip_atomic_fetch_add(pre + 8 + e, tot, __ATOMIC_RELAXED, __HIP_MEMORY_SCOPE_WORKGROUP); __hip_atomic_fetch_add(pre + e, bel, __ATOMIC_RELAXED, __HIP_MEMORY_SCOPE_WORKGROUP); } } }
    __syncthreads();
    int acc_t = 0;
#pragma unroll
    for (int e = 0; e < NE; ++e) { tb[e] = acc_t; acc_t += (__builtin_amdgcn_readfirstlane(pre[8 + e]) + 255) >> 8; }
    tb[NE] = acc_t;
}
__device__ __forceinline__ void phase_moe_gather(const Frame& F, ArgsP kargs) {
    int tb[NE + 1]; LAS int* pre = (LAS int*)(F.lds + 0);
    moe_tiles(F, kargs, tb, pre);
    LOCAL_IDS; FRESH(a); unsigned char* ws = a->ws;
    const int* TOPI = (const int*)(ws + WS_TOPI); const int* LRANK = (const int*)(ws + WS_LRANK); int* POS = (int*)(ws + WS_POS); float* SLOTR = (float*)(ws + WS_SLOTR); const float* RX = (const float*)(ws + WS_RX);
    int* TOKOF = (int*)(ws + WS_TOKOF);
    if (lane < 16) { const int pi = wave * 16 + lane, rib = pi >> 1, k = pi & 1, row = F.bid * 64 + rib;
        const int te = TOPI[row], e = k ? (te >> 8) : (te & 255); const int lr = LRANK[(size_t)row * 2 + k]; const float rx = RX[row];
        int bs = 0;
#pragma unroll
        for (int q = 0; q < NE; ++q) if (q == e) bs = tb[q] * 256;
        const int slot = bs + pre[e] + lr;
        POS[(size_t)row * 2 + k] = slot; SLOTR[slot] = rx; TOKOF[slot] = row; }
    if (F.bid < NE) { const int e = F.bid; int b0 = 0, b1 = 0;
#pragma unroll
        for (int q = 0; q < NE; ++q) if (q == e) { b0 = tb[q] * 256; b1 = tb[q + 1] * 256; }
        const int cnt = __builtin_amdgcn_readfirstlane(pre[8 + e]);
        for (int s = b0 + cnt + tid; s < b1; s += NWAVES * 64) { SLOTR[s] = 0.f; TOKOF[s] = 0; } }
    __syncthreads();
}
struct MoeOrder { enum { VARK = 0, GATHER = 0 }; int nN, G, c, T; int tb[NE + 1]; const char* A; const char* B; size_t astep, estep, bstep; int rev = 0;
    __device__ __forceinline__ bool next(int i, pg8::Unit& u) const { const long L = (long)i * G + c; if (L >= (long)T * nN) return false; int pm, pn; pg8::tile_of((int)L, T, nN, pm, pn); if (rev) pm = T - 1 - pm;
        int e = 0;
#pragma unroll
        for (int q = 1; q < NE; ++q) e += (pm >= tb[q]) ? 1 : 0;
        u.pm = pm; u.pn = pn; u.aux = e; u.A = A + (size_t)pm * astep; u.B = B + (size_t)e * estep + (size_t)pn * bstep; return true; } };
struct MoeUpOrder { enum { VARK = 0, GATHER = 1 }; int nN, G, c, T; int tb[NE + 1]; const char* A; const char* B; size_t estep, bstep; const LAS int* tokL;
    __device__ __forceinline__ bool next(int i, pg8::Unit& u) const { const long L = (long)i * G + c; if (L >= (long)T * nN) return false; int pm, pn; pg8::tile_of((int)L, T, nN, pm, pn);
        int e = 0;
#pragma unroll
        for (int q = 1; q < NE; ++q) e += (pm >= tb[q]) ? 1 : 0;
        u.pm = pm; u.pn = pn; u.aux = e; u.A = A; u.B = B + (size_t)e * estep + (size_t)pn * bstep; return true; } };
struct MoeTailOrder { enum { VARK = 1, GATHER = 0 }; static constexpr int PPU = DFE / 128;
    int nN, G, c, T; int tb[NE + 1]; const char* A; const char* B; size_t astep, estep, bstep; int rev = 0;
    __device__ __forceinline__ bool next(int i, pg8::Unit& u) const {
        const int U = T * nN, R = U / G, Lf = U - R * G, x = c & 7, j = c >> 3, nj = (G - x + 7) >> 3;
        const int Lfx = Lf > x ? (Lf - x + 7) >> 3 : 0;
        long L; int k0 = 0, np = PPU, part = 0, k = 0, r = 0, C = 1;
        if (i < R) L = (long)i * G + c;
        else if (i == R && Lfx > 0) { const int cap = nj / Lfx; C = cap >= 8 ? 8 : cap >= 1 ? cap : 1;
            r = j / C; k = j - r * C; if (r >= Lfx) return false;
            L = (long)R * G + x + 8 * r; if (C > 1) { const int q = PPU / C, rem = PPU - q * C; np = q + (k < rem ? 1 : 0); k0 = k * q + (k < rem ? k : rem); part = 3; } }
        else return false;
        int pm, pn; pg8::tile_of((int)L, T, nN, pm, pn); if (rev) pm = T - 1 - pm;
        int e = 0;
#pragma unroll
        for (int q = 1; q < NE; ++q) e += (pm >= tb[q]) ? 1 : 0;
        u.pm = pm; u.pn = pn; u.aux = e | (part << 4) | (k << 8) | (C << 16) | (r << 24); u.nt = 2 * np;
        u.A = A + (size_t)pm * astep + (size_t)k0 * 65536; u.B = B + (size_t)e * estep + (size_t)pn * bstep + (size_t)k0 * 65536; return true; } };
__device__ __forceinline__ void phase_moe_up(const Frame& F, ArgsP kargs) {
    if (PH(12)) { MoeUpOrder S; LAS int* pre = (LAS int*)(F.lds + RING_BYTES + 64); moe_tiles(F, kargs, S.tb, pre);
        FRESH(a); unsigned char* ws = a->ws; S.nN = 2 * DFE / 256; S.G = F.G; S.c = F.bid; S.T = S.tb[NE];
        S.A = (const char*)(ws + WS_XB); S.B = (const char*)(ws + WS_WFFN); S.estep = (size_t)2 * DFE * D * 2; S.bstep = (size_t)256 * D * 2;
        { LAS int* tokL = (LAS int*)(F.lds + RING_BYTES + 1024); S.tokL = tokL; const int* TOKOF = (const int*)(ws + WS_TOKOF);
          int tid_ = threadIdx.x; asm volatile("" : "+v"(tid_)); const int half_ = __builtin_amdgcn_readfirstlane(tid_ >> 8); int tkv[8];
#pragma unroll
          for (int j = 0; j < 8; ++j) { pg8::Unit u; const bool ok = S.next(2 * j + half_, u); tkv[j] = ok ? TOKOF[u.pm * 256 + (tid_ & 255)] : 0; }
#pragma unroll
          for (int j = 0; j < 8; ++j) tokL[(2 * j + half_) * 256 + (tid_ & 255)] = tkv[j];
          __syncthreads(); }
        pg8::EpiSwiGLU E{(const float*)(ws + WS_SLOTR), (bf16*)(ws + WS_HG), DFE, 0}; pg8::gemm_phase(F.lds, D, D, D, S, E); }
}
__device__ __forceinline__ void phase_moe_down(const Frame& F, ArgsP kargs, int j2) {
    if (PH(13)) { MoeTailOrder S; LAS int* pre = (LAS int*)(F.lds + RING_BYTES + 64); moe_tiles(F, kargs, S.tb, pre);
        FRESH(a); unsigned char* ws = a->ws; S.nN = 4; S.G = F.G; S.c = F.bid; S.T = S.tb[NE]; S.rev = 1;
        S.A = (const char*)(ws + WS_HG); S.B = (const char*)(ws + WS_W2M); S.astep = (size_t)256 * DFE * 2; S.estep = (size_t)D * DFE * 2; S.bstep = (size_t)256 * DFE * 2;
        pg8::EpiBf16KS E{(bf16*)(ws + WS_OUTG), D, (float*)(ws + WS_SKPART), (unsigned*)(ws + WS_CTL) + CW_SK + j2 * 512, F.bid}; pg8::gemm_phase(F.lds, 0, DFE, DFE, S, E); }
}
__device__ __forceinline__ void phase_moe_combine(const Frame& F, ArgsP kargs, bool last) {
    LOCAL_IDS; FRESH(a); unsigned char* ws = a->ws; float* OUT = a->out; const bf16* OUTG = (const bf16*)(ws + WS_OUTG); const int* POS = (const int*)(ws + WS_POS); const float* TOPW = (const float*)(ws + WS_TOPW);
    bf16* XB = (bf16*)(ws + WS_XB); float* RX = (float*)(ws + WS_RX); const float* g_final = a->g_final;
    int s0n, s1n; float w0n, w1n, w0c, w1c; u32x2 pn0[4], pn1[4], xn[4];
    { const int s0 = POS[(size_t)gw * 2], s1 = POS[(size_t)gw * 2 + 1]; w0c = TOPW[(size_t)gw * 2]; w1c = TOPW[(size_t)gw * 2 + 1];
      const int m1 = gw + F.NGW < M ? gw + F.NGW : gw; s0n = POS[(size_t)m1 * 2]; s1n = POS[(size_t)m1 * 2 + 1]; w0n = TOPW[(size_t)m1 * 2]; w1n = TOPW[(size_t)m1 * 2 + 1];
#pragma unroll
      for (int j = 0; j < 4; ++j) { pn0[j] = ((const u32x2*)(OUTG + (size_t)s0 * D) + lane)[64 * j]; pn1[j] = ((const u32x2*)(OUTG + (size_t)s1 * D) + lane)[64 * j]; xn[j] = ((const u32x2*)(XB + (size_t)gw * D) + lane)[64 * j]; } }
#pragma unroll 1
    for (int m = gw; m < M; m += F.NGW) {
        const float w0 = w0c, w1 = w1c; u32x2 p0c[4], p1c[4], xc[4];
#pragma unroll
        for (int j = 0; j < 4; ++j) { p0c[j] = pn0[j]; p1c[j] = pn1[j]; xc[j] = xn[j]; }
        { const int mn = m + F.NGW < M ? m + F.NGW : m, mnn = m + 2 * F.NGW < M ? m + 2 * F.NGW : m; const int s0 = s0n, s1 = s1n; w0c = w0n; w1c = w1n;
#pragma unroll
          for (int j = 0; j < 4; ++j) { pn0[j] = ((const u32x2*)(OUTG + (size_t)s0 * D) + lane)[64 * j]; pn1[j] = ((const u32x2*)(OUTG + (size_t)s1 * D) + lane)[64 * j]; xn[j] = ((const u32x2*)(XB + (size_t)mn * D) + lane)[64 * j]; }
          s0n = POS[(size_t)mnn * 2]; s1n = POS[(size_t)mnn * 2 + 1]; w0n = TOPW[(size_t)mnn * 2]; w1n = TOPW[(size_t)mnn * 2 + 1]; }
        f32x4 v[4]; float s = 0.f;
#pragma unroll
        for (int j = 0; j < 4; ++j) { const u32x2 p0 = p0c[j], p1 = p1c[j];
            const f32x4 o0 = {bflo(p0.x), bfhi(p0.x), bflo(p0.y), bfhi(p0.y)}, o1 = {bflo(p1.x), bfhi(p1.x), bflo(p1.y), bfhi(p1.y)};
            const f32x4 xf = {bflo(xc[j].x), bfhi(xc[j].x), bflo(xc[j].y), bfhi(xc[j].y)}; v[j] = xf + w0 * o0 + w1 * o1; s += sumsq4(v[j]); }
        const float r = __builtin_amdgcn_rsqf(wave_sum(s) * (1.f / D) + EPS);
        if (last) {
#pragma unroll
            for (int j = 0; j < 4; ++j) ((f32x4*)(OUT + (size_t)m * D) + lane)[64 * j] = v[j] * r * ((const f32x4*)g_final + lane)[64 * j];
        } else {
#pragma unroll
            for (int j = 0; j < 4; ++j) ((u32x2*)(XB + (size_t)m * D) + lane)[64 * j] = (u32x2){cvt_pk_bf16(v[j][0], v[j][1]), cvt_pk_bf16(v[j][2], v[j][3])};
            if (lane == 0) RX[m] = r;
        }
    }
}


#ifdef DBG_ENABLE
__device__ __forceinline__ float dbg_b(const unsigned char* ws, size_t off, size_t idx) { return bf2f(((const bf16*)(ws + off))[idx]); }
__device__ __forceinline__ void dbg_dump(const Frame& F, ArgsP kargs, int code) {
    LOCAL_IDS; FRESH(a); const unsigned char* ws = a->ws; float* out = a->out;
    unsigned tmo = ((const unsigned*)(ws + WS_CTL))[CW_BAR + XB_TMO];
    for (size_t i = (size_t)F.bid * 512 + tid; i < (size_t)M * D; i += (size_t)F.G * 512) { const size_t row = i >> 10, c = i & 1023; float v = 0.f;
        if (code == 1) v = dbg_b(ws, WS_CQ, row * 512 + (c & 511)) + dbg_b(ws, WS_CKV, row * 256 + (c & 255)) + dbg_b(ws, WS_U, row * 512 + (c & 511)) + dbg_b(ws, WS_VR, row * 512 + (c & 511)) + dbg_b(ws, WS_QX, row * 512 + (c & 511))
                         + dbg_b(ws, WS_GATE, row * 3072 + c) + dbg_b(ws, WS_GATE, row * 3072 + 1024 + c) + dbg_b(ws, WS_GATE, row * 3072 + 2048 + c) + dbg_b(ws, WS_KR, row * 32 + (c & 31));
        else if (code == 2) v = dbg_b(ws, WS_Q, row * 768 + (c % 768)) + dbg_b(ws, WS_KN, row * 512 + (c & 511)) + dbg_b(ws, WS_V, row * 512 + (c & 511)) + dbg_b(ws, WS_Y, row * 1536 + 512 + c);
        else if (code == 3) v = dbg_b(ws, WS_Y, row * 1536 + (c & 511));
        else if (code == 15) v = dbg_b(ws, WS_WINT, i % ((size_t)PPAD * D));
        else if (code == 13 || code == 14) v = dbg_b(ws, WS_GATE, row * 3072 + c) + dbg_b(ws, WS_GATE, row * 3072 + 1024 + c) + dbg_b(ws, WS_GATE, row * 3072 + 2048 + c);
        else if (code == 4) v = dbg_b(ws, WS_MIXB, row * 1024 + c);
        else if (code == 6) v = dbg_b(ws, WS_HFF, row * 2688 + c) + dbg_b(ws, WS_HFF, row * 2688 + 1024 + c) + dbg_b(ws, WS_HFF, row * 2688 + 1664 + c);
        else if (code == 9) { const int s0 = ((const int*)(ws + WS_POS))[row * 2], s1 = ((const int*)(ws + WS_POS))[row * 2 + 1]; v = dbg_b(ws, WS_XG, (size_t)s0 * 1024 + c) + 2.f * dbg_b(ws, WS_XG, (size_t)s1 * 1024 + c) + ((const float*)(ws + WS_TOPW))[row * 2] + (float)s0 * 1e-3f; }
        else if (code == 10) { const int s0 = ((const int*)(ws + WS_POS))[row * 2], s1 = ((const int*)(ws + WS_POS))[row * 2 + 1]; v = dbg_b(ws, WS_HG, (size_t)s0 * 3584 + c) + dbg_b(ws, WS_HG, (size_t)s1 * 3584 + 2560 + c) + dbg_b(ws, WS_HG, (size_t)s0 * 3584 + 1500 + c); }
        else if (code == 11) { const int s0 = ((const int*)(ws + WS_POS))[row * 2], s1 = ((const int*)(ws + WS_POS))[row * 2 + 1]; v = ((const float*)(ws + WS_OUTG))[(size_t)s0 * 1024 + c] + ((const float*)(ws + WS_OUTG))[(size_t)s1 * 1024 + c]; }
        else continue;
        if (tmo) v = __builtin_nanf("");
        out[i] = v; }
}
#define DBG(code) do { if (dbgc == (code)) { dbg_dump(F, kargs, code); return; } } while (0)
#else
#define DBG(code) do { } while (0)
#endif

__global__ void __launch_bounds__(NWAVES * 64, 2) fwd_kernel(Args args_by_value) {
    extern __shared__ __attribute__((aligned(16))) unsigned char lds_raw[];
    const ArgsP kargs = (ArgsP)__builtin_amdgcn_kernarg_segment_ptr();
    Frame F; F.lds = (LAS unsigned char*)lds_raw; F.G = gridDim.x; F.bid = blockIdx.x; F.NGW = F.G * NWAVES;
    for (int u = threadIdx.x; u < (LDS_BYTES - LDSCTL_OFF) / 4; u += NWAVES * 64) ((LAS unsigned*)(F.lds + LDSCTL_OFF))[u] = 0u;
    __syncthreads();
    volatile LAS unsigned* MISC = (volatile LAS unsigned*)(F.lds + MISC_OFF);
    XcdBarrier bar; { FRESH(a); bar = xcd_barrier_post((unsigned*)(a->ws + WS_CTL) + CW_BAR, MISC + 8); }
#define GRID_BAR() xcd_barrier(bar)

#ifdef ONLY_TEST
    ONLY_TEST; GRID_BAR(); return;
#endif
    const Frame F_ = F;
    int dbgc; { FRESH(a); dbgc = a->dbg; } (void)dbgc;
    phase_prologue(F, kargs); GRID_BAR();
#pragma unroll 1
    for (int l_ = 0; l_ < DEPTH; ++l_) {
        Frame F = F_; int l = l_; asm volatile("" : "+s"(F.G), "+s"(F.NGW), "+s"(F.bid), "+s"(l));
        const bool moe = (l & 1) != 0; const int j2 = l >> 1;
        if (l == 0) DBG(15);
#ifdef PROBE_INPROJ2
        { int reps = 2; asm volatile("" : "+s"(reps));
#pragma unroll 1
          for (int rep = 0; rep < reps; ++rep) { phase_inproj(F, kargs, l); GRID_BAR(); } }
#else
        phase_inproj(F, kargs, l); GRID_BAR(); if (l == 0) DBG(1); if (l == 0) DBG(14);
#endif
        phase_up(F, kargs, l); GRID_BAR(); if (l == 0) DBG(2);
        phase_attn(F, kargs, l); GRID_BAR(); if (l == 0) DBG(3); if (l == 0) DBG(13);
#ifdef PROBE_ATTN2
        phase_attn(F, kargs, l); GRID_BAR();
#endif
#ifdef PROBE_UP2
        phase_up(F, kargs, l); GRID_BAR();
#endif
        phase_branch(F, kargs); GRID_BAR(); if (l == 0) DBG(4);
#ifdef PROBE_RESID2
        { int reps = 2; asm volatile("" : "+s"(reps));
#pragma unroll 1
          for (int rep = reps - 1; rep >= 0; --rep) { phase_outproj(F, kargs, rep != 0); GRID_BAR(); } }
#else
        phase_outproj(F, kargs); GRID_BAR(); if (l == 0) DBG(5); if (l == 1) DBG(8);
#endif
        if (!moe) {
            phase_dense_conv(F, kargs, l, j2); GRID_BAR();
            phase_dense_up(F, kargs, l); GRID_BAR(); if (l == 0) DBG(6);
#ifdef PROBE_DENSE2
            phase_dense_up(F, kargs, l); GRID_BAR();
#endif
#ifdef PROBE_RESID2
            { int reps = 2; asm volatile("" : "+s"(reps));
#pragma unroll 1
              for (int rep = reps - 1; rep >= 0; --rep) { phase_dense_down(F, kargs, rep != 0); GRID_BAR(); } }
#else
            phase_dense_down(F, kargs); GRID_BAR(); if (l == 0) DBG(7);
#endif
        } else {
            phase_moe_route(F, kargs, l, j2); GRID_BAR();
            phase_moe_gather(F, kargs); GRID_BAR(); if (l == 1) DBG(9);
#ifdef PROBE_AUX2
            phase_moe_gather(F, kargs); GRID_BAR();
#endif
            phase_moe_up(F, kargs); GRID_BAR(); if (l == 1) DBG(10);
            phase_moe_down(F, kargs, j2); GRID_BAR(); if (l == 1) DBG(11);
#ifdef PROBE_MOE2
            phase_moe_up(F, kargs); GRID_BAR();
            phase_moe_down(F, kargs, j2); GRID_BAR();
#endif
            phase_moe_combine(F, kargs, l == DEPTH - 1);
            if (l != DEPTH - 1) GRID_BAR();
            if (l == 1) DBG(12);
        }
    }
}

extern "C" void kernel_launch(void* const* d_in, const int* in_sizes, int n_in, void* d_out, int out_size, void* d_ws, size_t ws_size, hipStream_t stream) {
    static int grid = 0;
    if (grid == 0) {
        if (n_in != 27 || in_sizes[0] != M * D || out_size != M * D || ws_size < WS_END) { fprintf(stderr, "kernel_launch: unexpected shapes (n_in %d, in0 %d, out %d, ws %zu)\n", n_in, n_in > 0 ? in_sizes[0] : -1, out_size, ws_size); grid = -1; return; }
        int dev = 0, cus = 0, per_cu = 0;
        if (hipGetDevice(&dev) != hipSuccess || hipDeviceGetAttribute(&cus, hipDeviceAttributeMultiprocessorCount, dev) != hipSuccess) { grid = -1; return; }
        if (hipFuncSetAttribute((const void*)fwd_kernel, hipFuncAttributeMaxDynamicSharedMemorySize, LDS_BYTES) != hipSuccess) { fprintf(stderr, "kernel_launch: hipFuncSetAttribute failed\n"); grid = -1; return; }
        if (hipOccupancyMaxActiveBlocksPerMultiprocessor(&per_cu, (const void*)fwd_kernel, NWAVES * 64, LDS_BYTES) != hipSuccess || per_cu < 1) { fprintf(stderr, "kernel_launch: occupancy query reports %d\n", per_cu); }
        (void)hipGetLastError();
        if (cus != 256) { fprintf(stderr, "kernel_launch: built for 256 CUs, device has %d\n", cus); grid = -1; return; }
        grid = 256;
    }
    if (grid < 0) return;
    if (hipMemsetAsync((char*)d_ws + WS_CTL, 0, CTL_ZERO_BYTES, stream) != hipSuccess) return;
    Args a{};
    a.x = (const float*)d_in[0]; a.mem = (const float*)d_in[1]; a.positions = (const int*)d_in[2]; a.g_mix = (const float*)d_in[3]; a.w_in = (const float*)d_in[4]; a.g_q = (const float*)d_in[5];
    a.g_kv = (const float*)d_in[6]; a.w_uq = (const float*)d_in[7]; a.w_uk = (const float*)d_in[8]; a.w_uv = (const float*)d_in[9]; a.g_sg = (const float*)d_in[10]; a.w_s = (const float*)d_in[11];
    a.b_s = (const float*)d_in[12]; a.g_mem = (const float*)d_in[13]; a.w_mkv = (const float*)d_in[14]; a.w_br = (const float*)d_in[15]; a.b_gate = (const float*)d_in[16]; a.w_out = (const float*)d_in[17];
    a.g_ffn = (const float*)d_in[18]; a.dense_w1 = (const float*)d_in[19]; a.dense_w3 = (const float*)d_in[20]; a.dense_w2 = (const float*)d_in[21]; a.w_router = (const float*)d_in[22];
    a.moe_w1 = (const float*)d_in[23]; a.moe_w3 = (const float*)d_in[24]; a.moe_w2 = (const float*)d_in[25]; a.g_final = (const float*)d_in[26];
    a.out = (float*)d_out; a.ws = (unsigned char*)d_ws;
#ifdef DBG_STOP
    a.dbg = DBG_STOP;
#endif
    hipLaunchKernelGGL(fwd_kernel, dim3(grid), dim3(NWAVES * 64), LDS_BYTES, stream, a);
    const hipError_t le = hipPeekAtLastError();
    if (le != hipSuccess) fprintf(stderr, "kernel_launch: launch failed: %s\n", hipGetErrorName(le));
}
```

```cpp
#include <hip/hip_runtime.h>
#include <cstdio>
#include <cstdint>

#ifndef PH_MASK
#define PH_MASK 0xffffffffu
#endif
#define PH(k) ((PH_MASK >> (k)) & 1u)
#define LAS __attribute__((address_space(3)))
#define GAS __attribute__((address_space(1)))
typedef unsigned short bf16;
typedef short bf16x8 __attribute__((ext_vector_type(8)));
typedef short s16x4 __attribute__((ext_vector_type(4)));
typedef float f32x4 __attribute__((ext_vector_type(4)));
typedef float f32x2 __attribute__((ext_vector_type(2)));
typedef float f32x16 __attribute__((ext_vector_type(16)));
typedef unsigned u32x4 __attribute__((ext_vector_type(4)));
typedef unsigned u32x2 __attribute__((ext_vector_type(2)));
typedef int i32x4 __attribute__((ext_vector_type(4)));

constexpr int M = 16384, D = 1024, DEPTH = 4, NMEM = 256;
constexpr int QRANK = 384, KVRANK = 256, NH = 8, QKD = 96, VD = 64;
constexpr int XH = 4, XD = 128, BW = 512;
constexpr int PTOT = 5280, PPAD = 5376, DFF = 2688, NE = 8, DFE = 3584;
constexpr float EPS = 1e-6f;
constexpr int MAXSLOT = 34816;
constexpr float LOG2E = 1.4426950408889634f;
constexpr float QSCALE = 0.10206207261596575f * LOG2E;
constexpr float XSCALE = 0.08838834764831845f * LOG2E;

constexpr size_t MiB = 1u << 20, KiB = 1u << 10;
constexpr size_t WS_CTL = 0, CTL_ZERO_BYTES = 128 * KiB;
constexpr size_t WS_ROPE = 2 * MiB;
constexpr size_t WS_XSTAT = 4 * MiB;
constexpr size_t WS_RX = 5 * MiB;
constexpr size_t WS_CQSTAT = 5 * MiB + 256 * KiB;
constexpr size_t WS_CKVSTAT = 5 * MiB + 768 * KiB;
constexpr size_t WS_VSTAT = 6 * MiB;
constexpr size_t WS_MEMB = 6 * MiB + 512 * KiB;
constexpr size_t WS_KVMEM = 7 * MiB;
constexpr size_t WS_TOPI = 9 * MiB;
constexpr size_t WS_TOPW = 9 * MiB + 256 * KiB;
constexpr size_t WS_LRANK = 9 * MiB + 512 * KiB;
constexpr size_t WS_POS = 9 * MiB + 768 * KiB;
constexpr size_t WS_BLKCNT = 10 * MiB;
constexpr size_t WS_SLOTR = 10 * MiB + 512 * KiB;
constexpr size_t WS_TOKOF = 10 * MiB + 768 * KiB;
constexpr size_t WS_WSB = 11 * MiB;
constexpr size_t WS_WMKVT = 12 * MiB;
constexpr size_t WS_WINT = 20 * MiB;
constexpr size_t WS_WUQT = 31 * MiB;
constexpr size_t WS_WUKVT = 32 * MiB;
constexpr size_t WS_WBRT = 33 * MiB;
constexpr size_t WS_WOUTT = 36 * MiB;
constexpr size_t WS_WFFN = 40 * MiB;
constexpr size_t WS_W2D = WS_WFFN + 11 * MiB;
constexpr size_t WS_W2M = WS_WFFN + 112 * MiB;
constexpr size_t WS_XB = 208 * MiB;
constexpr size_t WS_CQ = 240 * MiB;
constexpr size_t WS_CKV = 256 * MiB;
constexpr size_t WS_U = 264 * MiB;
constexpr size_t WS_VR = 280 * MiB;
constexpr size_t WS_QX = 296 * MiB;
constexpr size_t WS_GATE = 312 * MiB;
constexpr size_t WS_Q = 408 * MiB;
constexpr size_t WS_KN = 432 * MiB;
constexpr size_t WS_KR = 448 * MiB;
constexpr size_t WS_V = 450 * MiB;
constexpr size_t WS_Y = 466 * MiB;
constexpr size_t WS_MIX = 514 * MiB;
constexpr size_t WS_MIXB = 578 * MiB;
constexpr size_t WS_MIX1 = 610 * MiB;
constexpr size_t WS_HFF = 240 * MiB;
constexpr size_t WS_XG = 240 * MiB;
constexpr size_t WS_HG = 308 * MiB;
constexpr size_t WS_OUTG = 546 * MiB;
constexpr size_t WS_END = 682 * MiB;
constexpr int CW_TMO = 0, CW_CODE = 1, CW_CHK = 2, CW_BAR = 4096;
constexpr int CW_SK = 16384;
constexpr size_t WS_SKPART = 700 * MiB;
constexpr int CW_KMAX = 8192;

constexpr int RING_BYTES = 131072, LDSCTL_OFF = 159744, MISC_OFF = LDSCTL_OFF + 320, LDS_BYTES = 163840;
constexpr int NWAVES = 8;

#define RLX_AGENT __ATOMIC_RELAXED, __HIP_MEMORY_SCOPE_AGENT
#define LDS_WAIT() asm volatile("s_waitcnt lgkmcnt(0)" ::: "memory")
#define VM_WAIT() asm volatile("s_waitcnt vmcnt(0)" ::: "memory")
typedef __bf16 bf16x2_t __attribute__((ext_vector_type(2)));
__device__ __forceinline__ unsigned cvt_pk_bf16(float lo, float hi) { const f32x2 v = {lo, hi}; const bf16x2_t b = __builtin_convertvector(v, bf16x2_t); return __builtin_bit_cast(unsigned, b); }
__device__ __forceinline__ bf16 f2bf(float f) { return (bf16)(cvt_pk_bf16(f, 0.f) & 0xffffu); }
__device__ __forceinline__ float bf2f(bf16 v) { return __uint_as_float((unsigned)v << 16); }
__device__ __forceinline__ float bflo(unsigned w) { return __uint_as_float(w << 16); }
__device__ __forceinline__ float bfhi(unsigned w) { return __uint_as_float(w & 0xffff0000u); }
__device__ __forceinline__ float fast_exp2(float x) { return __builtin_amdgcn_exp2f(x); }
__device__ __forceinline__ float fast_rcp(float x) { return __builtin_amdgcn_rcpf(x); }
__device__ __forceinline__ float sigmoidf_(float z) { return fast_rcp(1.f + fast_exp2(-LOG2E * z)); }
__device__ __forceinline__ float gelu_tanh(float x) { const float t = x + 0.044715f * x * x * x; return x * fast_rcp(1.f + fast_exp2(-2.f * 0.7978845608028654f * LOG2E * t)); }
template <int CTRL> __device__ __forceinline__ float dppf(float v) { return __builtin_bit_cast(float, __builtin_amdgcn_update_dpp(0, __builtin_bit_cast(int, v), CTRL, 0xf, 0xf, true)); }
__device__ __forceinline__ float row_sum16(float v) { v += dppf<0xB1>(v); v += dppf<0x4E>(v); v += dppf<0x124>(v); v += dppf<0x128>(v); return v; }
__device__ __forceinline__ float row_max16(float v) { v = fmaxf(v, dppf<0xB1>(v)); v = fmaxf(v, dppf<0x4E>(v)); v = fmaxf(v, dppf<0x124>(v)); v = fmaxf(v, dppf<0x128>(v)); return v; }
__device__ __forceinline__ float xsum16(float v) { const auto r = __builtin_amdgcn_permlane16_swap(__float_as_uint(v), __float_as_uint(v), false, false); return __uint_as_float(r[0]) + __uint_as_float(r[1]); }
__device__ __forceinline__ float xsum32(float v) { const auto r = __builtin_amdgcn_permlane32_swap(__float_as_uint(v), __float_as_uint(v), false, false); return __uint_as_float(r[0]) + __uint_as_float(r[1]); }
__device__ __forceinline__ float wave_sum(float v) { return xsum32(xsum16(row_sum16(v))); }
__device__ __forceinline__ float sumsq4(f32x4 v) { return (v[0] * v[0] + v[1] * v[1]) + (v[2] * v[2] + v[3] * v[3]); }
__device__ __forceinline__ u32x2 pack8_u8(f32x4 a, f32x4 b) { unsigned w0 = 0, w1 = 0; a = a * 255.f; b = b * 255.f;
    w0 = __builtin_amdgcn_cvt_pk_u8_f32(a[0], 0, w0); w0 = __builtin_amdgcn_cvt_pk_u8_f32(a[1], 1, w0); w0 = __builtin_amdgcn_cvt_pk_u8_f32(a[2], 2, w0); w0 = __builtin_amdgcn_cvt_pk_u8_f32(a[3], 3, w0);
    w1 = __builtin_amdgcn_cvt_pk_u8_f32(b[0], 0, w1); w1 = __builtin_amdgcn_cvt_pk_u8_f32(b[1], 1, w1); w1 = __builtin_amdgcn_cvt_pk_u8_f32(b[2], 2, w1); w1 = __builtin_amdgcn_cvt_pk_u8_f32(b[3], 3, w1);
    return (u32x2){w0, w1}; }
__device__ __forceinline__ void unpack8_u8(u32x2 w, f32x4& a, f32x4& b) { constexpr float k = 1.f / 255.f;
    a = (f32x4){(float)(w.x & 255u), (float)((w.x >> 8) & 255u), (float)((w.x >> 16) & 255u), (float)(w.x >> 24)} * k;
    b = (f32x4){(float)(w.y & 255u), (float)((w.y >> 8) & 255u), (float)((w.y >> 16) & 255u), (float)(w.y >> 24)} * k; }
__device__ __forceinline__ u32x4 pack8(f32x4 a, f32x4 b) { u32x4 w; w.x = cvt_pk_bf16(a[0], a[1]); w.y = cvt_pk_bf16(a[2], a[3]); w.z = cvt_pk_bf16(b[0], b[1]); w.w = cvt_pk_bf16(b[2], b[3]); return w; }
__device__ __forceinline__ void unpack8(u32x4 w, f32x4& a, f32x4& b) { a = (f32x4){bflo(w.x), bfhi(w.x), bflo(w.y), bfhi(w.y)}; b = (f32x4){bflo(w.z), bfhi(w.z), bflo(w.w), bfhi(w.w)}; }

namespace pg8 {
constexpr int BM = 256, BK = 64, HALF = 128, HTB = HALF * BK * 2, STAGE_BYTES = 8 * HTB, NXCD = 8, WGM = 8;
__host__ __device__ __forceinline__ int lds_byte(int r, int c) { const int st = (r >> 4) * 2 + (c >> 5), rr = r & 15, cc = c & 31, ob = rr * 64 + cc * 2; return st * 1024 + (ob ^ (((ob >> 9) & 1) << 5)); }
__host__ __device__ __forceinline__ void stage_rc(int b, int& R, int& C) { const int st = b / 1024, sb = b % 1024, swz = sb ^ (((sb >> 9) & 1) << 5); R = (st >> 1) * 16 + swz / 64; C = (st & 1) * 32 + (swz % 64) / 2; }
__host__ __device__ __forceinline__ int perm32(int rho) { const int n = rho >> 4, i = rho & 15; return 8 * (i >> 2) + 4 * n + (i & 3); }

struct Unit { const char* A; const char* B; int pm, pn, aux, nt; };
typedef f32x4 Acc[2][2][4][2];

__device__ __forceinline__ void tile_of(int L, int nM, int nN, int& pm, int& pn) {
    const int nwg = nM * nN; int wgid = L;
    { const int q = nwg / NXCD, r = nwg % NXCD, xcd = wgid % NXCD, off = wgid / NXCD; wgid = (xcd < r ? xcd * (q + 1) : r * (q + 1) + (xcd - r) * q) + off; }
    const int nig = WGM * nN, gid = wgid / nig, fm = gid * WGM, gsz = (nM - fm) < WGM ? (nM - fm) : WGM;
    pm = fm + ((wgid % nig) % gsz); pn = (wgid % nig) / gsz;
}
struct TileOrder {
    enum { VARK = 0, GATHER = 0 };
    int nM, nN, G, c; const char* A; const char* B; size_t astep, bstep;
    int rev = 0;
    __device__ __forceinline__ bool next(int i, Unit& u) const {
        if (rev) { const int cnt = (nM * nN - c + G - 1) / G; if (i >= cnt) return false; i = cnt - 1 - i; }
        const long L = (long)i * G + c; if (L >= (long)nM * nN) return false;
        int pm, pn; tile_of((int)L, nM, nN, pm, pn);
        u.pm = pm; u.pn = pn; u.aux = i; u.A = A + (size_t)pm * astep; u.B = B + (size_t)pn * bstep; return true;
    }
};

template <class Epi, class Sched>
__device__ __forceinline__ void gemm_phase(LAS unsigned char* lds, const int lda, const int ldb, const int K, const Sched& S, const Epi& E) {
    int tid_ = threadIdx.x; asm volatile("" : "+v"(tid_));
    const int tid = tid_, wid = __builtin_amdgcn_readfirstlane(tid >> 6), lane = tid & 63, wr = wid >> 2, wc = wid & 3, fr = lane & 15, fq = lane >> 4;
    int nt = K / BK;
    unsigned voffA[2], voffB[2];
#pragma unroll
    for (int i = 0; i < 2; ++i) { int R, C; stage_rc(tid * 16 + i * 8192, R, C); const int Rb = (R & ~31) + perm32(R & 31);
        voffA[i] = (unsigned)(R * (lda ? lda : BK) + C) * 2u; voffB[i] = (unsigned)(Rb * BK + C) * 2u; }
    const size_t kstep = lda ? (size_t)(BK * 2) : (size_t)BM * BK * 2;
    const size_t hstepA = (size_t)HALF * (lda ? lda : BK) * 2, hstepB = (size_t)HALF * BK * 2, kstepB = (size_t)BM * BK * 2; (void)ldb;
    const unsigned ldsw = (unsigned)wid * 1024u;
    const int aoff = lds_byte(wr * 64 + fr, fq * 8), boff = lds_byte(wc * 32 + fr, fq * 8);
#define PG8_SA(b, h) (((b) * 2 + (h)) * HTB)
#define PG8_SB(b, h) ((4 + (b) * 2 + (h)) * HTB)
#define PG8_STAGE(bufoff, gbase, voff) do { _Pragma("unroll") for (int _i = 0; _i < 2; ++_i) \
        __builtin_amdgcn_global_load_lds((const unsigned*)((const char*)(gbase) + (voff)[_i]), (LAS unsigned*)(lds + (bufoff) + ldsw + _i * 8192), 16, 0, 0); } while (0)
#define PG8_STA(b, h, kptr, VG) do { if constexpr (Sched::GATHER) PG8_STAGE(PG8_SA(b, h), (kptr), VG[h]); else PG8_STAGE(PG8_SA(b, h), (kptr) + (h) * hstepA, voffA); } while (0)
#define PG8_GLOOKUP(VG, ui_) do { _Pragma("unroll") for (int _h = 0; _h < 2; ++_h) _Pragma("unroll") for (int _i = 0; _i < 2; ++_i) { int R_, C_; stage_rc(tid * 16 + _i * 8192, R_, C_); \
        VG[_h][_i] = (unsigned)S.tokL[(ui_) * 256 + _h * 128 + R_] * (unsigned)(lda * 2) + (unsigned)(C_ * 2); } } while (0)
#define PG8_LDA(dst, b, h) do { _Pragma("unroll") for (int m = 0; m < 4; ++m) _Pragma("unroll") for (int k = 0; k < 2; ++k) dst[m][k] = *(const LAS bf16x8*)(lds + PG8_SA(b, h) + aoff + m * 2048 + k * 1024); } while (0)
#define PG8_LDB(dst, b, h) do { _Pragma("unroll") for (int n = 0; n < 2; ++n) _Pragma("unroll") for (int k = 0; k < 2; ++k) dst[n][k] = *(const LAS bf16x8*)(lds + PG8_SB(b, h) + boff + n * 2048 + k * 1024); } while (0)
#define PG8_MMA(ai, bj, At, Bt) do { __builtin_amdgcn_s_setprio(1); _Pragma("unroll") for (int m = 0; m < 4; ++m) _Pragma("unroll") for (int n = 0; n < 2; ++n) _Pragma("unroll") for (int k = 0; k < 2; ++k) \
        acc[ai][bj][m][n] = __builtin_amdgcn_mfma_f32_16x16x32_bf16(Bt[n][k], At[m][k], acc[ai][bj][m][n], 0, 0, 0); __builtin_amdgcn_s_setprio(0); } while (0)
#define PG8_WAIT_V(n) asm volatile("s_waitcnt vmcnt(" #n ")" ::: "memory")
#define PG8_WAIT_L(n) asm volatile("s_waitcnt lgkmcnt(" #n ")" ::: "memory")
#define PG8_BAR __builtin_amdgcn_s_barrier()
#define PG8_SCHED __builtin_amdgcn_sched_barrier(0)
    Unit cur, nxt; int ui = 0;
    if (!S.next(0, cur)) return;
    if constexpr (Sched::VARK) nt = cur.nt;
    typename Epi::Pre pre = E.prefetch(cur, wr, fr);
    Acc acc;
#pragma unroll
    for (int a = 0; a < 2; ++a)
#pragma unroll
        for (int b = 0; b < 2; ++b)
#pragma unroll
            for (int m = 0; m < 4; ++m)
#pragma unroll
                for (int n = 0; n < 2; ++n) acc[a][b][m][n] = (f32x4){0.f, 0.f, 0.f, 0.f};
    bf16x8 At[4][2], B0[2][2], B1[2][2];
    const char* cA = cur.A; const char* cB = cur.B;
    unsigned vg[2][2] = {{0u, 0u}, {0u, 0u}}; if constexpr (Sched::GATHER) PG8_GLOOKUP(vg, 0);
    PG8_STAGE(PG8_SB(0, 0), cB, voffB); PG8_STAGE(PG8_SB(0, 1), cB + hstepB, voffB); PG8_STA(0, 0, cA, vg); PG8_STA(0, 1, cA, vg);
    if (wr == 1) PG8_BAR;
    PG8_WAIT_V(2); PG8_BAR;
    PG8_STAGE(PG8_SB(1, 0), cB + kstepB, voffB); PG8_STA(1, 0, cA + kstep, vg); PG8_STAGE(PG8_SB(1, 1), cB + hstepB + kstepB, voffB);
    PG8_WAIT_V(6); PG8_BAR;
    for (;;) {
        const bool has_next = S.next(ui + 1, nxt);
        const char* nA = has_next ? nxt.A : cA; const char* nB = has_next ? nxt.B : cB;
        for (int t = 0; t < nt; t += 2) {
            const bool last = (t == nt - 2);
            const char* a1 = cA + (size_t)(t + 1) * kstep;
            const char* a2 = last ? nA : cA + (size_t)(t + 2) * kstep; const char* b2 = last ? nB : cB + (size_t)(t + 2) * kstepB;
            const char* a3 = a2 + kstep; const char* b3 = b2 + kstepB;
            PG8_LDB(B0, 0, 0); PG8_LDB(B1, 0, 1); PG8_SCHED; PG8_LDA(At, 0, 0); PG8_STA(1, 1, a1, vg);
            if constexpr (Sched::GATHER) { if (last && has_next) PG8_GLOOKUP(vg, ui + 1); }
            PG8_WAIT_V(8); PG8_WAIT_L(0); PG8_BAR; PG8_MMA(0, 0, At, B0); PG8_MMA(0, 1, At, B1); PG8_BAR; PG8_SCHED;
            PG8_LDA(At, 0, 1); PG8_STAGE(PG8_SB(0, 0), b2, voffB); PG8_STAGE(PG8_SB(0, 1), b2 + hstepB, voffB); PG8_STA(0, 0, a2, vg);
            PG8_WAIT_V(8); PG8_WAIT_L(0); PG8_BAR; PG8_MMA(1, 0, At, B0); PG8_MMA(1, 1, At, B1); PG8_BAR; PG8_SCHED;
            PG8_LDB(B0, 1, 0); PG8_LDB(B1, 1, 1); PG8_SCHED; PG8_LDA(At, 1, 0); PG8_STA(0, 1, a2, vg);
            PG8_WAIT_V(8); PG8_WAIT_L(0); PG8_BAR; PG8_MMA(0, 0, At, B0); PG8_MMA(0, 1, At, B1); PG8_BAR; PG8_SCHED;
            PG8_LDA(At, 1, 1); PG8_STAGE(PG8_SB(1, 0), b3, voffB); PG8_STAGE(PG8_SB(1, 1), b3 + hstepB, voffB); PG8_STA(1, 0, a3, vg);
            PG8_WAIT_V(8); PG8_WAIT_L(0); PG8_BAR; PG8_MMA(1, 0, At, B0); PG8_MMA(1, 1, At, B1); PG8_BAR; PG8_SCHED;
        }
        if (wr == 0) PG8_BAR;
        E(acc, cur, wr, wc, fr, fq, pre);
        if (!has_next) break;
        pre = E.prefetch(nxt, wr, fr);
        if constexpr (!Epi::KEEP_ACC)
#pragma unroll
        for (int a = 0; a < 2; ++a)
#pragma unroll
            for (int b = 0; b < 2; ++b)
#pragma unroll
                for (int m = 0; m < 4; ++m)
#pragma unroll
                    for (int n = 0; n < 2; ++n) acc[a][b][m][n] = (f32x4){0.f, 0.f, 0.f, 0.f};
        cur = nxt; cA = nA; cB = nB; ++ui;
        if constexpr (Sched::VARK) nt = cur.nt;
        if (wr == 1) PG8_BAR;
    }
    PG8_WAIT_V(0);
    PG8_BAR;
#undef PG8_SA
#undef PG8_SB
#undef PG8_STAGE
#undef PG8_LDA
#undef PG8_STA
#undef PG8_GLOOKUP
#undef PG8_LDB
#undef PG8_MMA
#undef PG8_WAIT_V
#undef PG8_WAIT_L
#undef PG8_BAR
#undef PG8_SCHED
}

#define EPI_FOR _Pragma("unroll") for (int ai = 0; ai < 2; ++ai) _Pragma("unroll") for (int m = 0; m < 4; ++m)
#define EPI_ROW (u.pm * BM + ai * HALF + wr * 64 + m * 16 + fr)
#define EPI_C8(bj) (u.pn * BM + (bj) * HALF + wc * 32 + 8 * fq)
#define EPI_LOAD_R(rr, ptr) float rr[2][4]; _Pragma("unroll") for (int ai = 0; ai < 2; ++ai) _Pragma("unroll") for (int m = 0; m < 4; ++m) rr[ai][m] = (ptr)[EPI_ROW]; asm volatile("" ::: "memory")

#define EPI_LOAD_RS(rr, xstat) float rr[2][4]; { f32x4 st_[2][4]; _Pragma("unroll") for (int ai = 0; ai < 2; ++ai) _Pragma("unroll") for (int m = 0; m < 4; ++m) st_[ai][m] = *(const f32x4*)((xstat) + (size_t)EPI_ROW * 16 + 4 * fq); \
    asm volatile("" ::: "memory"); _Pragma("unroll") for (int ai = 0; ai < 2; ++ai) _Pragma("unroll") for (int m = 0; m < 4; ++m) { float t_ = (st_[ai][m][0] + st_[ai][m][1]) + (st_[ai][m][2] + st_[ai][m][3]); \
        t_ = xsum32(xsum16(t_)); rr[ai][m] = __builtin_amdgcn_rsqf(t_ * (1.f / D) + EPS); } }
struct NoPre {};
#define EPI_NOPRE static constexpr bool KEEP_ACC = false; typedef NoPre Pre; __device__ __forceinline__ Pre prefetch(const Unit&, int, int) const { return Pre{}; }
struct RowPre { float r[2][4]; };
struct EpiInProj {
    unsigned char* ws; const float* bgate; int layer; int from_stats; const LAS float* rtab;
    static constexpr bool KEEP_ACC = false; typedef RowPre Pre;
    __device__ __forceinline__ Pre prefetch(const Unit& u, int wr, int fr) const { Pre p; const float* rx = (const float*)(ws + WS_RX);
#pragma unroll
        for (int ai = 0; ai < 2; ++ai)
#pragma unroll
            for (int m = 0; m < 4; ++m) p.r[ai][m] = from_stats ? rtab[u.aux * 256 + ai * HALF + wr * 64 + m * 16 + fr] : rx[EPI_ROW];
        return p; }
    __device__ __forceinline__ void operator()(const Acc& acc, const Unit& u, int wr, int wc, int fr, int fq, const Pre& pre) const {
        const float* rope = (const float*)(ws + WS_ROPE);
        bf16* CQ = (bf16*)(ws + WS_CQ); bf16* KR = (bf16*)(ws + WS_KR); bf16* CKV = (bf16*)(ws + WS_CKV); bf16* U = (bf16*)(ws + WS_U); bf16* VR = (bf16*)(ws + WS_VR); bf16* QX = (bf16*)(ws + WS_QX); bf16* GATE = (bf16*)(ws + WS_GATE);
        float* cqstat = (float*)(ws + WS_CQSTAT); float* ckvstat = (float*)(ws + WS_CKVSTAT); float* vstat = (float*)(ws + WS_VSTAT); unsigned* kmax = (unsigned*)(ws + WS_CTL) + CW_KMAX + layer * 32;
        const int pn = u.pn;
        float rr[2][4];
#pragma unroll
        for (int ai = 0; ai < 2; ++ai)
#pragma unroll
            for (int m = 0; m < 4; ++m) rr[ai][m] = pre.r[ai][m];
        if (pn < 2) {
            float krmax = 0.f;
            EPI_FOR { const int row = EPI_ROW;
                const float r = rr[ai][m]; float ss = 0.f;
#pragma unroll
                for (int bj = 0; bj < 2; ++bj) { const f32x4 v0 = acc[ai][bj][m][0] * r, v1 = acc[ai][bj][m][1] * r;
                    if (!(pn == 1 && bj == 1)) ss += sumsq4(v0) + sumsq4(v1);
                    *(u32x4*)(CQ + (size_t)row * 512 + pn * 256 + bj * HALF + wc * 32 + 8 * fq) = pack8(v0, v1);
                    if (pn == 1 && bj == 1 && wc == 0) {
                        const f32x4 c = *(const f32x4*)(rope + (size_t)row * 32 + 4 * fq), s = *(const f32x4*)(rope + (size_t)row * 32 + 16 + 4 * fq);
                        const f32x4 o0 = v0 * c - v1 * s, o1 = v0 * s + v1 * c;
                        *(u32x4*)(KR + (size_t)row * 32 + 8 * fq) = pack8(o0, o1);
                        float q2 = sumsq4(o0) + sumsq4(o1); q2 = xsum32(xsum16(q2)); krmax = fmaxf(krmax, q2); } }
                ss = xsum32(xsum16(ss));
                if (fq == 0) cqstat[(size_t)row * 8 + pn * 4 + wc] = ss;
            }
            if (pn == 1 && wc == 0) {
                krmax = row_max16(krmax);
                if ((fr | fq) == 0) atomicMax(kmax + 16, __float_as_uint(krmax)); }
        } else if (pn == 2) {
            EPI_FOR { const int row = EPI_ROW;
                const float r = rr[ai][m]; float ss = 0.f;
#pragma unroll
                for (int bj = 0; bj < 2; ++bj) { const f32x4 v0 = acc[ai][bj][m][0] * r, v1 = acc[ai][bj][m][1] * r; ss += sumsq4(v0) + sumsq4(v1);
                    *(u32x4*)(CKV + (size_t)row * 256 + bj * HALF + wc * 32 + 8 * fq) = pack8(v0, v1); }
                ss = xsum32(xsum16(ss));
                if (fq == 0) ckvstat[(size_t)row * 4 + wc] = ss;
            }
        } else if (pn < 7) {
            const bool isv = pn >= 5; bf16* dst = isv ? VR : U; const int t = isv ? pn - 5 : pn - 3;
            EPI_FOR { const int row = EPI_ROW;
                const float r = rr[ai][m]; float ss = 0.f;
#pragma unroll
                for (int bj = 0; bj < 2; ++bj) { f32x4 v0 = acc[ai][bj][m][0] * r, v1 = acc[ai][bj][m][1] * r;
#pragma unroll
                    for (int e = 0; e < 4; ++e) { v0[e] = gelu_tanh(v0[e]); v1[e] = gelu_tanh(v1[e]); }
                    ss += sumsq4(v0) + sumsq4(v1);
                    *(u32x4*)(dst + (size_t)row * 512 + t * 256 + bj * HALF + wc * 32 + 8 * fq) = pack8(v0, v1); }
                if (isv) { ss = xsum32(xsum16(ss)); if (fq == 0) vstat[(size_t)row * 8 + t * 4 + wc] = ss; }
            }
        } else if (pn < 9) {
            EPI_FOR { const int row = EPI_ROW;
                const float r = rr[ai][m];
#pragma unroll
                for (int bj = 0; bj < 2; ++bj) *(u32x4*)(QX + (size_t)row * 512 + (pn - 7) * 256 + bj * HALF + wc * 32 + 8 * fq) = pack8(acc[ai][bj][m][0] * r, acc[ai][bj][m][1] * r);
            }
        } else {
            const int gc0 = (pn - 9) * 256 + wc * 32 + 8 * fq;
            f32x4 bg[2][2];
#pragma unroll
            for (int bj = 0; bj < 2; ++bj) { bg[bj][0] = *(const f32x4*)(bgate + gc0 + bj * HALF); bg[bj][1] = *(const f32x4*)(bgate + gc0 + bj * HALF + 4); }
            EPI_FOR { const int row = EPI_ROW;
                const float r = rr[ai][m];
#pragma unroll
                for (int bj = 0; bj < 2; ++bj) { f32x4 v0 = acc[ai][bj][m][0] * r + bg[bj][0], v1 = acc[ai][bj][m][1] * r + bg[bj][1];
#pragma unroll
                    for (int e = 0; e < 4; ++e) { v0[e] = sigmoidf_(v0[e]); v1[e] = sigmoidf_(v1[e]); }
#ifdef DBG_CONSTGATE
                    v0 = acc[ai][bj][m][0] * r; v1 = acc[ai][bj][m][1] * r;
#endif
                    *(u32x2*)((unsigned char*)GATE + (size_t)row * 3072 + gc0 + bj * HALF) = pack8_u8(v0, v1); }
            }
        }
    }
};
struct EpiMemKV {
    bf16* KV;
    EPI_NOPRE
    __device__ __forceinline__ void operator()(const Acc& acc, const Unit& u, int wr, int wc, int fr, int fq, const Pre&) const {
        EPI_FOR { const int row = EPI_ROW;
#pragma unroll
            for (int bj = 0; bj < 2; ++bj) *(u32x4*)(KV + (size_t)u.aux * 256 * 1024 + (size_t)row * 1024 + EPI_C8(bj)) = pack8(acc[ai][bj][m][0], acc[ai][bj][m][1]);
        }
    }
};
struct EpiQ {
    const float* cqstat; const float* rope; bf16* Q;
    EPI_NOPRE
    __device__ __forceinline__ void operator()(const Acc& acc, const Unit& u, int wr, int wc, int fr, int fq, const Pre&) const {
        EPI_FOR { const int row = EPI_ROW;
            const f32x4 s0 = *(const f32x4*)(cqstat + (size_t)row * 8), s1 = *(const f32x4*)(cqstat + (size_t)row * 8 + 4);
            const float r = __builtin_amdgcn_rsqf(((s0[0] + s0[1]) + (s0[2] + s0[3]) + (s1[0] + s1[1]) + (s1[2] + s1[3])) * (1.f / QRANK) + EPS);
#pragma unroll
            for (int bj = 0; bj < 2; ++bj) { f32x4 v0 = acc[ai][bj][m][0] * r, v1 = acc[ai][bj][m][1] * r;
                if (((8 * u.pn + 4 * bj + wc) % 3) == 2) {
                    const f32x4 c = *(const f32x4*)(rope + (size_t)row * 32 + 4 * fq), s = *(const f32x4*)(rope + (size_t)row * 32 + 16 + 4 * fq);
                    const f32x4 o0 = v0 * c - v1 * s, o1 = v0 * s + v1 * c; v0 = o0; v1 = o1; }
                *(u32x4*)(Q + (size_t)row * 768 + EPI_C8(bj)) = pack8(v0, v1); }
        }
    }
};
struct EpiKV {
    const float* ckvstat; bf16* KN; bf16* V; unsigned* kmax;
    EPI_NOPRE
    __device__ __forceinline__ void operator()(const Acc& acc, const Unit& u, int wr, int wc, int fr, int fq, const Pre&) const {
        bf16* dst = u.pn < 2 ? KN : V; const int t = u.pn & 1; float hm[2] = {0.f, 0.f};
        EPI_FOR { const int row = EPI_ROW;
            const f32x4 s0 = *(const f32x4*)(ckvstat + (size_t)row * 4);
            const float r = __builtin_amdgcn_rsqf(((s0[0] + s0[1]) + (s0[2] + s0[3])) * (1.f / KVRANK) + EPS);
#pragma unroll
            for (int bj = 0; bj < 2; ++bj) { const f32x4 v0 = acc[ai][bj][m][0] * r, v1 = acc[ai][bj][m][1] * r;
                *(u32x4*)(dst + (size_t)row * 512 + t * 256 + bj * HALF + wc * 32 + 8 * fq) = pack8(v0, v1);
                float q2 = sumsq4(v0) + sumsq4(v1); q2 = xsum32(xsum16(q2)); hm[bj] = fmaxf(hm[bj], q2); }
        }
        if (u.pn < 2) {
#pragma unroll
            for (int bj = 0; bj < 2; ++bj) { float v = hm[bj];
                v = row_max16(v);
                if ((fr | fq) == 0) atomicMax(kmax + 2 * (4 * u.pn + 2 * bj + (wc >> 1)) + (wc & 1), __float_as_uint(v)); }
        }
    }
};
struct EpiBranch {
    const unsigned char* GATE; bf16* MIXB;
    static constexpr bool KEEP_ACC = true; typedef NoPre Pre; __device__ __forceinline__ Pre prefetch(const Unit&, int, int) const { return Pre{}; }
    __device__ __forceinline__ void operator()(Acc& acc, const Unit& u, int wr, int wc, int fr, int fq, const Pre&) const {
        const int n = u.aux;
#pragma unroll
        for (int ai = 0; ai < 2; ++ai) {
            u32x2 gw[4][2], gn[4][2];
#pragma unroll
            for (int m = 0; m < 4; ++m)
#pragma unroll
                for (int bj = 0; bj < 2; ++bj) { const unsigned char* gp = GATE + (size_t)EPI_ROW * 3072 + n * 1024 + EPI_C8(bj);
                    gw[m][bj] = *(const u32x2*)gp; if (n < 2) gn[m][bj] = *(const u32x2*)(gp + 1024); }
            asm volatile("" ::: "memory");
#pragma unroll
            for (int m = 0; m < 4; ++m)
#pragma unroll
                for (int bj = 0; bj < 2; ++bj) {
                    f32x4 g0, g1; unpack8_u8(gw[m][bj], g0, g1);
#pragma unroll
                    for (int e = 0; e < 4; ++e) { g0[e] = fmaxf(g0[e], 0.001953125f); g1[e] = fmaxf(g1[e], 0.001953125f); }
                    if (n < 2) { f32x4 h0, h1; unpack8_u8(gn[m][bj], h0, h1);
#pragma unroll
                        for (int e = 0; e < 4; ++e) { g0[e] *= fast_rcp(fmaxf(h0[e], 0.001953125f)); g1[e] *= fast_rcp(fmaxf(h1[e], 0.001953125f)); }
                        acc[ai][bj][m][0] *= g0; acc[ai][bj][m][1] *= g1; }
                    else *(u32x4*)(MIXB + (size_t)u.pm * 256 * 1024 + (size_t)(4 * u.pn + 2 * bj + (wc >> 1)) * 16384 + (ai * HALF + wr * 64 + m * 16 + fr) * 64 + (wc & 1) * 32 + 8 * fq) = pack8(acc[ai][bj][m][0] * g0, acc[ai][bj][m][1] * g1);
                }
        }
        if (n == 2) {
#pragma unroll
            for (int ai = 0; ai < 2; ++ai)
#pragma unroll
                for (int bj = 0; bj < 2; ++bj)
#pragma unroll
                    for (int m = 0; m < 4; ++m) { acc[ai][bj][m][0] = (f32x4){0.f, 0.f, 0.f, 0.f}; acc[ai][bj][m][1] = (f32x4){0.f, 0.f, 0.f, 0.f}; }
        }
    }
};
struct EpiResid {
    bf16* XB; float* xstat;
    EPI_NOPRE
    __device__ __forceinline__ void operator()(const Acc& acc, const Unit& u, int wr, int wc, int fr, int fq, const Pre&) const {
        u32x4 xv[2][4][2];
#pragma unroll
        for (int ai = 0; ai < 2; ++ai)
#pragma unroll
            for (int m = 0; m < 4; ++m)
#pragma unroll
                for (int bj = 0; bj < 2; ++bj) xv[ai][m][bj] = *(const u32x4*)(XB + (size_t)EPI_ROW * 1024 + EPI_C8(bj));
        asm volatile("" ::: "memory");
#pragma unroll
        for (int ai = 0; ai < 2; ++ai) {
#pragma unroll
            for (int m = 0; m < 4; ++m) { const int row = EPI_ROW; float ss = 0.f;
#pragma unroll
                for (int bj = 0; bj < 2; ++bj) { const int col = EPI_C8(bj); f32x4 x0, x1; unpack8(xv[ai][m][bj], x0, x1);
                    const f32x4 v0 = x0 + acc[ai][bj][m][0], v1 = x1 + acc[ai][bj][m][1];
                    ss += sumsq4(v0) + sumsq4(v1);
                    *(u32x4*)(XB + (size_t)row * 1024 + col) = pack8(v0, v1); }
                ss = xsum32(xsum16(ss));
                if (fq == 0) xstat[(size_t)row * 16 + u.pn * 4 + wc] = ss; }
        }
    }
};
struct EpiSwiGLU {
    const float* rs; bf16* Hh; int ldh; int from_stats;
    static constexpr bool KEEP_ACC = false; typedef RowPre Pre;
    __device__ __forceinline__ Pre prefetch(const Unit& u, int wr, int fr) const { Pre p;
#pragma unroll
        for (int ai = 0; ai < 2; ++ai)
#pragma unroll
            for (int m = 0; m < 4; ++m) p.r[ai][m] = from_stats ? 0.f : rs[EPI_ROW];
        return p; }
    __device__ __forceinline__ void operator()(const Acc& acc, const Unit& u, int wr, int wc, int fr, int fq, const Pre& pre) const {
        float rr[2][4];
        if (from_stats) { EPI_LOAD_RS(rs_, rs);
#pragma unroll
            for (int ai = 0; ai < 2; ++ai)
#pragma unroll
                for (int m = 0; m < 4; ++m) rr[ai][m] = rs_[ai][m]; }
        else {
#pragma unroll
            for (int ai = 0; ai < 2; ++ai)
#pragma unroll
                for (int m = 0; m < 4; ++m) rr[ai][m] = pre.r[ai][m]; }
        bf16* hbase = Hh + (size_t)u.pm * 256 * ldh + (size_t)(2 * u.pn + (wc >> 1)) * 16384 + (wr * 64 + fr) * 64 + (wc & 1) * 32 + 8 * fq;
        EPI_FOR { const int row = EPI_ROW;
            const float r = rr[ai][m];
            f32x4 a0 = acc[ai][0][m][0] * r, a1 = acc[ai][0][m][1] * r; const f32x4 b0 = acc[ai][1][m][0] * r, b1 = acc[ai][1][m][1] * r;
#pragma unroll
            for (int e = 0; e < 4; ++e) { a0[e] = a0[e] * sigmoidf_(a0[e]) * b0[e]; a1[e] = a1[e] * sigmoidf_(a1[e]) * b1[e]; }
            (void)row; *(u32x4*)(hbase + (ai * HALF + m * 16) * 64) = pack8(a0, a1);
        }
    }
};
struct EpiBf16 {
    bf16* C; int ldc;
    EPI_NOPRE
    __device__ __forceinline__ void operator()(const Acc& acc, const Unit& u, int wr, int wc, int fr, int fq, const Pre&) const {
        EPI_FOR { const int row = EPI_ROW;
#pragma unroll
            for (int bj = 0; bj < 2; ++bj) *(u32x4*)(C + (size_t)row * ldc + EPI_C8(bj)) = pack8(acc[ai][bj][m][0], acc[ai][bj][m][1]);
        }
    }
};
__device__ __forceinline__ void ks_reduce(const float* part, int x, int r, int k, int CC, int tid, bf16* C, int ldc, const Unit& u, int wr, int wc, int fr, int fq) {
    for (int sp = k; sp < 16; sp += CC) { const int ai = sp >> 3, bj = (sp >> 2) & 1, m = sp & 3;
        f32x4 s0 = {0.f, 0.f, 0.f, 0.f}, s1 = {0.f, 0.f, 0.f, 0.f};
        for (int kk0 = 0; kk0 < CC; kk0 += 4) {
            f32x4 v0[4], v1[4];
#pragma unroll
            for (int kk = 0; kk < 4; ++kk) { const bool ok = kk0 + kk < CC; const float* q = part + (size_t)(x + 8 * (r * CC + (ok ? kk0 + kk : 0))) * 65536 + tid * 4 + sp * 4096;
                v0[kk] = *(const f32x4*)q; v1[kk] = *(const f32x4*)(q + 2048); if (!ok) { v0[kk] = (f32x4){0.f, 0.f, 0.f, 0.f}; v1[kk] = (f32x4){0.f, 0.f, 0.f, 0.f}; } }
#pragma unroll
            for (int kk = 0; kk < 4; ++kk) { s0 += v0[kk]; s1 += v1[kk]; } }
        const int row = u.pm * BM + ai * HALF + wr * 64 + m * 16 + fr;
        *(u32x4*)(C + (size_t)row * ldc + u.pn * BM + bj * HALF + wc * 32 + 8 * fq) = pack8(s0, s1); }
}
struct EpiBf16KS {
    bf16* C; int ldc; float* part; unsigned* cnt; int c;
    EPI_NOPRE
    __device__ __forceinline__ void operator()(const Acc& acc, const Unit& u, int wr, int wc, int fr, int fq, const Pre&) const {
        if (((u.aux >> 4) & 3) != 0) {
            int tid_ = threadIdx.x; asm volatile("" : "+v"(tid_));
            const int k = (u.aux >> 8) & 255, CC = (u.aux >> 16) & 255, r = u.aux >> 24, x = c & 7;
            float* p = part + (size_t)c * 65536 + tid_ * 4;
#pragma unroll
            for (int ai = 0; ai < 2; ++ai)
#pragma unroll
                for (int bj = 0; bj < 2; ++bj)
#pragma unroll
                    for (int m = 0; m < 4; ++m)
#pragma unroll
                        for (int n = 0; n < 2; ++n) *(f32x4*)(p + (((ai * 2 + bj) * 4 + m) * 2 + n) * 2048) = acc[ai][bj][m][n];
            asm volatile("s_waitcnt vmcnt(0)" ::: "memory");
            __syncthreads();
            if (tid_ == 0) { unsigned* w = cnt + x + 8 * r; __hip_atomic_fetch_add(w, 1u, __ATOMIC_RELEASE, __HIP_MEMORY_SCOPE_AGENT);
                while (__hip_atomic_load(w, __ATOMIC_ACQUIRE, __HIP_MEMORY_SCOPE_AGENT) < (unsigned)CC) __builtin_amdgcn_s_sleep(2); }
            __syncthreads();
            ks_reduce(part, x, r, k, CC, tid_, C, ldc, u, wr, wc, fr, fq);
            return;
        }
        EPI_FOR { const int row = EPI_ROW;
#pragma unroll
            for (int bj = 0; bj < 2; ++bj) *(u32x4*)(C + (size_t)row * ldc + EPI_C8(bj)) = pack8(acc[ai][bj][m][0], acc[ai][bj][m][1]);
        }
    }
};
struct EpiF32 {
    float* C; int ldc;
    EPI_NOPRE
    __device__ __forceinline__ void operator()(const Acc& acc, const Unit& u, int wr, int wc, int fr, int fq, const Pre&) const {
        EPI_FOR { const int row = EPI_ROW;
#pragma unroll
            for (int bj = 0; bj < 2; ++bj) { float* cp = C + (size_t)row * ldc + EPI_C8(bj); *(f32x4*)cp = acc[ai][bj][m][0]; *(f32x4*)(cp + 4) = acc[ai][bj][m][1]; }
        }
    }
};
}

namespace att {
#define KSWZ(row, colB) ((row) * 256 + ((colB) ^ (((row) & 7) << 4)))
#define SBAR() __builtin_amdgcn_sched_barrier(0)
constexpr float THR = 8.f;
__device__ __forceinline__ int crow(int r, int hi) { return (r & 3) + 8 * (r >> 2) + 4 * hi; }
template <int NB> __device__ __forceinline__ int v_st(int k, int c) { const int kk = (k & ~0xC) | ((k & 4) << 1) | ((k & 8) >> 1); return ((kk >> 3) * NB + (c >> 5)) * 512 + ((kk & 7) * 32 + (c & 31)) * 2; }
__device__ __forceinline__ int v_rd_base(int lane) { return ((lane & 3) << 3) | (((lane >> 2) & 3) << 6) | (((lane >> 4) & 1) << 5) | (((lane >> 5) & 1) << 8); }
template <int OFF> __device__ __forceinline__ s16x4 tr_read(int vb) { s16x4 r; asm volatile("ds_read_b64_tr_b16 %0, %1 offset:%2" : "=&v"(r) : "v"(vb), "i"(OFF) : "memory"); return r; }

__device__ __forceinline__ void partialSM(f32x16& p0, f32x16& p1, float& m_reg, float& alpha) {
    float pmax = p0[0];
#pragma unroll
    for (int r = 1; r < 16; ++r) pmax = fmaxf(pmax, p0[r]);
#pragma unroll
    for (int r = 0; r < 16; ++r) pmax = fmaxf(pmax, p1[r]);
    { auto rr = __builtin_amdgcn_permlane32_swap(__float_as_uint(pmax), __float_as_uint(pmax), false, false); pmax = fmaxf(__uint_as_float(rr[0]), __uint_as_float(rr[1])); }
    float mn;
    if (__builtin_expect(__all(pmax - m_reg <= THR), 1)) { mn = m_reg; alpha = 1.f; }
    else { mn = fmaxf(m_reg, pmax); alpha = __builtin_amdgcn_exp2f(m_reg - mn); m_reg = mn; }
#pragma unroll
    for (int r = 0; r < 16; ++r) { p0[r] -= mn; p1[r] -= mn; }
#pragma unroll
    for (int r = 0; r < 16; ++r) p0[r] = __builtin_amdgcn_exp2f(p0[r]);
}
__device__ __forceinline__ void finishSM(f32x16& p0, f32x16& p1, float alpha, float& l_reg, bf16x8& pa0, bf16x8& pa1, bf16x8& pa2, bf16x8& pa3) {
#pragma unroll
    for (int r = 0; r < 16; ++r) p1[r] = __builtin_amdgcn_exp2f(p1[r]);
    float ps = 0;
#pragma unroll
    for (int r = 0; r < 16; ++r) ps += p0[r];
#pragma unroll
    for (int r = 0; r < 16; ++r) ps += p1[r];
    { auto rr = __builtin_amdgcn_permlane32_swap(__float_as_uint(ps), __float_as_uint(ps), false, false); ps = __uint_as_float(rr[0]) + __uint_as_float(rr[1]); }
    l_reg = l_reg * alpha + ps;
#define PK4(P, BASE, OUT) do { unsigned a0 = cvt_pk_bf16(P[BASE + 0], P[BASE + 1]), a1 = cvt_pk_bf16(P[BASE + 2], P[BASE + 3]);   \
    unsigned b0 = cvt_pk_bf16(P[BASE + 4], P[BASE + 5]), b1 = cvt_pk_bf16(P[BASE + 6], P[BASE + 7]);                              \
    auto r0 = __builtin_amdgcn_permlane32_swap(a0, b0, false, false); auto r1 = __builtin_amdgcn_permlane32_swap(a1, b1, false, false); \
    u32x4 w = {r0[0], r1[0], r0[1], r1[1]}; OUT = __builtin_bit_cast(bf16x8, w); } while (0)
    PK4(p0, 0, pa0); PK4(p0, 8, pa1); PK4(p1, 0, pa2); PK4(p1, 8, pa3);
#undef PK4
}
template <int ND0> __device__ __forceinline__ void qkt(f32x16& p0, f32x16& p1, const LAS char* Ks, const bf16x8* qr, int r32, int hi, const f32x16& init) {
#pragma unroll
    for (int d0 = 0; d0 < ND0; ++d0) { const int cb = (d0 * 16 + hi * 8) * 2;
        const bf16x8 b0 = *(const LAS bf16x8*)(Ks + KSWZ(r32, cb));
        const bf16x8 b1 = *(const LAS bf16x8*)(Ks + KSWZ(32 + r32, cb));
        p0 = __builtin_amdgcn_mfma_f32_32x32x16_bf16(b0, qr[d0], d0 == 0 ? init : p0, 0, 0, 0);
        p1 = __builtin_amdgcn_mfma_f32_32x32x16_bf16(b1, qr[d0], d0 == 0 ? init : p1, 0, 0, 0); }
}
__device__ __forceinline__ void expA(f32x16& p0) {
#pragma unroll
    for (int r = 0; r < 16; ++r) p0[r] = __builtin_amdgcn_exp2f(p0[r]);
}
template <int NB, int D0> __device__ __forceinline__ void pv_one(f32x16& od, int vb, bf16x8 pa0, bf16x8 pa1, bf16x8 pa2, bf16x8 pa3) {
    const s16x4 l0 = tr_read<(0 * NB + D0) * 512>(vb), h0 = tr_read<(1 * NB + D0) * 512>(vb), l1 = tr_read<(2 * NB + D0) * 512>(vb), h1 = tr_read<(3 * NB + D0) * 512>(vb);
    const s16x4 l2 = tr_read<(4 * NB + D0) * 512>(vb), h2 = tr_read<(5 * NB + D0) * 512>(vb), l3 = tr_read<(6 * NB + D0) * 512>(vb), h3 = tr_read<(7 * NB + D0) * 512>(vb);
    asm volatile("s_waitcnt lgkmcnt(0)" ::: "memory"); SBAR();
#define PK(L, H) (bf16x8){L[0], L[1], L[2], L[3], H[0], H[1], H[2], H[3]}
    od = __builtin_amdgcn_mfma_f32_32x32x16_bf16(pa0, PK(l0, h0), od, 0, 0, 0);
    od = __builtin_amdgcn_mfma_f32_32x32x16_bf16(pa1, PK(l1, h1), od, 0, 0, 0);
    od = __builtin_amdgcn_mfma_f32_32x32x16_bf16(pa2, PK(l2, h2), od, 0, 0, 0);
    od = __builtin_amdgcn_mfma_f32_32x32x16_bf16(pa3, PK(l3, h3), od, 0, 0, 0);
#undef PK
}
template <int NB> __device__ __forceinline__ void pv_all(f32x16* o, int vb, bf16x8 pa0, bf16x8 pa1, bf16x8 pa2, bf16x8 pa3) {
    pv_one<NB, 0>(o[0], vb, pa0, pa1, pa2, pa3); pv_one<NB, 1>(o[1], vb, pa0, pa1, pa2, pa3);
    if constexpr (NB == 4) { pv_one<NB, 2>(o[2], vb, pa0, pa1, pa2, pa3); pv_one<NB, 3>(o[3], vb, pa0, pa1, pa2, pa3); }
}

template <int DQK, int D1, int DVV, bool FIXM>
__device__ __forceinline__ void attn_unit(const bf16* __restrict__ Qb, int ldq, const bf16* __restrict__ K1, int ldk1, const bf16* __restrict__ K2, int ldk2,
                                          const bf16* __restrict__ Vh, int ldv, bf16* __restrict__ Ob, int ldo, int seq, LAS char* lds, float kbound) {
    constexpr int ND0 = DQK / 16, NB = DVV / 32, CK = DQK / 8, CV = DVV / 8;
    constexpr int NKL = (64 * CK + 511) / 512, NVL = (64 * CV) / 512;
    constexpr int SHM_V = 64 * DVV * 2, SHM_K = 64 * 256;
    int tid_ = threadIdx.x; asm volatile("" : "+v"(tid_));
    const int tid = tid_, wid = tid >> 6, lane = tid & 63, r32 = lane & 31, hi = lane >> 5;
    LAS char* V_lds = lds; LAS char* K_lds = lds + 2 * SHM_V;
    LAS float* ws = (LAS float*)(lds + 2 * SHM_V + 2 * SHM_K) + wid * 64; LAS float* li_l = ws; LAS float* al_l = ws + 32;
    float m_reg = -1e30f, l_reg = 0; f32x16 o[NB]; bf16x8 qr[ND0];
#pragma unroll
    for (int d = 0; d < NB; ++d) o[d] = f32x16{};
    const bf16* Qw = Qb + (long)(wid * 32 + r32) * ldq + hi * 8;
#pragma unroll
    for (int d0 = 0; d0 < ND0; ++d0) qr[d0] = *(const bf16x8*)(Qw + d0 * 16);
    f32x16 init = f32x16{};
    if constexpr (FIXM) {
        float q2 = 0.f;
#pragma unroll
        for (int d0 = 0; d0 < ND0; ++d0) { const u32x4 w = __builtin_bit_cast(u32x4, qr[d0]); f32x4 a, b; unpack8(w, a, b); q2 += sumsq4(a) + sumsq4(b); }
        { auto rr = __builtin_amdgcn_permlane32_swap(__float_as_uint(q2), __float_as_uint(q2), false, false); q2 = __uint_as_float(rr[0]) + __uint_as_float(rr[1]); }
        const float nm = -sqrtf(q2) * kbound;
#pragma unroll
        for (int r = 0; r < 16; ++r) init[r] = nm;
        asm volatile("" : "+v"(init));
    }
    const bf16* kp[NKL]; int kstr[NKL], kdst[NKL]; bool kval[NKL];
#pragma unroll
    for (int i = 0; i < NKL; ++i) { const int c = tid + 512 * i; kval[i] = c < 64 * CK; const int cc_ = kval[i] ? c : 0; const int row = cc_ / CK, cc = cc_ % CK;
        if (cc * 8 < D1) { kp[i] = K1 + (long)row * ldk1 + cc * 8; kstr[i] = 64 * ldk1; } else { kp[i] = K2 + (long)row * ldk2 + (cc * 8 - D1); kstr[i] = 64 * ldk2; }
        kdst[i] = KSWZ(row, cc * 16); }
    const bf16* vp[NVL]; int vdst[NVL]; const int vstr = 64 * ldv;
#pragma unroll
    for (int i = 0; i < NVL; ++i) { const int c = tid + 512 * i; const int row = c / CV, cc = c % CV; vp[i] = Vh + (long)row * ldv + cc * 8; vdst[i] = v_st<NB>(row, cc * 8); }
    const int vb0 = (int)(uintptr_t)V_lds + v_rd_base(lane);
    struct { bf16x8 ks[NKL]; bf16x8 vs[NVL]; } sr_[2];
#define SLOAD(i, t) do { _Pragma("unroll") for (int q_ = 0; q_ < NVL; ++q_) sr_[i].vs[q_] = *(const bf16x8*)(vp[q_] + (long)(t) * vstr); \
    _Pragma("unroll") for (int q_ = 0; q_ < NKL; ++q_) { if (kval[q_]) sr_[i].ks[q_] = *(const bf16x8*)(kp[q_] + (long)(t) * kstr[q_]); } } while (0)
#define SWRITE(b, i) do { _Pragma("unroll") for (int q_ = 0; q_ < NVL; ++q_) *(LAS bf16x8*)(V_lds + (b) * SHM_V + vdst[q_]) = sr_[i].vs[q_]; \
    _Pragma("unroll") for (int q_ = 0; q_ < NKL; ++q_) { if (kval[q_]) *(LAS bf16x8*)(K_lds + (b) * SHM_K + kdst[q_]) = sr_[i].ks[q_]; } } while (0)
#define SWAIT() asm volatile("s_waitcnt vmcnt(%0)" :: "n"(NKL + NVL) : "memory")
#define RESC(a) do { if (__any((a) < 1.f)) { if (hi == 0) al_l[r32] = (a); asm volatile("s_waitcnt lgkmcnt(0)" ::: "memory"); \
    _Pragma("unroll") for (int d = 0; d < NB; ++d) _Pragma("unroll") for (int r = 0; r < 16; ++r) o[d][r] *= al_l[crow(r, hi)]; } } while (0)
    f32x16 pA0, pA1, pB0, pB1; float alA = 1.f, alB = 1.f; bf16x8 pa0, pa1, pa2, pa3; const int NT = seq / 64;
#define PSM(P0, P1, AL) do { if constexpr (FIXM) expA(P0); else partialSM(P0, P1, m_reg, AL); } while (0)
#define RSC(AL) do { if constexpr (!FIXM) RESC(AL); } while (0)
    SLOAD(0, 0); asm volatile("s_waitcnt vmcnt(0)" ::: "memory"); SWRITE(0, 0); __syncthreads();
    qkt<ND0>(pA0, pA1, K_lds, qr, r32, hi, init); PSM(pA0, pA1, alA);
    SLOAD(1, 1); if (2 < NT) SLOAD(0, 2);
    SWAIT(); SWRITE(1, 1); __syncthreads();
    for (int j = 1; j + 1 < NT; j += 2) {
        SBAR(); qkt<ND0>(pB0, pB1, K_lds + SHM_K, qr, r32, hi, init);
        finishSM(pA0, pA1, alA, l_reg, pa0, pa1, pa2, pa3); SBAR();
        SLOAD(1, j + 2); SBAR();
        pv_all<NB>(o, vb0, pa0, pa1, pa2, pa3); PSM(pB0, pB1, alB);
        __syncthreads(); SWAIT(); SWRITE(0, 0);
        RSC(alB); __syncthreads();
        SBAR(); qkt<ND0>(pA0, pA1, K_lds, qr, r32, hi, init);
        finishSM(pB0, pB1, alB, l_reg, pa0, pa1, pa2, pa3); SBAR();
        if (j + 3 < NT) SLOAD(0, j + 3); SBAR();
        pv_all<NB>(o, vb0 + SHM_V, pa0, pa1, pa2, pa3); PSM(pA0, pA1, alA);
        __syncthreads(); SWAIT(); SWRITE(1, 1);
        RSC(alA); __syncthreads();
    }
    SBAR(); qkt<ND0>(pB0, pB1, K_lds + SHM_K, qr, r32, hi, init);
    finishSM(pA0, pA1, alA, l_reg, pa0, pa1, pa2, pa3); SBAR();
    pv_all<NB>(o, vb0, pa0, pa1, pa2, pa3); PSM(pB0, pB1, alB);
    __syncthreads(); RSC(alB);
    finishSM(pB0, pB1, alB, l_reg, pa0, pa1, pa2, pa3); SBAR();
    pv_all<NB>(o, vb0 + SHM_V, pa0, pa1, pa2, pa3);
#undef PSM
#undef RSC
    if (hi == 0) li_l[r32] = l_reg; asm volatile("s_waitcnt lgkmcnt(0)" ::: "memory");
    float rli[16];
#pragma unroll
    for (int r = 0; r < 16; ++r) rli[r] = __builtin_amdgcn_rcpf(li_l[crow(r, hi)]);
    bf16* Ow = Ob + (long)(wid * 32) * ldo;
#pragma unroll
    for (int r = 0; r < 16; ++r) { const int orow = crow(r, hi);
#pragma unroll
        for (int d0 = 0; d0 < NB; ++d0) Ow[(long)orow * ldo + d0 * 32 + r32] = f2bf(o[d0][r] * rli[r]); }
    __syncthreads();
#undef SLOAD
#undef SWRITE
#undef SWAIT
#undef RESC
}

#define EXP4(P, B) do { P[B] = __builtin_amdgcn_exp2f(P[B]); P[B + 1] = __builtin_amdgcn_exp2f(P[B + 1]); P[B + 2] = __builtin_amdgcn_exp2f(P[B + 2]); P[B + 3] = __builtin_amdgcn_exp2f(P[B + 3]); } while (0)
#define SUM4(S, P, B) do { S += (P[B] + P[B + 1]) + (P[B + 2] + P[B + 3]); } while (0)
#define PK4X(P, BASE, OUT) do { const u32x4 w_ = {cvt_pk_bf16(P[BASE + 0], P[BASE + 1]), cvt_pk_bf16(P[BASE + 2], P[BASE + 3]), cvt_pk_bf16(P[BASE + 4], P[BASE + 5]), cvt_pk_bf16(P[BASE + 6], P[BASE + 7])}; OUT = __builtin_bit_cast(bf16x8, w_); } while (0)
typedef short v4i16_t __attribute__((ext_vector_type(4)));
__device__ __forceinline__ s16x4 vtr(const LAS char* p) { return __builtin_bit_cast(s16x4, __builtin_amdgcn_ds_read_tr16_b64_v4i16((LAS v4i16_t*)p)); }
#define KSWZ2(row, colB) ((row) * 256 + ((colB) ^ (((row) & 15) << 4)))
template <int DQK, int D1, int DVV>
__device__ __forceinline__ void attn_unit2(const bf16* __restrict__ Qb, int ldq, const bf16* __restrict__ K1, int ldk1, const bf16* __restrict__ K2, int ldk2,
                                           const bf16* __restrict__ Vh, int ldv, bf16* __restrict__ Ob, int ldo, int seq, LAS char* lds, float kbound) {
    constexpr int ND0 = DQK / 16, NB = DVV / 32, CK = DQK / 8;
    constexpr int SHM_V = 64 * DVV * 2, SHM_K = 64 * 256;
    static_assert(NB == 2 && ND0 == 6, "written for QK dim 96 / V dim 64");
    int tid_ = threadIdx.x; asm volatile("" : "+v"(tid_));
    const int tid = tid_, wid = __builtin_amdgcn_readfirstlane(tid >> 6), lane = tid & 63, r32 = lane & 31, hi = lane >> 5;
    LAS char* V_lds = lds; LAS char* K_lds = lds + 3 * SHM_V;
    LAS float* ws = (LAS float*)(lds + 3 * SHM_V + 2 * SHM_K) + wid * 64;
    LAS char* QAL = lds + 3 * SHM_V + 2 * SHM_K + 2048 + wid * (2 * ND0 * 1024) + lane * 16; LAS char* QBL = QAL + ND0 * 1024;
    float nm;
    { bf16x8 qa[ND0], qb[ND0];
      const bf16* QwA = Qb + (long)(wid * 64 + r32) * ldq + hi * 8; const bf16* QwB = QwA + (long)32 * ldq;
#pragma unroll
      for (int d0 = 0; d0 < ND0; ++d0) { qa[d0] = *(const bf16x8*)(QwA + d0 * 16); qb[d0] = *(const bf16x8*)(QwB + d0 * 16); }
      float q2a = 0.f, q2b = 0.f;
#pragma unroll
      for (int d0 = 0; d0 < ND0; ++d0) { f32x4 a, b; unpack8(__builtin_bit_cast(u32x4, qa[d0]), a, b); q2a += sumsq4(a) + sumsq4(b); unpack8(__builtin_bit_cast(u32x4, qb[d0]), a, b); q2b += sumsq4(a) + sumsq4(b);
          *(LAS bf16x8*)(QAL + d0 * 1024) = qa[d0]; *(LAS bf16x8*)(QBL + d0 * 1024) = qb[d0]; }
      { auto rr = __builtin_amdgcn_permlane32_swap(__float_as_uint(q2a), __float_as_uint(q2a), false, false); q2a = __uint_as_float(rr[0]) + __uint_as_float(rr[1]); }
      { auto rr = __builtin_amdgcn_permlane32_swap(__float_as_uint(q2b), __float_as_uint(q2b), false, false); q2b = __uint_as_float(rr[0]) + __uint_as_float(rr[1]); }
      nm = -sqrtf(fmaxf(q2a, q2b)) * kbound; }
    const bf16* kp[2]; int kstr[2];
#pragma unroll
    for (int i = 0; i < 2; ++i) { const int row = 8 * wid + 4 * i + (lane >> 4), cc = (lane & 15) ^ (row & 15);
        if (cc >= 8 && cc < CK) { kp[i] = K2 + (long)row * ldk2 + (cc * 8 - D1); kstr[i] = 64 * ldk2; } else { kp[i] = K1 + (long)row * ldk1 + (cc < 8 ? cc * 8 : 0); kstr[i] = 64 * ldk1; } }
    const bf16* vp; { const int k = 8 * wid + ((lane & 31) >> 2); vp = Vh + (long)k * ldv + (lane >> 5) * 32 + (lane & 3) * 8; }
    const int vstr = 64 * ldv;
    const LAS char* vrd0 = V_lds + v_rd_base(lane);
#define DMA2(t, kb, vbuf) do { \
    __builtin_amdgcn_global_load_lds((const unsigned*)(kp[0] + (long)(t) * kstr[0]), (LAS unsigned*)(K_lds + (kb) * SHM_K + wid * 2048), 16, 0, 0); \
    __builtin_amdgcn_global_load_lds((const unsigned*)(kp[1] + (long)(t) * kstr[1]), (LAS unsigned*)(K_lds + (kb) * SHM_K + wid * 2048 + 1024), 16, 0, 0); \
    __builtin_amdgcn_global_load_lds((const unsigned*)(vp + (long)(t) * vstr), (LAS unsigned*)(V_lds + (vbuf) * SHM_V + wid * 1024), 16, 0, 0); } while (0)
#define VRD8(arr, base, D0) do { _Pragma("unroll") for (int j_ = 0; j_ < 8; ++j_) arr[j_] = vtr((base) + (j_ * NB + (D0)) * 512); } while (0)
#define PKV(arr, ks) (bf16x8){arr[2 * (ks)][0], arr[2 * (ks)][1], arr[2 * (ks)][2], arr[2 * (ks)][3], arr[2 * (ks) + 1][0], arr[2 * (ks) + 1][1], arr[2 * (ks) + 1][2], arr[2 * (ks) + 1][3]}
    f32x16 oA[2], oB[2]; oA[0] = f32x16{}; oA[1] = f32x16{}; oB[0] = f32x16{}; oB[1] = f32x16{};
    float lA = 0.f, lB = 0.f; const int NT = seq / 64;
    f32x16 a0, a1, c0, c1; bf16x8 pa0, pa1, pa2, pa3;
#define HALF1(Kb) do { \
        f32x16 init; { float nmv = nm; asm volatile("" : "+v"(nmv)); _Pragma("unroll") for (int r = 0; r < 16; ++r) init[r] = nmv; } \
        SBAR(); __builtin_amdgcn_s_setprio(1); \
        _Pragma("unroll") for (int d0 = 0; d0 < ND0; ++d0) { const int cb = (d0 * 16 + hi * 8) * 2; \
            const bf16x8 k0 = *(const LAS bf16x8*)((Kb) + KSWZ2(r32, cb)), k1 = *(const LAS bf16x8*)((Kb) + KSWZ2(32 + r32, cb)), qv = *(const LAS bf16x8*)(QAL + d0 * 1024); \
            a0 = __builtin_amdgcn_mfma_f32_32x32x16_bf16(k0, qv, d0 == 0 ? init : a0, 0, 0, 0); \
            a1 = __builtin_amdgcn_mfma_f32_32x32x16_bf16(k1, qv, d0 == 0 ? init : a1, 0, 0, 0); } \
        __builtin_amdgcn_s_setprio(0); SBAR(); \
        float sA = 0.f; \
        _Pragma("unroll") for (int d0 = 0; d0 < ND0; ++d0) { const int cb = (d0 * 16 + hi * 8) * 2; \
            const bf16x8 k0 = *(const LAS bf16x8*)((Kb) + KSWZ2(r32, cb)), k1 = *(const LAS bf16x8*)((Kb) + KSWZ2(32 + r32, cb)), qv = *(const LAS bf16x8*)(QBL + d0 * 1024); \
            c0 = __builtin_amdgcn_mfma_f32_32x32x16_bf16(k0, qv, d0 == 0 ? init : c0, 0, 0, 0); \
            if (d0 == 0) { EXP4(a0, 0); } \
            if (d0 == 1) { EXP4(a0, 8); SUM4(sA, a0, 0); } \
            if (d0 == 2) { EXP4(a1, 0); SUM4(sA, a0, 8); } \
            if (d0 == 3) { EXP4(a1, 8); SUM4(sA, a1, 0); } \
            if (d0 == 4) { SUM4(sA, a1, 8); } \
            c1 = __builtin_amdgcn_mfma_f32_32x32x16_bf16(k1, qv, d0 == 0 ? init : c1, 0, 0, 0); \
            if (d0 == 0) { EXP4(a0, 4); } \
            if (d0 == 1) { EXP4(a0, 12); SUM4(sA, a0, 4); } \
            if (d0 == 2) { EXP4(a1, 4); SUM4(sA, a0, 12); } \
            if (d0 == 3) { EXP4(a1, 12); SUM4(sA, a1, 4); } \
            if (d0 == 4) { SUM4(sA, a1, 12); } \
            SBAR(); } \
        lA += sA; \
        PK4X(a0, 0, pa0); PK4X(a0, 8, pa1); PK4X(a1, 0, pa2); PK4X(a1, 8, pa3); \
        SBAR(); } while (0)
#define HALF2(vbase) do { \
        float sB = 0.f; s16x4 va[8], vb_[8]; \
        VRD8(va, vbase, 0); VRD8(vb_, vbase, 1); \
        oA[0] = __builtin_amdgcn_mfma_f32_32x32x16_bf16(pa0, PKV(va, 0), oA[0], 0, 0, 0); SBAR(); \
        oA[1] = __builtin_amdgcn_mfma_f32_32x32x16_bf16(pa0, PKV(vb_, 0), oA[1], 0, 0, 0); EXP4(c0, 0); EXP4(c0, 4); SBAR(); \
        oA[0] = __builtin_amdgcn_mfma_f32_32x32x16_bf16(pa1, PKV(va, 1), oA[0], 0, 0, 0); EXP4(c0, 8); EXP4(c0, 12); SUM4(sB, c0, 0); SBAR(); \
        oA[1] = __builtin_amdgcn_mfma_f32_32x32x16_bf16(pa1, PKV(vb_, 1), oA[1], 0, 0, 0); EXP4(c1, 0); SUM4(sB, c0, 4); SUM4(sB, c0, 8); SBAR(); \
        oA[0] = __builtin_amdgcn_mfma_f32_32x32x16_bf16(pa2, PKV(va, 2), oA[0], 0, 0, 0); EXP4(c1, 4); SUM4(sB, c0, 12); SBAR(); \
        oA[1] = __builtin_amdgcn_mfma_f32_32x32x16_bf16(pa2, PKV(vb_, 2), oA[1], 0, 0, 0); EXP4(c1, 8); SUM4(sB, c1, 0); SBAR(); \
        oA[0] = __builtin_amdgcn_mfma_f32_32x32x16_bf16(pa3, PKV(va, 3), oA[0], 0, 0, 0); EXP4(c1, 12); SUM4(sB, c1, 4); SBAR(); \
        oA[1] = __builtin_amdgcn_mfma_f32_32x32x16_bf16(pa3, PKV(vb_, 3), oA[1], 0, 0, 0); SUM4(sB, c1, 8); SUM4(sB, c1, 12); SBAR(); \
        lB += sB; \
        PK4X(c0, 0, pa0); PK4X(c0, 8, pa1); PK4X(c1, 0, pa2); PK4X(c1, 8, pa3); \
        SBAR(); \
        __builtin_amdgcn_s_setprio(1); VRD8(va, vbase, 0); VRD8(vb_, vbase, 1);                       \
        oB[0] = __builtin_amdgcn_mfma_f32_32x32x16_bf16(pa0, PKV(va, 0), oB[0], 0, 0, 0); \
        oB[1] = __builtin_amdgcn_mfma_f32_32x32x16_bf16(pa0, PKV(vb_, 0), oB[1], 0, 0, 0); \
        oB[0] = __builtin_amdgcn_mfma_f32_32x32x16_bf16(pa1, PKV(va, 1), oB[0], 0, 0, 0); \
        oB[1] = __builtin_amdgcn_mfma_f32_32x32x16_bf16(pa1, PKV(vb_, 1), oB[1], 0, 0, 0); \
        oB[0] = __builtin_amdgcn_mfma_f32_32x32x16_bf16(pa2, PKV(va, 2), oB[0], 0, 0, 0); \
        oB[1] = __builtin_amdgcn_mfma_f32_32x32x16_bf16(pa2, PKV(vb_, 2), oB[1], 0, 0, 0); \
        oB[0] = __builtin_amdgcn_mfma_f32_32x32x16_bf16(pa3, PKV(va, 3), oB[0], 0, 0, 0); \
        oB[1] = __builtin_amdgcn_mfma_f32_32x32x16_bf16(pa3, PKV(vb_, 3), oB[1], 0, 0, 0); \
        __builtin_amdgcn_s_setprio(0); SBAR(); } while (0)
#define TILE_BAR() do { asm volatile("s_waitcnt vmcnt(0)" ::: "memory"); __syncthreads(); } while (0)
    DMA2(0, 0, 0);
    if (wid < 4) {
        int vs = 0;
#pragma unroll 1
        for (int t = 0; t < NT; ++t) { TILE_BAR();
            const int vn = vs == 2 ? 0 : vs + 1; if (t + 1 < NT) DMA2(t + 1, (t + 1) & 1, vn);
            HALF1(K_lds + (t & 1) * SHM_K); HALF2(vrd0 + vs * SHM_V); vs = vn; }
        TILE_BAR();
    } else {
        TILE_BAR(); if (1 < NT) DMA2(1, 1, 1);
        HALF1(K_lds);
        int vs = 0;
#pragma unroll 1
        for (int t = 1; t < NT; ++t) { TILE_BAR();
            const int vn = vs == 2 ? 0 : vs + 1; const int vnn = vn == 2 ? 0 : vn + 1; if (t + 1 < NT) DMA2(t + 1, (t + 1) & 1, vnn);
            HALF2(vrd0 + vs * SHM_V); HALF1(K_lds + (t & 1) * SHM_K); vs = vn; }
        TILE_BAR();
        HALF2(vrd0 + vs * SHM_V);
        __builtin_amdgcn_s_setprio(0);
    }
#undef HALF1
#undef HALF2
#undef TILE_BAR
    { auto rr = __builtin_amdgcn_permlane32_swap(__float_as_uint(lA), __float_as_uint(lA), false, false); lA = __uint_as_float(rr[0]) + __uint_as_float(rr[1]); }
    { auto rr = __builtin_amdgcn_permlane32_swap(__float_as_uint(lB), __float_as_uint(lB), false, false); lB = __uint_as_float(rr[0]) + __uint_as_float(rr[1]); }
    if (hi == 0) { ws[r32] = lA; ws[32 + r32] = lB; } asm volatile("s_waitcnt lgkmcnt(0)" ::: "memory");
    bf16* Ow = Ob + (long)(wid * 64) * ldo;
#pragma unroll
    for (int r = 0; r < 16; ++r) { const int orow = crow(r, hi); const float ra = __builtin_amdgcn_rcpf(ws[orow]), rb = __builtin_amdgcn_rcpf(ws[32 + orow]);
#pragma unroll
        for (int d0 = 0; d0 < NB; ++d0) { Ow[(long)orow * ldo + d0 * 32 + r32] = f2bf(oA[d0][r] * ra); Ow[(long)(32 + orow) * ldo + d0 * 32 + r32] = f2bf(oB[d0][r] * rb); } }
    __syncthreads();
#undef DMA2
#undef VRD8
#undef PKV
}
#undef EXP4
#undef SUM4
#undef PK4X

__device__ __forceinline__ void spatial_unit(int chunk, int g, const bf16* __restrict__ U, const bf16* __restrict__ VR, const float* __restrict__ vstat, const float* __restrict__ g_sg,
                                             const bf16* __restrict__ Wsb, const float* __restrict__ b_s, bf16* __restrict__ Y, LAS char* lds) {
    int tid_ = threadIdx.x; asm volatile("" : "+v"(tid_));
    const int tid = tid_, wid = tid >> 6, lane = tid & 63, r32 = lane & 31, hi = lane >> 5, rb = wid & 3, ch = wid >> 2;
    LAS char* V_lds = lds; LAS float* rv = (LAS float*)(lds + 32768);
    const int row0 = chunk * 128;
    f32x4 s0 = {0.f, 0.f, 0.f, 0.f}, s1 = {0.f, 0.f, 0.f, 0.f};
    if (tid < 128) { s0 = *(const f32x4*)(vstat + (size_t)(row0 + tid) * 8); s1 = *(const f32x4*)(vstat + (size_t)(row0 + tid) * 8 + 4); }
    u32x4 wv[4];
#pragma unroll
    for (int i = 0; i < 4; ++i) { const int c = tid + 512 * i, row = c >> 4, cc = c & 15; wv[i] = *(const u32x4*)(VR + (size_t)(row0 + row) * 512 + g * 128 + cc * 8); }
    const f32x4 g0 = *(const f32x4*)(g_sg + g * 128 + (tid & 15) * 8), g1 = *(const f32x4*)(g_sg + g * 128 + (tid & 15) * 8 + 4);
    bf16x8 pa[8];
#pragma unroll
    for (int ks = 0; ks < 8; ++ks) pa[ks] = *(const bf16x8*)(Wsb + (size_t)g * 16384 + (size_t)(32 * rb + r32) * 128 + 16 * ks + 8 * hi);
    bf16 ur[16][2]; float bias[16];
#pragma unroll
    for (int r = 0; r < 16; ++r) { const int i = 32 * rb + crow(r, hi); bias[r] = b_s[g * 128 + i];
#pragma unroll
        for (int dd = 0; dd < 2; ++dd) ur[r][dd] = U[(size_t)(row0 + i) * 512 + g * 128 + 64 * ch + 32 * dd + r32]; }
    if (tid < 128) rv[tid] = __builtin_amdgcn_rsqf(((s0[0] + s0[1]) + (s0[2] + s0[3]) + (s1[0] + s1[1]) + (s1[2] + s1[3])) * (1.f / 512.f) + EPS);
    __syncthreads();
#pragma unroll
    for (int i = 0; i < 4; ++i) { const int c = tid + 512 * i, row = c >> 4, cc = c & 15; f32x4 a, b; unpack8(wv[i], a, b); const float r = rv[row];
        *(LAS u32x4*)(V_lds + (row >> 6) * 16384 + v_st<4>(row & 63, cc * 8)) = pack8(a * r * g0, b * r * g1); }
    __syncthreads();
    f32x16 o[2]; o[0] = f32x16{}; o[1] = f32x16{};
    const int vb = (int)(uintptr_t)V_lds + v_rd_base(lane) + (2 * ch) * 512;
    pv_one<4, 0>(o[0], vb, pa[0], pa[1], pa[2], pa[3]); pv_one<4, 1>(o[1], vb, pa[0], pa[1], pa[2], pa[3]);
    pv_one<4, 0>(o[0], vb + 16384, pa[4], pa[5], pa[6], pa[7]); pv_one<4, 1>(o[1], vb + 16384, pa[4], pa[5], pa[6], pa[7]);
#pragma unroll
    for (int r = 0; r < 16; ++r) { const int i = 32 * rb + crow(r, hi); const size_t row = (size_t)(row0 + i);
#pragma unroll
        for (int dd = 0; dd < 2; ++dd) { const int c = g * 128 + 64 * ch + 32 * dd + r32; const float uu = bf2f(ur[r][dd]);
            Y[row * 1536 + 512 + c] = f2bf(uu * (o[dd][r] + bias[r])); } }
    __syncthreads();
}
#undef KSWZ
#undef SBAR
}

#define XB_TMO      128
#define XB_XCNT(j)  (256  + 64 * (j))
#define XB_XSUB(j)  (1280 + 64 * (j))
#define XB_XGEN(j)  (2304 + 64 * (j))
#define XB_TOP      3328
#define XB_TOPGEN   3392
#define XCD_BAR_WORDS 3456
#define XB_SPIN_CAP (1u << 18)
__device__ __forceinline__ unsigned xb_ld(unsigned* p)              { return __hip_atomic_load((GAS unsigned*)p, __ATOMIC_RELAXED, __HIP_MEMORY_SCOPE_AGENT); }
__device__ __forceinline__ unsigned xb_add(unsigned* p, unsigned v) { return __hip_atomic_fetch_add((GAS unsigned*)p, v, __ATOMIC_RELAXED, __HIP_MEMORY_SCOPE_AGENT); }
__device__ __forceinline__ unsigned xb_xcc_id() { return (unsigned)__builtin_amdgcn_s_getreg((3 << 11) | 20) & 0xFu; }
#define XB_SPIN(cond, bar) do { unsigned _sp = 0; while (cond) { __builtin_amdgcn_s_sleep(1); \
    if ((++_sp & 255u) == 0u) { if (xb_ld(&(bar)[XB_TMO])) break; if (_sp > XB_SPIN_CAP) { xb_add(&(bar)[XB_TMO], 1u); break; } } } } while (0)
struct XcdBarrier { unsigned* bar; unsigned x; volatile LAS unsigned* st; };
__device__ __forceinline__ XcdBarrier xcd_barrier_post(unsigned* bar, volatile LAS unsigned* st) {
    XcdBarrier b; b.bar = bar; b.x = (unsigned)__builtin_amdgcn_readfirstlane((int)xb_xcc_id()); b.st = st;
    if (threadIdx.x == 0) (void)xb_add(&bar[XB_XCNT(b.x)], 1u);
    return b;
}
__device__ __forceinline__ void xcd_barrier_complete(unsigned* bar, unsigned x, unsigned& nloc, unsigned& nx) {
    const unsigned G = gridDim.x * gridDim.y * gridDim.z;
    unsigned sum, cnt, mine, sp = 0u;
    for (;;) {
        sum = 0u; cnt = 0u; mine = 0u;
#pragma unroll
        for (unsigned j = 0; j < 16; ++j) { const unsigned c = xb_ld(&bar[XB_XCNT(j)]); sum += c; cnt += (c > 0u) ? 1u : 0u; mine = (j == x) ? c : mine; }
        if (sum == G) break;
        __builtin_amdgcn_s_sleep(1);
        if ((++sp & 255u) == 0u) { if (xb_ld(&bar[XB_TMO])) break; if (sp > XB_SPIN_CAP) { xb_add(&bar[XB_TMO], 1u); break; } }
    }
    nloc = mine > 0u ? mine : 1u; nx = cnt > 0u ? cnt : 1u;
}
__device__ __forceinline__ void xcd_barrier(const XcdBarrier& b) {
    asm volatile("s_waitcnt vmcnt(0)" ::: "memory");
    __syncthreads();
    if (threadIdx.x == 0) {
        unsigned* bar = b.bar; unsigned bx = b.x; asm volatile("" : "+s"(bar), "+s"(bx));
        __builtin_amdgcn_s_waitcnt(0);
        unsigned nloc = b.st[0], nx = b.st[1];
        if (nloc == 0u) { xcd_barrier_complete(bar, bx, nloc, nx); b.st[0] = nloc; b.st[1] = nx; }
        const unsigned old = xb_add(&bar[XB_XSUB(bx)], 1u);
        const unsigned gen = old / nloc;
        if (old + 1u == (gen + 1u) * nloc) {
            __builtin_amdgcn_fence(__ATOMIC_RELEASE, "agent");
            asm volatile("s_waitcnt vmcnt(0)" ::: "memory");
            const unsigned og = xb_add(&bar[XB_TOP], 1u);
            const unsigned tg = og / nx;
            if (og + 1u == (tg + 1u) * nx) xb_add(&bar[XB_TOPGEN], 1u);
            else XB_SPIN(xb_ld(&bar[XB_TOPGEN]) == tg, bar);
            __builtin_amdgcn_fence(__ATOMIC_ACQUIRE, "agent");
            xb_add(&bar[XB_XGEN(bx)], 1u);
            asm volatile("s_waitcnt vmcnt(0)" ::: "memory");
        } else {
            XB_SPIN(xb_ld(&bar[XB_XGEN(bx)]) == gen, bar);
            __builtin_amdgcn_fence(__ATOMIC_ACQUIRE, "agent");
            asm volatile("s_waitcnt vmcnt(0)" ::: "memory");
        }
    }
    __syncthreads();
}

enum { CV_NAT = 0, CV_WIN = 1, CV_WUQ = 2, CV_W13 = 3 };
__device__ __forceinline__ int ropeperm(int p) { return ((p >> 2) & 1) * 16 + 4 * (p >> 3) + (p & 3); }
__device__ __forceinline__ int cv_map(int kind, int G, int& which, float& scale, bool& perm) {
    which = 0; scale = 1.f; perm = false; const int n = G * 32;
    if (kind == CV_WIN) {
        if (n < 384) return n;
        if (n < 416) { perm = true; return 640; }
        if (n < 512) return -1;
        if (n < 768) return 384 + (n - 512);
        if (n < 1280) return 672 + (n - 768);
        if (n < 1792) return 1184 + (n - 1280);
        if (n < 2304) { scale = XSCALE; return 1696 + (n - 1792); }
        return 2208 + (n - 2304);
    }
    if (kind == CV_WUQ) { scale = QSCALE; perm = (G % 3) == 2; return n; }
    if (kind == CV_W13) { which = (n >> 7) & 1; return 128 * (n >> 8) + (n & 127); }
    return n;
}
struct CvDesc { const float* src; const float* src2; const float* gain; bf16* dst; int K, Nsrc, Nout, kind; };
__device__ __forceinline__ void cv_item(const CvDesc& d, int item, LAS char* tile, int lane) {
    const int nI = d.Nout >> 7, kb = item / nI, nb = item - kb * nI, k0 = 64 * kb, n0 = 128 * nb;
    const int nq = lane & 31, kh = lane >> 5;
    const int nout = n0 + 4 * nq, G = nout >> 5, p = nout & 31;
    int which; float scale; bool perm; const int sc = cv_map(d.kind, G, which, scale, perm);
    const bool zero = sc < 0;
    const float* W = d.src + (ptrdiff_t)which * (d.src2 - d.src) + (size_t)k0 * d.Nsrc + (zero ? 0 : sc + (perm ? ropeperm(p) : p));
#pragma unroll
    for (int half = 0; half < 2; ++half) {
        f32x4 v[16];
#pragma unroll
        for (int i = 0; i < 16; ++i) { const int k = 32 * half + 2 * i + kh; v[i] = zero ? (f32x4){0.f, 0.f, 0.f, 0.f} : *(const f32x4*)(W + (size_t)k * d.Nsrc); }
#pragma unroll
        for (int i = 0; i < 16; ++i) { const int k = 32 * half + 2 * i + kh; const float g = d.gain ? d.gain[k0 + k] * scale : scale; const f32x4 w = v[i] * g;
            *(LAS u32x2*)(tile + att::v_st<4>(k, 4 * nq)) = (u32x2){cvt_pk_bf16(w[0], w[1]), cvt_pk_bf16(w[2], w[3])}; }
    }
    LDS_WAIT(); asm volatile("" ::: "memory");
    const int vb = (int)(uintptr_t)tile + att::v_rd_base(lane);
    bf16* drow = d.dst + (size_t)(n0 >> 8) * 256 * d.K + (size_t)kb * (256 * 64) + (size_t)((n0 & 255) + nq) * 64 + 8 * kh;
#define CV_RD(D0, KS) { const s16x4 l_ = att::tr_read<((2 * KS) * 4 + D0) * 512>(vb), h_ = att::tr_read<((2 * KS + 1) * 4 + D0) * 512>(vb); \
        asm volatile("s_waitcnt lgkmcnt(0)" ::: "memory"); __builtin_amdgcn_sched_barrier(0); \
        *(bf16x8*)(drow + (32 * D0) * 64 + 16 * KS) = (bf16x8){l_[0], l_[1], l_[2], l_[3], h_[0], h_[1], h_[2], h_[3]}; }
#define CV_RD4(D0) CV_RD(D0, 0) CV_RD(D0, 1) CV_RD(D0, 2) CV_RD(D0, 3)
    CV_RD4(0) CV_RD4(1) CV_RD4(2) CV_RD4(3)
#undef CV_RD4
#undef CV_RD
    LDS_WAIT(); asm volatile("" ::: "memory");
}

struct Args {
    const float* x; const float* mem; const int* positions; const float* g_mix; const float* w_in; const float* g_q; const float* g_kv; const float* w_uq; const float* w_uk; const float* w_uv;
    const float* g_sg; const float* w_s; const float* b_s; const float* g_mem; const float* w_mkv; const float* w_br; const float* b_gate; const float* w_out; const float* g_ffn;
    const float* dense_w1; const float* dense_w3; const float* dense_w2; const float* w_router; const float* moe_w1; const float* moe_w3; const float* moe_w2; const float* g_final;
    float* out; unsigned char* ws; int dbg; int pad;
};
typedef const __attribute__((address_space(4))) Args* ArgsP;
#define FRESH(ap) ArgsP ap = kargs; asm volatile("" : "+s"(ap))
__constant__ double INVF[16] = { 1.0, 0.5623413251903491, 0.31622776601683794, 0.1778279410038923, 0.1, 0.05623413251903491, 0.03162277660168379, 0.01778279410038923,
                                 0.01, 0.005623413251903491, 0.003162277660168379, 0.001778279410038923, 0.001, 0.0005623413251903491, 0.00031622776601683794, 0.0001778279410038923 };

struct Frame { LAS unsigned char* lds; int G, NGW, bid; };
#define LOCAL_IDS int tid = threadIdx.x; asm volatile("" : "+v"(tid)); const int lane = tid & 63, wave = __builtin_amdgcn_readfirstlane(tid >> 6), gw = F.bid * NWAVES + wave; (void)lane; (void)gw

__device__ __forceinline__ void conv_run(const Frame& F, const CvDesc& d) {
    LOCAL_IDS;
    LAS char* tile = (LAS char*)(F.lds + wave * 16384);
    const int nitems = (d.K / 64) * (d.Nout / 128);
    for (int it = gw; it < nitems; it += F.NGW) cv_item(d, it, tile, lane);
}
__device__ __forceinline__ void rx_from_stats(const Frame& F, ArgsP kargs) {
    LOCAL_IDS; FRESH(ap); const float* xstat = (const float*)(ap->ws + WS_XSTAT); float* rx = (float*)(ap->ws + WS_RX);
    for (int row = F.bid * 512 + tid; row < M; row += F.G * 512) {
        const f32x4* p = (const f32x4*)(xstat + (size_t)row * 16); const f32x4 a = p[0], b = p[1], c = p[2], d = p[3];
        const float s = ((a[0] + a[1]) + (a[2] + a[3])) + ((b[0] + b[1]) + (b[2] + b[3])) + ((c[0] + c[1]) + (c[2] + c[3])) + ((d[0] + d[1]) + (d[2] + d[3]));
        rx[row] = __builtin_amdgcn_rsqf(s * (1.f / D) + EPS);
    }
}
template <int MODE>
__device__ __forceinline__ void conv_flat(const Frame& F, ArgsP kargs, int l, int j2, int lmix) {
    int tid_ = threadIdx.x; asm volatile("" : "+v"(tid_)); const int lane_ = tid_ & 63, wave_ = __builtin_amdgcn_readfirstlane(tid_ >> 6);
    LAS char* tile = (LAS char*)(F.lds + wave_ * 16384);
    constexpr int I13D = (D / 64) * (2 * DFF / 128), I2D = (DFF / 64) * (D / 128), I13 = (D / 64) * (2 * DFE / 128), I2 = (DFE / 64) * (D / 128), IE = I13 + I2, IMKV = (D / 64) * (D / 128);
    constexpr int NB_ = MODE == 0 ? DEPTH * IMKV : MODE == 1 ? I13D + I2D : MODE == 2 ? NE * IE : 0;
    constexpr int M_IN = (D / 64) * (PPAD / 128), M_UQ = (QRANK / 64) * (768 / 128), M_UK = (KVRANK / 64) * (512 / 128), M_BR = (BW / 64) * (D / 128), M_OUT = (D / 64) * (D / 128);
    constexpr int O_UQ = M_IN, O_UK = O_UQ + M_UQ, O_UV = O_UK + M_UK, O_BR = O_UV + M_UK, O_OUT = O_BR + 3 * M_BR, NMIX = O_OUT + M_OUT;
    const int total = NB_ + ((lmix >= 0 && lmix < DEPTH) ? NMIX : 0);
#pragma unroll 1
    for (int idx = wave_ * F.G + F.bid; idx < total; idx += F.NGW) { FRESH(a); CvDesc d; int it;
        if (idx < NB_) {
            if constexpr (MODE == 0) { const int lq = idx / IMKV; it = idx - lq * IMKV; d = CvDesc{a->w_mkv + (size_t)lq * D * D, nullptr, nullptr, (bf16*)(a->ws + WS_WMKVT) + (size_t)lq * D * D, D, D, D, CV_NAT}; }
            else if constexpr (MODE == 1) {
                if (idx < I13D) { it = idx; d = CvDesc{a->dense_w1 + (size_t)j2 * D * DFF, a->dense_w3 + (size_t)j2 * D * DFF, a->g_ffn + l * D, (bf16*)(a->ws + WS_WFFN), D, DFF, 2 * DFF, CV_W13}; }
                else { it = idx - I13D; d = CvDesc{a->dense_w2 + (size_t)j2 * DFF * D, nullptr, nullptr, (bf16*)(a->ws + WS_W2D), DFF, D, D, CV_NAT}; } }
            else { const int e = idx / IE, r = idx - e * IE;
                if (r < I13) { it = r; d = CvDesc{a->moe_w1 + ((size_t)j2 * NE + e) * D * DFE, a->moe_w3 + ((size_t)j2 * NE + e) * D * DFE, a->g_ffn + l * D, (bf16*)(a->ws + WS_WFFN) + (size_t)e * 2 * DFE * D, D, DFE, 2 * DFE, CV_W13}; }
                else { it = r - I13; d = CvDesc{a->moe_w2 + ((size_t)j2 * NE + e) * DFE * D, nullptr, nullptr, (bf16*)(a->ws + WS_W2M) + (size_t)e * D * DFE, DFE, D, D, CV_NAT}; } }
        } else { const int r = idx - NB_;
            if (r < O_UQ) { it = r; d = CvDesc{a->w_in + (size_t)lmix * D * PTOT, nullptr, a->g_mix + lmix * D, (bf16*)(a->ws + WS_WINT), D, PTOT, PPAD, CV_WIN}; }
            else if (r < O_UK) { it = r - O_UQ; d = CvDesc{a->w_uq + (size_t)lmix * QRANK * 768, nullptr, a->g_q + lmix * QRANK, (bf16*)(a->ws + WS_WUQT), QRANK, 768, 768, CV_WUQ}; }
            else if (r < O_UV) { it = r - O_UK; d = CvDesc{a->w_uk + (size_t)lmix * KVRANK * 512, nullptr, a->g_kv + lmix * KVRANK, (bf16*)(a->ws + WS_WUKVT), KVRANK, 512, 512, CV_NAT}; }
            else if (r < O_BR) { it = r - O_UV; d = CvDesc{a->w_uv + (size_t)lmix * KVRANK * 512, nullptr, a->g_kv + lmix * KVRANK, (bf16*)(a->ws + WS_WUKVT) + 512 * KVRANK, KVRANK, 512, 512, CV_NAT}; }
            else if (r < O_OUT) { const int n = (r - O_BR) / M_BR; it = (r - O_BR) - n * M_BR; d = CvDesc{a->w_br + ((size_t)lmix * 3 + n) * BW * D, nullptr, nullptr, (bf16*)(a->ws + WS_WBRT) + (size_t)n * D * BW, BW, D, D, CV_NAT}; }
            else { it = r - O_OUT; d = CvDesc{a->w_out + (size_t)lmix * D * D, nullptr, nullptr, (bf16*)(a->ws + WS_WOUTT), D, D, D, CV_NAT}; } }
        cv_item(d, it, tile, lane_); }
    if (lmix >= 0 && lmix < DEPTH) {
        FRESH(a); const float* wsrc = a->w_s + (size_t)lmix * 65536; bf16* wdst = (bf16*)(a->ws + WS_WSB);
        for (int i = F.bid * 512 + tid_; i < 4 * 128 * 128 / 4; i += F.G * 512) { const f32x4 v = *(const f32x4*)(wsrc + (size_t)i * 4);
            *(u32x2*)(wdst + (size_t)i * 4) = (u32x2){cvt_pk_bf16(v[0], v[1]), cvt_pk_bf16(v[2], v[3])}; } }
}
__device__ __forceinline__ void phase_prologue(const Frame& F, ArgsP kargs) {
    LOCAL_IDS;
    { FRESH(a); float* ROPE = (float*)(a->ws + WS_ROPE); const int* pos = a->positions;
      for (int idx = F.bid * 512 + tid; idx < M * 16; idx += F.G * 512) { const int row = idx >> 4, i = idx & 15;
        const double t = (double)pos[row] * INVF[i] * 0.15915494309189535; const float fr = (float)(t - rint(t));
        ROPE[(size_t)row * 32 + i] = __builtin_amdgcn_cosf(fr); ROPE[(size_t)row * 32 + 16 + i] = __builtin_amdgcn_sinf(fr); } }
    { FRESH(a); const float* xin = a->x; bf16* XB = (bf16*)(a->ws + WS_XB); float* RX = (float*)(a->ws + WS_RX);
      f32x4 vn[4];
#pragma unroll
      for (int j = 0; j < 4; ++j) vn[j] = ((const f32x4*)(xin + (size_t)gw * D) + lane)[64 * j];
#pragma unroll 1
      for (int m = gw; m < M; m += F.NGW) { f32x4 v[4]; float s = 0.f; const int mn = m + F.NGW < M ? m + F.NGW : m;
#pragma unroll
        for (int j = 0; j < 4; ++j) { v[j] = vn[j]; s += sumsq4(v[j]); }
#pragma unroll
        for (int j = 0; j < 4; ++j) vn[j] = ((const f32x4*)(xin + (size_t)mn * D) + lane)[64 * j];
        s = wave_sum(s);
#pragma unroll
        for (int j = 0; j < 4; ++j) ((u32x2*)(XB + (size_t)m * D) + lane)[64 * j] = (u32x2){cvt_pk_bf16(v[j][0], v[j][1]), cvt_pk_bf16(v[j][2], v[j][3])};
        if (lane == 0) RX[m] = __builtin_amdgcn_rsqf(s * (1.f / D) + EPS); } }
    { FRESH(a); const float* mem = a->mem; const float* g_mem = a->g_mem; bf16* MEMB = (bf16*)(a->ws + WS_MEMB);
      for (int m = gw; m < NMEM; m += F.NGW) { const f32x4* xr = (const f32x4*)(mem + (size_t)m * D) + lane; f32x4 v[4]; float s = 0.f;
#pragma unroll
        for (int j = 0; j < 4; ++j) { v[j] = xr[64 * j]; s += sumsq4(v[j]); }
        const float r = __builtin_amdgcn_rsqf(wave_sum(s) * (1.f / D) + EPS);
#pragma unroll
        for (int j = 0; j < 4; ++j) { const f32x4 g = ((const f32x4*)g_mem + lane)[64 * j]; const f32x4 w = v[j] * r * g;
            ((u32x2*)(MEMB + (size_t)m * D) + lane)[64 * j] = (u32x2){cvt_pk_bf16(w[0], w[1]), cvt_pk_bf16(w[2], w[3])}; } } }
    conv_flat<0>(F, kargs, 0, 0, 0);
}
__device__ __forceinline__ void phase_inproj(const Frame& F, ArgsP kargs, int l) {
    if (PH(1)) { FRESH(a); unsigned char* ws = a->ws;
        pg8::TileOrder S{M / 256, PPAD / 256 - 1, F.G, F.bid, (const char*)(ws + WS_XB), (const char*)(ws + WS_WINT), (size_t)256 * D * 2, (size_t)256 * D * 2};
#ifdef DBG_REV
        S.rev = 1;
#endif
        LAS float* rtab = (LAS float*)(F.lds + RING_BYTES + 1024);
        if (l & 1) { int tid_ = threadIdx.x; asm volatile("" : "+v"(tid_)); const float* xstat = (const float*)(ws + WS_XSTAT); f32x4 st[6][4]; bool ok[6];
#pragma unroll
            for (int i = 0; i < 6; ++i) { pg8::Unit u; ok[i] = S.next(i, u) && tid_ < 256; const f32x4* p4 = (const f32x4*)(xstat + (size_t)(ok[i] ? u.pm * 256 + tid_ : 0) * 16);
#pragma unroll
                for (int q = 0; q < 4; ++q) st[i][q] = p4[q]; }
#pragma unroll
            for (int i = 0; i < 6; ++i) if (ok[i]) { float t_ = 0.f;
#pragma unroll
                for (int q = 0; q < 4; ++q) t_ += (st[i][q][0] + st[i][q][1]) + (st[i][q][2] + st[i][q][3]);
                rtab[i * 256 + tid_] = __builtin_amdgcn_rsqf(t_ * (1.f / D) + EPS); }
            __syncthreads(); }
        pg8::EpiInProj E{ws, a->b_gate + (size_t)l * 3 * D, l, (l & 1), rtab};
        pg8::gemm_phase(F.lds, D, D, D, S, E); }
    if (l == 0 && PH(2)) { FRESH(a); unsigned char* ws = a->ws;
        struct MemOrder { enum { VARK = 0, GATHER = 0 }; int c; const char* A; const char* B;
            __device__ __forceinline__ bool next(int i, pg8::Unit& u) const { if (i > 0 || c < 240) return false; const int idx = c - 240; u.pm = 0; u.pn = idx & 3; u.aux = idx >> 2; u.A = A; u.B = B + (size_t)u.aux * D * D * 2 + (size_t)u.pn * 256 * D * 2; return true; } };
        MemOrder S2{F.bid, (const char*)(ws + WS_MEMB), (const char*)(ws + WS_WMKVT)}; pg8::EpiMemKV E2{(bf16*)(ws + WS_KVMEM)};
        pg8::gemm_phase(F.lds, D, D, D, S2, E2); }
}
struct GateTailOrder { enum { VARK = 0, GATHER = 0 }; int c; const char* A; const char* B;
    __device__ __forceinline__ bool next(int i, pg8::Unit& u) const { if (i > 0 || c < 192) return false; u.pm = c - 192; u.pn = PPAD / 256 - 1; u.aux = 0; u.A = A + (size_t)u.pm * 256 * D * 2; u.B = B + (size_t)u.pn * 256 * D * 2; return true; } };
__device__ __forceinline__ void phase_up(const Frame& F, ArgsP kargs, int l) {
    if (PH(1)) { FRESH(a); unsigned char* ws = a->ws;
        GateTailOrder S{F.bid, (const char*)(ws + WS_XB), (const char*)(ws + WS_WINT)}; LAS float* rtab = (LAS float*)(F.lds + RING_BYTES + 1024);
        if (l & 1) { int tid_ = threadIdx.x; asm volatile("" : "+v"(tid_)); pg8::Unit u;
            if (S.next(0, u) && tid_ < 256) { const f32x4* p4 = (const f32x4*)((const float*)(ws + WS_XSTAT) + (size_t)(u.pm * 256 + tid_) * 16); float t_ = 0.f;
#pragma unroll
                for (int q = 0; q < 4; ++q) { const f32x4 v = p4[q]; t_ += (v[0] + v[1]) + (v[2] + v[3]); }
                rtab[tid_] = __builtin_amdgcn_rsqf(t_ * (1.f / D) + EPS); }
            __syncthreads(); }
        pg8::EpiInProj E{ws, a->b_gate + (size_t)l * 3 * D, l, (l & 1), rtab};
        pg8::gemm_phase(F.lds, D, D, D, S, E); }
    if (PH(3)) { FRESH(a); unsigned char* ws = a->ws;
        pg8::TileOrder S{M / 256, 3, F.G, F.bid, (const char*)(ws + WS_CQ), (const char*)(ws + WS_WUQT), (size_t)256 * 512 * 2, (size_t)256 * QRANK * 2};
        pg8::EpiQ E{(const float*)(ws + WS_CQSTAT), (const float*)(ws + WS_ROPE), (bf16*)(ws + WS_Q)}; pg8::gemm_phase(F.lds, 512, QRANK, QRANK, S, E); }
    if (PH(4)) { FRESH(a); unsigned char* ws = a->ws;
        pg8::TileOrder S{M / 256, 4, F.G, F.bid, (const char*)(ws + WS_CKV), (const char*)(ws + WS_WUKVT), (size_t)256 * KVRANK * 2, (size_t)256 * KVRANK * 2};
        pg8::EpiKV E{(const float*)(ws + WS_CKVSTAT), (bf16*)(ws + WS_KN), (bf16*)(ws + WS_V), (unsigned*)(ws + WS_CTL) + CW_KMAX + l * 32}; pg8::gemm_phase(F.lds, KVRANK, KVRANK, KVRANK, S, E); }
    if (PH(5)) { FRESH(a); unsigned char* ws = a->ws;
        for (int un = F.bid; un < 512; un += F.G)
            att::spatial_unit(un >> 2, un & 3, (const bf16*)(ws + WS_U), (const bf16*)(ws + WS_VR), (const float*)(ws + WS_VSTAT), a->g_sg + l * BW, (const bf16*)(ws + WS_WSB), a->b_s + l * 512, (bf16*)(ws + WS_Y), (LAS char*)F.lds); }
    if (PH(6)) { FRESH(a); unsigned char* ws = a->ws;
        for (int un = F.bid; un < 256; un += F.G) { const int h = un & 3, pm = un >> 2; const bf16* kvm = (const bf16*)(ws + WS_KVMEM) + (size_t)l * 256 * 1024;
            att::attn_unit<128, 128, 128, false>((const bf16*)(ws + WS_QX) + (size_t)pm * 256 * 512 + h * 128, 512, kvm + h * 128, 1024, kvm, 1024, kvm + 512 + h * 128, 1024,
                                          (bf16*)(ws + WS_Y) + (size_t)pm * 256 * 1536 + 1024 + h * 128, 1536, NMEM, (LAS char*)F.lds, 0.f); } }
}
__device__ __forceinline__ void phase_attn(const Frame& F, ArgsP kargs, int l) {
    if (PH(7)) { FRESH(a); unsigned char* ws = a->ws;
        for (int un = F.bid; un < 256; un += F.G) { const int h = un & 7, qb = un >> 3;
            const unsigned* km = (const unsigned*)(ws + WS_CTL) + CW_KMAX + l * 32;
            const float kbound = sqrtf(__uint_as_float(km[2 * h]) + __uint_as_float(km[2 * h + 1]) + __uint_as_float(km[16])) * 1.02f;
            att::attn_unit2<96, 64, 64>((const bf16*)(ws + WS_Q) + (size_t)qb * 512 * 768 + h * 96, 768, (const bf16*)(ws + WS_KN) + h * 64, 512, (const bf16*)(ws + WS_KR), 32, (const bf16*)(ws + WS_V) + h * 64, 512,
                                        (bf16*)(ws + WS_Y) + (size_t)qb * 512 * 1536 + h * 64, 1536, M, (LAS char*)F.lds, kbound); } }
}
__device__ __forceinline__ void phase_branch(const Frame& F, ArgsP kargs) {
    if (PH(8)) { FRESH(a); unsigned char* ws = a->ws;
        struct BranchOrder { enum { VARK = 0, GATHER = 0 }; int c; const char* A; const char* B;
            __device__ __forceinline__ bool next(int i, pg8::Unit& u) const { if (i >= 3 || c >= 256) return false; int pm, pn; pg8::tile_of(c, 64, 4, pm, pn); u.pm = pm; u.pn = pn; u.aux = i;
                u.A = A + (size_t)pm * 256 * 1536 * 2 + (size_t)i * 512 * 2; u.B = B + (size_t)i * D * BW * 2 + (size_t)pn * 256 * BW * 2; return true; } };
        BranchOrder S{F.bid, (const char*)(ws + WS_Y), (const char*)(ws + WS_WBRT)}; pg8::EpiBranch E{(const unsigned char*)(ws + WS_GATE), (bf16*)(ws + WS_MIXB)};
        pg8::gemm_phase(F.lds, 1536, BW, BW, S, E); }
}
__device__ __forceinline__ void phase_outproj(const Frame& F, ArgsP kargs, bool dummy = false) {
    if (PH(9)) { FRESH(a); unsigned char* ws = a->ws;
        pg8::TileOrder S{M / 256, 4, F.G, F.bid, (const char*)(ws + WS_MIXB), (const char*)(ws + WS_WOUTT), (size_t)256 * D * 2, (size_t)256 * D * 2};
        (void)dummy; pg8::EpiResid E{(bf16*)(ws + WS_XB), (float*)(ws + WS_XSTAT)}; pg8::gemm_phase(F.lds, 0, D, D, S, E); }
}
__device__ __forceinline__ void phase_dense_conv(const Frame& F, ArgsP kargs, int l, int j2) {
    rx_from_stats(F, kargs);
    conv_flat<1>(F, kargs, l, j2, -1);
}
__device__ __forceinline__ void phase_dense_up(const Frame& F, ArgsP kargs, int l) {
    if (PH(10)) { FRESH(a); unsigned char* ws = a->ws;
        pg8::TileOrder S{M / 256, 2 * DFF / 256, F.G, F.bid, (const char*)(ws + WS_XB), (const char*)(ws + WS_WFFN), (size_t)256 * D * 2, (size_t)256 * D * 2};
        pg8::EpiSwiGLU E{(const float*)(ws + WS_RX), (bf16*)(ws + WS_HFF), DFF, 0}; pg8::gemm_phase(F.lds, D, D, D, S, E); }
    { const int rem = ((M / 256) * (2 * DFF / 256)) % F.G; Frame F2 = F; if (rem != 0) { F2.G = F.G - rem; F2.bid = F.bid - rem; F2.NGW = F2.G * NWAVES; }
      if (rem == 0 || F.bid >= rem) { __syncthreads(); conv_flat<3>(F2, kargs, l, 0, l + 1); } }
}
__device__ __forceinline__ void phase_dense_down(const Frame& F, ArgsP kargs, bool dummy = false) {
    if (PH(11)) { FRESH(a); unsigned char* ws = a->ws;
        pg8::TileOrder S{M / 256, 4, F.G, F.bid, (const char*)(ws + WS_HFF), (const char*)(ws + WS_W2D), (size_t)256 * DFF * 2, (size_t)256 * DFF * 2};
        (void)dummy; pg8::EpiResid E{(bf16*)(ws + WS_XB), (float*)(ws + WS_XSTAT)}; pg8::gemm_phase(F.lds, 0, DFF, DFF, S, E); }
}
__device__ __forceinline__ void phase_moe_route(const Frame& F, ArgsP kargs, int l, int j2) {
    conv_flat<2>(F, kargs, l, j2, l + 1 < DEPTH ? l + 1 : -1);
    __syncthreads();
    LOCAL_IDS; FRESH(a); unsigned char* ws = a->ws; const bf16* X = (const bf16*)(ws + WS_XB);
    float* RX = (float*)(ws + WS_RX); int* TOPI = (int*)(ws + WS_TOPI); float* TOPW = (float*)(ws + WS_TOPW); int* LRANK = (int*)(ws + WS_LRANK); int* BLKCNT = (int*)(ws + WS_BLKCNT);
    LAS int* tope = (LAS int*)(F.lds + 0);
    const float* wr = a->w_router + (size_t)j2 * D * NE; const float* gf = a->g_ffn + l * D;
    f32x4 gvA[4], wA[4][4][2]; u32x2 xn[4];
#pragma unroll
    for (int j = 0; j < 4; ++j) { const int k0 = 4 * lane + 256 * j; gvA[j] = *(const f32x4*)(gf + k0);
#pragma unroll
        for (int q = 0; q < 4; ++q) { wA[j][q][0] = *(const f32x4*)(wr + (size_t)(k0 + q) * 8); wA[j][q][1] = *(const f32x4*)(wr + (size_t)(k0 + q) * 8 + 4); } }
#pragma unroll
    for (int j = 0; j < 4; ++j) xn[j] = *(const u32x2*)(X + (size_t)(F.bid * 64 + wave * 8) * D + 4 * lane + 256 * j);
#pragma unroll 1
    for (int i = 0; i < 8; ++i) { const int rib = wave * 8 + i, row = F.bid * 64 + rib;
        float lg[8]; float ss = 0.f; f32x4 xc[4];
#pragma unroll
        for (int e = 0; e < 8; ++e) lg[e] = 0.f;
#pragma unroll
        for (int j = 0; j < 4; ++j) xc[j] = (f32x4){bflo(xn[j].x), bfhi(xn[j].x), bflo(xn[j].y), bfhi(xn[j].y)};
        if (i + 1 < 8) {
#pragma unroll
            for (int j = 0; j < 4; ++j) xn[j] = *(const u32x2*)(X + (size_t)(row + 1) * D + 4 * lane + 256 * j); }
#pragma unroll
        for (int j = 0; j < 4; ++j) { const f32x4 xv = xc[j], gv = gvA[j]; ss += sumsq4(xv);
#pragma unroll
            for (int q = 0; q < 4; ++q) { const float hv = xv[q] * gv[q]; const f32x4 w0 = wA[j][q][0], w1 = wA[j][q][1];
                lg[0] += hv * w0[0]; lg[1] += hv * w0[1]; lg[2] += hv * w0[2]; lg[3] += hv * w0[3]; lg[4] += hv * w1[0]; lg[5] += hv * w1[1]; lg[6] += hv * w1[2]; lg[7] += hv * w1[3]; } }
        const float r = __builtin_amdgcn_rsqf(wave_sum(ss) * (1.f / D) + EPS);
#pragma unroll
        for (int e = 0; e < 8; ++e) lg[e] = wave_sum(lg[e]) * r;
        int e0 = 0; float v0 = lg[0];
#pragma unroll
        for (int e = 1; e < 8; ++e) if (lg[e] > v0) { v0 = lg[e]; e0 = e; }
        int e1 = e0 == 0 ? 1 : 0; float v1 = -3.0e38f;
#pragma unroll
        for (int e = 0; e < 8; ++e) if (e != e0 && lg[e] > v1) { v1 = lg[e]; e1 = e; }
        const float w0 = 1.f / (1.f + expf(v1 - v0));
        if (lane == 0) { RX[row] = r; TOPI[row] = e0 | (e1 << 8); TOPW[(size_t)row * 2] = w0; TOPW[(size_t)row * 2 + 1] = 1.f - w0; tope[rib] = e0 | (e1 << 8); } }
    __syncthreads();
    if (wave == 0) { const int te = tope[lane], e0 = te & 255, e1 = te >> 8, row = F.bid * 64 + lane; const unsigned long long below = (1ull << lane) - 1ull;
        int rk0 = 0, rk1 = 0;
#pragma unroll
        for (int e = 0; e < 8; ++e) { const unsigned long long m0 = __ballot(e0 == e), m1 = __ballot(e1 == e); const int c0 = __popcll(m0);
            if (e0 == e) rk0 = __popcll(m0 & below); if (e1 == e) rk1 = c0 + __popcll(m1 & below);
            if (lane == 0) BLKCNT[F.bid * 8 + e] = c0 + __popcll(m1); }
        LRANK[(size_t)row * 2] = rk0; LRANK[(size_t)row * 2 + 1] = rk1; }
    __syncthreads();
}
__device__ __forceinline__ void moe_tiles(const Frame& F, ArgsP kargs, int (&tb)[NE + 1], LAS int* pre) {
    LOCAL_IDS; FRESH(a); const int* BLKCNT = (const int*)(a->ws + WS_BLKCNT);
    __syncthreads();
    if (tid < 16) pre[tid] = 0;
    __syncthreads();
    if (tid < 256) { const i32x4 c0 = *(const i32x4*)(BLKCNT + tid * 8), c1 = *(const i32x4*)(BLKCNT + tid * 8 + 4); const int cc[8] = {c0[0], c0[1], c0[2], c0[3], c1[0], c1[1], c1[2], c1[3]};
#pragma unroll
        for (int e = 0; e < 8; ++e) { const int tot = (int)wave_sum((float)cc[e]); const int bel = (int)wave_sum(tid < F.bid ? (float)cc[e] : 0.f);
            if (lane == 0) { __hip_atomic_fetch_add(pre + 8 + e, tot, __ATOMIC_RELAXED, __HIP_MEMORY_SCOPE_WORKGROUP); __hip_atomic_fetch_add(pre + e, bel, __ATOMIC_RELAXED, __HIP_MEMORY_SCOPE_WORKGROUP); } } }
    __syncthreads();
    int acc_t = 0;
#pragma unroll
    for (int e = 0; e < NE; ++e) { tb[e] = acc_t; acc_t += (__builtin_amdgcn_readfirstlane(pre[8 + e]) + 255) >> 8; }
    tb[NE] = acc_t;
}
__device__ __forceinline__ void phase_moe_gather(const Frame& F, ArgsP kargs) {
    int tb[NE + 1]; LAS int* pre = (LAS int*)(F.lds + 0);
    moe_tiles(F, kargs, tb, pre);
    LOCAL_IDS; FRESH(a); unsigned char* ws = a->ws;
    const int* TOPI = (const int*)(ws + WS_TOPI); const int* LRANK = (const int*)(ws + WS_LRANK); int* POS = (int*)(ws + WS_POS); float* SLOTR = (float*)(ws + WS_SLOTR); const float* RX = (const float*)(ws + WS_RX);
    int* TOKOF = (int*)(ws + WS_TOKOF);
    if (lane < 16) { const int pi = wave * 16 + lane, rib = pi >> 1, k = pi & 1, row = F.bid * 64 + rib;
        const int te = TOPI[row], e = k ? (te >> 8) : (te & 255); const int lr = LRANK[(size_t)row * 2 + k]; const float rx = RX[row];
        int bs = 0;
#pragma unroll
        for (int q = 0; q < NE; ++q) if (q == e) bs = tb[q] * 256;
        const int slot = bs + pre[e] + lr;
        POS[(size_t)row * 2 + k] = slot; SLOTR[slot] = rx; TOKOF[slot] = row; }
    if (F.bid < NE) { const int e = F.bid; int b0 = 0, b1 = 0;
#pragma unroll
        for (int q = 0; q < NE; ++q) if (q == e) { b0 = tb[q] * 256; b1 = tb[q + 1] * 256; }
        const int cnt = __builtin_amdgcn_readfirstlane(pre[8 + e]);
        for (int s = b0 + cnt + tid; s < b1; s += NWAVES * 64) { SLOTR[s] = 0.f; TOKOF[s] = 0; } }
    __syncthreads();
}
struct MoeOrder { enum { VARK = 0, GATHER = 0 }; int nN, G, c, T; int tb[NE + 1]; const char* A; const char* B; size_t astep, estep, bstep; int rev = 0;
    __device__ __forceinline__ bool next(int i, pg8::Unit& u) const { const long L = (long)i * G + c; if (L >= (long)T * nN) return false; int pm, pn; pg8::tile_of((int)L, T, nN, pm, pn); if (rev) pm = T - 1 - pm;
        int e = 0;
#pragma unroll
        for (int q = 1; q < NE; ++q) e += (pm >= tb[q]) ? 1 : 0;
        u.pm = pm; u.pn = pn; u.aux = e; u.A = A + (size_t)pm * astep; u.B = B + (size_t)e * estep + (size_t)pn * bstep; return true; } };
struct MoeUpOrder { enum { VARK = 0, GATHER = 1 }; int nN, G, c, T; int tb[NE + 1]; const char* A; const char* B; size_t estep, bstep; const LAS int* tokL;
    __device__ __forceinline__ bool next(int i, pg8::Unit& u) const { const long L = (long)i * G + c; if (L >= (long)T * nN) return false; int pm, pn; pg8::tile_of((int)L, T, nN, pm, pn);
        int e = 0;
#pragma unroll
        for (int q = 1; q < NE; ++q) e += (pm >= tb[q]) ? 1 : 0;
        u.pm = pm; u.pn = pn; u.aux = e; u.A = A; u.B = B + (size_t)e * estep + (size_t)pn * bstep; return true; } };
struct MoeTailOrder { enum { VARK = 1, GATHER = 0 }; static constexpr int PPU = DFE / 128;
    int nN, G, c, T; int tb[NE + 1]; const char* A; const char* B; size_t astep, estep, bstep; int rev = 0;
    __device__ __forceinline__ bool next(int i, pg8::Unit& u) const {
        const int U = T * nN, R = U / G, Lf = U - R * G, x = c & 7, j = c >> 3, nj = (G - x + 7) >> 3;
        const int Lfx = Lf > x ? (Lf - x + 7) >> 3 : 0;
        long L; int k0 = 0, np = PPU, part = 0, k = 0, r = 0, C = 1;
        if (i < R) L = (long)i * G + c;
        else if (i == R && Lfx > 0) { const int cap = nj / Lfx; C = cap >= 8 ? 8 : cap >= 1 ? cap : 1;
            r = j / C; k = j - r * C; if (r >= Lfx) return false;
            L = (long)R * G + x + 8 * r; if (C > 1) { const int q = PPU / C, rem = PPU - q * C; np = q + (k < rem ? 1 : 0); k0 = k * q + (k < rem ? k : rem); part = 3; } }
        else return false;
        int pm, pn; pg8::tile_of((int)L, T, nN, pm, pn); if (rev) pm = T - 1 - pm;
        int e = 0;
#pragma unroll
        for (int q = 1; q < NE; ++q) e += (pm >= tb[q]) ? 1 : 0;
        u.pm = pm; u.pn = pn; u.aux = e | (part << 4) | (k << 8) | (C << 16) | (r << 24); u.nt = 2 * np;
        u.A = A + (size_t)pm * astep + (size_t)k0 * 65536; u.B = B + (size_t)e * estep + (size_t)pn * bstep + (size_t)k0 * 65536; return true; } };
__device__ __forceinline__ void phase_moe_up(const Frame& F, ArgsP kargs) {
    if (PH(12)) { MoeUpOrder S; LAS int* pre = (LAS int*)(F.lds + RING_BYTES + 64); moe_tiles(F, kargs, S.tb, pre);
        FRESH(a); unsigned char* ws = a->ws; S.nN = 2 * DFE / 256; S.G = F.G; S.c = F.bid; S.T = S.tb[NE];
        S.A = (const char*)(ws + WS_XB); S.B = (const char*)(ws + WS_WFFN); S.estep = (size_t)2 * DFE * D * 2; S.bstep = (size_t)256 * D * 2;
        { LAS int* tokL = (LAS int*)(F.lds + RING_BYTES + 1024); S.tokL = tokL; const int* TOKOF = (const int*)(ws + WS_TOKOF);
          int tid_ = threadIdx.x; asm volatile("" : "+v"(tid_)); const int half_ = __builtin_amdgcn_readfirstlane(tid_ >> 8); int tkv[8];
#pragma unroll
          for (int j = 0; j < 8; ++j) { pg8::Unit u; const bool ok = S.next(2 * j + half_, u); tkv[j] = ok ? TOKOF[u.pm * 256 + (tid_ & 255)] : 0; }
#pragma unroll
          for (int j = 0; j < 8; ++j) tokL[(2 * j + half_) * 256 + (tid_ & 255)] = tkv[j];
          __syncthreads(); }
        pg8::EpiSwiGLU E{(const float*)(ws + WS_SLOTR), (bf16*)(ws + WS_HG), DFE, 0}; pg8::gemm_phase(F.lds, D, D, D, S, E); }
}
__device__ __forceinline__ void phase_moe_down(const Frame& F, ArgsP kargs, int j2) {
    if (PH(13)) { MoeTailOrder S; LAS int* pre = (LAS int*)(F.lds + RING_BYTES + 64); moe_tiles(F, kargs, S.tb, pre);
        FRESH(a); unsigned char* ws = a->ws; S.nN = 4; S.G = F.G; S.c = F.bid; S.T = S.tb[NE]; S.rev = 1;
        S.A = (const char*)(ws + WS_HG); S.B = (const char*)(ws + WS_W2M); S.astep = (size_t)256 * DFE * 2; S.estep = (size_t)D * DFE * 2; S.bstep = (size_t)256 * DFE * 2;
        pg8::EpiBf16KS E{(bf16*)(ws + WS_OUTG), D, (float*)(ws + WS_SKPART), (unsigned*)(ws + WS_CTL) + CW_SK + j2 * 512, F.bid}; pg8::gemm_phase(F.lds, 0, DFE, DFE, S, E); }
}
__device__ __forceinline__ void phase_moe_combine(const Frame& F, ArgsP kargs, bool last) {
    LOCAL_IDS; FRESH(a); unsigned char* ws = a->ws; float* OUT = a->out; const bf16* OUTG = (const bf16*)(ws + WS_OUTG); const int* POS = (const int*)(ws + WS_POS); const float* TOPW = (const float*)(ws + WS_TOPW);
    bf16* XB = (bf16*)(ws + WS_XB); float* RX = (float*)(ws + WS_RX); const float* g_final = a->g_final;
    int s0n, s1n; float w0n, w1n, w0c, w1c; u32x2 pn0[4], pn1[4], xn[4];
    { const int s0 = POS[(size_t)gw * 2], s1 = POS[(size_t)gw * 2 + 1]; w0c = TOPW[(size_t)gw * 2]; w1c = TOPW[(size_t)gw * 2 + 1];
      const int m1 = gw + F.NGW < M ? gw + F.NGW : gw; s0n = POS[(size_t)m1 * 2]; s1n = POS[(size_t)m1 * 2 + 1]; w0n = TOPW[(size_t)m1 * 2]; w1n = TOPW[(size_t)m1 * 2 + 1];
#pragma unroll
      for (int j = 0; j < 4; ++j) { pn0[j] = ((const u32x2*)(OUTG + (size_t)s0 * D) + lane)[64 * j]; pn1[j] = ((const u32x2*)(OUTG + (size_t)s1 * D) + lane)[64 * j]; xn[j] = ((const u32x2*)(XB + (size_t)gw * D) + lane)[64 * j]; } }
#pragma unroll 1
    for (int m = gw; m < M; m += F.NGW) {
        const float w0 = w0c, w1 = w1c; u32x2 p0c[4], p1c[4], xc[4];
#pragma unroll
        for (int j = 0; j < 4; ++j) { p0c[j] = pn0[j]; p1c[j] = pn1[j]; xc[j] = xn[j]; }
        { const int mn = m + F.NGW < M ? m + F.NGW : m, mnn = m + 2 * F.NGW < M ? m + 2 * F.NGW : m; const int s0 = s0n, s1 = s1n; w0c = w0n; w1c = w1n;
#pragma unroll
          for (int j = 0; j < 4; ++j) { pn0[j] = ((const u32x2*)(OUTG + (size_t)s0 * D) + lane)[64 * j]; pn1[j] = ((const u32x2*)(OUTG + (size_t)s1 * D) + lane)[64 * j]; xn[j] = ((const u32x2*)(XB + (size_t)mn * D) + lane)[64 * j]; }
          s0n = POS[(size_t)mnn * 2]; s1n = POS[(size_t)mnn * 2 + 1]; w0n = TOPW[(size_t)mnn * 2]; w1n = TOPW[(size_t)mnn * 2 + 1]; }
        f32x4 v[4]; float s = 0.f;
#pragma unroll
        for (int j = 0; j < 4; ++j) { const u32x2 p0 = p0c[j], p1 = p1c[j];
            const f32x4 o0 = {bflo(p0.x), bfhi(p0.x), bflo(p0.y), bfhi(p0.y)}, o1 = {bflo(p1.x), bfhi(p1.x), bflo(p1.y), bfhi(p1.y)};
            const f32x4 xf = {bflo(xc[j].x), bfhi(xc[j].x), bflo(xc[j].y), bfhi(xc[j].y)}; v[j] = xf + w0 * o0 + w1 * o1; s += sumsq4(v[j]); }
        const float r = __builtin_amdgcn_rsqf(wave_sum(s) * (1.f / D) + EPS);
        if (last) {
#pragma unroll
            for (int j = 0; j < 4; ++j) ((f32x4*)(OUT + (size_t)m * D) + lane)[64 * j] = v[j] * r * ((const f32x4*)g_final + lane)[64 * j];
        } else {
#pragma unroll
            for (int j = 0; j < 4; ++j) ((u32x2*)(XB + (size_t)m * D) + lane)[64 * j] = (u32x2){cvt_pk_bf16(v[j][0], v[j][1]), cvt_pk_bf16(v[j][2], v[j][3])};
            if (lane == 0) RX[m] = r;
        }
    }
}


#ifdef DBG_ENABLE
__device__ __forceinline__ float dbg_b(const unsigned char* ws, size_t off, size_t idx) { return bf2f(((const bf16*)(ws + off))[idx]); }
__device__ __forceinline__ void dbg_dump(const Frame& F, ArgsP kargs, int code) {
    LOCAL_IDS; FRESH(a); const unsigned char* ws = a->ws; float* out = a->out;
    unsigned tmo = ((const unsigned*)(ws + WS_CTL))[CW_BAR + XB_TMO];
    for (size_t i = (size_t)F.bid * 512 + tid; i < (size_t)M * D; i += (size_t)F.G * 512) { const size_t row = i >> 10, c = i & 1023; float v = 0.f;
        if (code == 1) v = dbg_b(ws, WS_CQ, row * 512 + (c & 511)) + dbg_b(ws, WS_CKV, row * 256 + (c & 255)) + dbg_b(ws, WS_U, row * 512 + (c & 511)) + dbg_b(ws, WS_VR, row * 512 + (c & 511)) + dbg_b(ws, WS_QX, row * 512 + (c & 511))
                         + dbg_b(ws, WS_GATE, row * 3072 + c) + dbg_b(ws, WS_GATE, row * 3072 + 1024 + c) + dbg_b(ws, WS_GATE, row * 3072 + 2048 + c) + dbg_b(ws, WS_KR, row * 32 + (c & 31));
        else if (code == 2) v = dbg_b(ws, WS_Q, row * 768 + (c % 768)) + dbg_b(ws, WS_KN, row * 512 + (c & 511)) + dbg_b(ws, WS_V, row * 512 + (c & 511)) + dbg_b(ws, WS_Y, row * 1536 + 512 + c);
        else if (code == 3) v = dbg_b(ws, WS_Y, row * 1536 + (c & 511));
        else if (code == 15) v = dbg_b(ws, WS_WINT, i % ((size_t)PPAD * D));
        else if (code == 13 || code == 14) v = dbg_b(ws, WS_GATE, row * 3072 + c) + dbg_b(ws, WS_GATE, row * 3072 + 1024 + c) + dbg_b(ws, WS_GATE, row * 3072 + 2048 + c);
        else if (code == 4) v = dbg_b(ws, WS_MIXB, row * 1024 + c);
        else if (code == 6) v = dbg_b(ws, WS_HFF, row * 2688 + c) + dbg_b(ws, WS_HFF, row * 2688 + 1024 + c) + dbg_b(ws, WS_HFF, row * 2688 + 1664 + c);
        else if (code == 9) { const int s0 = ((const int*)(ws + WS_POS))[row * 2], s1 = ((const int*)(ws + WS_POS))[row * 2 + 1]; v = dbg_b(ws, WS_XG, (size_t)s0 * 1024 + c) + 2.f * dbg_b(ws, WS_XG, (size_t)s1 * 1024 + c) + ((const float*)(ws + WS_TOPW))[row * 2] + (float)s0 * 1e-3f; }
        else if (code == 10) { const int s0 = ((const int*)(ws + WS_POS))[row * 2], s1 = ((const int*)(ws + WS_POS))[row * 2 + 1]; v = dbg_b(ws, WS_HG, (size_t)s0 * 3584 + c) + dbg_b(ws, WS_HG, (size_t)s1 * 3584 + 2560 + c) + dbg_b(ws, WS_HG, (size_t)s0 * 3584 + 1500 + c); }
        else if (code == 11) { const int s0 = ((const int*)(ws + WS_POS))[row * 2], s1 = ((const int*)(ws + WS_POS))[row * 2 + 1]; v = ((const float*)(ws + WS_OUTG))[(size_t)s0 * 1024 + c] + ((const float*)(ws + WS_OUTG))[(size_t)s1 * 1024 + c]; }
        else continue;
        if (tmo) v = __builtin_nanf("");
        out[i] = v; }
}
#define DBG(code) do { if (dbgc == (code)) { dbg_dump(F, kargs, code); return; } } while (0)
#else
#define DBG(code) do { } while (0)
#endif

__global__ void __launch_bounds__(NWAVES * 64, 2) fwd_kernel(Args args_by_value) {
    extern __shared__ __attribute__((aligned(16))) unsigned char lds_raw[];
    const ArgsP kargs = (ArgsP)__builtin_amdgcn_kernarg_segment_ptr();
    Frame F; F.lds = (LAS unsigned char*)lds_raw; F.G = gridDim.x; F.bid = blockIdx.x; F.NGW = F.G * NWAVES;
    for (int u = threadIdx.x; u < (LDS_BYTES - LDSCTL_OFF) / 4; u += NWAVES * 64) ((LAS unsigned*)(F.lds + LDSCTL_OFF))[u] = 0u;
    __syncthreads();
    volatile LAS unsigned* MISC = (volatile LAS unsigned*)(F.lds + MISC_OFF);
    XcdBarrier bar; { FRESH(a); bar = xcd_barrier_post((unsigned*)(a->ws + WS_CTL) + CW_BAR, MISC + 8); }
#define GRID_BAR() xcd_barrier(bar)

#ifdef ONLY_TEST
    ONLY_TEST; GRID_BAR(); return;
#endif
    const Frame F_ = F;
    int dbgc; { FRESH(a); dbgc = a->dbg; } (void)dbgc;
    phase_prologue(F, kargs); GRID_BAR();
#pragma unroll 1
    for (int l_ = 0; l_ < DEPTH; ++l_) {
        Frame F = F_; int l = l_; asm volatile("" : "+s"(F.G), "+s"(F.NGW), "+s"(F.bid), "+s"(l));
        const bool moe = (l & 1) != 0; const int j2 = l >> 1;
        if (l == 0) DBG(15);
#ifdef PROBE_INPROJ2
        { int reps = 2; asm volatile("" : "+s"(reps));
#pragma unroll 1
          for (int rep = 0; rep < reps; ++rep) { phase_inproj(F, kargs, l); GRID_BAR(); } }
#else
        phase_inproj(F, kargs, l); GRID_BAR(); if (l == 0) DBG(1); if (l == 0) DBG(14);
#endif
        phase_up(F, kargs, l); GRID_BAR(); if (l == 0) DBG(2);
        phase_attn(F, kargs, l); GRID_BAR(); if (l == 0) DBG(3); if (l == 0) DBG(13);
#ifdef PROBE_ATTN2
        phase_attn(F, kargs, l); GRID_BAR();
#endif
#ifdef PROBE_UP2
        phase_up(F, kargs, l); GRID_BAR();
#endif
        phase_branch(F, kargs); GRID_BAR(); if (l == 0) DBG(4);
#ifdef PROBE_RESID2
        { int reps = 2; asm volatile("" : "+s"(reps));
#pragma unroll 1
          for (int rep = reps - 1; rep >= 0; --rep) { phase_outproj(F, kargs, rep != 0); GRID_BAR(); } }
#else
        phase_outproj(F, kargs); GRID_BAR(); if (l == 0) DBG(5); if (l == 1) DBG(8);
#endif
        if (!moe) {
            phase_dense_conv(F, kargs, l, j2); GRID_BAR();
            phase_dense_up(F, kargs, l); GRID_BAR(); if (l == 0) DBG(6);
#ifdef PROBE_DENSE2
            phase_dense_up(F, kargs, l); GRID_BAR();
#endif
#ifdef PROBE_RESID2
            { int reps = 2; asm volatile("" : "+s"(reps));
#pragma unroll 1
              for (int rep = reps - 1; rep >= 0; --rep) { phase_dense_down(F, kargs, rep != 0); GRID_BAR(); } }
#else
            phase_dense_down(F, kargs); GRID_BAR(); if (l == 0) DBG(7);
#endif
        } else {
            phase_moe_route(F, kargs, l, j2); GRID_BAR();
            phase_moe_gather(F, kargs); GRID_BAR(); if (l == 1) DBG(9);
#ifdef PROBE_AUX2
            phase_moe_gather(F, kargs); GRID_BAR();
#endif
            phase_moe_up(F, kargs); GRID_BAR(); if (l == 1) DBG(10);
            phase_moe_down(F, kargs, j2); GRID_BAR(); if (l == 1) DBG(11);
#ifdef PROBE_MOE2
            phase_moe_up(F, kargs); GRID_BAR();
            phase_moe_down(F, kargs, j2); GRID_BAR();
#endif
            phase_moe_combine(F, kargs, l == DEPTH - 1);
            if (l != DEPTH - 1) GRID_BAR();
            if (l == 1) DBG(12);
        }
    }
}

extern "C" void kernel_launch(void* const* d_in, const int* in_sizes, int n_in, void* d_out, int out_size, void* d_ws, size_t ws_size, hipStream_t stream) {
    static int grid = 0;
    if (grid == 0) {
        if (n_in != 27 || in_sizes[0] != M * D || out_size != M * D || ws_size < WS_END) { fprintf(stderr, "kernel_launch: unexpected shapes (n_in %d, in0 %d, out %d, ws %zu)\n", n_in, n_in > 0 ? in_sizes[0] : -1, out_size, ws_size); grid = -1; return; }
        int dev = 0, cus = 0, per_cu = 0;
        if (hipGetDevice(&dev) != hipSuccess || hipDeviceGetAttribute(&cus, hipDeviceAttributeMultiprocessorCount, dev) != hipSuccess) { grid = -1; return; }
        if (hipFuncSetAttribute((const void*)fwd_kernel, hipFuncAttributeMaxDynamicSharedMemorySize, LDS_BYTES) != hipSuccess) { fprintf(stderr, "kernel_launch: hipFuncSetAttribute failed\n"); grid = -1; return; }
        if (hipOccupancyMaxActiveBlocksPerMultiprocessor(&per_cu, (const void*)fwd_kernel, NWAVES * 64, LDS_BYTES) != hipSuccess || per_cu < 1) { fprintf(stderr, "kernel_launch: occupancy query reports %d\n", per_cu); }
        (void)hipGetLastError();
        if (cus != 256) { fprintf(stderr, "kernel_launch: built for 256 CUs, device has %d\n", cus); grid = -1; return; }
        grid = 256;
    }
    if (grid < 0) return;
    if (hipMemsetAsync((char*)d_ws + WS_CTL, 0, CTL_ZERO_BYTES, stream) != hipSuccess) return;
    Args a{};
    a.x = (const float*)d_in[0]; a.mem = (const float*)d_in[1]; a.positions = (const int*)d_in[2]; a.g_mix = (const float*)d_in[3]; a.w_in = (const float*)d_in[4]; a.g_q = (const float*)d_in[5];
    a.g_kv = (const float*)d_in[6]; a.w_uq = (const float*)d_in[7]; a.w_uk = (const float*)d_in[8]; a.w_uv = (const float*)d_in[9]; a.g_sg = (const float*)d_in[10]; a.w_s = (const float*)d_in[11];
    a.b_s = (const float*)d_in[12]; a.g_mem = (const float*)d_in[13]; a.w_mkv = (const float*)d_in[14]; a.w_br = (const float*)d_in[15]; a.b_gate = (const float*)d_in[16]; a.w_out = (const float*)d_in[17];
    a.g_ffn = (const float*)d_in[18]; a.dense_w1 = (const float*)d_in[19]; a.dense_w3 = (const float*)d_in[20]; a.dense_w2 = (const float*)d_in[21]; a.w_router = (const float*)d_in[22];
    a.moe_w1 = (const float*)d_in[23]; a.moe_w3 = (const float*)d_in[24]; a.moe_w2 = (const float*)d_in[25]; a.g_final = (const float*)d_in[26];
    a.out = (float*)d_out; a.ws = (unsigned char*)d_ws;
#ifdef DBG_STOP
    a.dbg = DBG_STOP;
#endif
    hipLaunchKernelGGL(fwd_kernel, dim3(grid), dim3(NWAVES * 64), LDS_BYTES, stream, a);
    const hipError_t le = hipPeekAtLastError();
    if (le != hipSuccess) fprintf(stderr, "kernel_launch: launch failed: %s\n", hipGetErrorName(le));
}
```

```cpp
#include <hip/hip_runtime.h>
#include <cstdio>
#include <cstdint>

#ifndef PH_MASK
#define PH_MASK 0xffffffffu
#endif
#define PH(k) ((PH_MASK >> (k)) & 1u)
#define LAS __attribute__((address_space(3)))
#define GAS __attribute__((address_space(1)))
typedef unsigned short bf16;
typedef short bf16x8 __attribute__((ext_vector_type(8)));
typedef short s16x4 __attribute__((ext_vector_type(4)));
typedef float f32x4 __attribute__((ext_vector_type(4)));
typedef float f32x2 __attribute__((ext_vector_type(2)));
typedef float f32x16 __attribute__((ext_vector_type(16)));
typedef unsigned u32x4 __attribute__((ext_vector_type(4)));
typedef unsigned u32x2 __attribute__((ext_vector_type(2)));
typedef int i32x4 __attribute__((ext_vector_type(4)));

constexpr int M = 16384, D = 1024, DEPTH = 4, NMEM = 256;
constexpr int QRANK = 384, KVRANK = 256, NH = 8, QKD = 96, VD = 64;
constexpr int XH = 4, XD = 128, BW = 512;
constexpr int PTOT = 5280, PPAD = 5376, DFF = 2688, NE = 8, DFE = 3584;
constexpr float EPS = 1e-6f;
constexpr int MAXSLOT = 34816;
constexpr float LOG2E = 1.4426950408889634f;
constexpr float QSCALE = 0.10206207261596575f * LOG2E;
constexpr float XSCALE = 0.08838834764831845f * LOG2E;

constexpr size_t MiB = 1u << 20, KiB = 1u << 10;
constexpr size_t WS_CTL = 0, CTL_ZERO_BYTES = 128 * KiB;
constexpr size_t WS_ROPE = 2 * MiB;
constexpr size_t WS_XSTAT = 4 * MiB;
constexpr size_t WS_RX = 5 * MiB;
constexpr size_t WS_CQSTAT = 5 * MiB + 256 * KiB;
constexpr size_t WS_CKVSTAT = 5 * MiB + 768 * KiB;
constexpr size_t WS_VSTAT = 6 * MiB;
constexpr size_t WS_MEMB = 6 * MiB + 512 * KiB;
constexpr size_t WS_KVMEM = 7 * MiB;
constexpr size_t WS_TOPI = 9 * MiB;
constexpr size_t WS_TOPW = 9 * MiB + 256 * KiB;
constexpr size_t WS_LRANK = 9 * MiB + 512 * KiB;
constexpr size_t WS_POS = 9 * MiB + 768 * KiB;
constexpr size_t WS_BLKCNT = 10 * MiB;
constexpr size_t WS_SLOTR = 10 * MiB + 512 * KiB;
constexpr size_t WS_TOKOF = 10 * MiB + 768 * KiB;
constexpr size_t WS_WSB = 11 * MiB;
constexpr size_t WS_WMKVT = 12 * MiB;
constexpr size_t WS_WINT = 20 * MiB;
constexpr size_t WS_WUQT = 31 * MiB;
constexpr size_t WS_WUKVT = 32 * MiB;
constexpr size_t WS_WBRT = 33 * MiB;
constexpr size_t WS_WOUTT = 36 * MiB;
constexpr size_t WS_WFFN = 40 * MiB;
constexpr size_t WS_W2D = WS_WFFN + 11 * MiB;
constexpr size_t WS_W2M = WS_WFFN + 112 * MiB;
constexpr size_t WS_XB = 208 * MiB;
constexpr size_t WS_CQ = 240 * MiB;
constexpr size_t WS_CKV = 256 * MiB;
constexpr size_t WS_U = 264 * MiB;
constexpr size_t WS_VR = 280 * MiB;
constexpr size_t WS_QX = 296 * MiB;
constexpr size_t WS_GATE = 312 * MiB;
constexpr size_t WS_Q = 408 * MiB;
constexpr size_t WS_KN = 432 * MiB;
constexpr size_t WS_KR = 448 * MiB;
constexpr size_t WS_V = 450 * MiB;
constexpr size_t WS_Y = 466 * MiB;
constexpr size_t WS_MIX = 514 * MiB;
constexpr size_t WS_MIXB = 578 * MiB;
constexpr size_t WS_MIX1 = 610 * MiB;
constexpr size_t WS_HFF = 240 * MiB;
constexpr size_t WS_XG = 240 * MiB;
constexpr size_t WS_HG = 308 * MiB;
constexpr size_t WS_OUTG = 546 * MiB;
constexpr size_t WS_END = 682 * MiB;
constexpr int CW_TMO = 0, CW_CODE = 1, CW_CHK = 2, CW_BAR = 4096;
constexpr int CW_SK = 16384;
constexpr size_t WS_SKPART = 700 * MiB;
constexpr int CW_KMAX = 8192;

constexpr int RING_BYTES = 131072, LDSCTL_OFF = 159744, MISC_OFF = LDSCTL_OFF + 320, LDS_BYTES = 163840;
constexpr int NWAVES = 8;

#define RLX_AGENT __ATOMIC_RELAXED, __HIP_MEMORY_SCOPE_AGENT
#define LDS_WAIT() asm volatile("s_waitcnt lgkmcnt(0)" ::: "memory")
#define VM_WAIT() asm volatile("s_waitcnt vmcnt(0)" ::: "memory")
typedef __bf16 bf16x2_t __attribute__((ext_vector_type(2)));
__device__ __forceinline__ unsigned cvt_pk_bf16(float lo, float hi) { const f32x2 v = {lo, hi}; const bf16x2_t b = __builtin_convertvector(v, bf16x2_t); return __builtin_bit_cast(unsigned, b); }
__device__ __forceinline__ bf16 f2bf(float f) { return (bf16)(cvt_pk_bf16(f, 0.f) & 0xffffu); }
__device__ __forceinline__ float bf2f(bf16 v) { return __uint_as_float((unsigned)v << 16); }
__device__ __forceinline__ float bflo(unsigned w) { return __uint_as_float(w << 16); }
__device__ __forceinline__ float bfhi(unsigned w) { return __uint_as_float(w & 0xffff0000u); }
__device__ __forceinline__ float fast_exp2(float x) { return __builtin_amdgcn_exp2f(x); }
__device__ __forceinline__ float fast_rcp(float x) { return __builtin_amdgcn_rcpf(x); }
__device__ __forceinline__ float sigmoidf_(float z) { return fast_rcp(1.f + fast_exp2(-LOG2E * z)); }
__device__ __forceinline__ float gelu_tanh(float x) { const float t = x + 0.044715f * x * x * x; return x * fast_rcp(1.f + fast_exp2(-2.f * 0.7978845608028654f * LOG2E * t)); }
template <int CTRL> __device__ __forceinline__ float dppf(float v) { return __builtin_bit_cast(float, __builtin_amdgcn_update_dpp(0, __builtin_bit_cast(int, v), CTRL, 0xf, 0xf, true)); }
__device__ __forceinline__ float row_sum16(float v) { v += dppf<0xB1>(v); v += dppf<0x4E>(v); v += dppf<0x124>(v); v += dppf<0x128>(v); return v; }
__device__ __forceinline__ float row_max16(float v) { v = fmaxf(v, dppf<0xB1>(v)); v = fmaxf(v, dppf<0x4E>(v)); v = fmaxf(v, dppf<0x124>(v)); v = fmaxf(v, dppf<0x128>(v)); return v; }
__device__ __forceinline__ float xsum16(float v) { const auto r = __builtin_amdgcn_permlane16_swap(__float_as_uint(v), __float_as_uint(v), false, false); return __uint_as_float(r[0]) + __uint_as_float(r[1]); }
__device__ __forceinline__ float xsum32(float v) { const auto r = __builtin_amdgcn_permlane32_swap(__float_as_uint(v), __float_as_uint(v), false, false); return __uint_as_float(r[0]) + __uint_as_float(r[1]); }
__device__ __forceinline__ float wave_sum(float v) { return xsum32(xsum16(row_sum16(v))); }
__device__ __forceinline__ float sumsq4(f32x4 v) { return (v[0] * v[0] + v[1] * v[1]) + (v[2] * v[2] + v[3] * v[3]); }
__device__ __forceinline__ u32x2 pack8_u8(f32x4 a, f32x4 b) { unsigned w0 = 0, w1 = 0; a = a * 255.f; b = b * 255.f;
    w0 = __builtin_amdgcn_cvt_pk_u8_f32(a[0], 0, w0); w0 = __builtin_amdgcn_cvt_pk_u8_f32(a[1], 1, w0); w0 = __builtin_amdgcn_cvt_pk_u8_f32(a[2], 2, w0); w0 = __builtin_amdgcn_cvt_pk_u8_f32(a[3], 3, w0);
    w1 = __builtin_amdgcn_cvt_pk_u8_f32(b[0], 0, w1); w1 = __builtin_amdgcn_cvt_pk_u8_f32(b[1], 1, w1); w1 = __builtin_amdgcn_cvt_pk_u8_f32(b[2], 2, w1); w1 = __builtin_amdgcn_cvt_pk_u8_f32(b[3], 3, w1);
    return (u32x2){w0, w1}; }
__device__ __forceinline__ void unpack8_u8(u32x2 w, f32x4& a, f32x4& b) { constexpr float k = 1.f / 255.f;
    a = (f32x4){(float)(w.x & 255u), (float)((w.x >> 8) & 255u), (float)((w.x >> 16) & 255u), (float)(w.x >> 24)} * k;
    b = (f32x4){(float)(w.y & 255u), (float)((w.y >> 8) & 255u), (float)((w.y >> 16) & 255u), (float)(w.y >> 24)} * k; }
__device__ __forceinline__ u32x4 pack8(f32x4 a, f32x4 b) { u32x4 w; w.x = cvt_pk_bf16(a[0], a[1]); w.y = cvt_pk_bf16(a[2], a[3]); w.z = cvt_pk_bf16(b[0], b[1]); w.w = cvt_pk_bf16(b[2], b[3]); return w; }
__device__ __forceinline__ void unpack8(u32x4 w, f32x4& a, f32x4& b) { a = (f32x4){bflo(w.x), bfhi(w.x), bflo(w.y), bfhi(w.y)}; b = (f32x4){bflo(w.z), bfhi(w.z), bflo(w.w), bfhi(w.w)}; }

namespace pg8 {
constexpr int BM = 256, BK = 64, HALF = 128, HTB = HALF * BK * 2, STAGE_BYTES = 8 * HTB, NXCD = 8, WGM = 8;
__host__ __device__ __forceinline__ int lds_byte(int r, int c) { const int st = (r >> 4) * 2 + (c >> 5), rr = r & 15, cc = c & 31, ob = rr * 64 + cc * 2; return st * 1024 + (ob ^ (((ob >> 9) & 1) << 5)); }
__host__ __device__ __forceinline__ void stage_rc(int b, int& R, int& C) { const int st = b / 1024, sb = b % 1024, swz = sb ^ (((sb >> 9) & 1) << 5); R = (st >> 1) * 16 + swz / 64; C = (st & 1) * 32 + (swz % 64) / 2; }
__host__ __device__ __forceinline__ int perm32(int rho) { const int n = rho >> 4, i = rho & 15; return 8 * (i >> 2) + 4 * n + (i & 3); }

struct Unit { const char* A; const char* B; int pm, pn, aux, nt; };
typedef f32x4 Acc[2][2][4][2];

__device__ __forceinline__ void tile_of(int L, int nM, int nN, int& pm, int& pn) {
    const int nwg = nM * nN; int wgid = L;
    { const int q = nwg / NXCD, r = nwg % NXCD, xcd = wgid % NXCD, off = wgid / NXCD; wgid = (xcd < r ? xcd * (q + 1) : r * (q + 1) + (xcd - r) * q) + off; }
    const int nig = WGM * nN, gid = wgid / nig, fm = gid * WGM, gsz = (nM - fm) < WGM ? (nM - fm) : WGM;
    pm = fm + ((wgid % nig) % gsz); pn = (wgid % nig) / gsz;
}
struct TileOrder {
    enum { VARK = 0, GATHER = 0 };
    int nM, nN, G, c; const char* A; const char* B; size_t astep, bstep;
    int rev = 0;
    __device__ __forceinline__ bool next(int i, Unit& u) const {
        if (rev) { const int cnt = (nM * nN - c + G - 1) / G; if (i >= cnt) return false; i = cnt - 1 - i; }
        const long L = (long)i * G + c; if (L >= (long)nM * nN) return false;
        int pm, pn; tile_of((int)L, nM, nN, pm, pn);
        u.pm = pm; u.pn = pn; u.aux = i; u.A = A + (size_t)pm * astep; u.B = B + (size_t)pn * bstep; return true;
    }
};

template <class Epi, class Sched>
__device__ __forceinline__ void gemm_phase(LAS unsigned char* lds, const int lda, const int ldb, const int K, const Sched& S, const Epi& E) {
    int tid_ = threadIdx.x; asm volatile("" : "+v"(tid_));
    const int tid = tid_, wid = __builtin_amdgcn_readfirstlane(tid >> 6), lane = tid & 63, wr = wid >> 2, wc = wid & 3, fr = lane & 15, fq = lane >> 4;
    int nt = K / BK;
    unsigned voffA[2], voffB[2];
#pragma unroll
    for (int i = 0; i < 2; ++i) { int R, C; stage_rc(tid * 16 + i * 8192, R, C); const int Rb = (R & ~31) + perm32(R & 31);
        voffA[i] = (unsigned)(R * (lda ? lda : BK) + C) * 2u; voffB[i] = (unsigned)(Rb * BK + C) * 2u; }
    const size_t kstep = lda ? (size_t)(BK * 2) : (size_t)BM * BK * 2;
    const size_t hstepA = (size_t)HALF * (lda ? lda : BK) * 2, hstepB = (size_t)HALF * BK * 2, kstepB = (size_t)BM * BK * 2; (void)ldb;
    const unsigned ldsw = (unsigned)wid * 1024u;
    const int aoff = lds_byte(wr * 64 + fr, fq * 8), boff = lds_byte(wc * 32 + fr, fq * 8);
#define PG8_SA(b, h) (((b) * 2 + (h)) * HTB)
#define PG8_SB(b, h) ((4 + (b) * 2 + (h)) * HTB)
#define PG8_STAGE(bufoff, gbase, voff) do { _Pragma("unroll") for (int _i = 0; _i < 2; ++_i) \
        __builtin_amdgcn_global_load_lds((const unsigned*)((const char*)(gbase) + (voff)[_i]), (LAS unsigned*)(lds + (bufoff) + ldsw + _i * 8192), 16, 0, 0); } while (0)
#define PG8_STA(b, h, kptr, VG) do { if constexpr (Sched::GATHER) PG8_STAGE(PG8_SA(b, h), (kptr), VG[h]); else PG8_STAGE(PG8_SA(b, h), (kptr) + (h) * hstepA, voffA); } while (0)
#define PG8_GLOOKUP(VG, ui_) do { _Pragma("unroll") for (int _h = 0; _h < 2; ++_h) _Pragma("unroll") for (int _i = 0; _i < 2; ++_i) { int R_, C_; stage_rc(tid * 16 + _i * 8192, R_, C_); \
        VG[_h][_i] = (unsigned)S.tokL[(ui_) * 256 + _h * 128 + R_] * (unsigned)(lda * 2) + (unsigned)(C_ * 2); } } while (0)
#define PG8_LDA(dst, b, h) do { _Pragma("unroll") for (int m = 0; m < 4; ++m) _Pragma("unroll") for (int k = 0; k < 2; ++k) dst[m][k] = *(const LAS bf16x8*)(lds + PG8_SA(b, h) + aoff + m * 2048 + k * 1024); } while (0)
#define PG8_LDB(dst, b, h) do { _Pragma("unroll") for (int n = 0; n < 2; ++n) _Pragma("unroll") for (int k = 0; k < 2; ++k) dst[n][k] = *(const LAS bf16x8*)(lds + PG8_SB(b, h) + boff + n * 2048 + k * 1024); } while (0)
#define PG8_MMA(ai, bj, At, Bt) do { __builtin_amdgcn_s_setprio(1); _Pragma("unroll") for (int m = 0; m < 4; ++m) _Pragma("unroll") for (int n = 0; n < 2; ++n) _Pragma("unroll") for (int k = 0; k < 2; ++k) \
        acc[ai][bj][m][n] = __builtin_amdgcn_mfma_f32_16x16x32_bf16(Bt[n][k], At[m][k], acc[ai][bj][m][n], 0, 0, 0); __builtin_amdgcn_s_setprio(0); } while (0)
#define PG8_WAIT_V(n) asm volatile("s_waitcnt vmcnt(" #n ")" ::: "memory")
#define PG8_WAIT_L(n) asm volatile("s_waitcnt lgkmcnt(" #n ")" ::: "memory")
#define PG8_BAR __builtin_amdgcn_s_barrier()
#define PG8_SCHED __builtin_amdgcn_sched_barrier(0)
    Unit cur, nxt; int ui = 0;
    if (!S.next(0, cur)) return;
    if constexpr (Sched::VARK) nt = cur.nt;
    typename Epi::Pre pre = E.prefetch(cur, wr, fr);
    Acc acc;
#pragma unroll
    for (int a = 0; a < 2; ++a)
#pragma unroll
        for (int b = 0; b < 2; ++b)
#pragma unroll
            for (int m = 0; m < 4; ++m)
#pragma unroll
                for (int n = 0; n < 2; ++n) acc[a][b][m][n] = (f32x4){0.f, 0.f, 0.f, 0.f};
    bf16x8 At[4][2], B0[2][2], B1[2][2];
    const char* cA = cur.A; const char* cB = cur.B;
    unsigned vg[2][2] = {{0u, 0u}, {0u, 0u}}; if constexpr (Sched::GATHER) PG8_GLOOKUP(vg, 0);
    PG8_STAGE(PG8_SB(0, 0), cB, voffB); PG8_STAGE(PG8_SB(0, 1), cB + hstepB, voffB); PG8_STA(0, 0, cA, vg); PG8_STA(0, 1, cA, vg);
    if (wr == 1) PG8_BAR;
    PG8_WAIT_V(2); PG8_BAR;
    PG8_STAGE(PG8_SB(1, 0), cB + kstepB, voffB); PG8_STA(1, 0, cA + kstep, vg); PG8_STAGE(PG8_SB(1, 1), cB + hstepB + kstepB, voffB);
    PG8_WAIT_V(6); PG8_BAR;
    for (;;) {
        const bool has_next = S.next(ui + 1, nxt);
        const char* nA = has_next ? nxt.A : cA; const char* nB = has_next ? nxt.B : cB;
        for (int t = 0; t < nt; t += 2) {
            const bool last = (t == nt - 2);
            const char* a1 = cA + (size_t)(t + 1) * kstep;
            const char* a2 = last ? nA : cA + (size_t)(t + 2) * kstep; const char* b2 = last ? nB : cB + (size_t)(t + 2) * kstepB;
            const char* a3 = a2 + kstep; const char* b3 = b2 + kstepB;
            PG8_LDB(B0, 0, 0); PG8_LDB(B1, 0, 1); PG8_SCHED; PG8_LDA(At, 0, 0); PG8_STA(1, 1, a1, vg);
            if constexpr (Sched::GATHER) { if (last && has_next) PG8_GLOOKUP(vg, ui + 1); }
            PG8_WAIT_V(8); PG8_WAIT_L(0); PG8_BAR; PG8_MMA(0, 0, At, B0); PG8_MMA(0, 1, At, B1); PG8_BAR; PG8_SCHED;
            PG8_LDA(At, 0, 1); PG8_STAGE(PG8_SB(0, 0), b2, voffB); PG8_STAGE(PG8_SB(0, 1), b2 + hstepB, voffB); PG8_STA(0, 0, a2, vg);
            PG8_WAIT_V(8); PG8_WAIT_L(0); PG8_BAR; PG8_MMA(1, 0, At, B0); PG8_MMA(1, 1, At, B1); PG8_BAR; PG8_SCHED;
            PG8_LDB(B0, 1, 0); PG8_LDB(B1, 1, 1); PG8_SCHED; PG8_LDA(At, 1, 0); PG8_STA(0, 1, a2, vg);
            PG8_WAIT_V(8); PG8_WAIT_L(0); PG8_BAR; PG8_MMA(0, 0, At, B0); PG8_MMA(0, 1, At, B1); PG8_BAR; PG8_SCHED;
            PG8_LDA(At, 1, 1); PG8_STAGE(PG8_SB(1, 0), b3, voffB); PG8_STAGE(PG8_SB(1, 1), b3 + hstepB, voffB); PG8_STA(1, 0, a3, vg);
            PG8_WAIT_V(8); PG8_WAIT_L(0); PG8_BAR; PG8_MMA(1, 0, At, B0); PG8_MMA(1, 1, At, B1); PG8_BAR; PG8_SCHED;
        }
        if (wr == 0) PG8_BAR;
        E(acc, cur, wr, wc, fr, fq, pre);
        if (!has_next) break;
        pre = E.prefetch(nxt, wr, fr);
        if constexpr (!Epi::KEEP_ACC)
#pragma unroll
        for (int a = 0; a < 2; ++a)
#pragma unroll
            for (int b = 0; b < 2; ++b)
#pragma unroll
                for (int m = 0; m < 4; ++m)
#pragma unroll
                    for (int n = 0; n < 2; ++n) acc[a][b][m][n] = (f32x4){0.f, 0.f, 0.f, 0.f};
        cur = nxt; cA = nA; cB = nB; ++ui;
        if constexpr (Sched::VARK) nt = cur.nt;
        if (wr == 1) PG8_BAR;
    }
    PG8_WAIT_V(0);
    PG8_BAR;
#undef PG8_SA
#undef PG8_SB
#undef PG8_STAGE
#undef PG8_LDA
#undef PG8_STA
#undef PG8_GLOOKUP
#undef PG8_LDB
#undef PG8_MMA
#undef PG8_WAIT_V
#undef PG8_WAIT_L
#undef PG8_BAR
#undef PG8_SCHED
}

#define EPI_FOR _Pragma("unroll") for (int ai = 0; ai < 2; ++ai) _Pragma("unroll") for (int m = 0; m < 4; ++m)
#define EPI_ROW (u.pm * BM + ai * HALF + wr * 64 + m * 16 + fr)
#define EPI_C8(bj) (u.pn * BM + (bj) * HALF + wc * 32 + 8 * fq)
#define EPI_LOAD_R(rr, ptr) float rr[2][4]; _Pragma("unroll") for (int ai = 0; ai < 2; ++ai) _Pragma("unroll") for (int m = 0; m < 4; ++m) rr[ai][m] = (ptr)[EPI_ROW]; asm volatile("" ::: "memory")

#define EPI_LOAD_RS(rr, xstat) float rr[2][4]; { f32x4 st_[2][4]; _Pragma("unroll") for (int ai = 0; ai < 2; ++ai) _Pragma("unroll") for (int m = 0; m < 4; ++m) st_[ai][m] = *(const f32x4*)((xstat) + (size_t)EPI_ROW * 16 + 4 * fq); \
    asm volatile("" ::: "memory"); _Pragma("unroll") for (int ai = 0; ai < 2; ++ai) _Pragma("unroll") for (int m = 0; m < 4; ++m) { float t_ = (st_[ai][m][0] + st_[ai][m][1]) + (st_[ai][m][2] + st_[ai][m][3]); \
        t_ = xsum32(xsum16(t_)); rr[ai][m] = __builtin_amdgcn_rsqf(t_ * (1.f / D) + EPS); } }
struct NoPre {};
#define EPI_NOPRE static constexpr bool KEEP_ACC = false; typedef NoPre Pre; __device__ __forceinline__ Pre prefetch(const Unit&, int, int) const { return Pre{}; }
struct RowPre { float r[2][4]; };
struct EpiInProj {
    unsigned char* ws; const float* bgate; int layer; int from_stats; const LAS float* rtab;
    static constexpr bool KEEP_ACC = false; typedef RowPre Pre;
    __device__ __forceinline__ Pre prefetch(const Unit& u, int wr, int fr) const { Pre p; const float* rx = (const float*)(ws + WS_RX);
#pragma unroll
        for (int ai = 0; ai < 2; ++ai)
#pragma unroll
            for (int m = 0; m < 4; ++m) p.r[ai][m] = from_stats ? rtab[u.aux * 256 + ai * HALF + wr * 64 + m * 16 + fr] : rx[EPI_ROW];
        return p; }
    __device__ __forceinline__ void operator()(const Acc& acc, const Unit& u, int wr, int wc, int fr, int fq, const Pre& pre) const {
        const float* rope = (const float*)(ws + WS_ROPE);
        bf16* CQ = (bf16*)(ws + WS_CQ); bf16* KR = (bf16*)(ws + WS_KR); bf16* CKV = (bf16*)(ws + WS_CKV); bf16* U = (bf16*)(ws + WS_U); bf16* VR = (bf16*)(ws + WS_VR); bf16* QX = (bf16*)(ws + WS_QX); bf16* GATE = (bf16*)(ws + WS_GATE);
        float* cqstat = (float*)(ws + WS_CQSTAT); float* ckvstat = (float*)(ws + WS_CKVSTAT); float* vstat = (float*)(ws + WS_VSTAT); unsigned* kmax = (unsigned*)(ws + WS_CTL) + CW_KMAX + layer * 32;
        const int pn = u.pn;
        float rr[2][4];
#pragma unroll
        for (int ai = 0; ai < 2; ++ai)
#pragma unroll
            for (int m = 0; m < 4; ++m) rr[ai][m] = pre.r[ai][m];
        if (pn < 2) {
            float krmax = 0.f;
            EPI_FOR { const int row = EPI_ROW;
                const float r = rr[ai][m]; float ss = 0.f;
#pragma unroll
                for (int bj = 0; bj < 2; ++bj) { const f32x4 v0 = acc[ai][bj][m][0] * r, v1 = acc[ai][bj][m][1] * r;
                    if (!(pn == 1 && bj == 1)) ss += sumsq4(v0) + sumsq4(v1);
                    *(u32x4*)(CQ + (size_t)row * 512 + pn * 256 + bj * HALF + wc * 32 + 8 * fq) = pack8(v0, v1);
                    if (pn == 1 && bj == 1 && wc == 0) {
                        const f32x4 c = *(const f32x4*)(rope + (size_t)row * 32 + 4 * fq), s = *(const f32x4*)(rope + (size_t)row * 32 + 16 + 4 * fq);
                        const f32x4 o0 = v0 * c - v1 * s, o1 = v0 * s + v1 * c;
                        *(u32x4*)(KR + (size_t)row * 32 + 8 * fq) = pack8(o0, o1);
                        float q2 = sumsq4(o0) + sumsq4(o1); q2 = xsum32(xsum16(q2)); krmax = fmaxf(krmax, q2); } }
                ss = xsum32(xsum16(ss));
                if (fq == 0) cqstat[(size_t)row * 8 + pn * 4 + wc] = ss;
            }
            if (pn == 1 && wc == 0) {
                krmax = row_max16(krmax);
                if ((fr | fq) == 0) atomicMax(kmax + 16, __float_as_uint(krmax)); }
        } else if (pn == 2) {
            EPI_FOR { const int row = EPI_ROW;
                const float r = rr[ai][m]; float ss = 0.f;
#pragma unroll
                for (int bj = 0; bj < 2; ++bj) { const f32x4 v0 = acc[ai][bj][m][0] * r, v1 = acc[ai][bj][m][1] * r; ss += sumsq4(v0) + sumsq4(v1);
                    *(u32x4*)(CKV + (size_t)row * 256 + bj * HALF + wc * 32 + 8 * fq) = pack8(v0, v1); }
                ss = xsum32(xsum16(ss));
                if (fq == 0) ckvstat[(size_t)row * 4 + wc] = ss;
            }
        } else if (pn < 7) {
            const bool isv = pn >= 5; bf16* dst = isv ? VR : U; const int t = isv ? pn - 5 : pn - 3;
            EPI_FOR { const int row = EPI_ROW;
                const float r = rr[ai][m]; float ss = 0.f;
#pragma unroll
                for (int bj = 0; bj < 2; ++bj) { f32x4 v0 = acc[ai][bj][m][0] * r, v1 = acc[ai][bj][m][1] * r;
#pragma unroll
                    for (int e = 0; e < 4; ++e) { v0[e] = gelu_tanh(v0[e]); v1[e] = gelu_tanh(v1[e]); }
                    ss += sumsq4(v0) + sumsq4(v1);
                    *(u32x4*)(dst + (size_t)row * 512 + t * 256 + bj * HALF + wc * 32 + 8 * fq) = pack8(v0, v1); }
                if (isv) { ss = xsum32(xsum16(ss)); if (fq == 0) vstat[(size_t)row * 8 + t * 4 + wc] = ss; }
            }
        } else if (pn < 9) {
            EPI_FOR { const int row = EPI_ROW;
                const float r = rr[ai][m];
#pragma unroll
                for (int bj = 0; bj < 2; ++bj) *(u32x4*)(QX + (size_t)row * 512 + (pn - 7) * 256 + bj * HALF + wc * 32 + 8 * fq) = pack8(acc[ai][bj][m][0] * r, acc[ai][bj][m][1] * r);
            }
        } else {
            const int gc0 = (pn - 9) * 256 + wc * 32 + 8 * fq;
            f32x4 bg[2][2];
#pragma unroll
            for (int bj = 0; bj < 2; ++bj) { bg[bj][0] = *(const f32x4*)(bgate + gc0 + bj * HALF); bg[bj][1] = *(const f32x4*)(bgate + gc0 + bj * HALF + 4); }
            EPI_FOR { const int row = EPI_ROW;
                const float r = rr[ai][m];
#pragma unroll
                for (int bj = 0; bj < 2; ++bj) { f32x4 v0 = acc[ai][bj][m][0] * r + bg[bj][0], v1 = acc[ai][bj][m][1] * r + bg[bj][1];
#pragma unroll
                    for (int e = 0; e < 4; ++e) { v0[e] = sigmoidf_(v0[e]); v1[e] = sigmoidf_(v1[e]); }
#ifdef DBG_CONSTGATE
                    v0 = acc[ai][bj][m][0] * r; v1 = acc[ai][bj][m][1] * r;
#endif
                    *(u32x2*)((unsigned char*)GATE + (size_t)row * 3072 + gc0 + bj * HALF) = pack8_u8(v0, v1); }
            }
        }
    }
};
struct EpiMemKV {
    bf16* KV;
    EPI_NOPRE
    __device__ __forceinline__ void operator()(const Acc& acc, const Unit& u, int wr, int wc, int fr, int fq, const Pre&) const {
        EPI_FOR { const int row = EPI_ROW;
#pragma unroll
            for (int bj = 0; bj < 2; ++bj) *(u32x4*)(KV + (size_t)u.aux * 256 * 1024 + (size_t)row * 1024 + EPI_C8(bj)) = pack8(acc[ai][bj][m][0], acc[ai][bj][m][1]);
        }
    }
};
struct EpiQ {
    const float* cqstat; const float* rope; bf16* Q;
    EPI_NOPRE
    __device__ __forceinline__ void operator()(const Acc& acc, const Unit& u, int wr, int wc, int fr, int fq, const Pre&) const {
        EPI_FOR { const int row = EPI_ROW;
            const f32x4 s0 = *(const f32x4*)(cqstat + (size_t)row * 8), s1 = *(const f32x4*)(cqstat + (size_t)row * 8 + 4);
            const float r = __builtin_amdgcn_rsqf(((s0[0] + s0[1]) + (s0[2] + s0[3]) + (s1[0] + s1[1]) + (s1[2] + s1[3])) * (1.f / QRANK) + EPS);
#pragma unroll
            for (int bj = 0; bj < 2; ++bj) { f32x4 v0 = acc[ai][bj][m][0] * r, v1 = acc[ai][bj][m][1] * r;
                if (((8 * u.pn + 4 * bj + wc) % 3) == 2) {
                    const f32x4 c = *(const f32x4*)(rope + (size_t)row * 32 + 4 * fq), s = *(const f32x4*)(rope + (size_t)row * 32 + 16 + 4 * fq);
                    const f32x4 o0 = v0 * c - v1 * s, o1 = v0 * s + v1 * c; v0 = o0; v1 = o1; }
                *(u32x4*)(Q + (size_t)row * 768 + EPI_C8(bj)) = pack8(v0, v1); }
        }
    }
};
struct EpiKV {
    const float* ckvstat; bf16* KN; bf16* V; unsigned* kmax;
    EPI_NOPRE
    __device__ __forceinline__ void operator()(const Acc& acc, const Unit& u, int wr, int wc, int fr, int fq, const Pre&) const {
        bf16* dst = u.pn < 2 ? KN : V; const int t = u.pn & 1; float hm[2] = {0.f, 0.f};
        EPI_FOR { const int row = EPI_ROW;
            const f32x4 s0 = *(const f32x4*)(ckvstat + (size_t)row * 4);
            const float r = __builtin_amdgcn_rsqf(((s0[0] + s0[1]) + (s0[2] + s0[3])) * (1.f / KVRANK) + EPS);
#pragma unroll
            for (int bj = 0; bj < 2; ++bj) { const f32x4 v0 = acc[ai][bj][m][0] * r, v1 = acc[ai][bj][m][1] * r;
                *(u32x4*)(dst + (size_t)row * 512 + t * 256 + bj * HALF + wc * 32 + 8 * fq) = pack8(v0, v1);
                float q2 = sumsq4(v0) + sumsq4(v1); q2 = xsum32(xsum16(q2)); hm[bj] = fmaxf(hm[bj], q2); }
        }
        if (u.pn < 2) {
#pragma unroll
            for (int bj = 0; bj < 2; ++bj) { float v = hm[bj];
                v = row_max16(v);
                if ((fr | fq) == 0) atomicMax(kmax + 2 * (4 * u.pn + 2 * bj + (wc >> 1)) + (wc & 1), __float_as_uint(v)); }
        }
    }
};
struct EpiBranch {
    const unsigned char* GATE; bf16* MIXB;
    static constexpr bool KEEP_ACC = true; typedef NoPre Pre; __device__ __forceinline__ Pre prefetch(const Unit&, int, int) const { return Pre{}; }
    __device__ __forceinline__ void operator()(Acc& acc, const Unit& u, int wr, int wc, int fr, int fq, const Pre&) const {
        const int n = u.aux;
#pragma unroll
        for (int ai = 0; ai < 2; ++ai) {
            u32x2 gw[4][2], gn[4][2];
#pragma unroll
            for (int m = 0; m < 4; ++m)
#pragma unroll
                for (int bj = 0; bj < 2; ++bj) { const unsigned char* gp = GATE + (size_t)EPI_ROW * 3072 + n * 1024 + EPI_C8(bj);
                    gw[m][bj] = *(const u32x2*)gp; if (n < 2) gn[m][bj] = *(const u32x2*)(gp + 1024); }
            asm volatile("" ::: "memory");
#pragma unroll
            for (int m = 0; m < 4; ++m)
#pragma unroll
                for (int bj = 0; bj < 2; ++bj) {
                    f32x4 g0, g1; unpack8_u8(gw[m][bj], g0, g1);
#pragma unroll
                    for (int e = 0; e < 4; ++e) { g0[e] = fmaxf(g0[e], 0.001953125f); g1[e] = fmaxf(g1[e], 0.001953125f); }
                    if (n < 2) { f32x4 h0, h1; unpack8_u8(gn[m][bj], h0, h1);
#pragma unroll
                        for (int e = 0; e < 4; ++e) { g0[e] *= fast_rcp(fmaxf(h0[e], 0.001953125f)); g1[e] *= fast_rcp(fmaxf(h1[e], 0.001953125f)); }
                        acc[ai][bj][m][0] *= g0; acc[ai][bj][m][1] *= g1; }
                    else *(u32x4*)(MIXB + (size_t)u.pm * 256 * 1024 + (size_t)(4 * u.pn + 2 * bj + (wc >> 1)) * 16384 + (ai * HALF + wr * 64 + m * 16 + fr) * 64 + (wc & 1) * 32 + 8 * fq) = pack8(acc[ai][bj][m][0] * g0, acc[ai][bj][m][1] * g1);
                }
        }
        if (n == 2) {
#pragma unroll
            for (int ai = 0; ai < 2; ++ai)
#pragma unroll
                for (int bj = 0; bj < 2; ++bj)
#pragma unroll
                    for (int m = 0; m < 4; ++m) { acc[ai][bj][m][0] = (f32x4){0.f, 0.f, 0.f, 0.f}; acc[ai][bj][m][1] = (f32x4){0.f, 0.f, 0.f, 0.f}; }
        }
    }
};
struct EpiResid {
    bf16* XB; float* xstat;
    EPI_NOPRE
    __device__ __forceinline__ void operator()(const Acc& acc, const Unit& u, int wr, int wc, int fr, int fq, const Pre&) const {
        u32x4 xv[2][4][2];
#pragma unroll
        for (int ai = 0; ai < 2; ++ai)
#pragma unroll
            for (int m = 0; m < 4; ++m)
#pragma unroll
                for (int bj = 0; bj < 2; ++bj) xv[ai][m][bj] = *(const u32x4*)(XB + (size_t)EPI_ROW * 1024 + EPI_C8(bj));
        asm volatile("" ::: "memory");
#pragma unroll
        for (int ai = 0; ai < 2; ++ai) {
#pragma unroll
            for (int m = 0; m < 4; ++m) { const int row = EPI_ROW; float ss = 0.f;
#pragma unroll
                for (int bj = 0; bj < 2; ++bj) { const int col = EPI_C8(bj); f32x4 x0, x1; unpack8(xv[ai][m][bj], x0, x1);
                    const f32x4 v0 = x0 + acc[ai][bj][m][0], v1 = x1 + acc[ai][bj][m][1];
                    ss += sumsq4(v0) + sumsq4(v1);
                    *(u32x4*)(XB + (size_t)row * 1024 + col) = pack8(v0, v1); }
                ss = xsum32(xsum16(ss));
                if (fq == 0) xstat[(size_t)row * 16 + u.pn * 4 + wc] = ss; }
        }
    }
};
struct EpiSwiGLU {
    const float* rs; bf16* Hh; int ldh; int from_stats;
    static constexpr bool KEEP_ACC = false; typedef RowPre Pre;
    __device__ __forceinline__ Pre prefetch(const Unit& u, int wr, int fr) const { Pre p;
#pragma unroll
        for (int ai = 0; ai < 2; ++ai)
#pragma unroll
            for (int m = 0; m < 4; ++m) p.r[ai][m] = from_stats ? 0.f : rs[EPI_ROW];
        return p; }
    __device__ __forceinline__ void operator()(const Acc& acc, const Unit& u, int wr, int wc, int fr, int fq, const Pre& pre) const {
        float rr[2][4];
        if (from_stats) { EPI_LOAD_RS(rs_, rs);
#pragma unroll
            for (int ai = 0; ai < 2; ++ai)
#pragma unroll
                for (int m = 0; m < 4; ++m) rr[ai][m] = rs_[ai][m]; }
        else {
#pragma unroll
            for (int ai = 0; ai < 2; ++ai)
#pragma unroll
                for (int m = 0; m < 4; ++m) rr[ai][m] = pre.r[ai][m]; }
        bf16* hbase = Hh + (size_t)u.pm * 256 * ldh + (size_t)(2 * u.pn + (wc >> 1)) * 16384 + (wr * 64 + fr) * 64 + (wc & 1) * 32 + 8 * fq;
        EPI_FOR { const int row = EPI_ROW;
            const float r = rr[ai][m];
            f32x4 a0 = acc[ai][0][m][0] * r, a1 = acc[ai][0][m][1] * r; const f32x4 b0 = acc[ai][1][m][0] * r, b1 = acc[ai][1][m][1] * r;
#pragma unroll
            for (int e = 0; e < 4; ++e) { a0[e] = a0[e] * sigmoidf_(a0[e]) * b0[e]; a1[e] = a1[e] * sigmoidf_(a1[e]) * b1[e]; }
            (void)row; *(u32x4*)(hbase + (ai * HALF + m * 16) * 64) = pack8(a0, a1);
        }
    }
};
struct EpiBf16 {
    bf16* C; int ldc;
    EPI_NOPRE
    __device__ __forceinline__ void operator()(const Acc& acc, const Unit& u, int wr, int wc, int fr, int fq, const Pre&) const {
        EPI_FOR { const int row = EPI_ROW;
#pragma unroll
            for (int bj = 0; bj < 2; ++bj) *(u32x4*)(C + (size_t)row * ldc + EPI_C8(bj)) = pack8(acc[ai][bj][m][0], acc[ai][bj][m][1]);
        }
    }
};
__device__ __forceinline__ void ks_reduce(const float* part, int x, int r, int k, int CC, int tid, bf16* C, int ldc, const Unit& u, int wr, int wc, int fr, int fq) {
    for (int sp = k; sp < 16; sp += CC) { const int ai = sp >> 3, bj = (sp >> 2) & 1, m = sp & 3;
        f32x4 s0 = {0.f, 0.f, 0.f, 0.f}, s1 = {0.f, 0.f, 0.f, 0.f};
        for (int kk0 = 0; kk0 < CC; kk0 += 4) {
            f32x4 v0[4], v1[4];
#pragma unroll
            for (int kk = 0; kk < 4; ++kk) { const bool ok = kk0 + kk < CC; const float* q = part + (size_t)(x + 8 * (r * CC + (ok ? kk0 + kk : 0))) * 65536 + tid * 4 + sp * 4096;
                v0[kk] = *(const f32x4*)q; v1[kk] = *(const f32x4*)(q + 2048); if (!ok) { v0[kk] = (f32x4){0.f, 0.f, 0.f, 0.f}; v1[kk] = (f32x4){0.f, 0.f, 0.f, 0.f}; } }
#pragma unroll
            for (int kk = 0; kk < 4; ++kk) { s0 += v0[kk]; s1 += v1[kk]; } }
        const int row = u.pm * BM + ai * HALF + wr * 64 + m * 16 + fr;
        *(u32x4*)(C + (size_t)row * ldc + u.pn * BM + bj * HALF + wc * 32 + 8 * fq) = pack8(s0, s1); }
}
struct EpiBf16KS {
    bf16* C; int ldc; float* part; unsigned* cnt; int c;
    EPI_NOPRE
    __device__ __forceinline__ void operator()(const Acc& acc, const Unit& u, int wr, int wc, int fr, int fq, const Pre&) const {
        if (((u.aux >> 4) & 3) != 0) {
            int tid_ = threadIdx.x; asm volatile("" : "+v"(tid_));
            const int k = (u.aux >> 8) & 255, CC = (u.aux >> 16) & 255, r = u.aux >> 24, x = c & 7;
            float* p = part + (size_t)c * 65536 + tid_ * 4;
#pragma unroll
            for (int ai = 0; ai < 2; ++ai)
#pragma unroll
                for (int bj = 0; bj < 2; ++bj)
#pragma unroll
                    for (int m = 0; m < 4; ++m)
#pragma unroll
                        for (int n = 0; n < 2; ++n) *(f32x4*)(p + (((ai * 2 + bj) * 4 + m) * 2 + n) * 2048) = acc[ai][bj][m][n];
            asm volatile("s_waitcnt vmcnt(0)" ::: "memory");
            __syncthreads();
            if (tid_ == 0) { unsigned* w = cnt + x + 8 * r; __hip_atomic_fetch_add(w, 1u, __ATOMIC_RELEASE, __HIP_MEMORY_SCOPE_AGENT);
                while (__hip_atomic_load(w, __ATOMIC_ACQUIRE, __HIP_MEMORY_SCOPE_AGENT) < (unsigned)CC) __builtin_amdgcn_s_sleep(2); }
            __syncthreads();
            ks_reduce(part, x, r, k, CC, tid_, C, ldc, u, wr, wc, fr, fq);
            return;
        }
        EPI_FOR { const int row = EPI_ROW;
#pragma unroll
            for (int bj = 0; bj < 2; ++bj) *(u32x4*)(C + (size_t)row * ldc + EPI_C8(bj)) = pack8(acc[ai][bj][m][0], acc[ai][bj][m][1]);
        }
    }
};
struct EpiF32 {
    float* C; int ldc;
    EPI_NOPRE
    __device__ __forceinline__ void operator()(const Acc& acc, const Unit& u, int wr, int wc, int fr, int fq, const Pre&) const {
        EPI_FOR { const int row = EPI_ROW;
#pragma unroll
            for (int bj = 0; bj < 2; ++bj) { float* cp = C + (size_t)row * ldc + EPI_C8(bj); *(f32x4*)cp = acc[ai][bj][m][0]; *(f32x4*)(cp + 4) = acc[ai][bj][m][1]; }
        }
    }
};
}

namespace att {
#define KSWZ(row, colB) ((row) * 256 + ((colB) ^ (((row) & 7) << 4)))
#define SBAR() __builtin_amdgcn_sched_barrier(0)
constexpr float THR = 8.f;
__device__ __forceinline__ int crow(int r, int hi) { return (r & 3) + 8 * (r >> 2) + 4 * hi; }
template <int NB> __device__ __forceinline__ int v_st(int k, int c) { const int kk = (k & ~0xC) | ((k & 4) << 1) | ((k & 8) >> 1); return ((kk >> 3) * NB + (c >> 5)) * 512 + ((kk & 7) * 32 + (c & 31)) * 2; }
__device__ __forceinline__ int v_rd_base(int lane) { return ((lane & 3) << 3) | (((lane >> 2) & 3) << 6) | (((lane >> 4) & 1) << 5) | (((lane >> 5) & 1) << 8); }
template <int OFF> __device__ __forceinline__ s16x4 tr_read(int vb) { s16x4 r; asm volatile("ds_read_b64_tr_b16 %0, %1 offset:%2" : "=&v"(r) : "v"(vb), "i"(OFF) : "memory"); return r; }

__device__ __forceinline__ void partialSM(f32x16& p0, f32x16& p1, float& m_reg, float& alpha) {
    float pmax = p0[0];
#pragma unroll
    for (int r = 1; r < 16; ++r) pmax = fmaxf(pmax, p0[r]);
#pragma unroll
    for (int r = 0; r < 16; ++r) pmax = fmaxf(pmax, p1[r]);
    { auto rr = __builtin_amdgcn_permlane32_swap(__float_as_uint(pmax), __float_as_uint(pmax), false, false); pmax = fmaxf(__uint_as_float(rr[0]), __uint_as_float(rr[1])); }
    float mn;
    if (__builtin_expect(__all(pmax - m_reg <= THR), 1)) { mn = m_reg; alpha = 1.f; }
    else { mn = fmaxf(m_reg, pmax); alpha = __builtin_amdgcn_exp2f(m_reg - mn); m_reg = mn; }
#pragma unroll
    for (int r = 0; r < 16; ++r) { p0[r] -= mn; p1[r] -= mn; }
#pragma unroll
    for (int r = 0; r < 16; ++r) p0[r] = __builtin_amdgcn_exp2f(p0[r]);
}
__device__ __forceinline__ void finishSM(f32x16& p0, f32x16& p1, float alpha, float& l_reg, bf16x8& pa0, bf16x8& pa1, bf16x8& pa2, bf16x8& pa3) {
#pragma unroll
    for (int r = 0; r < 16; ++r) p1[r] = __builtin_amdgcn_exp2f(p1[r]);
    float ps = 0;
#pragma unroll
    for (int r = 0; r < 16; ++r) ps += p0[r];
#pragma unroll
    for (int r = 0; r < 16; ++r) ps += p1[r];
    { auto rr = __builtin_amdgcn_permlane32_swap(__float_as_uint(ps), __float_as_uint(ps), false, false); ps = __uint_as_float(rr[0]) + __uint_as_float(rr[1]); }
    l_reg = l_reg * alpha + ps;
#define PK4(P, BASE, OUT) do { unsigned a0 = cvt_pk_bf16(P[BASE + 0], P[BASE + 1]), a1 = cvt_pk_bf16(P[BASE + 2], P[BASE + 3]);   \
    unsigned b0 = cvt_pk_bf16(P[BASE + 4], P[BASE + 5]), b1 = cvt_pk_bf16(P[BASE + 6], P[BASE + 7]);                              \
    auto r0 = __builtin_amdgcn_permlane32_swap(a0, b0, false, false); auto r1 = __builtin_amdgcn_permlane32_swap(a1, b1, false, false); \
    u32x4 w = {r0[0], r1[0], r0[1], r1[1]}; OUT = __builtin_bit_cast(bf16x8, w); } while (0)
    PK4(p0, 0, pa0); PK4(p0, 8, pa1); PK4(p1, 0, pa2); PK4(p1, 8, pa3);
#undef PK4
}
template <int ND0> __device__ __forceinline__ void qkt(f32x16& p0, f32x16& p1, const LAS char* Ks, const bf16x8* qr, int r32, int hi, const f32x16& init) {
#pragma unroll
    for (int d0 = 0; d0 < ND0; ++d0) { const int cb = (d0 * 16 + hi * 8) * 2;
        const bf16x8 b0 = *(const LAS bf16x8*)(Ks + KSWZ(r32, cb));
        const bf16x8 b1 = *(const LAS bf16x8*)(Ks + KSWZ(32 + r32, cb));
        p0 = __builtin_amdgcn_mfma_f32_32x32x16_bf16(b0, qr[d0], d0 == 0 ? init : p0, 0, 0, 0);
        p1 = __builtin_amdgcn_mfma_f32_32x32x16_bf16(b1, qr[d0], d0 == 0 ? init : p1, 0, 0, 0); }
}
__device__ __forceinline__ void expA(f32x16& p0) {
#pragma unroll
    for (int r = 0; r < 16; ++r) p0[r] = __builtin_amdgcn_exp2f(p0[r]);
}
template <int NB, int D0> __device__ __forceinline__ void pv_one(f32x16& od, int vb, bf16x8 pa0, bf16x8 pa1, bf16x8 pa2, bf16x8 pa3) {
    const s16x4 l0 = tr_read<(0 * NB + D0) * 512>(vb), h0 = tr_read<(1 * NB + D0) * 512>(vb), l1 = tr_read<(2 * NB + D0) * 512>(vb), h1 = tr_read<(3 * NB + D0) * 512>(vb);
    const s16x4 l2 = tr_read<(4 * NB + D0) * 512>(vb), h2 = tr_read<(5 * NB + D0) * 512>(vb), l3 = tr_read<(6 * NB + D0) * 512>(vb), h3 = tr_read<(7 * NB + D0) * 512>(vb);
    asm volatile("s_waitcnt lgkmcnt(0)" ::: "memory"); SBAR();
#define PK(L, H) (bf16x8){L[0], L[1], L[2], L[3], H[0], H[1], H[2], H[3]}
    od = __builtin_amdgcn_mfma_f32_32x32x16_bf16(pa0, PK(l0, h0), od, 0, 0, 0);
    od = __builtin_amdgcn_mfma_f32_32x32x16_bf16(pa1, PK(l1, h1), od, 0, 0, 0);
    od = __builtin_amdgcn_mfma_f32_32x32x16_bf16(pa2, PK(l2, h2), od, 0, 0, 0);
    od = __builtin_amdgcn_mfma_f32_32x32x16_bf16(pa3, PK(l3, h3), od, 0, 0, 0);
#undef PK
}
template <int NB> __device__ __forceinline__ void pv_all(f32x16* o, int vb, bf16x8 pa0, bf16x8 pa1, bf16x8 pa2, bf16x8 pa3) {
    pv_one<NB, 0>(o[0], vb, pa0, pa1, pa2, pa3); pv_one<NB, 1>(o[1], vb, pa0, pa1, pa2, pa3);
    if constexpr (NB == 4) { pv_one<NB, 2>(o[2], vb, pa0, pa1, pa2, pa3); pv_one<NB, 3>(o[3], vb, pa0, pa1, pa2, pa3); }
}

template <int DQK, int D1, int DVV, bool FIXM>
__device__ __forceinline__ void attn_unit(const bf16* __restrict__ Qb, int ldq, const bf16* __restrict__ K1, int ldk1, const bf16* __restrict__ K2, int ldk2,
                                          const bf16* __restrict__ Vh, int ldv, bf16* __restrict__ Ob, int ldo, int seq, LAS char* lds, float kbound) {
    constexpr int ND0 = DQK / 16, NB = DVV / 32, CK = DQK / 8, CV = DVV / 8;
    constexpr int NKL = (64 * CK + 511) / 512, NVL = (64 * CV) / 512;
    constexpr int SHM_V = 64 * DVV * 2, SHM_K = 64 * 256;
    int tid_ = threadIdx.x; asm volatile("" : "+v"(tid_));
    const int tid = tid_, wid = tid >> 6, lane = tid & 63, r32 = lane & 31, hi = lane >> 5;
    LAS char* V_lds = lds; LAS char* K_lds = lds + 2 * SHM_V;
    LAS float* ws = (LAS float*)(lds + 2 * SHM_V + 2 * SHM_K) + wid * 64; LAS float* li_l = ws; LAS float* al_l = ws + 32;
    float m_reg = -1e30f, l_reg = 0; f32x16 o[NB]; bf16x8 qr[ND0];
#pragma unroll
    for (int d = 0; d < NB; ++d) o[d] = f32x16{};
    const bf16* Qw = Qb + (long)(wid * 32 + r32) * ldq + hi * 8;
#pragma unroll
    for (int d0 = 0; d0 < ND0; ++d0) qr[d0] = *(const bf16x8*)(Qw + d0 * 16);
    f32x16 init = f32x16{};
    if constexpr (FIXM) {
        float q2 = 0.f;
#pragma unroll
        for (int d0 = 0; d0 < ND0; ++d0) { const u32x4 w = __builtin_bit_cast(u32x4, qr[d0]); f32x4 a, b; unpack8(w, a, b); q2 += sumsq4(a) + sumsq4(b); }
        { auto rr = __builtin_amdgcn_permlane32_swap(__float_as_uint(q2), __float_as_uint(q2), false, false); q2 = __uint_as_float(rr[0]) + __uint_as_float(rr[1]); }
        const float nm = -sqrtf(q2) * kbound;
#pragma unroll
        for (int r = 0; r < 16; ++r) init[r] = nm;
        asm volatile("" : "+v"(init));
    }
    const bf16* kp[NKL]; int kstr[NKL], kdst[NKL]; bool kval[NKL];
#pragma unroll
    for (int i = 0; i < NKL; ++i) { const int c = tid + 512 * i; kval[i] = c < 64 * CK; const int cc_ = kval[i] ? c : 0; const int row = cc_ / CK, cc = cc_ % CK;
        if (cc * 8 < D1) { kp[i] = K1 + (long)row * ldk1 + cc * 8; kstr[i] = 64 * ldk1; } else { kp[i] = K2 + (long)row * ldk2 + (cc * 8 - D1); kstr[i] = 64 * ldk2; }
        kdst[i] = KSWZ(row, cc * 16); }
    const bf16* vp[NVL]; int vdst[NVL]; const int vstr = 64 * ldv;
#pragma unroll
    for (int i = 0; i < NVL; ++i) { const int c = tid + 512 * i; const int row = c / CV, cc = c % CV; vp[i] = Vh + (long)row * ldv + cc * 8; vdst[i] = v_st<NB>(row, cc * 8); }
    const int vb0 = (int)(uintptr_t)V_lds + v_rd_base(lane);
    struct { bf16x8 ks[NKL]; bf16x8 vs[NVL]; } sr_[2];
#define SLOAD(i, t) do { _Pragma("unroll") for (int q_ = 0; q_ < NVL; ++q_) sr_[i].vs[q_] = *(const bf16x8*)(vp[q_] + (long)(t) * vstr); \
    _Pragma("unroll") for (int q_ = 0; q_ < NKL; ++q_) { if (kval[q_]) sr_[i].ks[q_] = *(const bf16x8*)(kp[q_] + (long)(t) * kstr[q_]); } } while (0)
#define SWRITE(b, i) do { _Pragma("unroll") for (int q_ = 0; q_ < NVL; ++q_) *(LAS bf16x8*)(V_lds + (b) * SHM_V + vdst[q_]) = sr_[i].vs[q_]; \
    _Pragma("unroll") for (int q_ = 0; q_ < NKL; ++q_) { if (kval[q_]) *(LAS bf16x8*)(K_lds + (b) * SHM_K + kdst[q_]) = sr_[i].ks[q_]; } } while (0)
#define SWAIT() asm volatile("s_waitcnt vmcnt(%0)" :: "n"(NKL + NVL) : "memory")
#define RESC(a) do { if (__any((a) < 1.f)) { if (hi == 0) al_l[r32] = (a); asm volatile("s_waitcnt lgkmcnt(0)" ::: "memory"); \
    _Pragma("unroll") for (int d = 0; d < NB; ++d) _Pragma("unroll") for (int r = 0; r < 16; ++r) o[d][r] *= al_l[crow(r, hi)]; } } while (0)
    f32x16 pA0, pA1, pB0, pB1; float alA = 1.f, alB = 1.f; bf16x8 pa0, pa1, pa2, pa3; const int NT = seq / 64;
#define PSM(P0, P1, AL) do { if constexpr (FIXM) expA(P0); else partialSM(P0, P1, m_reg, AL); } while (0)
#define RSC(AL) do { if constexpr (!FIXM) RESC(AL); } while (0)
    SLOAD(0, 0); asm volatile("s_waitcnt vmcnt(0)" ::: "memory"); SWRITE(0, 0); __syncthreads();
    qkt<ND0>(pA0, pA1, K_lds, qr, r32, hi, init); PSM(pA0, pA1, alA);
    SLOAD(1, 1); if (2 < NT) SLOAD(0, 2);
    SWAIT(); SWRITE(1, 1); __syncthreads();
    for (int j = 1; j + 1 < NT; j += 2) {
        SBAR(); qkt<ND0>(pB0, pB1, K_lds + SHM_K, qr, r32, hi, init);
        finishSM(pA0, pA1, alA, l_reg, pa0, pa1, pa2, pa3); SBAR();
        SLOAD(1, j + 2); SBAR();
        pv_all<NB>(o, vb0, pa0, pa1, pa2, pa3); PSM(pB0, pB1, alB);
        __syncthreads(); SWAIT(); SWRITE(0, 0);
        RSC(alB); __syncthreads();
        SBAR(); qkt<ND0>(pA0, pA1, K_lds, qr, r32, hi, init);
        finishSM(pB0, pB1, alB, l_reg, pa0, pa1, pa2, pa3); SBAR();
        if (j + 3 < NT) SLOAD(0, j + 3); SBAR();
        pv_all<NB>(o, vb0 + SHM_V, pa0, pa1, pa2, pa3); PSM(pA0, pA1, alA);
        __syncthreads(); SWAIT(); SWRITE(1, 1);
        RSC(alA); __syncthreads();
    }
    SBAR(); qkt<ND0>(pB0, pB1, K_lds + SHM_K, qr, r32, hi, init);
    finishSM(pA0, pA1, alA, l_reg, pa0, pa1, pa2, pa3); SBAR();
    pv_all<NB>(o, vb0, pa0, pa1, pa2, pa3); PSM(pB0, pB1, alB);
    __syncthreads(); RSC(alB);
    finishSM(pB0, pB1, alB, l_reg, pa0, pa1, pa2, pa3); SBAR();
    pv_all<NB>(o, vb0 + SHM_V, pa0, pa1, pa2, pa3);
#undef PSM
#undef RSC
    if (hi == 0) li_l[r32] = l_reg; asm volatile("s_waitcnt lgkmcnt(0)" ::: "memory");
    float rli[16];
#pragma unroll
    for (int r = 0; r < 16; ++r) rli[r] = __builtin_amdgcn_rcpf(li_l[crow(r, hi)]);
    bf16* Ow = Ob + (long)(wid * 32) * ldo;
#pragma unroll
    for (int r = 0; r < 16; ++r) { const int orow = crow(r, hi);
#pragma unroll
        for (int d0 = 0; d0 < NB; ++d0) Ow[(long)orow * ldo + d0 * 32 + r32] = f2bf(o[d0][r] * rli[r]); }
    __syncthreads();
#undef SLOAD
#undef SWRITE
#undef SWAIT
#undef RESC
}

#define EXP4(P, B) do { P[B] = __builtin_amdgcn_exp2f(P[B]); P[B + 1] = __builtin_amdgcn_exp2f(P[B + 1]); P[B + 2] = __builtin_amdgcn_exp2f(P[B + 2]); P[B + 3] = __builtin_amdgcn_exp2f(P[B + 3]); } while (0)
#define SUM4(S, P, B) do { S += (P[B] + P[B + 1]) + (P[B + 2] + P[B + 3]); } while (0)
#define PK4X(P, BASE, OUT) do { const u32x4 w_ = {cvt_pk_bf16(P[BASE + 0], P[BASE + 1]), cvt_pk_bf16(P[BASE + 2], P[BASE + 3]), cvt_pk_bf16(P[BASE + 4], P[BASE + 5]), cvt_pk_bf16(P[BASE + 6], P[BASE + 7])}; OUT = __builtin_bit_cast(bf16x8, w_); } while (0)
typedef short v4i16_t __attribute__((ext_vector_type(4)));
__device__ __forceinline__ s16x4 vtr(const LAS char* p) { return __builtin_bit_cast(s16x4, __builtin_amdgcn_ds_read_tr16_b64_v4i16((LAS v4i16_t*)p)); }
#define KSWZ2(row, colB) ((row) * 256 + ((colB) ^ (((row) & 15) << 4)))
template <int DQK, int D1, int DVV>
__device__ __forceinline__ void attn_unit2(const bf16* __restrict__ Qb, int ldq, const bf16* __restrict__ K1, int ldk1, const bf16* __restrict__ K2, int ldk2,
                                           const bf16* __restrict__ Vh, int ldv, bf16* __restrict__ Ob, int ldo, int seq, LAS char* lds, float kbound) {
    constexpr int ND0 = DQK / 16, NB = DVV / 32, CK = DQK / 8;
    constexpr int SHM_V = 64 * DVV * 2, SHM_K = 64 * 256;
    static_assert(NB == 2 && ND0 == 6, "written for QK dim 96 / V dim 64");
    int tid_ = threadIdx.x; asm volatile("" : "+v"(tid_));
    const int tid = tid_, wid = __builtin_amdgcn_readfirstlane(tid >> 6), lane = tid & 63, r32 = lane & 31, hi = lane >> 5;
    LAS char* V_lds = lds; LAS char* K_lds = lds + 3 * SHM_V;
    LAS float* ws = (LAS float*)(lds + 3 * SHM_V + 2 * SHM_K) + wid * 64;
    LAS char* QAL = lds + 3 * SHM_V + 2 * SHM_K + 2048 + wid * (2 * ND0 * 1024) + lane * 16; LAS char* QBL = QAL + ND0 * 1024;
    float nm;
    { bf16x8 qa[ND0], qb[ND0];
      const bf16* QwA = Qb + (long)(wid * 64 + r32) * ldq + hi * 8; const bf16* QwB = QwA + (long)32 * ldq;
#pragma unroll
      for (int d0 = 0; d0 < ND0; ++d0) { qa[d0] = *(const bf16x8*)(QwA + d0 * 16); qb[d0] = *(const bf16x8*)(QwB + d0 * 16); }
      float q2a = 0.f, q2b = 0.f;
#pragma unroll
      for (int d0 = 0; d0 < ND0; ++d0) { f32x4 a, b; unpack8(__builtin_bit_cast(u32x4, qa[d0]), a, b); q2a += sumsq4(a) + sumsq4(b); unpack8(__builtin_bit_cast(u32x4, qb[d0]), a, b); q2b += sumsq4(a) + sumsq4(b);
          *(LAS bf16x8*)(QAL + d0 * 1024) = qa[d0]; *(LAS bf16x8*)(QBL + d0 * 1024) = qb[d0]; }
      { auto rr = __builtin_amdgcn_permlane32_swap(__float_as_uint(q2a), __float_as_uint(q2a), false, false); q2a = __uint_as_float(rr[0]) + __uint_as_float(rr[1]); }
      { auto rr = __builtin_amdgcn_permlane32_swap(__float_as_uint(q2b), __float_as_uint(q2b), false, false); q2b = __uint_as_float(rr[0]) + __uint_as_float(rr[1]); }
      nm = -sqrtf(fmaxf(q2a, q2b)) * kbound; }
    const bf16* kp[2]; int kstr[2];
#pragma unroll
    for (int i = 0; i < 2; ++i) { const int row = 8 * wid + 4 * i + (lane >> 4), cc = (lane & 15) ^ (row & 15);
        if (cc >= 8 && cc < CK) { kp[i] = K2 + (long)row * ldk2 + (cc * 8 - D1); kstr[i] = 64 * ldk2; } else { kp[i] = K1 + (long)row * ldk1 + (cc < 8 ? cc * 8 : 0); kstr[i] = 64 * ldk1; } }
    const bf16* vp; { const int k = 8 * wid + ((lane & 31) >> 2); vp = Vh + (long)k * ldv + (lane >> 5) * 32 + (lane & 3) * 8; }
    const int vstr = 64 * ldv;
    const LAS char* vrd0 = V_lds + v_rd_base(lane);
#define DMA1(gp, lp) asm volatile("s_mov_b32 m0, %1\n\tglobal_load_lds_dwordx4 %0, off" :: "v"(gp), "s"((unsigned)(unsigned long)(lp)) : "memory", "m0")
#define DMA2(t, kb, vbuf) do { \
    DMA1(kp[0] + (long)(t) * kstr[0], K_lds + (kb) * SHM_K + wid * 2048); \
    DMA1(kp[1] + (long)(t) * kstr[1], K_lds + (kb) * SHM_K + wid * 2048 + 1024); \
    DMA1(vp + (long)(t) * vstr, V_lds + (vbuf) * SHM_V + wid * 1024); } while (0)
#define VRD8(arr, base, D0) do { _Pragma("unroll") for (int j_ = 0; j_ < 8; ++j_) arr[j_] = vtr((base) + (j_ * NB + (D0)) * 512); } while (0)
#define PKV(arr, ks) (bf16x8){arr[2 * (ks)][0], arr[2 * (ks)][1], arr[2 * (ks)][2], arr[2 * (ks)][3], arr[2 * (ks) + 1][0], arr[2 * (ks) + 1][1], arr[2 * (ks) + 1][2], arr[2 * (ks) + 1][3]}
    f32x16 oA[2], oB[2]; oA[0] = f32x16{}; oA[1] = f32x16{}; oB[0] = f32x16{}; oB[1] = f32x16{};
    float lA = 0.f, lB = 0.f; const int NT = seq / 64;
    f32x16 a0, a1, c0, c1; bf16x8 pa0, pa1, pa2, pa3;
#define HALF1(Kb) do { \
        f32x16 init; { float nmv = nm; asm volatile("" : "+v"(nmv)); _Pragma("unroll") for (int r = 0; r < 16; ++r) init[r] = nmv; } \
        SBAR(); __builtin_amdgcn_s_setprio(1); \
        _Pragma("unroll") for (int d0 = 0; d0 < ND0; ++d0) { const int cb = (d0 * 16 + hi * 8) * 2; \
            const bf16x8 k0 = *(const LAS bf16x8*)((Kb) + KSWZ2(r32, cb)), k1 = *(const LAS bf16x8*)((Kb) + KSWZ2(32 + r32, cb)), qv = *(const LAS bf16x8*)(QAL + d0 * 1024); \
            a0 = __builtin_amdgcn_mfma_f32_32x32x16_bf16(k0, qv, d0 == 0 ? init : a0, 0, 0, 0); \
            a1 = __builtin_amdgcn_mfma_f32_32x32x16_bf16(k1, qv, d0 == 0 ? init : a1, 0, 0, 0); } \
        __builtin_amdgcn_s_setprio(0); SBAR(); \
        float sA = 0.f; \
        _Pragma("unroll") for (int d0 = 0; d0 < ND0; ++d0) { const int cb = (d0 * 16 + hi * 8) * 2; \
            const bf16x8 k0 = *(const LAS bf16x8*)((Kb) + KSWZ2(r32, cb)), k1 = *(const LAS bf16x8*)((Kb) + KSWZ2(32 + r32, cb)), qv = *(const LAS bf16x8*)(QBL + d0 * 1024); \
            c0 = __builtin_amdgcn_mfma_f32_32x32x16_bf16(k0, qv, d0 == 0 ? init : c0, 0, 0, 0); \
            if (d0 == 0) { EXP4(a0, 0); } \
            if (d0 == 1) { EXP4(a0, 8); SUM4(sA, a0, 0); } \
            if (d0 == 2) { EXP4(a1, 0); SUM4(sA, a0, 8); } \
            if (d0 == 3) { EXP4(a1, 8); SUM4(sA, a1, 0); } \
            if (d0 == 4) { SUM4(sA, a1, 8); } \
            c1 = __builtin_amdgcn_mfma_f32_32x32x16_bf16(k1, qv, d0 == 0 ? init : c1, 0, 0, 0); \
            if (d0 == 0) { EXP4(a0, 4); } \
            if (d0 == 1) { EXP4(a0, 12); SUM4(sA, a0, 4); } \
            if (d0 == 2) { EXP4(a1, 4); SUM4(sA, a0, 12); } \
            if (d0 == 3) { EXP4(a1, 12); SUM4(sA, a1, 4); } \
            if (d0 == 4) { SUM4(sA, a1, 12); } \
            SBAR(); } \
        lA += sA; \
        PK4X(a0, 0, pa0); PK4X(a0, 8, pa1); PK4X(a1, 0, pa2); PK4X(a1, 8, pa3); \
        SBAR(); } while (0)
#define HALF2(vbase) do { \
        float sB = 0.f; s16x4 va[8], vb_[8]; \
        VRD8(va, vbase, 0); VRD8(vb_, vbase, 1); \
        oA[0] = __builtin_amdgcn_mfma_f32_32x32x16_bf16(pa0, PKV(va, 0), oA[0], 0, 0, 0); SBAR(); \
        oA[1] = __builtin_amdgcn_mfma_f32_32x32x16_bf16(pa0, PKV(vb_, 0), oA[1], 0, 0, 0); EXP4(c0, 0); EXP4(c0, 4); SBAR(); \
        oA[0] = __builtin_amdgcn_mfma_f32_32x32x16_bf16(pa1, PKV(va, 1), oA[0], 0, 0, 0); EXP4(c0, 8); EXP4(c0, 12); SUM4(sB, c0, 0); SBAR(); \
        oA[1] = __builtin_amdgcn_mfma_f32_32x32x16_bf16(pa1, PKV(vb_, 1), oA[1], 0, 0, 0); EXP4(c1, 0); SUM4(sB, c0, 4); SUM4(sB, c0, 8); SBAR(); \
        oA[0] = __builtin_amdgcn_mfma_f32_32x32x16_bf16(pa2, PKV(va, 2), oA[0], 0, 0, 0); EXP4(c1, 4); SUM4(sB, c0, 12); SBAR(); \
        oA[1] = __builtin_amdgcn_mfma_f32_32x32x16_bf16(pa2, PKV(vb_, 2), oA[1], 0, 0, 0); EXP4(c1, 8); SUM4(sB, c1, 0); SBAR(); \
        oA[0] = __builtin_amdgcn_mfma_f32_32x32x16_bf16(pa3, PKV(va, 3), oA[0], 0, 0, 0); EXP4(c1, 12); SUM4(sB, c1, 4); SBAR(); \
        oA[1] = __builtin_amdgcn_mfma_f32_32x32x16_bf16(pa3, PKV(vb_, 3), oA[1], 0, 0, 0); SUM4(sB, c1, 8); SUM4(sB, c1, 12); SBAR(); \
        lB += sB; \
        PK4X(c0, 0, pa0); PK4X(c0, 8, pa1); PK4X(c1, 0, pa2); PK4X(c1, 8, pa3); \
        SBAR(); \
        __builtin_amdgcn_s_setprio(1); VRD8(va, vbase, 0); VRD8(vb_, vbase, 1);                       \
        oB[0] = __builtin_amdgcn_mfma_f32_32x32x16_bf16(pa0, PKV(va, 0), oB[0], 0, 0, 0); \
        oB[1] = __builtin_amdgcn_mfma_f32_32x32x16_bf16(pa0, PKV(vb_, 0), oB[1], 0, 0, 0); \
        oB[0] = __builtin_amdgcn_mfma_f32_32x32x16_bf16(pa1, PKV(va, 1), oB[0], 0, 0, 0); \
        oB[1] = __builtin_amdgcn_mfma_f32_32x32x16_bf16(pa1, PKV(vb_, 1), oB[1], 0, 0, 0); \
        oB[0] = __builtin_amdgcn_mfma_f32_32x32x16_bf16(pa2, PKV(va, 2), oB[0], 0, 0, 0); \
        oB[1] = __builtin_amdgcn_mfma_f32_32x32x16_bf16(pa2, PKV(vb_, 2), oB[1], 0, 0, 0); \
        oB[0] = __builtin_amdgcn_mfma_f32_32x32x16_bf16(pa3, PKV(va, 3), oB[0], 0, 0, 0); \
        oB[1] = __builtin_amdgcn_mfma_f32_32x32x16_bf16(pa3, PKV(vb_, 3), oB[1], 0, 0, 0); \
        __builtin_amdgcn_s_setprio(0); SBAR(); } while (0)
#define TILE_BAR() do { asm volatile("s_waitcnt vmcnt(0)" ::: "memory"); __syncthreads(); } while (0)
    DMA2(0, 0, 0);
    if (wid < 4) {
        int vs = 0;
#pragma unroll 1
        for (int t = 0; t < NT; ++t) { TILE_BAR();
            const int vn = vs == 2 ? 0 : vs + 1; if (t + 1 < NT) DMA2(t + 1, (t + 1) & 1, vn);
            HALF1(K_lds + (t & 1) * SHM_K); HALF2(vrd0 + vs * SHM_V); vs = vn; }
        TILE_BAR();
    } else {
        TILE_BAR(); if (1 < NT) DMA2(1, 1, 1);
        HALF1(K_lds);
        int vs = 0;
#pragma unroll 1
        for (int t = 1; t < NT; ++t) { TILE_BAR();
            const int vn = vs == 2 ? 0 : vs + 1; const int vnn = vn == 2 ? 0 : vn + 1; if (t + 1 < NT) DMA2(t + 1, (t + 1) & 1, vnn);
            HALF2(vrd0 + vs * SHM_V); HALF1(K_lds + (t & 1) * SHM_K); vs = vn; }
        TILE_BAR();
        HALF2(vrd0 + vs * SHM_V);
        __builtin_amdgcn_s_setprio(0);
    }
#undef HALF1
#undef HALF2
#undef TILE_BAR
    { auto rr = __builtin_amdgcn_permlane32_swap(__float_as_uint(lA), __float_as_uint(lA), false, false); lA = __uint_as_float(rr[0]) + __uint_as_float(rr[1]); }
    { auto rr = __builtin_amdgcn_permlane32_swap(__float_as_uint(lB), __float_as_uint(lB), false, false); lB = __uint_as_float(rr[0]) + __uint_as_float(rr[1]); }
    if (hi == 0) { ws[r32] = lA; ws[32 + r32] = lB; } asm volatile("s_waitcnt lgkmcnt(0)" ::: "memory");
    bf16* Ow = Ob + (long)(wid * 64) * ldo;
#pragma unroll
    for (int r = 0; r < 16; ++r) { const int orow = crow(r, hi); const float ra = __builtin_amdgcn_rcpf(ws[orow]), rb = __builtin_amdgcn_rcpf(ws[32 + orow]);
#pragma unroll
        for (int d0 = 0; d0 < NB; ++d0) { Ow[(long)orow * ldo + d0 * 32 + r32] = f2bf(oA[d0][r] * ra); Ow[(long)(32 + orow) * ldo + d0 * 32 + r32] = f2bf(oB[d0][r] * rb); } }
    __syncthreads();
#undef DMA2
#undef DMA1
#undef VRD8
#undef PKV
}
#undef EXP4
#undef SUM4
#undef PK4X

__device__ __forceinline__ void spatial_unit(int chunk, int g, const bf16* __restrict__ U, const bf16* __restrict__ VR, const float* __restrict__ vstat, const float* __restrict__ g_sg,
                                             const bf16* __restrict__ Wsb, const float* __restrict__ b_s, bf16* __restrict__ Y, LAS char* lds) {
    int tid_ = threadIdx.x; asm volatile("" : "+v"(tid_));
    const int tid = tid_, wid = tid >> 6, lane = tid & 63, r32 = lane & 31, hi = lane >> 5, rb = wid & 3, ch = wid >> 2;
    LAS char* V_lds = lds; LAS float* rv = (LAS float*)(lds + 32768);
    const int row0 = chunk * 128;
    f32x4 s0 = {0.f, 0.f, 0.f, 0.f}, s1 = {0.f, 0.f, 0.f, 0.f};
    if (tid < 128) { s0 = *(const f32x4*)(vstat + (size_t)(row0 + tid) * 8); s1 = *(const f32x4*)(vstat + (size_t)(row0 + tid) * 8 + 4); }
    u32x4 wv[4];
#pragma unroll
    for (int i = 0; i < 4; ++i) { const int c = tid + 512 * i, row = c >> 4, cc = c & 15; wv[i] = *(const u32x4*)(VR + (size_t)(row0 + row) * 512 + g * 128 + cc * 8); }
    const f32x4 g0 = *(const f32x4*)(g_sg + g * 128 + (tid & 15) * 8), g1 = *(const f32x4*)(g_sg + g * 128 + (tid & 15) * 8 + 4);
    bf16x8 pa[8];
#pragma unroll
    for (int ks = 0; ks < 8; ++ks) pa[ks] = *(const bf16x8*)(Wsb + (size_t)g * 16384 + (size_t)(32 * rb + r32) * 128 + 16 * ks + 8 * hi);
    bf16 ur[16][2]; float bias[16];
#pragma unroll
    for (int r = 0; r < 16; ++r) { const int i = 32 * rb + crow(r, hi); bias[r] = b_s[g * 128 + i];
#pragma unroll
        for (int dd = 0; dd < 2; ++dd) ur[r][dd] = U[(size_t)(row0 + i) * 512 + g * 128 + 64 * ch + 32 * dd + r32]; }
    if (tid < 128) rv[tid] = __builtin_amdgcn_rsqf(((s0[0] + s0[1]) + (s0[2] + s0[3]) + (s1[0] + s1[1]) + (s1[2] + s1[3])) * (1.f / 512.f) + EPS);
    __syncthreads();
#pragma unroll
    for (int i = 0; i < 4; ++i) { const int c = tid + 512 * i, row = c >> 4, cc = c & 15; f32x4 a, b; unpack8(wv[i], a, b); const float r = rv[row];
        *(LAS u32x4*)(V_lds + (row >> 6) * 16384 + v_st<4>(row & 63, cc * 8)) = pack8(a * r * g0, b * r * g1); }
    __syncthreads();
    f32x16 o[2]; o[0] = f32x16{}; o[1] = f32x16{};
    const int vb = (int)(uintptr_t)V_lds + v_rd_base(lane) + (2 * ch) * 512;
    pv_one<4, 0>(o[0], vb, pa[0], pa[1], pa[2], pa[3]); pv_one<4, 1>(o[1], vb, pa[0], pa[1], pa[2], pa[3]);
    pv_one<4, 0>(o[0], vb + 16384, pa[4], pa[5], pa[6], pa[7]); pv_one<4, 1>(o[1], vb + 16384, pa[4], pa[5], pa[6], pa[7]);
#pragma unroll
    for (int r = 0; r < 16; ++r) { const int i = 32 * rb + crow(r, hi); const size_t row = (size_t)(row0 + i);
#pragma unroll
        for (int dd = 0; dd < 2; ++dd) { const int c = g * 128 + 64 * ch + 32 * dd + r32; const float uu = bf2f(ur[r][dd]);
            Y[row * 1536 + 512 + c] = f2bf(uu * (o[dd][r] + bias[r])); } }
    __syncthreads();
}
#undef KSWZ
#undef SBAR
}

#define XB_TMO      128
#define XB_XCNT(j)  (256  + 64 * (j))
#define XB_XSUB(j)  (1280 + 64 * (j))
#define XB_XGEN(j)  (2304 + 64 * (j))
#define XB_TOP      3328
#define XB_TOPGEN   3392
#define XCD_BAR_WORDS 3456
#define XB_SPIN_CAP (1u << 18)
__device__ __forceinline__ unsigned xb_ld(unsigned* p)              { return __hip_atomic_load((GAS unsigned*)p, __ATOMIC_RELAXED, __HIP_MEMORY_SCOPE_AGENT); }
__device__ __forceinline__ unsigned xb_add(unsigned* p, unsigned v) { return __hip_atomic_fetch_add((GAS unsigned*)p, v, __ATOMIC_RELAXED, __HIP_MEMORY_SCOPE_AGENT); }
__device__ __forceinline__ unsigned xb_xcc_id() { return (unsigned)__builtin_amdgcn_s_getreg((3 << 11) | 20) & 0xFu; }
#define XB_SPIN(cond, bar) do { unsigned _sp = 0; while (cond) { __builtin_amdgcn_s_sleep(1); \
    if ((++_sp & 255u) == 0u) { if (xb_ld(&(bar)[XB_TMO])) break; if (_sp > XB_SPIN_CAP) { xb_add(&(bar)[XB_TMO], 1u); break; } } } } while (0)
struct XcdBarrier { unsigned* bar; unsigned x; volatile LAS unsigned* st; };
__device__ __forceinline__ XcdBarrier xcd_barrier_post(unsigned* bar, volatile LAS unsigned* st) {
    XcdBarrier b; b.bar = bar; b.x = (unsigned)__builtin_amdgcn_readfirstlane((int)xb_xcc_id()); b.st = st;
    if (threadIdx.x == 0) (void)xb_add(&bar[XB_XCNT(b.x)], 1u);
    return b;
}
__device__ __forceinline__ void xcd_barrier_complete(unsigned* bar, unsigned x, unsigned& nloc, unsigned& nx) {
    const unsigned G = gridDim.x * gridDim.y * gridDim.z;
    unsigned sum, cnt, mine, sp = 0u;
    for (;;) {
        sum = 0u; cnt = 0u; mine = 0u;
#pragma unroll
        for (unsigned j = 0; j < 16; ++j) { const unsigned c = xb_ld(&bar[XB_XCNT(j)]); sum += c; cnt += (c > 0u) ? 1u : 0u; mine = (j == x) ? c : mine; }
        if (sum == G) break;
        __builtin_amdgcn_s_sleep(1);
        if ((++sp & 255u) == 0u) { if (xb_ld(&bar[XB_TMO])) break; if (sp > XB_SPIN_CAP) { xb_add(&bar[XB_TMO], 1u); break; } }
    }
    nloc = mine > 0u ? mine : 1u; nx = cnt > 0u ? cnt : 1u;
}
__device__ __forceinline__ void xcd_barrier(const XcdBarrier& b) {
    asm volatile("s_waitcnt vmcnt(0)" ::: "memory");
    __syncthreads();
    if (threadIdx.x == 0) {
        unsigned* bar = b.bar; unsigned bx = b.x; asm volatile("" : "+s"(bar), "+s"(bx));
        __builtin_amdgcn_s_waitcnt(0);
        unsigned nloc = b.st[0], nx = b.st[1];
        if (nloc == 0u) { xcd_barrier_complete(bar, bx, nloc, nx); b.st[0] = nloc; b.st[1] = nx; }
        const unsigned old = xb_add(&bar[XB_XSUB(bx)], 1u);
        const unsigned gen = old / nloc;
        if (old + 1u == (gen + 1u) * nloc) {
            __builtin_amdgcn_fence(__ATOMIC_RELEASE, "agent");
            asm volatile("s_waitcnt vmcnt(0)" ::: "memory");
            const unsigned og = xb_add(&bar[XB_TOP], 1u);
            const unsigned tg = og / nx;
            if (og + 1u == (tg + 1u) * nx) xb_add(&bar[XB_TOPGEN], 1u);
            else XB_SPIN(xb_ld(&bar[XB_TOPGEN]) == tg, bar);
            __builtin_amdgcn_fence(__ATOMIC_ACQUIRE, "agent");
            xb_add(&bar[XB_XGEN(bx)], 1u);
            asm volatile("s_waitcnt vmcnt(0)" ::: "memory");
        } else {
            XB_SPIN(xb_ld(&bar[XB_XGEN(bx)]) == gen, bar);
            __builtin_amdgcn_fence(__ATOMIC_ACQUIRE, "agent");
            asm volatile("s_waitcnt vmcnt(0)" ::: "memory");
        }
    }
    __syncthreads();
}

enum { CV_NAT = 0, CV_WIN = 1, CV_WUQ = 2, CV_W13 = 3 };
__device__ __forceinline__ int ropeperm(int p) { return ((p >> 2) & 1) * 16 + 4 * (p >> 3) + (p & 3); }
__device__ __forceinline__ int cv_map(int kind, int G, int& which, float& scale, bool& perm) {
    which = 0; scale = 1.f; perm = false; const int n = G * 32;
    if (kind == CV_WIN) {
        if (n < 384) return n;
        if (n < 416) { perm = true; return 640; }
        if (n < 512) return -1;
        if (n < 768) return 384 + (n - 512);
        if (n < 1280) return 672 + (n - 768);
        if (n < 1792) return 1184 + (n - 1280);
        if (n < 2304) { scale = XSCALE; return 1696 + (n - 1792); }
        return 2208 + (n - 2304);
    }
    if (kind == CV_WUQ) { scale = QSCALE; perm = (G % 3) == 2; return n; }
    if (kind == CV_W13) { which = (n >> 7) & 1; return 128 * (n >> 8) + (n & 127); }
    return n;
}
struct CvDesc { const float* src; const float* src2; const float* gain; bf16* dst; int K, Nsrc, Nout, kind; };
__device__ __forceinline__ void cv_item(const CvDesc& d, int item, LAS char* tile, int lane) {
    const int nI = d.Nout >> 7, kb = item / nI, nb = item - kb * nI, k0 = 64 * kb, n0 = 128 * nb;
    const int nq = lane & 31, kh = lane >> 5;
    const int nout = n0 + 4 * nq, G = nout >> 5, p = nout & 31;
    int which; float scale; bool perm; const int sc = cv_map(d.kind, G, which, scale, perm);
    const bool zero = sc < 0;
    const float* W = d.src + (ptrdiff_t)which * (d.src2 - d.src) + (size_t)k0 * d.Nsrc + (zero ? 0 : sc + (perm ? ropeperm(p) : p));
#pragma unroll
    for (int half = 0; half < 2; ++half) {
        f32x4 v[16];
#pragma unroll
        for (int i = 0; i < 16; ++i) { const int k = 32 * half + 2 * i + kh; v[i] = zero ? (f32x4){0.f, 0.f, 0.f, 0.f} : *(const f32x4*)(W + (size_t)k * d.Nsrc); }
#pragma unroll
        for (int i = 0; i < 16; ++i) { const int k = 32 * half + 2 * i + kh; const float g = d.gain ? d.gain[k0 + k] * scale : scale; const f32x4 w = v[i] * g;
            *(LAS u32x2*)(tile + att::v_st<4>(k, 4 * nq)) = (u32x2){cvt_pk_bf16(w[0], w[1]), cvt_pk_bf16(w[2], w[3])}; }
    }
    LDS_WAIT(); asm volatile("" ::: "memory");
    const int vb = (int)(uintptr_t)tile + att::v_rd_base(lane);
    bf16* drow = d.dst + (size_t)(n0 >> 8) * 256 * d.K + (size_t)kb * (256 * 64) + (size_t)((n0 & 255) + nq) * 64 + 8 * kh;
#define CV_RD(D0, KS) { const s16x4 l_ = att::tr_read<((2 * KS) * 4 + D0) * 512>(vb), h_ = att::tr_read<((2 * KS + 1) * 4 + D0) * 512>(vb); \
        asm volatile("s_waitcnt lgkmcnt(0)" ::: "memory"); __builtin_amdgcn_sched_barrier(0); \
        *(bf16x8*)(drow + (32 * D0) * 64 + 16 * KS) = (bf16x8){l_[0], l_[1], l_[2], l_[3], h_[0], h_[1], h_[2], h_[3]}; }
#define CV_RD4(D0) CV_RD(D0, 0) CV_RD(D0, 1) CV_RD(D0, 2) CV_RD(D0, 3)
    CV_RD4(0) CV_RD4(1) CV_RD4(2) CV_RD4(3)
#undef CV_RD4
#undef CV_RD
    LDS_WAIT(); asm volatile("" ::: "memory");
}

struct Args {
    const float* x; const float* mem; const int* positions; const float* g_mix; const float* w_in; const float* g_q; const float* g_kv; const float* w_uq; const float* w_uk; const float* w_uv;
    const float* g_sg; const float* w_s; const float* b_s; const float* g_mem; const float* w_mkv; const float* w_br; const float* b_gate; const float* w_out; const float* g_ffn;
    const float* dense_w1; const float* dense_w3; const float* dense_w2; const float* w_router; const float* moe_w1; const float* moe_w3; const float* moe_w2; const float* g_final;
    float* out; unsigned char* ws; int dbg; int pad;
};
typedef const __attribute__((address_space(4))) Args* ArgsP;
#define FRESH(ap) ArgsP ap = kargs; asm volatile("" : "+s"(ap))
__constant__ double INVF[16] = { 1.0, 0.5623413251903491, 0.31622776601683794, 0.1778279410038923, 0.1, 0.05623413251903491, 0.03162277660168379, 0.01778279410038923,
                                 0.01, 0.005623413251903491, 0.003162277660168379, 0.001778279410038923, 0.001, 0.0005623413251903491, 0.00031622776601683794, 0.0001778279410038923 };

struct Frame { LAS unsigned char* lds; int G, NGW, bid; };
#define LOCAL_IDS int tid = threadIdx.x; asm volatile("" : "+v"(tid)); const int lane = tid & 63, wave = __builtin_amdgcn_readfirstlane(tid >> 6), gw = F.bid * NWAVES + wave; (void)lane; (void)gw

__device__ __forceinline__ void conv_run(const Frame& F, const CvDesc& d) {
    LOCAL_IDS;
    LAS char* tile = (LAS char*)(F.lds + wave * 16384);
    const int nitems = (d.K / 64) * (d.Nout / 128);
    for (int it = gw; it < nitems; it += F.NGW) cv_item(d, it, tile, lane);
}
__device__ __forceinline__ void rx_from_stats(const Frame& F, ArgsP kargs) {
    LOCAL_IDS; FRESH(ap); const float* xstat = (const float*)(ap->ws + WS_XSTAT); float* rx = (float*)(ap->ws + WS_RX);
    for (int row = F.bid * 512 + tid; row < M; row += F.G * 512) {
        const f32x4* p = (const f32x4*)(xstat + (size_t)row * 16); const f32x4 a = p[0], b = p[1], c = p[2], d = p[3];
        const float s = ((a[0] + a[1]) + (a[2] + a[3])) + ((b[0] + b[1]) + (b[2] + b[3])) + ((c[0] + c[1]) + (c[2] + c[3])) + ((d[0] + d[1]) + (d[2] + d[3]));
        rx[row] = __builtin_amdgcn_rsqf(s * (1.f / D) + EPS);
    }
}
template <int MODE>
__device__ __forceinline__ void conv_flat(const Frame& F, ArgsP kargs, int l, int j2, int lmix) {
    int tid_ = threadIdx.x; asm volatile("" : "+v"(tid_)); const int lane_ = tid_ & 63, wave_ = __builtin_amdgcn_readfirstlane(tid_ >> 6);
    LAS char* tile = (LAS char*)(F.lds + wave_ * 16384);
    constexpr int I13D = (D / 64) * (2 * DFF / 128), I2D = (DFF / 64) * (D / 128), I13 = (D / 64) * (2 * DFE / 128), I2 = (DFE / 64) * (D / 128), IE = I13 + I2, IMKV = (D / 64) * (D / 128);
    constexpr int NB_ = MODE == 0 ? DEPTH * IMKV : MODE == 1 ? I13D + I2D : MODE == 2 ? NE * IE : 0;
    constexpr int M_IN = (D / 64) * (PPAD / 128), M_UQ = (QRANK / 64) * (768 / 128), M_UK = (KVRANK / 64) * (512 / 128), M_BR = (BW / 64) * (D / 128), M_OUT = (D / 64) * (D / 128);
    constexpr int O_UQ = M_IN, O_UK = O_UQ + M_UQ, O_UV = O_UK + M_UK, O_BR = O_UV + M_UK, O_OUT = O_BR + 3 * M_BR, NMIX = O_OUT + M_OUT;
    const int total = NB_ + ((lmix >= 0 && lmix < DEPTH) ? NMIX : 0);
#pragma unroll 1
    for (int idx = wave_ * F.G + F.bid; idx < total; idx += F.NGW) { FRESH(a); CvDesc d; int it;
        if (idx < NB_) {
            if constexpr (MODE == 0) { const int lq = idx / IMKV; it = idx - lq * IMKV; d = CvDesc{a->w_mkv + (size_t)lq * D * D, nullptr, nullptr, (bf16*)(a->ws + WS_WMKVT) + (size_t)lq * D * D, D, D, D, CV_NAT}; }
            else if constexpr (MODE == 1) {
                if (idx < I13D) { it = idx; d = CvDesc{a->dense_w1 + (size_t)j2 * D * DFF, a->dense_w3 + (size_t)j2 * D * DFF, a->g_ffn + l * D, (bf16*)(a->ws + WS_WFFN), D, DFF, 2 * DFF, CV_W13}; }
                else { it = idx - I13D; d = CvDesc{a->dense_w2 + (size_t)j2 * DFF * D, nullptr, nullptr, (bf16*)(a->ws + WS_W2D), DFF, D, D, CV_NAT}; } }
            else { const int e = idx / IE, r = idx - e * IE;
                if (r < I13) { it = r; d = CvDesc{a->moe_w1 + ((size_t)j2 * NE + e) * D * DFE, a->moe_w3 + ((size_t)j2 * NE + e) * D * DFE, a->g_ffn + l * D, (bf16*)(a->ws + WS_WFFN) + (size_t)e * 2 * DFE * D, D, DFE, 2 * DFE, CV_W13}; }
                else { it = r - I13; d = CvDesc{a->moe_w2 + ((size_t)j2 * NE + e) * DFE * D, nullptr, nullptr, (bf16*)(a->ws + WS_W2M) + (size_t)e * D * DFE, DFE, D, D, CV_NAT}; } }
        } else { const int r = idx - NB_;
            if (r < O_UQ) { it = r; d = CvDesc{a->w_in + (size_t)lmix * D * PTOT, nullptr, a->g_mix + lmix * D, (bf16*)(a->ws + WS_WINT), D, PTOT, PPAD, CV_WIN}; }
            else if (r < O_UK) { it = r - O_UQ; d = CvDesc{a->w_uq + (size_t)lmix * QRANK * 768, nullptr, a->g_q + lmix * QRANK, (bf16*)(a->ws + WS_WUQT), QRANK, 768, 768, CV_WUQ}; }
            else if (r < O_UV) { it = r - O_UK; d = CvDesc{a->w_uk + (size_t)lmix * KVRANK * 512, nullptr, a->g_kv + lmix * KVRANK, (bf16*)(a->ws + WS_WUKVT), KVRANK, 512, 512, CV_NAT}; }
            else if (r < O_BR) { it = r - O_UV; d = CvDesc{a->w_uv + (size_t)lmix * KVRANK * 512, nullptr, a->g_kv + lmix * KVRANK, (bf16*)(a->ws + WS_WUKVT) + 512 * KVRANK, KVRANK, 512, 512, CV_NAT}; }
            else if (r < O_OUT) { const int n = (r - O_BR) / M_BR; it = (r - O_BR) - n * M_BR; d = CvDesc{a->w_br + ((size_t)lmix * 3 + n) * BW * D, nullptr, nullptr, (bf16*)(a->ws + WS_WBRT) + (size_t)n * D * BW, BW, D, D, CV_NAT}; }
            else { it = r - O_OUT; d = CvDesc{a->w_out + (size_t)lmix * D * D, nullptr, nullptr, (bf16*)(a->ws + WS_WOUTT), D, D, D, CV_NAT}; } }
        cv_item(d, it, tile, lane_); }
    if (lmix >= 0 && lmix < DEPTH) {
        FRESH(a); const float* wsrc = a->w_s + (size_t)lmix * 65536; bf16* wdst = (bf16*)(a->ws + WS_WSB);
        for (int i = F.bid * 512 + tid_; i < 4 * 128 * 128 / 4; i += F.G * 512) { const f32x4 v = *(const f32x4*)(wsrc + (size_t)i * 4);
            *(u32x2*)(wdst + (size_t)i * 4) = (u32x2){cvt_pk_bf16(v[0], v[1]), cvt_pk_bf16(v[2], v[3])}; } }
}
__device__ __forceinline__ void phase_prologue(const Frame& F, ArgsP kargs) {
    LOCAL_IDS;
    { FRESH(a); float* ROPE = (float*)(a->ws + WS_ROPE); const int* pos = a->positions;
      for (int idx = F.bid * 512 + tid; idx < M * 16; idx += F.G * 512) { const int row = idx >> 4, i = idx & 15;
        const double t = (double)pos[row] * INVF[i] * 0.15915494309189535; const float fr = (float)(t - rint(t));
        ROPE[(size_t)row * 32 + i] = __builtin_amdgcn_cosf(fr); ROPE[(size_t)row * 32 + 16 + i] = __builtin_amdgcn_sinf(fr); } }
    { FRESH(a); const float* xin = a->x; bf16* XB = (bf16*)(a->ws + WS_XB); float* RX = (float*)(a->ws + WS_RX);
      f32x4 vn[4];
#pragma unroll
      for (int j = 0; j < 4; ++j) vn[j] = ((const f32x4*)(xin + (size_t)gw * D) + lane)[64 * j];
#pragma unroll 1
      for (int m = gw; m < M; m += F.NGW) { f32x4 v[4]; float s = 0.f; const int mn = m + F.NGW < M ? m + F.NGW : m;
#pragma unroll
        for (int j = 0; j < 4; ++j) { v[j] = vn[j]; s += sumsq4(v[j]); }
#pragma unroll
        for (int j = 0; j < 4; ++j) vn[j] = ((const f32x4*)(xin + (size_t)mn * D) + lane)[64 * j];
        s = wave_sum(s);
#pragma unroll
        for (int j = 0; j < 4; ++j) ((u32x2*)(XB + (size_t)m * D) + lane)[64 * j] = (u32x2){cvt_pk_bf16(v[j][0], v[j][1]), cvt_pk_bf16(v[j][2], v[j][3])};
        if (lane == 0) RX[m] = __builtin_amdgcn_rsqf(s * (1.f / D) + EPS); } }
    { FRESH(a); const float* mem = a->mem; const float* g_mem = a->g_mem; bf16* MEMB = (bf16*)(a->ws + WS_MEMB);
      for (int m = gw; m < NMEM; m += F.NGW) { const f32x4* xr = (const f32x4*)(mem + (size_t)m * D) + lane; f32x4 v[4]; float s = 0.f;
#pragma unroll
        for (int j = 0; j < 4; ++j) { v[j] = xr[64 * j]; s += sumsq4(v[j]); }
        const float r = __builtin_amdgcn_rsqf(wave_sum(s) * (1.f / D) + EPS);
#pragma unroll
        for (int j = 0; j < 4; ++j) { const f32x4 g = ((const f32x4*)g_mem + lane)[64 * j]; const f32x4 w = v[j] * r * g;
            ((u32x2*)(MEMB + (size_t)m * D) + lane)[64 * j] = (u32x2){cvt_pk_bf16(w[0], w[1]), cvt_pk_bf16(w[2], w[3])}; } } }
    conv_flat<0>(F, kargs, 0, 0, 0);
}
__device__ __forceinline__ void phase_inproj(const Frame& F, ArgsP kargs, int l) {
    if (PH(1)) { FRESH(a); unsigned char* ws = a->ws;
        pg8::TileOrder S{M / 256, PPAD / 256 - 1, F.G, F.bid, (const char*)(ws + WS_XB), (const char*)(ws + WS_WINT), (size_t)256 * D * 2, (size_t)256 * D * 2};
#ifdef DBG_REV
        S.rev = 1;
#endif
        LAS float* rtab = (LAS float*)(F.lds + RING_BYTES + 1024);
        if (l & 1) { int tid_ = threadIdx.x; asm volatile("" : "+v"(tid_)); const float* xstat = (const float*)(ws + WS_XSTAT); f32x4 st[6][4]; bool ok[6];
#pragma unroll
            for (int i = 0; i < 6; ++i) { pg8::Unit u; ok[i] = S.next(i, u) && tid_ < 256; const f32x4* p4 = (const f32x4*)(xstat + (size_t)(ok[i] ? u.pm * 256 + tid_ : 0) * 16);
#pragma unroll
                for (int q = 0; q < 4; ++q) st[i][q] = p4[q]; }
#pragma unroll
            for (int i = 0; i < 6; ++i) if (ok[i]) { float t_ = 0.f;
#pragma unroll
                for (int q = 0; q < 4; ++q) t_ += (st[i][q][0] + st[i][q][1]) + (st[i][q][2] + st[i][q][3]);
                rtab[i * 256 + tid_] = __builtin_amdgcn_rsqf(t_ * (1.f / D) + EPS); }
            __syncthreads(); }
        pg8::EpiInProj E{ws, a->b_gate + (size_t)l * 3 * D, l, (l & 1), rtab};
        pg8::gemm_phase(F.lds, D, D, D, S, E); }
    if (l == 0 && PH(2)) { FRESH(a); unsigned char* ws = a->ws;
        struct MemOrder { enum { VARK = 0, GATHER = 0 }; int c; const char* A; const char* B;
            __device__ __forceinline__ bool next(int i, pg8::Unit& u) const { if (i > 0 || c < 240) return false; const int idx = c - 240; u.pm = 0; u.pn = idx & 3; u.aux = idx >> 2; u.A = A; u.B = B + (size_t)u.aux * D * D * 2 + (size_t)u.pn * 256 * D * 2; return true; } };
        MemOrder S2{F.bid, (const char*)(ws + WS_MEMB), (const char*)(ws + WS_WMKVT)}; pg8::EpiMemKV E2{(bf16*)(ws + WS_KVMEM)};
        pg8::gemm_phase(F.lds, D, D, D, S2, E2); }
}
struct GateTailOrder { enum { VARK = 0, GATHER = 0 }; int c; const char* A; const char* B;
    __device__ __forceinline__ bool next(int i, pg8::Unit& u) const { if (i > 0 || c < 192) return false; u.pm = c - 192; u.pn = PPAD / 256 - 1; u.aux = 0; u.A = A + (size_t)u.pm * 256 * D * 2; u.B = B + (size_t)u.pn * 256 * D * 2; return true; } };
__device__ __forceinline__ void phase_up(const Frame& F, ArgsP kargs, int l) {
    if (PH(1)) { FRESH(a); unsigned char* ws = a->ws;
        GateTailOrder S{F.bid, (const char*)(ws + WS_XB), (const char*)(ws + WS_WINT)}; LAS float* rtab = (LAS float*)(F.lds + RING_BYTES + 1024);
        if (l & 1) { int tid_ = threadIdx.x; asm volatile("" : "+v"(tid_)); pg8::Unit u;
            if (S.next(0, u) && tid_ < 256) { const f32x4* p4 = (const f32x4*)((const float*)(ws + WS_XSTAT) + (size_t)(u.pm * 256 + tid_) * 16); float t_ = 0.f;
#pragma unroll
                for (int q = 0; q < 4; ++q) { const f32x4 v = p4[q]; t_ += (v[0] + v[1]) + (v[2] + v[3]); }
                rtab[tid_] = __builtin_amdgcn_rsqf(t_ * (1.f / D) + EPS); }
            __syncthreads(); }
        pg8::EpiInProj E{ws, a->b_gate + (size_t)l * 3 * D, l, (l & 1), rtab};
        pg8::gemm_phase(F.lds, D, D, D, S, E); }
    if (PH(3)) { FRESH(a); unsigned char* ws = a->ws;
        pg8::TileOrder S{M / 256, 3, F.G, F.bid, (const char*)(ws + WS_CQ), (const char*)(ws + WS_WUQT), (size_t)256 * 512 * 2, (size_t)256 * QRANK * 2};
        pg8::EpiQ E{(const float*)(ws + WS_CQSTAT), (const float*)(ws + WS_ROPE), (bf16*)(ws + WS_Q)}; pg8::gemm_phase(F.lds, 512, QRANK, QRANK, S, E); }
    if (PH(4)) { FRESH(a); unsigned char* ws = a->ws;
        pg8::TileOrder S{M / 256, 4, F.G, F.bid, (const char*)(ws + WS_CKV), (const char*)(ws + WS_WUKVT), (size_t)256 * KVRANK * 2, (size_t)256 * KVRANK * 2};
        pg8::EpiKV E{(const float*)(ws + WS_CKVSTAT), (bf16*)(ws + WS_KN), (bf16*)(ws + WS_V), (unsigned*)(ws + WS_CTL) + CW_KMAX + l * 32}; pg8::gemm_phase(F.lds, KVRANK, KVRANK, KVRANK, S, E); }
    if (PH(5)) { FRESH(a); unsigned char* ws = a->ws;
        for (int un = F.bid; un < 512; un += F.G)
            att::spatial_unit(un >> 2, un & 3, (const bf16*)(ws + WS_U), (const bf16*)(ws + WS_VR), (const float*)(ws + WS_VSTAT), a->g_sg + l * BW, (const bf16*)(ws + WS_WSB), a->b_s + l * 512, (bf16*)(ws + WS_Y), (LAS char*)F.lds); }
    if (PH(6)) { FRESH(a); unsigned char* ws = a->ws;
        for (int un = F.bid; un < 256; un += F.G) { const int h = un & 3, pm = un >> 2; const bf16* kvm = (const bf16*)(ws + WS_KVMEM) + (size_t)l * 256 * 1024;
            att::attn_unit<128, 128, 128, false>((const bf16*)(ws + WS_QX) + (size_t)pm * 256 * 512 + h * 128, 512, kvm + h * 128, 1024, kvm, 1024, kvm + 512 + h * 128, 1024,
                                          (bf16*)(ws + WS_Y) + (size_t)pm * 256 * 1536 + 1024 + h * 128, 1536, NMEM, (LAS char*)F.lds, 0.f); } }
}
__device__ __forceinline__ void phase_attn(const Frame& F, ArgsP kargs, int l) {
    if (PH(7)) { FRESH(a); unsigned char* ws = a->ws;
        for (int un = F.bid; un < 256; un += F.G) { const int h = un & 7, qb = un >> 3;
            const unsigned* km = (const unsigned*)(ws + WS_CTL) + CW_KMAX + l * 32;
            const float kbound = sqrtf(__uint_as_float(km[2 * h]) + __uint_as_float(km[2 * h + 1]) + __uint_as_float(km[16])) * 1.02f;
            att::attn_unit2<96, 64, 64>((const bf16*)(ws + WS_Q) + (size_t)qb * 512 * 768 + h * 96, 768, (const bf16*)(ws + WS_KN) + h * 64, 512, (const bf16*)(ws + WS_KR), 32, (const bf16*)(ws + WS_V) + h * 64, 512,
                                        (bf16*)(ws + WS_Y) + (size_t)qb * 512 * 1536 + h * 64, 1536, M, (LAS char*)F.lds, kbound); } }
}
__device__ __forceinline__ void phase_branch(const Frame& F, ArgsP kargs) {
    if (PH(8)) { FRESH(a); unsigned char* ws = a->ws;
        struct BranchOrder { enum { VARK = 0, GATHER = 0 }; int c; const char* A; const char* B;
            __device__ __forceinline__ bool next(int i, pg8::Unit& u) const { if (i >= 3 || c >= 256) return false; int pm, pn; pg8::tile_of(c, 64, 4, pm, pn); u.pm = pm; u.pn = pn; u.aux = i;
                u.A = A + (size_t)pm * 256 * 1536 * 2 + (size_t)i * 512 * 2; u.B = B + (size_t)i * D * BW * 2 + (size_t)pn * 256 * BW * 2; return true; } };
        BranchOrder S{F.bid, (const char*)(ws + WS_Y), (const char*)(ws + WS_WBRT)}; pg8::EpiBranch E{(const unsigned char*)(ws + WS_GATE), (bf16*)(ws + WS_MIXB)};
        pg8::gemm_phase(F.lds, 1536, BW, BW, S, E); }
}
__device__ __forceinline__ void phase_outproj(const Frame& F, ArgsP kargs, bool dummy = false) {
    if (PH(9)) { FRESH(a); unsigned char* ws = a->ws;
        pg8::TileOrder S{M / 256, 4, F.G, F.bid, (const char*)(ws + WS_MIXB), (const char*)(ws + WS_WOUTT), (size_t)256 * D * 2, (size_t)256 * D * 2};
        (void)dummy; pg8::EpiResid E{(bf16*)(ws + WS_XB), (float*)(ws + WS_XSTAT)}; pg8::gemm_phase(F.lds, 0, D, D, S, E); }
}
__device__ __forceinline__ void phase_dense_conv(const Frame& F, ArgsP kargs, int l, int j2) {
    rx_from_stats(F, kargs);
    conv_flat<1>(F, kargs, l, j2, -1);
}
__device__ __forceinline__ void phase_dense_up(const Frame& F, ArgsP kargs, int l) {
    if (PH(10)) { FRESH(a); unsigned char* ws = a->ws;
        pg8::TileOrder S{M / 256, 2 * DFF / 256, F.G, F.bid, (const char*)(ws + WS_XB), (const char*)(ws + WS_WFFN), (size_t)256 * D * 2, (size_t)256 * D * 2};
        pg8::EpiSwiGLU E{(const float*)(ws + WS_RX), (bf16*)(ws + WS_HFF), DFF, 0}; pg8::gemm_phase(F.lds, D, D, D, S, E); }
    { const int rem = ((M / 256) * (2 * DFF / 256)) % F.G; Frame F2 = F; if (rem != 0) { F2.G = F.G - rem; F2.bid = F.bid - rem; F2.NGW = F2.G * NWAVES; }
      if (rem == 0 || F.bid >= rem) { __syncthreads(); conv_flat<3>(F2, kargs, l, 0, l + 1); } }
}
__device__ __forceinline__ void phase_dense_down(const Frame& F, ArgsP kargs, bool dummy = false) {
    if (PH(11)) { FRESH(a); unsigned char* ws = a->ws;
        pg8::TileOrder S{M / 256, 4, F.G, F.bid, (const char*)(ws + WS_HFF), (const char*)(ws + WS_W2D), (size_t)256 * DFF * 2, (size_t)256 * DFF * 2};
        (void)dummy; pg8::EpiResid E{(bf16*)(ws + WS_XB), (float*)(ws + WS_XSTAT)}; pg8::gemm_phase(F.lds, 0, DFF, DFF, S, E); }
}
__device__ __forceinline__ void phase_moe_route(const Frame& F, ArgsP kargs, int l, int j2) {
    conv_flat<2>(F, kargs, l, j2, l + 1 < DEPTH ? l + 1 : -1);
    __syncthreads();
    LOCAL_IDS; FRESH(a); unsigned char* ws = a->ws; const bf16* X = (const bf16*)(ws + WS_XB);
    float* RX = (float*)(ws + WS_RX); int* TOPI = (int*)(ws + WS_TOPI); float* TOPW = (float*)(ws + WS_TOPW); int* LRANK = (int*)(ws + WS_LRANK); int* BLKCNT = (int*)(ws + WS_BLKCNT);
    LAS int* tope = (LAS int*)(F.lds + 0);
    const float* wr = a->w_router + (size_t)j2 * D * NE; const float* gf = a->g_ffn + l * D;
    f32x4 gvA[4], wA[4][4][2]; u32x2 xn[4];
#pragma unroll
    for (int j = 0; j < 4; ++j) { const int k0 = 4 * lane + 256 * j; gvA[j] = *(const f32x4*)(gf + k0);
#pragma unroll
        for (int q = 0; q < 4; ++q) { wA[j][q][0] = *(const f32x4*)(wr + (size_t)(k0 + q) * 8); wA[j][q][1] = *(const f32x4*)(wr + (size_t)(k0 + q) * 8 + 4); } }
#pragma unroll
    for (int j = 0; j < 4; ++j) xn[j] = *(const u32x2*)(X + (size_t)(F.bid * 64 + wave * 8) * D + 4 * lane + 256 * j);
#pragma unroll 1
    for (int i = 0; i < 8; ++i) { const int rib = wave * 8 + i, row = F.bid * 64 + rib;
        float lg[8]; float ss = 0.f; f32x4 xc[4];
#pragma unroll
        for (int e = 0; e < 8; ++e) lg[e] = 0.f;
#pragma unroll
        for (int j = 0; j < 4; ++j) xc[j] = (f32x4){bflo(xn[j].x), bfhi(xn[j].x), bflo(xn[j].y), bfhi(xn[j].y)};
        if (i + 1 < 8) {
#pragma unroll
            for (int j = 0; j < 4; ++j) xn[j] = *(const u32x2*)(X + (size_t)(row + 1) * D + 4 * lane + 256 * j); }
#pragma unroll
        for (int j = 0; j < 4; ++j) { const f32x4 xv = xc[j], gv = gvA[j]; ss += sumsq4(xv);
#pragma unroll
            for (int q = 0; q < 4; ++q) { const float hv = xv[q] * gv[q]; const f32x4 w0 = wA[j][q][0], w1 = wA[j][q][1];
                lg[0] += hv * w0[0]; lg[1] += hv * w0[1]; lg[2] += hv * w0[2]; lg[3] += hv * w0[3]; lg[4] += hv * w1[0]; lg[5] += hv * w1[1]; lg[6] += hv * w1[2]; lg[7] += hv * w1[3]; } }
        const float r = __builtin_amdgcn_rsqf(wave_sum(ss) * (1.f / D) + EPS);
#pragma unroll
        for (int e = 0; e < 8; ++e) lg[e] = wave_sum(lg[e]) * r;
        int e0 = 0; float v0 = lg[0];
#pragma unroll
        for (int e = 1; e < 8; ++e) if (lg[e] > v0) { v0 = lg[e]; e0 = e; }
        int e1 = e0 == 0 ? 1 : 0; float v1 = -3.0e38f;
#pragma unroll
        for (int e = 0; e < 8; ++e) if (e != e0 && lg[e] > v1) { v1 = lg[e]; e1 = e; }
        const float w0 = 1.f / (1.f + expf(v1 - v0));
        if (lane == 0) { RX[row] = r; TOPI[row] = e0 | (e1 << 8); TOPW[(size_t)row * 2] = w0; TOPW[(size_t)row * 2 + 1] = 1.f - w0; tope[rib] = e0 | (e1 << 8); } }
    __syncthreads();
    if (wave == 0) { const int te = tope[lane], e0 = te & 255, e1 = te >> 8, row = F.bid * 64 + lane; const unsigned long long below = (1ull << lane) - 1ull;
        int rk0 = 0, rk1 = 0;
#pragma unroll
        for (int e = 0; e < 8; ++e) { const unsigned long long m0 = __ballot(e0 == e), m1 = __ballot(e1 == e); const int c0 = __popcll(m0);
            if (e0 == e) rk0 = __popcll(m0 & below); if (e1 == e) rk1 = c0 + __popcll(m1 & below);
            if (lane == 0) BLKCNT[F.bid * 8 + e] = c0 + __popcll(m1); }
        LRANK[(size_t)row * 2] = rk0; LRANK[(size_t)row * 2 + 1] = rk1; }
    __syncthreads();
}
__device__ __forceinline__ void moe_tiles(const Frame& F, ArgsP kargs, int (&tb)[NE + 1], LAS int* pre) {
    LOCAL_IDS; FRESH(a); const int* BLKCNT = (const int*)(a->ws + WS_BLKCNT);
    __syncthreads();
    if (tid < 16) pre[tid] = 0;
    __syncthreads();
    if (tid < 256) { const i32x4 c0 = *(const i32x4*)(BLKCNT + tid * 8), c1 = *(const i32x4*)(BLKCNT + tid * 8 + 4); const int cc[8] = {c0[0], c0[1], c0[2], c0[3], c1[0], c1[1], c1[2], c1[3]};
#pragma unroll
        for (int e = 0; e < 8; ++e) { const int tot = (int)wave_sum((float)cc[e]); const int bel = (int)wave_sum(tid < F.bid ? (float)cc[e] : 0.f);
            if (lane == 0) { __hip_atomic_fetch_add(pre + 8 + e, tot, __ATOMIC_RELAXED, __HIP_MEMORY_SCOPE_WORKGROUP); __hip_atomic_fetch_add(pre + e, bel, __ATOMIC_RELAXED, __HIP_MEMORY_SCOPE_WORKGROUP); } } }
    __syncthreads();
    int acc_t = 0;
#pragma unroll
    for (int e = 0; e < NE; ++e) { tb[e] = acc_t; acc_t += (__builtin_amdgcn_readfirstlane(pre[8 + e]) + 255) >> 8; }
    tb[NE] = acc_t;
}
__device__ __forceinline__ void phase_moe_gather(const Frame& F, ArgsP kargs) {
    int tb[NE + 1]; LAS int* pre = (LAS int*)(F.lds + 0);
    moe_tiles(F, kargs, tb, pre);
    LOCAL_IDS; FRESH(a); unsigned char* ws = a->ws;
    const int* TOPI = (const int*)(ws + WS_TOPI); const int* LRANK = (const int*)(ws + WS_LRANK); int* POS = (int*)(ws + WS_POS); float* SLOTR = (float*)(ws + WS_SLOTR); const float* RX = (const float*)(ws + WS_RX);
    int* TOKOF = (int*)(ws + WS_TOKOF);
    if (lane < 16) { const int pi = wave * 16 + lane, rib = pi >> 1, k = pi & 1, row = F.bid * 64 + rib;
        const int te = TOPI[row], e = k ? (te >> 8) : (te & 255); const int lr = LRANK[(size_t)row * 2 + k]; const float rx = RX[row];
        int bs = 0;
#pragma unroll
        for (int q = 0; q < NE; ++q) if (q == e) bs = tb[q] * 256;
        const int slot = bs + pre[e] + lr;
        POS[(size_t)row * 2 + k] = slot; SLOTR[slot] = rx; TOKOF[slot] = row; }
    if (F.bid < NE) { const int e = F.bid; int b0 = 0, b1 = 0;
#pragma unroll
        for (int q = 0; q < NE; ++q) if (q == e) { b0 = tb[q] * 256; b1 = tb[q + 1] * 256; }
        const int cnt = __builtin_amdgcn_readfirstlane(pre[8 + e]);
        for (int s = b0 + cnt + tid; s < b1; s += NWAVES * 64) { SLOTR[s] = 0.f; TOKOF[s] = 0; } }
    __syncthreads();
}
struct MoeOrder { enum { VARK = 0, GATHER = 0 }; int nN, G, c, T; int tb[NE + 1]; const char* A; const char* B; size_t astep, estep, bstep; int rev = 0;
    __device__ __forceinline__ bool next(int i, pg8::Unit& u) const { const long L = (long)i * G + c; if (L >= (long)T * nN) return false; int pm, pn; pg8::tile_of((int)L, T, nN, pm, pn); if (rev) pm = T - 1 - pm;
        int e = 0;
#pragma unroll
        for (int q = 1; q < NE; ++q) e += (pm >= tb[q]) ? 1 : 0;
        u.pm = pm; u.pn = pn; u.aux = e; u.A = A + (size_t)pm * astep; u.B = B + (size_t)e * estep + (size_t)pn * bstep; return true; } };
struct MoeUpOrder { enum { VARK = 0, GATHER = 1 }; int nN, G, c, T; int tb[NE + 1]; const char* A; const char* B; size_t estep, bstep; const LAS int* tokL;
    __device__ __forceinline__ bool next(int i, pg8::Unit& u) const { const long L = (long)i * G + c; if (L >= (long)T * nN) return false; int pm, pn; pg8::tile_of((int)L, T, nN, pm, pn);
        int e = 0;
#pragma unroll
        for (int q = 1; q < NE; ++q) e += (pm >= tb[q]) ? 1 : 0;
        u.pm = pm; u.pn = pn; u.aux = e; u.A = A; u.B = B + (size_t)e * estep + (size_t)pn * bstep; return true; } };
struct MoeTailOrder { enum { VARK = 1, GATHER = 0 }; static constexpr int PPU = DFE / 128;
    int nN, G, c, T; int tb[NE + 1]; const char* A; const char* B; size_t astep, estep, bstep; int rev = 0;
    __device__ __forceinline__ bool next(int i, pg8::Unit& u) const {
        const int U = T * nN, R = U / G, Lf = U - R * G, x = c & 7, j = c >> 3, nj = (G - x + 7) >> 3;
        const int Lfx = Lf > x ? (Lf - x + 7) >> 3 : 0;
        long L; int k0 = 0, np = PPU, part = 0, k = 0, r = 0, C = 1;
        if (i < R) L = (long)i * G + c;
        else if (i == R && Lfx > 0) { const int cap = nj / Lfx; C = cap >= 8 ? 8 : cap >= 1 ? cap : 1;
            r = j / C; k = j - r * C; if (r >= Lfx) return false;
            L = (long)R * G + x + 8 * r; if (C > 1) { const int q = PPU / C, rem = PPU - q * C; np = q + (k < rem ? 1 : 0); k0 = k * q + (k < rem ? k : rem); part = 3; } }
        else return false;
        int pm, pn; pg8::tile_of((int)L, T, nN, pm, pn); if (rev) pm = T - 1 - pm;
        int e = 0;
#pragma unroll
        for (int q = 1; q < NE; ++q) e += (pm >= tb[q]) ? 1 : 0;
        u.pm = pm; u.pn = pn; u.aux = e | (part << 4) | (k << 8) | (C << 16) | (r << 24); u.nt = 2 * np;
        u.A = A + (size_t)pm * astep + (size_t)k0 * 65536; u.B = B + (size_t)e * estep + (size_t)pn * bstep + (size_t)k0 * 65536; return true; } };
__device__ __forceinline__ void phase_moe_up(const Frame& F, ArgsP kargs) {
    if (PH(12)) { MoeUpOrder S; LAS int* pre = (LAS int*)(F.lds + RING_BYTES + 64); moe_tiles(F, kargs, S.tb, pre);
        FRESH(a); unsigned char* ws = a->ws; S.nN = 2 * DFE / 256; S.G = F.G; S.c = F.bid; S.T = S.tb[NE];
        S.A = (const char*)(ws + WS_XB); S.B = (const char*)(ws + WS_WFFN); S.estep = (size_t)2 * DFE * D * 2; S.bstep = (size_t)256 * D * 2;
        { LAS int* tokL = (LAS int*)(F.lds + RING_BYTES + 1024); S.tokL = tokL; const int* TOKOF = (const int*)(ws + WS_TOKOF);
          int tid_ = threadIdx.x; asm volatile("" : "+v"(tid_)); const int half_ = __builtin_amdgcn_readfirstlane(tid_ >> 8); int tkv[8];
#pragma unroll
          for (int j = 0; j < 8; ++j) { pg8::Unit u; const bool ok = S.next(2 * j + half_, u); tkv[j] = ok ? TOKOF[u.pm * 256 + (tid_ & 255)] : 0; }
#pragma unroll
          for (int j = 0; j < 8; ++j) tokL[(2 * j + half_) * 256 + (tid_ & 255)] = tkv[j];
          __syncthreads(); }
        pg8::EpiSwiGLU E{(const float*)(ws + WS_SLOTR), (bf16*)(ws + WS_HG), DFE, 0}; pg8::gemm_phase(F.lds, D, D, D, S, E); }
}
__device__ __forceinline__ void phase_moe_down(const Frame& F, ArgsP kargs, int j2) {
    if (PH(13)) { MoeTailOrder S; LAS int* pre = (LAS int*)(F.lds + RING_BYTES + 64); moe_tiles(F, kargs, S.tb, pre);
        FRESH(a); unsigned char* ws = a->ws; S.nN = 4; S.G = F.G; S.c = F.bid; S.T = S.tb[NE]; S.rev = 1;
        S.A = (const char*)(ws + WS_HG); S.B = (const char*)(ws + WS_W2M); S.astep = (size_t)256 * DFE * 2; S.estep = (size_t)D * DFE * 2; S.bstep = (size_t)256 * DFE * 2;
        pg8::EpiBf16KS E{(bf16*)(ws + WS_OUTG), D, (float*)(ws + WS_SKPART), (unsigned*)(ws + WS_CTL) + CW_SK + j2 * 512, F.bid}; pg8::gemm_phase(F.lds, 0, DFE, DFE, S, E); }
}
__device__ __forceinline__ void phase_moe_combine(const Frame& F, ArgsP kargs, bool last) {
    LOCAL_IDS; FRESH(a); unsigned char* ws = a->ws; float* OUT = a->out; const bf16* OUTG = (const bf16*)(ws + WS_OUTG); const int* POS = (const int*)(ws + WS_POS); const float* TOPW = (const float*)(ws + WS_TOPW);
    bf16* XB = (bf16*)(ws + WS_XB); float* RX = (float*)(ws + WS_RX); const float* g_final = a->g_final;
    int s0n, s1n; float w0n, w1n, w0c, w1c; u32x2 pn0[4], pn1[4], xn[4];
    { const int s0 = POS[(size_t)gw * 2], s1 = POS[(size_t)gw * 2 + 1]; w0c = TOPW[(size_t)gw * 2]; w1c = TOPW[(size_t)gw * 2 + 1];
      const int m1 = gw + F.NGW < M ? gw + F.NGW : gw; s0n = POS[(size_t)m1 * 2]; s1n = POS[(size_t)m1 * 2 + 1]; w0n = TOPW[(size_t)m1 * 2]; w1n = TOPW[(size_t)m1 * 2 + 1];
#pragma unroll
      for (int j = 0; j < 4; ++j) { pn0[j] = ((const u32x2*)(OUTG + (size_t)s0 * D) + lane)[64 * j]; pn1[j] = ((const u32x2*)(OUTG + (size_t)s1 * D) + lane)[64 * j]; xn[j] = ((const u32x2*)(XB + (size_t)gw * D) + lane)[64 * j]; } }
#pragma unroll 1
    for (int m = gw; m < M; m += F.NGW) {
        const float w0 = w0c, w1 = w1c; u32x2 p0c[4], p1c[4], xc[4];
#pragma unroll
        for (int j = 0; j < 4; ++j) { p0c[j] = pn0[j]; p1c[j] = pn1[j]; xc[j] = xn[j]; }
        { const int mn = m + F.NGW < M ? m + F.NGW : m, mnn = m + 2 * F.NGW < M ? m + 2 * F.NGW : m; const int s0 = s0n, s1 = s1n; w0c = w0n; w1c = w1n;
#pragma unroll
          for (int j = 0; j < 4; ++j) { pn0[j] = ((const u32x2*)(OUTG + (size_t)s0 * D) + lane)[64 * j]; pn1[j] = ((const u32x2*)(OUTG + (size_t)s1 * D) + lane)[64 * j]; xn[j] = ((const u32x2*)(XB + (size_t)mn * D) + lane)[64 * j]; }
          s0n = POS[(size_t)mnn * 2]; s1n = POS[(size_t)mnn * 2 + 1]; w0n = TOPW[(size_t)mnn * 2]; w1n = TOPW[(size_t)mnn * 2 + 1]; }
        f32x4 v[4]; float s = 0.f;
#pragma unroll
        for (int j = 0; j < 4; ++j) { const u32x2 p0 = p0c[j], p1 = p1c[j];
            const f32x4 o0 = {bflo(p0.x), bfhi(p0.x), bflo(p0.y), bfhi(p0.y)}, o1 = {bflo(p1.x), bfhi(p1.x), bflo(p1.y), bfhi(p1.y)};
            const f32x4 xf = {bflo(xc[j].x), bfhi(xc[j].x), bflo(xc[j].y), bfhi(xc[j].y)}; v[j] = xf + w0 * o0 + w1 * o1; s += sumsq4(v[j]); }
        const float r = __builtin_amdgcn_rsqf(wave_sum(s) * (1.f / D) + EPS);
        if (last) {
#pragma unroll
            for (int j = 0; j < 4; ++j) ((f32x4*)(OUT + (size_t)m * D) + lane)[64 * j] = v[j] * r * ((const f32x4*)g_final + lane)[64 * j];
        } else {
#pragma unroll
            for (int j = 0; j < 4; ++j) ((u32x2*)(XB + (size_t)m * D) + lane)[64 * j] = (u32x2){cvt_pk_bf16(v[j][0], v[j][1]), cvt_pk_bf16(v[j][2], v[j][3])};
            if (lane == 0) RX[m] = r;
        }
    }
}


#ifdef DBG_ENABLE
__device__ __forceinline__ float dbg_b(const unsigned char* ws, size_t off, size_t idx) { return bf2f(((const bf16*)(ws + off))[idx]); }
__device__ __forceinline__ void dbg_dump(const Frame& F, ArgsP kargs, int code) {
    LOCAL_IDS; FRESH(a); const unsigned char* ws = a->ws; float* out = a->out;
    unsigned tmo = ((const unsigned*)(ws + WS_CTL))[CW_BAR + XB_TMO];
    for (size_t i = (size_t)F.bid * 512 + tid; i < (size_t)M * D; i += (size_t)F.G * 512) { const size_t row = i >> 10, c = i & 1023; float v = 0.f;
        if (code == 1) v = dbg_b(ws, WS_CQ, row * 512 + (c & 511)) + dbg_b(ws, WS_CKV, row * 256 + (c & 255)) + dbg_b(ws, WS_U, row * 512 + (c & 511)) + dbg_b(ws, WS_VR, row * 512 + (c & 511)) + dbg_b(ws, WS_QX, row * 512 + (c & 511))
                         + dbg_b(ws, WS_GATE, row * 3072 + c) + dbg_b(ws, WS_GATE, row * 3072 + 1024 + c) + dbg_b(ws, WS_GATE, row * 3072 + 2048 + c) + dbg_b(ws, WS_KR, row * 32 + (c & 31));
        else if (code == 2) v = dbg_b(ws, WS_Q, row * 768 + (c % 768)) + dbg_b(ws, WS_KN, row * 512 + (c & 511)) + dbg_b(ws, WS_V, row * 512 + (c & 511)) + dbg_b(ws, WS_Y, row * 1536 + 512 + c);
        else if (code == 3) v = dbg_b(ws, WS_Y, row * 1536 + (c & 511));
        else if (code == 15) v = dbg_b(ws, WS_WINT, i % ((size_t)PPAD * D));
        else if (code == 13 || code == 14) v = dbg_b(ws, WS_GATE, row * 3072 + c) + dbg_b(ws, WS_GATE, row * 3072 + 1024 + c) + dbg_b(ws, WS_GATE, row * 3072 + 2048 + c);
        else if (code == 4) v = dbg_b(ws, WS_MIXB, row * 1024 + c);
        else if (code == 6) v = dbg_b(ws, WS_HFF, row * 2688 + c) + dbg_b(ws, WS_HFF, row * 2688 + 1024 + c) + dbg_b(ws, WS_HFF, row * 2688 + 1664 + c);
        else if (code == 9) { const int s0 = ((const int*)(ws + WS_POS))[row * 2], s1 = ((const int*)(ws + WS_POS))[row * 2 + 1]; v = dbg_b(ws, WS_XG, (size_t)s0 * 1024 + c) + 2.f * dbg_b(ws, WS_XG, (size_t)s1 * 1024 + c) + ((const float*)(ws + WS_TOPW))[row * 2] + (float)s0 * 1e-3f; }
        else if (code == 10) { const int s0 = ((const int*)(ws + WS_POS))[row * 2], s1 = ((const int*)(ws + WS_POS))[row * 2 + 1]; v = dbg_b(ws, WS_HG, (size_t)s0 * 3584 + c) + dbg_b(ws, WS_HG, (size_t)s1 * 3584 + 2560 + c) + dbg_b(ws, WS_HG, (size_t)s0 * 3584 + 1500 + c); }
        else if (code == 11) { const int s0 = ((const int*)(ws + WS_POS))[row * 2], s1 = ((const int*)(ws + WS_POS))[row * 2 + 1]; v = ((const float*)(ws + WS_OUTG))[(size_t)s0 * 1024 + c] + ((const float*)(ws + WS_OUTG))[(size_t)s1 * 1024 + c]; }
        else continue;
        if (tmo) v = __builtin_nanf("");
        out[i] = v; }
}
#define DBG(code) do { if (dbgc == (code)) { dbg_dump(F, kargs, code); return; } } while (0)
#else
#define DBG(code) do { } while (0)
#endif

__global__ void __launch_bounds__(NWAVES * 64, 2) fwd_kernel(Args args_by_value) {
    extern __shared__ __attribute__((aligned(16))) unsigned char lds_raw[];
    const ArgsP kargs = (ArgsP)__builtin_amdgcn_kernarg_segment_ptr();
    Frame F; F.lds = (LAS unsigned char*)lds_raw; F.G = gridDim.x; F.bid = blockIdx.x; F.NGW = F.G * NWAVES;
    for (int u = threadIdx.x; u < (LDS_BYTES - LDSCTL_OFF) / 4; u += NWAVES * 64) ((LAS unsigned*)(F.lds + LDSCTL_OFF))[u] = 0u;
    __syncthreads();
    volatile LAS unsigned* MISC = (volatile LAS unsigned*)(F.lds + MISC_OFF);
    XcdBarrier bar; { FRESH(a); bar = xcd_barrier_post((unsigned*)(a->ws + WS_CTL) + CW_BAR, MISC + 8); }
#define GRID_BAR() xcd_barrier(bar)

#ifdef ONLY_TEST
    ONLY_TEST; GRID_BAR(); return;
#endif
    const Frame F_ = F;
    int dbgc; { FRESH(a); dbgc = a->dbg; } (void)dbgc;
    phase_prologue(F, kargs); GRID_BAR();
#pragma unroll 1
    for (int l_ = 0; l_ < DEPTH; ++l_) {
        Frame F = F_; int l = l_; asm volatile("" : "+s"(F.G), "+s"(F.NGW), "+s"(F.bid), "+s"(l));
        const bool moe = (l & 1) != 0; const int j2 = l >> 1;
        if (l == 0) DBG(15);
#ifdef PROBE_INPROJ2
        { int reps = 2; asm volatile("" : "+s"(reps));
#pragma unroll 1
          for (int rep = 0; rep < reps; ++rep) { phase_inproj(F, kargs, l); GRID_BAR(); } }
#else
        phase_inproj(F, kargs, l); GRID_BAR(); if (l == 0) DBG(1); if (l == 0) DBG(14);
#endif
        phase_up(F, kargs, l); GRID_BAR(); if (l == 0) DBG(2);
        phase_attn(F, kargs, l); GRID_BAR(); if (l == 0) DBG(3); if (l == 0) DBG(13);
#ifdef PROBE_ATTN2
        phase_attn(F, kargs, l); GRID_BAR();
#endif
#ifdef PROBE_UP2
        phase_up(F, kargs, l); GRID_BAR();
#endif
        phase_branch(F, kargs); GRID_BAR(); if (l == 0) DBG(4);
#ifdef PROBE_RESID2
        { int reps = 2; asm volatile("" : "+s"(reps));
#pragma unroll 1
          for (int rep = reps - 1; rep >= 0; --rep) { phase_outproj(F, kargs, rep != 0); GRID_BAR(); } }
#else
        phase_outproj(F, kargs); GRID_BAR(); if (l == 0) DBG(5); if (l == 1) DBG(8);
#endif
        if (!moe) {
            phase_dense_conv(F, kargs, l, j2); GRID_BAR();
            phase_dense_up(F, kargs, l); GRID_BAR(); if (l == 0) DBG(6);
#ifdef PROBE_DENSE2
            phase_dense_up(F, kargs, l); GRID_BAR();
#endif
#ifdef PROBE_RESID2
            { int reps = 2; asm volatile("" : "+s"(reps));
#pragma unroll 1
              for (int rep = reps - 1; rep >= 0; --rep) { phase_dense_down(F, kargs, rep != 0); GRID_BAR(); } }
#else
            phase_dense_down(F, kargs); GRID_BAR(); if (l == 0) DBG(7);
#endif
        } else {
            phase_moe_route(F, kargs, l, j2); GRID_BAR();
            phase_moe_gather(F, kargs); GRID_BAR(); if (l == 1) DBG(9);
#ifdef PROBE_AUX2
            phase_moe_gather(F, kargs); GRID_BAR();
#endif
            phase_moe_up(F, kargs); GRID_BAR(); if (l == 1) DBG(10);
            phase_moe_down(F, kargs, j2); GRID_BAR(); if (l == 1) DBG(11);
#ifdef PROBE_MOE2
            phase_moe_up(F, kargs); GRID_BAR();
            phase_moe_down(F, kargs, j2); GRID_BAR();
#endif
            phase_moe_combine(F, kargs, l == DEPTH - 1);
            if (l != DEPTH - 1) GRID_BAR();
            if (l == 1) DBG(12);
        }
    }
}

extern "C" void kernel_launch(void* const* d_in, const int* in_sizes, int n_in, void* d_out, int out_size, void* d_ws, size_t ws_size, hipStream_t stream) {
    static int grid = 0;
    if (grid == 0) {
        if (n_in != 27 || in_sizes[0] != M * D || out_size != M * D || ws_size < WS_END) { fprintf(stderr, "kernel_launch: unexpected shapes (n_in %d, in0 %d, out %d, ws %zu)\n", n_in, n_in > 0 ? in_sizes[0] : -1, out_size, ws_size); grid = -1; return; }
        int dev = 0, cus = 0, per_cu = 0;
        if (hipGetDevice(&dev) != hipSuccess || hipDeviceGetAttribute(&cus, hipDeviceAttributeMultiprocessorCount, dev) != hipSuccess) { grid = -1; return; }
        if (hipFuncSetAttribute((const void*)fwd_kernel, hipFuncAttributeMaxDynamicSharedMemorySize, LDS_BYTES) != hipSuccess) { fprintf(stderr, "kernel_launch: hipFuncSetAttribute failed\n"); grid = -1; return; }
        if (hipOccupancyMaxActiveBlocksPerMultiprocessor(&per_cu, (const void*)fwd_kernel, NWAVES * 64, LDS_BYTES) != hipSuccess || per_cu < 1) { fprintf(stderr, "kernel_launch: occupancy query reports %d\n", per_cu); }
        (void)hipGetLastError();
        if (cus != 256) { fprintf(stderr, "kernel_launch: built for 256 CUs, device has %d\n", cus); grid = -1; return; }
        grid = 256;
    }
    if (grid < 0) return;
    if (hipMemsetAsync((char*)d_ws + WS_CTL, 0, CTL_ZERO_BYTES, stream) != hipSuccess) return;
    Args a{};
    a.x = (const float*)d_in[0]; a.mem = (const float*)d_in[1]; a.positions = (const int*)d_in[2]; a.g_mix = (const float*)d_in[3]; a.w_in = (const float*)d_in[4]; a.g_q = (const float*)d_in[5];
    a.g_kv = (const float*)d_in[6]; a.w_uq = (const float*)d_in[7]; a.w_uk = (const float*)d_in[8]; a.w_uv = (const float*)d_in[9]; a.g_sg = (const float*)d_in[10]; a.w_s = (const float*)d_in[11];
    a.b_s = (const float*)d_in[12]; a.g_mem = (const float*)d_in[13]; a.w_mkv = (const float*)d_in[14]; a.w_br = (const float*)d_in[15]; a.b_gate = (const float*)d_in[16]; a.w_out = (const float*)d_in[17];
    a.g_ffn = (const float*)d_in[18]; a.dense_w1 = (const float*)d_in[19]; a.dense_w3 = (const float*)d_in[20]; a.dense_w2 = (const float*)d_in[21]; a.w_router = (const float*)d_in[22];
    a.moe_w1 = (const float*)d_in[23]; a.moe_w3 = (const float*)d_in[24]; a.moe_w2 = (const float*)d_in[25]; a.g_final = (const float*)d_in[26];
    a.out = (float*)d_out; a.ws = (unsigned char*)d_ws;
#ifdef DBG_STOP
    a.dbg = DBG_STOP;
#endif
    hipLaunchKernelGGL(fwd_kernel, dim3(grid), dim3(NWAVES * 64), LDS_BYTES, stream, a);
    const hipError_t le = hipPeekAtLastError();
    if (le != hipSuccess) fprintf(stderr, "kernel_launch: launch failed: %s\n", hipGetErrorName(le));
}
```
